# Optimizing an MI355X kernel written in HIP

```python
import jax
import jax.numpy as jnp
from jax import lax
import numpy as np

D_MODEL = 1024
BATCH = 8
SEQ = 4096
DEPTH = 1

CHUNK = 64
Q_BLOCK = 128
LN_EPS = 1e-5
FOX_HEADS = 8
FOX_HEAD_DIM = 64
FOX_WIDTH = FOX_HEADS * FOX_HEAD_DIM
GLA_HEADS = 4
GLA_KEY_DIM = 64
GLA_VALUE_DIM = 128
GLA_KEY_WIDTH = GLA_HEADS * GLA_KEY_DIM
GLA_WIDTH = GLA_HEADS * GLA_VALUE_DIM
GLA_GATE_RANK = 16
GLA_GATE_TEMP = 16.0
MIX_WIDTH = FOX_WIDTH + GLA_WIDTH
N_EXPERTS = 256
N_GROUPS = 8
TOPK_GROUPS = 4
TOP_K = 8
EXPERT_DIM = 256
SHARED_DIM = 256
ROUTED_SCALE = 2.5
EXPERT_ROWS = 64
DEEPNORM_ALPHA = (2.0 * DEPTH) ** 0.25
DEEPNORM_BETA = (8.0 * DEPTH) ** -0.25
IN_SPLITS = (FOX_WIDTH, FOX_WIDTH, FOX_WIDTH, FOX_HEADS, GLA_KEY_WIDTH, GLA_KEY_WIDTH, GLA_WIDTH, GLA_GATE_RANK, GLA_WIDTH)
IN_SCALES = (1.0, 1.0, DEEPNORM_BETA, 1.0, 1.0, 1.0, DEEPNORM_BETA, 1.0, 1.0)
IN_WIDTH = sum(IN_SPLITS)

kernel_name = 'hybrid_fox_gla_moe_deepnorm_layer'


def layer_norm(x, g, b):
    xf = x.astype(jnp.float32)
    mu = jnp.mean(xf, axis=-1, keepdims=True)
    xc = xf - mu
    var = jnp.mean(xc * xc, axis=-1, keepdims=True)
    return (xc * lax.rsqrt(var + LN_EPS) * g + b).astype(x.dtype)


def rms_norm(x, g):
    xf = x.astype(jnp.float32)
    return xf * lax.rsqrt(jnp.mean(xf * xf, axis=-1, keepdims=True) + LN_EPS) * g


def forgetting_attention(q, k, v, log_f):
    B, S, H, Dh = q.shape
    scale = Dh ** -0.5
    c = jnp.cumsum(log_f, axis=1).transpose(0, 2, 1)
    outs = []
    for i in range(S // Q_BLOCK):
        q0, q1 = i * Q_BLOCK, (i + 1) * Q_BLOCK
        logits = jnp.einsum('bqhd,bkhd->bhqk', q[:, q0:q1], k[:, :q1]).astype(jnp.float32) * scale
        logits = logits + (c[:, :, q0:q1, None] - c[:, :, None, :q1])
        causal = jnp.arange(q0, q1)[:, None] >= jnp.arange(q1)[None, :]
        p = jax.nn.softmax(jnp.where(causal, logits, -jnp.inf), axis=-1)
        outs.append(jnp.einsum('bhqk,bkhd->bqhd', p.astype(v.dtype), v[:, :q1]))
    return jnp.concatenate(outs, axis=1)


def gla_chunked(q, k, v, log_a):
    B, S, H, Dk = q.shape
    Dv = v.shape[-1]
    N = S // CHUNK

    def to_chunks(t):
        return t.astype(jnp.float32).reshape(B, N, CHUNK, H, -1).transpose(1, 0, 3, 2, 4)

    qc = to_chunks(q) * (Dk ** -0.5)
    kc = to_chunks(k)
    vc = to_chunks(v)
    lac = to_chunks(log_a)
    causal = jnp.tril(jnp.ones((CHUNK, CHUNK), dtype=bool))

    def step(state, inp):
        qi, ki, vi, lai = inp
        b = jnp.cumsum(lai, axis=2)
        o_inter = jnp.einsum('bhtd,bhde->bhte', qi * jnp.exp(b), state)
        diff = b[:, :, :, None, :] - b[:, :, None, :, :]
        decay = jnp.exp(jnp.where(causal[:, :, None], diff, -jnp.inf))
        scores = jnp.einsum('bhtd,bhsd,bhtsd->bhts', qi, ki, decay)
        o_intra = jnp.einsum('bhts,bhse->bhte', scores, vi)
        b_last = b[:, :, -1:, :]
        new_state = (jnp.exp(b_last[:, :, 0, :, None]) * state
                     + jnp.einsum('bhsd,bhse->bhde', ki * jnp.exp(b_last - b), vi))
        return new_state, o_inter + o_intra

    state0 = jnp.zeros((B, H, Dk, Dv), jnp.float32)
    _, o = lax.scan(step, state0, (qc, kc, vc, lac))
    return o.transpose(1, 0, 3, 2, 4).reshape(B, S, H, Dv)


def hybrid_mixer(h, w_in, b_fgate, w_gate_up, b_gate, g_gla_norm, w_out):
    B, S, _ = h.shape
    proj = jnp.einsum('bsd,de->bse', h, w_in)
    fq, fk, fv, ff, gq, gk, gv, ga, gr = jnp.split(proj, np.cumsum(IN_SPLITS)[:-1].tolist(), axis=-1)
    log_f = jax.nn.log_sigmoid((ff + b_fgate).astype(jnp.float32))
    y_fox = forgetting_attention(fq.reshape(B, S, FOX_HEADS, FOX_HEAD_DIM),
                                 fk.reshape(B, S, FOX_HEADS, FOX_HEAD_DIM),
                                 fv.reshape(B, S, FOX_HEADS, FOX_HEAD_DIM), log_f)
    y_fox = y_fox.reshape(B, S, FOX_WIDTH).astype(h.dtype)
    gate_logits = jnp.einsum('bsr,rk->bsk', ga, w_gate_up) + b_gate
    log_a = jax.nn.log_sigmoid(gate_logits.astype(jnp.float32)) / GLA_GATE_TEMP
    o = gla_chunked(gq.reshape(B, S, GLA_HEADS, GLA_KEY_DIM),
                    gk.reshape(B, S, GLA_HEADS, GLA_KEY_DIM),
                    gv.reshape(B, S, GLA_HEADS, GLA_VALUE_DIM),
                    log_a.reshape(B, S, GLA_HEADS, GLA_KEY_DIM))
    o = rms_norm(o, g_gla_norm) * jax.nn.silu(gr.astype(jnp.float32)).reshape(B, S, GLA_HEADS, GLA_VALUE_DIM)
    y_gla = o.reshape(B, S, GLA_WIDTH).astype(h.dtype)
    y = jnp.concatenate([y_fox, y_gla], axis=-1)
    return jnp.einsum('bse,ed->bsd', y, w_out)


def swiglu(x, wg, wu, wd):
    return (jax.nn.silu(x @ wg) * (x @ wu)) @ wd


def moe_ffn(h, w_router, router_bias, w_exp_gate, w_exp_up, w_exp_down, w_sh_gate, w_sh_up, w_sh_down):
    B, S, D = h.shape
    xf = h.reshape(-1, D)
    T = B * S
    scores = jax.nn.sigmoid(jnp.einsum('td,de->te', xf.astype(jnp.float32), w_router.astype(jnp.float32)))
    biased = scores + router_bias.astype(jnp.float32)
    grp_score = lax.top_k(biased.reshape(T, N_GROUPS, N_EXPERTS // N_GROUPS), 2)[0].sum(-1)
    _, grp_idx = lax.top_k(grp_score, TOPK_GROUPS)
    grp_mask = jnp.any(grp_idx[:, :, None] == jnp.arange(N_GROUPS)[None, None, :], axis=1)
    expert_mask = jnp.repeat(grp_mask, N_EXPERTS // N_GROUPS, axis=1)
    _, top_idx = lax.top_k(jnp.where(expert_mask, biased, -jnp.inf), TOP_K)
    top_w = jnp.take_along_axis(scores, top_idx, axis=1)
    top_w = top_w / jnp.sum(top_w, axis=-1, keepdims=True) * ROUTED_SCALE
    A = T * TOP_K
    eid = top_idx.reshape(-1).astype(jnp.int32)
    tok = jnp.repeat(jnp.arange(T, dtype=jnp.int32), TOP_K)
    gate = top_w.reshape(-1)
    order = jnp.argsort(eid)
    eid_s, tok_s, gate_s = eid[order], tok[order], gate[order]
    counts = jnp.bincount(eid, length=N_EXPERTS).astype(jnp.int32)
    padded = (counts + EXPERT_ROWS - 1) // EXPERT_ROWS * EXPERT_ROWS
    start = jnp.cumsum(counts) - counts
    pend = jnp.cumsum(padded)
    pstart = pend - padded
    dest = pstart[eid_s] + jnp.arange(A, dtype=jnp.int32) - start[eid_s]
    P = -(-A // EXPERT_ROWS) * EXPERT_ROWS + N_EXPERTS * EXPERT_ROWS
    nb = P // EXPERT_ROWS
    row_tok = jnp.zeros((P,), jnp.int32).at[dest].set(tok_s)
    row_gate = jnp.zeros((P,), jnp.float32).at[dest].set(gate_s)
    blk_exp = jnp.minimum(jnp.searchsorted(pend, jnp.arange(nb, dtype=jnp.int32) * EXPERT_ROWS, side='right'),
                          N_EXPERTS - 1)

    def body(acc, inp):
        rt, rg, e = inp
        y = swiglu(xf[rt], w_exp_gate[e], w_exp_up[e], w_exp_down[e]).astype(jnp.float32) * rg[:, None]
        return acc.at[rt].add(y), None

    routed, _ = lax.scan(body, jnp.zeros((T, D), jnp.float32),
                         (row_tok.reshape(nb, EXPERT_ROWS), row_gate.reshape(nb, EXPERT_ROWS), blk_exp))
    shared = swiglu(xf, w_sh_gate, w_sh_up, w_sh_down).astype(jnp.float32)
    return (routed + shared).astype(h.dtype).reshape(B, S, D)


def setup_inputs(seed: int = 0) -> dict:
    key = jax.random.key(seed)
    ks = jax.random.split(key, 24)
    L, D = DEPTH, D_MODEL

    def nrm(k, shape, scale):
        return jax.random.normal(k, shape, jnp.float32) * scale

    col_scale = jnp.asarray(np.concatenate([np.full((n,), s, np.float32) for n, s in zip(IN_SPLITS, IN_SCALES)]))
    return {
        'x': jax.random.normal(ks[0], (BATCH, SEQ, D), jnp.float32),
        'ln_in_g': 1.0 + nrm(ks[1], (D,), 0.02),
        'ln_in_b': nrm(ks[2], (D,), 0.02),
        'w_in': nrm(ks[3], (L, D, IN_WIDTH), D ** -0.5) * col_scale,
        'b_fgate': jax.random.uniform(ks[4], (L, FOX_HEADS), jnp.float32, 1.0, 4.0),
        'w_gate_up': nrm(ks[5], (L, GLA_GATE_RANK, GLA_KEY_WIDTH), GLA_GATE_RANK ** -0.5),
        'b_gate': nrm(ks[6], (L, GLA_KEY_WIDTH), 0.1),
        'g_gla_norm': 1.0 + nrm(ks[7], (L, GLA_VALUE_DIM), 0.02),
        'w_out': nrm(ks[8], (L, MIX_WIDTH, D), MIX_WIDTH ** -0.5 * DEEPNORM_BETA),
        'ln1_g': 1.0 + nrm(ks[9], (L, D), 0.02),
        'ln1_b': nrm(ks[10], (L, D), 0.02),
        'w_router': nrm(ks[11], (L, D, N_EXPERTS), D ** -0.5),
        'router_bias': nrm(ks[12], (L, N_EXPERTS), 0.01),
        'w_exp_gate': nrm(ks[13], (L, N_EXPERTS, D, EXPERT_DIM), D ** -0.5),
        'w_exp_up': nrm(ks[14], (L, N_EXPERTS, D, EXPERT_DIM), D ** -0.5 * DEEPNORM_BETA),
        'w_exp_down': nrm(ks[15], (L, N_EXPERTS, EXPERT_DIM, D), EXPERT_DIM ** -0.5 * DEEPNORM_BETA),
        'w_sh_gate': nrm(ks[16], (L, D, SHARED_DIM), D ** -0.5),
        'w_sh_up': nrm(ks[17], (L, D, SHARED_DIM), D ** -0.5 * DEEPNORM_BETA),
        'w_sh_down': nrm(ks[18], (L, SHARED_DIM, D), SHARED_DIM ** -0.5 * DEEPNORM_BETA),
        'ln2_g': 1.0 + nrm(ks[19], (L, D), 0.02),
        'ln2_b': nrm(ks[20], (L, D), 0.02),
    }


def reference(x, ln_in_g, ln_in_b, w_in, b_fgate, w_gate_up, b_gate, g_gla_norm, w_out, ln1_g, ln1_b,
              w_router, router_bias, w_exp_gate, w_exp_up, w_exp_down, w_sh_gate, w_sh_up, w_sh_down,
              ln2_g, ln2_b):
    h = layer_norm(x, ln_in_g, ln_in_b)
    for l in range(DEPTH):
        mix = hybrid_mixer(h, w_in[l], b_fgate[l], w_gate_up[l], b_gate[l], g_gla_norm[l], w_out[l])
        h = layer_norm(DEEPNORM_ALPHA * h + mix, ln1_g[l], ln1_b[l])
        ffn = moe_ffn(h, w_router[l], router_bias[l], w_exp_gate[l], w_exp_up[l], w_exp_down[l],
                      w_sh_gate[l], w_sh_up[l], w_sh_down[l])
        h = layer_norm(DEEPNORM_ALPHA * h + ffn, ln2_g[l], ln2_b[l])
    return h
```

```cpp
#include <hip/hip_runtime.h>
#include <cstdio>
#include <cstdint>
#include <cmath>

namespace nv {
constexpr int D = 1024, B = 8, S = 4096, T = B * S;
constexpr int FH = 8, FD = 64, GH = 4, GK = 64, GV = 128, RANK = 16;
constexpr int INW = 3096;
constexpr int O_FQ = 0, O_FK = 512, O_FV = 1024, O_FF = 1536, O_GQ = 1544, O_GK = 1800, O_GV = 2056, O_GA = 2568, O_GR = 2584;
constexpr int NE = 256, NG = 8, TOPK = 8, ED = 256;
constexpr float LN_EPS = 1e-5f;
constexpr float ALPHA = 1.189207115002721f;
constexpr int PADR = 64;
constexpr int APAD = T * TOPK + NE * PADR;

__global__ __launch_bounds__(256) void ln_rows(const float* __restrict__ in1, float a, const float* __restrict__ in2,
                                               const float* __restrict__ g, const float* __restrict__ b, float* __restrict__ out) {
    __shared__ float red[8];
    const int r = blockIdx.x, tid = threadIdx.x;
    float4 v = ((const float4*)(in1 + (size_t)r * D))[tid];
    v.x *= a; v.y *= a; v.z *= a; v.w *= a;
    if (in2) { const float4 w = ((const float4*)(in2 + (size_t)r * D))[tid]; v.x += w.x; v.y += w.y; v.z += w.z; v.w += w.w; }
    float s = v.x + v.y + v.z + v.w;
    for (int o = 32; o > 0; o >>= 1) s += __shfl_xor(s, o);
    if ((tid & 63) == 0) red[tid >> 6] = s;
    __syncthreads();
    const float mean = (red[0] + red[1] + red[2] + red[3]) * (1.f / D);
    v.x -= mean; v.y -= mean; v.z -= mean; v.w -= mean;
    float q = v.x * v.x + v.y * v.y + v.z * v.z + v.w * v.w;
    for (int o = 32; o > 0; o >>= 1) q += __shfl_xor(q, o);
    if ((tid & 63) == 0) red[4 + (tid >> 6)] = q;
    __syncthreads();
    const float rstd = rsqrtf((red[4] + red[5] + red[6] + red[7]) * (1.f / D) + LN_EPS);
    const float4 gg = ((const float4*)g)[tid], bb = ((const float4*)b)[tid];
    float4 o4; o4.x = v.x * rstd * gg.x + bb.x; o4.y = v.y * rstd * gg.y + bb.y; o4.z = v.z * rstd * gg.z + bb.z; o4.w = v.w * rstd * gg.w + bb.w;
    ((float4*)(out + (size_t)r * D))[tid] = o4;
}

__global__ __launch_bounds__(256) void gemm_f32(const float* __restrict__ A, const float* __restrict__ Bm, float* __restrict__ C,
                                                int M, int N, int K, int lda, int ldb, int ldc) {
    __shared__ float As[16][68];
    __shared__ float Bs[16][68];
    const int tid = threadIdx.x, tx = tid & 15, ty = tid >> 4;
    const int row0 = blockIdx.y * 64, col0 = blockIdx.x * 64;
    float acc[4][4] = {};
    const int ar = tid >> 2, ak = (tid & 3) * 4;
    const int bk = tid >> 4, bc = (tid & 15) * 4;
    const bool bok = (col0 + bc) < N;
    for (int k0 = 0; k0 < K; k0 += 16) {
        const float4 av = *(const float4*)(A + (size_t)(row0 + ar) * lda + k0 + ak);
        float4 bv = make_float4(0.f, 0.f, 0.f, 0.f);
        if (bok) bv = *(const float4*)(Bm + (size_t)(k0 + bk) * ldb + col0 + bc);
        __syncthreads();
        As[ak + 0][ar] = av.x; As[ak + 1][ar] = av.y; As[ak + 2][ar] = av.z; As[ak + 3][ar] = av.w;
        *(float4*)&Bs[bk][bc] = bv;
        __syncthreads();
#pragma unroll
        for (int k = 0; k < 16; ++k) {
            const float4 a4 = *(const float4*)&As[k][ty * 4];
            const float4 b4 = *(const float4*)&Bs[k][tx * 4];
            const float aa[4] = {a4.x, a4.y, a4.z, a4.w}, bb[4] = {b4.x, b4.y, b4.z, b4.w};
#pragma unroll
            for (int i = 0; i < 4; ++i)
#pragma unroll
                for (int j = 0; j < 4; ++j) acc[i][j] += aa[i] * bb[j];
        }
    }
    if (col0 + tx * 4 < N) {
#pragma unroll
        for (int i = 0; i < 4; ++i)
            *(float4*)(C + (size_t)(row0 + ty * 4 + i) * ldc + col0 + tx * 4) = make_float4(acc[i][0], acc[i][1], acc[i][2], acc[i][3]);
    }
}

__device__ __forceinline__ float logsigmoidf(float x) { return fminf(x, 0.f) - log1pf(expf(-fabsf(x))); }
__device__ __forceinline__ float siluf(float x) { return x / (1.f + expf(-x)); }

__global__ __launch_bounds__(64) void fox_prep(const float* __restrict__ proj, const float* __restrict__ bf, float* __restrict__ cbuf) {
    const int bh = blockIdx.x, b = bh / FH, h = bh % FH, lane = threadIdx.x;
    const float bias = bf[h];
    float s = 0.f;
    for (int i = 0; i < 64; ++i) { const int t = lane * 64 + i; s += logsigmoidf(proj[(size_t)(b * S + t) * INW + O_FF + h] + bias); }
    float inc = s;
    for (int o = 1; o < 64; o <<= 1) { const float n = __shfl_up(inc, o); if (lane >= o) inc += n; }
    float run = inc - s;
    for (int i = 0; i < 64; ++i) { const int t = lane * 64 + i; run += logsigmoidf(proj[(size_t)(b * S + t) * INW + O_FF + h] + bias); cbuf[(size_t)bh * S + t] = run; }
}

__global__ __launch_bounds__(64) void fox_attn(const float* __restrict__ proj, const float* __restrict__ cbuf, float* __restrict__ y) {
    const int blk = blockIdx.x, qb = blk % (S / 64), bh = blk / (S / 64), b = bh / FH, h = bh % FH;
    const int t = qb * 64 + threadIdx.x;
    const float* qp = proj + (size_t)(b * S + t) * INW + O_FQ + h * FD;
    float q[64], o[64];
#pragma unroll
    for (int d = 0; d < 64; ++d) { q[d] = qp[d] * 0.125f; o[d] = 0.f; }
    const float ct = cbuf[(size_t)bh * S + t];
    float m = -INFINITY, l = 0.f;
    const int smax = qb * 64 + 63;
    for (int s = 0; s <= smax; ++s) {
        const float* kp = proj + (size_t)(b * S + s) * INW + O_FK + h * FD;
        const float* vp = proj + (size_t)(b * S + s) * INW + O_FV + h * FD;
        float dot = 0.f;
#pragma unroll
        for (int d = 0; d < 64; ++d) dot += q[d] * kp[d];
        const float x = dot + (ct - cbuf[(size_t)bh * S + s]);
        if (s <= t) {
            if (x > m) { const float al = expf(m - x); l *= al;
#pragma unroll
                for (int d = 0; d < 64; ++d) o[d] *= al;
                m = x; }
            const float p = expf(x - m); l += p;
#pragma unroll
            for (int d = 0; d < 64; ++d) o[d] += p * vp[d];
        }
    }
    const float il = 1.f / l;
    float* yp = y + (size_t)(b * S + t) * D + h * FD;
#pragma unroll
    for (int d = 0; d < 64; ++d) yp[d] = o[d] * il;
}

__global__ __launch_bounds__(256) void gla_prep(const float* __restrict__ proj, const float* __restrict__ wgu, const float* __restrict__ bg, float* __restrict__ abuf) {
    const int t = blockIdx.x, j = threadIdx.x;
    const float* ga = proj + (size_t)t * INW + O_GA;
    float s = bg[j];
#pragma unroll
    for (int r = 0; r < RANK; ++r) s += ga[r] * wgu[r * 256 + j];
    abuf[(size_t)t * 256 + j] = expf(logsigmoidf(s) * (1.f / 16.f));
}

__global__ __launch_bounds__(128) void gla_rec(const float* __restrict__ proj, const float* __restrict__ abuf, float* __restrict__ glao) {
    const int bh = blockIdx.x, b = bh / GH, h = bh % GH, e = threadIdx.x;
    float st[64];
#pragma unroll
    for (int d = 0; d < 64; ++d) st[d] = 0.f;
    for (int s = 0; s < S; ++s) {
        const size_t t = (size_t)b * S + s;
        const float* qp = proj + t * INW + O_GQ + h * GK;
        const float* kp = proj + t * INW + O_GK + h * GK;
        const float* ap = abuf + t * 256 + h * GK;
        const float v = proj[t * INW + O_GV + h * GV + e];
        float o = 0.f;
#pragma unroll
        for (int d = 0; d < 64; ++d) { st[d] = ap[d] * st[d] + kp[d] * v; o += qp[d] * st[d]; }
        glao[t * 512 + h * GV + e] = o * 0.125f;
    }
}

__global__ __launch_bounds__(256) void gla_post(const float* __restrict__ glao, const float* __restrict__ proj, const float* __restrict__ g, float* __restrict__ y) {
    const int w = blockIdx.x * 4 + (threadIdx.x >> 6), lane = threadIdx.x & 63;
    const int t = w >> 2, h = w & 3;
    const float o0 = glao[(size_t)t * 512 + h * GV + lane], o1 = glao[(size_t)t * 512 + h * GV + 64 + lane];
    float ss = o0 * o0 + o1 * o1;
    for (int o = 32; o > 0; o >>= 1) ss += __shfl_xor(ss, o);
    const float r = rsqrtf(ss * (1.f / GV) + LN_EPS);
    const float g0 = proj[(size_t)t * INW + O_GR + h * GV + lane], g1 = proj[(size_t)t * INW + O_GR + h * GV + 64 + lane];
    y[(size_t)t * D + 512 + h * GV + lane] = o0 * r * g[lane] * siluf(g0);
    y[(size_t)t * D + 512 + h * GV + 64 + lane] = o1 * r * g[64 + lane] * siluf(g1);
}

__global__ __launch_bounds__(256) void routing(const float* __restrict__ logits, const float* __restrict__ rbias,
                                               int* __restrict__ top_e, float* __restrict__ top_w, int* __restrict__ top_pos, int* __restrict__ counts) {
    const int t = blockIdx.x * 4 + (threadIdx.x >> 6), lane = threadIdx.x & 63;
    const float4 lg = ((const float4*)(logits + (size_t)t * NE))[lane];
    const float4 rb = ((const float4*)rbias)[lane];
    float sc[4] = {1.f / (1.f + expf(-lg.x)), 1.f / (1.f + expf(-lg.y)), 1.f / (1.f + expf(-lg.z)), 1.f / (1.f + expf(-lg.w))};
    float bv[4] = {sc[0] + rb.x, sc[1] + rb.y, sc[2] + rb.z, sc[3] + rb.w};
    float m1 = fmaxf(bv[0], bv[1]), m2 = fminf(bv[0], bv[1]);
    { const float a = fmaxf(bv[2], bv[3]), c = fminf(bv[2], bv[3]); const float n1 = fmaxf(m1, a); m2 = fmaxf(fminf(m1, a), fmaxf(m2, c)); m1 = n1; }
    for (int o = 1; o < 8; o <<= 1) { const float p1 = __shfl_xor(m1, o), p2 = __shfl_xor(m2, o); const float n1 = fmaxf(m1, p1); m2 = fmaxf(fminf(m1, p1), fmaxf(m2, p2)); m1 = n1; }
    const float gs = m1 + m2;
    const int myg = lane >> 3;
    int rank = 0;
    for (int g2 = 0; g2 < NG; ++g2) { const float og = __shfl(gs, g2 * 8); if (og > gs || (og == gs && g2 < myg)) ++rank; }
    const bool sel = rank < 4;
    float mv[4];
#pragma unroll
    for (int i = 0; i < 4; ++i) mv[i] = sel ? bv[i] : -INFINITY;
    int we[TOPK]; float ws[TOPK]; float wsum = 0.f;
#pragma unroll
    for (int k = 0; k < TOPK; ++k) {
        float bvv = mv[0]; int bi = 0;
#pragma unroll
        for (int i = 1; i < 4; ++i) if (mv[i] > bvv) { bvv = mv[i]; bi = i; }
        int gi = lane * 4 + bi;
        for (int o = 32; o > 0; o >>= 1) { const float ov = __shfl_xor(bvv, o); const int oi = __shfl_xor(gi, o); if (ov > bvv || (ov == bvv && oi < gi)) { bvv = ov; gi = oi; } }
        const int ol = gi >> 2, oi = gi & 3;
        float s_own = (oi == 0) ? sc[0] : (oi == 1) ? sc[1] : (oi == 2) ? sc[2] : sc[3];
        const float sw = __shfl(s_own, ol);
        if (lane == ol) { if (oi == 0) mv[0] = -INFINITY; else if (oi == 1) mv[1] = -INFINITY; else if (oi == 2) mv[2] = -INFINITY; else mv[3] = -INFINITY; }
        we[k] = gi; ws[k] = sw; wsum += sw;
    }
    if (lane == 0) {
        const float inv = 2.5f / wsum;
#pragma unroll
        for (int k = 0; k < TOPK; ++k) {
            top_e[t * TOPK + k] = we[k]; top_w[t * TOPK + k] = ws[k] * inv;
            top_pos[t * TOPK + k] = atomicAdd(&counts[we[k]], 1);
        }
    }
}

__global__ __launch_bounds__(256) void moe_offsets(const int* __restrict__ counts, int* __restrict__ off, int* __restrict__ blk_exp, int* __restrict__ nblk) {
    __shared__ int sp[256];
    const int e = threadIdx.x;
    const int pc = (counts[e] + PADR - 1) / PADR * PADR;
    sp[e] = pc; __syncthreads();
    for (int o = 1; o < 256; o <<= 1) { const int v = (e >= o) ? sp[e - o] : 0; __syncthreads(); sp[e] += v; __syncthreads(); }
    const int start = sp[e] - pc;
    off[e] = start;
    for (int i = start / PADR; i < (start + pc) / PADR; ++i) blk_exp[i] = e;
    if (e == 255) nblk[0] = sp[255] / PADR;
}

__global__ __launch_bounds__(256) void moe_scatter(const int* __restrict__ top_e, const float* __restrict__ top_w, const int* __restrict__ top_pos, const int* __restrict__ off,
                                                   int* __restrict__ row_tok, float* __restrict__ row_gate, int* __restrict__ slot_of) {
    const int a = blockIdx.x * 256 + threadIdx.x;
    const int slot = off[top_e[a]] + top_pos[a];
    row_tok[slot] = a / TOPK; row_gate[slot] = top_w[a]; slot_of[a] = slot;
}

__global__ __launch_bounds__(256) void moe_hidden(const float* __restrict__ h1, const float* __restrict__ wg, const float* __restrict__ wu,
                                                  const int* __restrict__ row_tok, const float* __restrict__ row_gate, const int* __restrict__ blk_exp, const int* __restrict__ nblk,
                                                  float* __restrict__ hidden) {
    __shared__ float xs[16][D];
    const int g16 = blockIdx.x;
    if (g16 * 16 >= nblk[0] * PADR) return;
    const int e = blk_exp[(g16 * 16) / PADR];
    const int j = threadIdx.x;
    for (int r = 0; r < 16; ++r) { const int tok = row_tok[g16 * 16 + r]; ((float4*)xs[r])[j] = ((const float4*)(h1 + (size_t)tok * D))[j]; }
    __syncthreads();
    float ag[16], au[16];
#pragma unroll
    for (int r = 0; r < 16; ++r) { ag[r] = 0.f; au[r] = 0.f; }
    const float* wgp = wg + (size_t)e * D * ED + j; const float* wup = wu + (size_t)e * D * ED + j;
    for (int d = 0; d < D; d += 4) {
        const float g0 = wgp[(size_t)(d + 0) * ED], g1 = wgp[(size_t)(d + 1) * ED], g2 = wgp[(size_t)(d + 2) * ED], g3 = wgp[(size_t)(d + 3) * ED];
        const float u0 = wup[(size_t)(d + 0) * ED], u1 = wup[(size_t)(d + 1) * ED], u2 = wup[(size_t)(d + 2) * ED], u3 = wup[(size_t)(d + 3) * ED];
#pragma unroll
        for (int r = 0; r < 16; ++r) { const float4 x = *(const float4*)&xs[r][d];
            ag[r] += x.x * g0 + x.y * g1 + x.z * g2 + x.w * g3; au[r] += x.x * u0 + x.y * u1 + x.z * u2 + x.w * u3; }
    }
#pragma unroll
    for (int r = 0; r < 16; ++r) hidden[(size_t)(g16 * 16 + r) * ED + j] = row_gate[g16 * 16 + r] * siluf(ag[r]) * au[r];
}

__global__ __launch_bounds__(256) void moe_down(const float* __restrict__ hidden, const float* __restrict__ wd, const int* __restrict__ top_e, const int* __restrict__ slot_of, float* __restrict__ ffn) {
    __shared__ float hs[ED];
    const int t = blockIdx.x, i = threadIdx.x;
    float4 acc = ((float4*)(ffn + (size_t)t * D))[i];
    for (int k = 0; k < TOPK; ++k) {
        const int e = top_e[t * TOPK + k], slot = slot_of[t * TOPK + k];
        __syncthreads();
        hs[i] = hidden[(size_t)slot * ED + i];
        __syncthreads();
        const float4* wp = (const float4*)(wd + (size_t)e * ED * D) + i;
        for (int j = 0; j < ED; ++j) { const float4 w = wp[(size_t)j * (D / 4)]; const float hv = hs[j]; acc.x += hv * w.x; acc.y += hv * w.y; acc.z += hv * w.z; acc.w += hv * w.w; }
    }
    ((float4*)(ffn + (size_t)t * D))[i] = acc;
}

__global__ __launch_bounds__(256) void swiglu_ew(float* __restrict__ g, const float* __restrict__ u, size_t n) {
    const size_t i = (size_t)blockIdx.x * 256 + threadIdx.x; if (i < n) g[i] = siluf(g[i]) * u[i];
}
}

extern "C" void kernel_launch(void* const* d_in, const int* in_sizes, int n_in, void* d_out, int out_size, void* d_ws, size_t ws_size, hipStream_t stream) {
    using namespace nv;
    const size_t MiB = 1u << 20;
    if (n_in != 21 || out_size != T * D || ws_size < 1024 * MiB) { fprintf(stderr, "kernel_launch: unexpected shapes n_in=%d out=%d ws=%zu\n", n_in, out_size, ws_size); return; }
    const float* x = (const float*)d_in[0];
    const float* ln_in_g = (const float*)d_in[1]; const float* ln_in_b = (const float*)d_in[2];
    const float* w_in = (const float*)d_in[3]; const float* b_fgate = (const float*)d_in[4];
    const float* w_gate_up = (const float*)d_in[5]; const float* b_gate = (const float*)d_in[6]; const float* g_gla = (const float*)d_in[7];
    const float* w_out = (const float*)d_in[8]; const float* ln1_g = (const float*)d_in[9]; const float* ln1_b = (const float*)d_in[10];
    const float* w_router = (const float*)d_in[11]; const float* rbias = (const float*)d_in[12];
    const float* w_eg = (const float*)d_in[13]; const float* w_eu = (const float*)d_in[14]; const float* w_ed = (const float*)d_in[15];
    const float* w_sg = (const float*)d_in[16]; const float* w_su = (const float*)d_in[17]; const float* w_sd = (const float*)d_in[18];
    const float* ln2_g = (const float*)d_in[19]; const float* ln2_b = (const float*)d_in[20];
    float* out = (float*)d_out;
    char* ws = (char*)d_ws;
    int* counts = (int*)(ws);
    int* off = counts + 256; int* nblk = off + 256; int* blk_exp = nblk + 64;
    float* h0 = (float*)(ws + 1 * MiB);
    float* proj = (float*)(ws + 129 * MiB);
    float* abuf = (float*)(ws + 537 * MiB);
    float* cbuf = (float*)(ws + 569 * MiB);
    float* glao = (float*)(ws + 570 * MiB);
    float* y = (float*)(ws + 634 * MiB);
    float* mix = (float*)(ws + 762 * MiB);
    float* h1 = (float*)(ws + 890 * MiB);
    int* top_e = (int*)(ws + 1018 * MiB); float* top_w = (float*)(ws + 1019 * MiB); int* top_pos = (int*)(ws + 1020 * MiB); int* slot_of = top_pos;
    int* row_tok = (int*)(ws + 1021 * MiB); float* row_gate2 = (float*)(ws + 1022 * MiB + 256 * 1024);
    float* logits = (float*)(ws + 129 * MiB);
    float* hidden = (float*)(ws + 161 * MiB);
    float* shg = (float*)(ws + 446 * MiB); float* shu = (float*)(ws + 478 * MiB);
    float* ffn = (float*)(ws + 510 * MiB);

    hipMemsetAsync(ws, 0, 64 * 1024, stream);
    hipMemsetAsync(row_tok, 0, 2 * MiB + 512 * 1024, stream);
    ln_rows<<<T, 256, 0, stream>>>(x, 1.f, nullptr, ln_in_g, ln_in_b, h0);
    gemm_f32<<<dim3((INW + 63) / 64, T / 64), 256, 0, stream>>>(h0, w_in, proj, T, INW, D, D, INW, INW);
    fox_prep<<<B * FH, 64, 0, stream>>>(proj, b_fgate, cbuf);
    fox_attn<<<B * FH * (S / 64), 64, 0, stream>>>(proj, cbuf, y);
    gla_prep<<<T, 256, 0, stream>>>(proj, w_gate_up, b_gate, abuf);
    gla_rec<<<B * GH, 128, 0, stream>>>(proj, abuf, glao);
    gla_post<<<T, 256, 0, stream>>>(glao, proj, g_gla, y);
    gemm_f32<<<dim3(D / 64, T / 64), 256, 0, stream>>>(y, w_out, mix, T, D, D, D, D, D);
    ln_rows<<<T, 256, 0, stream>>>(h0, ALPHA, mix, ln1_g, ln1_b, h1);
    gemm_f32<<<dim3(NE / 64, T / 64), 256, 0, stream>>>(h1, w_router, logits, T, NE, D, D, NE, NE);
    routing<<<T / 4, 256, 0, stream>>>(logits, rbias, top_e, top_w, top_pos, counts);
    moe_offsets<<<1, 256, 0, stream>>>(counts, off, blk_exp, nblk);
    moe_scatter<<<T * TOPK / 256, 256, 0, stream>>>(top_e, top_w, top_pos, off, row_tok, row_gate2, slot_of);
    moe_hidden<<<APAD / 16, 256, 0, stream>>>(h1, w_eg, w_eu, row_tok, row_gate2, blk_exp, nblk, hidden);
    gemm_f32<<<dim3(ED / 64, T / 64), 256, 0, stream>>>(h1, w_sg, shg, T, ED, D, D, ED, ED);
    gemm_f32<<<dim3(ED / 64, T / 64), 256, 0, stream>>>(h1, w_su, shu, T, ED, D, D, ED, ED);
    swiglu_ew<<<(T * ED) / 256, 256, 0, stream>>>(shg, shu, (size_t)T * ED);
    gemm_f32<<<dim3(D / 64, T / 64), 256, 0, stream>>>(shg, w_sd, ffn, T, D, ED, ED, D, D);
    moe_down<<<T, 256, 0, stream>>>(hidden, w_ed, top_e, slot_of, ffn);
    ln_rows<<<T, 256, 0, stream>>>(h1, ALPHA, ffn, ln2_g, ln2_b, out);
}
```

```cpp
#include <hip/hip_runtime.h>
#include <cstdio>
#include <cstdint>
#include <cmath>

#define LAS __attribute__((address_space(3)))
#define GAS __attribute__((address_space(1)))

#define XB_TMO      128
#define XB_XCNT(j)  (256  + 64 * (j))
#define XB_XSUB(j)  (1280 + 64 * (j))
#define XB_XGEN(j)  (2304 + 64 * (j))
#define XB_TOP      3328
#define XB_TOPGEN   3392
#define XCD_BAR_WORDS 3456
#define XB_SPIN_CAP (1u << 27)
__device__ __forceinline__ unsigned xb_ld(unsigned* p)              { return __hip_atomic_load(p, __ATOMIC_RELAXED, __HIP_MEMORY_SCOPE_AGENT); }
__device__ __forceinline__ unsigned xb_add(unsigned* p, unsigned v) { return __hip_atomic_fetch_add(p, v, __ATOMIC_RELAXED, __HIP_MEMORY_SCOPE_AGENT); }
__device__ __forceinline__ unsigned xb_xcc_id() { return (unsigned)__builtin_amdgcn_s_getreg((3 << 11) | 20) & 0xFu; }
#define XB_SPIN(cond, bar) do { unsigned _sp = 0; while (cond) { __builtin_amdgcn_s_sleep(1); \
    if ((++_sp & 255u) == 0u) { if (xb_ld(&(bar)[XB_TMO])) break; if (_sp > XB_SPIN_CAP) { atomicAdd(&(bar)[XB_TMO], 1u); break; } } } } while (0)
struct XcdBarrier { unsigned* bar; unsigned x; volatile LAS unsigned* st; };
__device__ __forceinline__ XcdBarrier xcd_barrier_post(unsigned* bar, volatile LAS unsigned* st) {
    XcdBarrier b; b.bar = bar; b.x = xb_xcc_id(); b.st = st;
    if (threadIdx.x == 0) (void)xb_add(&bar[XB_XCNT(b.x)], 1u);
    return b;
}
__device__ __forceinline__ void xcd_barrier_complete(unsigned* bar, unsigned x, unsigned& nloc, unsigned& nx) {
    const unsigned G = gridDim.x * gridDim.y * gridDim.z;
    unsigned sum, cnt, mine, sp = 0u;
    for (;;) {
        sum = 0u; cnt = 0u; mine = 0u;
#pragma unroll
        for (unsigned j = 0; j < 16; ++j) { const unsigned c = xb_ld(&bar[XB_XCNT(j)]); sum += c; cnt += (c > 0u) ? 1u : 0u; mine = (j == x) ? c : mine; }
        if (sum == G) break;
        __builtin_amdgcn_s_sleep(1);
        if ((++sp & 255u) == 0u) { if (xb_ld(&bar[XB_TMO])) break; if (sp > XB_SPIN_CAP) { atomicAdd(&bar[XB_TMO], 1u); break; } }
    }
    nloc = mine > 0u ? mine : 1u; nx = cnt > 0u ? cnt : 1u;
}
__device__ __forceinline__ void xcd_barrier(const XcdBarrier& b) {
    asm volatile("s_waitcnt vmcnt(0)" ::: "memory");
    __syncthreads();
    if (threadIdx.x == 0) {
        unsigned* bar = b.bar;
        __builtin_amdgcn_s_waitcnt(0);
        unsigned nloc = b.st[0], nx = b.st[1];
        if (nloc == 0u) { xcd_barrier_complete(bar, b.x, nloc, nx); b.st[0] = nloc; b.st[1] = nx; }
        const unsigned old = xb_add(&bar[XB_XSUB(b.x)], 1u);
        const unsigned gen = old / nloc;
        if (old + 1u == (gen + 1u) * nloc) {
            __builtin_amdgcn_fence(__ATOMIC_RELEASE, "agent");
            asm volatile("s_waitcnt vmcnt(0)" ::: "memory");
            const unsigned og = xb_add(&bar[XB_TOP], 1u);
            const unsigned tg = og / nx;
            if (og + 1u == (tg + 1u) * nx) xb_add(&bar[XB_TOPGEN], 1u);
            else XB_SPIN(xb_ld(&bar[XB_TOPGEN]) == tg, bar);
            __builtin_amdgcn_fence(__ATOMIC_ACQUIRE, "agent");
            xb_add(&bar[XB_XGEN(b.x)], 1u);
            asm volatile("s_waitcnt vmcnt(0)" ::: "memory");
        } else {
            XB_SPIN(xb_ld(&bar[XB_XGEN(b.x)]) == gen, bar);
            __builtin_amdgcn_fence(__ATOMIC_ACQUIRE, "agent");
            asm volatile("s_waitcnt vmcnt(0)" ::: "memory");
        }
    }
    __syncthreads();
}

namespace nv {
constexpr int D = 1024, B = 8, S = 4096, T = B * S;
constexpr int FH = 8, FD = 64, GH = 4, GK = 64, GV = 128, RANK = 16;
constexpr int INW = 3096;
constexpr int O_FQ = 0, O_FK = 512, O_FV = 1024, O_FF = 1536, O_GQ = 1544, O_GK = 1800, O_GV = 2056, O_GA = 2568, O_GR = 2584;
constexpr int NE = 256, NG = 8, TOPK = 8, ED = 256;
constexpr float LN_EPS = 1e-5f;
constexpr float ALPHA = 1.189207115002721f;
constexpr int PADR = 64;
constexpr int APAD = T * TOPK + NE * PADR;

__device__ __forceinline__ float logsigmoidf(float x) { return fminf(x, 0.f) - log1pf(expf(-fabsf(x))); }
__device__ __forceinline__ float siluf(float x) { return x / (1.f + expf(-x)); }


__device__ __forceinline__ void ln_row(const float* in1, float a, const float* in2, const float* __restrict__ g, const float* __restrict__ b, float* out, int r, int tid, float* sh) {
    float4 v = ((const float4*)(in1 + (size_t)r * D))[tid];
    v.x *= a; v.y *= a; v.z *= a; v.w *= a;
    if (in2) { const float4 w = ((const float4*)(in2 + (size_t)r * D))[tid]; v.x += w.x; v.y += w.y; v.z += w.z; v.w += w.w; }
    float s = v.x + v.y + v.z + v.w;
    for (int o = 32; o > 0; o >>= 1) s += __shfl_xor(s, o);
    __syncthreads();
    if ((tid & 63) == 0) sh[tid >> 6] = s;
    __syncthreads();
    const float mean = (sh[0] + sh[1] + sh[2] + sh[3]) * (1.f / D);
    v.x -= mean; v.y -= mean; v.z -= mean; v.w -= mean;
    float q = v.x * v.x + v.y * v.y + v.z * v.z + v.w * v.w;
    for (int o = 32; o > 0; o >>= 1) q += __shfl_xor(q, o);
    if ((tid & 63) == 0) sh[4 + (tid >> 6)] = q;
    __syncthreads();
    const float rstd = rsqrtf((sh[4] + sh[5] + sh[6] + sh[7]) * (1.f / D) + LN_EPS);
    const float4 gg = ((const float4*)g)[tid], bb = ((const float4*)b)[tid];
    float4 o4; o4.x = v.x * rstd * gg.x + bb.x; o4.y = v.y * rstd * gg.y + bb.y; o4.z = v.z * rstd * gg.z + bb.z; o4.w = v.w * rstd * gg.w + bb.w;
    ((float4*)(out + (size_t)r * D))[tid] = o4;
}

__device__ __forceinline__ void gemm_tile(const float* A, const float* Bm, float* C, int N, int K, int lda, int ldb, int ldc, int tile_x, int tile_y, int tid, float* sh) {
    float (*As)[68] = (float (*)[68])sh;
    float (*Bs)[68] = (float (*)[68])(sh + 16 * 68);
    const int tx = tid & 15, ty = tid >> 4;
    const int row0 = tile_y * 64, col0 = tile_x * 64;
    float acc[4][4] = {};
    const int ar = tid >> 2, ak = (tid & 3) * 4;
    const int bk = tid >> 4, bc = (tid & 15) * 4;
    const bool bok = (col0 + bc) < N;
    for (int k0 = 0; k0 < K; k0 += 16) {
        const float4 av = *(const float4*)(A + (size_t)(row0 + ar) * lda + k0 + ak);
        float4 bv = make_float4(0.f, 0.f, 0.f, 0.f);
        if (bok) bv = *(const float4*)(Bm + (size_t)(k0 + bk) * ldb + col0 + bc);
        __syncthreads();
        As[ak + 0][ar] = av.x; As[ak + 1][ar] = av.y; As[ak + 2][ar] = av.z; As[ak + 3][ar] = av.w;
        *(float4*)&Bs[bk][bc] = bv;
        __syncthreads();
#pragma unroll
        for (int k = 0; k < 16; ++k) {
            const float4 a4 = *(const float4*)&As[k][ty * 4];
            const float4 b4 = *(const float4*)&Bs[k][tx * 4];
            const float aa[4] = {a4.x, a4.y, a4.z, a4.w}, bb[4] = {b4.x, b4.y, b4.z, b4.w};
#pragma unroll
            for (int i = 0; i < 4; ++i)
#pragma unroll
                for (int j = 0; j < 4; ++j) acc[i][j] += aa[i] * bb[j];
        }
    }
    if (col0 + tx * 4 < N) {
#pragma unroll
        for (int i = 0; i < 4; ++i)
            *(float4*)(C + (size_t)(row0 + ty * 4 + i) * ldc + col0 + tx * 4) = make_float4(acc[i][0], acc[i][1], acc[i][2], acc[i][3]);
    }
}
__device__ __forceinline__ void gemm_phase(const float* A, const float* Bm, float* C, int M, int N, int K, int lda, int ldb, int ldc, int half, int tid, float* sh) {
    const int ntx = (N + 63) / 64, nty = M / 64, ntile = ntx * nty, G2 = gridDim.x * 2;
    for (int t0 = blockIdx.x * 2; t0 < ntile; t0 += G2) {
        int tl = t0 + half; if (tl >= ntile) tl = ntile - 1;
        gemm_tile(A, Bm, C, N, K, lda, ldb, ldc, tl % ntx, tl / ntx, tid, sh);
    }
}

__device__ __forceinline__ void fox_prep(const float* proj, const float* __restrict__ bf, float* cbuf, int bh, int lane) {
    const int b = bh / FH, h = bh % FH;
    const float bias = bf[h];
    float s = 0.f;
    for (int i = 0; i < 64; ++i) { const int t = lane * 64 + i; s += logsigmoidf(proj[(size_t)(b * S + t) * INW + O_FF + h] + bias); }
    float inc = s;
    for (int o = 1; o < 64; o <<= 1) { const float n = __shfl_up(inc, o); if (lane >= o) inc += n; }
    float run = inc - s;
    for (int i = 0; i < 64; ++i) { const int t = lane * 64 + i; run += logsigmoidf(proj[(size_t)(b * S + t) * INW + O_FF + h] + bias); cbuf[(size_t)bh * S + t] = run; }
}

__device__ __forceinline__ void fox_attn(const float* proj, const float* cbuf, float* y, int blk, int lane) {
    const int qb = blk % (S / 64), bh = blk / (S / 64), b = bh / FH, h = bh % FH;
    const int t = qb * 64 + lane;
    const float* qp = proj + (size_t)(b * S + t) * INW + O_FQ + h * FD;
    float q[64], o[64];
#pragma unroll
    for (int d = 0; d < 64; ++d) { q[d] = qp[d] * 0.125f; o[d] = 0.f; }
    const float ct = cbuf[(size_t)bh * S + t];
    float m = -INFINITY, l = 0.f;
    const int smax = qb * 64 + 63;
    for (int s = 0; s <= smax; ++s) {
        const float* kp = proj + (size_t)(b * S + s) * INW + O_FK + h * FD;
        const float* vp = proj + (size_t)(b * S + s) * INW + O_FV + h * FD;
        float dot = 0.f;
#pragma unroll
        for (int d = 0; d < 64; ++d) dot += q[d] * kp[d];
        const float x = dot + (ct - cbuf[(size_t)bh * S + s]);
        if (s <= t) {
            if (x > m) { const float al = expf(m - x); l *= al;
#pragma unroll
                for (int d = 0; d < 64; ++d) o[d] *= al;
                m = x; }
            const float p = expf(x - m); l += p;
#pragma unroll
            for (int d = 0; d < 64; ++d) o[d] += p * vp[d];
        }
    }
    const float il = 1.f / l;
    float* yp = y + (size_t)(b * S + t) * D + h * FD;
#pragma unroll
    for (int d = 0; d < 64; ++d) yp[d] = o[d] * il;
}

__device__ __forceinline__ void gla_prep(const float* proj, const float* __restrict__ wgu, const float* __restrict__ bg, float* abuf, int t, int j) {
    const float* ga = proj + (size_t)t * INW + O_GA;
    float s = bg[j];
#pragma unroll
    for (int r = 0; r < RANK; ++r) s += ga[r] * wgu[r * 256 + j];
    abuf[(size_t)t * 256 + j] = expf(logsigmoidf(s) * (1.f / 16.f));
}

__device__ __forceinline__ void gla_rec(const float* proj, const float* abuf, float* glao, int bh, int e) {
    const int b = bh / GH, h = bh % GH;
    float st[64];
#pragma unroll
    for (int d = 0; d < 64; ++d) st[d] = 0.f;
    for (int s = 0; s < S; ++s) {
        const size_t t = (size_t)b * S + s;
        const float* qp = proj + t * INW + O_GQ + h * GK;
        const float* kp = proj + t * INW + O_GK + h * GK;
        const float* ap = abuf + t * 256 + h * GK;
        const float v = proj[t * INW + O_GV + h * GV + e];
        float o = 0.f;
#pragma unroll
        for (int d = 0; d < 64; ++d) { st[d] = ap[d] * st[d] + kp[d] * v; o += qp[d] * st[d]; }
        glao[t * 512 + h * GV + e] = o * 0.125f;
    }
}

__device__ __forceinline__ void gla_post(const float* glao, const float* proj, const float* __restrict__ g, float* y, int w, int lane) {
    const int t = w >> 2, h = w & 3;
    const float o0 = glao[(size_t)t * 512 + h * GV + lane], o1 = glao[(size_t)t * 512 + h * GV + 64 + lane];
    float ss = o0 * o0 + o1 * o1;
    for (int o = 32; o > 0; o >>= 1) ss += __shfl_xor(ss, o);
    const float r = rsqrtf(ss * (1.f / GV) + LN_EPS);
    const float g0 = proj[(size_t)t * INW + O_GR + h * GV + lane], g1 = proj[(size_t)t * INW + O_GR + h * GV + 64 + lane];
    y[(size_t)t * D + 512 + h * GV + lane] = o0 * r * g[lane] * siluf(g0);
    y[(size_t)t * D + 512 + h * GV + 64 + lane] = o1 * r * g[64 + lane] * siluf(g1);
}

__device__ __forceinline__ void route_token(const float* logits, const float* __restrict__ rbias, int* top_e, float* top_w, int* top_pos, int* counts, int t, int lane) {
    const float4 lg = ((const float4*)(logits + (size_t)t * NE))[lane];
    const float4 rb = ((const float4*)rbias)[lane];
    float sc[4] = {1.f / (1.f + expf(-lg.x)), 1.f / (1.f + expf(-lg.y)), 1.f / (1.f + expf(-lg.z)), 1.f / (1.f + expf(-lg.w))};
    float bv[4] = {sc[0] + rb.x, sc[1] + rb.y, sc[2] + rb.z, sc[3] + rb.w};
    float m1 = fmaxf(bv[0], bv[1]), m2 = fminf(bv[0], bv[1]);
    { const float a = fmaxf(bv[2], bv[3]), c = fminf(bv[2], bv[3]); const float n1 = fmaxf(m1, a); m2 = fmaxf(fminf(m1, a), fmaxf(m2, c)); m1 = n1; }
    for (int o = 1; o < 8; o <<= 1) { const float p1 = __shfl_xor(m1, o), p2 = __shfl_xor(m2, o); const float n1 = fmaxf(m1, p1); m2 = fmaxf(fminf(m1, p1), fmaxf(m2, p2)); m1 = n1; }
    const float gs = m1 + m2;
    const int myg = lane >> 3;
    int rank = 0;
#pragma unroll
    for (int g2 = 0; g2 < NG; ++g2) { const float og = __shfl(gs, g2 * 8); if (og > gs || (og == gs && g2 < myg)) ++rank; }
    const bool sel = rank < 4;
    float mv[4];
#pragma unroll
    for (int i = 0; i < 4; ++i) mv[i] = sel ? bv[i] : -INFINITY;
    int we[TOPK]; float ws[TOPK]; float wsum = 0.f;
#pragma unroll
    for (int k = 0; k < TOPK; ++k) {
        float bvv = mv[0]; int bi = 0;
#pragma unroll
        for (int i = 1; i < 4; ++i) if (mv[i] > bvv) { bvv = mv[i]; bi = i; }
        int gi = lane * 4 + bi;
        for (int o = 32; o > 0; o >>= 1) { const float ov = __shfl_xor(bvv, o); const int oi = __shfl_xor(gi, o); if (ov > bvv || (ov == bvv && oi < gi)) { bvv = ov; gi = oi; } }
        const int ol = gi >> 2, oi = gi & 3;
        const float s_own = (oi == 0) ? sc[0] : (oi == 1) ? sc[1] : (oi == 2) ? sc[2] : sc[3];
        const float sw = __shfl(s_own, ol);
        if (lane == ol) { if (oi == 0) mv[0] = -INFINITY; else if (oi == 1) mv[1] = -INFINITY; else if (oi == 2) mv[2] = -INFINITY; else mv[3] = -INFINITY; }
        we[k] = gi; ws[k] = sw; wsum += sw;
    }
    if (lane == 0) {
        const float inv = 2.5f / wsum;
#pragma unroll
        for (int k = 0; k < TOPK; ++k) {
            top_e[t * TOPK + k] = we[k]; top_w[t * TOPK + k] = ws[k] * inv;
            top_pos[t * TOPK + k] = atomicAdd(&counts[we[k]], 1);
        }
    }
}

__device__ __forceinline__ void moe_offsets(const int* counts, int* off, int* blk_exp, int* nblk, int lane) {
    int pc[4], st[4]; int tot = 0;
#pragma unroll
    for (int i = 0; i < 4; ++i) { pc[i] = (counts[lane * 4 + i] + PADR - 1) / PADR * PADR; st[i] = tot; tot += pc[i]; }
    int inc = tot;
    for (int o = 1; o < 64; o <<= 1) { const int n = __shfl_up(inc, o); if (lane >= o) inc += n; }
    const int base = inc - tot;
#pragma unroll
    for (int i = 0; i < 4; ++i) { const int start = base + st[i]; off[lane * 4 + i] = start; for (int k = start / PADR; k < (start + pc[i]) / PADR; ++k) blk_exp[k] = lane * 4 + i; }
    if (lane == 63) nblk[0] = inc / PADR;
}

__device__ __forceinline__ void moe_scatter(const int* top_e, const float* top_w, const int* top_pos, const int* off, int* row_tok, float* row_gate, int* slot_of, int a) {
    const int slot = off[top_e[a]] + top_pos[a];
    row_tok[slot] = a / TOPK; row_gate[slot] = top_w[a]; slot_of[a] = slot;
}

__device__ __forceinline__ void moe_hidden(const float* h1, const float* __restrict__ wg, const float* __restrict__ wu, const int* row_tok, const float* row_gate, const int* blk_exp, const int* nblk,
                                           float* hidden, int g16, int j, float* sh) {
    const bool active = g16 * 16 < nblk[0] * PADR;
    float (*xs)[D] = (float (*)[D])sh;
    __syncthreads();
    if (active) for (int r = 0; r < 16; ++r) { const int tok = row_tok[g16 * 16 + r]; ((float4*)xs[r])[j] = ((const float4*)(h1 + (size_t)tok * D))[j]; }
    __syncthreads();
    if (!active) return;
    const int e = blk_exp[(g16 * 16) / PADR];
    float ag[16], au[16];
#pragma unroll
    for (int r = 0; r < 16; ++r) { ag[r] = 0.f; au[r] = 0.f; }
    const float* wgp = wg + (size_t)e * D * ED + j; const float* wup = wu + (size_t)e * D * ED + j;
    for (int d = 0; d < D; d += 4) {
        const float g0 = wgp[(size_t)(d + 0) * ED], g1 = wgp[(size_t)(d + 1) * ED], g2 = wgp[(size_t)(d + 2) * ED], g3 = wgp[(size_t)(d + 3) * ED];
        const float u0 = wup[(size_t)(d + 0) * ED], u1 = wup[(size_t)(d + 1) * ED], u2 = wup[(size_t)(d + 2) * ED], u3 = wup[(size_t)(d + 3) * ED];
#pragma unroll
        for (int r = 0; r < 16; ++r) { const float4 x = *(const float4*)&xs[r][d];
            ag[r] += x.x * g0 + x.y * g1 + x.z * g2 + x.w * g3; au[r] += x.x * u0 + x.y * u1 + x.z * u2 + x.w * u3; }
    }
#pragma unroll
    for (int r = 0; r < 16; ++r) hidden[(size_t)(g16 * 16 + r) * ED + j] = row_gate[g16 * 16 + r] * siluf(ag[r]) * au[r];
}

__device__ __forceinline__ void moe_down(const float* hidden, const float* __restrict__ wd, const int* top_e, const int* slot_of, float* ffn, int t, int i, float* sh) {
    float4 acc = ((float4*)(ffn + (size_t)t * D))[i];
    for (int k = 0; k < TOPK; ++k) {
        const int e = top_e[t * TOPK + k], slot = slot_of[t * TOPK + k];
        __syncthreads();
        sh[i] = hidden[(size_t)slot * ED + i];
        __syncthreads();
        const float4* wp = (const float4*)(wd + (size_t)e * ED * D) + i;
        for (int j = 0; j < ED; ++j) { const float4 w = wp[(size_t)j * (D / 4)]; const float hv = sh[j]; acc.x += hv * w.x; acc.y += hv * w.y; acc.z += hv * w.z; acc.w += hv * w.w; }
    }
    ((float4*)(ffn + (size_t)t * D))[i] = acc;
}
}

constexpr int NTHR = 512;
constexpr int LDS_BYTES = 147456;
constexpr int MISC_OFF = 131072 + 320;
constexpr size_t MiB = 1u << 20;
constexpr size_t CTL_ZERO_BYTES = 1 * MiB;
constexpr int CW_BAR = 4096;
constexpr int CW_MOE = 16384;

struct Args { const float* in[21]; float* out; unsigned char* ws; int ph_lo, ph_hi; };

__global__ void __launch_bounds__(NTHR, 2) mega_fwd(Args a) {
    using namespace nv;
    extern __shared__ __attribute__((aligned(16))) unsigned char lds[];
    const int tid = threadIdx.x, lane = tid & 63, wave = __builtin_amdgcn_readfirstlane(tid >> 6), half = tid >> 8, htid = tid & 255;
    const int G = gridDim.x, bx = blockIdx.x;
    float* sh = (float*)(lds + half * 65536);
    volatile LAS unsigned* MISC = (volatile LAS unsigned*)((LAS unsigned char*)lds + MISC_OFF);
    for (int u = tid; u < (LDS_BYTES - 131072) / 4; u += NTHR) ((LAS unsigned*)((LAS unsigned char*)lds + 131072))[u] = 0u;
    __syncthreads();
    unsigned char* ws = a.ws;
    unsigned* ctl = (unsigned*)ws;
    XcdBarrier bar = xcd_barrier_post(ctl + CW_BAR, MISC + 8);
    const float* x = a.in[0];
    const float* ln_in_g = a.in[1]; const float* ln_in_b = a.in[2];
    const float* w_in = a.in[3]; const float* b_fgate = a.in[4];
    const float* w_gate_up = a.in[5]; const float* b_gate = a.in[6]; const float* g_gla = a.in[7];
    const float* w_out = a.in[8]; const float* ln1_g = a.in[9]; const float* ln1_b = a.in[10];
    const float* w_router = a.in[11]; const float* rbias = a.in[12];
    const float* w_eg = a.in[13]; const float* w_eu = a.in[14]; const float* w_ed = a.in[15];
    const float* w_sg = a.in[16]; const float* w_su = a.in[17]; const float* w_sd = a.in[18];
    const float* ln2_g = a.in[19]; const float* ln2_b = a.in[20];
    float* out = a.out;
    int* counts = (int*)(ctl + CW_MOE); int* off = counts + 256; int* nblk = off + 256; int* blk_exp = nblk + 64;
    float* h0 = (float*)(ws + 1 * MiB);
    float* proj = (float*)(ws + 129 * MiB);
    float* abuf = (float*)(ws + 537 * MiB);
    float* cbuf = (float*)(ws + 569 * MiB);
    float* glao = (float*)(ws + 570 * MiB);
    float* y = (float*)(ws + 634 * MiB);
    float* mix = (float*)(ws + 762 * MiB);
    float* h1 = (float*)(ws + 890 * MiB);
    int* top_e = (int*)(ws + 1018 * MiB); float* top_w = (float*)(ws + 1019 * MiB); int* top_pos = (int*)(ws + 1020 * MiB); int* slot_of = top_pos;
    int* row_tok = (int*)(ws + 1021 * MiB); float* row_gate = (float*)(ws + 1022 * MiB + 256 * 1024);
    float* logits = (float*)(ws + 129 * MiB);
    float* hidden = (float*)(ws + 161 * MiB);
    float* shg = (float*)(ws + 446 * MiB); float* shu = (float*)(ws + 478 * MiB);
    float* ffn = (float*)(ws + 510 * MiB);

    const int lo = a.ph_lo, hi = a.ph_hi;
#define IN(k) (lo <= (k) && (k) < hi)
#define SEAM(k) do { if (IN(k) && IN((k) + 1)) xcd_barrier(bar); } while (0)
    const int gh = bx * 2 + half, GH2 = G * 2;
    const int gw = bx * 8 + wave, GW = G * 8;

    if (IN(0)) {
        for (int r = gh; r < T; r += GH2) ln_row(x, 1.f, nullptr, ln_in_g, ln_in_b, h0, r, htid, sh);
        for (int i = bx * NTHR + tid; i < (int)((2 * MiB + 512 * 1024) / 4); i += G * NTHR) row_tok[i] = 0;
    }
    SEAM(0);
    if (IN(1)) gemm_phase(h0, w_in, proj, T, INW, D, D, INW, INW, half, htid, sh);
    SEAM(1);
    if (IN(2)) {
        for (int bh = gw; bh < B * FH; bh += GW) fox_prep(proj, b_fgate, cbuf, bh, lane);
        for (int t = gh; t < T; t += GH2) gla_prep(proj, w_gate_up, b_gate, abuf, t, htid);
    }
    SEAM(2);
    if (IN(3)) {
        { const int q = bx * 4 + (tid >> 7); if (q < B * GH) gla_rec(proj, abuf, glao, q, tid & 127); }
        for (int blk = gw; blk < B * FH * (S / 64); blk += GW) { const int b2 = (blk >= 2048) ? ((blk & ~63) | (63 - (blk & 63))) : blk; fox_attn(proj, cbuf, y, b2, lane); }
    }
    SEAM(3);
    if (IN(4)) for (int w = gw; w < T * GH; w += GW) gla_post(glao, proj, g_gla, y, w, lane);
    SEAM(4);
    if (IN(5)) gemm_phase(y, w_out, mix, T, D, D, D, D, D, half, htid, sh);
    SEAM(5);
    if (IN(6)) for (int r = gh; r < T; r += GH2) ln_row(h0, ALPHA, mix, ln1_g, ln1_b, h1, r, htid, sh);
    SEAM(6);
    if (IN(7)) {
        gemm_phase(h1, w_router, logits, T, NE, D, D, NE, NE, half, htid, sh);
        gemm_phase(h1, w_sg, shg, T, ED, D, D, ED, ED, half, htid, sh);
        gemm_phase(h1, w_su, shu, T, ED, D, D, ED, ED, half, htid, sh);
    }
    SEAM(7);
    if (IN(8)) {
        for (int t = gw; t < T; t += GW) route_token(logits, rbias, top_e, top_w, top_pos, counts, t, lane);
        for (size_t i = (size_t)bx * NTHR + tid; i < (size_t)T * ED; i += (size_t)G * NTHR) shg[i] = siluf(shg[i]) * shu[i];
    }
    SEAM(8);
    if (IN(9)) {
        if (gw == 0) moe_offsets(counts, off, blk_exp, nblk, lane);
        gemm_phase(shg, w_sd, ffn, T, D, ED, ED, D, D, half, htid, sh);
    }
    SEAM(9);
    if (IN(10)) for (int i = bx * NTHR + tid; i < T * TOPK; i += G * NTHR) moe_scatter(top_e, top_w, top_pos, off, row_tok, row_gate, slot_of, i);
    SEAM(10);
    if (IN(11)) for (int g0 = bx * 2; g0 < APAD / 16; g0 += GH2) moe_hidden(h1, w_eg, w_eu, row_tok, row_gate, blk_exp, nblk, hidden, g0 + half, htid, sh);
    SEAM(11);
    if (IN(12)) for (int t = gh; t < T; t += GH2) moe_down(hidden, w_ed, top_e, slot_of, ffn, t, htid, sh);
    SEAM(12);
    if (IN(13)) for (int r = gh; r < T; r += GH2) ln_row(h1, ALPHA, ffn, ln2_g, ln2_b, out, r, htid, sh);
#undef IN
#undef SEAM
}

extern "C" void kernel_launch(void* const* d_in, const int* in_sizes, int n_in, void* d_out, int out_size, void* d_ws, size_t ws_size, hipStream_t stream) {
    static int grid = 0;
    if (grid == 0) {
        if (n_in != 21 || out_size != nv::T * nv::D || ws_size < 1024 * MiB) { fprintf(stderr, "kernel_launch: unexpected shapes n_in=%d out=%d ws=%zu\n", n_in, out_size, ws_size); grid = -1; return; }
        int dev = 0, cus = 0;
        if (hipGetDevice(&dev) != hipSuccess || hipDeviceGetAttribute(&cus, hipDeviceAttributeMultiprocessorCount, dev) != hipSuccess) { grid = -1; return; }
        if (hipFuncSetAttribute((const void*)mega_fwd, hipFuncAttributeMaxDynamicSharedMemorySize, LDS_BYTES) != hipSuccess) { fprintf(stderr, "kernel_launch: hipFuncSetAttribute failed\n"); grid = -1; return; }
        grid = cus;
    }
    if (grid < 0) return;
    if (hipMemsetAsync(d_ws, 0, CTL_ZERO_BYTES, stream) != hipSuccess) return;
    Args a{};
    for (int i = 0; i < 21; ++i) a.in[i] = (const float*)d_in[i];
    a.out = (float*)d_out; a.ws = (unsigned char*)d_ws; a.ph_lo = 0; a.ph_hi = 14;
    hipLaunchKernelGGL(mega_fwd, dim3(grid), dim3(NTHR), LDS_BYTES, stream, a);
}
```

```cpp
#include <hip/hip_runtime.h>
#include <cstdio>
#include <cstdint>
#include <cmath>

#define LAS __attribute__((address_space(3)))
#define GAS __attribute__((address_space(1)))

#define XB_TMO      128
#define XB_XCNT(j)  (256  + 64 * (j))
#define XB_XSUB(j)  (1280 + 64 * (j))
#define XB_XGEN(j)  (2304 + 64 * (j))
#define XB_TOP      3328
#define XB_TOPGEN   3392
#define XCD_BAR_WORDS 3456
#define XB_SPIN_CAP (1u << 27)
__device__ __forceinline__ unsigned xb_ld(unsigned* p)              { return __hip_atomic_load(p, __ATOMIC_RELAXED, __HIP_MEMORY_SCOPE_AGENT); }
__device__ __forceinline__ unsigned xb_add(unsigned* p, unsigned v) { return __hip_atomic_fetch_add(p, v, __ATOMIC_RELAXED, __HIP_MEMORY_SCOPE_AGENT); }
__device__ __forceinline__ unsigned xb_xcc_id() { return (unsigned)__builtin_amdgcn_s_getreg((3 << 11) | 20) & 0xFu; }
#define XB_SPIN(cond, bar) do { unsigned _sp = 0; while (cond) { __builtin_amdgcn_s_sleep(1); \
    if ((++_sp & 255u) == 0u) { if (xb_ld(&(bar)[XB_TMO])) break; if (_sp > XB_SPIN_CAP) { atomicAdd(&(bar)[XB_TMO], 1u); break; } } } } while (0)
struct XcdBarrier { unsigned* bar; unsigned x; volatile LAS unsigned* st; };
__device__ __forceinline__ XcdBarrier xcd_barrier_post(unsigned* bar, volatile LAS unsigned* st) {
    XcdBarrier b; b.bar = bar; b.x = xb_xcc_id(); b.st = st;
    if (threadIdx.x == 0) (void)xb_add(&bar[XB_XCNT(b.x)], 1u);
    return b;
}
__device__ __forceinline__ void xcd_barrier_complete(unsigned* bar, unsigned x, unsigned& nloc, unsigned& nx) {
    const unsigned G = gridDim.x * gridDim.y * gridDim.z;
    unsigned sum, cnt, mine, sp = 0u;
    for (;;) {
        sum = 0u; cnt = 0u; mine = 0u;
#pragma unroll
        for (unsigned j = 0; j < 16; ++j) { const unsigned c = xb_ld(&bar[XB_XCNT(j)]); sum += c; cnt += (c > 0u) ? 1u : 0u; mine = (j == x) ? c : mine; }
        if (sum == G) break;
        __builtin_amdgcn_s_sleep(1);
        if ((++sp & 255u) == 0u) { if (xb_ld(&bar[XB_TMO])) break; if (sp > XB_SPIN_CAP) { atomicAdd(&bar[XB_TMO], 1u); break; } }
    }
    nloc = mine > 0u ? mine : 1u; nx = cnt > 0u ? cnt : 1u;
}
__device__ __forceinline__ void xcd_barrier(const XcdBarrier& b) {
    asm volatile("s_waitcnt vmcnt(0)" ::: "memory");
    __syncthreads();
    if (threadIdx.x == 0) {
        unsigned* bar = b.bar;
        __builtin_amdgcn_s_waitcnt(0);
        unsigned nloc = b.st[0], nx = b.st[1];
        if (nloc == 0u) { xcd_barrier_complete(bar, b.x, nloc, nx); b.st[0] = nloc; b.st[1] = nx; }
        const unsigned old = xb_add(&bar[XB_XSUB(b.x)], 1u);
        const unsigned gen = old / nloc;
        if (old + 1u == (gen + 1u) * nloc) {
            __builtin_amdgcn_fence(__ATOMIC_RELEASE, "agent");
            asm volatile("s_waitcnt vmcnt(0)" ::: "memory");
            const unsigned og = xb_add(&bar[XB_TOP], 1u);
            const unsigned tg = og / nx;
            if (og + 1u == (tg + 1u) * nx) xb_add(&bar[XB_TOPGEN], 1u);
            else XB_SPIN(xb_ld(&bar[XB_TOPGEN]) == tg, bar);
            __builtin_amdgcn_fence(__ATOMIC_ACQUIRE, "agent");
            xb_add(&bar[XB_XGEN(b.x)], 1u);
            asm volatile("s_waitcnt vmcnt(0)" ::: "memory");
        } else {
            XB_SPIN(xb_ld(&bar[XB_XGEN(b.x)]) == gen, bar);
            __builtin_amdgcn_fence(__ATOMIC_ACQUIRE, "agent");
            asm volatile("s_waitcnt vmcnt(0)" ::: "memory");
        }
    }
    __syncthreads();
}
namespace pg8 {
#define PG8_LAS __attribute__((address_space(3)))
typedef unsigned short bf16_t;
typedef short bf16x8 __attribute__((ext_vector_type(8)));
typedef float f32x4 __attribute__((ext_vector_type(4)));
typedef unsigned u32x4 __attribute__((ext_vector_type(4)));
constexpr int BM = 256, BK = 64, HALF = 128, HTB = HALF * BK * 2  , STAGE_BYTES = 8 * HTB, NXCD = 8, WGM = 8;

__host__ __device__ __forceinline__ int lds_byte(int r, int c) { const int st = (r >> 4) * 2 + (c >> 5), rr = r & 15, cc = c & 31, ob = rr * 64 + cc * 2; return st * 1024 + (ob ^ (((ob >> 9) & 1) << 5)); }
__host__ __device__ __forceinline__ void stage_rc(int b, int& R, int& C) { const int st = b / 1024, sb = b % 1024, swz = sb ^ (((sb >> 9) & 1) << 5); R = (st >> 1) * 16 + swz / 64; C = (st & 1) * 32 + (swz % 64) / 2; }
__host__ __device__ __forceinline__ int perm32(int rho) { const int n = rho >> 4, i = rho & 15; return 8 * (i >> 2) + 4 * n + (i & 3); }

struct Unit { int pm, pn; };
struct Gemm { const bf16_t* A; const bf16_t* Bt; int M, N, K, lda; };

struct StaticOrder {
    int nM, nN, nwg, G, c;
    __host__ __device__ void init(int M, int N, int G_, int c_) { nM = M / BM; nN = N / BM; nwg = nM * nN; G = G_; c = c_; }
    __host__ __device__ bool next(int i, Unit& u) const {
        const long L = (long)i * G + c; if (L >= nwg) return false;
        int wgid = (int)L; { const int q = nwg / NXCD, r = nwg % NXCD, xcd = wgid % NXCD, off = wgid / NXCD; wgid = (xcd < r ? xcd * (q + 1) : r * (q + 1) + (xcd - r) * q) + off; }
        const int nig = WGM * nN, gid = wgid / nig, fm = gid * WGM, gsz = (nM - fm) < WGM ? (nM - fm) : WGM;
        u.pm = fm + ((wgid % nig) % gsz); u.pn = (wgid % nig) / gsz; return true;
    }
    __device__ __forceinline__ void a_ready(const Unit&) const {}
    __device__ __forceinline__ void done(const Unit&) const {}
};

__device__ __forceinline__ unsigned cvt_pk_bf16(float lo, float hi) { unsigned r; asm volatile("v_cvt_pk_bf16_f32 %0, %1, %2" : "=v"(r) : "v"(lo), "v"(hi)); return r; }
typedef float f32x2 __attribute__((ext_vector_type(2)));
__device__ __forceinline__ f32x2 gelu_pk(f32x2 v) {
    const f32x2 av = __builtin_elementwise_abs(v), d = av * 0.2316418882f + 1.0f;
    f32x2 t; t.x = __builtin_amdgcn_rcpf(d.x); t.y = __builtin_amdgcn_rcpf(d.y);
    f32x2 q = t * 0.5307027145f + (-0.7265760135f); q = q * t + 0.7107068705f; q = q * t + (-0.142248368f); q = q * t + 0.127414796f; q = q * t;
    const f32x2 s = (v * v) * (-0.72134752044f);
    f32x2 e; e.x = __builtin_amdgcn_exp2f(s.x); e.y = __builtin_amdgcn_exp2f(s.y);
    const f32x2 m = v * (q * e), r = v - m;
    f32x2 o; o.x = v.x < 0.f ? m.x : r.x; o.y = v.y < 0.f ? m.y : r.y; return o;
}

template <int ACT  > struct EpiBf16 {
    static constexpr bool PERM = true, AFTER_DRAIN = false; static_assert(ACT == 0 || ACT == 1, "EpiBf16: ACT is 0 (none) or 1 (gelu_pk)");
    bf16_t* O; int ldc; const float* bias; int split_cols; size_t split_stride; float scale0;
    __device__ __forceinline__ void operator()(const f32x4 (&acc)[2][2][4][2], const Unit& u, int wr, int wc, int fr, int fq) const {
        const int row0 = u.pm * BM + wr * 64 + fr; int colt = u.pn * BM; bf16_t* base = O;
        float sc = 1.f; if (split_cols) { const int t = colt / split_cols; base += (size_t)t * split_stride; colt -= t * split_cols; if (t == 0) sc = scale0; }
        const int col0 = colt + wc * 32 + 8 * fq, bcol0 = u.pn * BM + wc * 32 + 8 * fq;
        f32x4 bv[2][2];
#pragma unroll
        for (int bj = 0; bj < 2; ++bj)
#pragma unroll
            for (int n = 0; n < 2; ++n) bv[bj][n] = bias ? *(const f32x4*)(bias + bcol0 + bj * HALF + 4 * n) : (f32x4){0.f, 0.f, 0.f, 0.f};
#pragma unroll
        for (int ai = 0; ai < 2; ++ai)
#pragma unroll
            for (int m = 0; m < 4; ++m) { bf16_t* rowp = base + (size_t)(row0 + ai * HALF + m * 16) * ldc + col0;
#pragma unroll
                for (int bj = 0; bj < 2; ++bj) { f32x4 v0 = acc[ai][bj][m][0] + bv[bj][0], v1 = acc[ai][bj][m][1] + bv[bj][1];
                    if (ACT == 1) { f32x2 a = gelu_pk((f32x2){v0[0], v0[1]}), b = gelu_pk((f32x2){v0[2], v0[3]}), c = gelu_pk((f32x2){v1[0], v1[1]}), d = gelu_pk((f32x2){v1[2], v1[3]});
                        v0 = (f32x4){a.x, a.y, b.x, b.y}; v1 = (f32x4){c.x, c.y, d.x, d.y}; }
                    v0 = v0 * sc; v1 = v1 * sc; u32x4 w; w.x = cvt_pk_bf16(v0[0], v0[1]); w.y = cvt_pk_bf16(v0[2], v0[3]); w.z = cvt_pk_bf16(v1[0], v1[1]); w.w = cvt_pk_bf16(v1[2], v1[3]);
                    *(u32x4*)(rowp + bj * HALF) = w; } }
    }
};

template <class Epi, class Sched, bool ALIGN_EPI = false, bool SP2 = false>
__device__ __forceinline__ void gemm_phase(PG8_LAS unsigned char* lds, const Gemm g, const Sched& S, const Epi& E) {
    const int tid = threadIdx.x, wid = __builtin_amdgcn_readfirstlane(tid >> 6), lane = tid & 63, wr = wid >> 2, wc = wid & 3, fr = lane & 15, fq = lane >> 4;
    const int K = g.K, nt = K / BK;
    unsigned voffA[2], voffB[2];
#pragma unroll
    for (int i = 0; i < 2; ++i) { int R, C; stage_rc(tid * 16 + i * 8192, R, C); const int Rb = Epi::PERM ? ((R & ~31) + perm32(R & 31)) : R;
        voffA[i] = (unsigned)(R * g.lda + C) * 2u; voffB[i] = (unsigned)(Rb * K + C) * 2u; }
    const size_t kstep = (size_t)(BK * 2);
    const size_t hstepA = (size_t)HALF * g.lda * 2, hstepB = (size_t)HALF * K * 2;
    const size_t tstepA = 2 * hstepA, tstepB = 2 * hstepB;
    const unsigned ldsw = (unsigned)wid * 1024u;
    const int aoff = lds_byte(wr * 64 + fr, fq * 8), boff = lds_byte(wc * 32 + fr, fq * 8);
#define PG8_SA(b, h) (((b) * 2 + (h)) * HTB)
#define PG8_SB(b, h) ((4 + (b) * 2 + (h)) * HTB)
#define PG8_STAGE(bufoff, gbase, voff) do { _Pragma("unroll") for (int _i = 0; _i < 2; ++_i) \
        __builtin_amdgcn_global_load_lds((const unsigned*)((const char*)(gbase) + (voff)[_i]), (PG8_LAS unsigned*)(lds + (bufoff) + ldsw + _i * 8192), 16, 0, 0); } while (0)
#define PG8_LDA(dst, b, h) do { _Pragma("unroll") for (int m = 0; m < 4; ++m) _Pragma("unroll") for (int k = 0; k < 2; ++k) dst[m][k] = *(const PG8_LAS bf16x8*)(lds + PG8_SA(b, h) + aoff + m * 2048 + k * 1024); } while (0)
#define PG8_LDB(dst, b, h) do { _Pragma("unroll") for (int n = 0; n < 2; ++n) _Pragma("unroll") for (int k = 0; k < 2; ++k) dst[n][k] = *(const PG8_LAS bf16x8*)(lds + PG8_SB(b, h) + boff + n * 2048 + k * 1024); } while (0)
#define PG8_MMA(ai, bj, At, Bt) do { __builtin_amdgcn_s_setprio(1); _Pragma("unroll") for (int m = 0; m < 4; ++m) _Pragma("unroll") for (int n = 0; n < 2; ++n) _Pragma("unroll") for (int k = 0; k < 2; ++k) \
        acc[ai][bj][m][n] = __builtin_amdgcn_mfma_f32_16x16x32_bf16(Bt[n][k], At[m][k], acc[ai][bj][m][n], 0, 0, 0); __builtin_amdgcn_s_setprio(0); } while (0)
#define PG8_WAIT_V(n) asm volatile("s_waitcnt vmcnt(" #n ")" ::: "memory")
#define PG8_WAIT_L(n) asm volatile("s_waitcnt lgkmcnt(" #n ")" ::: "memory")
#define PG8_BAR __builtin_amdgcn_s_barrier()
#define PG8_SCHED __builtin_amdgcn_sched_barrier(0)
    Unit cur, nxt; int ui = 0;
    if (!S.next(0, cur)) return;
    f32x4 acc[2][2][4][2];
#pragma unroll
    for (int a = 0; a < 2; ++a)
#pragma unroll
        for (int b = 0; b < 2; ++b)
#pragma unroll
            for (int m = 0; m < 4; ++m)
#pragma unroll
                for (int n = 0; n < 2; ++n) acc[a][b][m][n] = (f32x4){0.f, 0.f, 0.f, 0.f};
    bf16x8 At[4][2], B0[2][2], B1[2][2];
    const char* cA = (const char*)g.A + (size_t)cur.pm * tstepA; const char* cB = (const char*)g.Bt + (size_t)cur.pn * tstepB;
    S.a_ready(cur);
    if constexpr (SP2) {
        PG8_STAGE(PG8_SB(0, 0), cB, voffB); PG8_STAGE(PG8_SB(0, 1), cB + hstepB, voffB); PG8_STAGE(PG8_SA(0, 0), cA, voffA); PG8_STAGE(PG8_SA(0, 1), cA + hstepA, voffA);
        if (wr == 1) PG8_BAR;
        PG8_WAIT_V(2); PG8_BAR;
        PG8_STAGE(PG8_SB(1, 0), cB + kstep, voffB); PG8_STAGE(PG8_SA(1, 0), cA + kstep, voffA); PG8_STAGE(PG8_SB(1, 1), cB + hstepB + kstep, voffB);
        PG8_WAIT_V(6); PG8_BAR;
    } else {
        PG8_STAGE(PG8_SB(0, 0), cB, voffB); PG8_STAGE(PG8_SA(0, 0), cA, voffA); PG8_STAGE(PG8_SB(0, 1), cB + hstepB, voffB); PG8_STAGE(PG8_SA(0, 1), cA + hstepA, voffA);
        if (wr == 1) PG8_BAR;
        PG8_WAIT_V(4); PG8_BAR;
        PG8_STAGE(PG8_SB(1, 0), cB + kstep, voffB); PG8_STAGE(PG8_SA(1, 0), cA + kstep, voffA); PG8_STAGE(PG8_SB(1, 1), cB + hstepB + kstep, voffB);
        PG8_WAIT_V(6); PG8_BAR;
    }
    for (;;) {
        const bool has_next = S.next(ui + 1, nxt);
        const char* nA = has_next ? (const char*)g.A + (size_t)nxt.pm * tstepA : cA; const char* nB = has_next ? (const char*)g.Bt + (size_t)nxt.pn * tstepB : cB;
        for (int t = 0; t < nt; t += 2) {
            const bool last = (t == nt - 2);
            const char* a1 = cA + (size_t)(t + 1) * kstep;
            const char* a2 = last ? nA : cA + (size_t)(t + 2) * kstep; const char* b2 = last ? nB : cB + (size_t)(t + 2) * kstep;
            const char* a3 = a2 + kstep; const char* b3 = b2 + kstep;
            if (last && has_next) S.a_ready(nxt);
            if constexpr (SP2) {
            PG8_LDB(B0, 0, 0); PG8_LDB(B1, 0, 1); PG8_SCHED; PG8_LDA(At, 0, 0); PG8_STAGE(PG8_SA(1, 1), a1 + hstepA, voffA);
            PG8_WAIT_V(8); PG8_WAIT_L(0); PG8_BAR; PG8_MMA(0, 0, At, B0); PG8_MMA(0, 1, At, B1); PG8_BAR; PG8_SCHED;
            PG8_LDA(At, 0, 1); PG8_STAGE(PG8_SB(0, 0), b2, voffB); PG8_STAGE(PG8_SB(0, 1), b2 + hstepB, voffB); PG8_STAGE(PG8_SA(0, 0), a2, voffA);
            PG8_WAIT_V(8); PG8_WAIT_L(0); PG8_BAR; PG8_MMA(1, 0, At, B0); PG8_MMA(1, 1, At, B1); PG8_BAR; PG8_SCHED;
            PG8_LDB(B0, 1, 0); PG8_LDB(B1, 1, 1); PG8_SCHED; PG8_LDA(At, 1, 0); PG8_STAGE(PG8_SA(0, 1), a2 + hstepA, voffA);
            PG8_WAIT_V(8); PG8_WAIT_L(0); PG8_BAR; PG8_MMA(0, 0, At, B0); PG8_MMA(0, 1, At, B1); PG8_BAR; PG8_SCHED;
            PG8_LDA(At, 1, 1); PG8_STAGE(PG8_SB(1, 0), b3, voffB); PG8_STAGE(PG8_SB(1, 1), b3 + hstepB, voffB); PG8_STAGE(PG8_SA(1, 0), a3, voffA);
            PG8_WAIT_V(8); PG8_WAIT_L(0); PG8_BAR; PG8_MMA(1, 0, At, B0); PG8_MMA(1, 1, At, B1); PG8_BAR; PG8_SCHED;
            } else {
            PG8_LDB(B0, 0, 0); PG8_SCHED; PG8_LDA(At, 0, 0); PG8_STAGE(PG8_SA(1, 1), a1 + hstepA, voffA);
            PG8_WAIT_L(8); PG8_BAR; PG8_WAIT_L(0); PG8_MMA(0, 0, At, B0); PG8_BAR; PG8_SCHED;
            PG8_LDB(B1, 0, 1); PG8_STAGE(PG8_SB(0, 0), b2, voffB);
            PG8_BAR; PG8_WAIT_L(0); PG8_MMA(0, 1, At, B1); PG8_BAR;
            PG8_LDA(At, 0, 1); PG8_STAGE(PG8_SA(0, 0), a2, voffA);
            PG8_BAR; PG8_WAIT_L(0); PG8_MMA(1, 0, At, B0); PG8_BAR; PG8_SCHED;
            PG8_STAGE(PG8_SB(0, 1), b2 + hstepB, voffB);
            PG8_WAIT_V(6); PG8_BAR; PG8_MMA(1, 1, At, B1); PG8_BAR;
            PG8_LDB(B0, 1, 0); PG8_SCHED; PG8_LDA(At, 1, 0); PG8_STAGE(PG8_SA(0, 1), a2 + hstepA, voffA);
            PG8_WAIT_L(8); PG8_BAR; PG8_WAIT_L(0); PG8_MMA(0, 0, At, B0); PG8_BAR; PG8_SCHED;
            PG8_LDB(B1, 1, 1); PG8_STAGE(PG8_SB(1, 0), b3, voffB);
            PG8_BAR; PG8_WAIT_L(0); PG8_MMA(0, 1, At, B1); PG8_BAR;
            PG8_LDA(At, 1, 1); PG8_STAGE(PG8_SA(1, 0), a3, voffA);
            PG8_BAR; PG8_WAIT_L(0); PG8_MMA(1, 0, At, B0); PG8_BAR; PG8_SCHED;
            PG8_STAGE(PG8_SB(1, 1), b3 + hstepB, voffB);
            PG8_WAIT_V(6); PG8_BAR; PG8_MMA(1, 1, At, B1); PG8_BAR;
            }
        }
        if constexpr (ALIGN_EPI) { if (wr == 0) PG8_BAR; }
        if constexpr (!Epi::AFTER_DRAIN) { E(acc, cur, wr, wc, fr, fq); S.done(cur); }
        if (!has_next) break;
#pragma unroll
        for (int a = 0; a < 2; ++a)
#pragma unroll
            for (int b = 0; b < 2; ++b)
#pragma unroll
                for (int m = 0; m < 4; ++m)
#pragma unroll
                    for (int n = 0; n < 2; ++n) acc[a][b][m][n] = (f32x4){0.f, 0.f, 0.f, 0.f};
        cur = nxt; cA = nA; cB = nB; ++ui;
        if constexpr (ALIGN_EPI) { if (wr == 1) PG8_BAR; }
    }
    PG8_WAIT_V(0);
    if constexpr (!ALIGN_EPI) { if (wr == 0) PG8_BAR; }
    PG8_BAR;
    if constexpr (Epi::AFTER_DRAIN) { E.fused(acc, cur, wr, wc, fr, fq, lds, wid, lane); S.done(cur); }
#undef PG8_SA
#undef PG8_SB
#undef PG8_STAGE
#undef PG8_LDA
#undef PG8_LDB
#undef PG8_MMA
#undef PG8_WAIT_V
#undef PG8_WAIT_L
#undef PG8_BAR
#undef PG8_SCHED
}
}
namespace pg8 {
struct Unit2 { int pm, pn, e, cnt, jt; };
template <class Epi, class Sched>
__device__ __forceinline__ void gemm_phase2(PG8_LAS unsigned char* lds, const bf16_t* Abase, int lda, int ldb, int K, const Sched& S, const Epi& E) {
    int tid_ = threadIdx.x; asm volatile("" : "+v"(tid_));
    const int tid = tid_, wid = __builtin_amdgcn_readfirstlane(tid >> 6), lane = tid & 63, wr = wid >> 2, wc = wid & 3, fr = lane & 15, fq = lane >> 4;
    int K_ = K; asm volatile("" : "+s"(K_));
    const int nt = K_ / BK;
    unsigned voffB[2];
#pragma unroll
    for (int i = 0; i < 2; ++i) { int R, C; stage_rc(tid * 16 + i * 8192, R, C); const int Rb = Epi::PERM ? ((R & ~31) + perm32(R & 31)) : R; voffB[i] = (unsigned)(Rb * ldb + C) * 2u; }
    const unsigned lda2 = (unsigned)lda * 2u;
#define PG8_AOFFS(U, o0, o1) do { int t2_ = threadIdx.x; asm volatile("" : "+v"(t2_)); _Pragma("unroll") for (int i_ = 0; i_ < 2; ++i_) { int R_, C_; stage_rc(t2_ * 16 + i_ * 8192, R_, C_); \
        o0[i_] = (unsigned)S.arow(U, R_) * lda2 + (unsigned)C_ * 2u; o1[i_] = (unsigned)S.arow(U, HALF + R_) * lda2 + (unsigned)C_ * 2u; } } while (0)
    const size_t kstep = (size_t)(BK * 2);
    const size_t hstepB = (size_t)HALF * ldb * 2;
    const unsigned ldsw = (unsigned)wid * 1024u;
    const int aoff = lds_byte(wr * 64 + fr, fq * 8), boff = lds_byte(wc * 32 + fr, fq * 8);
#define PG8_SA(b, h) (((b) * 2 + (h)) * HTB)
#define PG8_SB(b, h) ((4 + (b) * 2 + (h)) * HTB)
#define PG8_STAGE(bufoff, gbase, voff) do { _Pragma("unroll") for (int _i = 0; _i < 2; ++_i) \
        __builtin_amdgcn_global_load_lds((const unsigned*)((const char*)(gbase) + (voff)[_i]), (PG8_LAS unsigned*)(lds + (bufoff) + ldsw + _i * 8192), 16, 0, 0); } while (0)
#define PG8_LDA(dst, b, h) do { _Pragma("unroll") for (int m = 0; m < 4; ++m) _Pragma("unroll") for (int k = 0; k < 2; ++k) dst[m][k] = *(const PG8_LAS bf16x8*)(lds + PG8_SA(b, h) + aoff + m * 2048 + k * 1024); } while (0)
#define PG8_LDB(dst, b, h) do { _Pragma("unroll") for (int n = 0; n < 2; ++n) _Pragma("unroll") for (int k = 0; k < 2; ++k) dst[n][k] = *(const PG8_LAS bf16x8*)(lds + PG8_SB(b, h) + boff + n * 2048 + k * 1024); } while (0)
#define PG8_MMA(ai, bj, At, Bt) do { __builtin_amdgcn_s_setprio(1); _Pragma("unroll") for (int m = 0; m < 4; ++m) _Pragma("unroll") for (int n = 0; n < 2; ++n) _Pragma("unroll") for (int k = 0; k < 2; ++k) \
        acc[ai][bj][m][n] = __builtin_amdgcn_mfma_f32_16x16x32_bf16(Bt[n][k], At[m][k], acc[ai][bj][m][n], 0, 0, 0); __builtin_amdgcn_s_setprio(0); } while (0)
#define PG8_WAIT_V(n) asm volatile("s_waitcnt vmcnt(" #n ")" ::: "memory")
#define PG8_WAIT_L(n) asm volatile("s_waitcnt lgkmcnt(" #n ")" ::: "memory")
#define PG8_BAR __builtin_amdgcn_s_barrier()
#define PG8_SCHED __builtin_amdgcn_sched_barrier(0)
    Unit2 cur, nxt; int ui = 0;
    if (!S.next(0, cur)) return;
    f32x4 acc[2][2][4][2];
#pragma unroll
    for (int a = 0; a < 2; ++a)
#pragma unroll
        for (int b = 0; b < 2; ++b)
#pragma unroll
            for (int m = 0; m < 4; ++m)
#pragma unroll
                for (int n = 0; n < 2; ++n) acc[a][b][m][n] = (f32x4){0.f, 0.f, 0.f, 0.f};
    bf16x8 At[4][2], B0[2][2], B1[2][2];
    unsigned cv0[2], cv1[2], nv0[2], nv1[2];
    PG8_AOFFS(cur, cv0, cv1);
    const char* cA = (const char*)Abase + S.aoff(cur); const char* cB = S.bptr(cur);
    PG8_STAGE(PG8_SB(0, 0), cB, voffB); PG8_STAGE(PG8_SB(0, 1), cB + hstepB, voffB); PG8_STAGE(PG8_SA(0, 0), cA, cv0); PG8_STAGE(PG8_SA(0, 1), cA, cv1);
    if (wr == 1) PG8_BAR;
    PG8_WAIT_V(2); PG8_BAR;
    PG8_STAGE(PG8_SB(1, 0), cB + kstep, voffB); PG8_STAGE(PG8_SA(1, 0), cA + kstep, cv0); PG8_STAGE(PG8_SB(1, 1), cB + hstepB + kstep, voffB);
    PG8_WAIT_V(6); PG8_BAR;
    for (;;) {
        const bool has_next = S.next(ui + 1, nxt);
        const char* nA = has_next ? (const char*)Abase + S.aoff(nxt) : cA; const char* nB = has_next ? S.bptr(nxt) : cB;
#pragma unroll
        for (int i = 0; i < 2; ++i) { nv0[i] = cv0[i]; nv1[i] = cv1[i]; }
        if (has_next) PG8_AOFFS(nxt, nv0, nv1);
        for (int t = 0; t < nt; t += 2) {
            const bool last = (t == nt - 2);
            const char* a1 = cA + (size_t)(t + 1) * kstep;
            const char* a2 = last ? nA : cA + (size_t)(t + 2) * kstep; const char* b2 = last ? nB : cB + (size_t)(t + 2) * kstep;
            const char* a3 = a2 + kstep; const char* b3 = b2 + kstep;
            unsigned s0[2] = {cv0[0], cv0[1]}, s1[2] = {cv1[0], cv1[1]};
            if (last) { asm volatile("" ::: "memory"); s0[0] = nv0[0]; s0[1] = nv0[1]; s1[0] = nv1[0]; s1[1] = nv1[1]; }
            PG8_LDB(B0, 0, 0); PG8_LDB(B1, 0, 1); PG8_SCHED; PG8_LDA(At, 0, 0); PG8_STAGE(PG8_SA(1, 1), a1, cv1);
            PG8_WAIT_V(8); PG8_WAIT_L(0); PG8_BAR; PG8_MMA(0, 0, At, B0); PG8_MMA(0, 1, At, B1); PG8_BAR; PG8_SCHED;
            PG8_LDA(At, 0, 1); PG8_STAGE(PG8_SB(0, 0), b2, voffB); PG8_STAGE(PG8_SB(0, 1), b2 + hstepB, voffB); PG8_STAGE(PG8_SA(0, 0), a2, s0);
            PG8_WAIT_V(8); PG8_WAIT_L(0); PG8_BAR; PG8_MMA(1, 0, At, B0); PG8_MMA(1, 1, At, B1); PG8_BAR; PG8_SCHED;
            PG8_LDB(B0, 1, 0); PG8_LDB(B1, 1, 1); PG8_SCHED; PG8_LDA(At, 1, 0); PG8_STAGE(PG8_SA(0, 1), a2, s1);
            PG8_WAIT_V(8); PG8_WAIT_L(0); PG8_BAR; PG8_MMA(0, 0, At, B0); PG8_MMA(0, 1, At, B1); PG8_BAR; PG8_SCHED;
            PG8_LDA(At, 1, 1); PG8_STAGE(PG8_SB(1, 0), b3, voffB); PG8_STAGE(PG8_SB(1, 1), b3 + hstepB, voffB); PG8_STAGE(PG8_SA(1, 0), a3, s0);
            PG8_WAIT_V(8); PG8_WAIT_L(0); PG8_BAR; PG8_MMA(1, 0, At, B0); PG8_MMA(1, 1, At, B1); PG8_BAR; PG8_SCHED;
        }
        if (wr == 0) PG8_BAR;
        { Unit2 eu = cur; asm volatile("" : "+s"(eu.pm), "+s"(eu.pn), "+s"(eu.e), "+s"(eu.cnt), "+s"(eu.jt));
          E(acc, eu, wr, wc, fr, fq); }
        if (!has_next) break;
#pragma unroll
        for (int a = 0; a < 2; ++a)
#pragma unroll
            for (int b = 0; b < 2; ++b)
#pragma unroll
                for (int m = 0; m < 4; ++m)
#pragma unroll
                    for (int n = 0; n < 2; ++n) acc[a][b][m][n] = (f32x4){0.f, 0.f, 0.f, 0.f};
        cur = nxt; cA = nA; cB = nB; ++ui;
#pragma unroll
        for (int i = 0; i < 2; ++i) { cv0[i] = nv0[i]; cv1[i] = nv1[i]; }
        if (wr == 1) PG8_BAR;
    }
    PG8_WAIT_V(0);
    PG8_BAR;
#undef PG8_AOFFS
#undef PG8_SA
#undef PG8_SB
#undef PG8_STAGE
#undef PG8_LDA
#undef PG8_LDB
#undef PG8_MMA
#undef PG8_WAIT_V
#undef PG8_WAIT_L
#undef PG8_BAR
#undef PG8_SCHED
}

struct DenseSched {
    StaticOrder so; const bf16_t* Bt; int ldb;
    __device__ __forceinline__ bool next(int i, Unit2& u) const { Unit t; if (!so.next(i, t)) return false; u.pm = t.pm; u.pn = t.pn; u.e = 0; u.cnt = 256; u.jt = 0; return true; }
    __device__ __forceinline__ int arow(const Unit2& u, int r) const { return u.pm * BM + r; }
    __device__ __forceinline__ size_t aoff(const Unit2&) const { return 0; }
    __device__ __forceinline__ const char* bptr(const Unit2& u) const { return (const char*)(Bt + (size_t)u.pn * BM * ldb); }
};
struct EpiResid {
    static constexpr bool PERM = false, AFTER_DRAIN = false;
    float* C; int ldc; const float* x; const float* stats; const float* g; const float* b; float alpha;
    __device__ __forceinline__ void operator()(const f32x4 (&acc)[2][2][4][2], const Unit2& u, int wr, int wc, int fr, int fq) const {
        const int row0 = u.pm * BM + wr * 64 + fr, col0 = u.pn * BM + wc * 32 + 4 * fq;
        f32x4 gv[2][2], bv[2][2];
#pragma unroll
        for (int bj = 0; bj < 2; ++bj)
#pragma unroll
            for (int n = 0; n < 2; ++n) { gv[bj][n] = *(const f32x4*)(g + col0 + bj * HALF + n * 16) * alpha; bv[bj][n] = *(const f32x4*)(b + col0 + bj * HALF + n * 16) * alpha; }
#pragma unroll
        for (int ai = 0; ai < 2; ++ai)
#pragma unroll
            for (int m = 0; m < 4; ++m) { const int row = row0 + ai * HALF + m * 16; const float mean = stats[2 * row], rstd = stats[2 * row + 1];
                const float* xr = x + (size_t)row * ldc + col0; float* cr = C + (size_t)row * ldc + col0;
#pragma unroll
                for (int bj = 0; bj < 2; ++bj)
#pragma unroll
                    for (int n = 0; n < 2; ++n) { const f32x4 xv = *(const f32x4*)(xr + bj * HALF + n * 16);
                        *(f32x4*)(cr + bj * HALF + n * 16) = acc[ai][bj][m][n] + ((xv - mean) * rstd) * gv[bj][n] + bv[bj][n]; } }
    }
};
}
namespace nv {
constexpr int D = 1024, B = 8, S = 4096, T = B * S;
constexpr int FH = 8, FD = 64, GH = 4, GK = 64, GV = 128, RANK = 16;
constexpr int INW = 3096;
constexpr int O_FQ = 0, O_FK = 512, O_FV = 1024, O_FF = 1536, O_GQ = 1544, O_GK = 1800, O_GV = 2056, O_GA = 2568, O_GR = 2584;
constexpr int NE = 256, NG = 8, TOPK = 8, ED = 256;
constexpr float LN_EPS = 1e-5f;
constexpr float ALPHA = 1.189207115002721f;
constexpr int PADR = 64;
constexpr int APAD = T * TOPK + NE * PADR;

__device__ __forceinline__ float logsigmoidf(float x) { return fminf(x, 0.f) - log1pf(expf(-fabsf(x))); }
__device__ __forceinline__ float siluf(float x) { return x / (1.f + expf(-x)); }


__device__ __forceinline__ void ln_row(const float* in1, float a, const float* in2, const float* __restrict__ g, const float* __restrict__ b, float* out, int r, int tid, float* sh) {
    float4 v = ((const float4*)(in1 + (size_t)r * D))[tid];
    v.x *= a; v.y *= a; v.z *= a; v.w *= a;
    if (in2) { const float4 w = ((const float4*)(in2 + (size_t)r * D))[tid]; v.x += w.x; v.y += w.y; v.z += w.z; v.w += w.w; }
    float s = v.x + v.y + v.z + v.w;
    for (int o = 32; o > 0; o >>= 1) s += __shfl_xor(s, o);
    __syncthreads();
    if ((tid & 63) == 0) sh[tid >> 6] = s;
    __syncthreads();
    const float mean = (sh[0] + sh[1] + sh[2] + sh[3]) * (1.f / D);
    v.x -= mean; v.y -= mean; v.z -= mean; v.w -= mean;
    float q = v.x * v.x + v.y * v.y + v.z * v.z + v.w * v.w;
    for (int o = 32; o > 0; o >>= 1) q += __shfl_xor(q, o);
    if ((tid & 63) == 0) sh[4 + (tid >> 6)] = q;
    __syncthreads();
    const float rstd = rsqrtf((sh[4] + sh[5] + sh[6] + sh[7]) * (1.f / D) + LN_EPS);
    const float4 gg = ((const float4*)g)[tid], bb = ((const float4*)b)[tid];
    float4 o4; o4.x = v.x * rstd * gg.x + bb.x; o4.y = v.y * rstd * gg.y + bb.y; o4.z = v.z * rstd * gg.z + bb.z; o4.w = v.w * rstd * gg.w + bb.w;
    ((float4*)(out + (size_t)r * D))[tid] = o4;
}

__device__ __forceinline__ void gemm_tile(const float* A, const float* Bm, float* C, int N, int K, int lda, int ldb, int ldc, int tile_x, int tile_y, int tid, float* sh) {
    float (*As)[68] = (float (*)[68])sh;
    float (*Bs)[68] = (float (*)[68])(sh + 16 * 68);
    const int tx = tid & 15, ty = tid >> 4;
    const int row0 = tile_y * 64, col0 = tile_x * 64;
    float acc[4][4] = {};
    const int ar = tid >> 2, ak = (tid & 3) * 4;
    const int bk = tid >> 4, bc = (tid & 15) * 4;
    const bool bok = (col0 + bc) < N;
    for (int k0 = 0; k0 < K; k0 += 16) {
        const float4 av = *(const float4*)(A + (size_t)(row0 + ar) * lda + k0 + ak);
        float4 bv = make_float4(0.f, 0.f, 0.f, 0.f);
        if (bok) bv = *(const float4*)(Bm + (size_t)(k0 + bk) * ldb + col0 + bc);
        __syncthreads();
        As[ak + 0][ar] = av.x; As[ak + 1][ar] = av.y; As[ak + 2][ar] = av.z; As[ak + 3][ar] = av.w;
        *(float4*)&Bs[bk][bc] = bv;
        __syncthreads();
#pragma unroll
        for (int k = 0; k < 16; ++k) {
            const float4 a4 = *(const float4*)&As[k][ty * 4];
            const float4 b4 = *(const float4*)&Bs[k][tx * 4];
            const float aa[4] = {a4.x, a4.y, a4.z, a4.w}, bb[4] = {b4.x, b4.y, b4.z, b4.w};
#pragma unroll
            for (int i = 0; i < 4; ++i)
#pragma unroll
                for (int j = 0; j < 4; ++j) acc[i][j] += aa[i] * bb[j];
        }
    }
    if (col0 + tx * 4 < N) {
#pragma unroll
        for (int i = 0; i < 4; ++i)
            *(float4*)(C + (size_t)(row0 + ty * 4 + i) * ldc + col0 + tx * 4) = make_float4(acc[i][0], acc[i][1], acc[i][2], acc[i][3]);
    }
}
__device__ __forceinline__ void gemm_phase(const float* A, const float* Bm, float* C, int M, int N, int K, int lda, int ldb, int ldc, int half, int tid, float* sh) {
    const int ntx = (N + 63) / 64, nty = M / 64, ntile = ntx * nty, G2 = gridDim.x * 2;
    for (int t0 = blockIdx.x * 2; t0 < ntile; t0 += G2) {
        int tl = t0 + half; if (tl >= ntile) tl = ntile - 1;
        gemm_tile(A, Bm, C, N, K, lda, ldb, ldc, tl % ntx, tl / ntx, tid, sh);
    }
}

__device__ __forceinline__ void fox_prep(const float* proj, const float* __restrict__ bf, float* cbuf, int bh, int lane) {
    const int b = bh / FH, h = bh % FH;
    const float bias = bf[h];
    float s = 0.f;
    for (int i = 0; i < 64; ++i) { const int t = lane * 64 + i; s += logsigmoidf(proj[(size_t)(b * S + t) * INW + O_FF + h] + bias); }
    float inc = s;
    for (int o = 1; o < 64; o <<= 1) { const float n = __shfl_up(inc, o); if (lane >= o) inc += n; }
    float run = inc - s;
    for (int i = 0; i < 64; ++i) { const int t = lane * 64 + i; run += logsigmoidf(proj[(size_t)(b * S + t) * INW + O_FF + h] + bias); cbuf[(size_t)bh * S + t] = run; }
}

__device__ __forceinline__ void fox_attn(const float* proj, const float* cbuf, float* y, int blk, int lane) {
    const int qb = blk % (S / 64), bh = blk / (S / 64), b = bh / FH, h = bh % FH;
    const int t = qb * 64 + lane;
    const float* qp = proj + (size_t)(b * S + t) * INW + O_FQ + h * FD;
    float q[64], o[64];
#pragma unroll
    for (int d = 0; d < 64; ++d) { q[d] = qp[d] * 0.125f; o[d] = 0.f; }
    const float ct = cbuf[(size_t)bh * S + t];
    float m = -INFINITY, l = 0.f;
    const int smax = qb * 64 + 63;
    for (int s = 0; s <= smax; ++s) {
        const float* kp = proj + (size_t)(b * S + s) * INW + O_FK + h * FD;
        const float* vp = proj + (size_t)(b * S + s) * INW + O_FV + h * FD;
        float dot = 0.f;
#pragma unroll
        for (int d = 0; d < 64; ++d) dot += q[d] * kp[d];
        const float x = dot + (ct - cbuf[(size_t)bh * S + s]);
        if (s <= t) {
            if (x > m) { const float al = expf(m - x); l *= al;
#pragma unroll
                for (int d = 0; d < 64; ++d) o[d] *= al;
                m = x; }
            const float p = expf(x - m); l += p;
#pragma unroll
            for (int d = 0; d < 64; ++d) o[d] += p * vp[d];
        }
    }
    const float il = 1.f / l;
    float* yp = y + (size_t)(b * S + t) * D + h * FD;
#pragma unroll
    for (int d = 0; d < 64; ++d) yp[d] = o[d] * il;
}

__device__ __forceinline__ void gla_prep(const float* proj, const float* __restrict__ wgu, const float* __restrict__ bg, float* abuf, int t, int j) {
    const float* ga = proj + (size_t)t * INW + O_GA;
    float s = bg[j];
#pragma unroll
    for (int r = 0; r < RANK; ++r) s += ga[r] * wgu[r * 256 + j];
    abuf[(size_t)t * 256 + j] = expf(logsigmoidf(s) * (1.f / 16.f));
}

__device__ __forceinline__ void gla_rec(const float* proj, const float* abuf, float* glao, int bh, int e) {
    const int b = bh / GH, h = bh % GH;
    float st[64];
#pragma unroll
    for (int d = 0; d < 64; ++d) st[d] = 0.f;
    for (int s = 0; s < S; ++s) {
        const size_t t = (size_t)b * S + s;
        const float* qp = proj + t * INW + O_GQ + h * GK;
        const float* kp = proj + t * INW + O_GK + h * GK;
        const float* ap = abuf + t * 256 + h * GK;
        const float v = proj[t * INW + O_GV + h * GV + e];
        float o = 0.f;
#pragma unroll
        for (int d = 0; d < 64; ++d) { st[d] = ap[d] * st[d] + kp[d] * v; o += qp[d] * st[d]; }
        glao[t * 512 + h * GV + e] = o * 0.125f;
    }
}

__device__ __forceinline__ void gla_post(const float* glao, const float* proj, const float* __restrict__ g, float* y, int w, int lane) {
    const int t = w >> 2, h = w & 3;
    const float o0 = glao[(size_t)t * 512 + h * GV + lane], o1 = glao[(size_t)t * 512 + h * GV + 64 + lane];
    float ss = o0 * o0 + o1 * o1;
    for (int o = 32; o > 0; o >>= 1) ss += __shfl_xor(ss, o);
    const float r = rsqrtf(ss * (1.f / GV) + LN_EPS);
    const float g0 = proj[(size_t)t * INW + O_GR + h * GV + lane], g1 = proj[(size_t)t * INW + O_GR + h * GV + 64 + lane];
    y[(size_t)t * D + 512 + h * GV + lane] = o0 * r * g[lane] * siluf(g0);
    y[(size_t)t * D + 512 + h * GV + 64 + lane] = o1 * r * g[64 + lane] * siluf(g1);
}

__device__ __forceinline__ void route_token(const float* logits, const float* __restrict__ rbias, int* top_e, float* top_w, int* top_pos, int* counts, int t, int lane) {
    const float4 lg = ((const float4*)(logits + (size_t)t * NE))[lane];
    const float4 rb = ((const float4*)rbias)[lane];
    float sc[4] = {1.f / (1.f + expf(-lg.x)), 1.f / (1.f + expf(-lg.y)), 1.f / (1.f + expf(-lg.z)), 1.f / (1.f + expf(-lg.w))};
    float bv[4] = {sc[0] + rb.x, sc[1] + rb.y, sc[2] + rb.z, sc[3] + rb.w};
    float m1 = fmaxf(bv[0], bv[1]), m2 = fminf(bv[0], bv[1]);
    { const float a = fmaxf(bv[2], bv[3]), c = fminf(bv[2], bv[3]); const float n1 = fmaxf(m1, a); m2 = fmaxf(fminf(m1, a), fmaxf(m2, c)); m1 = n1; }
    for (int o = 1; o < 8; o <<= 1) { const float p1 = __shfl_xor(m1, o), p2 = __shfl_xor(m2, o); const float n1 = fmaxf(m1, p1); m2 = fmaxf(fminf(m1, p1), fmaxf(m2, p2)); m1 = n1; }
    const float gs = m1 + m2;
    const int myg = lane >> 3;
    int rank = 0;
#pragma unroll
    for (int g2 = 0; g2 < NG; ++g2) { const float og = __shfl(gs, g2 * 8); if (og > gs || (og == gs && g2 < myg)) ++rank; }
    const bool sel = rank < 4;
    float mv[4];
#pragma unroll
    for (int i = 0; i < 4; ++i) mv[i] = sel ? bv[i] : -INFINITY;
    int we[TOPK]; float ws[TOPK]; float wsum = 0.f;
#pragma unroll
    for (int k = 0; k < TOPK; ++k) {
        float bvv = mv[0]; int bi = 0;
#pragma unroll
        for (int i = 1; i < 4; ++i) if (mv[i] > bvv) { bvv = mv[i]; bi = i; }
        int gi = lane * 4 + bi;
        for (int o = 32; o > 0; o >>= 1) { const float ov = __shfl_xor(bvv, o); const int oi = __shfl_xor(gi, o); if (ov > bvv || (ov == bvv && oi < gi)) { bvv = ov; gi = oi; } }
        const int ol = gi >> 2, oi = gi & 3;
        const float s_own = (oi == 0) ? sc[0] : (oi == 1) ? sc[1] : (oi == 2) ? sc[2] : sc[3];
        const float sw = __shfl(s_own, ol);
        if (lane == ol) { if (oi == 0) mv[0] = -INFINITY; else if (oi == 1) mv[1] = -INFINITY; else if (oi == 2) mv[2] = -INFINITY; else mv[3] = -INFINITY; }
        we[k] = gi; ws[k] = sw; wsum += sw;
    }
    if (lane == 0) {
        const float inv = 2.5f / wsum;
#pragma unroll
        for (int k = 0; k < TOPK; ++k) {
            top_e[t * TOPK + k] = we[k]; top_w[t * TOPK + k] = ws[k] * inv;
            top_pos[t * TOPK + k] = atomicAdd(&counts[we[k]], 1);
        }
    }
}

__device__ __forceinline__ void moe_offsets(const int* counts, int* off, int* blk_exp, int* nblk, int lane) {
    int pc[4], st[4]; int tot = 0;
#pragma unroll
    for (int i = 0; i < 4; ++i) { pc[i] = (counts[lane * 4 + i] + PADR - 1) / PADR * PADR; st[i] = tot; tot += pc[i]; }
    int inc = tot;
    for (int o = 1; o < 64; o <<= 1) { const int n = __shfl_up(inc, o); if (lane >= o) inc += n; }
    const int base = inc - tot;
#pragma unroll
    for (int i = 0; i < 4; ++i) { const int start = base + st[i]; off[lane * 4 + i] = start; for (int k = start / PADR; k < (start + pc[i]) / PADR; ++k) blk_exp[k] = lane * 4 + i; }
    if (lane == 63) nblk[0] = inc / PADR;
}

__device__ __forceinline__ void moe_scatter(const int* top_e, const float* top_w, const int* top_pos, const int* off, int* row_tok, float* row_gate, int* slot_of, int a) {
    const int slot = off[top_e[a]] + top_pos[a];
    row_tok[slot] = a / TOPK; row_gate[slot] = top_w[a]; slot_of[a] = slot;
}

__device__ __forceinline__ void moe_hidden(const float* h1, const float* __restrict__ wg, const float* __restrict__ wu, const int* row_tok, const float* row_gate, const int* blk_exp, const int* nblk,
                                           float* hidden, int g16, int j, float* sh) {
    const bool active = g16 * 16 < nblk[0] * PADR;
    float (*xs)[D] = (float (*)[D])sh;
    __syncthreads();
    if (active) for (int r = 0; r < 16; ++r) { const int tok = row_tok[g16 * 16 + r]; ((float4*)xs[r])[j] = ((const float4*)(h1 + (size_t)tok * D))[j]; }
    __syncthreads();
    if (!active) return;
    const int e = blk_exp[(g16 * 16) / PADR];
    float ag[16], au[16];
#pragma unroll
    for (int r = 0; r < 16; ++r) { ag[r] = 0.f; au[r] = 0.f; }
    const float* wgp = wg + (size_t)e * D * ED + j; const float* wup = wu + (size_t)e * D * ED + j;
    for (int d = 0; d < D; d += 4) {
        const float g0 = wgp[(size_t)(d + 0) * ED], g1 = wgp[(size_t)(d + 1) * ED], g2 = wgp[(size_t)(d + 2) * ED], g3 = wgp[(size_t)(d + 3) * ED];
        const float u0 = wup[(size_t)(d + 0) * ED], u1 = wup[(size_t)(d + 1) * ED], u2 = wup[(size_t)(d + 2) * ED], u3 = wup[(size_t)(d + 3) * ED];
#pragma unroll
        for (int r = 0; r < 16; ++r) { const float4 x = *(const float4*)&xs[r][d];
            ag[r] += x.x * g0 + x.y * g1 + x.z * g2 + x.w * g3; au[r] += x.x * u0 + x.y * u1 + x.z * u2 + x.w * u3; }
    }
#pragma unroll
    for (int r = 0; r < 16; ++r) hidden[(size_t)(g16 * 16 + r) * ED + j] = row_gate[g16 * 16 + r] * siluf(ag[r]) * au[r];
}

__device__ __forceinline__ void moe_down(const float* hidden, const float* __restrict__ wd, const int* top_e, const int* slot_of, float* ffn, int t, int i, float* sh) {
    float4 acc = ((float4*)(ffn + (size_t)t * D))[i];
    for (int k = 0; k < TOPK; ++k) {
        const int e = top_e[t * TOPK + k], slot = slot_of[t * TOPK + k];
        __syncthreads();
        sh[i] = hidden[(size_t)slot * ED + i];
        __syncthreads();
        const float4* wp = (const float4*)(wd + (size_t)e * ED * D) + i;
        for (int j = 0; j < ED; ++j) { const float4 w = wp[(size_t)j * (D / 4)]; const float hv = sh[j]; acc.x += hv * w.x; acc.y += hv * w.y; acc.z += hv * w.z; acc.w += hv * w.w; }
    }
    ((float4*)(ffn + (size_t)t * D))[i] = acc;
}
}
#include <hip/hip_bf16.h>
#include <cmath>
namespace attn_body {
using bf16=__hip_bfloat16;
using bf16x8=__attribute__((ext_vector_type(8)))short;
using s16x4=__attribute__((ext_vector_type(4)))short;
using f32x16=__attribute__((ext_vector_type(16)))float;
using u32x4=__attribute__((ext_vector_type(4)))unsigned;
constexpr int BATCH=8,NHEAD=8,SEQ=4096,D=64,DM=3072,OPITCH=1024;
constexpr int NW=8,QBLK=32,QB=QBLK*NW,KVBLK=64,NQB=SEQ/QB;
constexpr int ATTN_PITCH=DM, ATTN_UNIT_ROWS=QB;
__device__ __forceinline__ int crow(int r,int hi){return (r&3)+8*(r>>2)+4*hi;}
#define SBAR() __builtin_amdgcn_sched_barrier(0)
__device__ __forceinline__ void cmask(f32x16&p0,f32x16&p1,int jb,int qrel,int hi){
  const float NEG=-INFINITY; int kb=64*jb+4*hi;
  #pragma unroll
  for(int r=0;r<16;++r){int kv=kb+(r&3)+8*(r>>2); if(kv>qrel)p0[r]=NEG; if(kv+32>qrel)p1[r]=NEG;}
}

constexpr int NSLOT=3, SLOTB=8192;
constexpr int LDS_K=0, LDS_V=NSLOT*SLOTB, LDS_WS=2*NSLOT*SLOTB, LDS_OST=LDS_WS+NW*64*4, LDS_CS=LDS_OST+NW*4096, LDS_BYTES=LDS_CS+SEQ*4;
constexpr float C2=0.125f*1.4426950408889634f;
__device__ __forceinline__ void glds16(const void*gsrc,unsigned lds_dst){unsigned keep;
  asm volatile("s_mov_b32 %0, m0\n\ts_mov_b32 m0, %2\n\ts_nop 0\n\tglobal_load_lds_dwordx4 %1, off\n\ts_mov_b32 m0, %0":"=&s"(keep):"v"(gsrc),"s"(lds_dst):"memory");}
__device__ __forceinline__ float max3f(float a,float b,float c){float r;asm("v_max3_f32 %0, %1, %2, %3":"=v"(r):"v"(a),"v"(b),"v"(c));return r;}
__device__ __forceinline__ float max2f(float a,float b){float r;asm("v_max_f32_e32 %0, %1, %2":"=v"(r):"v"(a),"v"(b));return r;}
__device__ __forceinline__ float fadd_s(float a,float b){float r;asm("v_add_f32_e32 %0, %1, %2":"=v"(r):"v"(a),"v"(b));return r;}
__device__ __forceinline__ float fsub_s(float a,float b){float r;asm("v_sub_f32_e32 %0, %1, %2":"=v"(r):"v"(a),"v"(b));return r;}
typedef float f32x2_t __attribute__((ext_vector_type(2))); typedef float f32x4_t __attribute__((ext_vector_type(4))); typedef __bf16 bf16x2_t __attribute__((ext_vector_type(2)));
__device__ __forceinline__ unsigned cvtpk_s(float lo,float hi){f32x2_t v={lo,hi};bf16x2_t b=__builtin_convertvector(v,bf16x2_t);return __builtin_bit_cast(unsigned,b);}
#define WAIT_BAR(N) asm volatile("s_waitcnt vmcnt(" #N ") lgkmcnt(0)\n\ts_barrier":::"memory")

__device__ __forceinline__ void split3(float b,unsigned&h,unsigned&m,unsigned&l){
  h=cvtpk_s(b,0.f)&0xffffu; const float r1=b-__uint_as_float(h<<16);
  m=cvtpk_s(r1,0.f)&0xffffu; const float r2=r1-__uint_as_float(m<<16);
  l=cvtpk_s(r2,0.f)&0xffffu; }
__device__ __forceinline__ bf16x8 kbias_frag(float b,int hi){unsigned h,m,l;split3(b,h,m,l);u32x4 w;w.x=h|(m<<16);w.y=l|0x3F800000u;w.z=0x3F803F80u;w.w=0u;if(hi){w.x=0u;w.y=0u;w.z=0u;}return __builtin_bit_cast(bf16x8,w);}
__device__ __forceinline__ bf16x8 qref_frag(float x,int hi){unsigned h,m,l;split3(x,h,m,l);u32x4 w;w.x=0x3F803F80u;w.y=0x3F80u|(h<<16);w.z=m|(l<<16);w.w=0u;if(hi){w.x=0u;w.y=0u;w.z=0u;}return __builtin_bit_cast(bf16x8,w);}
__device__ __forceinline__ void qkt(f32x16&p0,f32x16&p1,const char*Kslot,const bf16x8*qr,bf16x8 kb0,bf16x8 kb1,bf16x8 qx,int r32,int hi){
  const f32x16 negm=f32x16{};
  const char*kb=Kslot+hi*1024+r32*16;
  #pragma unroll
  for(int d0=0;d0<4;++d0){
    const bf16x8 b0=*reinterpret_cast<const bf16x8*>(kb+d0*2048);
    const bf16x8 b1=*reinterpret_cast<const bf16x8*>(kb+d0*2048+512);
    if(d0==0){p0=__builtin_amdgcn_mfma_f32_32x32x16_bf16(b0,qr[0],negm,0,0,0);p1=__builtin_amdgcn_mfma_f32_32x32x16_bf16(b1,qr[0],negm,0,0,0);}
    else{p0=__builtin_amdgcn_mfma_f32_32x32x16_bf16(b0,qr[d0],p0,0,0,0);p1=__builtin_amdgcn_mfma_f32_32x32x16_bf16(b1,qr[d0],p1,0,0,0);}}
  p0=__builtin_amdgcn_mfma_f32_32x32x16_bf16(kb0,qx,p0,0,0,0);p1=__builtin_amdgcn_mfma_f32_32x32x16_bf16(kb1,qx,p1,0,0,0);
}
typedef __attribute__((address_space(3))) const char* lds_cptr;
typedef short v4i16_t __attribute__((ext_vector_type(4)));
__device__ __forceinline__ void kload8(bf16x8*kf,lds_cptr kp){
  kf[0]=*(const __attribute__((address_space(3))) bf16x8*)(kp);      kf[1]=*(const __attribute__((address_space(3))) bf16x8*)(kp+512);
  kf[2]=*(const __attribute__((address_space(3))) bf16x8*)(kp+2048); kf[3]=*(const __attribute__((address_space(3))) bf16x8*)(kp+2560);
  kf[4]=*(const __attribute__((address_space(3))) bf16x8*)(kp+4096); kf[5]=*(const __attribute__((address_space(3))) bf16x8*)(kp+4608);
  kf[6]=*(const __attribute__((address_space(3))) bf16x8*)(kp+6144); kf[7]=*(const __attribute__((address_space(3))) bf16x8*)(kp+6656);
}
__device__ __forceinline__ void kload2(bf16x8*kf,lds_cptr kp,int j){ kf[2*j]=*(const __attribute__((address_space(3))) bf16x8*)(kp+j*2048); kf[2*j+1]=*(const __attribute__((address_space(3))) bf16x8*)(kp+j*2048+512); }
__device__ __forceinline__ s16x4 vtr(lds_cptr p){ return __builtin_bit_cast(s16x4,__builtin_amdgcn_ds_read_tr16_b64_v4i16((__attribute__((address_space(3))) v4i16_t*)p)); }
__device__ __forceinline__ float rowmax(const f32x16&p0,const f32x16&p1){
  float a=max3f(p0[0],p0[1],p1[0]),b=max3f(p0[2],p0[3],p1[1]);a=max3f(a,p1[2],p1[3]);
  #pragma unroll
  for(int r=4;r<16;r+=4){a=max3f(a,p0[r],p0[r+1]);b=max3f(b,p0[r+2],p0[r+3]);a=max3f(a,p1[r],p1[r+1]);b=max3f(b,p1[r+2],p1[r+3]);}
  const float m=max2f(a,b);
  auto rr=__builtin_amdgcn_permlane32_swap(__float_as_uint(m),__float_as_uint(m),false,false);
  return max2f(__uint_as_float(rr[0]),__uint_as_float(rr[1]));
}
__device__ __forceinline__ void pv(f32x16*o,int vb,bf16x8 pa0,bf16x8 pa1,bf16x8 pa2,bf16x8 pa3){
  #pragma unroll
  for(int d0=0;d0<2;++d0){s16x4 lo[4],hi[4];
    #pragma unroll
    for(int ks=0;ks<4;++ks){
      asm volatile("ds_read_b64_tr_b16 %0,%1 offset:%c2":"=&v"(lo[ks]):"v"(vb),"i"(d0*4096+ks*1024):"memory");
      asm volatile("ds_read_b64_tr_b16 %0,%1 offset:%c2":"=&v"(hi[ks]):"v"(vb),"i"(d0*4096+ks*1024+512):"memory");}
    asm volatile("s_waitcnt lgkmcnt(0)":::"memory");SBAR();
    #define PK(k) (bf16x8){lo[k][0],lo[k][1],lo[k][2],lo[k][3],hi[k][0],hi[k][1],hi[k][2],hi[k][3]}
    o[d0]=__builtin_amdgcn_mfma_f32_32x32x16_bf16(pa0,PK(0),o[d0],0,0,0);
    o[d0]=__builtin_amdgcn_mfma_f32_32x32x16_bf16(pa1,PK(1),o[d0],0,0,0);
    o[d0]=__builtin_amdgcn_mfma_f32_32x32x16_bf16(pa2,PK(2),o[d0],0,0,0);
    o[d0]=__builtin_amdgcn_mfma_f32_32x32x16_bf16(pa3,PK(3),o[d0],0,0,0);
    #undef PK
  }
}

#ifndef ATTN_STORE16
#define ATTN_STORE16(p,v) (*(u32x4*)(p)=(v))
#endif
template<int THRL> __device__ __forceinline__ void attn_unit(int b,int h,int qb,const bf16*Q,const bf16* K,const bf16* V,bf16*O,const float*LF,char*shm){
  int tid_=threadIdx.x; asm volatile("":"+v"(tid_));
  const int tid=tid_,lane=tid&63,r32=lane&31,hi=lane>>5; const int wid=__builtin_amdgcn_readfirstlane(tid>>6);
  const long rowbase=(long)b*SEQ; const int q0=qb*QB;
  float*csl=(float*)(shm+LDS_CS); float cq0;
  { const int n=q0+QB; const float*lf=LF+((long)b*NHEAD+h)*SEQ; float*wt=(float*)(shm+LDS_WS);
    f32x4_t va={0.f,0.f,0.f,0.f},vb={0.f,0.f,0.f,0.f};
    if(8*tid<n){ va=*(const f32x4_t*)(lf+8*tid); vb=*(const f32x4_t*)(lf+8*tid+4); }
    va[1]+=va[0];va[2]+=va[1];va[3]+=va[2];vb[0]+=va[3];vb[1]+=vb[0];vb[2]+=vb[1];vb[3]+=vb[2];
    const float tot=vb[3]; float inc=tot;
    #pragma unroll
    for(int o_=1;o_<64;o_<<=1){const float nn=__shfl_up(inc,o_);if(lane>=o_)inc+=nn;}
    if(lane==63)wt[wid*64]=inc;
    __syncthreads();
    float base=inc-tot;
    #pragma unroll
    for(int w_=0;w_<NW;++w_){const float x_=wt[w_*64]; if(w_<wid)base+=x_;}
    if(8*tid<n){ va=va+base; vb=vb+base; *(f32x4_t*)(csl+8*tid)=va; *(f32x4_t*)(csl+8*tid+4)=vb; }
    __syncthreads();
    cq0=csl[q0]; }
  const bf16*Qw=Q+(rowbase+q0+wid*QBLK)*DM+h*D;
  const bf16*Kh=K+rowbase*DM+h*D,*Vh=V+rowbase*DM+h*D;
  const unsigned lds0=(unsigned)(uintptr_t)shm;
  float*wsf=(float*)(shm+LDS_WS)+wid*64;
  const bf16*ksrc=Kh+(long)lane*DM+wid*8;
  const bf16*vsrc=Vh+(long)(16*(wid&3)+(lane>>2))*DM+(wid>>2)*32+(lane&3)*8;
  const unsigned kdst=lds0+LDS_K+wid*1024, vdst=lds0+LDS_V+wid*1024;
  #define DMA_K(t,slot) glds16(ksrc+(long)(t)*KVBLK*DM,(unsigned)__builtin_amdgcn_readfirstlane(kdst+(slot)))
  #define DMA_V(t,slot) glds16(vsrc+(long)(t)*KVBLK*DM,(unsigned)__builtin_amdgcn_readfirstlane(vdst+(slot)))
  const int vb0=(int)(lds0+LDS_V)+((lane>>4)&1)*32+(lane&3)*8+(4*hi+((lane&15)>>2))*64;
  const char*Kbase=shm+LDS_K; bf16x8 kf[8];
  const lds_cptr shm3=(lds_cptr)shm; const lds_cptr kp0=shm3+LDS_K+hi*1024+r32*16; const lds_cptr vp0=shm3+LDS_V+((lane>>4)&1)*32+(lane&3)*8+(4*hi+((lane&15)>>2))*64;
  const int NT=(q0+QB)/KVBLK;
  DMA_K(0,0);DMA_V(0,0);DMA_K(1,SLOTB);
  bf16x8 qr[4];
  #pragma unroll
  for(int d0=0;d0<4;++d0)qr[d0]=*reinterpret_cast<const bf16x8*>(&Qw[(long)r32*DM+d0*16+hi*8]);
  float mhat=0.f,l_reg=0.f;f32x16 o[2];o[0]=f32x16{};o[1]=f32x16{};const f32x16 negm=f32x16{};
  bf16x8 qx=qref_frag(0.f,hi);
  const int qrel=wid*QBLK+r32;
  #define CMASK(P0,P1,t) do{int jb_=(t)-(NT-4); if(jb_>=0)cmask(P0,P1,jb_,qrel,hi);}while(0)
  bool resc=false;
  #define START(P0,P1) do{ const float rm=rowmax(P0,P1); resc=false; \
    { const float dl=rm; mhat=fadd_s(mhat,dl); \
      _Pragma("unroll") for(int r=0;r<16;++r){P0[r]=fsub_s(P0[r],dl);P1[r]=fsub_s(P1[r],dl);} \
      qx=qref_frag(-mhat,hi); } \
    _Pragma("unroll") for(int r=0;r<16;++r)P0[r]=__builtin_amdgcn_exp2f(P0[r]); }while(0)
  #define RESC() do{ if(resc){ asm volatile("s_waitcnt lgkmcnt(0)":::"memory"); \
      _Pragma("unroll") for(int d_=0;d_<2;++d_) _Pragma("unroll") for(int r=0;r<16;++r)o[d_][r]*=wsf[crow(r,hi)]; } }while(0)
  f32x16 pA0,pA1,pB0,pB1;
  int sl_prev=0,sl_cur=0,sl_next=SLOTB;
  #define ROT() do{sl_prev=sl_cur;sl_cur=sl_next;sl_next=(sl_next==(NSLOT-1)*SLOTB)?0:sl_next+SLOTB;}while(0)
  DMA_K(2,2*SLOTB);
  WAIT_BAR(3);
  qkt(pA0,pA1,Kbase,qr,kbias_frag(cq0-csl[r32],hi),kbias_frag(cq0-csl[32+r32],hi),qx,r32,hi);asm volatile("s_nop 15\n\ts_nop 7":"+v"(pA0),"+v"(pA1));CMASK(pA0,pA1,0);
  START(pA0,pA1);
  _Pragma("unroll") for(int r=0;r<16;++r)pA1[r]=__builtin_amdgcn_exp2f(pA1[r]);
  WAIT_BAR(0);
  DMA_K(3,0);DMA_V(1,SLOTB);
  ROT();
  kload8(kf,kp0+sl_cur);
  WAIT_BAR(2);
  s16x4 vlo[8],vhi[8]; u32x4 pw0,pw1,pw2,pw3;
  #define PKW(P,B) cvtpk_s(P[B],P[B+1])
  #define PAF(k) __builtin_bit_cast(bf16x8,pw##k)
  #define VFR(i) (bf16x8){vlo[i][0],vlo[i][1],vlo[i][2],vlo[i][3],vhi[i][0],vhi[i][1],vhi[i][2],vhi[i][3]}
  #define PIN(x) asm volatile("":"+v"(x))
  #define MX3(a,b,c) __builtin_fmaxf(__builtin_fmaxf((a),(b)),(c))
  #define GAPA(MF,A0,A1,A2,A3,W0,W1,PW) do{ MF; sacc+=A0; sacc+=A1; sacc+=A2; sacc+=A3; PIN(sacc); W0; W1; PIN(PW); SBAR(); }while(0)
  #define EX(v) __builtin_amdgcn_exp2f(v)
  #define GAPB(MF,X,B) do{ MF; X[B]=EX(X[B]); X[B+1]=EX(X[B+1]); X[B+2]=EX(X[B+2]); X[B+3]=EX(X[B+3]); PIN(X); SBAR(); }while(0)
  #define VRD(i) do{ vlo[i]=vtr(vp_+(((i)>>2)*4096+((i)&3)*1024)); vhi[i]=vtr(vp_+(((i)>>2)*4096+((i)&3)*1024+512)); }while(0)
  #define KRD(G,j) do{ if(G){ kload2(kf,kp0+sl_next,j); SBAR(); } }while(0)
  #define STEP(C0,C1,P0,P1,t,GK,GV,GL) do{ SBAR(); \
    const lds_cptr vp_=vp0+sl_prev; const float nb0_=csl[64*(t)+r32],nb1_=csl[64*(t)+32+r32]; \
    VRD(0); SBAR(); float sacc=(P0[0]+P0[1]); \
    GAPA(C0=__builtin_amdgcn_mfma_f32_32x32x16_bf16(kf[0],qr[0],negm,0,0,0), P0[2],P0[3],P0[4],P0[5],     pw0[0]=PKW(P0,0), pw0[1]=PKW(P0,2), pw0); \
    VRD(4); SBAR(); GAPA(C1=__builtin_amdgcn_mfma_f32_32x32x16_bf16(kf[1],qr[0],negm,0,0,0), P0[6],P0[7],P0[8],P0[9],     pw0[2]=PKW(P0,4), pw0[3]=PKW(P0,6), pw0); \
    VRD(1); SBAR(); GAPA(C0=__builtin_amdgcn_mfma_f32_32x32x16_bf16(kf[2],qr[1],C0,0,0,0),   P0[10],P0[11],P0[12],P0[13], pw1[0]=PKW(P0,8), pw1[1]=PKW(P0,10), pw1); \
    VRD(5); SBAR(); GAPA(C1=__builtin_amdgcn_mfma_f32_32x32x16_bf16(kf[3],qr[1],C1,0,0,0),   P0[14],P0[15],P1[0],P1[1],   pw1[2]=PKW(P0,12),pw1[3]=PKW(P0,14), pw1); \
    VRD(2); SBAR(); GAPA(C0=__builtin_amdgcn_mfma_f32_32x32x16_bf16(kf[4],qr[2],C0,0,0,0),   P1[2],P1[3],P1[4],P1[5],     pw2[0]=PKW(P1,0), pw2[1]=PKW(P1,2), pw2); \
    VRD(6); SBAR(); GAPA(C1=__builtin_amdgcn_mfma_f32_32x32x16_bf16(kf[5],qr[2],C1,0,0,0),   P1[6],P1[7],P1[8],P1[9],     pw2[2]=PKW(P1,4), pw2[3]=PKW(P1,6), pw2); \
    VRD(3); SBAR(); GAPA(C0=__builtin_amdgcn_mfma_f32_32x32x16_bf16(kf[6],qr[3],C0,0,0,0),   P1[10],P1[11],P1[12],P1[13], pw3[0]=PKW(P1,8), pw3[1]=PKW(P1,10), pw3); \
    VRD(7); SBAR(); GAPA(C1=__builtin_amdgcn_mfma_f32_32x32x16_bf16(kf[7],qr[3],C1,0,0,0),   P1[14],P1[15],0.f,0.f,       pw3[2]=PKW(P1,12),pw3[3]=PKW(P1,14), pw3); \
    { const bf16x8 kb0_=kbias_frag(cq0-nb0_,hi),kb1_=kbias_frag(cq0-nb1_,hi); C0=__builtin_amdgcn_mfma_f32_32x32x16_bf16(kb0_,qx,C0,0,0,0); C1=__builtin_amdgcn_mfma_f32_32x32x16_bf16(kb1_,qx,C1,0,0,0); } SBAR(); \
    l_reg+=sacc; \
    if(GK){DMA_K((t)+3,sl_cur);} if(GV){DMA_V((t)+1,sl_next);} \
    CMASK(C0,C1,t); \
    { float a=MX3(C0[0],C0[1],C1[0]),b=MX3(C0[2],C0[3],C1[1]); a=MX3(a,C1[2],C1[3]); \
      _Pragma("unroll") for(int r=4;r<16;r+=4){a=MX3(a,C0[r],C0[r+1]);b=MX3(b,C0[r+2],C0[r+3]);a=MX3(a,C1[r],C1[r+1]);b=MX3(b,C1[r+2],C1[r+3]);} \
      float rm=__builtin_fmaxf(a,b); { auto rr=__builtin_amdgcn_permlane32_swap(__float_as_uint(rm),__float_as_uint(rm),false,false); rm=__builtin_fmaxf(__uint_as_float(rr[0]),__uint_as_float(rr[1])); } \
      resc=false; \
      if(__builtin_expect(__any(rm>(float)THRL),0)){ const float dl=__builtin_fmaxf(rm,0.f); mhat+=dl; \
        _Pragma("unroll") for(int r=0;r<16;++r){C0[r]-=dl;C1[r]-=dl;} \
        qx=qref_frag(-mhat,hi); \
        const float f=__builtin_amdgcn_exp2f(-dl); l_reg*=f; if(hi==0)wsf[r32]=f; resc=true; } } \
    SBAR(); \
    GAPB(o[0]=__builtin_amdgcn_mfma_f32_32x32x16_bf16(PAF(0),VFR(0),o[0],0,0,0), C0,0); \
    GAPB(o[1]=__builtin_amdgcn_mfma_f32_32x32x16_bf16(PAF(0),VFR(4),o[1],0,0,0), C0,4); \
    KRD(GL,0); GAPB(o[0]=__builtin_amdgcn_mfma_f32_32x32x16_bf16(PAF(1),VFR(1),o[0],0,0,0), C0,8); \
    KRD(GL,1); GAPB(o[1]=__builtin_amdgcn_mfma_f32_32x32x16_bf16(PAF(1),VFR(5),o[1],0,0,0), C0,12); \
    KRD(GL,2); GAPB(o[0]=__builtin_amdgcn_mfma_f32_32x32x16_bf16(PAF(2),VFR(2),o[0],0,0,0), C1,0); \
    KRD(GL,3); GAPB(o[1]=__builtin_amdgcn_mfma_f32_32x32x16_bf16(PAF(2),VFR(6),o[1],0,0,0), C1,4); \
    GAPB(o[0]=__builtin_amdgcn_mfma_f32_32x32x16_bf16(PAF(3),VFR(3),o[0],0,0,0), C1,8); \
    GAPB(o[1]=__builtin_amdgcn_mfma_f32_32x32x16_bf16(PAF(3),VFR(7),o[1],0,0,0), C1,12); \
    }while(0)
  int t=1;
  #undef CMASK
  #define CMASK(P0,P1,t) do{}while(0)
  for(;t+5<NT;t+=2){
    STEP(pB0,pB1,pA0,pA1,t,true,true,true);     WAIT_BAR(2); RESC(); ROT();
    STEP(pA0,pA1,pB0,pB1,t+1,true,true,true);   WAIT_BAR(2); RESC(); ROT();
  }
  #undef CMASK
  #define CMASK(P0,P1,t) do{int jb_=(t)-(NT-4); if(jb_>=0)cmask(P0,P1,jb_,qrel,hi);}while(0)
  #define ENDW(tt) do{ if((tt)+3<NT){WAIT_BAR(2);} else if((tt)+2<NT){WAIT_BAR(1);} else {WAIT_BAR(0);} }while(0)
  for(;t+1<NT;t+=2){
    STEP(pB0,pB1,pA0,pA1,t,(t+3<NT),(t+1<NT),(t+1<NT));       ENDW(t);   RESC(); ROT();
    STEP(pA0,pA1,pB0,pB1,t+1,(t+4<NT),(t+2<NT),(t+2<NT));     ENDW(t+1); RESC(); ROT();
  }
  STEP(pB0,pB1,pA0,pA1,NT-1,false,false,false); RESC();
  { float sacc=pB0[0]+pB0[1]; _Pragma("unroll") for(int r=2;r<16;++r)sacc+=pB0[r]; _Pragma("unroll") for(int r=0;r<16;++r)sacc+=pB1[r]; l_reg+=sacc;
    pw0=(u32x4){PKW(pB0,0),PKW(pB0,2),PKW(pB0,4),PKW(pB0,6)};pw1=(u32x4){PKW(pB0,8),PKW(pB0,10),PKW(pB0,12),PKW(pB0,14)};pw2=(u32x4){PKW(pB1,0),PKW(pB1,2),PKW(pB1,4),PKW(pB1,6)};pw3=(u32x4){PKW(pB1,8),PKW(pB1,10),PKW(pB1,12),PKW(pB1,14)};
    SBAR(); pv(o,vb0+sl_cur,PAF(0),PAF(1),PAF(2),PAF(3)); }
  #undef PKW
  #undef PAF
  #undef VFR
  #undef PIN
  #undef MX3
  #undef GAPA
  #undef GAPB
  #undef EX
  #undef VRD
  #undef KRD
  #undef STEP
  #undef ENDW
  {auto rr=__builtin_amdgcn_permlane32_swap(__float_as_uint(l_reg),__float_as_uint(l_reg),false,false);l_reg=__uint_as_float(rr[0])+__uint_as_float(rr[1]);}
  if(hi==0)wsf[32+r32]=l_reg;asm volatile("s_waitcnt lgkmcnt(0)":::"memory");
  float rli[16];
  #pragma unroll
  for(int r=0;r<16;++r)rli[r]=__builtin_amdgcn_rcpf(wsf[32+crow(r,hi)]);
  bf16*Ow=O+(rowbase+q0+wid*QBLK)*OPITCH+h*D;
  { bf16*stg=(bf16*)(shm+LDS_OST)+wid*2048;
    #pragma unroll
    for(int r=0;r<16;++r){const int orow=crow(r,hi);
      #pragma unroll
      for(int d0=0;d0<2;++d0)stg[orow*64+d0*32+r32]=__float2bfloat16(o[d0][r]*rli[r]);}
    asm volatile("s_waitcnt lgkmcnt(0)":::"memory");
    #pragma unroll
    for(int i=0;i<4;++i){const int row=i*8+(lane>>3),ch=lane&7; const u32x4 v=*(const u32x4*)(stg+row*64+ch*8); ATTN_STORE16(Ow+(long)row*OPITCH+ch*8,v);} }
  asm volatile("s_waitcnt lgkmcnt(0)\n\ts_barrier":::"memory");
  #undef DMA_K
  #undef DMA_V
  #undef CMASK
  #undef START
  #undef RESC
  #undef ROT
}
constexpr int ATTN_LDS_BYTES=LDS_BYTES;
struct AttnTensors { const bf16* Q; const bf16* K; const bf16* V; bf16* O; const float* LF; };
struct AttnUnit { int bh; int qb; };
struct StaticOrder {
  int vcu,grid;
  __device__ __forceinline__ explicit StaticOrder(int grid_,int block):vcu((grid_%8==0)?(block%8)*(grid_/8)+block/8:block),grid(grid_){}
  __device__ __forceinline__ bool next(int i,AttnUnit&u)const{
    if(grid==256){ if(i>=4)return false; const int s=vcu&3; u.bh=vcu>>2; u.qb=(i==0)?s:(i==1)?7-s:(i==2)?8+s:15-s; return true; }
    const int L=i*grid+vcu; if(L>=BATCH*NHEAD*NQB)return false; u.bh=L/NQB; u.qb=L%NQB; return true; }
  __device__ __forceinline__ void a_ready(const AttnUnit&)const{}
  __device__ __forceinline__ void done(const AttnUnit&)const{}
};
template<class Sched,int THRL=8> __device__ __forceinline__ void attn_phase(char*lds,const AttnTensors&T,const Sched&S){
  AttnUnit u;
  for(int i=0;S.next(i,u);++i){ S.a_ready(u); attn_unit<THRL>(u.bh/NHEAD,u.bh%NHEAD,u.qb,T.Q,T.K,T.V,T.O,T.LF,lds); S.done(u); }
}
#undef SBAR
#undef WAIT_BAR
}
namespace fx {
using namespace nv;
typedef unsigned short bf16;
typedef unsigned v4u __attribute__((ext_vector_type(4)));
typedef float f32x4 __attribute__((ext_vector_type(4)));
constexpr float C2 = 0.125f * 1.4426950408889634f;
constexpr int NIN = 3328;
constexpr int QKVP = 3072;
constexpr int P_FQ = 0, P_FK = 512, P_FV = 1024, P_GQ = 1536, P_GK = 1792, P_GV = 2048, P_GR = 2560;
__device__ __forceinline__ int inproj_src(int d) {
    if (d < 1536) return d;
    if (d < 1792) return O_GQ + (d - 1536);
    if (d < 2048) return O_GK + (d - 1792);
    if (d < 2560) return O_GV + (d - 2048);
    if (d < 3072) return O_GR + (d - 2560);
    if (d < 3080) return O_FF + (d - 3072);
    if (d < 3096) return O_GA + (d - 3080);
    return -1;
}
__device__ __forceinline__ unsigned f2bf(float f) { unsigned u = __builtin_bit_cast(unsigned, f); return (u + 0x7fffu + ((u >> 16) & 1u)) >> 16; }
__device__ __forceinline__ unsigned pk2(float lo, float hi) { return f2bf(lo) | (f2bf(hi) << 16); }
__device__ __forceinline__ float bf2f(unsigned short h) { return __builtin_bit_cast(float, (unsigned)h << 16); }
__device__ __forceinline__ float wave_sum(float v) {
#pragma unroll
    for (int o = 1; o < 64; o <<= 1) v += __shfl_xor(v, o);
    return v;
}
#define FX_LDS_WAIT() asm volatile("s_waitcnt lgkmcnt(0)" ::: "memory")

template <class Map> __device__ __forceinline__ void transpose_item(const float* __restrict__ W, int K, int N, bf16* WT, LAS float* scr, int kb, int nb, int lane, Map srcmap) {
    const int k0 = 64 * kb, n0 = 32 * nb;
    const int src = srcmap(n0 + (lane & 31));
#pragma unroll 8
    for (int i = 0; i < 32; ++i) { const int kk = 2 * i + (lane >> 5); scr[kk * 33 + (lane & 31)] = (src >= 0) ? W[(size_t)(k0 + kk) * N + src] : 0.f; }
    FX_LDS_WAIT(); asm volatile("" ::: "memory");
    const int c = lane & 7;
#pragma unroll
    for (int j = 0; j < 4; ++j) { const int n = (lane >> 3) + 8 * j; const LAS float* s = scr + (8 * c) * 33 + n;
        v4u o; o.x = pk2(s[0 * 33], s[1 * 33]); o.y = pk2(s[2 * 33], s[3 * 33]); o.z = pk2(s[4 * 33], s[5 * 33]); o.w = pk2(s[6 * 33], s[7 * 33]);
        *(GAS v4u*)(WT + (size_t)(n0 + n) * K + k0 + 8 * c) = o; }
    FX_LDS_WAIT(); asm volatile("" ::: "memory");
}

__device__ __forceinline__ void ln_row_bf16(const float* xrow, const float* __restrict__ g, const float* __restrict__ b, bf16* orow, float* frow, float* st, int lane) {
    const GAS f32x4* xr = (const GAS f32x4*)xrow + lane;
    f32x4 v[4]; float s = 0.f;
#pragma unroll
    for (int j = 0; j < 4; ++j) { v[j] = xr[64 * j]; s += (v[j].x + v[j].y) + (v[j].z + v[j].w); }
    const float mean = wave_sum(s) * (1.f / D); float s2 = 0.f;
#pragma unroll
    for (int j = 0; j < 4; ++j) { v[j] = v[j] - mean; s2 += (v[j].x * v[j].x + v[j].y * v[j].y) + (v[j].z * v[j].z + v[j].w * v[j].w); }
    const float rstd = 1.f / sqrtf(wave_sum(s2) * (1.f / D) + LN_EPS);
    if (st && lane == 0) { st[0] = mean; st[1] = rstd; }
    GAS unsigned long long* o8 = (GAS unsigned long long*)orow + lane;
#pragma unroll
    for (int j = 0; j < 4; ++j) {
        const f32x4 gg = ((const f32x4*)g)[lane + 64 * j], bb = ((const f32x4*)b)[lane + 64 * j];
        const f32x4 o = v[j] * rstd * gg + bb;
        o8[64 * j] = (unsigned long long)pk2(o.x, o.y) | ((unsigned long long)pk2(o.z, o.w) << 32);
        if (frow) ((GAS f32x4*)frow)[lane + 64 * j] = o;
    }
}
}

namespace pg8 {
struct EpiInProj {
    static constexpr bool PERM = true, AFTER_DRAIN = false;
    bf16_t* QKV; float* FG; float* LF; const float* bfg;
    __device__ __forceinline__ void operator()(const f32x4 (&acc)[2][2][4][2], const Unit& u, int wr, int wc, int fr, int fq) const {
        const int row0 = u.pm * BM + wr * 64 + fr;
        if (u.pn < 12) {
            const float sc = (u.pn < 2) ? fx::C2 : 1.f;
            const int col0 = u.pn * BM + wc * 32 + 8 * fq;
#pragma unroll
            for (int ai = 0; ai < 2; ++ai)
#pragma unroll
                for (int m = 0; m < 4; ++m) { bf16_t* rowp = QKV + (size_t)(row0 + ai * HALF + m * 16) * fx::QKVP + col0;
#pragma unroll
                    for (int bj = 0; bj < 2; ++bj) { const f32x4 v0 = acc[ai][bj][m][0] * sc, v1 = acc[ai][bj][m][1] * sc;
                        u32x4 w; w.x = cvt_pk_bf16(v0[0], v0[1]); w.y = cvt_pk_bf16(v0[2], v0[3]); w.z = cvt_pk_bf16(v1[0], v1[1]); w.w = cvt_pk_bf16(v1[2], v1[3]);
                        *(u32x4*)(rowp + bj * HALF) = w; } }
        } else if (wc == 0 && fq < 3) {
#pragma unroll
            for (int ai = 0; ai < 2; ++ai)
#pragma unroll
                for (int m = 0; m < 4; ++m) { const int row = row0 + ai * HALF + m * 16; float* p = FG + (size_t)row * 32 + 8 * fq;
                    *(f32x4*)p = acc[ai][0][m][0]; *(f32x4*)(p + 4) = acc[ai][0][m][1];
                    if (fq == 0) { const int b = row >> 12, s = row & 4095;
#pragma unroll
                        for (int n = 0; n < 2; ++n)
#pragma unroll
                            for (int i = 0; i < 4; ++i) { const int h = 4 * n + i; LF[(size_t)(b * 8 + h) * nv::S + s] = 1.4426950408889634f * nv::logsigmoidf(acc[ai][0][m][n][i] + bfg[h]); } } }
        }
    }
};
}
namespace gl {
using namespace nv;
typedef unsigned short bf16;
typedef short bf16x8 __attribute__((ext_vector_type(8)));
typedef float f32x4 __attribute__((ext_vector_type(4)));
typedef unsigned u32x4 __attribute__((ext_vector_type(4)));
typedef unsigned u32x2 __attribute__((ext_vector_type(2)));
constexpr int NCH = S / 64;
constexpr int NUNIT = B * GH * NCH;
constexpr int LS = 72;
constexpr int L_WGU = 0, L_BG = 4096, L_QP = 8192, L_KP = L_QP + 64 * LS * 2, L_KPT = L_KP + 64 * LS * 2, L_VT = L_KPT + 64 * LS * 2, L_PP = L_VT + 128 * LS * 2, L_WT = L_PP + 64 * LS * 2, L_END = L_WT + 2048;
static_assert(L_END <= 131072, "gla prep LDS");
constexpr int C_ST = 0, C_PART = 128 * LS * 2, C_END = C_PART + 2 * 8 * 64 * 4;
constexpr size_t QPG_B = 64 * 64 * 2, OI_B = 8 * 4 * 64 * 16, UU_B = OI_B, DEC_B = 256;

__device__ __forceinline__ unsigned pkbf(float lo, float hi) { typedef float f2 __attribute__((ext_vector_type(2))); typedef __bf16 b2 __attribute__((ext_vector_type(2))); f2 v = {lo, hi}; b2 r = __builtin_convertvector(v, b2); return __builtin_bit_cast(unsigned, r); }
__device__ __forceinline__ float bf2f(unsigned short h) { return __builtin_bit_cast(float, (unsigned)h << 16); }
__device__ __forceinline__ float bflo(unsigned w) { return __builtin_bit_cast(float, w << 16); }
__device__ __forceinline__ float bfhi(unsigned w) { return __builtin_bit_cast(float, w & 0xffff0000u); }

__device__ __forceinline__ void prep_unit(int unit, const bf16* QKV, const float* FG, const float* __restrict__ wgu, const float* __restrict__ bgate,
                                          unsigned char* QPG, unsigned char* OI, unsigned char* UU, float* DEC, unsigned char* lds, int& cur_h) {
    int tid_ = threadIdx.x; asm volatile("" : "+v"(tid_));
    const int tid = tid_, lane = tid & 63, wid = __builtin_amdgcn_readfirstlane(tid >> 6), l15 = lane & 15, g = lane >> 4;
    const int n = unit % NCH, bh = unit / NCH, h = bh % GH, b = bh / GH;
    const size_t row0 = (size_t)b * S + (size_t)n * 64;
    float* WGU = (float*)(lds + L_WGU); float* BG = (float*)(lds + L_BG); float* WT = (float*)(lds + L_WT);
    bf16* QP = (bf16*)(lds + L_QP); bf16* KP = (bf16*)(lds + L_KP); bf16* KPT = (bf16*)(lds + L_KPT); bf16* VT = (bf16*)(lds + L_VT); bf16* PP = (bf16*)(lds + L_PP);
    if (cur_h != h) { __syncthreads(); for (int i = tid; i < 16 * 64; i += 512) WGU[i] = wgu[(i >> 6) * 256 + h * 64 + (i & 63)]; if (tid < 64) BG[tid] = bgate[h * 64 + tid]; cur_h = h; __syncthreads(); }
    const int t = tid >> 3, oc = tid & 7, d0 = oc * 8;
    float la[8];
    { const float* gp = FG + (row0 + t) * 32 + 8;
      f32x4 ga4[4];
#pragma unroll
      for (int i = 0; i < 4; ++i) ga4[i] = *(const f32x4*)(gp + 4 * i);
#pragma unroll
      for (int j = 0; j < 8; ++j) la[j] = BG[d0 + j];
#pragma unroll
      for (int r = 0; r < 16; ++r) { const float gv = ga4[r >> 2][r & 3]; const f32x4 w0 = *(const f32x4*)(WGU + r * 64 + d0), w1 = *(const f32x4*)(WGU + r * 64 + d0 + 4);
#pragma unroll
          for (int j = 0; j < 4; ++j) { la[j] += gv * w0[j]; la[4 + j] += gv * w1[j]; } }
#pragma unroll
      for (int j = 0; j < 8; ++j) la[j] = logsigmoidf(la[j]) * (1.f / 16.f); }
    const u32x4 qv = *(const u32x4*)(QKV + (row0 + t) * fx::QKVP + fx::P_GQ + h * 64 + d0);
    const u32x4 kv = *(const u32x4*)(QKV + (row0 + t) * fx::QKVP + fx::P_GK + h * 64 + d0);
    const u32x4 vv0 = *(const u32x4*)(QKV + (row0 + t) * fx::QKVP + fx::P_GV + h * 128 + oc * 16);
    const u32x4 vv1 = *(const u32x4*)(QKV + (row0 + t) * fx::QKVP + fx::P_GV + h * 128 + oc * 16 + 8);
#pragma unroll
    for (int off = 8; off < 64; off <<= 1) {
#pragma unroll
        for (int j = 0; j < 8; ++j) { const float o = __shfl_up(la[j], off); if (lane >= off) la[j] += o; } }
    if (lane >= 56) {
#pragma unroll
        for (int j = 0; j < 8; ++j) WT[wid * 64 + d0 + j] = la[j]; }
    __syncthreads();
    float bl[8];
#pragma unroll
    for (int j = 0; j < 8; ++j) bl[j] = 0.f;
#pragma unroll
    for (int w = 0; w < 8; ++w) {
        const f32x4 a0 = *(const f32x4*)(WT + w * 64 + d0), a1 = *(const f32x4*)(WT + w * 64 + d0 + 4);
#pragma unroll
        for (int j = 0; j < 4; ++j) { bl[j] += a0[j]; bl[4 + j] += a1[j]; if (w < wid) { la[j] += a0[j]; la[4 + j] += a1[j]; } } }
    {
        const unsigned qw[4] = {qv.x, qv.y, qv.z, qv.w}, kw[4] = {kv.x, kv.y, kv.z, kv.w};
        float qf[8], kf[8];
#pragma unroll
        for (int i = 0; i < 4; ++i) { qf[2 * i] = bflo(qw[i]); qf[2 * i + 1] = bfhi(qw[i]); kf[2 * i] = bflo(kw[i]); kf[2 * i + 1] = bfhi(kw[i]); }
        float qp[8], kp[8], kpp[8];
#pragma unroll
        for (int j = 0; j < 8; ++j) { const float bb = la[j] * 1.4426950408889634f, bbl = bl[j] * 1.4426950408889634f;
            qp[j] = qf[j] * (0.125f * exp2f(bb)); kp[j] = kf[j] * exp2f(-bb); kpp[j] = kf[j] * exp2f(bbl - bb); }
        u32x4 qo, ko; qo.x = pkbf(qp[0], qp[1]); qo.y = pkbf(qp[2], qp[3]); qo.z = pkbf(qp[4], qp[5]); qo.w = pkbf(qp[6], qp[7]);
        ko.x = pkbf(kp[0], kp[1]); ko.y = pkbf(kp[2], kp[3]); ko.z = pkbf(kp[4], kp[5]); ko.w = pkbf(kp[6], kp[7]);
        *(u32x4*)(QP + t * LS + d0) = qo; *(u32x4*)(KP + t * LS + d0) = ko;
        *(u32x4*)(QPG + (size_t)unit * QPG_B + (size_t)(t * 64 + d0) * 2) = qo;
#pragma unroll
        for (int j = 0; j < 8; ++j) KPT[(d0 + j) * LS + t] = (bf16)(pkbf(kpp[j], 0.f) & 0xffffu);
        const unsigned vw[8] = {vv0.x, vv0.y, vv0.z, vv0.w, vv1.x, vv1.y, vv1.z, vv1.w};
#pragma unroll
        for (int i = 0; i < 8; ++i) { VT[(oc * 16 + 2 * i) * LS + t] = (bf16)(vw[i] & 0xffffu); VT[(oc * 16 + 2 * i + 1) * LS + t] = (bf16)(vw[i] >> 16); }
        if (t == 0) {
#pragma unroll
            for (int j = 0; j < 8; ++j) DEC[(size_t)unit * 64 + d0 + j] = exp2f(bl[j] * 1.4426950408889634f); }
    }
    __syncthreads();
    { const int ti = wid >> 1;
#pragma unroll
      for (int q2 = 0; q2 < 2; ++q2) { const int sj = 2 * (wid & 1) + q2;
          f32x4 acc = {0.f, 0.f, 0.f, 0.f};
          if (sj <= ti) {
#pragma unroll
              for (int ks = 0; ks < 2; ++ks) { const bf16x8 a = *(const bf16x8*)(QP + (16 * ti + l15) * LS + 32 * ks + 8 * g), bb = *(const bf16x8*)(KP + (16 * sj + l15) * LS + 32 * ks + 8 * g);
                  acc = __builtin_amdgcn_mfma_f32_16x16x32_bf16(a, bb, acc, 0, 0, 0); }
              if (sj == ti) {
#pragma unroll
                  for (int r = 0; r < 4; ++r) if (l15 > 4 * g + r) acc[r] = 0.f; }
          }
#pragma unroll
          for (int r = 0; r < 4; ++r) PP[(16 * ti + 4 * g + r) * LS + 16 * sj + l15] = (bf16)(pkbf(acc[r], 0.f) & 0xffffu);
      } }
    __syncthreads();
    { bf16x8 vb[2];
#pragma unroll
      for (int ks = 0; ks < 2; ++ks) vb[ks] = *(const bf16x8*)(VT + (16 * wid + l15) * LS + 32 * ks + 8 * g);
#pragma unroll
      for (int m = 0; m < 4; ++m) { f32x4 acc = {0.f, 0.f, 0.f, 0.f};
#pragma unroll
          for (int ks = 0; ks < 2; ++ks) { const bf16x8 a = *(const bf16x8*)(PP + (16 * m + l15) * LS + 32 * ks + 8 * g); acc = __builtin_amdgcn_mfma_f32_16x16x32_bf16(a, vb[ks], acc, 0, 0, 0); }
          *(f32x4*)(OI + (size_t)unit * OI_B + (size_t)((wid * 4 + m) * 64 + lane) * 16) = acc; }
#pragma unroll
      for (int db = 0; db < 4; ++db) { f32x4 acc = {0.f, 0.f, 0.f, 0.f};
#pragma unroll
          for (int ks = 0; ks < 2; ++ks) { const bf16x8 a = *(const bf16x8*)(KPT + (16 * db + l15) * LS + 32 * ks + 8 * g); acc = __builtin_amdgcn_mfma_f32_16x16x32_bf16(a, vb[ks], acc, 0, 0, 0); }
          *(f32x4*)(UU + (size_t)unit * UU_B + (size_t)((wid * 4 + db) * 64 + lane) * 16) = acc; }
    }
}

__device__ __forceinline__ void chain(int bh, const bf16* QKV, const unsigned char* QPG, const unsigned char* OI, const unsigned char* UU, const float* DEC, const float* __restrict__ gnorm,
                                      bf16* Y, unsigned char* lds) {
    int tid_ = threadIdx.x; asm volatile("" : "+v"(tid_));
    const int tid = tid_, lane = tid & 63, wid = __builtin_amdgcn_readfirstlane(tid >> 6), l15 = lane & 15, g = lane >> 4;
    const int h = bh % GH, b = bh / GH;
    bf16* ST = (bf16*)(lds + C_ST); float* PART = (float*)(lds + C_PART);
    const int e = 16 * wid + l15;
    const float gn = gnorm[e];
    f32x4 Sa[4];
#pragma unroll
    for (int db = 0; db < 4; ++db) { Sa[db] = (f32x4){0.f, 0.f, 0.f, 0.f}; *(u32x2*)(ST + e * LS + 16 * db + 4 * g) = (u32x2){0u, 0u}; }
    __syncthreads();
    for (int n = 0; n < NCH; ++n) {
        const int unit = bh * NCH + n;
        const size_t row0 = (size_t)b * S + (size_t)n * 64;
        f32x4 o[4], Uf[4], dv[4]; bf16x8 qa[4][2]; unsigned short grv[4][4];
#pragma unroll
        for (int m = 0; m < 4; ++m) {
            o[m] = *(const f32x4*)(OI + (size_t)unit * OI_B + (size_t)((wid * 4 + m) * 64 + lane) * 16);
            Uf[m] = *(const f32x4*)(UU + (size_t)unit * UU_B + (size_t)((wid * 4 + m) * 64 + lane) * 16);
            dv[m] = *(const f32x4*)(DEC + (size_t)unit * 64 + 16 * m + 4 * g);
#pragma unroll
            for (int ks = 0; ks < 2; ++ks) qa[m][ks] = *(const bf16x8*)(QPG + (size_t)unit * QPG_B + (size_t)((16 * m + l15) * 64 + 32 * ks + 8 * g) * 2);
#pragma unroll
            for (int r = 0; r < 4; ++r) grv[m][r] = QKV[(row0 + 16 * m + 4 * g + r) * fx::QKVP + fx::P_GR + h * 128 + e];
        }
        bf16x8 sb[2];
#pragma unroll
        for (int ks = 0; ks < 2; ++ks) sb[ks] = *(const bf16x8*)(ST + e * LS + 32 * ks + 8 * g);
#pragma unroll
        for (int m = 0; m < 4; ++m)
#pragma unroll
            for (int ks = 0; ks < 2; ++ks) o[m] = __builtin_amdgcn_mfma_f32_16x16x32_bf16(qa[m][ks], sb[ks], o[m], 0, 0, 0);
#pragma unroll
        for (int m = 0; m < 4; ++m) { f32x4 q = o[m] * o[m];
#pragma unroll
            for (int off = 1; off < 16; off <<= 1) { q[0] += __shfl_xor(q[0], off); q[1] += __shfl_xor(q[1], off); q[2] += __shfl_xor(q[2], off); q[3] += __shfl_xor(q[3], off); }
            if (l15 == 0) *(f32x4*)(PART + ((n & 1) * 8 + wid) * 64 + 16 * m + 4 * g) = q; }
#pragma unroll
        for (int db = 0; db < 4; ++db) { Sa[db] = dv[db] * Sa[db] + Uf[db];
            *(u32x2*)(ST + e * LS + 16 * db + 4 * g) = (u32x2){pkbf(Sa[db][0], Sa[db][1]), pkbf(Sa[db][2], Sa[db][3])}; }
        __syncthreads();
#pragma unroll
        for (int m = 0; m < 4; ++m) { f32x4 tot = {0.f, 0.f, 0.f, 0.f};
#pragma unroll
            for (int w = 0; w < 8; ++w) tot += *(const f32x4*)(PART + ((n & 1) * 8 + w) * 64 + 16 * m + 4 * g);
#pragma unroll
            for (int r = 0; r < 4; ++r) { const float rs = rsqrtf(tot[r] * (1.f / GV) + LN_EPS); const float gr = bf2f(grv[m][r]);
                const float v = o[m][r] * rs * gn * (gr / (1.f + __expf(-gr)));
                Y[(row0 + 16 * m + 4 * g + r) * D + 512 + h * GV + e] = (bf16)(pkbf(v, 0.f) & 0xffffu); } }
    }
}
}
namespace mo {
using namespace nv;
typedef unsigned short bf16;
typedef float f32x4 __attribute__((ext_vector_type(4)));
typedef unsigned u32x4 __attribute__((ext_vector_type(4)));
constexpr int CAP = 8192;
constexpr int NEX = NE + 1;
constexpr int YSH = T * TOPK;
constexpr int L_TB = 132096, L_YB = L_TB + 1040;

__device__ __forceinline__ void moe_tables(const int* counts, int* tb, int* yb, int lane) {
    int c[4], nt[4]; int st = 0, sy = 0, pt[4], py[4];
#pragma unroll
    for (int i = 0; i < 4; ++i) { c[i] = counts[lane * 4 + i]; c[i] = c[i] > CAP ? CAP : c[i]; nt[i] = (c[i] + 255) >> 8; pt[i] = st; py[i] = sy; st += nt[i]; sy += c[i]; }
    int it = st, iy = sy;
    for (int o = 1; o < 64; o <<= 1) { const int a = __shfl_up(it, o), b = __shfl_up(iy, o); if (lane >= o) { it += a; iy += b; } }
    const int bt = it - st, by = iy - sy;
#pragma unroll
    for (int i = 0; i < 4; ++i) { tb[lane * 4 + i] = bt + pt[i]; yb[lane * 4 + i] = by + py[i]; }
    if (lane == 63) { tb[256] = it; tb[257] = it + T / 256; yb[256] = YSH; }
}

__device__ __forceinline__ void route_token(const float* LG, const float* __restrict__ rbias, int* counts, int* list_tok, float* list_gate, int* TK, int t, int lane) {
    const float4 l0 = ((const float4*)(LG + (size_t)t * NE))[lane], l1 = ((const float4*)(LG + (size_t)(T + t) * NE))[lane];
    const float4 rb = ((const float4*)rbias)[lane];
    float sc[4] = {1.f / (1.f + expf(-(l0.x + l1.x))), 1.f / (1.f + expf(-(l0.y + l1.y))), 1.f / (1.f + expf(-(l0.z + l1.z))), 1.f / (1.f + expf(-(l0.w + l1.w)))};
    float bv[4] = {sc[0] + rb.x, sc[1] + rb.y, sc[2] + rb.z, sc[3] + rb.w};
    float m1 = fmaxf(bv[0], bv[1]), m2 = fminf(bv[0], bv[1]);
    { const float a = fmaxf(bv[2], bv[3]), c = fminf(bv[2], bv[3]); const float n1 = fmaxf(m1, a); m2 = fmaxf(fminf(m1, a), fmaxf(m2, c)); m1 = n1; }
    for (int o = 1; o < 8; o <<= 1) { const float p1 = __shfl_xor(m1, o), p2 = __shfl_xor(m2, o); const float n1 = fmaxf(m1, p1); m2 = fmaxf(fminf(m1, p1), fmaxf(m2, p2)); m1 = n1; }
    const float gs = m1 + m2;
    const int myg = lane >> 3;
    int rank = 0;
#pragma unroll
    for (int g2 = 0; g2 < NG; ++g2) { const float og = __shfl(gs, g2 * 8); if (og > gs || (og == gs && g2 < myg)) ++rank; }
    const bool sel = rank < 4;
    float mv[4];
#pragma unroll
    for (int i = 0; i < 4; ++i) mv[i] = sel ? bv[i] : -INFINITY;
    int we[TOPK]; float ws[TOPK]; float wsum = 0.f;
#pragma unroll
    for (int k = 0; k < TOPK; ++k) {
        float bvv = mv[0]; int bi = 0;
#pragma unroll
        for (int i = 1; i < 4; ++i) if (mv[i] > bvv) { bvv = mv[i]; bi = i; }
        int gi = lane * 4 + bi;
        for (int o = 32; o > 0; o >>= 1) { const float ov = __shfl_xor(bvv, o); const int oi = __shfl_xor(gi, o); if (ov > bvv || (ov == bvv && oi < gi)) { bvv = ov; gi = oi; } }
        const int ol = gi >> 2, oi = gi & 3;
        const float s_own = (oi == 0) ? sc[0] : (oi == 1) ? sc[1] : (oi == 2) ? sc[2] : sc[3];
        const float sw = __shfl(s_own, ol);
        if (lane == ol) { if (oi == 0) mv[0] = -INFINITY; else if (oi == 1) mv[1] = -INFINITY; else if (oi == 2) mv[2] = -INFINITY; else mv[3] = -INFINITY; }
        we[k] = gi; ws[k] = sw; wsum += sw;
    }
    const float inv = 2.5f / wsum;
#pragma unroll
    for (int k = 0; k < TOPK; ++k) if (lane == k) {
        const int e = we[k]; const int pos = atomicAdd(&counts[e], 1);
        if (pos < CAP) { list_tok[e * CAP + pos] = t; list_gate[e * CAP + pos] = ws[k] * inv; }
        TK[t * TOPK + k] = e | (pos << 9);
    }
}

__device__ __forceinline__ void combine_token(const bf16* H1, const bf16* Y, const int* TK, const int* yb, const float* __restrict__ g, const float* __restrict__ b, float* out, int t, int lane) {
    float v[16];
    { const u32x4 a = *(const u32x4*)(H1 + (size_t)t * D + 16 * lane), c = *(const u32x4*)(H1 + (size_t)t * D + 16 * lane + 8);
      const unsigned w[8] = {a.x, a.y, a.z, a.w, c.x, c.y, c.z, c.w};
#pragma unroll
      for (int i = 0; i < 8; ++i) { v[2 * i] = ALPHA * __builtin_bit_cast(float, w[i] << 16); v[2 * i + 1] = ALPHA * __builtin_bit_cast(float, w[i] & 0xffff0000u); } }
    int tk = (lane < TOPK) ? TK[t * TOPK + lane] : 0;
#pragma unroll
    for (int k = 0; k <= TOPK; ++k) {
        size_t yrow;
        if (k < TOPK) { const int x = __shfl(tk, k); yrow = (size_t)(yb[x & 511] + (x >> 9)); } else yrow = (size_t)YSH + t;
        const u32x4 a = *(const u32x4*)(Y + yrow * D + 16 * lane), c = *(const u32x4*)(Y + yrow * D + 16 * lane + 8);
        const unsigned w[8] = {a.x, a.y, a.z, a.w, c.x, c.y, c.z, c.w};
#pragma unroll
        for (int i = 0; i < 8; ++i) { v[2 * i] += __builtin_bit_cast(float, w[i] << 16); v[2 * i + 1] += __builtin_bit_cast(float, w[i] & 0xffff0000u); }
    }
    float s = 0.f;
#pragma unroll
    for (int i = 0; i < 16; ++i) s += v[i];
    const float mean = fx::wave_sum(s) * (1.f / D); float q = 0.f;
#pragma unroll
    for (int i = 0; i < 16; ++i) { v[i] -= mean; q += v[i] * v[i]; }
    const float rstd = 1.f / sqrtf(fx::wave_sum(q) * (1.f / D) + LN_EPS);
#pragma unroll
    for (int i = 0; i < 4; ++i) { const f32x4 gg = *(const f32x4*)(g + 16 * lane + 4 * i), bb = *(const f32x4*)(b + 16 * lane + 4 * i);
        f32x4 o; o[0] = v[4 * i] * rstd * gg[0] + bb[0]; o[1] = v[4 * i + 1] * rstd * gg[1] + bb[1]; o[2] = v[4 * i + 2] * rstd * gg[2] + bb[2]; o[3] = v[4 * i + 3] * rstd * gg[3] + bb[3];
        *(f32x4*)(out + (size_t)t * D + 16 * lane + 4 * i) = o; }
}
}

namespace pg8 {
struct RouterSched {
    int G, vcu; const bf16_t* Bt;
    __device__ __forceinline__ bool next(int i, Unit2& u) const { const int L = i * G + vcu; if (L >= 2 * (nv::T / BM)) return false; u.pm = L >> 1; u.pn = L & 1; u.e = 0; u.cnt = 256; u.jt = 0; return true; }
    __device__ __forceinline__ int arow(const Unit2& u, int r) const { return u.pm * BM + r; }
    __device__ __forceinline__ size_t aoff(const Unit2& u) const { return (size_t)u.pn * 1024; }
    __device__ __forceinline__ const char* bptr(const Unit2& u) const { return (const char*)(Bt + u.pn * 512); }
};
struct EpiLogits {
    static constexpr bool PERM = false, AFTER_DRAIN = false;
    float* LG;
    __device__ __forceinline__ void operator()(const f32x4 (&acc)[2][2][4][2], const Unit2& u, int wr, int wc, int fr, int fq) const {
        const int row0 = u.pm * BM + wr * 64 + fr, col0 = wc * 32 + 4 * fq; float* base = LG + (size_t)u.pn * nv::T * nv::NE;
#pragma unroll
        for (int ai = 0; ai < 2; ++ai)
#pragma unroll
            for (int m = 0; m < 4; ++m) { float* rowp = base + (size_t)(row0 + ai * HALF + m * 16) * nv::NE + col0;
#pragma unroll
                for (int bj = 0; bj < 2; ++bj)
#pragma unroll
                    for (int n = 0; n < 2; ++n) *(f32x4*)(rowp + bj * HALF + n * 16) = acc[ai][bj][m][n]; }
    }
};
template <int PH> struct MoeSched {
    int G, vcu, nrt; const int* tb; const int* counts; const int* list_tok; const bf16_t* W;
    static constexpr int NC = PH == 0 ? 2 : 4;
    __device__ __forceinline__ bool next(int i, Unit2& u) const {
        const int L = i * G + vcu; if (L >= nrt * NC) return false;
        const int rt = L / NC, c = L % NC;
        int lo = 0, hi = 256;
        while (lo < hi) { const int mid = (lo + hi + 1) >> 1; if (tb[mid] <= rt) lo = mid; else hi = mid - 1; }
        const int e = lo, jt = rt - tb[e]; int total = nv::T; if (e < 256) { total = counts[e]; total = total > mo::CAP ? mo::CAP : total; }
        const int rem = total - 256 * jt;
        u.pm = rt; u.pn = c; u.e = __builtin_amdgcn_readfirstlane(e); u.jt = __builtin_amdgcn_readfirstlane(jt); u.cnt = __builtin_amdgcn_readfirstlane(rem < 256 ? rem : 256); return true;
    }
    __device__ __forceinline__ int arow(const Unit2& u, int r) const {
        if (PH == 1) return u.pm * BM + r;
        if (u.e == 256) return u.jt * BM + r;
        return (r < u.cnt) ? list_tok[u.e * mo::CAP + u.jt * BM + r] : 0;
    }
    __device__ __forceinline__ size_t aoff(const Unit2&) const { return 0; }
    __device__ __forceinline__ const char* bptr(const Unit2& u) const {
        return PH == 0 ? (const char*)(W + ((size_t)u.e * 512 + 256 * u.pn) * 1024) : (const char*)(W + ((size_t)u.e * 1024 + 256 * u.pn) * 256);
    }
};
struct EpiSwiGLU {
    static constexpr bool PERM = true, AFTER_DRAIN = false;
    bf16_t* H; const float* list_gate;
    __device__ __forceinline__ void operator()(const f32x4 (&acc)[2][2][4][2], const Unit2& u, int wr, int wc, int fr, int fq) const {
        const int col0 = u.pn * 128 + wc * 32 + 8 * fq;
#pragma unroll
        for (int ai = 0; ai < 2; ++ai)
#pragma unroll
            for (int m = 0; m < 4; ++m) { const int r = ai * HALF + wr * 64 + m * 16 + fr;
                float gt = 1.f; if (u.e < 256) gt = (r < u.cnt) ? list_gate[u.e * mo::CAP + u.jt * BM + r] : 0.f;
                float hv[8];
#pragma unroll
                for (int n = 0; n < 2; ++n)
#pragma unroll
                    for (int i = 0; i < 4; ++i) { const float gg = acc[ai][0][m][n][i], uu = acc[ai][1][m][n][i]; hv[4 * n + i] = gt * uu * (gg / (1.f + __expf(-gg))); }
                u32x4 w; w.x = cvt_pk_bf16(hv[0], hv[1]); w.y = cvt_pk_bf16(hv[2], hv[3]); w.z = cvt_pk_bf16(hv[4], hv[5]); w.w = cvt_pk_bf16(hv[6], hv[7]);
                *(u32x4*)(H + (size_t)(u.pm * BM + r) * 256 + col0) = w; }
    }
};
struct EpiDown {
    static constexpr bool PERM = true, AFTER_DRAIN = false;
    bf16_t* Y; const int* yb;
    __device__ __forceinline__ void operator()(const f32x4 (&acc)[2][2][4][2], const Unit2& u, int wr, int wc, int fr, int fq) const {
        const int col0 = u.pn * BM + wc * 32 + 8 * fq; const int ybase = yb[u.e] + u.jt * BM;
#pragma unroll
        for (int ai = 0; ai < 2; ++ai)
#pragma unroll
            for (int m = 0; m < 4; ++m) { const int r = ai * HALF + wr * 64 + m * 16 + fr;
                if (r < u.cnt) { bf16_t* rowp = Y + (size_t)(ybase + r) * nv::D + col0;
#pragma unroll
                    for (int bj = 0; bj < 2; ++bj) { const f32x4 v0 = acc[ai][bj][m][0], v1 = acc[ai][bj][m][1];
                        u32x4 w; w.x = cvt_pk_bf16(v0[0], v0[1]); w.y = cvt_pk_bf16(v0[2], v0[3]); w.z = cvt_pk_bf16(v1[0], v1[1]); w.w = cvt_pk_bf16(v1[2], v1[3]);
                        *(u32x4*)(rowp + bj * HALF) = w; } } }
    }
};
}
constexpr int NTHR = 512;
constexpr int LDS_BYTES = 147456;
constexpr int MISC_OFF = 131072 + 320;
constexpr size_t MiB = 1u << 20;
constexpr size_t CTL_ZERO_BYTES = 1 * MiB;
constexpr int CW_BAR = 4096;
constexpr int CW_MOE = 16384;
constexpr int NPHASE = 11;
constexpr size_t WS_H1 = 1, WS_WR = 65, WS_STATS = 66, WS_LF = 67, WS_FG = 68, WS_WO = 72, WS_WIN = 74, WS_TK = 81, WS_LTOK = 83, WS_LGATE = 91,
                 WS_WED = 100, WS_HID = 230, WS_GLA = 230, WS_WEG = 416, WS_XN = 673, WS_YBF = 673, WS_QKV = 737, WS_Z1 = 737, WS_LG = 865, WS_Y = 416, WS_END = 992;

struct Args { const float* in[21]; float* out; unsigned char* ws; int ph_lo, ph_hi; };

__global__ void __launch_bounds__(NTHR, 2) mega_fwd(Args a) {
    using namespace nv;
    extern __shared__ __attribute__((aligned(16))) unsigned char lds[];
    const int G = gridDim.x, bx = blockIdx.x;
    const int vcu = (G % 8 == 0) ? (bx % 8) * (G / 8) + bx / 8 : bx;
    int tid, lane, wave, vw;
#define DERIVE() do { int t_ = threadIdx.x; asm volatile("" : "+v"(t_)); tid = t_; lane = tid & 63; wave = __builtin_amdgcn_readfirstlane(tid >> 6); vw = vcu * 8 + wave; } while (0)
    DERIVE();
    volatile LAS unsigned* MISC = (volatile LAS unsigned*)((LAS unsigned char*)lds + MISC_OFF);
    for (int u = tid; u < (LDS_BYTES - 131072) / 4; u += NTHR) ((LAS unsigned*)((LAS unsigned char*)lds + 131072))[u] = 0u;
    __syncthreads();
    unsigned char* ws = a.ws;
    unsigned* ctl = (unsigned*)ws;
    XcdBarrier bar = xcd_barrier_post(ctl + CW_BAR, MISC + 8);
    const float* x = a.in[0];
    const float* ln_in_g = a.in[1]; const float* ln_in_b = a.in[2];
    const float* w_in = a.in[3]; const float* b_fgate = a.in[4];
    const float* w_gate_up = a.in[5]; const float* b_gate = a.in[6]; const float* g_gla = a.in[7];
    const float* w_out = a.in[8]; const float* ln1_g = a.in[9]; const float* ln1_b = a.in[10];
    const float* w_router = a.in[11]; const float* rbias = a.in[12];
    const float* w_eg = a.in[13]; const float* w_eu = a.in[14]; const float* w_ed = a.in[15];
    const float* w_sg = a.in[16]; const float* w_su = a.in[17]; const float* w_sd = a.in[18];
    const float* ln2_g = a.in[19]; const float* ln2_b = a.in[20];
    float* out = a.out;
    int* counts = (int*)(ctl + CW_MOE);
    fx::bf16* H1 = (fx::bf16*)(ws + WS_H1 * MiB);
    fx::bf16* WrT = (fx::bf16*)(ws + WS_WR * MiB);
    float* stats = (float*)(ws + WS_STATS * MiB);
    float* LF = (float*)(ws + WS_LF * MiB);
    float* FG = (float*)(ws + WS_FG * MiB);
    fx::bf16* WoT = (fx::bf16*)(ws + WS_WO * MiB);
    fx::bf16* WinT = (fx::bf16*)(ws + WS_WIN * MiB);
    int* TK = (int*)(ws + WS_TK * MiB);
    int* list_tok = (int*)(ws + WS_LTOK * MiB);
    float* list_gate = (float*)(ws + WS_LGATE * MiB);
    fx::bf16* WedT = (fx::bf16*)(ws + WS_WED * MiB);
    fx::bf16* HID = (fx::bf16*)(ws + WS_HID * MiB);
    unsigned char* QPG = ws + WS_GLA * MiB; unsigned char* OIb = ws + (WS_GLA + 16) * MiB; unsigned char* UUb = ws + (WS_GLA + 80) * MiB; float* DECb = (float*)(ws + (WS_GLA + 144) * MiB);
    fx::bf16* WegT = (fx::bf16*)(ws + WS_WEG * MiB);
    fx::bf16* XN = (fx::bf16*)(ws + WS_XN * MiB);
    fx::bf16* Ybf = (fx::bf16*)(ws + WS_YBF * MiB);
    fx::bf16* QKV = (fx::bf16*)(ws + WS_QKV * MiB);
    float* z1 = (float*)(ws + WS_Z1 * MiB);
    float* LG = (float*)(ws + WS_LG * MiB);
    fx::bf16* YA = (fx::bf16*)(ws + WS_Y * MiB);
    int* tb = (int*)(lds + mo::L_TB); int* yb = (int*)(lds + mo::L_YB);

    const int lo = a.ph_lo, hi = a.ph_hi;
#define IN(k) (lo <= (k) && (k) < hi)
#define SEAM(k) do { if (IN(k) && IN((k) + 1)) xcd_barrier(bar); DERIVE(); } while (0)
    const int GW = G * 8;

    if (IN(0)) {
        LAS float* scr = (LAS float*)((LAS unsigned char*)lds + wave * 16384);
        constexpr int I_IN = 16 * (fx::NIN / 32), I_OUT = 16 * 32, I_R = 16 * 8, I_EG = mo::NEX * 256, I_ED = mo::NEX * 128, I_ALL = I_IN + I_OUT + I_R + I_EG + I_ED;
        for (int it = vw; it < I_ALL; it += GW) {
            int r = it;
            if (r < I_IN) { fx::transpose_item(w_in, D, INW, WinT, scr, r / (fx::NIN / 32), r % (fx::NIN / 32), lane, [](int d) { return fx::inproj_src(d); }); continue; } r -= I_IN;
            if (r < I_OUT) { fx::transpose_item(w_out, D, D, WoT, scr, r / 32, r % 32, lane, [](int d) { return d; }); continue; } r -= I_OUT;
            if (r < I_R) { fx::transpose_item(w_router, D, NE, WrT, scr, r / 8, r % 8, lane, [](int d) { return d; }); continue; } r -= I_R;
            if (r < I_EG) { const int e = r >> 8, kb = (r >> 4) & 15, nb = r & 15, c = nb >> 3, sub = nb & 7;
                const float* W = (e < NE) ? ((sub < 4 ? w_eg : w_eu) + (size_t)e * D * ED) : (sub < 4 ? w_sg : w_su);
                const int cb = 128 * c + 32 * (sub & 3);
                fx::transpose_item(W, D, ED, WegT + (size_t)e * 512 * D, scr, kb, nb, lane, [cb](int d) { return cb + (d & 31); }); continue; } r -= I_EG;
            { const int e = r >> 7, kb = (r >> 5) & 3, nb = r & 31;
              const float* W = (e < NE) ? (w_ed + (size_t)e * ED * D) : w_sd;
              fx::transpose_item(W, ED, D, WedT + (size_t)e * D * ED, scr, kb, nb, lane, [](int d) { return d; }); }
        }
        for (int r = vw; r < T; r += GW) fx::ln_row_bf16(x + (size_t)r * D, ln_in_g, ln_in_b, XN + (size_t)r * D, nullptr, stats + 2 * (size_t)r, lane);
    }
    SEAM(0);
    if (IN(1)) {
        pg8::Gemm g{XN, WinT, T, fx::NIN, D, D}; pg8::StaticOrder S; S.init(T, fx::NIN, G, bx);
        pg8::EpiInProj E{QKV, FG, LF, b_fgate};
        pg8::gemm_phase<pg8::EpiInProj, pg8::StaticOrder, true, true>((LAS unsigned char*)lds, g, S, E);
    }
    SEAM(1);
    if (IN(2)) {
        int cur_h = -1;
        if (gl::NUNIT % G == 0) { const int per = gl::NUNIT / G; for (int i = 0; i < per; ++i) gl::prep_unit(vcu * per + i, QKV, FG, w_gate_up, b_gate, QPG, OIb, UUb, DECb, lds, cur_h); }
        else for (int u = vcu; u < gl::NUNIT; u += G) gl::prep_unit(u, QKV, FG, w_gate_up, b_gate, QPG, OIb, UUb, DECb, lds, cur_h);
    }
    SEAM(2);
    if (IN(3)) {
        if (bx < B * GH) { gl::chain(bx, QKV, QPG, OIb, UUb, DECb, g_gla, Ybf, lds); }
        __syncthreads();
        { const attn_body::AttnTensors AT{(const attn_body::bf16*)(QKV + fx::P_FQ), (const attn_body::bf16*)(QKV + fx::P_FK), (const attn_body::bf16*)(QKV + fx::P_FV), (attn_body::bf16*)Ybf, LF};
          const attn_body::StaticOrder SO(G, bx);
          attn_body::attn_phase<attn_body::StaticOrder>((char*)lds, AT, SO); }
    }
    SEAM(3);
    if (IN(4)) {
        pg8::DenseSched DS; DS.so.init(T, D, G, bx); DS.Bt = WoT; DS.ldb = D;
        pg8::EpiResid E{z1, D, x, stats, ln_in_g, ln_in_b, ALPHA};
        pg8::gemm_phase2<pg8::EpiResid, pg8::DenseSched>((LAS unsigned char*)lds, Ybf, D, D, D, DS, E);
    }
    SEAM(4);
    if (IN(5)) {
        for (int r = vw; r < T; r += GW) fx::ln_row_bf16(z1 + (size_t)r * D, ln1_g, ln1_b, H1 + (size_t)r * D, nullptr, nullptr, lane);
    }
    SEAM(5);
    if (IN(6)) {
        pg8::RouterSched RS{G, vcu, WrT}; pg8::EpiLogits E{LG};
        pg8::gemm_phase2<pg8::EpiLogits, pg8::RouterSched>((LAS unsigned char*)lds, H1, D, D, 512, RS, E);
    }
    SEAM(6);
    if (IN(7)) {
        for (int t = vw; t < T; t += GW) mo::route_token(LG, rbias, counts, list_tok, list_gate, TK, t, lane);
    }
    SEAM(7);
    if (IN(8)) {
        if (wave == 0) mo::moe_tables(counts, tb, yb, lane);
        __syncthreads();
        pg8::MoeSched<0> MS{G, vcu, tb[257], tb, counts, list_tok, WegT}; pg8::EpiSwiGLU E{HID, list_gate};
        pg8::gemm_phase2<pg8::EpiSwiGLU, pg8::MoeSched<0>>((LAS unsigned char*)lds, H1, D, D, D, MS, E);
    }
    SEAM(8);
    if (IN(9)) {
        if (wave == 0) mo::moe_tables(counts, tb, yb, lane);
        __syncthreads();
        pg8::MoeSched<1> MS{G, vcu, tb[257], tb, counts, list_tok, WedT}; pg8::EpiDown E{YA, yb};
        pg8::gemm_phase2<pg8::EpiDown, pg8::MoeSched<1>>((LAS unsigned char*)lds, HID, ED, ED, ED, MS, E);
    }
    SEAM(9);
    if (IN(10)) {
        if (wave == 0) mo::moe_tables(counts, tb, yb, lane);
        __syncthreads();
        for (int t = vw; t < T; t += GW) mo::combine_token(H1, YA, TK, yb, ln2_g, ln2_b, out, t, lane);
    }
#undef IN
#undef SEAM
}

extern "C" void kernel_launch(void* const* d_in, const int* in_sizes, int n_in, void* d_out, int out_size, void* d_ws, size_t ws_size, hipStream_t stream) {
    static int grid = 0;
    if (grid == 0) {
        if (n_in != 21 || out_size != nv::T * nv::D || ws_size < WS_END * MiB) { fprintf(stderr, "kernel_launch: unexpected shapes n_in=%d out=%d ws=%zu\n", n_in, out_size, ws_size); grid = -1; return; }
        int dev = 0, cus = 0;
        if (hipGetDevice(&dev) != hipSuccess || hipDeviceGetAttribute(&cus, hipDeviceAttributeMultiprocessorCount, dev) != hipSuccess) { grid = -1; return; }
        if (hipFuncSetAttribute((const void*)mega_fwd, hipFuncAttributeMaxDynamicSharedMemorySize, LDS_BYTES) != hipSuccess) { fprintf(stderr, "kernel_launch: hipFuncSetAttribute failed\n"); grid = -1; return; }
        grid = cus;
    }
    if (grid < 0) return;
    if (hipMemsetAsync(d_ws, 0, CTL_ZERO_BYTES, stream) != hipSuccess) return;
    Args a{};
    for (int i = 0; i < 21; ++i) a.in[i] = (const float*)d_in[i];
    a.out = (float*)d_out; a.ws = (unsigned char*)d_ws; a.ph_lo = 0; a.ph_hi = NPHASE;
    hipLaunchKernelGGL(mega_fwd, dim3(grid), dim3(NTHR), LDS_BYTES, stream, a);
}
```

```cpp
#include <hip/hip_runtime.h>
#include <cstdio>
#include <cstdint>
#include <cmath>

#define LAS __attribute__((address_space(3)))
#define GAS __attribute__((address_space(1)))

#define XB_TMO      128
#define XB_XCNT(j)  (256  + 64 * (j))
#define XB_XSUB(j)  (1280 + 64 * (j))
#define XB_XGEN(j)  (2304 + 64 * (j))
#define XB_TOP      3328
#define XB_TOPGEN   3392
#define XCD_BAR_WORDS 3456
#define XB_SPIN_CAP (1u << 27)
__device__ __forceinline__ unsigned xb_ld(unsigned* p)              { return __hip_atomic_load(p, __ATOMIC_RELAXED, __HIP_MEMORY_SCOPE_AGENT); }
__device__ __forceinline__ unsigned xb_add(unsigned* p, unsigned v) { return __hip_atomic_fetch_add(p, v, __ATOMIC_RELAXED, __HIP_MEMORY_SCOPE_AGENT); }
__device__ __forceinline__ unsigned xb_xcc_id() { return (unsigned)__builtin_amdgcn_s_getreg((3 << 11) | 20) & 0xFu; }
#define XB_SPIN(cond, bar) do { unsigned _sp = 0; while (cond) { __builtin_amdgcn_s_sleep(1); \
    if ((++_sp & 255u) == 0u) { if (xb_ld(&(bar)[XB_TMO])) break; if (_sp > XB_SPIN_CAP) { atomicAdd(&(bar)[XB_TMO], 1u); break; } } } } while (0)
struct XcdBarrier { unsigned* bar; unsigned x; volatile LAS unsigned* st; };
__device__ __forceinline__ XcdBarrier xcd_barrier_post(unsigned* bar, volatile LAS unsigned* st) {
    XcdBarrier b; b.bar = bar; b.x = xb_xcc_id(); b.st = st;
    if (threadIdx.x == 0) (void)xb_add(&bar[XB_XCNT(b.x)], 1u);
    return b;
}
__device__ __forceinline__ void xcd_barrier_complete(unsigned* bar, unsigned x, unsigned& nloc, unsigned& nx) {
    const unsigned G = gridDim.x * gridDim.y * gridDim.z;
    unsigned sum, cnt, mine, sp = 0u;
    for (;;) {
        sum = 0u; cnt = 0u; mine = 0u;
#pragma unroll
        for (unsigned j = 0; j < 16; ++j) { const unsigned c = xb_ld(&bar[XB_XCNT(j)]); sum += c; cnt += (c > 0u) ? 1u : 0u; mine = (j == x) ? c : mine; }
        if (sum == G) break;
        __builtin_amdgcn_s_sleep(1);
        if ((++sp & 255u) == 0u) { if (xb_ld(&bar[XB_TMO])) break; if (sp > XB_SPIN_CAP) { atomicAdd(&bar[XB_TMO], 1u); break; } }
    }
    nloc = mine > 0u ? mine : 1u; nx = cnt > 0u ? cnt : 1u;
}
__device__ __forceinline__ void xcd_barrier(const XcdBarrier& b) {
    asm volatile("s_waitcnt vmcnt(0)" ::: "memory");
    __syncthreads();
    if (threadIdx.x == 0) {
        unsigned* bar = b.bar;
        __builtin_amdgcn_s_waitcnt(0);
        unsigned nloc = b.st[0], nx = b.st[1];
        if (nloc == 0u) { xcd_barrier_complete(bar, b.x, nloc, nx); b.st[0] = nloc; b.st[1] = nx; }
        const unsigned old = xb_add(&bar[XB_XSUB(b.x)], 1u);
        const unsigned gen = old / nloc;
        if (old + 1u == (gen + 1u) * nloc) {
            __builtin_amdgcn_fence(__ATOMIC_RELEASE, "agent");
            asm volatile("s_waitcnt vmcnt(0)" ::: "memory");
            const unsigned og = xb_add(&bar[XB_TOP], 1u);
            const unsigned tg = og / nx;
            if (og + 1u == (tg + 1u) * nx) xb_add(&bar[XB_TOPGEN], 1u);
            else XB_SPIN(xb_ld(&bar[XB_TOPGEN]) == tg, bar);
            __builtin_amdgcn_fence(__ATOMIC_ACQUIRE, "agent");
            xb_add(&bar[XB_XGEN(b.x)], 1u);
            asm volatile("s_waitcnt vmcnt(0)" ::: "memory");
        } else {
            XB_SPIN(xb_ld(&bar[XB_XGEN(b.x)]) == gen, bar);
            __builtin_amdgcn_fence(__ATOMIC_ACQUIRE, "agent");
            asm volatile("s_waitcnt vmcnt(0)" ::: "memory");
        }
    }
    __syncthreads();
}
namespace pg8 {
#define PG8_LAS __attribute__((address_space(3)))
typedef unsigned short bf16_t;
typedef short bf16x8 __attribute__((ext_vector_type(8)));
typedef float f32x4 __attribute__((ext_vector_type(4)));
typedef unsigned u32x4 __attribute__((ext_vector_type(4)));
constexpr int BM = 256, BK = 64, HALF = 128, HTB = HALF * BK * 2  , STAGE_BYTES = 8 * HTB, NXCD = 8, WGM = 8;

__host__ __device__ __forceinline__ int lds_byte(int r, int c) { const int st = (r >> 4) * 2 + (c >> 5), rr = r & 15, cc = c & 31, ob = rr * 64 + cc * 2; return st * 1024 + (ob ^ (((ob >> 9) & 1) << 5)); }
__host__ __device__ __forceinline__ void stage_rc(int b, int& R, int& C) { const int st = b / 1024, sb = b % 1024, swz = sb ^ (((sb >> 9) & 1) << 5); R = (st >> 1) * 16 + swz / 64; C = (st & 1) * 32 + (swz % 64) / 2; }
__host__ __device__ __forceinline__ int perm32(int rho) { const int n = rho >> 4, i = rho & 15; return 8 * (i >> 2) + 4 * n + (i & 3); }

struct Unit { int pm, pn; };
struct Gemm { const bf16_t* A; const bf16_t* Bt; int M, N, K, lda; };

struct StaticOrder {
    int nM, nN, nwg, G, c;
    __host__ __device__ void init(int M, int N, int G_, int c_) { nM = M / BM; nN = N / BM; nwg = nM * nN; G = G_; c = c_; }
    __host__ __device__ bool next(int i, Unit& u) const {
        const long L = (long)i * G + c; if (L >= nwg) return false;
        int wgid = (int)L; { const int q = nwg / NXCD, r = nwg % NXCD, xcd = wgid % NXCD, off = wgid / NXCD; wgid = (xcd < r ? xcd * (q + 1) : r * (q + 1) + (xcd - r) * q) + off; }
        const int nig = WGM * nN, gid = wgid / nig, fm = gid * WGM, gsz = (nM - fm) < WGM ? (nM - fm) : WGM;
        u.pm = fm + ((wgid % nig) % gsz); u.pn = (wgid % nig) / gsz; return true;
    }
    __device__ __forceinline__ void a_ready(const Unit&) const {}
    __device__ __forceinline__ void done(const Unit&) const {}
};

__device__ __forceinline__ unsigned cvt_pk_bf16(float lo, float hi) { unsigned r; asm volatile("v_cvt_pk_bf16_f32 %0, %1, %2" : "=v"(r) : "v"(lo), "v"(hi)); return r; }
typedef float f32x2 __attribute__((ext_vector_type(2)));
__device__ __forceinline__ f32x2 gelu_pk(f32x2 v) {
    const f32x2 av = __builtin_elementwise_abs(v), d = av * 0.2316418882f + 1.0f;
    f32x2 t; t.x = __builtin_amdgcn_rcpf(d.x); t.y = __builtin_amdgcn_rcpf(d.y);
    f32x2 q = t * 0.5307027145f + (-0.7265760135f); q = q * t + 0.7107068705f; q = q * t + (-0.142248368f); q = q * t + 0.127414796f; q = q * t;
    const f32x2 s = (v * v) * (-0.72134752044f);
    f32x2 e; e.x = __builtin_amdgcn_exp2f(s.x); e.y = __builtin_amdgcn_exp2f(s.y);
    const f32x2 m = v * (q * e), r = v - m;
    f32x2 o; o.x = v.x < 0.f ? m.x : r.x; o.y = v.y < 0.f ? m.y : r.y; return o;
}

template <int ACT  > struct EpiBf16 {
    static constexpr bool PERM = true, AFTER_DRAIN = false; static_assert(ACT == 0 || ACT == 1, "EpiBf16: ACT is 0 (none) or 1 (gelu_pk)");
    bf16_t* O; int ldc; const float* bias; int split_cols; size_t split_stride; float scale0;
    __device__ __forceinline__ void operator()(const f32x4 (&acc)[2][2][4][2], const Unit& u, int wr, int wc, int fr, int fq) const {
        const int row0 = u.pm * BM + wr * 64 + fr; int colt = u.pn * BM; bf16_t* base = O;
        float sc = 1.f; if (split_cols) { const int t = colt / split_cols; base += (size_t)t * split_stride; colt -= t * split_cols; if (t == 0) sc = scale0; }
        const int col0 = colt + wc * 32 + 8 * fq, bcol0 = u.pn * BM + wc * 32 + 8 * fq;
        f32x4 bv[2][2];
#pragma unroll
        for (int bj = 0; bj < 2; ++bj)
#pragma unroll
            for (int n = 0; n < 2; ++n) bv[bj][n] = bias ? *(const f32x4*)(bias + bcol0 + bj * HALF + 4 * n) : (f32x4){0.f, 0.f, 0.f, 0.f};
#pragma unroll
        for (int ai = 0; ai < 2; ++ai)
#pragma unroll
            for (int m = 0; m < 4; ++m) { bf16_t* rowp = base + (size_t)(row0 + ai * HALF + m * 16) * ldc + col0;
#pragma unroll
                for (int bj = 0; bj < 2; ++bj) { f32x4 v0 = acc[ai][bj][m][0] + bv[bj][0], v1 = acc[ai][bj][m][1] + bv[bj][1];
                    if (ACT == 1) { f32x2 a = gelu_pk((f32x2){v0[0], v0[1]}), b = gelu_pk((f32x2){v0[2], v0[3]}), c = gelu_pk((f32x2){v1[0], v1[1]}), d = gelu_pk((f32x2){v1[2], v1[3]});
                        v0 = (f32x4){a.x, a.y, b.x, b.y}; v1 = (f32x4){c.x, c.y, d.x, d.y}; }
                    v0 = v0 * sc; v1 = v1 * sc; u32x4 w; w.x = cvt_pk_bf16(v0[0], v0[1]); w.y = cvt_pk_bf16(v0[2], v0[3]); w.z = cvt_pk_bf16(v1[0], v1[1]); w.w = cvt_pk_bf16(v1[2], v1[3]);
                    *(u32x4*)(rowp + bj * HALF) = w; } }
    }
};

template <class Epi, class Sched, bool ALIGN_EPI = false, bool SP2 = false>
__device__ __forceinline__ void gemm_phase(PG8_LAS unsigned char* lds, const Gemm g, const Sched& S, const Epi& E) {
    const int tid = threadIdx.x, wid = __builtin_amdgcn_readfirstlane(tid >> 6), lane = tid & 63, wr = wid >> 2, wc = wid & 3, fr = lane & 15, fq = lane >> 4;
    const int K = g.K, nt = K / BK;
    unsigned voffA[2], voffB[2];
#pragma unroll
    for (int i = 0; i < 2; ++i) { int R, C; stage_rc(tid * 16 + i * 8192, R, C); const int Rb = Epi::PERM ? ((R & ~31) + perm32(R & 31)) : R;
        voffA[i] = (unsigned)(R * g.lda + C) * 2u; voffB[i] = (unsigned)(Rb * K + C) * 2u; }
    const size_t kstep = (size_t)(BK * 2);
    const size_t hstepA = (size_t)HALF * g.lda * 2, hstepB = (size_t)HALF * K * 2;
    const size_t tstepA = 2 * hstepA, tstepB = 2 * hstepB;
    const unsigned ldsw = (unsigned)wid * 1024u;
    const int aoff = lds_byte(wr * 64 + fr, fq * 8), boff = lds_byte(wc * 32 + fr, fq * 8);
#define PG8_SA(b, h) (((b) * 2 + (h)) * HTB)
#define PG8_SB(b, h) ((4 + (b) * 2 + (h)) * HTB)
#define PG8_STAGE(bufoff, gbase, voff) do { _Pragma("unroll") for (int _i = 0; _i < 2; ++_i) \
        __builtin_amdgcn_global_load_lds((const unsigned*)((const char*)(gbase) + (voff)[_i]), (PG8_LAS unsigned*)(lds + (bufoff) + ldsw + _i * 8192), 16, 0, 0); } while (0)
#define PG8_LDA(dst, b, h) do { _Pragma("unroll") for (int m = 0; m < 4; ++m) _Pragma("unroll") for (int k = 0; k < 2; ++k) dst[m][k] = *(const PG8_LAS bf16x8*)(lds + PG8_SA(b, h) + aoff + m * 2048 + k * 1024); } while (0)
#define PG8_LDB(dst, b, h) do { _Pragma("unroll") for (int n = 0; n < 2; ++n) _Pragma("unroll") for (int k = 0; k < 2; ++k) dst[n][k] = *(const PG8_LAS bf16x8*)(lds + PG8_SB(b, h) + boff + n * 2048 + k * 1024); } while (0)
#define PG8_MMA(ai, bj, At, Bt) do { __builtin_amdgcn_s_setprio(1); _Pragma("unroll") for (int m = 0; m < 4; ++m) _Pragma("unroll") for (int n = 0; n < 2; ++n) _Pragma("unroll") for (int k = 0; k < 2; ++k) \
        acc[ai][bj][m][n] = __builtin_amdgcn_mfma_f32_16x16x32_bf16(Bt[n][k], At[m][k], acc[ai][bj][m][n], 0, 0, 0); __builtin_amdgcn_s_setprio(0); } while (0)
#define PG8_WAIT_V(n) asm volatile("s_waitcnt vmcnt(" #n ")" ::: "memory")
#define PG8_WAIT_L(n) asm volatile("s_waitcnt lgkmcnt(" #n ")" ::: "memory")
#define PG8_BAR __builtin_amdgcn_s_barrier()
#define PG8_SCHED __builtin_amdgcn_sched_barrier(0)
    Unit cur, nxt; int ui = 0;
    if (!S.next(0, cur)) return;
    f32x4 acc[2][2][4][2];
#pragma unroll
    for (int a = 0; a < 2; ++a)
#pragma unroll
        for (int b = 0; b < 2; ++b)
#pragma unroll
            for (int m = 0; m < 4; ++m)
#pragma unroll
                for (int n = 0; n < 2; ++n) acc[a][b][m][n] = (f32x4){0.f, 0.f, 0.f, 0.f};
    bf16x8 At[4][2], B0[2][2], B1[2][2];
    const char* cA = (const char*)g.A + (size_t)cur.pm * tstepA; const char* cB = (const char*)g.Bt + (size_t)cur.pn * tstepB;
    S.a_ready(cur);
    if constexpr (SP2) {
        PG8_STAGE(PG8_SB(0, 0), cB, voffB); PG8_STAGE(PG8_SB(0, 1), cB + hstepB, voffB); PG8_STAGE(PG8_SA(0, 0), cA, voffA); PG8_STAGE(PG8_SA(0, 1), cA + hstepA, voffA);
        if (wr == 1) PG8_BAR;
        PG8_WAIT_V(2); PG8_BAR;
        PG8_STAGE(PG8_SB(1, 0), cB + kstep, voffB); PG8_STAGE(PG8_SA(1, 0), cA + kstep, voffA); PG8_STAGE(PG8_SB(1, 1), cB + hstepB + kstep, voffB);
        PG8_WAIT_V(6); PG8_BAR;
    } else {
        PG8_STAGE(PG8_SB(0, 0), cB, voffB); PG8_STAGE(PG8_SA(0, 0), cA, voffA); PG8_STAGE(PG8_SB(0, 1), cB + hstepB, voffB); PG8_STAGE(PG8_SA(0, 1), cA + hstepA, voffA);
        if (wr == 1) PG8_BAR;
        PG8_WAIT_V(4); PG8_BAR;
        PG8_STAGE(PG8_SB(1, 0), cB + kstep, voffB); PG8_STAGE(PG8_SA(1, 0), cA + kstep, voffA); PG8_STAGE(PG8_SB(1, 1), cB + hstepB + kstep, voffB);
        PG8_WAIT_V(6); PG8_BAR;
    }
    for (;;) {
        const bool has_next = S.next(ui + 1, nxt);
        const char* nA = has_next ? (const char*)g.A + (size_t)nxt.pm * tstepA : cA; const char* nB = has_next ? (const char*)g.Bt + (size_t)nxt.pn * tstepB : cB;
        for (int t = 0; t < nt; t += 2) {
            const bool last = (t == nt - 2);
            const char* a1 = cA + (size_t)(t + 1) * kstep;
            const char* a2 = last ? nA : cA + (size_t)(t + 2) * kstep; const char* b2 = last ? nB : cB + (size_t)(t + 2) * kstep;
            const char* a3 = a2 + kstep; const char* b3 = b2 + kstep;
            if (last && has_next) S.a_ready(nxt);
            if constexpr (SP2) {
            PG8_LDB(B0, 0, 0); PG8_LDB(B1, 0, 1); PG8_SCHED; PG8_LDA(At, 0, 0); PG8_STAGE(PG8_SA(1, 1), a1 + hstepA, voffA);
            PG8_WAIT_V(8); PG8_WAIT_L(0); PG8_BAR; PG8_MMA(0, 0, At, B0); PG8_MMA(0, 1, At, B1); PG8_BAR; PG8_SCHED;
            PG8_LDA(At, 0, 1); PG8_STAGE(PG8_SB(0, 0), b2, voffB); PG8_STAGE(PG8_SB(0, 1), b2 + hstepB, voffB); PG8_STAGE(PG8_SA(0, 0), a2, voffA);
            PG8_WAIT_V(8); PG8_WAIT_L(0); PG8_BAR; PG8_MMA(1, 0, At, B0); PG8_MMA(1, 1, At, B1); PG8_BAR; PG8_SCHED;
            PG8_LDB(B0, 1, 0); PG8_LDB(B1, 1, 1); PG8_SCHED; PG8_LDA(At, 1, 0); PG8_STAGE(PG8_SA(0, 1), a2 + hstepA, voffA);
            PG8_WAIT_V(8); PG8_WAIT_L(0); PG8_BAR; PG8_MMA(0, 0, At, B0); PG8_MMA(0, 1, At, B1); PG8_BAR; PG8_SCHED;
            PG8_LDA(At, 1, 1); PG8_STAGE(PG8_SB(1, 0), b3, voffB); PG8_STAGE(PG8_SB(1, 1), b3 + hstepB, voffB); PG8_STAGE(PG8_SA(1, 0), a3, voffA);
            PG8_WAIT_V(8); PG8_WAIT_L(0); PG8_BAR; PG8_MMA(1, 0, At, B0); PG8_MMA(1, 1, At, B1); PG8_BAR; PG8_SCHED;
            } else {
            PG8_LDB(B0, 0, 0); PG8_SCHED; PG8_LDA(At, 0, 0); PG8_STAGE(PG8_SA(1, 1), a1 + hstepA, voffA);
            PG8_WAIT_L(8); PG8_BAR; PG8_WAIT_L(0); PG8_MMA(0, 0, At, B0); PG8_BAR; PG8_SCHED;
            PG8_LDB(B1, 0, 1); PG8_STAGE(PG8_SB(0, 0), b2, voffB);
            PG8_BAR; PG8_WAIT_L(0); PG8_MMA(0, 1, At, B1); PG8_BAR;
            PG8_LDA(At, 0, 1); PG8_STAGE(PG8_SA(0, 0), a2, voffA);
            PG8_BAR; PG8_WAIT_L(0); PG8_MMA(1, 0, At, B0); PG8_BAR; PG8_SCHED;
            PG8_STAGE(PG8_SB(0, 1), b2 + hstepB, voffB);
            PG8_WAIT_V(6); PG8_BAR; PG8_MMA(1, 1, At, B1); PG8_BAR;
            PG8_LDB(B0, 1, 0); PG8_SCHED; PG8_LDA(At, 1, 0); PG8_STAGE(PG8_SA(0, 1), a2 + hstepA, voffA);
            PG8_WAIT_L(8); PG8_BAR; PG8_WAIT_L(0); PG8_MMA(0, 0, At, B0); PG8_BAR; PG8_SCHED;
            PG8_LDB(B1, 1, 1); PG8_STAGE(PG8_SB(1, 0), b3, voffB);
            PG8_BAR; PG8_WAIT_L(0); PG8_MMA(0, 1, At, B1); PG8_BAR;
            PG8_LDA(At, 1, 1); PG8_STAGE(PG8_SA(1, 0), a3, voffA);
            PG8_BAR; PG8_WAIT_L(0); PG8_MMA(1, 0, At, B0); PG8_BAR; PG8_SCHED;
            PG8_STAGE(PG8_SB(1, 1), b3 + hstepB, voffB);
            PG8_WAIT_V(6); PG8_BAR; PG8_MMA(1, 1, At, B1); PG8_BAR;
            }
        }
        if constexpr (ALIGN_EPI) { if (wr == 0) PG8_BAR; }
        if constexpr (!Epi::AFTER_DRAIN) { E(acc, cur, wr, wc, fr, fq); S.done(cur); }
        if (!has_next) break;
#pragma unroll
        for (int a = 0; a < 2; ++a)
#pragma unroll
            for (int b = 0; b < 2; ++b)
#pragma unroll
                for (int m = 0; m < 4; ++m)
#pragma unroll
                    for (int n = 0; n < 2; ++n) acc[a][b][m][n] = (f32x4){0.f, 0.f, 0.f, 0.f};
        cur = nxt; cA = nA; cB = nB; ++ui;
        if constexpr (ALIGN_EPI) { if (wr == 1) PG8_BAR; }
    }
    PG8_WAIT_V(0);
    if constexpr (!ALIGN_EPI) { if (wr == 0) PG8_BAR; }
    PG8_BAR;
    if constexpr (Epi::AFTER_DRAIN) { E.fused(acc, cur, wr, wc, fr, fq, lds, wid, lane); S.done(cur); }
#undef PG8_SA
#undef PG8_SB
#undef PG8_STAGE
#undef PG8_LDA
#undef PG8_LDB
#undef PG8_MMA
#undef PG8_WAIT_V
#undef PG8_WAIT_L
#undef PG8_BAR
#undef PG8_SCHED
}
}
namespace pg8 {
struct Unit2 { int pm, pn, e, cnt, jt; };
template <class Epi, class Sched>
__device__ __forceinline__ void gemm_phase2(PG8_LAS unsigned char* lds, const bf16_t* Abase, int lda, int ldb, int K, const Sched& S, const Epi& E) {
    int tid_ = threadIdx.x; asm volatile("" : "+v"(tid_));
    const int tid = tid_, wid = __builtin_amdgcn_readfirstlane(tid >> 6), lane = tid & 63, wr = wid >> 2, wc = wid & 3, fr = lane & 15, fq = lane >> 4;
    int K_ = K; asm volatile("" : "+s"(K_));
    const int nt = K_ / BK;
    unsigned voffB[2];
#pragma unroll
    for (int i = 0; i < 2; ++i) { int R, C; stage_rc(tid * 16 + i * 8192, R, C); const int Rb = Epi::PERM ? ((R & ~31) + perm32(R & 31)) : R; voffB[i] = (unsigned)(Rb * ldb + C) * 2u; }
    const unsigned lda2 = (unsigned)lda * 2u;
#define PG8_AOFFS(U, o0, o1) do { int t2_ = threadIdx.x; asm volatile("" : "+v"(t2_)); _Pragma("unroll") for (int i_ = 0; i_ < 2; ++i_) { int R_, C_; stage_rc(t2_ * 16 + i_ * 8192, R_, C_); \
        o0[i_] = (unsigned)S.arow(U, R_) * lda2 + (unsigned)C_ * 2u; o1[i_] = (unsigned)S.arow(U, HALF + R_) * lda2 + (unsigned)C_ * 2u; } } while (0)
    const size_t kstep = (size_t)(BK * 2);
    const size_t hstepB = (size_t)HALF * ldb * 2;
    const unsigned ldsw = (unsigned)wid * 1024u;
    const int aoff = lds_byte(wr * 64 + fr, fq * 8), boff = lds_byte(wc * 32 + fr, fq * 8);
#define PG8_SA(b, h) (((b) * 2 + (h)) * HTB)
#define PG8_SB(b, h) ((4 + (b) * 2 + (h)) * HTB)
#define PG8_STAGE(bufoff, gbase, voff) do { _Pragma("unroll") for (int _i = 0; _i < 2; ++_i) \
        __builtin_amdgcn_global_load_lds((const unsigned*)((const char*)(gbase) + (voff)[_i]), (PG8_LAS unsigned*)(lds + (bufoff) + ldsw + _i * 8192), 16, 0, 0); } while (0)
#define PG8_LDA(dst, b, h) do { _Pragma("unroll") for (int m = 0; m < 4; ++m) _Pragma("unroll") for (int k = 0; k < 2; ++k) dst[m][k] = *(const PG8_LAS bf16x8*)(lds + PG8_SA(b, h) + aoff + m * 2048 + k * 1024); } while (0)
#define PG8_LDB(dst, b, h) do { _Pragma("unroll") for (int n = 0; n < 2; ++n) _Pragma("unroll") for (int k = 0; k < 2; ++k) dst[n][k] = *(const PG8_LAS bf16x8*)(lds + PG8_SB(b, h) + boff + n * 2048 + k * 1024); } while (0)
#define PG8_MMA(ai, bj, At, Bt) do { __builtin_amdgcn_s_setprio(1); _Pragma("unroll") for (int m = 0; m < 4; ++m) _Pragma("unroll") for (int n = 0; n < 2; ++n) _Pragma("unroll") for (int k = 0; k < 2; ++k) \
        acc[ai][bj][m][n] = __builtin_amdgcn_mfma_f32_16x16x32_bf16(Bt[n][k], At[m][k], acc[ai][bj][m][n], 0, 0, 0); __builtin_amdgcn_s_setprio(0); } while (0)
#define PG8_WAIT_V(n) asm volatile("s_waitcnt vmcnt(" #n ")" ::: "memory")
#define PG8_WAIT_L(n) asm volatile("s_waitcnt lgkmcnt(" #n ")" ::: "memory")
#define PG8_BAR __builtin_amdgcn_s_barrier()
#define PG8_SCHED __builtin_amdgcn_sched_barrier(0)
    Unit2 cur, nxt; int ui = 0;
    if (!S.next(0, cur)) return;
    f32x4 acc[2][2][4][2];
#pragma unroll
    for (int a = 0; a < 2; ++a)
#pragma unroll
        for (int b = 0; b < 2; ++b)
#pragma unroll
            for (int m = 0; m < 4; ++m)
#pragma unroll
                for (int n = 0; n < 2; ++n) acc[a][b][m][n] = (f32x4){0.f, 0.f, 0.f, 0.f};
    bf16x8 At[4][2], B0[2][2], B1[2][2];
    unsigned cv0[2], cv1[2], nv0[2], nv1[2];
    PG8_AOFFS(cur, cv0, cv1);
    const char* cA = (const char*)Abase + S.aoff(cur); const char* cB = S.bptr(cur);
    PG8_STAGE(PG8_SB(0, 0), cB, voffB); PG8_STAGE(PG8_SB(0, 1), cB + hstepB, voffB); PG8_STAGE(PG8_SA(0, 0), cA, cv0); PG8_STAGE(PG8_SA(0, 1), cA, cv1);
    if (wr == 1) PG8_BAR;
    PG8_WAIT_V(2); PG8_BAR;
    PG8_STAGE(PG8_SB(1, 0), cB + kstep, voffB); PG8_STAGE(PG8_SA(1, 0), cA + kstep, cv0); PG8_STAGE(PG8_SB(1, 1), cB + hstepB + kstep, voffB);
    PG8_WAIT_V(6); PG8_BAR;
    for (;;) {
        const bool has_next = S.next(ui + 1, nxt);
        const char* nA = has_next ? (const char*)Abase + S.aoff(nxt) : cA; const char* nB = has_next ? S.bptr(nxt) : cB;
#pragma unroll
        for (int i = 0; i < 2; ++i) { nv0[i] = cv0[i]; nv1[i] = cv1[i]; }
        if (has_next) PG8_AOFFS(nxt, nv0, nv1);
        for (int t = 0; t < nt; t += 2) {
            const bool last = (t == nt - 2);
            const char* a1 = cA + (size_t)(t + 1) * kstep;
            const char* a2 = last ? nA : cA + (size_t)(t + 2) * kstep; const char* b2 = last ? nB : cB + (size_t)(t + 2) * kstep;
            const char* a3 = a2 + kstep; const char* b3 = b2 + kstep;
            unsigned s0[2] = {cv0[0], cv0[1]}, s1[2] = {cv1[0], cv1[1]};
            if (last) { asm volatile("" ::: "memory"); s0[0] = nv0[0]; s0[1] = nv0[1]; s1[0] = nv1[0]; s1[1] = nv1[1]; }
            PG8_LDB(B0, 0, 0); PG8_LDB(B1, 0, 1); PG8_SCHED; PG8_LDA(At, 0, 0); PG8_STAGE(PG8_SA(1, 1), a1, cv1);
            PG8_WAIT_V(8); PG8_WAIT_L(0); PG8_BAR; PG8_MMA(0, 0, At, B0); PG8_MMA(0, 1, At, B1); PG8_BAR; PG8_SCHED;
            PG8_LDA(At, 0, 1); PG8_STAGE(PG8_SB(0, 0), b2, voffB); PG8_STAGE(PG8_SB(0, 1), b2 + hstepB, voffB); PG8_STAGE(PG8_SA(0, 0), a2, s0);
            PG8_WAIT_V(8); PG8_WAIT_L(0); PG8_BAR; PG8_MMA(1, 0, At, B0); PG8_MMA(1, 1, At, B1); PG8_BAR; PG8_SCHED;
            PG8_LDB(B0, 1, 0); PG8_LDB(B1, 1, 1); PG8_SCHED; PG8_LDA(At, 1, 0); PG8_STAGE(PG8_SA(0, 1), a2, s1);
            PG8_WAIT_V(8); PG8_WAIT_L(0); PG8_BAR; PG8_MMA(0, 0, At, B0); PG8_MMA(0, 1, At, B1); PG8_BAR; PG8_SCHED;
            PG8_LDA(At, 1, 1); PG8_STAGE(PG8_SB(1, 0), b3, voffB); PG8_STAGE(PG8_SB(1, 1), b3 + hstepB, voffB); PG8_STAGE(PG8_SA(1, 0), a3, s0);
            PG8_WAIT_V(8); PG8_WAIT_L(0); PG8_BAR; PG8_MMA(1, 0, At, B0); PG8_MMA(1, 1, At, B1); PG8_BAR; PG8_SCHED;
        }
        if (wr == 0) PG8_BAR;
        { Unit2 eu = cur; asm volatile("" : "+s"(eu.pm), "+s"(eu.pn), "+s"(eu.e), "+s"(eu.cnt), "+s"(eu.jt));
          E(acc, eu, wr, wc, fr, fq); }
        if (!has_next) break;
#pragma unroll
        for (int a = 0; a < 2; ++a)
#pragma unroll
            for (int b = 0; b < 2; ++b)
#pragma unroll
                for (int m = 0; m < 4; ++m)
#pragma unroll
                    for (int n = 0; n < 2; ++n) acc[a][b][m][n] = (f32x4){0.f, 0.f, 0.f, 0.f};
        cur = nxt; cA = nA; cB = nB; ++ui;
#pragma unroll
        for (int i = 0; i < 2; ++i) { cv0[i] = nv0[i]; cv1[i] = nv1[i]; }
        if (wr == 1) PG8_BAR;
    }
    PG8_WAIT_V(0);
    PG8_BAR;
#undef PG8_AOFFS
#undef PG8_SA
#undef PG8_SB
#undef PG8_STAGE
#undef PG8_LDA
#undef PG8_LDB
#undef PG8_MMA
#undef PG8_WAIT_V
#undef PG8_WAIT_L
#undef PG8_BAR
#undef PG8_SCHED
}

struct DenseSched {
    StaticOrder so; const bf16_t* Bt; int ldb;
    __device__ __forceinline__ bool next(int i, Unit2& u) const { Unit t; if (!so.next(i, t)) return false; u.pm = t.pm; u.pn = t.pn; u.e = 0; u.cnt = 256; u.jt = 0; return true; }
    __device__ __forceinline__ int arow(const Unit2& u, int r) const { return u.pm * BM + r; }
    __device__ __forceinline__ size_t aoff(const Unit2&) const { return 0; }
    __device__ __forceinline__ const char* bptr(const Unit2& u) const { return (const char*)(Bt + (size_t)u.pn * BM * ldb); }
};
struct EpiResid {
    static constexpr bool PERM = false, AFTER_DRAIN = false;
    float* C; int ldc; const float* x; const float* stats; const float* g; const float* b; float alpha;
    __device__ __forceinline__ void operator()(const f32x4 (&acc)[2][2][4][2], const Unit2& u, int wr, int wc, int fr, int fq) const {
        const int row0 = u.pm * BM + wr * 64 + fr, col0 = u.pn * BM + wc * 32 + 4 * fq;
        f32x4 gv[2][2], bv[2][2];
#pragma unroll
        for (int bj = 0; bj < 2; ++bj)
#pragma unroll
            for (int n = 0; n < 2; ++n) { gv[bj][n] = *(const f32x4*)(g + col0 + bj * HALF + n * 16) * alpha; bv[bj][n] = *(const f32x4*)(b + col0 + bj * HALF + n * 16) * alpha; }
#pragma unroll
        for (int ai = 0; ai < 2; ++ai)
#pragma unroll
            for (int m = 0; m < 4; ++m) { const int row = row0 + ai * HALF + m * 16; const float mean = stats[2 * row], rstd = stats[2 * row + 1];
                const float* xr = x + (size_t)row * ldc + col0; float* cr = C + (size_t)row * ldc + col0;
#pragma unroll
                for (int bj = 0; bj < 2; ++bj)
#pragma unroll
                    for (int n = 0; n < 2; ++n) { const f32x4 xv = *(const f32x4*)(xr + bj * HALF + n * 16);
                        *(f32x4*)(cr + bj * HALF + n * 16) = acc[ai][bj][m][n] + ((xv - mean) * rstd) * gv[bj][n] + bv[bj][n]; } }
    }
};
}
namespace nv {
constexpr int D = 1024, B = 8, S = 4096, T = B * S;
constexpr int FH = 8, FD = 64, GH = 4, GK = 64, GV = 128, RANK = 16;
constexpr int INW = 3096;
constexpr int O_FQ = 0, O_FK = 512, O_FV = 1024, O_FF = 1536, O_GQ = 1544, O_GK = 1800, O_GV = 2056, O_GA = 2568, O_GR = 2584;
constexpr int NE = 256, NG = 8, TOPK = 8, ED = 256;
constexpr float LN_EPS = 1e-5f;
constexpr float ALPHA = 1.189207115002721f;
constexpr int PADR = 64;
constexpr int APAD = T * TOPK + NE * PADR;

__device__ __forceinline__ float logsigmoidf(float x) { return fminf(x, 0.f) - log1pf(expf(-fabsf(x))); }
__device__ __forceinline__ float siluf(float x) { return x / (1.f + expf(-x)); }


__device__ __forceinline__ void ln_row(const float* in1, float a, const float* in2, const float* __restrict__ g, const float* __restrict__ b, float* out, int r, int tid, float* sh) {
    float4 v = ((const float4*)(in1 + (size_t)r * D))[tid];
    v.x *= a; v.y *= a; v.z *= a; v.w *= a;
    if (in2) { const float4 w = ((const float4*)(in2 + (size_t)r * D))[tid]; v.x += w.x; v.y += w.y; v.z += w.z; v.w += w.w; }
    float s = v.x + v.y + v.z + v.w;
    for (int o = 32; o > 0; o >>= 1) s += __shfl_xor(s, o);
    __syncthreads();
    if ((tid & 63) == 0) sh[tid >> 6] = s;
    __syncthreads();
    const float mean = (sh[0] + sh[1] + sh[2] + sh[3]) * (1.f / D);
    v.x -= mean; v.y -= mean; v.z -= mean; v.w -= mean;
    float q = v.x * v.x + v.y * v.y + v.z * v.z + v.w * v.w;
    for (int o = 32; o > 0; o >>= 1) q += __shfl_xor(q, o);
    if ((tid & 63) == 0) sh[4 + (tid >> 6)] = q;
    __syncthreads();
    const float rstd = rsqrtf((sh[4] + sh[5] + sh[6] + sh[7]) * (1.f / D) + LN_EPS);
    const float4 gg = ((const float4*)g)[tid], bb = ((const float4*)b)[tid];
    float4 o4; o4.x = v.x * rstd * gg.x + bb.x; o4.y = v.y * rstd * gg.y + bb.y; o4.z = v.z * rstd * gg.z + bb.z; o4.w = v.w * rstd * gg.w + bb.w;
    ((float4*)(out + (size_t)r * D))[tid] = o4;
}

__device__ __forceinline__ void gemm_tile(const float* A, const float* Bm, float* C, int N, int K, int lda, int ldb, int ldc, int tile_x, int tile_y, int tid, float* sh) {
    float (*As)[68] = (float (*)[68])sh;
    float (*Bs)[68] = (float (*)[68])(sh + 16 * 68);
    const int tx = tid & 15, ty = tid >> 4;
    const int row0 = tile_y * 64, col0 = tile_x * 64;
    float acc[4][4] = {};
    const int ar = tid >> 2, ak = (tid & 3) * 4;
    const int bk = tid >> 4, bc = (tid & 15) * 4;
    const bool bok = (col0 + bc) < N;
    for (int k0 = 0; k0 < K; k0 += 16) {
        const float4 av = *(const float4*)(A + (size_t)(row0 + ar) * lda + k0 + ak);
        float4 bv = make_float4(0.f, 0.f, 0.f, 0.f);
        if (bok) bv = *(const float4*)(Bm + (size_t)(k0 + bk) * ldb + col0 + bc);
        __syncthreads();
        As[ak + 0][ar] = av.x; As[ak + 1][ar] = av.y; As[ak + 2][ar] = av.z; As[ak + 3][ar] = av.w;
        *(float4*)&Bs[bk][bc] = bv;
        __syncthreads();
#pragma unroll
        for (int k = 0; k < 16; ++k) {
            const float4 a4 = *(const float4*)&As[k][ty * 4];
            const float4 b4 = *(const float4*)&Bs[k][tx * 4];
            const float aa[4] = {a4.x, a4.y, a4.z, a4.w}, bb[4] = {b4.x, b4.y, b4.z, b4.w};
#pragma unroll
            for (int i = 0; i < 4; ++i)
#pragma unroll
                for (int j = 0; j < 4; ++j) acc[i][j] += aa[i] * bb[j];
        }
    }
    if (col0 + tx * 4 < N) {
#pragma unroll
        for (int i = 0; i < 4; ++i)
            *(float4*)(C + (size_t)(row0 + ty * 4 + i) * ldc + col0 + tx * 4) = make_float4(acc[i][0], acc[i][1], acc[i][2], acc[i][3]);
    }
}
__device__ __forceinline__ void gemm_phase(const float* A, const float* Bm, float* C, int M, int N, int K, int lda, int ldb, int ldc, int half, int tid, float* sh) {
    const int ntx = (N + 63) / 64, nty = M / 64, ntile = ntx * nty, G2 = gridDim.x * 2;
    for (int t0 = blockIdx.x * 2; t0 < ntile; t0 += G2) {
        int tl = t0 + half; if (tl >= ntile) tl = ntile - 1;
        gemm_tile(A, Bm, C, N, K, lda, ldb, ldc, tl % ntx, tl / ntx, tid, sh);
    }
}

__device__ __forceinline__ void fox_prep(const float* proj, const float* __restrict__ bf, float* cbuf, int bh, int lane) {
    const int b = bh / FH, h = bh % FH;
    const float bias = bf[h];
    float s = 0.f;
    for (int i = 0; i < 64; ++i) { const int t = lane * 64 + i; s += logsigmoidf(proj[(size_t)(b * S + t) * INW + O_FF + h] + bias); }
    float inc = s;
    for (int o = 1; o < 64; o <<= 1) { const float n = __shfl_up(inc, o); if (lane >= o) inc += n; }
    float run = inc - s;
    for (int i = 0; i < 64; ++i) { const int t = lane * 64 + i; run += logsigmoidf(proj[(size_t)(b * S + t) * INW + O_FF + h] + bias); cbuf[(size_t)bh * S + t] = run; }
}

__device__ __forceinline__ void fox_attn(const float* proj, const float* cbuf, float* y, int blk, int lane) {
    const int qb = blk % (S / 64), bh = blk / (S / 64), b = bh / FH, h = bh % FH;
    const int t = qb * 64 + lane;
    const float* qp = proj + (size_t)(b * S + t) * INW + O_FQ + h * FD;
    float q[64], o[64];
#pragma unroll
    for (int d = 0; d < 64; ++d) { q[d] = qp[d] * 0.125f; o[d] = 0.f; }
    const float ct = cbuf[(size_t)bh * S + t];
    float m = -INFINITY, l = 0.f;
    const int smax = qb * 64 + 63;
    for (int s = 0; s <= smax; ++s) {
        const float* kp = proj + (size_t)(b * S + s) * INW + O_FK + h * FD;
        const float* vp = proj + (size_t)(b * S + s) * INW + O_FV + h * FD;
        float dot = 0.f;
#pragma unroll
        for (int d = 0; d < 64; ++d) dot += q[d] * kp[d];
        const float x = dot + (ct - cbuf[(size_t)bh * S + s]);
        if (s <= t) {
            if (x > m) { const float al = expf(m - x); l *= al;
#pragma unroll
                for (int d = 0; d < 64; ++d) o[d] *= al;
                m = x; }
            const float p = expf(x - m); l += p;
#pragma unroll
            for (int d = 0; d < 64; ++d) o[d] += p * vp[d];
        }
    }
    const float il = 1.f / l;
    float* yp = y + (size_t)(b * S + t) * D + h * FD;
#pragma unroll
    for (int d = 0; d < 64; ++d) yp[d] = o[d] * il;
}

__device__ __forceinline__ void gla_prep(const float* proj, const float* __restrict__ wgu, const float* __restrict__ bg, float* abuf, int t, int j) {
    const float* ga = proj + (size_t)t * INW + O_GA;
    float s = bg[j];
#pragma unroll
    for (int r = 0; r < RANK; ++r) s += ga[r] * wgu[r * 256 + j];
    abuf[(size_t)t * 256 + j] = expf(logsigmoidf(s) * (1.f / 16.f));
}

__device__ __forceinline__ void gla_rec(const float* proj, const float* abuf, float* glao, int bh, int e) {
    const int b = bh / GH, h = bh % GH;
    float st[64];
#pragma unroll
    for (int d = 0; d < 64; ++d) st[d] = 0.f;
    for (int s = 0; s < S; ++s) {
        const size_t t = (size_t)b * S + s;
        const float* qp = proj + t * INW + O_GQ + h * GK;
        const float* kp = proj + t * INW + O_GK + h * GK;
        const float* ap = abuf + t * 256 + h * GK;
        const float v = proj[t * INW + O_GV + h * GV + e];
        float o = 0.f;
#pragma unroll
        for (int d = 0; d < 64; ++d) { st[d] = ap[d] * st[d] + kp[d] * v; o += qp[d] * st[d]; }
        glao[t * 512 + h * GV + e] = o * 0.125f;
    }
}

__device__ __forceinline__ void gla_post(const float* glao, const float* proj, const float* __restrict__ g, float* y, int w, int lane) {
    const int t = w >> 2, h = w & 3;
    const float o0 = glao[(size_t)t * 512 + h * GV + lane], o1 = glao[(size_t)t * 512 + h * GV + 64 + lane];
    float ss = o0 * o0 + o1 * o1;
    for (int o = 32; o > 0; o >>= 1) ss += __shfl_xor(ss, o);
    const float r = rsqrtf(ss * (1.f / GV) + LN_EPS);
    const float g0 = proj[(size_t)t * INW + O_GR + h * GV + lane], g1 = proj[(size_t)t * INW + O_GR + h * GV + 64 + lane];
    y[(size_t)t * D + 512 + h * GV + lane] = o0 * r * g[lane] * siluf(g0);
    y[(size_t)t * D + 512 + h * GV + 64 + lane] = o1 * r * g[64 + lane] * siluf(g1);
}

__device__ __forceinline__ void route_token(const float* logits, const float* __restrict__ rbias, int* top_e, float* top_w, int* top_pos, int* counts, int t, int lane) {
    const float4 lg = ((const float4*)(logits + (size_t)t * NE))[lane];
    const float4 rb = ((const float4*)rbias)[lane];
    float sc[4] = {1.f / (1.f + expf(-lg.x)), 1.f / (1.f + expf(-lg.y)), 1.f / (1.f + expf(-lg.z)), 1.f / (1.f + expf(-lg.w))};
    float bv[4] = {sc[0] + rb.x, sc[1] + rb.y, sc[2] + rb.z, sc[3] + rb.w};
    float m1 = fmaxf(bv[0], bv[1]), m2 = fminf(bv[0], bv[1]);
    { const float a = fmaxf(bv[2], bv[3]), c = fminf(bv[2], bv[3]); const float n1 = fmaxf(m1, a); m2 = fmaxf(fminf(m1, a), fmaxf(m2, c)); m1 = n1; }
    for (int o = 1; o < 8; o <<= 1) { const float p1 = __shfl_xor(m1, o), p2 = __shfl_xor(m2, o); const float n1 = fmaxf(m1, p1); m2 = fmaxf(fminf(m1, p1), fmaxf(m2, p2)); m1 = n1; }
    const float gs = m1 + m2;
    const int myg = lane >> 3;
    int rank = 0;
#pragma unroll
    for (int g2 = 0; g2 < NG; ++g2) { const float og = __shfl(gs, g2 * 8); if (og > gs || (og == gs && g2 < myg)) ++rank; }
    const bool sel = rank < 4;
    float mv[4];
#pragma unroll
    for (int i = 0; i < 4; ++i) mv[i] = sel ? bv[i] : -INFINITY;
    int we[TOPK]; float ws[TOPK]; float wsum = 0.f;
#pragma unroll
    for (int k = 0; k < TOPK; ++k) {
        float bvv = mv[0]; int bi = 0;
#pragma unroll
        for (int i = 1; i < 4; ++i) if (mv[i] > bvv) { bvv = mv[i]; bi = i; }
        int gi = lane * 4 + bi;
        for (int o = 32; o > 0; o >>= 1) { const float ov = __shfl_xor(bvv, o); const int oi = __shfl_xor(gi, o); if (ov > bvv || (ov == bvv && oi < gi)) { bvv = ov; gi = oi; } }
        const int ol = gi >> 2, oi = gi & 3;
        const float s_own = (oi == 0) ? sc[0] : (oi == 1) ? sc[1] : (oi == 2) ? sc[2] : sc[3];
        const float sw = __shfl(s_own, ol);
        if (lane == ol) { if (oi == 0) mv[0] = -INFINITY; else if (oi == 1) mv[1] = -INFINITY; else if (oi == 2) mv[2] = -INFINITY; else mv[3] = -INFINITY; }
        we[k] = gi; ws[k] = sw; wsum += sw;
    }
    if (lane == 0) {
        const float inv = 2.5f / wsum;
#pragma unroll
        for (int k = 0; k < TOPK; ++k) {
            top_e[t * TOPK + k] = we[k]; top_w[t * TOPK + k] = ws[k] * inv;
            top_pos[t * TOPK + k] = atomicAdd(&counts[we[k]], 1);
        }
    }
}

__device__ __forceinline__ void moe_offsets(const int* counts, int* off, int* blk_exp, int* nblk, int lane) {
    int pc[4], st[4]; int tot = 0;
#pragma unroll
    for (int i = 0; i < 4; ++i) { pc[i] = (counts[lane * 4 + i] + PADR - 1) / PADR * PADR; st[i] = tot; tot += pc[i]; }
    int inc = tot;
    for (int o = 1; o < 64; o <<= 1) { const int n = __shfl_up(inc, o); if (lane >= o) inc += n; }
    const int base = inc - tot;
#pragma unroll
    for (int i = 0; i < 4; ++i) { const int start = base + st[i]; off[lane * 4 + i] = start; for (int k = start / PADR; k < (start + pc[i]) / PADR; ++k) blk_exp[k] = lane * 4 + i; }
    if (lane == 63) nblk[0] = inc / PADR;
}

__device__ __forceinline__ void moe_scatter(const int* top_e, const float* top_w, const int* top_pos, const int* off, int* row_tok, float* row_gate, int* slot_of, int a) {
    const int slot = off[top_e[a]] + top_pos[a];
    row_tok[slot] = a / TOPK; row_gate[slot] = top_w[a]; slot_of[a] = slot;
}

__device__ __forceinline__ void moe_hidden(const float* h1, const float* __restrict__ wg, const float* __restrict__ wu, const int* row_tok, const float* row_gate, const int* blk_exp, const int* nblk,
                                           float* hidden, int g16, int j, float* sh) {
    const bool active = g16 * 16 < nblk[0] * PADR;
    float (*xs)[D] = (float (*)[D])sh;
    __syncthreads();
    if (active) for (int r = 0; r < 16; ++r) { const int tok = row_tok[g16 * 16 + r]; ((float4*)xs[r])[j] = ((const float4*)(h1 + (size_t)tok * D))[j]; }
    __syncthreads();
    if (!active) return;
    const int e = blk_exp[(g16 * 16) / PADR];
    float ag[16], au[16];
#pragma unroll
    for (int r = 0; r < 16; ++r) { ag[r] = 0.f; au[r] = 0.f; }
    const float* wgp = wg + (size_t)e * D * ED + j; const float* wup = wu + (size_t)e * D * ED + j;
    for (int d = 0; d < D; d += 4) {
        const float g0 = wgp[(size_t)(d + 0) * ED], g1 = wgp[(size_t)(d + 1) * ED], g2 = wgp[(size_t)(d + 2) * ED], g3 = wgp[(size_t)(d + 3) * ED];
        const float u0 = wup[(size_t)(d + 0) * ED], u1 = wup[(size_t)(d + 1) * ED], u2 = wup[(size_t)(d + 2) * ED], u3 = wup[(size_t)(d + 3) * ED];
#pragma unroll
        for (int r = 0; r < 16; ++r) { const float4 x = *(const float4*)&xs[r][d];
            ag[r] += x.x * g0 + x.y * g1 + x.z * g2 + x.w * g3; au[r] += x.x * u0 + x.y * u1 + x.z * u2 + x.w * u3; }
    }
#pragma unroll
    for (int r = 0; r < 16; ++r) hidden[(size_t)(g16 * 16 + r) * ED + j] = row_gate[g16 * 16 + r] * siluf(ag[r]) * au[r];
}

__device__ __forceinline__ void moe_down(const float* hidden, const float* __restrict__ wd, const int* top_e, const int* slot_of, float* ffn, int t, int i, float* sh) {
    float4 acc = ((float4*)(ffn + (size_t)t * D))[i];
    for (int k = 0; k < TOPK; ++k) {
        const int e = top_e[t * TOPK + k], slot = slot_of[t * TOPK + k];
        __syncthreads();
        sh[i] = hidden[(size_t)slot * ED + i];
        __syncthreads();
        const float4* wp = (const float4*)(wd + (size_t)e * ED * D) + i;
        for (int j = 0; j < ED; ++j) { const float4 w = wp[(size_t)j * (D / 4)]; const float hv = sh[j]; acc.x += hv * w.x; acc.y += hv * w.y; acc.z += hv * w.z; acc.w += hv * w.w; }
    }
    ((float4*)(ffn + (size_t)t * D))[i] = acc;
}
}
#include <hip/hip_bf16.h>
#include <cmath>
namespace attn_body {
using bf16=__hip_bfloat16;
using bf16x8=__attribute__((ext_vector_type(8)))short;
using s16x4=__attribute__((ext_vector_type(4)))short;
using f32x16=__attribute__((ext_vector_type(16)))float;
using u32x4=__attribute__((ext_vector_type(4)))unsigned;
constexpr int BATCH=8,NHEAD=8,SEQ=4096,D=64,DM=3072,OPITCH=1024;
constexpr int NW=8,QBLK=32,QB=QBLK*NW,KVBLK=64,NQB=SEQ/QB;
constexpr int ATTN_PITCH=DM, ATTN_UNIT_ROWS=QB;
__device__ __forceinline__ int crow(int r,int hi){return (r&3)+8*(r>>2)+4*hi;}
#define SBAR() __builtin_amdgcn_sched_barrier(0)
__device__ __forceinline__ void cmask(f32x16&p0,f32x16&p1,int jb,int qrel,int hi){
  const float NEG=-INFINITY; int kb=64*jb+4*hi;
  #pragma unroll
  for(int r=0;r<16;++r){int kv=kb+(r&3)+8*(r>>2); if(kv>qrel)p0[r]=NEG; if(kv+32>qrel)p1[r]=NEG;}
}

constexpr int NSLOT=3, SLOTB=8192;
constexpr int LDS_K=0, LDS_V=NSLOT*SLOTB, LDS_WS=2*NSLOT*SLOTB, LDS_OST=LDS_WS+NW*64*4, LDS_CS=LDS_OST+NW*4096, LDS_BYTES=LDS_CS+SEQ*4;
constexpr float C2=0.125f*1.4426950408889634f;
__device__ __forceinline__ void glds16(const void*gsrc,unsigned lds_dst){unsigned keep;
  asm volatile("s_mov_b32 %0, m0\n\ts_mov_b32 m0, %2\n\ts_nop 0\n\tglobal_load_lds_dwordx4 %1, off\n\ts_mov_b32 m0, %0":"=&s"(keep):"v"(gsrc),"s"(lds_dst):"memory");}
__device__ __forceinline__ float max3f(float a,float b,float c){float r;asm("v_max3_f32 %0, %1, %2, %3":"=v"(r):"v"(a),"v"(b),"v"(c));return r;}
__device__ __forceinline__ float max2f(float a,float b){float r;asm("v_max_f32_e32 %0, %1, %2":"=v"(r):"v"(a),"v"(b));return r;}
__device__ __forceinline__ float fadd_s(float a,float b){float r;asm("v_add_f32_e32 %0, %1, %2":"=v"(r):"v"(a),"v"(b));return r;}
__device__ __forceinline__ float fsub_s(float a,float b){float r;asm("v_sub_f32_e32 %0, %1, %2":"=v"(r):"v"(a),"v"(b));return r;}
typedef float f32x2_t __attribute__((ext_vector_type(2))); typedef float f32x4_t __attribute__((ext_vector_type(4))); typedef __bf16 bf16x2_t __attribute__((ext_vector_type(2)));
__device__ __forceinline__ unsigned cvtpk_s(float lo,float hi){f32x2_t v={lo,hi};bf16x2_t b=__builtin_convertvector(v,bf16x2_t);return __builtin_bit_cast(unsigned,b);}
#define WAIT_BAR(N) asm volatile("s_waitcnt vmcnt(" #N ") lgkmcnt(0)\n\ts_barrier":::"memory")

__device__ __forceinline__ void split3(float b,unsigned&h,unsigned&m,unsigned&l){
  h=cvtpk_s(b,0.f)&0xffffu; const float r1=b-__uint_as_float(h<<16);
  m=cvtpk_s(r1,0.f)&0xffffu; const float r2=r1-__uint_as_float(m<<16);
  l=cvtpk_s(r2,0.f)&0xffffu; }
__device__ __forceinline__ bf16x8 kbias_frag(float b,int hi){unsigned h,m,l;split3(b,h,m,l);u32x4 w;w.x=h|(m<<16);w.y=l|0x3F800000u;w.z=0x3F803F80u;w.w=0u;if(hi){w.x=0u;w.y=0u;w.z=0u;}return __builtin_bit_cast(bf16x8,w);}
__device__ __forceinline__ bf16x8 qref_frag(float x,int hi){unsigned h,m,l;split3(x,h,m,l);u32x4 w;w.x=0x3F803F80u;w.y=0x3F80u|(h<<16);w.z=m|(l<<16);w.w=0u;if(hi){w.x=0u;w.y=0u;w.z=0u;}return __builtin_bit_cast(bf16x8,w);}
__device__ __forceinline__ void qkt(f32x16&p0,f32x16&p1,const char*Kslot,const bf16x8*qr,bf16x8 kb0,bf16x8 kb1,bf16x8 qx,int r32,int hi){
  const f32x16 negm=f32x16{};
  const char*kb=Kslot+hi*1024+r32*16;
  #pragma unroll
  for(int d0=0;d0<4;++d0){
    const bf16x8 b0=*reinterpret_cast<const bf16x8*>(kb+d0*2048);
    const bf16x8 b1=*reinterpret_cast<const bf16x8*>(kb+d0*2048+512);
    if(d0==0){p0=__builtin_amdgcn_mfma_f32_32x32x16_bf16(b0,qr[0],negm,0,0,0);p1=__builtin_amdgcn_mfma_f32_32x32x16_bf16(b1,qr[0],negm,0,0,0);}
    else{p0=__builtin_amdgcn_mfma_f32_32x32x16_bf16(b0,qr[d0],p0,0,0,0);p1=__builtin_amdgcn_mfma_f32_32x32x16_bf16(b1,qr[d0],p1,0,0,0);}}
  p0=__builtin_amdgcn_mfma_f32_32x32x16_bf16(kb0,qx,p0,0,0,0);p1=__builtin_amdgcn_mfma_f32_32x32x16_bf16(kb1,qx,p1,0,0,0);
}
typedef __attribute__((address_space(3))) const char* lds_cptr;
typedef short v4i16_t __attribute__((ext_vector_type(4)));
__device__ __forceinline__ void kload8(bf16x8*kf,lds_cptr kp){
  kf[0]=*(const __attribute__((address_space(3))) bf16x8*)(kp);      kf[1]=*(const __attribute__((address_space(3))) bf16x8*)(kp+512);
  kf[2]=*(const __attribute__((address_space(3))) bf16x8*)(kp+2048); kf[3]=*(const __attribute__((address_space(3))) bf16x8*)(kp+2560);
  kf[4]=*(const __attribute__((address_space(3))) bf16x8*)(kp+4096); kf[5]=*(const __attribute__((address_space(3))) bf16x8*)(kp+4608);
  kf[6]=*(const __attribute__((address_space(3))) bf16x8*)(kp+6144); kf[7]=*(const __attribute__((address_space(3))) bf16x8*)(kp+6656);
}
__device__ __forceinline__ void kload2(bf16x8*kf,lds_cptr kp,int j){ kf[2*j]=*(const __attribute__((address_space(3))) bf16x8*)(kp+j*2048); kf[2*j+1]=*(const __attribute__((address_space(3))) bf16x8*)(kp+j*2048+512); }
__device__ __forceinline__ s16x4 vtr(lds_cptr p){ return __builtin_bit_cast(s16x4,__builtin_amdgcn_ds_read_tr16_b64_v4i16((__attribute__((address_space(3))) v4i16_t*)p)); }
__device__ __forceinline__ float rowmax(const f32x16&p0,const f32x16&p1){
  float a=max3f(p0[0],p0[1],p1[0]),b=max3f(p0[2],p0[3],p1[1]);a=max3f(a,p1[2],p1[3]);
  #pragma unroll
  for(int r=4;r<16;r+=4){a=max3f(a,p0[r],p0[r+1]);b=max3f(b,p0[r+2],p0[r+3]);a=max3f(a,p1[r],p1[r+1]);b=max3f(b,p1[r+2],p1[r+3]);}
  const float m=max2f(a,b);
  auto rr=__builtin_amdgcn_permlane32_swap(__float_as_uint(m),__float_as_uint(m),false,false);
  return max2f(__uint_as_float(rr[0]),__uint_as_float(rr[1]));
}
__device__ __forceinline__ void pv(f32x16*o,int vb,bf16x8 pa0,bf16x8 pa1,bf16x8 pa2,bf16x8 pa3){
  #pragma unroll
  for(int d0=0;d0<2;++d0){s16x4 lo[4],hi[4];
    #pragma unroll
    for(int ks=0;ks<4;++ks){
      asm volatile("ds_read_b64_tr_b16 %0,%1 offset:%c2":"=&v"(lo[ks]):"v"(vb),"i"(d0*4096+ks*1024):"memory");
      asm volatile("ds_read_b64_tr_b16 %0,%1 offset:%c2":"=&v"(hi[ks]):"v"(vb),"i"(d0*4096+ks*1024+512):"memory");}
    asm volatile("s_waitcnt lgkmcnt(0)":::"memory");SBAR();
    #define PK(k) (bf16x8){lo[k][0],lo[k][1],lo[k][2],lo[k][3],hi[k][0],hi[k][1],hi[k][2],hi[k][3]}
    o[d0]=__builtin_amdgcn_mfma_f32_32x32x16_bf16(pa0,PK(0),o[d0],0,0,0);
    o[d0]=__builtin_amdgcn_mfma_f32_32x32x16_bf16(pa1,PK(1),o[d0],0,0,0);
    o[d0]=__builtin_amdgcn_mfma_f32_32x32x16_bf16(pa2,PK(2),o[d0],0,0,0);
    o[d0]=__builtin_amdgcn_mfma_f32_32x32x16_bf16(pa3,PK(3),o[d0],0,0,0);
    #undef PK
  }
}

#ifndef ATTN_STORE16
#define ATTN_STORE16(p,v) (*(u32x4*)(p)=(v))
#endif
template<int THRL> __device__ __forceinline__ void attn_unit(int b,int h,int qb,const bf16*Q,const bf16* K,const bf16* V,bf16*O,const float*LF,char*shm){
  int tid_=threadIdx.x; asm volatile("":"+v"(tid_));
  const int tid=tid_,lane=tid&63,r32=lane&31,hi=lane>>5; const int wid=__builtin_amdgcn_readfirstlane(tid>>6);
  const long rowbase=(long)b*SEQ; const int q0=qb*QB;
  float*csl=(float*)(shm+LDS_CS); float cq0;
  { const int n=q0+QB; const float*lf=LF+((long)b*NHEAD+h)*SEQ; float*wt=(float*)(shm+LDS_WS);
    f32x4_t va={0.f,0.f,0.f,0.f},vb={0.f,0.f,0.f,0.f};
    if(8*tid<n){ va=*(const f32x4_t*)(lf+8*tid); vb=*(const f32x4_t*)(lf+8*tid+4); }
    va[1]+=va[0];va[2]+=va[1];va[3]+=va[2];vb[0]+=va[3];vb[1]+=vb[0];vb[2]+=vb[1];vb[3]+=vb[2];
    const float tot=vb[3]; float inc=tot;
    #pragma unroll
    for(int o_=1;o_<64;o_<<=1){const float nn=__shfl_up(inc,o_);if(lane>=o_)inc+=nn;}
    if(lane==63)wt[wid*64]=inc;
    __syncthreads();
    float base=inc-tot;
    #pragma unroll
    for(int w_=0;w_<NW;++w_){const float x_=wt[w_*64]; if(w_<wid)base+=x_;}
    if(8*tid<n){ va=va+base; vb=vb+base; *(f32x4_t*)(csl+8*tid)=va; *(f32x4_t*)(csl+8*tid+4)=vb; }
    __syncthreads();
    cq0=csl[q0]; }
  const bf16*Qw=Q+(rowbase+q0+wid*QBLK)*DM+h*D;
  const bf16*Kh=K+rowbase*DM+h*D,*Vh=V+rowbase*DM+h*D;
  const unsigned lds0=(unsigned)(uintptr_t)shm;
  float*wsf=(float*)(shm+LDS_WS)+wid*64;
  const bf16*ksrc=Kh+(long)lane*DM+wid*8;
  const bf16*vsrc=Vh+(long)(16*(wid&3)+(lane>>2))*DM+(wid>>2)*32+(lane&3)*8;
  const unsigned kdst=lds0+LDS_K+wid*1024, vdst=lds0+LDS_V+wid*1024;
  #define DMA_K(t,slot) glds16(ksrc+(long)(t)*KVBLK*DM,(unsigned)__builtin_amdgcn_readfirstlane(kdst+(slot)))
  #define DMA_V(t,slot) glds16(vsrc+(long)(t)*KVBLK*DM,(unsigned)__builtin_amdgcn_readfirstlane(vdst+(slot)))
  const int vb0=(int)(lds0+LDS_V)+((lane>>4)&1)*32+(lane&3)*8+(4*hi+((lane&15)>>2))*64;
  const char*Kbase=shm+LDS_K; bf16x8 kf[8];
  const lds_cptr shm3=(lds_cptr)shm; const lds_cptr kp0=shm3+LDS_K+hi*1024+r32*16; const lds_cptr vp0=shm3+LDS_V+((lane>>4)&1)*32+(lane&3)*8+(4*hi+((lane&15)>>2))*64;
  const int NT=(q0+QB)/KVBLK;
  DMA_K(0,0);DMA_V(0,0);DMA_K(1,SLOTB);
  bf16x8 qr[4];
  #pragma unroll
  for(int d0=0;d0<4;++d0)qr[d0]=*reinterpret_cast<const bf16x8*>(&Qw[(long)r32*DM+d0*16+hi*8]);
  float mhat=0.f,l_reg=0.f;f32x16 o[2];o[0]=f32x16{};o[1]=f32x16{};const f32x16 negm=f32x16{};
  bf16x8 qx=qref_frag(0.f,hi);
  const int qrel=wid*QBLK+r32;
  #define CMASK(P0,P1,t) do{int jb_=(t)-(NT-4); if(jb_>=0)cmask(P0,P1,jb_,qrel,hi);}while(0)
  bool resc=false;
  #define START(P0,P1) do{ const float rm=rowmax(P0,P1); resc=false; \
    { const float dl=rm; mhat=fadd_s(mhat,dl); \
      _Pragma("unroll") for(int r=0;r<16;++r){P0[r]=fsub_s(P0[r],dl);P1[r]=fsub_s(P1[r],dl);} \
      qx=qref_frag(-mhat,hi); } \
    _Pragma("unroll") for(int r=0;r<16;++r)P0[r]=__builtin_amdgcn_exp2f(P0[r]); }while(0)
  #define RESC() do{ if(resc){ asm volatile("s_waitcnt lgkmcnt(0)":::"memory"); \
      _Pragma("unroll") for(int d_=0;d_<2;++d_) _Pragma("unroll") for(int r=0;r<16;++r)o[d_][r]*=wsf[crow(r,hi)]; } }while(0)
  f32x16 pA0,pA1,pB0,pB1;
  int sl_prev=0,sl_cur=0,sl_next=SLOTB;
  #define ROT() do{sl_prev=sl_cur;sl_cur=sl_next;sl_next=(sl_next==(NSLOT-1)*SLOTB)?0:sl_next+SLOTB;}while(0)
  DMA_K(2,2*SLOTB);
  WAIT_BAR(3);
  qkt(pA0,pA1,Kbase,qr,kbias_frag(cq0-csl[r32],hi),kbias_frag(cq0-csl[32+r32],hi),qx,r32,hi);asm volatile("s_nop 15\n\ts_nop 7":"+v"(pA0),"+v"(pA1));CMASK(pA0,pA1,0);
  START(pA0,pA1);
  _Pragma("unroll") for(int r=0;r<16;++r)pA1[r]=__builtin_amdgcn_exp2f(pA1[r]);
  WAIT_BAR(0);
  DMA_K(3,0);DMA_V(1,SLOTB);
  ROT();
  kload8(kf,kp0+sl_cur);
  WAIT_BAR(2);
  s16x4 vlo[8],vhi[8]; u32x4 pw0,pw1,pw2,pw3;
  #define PKW(P,B) cvtpk_s(P[B],P[B+1])
  #define PAF(k) __builtin_bit_cast(bf16x8,pw##k)
  #define VFR(i) (bf16x8){vlo[i][0],vlo[i][1],vlo[i][2],vlo[i][3],vhi[i][0],vhi[i][1],vhi[i][2],vhi[i][3]}
  #define PIN(x) asm volatile("":"+v"(x))
  #define MX3(a,b,c) __builtin_fmaxf(__builtin_fmaxf((a),(b)),(c))
  #define GAPA(MF,A0,A1,A2,A3,W0,W1,PW) do{ MF; sacc+=A0; sacc+=A1; sacc+=A2; sacc+=A3; PIN(sacc); W0; W1; PIN(PW); SBAR(); }while(0)
  #define EX(v) __builtin_amdgcn_exp2f(v)
  #define GAPB(MF,X,B) do{ MF; X[B]=EX(X[B]); X[B+1]=EX(X[B+1]); X[B+2]=EX(X[B+2]); X[B+3]=EX(X[B+3]); PIN(X); SBAR(); }while(0)
  #define VRD(i) do{ vlo[i]=vtr(vp_+(((i)>>2)*4096+((i)&3)*1024)); vhi[i]=vtr(vp_+(((i)>>2)*4096+((i)&3)*1024+512)); }while(0)
  #define KRD(G,j) do{ if(G){ kload2(kf,kp0+sl_next,j); SBAR(); } }while(0)
  #define STEP(C0,C1,P0,P1,t,GK,GV,GL) do{ SBAR(); \
    const lds_cptr vp_=vp0+sl_prev; const float nb0_=csl[64*(t)+r32],nb1_=csl[64*(t)+32+r32]; \
    VRD(0); SBAR(); float sacc=(P0[0]+P0[1]); \
    GAPA(C0=__builtin_amdgcn_mfma_f32_32x32x16_bf16(kf[0],qr[0],negm,0,0,0), P0[2],P0[3],P0[4],P0[5],     pw0[0]=PKW(P0,0), pw0[1]=PKW(P0,2), pw0); \
    VRD(4); SBAR(); GAPA(C1=__builtin_amdgcn_mfma_f32_32x32x16_bf16(kf[1],qr[0],negm,0,0,0), P0[6],P0[7],P0[8],P0[9],     pw0[2]=PKW(P0,4), pw0[3]=PKW(P0,6), pw0); \
    VRD(1); SBAR(); GAPA(C0=__builtin_amdgcn_mfma_f32_32x32x16_bf16(kf[2],qr[1],C0,0,0,0),   P0[10],P0[11],P0[12],P0[13], pw1[0]=PKW(P0,8), pw1[1]=PKW(P0,10), pw1); \
    VRD(5); SBAR(); GAPA(C1=__builtin_amdgcn_mfma_f32_32x32x16_bf16(kf[3],qr[1],C1,0,0,0),   P0[14],P0[15],P1[0],P1[1],   pw1[2]=PKW(P0,12),pw1[3]=PKW(P0,14), pw1); \
    VRD(2); SBAR(); GAPA(C0=__builtin_amdgcn_mfma_f32_32x32x16_bf16(kf[4],qr[2],C0,0,0,0),   P1[2],P1[3],P1[4],P1[5],     pw2[0]=PKW(P1,0), pw2[1]=PKW(P1,2), pw2); \
    VRD(6); SBAR(); GAPA(C1=__builtin_amdgcn_mfma_f32_32x32x16_bf16(kf[5],qr[2],C1,0,0,0),   P1[6],P1[7],P1[8],P1[9],     pw2[2]=PKW(P1,4), pw2[3]=PKW(P1,6), pw2); \
    VRD(3); SBAR(); GAPA(C0=__builtin_amdgcn_mfma_f32_32x32x16_bf16(kf[6],qr[3],C0,0,0,0),   P1[10],P1[11],P1[12],P1[13], pw3[0]=PKW(P1,8), pw3[1]=PKW(P1,10), pw3); \
    VRD(7); SBAR(); GAPA(C1=__builtin_amdgcn_mfma_f32_32x32x16_bf16(kf[7],qr[3],C1,0,0,0),   P1[14],P1[15],0.f,0.f,       pw3[2]=PKW(P1,12),pw3[3]=PKW(P1,14), pw3); \
    { const bf16x8 kb0_=kbias_frag(cq0-nb0_,hi),kb1_=kbias_frag(cq0-nb1_,hi); C0=__builtin_amdgcn_mfma_f32_32x32x16_bf16(kb0_,qx,C0,0,0,0); C1=__builtin_amdgcn_mfma_f32_32x32x16_bf16(kb1_,qx,C1,0,0,0); } SBAR(); \
    l_reg+=sacc; \
    if(GK){DMA_K((t)+3,sl_cur);} if(GV){DMA_V((t)+1,sl_next);} \
    CMASK(C0,C1,t); \
    { float a=MX3(C0[0],C0[1],C1[0]),b=MX3(C0[2],C0[3],C1[1]); a=MX3(a,C1[2],C1[3]); \
      _Pragma("unroll") for(int r=4;r<16;r+=4){a=MX3(a,C0[r],C0[r+1]);b=MX3(b,C0[r+2],C0[r+3]);a=MX3(a,C1[r],C1[r+1]);b=MX3(b,C1[r+2],C1[r+3]);} \
      float rm=__builtin_fmaxf(a,b); { auto rr=__builtin_amdgcn_permlane32_swap(__float_as_uint(rm),__float_as_uint(rm),false,false); rm=__builtin_fmaxf(__uint_as_float(rr[0]),__uint_as_float(rr[1])); } \
      resc=false; \
      if(__builtin_expect(__any(rm>(float)THRL),0)){ const float dl=__builtin_fmaxf(rm,0.f); mhat+=dl; \
        _Pragma("unroll") for(int r=0;r<16;++r){C0[r]-=dl;C1[r]-=dl;} \
        qx=qref_frag(-mhat,hi); \
        const float f=__builtin_amdgcn_exp2f(-dl); l_reg*=f; if(hi==0)wsf[r32]=f; resc=true; } } \
    SBAR(); \
    GAPB(o[0]=__builtin_amdgcn_mfma_f32_32x32x16_bf16(PAF(0),VFR(0),o[0],0,0,0), C0,0); \
    GAPB(o[1]=__builtin_amdgcn_mfma_f32_32x32x16_bf16(PAF(0),VFR(4),o[1],0,0,0), C0,4); \
    KRD(GL,0); GAPB(o[0]=__builtin_amdgcn_mfma_f32_32x32x16_bf16(PAF(1),VFR(1),o[0],0,0,0), C0,8); \
    KRD(GL,1); GAPB(o[1]=__builtin_amdgcn_mfma_f32_32x32x16_bf16(PAF(1),VFR(5),o[1],0,0,0), C0,12); \
    KRD(GL,2); GAPB(o[0]=__builtin_amdgcn_mfma_f32_32x32x16_bf16(PAF(2),VFR(2),o[0],0,0,0), C1,0); \
    KRD(GL,3); GAPB(o[1]=__builtin_amdgcn_mfma_f32_32x32x16_bf16(PAF(2),VFR(6),o[1],0,0,0), C1,4); \
    GAPB(o[0]=__builtin_amdgcn_mfma_f32_32x32x16_bf16(PAF(3),VFR(3),o[0],0,0,0), C1,8); \
    GAPB(o[1]=__builtin_amdgcn_mfma_f32_32x32x16_bf16(PAF(3),VFR(7),o[1],0,0,0), C1,12); \
    }while(0)
  int t=1;
  #undef CMASK
  #define CMASK(P0,P1,t) do{}while(0)
  for(;t+5<NT;t+=2){
    STEP(pB0,pB1,pA0,pA1,t,true,true,true);     WAIT_BAR(2); RESC(); ROT();
    STEP(pA0,pA1,pB0,pB1,t+1,true,true,true);   WAIT_BAR(2); RESC(); ROT();
  }
  #undef CMASK
  #define CMASK(P0,P1,t) do{int jb_=(t)-(NT-4); if(jb_>=0)cmask(P0,P1,jb_,qrel,hi);}while(0)
  #define ENDW(tt) do{ if((tt)+3<NT){WAIT_BAR(2);} else if((tt)+2<NT){WAIT_BAR(1);} else {WAIT_BAR(0);} }while(0)
  for(;t+1<NT;t+=2){
    STEP(pB0,pB1,pA0,pA1,t,(t+3<NT),(t+1<NT),(t+1<NT));       ENDW(t);   RESC(); ROT();
    STEP(pA0,pA1,pB0,pB1,t+1,(t+4<NT),(t+2<NT),(t+2<NT));     ENDW(t+1); RESC(); ROT();
  }
  STEP(pB0,pB1,pA0,pA1,NT-1,false,false,false); RESC();
  { float sacc=pB0[0]+pB0[1]; _Pragma("unroll") for(int r=2;r<16;++r)sacc+=pB0[r]; _Pragma("unroll") for(int r=0;r<16;++r)sacc+=pB1[r]; l_reg+=sacc;
    pw0=(u32x4){PKW(pB0,0),PKW(pB0,2),PKW(pB0,4),PKW(pB0,6)};pw1=(u32x4){PKW(pB0,8),PKW(pB0,10),PKW(pB0,12),PKW(pB0,14)};pw2=(u32x4){PKW(pB1,0),PKW(pB1,2),PKW(pB1,4),PKW(pB1,6)};pw3=(u32x4){PKW(pB1,8),PKW(pB1,10),PKW(pB1,12),PKW(pB1,14)};
    SBAR(); pv(o,vb0+sl_cur,PAF(0),PAF(1),PAF(2),PAF(3)); }
  #undef PKW
  #undef PAF
  #undef VFR
  #undef PIN
  #undef MX3
  #undef GAPA
  #undef GAPB
  #undef EX
  #undef VRD
  #undef KRD
  #undef STEP
  #undef ENDW
  {auto rr=__builtin_amdgcn_permlane32_swap(__float_as_uint(l_reg),__float_as_uint(l_reg),false,false);l_reg=__uint_as_float(rr[0])+__uint_as_float(rr[1]);}
  if(hi==0)wsf[32+r32]=l_reg;asm volatile("s_waitcnt lgkmcnt(0)":::"memory");
  float rli[16];
  #pragma unroll
  for(int r=0;r<16;++r)rli[r]=__builtin_amdgcn_rcpf(wsf[32+crow(r,hi)]);
  bf16*Ow=O+(rowbase+q0+wid*QBLK)*OPITCH+h*D;
  { bf16*stg=(bf16*)(shm+LDS_OST)+wid*2048;
    #pragma unroll
    for(int r=0;r<16;++r){const int orow=crow(r,hi);
      #pragma unroll
      for(int d0=0;d0<2;++d0)stg[orow*64+d0*32+r32]=__float2bfloat16(o[d0][r]*rli[r]);}
    asm volatile("s_waitcnt lgkmcnt(0)":::"memory");
    #pragma unroll
    for(int i=0;i<4;++i){const int row=i*8+(lane>>3),ch=lane&7; const u32x4 v=*(const u32x4*)(stg+row*64+ch*8); ATTN_STORE16(Ow+(long)row*OPITCH+ch*8,v);} }
  asm volatile("s_waitcnt lgkmcnt(0)\n\ts_barrier":::"memory");
  #undef DMA_K
  #undef DMA_V
  #undef CMASK
  #undef START
  #undef RESC
  #undef ROT
}
constexpr int ATTN_LDS_BYTES=LDS_BYTES;
struct AttnTensors { const bf16* Q; const bf16* K; const bf16* V; bf16* O; const float* LF; };
struct AttnUnit { int bh; int qb; };
struct StaticOrder {
  int vcu,grid;
  __device__ __forceinline__ explicit StaticOrder(int grid_,int block):vcu((grid_%8==0)?(block%8)*(grid_/8)+block/8:block),grid(grid_){}
  __device__ __forceinline__ bool next(int i,AttnUnit&u)const{
    if(grid==256){ if(i>=4)return false; const int s=vcu&3; u.bh=vcu>>2; u.qb=(i==0)?s:(i==1)?7-s:(i==2)?8+s:15-s; return true; }
    const int L=i*grid+vcu; if(L>=BATCH*NHEAD*NQB)return false; u.bh=L/NQB; u.qb=L%NQB; return true; }
  __device__ __forceinline__ void a_ready(const AttnUnit&)const{}
  __device__ __forceinline__ void done(const AttnUnit&)const{}
};
template<class Sched,int THRL=8> __device__ __forceinline__ void attn_phase(char*lds,const AttnTensors&T,const Sched&S){
  AttnUnit u;
  for(int i=0;S.next(i,u);++i){ S.a_ready(u); attn_unit<THRL>(u.bh/NHEAD,u.bh%NHEAD,u.qb,T.Q,T.K,T.V,T.O,T.LF,lds); S.done(u); }
}
#undef SBAR
#undef WAIT_BAR
}
namespace fx {
using namespace nv;
typedef unsigned short bf16;
typedef unsigned v4u __attribute__((ext_vector_type(4)));
typedef float f32x4 __attribute__((ext_vector_type(4)));
constexpr float C2 = 0.125f * 1.4426950408889634f;
constexpr int NIN = 3328;
constexpr int QKVP = 3072;
constexpr int P_FQ = 0, P_FK = 512, P_FV = 1024, P_GQ = 1536, P_GK = 1792, P_GV = 2048, P_GR = 2560;
__device__ __forceinline__ int inproj_src(int d) {
    if (d < 1536) return d;
    if (d < 1792) return O_GQ + (d - 1536);
    if (d < 2048) return O_GK + (d - 1792);
    if (d < 2560) return O_GV + (d - 2048);
    if (d < 3072) return O_GR + (d - 2560);
    if (d < 3080) return O_FF + (d - 3072);
    if (d < 3096) return O_GA + (d - 3080);
    return -1;
}
__device__ __forceinline__ unsigned f2bf(float f) { unsigned u = __builtin_bit_cast(unsigned, f); return (u + 0x7fffu + ((u >> 16) & 1u)) >> 16; }
__device__ __forceinline__ unsigned pk2(float lo, float hi) { return f2bf(lo) | (f2bf(hi) << 16); }
__device__ __forceinline__ float bf2f(unsigned short h) { return __builtin_bit_cast(float, (unsigned)h << 16); }
__device__ __forceinline__ float wave_sum(float v) {
#pragma unroll
    for (int o = 1; o < 64; o <<= 1) v += __shfl_xor(v, o);
    return v;
}
#define FX_LDS_WAIT() asm volatile("s_waitcnt lgkmcnt(0)" ::: "memory")

template <class Map> __device__ __forceinline__ void transpose_item(const float* __restrict__ W, int K, int N, bf16* WT, LAS float* scr, int kb, int nb, int lane, Map srcmap) {
    const int k0 = 64 * kb, n0 = 32 * nb;
    const int src = srcmap(n0 + (lane & 31));
#pragma unroll 8
    for (int i = 0; i < 32; ++i) { const int kk = 2 * i + (lane >> 5); scr[kk * 33 + (lane & 31)] = (src >= 0) ? W[(size_t)(k0 + kk) * N + src] : 0.f; }
    FX_LDS_WAIT(); asm volatile("" ::: "memory");
    const int c = lane & 7;
#pragma unroll
    for (int j = 0; j < 4; ++j) { const int n = (lane >> 3) + 8 * j; const LAS float* s = scr + (8 * c) * 33 + n;
        v4u o; o.x = pk2(s[0 * 33], s[1 * 33]); o.y = pk2(s[2 * 33], s[3 * 33]); o.z = pk2(s[4 * 33], s[5 * 33]); o.w = pk2(s[6 * 33], s[7 * 33]);
        *(GAS v4u*)(WT + (size_t)(n0 + n) * K + k0 + 8 * c) = o; }
    FX_LDS_WAIT(); asm volatile("" ::: "memory");
}

__device__ __forceinline__ void ln_row_bf16(const float* xrow, const float* __restrict__ g, const float* __restrict__ b, bf16* orow, float* frow, float* st, int lane) {
    const GAS f32x4* xr = (const GAS f32x4*)xrow + lane;
    f32x4 v[4]; float s = 0.f;
#pragma unroll
    for (int j = 0; j < 4; ++j) { v[j] = xr[64 * j]; s += (v[j].x + v[j].y) + (v[j].z + v[j].w); }
    const float mean = wave_sum(s) * (1.f / D); float s2 = 0.f;
#pragma unroll
    for (int j = 0; j < 4; ++j) { v[j] = v[j] - mean; s2 += (v[j].x * v[j].x + v[j].y * v[j].y) + (v[j].z * v[j].z + v[j].w * v[j].w); }
    const float rstd = 1.f / sqrtf(wave_sum(s2) * (1.f / D) + LN_EPS);
    if (st && lane == 0) { st[0] = mean; st[1] = rstd; }
    GAS unsigned long long* o8 = (GAS unsigned long long*)orow + lane;
#pragma unroll
    for (int j = 0; j < 4; ++j) {
        const f32x4 gg = ((const f32x4*)g)[lane + 64 * j], bb = ((const f32x4*)b)[lane + 64 * j];
        const f32x4 o = v[j] * rstd * gg + bb;
        o8[64 * j] = (unsigned long long)pk2(o.x, o.y) | ((unsigned long long)pk2(o.z, o.w) << 32);
        if (frow) ((GAS f32x4*)frow)[lane + 64 * j] = o;
    }
}
}

namespace pg8 {
struct EpiInProj {
    static constexpr bool PERM = true, AFTER_DRAIN = false;
    bf16_t* QKV; float* FG; float* LF; const float* bfg;
    __device__ __forceinline__ void operator()(const f32x4 (&acc)[2][2][4][2], const Unit& u, int wr, int wc, int fr, int fq) const {
        const int row0 = u.pm * BM + wr * 64 + fr;
        if (u.pn < 12) {
            const float sc = (u.pn < 2) ? fx::C2 : 1.f;
            const int col0 = u.pn * BM + wc * 32 + 8 * fq;
#pragma unroll
            for (int ai = 0; ai < 2; ++ai)
#pragma unroll
                for (int m = 0; m < 4; ++m) { bf16_t* rowp = QKV + (size_t)(row0 + ai * HALF + m * 16) * fx::QKVP + col0;
#pragma unroll
                    for (int bj = 0; bj < 2; ++bj) { const f32x4 v0 = acc[ai][bj][m][0] * sc, v1 = acc[ai][bj][m][1] * sc;
                        u32x4 w; w.x = cvt_pk_bf16(v0[0], v0[1]); w.y = cvt_pk_bf16(v0[2], v0[3]); w.z = cvt_pk_bf16(v1[0], v1[1]); w.w = cvt_pk_bf16(v1[2], v1[3]);
                        *(u32x4*)(rowp + bj * HALF) = w; } }
        } else if (wc == 0 && fq < 3) {
#pragma unroll
            for (int ai = 0; ai < 2; ++ai)
#pragma unroll
                for (int m = 0; m < 4; ++m) { const int row = row0 + ai * HALF + m * 16; float* p = FG + (size_t)row * 32 + 8 * fq;
                    *(f32x4*)p = acc[ai][0][m][0]; *(f32x4*)(p + 4) = acc[ai][0][m][1];
                    if (fq == 0) { const int b = row >> 12, s = row & 4095;
#pragma unroll
                        for (int n = 0; n < 2; ++n)
#pragma unroll
                            for (int i = 0; i < 4; ++i) { const int h = 4 * n + i; LF[(size_t)(b * 8 + h) * nv::S + s] = 1.4426950408889634f * nv::logsigmoidf(acc[ai][0][m][n][i] + bfg[h]); } } }
        }
    }
};
}
namespace gl {
using namespace nv;
typedef unsigned short bf16;
typedef short bf16x8 __attribute__((ext_vector_type(8)));
typedef float f32x4 __attribute__((ext_vector_type(4)));
typedef unsigned u32x4 __attribute__((ext_vector_type(4)));
typedef unsigned u32x2 __attribute__((ext_vector_type(2)));
constexpr int NCH = S / 64;
constexpr int NUNIT = B * GH * NCH;
constexpr int LS = 72;
constexpr int L_WGU = 0, L_BG = 4096, L_QP = 8192, L_KP = L_QP + 64 * LS * 2, L_KPT = L_KP + 64 * LS * 2, L_VT = L_KPT + 64 * LS * 2, L_PP = L_VT + 128 * LS * 2, L_WT = L_PP + 64 * LS * 2, L_END = L_WT + 2048;
static_assert(L_END <= 131072, "gla prep LDS");
constexpr int C_ST = 0, C_PART = 128 * LS * 2, C_END = C_PART + 2 * 8 * 64 * 4;
constexpr size_t QPG_B = 64 * 64 * 2, OI_B = 8 * 4 * 64 * 16, UU_B = OI_B, DEC_B = 256;

__device__ __forceinline__ unsigned pkbf(float lo, float hi) { typedef float f2 __attribute__((ext_vector_type(2))); typedef __bf16 b2 __attribute__((ext_vector_type(2))); f2 v = {lo, hi}; b2 r = __builtin_convertvector(v, b2); return __builtin_bit_cast(unsigned, r); }
__device__ __forceinline__ float bf2f(unsigned short h) { return __builtin_bit_cast(float, (unsigned)h << 16); }
__device__ __forceinline__ float bflo(unsigned w) { return __builtin_bit_cast(float, w << 16); }
__device__ __forceinline__ float bfhi(unsigned w) { return __builtin_bit_cast(float, w & 0xffff0000u); }

__device__ __forceinline__ void prep_unit(int unit, const bf16* QKV, const float* FG, const float* __restrict__ wgu, const float* __restrict__ bgate,
                                          unsigned char* QPG, unsigned char* OI, unsigned char* UU, float* DEC, unsigned char* lds, int& cur_h) {
    int tid_ = threadIdx.x; asm volatile("" : "+v"(tid_));
    const int tid = tid_, lane = tid & 63, wid = __builtin_amdgcn_readfirstlane(tid >> 6), l15 = lane & 15, g = lane >> 4;
    const int n = unit % NCH, bh = unit / NCH, h = bh % GH, b = bh / GH;
    const size_t row0 = (size_t)b * S + (size_t)n * 64;
    float* WGU = (float*)(lds + L_WGU); float* BG = (float*)(lds + L_BG); float* WT = (float*)(lds + L_WT);
    bf16* QP = (bf16*)(lds + L_QP); bf16* KP = (bf16*)(lds + L_KP); bf16* KPT = (bf16*)(lds + L_KPT); bf16* VT = (bf16*)(lds + L_VT); bf16* PP = (bf16*)(lds + L_PP);
    if (cur_h != h) { __syncthreads(); for (int i = tid; i < 16 * 64; i += 512) WGU[i] = wgu[(i >> 6) * 256 + h * 64 + (i & 63)]; if (tid < 64) BG[tid] = bgate[h * 64 + tid]; cur_h = h; __syncthreads(); }
    const int t = tid >> 3, oc = tid & 7, d0 = oc * 8;
    float la[8];
    { const float* gp = FG + (row0 + t) * 32 + 8;
      f32x4 ga4[4];
#pragma unroll
      for (int i = 0; i < 4; ++i) ga4[i] = *(const f32x4*)(gp + 4 * i);
#pragma unroll
      for (int j = 0; j < 8; ++j) la[j] = BG[d0 + j];
#pragma unroll
      for (int r = 0; r < 16; ++r) { const float gv = ga4[r >> 2][r & 3]; const f32x4 w0 = *(const f32x4*)(WGU + r * 64 + d0), w1 = *(const f32x4*)(WGU + r * 64 + d0 + 4);
#pragma unroll
          for (int j = 0; j < 4; ++j) { la[j] += gv * w0[j]; la[4 + j] += gv * w1[j]; } }
#pragma unroll
      for (int j = 0; j < 8; ++j) la[j] = logsigmoidf(la[j]) * (1.f / 16.f); }
    const u32x4 qv = *(const u32x4*)(QKV + (row0 + t) * fx::QKVP + fx::P_GQ + h * 64 + d0);
    const u32x4 kv = *(const u32x4*)(QKV + (row0 + t) * fx::QKVP + fx::P_GK + h * 64 + d0);
    const u32x4 vv0 = *(const u32x4*)(QKV + (row0 + t) * fx::QKVP + fx::P_GV + h * 128 + oc * 16);
    const u32x4 vv1 = *(const u32x4*)(QKV + (row0 + t) * fx::QKVP + fx::P_GV + h * 128 + oc * 16 + 8);
#pragma unroll
    for (int off = 8; off < 64; off <<= 1) {
#pragma unroll
        for (int j = 0; j < 8; ++j) { const float o = __shfl_up(la[j], off); if (lane >= off) la[j] += o; } }
    if (lane >= 56) {
#pragma unroll
        for (int j = 0; j < 8; ++j) WT[wid * 64 + d0 + j] = la[j]; }
    __syncthreads();
    float bl[8];
#pragma unroll
    for (int j = 0; j < 8; ++j) bl[j] = 0.f;
#pragma unroll
    for (int w = 0; w < 8; ++w) {
        const f32x4 a0 = *(const f32x4*)(WT + w * 64 + d0), a1 = *(const f32x4*)(WT + w * 64 + d0 + 4);
#pragma unroll
        for (int j = 0; j < 4; ++j) { bl[j] += a0[j]; bl[4 + j] += a1[j]; if (w < wid) { la[j] += a0[j]; la[4 + j] += a1[j]; } } }
    {
        const unsigned qw[4] = {qv.x, qv.y, qv.z, qv.w}, kw[4] = {kv.x, kv.y, kv.z, kv.w};
        float qf[8], kf[8];
#pragma unroll
        for (int i = 0; i < 4; ++i) { qf[2 * i] = bflo(qw[i]); qf[2 * i + 1] = bfhi(qw[i]); kf[2 * i] = bflo(kw[i]); kf[2 * i + 1] = bfhi(kw[i]); }
        float qp[8], kp[8], kpp[8];
#pragma unroll
        for (int j = 0; j < 8; ++j) { const float bb = la[j] * 1.4426950408889634f, bbl = bl[j] * 1.4426950408889634f;
            qp[j] = qf[j] * (0.125f * exp2f(bb)); kp[j] = kf[j] * exp2f(-bb); kpp[j] = kf[j] * exp2f(bbl - bb); }
        u32x4 qo, ko; qo.x = pkbf(qp[0], qp[1]); qo.y = pkbf(qp[2], qp[3]); qo.z = pkbf(qp[4], qp[5]); qo.w = pkbf(qp[6], qp[7]);
        ko.x = pkbf(kp[0], kp[1]); ko.y = pkbf(kp[2], kp[3]); ko.z = pkbf(kp[4], kp[5]); ko.w = pkbf(kp[6], kp[7]);
        *(u32x4*)(QP + t * LS + d0) = qo; *(u32x4*)(KP + t * LS + d0) = ko;
        *(u32x4*)(QPG + (size_t)unit * QPG_B + (size_t)(t * 64 + d0) * 2) = qo;
#pragma unroll
        for (int j = 0; j < 8; ++j) KPT[(d0 + j) * LS + t] = (bf16)(pkbf(kpp[j], 0.f) & 0xffffu);
        const unsigned vw[8] = {vv0.x, vv0.y, vv0.z, vv0.w, vv1.x, vv1.y, vv1.z, vv1.w};
#pragma unroll
        for (int i = 0; i < 8; ++i) { VT[(oc * 16 + 2 * i) * LS + t] = (bf16)(vw[i] & 0xffffu); VT[(oc * 16 + 2 * i + 1) * LS + t] = (bf16)(vw[i] >> 16); }
        if (t == 0) {
#pragma unroll
            for (int j = 0; j < 8; ++j) DEC[(size_t)unit * 64 + d0 + j] = exp2f(bl[j] * 1.4426950408889634f); }
    }
    __syncthreads();
    { const int ti = wid >> 1;
#pragma unroll
      for (int q2 = 0; q2 < 2; ++q2) { const int sj = 2 * (wid & 1) + q2;
          f32x4 acc = {0.f, 0.f, 0.f, 0.f};
          if (sj <= ti) {
#pragma unroll
              for (int ks = 0; ks < 2; ++ks) { const bf16x8 a = *(const bf16x8*)(QP + (16 * ti + l15) * LS + 32 * ks + 8 * g), bb = *(const bf16x8*)(KP + (16 * sj + l15) * LS + 32 * ks + 8 * g);
                  acc = __builtin_amdgcn_mfma_f32_16x16x32_bf16(a, bb, acc, 0, 0, 0); }
              if (sj == ti) {
#pragma unroll
                  for (int r = 0; r < 4; ++r) if (l15 > 4 * g + r) acc[r] = 0.f; }
          }
#pragma unroll
          for (int r = 0; r < 4; ++r) PP[(16 * ti + 4 * g + r) * LS + 16 * sj + l15] = (bf16)(pkbf(acc[r], 0.f) & 0xffffu);
      } }
    __syncthreads();
    { bf16x8 vb[2];
#pragma unroll
      for (int ks = 0; ks < 2; ++ks) vb[ks] = *(const bf16x8*)(VT + (16 * wid + l15) * LS + 32 * ks + 8 * g);
#pragma unroll
      for (int m = 0; m < 4; ++m) { f32x4 acc = {0.f, 0.f, 0.f, 0.f};
#pragma unroll
          for (int ks = 0; ks < 2; ++ks) { const bf16x8 a = *(const bf16x8*)(PP + (16 * m + l15) * LS + 32 * ks + 8 * g); acc = __builtin_amdgcn_mfma_f32_16x16x32_bf16(a, vb[ks], acc, 0, 0, 0); }
          *(f32x4*)(OI + (size_t)unit * OI_B + (size_t)((wid * 4 + m) * 64 + lane) * 16) = acc; }
#pragma unroll
      for (int db = 0; db < 4; ++db) { f32x4 acc = {0.f, 0.f, 0.f, 0.f};
#pragma unroll
          for (int ks = 0; ks < 2; ++ks) { const bf16x8 a = *(const bf16x8*)(KPT + (16 * db + l15) * LS + 32 * ks + 8 * g); acc = __builtin_amdgcn_mfma_f32_16x16x32_bf16(a, vb[ks], acc, 0, 0, 0); }
          *(f32x4*)(UU + (size_t)unit * UU_B + (size_t)((wid * 4 + db) * 64 + lane) * 16) = acc; }
    }
}

constexpr size_t STG_B = 128 * 64 * 2;
__device__ __forceinline__ void scan_wave(int gwave, const unsigned char* UU, const float* DEC, unsigned char* STG, int lane) {
    const int bh = gwave >> 5, w = (gwave >> 2) & 7, db = gwave & 3, l15 = lane & 15, g = lane >> 4;
    f32x4 Sv = {0.f, 0.f, 0.f, 0.f};
    const size_t u0 = (size_t)bh * NCH;
    for (int n0 = 0; n0 < NCH; n0 += 8) {
        f32x4 Uf[8], dv[8];
#pragma unroll
        for (int j = 0; j < 8; ++j) { const size_t unit = u0 + n0 + j;
            Uf[j] = *(const f32x4*)(UU + unit * UU_B + (size_t)((w * 4 + db) * 64 + lane) * 16);
            dv[j] = *(const f32x4*)(DEC + unit * 64 + 16 * db + 4 * g); }
#pragma unroll
        for (int j = 0; j < 8; ++j) { const size_t unit = u0 + n0 + j;
            *(u32x2*)(STG + unit * STG_B + (size_t)((16 * w + l15) * 64 + 16 * db + 4 * g) * 2) = (u32x2){pkbf(Sv[0], Sv[1]), pkbf(Sv[2], Sv[3])};
            Sv = dv[j] * Sv + Uf[j]; }
    }
}

constexpr int GS = 136;
constexpr int PO_GR = 0, PO_YT = 64 * GS * 2, PO_PART = 2 * 64 * GS * 2, PO_END = PO_PART + 8 * 64 * 4;
__device__ __forceinline__ void post_unit(int unit, const bf16* QKV, const unsigned char* QPG, const unsigned char* OI, const unsigned char* STG, const float* __restrict__ gnorm, bf16* Y, unsigned char* lds) {
    int tid_ = threadIdx.x; asm volatile("" : "+v"(tid_));
    const int tid = tid_, lane = tid & 63, wid = __builtin_amdgcn_readfirstlane(tid >> 6), l15 = lane & 15, g = lane >> 4;
    const int n = unit % NCH, bh = unit / NCH, h = bh % GH, b = bh / GH;
    const size_t row0 = (size_t)b * S + (size_t)n * 64;
    bf16* GRs = (bf16*)(lds + PO_GR); bf16* YT = (bf16*)(lds + PO_YT); float* PART = (float*)(lds + PO_PART);
    const int t = tid >> 3, oc = tid & 7, e = 16 * wid + l15;
    const u32x4 g0 = *(const u32x4*)(QKV + (row0 + t) * fx::QKVP + fx::P_GR + h * 128 + oc * 16), g1 = *(const u32x4*)(QKV + (row0 + t) * fx::QKVP + fx::P_GR + h * 128 + oc * 16 + 8);
    f32x4 o[4]; bf16x8 qa[4][2], sb[2];
#pragma unroll
    for (int m = 0; m < 4; ++m) { o[m] = *(const f32x4*)(OI + (size_t)unit * OI_B + (size_t)((wid * 4 + m) * 64 + lane) * 16);
#pragma unroll
        for (int ks = 0; ks < 2; ++ks) qa[m][ks] = *(const bf16x8*)(QPG + (size_t)unit * QPG_B + (size_t)((16 * m + l15) * 64 + 32 * ks + 8 * g) * 2); }
#pragma unroll
    for (int ks = 0; ks < 2; ++ks) sb[ks] = *(const bf16x8*)(STG + (size_t)unit * STG_B + (size_t)(e * 64 + 32 * ks + 8 * g) * 2);
    const float gn = gnorm[e];
    *(u32x4*)(GRs + t * GS + oc * 16) = g0; *(u32x4*)(GRs + t * GS + oc * 16 + 8) = g1;
#pragma unroll
    for (int m = 0; m < 4; ++m)
#pragma unroll
        for (int ks = 0; ks < 2; ++ks) o[m] = __builtin_amdgcn_mfma_f32_16x16x32_bf16(qa[m][ks], sb[ks], o[m], 0, 0, 0);
#pragma unroll
    for (int m = 0; m < 4; ++m) { f32x4 q = o[m] * o[m];
#pragma unroll
        for (int off = 1; off < 16; off <<= 1) { q[0] += __shfl_xor(q[0], off); q[1] += __shfl_xor(q[1], off); q[2] += __shfl_xor(q[2], off); q[3] += __shfl_xor(q[3], off); }
        if (l15 == 0) *(f32x4*)(PART + wid * 64 + 16 * m + 4 * g) = q; }
    __syncthreads();
#pragma unroll
    for (int m = 0; m < 4; ++m) { f32x4 tot = {0.f, 0.f, 0.f, 0.f};
#pragma unroll
        for (int w = 0; w < 8; ++w) tot += *(const f32x4*)(PART + w * 64 + 16 * m + 4 * g);
#pragma unroll
        for (int r = 0; r < 4; ++r) { const int tt = 16 * m + 4 * g + r; const float rs = rsqrtf(tot[r] * (1.f / GV) + LN_EPS); const float gr = bf2f(GRs[tt * GS + e]);
            const float v = o[m][r] * rs * gn * (gr / (1.f + __expf(-gr)));
            YT[tt * GS + e] = (bf16)(pkbf(v, 0.f) & 0xffffu); } }
    __syncthreads();
    { const u32x4 y0 = *(const u32x4*)(YT + t * GS + oc * 16), y1 = *(const u32x4*)(YT + t * GS + oc * 16 + 8);
      *(u32x4*)(Y + (row0 + t) * D + 512 + h * GV + oc * 16) = y0; *(u32x4*)(Y + (row0 + t) * D + 512 + h * GV + oc * 16 + 8) = y1; }
    __syncthreads();
}
}
namespace mo {
using namespace nv;
typedef unsigned short bf16;
typedef float f32x4 __attribute__((ext_vector_type(4)));
typedef unsigned u32x4 __attribute__((ext_vector_type(4)));
constexpr int CAP = 8192;
constexpr int NEX = NE + 1;
constexpr int YSH = T * TOPK;
constexpr int L_TB = 132096, L_YB = L_TB + 1040;

__device__ __forceinline__ void moe_tables(const int* counts, int* tb, int* yb, int lane) {
    int c[4], nt[4]; int st = 0, sy = 0, pt[4], py[4];
#pragma unroll
    for (int i = 0; i < 4; ++i) { c[i] = counts[lane * 4 + i]; c[i] = c[i] > CAP ? CAP : c[i]; nt[i] = (c[i] + 255) >> 8; pt[i] = st; py[i] = sy; st += nt[i]; sy += c[i]; }
    int it = st, iy = sy;
    for (int o = 1; o < 64; o <<= 1) { const int a = __shfl_up(it, o), b = __shfl_up(iy, o); if (lane >= o) { it += a; iy += b; } }
    const int bt = it - st, by = iy - sy;
#pragma unroll
    for (int i = 0; i < 4; ++i) { tb[lane * 4 + i] = bt + pt[i]; yb[lane * 4 + i] = by + py[i]; }
    if (lane == 63) { tb[256] = it; tb[257] = it + T / 256; yb[256] = YSH; }
}

__device__ __forceinline__ void route_token(const float* LG, const float* __restrict__ rbias, int* lcnt, int* TK, float* TW, int t, int lane) {
    const float4 l0 = ((const float4*)(LG + (size_t)t * NE))[lane], l1 = ((const float4*)(LG + (size_t)(T + t) * NE))[lane];
    const float4 rb = ((const float4*)rbias)[lane];
    float sc[4] = {1.f / (1.f + expf(-(l0.x + l1.x))), 1.f / (1.f + expf(-(l0.y + l1.y))), 1.f / (1.f + expf(-(l0.z + l1.z))), 1.f / (1.f + expf(-(l0.w + l1.w)))};
    float bv[4] = {sc[0] + rb.x, sc[1] + rb.y, sc[2] + rb.z, sc[3] + rb.w};
    float m1 = fmaxf(bv[0], bv[1]), m2 = fminf(bv[0], bv[1]);
    { const float a = fmaxf(bv[2], bv[3]), c = fminf(bv[2], bv[3]); const float n1 = fmaxf(m1, a); m2 = fmaxf(fminf(m1, a), fmaxf(m2, c)); m1 = n1; }
    for (int o = 1; o < 8; o <<= 1) { const float p1 = __shfl_xor(m1, o), p2 = __shfl_xor(m2, o); const float n1 = fmaxf(m1, p1); m2 = fmaxf(fminf(m1, p1), fmaxf(m2, p2)); m1 = n1; }
    const float gs = m1 + m2;
    const int myg = lane >> 3;
    int rank = 0;
#pragma unroll
    for (int g2 = 0; g2 < NG; ++g2) { const float og = __shfl(gs, g2 * 8); if (og > gs || (og == gs && g2 < myg)) ++rank; }
    const bool sel = rank < 4;
    float mv[4];
#pragma unroll
    for (int i = 0; i < 4; ++i) mv[i] = sel ? bv[i] : -INFINITY;
    int mye = 0; float myw = 0.f; float wsum = 0.f;
#pragma unroll
    for (int k = 0; k < TOPK; ++k) {
        float bvv = mv[0]; int bi = 0;
#pragma unroll
        for (int i = 1; i < 4; ++i) if (mv[i] > bvv) { bvv = mv[i]; bi = i; }
        int gi = lane * 4 + bi;
        for (int o = 32; o > 0; o >>= 1) { const float ov = __shfl_xor(bvv, o); const int oi = __shfl_xor(gi, o); if (ov > bvv || (ov == bvv && oi < gi)) { bvv = ov; gi = oi; } }
        const int ol = gi >> 2, oi = gi & 3;
        const float s_own = (oi == 0) ? sc[0] : (oi == 1) ? sc[1] : (oi == 2) ? sc[2] : sc[3];
        const float sw = __shfl(s_own, ol);
        if (lane == ol) { if (oi == 0) mv[0] = -INFINITY; else if (oi == 1) mv[1] = -INFINITY; else if (oi == 2) mv[2] = -INFINITY; else mv[3] = -INFINITY; }
        if (lane == k) { mye = gi; myw = sw; } wsum += sw;
    }
    if (lane < TOPK) { const int lp = atomicAdd(&lcnt[mye], 1); TK[t * TOPK + lane] = mye | (lp << 9); TW[t * TOPK + lane] = myw * (2.5f / wsum); }
}
__device__ __forceinline__ void route_finish(const int* lbase, int* list_tok, float* list_gate, int* TK, const float* TW, int t, int lane) {
    if (lane < TOPK) { const int tk = TK[t * TOPK + lane]; const int e = tk & 511, pos = lbase[e] + (tk >> 9);
        if (pos < CAP) { list_tok[e * CAP + pos] = t; list_gate[e * CAP + pos] = TW[t * TOPK + lane]; }
        TK[t * TOPK + lane] = e | (pos << 9); }
}

__device__ __forceinline__ void combine_token(const bf16* H1, const bf16* Y, const int* TK, const int* yb, const float* __restrict__ g, const float* __restrict__ b, float* out, int t, int lane) {
    float v[16];
    { const u32x4 a = *(const u32x4*)(H1 + (size_t)t * D + 16 * lane), c = *(const u32x4*)(H1 + (size_t)t * D + 16 * lane + 8);
      const unsigned w[8] = {a.x, a.y, a.z, a.w, c.x, c.y, c.z, c.w};
#pragma unroll
      for (int i = 0; i < 8; ++i) { v[2 * i] = ALPHA * __builtin_bit_cast(float, w[i] << 16); v[2 * i + 1] = ALPHA * __builtin_bit_cast(float, w[i] & 0xffff0000u); } }
    int tk = (lane < TOPK) ? TK[t * TOPK + lane] : 0;
#pragma unroll
    for (int k = 0; k <= TOPK; ++k) {
        size_t yrow;
        if (k < TOPK) { const int x = __shfl(tk, k); yrow = (size_t)(yb[x & 511] + (x >> 9)); } else yrow = (size_t)YSH + t;
        const u32x4 a = *(const u32x4*)(Y + yrow * D + 16 * lane), c = *(const u32x4*)(Y + yrow * D + 16 * lane + 8);
        const unsigned w[8] = {a.x, a.y, a.z, a.w, c.x, c.y, c.z, c.w};
#pragma unroll
        for (int i = 0; i < 8; ++i) { v[2 * i] += __builtin_bit_cast(float, w[i] << 16); v[2 * i + 1] += __builtin_bit_cast(float, w[i] & 0xffff0000u); }
    }
    float s = 0.f;
#pragma unroll
    for (int i = 0; i < 16; ++i) s += v[i];
    const float mean = fx::wave_sum(s) * (1.f / D); float q = 0.f;
#pragma unroll
    for (int i = 0; i < 16; ++i) { v[i] -= mean; q += v[i] * v[i]; }
    const float rstd = 1.f / sqrtf(fx::wave_sum(q) * (1.f / D) + LN_EPS);
#pragma unroll
    for (int i = 0; i < 4; ++i) { const f32x4 gg = *(const f32x4*)(g + 16 * lane + 4 * i), bb = *(const f32x4*)(b + 16 * lane + 4 * i);
        f32x4 o; o[0] = v[4 * i] * rstd * gg[0] + bb[0]; o[1] = v[4 * i + 1] * rstd * gg[1] + bb[1]; o[2] = v[4 * i + 2] * rstd * gg[2] + bb[2]; o[3] = v[4 * i + 3] * rstd * gg[3] + bb[3];
        *(f32x4*)(out + (size_t)t * D + 16 * lane + 4 * i) = o; }
}
}

namespace pg8 {
struct RouterSched {
    int G, vcu; const bf16_t* Bt;
    __device__ __forceinline__ bool next(int i, Unit2& u) const { const int L = i * G + vcu; if (L >= 2 * (nv::T / BM)) return false; u.pm = L >> 1; u.pn = L & 1; u.e = 0; u.cnt = 256; u.jt = 0; return true; }
    __device__ __forceinline__ int arow(const Unit2& u, int r) const { return u.pm * BM + r; }
    __device__ __forceinline__ size_t aoff(const Unit2& u) const { return (size_t)u.pn * 1024; }
    __device__ __forceinline__ const char* bptr(const Unit2& u) const { return (const char*)(Bt + u.pn * 512); }
};
struct EpiLogits {
    static constexpr bool PERM = false, AFTER_DRAIN = false;
    float* LG;
    __device__ __forceinline__ void operator()(const f32x4 (&acc)[2][2][4][2], const Unit2& u, int wr, int wc, int fr, int fq) const {
        const int row0 = u.pm * BM + wr * 64 + fr, col0 = wc * 32 + 4 * fq; float* base = LG + (size_t)u.pn * nv::T * nv::NE;
#pragma unroll
        for (int ai = 0; ai < 2; ++ai)
#pragma unroll
            for (int m = 0; m < 4; ++m) { float* rowp = base + (size_t)(row0 + ai * HALF + m * 16) * nv::NE + col0;
#pragma unroll
                for (int bj = 0; bj < 2; ++bj)
#pragma unroll
                    for (int n = 0; n < 2; ++n) *(f32x4*)(rowp + bj * HALF + n * 16) = acc[ai][bj][m][n]; }
    }
};
template <int PH> struct MoeSched {
    int G, vcu, nrt; const int* tb; const int* counts; const int* list_tok; const bf16_t* W;
    static constexpr int NC = PH == 0 ? 2 : 4;
    __device__ __forceinline__ bool next(int i, Unit2& u) const {
        const int L = i * G + vcu; if (L >= nrt * NC) return false;
        const int rt = L / NC, c = L % NC;
        int lo = 0, hi = 256;
        while (lo < hi) { const int mid = (lo + hi + 1) >> 1; if (tb[mid] <= rt) lo = mid; else hi = mid - 1; }
        const int e = lo, jt = rt - tb[e]; int total = nv::T; if (e < 256) { total = counts[e]; total = total > mo::CAP ? mo::CAP : total; }
        const int rem = total - 256 * jt;
        u.pm = rt; u.pn = c; u.e = __builtin_amdgcn_readfirstlane(e); u.jt = __builtin_amdgcn_readfirstlane(jt); u.cnt = __builtin_amdgcn_readfirstlane(rem < 256 ? rem : 256); return true;
    }
    __device__ __forceinline__ int arow(const Unit2& u, int r) const {
        if (PH == 1) return u.pm * BM + r;
        if (u.e == 256) return u.jt * BM + r;
        return (r < u.cnt) ? list_tok[u.e * mo::CAP + u.jt * BM + r] : 0;
    }
    __device__ __forceinline__ size_t aoff(const Unit2&) const { return 0; }
    __device__ __forceinline__ const char* bptr(const Unit2& u) const {
        return PH == 0 ? (const char*)(W + ((size_t)u.e * 512 + 256 * u.pn) * 1024) : (const char*)(W + ((size_t)u.e * 1024 + 256 * u.pn) * 256);
    }
};
struct EpiSwiGLU {
    static constexpr bool PERM = true, AFTER_DRAIN = false;
    bf16_t* H; const float* list_gate;
    __device__ __forceinline__ void operator()(const f32x4 (&acc)[2][2][4][2], const Unit2& u, int wr, int wc, int fr, int fq) const {
        const int col0 = u.pn * 128 + wc * 32 + 8 * fq;
#pragma unroll
        for (int ai = 0; ai < 2; ++ai)
#pragma unroll
            for (int m = 0; m < 4; ++m) { const int r = ai * HALF + wr * 64 + m * 16 + fr;
                float gt = 1.f; if (u.e < 256) gt = (r < u.cnt) ? list_gate[u.e * mo::CAP + u.jt * BM + r] : 0.f;
                float hv[8];
#pragma unroll
                for (int n = 0; n < 2; ++n)
#pragma unroll
                    for (int i = 0; i < 4; ++i) { const float gg = acc[ai][0][m][n][i], uu = acc[ai][1][m][n][i]; hv[4 * n + i] = gt * uu * (gg / (1.f + __expf(-gg))); }
                u32x4 w; w.x = cvt_pk_bf16(hv[0], hv[1]); w.y = cvt_pk_bf16(hv[2], hv[3]); w.z = cvt_pk_bf16(hv[4], hv[5]); w.w = cvt_pk_bf16(hv[6], hv[7]);
                *(u32x4*)(H + (size_t)(u.pm * BM + r) * 256 + col0) = w; }
    }
};
struct EpiDown {
    static constexpr bool PERM = true, AFTER_DRAIN = false;
    bf16_t* Y; const int* yb;
    __device__ __forceinline__ void operator()(const f32x4 (&acc)[2][2][4][2], const Unit2& u, int wr, int wc, int fr, int fq) const {
        const int col0 = u.pn * BM + wc * 32 + 8 * fq; const int ybase = yb[u.e] + u.jt * BM;
#pragma unroll
        for (int ai = 0; ai < 2; ++ai)
#pragma unroll
            for (int m = 0; m < 4; ++m) { const int r = ai * HALF + wr * 64 + m * 16 + fr;
                if (r < u.cnt) { bf16_t* rowp = Y + (size_t)(ybase + r) * nv::D + col0;
#pragma unroll
                    for (int bj = 0; bj < 2; ++bj) { const f32x4 v0 = acc[ai][bj][m][0], v1 = acc[ai][bj][m][1];
                        u32x4 w; w.x = cvt_pk_bf16(v0[0], v0[1]); w.y = cvt_pk_bf16(v0[2], v0[3]); w.z = cvt_pk_bf16(v1[0], v1[1]); w.w = cvt_pk_bf16(v1[2], v1[3]);
                        *(u32x4*)(rowp + bj * HALF) = w; } } }
    }
};
}
constexpr int NTHR = 512;
constexpr int LDS_BYTES = 147456;
constexpr int MISC_OFF = 131072 + 320;
constexpr size_t MiB = 1u << 20;
constexpr size_t CTL_ZERO_BYTES = 1 * MiB;
constexpr int CW_BAR = 4096;
constexpr int CW_MOE = 16384;
constexpr int NPHASE = 12;
constexpr size_t WS_H1 = 1, WS_WR = 65, WS_STATS = 66, WS_LF = 67, WS_FG = 68, WS_WO = 72, WS_WIN = 74, WS_TK = 81, WS_LTOK = 83, WS_LGATE = 91,
                 WS_WED = 100, WS_HID = 230, WS_GLA = 230, WS_WEG = 416, WS_XN = 673, WS_YBF = 673, WS_QKV = 737, WS_Z1 = 737, WS_LG = 865, WS_Y = 416, WS_END = 992;

struct Args { const float* in[21]; float* out; unsigned char* ws; int ph_lo, ph_hi, li, pad; };

__global__ void __launch_bounds__(NTHR, 2) mega_fwd(Args a) {
    using namespace nv;
    extern __shared__ __attribute__((aligned(16))) unsigned char lds[];
    const int G = gridDim.x, bx = blockIdx.x;
    const int vcu = (G % 8 == 0) ? (bx % 8) * (G / 8) + bx / 8 : bx;
    int tid, lane, wave, vw;
#define DERIVE() do { int t_ = threadIdx.x; asm volatile("" : "+v"(t_)); tid = t_; lane = tid & 63; wave = __builtin_amdgcn_readfirstlane(tid >> 6); vw = vcu * 8 + wave; } while (0)
    DERIVE();
    volatile LAS unsigned* MISC = (volatile LAS unsigned*)((LAS unsigned char*)lds + MISC_OFF);
    for (int u = tid; u < (LDS_BYTES - 131072) / 4; u += NTHR) ((LAS unsigned*)((LAS unsigned char*)lds + 131072))[u] = 0u;
    __syncthreads();
    unsigned char* ws = a.ws;
    unsigned* ctl = (unsigned*)ws;
    XcdBarrier bar = xcd_barrier_post(ctl + CW_BAR + a.li * XCD_BAR_WORDS, MISC + 8);
    const float* x = a.in[0];
    const float* ln_in_g = a.in[1]; const float* ln_in_b = a.in[2];
    const float* w_in = a.in[3]; const float* b_fgate = a.in[4];
    const float* w_gate_up = a.in[5]; const float* b_gate = a.in[6]; const float* g_gla = a.in[7];
    const float* w_out = a.in[8]; const float* ln1_g = a.in[9]; const float* ln1_b = a.in[10];
    const float* w_router = a.in[11]; const float* rbias = a.in[12];
    const float* w_eg = a.in[13]; const float* w_eu = a.in[14]; const float* w_ed = a.in[15];
    const float* w_sg = a.in[16]; const float* w_su = a.in[17]; const float* w_sd = a.in[18];
    const float* ln2_g = a.in[19]; const float* ln2_b = a.in[20];
    float* out = a.out;
    int* counts = (int*)(ctl + CW_MOE);
    fx::bf16* H1 = (fx::bf16*)(ws + WS_H1 * MiB);
    fx::bf16* WrT = (fx::bf16*)(ws + WS_WR * MiB);
    float* stats = (float*)(ws + WS_STATS * MiB);
    float* LF = (float*)(ws + WS_LF * MiB);
    float* FG = (float*)(ws + WS_FG * MiB);
    fx::bf16* WoT = (fx::bf16*)(ws + WS_WO * MiB);
    fx::bf16* WinT = (fx::bf16*)(ws + WS_WIN * MiB);
    int* TK = (int*)(ws + WS_TK * MiB);
    float* TW = (float*)(ws + (WS_TK + 1) * MiB);
    int* list_tok = (int*)(ws + WS_LTOK * MiB);
    float* list_gate = (float*)(ws + WS_LGATE * MiB);
    fx::bf16* WedT = (fx::bf16*)(ws + WS_WED * MiB);
    fx::bf16* HID = (fx::bf16*)(ws + WS_HID * MiB);
    unsigned char* QPG = ws + WS_GLA * MiB; unsigned char* OIb = ws + (WS_GLA + 16) * MiB; unsigned char* UUb = ws + (WS_GLA + 80) * MiB; float* DECb = (float*)(ws + (WS_GLA + 144) * MiB); unsigned char* STGb = ws + (WS_GLA + 145) * MiB;
    fx::bf16* WegT = (fx::bf16*)(ws + WS_WEG * MiB);
    fx::bf16* XN = (fx::bf16*)(ws + WS_XN * MiB);
    fx::bf16* Ybf = (fx::bf16*)(ws + WS_YBF * MiB);
    fx::bf16* QKV = (fx::bf16*)(ws + WS_QKV * MiB);
    float* z1 = (float*)(ws + WS_Z1 * MiB);
    float* LG = (float*)(ws + WS_LG * MiB);
    fx::bf16* YA = (fx::bf16*)(ws + WS_Y * MiB);
    int* tb = (int*)(lds + mo::L_TB); int* yb = (int*)(lds + mo::L_YB);

    const int lo = a.ph_lo, hi = a.ph_hi;
#define IN(k) (lo <= (k) && (k) < hi)
#define SEAM(k) do { if (IN(k) && IN((k) + 1)) xcd_barrier(bar); DERIVE(); } while (0)
    const int GW = G * 8;

    if (IN(0)) {
        LAS float* scr = (LAS float*)((LAS unsigned char*)lds + wave * 16384);
        constexpr int I_IN = 16 * (fx::NIN / 32), I_OUT = 16 * 32, I_R = 16 * 8, I_EG = mo::NEX * 256, I_ED = mo::NEX * 128, I_ALL = I_IN + I_OUT + I_R + I_EG + I_ED;
        for (int it = vw; it < I_ALL; it += GW) {
            int r = it;
            if (r < I_IN) { fx::transpose_item(w_in, D, INW, WinT, scr, r / (fx::NIN / 32), r % (fx::NIN / 32), lane, [](int d) { return fx::inproj_src(d); }); continue; } r -= I_IN;
            if (r < I_OUT) { fx::transpose_item(w_out, D, D, WoT, scr, r / 32, r % 32, lane, [](int d) { return d; }); continue; } r -= I_OUT;
            if (r < I_R) { fx::transpose_item(w_router, D, NE, WrT, scr, r / 8, r % 8, lane, [](int d) { return d; }); continue; } r -= I_R;
            if (r < I_EG) { const int e = r >> 8, kb = (r >> 4) & 15, nb = r & 15, c = nb >> 3, sub = nb & 7;
                const float* W = (e < NE) ? ((sub < 4 ? w_eg : w_eu) + (size_t)e * D * ED) : (sub < 4 ? w_sg : w_su);
                const int cb = 128 * c + 32 * (sub & 3);
                fx::transpose_item(W, D, ED, WegT + (size_t)e * 512 * D, scr, kb, nb, lane, [cb](int d) { return cb + (d & 31); }); continue; } r -= I_EG;
            { const int e = r >> 7, kb = (r >> 5) & 3, nb = r & 31;
              const float* W = (e < NE) ? (w_ed + (size_t)e * ED * D) : w_sd;
              fx::transpose_item(W, ED, D, WedT + (size_t)e * D * ED, scr, kb, nb, lane, [](int d) { return d; }); }
        }
        for (int r = vw; r < T; r += GW) fx::ln_row_bf16(x + (size_t)r * D, ln_in_g, ln_in_b, XN + (size_t)r * D, nullptr, stats + 2 * (size_t)r, lane);
    }
    SEAM(0);
    if (IN(1)) {
        pg8::Gemm g{XN, WinT, T, fx::NIN, D, D}; pg8::StaticOrder S; S.init(T, fx::NIN, G, bx);
        pg8::EpiInProj E{QKV, FG, LF, b_fgate};
        pg8::gemm_phase<pg8::EpiInProj, pg8::StaticOrder, true, true>((LAS unsigned char*)lds, g, S, E);
    }
    SEAM(1);
    if (IN(2)) {
        int cur_h = -1;
        if (gl::NUNIT % G == 0) { const int per = gl::NUNIT / G; for (int i = 0; i < per; ++i) gl::prep_unit(vcu * per + i, QKV, FG, w_gate_up, b_gate, QPG, OIb, UUb, DECb, lds, cur_h); }
        else for (int u = vcu; u < gl::NUNIT; u += G) gl::prep_unit(u, QKV, FG, w_gate_up, b_gate, QPG, OIb, UUb, DECb, lds, cur_h);
    }
    SEAM(2);
    if (IN(3)) {
        if (bx < 128) gl::scan_wave(bx * 8 + wave, UUb, DECb, STGb, lane);
    }
    SEAM(3);
    if (IN(4)) {
        if (gl::NUNIT % G == 0) { const int per = gl::NUNIT / G; for (int i = 0; i < per; ++i) gl::post_unit(vcu * per + i, QKV, QPG, OIb, STGb, g_gla, Ybf, lds); }
        else for (int u = vcu; u < gl::NUNIT; u += G) gl::post_unit(u, QKV, QPG, OIb, STGb, g_gla, Ybf, lds);
        { const attn_body::AttnTensors AT{(const attn_body::bf16*)(QKV + fx::P_FQ), (const attn_body::bf16*)(QKV + fx::P_FK), (const attn_body::bf16*)(QKV + fx::P_FV), (attn_body::bf16*)Ybf, LF};
          const attn_body::StaticOrder SO(G, bx);
          attn_body::attn_phase<attn_body::StaticOrder>((char*)lds, AT, SO); }
    }
    SEAM(4);
    if (IN(5)) {
        pg8::DenseSched DS; DS.so.init(T, D, G, bx); DS.Bt = WoT; DS.ldb = D;
        pg8::EpiResid E{z1, D, x, stats, ln_in_g, ln_in_b, ALPHA};
        pg8::gemm_phase2<pg8::EpiResid, pg8::DenseSched>((LAS unsigned char*)lds, Ybf, D, D, D, DS, E);
    }
    SEAM(5);
    if (IN(6)) {
        for (int r = vw; r < T; r += GW) fx::ln_row_bf16(z1 + (size_t)r * D, ln1_g, ln1_b, H1 + (size_t)r * D, nullptr, nullptr, lane);
    }
    SEAM(6);
    if (IN(7)) {
        pg8::RouterSched RS{G, vcu, WrT}; pg8::EpiLogits E{LG};
        pg8::gemm_phase2<pg8::EpiLogits, pg8::RouterSched>((LAS unsigned char*)lds, H1, D, D, 512, RS, E);
    }
    SEAM(7);
    if (IN(8)) {
        int* lcnt = (int*)(lds + 4096); int* lbase = lcnt + 256;
        if (tid < 256) lcnt[tid] = 0;
        __syncthreads();
        for (int t = vw; t < T; t += GW) mo::route_token(LG, rbias, lcnt, TK, TW, t, lane);
        __syncthreads();
        if (tid < 256) { const int c = lcnt[tid]; lbase[tid] = c ? atomicAdd(&counts[tid], c) : 0; }
        __syncthreads();
        for (int t = vw; t < T; t += GW) mo::route_finish(lbase, list_tok, list_gate, TK, TW, t, lane);
    }
    SEAM(8);
    if (IN(9)) {
        if (wave == 0) mo::moe_tables(counts, tb, yb, lane);
        __syncthreads();
        pg8::MoeSched<0> MS{G, vcu, tb[257], tb, counts, list_tok, WegT}; pg8::EpiSwiGLU E{HID, list_gate};
        pg8::gemm_phase2<pg8::EpiSwiGLU, pg8::MoeSched<0>>((LAS unsigned char*)lds, H1, D, D, D, MS, E);
    }
    SEAM(9);
    if (IN(10)) {
        if (wave == 0) mo::moe_tables(counts, tb, yb, lane);
        __syncthreads();
        pg8::MoeSched<1> MS{G, vcu, tb[257], tb, counts, list_tok, WedT}; pg8::EpiDown E{YA, yb};
        pg8::gemm_phase2<pg8::EpiDown, pg8::MoeSched<1>>((LAS unsigned char*)lds, HID, ED, ED, ED, MS, E);
    }
    SEAM(10);
    if (IN(11)) {
        if (wave == 0) mo::moe_tables(counts, tb, yb, lane);
        __syncthreads();
        for (int t = vw; t < T; t += GW) mo::combine_token(H1, YA, TK, yb, ln2_g, ln2_b, out, t, lane);
    }
#undef IN
#undef SEAM
}

extern "C" void kernel_launch(void* const* d_in, const int* in_sizes, int n_in, void* d_out, int out_size, void* d_ws, size_t ws_size, hipStream_t stream) {
    static int grid = 0;
    if (grid == 0) {
        if (n_in != 21 || out_size != nv::T * nv::D || ws_size < WS_END * MiB) { fprintf(stderr, "kernel_launch: unexpected shapes n_in=%d out=%d ws=%zu\n", n_in, out_size, ws_size); grid = -1; return; }
        int dev = 0, cus = 0;
        if (hipGetDevice(&dev) != hipSuccess || hipDeviceGetAttribute(&cus, hipDeviceAttributeMultiprocessorCount, dev) != hipSuccess) { grid = -1; return; }
        if (hipFuncSetAttribute((const void*)mega_fwd, hipFuncAttributeMaxDynamicSharedMemorySize, LDS_BYTES) != hipSuccess) { fprintf(stderr, "kernel_launch: hipFuncSetAttribute failed\n"); grid = -1; return; }
        grid = cus;
    }
    if (grid < 0) return;
    if (hipMemsetAsync(d_ws, 0, CTL_ZERO_BYTES, stream) != hipSuccess) return;
    Args a{};
    for (int i = 0; i < 21; ++i) a.in[i] = (const float*)d_in[i];
    a.out = (float*)d_out; a.ws = (unsigned char*)d_ws; a.ph_lo = 0; a.ph_hi = NPHASE; a.li = 0;
#ifdef REPEAT_PH
    a.ph_hi = REPEAT_PH + 1; hipLaunchKernelGGL(mega_fwd, dim3(grid), dim3(NTHR), LDS_BYTES, stream, a);
    a.ph_lo = REPEAT_PH; a.ph_hi = NPHASE; a.li = 1;
#endif
    hipLaunchKernelGGL(mega_fwd, dim3(grid), dim3(NTHR), LDS_BYTES, stream, a);
}
```

```cpp
#include <hip/hip_runtime.h>
#include <cstdio>
#include <cstdint>
#include <cmath>

#define LAS __attribute__((address_space(3)))
#define GAS __attribute__((address_space(1)))

#define XB_TMO      128
#define XB_XCNT(j)  (256  + 64 * (j))
#define XB_XSUB(j)  (1280 + 64 * (j))
#define XB_XGEN(j)  (2304 + 64 * (j))
#define XB_TOP      3328
#define XB_TOPGEN   3392
#define XCD_BAR_WORDS 3456
#define XB_SPIN_CAP (1u << 27)
__device__ __forceinline__ unsigned xb_ld(unsigned* p)              { return __hip_atomic_load(p, __ATOMIC_RELAXED, __HIP_MEMORY_SCOPE_AGENT); }
__device__ __forceinline__ unsigned xb_add(unsigned* p, unsigned v) { return __hip_atomic_fetch_add(p, v, __ATOMIC_RELAXED, __HIP_MEMORY_SCOPE_AGENT); }
__device__ __forceinline__ unsigned xb_xcc_id() { return (unsigned)__builtin_amdgcn_s_getreg((3 << 11) | 20) & 0xFu; }
#define XB_SPIN(cond, bar) do { unsigned _sp = 0; while (cond) { __builtin_amdgcn_s_sleep(1); \
    if ((++_sp & 255u) == 0u) { if (xb_ld(&(bar)[XB_TMO])) break; if (_sp > XB_SPIN_CAP) { atomicAdd(&(bar)[XB_TMO], 1u); break; } } } } while (0)
struct XcdBarrier { unsigned* bar; unsigned x; volatile LAS unsigned* st; };
__device__ __forceinline__ XcdBarrier xcd_barrier_post(unsigned* bar, volatile LAS unsigned* st) {
    XcdBarrier b; b.bar = bar; b.x = xb_xcc_id(); b.st = st;
    if (threadIdx.x == 0) (void)xb_add(&bar[XB_XCNT(b.x)], 1u);
    return b;
}
__device__ __forceinline__ void xcd_barrier_complete(unsigned* bar, unsigned x, unsigned& nloc, unsigned& nx) {
    const unsigned G = gridDim.x * gridDim.y * gridDim.z;
    unsigned sum, cnt, mine, sp = 0u;
    for (;;) {
        sum = 0u; cnt = 0u; mine = 0u;
#pragma unroll
        for (unsigned j = 0; j < 16; ++j) { const unsigned c = xb_ld(&bar[XB_XCNT(j)]); sum += c; cnt += (c > 0u) ? 1u : 0u; mine = (j == x) ? c : mine; }
        if (sum == G) break;
        __builtin_amdgcn_s_sleep(1);
        if ((++sp & 255u) == 0u) { if (xb_ld(&bar[XB_TMO])) break; if (sp > XB_SPIN_CAP) { atomicAdd(&bar[XB_TMO], 1u); break; } }
    }
    nloc = mine > 0u ? mine : 1u; nx = cnt > 0u ? cnt : 1u;
}
__device__ __forceinline__ void xcd_barrier(const XcdBarrier& b) {
    asm volatile("s_waitcnt vmcnt(0)" ::: "memory");
    __syncthreads();
    if (threadIdx.x == 0) {
        unsigned* bar = b.bar;
        __builtin_amdgcn_s_waitcnt(0);
        unsigned nloc = b.st[0], nx = b.st[1];
        if (nloc == 0u) { xcd_barrier_complete(bar, b.x, nloc, nx); b.st[0] = nloc; b.st[1] = nx; }
        const unsigned old = xb_add(&bar[XB_XSUB(b.x)], 1u);
        const unsigned gen = old / nloc;
        if (old + 1u == (gen + 1u) * nloc) {
            __builtin_amdgcn_fence(__ATOMIC_RELEASE, "agent");
            asm volatile("s_waitcnt vmcnt(0)" ::: "memory");
            const unsigned og = xb_add(&bar[XB_TOP], 1u);
            const unsigned tg = og / nx;
            if (og + 1u == (tg + 1u) * nx) xb_add(&bar[XB_TOPGEN], 1u);
            else XB_SPIN(xb_ld(&bar[XB_TOPGEN]) == tg, bar);
            __builtin_amdgcn_fence(__ATOMIC_ACQUIRE, "agent");
            xb_add(&bar[XB_XGEN(b.x)], 1u);
            asm volatile("s_waitcnt vmcnt(0)" ::: "memory");
        } else {
            XB_SPIN(xb_ld(&bar[XB_XGEN(b.x)]) == gen, bar);
            __builtin_amdgcn_fence(__ATOMIC_ACQUIRE, "agent");
            asm volatile("s_waitcnt vmcnt(0)" ::: "memory");
        }
    }
    __syncthreads();
}
namespace pg8 {
#define PG8_LAS __attribute__((address_space(3)))
typedef unsigned short bf16_t;
typedef short bf16x8 __attribute__((ext_vector_type(8)));
typedef float f32x4 __attribute__((ext_vector_type(4)));
typedef unsigned u32x4 __attribute__((ext_vector_type(4)));
constexpr int BM = 256, BK = 64, HALF = 128, HTB = HALF * BK * 2  , STAGE_BYTES = 8 * HTB, NXCD = 8, WGM = 8;

__host__ __device__ __forceinline__ int lds_byte(int r, int c) { const int st = (r >> 4) * 2 + (c >> 5), rr = r & 15, cc = c & 31, ob = rr * 64 + cc * 2; return st * 1024 + (ob ^ (((ob >> 9) & 1) << 5)); }
__host__ __device__ __forceinline__ void stage_rc(int b, int& R, int& C) { const int st = b / 1024, sb = b % 1024, swz = sb ^ (((sb >> 9) & 1) << 5); R = (st >> 1) * 16 + swz / 64; C = (st & 1) * 32 + (swz % 64) / 2; }
__host__ __device__ __forceinline__ int perm32(int rho) { const int n = rho >> 4, i = rho & 15; return 8 * (i >> 2) + 4 * n + (i & 3); }

struct Unit { int pm, pn; };
struct Gemm { const bf16_t* A; const bf16_t* Bt; int M, N, K, lda; };

struct StaticOrder {
    int nM, nN, nwg, G, c;
    __host__ __device__ void init(int M, int N, int G_, int c_) { nM = M / BM; nN = N / BM; nwg = nM * nN; G = G_; c = c_; }
    __host__ __device__ bool next(int i, Unit& u) const {
        const long L = (long)i * G + c; if (L >= nwg) return false;
        int wgid = (int)L; { const int q = nwg / NXCD, r = nwg % NXCD, xcd = wgid % NXCD, off = wgid / NXCD; wgid = (xcd < r ? xcd * (q + 1) : r * (q + 1) + (xcd - r) * q) + off; }
        const int nig = WGM * nN, gid = wgid / nig, fm = gid * WGM, gsz = (nM - fm) < WGM ? (nM - fm) : WGM;
        u.pm = fm + ((wgid % nig) % gsz); u.pn = (wgid % nig) / gsz; return true;
    }
    __device__ __forceinline__ void a_ready(const Unit&) const {}
    __device__ __forceinline__ void done(const Unit&) const {}
};

__device__ __forceinline__ unsigned cvt_pk_bf16(float lo, float hi) { unsigned r; asm volatile("v_cvt_pk_bf16_f32 %0, %1, %2" : "=v"(r) : "v"(lo), "v"(hi)); return r; }
typedef float f32x2 __attribute__((ext_vector_type(2)));
__device__ __forceinline__ f32x2 gelu_pk(f32x2 v) {
    const f32x2 av = __builtin_elementwise_abs(v), d = av * 0.2316418882f + 1.0f;
    f32x2 t; t.x = __builtin_amdgcn_rcpf(d.x); t.y = __builtin_amdgcn_rcpf(d.y);
    f32x2 q = t * 0.5307027145f + (-0.7265760135f); q = q * t + 0.7107068705f; q = q * t + (-0.142248368f); q = q * t + 0.127414796f; q = q * t;
    const f32x2 s = (v * v) * (-0.72134752044f);
    f32x2 e; e.x = __builtin_amdgcn_exp2f(s.x); e.y = __builtin_amdgcn_exp2f(s.y);
    const f32x2 m = v * (q * e), r = v - m;
    f32x2 o; o.x = v.x < 0.f ? m.x : r.x; o.y = v.y < 0.f ? m.y : r.y; return o;
}

template <int ACT  > struct EpiBf16 {
    static constexpr bool PERM = true, AFTER_DRAIN = false; static_assert(ACT == 0 || ACT == 1, "EpiBf16: ACT is 0 (none) or 1 (gelu_pk)");
    bf16_t* O; int ldc; const float* bias; int split_cols; size_t split_stride; float scale0;
    __device__ __forceinline__ void operator()(const f32x4 (&acc)[2][2][4][2], const Unit& u, int wr, int wc, int fr, int fq) const {
        const int row0 = u.pm * BM + wr * 64 + fr; int colt = u.pn * BM; bf16_t* base = O;
        float sc = 1.f; if (split_cols) { const int t = colt / split_cols; base += (size_t)t * split_stride; colt -= t * split_cols; if (t == 0) sc = scale0; }
        const int col0 = colt + wc * 32 + 8 * fq, bcol0 = u.pn * BM + wc * 32 + 8 * fq;
        f32x4 bv[2][2];
#pragma unroll
        for (int bj = 0; bj < 2; ++bj)
#pragma unroll
            for (int n = 0; n < 2; ++n) bv[bj][n] = bias ? *(const f32x4*)(bias + bcol0 + bj * HALF + 4 * n) : (f32x4){0.f, 0.f, 0.f, 0.f};
#pragma unroll
        for (int ai = 0; ai < 2; ++ai)
#pragma unroll
            for (int m = 0; m < 4; ++m) { bf16_t* rowp = base + (size_t)(row0 + ai * HALF + m * 16) * ldc + col0;
#pragma unroll
                for (int bj = 0; bj < 2; ++bj) { f32x4 v0 = acc[ai][bj][m][0] + bv[bj][0], v1 = acc[ai][bj][m][1] + bv[bj][1];
                    if (ACT == 1) { f32x2 a = gelu_pk((f32x2){v0[0], v0[1]}), b = gelu_pk((f32x2){v0[2], v0[3]}), c = gelu_pk((f32x2){v1[0], v1[1]}), d = gelu_pk((f32x2){v1[2], v1[3]});
                        v0 = (f32x4){a.x, a.y, b.x, b.y}; v1 = (f32x4){c.x, c.y, d.x, d.y}; }
                    v0 = v0 * sc; v1 = v1 * sc; u32x4 w; w.x = cvt_pk_bf16(v0[0], v0[1]); w.y = cvt_pk_bf16(v0[2], v0[3]); w.z = cvt_pk_bf16(v1[0], v1[1]); w.w = cvt_pk_bf16(v1[2], v1[3]);
                    *(u32x4*)(rowp + bj * HALF) = w; } }
    }
};

template <class Epi, class Sched, bool ALIGN_EPI = false, bool SP2 = false>
__device__ __forceinline__ void gemm_phase(PG8_LAS unsigned char* lds, const Gemm g, const Sched& S, const Epi& E) {
    const int tid = threadIdx.x, wid = __builtin_amdgcn_readfirstlane(tid >> 6), lane = tid & 63, wr = wid >> 2, wc = wid & 3, fr = lane & 15, fq = lane >> 4;
    const int K = g.K, nt = K / BK;
    unsigned voffA[2], voffB[2];
#pragma unroll
    for (int i = 0; i < 2; ++i) { int R, C; stage_rc(tid * 16 + i * 8192, R, C); const int Rb = Epi::PERM ? ((R & ~31) + perm32(R & 31)) : R;
        voffA[i] = (unsigned)(R * g.lda + C) * 2u; voffB[i] = (unsigned)(Rb * K + C) * 2u; }
    const size_t kstep = (size_t)(BK * 2);
    const size_t hstepA = (size_t)HALF * g.lda * 2, hstepB = (size_t)HALF * K * 2;
    const size_t tstepA = 2 * hstepA, tstepB = 2 * hstepB;
    const unsigned ldsw = (unsigned)wid * 1024u;
    const int aoff = lds_byte(wr * 64 + fr, fq * 8), boff = lds_byte(wc * 32 + fr, fq * 8);
#define PG8_SA(b, h) (((b) * 2 + (h)) * HTB)
#define PG8_SB(b, h) ((4 + (b) * 2 + (h)) * HTB)
#define PG8_STAGE(bufoff, gbase, voff) do { _Pragma("unroll") for (int _i = 0; _i < 2; ++_i) \
        __builtin_amdgcn_global_load_lds((const unsigned*)((const char*)(gbase) + (voff)[_i]), (PG8_LAS unsigned*)(lds + (bufoff) + ldsw + _i * 8192), 16, 0, 0); } while (0)
#define PG8_LDA(dst, b, h) do { _Pragma("unroll") for (int m = 0; m < 4; ++m) _Pragma("unroll") for (int k = 0; k < 2; ++k) dst[m][k] = *(const PG8_LAS bf16x8*)(lds + PG8_SA(b, h) + aoff + m * 2048 + k * 1024); } while (0)
#define PG8_LDB(dst, b, h) do { _Pragma("unroll") for (int n = 0; n < 2; ++n) _Pragma("unroll") for (int k = 0; k < 2; ++k) dst[n][k] = *(const PG8_LAS bf16x8*)(lds + PG8_SB(b, h) + boff + n * 2048 + k * 1024); } while (0)
#define PG8_MMA(ai, bj, At, Bt) do { __builtin_amdgcn_s_setprio(1); _Pragma("unroll") for (int m = 0; m < 4; ++m) _Pragma("unroll") for (int n = 0; n < 2; ++n) _Pragma("unroll") for (int k = 0; k < 2; ++k) \
        acc[ai][bj][m][n] = __builtin_amdgcn_mfma_f32_16x16x32_bf16(Bt[n][k], At[m][k], acc[ai][bj][m][n], 0, 0, 0); __builtin_amdgcn_s_setprio(0); } while (0)
#define PG8_WAIT_V(n) asm volatile("s_waitcnt vmcnt(" #n ")" ::: "memory")
#define PG8_WAIT_L(n) asm volatile("s_waitcnt lgkmcnt(" #n ")" ::: "memory")
#define PG8_BAR __builtin_amdgcn_s_barrier()
#define PG8_SCHED __builtin_amdgcn_sched_barrier(0)
    Unit cur, nxt; int ui = 0;
    if (!S.next(0, cur)) return;
    f32x4 acc[2][2][4][2];
#pragma unroll
    for (int a = 0; a < 2; ++a)
#pragma unroll
        for (int b = 0; b < 2; ++b)
#pragma unroll
            for (int m = 0; m < 4; ++m)
#pragma unroll
                for (int n = 0; n < 2; ++n) acc[a][b][m][n] = (f32x4){0.f, 0.f, 0.f, 0.f};
    bf16x8 At[4][2], B0[2][2], B1[2][2];
    const char* cA = (const char*)g.A + (size_t)cur.pm * tstepA; const char* cB = (const char*)g.Bt + (size_t)cur.pn * tstepB;
    S.a_ready(cur);
    if constexpr (SP2) {
        PG8_STAGE(PG8_SB(0, 0), cB, voffB); PG8_STAGE(PG8_SB(0, 1), cB + hstepB, voffB); PG8_STAGE(PG8_SA(0, 0), cA, voffA); PG8_STAGE(PG8_SA(0, 1), cA + hstepA, voffA);
        if (wr == 1) PG8_BAR;
        PG8_WAIT_V(2); PG8_BAR;
        PG8_STAGE(PG8_SB(1, 0), cB + kstep, voffB); PG8_STAGE(PG8_SA(1, 0), cA + kstep, voffA); PG8_STAGE(PG8_SB(1, 1), cB + hstepB + kstep, voffB);
        PG8_WAIT_V(6); PG8_BAR;
    } else {
        PG8_STAGE(PG8_SB(0, 0), cB, voffB); PG8_STAGE(PG8_SA(0, 0), cA, voffA); PG8_STAGE(PG8_SB(0, 1), cB + hstepB, voffB); PG8_STAGE(PG8_SA(0, 1), cA + hstepA, voffA);
        if (wr == 1) PG8_BAR;
        PG8_WAIT_V(4); PG8_BAR;
        PG8_STAGE(PG8_SB(1, 0), cB + kstep, voffB); PG8_STAGE(PG8_SA(1, 0), cA + kstep, voffA); PG8_STAGE(PG8_SB(1, 1), cB + hstepB + kstep, voffB);
        PG8_WAIT_V(6); PG8_BAR;
    }
    for (;;) {
        const bool has_next = S.next(ui + 1, nxt);
        const char* nA = has_next ? (const char*)g.A + (size_t)nxt.pm * tstepA : cA; const char* nB = has_next ? (const char*)g.Bt + (size_t)nxt.pn * tstepB : cB;
        for (int t = 0; t < nt; t += 2) {
            const bool last = (t == nt - 2);
            const char* a1 = cA + (size_t)(t + 1) * kstep;
            const char* a2 = last ? nA : cA + (size_t)(t + 2) * kstep; const char* b2 = last ? nB : cB + (size_t)(t + 2) * kstep;
            const char* a3 = a2 + kstep; const char* b3 = b2 + kstep;
            if (last && has_next) S.a_ready(nxt);
            if constexpr (SP2) {
            PG8_LDB(B0, 0, 0); PG8_LDB(B1, 0, 1); PG8_SCHED; PG8_LDA(At, 0, 0); PG8_STAGE(PG8_SA(1, 1), a1 + hstepA, voffA);
            PG8_WAIT_V(8); PG8_WAIT_L(0); PG8_BAR; PG8_MMA(0, 0, At, B0); PG8_MMA(0, 1, At, B1); PG8_BAR; PG8_SCHED;
            PG8_LDA(At, 0, 1); PG8_STAGE(PG8_SB(0, 0), b2, voffB); PG8_STAGE(PG8_SB(0, 1), b2 + hstepB, voffB); PG8_STAGE(PG8_SA(0, 0), a2, voffA);
            PG8_WAIT_V(8); PG8_WAIT_L(0); PG8_BAR; PG8_MMA(1, 0, At, B0); PG8_MMA(1, 1, At, B1); PG8_BAR; PG8_SCHED;
            PG8_LDB(B0, 1, 0); PG8_LDB(B1, 1, 1); PG8_SCHED; PG8_LDA(At, 1, 0); PG8_STAGE(PG8_SA(0, 1), a2 + hstepA, voffA);
            PG8_WAIT_V(8); PG8_WAIT_L(0); PG8_BAR; PG8_MMA(0, 0, At, B0); PG8_MMA(0, 1, At, B1); PG8_BAR; PG8_SCHED;
            PG8_LDA(At, 1, 1); PG8_STAGE(PG8_SB(1, 0), b3, voffB); PG8_STAGE(PG8_SB(1, 1), b3 + hstepB, voffB); PG8_STAGE(PG8_SA(1, 0), a3, voffA);
            PG8_WAIT_V(8); PG8_WAIT_L(0); PG8_BAR; PG8_MMA(1, 0, At, B0); PG8_MMA(1, 1, At, B1); PG8_BAR; PG8_SCHED;
            } else {
            PG8_LDB(B0, 0, 0); PG8_SCHED; PG8_LDA(At, 0, 0); PG8_STAGE(PG8_SA(1, 1), a1 + hstepA, voffA);
            PG8_WAIT_L(8); PG8_BAR; PG8_WAIT_L(0); PG8_MMA(0, 0, At, B0); PG8_BAR; PG8_SCHED;
            PG8_LDB(B1, 0, 1); PG8_STAGE(PG8_SB(0, 0), b2, voffB);
            PG8_BAR; PG8_WAIT_L(0); PG8_MMA(0, 1, At, B1); PG8_BAR;
            PG8_LDA(At, 0, 1); PG8_STAGE(PG8_SA(0, 0), a2, voffA);
            PG8_BAR; PG8_WAIT_L(0); PG8_MMA(1, 0, At, B0); PG8_BAR; PG8_SCHED;
            PG8_STAGE(PG8_SB(0, 1), b2 + hstepB, voffB);
            PG8_WAIT_V(6); PG8_BAR; PG8_MMA(1, 1, At, B1); PG8_BAR;
            PG8_LDB(B0, 1, 0); PG8_SCHED; PG8_LDA(At, 1, 0); PG8_STAGE(PG8_SA(0, 1), a2 + hstepA, voffA);
            PG8_WAIT_L(8); PG8_BAR; PG8_WAIT_L(0); PG8_MMA(0, 0, At, B0); PG8_BAR; PG8_SCHED;
            PG8_LDB(B1, 1, 1); PG8_STAGE(PG8_SB(1, 0), b3, voffB);
            PG8_BAR; PG8_WAIT_L(0); PG8_MMA(0, 1, At, B1); PG8_BAR;
            PG8_LDA(At, 1, 1); PG8_STAGE(PG8_SA(1, 0), a3, voffA);
            PG8_BAR; PG8_WAIT_L(0); PG8_MMA(1, 0, At, B0); PG8_BAR; PG8_SCHED;
            PG8_STAGE(PG8_SB(1, 1), b3 + hstepB, voffB);
            PG8_WAIT_V(6); PG8_BAR; PG8_MMA(1, 1, At, B1); PG8_BAR;
            }
        }
        if constexpr (ALIGN_EPI) { if (wr == 0) PG8_BAR; }
        if constexpr (!Epi::AFTER_DRAIN) { E(acc, cur, wr, wc, fr, fq); S.done(cur); }
        if (!has_next) break;
#pragma unroll
        for (int a = 0; a < 2; ++a)
#pragma unroll
            for (int b = 0; b < 2; ++b)
#pragma unroll
                for (int m = 0; m < 4; ++m)
#pragma unroll
                    for (int n = 0; n < 2; ++n) acc[a][b][m][n] = (f32x4){0.f, 0.f, 0.f, 0.f};
        cur = nxt; cA = nA; cB = nB; ++ui;
        if constexpr (ALIGN_EPI) { if (wr == 1) PG8_BAR; }
    }
    PG8_WAIT_V(0);
    if constexpr (!ALIGN_EPI) { if (wr == 0) PG8_BAR; }
    PG8_BAR;
    if constexpr (Epi::AFTER_DRAIN) { E.fused(acc, cur, wr, wc, fr, fq, lds, wid, lane); S.done(cur); }
#undef PG8_SA
#undef PG8_SB
#undef PG8_STAGE
#undef PG8_LDA
#undef PG8_LDB
#undef PG8_MMA
#undef PG8_WAIT_V
#undef PG8_WAIT_L
#undef PG8_BAR
#undef PG8_SCHED
}
}
namespace pg8 {
struct Unit2 { int pm, pn, e, cnt, jt; };
template <class Epi, class Sched>
__device__ __forceinline__ void gemm_phase2(PG8_LAS unsigned char* lds, const bf16_t* Abase, int lda, int ldb, int K, const Sched& S, const Epi& E) {
    int tid_ = threadIdx.x; asm volatile("" : "+v"(tid_));
    const int tid = tid_, wid = __builtin_amdgcn_readfirstlane(tid >> 6), lane = tid & 63, wr = wid >> 2, wc = wid & 3, fr = lane & 15, fq = lane >> 4;
    int K_ = K; asm volatile("" : "+s"(K_));
    const int nt = K_ / BK;
    unsigned voffB[2];
#pragma unroll
    for (int i = 0; i < 2; ++i) { int R, C; stage_rc(tid * 16 + i * 8192, R, C); const int Rb = Epi::PERM ? ((R & ~31) + perm32(R & 31)) : R; voffB[i] = (unsigned)(Rb * ldb + C) * 2u; }
    const unsigned lda2 = (unsigned)lda * 2u;
#define PG8_AOFFS(U, o0, o1) do { int t2_ = threadIdx.x; asm volatile("" : "+v"(t2_)); _Pragma("unroll") for (int i_ = 0; i_ < 2; ++i_) { int R_, C_; stage_rc(t2_ * 16 + i_ * 8192, R_, C_); \
        o0[i_] = (unsigned)S.arow(U, R_) * lda2 + (unsigned)C_ * 2u; o1[i_] = (unsigned)S.arow(U, HALF + R_) * lda2 + (unsigned)C_ * 2u; } } while (0)
    const size_t kstep = (size_t)(BK * 2);
    const size_t hstepB = (size_t)HALF * ldb * 2;
    const unsigned ldsw = (unsigned)wid * 1024u;
    const int aoff = lds_byte(wr * 64 + fr, fq * 8), boff = lds_byte(wc * 32 + fr, fq * 8);
#define PG8_SA(b, h) (((b) * 2 + (h)) * HTB)
#define PG8_SB(b, h) ((4 + (b) * 2 + (h)) * HTB)
#define PG8_STAGE(bufoff, gbase, voff) do { _Pragma("unroll") for (int _i = 0; _i < 2; ++_i) \
        __builtin_amdgcn_global_load_lds((const unsigned*)((const char*)(gbase) + (voff)[_i]), (PG8_LAS unsigned*)(lds + (bufoff) + ldsw + _i * 8192), 16, 0, 0); } while (0)
#define PG8_LDA(dst, b, h) do { _Pragma("unroll") for (int m = 0; m < 4; ++m) _Pragma("unroll") for (int k = 0; k < 2; ++k) dst[m][k] = *(const PG8_LAS bf16x8*)(lds + PG8_SA(b, h) + aoff + m * 2048 + k * 1024); } while (0)
#define PG8_LDB(dst, b, h) do { _Pragma("unroll") for (int n = 0; n < 2; ++n) _Pragma("unroll") for (int k = 0; k < 2; ++k) dst[n][k] = *(const PG8_LAS bf16x8*)(lds + PG8_SB(b, h) + boff + n * 2048 + k * 1024); } while (0)
#define PG8_MMA(ai, bj, At, Bt) do { __builtin_amdgcn_s_setprio(1); _Pragma("unroll") for (int m = 0; m < 4; ++m) _Pragma("unroll") for (int n = 0; n < 2; ++n) _Pragma("unroll") for (int k = 0; k < 2; ++k) \
        acc[ai][bj][m][n] = __builtin_amdgcn_mfma_f32_16x16x32_bf16(Bt[n][k], At[m][k], acc[ai][bj][m][n], 0, 0, 0); __builtin_amdgcn_s_setprio(0); } while (0)
#define PG8_WAIT_V(n) asm volatile("s_waitcnt vmcnt(" #n ")" ::: "memory")
#define PG8_WAIT_L(n) asm volatile("s_waitcnt lgkmcnt(" #n ")" ::: "memory")
#define PG8_BAR __builtin_amdgcn_s_barrier()
#define PG8_SCHED __builtin_amdgcn_sched_barrier(0)
    Unit2 cur, nxt; int ui = 0;
    if (!S.next(0, cur)) return;
    f32x4 acc[2][2][4][2];
#pragma unroll
    for (int a = 0; a < 2; ++a)
#pragma unroll
        for (int b = 0; b < 2; ++b)
#pragma unroll
            for (int m = 0; m < 4; ++m)
#pragma unroll
                for (int n = 0; n < 2; ++n) acc[a][b][m][n] = (f32x4){0.f, 0.f, 0.f, 0.f};
    bf16x8 At[4][2], B0[2][2], B1[2][2];
    unsigned cv0[2], cv1[2], nv0[2], nv1[2];
    PG8_AOFFS(cur, cv0, cv1);
    const char* cA = (const char*)Abase + S.aoff(cur); const char* cB = S.bptr(cur);
    PG8_STAGE(PG8_SB(0, 0), cB, voffB); PG8_STAGE(PG8_SB(0, 1), cB + hstepB, voffB); PG8_STAGE(PG8_SA(0, 0), cA, cv0); PG8_STAGE(PG8_SA(0, 1), cA, cv1);
    if (wr == 1) PG8_BAR;
    PG8_WAIT_V(2); PG8_BAR;
    PG8_STAGE(PG8_SB(1, 0), cB + kstep, voffB); PG8_STAGE(PG8_SA(1, 0), cA + kstep, cv0); PG8_STAGE(PG8_SB(1, 1), cB + hstepB + kstep, voffB);
    PG8_WAIT_V(6); PG8_BAR;
    for (;;) {
        const bool has_next = S.next(ui + 1, nxt);
        const char* nA = has_next ? (const char*)Abase + S.aoff(nxt) : cA; const char* nB = has_next ? S.bptr(nxt) : cB;
#pragma unroll
        for (int i = 0; i < 2; ++i) { nv0[i] = cv0[i]; nv1[i] = cv1[i]; }
        if (has_next) PG8_AOFFS(nxt, nv0, nv1);
        for (int t = 0; t < nt; t += 2) {
            const bool last = (t == nt - 2);
            const char* a1 = cA + (size_t)(t + 1) * kstep;
            const char* a2 = last ? nA : cA + (size_t)(t + 2) * kstep; const char* b2 = last ? nB : cB + (size_t)(t + 2) * kstep;
            const char* a3 = a2 + kstep; const char* b3 = b2 + kstep;
            unsigned s0[2] = {cv0[0], cv0[1]}, s1[2] = {cv1[0], cv1[1]};
            if (last) { asm volatile("" ::: "memory"); s0[0] = nv0[0]; s0[1] = nv0[1]; s1[0] = nv1[0]; s1[1] = nv1[1]; }
            PG8_LDB(B0, 0, 0); PG8_LDB(B1, 0, 1); PG8_SCHED; PG8_LDA(At, 0, 0); PG8_STAGE(PG8_SA(1, 1), a1, cv1);
            PG8_WAIT_V(8); PG8_WAIT_L(0); PG8_BAR; PG8_MMA(0, 0, At, B0); PG8_MMA(0, 1, At, B1); PG8_BAR; PG8_SCHED;
            PG8_LDA(At, 0, 1); PG8_STAGE(PG8_SB(0, 0), b2, voffB); PG8_STAGE(PG8_SB(0, 1), b2 + hstepB, voffB); PG8_STAGE(PG8_SA(0, 0), a2, s0);
            PG8_WAIT_V(8); PG8_WAIT_L(0); PG8_BAR; PG8_MMA(1, 0, At, B0); PG8_MMA(1, 1, At, B1); PG8_BAR; PG8_SCHED;
            PG8_LDB(B0, 1, 0); PG8_LDB(B1, 1, 1); PG8_SCHED; PG8_LDA(At, 1, 0); PG8_STAGE(PG8_SA(0, 1), a2, s1);
            PG8_WAIT_V(8); PG8_WAIT_L(0); PG8_BAR; PG8_MMA(0, 0, At, B0); PG8_MMA(0, 1, At, B1); PG8_BAR; PG8_SCHED;
            PG8_LDA(At, 1, 1); PG8_STAGE(PG8_SB(1, 0), b3, voffB); PG8_STAGE(PG8_SB(1, 1), b3 + hstepB, voffB); PG8_STAGE(PG8_SA(1, 0), a3, s0);
            PG8_WAIT_V(8); PG8_WAIT_L(0); PG8_BAR; PG8_MMA(1, 0, At, B0); PG8_MMA(1, 1, At, B1); PG8_BAR; PG8_SCHED;
        }
        if (wr == 0) PG8_BAR;
        { Unit2 eu = cur; asm volatile("" : "+s"(eu.pm), "+s"(eu.pn), "+s"(eu.e), "+s"(eu.cnt), "+s"(eu.jt));
          E(acc, eu, wr, wc, fr, fq); }
        if (!has_next) break;
#pragma unroll
        for (int a = 0; a < 2; ++a)
#pragma unroll
            for (int b = 0; b < 2; ++b)
#pragma unroll
                for (int m = 0; m < 4; ++m)
#pragma unroll
                    for (int n = 0; n < 2; ++n) acc[a][b][m][n] = (f32x4){0.f, 0.f, 0.f, 0.f};
        cur = nxt; cA = nA; cB = nB; ++ui;
#pragma unroll
        for (int i = 0; i < 2; ++i) { cv0[i] = nv0[i]; cv1[i] = nv1[i]; }
        if (wr == 1) PG8_BAR;
    }
    PG8_WAIT_V(0);
    PG8_BAR;
#undef PG8_AOFFS
#undef PG8_SA
#undef PG8_SB
#undef PG8_STAGE
#undef PG8_LDA
#undef PG8_LDB
#undef PG8_MMA
#undef PG8_WAIT_V
#undef PG8_WAIT_L
#undef PG8_BAR
#undef PG8_SCHED
}

struct DenseSched {
    StaticOrder so; const bf16_t* Bt; int ldb;
    __device__ __forceinline__ bool next(int i, Unit2& u) const { Unit t; if (!so.next(i, t)) return false; u.pm = t.pm; u.pn = t.pn; u.e = 0; u.cnt = 256; u.jt = 0; return true; }
    __device__ __forceinline__ int arow(const Unit2& u, int r) const { return u.pm * BM + r; }
    __device__ __forceinline__ size_t aoff(const Unit2&) const { return 0; }
    __device__ __forceinline__ const char* bptr(const Unit2& u) const { return (const char*)(Bt + (size_t)u.pn * BM * ldb); }
};
struct EpiResid {
    static constexpr bool PERM = false, AFTER_DRAIN = false;
    float* C; int ldc; const float* x; const float* stats; const float* g; const float* b; float alpha;
    __device__ __forceinline__ void operator()(const f32x4 (&acc)[2][2][4][2], const Unit2& u, int wr, int wc, int fr, int fq) const {
        const int row0 = u.pm * BM + wr * 64 + fr, col0 = u.pn * BM + wc * 32 + 4 * fq;
        f32x4 gv[2][2], bv[2][2];
#pragma unroll
        for (int bj = 0; bj < 2; ++bj)
#pragma unroll
            for (int n = 0; n < 2; ++n) { gv[bj][n] = *(const f32x4*)(g + col0 + bj * HALF + n * 16) * alpha; bv[bj][n] = *(const f32x4*)(b + col0 + bj * HALF + n * 16) * alpha; }
#pragma unroll
        for (int ai = 0; ai < 2; ++ai)
#pragma unroll
            for (int m = 0; m < 4; ++m) { const int row = row0 + ai * HALF + m * 16; const float mean = stats[2 * row], rstd = stats[2 * row + 1];
                const float* xr = x + (size_t)row * ldc + col0; float* cr = C + (size_t)row * ldc + col0;
#pragma unroll
                for (int bj = 0; bj < 2; ++bj)
#pragma unroll
                    for (int n = 0; n < 2; ++n) { const f32x4 xv = *(const f32x4*)(xr + bj * HALF + n * 16);
                        *(f32x4*)(cr + bj * HALF + n * 16) = acc[ai][bj][m][n] + ((xv - mean) * rstd) * gv[bj][n] + bv[bj][n]; } }
    }
};
}
namespace nv {
constexpr int D = 1024, B = 8, S = 4096, T = B * S;
constexpr int FH = 8, FD = 64, GH = 4, GK = 64, GV = 128, RANK = 16;
constexpr int INW = 3096;
constexpr int O_FQ = 0, O_FK = 512, O_FV = 1024, O_FF = 1536, O_GQ = 1544, O_GK = 1800, O_GV = 2056, O_GA = 2568, O_GR = 2584;
constexpr int NE = 256, NG = 8, TOPK = 8, ED = 256;
constexpr float LN_EPS = 1e-5f;
constexpr float ALPHA = 1.189207115002721f;
constexpr int PADR = 64;
constexpr int APAD = T * TOPK + NE * PADR;

__device__ __forceinline__ float logsigmoidf(float x) { return fminf(x, 0.f) - log1pf(expf(-fabsf(x))); }
__device__ __forceinline__ float siluf(float x) { return x / (1.f + expf(-x)); }


__device__ __forceinline__ void ln_row(const float* in1, float a, const float* in2, const float* __restrict__ g, const float* __restrict__ b, float* out, int r, int tid, float* sh) {
    float4 v = ((const float4*)(in1 + (size_t)r * D))[tid];
    v.x *= a; v.y *= a; v.z *= a; v.w *= a;
    if (in2) { const float4 w = ((const float4*)(in2 + (size_t)r * D))[tid]; v.x += w.x; v.y += w.y; v.z += w.z; v.w += w.w; }
    float s = v.x + v.y + v.z + v.w;
    for (int o = 32; o > 0; o >>= 1) s += __shfl_xor(s, o);
    __syncthreads();
    if ((tid & 63) == 0) sh[tid >> 6] = s;
    __syncthreads();
    const float mean = (sh[0] + sh[1] + sh[2] + sh[3]) * (1.f / D);
    v.x -= mean; v.y -= mean; v.z -= mean; v.w -= mean;
    float q = v.x * v.x + v.y * v.y + v.z * v.z + v.w * v.w;
    for (int o = 32; o > 0; o >>= 1) q += __shfl_xor(q, o);
    if ((tid & 63) == 0) sh[4 + (tid >> 6)] = q;
    __syncthreads();
    const float rstd = rsqrtf((sh[4] + sh[5] + sh[6] + sh[7]) * (1.f / D) + LN_EPS);
    const float4 gg = ((const float4*)g)[tid], bb = ((const float4*)b)[tid];
    float4 o4; o4.x = v.x * rstd * gg.x + bb.x; o4.y = v.y * rstd * gg.y + bb.y; o4.z = v.z * rstd * gg.z + bb.z; o4.w = v.w * rstd * gg.w + bb.w;
    ((float4*)(out + (size_t)r * D))[tid] = o4;
}

__device__ __forceinline__ void gemm_tile(const float* A, const float* Bm, float* C, int N, int K, int lda, int ldb, int ldc, int tile_x, int tile_y, int tid, float* sh) {
    float (*As)[68] = (float (*)[68])sh;
    float (*Bs)[68] = (float (*)[68])(sh + 16 * 68);
    const int tx = tid & 15, ty = tid >> 4;
    const int row0 = tile_y * 64, col0 = tile_x * 64;
    float acc[4][4] = {};
    const int ar = tid >> 2, ak = (tid & 3) * 4;
    const int bk = tid >> 4, bc = (tid & 15) * 4;
    const bool bok = (col0 + bc) < N;
    for (int k0 = 0; k0 < K; k0 += 16) {
        const float4 av = *(const float4*)(A + (size_t)(row0 + ar) * lda + k0 + ak);
        float4 bv = make_float4(0.f, 0.f, 0.f, 0.f);
        if (bok) bv = *(const float4*)(Bm + (size_t)(k0 + bk) * ldb + col0 + bc);
        __syncthreads();
        As[ak + 0][ar] = av.x; As[ak + 1][ar] = av.y; As[ak + 2][ar] = av.z; As[ak + 3][ar] = av.w;
        *(float4*)&Bs[bk][bc] = bv;
        __syncthreads();
#pragma unroll
        for (int k = 0; k < 16; ++k) {
            const float4 a4 = *(const float4*)&As[k][ty * 4];
            const float4 b4 = *(const float4*)&Bs[k][tx * 4];
            const float aa[4] = {a4.x, a4.y, a4.z, a4.w}, bb[4] = {b4.x, b4.y, b4.z, b4.w};
#pragma unroll
            for (int i = 0; i < 4; ++i)
#pragma unroll
                for (int j = 0; j < 4; ++j) acc[i][j] += aa[i] * bb[j];
        }
    }
    if (col0 + tx * 4 < N) {
#pragma unroll
        for (int i = 0; i < 4; ++i)
            *(float4*)(C + (size_t)(row0 + ty * 4 + i) * ldc + col0 + tx * 4) = make_float4(acc[i][0], acc[i][1], acc[i][2], acc[i][3]);
    }
}
__device__ __forceinline__ void gemm_phase(const float* A, const float* Bm, float* C, int M, int N, int K, int lda, int ldb, int ldc, int half, int tid, float* sh) {
    const int ntx = (N + 63) / 64, nty = M / 64, ntile = ntx * nty, G2 = gridDim.x * 2;
    for (int t0 = blockIdx.x * 2; t0 < ntile; t0 += G2) {
        int tl = t0 + half; if (tl >= ntile) tl = ntile - 1;
        gemm_tile(A, Bm, C, N, K, lda, ldb, ldc, tl % ntx, tl / ntx, tid, sh);
    }
}

__device__ __forceinline__ void fox_prep(const float* proj, const float* __restrict__ bf, float* cbuf, int bh, int lane) {
    const int b = bh / FH, h = bh % FH;
    const float bias = bf[h];
    float s = 0.f;
    for (int i = 0; i < 64; ++i) { const int t = lane * 64 + i; s += logsigmoidf(proj[(size_t)(b * S + t) * INW + O_FF + h] + bias); }
    float inc = s;
    for (int o = 1; o < 64; o <<= 1) { const float n = __shfl_up(inc, o); if (lane >= o) inc += n; }
    float run = inc - s;
    for (int i = 0; i < 64; ++i) { const int t = lane * 64 + i; run += logsigmoidf(proj[(size_t)(b * S + t) * INW + O_FF + h] + bias); cbuf[(size_t)bh * S + t] = run; }
}

__device__ __forceinline__ void fox_attn(const float* proj, const float* cbuf, float* y, int blk, int lane) {
    const int qb = blk % (S / 64), bh = blk / (S / 64), b = bh / FH, h = bh % FH;
    const int t = qb * 64 + lane;
    const float* qp = proj + (size_t)(b * S + t) * INW + O_FQ + h * FD;
    float q[64], o[64];
#pragma unroll
    for (int d = 0; d < 64; ++d) { q[d] = qp[d] * 0.125f; o[d] = 0.f; }
    const float ct = cbuf[(size_t)bh * S + t];
    float m = -INFINITY, l = 0.f;
    const int smax = qb * 64 + 63;
    for (int s = 0; s <= smax; ++s) {
        const float* kp = proj + (size_t)(b * S + s) * INW + O_FK + h * FD;
        const float* vp = proj + (size_t)(b * S + s) * INW + O_FV + h * FD;
        float dot = 0.f;
#pragma unroll
        for (int d = 0; d < 64; ++d) dot += q[d] * kp[d];
        const float x = dot + (ct - cbuf[(size_t)bh * S + s]);
        if (s <= t) {
            if (x > m) { const float al = expf(m - x); l *= al;
#pragma unroll
                for (int d = 0; d < 64; ++d) o[d] *= al;
                m = x; }
            const float p = expf(x - m); l += p;
#pragma unroll
            for (int d = 0; d < 64; ++d) o[d] += p * vp[d];
        }
    }
    const float il = 1.f / l;
    float* yp = y + (size_t)(b * S + t) * D + h * FD;
#pragma unroll
    for (int d = 0; d < 64; ++d) yp[d] = o[d] * il;
}

__device__ __forceinline__ void gla_prep(const float* proj, const float* __restrict__ wgu, const float* __restrict__ bg, float* abuf, int t, int j) {
    const float* ga = proj + (size_t)t * INW + O_GA;
    float s = bg[j];
#pragma unroll
    for (int r = 0; r < RANK; ++r) s += ga[r] * wgu[r * 256 + j];
    abuf[(size_t)t * 256 + j] = expf(logsigmoidf(s) * (1.f / 16.f));
}

__device__ __forceinline__ void gla_rec(const float* proj, const float* abuf, float* glao, int bh, int e) {
    const int b = bh / GH, h = bh % GH;
    float st[64];
#pragma unroll
    for (int d = 0; d < 64; ++d) st[d] = 0.f;
    for (int s = 0; s < S; ++s) {
        const size_t t = (size_t)b * S + s;
        const float* qp = proj + t * INW + O_GQ + h * GK;
        const float* kp = proj + t * INW + O_GK + h * GK;
        const float* ap = abuf + t * 256 + h * GK;
        const float v = proj[t * INW + O_GV + h * GV + e];
        float o = 0.f;
#pragma unroll
        for (int d = 0; d < 64; ++d) { st[d] = ap[d] * st[d] + kp[d] * v; o += qp[d] * st[d]; }
        glao[t * 512 + h * GV + e] = o * 0.125f;
    }
}

__device__ __forceinline__ void gla_post(const float* glao, const float* proj, const float* __restrict__ g, float* y, int w, int lane) {
    const int t = w >> 2, h = w & 3;
    const float o0 = glao[(size_t)t * 512 + h * GV + lane], o1 = glao[(size_t)t * 512 + h * GV + 64 + lane];
    float ss = o0 * o0 + o1 * o1;
    for (int o = 32; o > 0; o >>= 1) ss += __shfl_xor(ss, o);
    const float r = rsqrtf(ss * (1.f / GV) + LN_EPS);
    const float g0 = proj[(size_t)t * INW + O_GR + h * GV + lane], g1 = proj[(size_t)t * INW + O_GR + h * GV + 64 + lane];
    y[(size_t)t * D + 512 + h * GV + lane] = o0 * r * g[lane] * siluf(g0);
    y[(size_t)t * D + 512 + h * GV + 64 + lane] = o1 * r * g[64 + lane] * siluf(g1);
}

__device__ __forceinline__ void route_token(const float* logits, const float* __restrict__ rbias, int* top_e, float* top_w, int* top_pos, int* counts, int t, int lane) {
    const float4 lg = ((const float4*)(logits + (size_t)t * NE))[lane];
    const float4 rb = ((const float4*)rbias)[lane];
    float sc[4] = {1.f / (1.f + expf(-lg.x)), 1.f / (1.f + expf(-lg.y)), 1.f / (1.f + expf(-lg.z)), 1.f / (1.f + expf(-lg.w))};
    float bv[4] = {sc[0] + rb.x, sc[1] + rb.y, sc[2] + rb.z, sc[3] + rb.w};
    float m1 = fmaxf(bv[0], bv[1]), m2 = fminf(bv[0], bv[1]);
    { const float a = fmaxf(bv[2], bv[3]), c = fminf(bv[2], bv[3]); const float n1 = fmaxf(m1, a); m2 = fmaxf(fminf(m1, a), fmaxf(m2, c)); m1 = n1; }
    for (int o = 1; o < 8; o <<= 1) { const float p1 = __shfl_xor(m1, o), p2 = __shfl_xor(m2, o); const float n1 = fmaxf(m1, p1); m2 = fmaxf(fminf(m1, p1), fmaxf(m2, p2)); m1 = n1; }
    const float gs = m1 + m2;
    const int myg = lane >> 3;
    int rank = 0;
#pragma unroll
    for (int g2 = 0; g2 < NG; ++g2) { const float og = __shfl(gs, g2 * 8); if (og > gs || (og == gs && g2 < myg)) ++rank; }
    const bool sel = rank < 4;
    float mv[4];
#pragma unroll
    for (int i = 0; i < 4; ++i) mv[i] = sel ? bv[i] : -INFINITY;
    int we[TOPK]; float ws[TOPK]; float wsum = 0.f;
#pragma unroll
    for (int k = 0; k < TOPK; ++k) {
        float bvv = mv[0]; int bi = 0;
#pragma unroll
        for (int i = 1; i < 4; ++i) if (mv[i] > bvv) { bvv = mv[i]; bi = i; }
        int gi = lane * 4 + bi;
        for (int o = 32; o > 0; o >>= 1) { const float ov = __shfl_xor(bvv, o); const int oi = __shfl_xor(gi, o); if (ov > bvv || (ov == bvv && oi < gi)) { bvv = ov; gi = oi; } }
        const int ol = gi >> 2, oi = gi & 3;
        const float s_own = (oi == 0) ? sc[0] : (oi == 1) ? sc[1] : (oi == 2) ? sc[2] : sc[3];
        const float sw = __shfl(s_own, ol);
        if (lane == ol) { if (oi == 0) mv[0] = -INFINITY; else if (oi == 1) mv[1] = -INFINITY; else if (oi == 2) mv[2] = -INFINITY; else mv[3] = -INFINITY; }
        we[k] = gi; ws[k] = sw; wsum += sw;
    }
    if (lane == 0) {
        const float inv = 2.5f / wsum;
#pragma unroll
        for (int k = 0; k < TOPK; ++k) {
            top_e[t * TOPK + k] = we[k]; top_w[t * TOPK + k] = ws[k] * inv;
            top_pos[t * TOPK + k] = atomicAdd(&counts[we[k]], 1);
        }
    }
}

__device__ __forceinline__ void moe_offsets(const int* counts, int* off, int* blk_exp, int* nblk, int lane) {
    int pc[4], st[4]; int tot = 0;
#pragma unroll
    for (int i = 0; i < 4; ++i) { pc[i] = (counts[lane * 4 + i] + PADR - 1) / PADR * PADR; st[i] = tot; tot += pc[i]; }
    int inc = tot;
    for (int o = 1; o < 64; o <<= 1) { const int n = __shfl_up(inc, o); if (lane >= o) inc += n; }
    const int base = inc - tot;
#pragma unroll
    for (int i = 0; i < 4; ++i) { const int start = base + st[i]; off[lane * 4 + i] = start; for (int k = start / PADR; k < (start + pc[i]) / PADR; ++k) blk_exp[k] = lane * 4 + i; }
    if (lane == 63) nblk[0] = inc / PADR;
}

__device__ __forceinline__ void moe_scatter(const int* top_e, const float* top_w, const int* top_pos, const int* off, int* row_tok, float* row_gate, int* slot_of, int a) {
    const int slot = off[top_e[a]] + top_pos[a];
    row_tok[slot] = a / TOPK; row_gate[slot] = top_w[a]; slot_of[a] = slot;
}

__device__ __forceinline__ void moe_hidden(const float* h1, const float* __restrict__ wg, const float* __restrict__ wu, const int* row_tok, const float* row_gate, const int* blk_exp, const int* nblk,
                                           float* hidden, int g16, int j, float* sh) {
    const bool active = g16 * 16 < nblk[0] * PADR;
    float (*xs)[D] = (float (*)[D])sh;
    __syncthreads();
    if (active) for (int r = 0; r < 16; ++r) { const int tok = row_tok[g16 * 16 + r]; ((float4*)xs[r])[j] = ((const float4*)(h1 + (size_t)tok * D))[j]; }
    __syncthreads();
    if (!active) return;
    const int e = blk_exp[(g16 * 16) / PADR];
    float ag[16], au[16];
#pragma unroll
    for (int r = 0; r < 16; ++r) { ag[r] = 0.f; au[r] = 0.f; }
    const float* wgp = wg + (size_t)e * D * ED + j; const float* wup = wu + (size_t)e * D * ED + j;
    for (int d = 0; d < D; d += 4) {
        const float g0 = wgp[(size_t)(d + 0) * ED], g1 = wgp[(size_t)(d + 1) * ED], g2 = wgp[(size_t)(d + 2) * ED], g3 = wgp[(size_t)(d + 3) * ED];
        const float u0 = wup[(size_t)(d + 0) * ED], u1 = wup[(size_t)(d + 1) * ED], u2 = wup[(size_t)(d + 2) * ED], u3 = wup[(size_t)(d + 3) * ED];
#pragma unroll
        for (int r = 0; r < 16; ++r) { const float4 x = *(const float4*)&xs[r][d];
            ag[r] += x.x * g0 + x.y * g1 + x.z * g2 + x.w * g3; au[r] += x.x * u0 + x.y * u1 + x.z * u2 + x.w * u3; }
    }
#pragma unroll
    for (int r = 0; r < 16; ++r) hidden[(size_t)(g16 * 16 + r) * ED + j] = row_gate[g16 * 16 + r] * siluf(ag[r]) * au[r];
}

__device__ __forceinline__ void moe_down(const float* hidden, const float* __restrict__ wd, const int* top_e, const int* slot_of, float* ffn, int t, int i, float* sh) {
    float4 acc = ((float4*)(ffn + (size_t)t * D))[i];
    for (int k = 0; k < TOPK; ++k) {
        const int e = top_e[t * TOPK + k], slot = slot_of[t * TOPK + k];
        __syncthreads();
        sh[i] = hidden[(size_t)slot * ED + i];
        __syncthreads();
        const float4* wp = (const float4*)(wd + (size_t)e * ED * D) + i;
        for (int j = 0; j < ED; ++j) { const float4 w = wp[(size_t)j * (D / 4)]; const float hv = sh[j]; acc.x += hv * w.x; acc.y += hv * w.y; acc.z += hv * w.z; acc.w += hv * w.w; }
    }
    ((float4*)(ffn + (size_t)t * D))[i] = acc;
}
}
#include <hip/hip_bf16.h>
#include <cmath>
namespace attn_body {
using bf16=__hip_bfloat16;
using bf16x8=__attribute__((ext_vector_type(8)))short;
using s16x4=__attribute__((ext_vector_type(4)))short;
using f32x16=__attribute__((ext_vector_type(16)))float;
using u32x4=__attribute__((ext_vector_type(4)))unsigned;
constexpr int BATCH=8,NHEAD=8,SEQ=4096,D=64,DM=3072,OPITCH=1024;
constexpr int NW=8,QBLK=32,QB=QBLK*NW,KVBLK=64,NQB=SEQ/QB;
constexpr int ATTN_PITCH=DM, ATTN_UNIT_ROWS=QB;
__device__ __forceinline__ int crow(int r,int hi){return (r&3)+8*(r>>2)+4*hi;}
#define SBAR() __builtin_amdgcn_sched_barrier(0)
__device__ __forceinline__ void cmask(f32x16&p0,f32x16&p1,int jb,int qrel,int hi){
  const float NEG=-INFINITY; int kb=64*jb+4*hi;
  #pragma unroll
  for(int r=0;r<16;++r){int kv=kb+(r&3)+8*(r>>2); if(kv>qrel)p0[r]=NEG; if(kv+32>qrel)p1[r]=NEG;}
}

constexpr int NSLOT=3, SLOTB=8192;
constexpr int LDS_K=0, LDS_V=NSLOT*SLOTB, LDS_WS=2*NSLOT*SLOTB, LDS_OST=LDS_WS+NW*64*4, LDS_CS=LDS_OST+NW*4096, LDS_BYTES=LDS_CS+SEQ*4;
constexpr float C2=0.125f*1.4426950408889634f;
__device__ __forceinline__ void glds16(const void*gsrc,unsigned lds_dst){unsigned keep;
  asm volatile("s_mov_b32 %0, m0\n\ts_mov_b32 m0, %2\n\ts_nop 0\n\tglobal_load_lds_dwordx4 %1, off\n\ts_mov_b32 m0, %0":"=&s"(keep):"v"(gsrc),"s"(lds_dst):"memory");}
__device__ __forceinline__ float max3f(float a,float b,float c){float r;asm("v_max3_f32 %0, %1, %2, %3":"=v"(r):"v"(a),"v"(b),"v"(c));return r;}
__device__ __forceinline__ float max2f(float a,float b){float r;asm("v_max_f32_e32 %0, %1, %2":"=v"(r):"v"(a),"v"(b));return r;}
__device__ __forceinline__ float fadd_s(float a,float b){float r;asm("v_add_f32_e32 %0, %1, %2":"=v"(r):"v"(a),"v"(b));return r;}
__device__ __forceinline__ float fsub_s(float a,float b){float r;asm("v_sub_f32_e32 %0, %1, %2":"=v"(r):"v"(a),"v"(b));return r;}
typedef float f32x2_t __attribute__((ext_vector_type(2))); typedef float f32x4_t __attribute__((ext_vector_type(4))); typedef __bf16 bf16x2_t __attribute__((ext_vector_type(2)));
__device__ __forceinline__ unsigned cvtpk_s(float lo,float hi){f32x2_t v={lo,hi};bf16x2_t b=__builtin_convertvector(v,bf16x2_t);return __builtin_bit_cast(unsigned,b);}
#define WAIT_BAR(N) asm volatile("s_waitcnt vmcnt(" #N ") lgkmcnt(0)\n\ts_barrier":::"memory")

__device__ __forceinline__ void split3(float b,unsigned&h,unsigned&m,unsigned&l){
  h=cvtpk_s(b,0.f)&0xffffu; const float r1=b-__uint_as_float(h<<16);
  m=cvtpk_s(r1,0.f)&0xffffu; const float r2=r1-__uint_as_float(m<<16);
  l=cvtpk_s(r2,0.f)&0xffffu; }
__device__ __forceinline__ bf16x8 kbias_frag(float b,int hi){unsigned h,m,l;split3(b,h,m,l);u32x4 w;w.x=h|(m<<16);w.y=l|0x3F800000u;w.z=0x3F803F80u;w.w=0u;if(hi){w.x=0u;w.y=0u;w.z=0u;}return __builtin_bit_cast(bf16x8,w);}
__device__ __forceinline__ bf16x8 qref_frag(float x,int hi){unsigned h,m,l;split3(x,h,m,l);u32x4 w;w.x=0x3F803F80u;w.y=0x3F80u|(h<<16);w.z=m|(l<<16);w.w=0u;if(hi){w.x=0u;w.y=0u;w.z=0u;}return __builtin_bit_cast(bf16x8,w);}
__device__ __forceinline__ void qkt(f32x16&p0,f32x16&p1,const char*Kslot,const bf16x8*qr,bf16x8 kb0,bf16x8 kb1,bf16x8 qx,int r32,int hi){
  const f32x16 negm=f32x16{};
  const char*kb=Kslot+hi*1024+r32*16;
  #pragma unroll
  for(int d0=0;d0<4;++d0){
    const bf16x8 b0=*reinterpret_cast<const bf16x8*>(kb+d0*2048);
    const bf16x8 b1=*reinterpret_cast<const bf16x8*>(kb+d0*2048+512);
    if(d0==0){p0=__builtin_amdgcn_mfma_f32_32x32x16_bf16(b0,qr[0],negm,0,0,0);p1=__builtin_amdgcn_mfma_f32_32x32x16_bf16(b1,qr[0],negm,0,0,0);}
    else{p0=__builtin_amdgcn_mfma_f32_32x32x16_bf16(b0,qr[d0],p0,0,0,0);p1=__builtin_amdgcn_mfma_f32_32x32x16_bf16(b1,qr[d0],p1,0,0,0);}}
  p0=__builtin_amdgcn_mfma_f32_32x32x16_bf16(kb0,qx,p0,0,0,0);p1=__builtin_amdgcn_mfma_f32_32x32x16_bf16(kb1,qx,p1,0,0,0);
}
typedef __attribute__((address_space(3))) const char* lds_cptr;
typedef short v4i16_t __attribute__((ext_vector_type(4)));
__device__ __forceinline__ void kload8(bf16x8*kf,lds_cptr kp){
  kf[0]=*(const __attribute__((address_space(3))) bf16x8*)(kp);      kf[1]=*(const __attribute__((address_space(3))) bf16x8*)(kp+512);
  kf[2]=*(const __attribute__((address_space(3))) bf16x8*)(kp+2048); kf[3]=*(const __attribute__((address_space(3))) bf16x8*)(kp+2560);
  kf[4]=*(const __attribute__((address_space(3))) bf16x8*)(kp+4096); kf[5]=*(const __attribute__((address_space(3))) bf16x8*)(kp+4608);
  kf[6]=*(const __attribute__((address_space(3))) bf16x8*)(kp+6144); kf[7]=*(const __attribute__((address_space(3))) bf16x8*)(kp+6656);
}
__device__ __forceinline__ void kload2(bf16x8*kf,lds_cptr kp,int j){ kf[2*j]=*(const __attribute__((address_space(3))) bf16x8*)(kp+j*2048); kf[2*j+1]=*(const __attribute__((address_space(3))) bf16x8*)(kp+j*2048+512); }
__device__ __forceinline__ s16x4 vtr(lds_cptr p){ return __builtin_bit_cast(s16x4,__builtin_amdgcn_ds_read_tr16_b64_v4i16((__attribute__((address_space(3))) v4i16_t*)p)); }
__device__ __forceinline__ float rowmax(const f32x16&p0,const f32x16&p1){
  float a=max3f(p0[0],p0[1],p1[0]),b=max3f(p0[2],p0[3],p1[1]);a=max3f(a,p1[2],p1[3]);
  #pragma unroll
  for(int r=4;r<16;r+=4){a=max3f(a,p0[r],p0[r+1]);b=max3f(b,p0[r+2],p0[r+3]);a=max3f(a,p1[r],p1[r+1]);b=max3f(b,p1[r+2],p1[r+3]);}
  const float m=max2f(a,b);
  auto rr=__builtin_amdgcn_permlane32_swap(__float_as_uint(m),__float_as_uint(m),false,false);
  return max2f(__uint_as_float(rr[0]),__uint_as_float(rr[1]));
}
__device__ __forceinline__ void pv(f32x16*o,int vb,bf16x8 pa0,bf16x8 pa1,bf16x8 pa2,bf16x8 pa3){
  #pragma unroll
  for(int d0=0;d0<2;++d0){s16x4 lo[4],hi[4];
    #pragma unroll
    for(int ks=0;ks<4;++ks){
      asm volatile("ds_read_b64_tr_b16 %0,%1 offset:%c2":"=&v"(lo[ks]):"v"(vb),"i"(d0*4096+ks*1024):"memory");
      asm volatile("ds_read_b64_tr_b16 %0,%1 offset:%c2":"=&v"(hi[ks]):"v"(vb),"i"(d0*4096+ks*1024+512):"memory");}
    asm volatile("s_waitcnt lgkmcnt(0)":::"memory");SBAR();
    #define PK(k) (bf16x8){lo[k][0],lo[k][1],lo[k][2],lo[k][3],hi[k][0],hi[k][1],hi[k][2],hi[k][3]}
    o[d0]=__builtin_amdgcn_mfma_f32_32x32x16_bf16(pa0,PK(0),o[d0],0,0,0);
    o[d0]=__builtin_amdgcn_mfma_f32_32x32x16_bf16(pa1,PK(1),o[d0],0,0,0);
    o[d0]=__builtin_amdgcn_mfma_f32_32x32x16_bf16(pa2,PK(2),o[d0],0,0,0);
    o[d0]=__builtin_amdgcn_mfma_f32_32x32x16_bf16(pa3,PK(3),o[d0],0,0,0);
    #undef PK
  }
}

#ifndef ATTN_STORE16
#define ATTN_STORE16(p,v) (*(u32x4*)(p)=(v))
#endif
template<int THRL> __device__ __forceinline__ void attn_unit(int b,int h,int qb,const bf16*Q,const bf16* K,const bf16* V,bf16*O,const float*LF,char*shm){
  int tid_=threadIdx.x; asm volatile("":"+v"(tid_));
  const int tid=tid_,lane=tid&63,r32=lane&31,hi=lane>>5; const int wid=__builtin_amdgcn_readfirstlane(tid>>6);
  const long rowbase=(long)b*SEQ; const int q0=qb*QB;
  float*csl=(float*)(shm+LDS_CS); float cq0;
  { const int n=q0+QB; const float*lf=LF+((long)b*NHEAD+h)*SEQ; float*wt=(float*)(shm+LDS_WS);
    f32x4_t va={0.f,0.f,0.f,0.f},vb={0.f,0.f,0.f,0.f};
    if(8*tid<n){ va=*(const f32x4_t*)(lf+8*tid); vb=*(const f32x4_t*)(lf+8*tid+4); }
    va[1]+=va[0];va[2]+=va[1];va[3]+=va[2];vb[0]+=va[3];vb[1]+=vb[0];vb[2]+=vb[1];vb[3]+=vb[2];
    const float tot=vb[3]; float inc=tot;
    #pragma unroll
    for(int o_=1;o_<64;o_<<=1){const float nn=__shfl_up(inc,o_);if(lane>=o_)inc+=nn;}
    if(lane==63)wt[wid*64]=inc;
    __syncthreads();
    float base=inc-tot;
    #pragma unroll
    for(int w_=0;w_<NW;++w_){const float x_=wt[w_*64]; if(w_<wid)base+=x_;}
    if(8*tid<n){ va=va+base; vb=vb+base; *(f32x4_t*)(csl+8*tid)=va; *(f32x4_t*)(csl+8*tid+4)=vb; }
    __syncthreads();
    cq0=csl[q0]; }
  const bf16*Qw=Q+(rowbase+q0+wid*QBLK)*DM+h*D;
  const bf16*Kh=K+rowbase*DM+h*D,*Vh=V+rowbase*DM+h*D;
  const unsigned lds0=(unsigned)(uintptr_t)shm;
  float*wsf=(float*)(shm+LDS_WS)+wid*64;
  const bf16*ksrc=Kh+(long)lane*DM+wid*8;
  const bf16*vsrc=Vh+(long)(16*(wid&3)+(lane>>2))*DM+(wid>>2)*32+(lane&3)*8;
  const unsigned kdst=lds0+LDS_K+wid*1024, vdst=lds0+LDS_V+wid*1024;
  #define DMA_K(t,slot) glds16(ksrc+(long)(t)*KVBLK*DM,(unsigned)__builtin_amdgcn_readfirstlane(kdst+(slot)))
  #define DMA_V(t,slot) glds16(vsrc+(long)(t)*KVBLK*DM,(unsigned)__builtin_amdgcn_readfirstlane(vdst+(slot)))
  const int vb0=(int)(lds0+LDS_V)+((lane>>4)&1)*32+(lane&3)*8+(4*hi+((lane&15)>>2))*64;
  const char*Kbase=shm+LDS_K; bf16x8 kf[8];
  const lds_cptr shm3=(lds_cptr)shm; const lds_cptr kp0=shm3+LDS_K+hi*1024+r32*16; const lds_cptr vp0=shm3+LDS_V+((lane>>4)&1)*32+(lane&3)*8+(4*hi+((lane&15)>>2))*64;
  const int NT=(q0+QB)/KVBLK;
  DMA_K(0,0);DMA_V(0,0);DMA_K(1,SLOTB);
  bf16x8 qr[4];
  #pragma unroll
  for(int d0=0;d0<4;++d0)qr[d0]=*reinterpret_cast<const bf16x8*>(&Qw[(long)r32*DM+d0*16+hi*8]);
  float mhat=0.f,l_reg=0.f;f32x16 o[2];o[0]=f32x16{};o[1]=f32x16{};const f32x16 negm=f32x16{};
  bf16x8 qx=qref_frag(0.f,hi);
  const int qrel=wid*QBLK+r32;
  #define CMASK(P0,P1,t) do{int jb_=(t)-(NT-4); if(jb_>=0)cmask(P0,P1,jb_,qrel,hi);}while(0)
  bool resc=false;
  #define START(P0,P1) do{ const float rm=rowmax(P0,P1); resc=false; \
    { const float dl=rm; mhat=fadd_s(mhat,dl); \
      _Pragma("unroll") for(int r=0;r<16;++r){P0[r]=fsub_s(P0[r],dl);P1[r]=fsub_s(P1[r],dl);} \
      qx=qref_frag(-mhat,hi); } \
    _Pragma("unroll") for(int r=0;r<16;++r)P0[r]=__builtin_amdgcn_exp2f(P0[r]); }while(0)
  #define RESC() do{ if(resc){ asm volatile("s_waitcnt lgkmcnt(0)":::"memory"); \
      _Pragma("unroll") for(int d_=0;d_<2;++d_) _Pragma("unroll") for(int r=0;r<16;++r)o[d_][r]*=wsf[crow(r,hi)]; } }while(0)
  f32x16 pA0,pA1,pB0,pB1;
  int sl_prev=0,sl_cur=0,sl_next=SLOTB;
  #define ROT() do{sl_prev=sl_cur;sl_cur=sl_next;sl_next=(sl_next==(NSLOT-1)*SLOTB)?0:sl_next+SLOTB;}while(0)
  DMA_K(2,2*SLOTB);
  WAIT_BAR(3);
  qkt(pA0,pA1,Kbase,qr,kbias_frag(cq0-csl[r32],hi),kbias_frag(cq0-csl[32+r32],hi),qx,r32,hi);asm volatile("s_nop 15\n\ts_nop 7":"+v"(pA0),"+v"(pA1));CMASK(pA0,pA1,0);
  START(pA0,pA1);
  _Pragma("unroll") for(int r=0;r<16;++r)pA1[r]=__builtin_amdgcn_exp2f(pA1[r]);
  WAIT_BAR(0);
  DMA_K(3,0);DMA_V(1,SLOTB);
  ROT();
  kload8(kf,kp0+sl_cur);
  WAIT_BAR(2);
  s16x4 vlo[8],vhi[8]; u32x4 pw0,pw1,pw2,pw3;
  #define PKW(P,B) cvtpk_s(P[B],P[B+1])
  #define PAF(k) __builtin_bit_cast(bf16x8,pw##k)
  #define VFR(i) (bf16x8){vlo[i][0],vlo[i][1],vlo[i][2],vlo[i][3],vhi[i][0],vhi[i][1],vhi[i][2],vhi[i][3]}
  #define PIN(x) asm volatile("":"+v"(x))
  #define MX3(a,b,c) __builtin_fmaxf(__builtin_fmaxf((a),(b)),(c))
  #define GAPA(MF,A0,A1,A2,A3,W0,W1,PW) do{ MF; sacc+=A0; sacc+=A1; sacc+=A2; sacc+=A3; PIN(sacc); W0; W1; PIN(PW); SBAR(); }while(0)
  #define EX(v) __builtin_amdgcn_exp2f(v)
  #define GAPB(MF,X,B) do{ MF; X[B]=EX(X[B]); X[B+1]=EX(X[B+1]); X[B+2]=EX(X[B+2]); X[B+3]=EX(X[B+3]); PIN(X); SBAR(); }while(0)
  #define VRD(i) do{ vlo[i]=vtr(vp_+(((i)>>2)*4096+((i)&3)*1024)); vhi[i]=vtr(vp_+(((i)>>2)*4096+((i)&3)*1024+512)); }while(0)
  #define KRD(G,j) do{ if(G){ kload2(kf,kp0+sl_next,j); SBAR(); } }while(0)
  #define STEP(C0,C1,P0,P1,t,GK,GV,GL) do{ SBAR(); \
    const lds_cptr vp_=vp0+sl_prev; const float nb0_=csl[64*(t)+r32],nb1_=csl[64*(t)+32+r32]; \
    VRD(0); SBAR(); float sacc=(P0[0]+P0[1]); \
    GAPA(C0=__builtin_amdgcn_mfma_f32_32x32x16_bf16(kf[0],qr[0],negm,0,0,0), P0[2],P0[3],P0[4],P0[5],     pw0[0]=PKW(P0,0), pw0[1]=PKW(P0,2), pw0); \
    VRD(4); SBAR(); GAPA(C1=__builtin_amdgcn_mfma_f32_32x32x16_bf16(kf[1],qr[0],negm,0,0,0), P0[6],P0[7],P0[8],P0[9],     pw0[2]=PKW(P0,4), pw0[3]=PKW(P0,6), pw0); \
    VRD(1); SBAR(); GAPA(C0=__builtin_amdgcn_mfma_f32_32x32x16_bf16(kf[2],qr[1],C0,0,0,0),   P0[10],P0[11],P0[12],P0[13], pw1[0]=PKW(P0,8), pw1[1]=PKW(P0,10), pw1); \
    VRD(5); SBAR(); GAPA(C1=__builtin_amdgcn_mfma_f32_32x32x16_bf16(kf[3],qr[1],C1,0,0,0),   P0[14],P0[15],P1[0],P1[1],   pw1[2]=PKW(P0,12),pw1[3]=PKW(P0,14), pw1); \
    VRD(2); SBAR(); GAPA(C0=__builtin_amdgcn_mfma_f32_32x32x16_bf16(kf[4],qr[2],C0,0,0,0),   P1[2],P1[3],P1[4],P1[5],     pw2[0]=PKW(P1,0), pw2[1]=PKW(P1,2), pw2); \
    VRD(6); SBAR(); GAPA(C1=__builtin_amdgcn_mfma_f32_32x32x16_bf16(kf[5],qr[2],C1,0,0,0),   P1[6],P1[7],P1[8],P1[9],     pw2[2]=PKW(P1,4), pw2[3]=PKW(P1,6), pw2); \
    VRD(3); SBAR(); GAPA(C0=__builtin_amdgcn_mfma_f32_32x32x16_bf16(kf[6],qr[3],C0,0,0,0),   P1[10],P1[11],P1[12],P1[13], pw3[0]=PKW(P1,8), pw3[1]=PKW(P1,10), pw3); \
    VRD(7); SBAR(); GAPA(C1=__builtin_amdgcn_mfma_f32_32x32x16_bf16(kf[7],qr[3],C1,0,0,0),   P1[14],P1[15],0.f,0.f,       pw3[2]=PKW(P1,12),pw3[3]=PKW(P1,14), pw3); \
    { const bf16x8 kb0_=kbias_frag(cq0-nb0_,hi),kb1_=kbias_frag(cq0-nb1_,hi); C0=__builtin_amdgcn_mfma_f32_32x32x16_bf16(kb0_,qx,C0,0,0,0); C1=__builtin_amdgcn_mfma_f32_32x32x16_bf16(kb1_,qx,C1,0,0,0); } SBAR(); \
    l_reg+=sacc; \
    if(GK){DMA_K((t)+3,sl_cur);} if(GV){DMA_V((t)+1,sl_next);} \
    CMASK(C0,C1,t); \
    { float a=MX3(C0[0],C0[1],C1[0]),b=MX3(C0[2],C0[3],C1[1]); a=MX3(a,C1[2],C1[3]); \
      _Pragma("unroll") for(int r=4;r<16;r+=4){a=MX3(a,C0[r],C0[r+1]);b=MX3(b,C0[r+2],C0[r+3]);a=MX3(a,C1[r],C1[r+1]);b=MX3(b,C1[r+2],C1[r+3]);} \
      float rm=__builtin_fmaxf(a,b); { auto rr=__builtin_amdgcn_permlane32_swap(__float_as_uint(rm),__float_as_uint(rm),false,false); rm=__builtin_fmaxf(__uint_as_float(rr[0]),__uint_as_float(rr[1])); } \
      resc=false; \
      if(__builtin_expect(__any(rm>(float)THRL),0)){ const float dl=__builtin_fmaxf(rm,0.f); mhat+=dl; \
        _Pragma("unroll") for(int r=0;r<16;++r){C0[r]-=dl;C1[r]-=dl;} \
        qx=qref_frag(-mhat,hi); \
        const float f=__builtin_amdgcn_exp2f(-dl); l_reg*=f; if(hi==0)wsf[r32]=f; resc=true; } } \
    SBAR(); \
    GAPB(o[0]=__builtin_amdgcn_mfma_f32_32x32x16_bf16(PAF(0),VFR(0),o[0],0,0,0), C0,0); \
    GAPB(o[1]=__builtin_amdgcn_mfma_f32_32x32x16_bf16(PAF(0),VFR(4),o[1],0,0,0), C0,4); \
    KRD(GL,0); GAPB(o[0]=__builtin_amdgcn_mfma_f32_32x32x16_bf16(PAF(1),VFR(1),o[0],0,0,0), C0,8); \
    KRD(GL,1); GAPB(o[1]=__builtin_amdgcn_mfma_f32_32x32x16_bf16(PAF(1),VFR(5),o[1],0,0,0), C0,12); \
    KRD(GL,2); GAPB(o[0]=__builtin_amdgcn_mfma_f32_32x32x16_bf16(PAF(2),VFR(2),o[0],0,0,0), C1,0); \
    KRD(GL,3); GAPB(o[1]=__builtin_amdgcn_mfma_f32_32x32x16_bf16(PAF(2),VFR(6),o[1],0,0,0), C1,4); \
    GAPB(o[0]=__builtin_amdgcn_mfma_f32_32x32x16_bf16(PAF(3),VFR(3),o[0],0,0,0), C1,8); \
    GAPB(o[1]=__builtin_amdgcn_mfma_f32_32x32x16_bf16(PAF(3),VFR(7),o[1],0,0,0), C1,12); \
    }while(0)
  int t=1;
  #undef CMASK
  #define CMASK(P0,P1,t) do{}while(0)
  for(;t+5<NT;t+=2){
    STEP(pB0,pB1,pA0,pA1,t,true,true,true);     WAIT_BAR(2); RESC(); ROT();
    STEP(pA0,pA1,pB0,pB1,t+1,true,true,true);   WAIT_BAR(2); RESC(); ROT();
  }
  #undef CMASK
  #define CMASK(P0,P1,t) do{int jb_=(t)-(NT-4); if(jb_>=0)cmask(P0,P1,jb_,qrel,hi);}while(0)
  #define ENDW(tt) do{ if((tt)+3<NT){WAIT_BAR(2);} else if((tt)+2<NT){WAIT_BAR(1);} else {WAIT_BAR(0);} }while(0)
  for(;t+1<NT;t+=2){
    STEP(pB0,pB1,pA0,pA1,t,(t+3<NT),(t+1<NT),(t+1<NT));       ENDW(t);   RESC(); ROT();
    STEP(pA0,pA1,pB0,pB1,t+1,(t+4<NT),(t+2<NT),(t+2<NT));     ENDW(t+1); RESC(); ROT();
  }
  STEP(pB0,pB1,pA0,pA1,NT-1,false,false,false); RESC();
  { float sacc=pB0[0]+pB0[1]; _Pragma("unroll") for(int r=2;r<16;++r)sacc+=pB0[r]; _Pragma("unroll") for(int r=0;r<16;++r)sacc+=pB1[r]; l_reg+=sacc;
    pw0=(u32x4){PKW(pB0,0),PKW(pB0,2),PKW(pB0,4),PKW(pB0,6)};pw1=(u32x4){PKW(pB0,8),PKW(pB0,10),PKW(pB0,12),PKW(pB0,14)};pw2=(u32x4){PKW(pB1,0),PKW(pB1,2),PKW(pB1,4),PKW(pB1,6)};pw3=(u32x4){PKW(pB1,8),PKW(pB1,10),PKW(pB1,12),PKW(pB1,14)};
    SBAR(); pv(o,vb0+sl_cur,PAF(0),PAF(1),PAF(2),PAF(3)); }
  #undef PKW
  #undef PAF
  #undef VFR
  #undef PIN
  #undef MX3
  #undef GAPA
  #undef GAPB
  #undef EX
  #undef VRD
  #undef KRD
  #undef STEP
  #undef ENDW
  {auto rr=__builtin_amdgcn_permlane32_swap(__float_as_uint(l_reg),__float_as_uint(l_reg),false,false);l_reg=__uint_as_float(rr[0])+__uint_as_float(rr[1]);}
  if(hi==0)wsf[32+r32]=l_reg;asm volatile("s_waitcnt lgkmcnt(0)":::"memory");
  float rli[16];
  #pragma unroll
  for(int r=0;r<16;++r)rli[r]=__builtin_amdgcn_rcpf(wsf[32+crow(r,hi)]);
  bf16*Ow=O+(rowbase+q0+wid*QBLK)*OPITCH+h*D;
  { bf16*stg=(bf16*)(shm+LDS_OST)+wid*2048;
    #pragma unroll
    for(int r=0;r<16;++r){const int orow=crow(r,hi);
      #pragma unroll
      for(int d0=0;d0<2;++d0)stg[orow*64+d0*32+r32]=__float2bfloat16(o[d0][r]*rli[r]);}
    asm volatile("s_waitcnt lgkmcnt(0)":::"memory");
    #pragma unroll
    for(int i=0;i<4;++i){const int row=i*8+(lane>>3),ch=lane&7; const u32x4 v=*(const u32x4*)(stg+row*64+ch*8); ATTN_STORE16(Ow+(long)row*OPITCH+ch*8,v);} }
  asm volatile("s_waitcnt lgkmcnt(0)\n\ts_barrier":::"memory");
  #undef DMA_K
  #undef DMA_V
  #undef CMASK
  #undef START
  #undef RESC
  #undef ROT
}
constexpr int ATTN_LDS_BYTES=LDS_BYTES;
struct AttnTensors { const bf16* Q; const bf16* K; const bf16* V; bf16* O; const float* LF; };
struct AttnUnit { int bh; int qb; };
struct StaticOrder {
  int vcu,grid;
  __device__ __forceinline__ explicit StaticOrder(int grid_,int block):vcu((grid_%8==0)?(block%8)*(grid_/8)+block/8:block),grid(grid_){}
  __device__ __forceinline__ bool next(int i,AttnUnit&u)const{
    if(grid==256){ if(i>=4)return false; const int s=vcu&3; u.bh=vcu>>2; u.qb=(i==0)?s:(i==1)?7-s:(i==2)?8+s:15-s; return true; }
    const int L=i*grid+vcu; if(L>=BATCH*NHEAD*NQB)return false; u.bh=L/NQB; u.qb=L%NQB; return true; }
  __device__ __forceinline__ void a_ready(const AttnUnit&)const{}
  __device__ __forceinline__ void done(const AttnUnit&)const{}
};
template<class Sched,int THRL=8> __device__ __forceinline__ void attn_phase(char*lds,const AttnTensors&T,const Sched&S){
  AttnUnit u;
  for(int i=0;S.next(i,u);++i){ S.a_ready(u); attn_unit<THRL>(u.bh/NHEAD,u.bh%NHEAD,u.qb,T.Q,T.K,T.V,T.O,T.LF,lds); S.done(u); }
}
#undef SBAR
#undef WAIT_BAR
}
namespace fx {
using namespace nv;
typedef unsigned short bf16;
typedef unsigned v4u __attribute__((ext_vector_type(4)));
typedef float f32x4 __attribute__((ext_vector_type(4)));
constexpr float C2 = 0.125f * 1.4426950408889634f;
constexpr int NIN = 3328;
constexpr int QKVP = 3072;
constexpr int P_FQ = 0, P_FK = 512, P_FV = 1024, P_GQ = 1536, P_GK = 1792, P_GV = 2048, P_GR = 2560;
__device__ __forceinline__ int inproj_src(int d) {
    if (d < 1536) return d;
    if (d < 1792) return O_GQ + (d - 1536);
    if (d < 2048) return O_GK + (d - 1792);
    if (d < 2560) return O_GV + (d - 2048);
    if (d < 3072) return O_GR + (d - 2560);
    if (d < 3080) return O_FF + (d - 3072);
    if (d < 3096) return O_GA + (d - 3080);
    return -1;
}
__device__ __forceinline__ unsigned f2bf(float f) { unsigned u = __builtin_bit_cast(unsigned, f); return (u + 0x7fffu + ((u >> 16) & 1u)) >> 16; }
__device__ __forceinline__ unsigned pk2(float lo, float hi) { return f2bf(lo) | (f2bf(hi) << 16); }
__device__ __forceinline__ float bf2f(unsigned short h) { return __builtin_bit_cast(float, (unsigned)h << 16); }
__device__ __forceinline__ float wave_sum(float v) {
#pragma unroll
    for (int o = 1; o < 64; o <<= 1) v += __shfl_xor(v, o);
    return v;
}
#define FX_LDS_WAIT() asm volatile("s_waitcnt lgkmcnt(0)" ::: "memory")

template <class Map> __device__ __forceinline__ void transpose_item(const float* __restrict__ W, int K, int N, bf16* WT, LAS float* scr, int kb, int nb, int lane, Map srcmap) {
    const int k0 = 64 * kb, n0 = 32 * nb;
    const int src = srcmap(n0 + (lane & 31));
#pragma unroll 8
    for (int i = 0; i < 32; ++i) { const int kk = 2 * i + (lane >> 5); scr[kk * 33 + (lane & 31)] = (src >= 0) ? W[(size_t)(k0 + kk) * N + src] : 0.f; }
    FX_LDS_WAIT(); asm volatile("" ::: "memory");
    const int c = lane & 7;
#pragma unroll
    for (int j = 0; j < 4; ++j) { const int n = (lane >> 3) + 8 * j; const LAS float* s = scr + (8 * c) * 33 + n;
        v4u o; o.x = pk2(s[0 * 33], s[1 * 33]); o.y = pk2(s[2 * 33], s[3 * 33]); o.z = pk2(s[4 * 33], s[5 * 33]); o.w = pk2(s[6 * 33], s[7 * 33]);
        *(GAS v4u*)(WT + (size_t)(n0 + n) * K + k0 + 8 * c) = o; }
    FX_LDS_WAIT(); asm volatile("" ::: "memory");
}

__device__ __forceinline__ void ln_row_bf16(const float* xrow, const float* __restrict__ g, const float* __restrict__ b, bf16* orow, float* frow, float* st, int lane) {
    const GAS f32x4* xr = (const GAS f32x4*)xrow + lane;
    f32x4 v[4]; float s = 0.f;
#pragma unroll
    for (int j = 0; j < 4; ++j) { v[j] = xr[64 * j]; s += (v[j].x + v[j].y) + (v[j].z + v[j].w); }
    const float mean = wave_sum(s) * (1.f / D); float s2 = 0.f;
#pragma unroll
    for (int j = 0; j < 4; ++j) { v[j] = v[j] - mean; s2 += (v[j].x * v[j].x + v[j].y * v[j].y) + (v[j].z * v[j].z + v[j].w * v[j].w); }
    const float rstd = 1.f / sqrtf(wave_sum(s2) * (1.f / D) + LN_EPS);
    if (st && lane == 0) { st[0] = mean; st[1] = rstd; }
    GAS unsigned long long* o8 = (GAS unsigned long long*)orow + lane;
#pragma unroll
    for (int j = 0; j < 4; ++j) {
        const f32x4 gg = ((const f32x4*)g)[lane + 64 * j], bb = ((const f32x4*)b)[lane + 64 * j];
        const f32x4 o = v[j] * rstd * gg + bb;
        o8[64 * j] = (unsigned long long)pk2(o.x, o.y) | ((unsigned long long)pk2(o.z, o.w) << 32);
        if (frow) ((GAS f32x4*)frow)[lane + 64 * j] = o;
    }
}

struct CvItem { const float* W; bf16* WT; int N, K, k0, n0, s0; };
__device__ __forceinline__ void cv_load(const CvItem& it, f32x4 (&v)[8], int lane) {
    const float* p = it.W + (size_t)(it.k0 + (lane >> 3)) * it.N + it.s0 + 4 * (lane & 7);
#pragma unroll
    for (int i = 0; i < 8; ++i) v[i] = __builtin_nontemporal_load((const f32x4*)(p + (size_t)(8 * i) * it.N));
}
__device__ __forceinline__ void cv_finish(const CvItem& it, const f32x4 (&v)[8], LAS float* scr, int lane) {
    const int rr = lane >> 3, cq = lane & 7;
#pragma unroll
    for (int i = 0; i < 8; ++i) { LAS float* d = scr + (8 * i + rr) * 33 + 4 * cq; d[0] = v[i][0]; d[1] = v[i][1]; d[2] = v[i][2]; d[3] = v[i][3]; }
    FX_LDS_WAIT(); asm volatile("" ::: "memory");
    const int c = lane & 7;
#pragma unroll
    for (int j = 0; j < 4; ++j) { const int n = (lane >> 3) + 8 * j; const LAS float* s = scr + (8 * c) * 33 + n;
        v4u o; o.x = pk2(s[0 * 33], s[1 * 33]); o.y = pk2(s[2 * 33], s[3 * 33]); o.z = pk2(s[4 * 33], s[5 * 33]); o.w = pk2(s[6 * 33], s[7 * 33]);
        *(GAS v4u*)(it.WT + (size_t)(it.n0 + n) * it.K + it.k0 + 8 * c) = o; }
    FX_LDS_WAIT(); asm volatile("" ::: "memory");
}
}

namespace pg8 {
struct EpiInProj {
    static constexpr bool PERM = true, AFTER_DRAIN = false;
    bf16_t* QKV; float* FG; float* LF; const float* bfg;
    __device__ __forceinline__ void operator()(const f32x4 (&acc)[2][2][4][2], const Unit& u, int wr, int wc, int fr, int fq) const {
        const int row0 = u.pm * BM + wr * 64 + fr;
        if (u.pn < 12) {
            const float sc = (u.pn < 2) ? fx::C2 : 1.f;
            const int col0 = u.pn * BM + wc * 32 + 8 * fq;
#pragma unroll
            for (int ai = 0; ai < 2; ++ai)
#pragma unroll
                for (int m = 0; m < 4; ++m) { bf16_t* rowp = QKV + (size_t)(row0 + ai * HALF + m * 16) * fx::QKVP + col0;
#pragma unroll
                    for (int bj = 0; bj < 2; ++bj) { const f32x4 v0 = acc[ai][bj][m][0] * sc, v1 = acc[ai][bj][m][1] * sc;
                        u32x4 w; w.x = cvt_pk_bf16(v0[0], v0[1]); w.y = cvt_pk_bf16(v0[2], v0[3]); w.z = cvt_pk_bf16(v1[0], v1[1]); w.w = cvt_pk_bf16(v1[2], v1[3]);
                        *(u32x4*)(rowp + bj * HALF) = w; } }
        } else if (wc == 0 && fq < 3) {
#pragma unroll
            for (int ai = 0; ai < 2; ++ai)
#pragma unroll
                for (int m = 0; m < 4; ++m) { const int row = row0 + ai * HALF + m * 16; float* p = FG + (size_t)row * 32 + 8 * fq;
                    *(f32x4*)p = acc[ai][0][m][0]; *(f32x4*)(p + 4) = acc[ai][0][m][1];
                    if (fq == 0) { const int b = row >> 12, s = row & 4095;
#pragma unroll
                        for (int n = 0; n < 2; ++n)
#pragma unroll
                            for (int i = 0; i < 4; ++i) { const int h = 4 * n + i; LF[(size_t)(b * 8 + h) * nv::S + s] = 1.4426950408889634f * nv::logsigmoidf(acc[ai][0][m][n][i] + bfg[h]); } } }
        }
    }
};
}
namespace gl {
using namespace nv;
typedef unsigned short bf16;
typedef short bf16x8 __attribute__((ext_vector_type(8)));
typedef float f32x4 __attribute__((ext_vector_type(4)));
typedef unsigned u32x4 __attribute__((ext_vector_type(4)));
typedef unsigned u32x2 __attribute__((ext_vector_type(2)));
constexpr int NCH = S / 64;
constexpr int NUNIT = B * GH * NCH;
constexpr int LS = 72;
constexpr int L_WGU = 0, L_BG = 4096, L_QP = 8192, L_KP = L_QP + 64 * LS * 2, L_KPT = L_KP + 64 * LS * 2, L_VT = L_KPT + 64 * LS * 2, L_PP = L_VT + 128 * LS * 2, L_WT = L_PP + 64 * LS * 2, L_END = L_WT + 2048;
static_assert(L_END <= 131072, "gla prep LDS");
constexpr int C_ST = 0, C_PART = 128 * LS * 2, C_END = C_PART + 2 * 8 * 64 * 4;
constexpr size_t QPG_B = 64 * 64 * 2, OI_B = 8 * 4 * 64 * 16, UU_B = OI_B, DEC_B = 256;

__device__ __forceinline__ unsigned pkbf(float lo, float hi) { typedef float f2 __attribute__((ext_vector_type(2))); typedef __bf16 b2 __attribute__((ext_vector_type(2))); f2 v = {lo, hi}; b2 r = __builtin_convertvector(v, b2); return __builtin_bit_cast(unsigned, r); }
__device__ __forceinline__ float bf2f(unsigned short h) { return __builtin_bit_cast(float, (unsigned)h << 16); }
__device__ __forceinline__ float bflo(unsigned w) { return __builtin_bit_cast(float, w << 16); }
__device__ __forceinline__ float bfhi(unsigned w) { return __builtin_bit_cast(float, w & 0xffff0000u); }

__device__ __forceinline__ void prep_unit(int unit, const bf16* QKV, const float* FG, const float* __restrict__ wgu, const float* __restrict__ bgate,
                                          unsigned char* QPG, unsigned char* OI, unsigned char* UU, float* DEC, unsigned char* lds, int& cur_h) {
    int tid_ = threadIdx.x; asm volatile("" : "+v"(tid_));
    const int tid = tid_, lane = tid & 63, wid = __builtin_amdgcn_readfirstlane(tid >> 6), l15 = lane & 15, g = lane >> 4;
    const int n = unit % NCH, bh = unit / NCH, h = bh % GH, b = bh / GH;
    const size_t row0 = (size_t)b * S + (size_t)n * 64;
    float* WGU = (float*)(lds + L_WGU); float* BG = (float*)(lds + L_BG); float* WT = (float*)(lds + L_WT);
    bf16* QP = (bf16*)(lds + L_QP); bf16* KP = (bf16*)(lds + L_KP); bf16* KPT = (bf16*)(lds + L_KPT); bf16* VT = (bf16*)(lds + L_VT); bf16* PP = (bf16*)(lds + L_PP);
    if (cur_h != h) { __syncthreads(); for (int i = tid; i < 16 * 64; i += 512) WGU[i] = wgu[(i >> 6) * 256 + h * 64 + (i & 63)]; if (tid < 64) BG[tid] = bgate[h * 64 + tid]; cur_h = h; __syncthreads(); }
    const int t = tid >> 3, oc = tid & 7, d0 = oc * 8;
    float la[8];
    { const float* gp = FG + (row0 + t) * 32 + 8;
      f32x4 ga4[4];
#pragma unroll
      for (int i = 0; i < 4; ++i) ga4[i] = *(const f32x4*)(gp + 4 * i);
#pragma unroll
      for (int j = 0; j < 8; ++j) la[j] = BG[d0 + j];
#pragma unroll
      for (int r = 0; r < 16; ++r) { const float gv = ga4[r >> 2][r & 3]; const f32x4 w0 = *(const f32x4*)(WGU + r * 64 + d0), w1 = *(const f32x4*)(WGU + r * 64 + d0 + 4);
#pragma unroll
          for (int j = 0; j < 4; ++j) { la[j] += gv * w0[j]; la[4 + j] += gv * w1[j]; } }
#pragma unroll
      for (int j = 0; j < 8; ++j) la[j] = logsigmoidf(la[j]) * (1.f / 16.f); }
    const u32x4 qv = *(const u32x4*)(QKV + (row0 + t) * fx::QKVP + fx::P_GQ + h * 64 + d0);
    const u32x4 kv = *(const u32x4*)(QKV + (row0 + t) * fx::QKVP + fx::P_GK + h * 64 + d0);
    const u32x4 vv0 = *(const u32x4*)(QKV + (row0 + t) * fx::QKVP + fx::P_GV + h * 128 + oc * 16);
    const u32x4 vv1 = *(const u32x4*)(QKV + (row0 + t) * fx::QKVP + fx::P_GV + h * 128 + oc * 16 + 8);
#pragma unroll
    for (int off = 8; off < 64; off <<= 1) {
#pragma unroll
        for (int j = 0; j < 8; ++j) { const float o = __shfl_up(la[j], off); if (lane >= off) la[j] += o; } }
    if (lane >= 56) {
#pragma unroll
        for (int j = 0; j < 8; ++j) WT[wid * 64 + d0 + j] = la[j]; }
    __syncthreads();
    float bl[8];
#pragma unroll
    for (int j = 0; j < 8; ++j) bl[j] = 0.f;
#pragma unroll
    for (int w = 0; w < 8; ++w) {
        const f32x4 a0 = *(const f32x4*)(WT + w * 64 + d0), a1 = *(const f32x4*)(WT + w * 64 + d0 + 4);
#pragma unroll
        for (int j = 0; j < 4; ++j) { bl[j] += a0[j]; bl[4 + j] += a1[j]; if (w < wid) { la[j] += a0[j]; la[4 + j] += a1[j]; } } }
    {
        const unsigned qw[4] = {qv.x, qv.y, qv.z, qv.w}, kw[4] = {kv.x, kv.y, kv.z, kv.w};
        float qf[8], kf[8];
#pragma unroll
        for (int i = 0; i < 4; ++i) { qf[2 * i] = bflo(qw[i]); qf[2 * i + 1] = bfhi(qw[i]); kf[2 * i] = bflo(kw[i]); kf[2 * i + 1] = bfhi(kw[i]); }
        float qp[8], kp[8], kpp[8];
#pragma unroll
        for (int j = 0; j < 8; ++j) { const float bb = la[j] * 1.4426950408889634f, bbl = bl[j] * 1.4426950408889634f;
            qp[j] = qf[j] * (0.125f * exp2f(bb)); kp[j] = kf[j] * exp2f(-bb); kpp[j] = kf[j] * exp2f(bbl - bb); }
        u32x4 qo, ko; qo.x = pkbf(qp[0], qp[1]); qo.y = pkbf(qp[2], qp[3]); qo.z = pkbf(qp[4], qp[5]); qo.w = pkbf(qp[6], qp[7]);
        ko.x = pkbf(kp[0], kp[1]); ko.y = pkbf(kp[2], kp[3]); ko.z = pkbf(kp[4], kp[5]); ko.w = pkbf(kp[6], kp[7]);
        *(u32x4*)(QP + t * LS + d0) = qo; *(u32x4*)(KP + t * LS + d0) = ko;
        *(u32x4*)(QPG + (size_t)unit * QPG_B + (size_t)(t * 64 + d0) * 2) = qo;
#pragma unroll
        for (int j = 0; j < 8; ++j) KPT[(d0 + j) * LS + t] = (bf16)(pkbf(kpp[j], 0.f) & 0xffffu);
        const unsigned vw[8] = {vv0.x, vv0.y, vv0.z, vv0.w, vv1.x, vv1.y, vv1.z, vv1.w};
#pragma unroll
        for (int i = 0; i < 8; ++i) { VT[(oc * 16 + 2 * i) * LS + t] = (bf16)(vw[i] & 0xffffu); VT[(oc * 16 + 2 * i + 1) * LS + t] = (bf16)(vw[i] >> 16); }
        if (t == 0) {
#pragma unroll
            for (int j = 0; j < 8; ++j) DEC[(size_t)unit * 64 + d0 + j] = exp2f(bl[j] * 1.4426950408889634f); }
    }
    __syncthreads();
    { const int ti = wid >> 1;
#pragma unroll
      for (int q2 = 0; q2 < 2; ++q2) { const int sj = 2 * (wid & 1) + q2;
          f32x4 acc = {0.f, 0.f, 0.f, 0.f};
          if (sj <= ti) {
#pragma unroll
              for (int ks = 0; ks < 2; ++ks) { const bf16x8 a = *(const bf16x8*)(QP + (16 * ti + l15) * LS + 32 * ks + 8 * g), bb = *(const bf16x8*)(KP + (16 * sj + l15) * LS + 32 * ks + 8 * g);
                  acc = __builtin_amdgcn_mfma_f32_16x16x32_bf16(a, bb, acc, 0, 0, 0); }
              if (sj == ti) {
#pragma unroll
                  for (int r = 0; r < 4; ++r) if (l15 > 4 * g + r) acc[r] = 0.f; }
          }
#pragma unroll
          for (int r = 0; r < 4; ++r) PP[(16 * ti + 4 * g + r) * LS + 16 * sj + l15] = (bf16)(pkbf(acc[r], 0.f) & 0xffffu);
      } }
    __syncthreads();
    { bf16x8 vb[2];
#pragma unroll
      for (int ks = 0; ks < 2; ++ks) vb[ks] = *(const bf16x8*)(VT + (16 * wid + l15) * LS + 32 * ks + 8 * g);
#pragma unroll
      for (int m = 0; m < 4; ++m) { f32x4 acc = {0.f, 0.f, 0.f, 0.f};
#pragma unroll
          for (int ks = 0; ks < 2; ++ks) { const bf16x8 a = *(const bf16x8*)(PP + (16 * m + l15) * LS + 32 * ks + 8 * g); acc = __builtin_amdgcn_mfma_f32_16x16x32_bf16(a, vb[ks], acc, 0, 0, 0); }
          *(f32x4*)(OI + (size_t)unit * OI_B + (size_t)((wid * 4 + m) * 64 + lane) * 16) = acc; }
#pragma unroll
      for (int db = 0; db < 4; ++db) { f32x4 acc = {0.f, 0.f, 0.f, 0.f};
#pragma unroll
          for (int ks = 0; ks < 2; ++ks) { const bf16x8 a = *(const bf16x8*)(KPT + (16 * db + l15) * LS + 32 * ks + 8 * g); acc = __builtin_amdgcn_mfma_f32_16x16x32_bf16(a, vb[ks], acc, 0, 0, 0); }
          *(f32x4*)(UU + (size_t)unit * UU_B + (size_t)((wid * 4 + db) * 64 + lane) * 16) = acc; }
    }
}

constexpr size_t STG_B = 128 * 64 * 2;
__device__ __forceinline__ void scan_wave(int gwave, const unsigned char* UU, const float* DEC, unsigned char* STG, int lane) {
    const int bh = gwave >> 5, w = (gwave >> 2) & 7, db = gwave & 3, l15 = lane & 15, g = lane >> 4;
    f32x4 Sv = {0.f, 0.f, 0.f, 0.f};
    const size_t u0 = (size_t)bh * NCH;
    for (int n0 = 0; n0 < NCH; n0 += 8) {
        f32x4 Uf[8], dv[8];
#pragma unroll
        for (int j = 0; j < 8; ++j) { const size_t unit = u0 + n0 + j;
            Uf[j] = *(const f32x4*)(UU + unit * UU_B + (size_t)((w * 4 + db) * 64 + lane) * 16);
            dv[j] = *(const f32x4*)(DEC + unit * 64 + 16 * db + 4 * g); }
#pragma unroll
        for (int j = 0; j < 8; ++j) { const size_t unit = u0 + n0 + j;
            *(u32x2*)(STG + unit * STG_B + (size_t)((16 * w + l15) * 64 + 16 * db + 4 * g) * 2) = (u32x2){pkbf(Sv[0], Sv[1]), pkbf(Sv[2], Sv[3])};
            Sv = dv[j] * Sv + Uf[j]; }
    }
}

constexpr int GS = 136;
constexpr int PO_GR = 0, PO_YT = 64 * GS * 2, PO_PART = 2 * 64 * GS * 2, PO_END = PO_PART + 8 * 64 * 4;
__device__ __forceinline__ void post_unit(int unit, const bf16* QKV, const unsigned char* QPG, const unsigned char* OI, const unsigned char* STG, const float* __restrict__ gnorm, bf16* Y, unsigned char* lds) {
    int tid_ = threadIdx.x; asm volatile("" : "+v"(tid_));
    const int tid = tid_, lane = tid & 63, wid = __builtin_amdgcn_readfirstlane(tid >> 6), l15 = lane & 15, g = lane >> 4;
    const int n = unit % NCH, bh = unit / NCH, h = bh % GH, b = bh / GH;
    const size_t row0 = (size_t)b * S + (size_t)n * 64;
    bf16* GRs = (bf16*)(lds + PO_GR); bf16* YT = (bf16*)(lds + PO_YT); float* PART = (float*)(lds + PO_PART);
    const int t = tid >> 3, oc = tid & 7, e = 16 * wid + l15;
    const u32x4 g0 = *(const u32x4*)(QKV + (row0 + t) * fx::QKVP + fx::P_GR + h * 128 + oc * 16), g1 = *(const u32x4*)(QKV + (row0 + t) * fx::QKVP + fx::P_GR + h * 128 + oc * 16 + 8);
    f32x4 o[4]; bf16x8 qa[4][2], sb[2];
#pragma unroll
    for (int m = 0; m < 4; ++m) { o[m] = *(const f32x4*)(OI + (size_t)unit * OI_B + (size_t)((wid * 4 + m) * 64 + lane) * 16);
#pragma unroll
        for (int ks = 0; ks < 2; ++ks) qa[m][ks] = *(const bf16x8*)(QPG + (size_t)unit * QPG_B + (size_t)((16 * m + l15) * 64 + 32 * ks + 8 * g) * 2); }
#pragma unroll
    for (int ks = 0; ks < 2; ++ks) sb[ks] = *(const bf16x8*)(STG + (size_t)unit * STG_B + (size_t)(e * 64 + 32 * ks + 8 * g) * 2);
    const float gn = gnorm[e];
    *(u32x4*)(GRs + t * GS + oc * 16) = g0; *(u32x4*)(GRs + t * GS + oc * 16 + 8) = g1;
#pragma unroll
    for (int m = 0; m < 4; ++m)
#pragma unroll
        for (int ks = 0; ks < 2; ++ks) o[m] = __builtin_amdgcn_mfma_f32_16x16x32_bf16(qa[m][ks], sb[ks], o[m], 0, 0, 0);
#pragma unroll
    for (int m = 0; m < 4; ++m) { f32x4 q = o[m] * o[m];
#pragma unroll
        for (int off = 1; off < 16; off <<= 1) { q[0] += __shfl_xor(q[0], off); q[1] += __shfl_xor(q[1], off); q[2] += __shfl_xor(q[2], off); q[3] += __shfl_xor(q[3], off); }
        if (l15 == 0) *(f32x4*)(PART + wid * 64 + 16 * m + 4 * g) = q; }
    __syncthreads();
#pragma unroll
    for (int m = 0; m < 4; ++m) { f32x4 tot = {0.f, 0.f, 0.f, 0.f};
#pragma unroll
        for (int w = 0; w < 8; ++w) tot += *(const f32x4*)(PART + w * 64 + 16 * m + 4 * g);
#pragma unroll
        for (int r = 0; r < 4; ++r) { const int tt = 16 * m + 4 * g + r; const float rs = rsqrtf(tot[r] * (1.f / GV) + LN_EPS); const float gr = bf2f(GRs[tt * GS + e]);
            const float v = o[m][r] * rs * gn * (gr / (1.f + __expf(-gr)));
            YT[tt * GS + e] = (bf16)(pkbf(v, 0.f) & 0xffffu); } }
    __syncthreads();
    { const u32x4 y0 = *(const u32x4*)(YT + t * GS + oc * 16), y1 = *(const u32x4*)(YT + t * GS + oc * 16 + 8);
      *(u32x4*)(Y + (row0 + t) * D + 512 + h * GV + oc * 16) = y0; *(u32x4*)(Y + (row0 + t) * D + 512 + h * GV + oc * 16 + 8) = y1; }
    __syncthreads();
}
}
namespace mo {
using namespace nv;
typedef unsigned short bf16;
typedef float f32x4 __attribute__((ext_vector_type(4)));
typedef unsigned u32x4 __attribute__((ext_vector_type(4)));
constexpr int CAP = 8192;
constexpr int NEX = NE + 1;
constexpr int YSH = T * TOPK;
constexpr int L_TB = 132096, L_YB = L_TB + 1040, L_CN = L_YB + 1040;
typedef LAS int* lint;

__device__ __forceinline__ void moe_tables(const int* counts, lint tb, lint yb, lint cn, int lane) {
    int c[4], nt[4]; int st = 0, sy = 0, pt[4], py[4];
#pragma unroll
    for (int i = 0; i < 4; ++i) { c[i] = counts[lane * 4 + i]; c[i] = c[i] > CAP ? CAP : c[i]; nt[i] = (c[i] + 255) >> 8; pt[i] = st; py[i] = sy; st += nt[i]; sy += c[i]; }
    int it = st, iy = sy;
    for (int o = 1; o < 64; o <<= 1) { const int a = __shfl_up(it, o), b = __shfl_up(iy, o); if (lane >= o) { it += a; iy += b; } }
    const int bt = it - st, by = iy - sy;
#pragma unroll
    for (int i = 0; i < 4; ++i) { tb[lane * 4 + i] = bt + pt[i]; yb[lane * 4 + i] = by + py[i]; cn[lane * 4 + i] = c[i]; }
    if (lane == 63) { tb[256] = it; tb[257] = it + T / 256; yb[256] = YSH; cn[256] = T; }
}

__device__ __forceinline__ void route_token(const float* LG, const float* __restrict__ rbias, int* lcnt, int* TK, float* TW, int t, int lane) {
    const float4 l0 = ((const float4*)(LG + (size_t)t * NE))[lane], l1 = ((const float4*)(LG + (size_t)(T + t) * NE))[lane];
    const float4 rb = ((const float4*)rbias)[lane];
    float sc[4] = {1.f / (1.f + expf(-(l0.x + l1.x))), 1.f / (1.f + expf(-(l0.y + l1.y))), 1.f / (1.f + expf(-(l0.z + l1.z))), 1.f / (1.f + expf(-(l0.w + l1.w)))};
    float bv[4] = {sc[0] + rb.x, sc[1] + rb.y, sc[2] + rb.z, sc[3] + rb.w};
    float m1 = fmaxf(bv[0], bv[1]), m2 = fminf(bv[0], bv[1]);
    { const float a = fmaxf(bv[2], bv[3]), c = fminf(bv[2], bv[3]); const float n1 = fmaxf(m1, a); m2 = fmaxf(fminf(m1, a), fmaxf(m2, c)); m1 = n1; }
    for (int o = 1; o < 8; o <<= 1) { const float p1 = __shfl_xor(m1, o), p2 = __shfl_xor(m2, o); const float n1 = fmaxf(m1, p1); m2 = fmaxf(fminf(m1, p1), fmaxf(m2, p2)); m1 = n1; }
    const float gs = m1 + m2;
    const int myg = lane >> 3;
    int rank = 0;
#pragma unroll
    for (int g2 = 0; g2 < NG; ++g2) { const float og = __shfl(gs, g2 * 8); if (og > gs || (og == gs && g2 < myg)) ++rank; }
    const bool sel = rank < 4;
    float mv[4];
#pragma unroll
    for (int i = 0; i < 4; ++i) mv[i] = sel ? bv[i] : -INFINITY;
    int mye = 0; float myw = 0.f; float wsum = 0.f;
#pragma unroll
    for (int k = 0; k < TOPK; ++k) {
        float bvv = mv[0]; int bi = 0;
#pragma unroll
        for (int i = 1; i < 4; ++i) if (mv[i] > bvv) { bvv = mv[i]; bi = i; }
        int gi = lane * 4 + bi;
        for (int o = 32; o > 0; o >>= 1) { const float ov = __shfl_xor(bvv, o); const int oi = __shfl_xor(gi, o); if (ov > bvv || (ov == bvv && oi < gi)) { bvv = ov; gi = oi; } }
        const int ol = gi >> 2, oi = gi & 3;
        const float s_own = (oi == 0) ? sc[0] : (oi == 1) ? sc[1] : (oi == 2) ? sc[2] : sc[3];
        const float sw = __shfl(s_own, ol);
        if (lane == ol) { if (oi == 0) mv[0] = -INFINITY; else if (oi == 1) mv[1] = -INFINITY; else if (oi == 2) mv[2] = -INFINITY; else mv[3] = -INFINITY; }
        if (lane == k) { mye = gi; myw = sw; } wsum += sw;
    }
    if (lane < TOPK) { const int lp = atomicAdd(&lcnt[mye], 1); TK[t * TOPK + lane] = mye | (lp << 9); TW[t * TOPK + lane] = myw * (2.5f / wsum); }
}
__device__ __forceinline__ void route_finish(const int* lbase, int* list_tok, float* list_gate, int* TK, const float* TW, int t, int lane) {
    if (lane < TOPK) { const int tk = TK[t * TOPK + lane]; const int e = tk & 511, pos = lbase[e] + (tk >> 9);
        if (pos < CAP) { list_tok[e * CAP + pos] = t; list_gate[e * CAP + pos] = TW[t * TOPK + lane]; }
        TK[t * TOPK + lane] = e | (pos << 9); }
}

constexpr float YSC = 16.f;
__device__ __forceinline__ void combine_token(const bf16* H1, const unsigned char* Y, const int* TK, lint yb, const float* __restrict__ g, const float* __restrict__ b, float* out, int t, int lane) {
    typedef float f2 __attribute__((ext_vector_type(2)));
    float v[16], s[16];
    { const u32x4 a = *(const u32x4*)(H1 + (size_t)t * D + 16 * lane), c = *(const u32x4*)(H1 + (size_t)t * D + 16 * lane + 8);
      const unsigned w[8] = {a.x, a.y, a.z, a.w, c.x, c.y, c.z, c.w};
#pragma unroll
      for (int i = 0; i < 8; ++i) { v[2 * i] = ALPHA * __builtin_bit_cast(float, w[i] << 16); v[2 * i + 1] = ALPHA * __builtin_bit_cast(float, w[i] & 0xffff0000u); } }
#pragma unroll
    for (int i = 0; i < 16; ++i) s[i] = 0.f;
    int tk = (lane < TOPK) ? TK[t * TOPK + lane] : 0;
#pragma unroll
    for (int k = 0; k <= TOPK; ++k) {
        size_t yrow;
        if (k < TOPK) { const int x = __shfl(tk, k); yrow = (size_t)(yb[x & 511] + (x >> 9)); } else yrow = (size_t)YSH + t;
        const u32x4 a = *(const u32x4*)(Y + yrow * D + 16 * lane);
        const int w[4] = {(int)a.x, (int)a.y, (int)a.z, (int)a.w};
#pragma unroll
        for (int i = 0; i < 4; ++i) { const f2 lo = __builtin_amdgcn_cvt_pk_f32_fp8(w[i], false), hi = __builtin_amdgcn_cvt_pk_f32_fp8(w[i], true);
            s[4 * i] += lo[0]; s[4 * i + 1] += lo[1]; s[4 * i + 2] += hi[0]; s[4 * i + 3] += hi[1]; }
    }
    float sm = 0.f;
#pragma unroll
    for (int i = 0; i < 16; ++i) { v[i] += s[i] * (1.f / YSC); sm += v[i]; }
    const float mean = fx::wave_sum(sm) * (1.f / D); float q = 0.f;
#pragma unroll
    for (int i = 0; i < 16; ++i) { v[i] -= mean; q += v[i] * v[i]; }
    const float rstd = 1.f / sqrtf(fx::wave_sum(q) * (1.f / D) + LN_EPS);
#pragma unroll
    for (int i = 0; i < 4; ++i) { const f32x4 gg = *(const f32x4*)(g + 16 * lane + 4 * i), bb = *(const f32x4*)(b + 16 * lane + 4 * i);
        f32x4 o; o[0] = v[4 * i] * rstd * gg[0] + bb[0]; o[1] = v[4 * i + 1] * rstd * gg[1] + bb[1]; o[2] = v[4 * i + 2] * rstd * gg[2] + bb[2]; o[3] = v[4 * i + 3] * rstd * gg[3] + bb[3];
        *(f32x4*)(out + (size_t)t * D + 16 * lane + 4 * i) = o; }
}
}

namespace pg8 {
struct RouterSched {
    int G, vcu; const bf16_t* Bt;
    __device__ __forceinline__ bool next(int i, Unit2& u) const { const int L = i * G + vcu; if (L >= 2 * (nv::T / BM)) return false; u.pm = L >> 1; u.pn = L & 1; u.e = 0; u.cnt = 256; u.jt = 0; return true; }
    __device__ __forceinline__ int arow(const Unit2& u, int r) const { return u.pm * BM + r; }
    __device__ __forceinline__ size_t aoff(const Unit2& u) const { return (size_t)u.pn * 1024; }
    __device__ __forceinline__ const char* bptr(const Unit2& u) const { return (const char*)(Bt + u.pn * 512); }
};
struct EpiLogits {
    static constexpr bool PERM = false, AFTER_DRAIN = false;
    float* LG;
    __device__ __forceinline__ void operator()(const f32x4 (&acc)[2][2][4][2], const Unit2& u, int wr, int wc, int fr, int fq) const {
        const int row0 = u.pm * BM + wr * 64 + fr, col0 = wc * 32 + 4 * fq; float* base = LG + (size_t)u.pn * nv::T * nv::NE;
#pragma unroll
        for (int ai = 0; ai < 2; ++ai)
#pragma unroll
            for (int m = 0; m < 4; ++m) { float* rowp = base + (size_t)(row0 + ai * HALF + m * 16) * nv::NE + col0;
#pragma unroll
                for (int bj = 0; bj < 2; ++bj)
#pragma unroll
                    for (int n = 0; n < 2; ++n) *(f32x4*)(rowp + bj * HALF + n * 16) = acc[ai][bj][m][n]; }
    }
};
template <int PH> struct MoeSched {
    int G, vcu, nrt; mo::lint tb; mo::lint cn; const int* list_tok; const bf16_t* W;
    static constexpr int NC = PH == 0 ? 2 : 4;
    __device__ __forceinline__ bool next(int i, Unit2& u) const {
        const int L = i * G + vcu; if (L >= nrt * NC) return false;
        const int rt = L / NC, c = L % NC;
        int lo = 0, hi = 256;
        while (lo < hi) { const int mid = (lo + hi + 1) >> 1; if (tb[mid] <= rt) lo = mid; else hi = mid - 1; }
        const int e = lo, jt = rt - tb[e]; const int total = cn[e];
        const int rem = total - 256 * jt;
        u.pm = rt; u.pn = c; u.e = __builtin_amdgcn_readfirstlane(e); u.jt = __builtin_amdgcn_readfirstlane(jt); u.cnt = __builtin_amdgcn_readfirstlane(rem < 256 ? rem : 256); return true;
    }
    __device__ __forceinline__ int arow(const Unit2& u, int r) const {
        if (PH == 1) return u.pm * BM + r;
        if (u.e == 256) return u.jt * BM + r;
        return (r < u.cnt) ? list_tok[u.e * mo::CAP + u.jt * BM + r] : 0;
    }
    __device__ __forceinline__ size_t aoff(const Unit2&) const { return 0; }
    __device__ __forceinline__ const char* bptr(const Unit2& u) const {
        return PH == 0 ? (const char*)(W + ((size_t)u.e * 512 + 256 * u.pn) * 1024) : (const char*)(W + ((size_t)u.e * 1024 + 256 * u.pn) * 256);
    }
};
struct EpiSwiGLU {
    static constexpr bool PERM = true, AFTER_DRAIN = false;
    bf16_t* H; const float* list_gate;
    __device__ __forceinline__ void operator()(const f32x4 (&acc)[2][2][4][2], const Unit2& u, int wr, int wc, int fr, int fq) const {
        const int col0 = u.pn * 128 + wc * 32 + 8 * fq;
#pragma unroll
        for (int ai = 0; ai < 2; ++ai)
#pragma unroll
            for (int m = 0; m < 4; ++m) { const int r = ai * HALF + wr * 64 + m * 16 + fr;
                float gt = 1.f; if (u.e < 256) gt = (r < u.cnt) ? list_gate[u.e * mo::CAP + u.jt * BM + r] : 0.f;
                float hv[8];
#pragma unroll
                for (int n = 0; n < 2; ++n)
#pragma unroll
                    for (int i = 0; i < 4; ++i) { const float gg = acc[ai][0][m][n][i], uu = acc[ai][1][m][n][i]; hv[4 * n + i] = gt * uu * (gg / (1.f + __expf(-gg))); }
                u32x4 w; w.x = cvt_pk_bf16(hv[0], hv[1]); w.y = cvt_pk_bf16(hv[2], hv[3]); w.z = cvt_pk_bf16(hv[4], hv[5]); w.w = cvt_pk_bf16(hv[6], hv[7]);
                *(u32x4*)(H + (size_t)(u.pm * BM + r) * 256 + col0) = w; }
    }
};
struct EpiDown {
    static constexpr bool PERM = true, AFTER_DRAIN = false;
    unsigned char* Y; mo::lint yb;
    __device__ __forceinline__ void operator()(const f32x4 (&acc)[2][2][4][2], const Unit2& u, int wr, int wc, int fr, int fq) const {
        typedef unsigned u32x2v __attribute__((ext_vector_type(2)));
        const int col0 = u.pn * BM + wc * 32 + 8 * fq; const int ybase = yb[u.e] + u.jt * BM;
#pragma unroll
        for (int ai = 0; ai < 2; ++ai)
#pragma unroll
            for (int m = 0; m < 4; ++m) { const int r = ai * HALF + wr * 64 + m * 16 + fr;
                if (r < u.cnt) { unsigned char* rowp = Y + (size_t)(ybase + r) * nv::D + col0;
#pragma unroll
                    for (int bj = 0; bj < 2; ++bj) { const f32x4 v0 = acc[ai][bj][m][0] * mo::YSC, v1 = acc[ai][bj][m][1] * mo::YSC;
                        int w0 = __builtin_amdgcn_cvt_pk_fp8_f32(v0[0], v0[1], 0, false); w0 = __builtin_amdgcn_cvt_pk_fp8_f32(v0[2], v0[3], w0, true);
                        int w1 = __builtin_amdgcn_cvt_pk_fp8_f32(v1[0], v1[1], 0, false); w1 = __builtin_amdgcn_cvt_pk_fp8_f32(v1[2], v1[3], w1, true);
                        *(u32x2v*)(rowp + bj * HALF) = (u32x2v){(unsigned)w0, (unsigned)w1}; } } }
    }
};
}
constexpr int NTHR = 512;
constexpr int LDS_BYTES = 147456;
constexpr int MISC_OFF = 131072 + 320;
constexpr size_t MiB = 1u << 20;
constexpr size_t CTL_ZERO_BYTES = 1 * MiB;
constexpr int CW_BAR = 4096;
constexpr int CW_MOE = 16384;
constexpr int NPHASE = 12;
constexpr size_t WS_H1 = 1, WS_WR = 65, WS_STATS = 66, WS_LF = 67, WS_FG = 68, WS_WO = 72, WS_WIN = 74, WS_TK = 81, WS_LTOK = 83, WS_LGATE = 91,
                 WS_WED = 100, WS_HID = 230, WS_GLA = 230, WS_WEG = 416, WS_XN = 673, WS_YBF = 673, WS_QKV = 737, WS_Z1 = 737, WS_LG = 865, WS_Y = 416, WS_END = 992;

struct Args { const float* in[21]; float* out; unsigned char* ws; int ph_lo, ph_hi, li, pad; };

__global__ void __launch_bounds__(NTHR, 2) mega_fwd(Args a) {
    using namespace nv;
    extern __shared__ __attribute__((aligned(16))) unsigned char lds[];
    const int G = gridDim.x, bx = blockIdx.x;
    const int vcu = (G % 8 == 0) ? (bx % 8) * (G / 8) + bx / 8 : bx;
    int tid, lane, wave, vw;
#define DERIVE() do { int t_ = threadIdx.x; asm volatile("" : "+v"(t_)); tid = t_; lane = tid & 63; wave = __builtin_amdgcn_readfirstlane(tid >> 6); vw = vcu * 8 + wave; } while (0)
    DERIVE();
    volatile LAS unsigned* MISC = (volatile LAS unsigned*)((LAS unsigned char*)lds + MISC_OFF);
    for (int u = tid; u < (LDS_BYTES - 131072) / 4; u += NTHR) ((LAS unsigned*)((LAS unsigned char*)lds + 131072))[u] = 0u;
    __syncthreads();
    unsigned char* ws = a.ws;
    unsigned* ctl = (unsigned*)ws;
    XcdBarrier bar = xcd_barrier_post(ctl + CW_BAR + a.li * XCD_BAR_WORDS, MISC + 8);
    const float* x = a.in[0];
    const float* ln_in_g = a.in[1]; const float* ln_in_b = a.in[2];
    const float* w_in = a.in[3]; const float* b_fgate = a.in[4];
    const float* w_gate_up = a.in[5]; const float* b_gate = a.in[6]; const float* g_gla = a.in[7];
    const float* w_out = a.in[8]; const float* ln1_g = a.in[9]; const float* ln1_b = a.in[10];
    const float* w_router = a.in[11]; const float* rbias = a.in[12];
    const float* w_eg = a.in[13]; const float* w_eu = a.in[14]; const float* w_ed = a.in[15];
    const float* w_sg = a.in[16]; const float* w_su = a.in[17]; const float* w_sd = a.in[18];
    const float* ln2_g = a.in[19]; const float* ln2_b = a.in[20];
    float* out = a.out;
    int* counts = (int*)(ctl + CW_MOE);
    fx::bf16* H1 = (fx::bf16*)(ws + WS_H1 * MiB);
    fx::bf16* WrT = (fx::bf16*)(ws + WS_WR * MiB);
    float* stats = (float*)(ws + WS_STATS * MiB);
    float* LF = (float*)(ws + WS_LF * MiB);
    float* FG = (float*)(ws + WS_FG * MiB);
    fx::bf16* WoT = (fx::bf16*)(ws + WS_WO * MiB);
    fx::bf16* WinT = (fx::bf16*)(ws + WS_WIN * MiB);
    int* TK = (int*)(ws + WS_TK * MiB);
    float* TW = (float*)(ws + (WS_TK + 1) * MiB);
    int* list_tok = (int*)(ws + WS_LTOK * MiB);
    float* list_gate = (float*)(ws + WS_LGATE * MiB);
    fx::bf16* WedT = (fx::bf16*)(ws + WS_WED * MiB);
    fx::bf16* HID = (fx::bf16*)(ws + WS_HID * MiB);
    unsigned char* QPG = ws + WS_GLA * MiB; unsigned char* OIb = ws + (WS_GLA + 16) * MiB; unsigned char* UUb = ws + (WS_GLA + 80) * MiB; float* DECb = (float*)(ws + (WS_GLA + 144) * MiB); unsigned char* STGb = ws + (WS_GLA + 145) * MiB;
    fx::bf16* WegT = (fx::bf16*)(ws + WS_WEG * MiB);
    fx::bf16* XN = (fx::bf16*)(ws + WS_XN * MiB);
    fx::bf16* Ybf = (fx::bf16*)(ws + WS_YBF * MiB);
    fx::bf16* QKV = (fx::bf16*)(ws + WS_QKV * MiB);
    float* z1 = (float*)(ws + WS_Z1 * MiB);
    float* LG = (float*)(ws + WS_LG * MiB);
    unsigned char* YA = ws + WS_Y * MiB;
    mo::lint tb = (mo::lint)((LAS unsigned char*)lds + mo::L_TB), yb = (mo::lint)((LAS unsigned char*)lds + mo::L_YB), cn = (mo::lint)((LAS unsigned char*)lds + mo::L_CN);

    const int lo = a.ph_lo, hi = a.ph_hi;
#define IN(k) (lo <= (k) && (k) < hi)
#define SEAM(k) do { if (IN(k) && IN((k) + 1)) xcd_barrier(bar); DERIVE(); } while (0)
    const int GW = G * 8;

    if (IN(0)) {
        LAS float* scr = (LAS float*)((LAS unsigned char*)lds + wave * 16384);
        constexpr int I_IN = 16 * (fx::NIN / 32), I_OUT = 16 * 32, I_R = 16 * 8, I_SMALL = I_IN + I_OUT + I_R, I_EG = mo::NEX * 256, I_ED = mo::NEX * 128, I_EXP = I_EG + I_ED;
        for (int it = vw; it < I_SMALL; it += GW) {
            int r = it;
            if (r < I_IN) { fx::transpose_item(w_in, D, INW, WinT, scr, r / (fx::NIN / 32), r % (fx::NIN / 32), lane, [](int d) { return fx::inproj_src(d); }); continue; } r -= I_IN;
            if (r < I_OUT) { fx::transpose_item(w_out, D, D, WoT, scr, r / 32, r % 32, lane, [](int d) { return d; }); continue; } r -= I_OUT;
            fx::transpose_item(w_router, D, NE, WrT, scr, r / 8, r % 8, lane, [](int d) { return d; });
        }
        for (int r = vw; r < T; r += GW) fx::ln_row_bf16(x + (size_t)r * D, ln_in_g, ln_in_b, XN + (size_t)r * D, nullptr, stats + 2 * (size_t)r, lane);
#define CV_DECODE(r_, I) do { int r = (r_); if (r < I_EG) { const int e = r >> 8, kb = (r >> 4) & 15, nb = r & 15, c = nb >> 3, sub = nb & 7; \
            I.W = (e < NE) ? ((sub < 4 ? w_eg : w_eu) + (size_t)e * D * ED) : (sub < 4 ? w_sg : w_su); I.WT = WegT + (size_t)e * 512 * D; I.N = ED; I.K = D; I.k0 = 64 * kb; I.n0 = 32 * nb; I.s0 = 128 * c + 32 * (sub & 3); } \
          else { r -= I_EG; const int e = r >> 7, kb = (r >> 5) & 3, nb = r & 31; I.W = (e < NE) ? (w_ed + (size_t)e * ED * D) : w_sd; I.WT = WedT + (size_t)e * D * ED; I.N = D; I.K = ED; I.k0 = 64 * kb; I.n0 = 32 * nb; I.s0 = 32 * nb; } } while (0)
        { int it = vw; fx::CvItem cur, nx; fx::f32x4 v[8], w[8];
          if (it < I_EXP) { CV_DECODE(it, cur); fx::cv_load(cur, v, lane); }
          while (it < I_EXP) { const int itn = it + GW; if (itn < I_EXP) { CV_DECODE(itn, nx); fx::cv_load(nx, w, lane); }
              fx::cv_finish(cur, v, scr, lane); cur = nx;
#pragma unroll
              for (int i = 0; i < 8; ++i) v[i] = w[i];
              it = itn; } }
#undef CV_DECODE
    }
    SEAM(0);
    if (IN(1)) {
        pg8::Gemm g{XN, WinT, T, fx::NIN, D, D}; pg8::StaticOrder S; S.init(T, fx::NIN, G, bx);
        pg8::EpiInProj E{QKV, FG, LF, b_fgate};
        pg8::gemm_phase<pg8::EpiInProj, pg8::StaticOrder, true, true>((LAS unsigned char*)lds, g, S, E);
    }
    SEAM(1);
    if (IN(2)) {
        int cur_h = -1;
        if (gl::NUNIT % G == 0) { const int per = gl::NUNIT / G; for (int i = 0; i < per; ++i) gl::prep_unit(vcu * per + i, QKV, FG, w_gate_up, b_gate, QPG, OIb, UUb, DECb, lds, cur_h); }
        else for (int u = vcu; u < gl::NUNIT; u += G) gl::prep_unit(u, QKV, FG, w_gate_up, b_gate, QPG, OIb, UUb, DECb, lds, cur_h);
    }
    SEAM(2);
    if (IN(3)) {
        if (bx < 128) gl::scan_wave(bx * 8 + wave, UUb, DECb, STGb, lane);
    }
    SEAM(3);
    if (IN(4)) {
        if (gl::NUNIT % G == 0) { const int per = gl::NUNIT / G; for (int i = 0; i < per; ++i) gl::post_unit(vcu * per + i, QKV, QPG, OIb, STGb, g_gla, Ybf, lds); }
        else for (int u = vcu; u < gl::NUNIT; u += G) gl::post_unit(u, QKV, QPG, OIb, STGb, g_gla, Ybf, lds);
        { const attn_body::AttnTensors AT{(const attn_body::bf16*)(QKV + fx::P_FQ), (const attn_body::bf16*)(QKV + fx::P_FK), (const attn_body::bf16*)(QKV + fx::P_FV), (attn_body::bf16*)Ybf, LF};
          const attn_body::StaticOrder SO(G, bx);
          attn_body::attn_phase<attn_body::StaticOrder>((char*)lds, AT, SO); }
    }
    SEAM(4);
    if (IN(5)) {
        pg8::DenseSched DS; DS.so.init(T, D, G, bx); DS.Bt = WoT; DS.ldb = D;
        pg8::EpiResid E{z1, D, x, stats, ln_in_g, ln_in_b, ALPHA};
        pg8::gemm_phase2<pg8::EpiResid, pg8::DenseSched>((LAS unsigned char*)lds, Ybf, D, D, D, DS, E);
    }
    SEAM(5);
    if (IN(6)) {
        for (int r = vw; r < T; r += GW) fx::ln_row_bf16(z1 + (size_t)r * D, ln1_g, ln1_b, H1 + (size_t)r * D, nullptr, nullptr, lane);
    }
    SEAM(6);
    if (IN(7)) {
        pg8::RouterSched RS{G, vcu, WrT}; pg8::EpiLogits E{LG};
        pg8::gemm_phase2<pg8::EpiLogits, pg8::RouterSched>((LAS unsigned char*)lds, H1, D, D, 512, RS, E);
    }
    SEAM(7);
    if (IN(8)) {
        int* lcnt = (int*)(lds + 4096); int* lbase = lcnt + 256;
        if (tid < 256) lcnt[tid] = 0;
        __syncthreads();
        for (int t = vw; t < T; t += GW) mo::route_token(LG, rbias, lcnt, TK, TW, t, lane);
        __syncthreads();
        if (tid < 256) { const int c = lcnt[tid]; lbase[tid] = c ? atomicAdd(&counts[tid], c) : 0; }
        __syncthreads();
        for (int t = vw; t < T; t += GW) mo::route_finish(lbase, list_tok, list_gate, TK, TW, t, lane);
    }
    SEAM(8);
    if (IN(9)) {
        if (wave == 0) mo::moe_tables(counts, tb, yb, cn, lane);
        __syncthreads();
        pg8::MoeSched<0> MS{G, vcu, tb[257], tb, cn, list_tok, WegT}; pg8::EpiSwiGLU E{HID, list_gate};
        pg8::gemm_phase2<pg8::EpiSwiGLU, pg8::MoeSched<0>>((LAS unsigned char*)lds, H1, D, D, D, MS, E);
    }
    SEAM(9);
    if (IN(10)) {
        if (wave == 0) mo::moe_tables(counts, tb, yb, cn, lane);
        __syncthreads();
        pg8::MoeSched<1> MS{G, vcu, tb[257], tb, cn, list_tok, WedT}; pg8::EpiDown E{YA, yb};
        pg8::gemm_phase2<pg8::EpiDown, pg8::MoeSched<1>>((LAS unsigned char*)lds, HID, ED, ED, ED, MS, E);
    }
    SEAM(10);
    if (IN(11)) {
        if (wave == 0) mo::moe_tables(counts, tb, yb, cn, lane);
        __syncthreads();
        for (int t = vw; t < T; t += GW) mo::combine_token(H1, YA, TK, yb, ln2_g, ln2_b, out, t, lane);
    }
#undef IN
#undef SEAM
}

extern "C" void kernel_launch(void* const* d_in, const int* in_sizes, int n_in, void* d_out, int out_size, void* d_ws, size_t ws_size, hipStream_t stream) {
    static int grid = 0;
    if (grid == 0) {
        if (n_in != 21 || out_size != nv::T * nv::D || ws_size < WS_END * MiB) { fprintf(stderr, "kernel_launch: unexpected shapes n_in=%d out=%d ws=%zu\n", n_in, out_size, ws_size); grid = -1; return; }
        int dev = 0, cus = 0;
        if (hipGetDevice(&dev) != hipSuccess || hipDeviceGetAttribute(&cus, hipDeviceAttributeMultiprocessorCount, dev) != hipSuccess) { grid = -1; return; }
        if (hipFuncSetAttribute((const void*)mega_fwd, hipFuncAttributeMaxDynamicSharedMemorySize, LDS_BYTES) != hipSuccess) { fprintf(stderr, "kernel_launch: hipFuncSetAttribute failed\n"); grid = -1; return; }
        grid = cus;
    }
    if (grid < 0) return;
    if (hipMemsetAsync(d_ws, 0, CTL_ZERO_BYTES, stream) != hipSuccess) return;
    Args a{};
    for (int i = 0; i < 21; ++i) a.in[i] = (const float*)d_in[i];
    a.out = (float*)d_out; a.ws = (unsigned char*)d_ws; a.ph_lo = 0; a.ph_hi = NPHASE; a.li = 0;
#ifdef REPEAT_PH
    a.ph_hi = REPEAT_PH + 1; hipLaunchKernelGGL(mega_fwd, dim3(grid), dim3(NTHR), LDS_BYTES, stream, a);
    a.ph_lo = REPEAT_PH; a.ph_hi = NPHASE; a.li = 1;
#endif
    hipLaunchKernelGGL(mega_fwd, dim3(grid), dim3(NTHR), LDS_BYTES, stream, a);
}
```

```cpp
#include <hip/hip_runtime.h>
#include <cstdio>
#include <cstdint>
#include <cmath>

#define LAS __attribute__((address_space(3)))
#define GAS __attribute__((address_space(1)))

#define XB_TMO      128
#define XB_XCNT(j)  (256  + 64 * (j))
#define XB_XSUB(j)  (1280 + 64 * (j))
#define XB_XGEN(j)  (2304 + 64 * (j))
#define XB_TOP      3328
#define XB_TOPGEN   3392
#define XCD_BAR_WORDS 3456
#define XB_SPIN_CAP (1u << 27)
__device__ __forceinline__ unsigned xb_ld(unsigned* p)              { return __hip_atomic_load(p, __ATOMIC_RELAXED, __HIP_MEMORY_SCOPE_AGENT); }
__device__ __forceinline__ unsigned xb_add(unsigned* p, unsigned v) { return __hip_atomic_fetch_add(p, v, __ATOMIC_RELAXED, __HIP_MEMORY_SCOPE_AGENT); }
__device__ __forceinline__ unsigned xb_xcc_id() { return (unsigned)__builtin_amdgcn_s_getreg((3 << 11) | 20) & 0xFu; }
#define XB_SPIN(cond, bar) do { unsigned _sp = 0; while (cond) { __builtin_amdgcn_s_sleep(1); \
    if ((++_sp & 255u) == 0u) { if (xb_ld(&(bar)[XB_TMO])) break; if (_sp > XB_SPIN_CAP) { atomicAdd(&(bar)[XB_TMO], 1u); break; } } } } while (0)
struct XcdBarrier { unsigned* bar; unsigned x; volatile LAS unsigned* st; };
__device__ __forceinline__ XcdBarrier xcd_barrier_post(unsigned* bar, volatile LAS unsigned* st) {
    XcdBarrier b; b.bar = bar; b.x = xb_xcc_id(); b.st = st;
    if (threadIdx.x == 0) (void)xb_add(&bar[XB_XCNT(b.x)], 1u);
    return b;
}
__device__ __forceinline__ void xcd_barrier_complete(unsigned* bar, unsigned x, unsigned& nloc, unsigned& nx) {
    const unsigned G = gridDim.x * gridDim.y * gridDim.z;
    unsigned sum, cnt, mine, sp = 0u;
    for (;;) {
        sum = 0u; cnt = 0u; mine = 0u;
#pragma unroll
        for (unsigned j = 0; j < 16; ++j) { const unsigned c = xb_ld(&bar[XB_XCNT(j)]); sum += c; cnt += (c > 0u) ? 1u : 0u; mine = (j == x) ? c : mine; }
        if (sum == G) break;
        __builtin_amdgcn_s_sleep(1);
        if ((++sp & 255u) == 0u) { if (xb_ld(&bar[XB_TMO])) break; if (sp > XB_SPIN_CAP) { atomicAdd(&bar[XB_TMO], 1u); break; } }
    }
    nloc = mine > 0u ? mine : 1u; nx = cnt > 0u ? cnt : 1u;
}
__device__ __forceinline__ void xcd_barrier(const XcdBarrier& b) {
    asm volatile("s_waitcnt vmcnt(0)" ::: "memory");
    __syncthreads();
    if (threadIdx.x == 0) {
        unsigned* bar = b.bar;
        __builtin_amdgcn_s_waitcnt(0);
        unsigned nloc = b.st[0], nx = b.st[1];
        if (nloc == 0u) { xcd_barrier_complete(bar, b.x, nloc, nx); b.st[0] = nloc; b.st[1] = nx; }
        const unsigned old = xb_add(&bar[XB_XSUB(b.x)], 1u);
        const unsigned gen = old / nloc;
        if (old + 1u == (gen + 1u) * nloc) {
            __builtin_amdgcn_fence(__ATOMIC_RELEASE, "agent");
            asm volatile("s_waitcnt vmcnt(0)" ::: "memory");
            const unsigned og = xb_add(&bar[XB_TOP], 1u);
            const unsigned tg = og / nx;
            if (og + 1u == (tg + 1u) * nx) xb_add(&bar[XB_TOPGEN], 1u);
            else XB_SPIN(xb_ld(&bar[XB_TOPGEN]) == tg, bar);
            __builtin_amdgcn_fence(__ATOMIC_ACQUIRE, "agent");
            xb_add(&bar[XB_XGEN(b.x)], 1u);
            asm volatile("s_waitcnt vmcnt(0)" ::: "memory");
        } else {
            XB_SPIN(xb_ld(&bar[XB_XGEN(b.x)]) == gen, bar);
            __builtin_amdgcn_fence(__ATOMIC_ACQUIRE, "agent");
            asm volatile("s_waitcnt vmcnt(0)" ::: "memory");
        }
    }
    __syncthreads();
}
namespace pg8 {
#define PG8_LAS __attribute__((address_space(3)))
typedef unsigned short bf16_t;
typedef short bf16x8 __attribute__((ext_vector_type(8)));
typedef float f32x4 __attribute__((ext_vector_type(4)));
typedef unsigned u32x4 __attribute__((ext_vector_type(4)));
constexpr int BM = 256, BK = 64, HALF = 128, HTB = HALF * BK * 2  , STAGE_BYTES = 8 * HTB, NXCD = 8, WGM = 8;

__host__ __device__ __forceinline__ int lds_byte(int r, int c) { const int st = (r >> 4) * 2 + (c >> 5), rr = r & 15, cc = c & 31, ob = rr * 64 + cc * 2; return st * 1024 + (ob ^ (((ob >> 9) & 1) << 5)); }
__host__ __device__ __forceinline__ void stage_rc(int b, int& R, int& C) { const int st = b / 1024, sb = b % 1024, swz = sb ^ (((sb >> 9) & 1) << 5); R = (st >> 1) * 16 + swz / 64; C = (st & 1) * 32 + (swz % 64) / 2; }
__host__ __device__ __forceinline__ int perm32(int rho) { const int n = rho >> 4, i = rho & 15; return 8 * (i >> 2) + 4 * n + (i & 3); }

struct Unit { int pm, pn; };
struct Gemm { const bf16_t* A; const bf16_t* Bt; int M, N, K, lda; };

struct StaticOrder {
    int nM, nN, nwg, G, c;
    __host__ __device__ void init(int M, int N, int G_, int c_) { nM = M / BM; nN = N / BM; nwg = nM * nN; G = G_; c = c_; }
    __host__ __device__ bool next(int i, Unit& u) const {
        const long L = (long)i * G + c; if (L >= nwg) return false;
        int wgid = (int)L; { const int q = nwg / NXCD, r = nwg % NXCD, xcd = wgid % NXCD, off = wgid / NXCD; wgid = (xcd < r ? xcd * (q + 1) : r * (q + 1) + (xcd - r) * q) + off; }
        const int nig = WGM * nN, gid = wgid / nig, fm = gid * WGM, gsz = (nM - fm) < WGM ? (nM - fm) : WGM;
        u.pm = fm + ((wgid % nig) % gsz); u.pn = (wgid % nig) / gsz; return true;
    }
    __device__ __forceinline__ void a_ready(const Unit&) const {}
    __device__ __forceinline__ void done(const Unit&) const {}
};

__device__ __forceinline__ unsigned cvt_pk_bf16(float lo, float hi) { unsigned r; asm volatile("v_cvt_pk_bf16_f32 %0, %1, %2" : "=v"(r) : "v"(lo), "v"(hi)); return r; }
typedef float f32x2 __attribute__((ext_vector_type(2)));
__device__ __forceinline__ f32x2 gelu_pk(f32x2 v) {
    const f32x2 av = __builtin_elementwise_abs(v), d = av * 0.2316418882f + 1.0f;
    f32x2 t; t.x = __builtin_amdgcn_rcpf(d.x); t.y = __builtin_amdgcn_rcpf(d.y);
    f32x2 q = t * 0.5307027145f + (-0.7265760135f); q = q * t + 0.7107068705f; q = q * t + (-0.142248368f); q = q * t + 0.127414796f; q = q * t;
    const f32x2 s = (v * v) * (-0.72134752044f);
    f32x2 e; e.x = __builtin_amdgcn_exp2f(s.x); e.y = __builtin_amdgcn_exp2f(s.y);
    const f32x2 m = v * (q * e), r = v - m;
    f32x2 o; o.x = v.x < 0.f ? m.x : r.x; o.y = v.y < 0.f ? m.y : r.y; return o;
}

template <int ACT  > struct EpiBf16 {
    static constexpr bool PERM = true, AFTER_DRAIN = false; static_assert(ACT == 0 || ACT == 1, "EpiBf16: ACT is 0 (none) or 1 (gelu_pk)");
    bf16_t* O; int ldc; const float* bias; int split_cols; size_t split_stride; float scale0;
    __device__ __forceinline__ void operator()(const f32x4 (&acc)[2][2][4][2], const Unit& u, int wr, int wc, int fr, int fq) const {
        const int row0 = u.pm * BM + wr * 64 + fr; int colt = u.pn * BM; bf16_t* base = O;
        float sc = 1.f; if (split_cols) { const int t = colt / split_cols; base += (size_t)t * split_stride; colt -= t * split_cols; if (t == 0) sc = scale0; }
        const int col0 = colt + wc * 32 + 8 * fq, bcol0 = u.pn * BM + wc * 32 + 8 * fq;
        f32x4 bv[2][2];
#pragma unroll
        for (int bj = 0; bj < 2; ++bj)
#pragma unroll
            for (int n = 0; n < 2; ++n) bv[bj][n] = bias ? *(const f32x4*)(bias + bcol0 + bj * HALF + 4 * n) : (f32x4){0.f, 0.f, 0.f, 0.f};
#pragma unroll
        for (int ai = 0; ai < 2; ++ai)
#pragma unroll
            for (int m = 0; m < 4; ++m) { bf16_t* rowp = base + (size_t)(row0 + ai * HALF + m * 16) * ldc + col0;
#pragma unroll
                for (int bj = 0; bj < 2; ++bj) { f32x4 v0 = acc[ai][bj][m][0] + bv[bj][0], v1 = acc[ai][bj][m][1] + bv[bj][1];
                    if (ACT == 1) { f32x2 a = gelu_pk((f32x2){v0[0], v0[1]}), b = gelu_pk((f32x2){v0[2], v0[3]}), c = gelu_pk((f32x2){v1[0], v1[1]}), d = gelu_pk((f32x2){v1[2], v1[3]});
                        v0 = (f32x4){a.x, a.y, b.x, b.y}; v1 = (f32x4){c.x, c.y, d.x, d.y}; }
                    v0 = v0 * sc; v1 = v1 * sc; u32x4 w; w.x = cvt_pk_bf16(v0[0], v0[1]); w.y = cvt_pk_bf16(v0[2], v0[3]); w.z = cvt_pk_bf16(v1[0], v1[1]); w.w = cvt_pk_bf16(v1[2], v1[3]);
                    *(u32x4*)(rowp + bj * HALF) = w; } }
    }
};

template <class Epi, class Sched, bool ALIGN_EPI = false, bool SP2 = false>
__device__ __forceinline__ void gemm_phase(PG8_LAS unsigned char* lds, const Gemm g, const Sched& S, const Epi& E) {
    const int tid = threadIdx.x, wid = __builtin_amdgcn_readfirstlane(tid >> 6), lane = tid & 63, wr = wid >> 2, wc = wid & 3, fr = lane & 15, fq = lane >> 4;
    const int K = g.K, nt = K / BK;
    unsigned voffA[2], voffB[2];
#pragma unroll
    for (int i = 0; i < 2; ++i) { int R, C; stage_rc(tid * 16 + i * 8192, R, C); const int Rb = Epi::PERM ? ((R & ~31) + perm32(R & 31)) : R;
        voffA[i] = (unsigned)(R * g.lda + C) * 2u; voffB[i] = (unsigned)(Rb * K + C) * 2u; }
    const size_t kstep = (size_t)(BK * 2);
    const size_t hstepA = (size_t)HALF * g.lda * 2, hstepB = (size_t)HALF * K * 2;
    const size_t tstepA = 2 * hstepA, tstepB = 2 * hstepB;
    const unsigned ldsw = (unsigned)wid * 1024u;
    const int aoff = lds_byte(wr * 64 + fr, fq * 8), boff = lds_byte(wc * 32 + fr, fq * 8);
#define PG8_SA(b, h) (((b) * 2 + (h)) * HTB)
#define PG8_SB(b, h) ((4 + (b) * 2 + (h)) * HTB)
#define PG8_STAGE(bufoff, gbase, voff) do { _Pragma("unroll") for (int _i = 0; _i < 2; ++_i) \
        __builtin_amdgcn_global_load_lds((const unsigned*)((const char*)(gbase) + (voff)[_i]), (PG8_LAS unsigned*)(lds + (bufoff) + ldsw + _i * 8192), 16, 0, 0); } while (0)
#define PG8_LDA(dst, b, h) do { _Pragma("unroll") for (int m = 0; m < 4; ++m) _Pragma("unroll") for (int k = 0; k < 2; ++k) dst[m][k] = *(const PG8_LAS bf16x8*)(lds + PG8_SA(b, h) + aoff + m * 2048 + k * 1024); } while (0)
#define PG8_LDB(dst, b, h) do { _Pragma("unroll") for (int n = 0; n < 2; ++n) _Pragma("unroll") for (int k = 0; k < 2; ++k) dst[n][k] = *(const PG8_LAS bf16x8*)(lds + PG8_SB(b, h) + boff + n * 2048 + k * 1024); } while (0)
#define PG8_MMA(ai, bj, At, Bt) do { __builtin_amdgcn_s_setprio(1); _Pragma("unroll") for (int m = 0; m < 4; ++m) _Pragma("unroll") for (int n = 0; n < 2; ++n) _Pragma("unroll") for (int k = 0; k < 2; ++k) \
        acc[ai][bj][m][n] = __builtin_amdgcn_mfma_f32_16x16x32_bf16(Bt[n][k], At[m][k], acc[ai][bj][m][n], 0, 0, 0); __builtin_amdgcn_s_setprio(0); } while (0)
#define PG8_WAIT_V(n) asm volatile("s_waitcnt vmcnt(" #n ")" ::: "memory")
#define PG8_WAIT_L(n) asm volatile("s_waitcnt lgkmcnt(" #n ")" ::: "memory")
#define PG8_BAR __builtin_amdgcn_s_barrier()
#define PG8_SCHED __builtin_amdgcn_sched_barrier(0)
    Unit cur, nxt; int ui = 0;
    if (!S.next(0, cur)) return;
    f32x4 acc[2][2][4][2];
#pragma unroll
    for (int a = 0; a < 2; ++a)
#pragma unroll
        for (int b = 0; b < 2; ++b)
#pragma unroll
            for (int m = 0; m < 4; ++m)
#pragma unroll
                for (int n = 0; n < 2; ++n) acc[a][b][m][n] = (f32x4){0.f, 0.f, 0.f, 0.f};
    bf16x8 At[4][2], B0[2][2], B1[2][2];
    const char* cA = (const char*)g.A + (size_t)cur.pm * tstepA; const char* cB = (const char*)g.Bt + (size_t)cur.pn * tstepB;
    S.a_ready(cur);
    if constexpr (SP2) {
        PG8_STAGE(PG8_SB(0, 0), cB, voffB); PG8_STAGE(PG8_SB(0, 1), cB + hstepB, voffB); PG8_STAGE(PG8_SA(0, 0), cA, voffA); PG8_STAGE(PG8_SA(0, 1), cA + hstepA, voffA);
        if (wr == 1) PG8_BAR;
        PG8_WAIT_V(2); PG8_BAR;
        PG8_STAGE(PG8_SB(1, 0), cB + kstep, voffB); PG8_STAGE(PG8_SA(1, 0), cA + kstep, voffA); PG8_STAGE(PG8_SB(1, 1), cB + hstepB + kstep, voffB);
        PG8_WAIT_V(6); PG8_BAR;
    } else {
        PG8_STAGE(PG8_SB(0, 0), cB, voffB); PG8_STAGE(PG8_SA(0, 0), cA, voffA); PG8_STAGE(PG8_SB(0, 1), cB + hstepB, voffB); PG8_STAGE(PG8_SA(0, 1), cA + hstepA, voffA);
        if (wr == 1) PG8_BAR;
        PG8_WAIT_V(4); PG8_BAR;
        PG8_STAGE(PG8_SB(1, 0), cB + kstep, voffB); PG8_STAGE(PG8_SA(1, 0), cA + kstep, voffA); PG8_STAGE(PG8_SB(1, 1), cB + hstepB + kstep, voffB);
        PG8_WAIT_V(6); PG8_BAR;
    }
    for (;;) {
        const bool has_next = S.next(ui + 1, nxt);
        const char* nA = has_next ? (const char*)g.A + (size_t)nxt.pm * tstepA : cA; const char* nB = has_next ? (const char*)g.Bt + (size_t)nxt.pn * tstepB : cB;
        for (int t = 0; t < nt; t += 2) {
            const bool last = (t == nt - 2);
            const char* a1 = cA + (size_t)(t + 1) * kstep;
            const char* a2 = last ? nA : cA + (size_t)(t + 2) * kstep; const char* b2 = last ? nB : cB + (size_t)(t + 2) * kstep;
            const char* a3 = a2 + kstep; const char* b3 = b2 + kstep;
            if (last && has_next) S.a_ready(nxt);
            if constexpr (SP2) {
            PG8_LDB(B0, 0, 0); PG8_LDB(B1, 0, 1); PG8_SCHED; PG8_LDA(At, 0, 0); PG8_STAGE(PG8_SA(1, 1), a1 + hstepA, voffA);
            PG8_WAIT_V(8); PG8_WAIT_L(0); PG8_BAR; PG8_MMA(0, 0, At, B0); PG8_MMA(0, 1, At, B1); PG8_BAR; PG8_SCHED;
            PG8_LDA(At, 0, 1); PG8_STAGE(PG8_SB(0, 0), b2, voffB); PG8_STAGE(PG8_SB(0, 1), b2 + hstepB, voffB); PG8_STAGE(PG8_SA(0, 0), a2, voffA);
            PG8_WAIT_V(8); PG8_WAIT_L(0); PG8_BAR; PG8_MMA(1, 0, At, B0); PG8_MMA(1, 1, At, B1); PG8_BAR; PG8_SCHED;
            PG8_LDB(B0, 1, 0); PG8_LDB(B1, 1, 1); PG8_SCHED; PG8_LDA(At, 1, 0); PG8_STAGE(PG8_SA(0, 1), a2 + hstepA, voffA);
            PG8_WAIT_V(8); PG8_WAIT_L(0); PG8_BAR; PG8_MMA(0, 0, At, B0); PG8_MMA(0, 1, At, B1); PG8_BAR; PG8_SCHED;
            PG8_LDA(At, 1, 1); PG8_STAGE(PG8_SB(1, 0), b3, voffB); PG8_STAGE(PG8_SB(1, 1), b3 + hstepB, voffB); PG8_STAGE(PG8_SA(1, 0), a3, voffA);
            PG8_WAIT_V(8); PG8_WAIT_L(0); PG8_BAR; PG8_MMA(1, 0, At, B0); PG8_MMA(1, 1, At, B1); PG8_BAR; PG8_SCHED;
            } else {
            PG8_LDB(B0, 0, 0); PG8_SCHED; PG8_LDA(At, 0, 0); PG8_STAGE(PG8_SA(1, 1), a1 + hstepA, voffA);
            PG8_WAIT_L(8); PG8_BAR; PG8_WAIT_L(0); PG8_MMA(0, 0, At, B0); PG8_BAR; PG8_SCHED;
            PG8_LDB(B1, 0, 1); PG8_STAGE(PG8_SB(0, 0), b2, voffB);
            PG8_BAR; PG8_WAIT_L(0); PG8_MMA(0, 1, At, B1); PG8_BAR;
            PG8_LDA(At, 0, 1); PG8_STAGE(PG8_SA(0, 0), a2, voffA);
            PG8_BAR; PG8_WAIT_L(0); PG8_MMA(1, 0, At, B0); PG8_BAR; PG8_SCHED;
            PG8_STAGE(PG8_SB(0, 1), b2 + hstepB, voffB);
            PG8_WAIT_V(6); PG8_BAR; PG8_MMA(1, 1, At, B1); PG8_BAR;
            PG8_LDB(B0, 1, 0); PG8_SCHED; PG8_LDA(At, 1, 0); PG8_STAGE(PG8_SA(0, 1), a2 + hstepA, voffA);
            PG8_WAIT_L(8); PG8_BAR; PG8_WAIT_L(0); PG8_MMA(0, 0, At, B0); PG8_BAR; PG8_SCHED;
            PG8_LDB(B1, 1, 1); PG8_STAGE(PG8_SB(1, 0), b3, voffB);
            PG8_BAR; PG8_WAIT_L(0); PG8_MMA(0, 1, At, B1); PG8_BAR;
            PG8_LDA(At, 1, 1); PG8_STAGE(PG8_SA(1, 0), a3, voffA);
            PG8_BAR; PG8_WAIT_L(0); PG8_MMA(1, 0, At, B0); PG8_BAR; PG8_SCHED;
            PG8_STAGE(PG8_SB(1, 1), b3 + hstepB, voffB);
            PG8_WAIT_V(6); PG8_BAR; PG8_MMA(1, 1, At, B1); PG8_BAR;
            }
        }
        if constexpr (ALIGN_EPI) { if (wr == 0) PG8_BAR; }
        if constexpr (!Epi::AFTER_DRAIN) { E(acc, cur, wr, wc, fr, fq); S.done(cur); }
        if (!has_next) break;
#pragma unroll
        for (int a = 0; a < 2; ++a)
#pragma unroll
            for (int b = 0; b < 2; ++b)
#pragma unroll
                for (int m = 0; m < 4; ++m)
#pragma unroll
                    for (int n = 0; n < 2; ++n) acc[a][b][m][n] = (f32x4){0.f, 0.f, 0.f, 0.f};
        cur = nxt; cA = nA; cB = nB; ++ui;
        if constexpr (ALIGN_EPI) { if (wr == 1) PG8_BAR; }
    }
    PG8_WAIT_V(0);
    if constexpr (!ALIGN_EPI) { if (wr == 0) PG8_BAR; }
    PG8_BAR;
    if constexpr (Epi::AFTER_DRAIN) { E.fused(acc, cur, wr, wc, fr, fq, lds, wid, lane); S.done(cur); }
#undef PG8_SA
#undef PG8_SB
#undef PG8_STAGE
#undef PG8_LDA
#undef PG8_LDB
#undef PG8_MMA
#undef PG8_WAIT_V
#undef PG8_WAIT_L
#undef PG8_BAR
#undef PG8_SCHED
}
}
namespace pg8 {
struct Unit2 { int pm, pn, e, cnt, jt; };
template <class Epi, class Sched>
__device__ __forceinline__ void gemm_phase2(PG8_LAS unsigned char* lds, const bf16_t* Abase, int lda, int ldb, int K, const Sched& S, const Epi& E) {
    int tid_ = threadIdx.x; asm volatile("" : "+v"(tid_));
    const int tid = tid_, wid = __builtin_amdgcn_readfirstlane(tid >> 6), lane = tid & 63, wr = wid >> 2, wc = wid & 3, fr = lane & 15, fq = lane >> 4;
    int K_ = K; asm volatile("" : "+s"(K_));
    const int nt = K_ / BK;
    unsigned voffB[2];
#pragma unroll
    for (int i = 0; i < 2; ++i) { int R, C; stage_rc(tid * 16 + i * 8192, R, C); const int Rb = Epi::PERM ? ((R & ~31) + perm32(R & 31)) : R; voffB[i] = (unsigned)(Rb * ldb + C) * 2u; }
    const unsigned lda2 = (unsigned)lda * 2u;
#define PG8_AOFFS(U, o0, o1) do { int t2_ = threadIdx.x; asm volatile("" : "+v"(t2_)); _Pragma("unroll") for (int i_ = 0; i_ < 2; ++i_) { int R_, C_; stage_rc(t2_ * 16 + i_ * 8192, R_, C_); \
        o0[i_] = (unsigned)S.arow(U, R_) * lda2 + (unsigned)C_ * 2u; o1[i_] = (unsigned)S.arow(U, HALF + R_) * lda2 + (unsigned)C_ * 2u; } } while (0)
    const size_t kstep = (size_t)(BK * 2);
    const size_t hstepB = (size_t)HALF * ldb * 2;
    const unsigned ldsw = (unsigned)wid * 1024u;
    const int aoff = lds_byte(wr * 64 + fr, fq * 8), boff = lds_byte(wc * 32 + fr, fq * 8);
#define PG8_SA(b, h) (((b) * 2 + (h)) * HTB)
#define PG8_SB(b, h) ((4 + (b) * 2 + (h)) * HTB)
#define PG8_STAGE(bufoff, gbase, voff) do { _Pragma("unroll") for (int _i = 0; _i < 2; ++_i) \
        __builtin_amdgcn_global_load_lds((const unsigned*)((const char*)(gbase) + (voff)[_i]), (PG8_LAS unsigned*)(lds + (bufoff) + ldsw + _i * 8192), 16, 0, 0); } while (0)
#define PG8_LDA(dst, b, h) do { _Pragma("unroll") for (int m = 0; m < 4; ++m) _Pragma("unroll") for (int k = 0; k < 2; ++k) dst[m][k] = *(const PG8_LAS bf16x8*)(lds + PG8_SA(b, h) + aoff + m * 2048 + k * 1024); } while (0)
#define PG8_LDB(dst, b, h) do { _Pragma("unroll") for (int n = 0; n < 2; ++n) _Pragma("unroll") for (int k = 0; k < 2; ++k) dst[n][k] = *(const PG8_LAS bf16x8*)(lds + PG8_SB(b, h) + boff + n * 2048 + k * 1024); } while (0)
#define PG8_MMA(ai, bj, At, Bt) do { __builtin_amdgcn_s_setprio(1); _Pragma("unroll") for (int m = 0; m < 4; ++m) _Pragma("unroll") for (int n = 0; n < 2; ++n) _Pragma("unroll") for (int k = 0; k < 2; ++k) \
        acc[ai][bj][m][n] = __builtin_amdgcn_mfma_f32_16x16x32_bf16(Bt[n][k], At[m][k], acc[ai][bj][m][n], 0, 0, 0); __builtin_amdgcn_s_setprio(0); } while (0)
#define PG8_WAIT_V(n) asm volatile("s_waitcnt vmcnt(" #n ")" ::: "memory")
#define PG8_WAIT_L(n) asm volatile("s_waitcnt lgkmcnt(" #n ")" ::: "memory")
#define PG8_BAR __builtin_amdgcn_s_barrier()
#define PG8_SCHED __builtin_amdgcn_sched_barrier(0)
    Unit2 cur, nxt; int ui = 0;
    if (!S.next(0, cur)) return;
    f32x4 acc[2][2][4][2];
#pragma unroll
    for (int a = 0; a < 2; ++a)
#pragma unroll
        for (int b = 0; b < 2; ++b)
#pragma unroll
            for (int m = 0; m < 4; ++m)
#pragma unroll
                for (int n = 0; n < 2; ++n) acc[a][b][m][n] = (f32x4){0.f, 0.f, 0.f, 0.f};
    bf16x8 At[4][2], B0[2][2], B1[2][2];
    unsigned cv0[2], cv1[2], nv0[2], nv1[2];
    PG8_AOFFS(cur, cv0, cv1);
    const char* cA = (const char*)Abase + S.aoff(cur); const char* cB = S.bptr(cur);
    PG8_STAGE(PG8_SB(0, 0), cB, voffB); PG8_STAGE(PG8_SB(0, 1), cB + hstepB, voffB); PG8_STAGE(PG8_SA(0, 0), cA, cv0); PG8_STAGE(PG8_SA(0, 1), cA, cv1);
    if (wr == 1) PG8_BAR;
    PG8_WAIT_V(2); PG8_BAR;
    PG8_STAGE(PG8_SB(1, 0), cB + kstep, voffB); PG8_STAGE(PG8_SA(1, 0), cA + kstep, cv0); PG8_STAGE(PG8_SB(1, 1), cB + hstepB + kstep, voffB);
    PG8_WAIT_V(6); PG8_BAR;
    for (;;) {
        const bool has_next = S.next(ui + 1, nxt);
        const char* nA = has_next ? (const char*)Abase + S.aoff(nxt) : cA; const char* nB = has_next ? S.bptr(nxt) : cB;
#pragma unroll
        for (int i = 0; i < 2; ++i) { nv0[i] = cv0[i]; nv1[i] = cv1[i]; }
        if (has_next) PG8_AOFFS(nxt, nv0, nv1);
        for (int t = 0; t < nt; t += 2) {
            const bool last = (t == nt - 2);
            const char* a1 = cA + (size_t)(t + 1) * kstep;
            const char* a2 = last ? nA : cA + (size_t)(t + 2) * kstep; const char* b2 = last ? nB : cB + (size_t)(t + 2) * kstep;
            const char* a3 = a2 + kstep; const char* b3 = b2 + kstep;
            unsigned s0[2] = {cv0[0], cv0[1]}, s1[2] = {cv1[0], cv1[1]};
            if (last) { asm volatile("" ::: "memory"); s0[0] = nv0[0]; s0[1] = nv0[1]; s1[0] = nv1[0]; s1[1] = nv1[1]; }
            PG8_LDB(B0, 0, 0); PG8_LDB(B1, 0, 1); PG8_SCHED; PG8_LDA(At, 0, 0); PG8_STAGE(PG8_SA(1, 1), a1, cv1);
            PG8_WAIT_V(8); PG8_WAIT_L(0); PG8_BAR; PG8_MMA(0, 0, At, B0); PG8_MMA(0, 1, At, B1); PG8_BAR; PG8_SCHED;
            PG8_LDA(At, 0, 1); PG8_STAGE(PG8_SB(0, 0), b2, voffB); PG8_STAGE(PG8_SB(0, 1), b2 + hstepB, voffB); PG8_STAGE(PG8_SA(0, 0), a2, s0);
            PG8_WAIT_V(8); PG8_WAIT_L(0); PG8_BAR; PG8_MMA(1, 0, At, B0); PG8_MMA(1, 1, At, B1); PG8_BAR; PG8_SCHED;
            PG8_LDB(B0, 1, 0); PG8_LDB(B1, 1, 1); PG8_SCHED; PG8_LDA(At, 1, 0); PG8_STAGE(PG8_SA(0, 1), a2, s1);
            PG8_WAIT_V(8); PG8_WAIT_L(0); PG8_BAR; PG8_MMA(0, 0, At, B0); PG8_MMA(0, 1, At, B1); PG8_BAR; PG8_SCHED;
            PG8_LDA(At, 1, 1); PG8_STAGE(PG8_SB(1, 0), b3, voffB); PG8_STAGE(PG8_SB(1, 1), b3 + hstepB, voffB); PG8_STAGE(PG8_SA(1, 0), a3, s0);
            PG8_WAIT_V(8); PG8_WAIT_L(0); PG8_BAR; PG8_MMA(1, 0, At, B0); PG8_MMA(1, 1, At, B1); PG8_BAR; PG8_SCHED;
        }
        if (wr == 0) PG8_BAR;
        { Unit2 eu = cur; asm volatile("" : "+s"(eu.pm), "+s"(eu.pn), "+s"(eu.e), "+s"(eu.cnt), "+s"(eu.jt));
          E(acc, eu, wr, wc, fr, fq); }
        if (!has_next) break;
#pragma unroll
        for (int a = 0; a < 2; ++a)
#pragma unroll
            for (int b = 0; b < 2; ++b)
#pragma unroll
                for (int m = 0; m < 4; ++m)
#pragma unroll
                    for (int n = 0; n < 2; ++n) acc[a][b][m][n] = (f32x4){0.f, 0.f, 0.f, 0.f};
        cur = nxt; cA = nA; cB = nB; ++ui;
#pragma unroll
        for (int i = 0; i < 2; ++i) { cv0[i] = nv0[i]; cv1[i] = nv1[i]; }
        if (wr == 1) PG8_BAR;
    }
    PG8_WAIT_V(0);
    PG8_BAR;
#undef PG8_AOFFS
#undef PG8_SA
#undef PG8_SB
#undef PG8_STAGE
#undef PG8_LDA
#undef PG8_LDB
#undef PG8_MMA
#undef PG8_WAIT_V
#undef PG8_WAIT_L
#undef PG8_BAR
#undef PG8_SCHED
}

struct DenseSched {
    StaticOrder so; const bf16_t* Bt; int ldb;
    __device__ __forceinline__ bool next(int i, Unit2& u) const { Unit t; if (!so.next(i, t)) return false; u.pm = t.pm; u.pn = t.pn; u.e = 0; u.cnt = 256; u.jt = 0; return true; }
    __device__ __forceinline__ int arow(const Unit2& u, int r) const { return u.pm * BM + r; }
    __device__ __forceinline__ size_t aoff(const Unit2&) const { return 0; }
    __device__ __forceinline__ const char* bptr(const Unit2& u) const { return (const char*)(Bt + (size_t)u.pn * BM * ldb); }
};
struct EpiResid {
    static constexpr bool PERM = false, AFTER_DRAIN = false;
    float* C; int ldc; const float* x; const float* stats; const float* g; const float* b; float alpha;
    __device__ __forceinline__ void operator()(const f32x4 (&acc)[2][2][4][2], const Unit2& u, int wr, int wc, int fr, int fq) const {
        const int row0 = u.pm * BM + wr * 64 + fr, col0 = u.pn * BM + wc * 32 + 4 * fq;
        f32x4 gv[2][2], bv[2][2];
#pragma unroll
        for (int bj = 0; bj < 2; ++bj)
#pragma unroll
            for (int n = 0; n < 2; ++n) { gv[bj][n] = *(const f32x4*)(g + col0 + bj * HALF + n * 16) * alpha; bv[bj][n] = *(const f32x4*)(b + col0 + bj * HALF + n * 16) * alpha; }
#pragma unroll
        for (int ai = 0; ai < 2; ++ai)
#pragma unroll
            for (int m = 0; m < 4; ++m) { const int row = row0 + ai * HALF + m * 16; const float mean = stats[2 * row], rstd = stats[2 * row + 1];
                const float* xr = x + (size_t)row * ldc + col0; float* cr = C + (size_t)row * ldc + col0;
#pragma unroll
                for (int bj = 0; bj < 2; ++bj)
#pragma unroll
                    for (int n = 0; n < 2; ++n) { const f32x4 xv = *(const f32x4*)(xr + bj * HALF + n * 16);
                        *(f32x4*)(cr + bj * HALF + n * 16) = acc[ai][bj][m][n] + ((xv - mean) * rstd) * gv[bj][n] + bv[bj][n]; } }
    }
};
}
namespace nv {
constexpr int D = 1024, B = 8, S = 4096, T = B * S;
constexpr int FH = 8, FD = 64, GH = 4, GK = 64, GV = 128, RANK = 16;
constexpr int INW = 3096;
constexpr int O_FQ = 0, O_FK = 512, O_FV = 1024, O_FF = 1536, O_GQ = 1544, O_GK = 1800, O_GV = 2056, O_GA = 2568, O_GR = 2584;
constexpr int NE = 256, NG = 8, TOPK = 8, ED = 256;
constexpr float LN_EPS = 1e-5f;
constexpr float ALPHA = 1.189207115002721f;
constexpr int PADR = 64;
constexpr int APAD = T * TOPK + NE * PADR;

__device__ __forceinline__ float logsigmoidf(float x) { return fminf(x, 0.f) - log1pf(expf(-fabsf(x))); }
__device__ __forceinline__ float siluf(float x) { return x / (1.f + expf(-x)); }


__device__ __forceinline__ void ln_row(const float* in1, float a, const float* in2, const float* __restrict__ g, const float* __restrict__ b, float* out, int r, int tid, float* sh) {
    float4 v = ((const float4*)(in1 + (size_t)r * D))[tid];
    v.x *= a; v.y *= a; v.z *= a; v.w *= a;
    if (in2) { const float4 w = ((const float4*)(in2 + (size_t)r * D))[tid]; v.x += w.x; v.y += w.y; v.z += w.z; v.w += w.w; }
    float s = v.x + v.y + v.z + v.w;
    for (int o = 32; o > 0; o >>= 1) s += __shfl_xor(s, o);
    __syncthreads();
    if ((tid & 63) == 0) sh[tid >> 6] = s;
    __syncthreads();
    const float mean = (sh[0] + sh[1] + sh[2] + sh[3]) * (1.f / D);
    v.x -= mean; v.y -= mean; v.z -= mean; v.w -= mean;
    float q = v.x * v.x + v.y * v.y + v.z * v.z + v.w * v.w;
    for (int o = 32; o > 0; o >>= 1) q += __shfl_xor(q, o);
    if ((tid & 63) == 0) sh[4 + (tid >> 6)] = q;
    __syncthreads();
    const float rstd = rsqrtf((sh[4] + sh[5] + sh[6] + sh[7]) * (1.f / D) + LN_EPS);
    const float4 gg = ((const float4*)g)[tid], bb = ((const float4*)b)[tid];
    float4 o4; o4.x = v.x * rstd * gg.x + bb.x; o4.y = v.y * rstd * gg.y + bb.y; o4.z = v.z * rstd * gg.z + bb.z; o4.w = v.w * rstd * gg.w + bb.w;
    ((float4*)(out + (size_t)r * D))[tid] = o4;
}

__device__ __forceinline__ void gemm_tile(const float* A, const float* Bm, float* C, int N, int K, int lda, int ldb, int ldc, int tile_x, int tile_y, int tid, float* sh) {
    float (*As)[68] = (float (*)[68])sh;
    float (*Bs)[68] = (float (*)[68])(sh + 16 * 68);
    const int tx = tid & 15, ty = tid >> 4;
    const int row0 = tile_y * 64, col0 = tile_x * 64;
    float acc[4][4] = {};
    const int ar = tid >> 2, ak = (tid & 3) * 4;
    const int bk = tid >> 4, bc = (tid & 15) * 4;
    const bool bok = (col0 + bc) < N;
    for (int k0 = 0; k0 < K; k0 += 16) {
        const float4 av = *(const float4*)(A + (size_t)(row0 + ar) * lda + k0 + ak);
        float4 bv = make_float4(0.f, 0.f, 0.f, 0.f);
        if (bok) bv = *(const float4*)(Bm + (size_t)(k0 + bk) * ldb + col0 + bc);
        __syncthreads();
        As[ak + 0][ar] = av.x; As[ak + 1][ar] = av.y; As[ak + 2][ar] = av.z; As[ak + 3][ar] = av.w;
        *(float4*)&Bs[bk][bc] = bv;
        __syncthreads();
#pragma unroll
        for (int k = 0; k < 16; ++k) {
            const float4 a4 = *(const float4*)&As[k][ty * 4];
            const float4 b4 = *(const float4*)&Bs[k][tx * 4];
            const float aa[4] = {a4.x, a4.y, a4.z, a4.w}, bb[4] = {b4.x, b4.y, b4.z, b4.w};
#pragma unroll
            for (int i = 0; i < 4; ++i)
#pragma unroll
                for (int j = 0; j < 4; ++j) acc[i][j] += aa[i] * bb[j];
        }
    }
    if (col0 + tx * 4 < N) {
#pragma unroll
        for (int i = 0; i < 4; ++i)
            *(float4*)(C + (size_t)(row0 + ty * 4 + i) * ldc + col0 + tx * 4) = make_float4(acc[i][0], acc[i][1], acc[i][2], acc[i][3]);
    }
}
__device__ __forceinline__ void gemm_phase(const float* A, const float* Bm, float* C, int M, int N, int K, int lda, int ldb, int ldc, int half, int tid, float* sh) {
    const int ntx = (N + 63) / 64, nty = M / 64, ntile = ntx * nty, G2 = gridDim.x * 2;
    for (int t0 = blockIdx.x * 2; t0 < ntile; t0 += G2) {
        int tl = t0 + half; if (tl >= ntile) tl = ntile - 1;
        gemm_tile(A, Bm, C, N, K, lda, ldb, ldc, tl % ntx, tl / ntx, tid, sh);
    }
}

__device__ __forceinline__ void fox_prep(const float* proj, const float* __restrict__ bf, float* cbuf, int bh, int lane) {
    const int b = bh / FH, h = bh % FH;
    const float bias = bf[h];
    float s = 0.f;
    for (int i = 0; i < 64; ++i) { const int t = lane * 64 + i; s += logsigmoidf(proj[(size_t)(b * S + t) * INW + O_FF + h] + bias); }
    float inc = s;
    for (int o = 1; o < 64; o <<= 1) { const float n = __shfl_up(inc, o); if (lane >= o) inc += n; }
    float run = inc - s;
    for (int i = 0; i < 64; ++i) { const int t = lane * 64 + i; run += logsigmoidf(proj[(size_t)(b * S + t) * INW + O_FF + h] + bias); cbuf[(size_t)bh * S + t] = run; }
}

__device__ __forceinline__ void fox_attn(const float* proj, const float* cbuf, float* y, int blk, int lane) {
    const int qb = blk % (S / 64), bh = blk / (S / 64), b = bh / FH, h = bh % FH;
    const int t = qb * 64 + lane;
    const float* qp = proj + (size_t)(b * S + t) * INW + O_FQ + h * FD;
    float q[64], o[64];
#pragma unroll
    for (int d = 0; d < 64; ++d) { q[d] = qp[d] * 0.125f; o[d] = 0.f; }
    const float ct = cbuf[(size_t)bh * S + t];
    float m = -INFINITY, l = 0.f;
    const int smax = qb * 64 + 63;
    for (int s = 0; s <= smax; ++s) {
        const float* kp = proj + (size_t)(b * S + s) * INW + O_FK + h * FD;
        const float* vp = proj + (size_t)(b * S + s) * INW + O_FV + h * FD;
        float dot = 0.f;
#pragma unroll
        for (int d = 0; d < 64; ++d) dot += q[d] * kp[d];
        const float x = dot + (ct - cbuf[(size_t)bh * S + s]);
        if (s <= t) {
            if (x > m) { const float al = expf(m - x); l *= al;
#pragma unroll
                for (int d = 0; d < 64; ++d) o[d] *= al;
                m = x; }
            const float p = expf(x - m); l += p;
#pragma unroll
            for (int d = 0; d < 64; ++d) o[d] += p * vp[d];
        }
    }
    const float il = 1.f / l;
    float* yp = y + (size_t)(b * S + t) * D + h * FD;
#pragma unroll
    for (int d = 0; d < 64; ++d) yp[d] = o[d] * il;
}

__device__ __forceinline__ void gla_prep(const float* proj, const float* __restrict__ wgu, const float* __restrict__ bg, float* abuf, int t, int j) {
    const float* ga = proj + (size_t)t * INW + O_GA;
    float s = bg[j];
#pragma unroll
    for (int r = 0; r < RANK; ++r) s += ga[r] * wgu[r * 256 + j];
    abuf[(size_t)t * 256 + j] = expf(logsigmoidf(s) * (1.f / 16.f));
}

__device__ __forceinline__ void gla_rec(const float* proj, const float* abuf, float* glao, int bh, int e) {
    const int b = bh / GH, h = bh % GH;
    float st[64];
#pragma unroll
    for (int d = 0; d < 64; ++d) st[d] = 0.f;
    for (int s = 0; s < S; ++s) {
        const size_t t = (size_t)b * S + s;
        const float* qp = proj + t * INW + O_GQ + h * GK;
        const float* kp = proj + t * INW + O_GK + h * GK;
        const float* ap = abuf + t * 256 + h * GK;
        const float v = proj[t * INW + O_GV + h * GV + e];
        float o = 0.f;
#pragma unroll
        for (int d = 0; d < 64; ++d) { st[d] = ap[d] * st[d] + kp[d] * v; o += qp[d] * st[d]; }
        glao[t * 512 + h * GV + e] = o * 0.125f;
    }
}

__device__ __forceinline__ void gla_post(const float* glao, const float* proj, const float* __restrict__ g, float* y, int w, int lane) {
    const int t = w >> 2, h = w & 3;
    const float o0 = glao[(size_t)t * 512 + h * GV + lane], o1 = glao[(size_t)t * 512 + h * GV + 64 + lane];
    float ss = o0 * o0 + o1 * o1;
    for (int o = 32; o > 0; o >>= 1) ss += __shfl_xor(ss, o);
    const float r = rsqrtf(ss * (1.f / GV) + LN_EPS);
    const float g0 = proj[(size_t)t * INW + O_GR + h * GV + lane], g1 = proj[(size_t)t * INW + O_GR + h * GV + 64 + lane];
    y[(size_t)t * D + 512 + h * GV + lane] = o0 * r * g[lane] * siluf(g0);
    y[(size_t)t * D + 512 + h * GV + 64 + lane] = o1 * r * g[64 + lane] * siluf(g1);
}

__device__ __forceinline__ void route_token(const float* logits, const float* __restrict__ rbias, int* top_e, float* top_w, int* top_pos, int* counts, int t, int lane) {
    const float4 lg = ((const float4*)(logits + (size_t)t * NE))[lane];
    const float4 rb = ((const float4*)rbias)[lane];
    float sc[4] = {1.f / (1.f + expf(-lg.x)), 1.f / (1.f + expf(-lg.y)), 1.f / (1.f + expf(-lg.z)), 1.f / (1.f + expf(-lg.w))};
    float bv[4] = {sc[0] + rb.x, sc[1] + rb.y, sc[2] + rb.z, sc[3] + rb.w};
    float m1 = fmaxf(bv[0], bv[1]), m2 = fminf(bv[0], bv[1]);
    { const float a = fmaxf(bv[2], bv[3]), c = fminf(bv[2], bv[3]); const float n1 = fmaxf(m1, a); m2 = fmaxf(fminf(m1, a), fmaxf(m2, c)); m1 = n1; }
    for (int o = 1; o < 8; o <<= 1) { const float p1 = __shfl_xor(m1, o), p2 = __shfl_xor(m2, o); const float n1 = fmaxf(m1, p1); m2 = fmaxf(fminf(m1, p1), fmaxf(m2, p2)); m1 = n1; }
    const float gs = m1 + m2;
    const int myg = lane >> 3;
    int rank = 0;
#pragma unroll
    for (int g2 = 0; g2 < NG; ++g2) { const float og = __shfl(gs, g2 * 8); if (og > gs || (og == gs && g2 < myg)) ++rank; }
    const bool sel = rank < 4;
    float mv[4];
#pragma unroll
    for (int i = 0; i < 4; ++i) mv[i] = sel ? bv[i] : -INFINITY;
    int we[TOPK]; float ws[TOPK]; float wsum = 0.f;
#pragma unroll
    for (int k = 0; k < TOPK; ++k) {
        float bvv = mv[0]; int bi = 0;
#pragma unroll
        for (int i = 1; i < 4; ++i) if (mv[i] > bvv) { bvv = mv[i]; bi = i; }
        int gi = lane * 4 + bi;
        for (int o = 32; o > 0; o >>= 1) { const float ov = __shfl_xor(bvv, o); const int oi = __shfl_xor(gi, o); if (ov > bvv || (ov == bvv && oi < gi)) { bvv = ov; gi = oi; } }
        const int ol = gi >> 2, oi = gi & 3;
        const float s_own = (oi == 0) ? sc[0] : (oi == 1) ? sc[1] : (oi == 2) ? sc[2] : sc[3];
        const float sw = __shfl(s_own, ol);
        if (lane == ol) { if (oi == 0) mv[0] = -INFINITY; else if (oi == 1) mv[1] = -INFINITY; else if (oi == 2) mv[2] = -INFINITY; else mv[3] = -INFINITY; }
        we[k] = gi; ws[k] = sw; wsum += sw;
    }
    if (lane == 0) {
        const float inv = 2.5f / wsum;
#pragma unroll
        for (int k = 0; k < TOPK; ++k) {
            top_e[t * TOPK + k] = we[k]; top_w[t * TOPK + k] = ws[k] * inv;
            top_pos[t * TOPK + k] = atomicAdd(&counts[we[k]], 1);
        }
    }
}

__device__ __forceinline__ void moe_offsets(const int* counts, int* off, int* blk_exp, int* nblk, int lane) {
    int pc[4], st[4]; int tot = 0;
#pragma unroll
    for (int i = 0; i < 4; ++i) { pc[i] = (counts[lane * 4 + i] + PADR - 1) / PADR * PADR; st[i] = tot; tot += pc[i]; }
    int inc = tot;
    for (int o = 1; o < 64; o <<= 1) { const int n = __shfl_up(inc, o); if (lane >= o) inc += n; }
    const int base = inc - tot;
#pragma unroll
    for (int i = 0; i < 4; ++i) { const int start = base + st[i]; off[lane * 4 + i] = start; for (int k = start / PADR; k < (start + pc[i]) / PADR; ++k) blk_exp[k] = lane * 4 + i; }
    if (lane == 63) nblk[0] = inc / PADR;
}

__device__ __forceinline__ void moe_scatter(const int* top_e, const float* top_w, const int* top_pos, const int* off, int* row_tok, float* row_gate, int* slot_of, int a) {
    const int slot = off[top_e[a]] + top_pos[a];
    row_tok[slot] = a / TOPK; row_gate[slot] = top_w[a]; slot_of[a] = slot;
}

__device__ __forceinline__ void moe_hidden(const float* h1, const float* __restrict__ wg, const float* __restrict__ wu, const int* row_tok, const float* row_gate, const int* blk_exp, const int* nblk,
                                           float* hidden, int g16, int j, float* sh) {
    const bool active = g16 * 16 < nblk[0] * PADR;
    float (*xs)[D] = (float (*)[D])sh;
    __syncthreads();
    if (active) for (int r = 0; r < 16; ++r) { const int tok = row_tok[g16 * 16 + r]; ((float4*)xs[r])[j] = ((const float4*)(h1 + (size_t)tok * D))[j]; }
    __syncthreads();
    if (!active) return;
    const int e = blk_exp[(g16 * 16) / PADR];
    float ag[16], au[16];
#pragma unroll
    for (int r = 0; r < 16; ++r) { ag[r] = 0.f; au[r] = 0.f; }
    const float* wgp = wg + (size_t)e * D * ED + j; const float* wup = wu + (size_t)e * D * ED + j;
    for (int d = 0; d < D; d += 4) {
        const float g0 = wgp[(size_t)(d + 0) * ED], g1 = wgp[(size_t)(d + 1) * ED], g2 = wgp[(size_t)(d + 2) * ED], g3 = wgp[(size_t)(d + 3) * ED];
        const float u0 = wup[(size_t)(d + 0) * ED], u1 = wup[(size_t)(d + 1) * ED], u2 = wup[(size_t)(d + 2) * ED], u3 = wup[(size_t)(d + 3) * ED];
#pragma unroll
        for (int r = 0; r < 16; ++r) { const float4 x = *(const float4*)&xs[r][d];
            ag[r] += x.x * g0 + x.y * g1 + x.z * g2 + x.w * g3; au[r] += x.x * u0 + x.y * u1 + x.z * u2 + x.w * u3; }
    }
#pragma unroll
    for (int r = 0; r < 16; ++r) hidden[(size_t)(g16 * 16 + r) * ED + j] = row_gate[g16 * 16 + r] * siluf(ag[r]) * au[r];
}

__device__ __forceinline__ void moe_down(const float* hidden, const float* __restrict__ wd, const int* top_e, const int* slot_of, float* ffn, int t, int i, float* sh) {
    float4 acc = ((float4*)(ffn + (size_t)t * D))[i];
    for (int k = 0; k < TOPK; ++k) {
        const int e = top_e[t * TOPK + k], slot = slot_of[t * TOPK + k];
        __syncthreads();
        sh[i] = hidden[(size_t)slot * ED + i];
        __syncthreads();
        const float4* wp = (const float4*)(wd + (size_t)e * ED * D) + i;
        for (int j = 0; j < ED; ++j) { const float4 w = wp[(size_t)j * (D / 4)]; const float hv = sh[j]; acc.x += hv * w.x; acc.y += hv * w.y; acc.z += hv * w.z; acc.w += hv * w.w; }
    }
    ((float4*)(ffn + (size_t)t * D))[i] = acc;
}
}
#include <hip/hip_bf16.h>
#include <cmath>
namespace attn_body {
using bf16=__hip_bfloat16;
using bf16x8=__attribute__((ext_vector_type(8)))short;
using s16x4=__attribute__((ext_vector_type(4)))short;
using f32x16=__attribute__((ext_vector_type(16)))float;
using u32x4=__attribute__((ext_vector_type(4)))unsigned;
constexpr int BATCH=8,NHEAD=8,SEQ=4096,D=64,DM=3072,OPITCH=1024;
constexpr int NW=8,QBLK=32,QB=QBLK*NW,KVBLK=64,NQB=SEQ/QB;
constexpr int ATTN_PITCH=DM, ATTN_UNIT_ROWS=QB;
__device__ __forceinline__ int crow(int r,int hi){return (r&3)+8*(r>>2)+4*hi;}
#define SBAR() __builtin_amdgcn_sched_barrier(0)
__device__ __forceinline__ void cmask(f32x16&p0,f32x16&p1,int jb,int qrel,int hi){
  const float NEG=-INFINITY; int kb=64*jb+4*hi;
  #pragma unroll
  for(int r=0;r<16;++r){int kv=kb+(r&3)+8*(r>>2); if(kv>qrel)p0[r]=NEG; if(kv+32>qrel)p1[r]=NEG;}
}

constexpr int NSLOT=3, SLOTB=8192;
constexpr int LDS_K=0, LDS_V=NSLOT*SLOTB, LDS_WS=2*NSLOT*SLOTB, LDS_OST=LDS_WS+NW*64*4, LDS_KB=LDS_OST+NW*4096, LDS_BYTES=LDS_KB+(SEQ+2)*8;
constexpr float C2=0.125f*1.4426950408889634f;
__device__ __forceinline__ void glds16(const void*gsrc,unsigned lds_dst){unsigned keep;
  asm volatile("s_mov_b32 %0, m0\n\ts_mov_b32 m0, %2\n\ts_nop 0\n\tglobal_load_lds_dwordx4 %1, off\n\ts_mov_b32 m0, %0":"=&s"(keep):"v"(gsrc),"s"(lds_dst):"memory");}
__device__ __forceinline__ float max3f(float a,float b,float c){float r;asm("v_max3_f32 %0, %1, %2, %3":"=v"(r):"v"(a),"v"(b),"v"(c));return r;}
__device__ __forceinline__ float max2f(float a,float b){float r;asm("v_max_f32_e32 %0, %1, %2":"=v"(r):"v"(a),"v"(b));return r;}
__device__ __forceinline__ float fadd_s(float a,float b){float r;asm("v_add_f32_e32 %0, %1, %2":"=v"(r):"v"(a),"v"(b));return r;}
__device__ __forceinline__ float fsub_s(float a,float b){float r;asm("v_sub_f32_e32 %0, %1, %2":"=v"(r):"v"(a),"v"(b));return r;}
typedef float f32x2_t __attribute__((ext_vector_type(2))); typedef float f32x4_t __attribute__((ext_vector_type(4))); typedef __bf16 bf16x2_t __attribute__((ext_vector_type(2)));
__device__ __forceinline__ unsigned cvtpk_s(float lo,float hi){f32x2_t v={lo,hi};bf16x2_t b=__builtin_convertvector(v,bf16x2_t);return __builtin_bit_cast(unsigned,b);}
#define WAIT_BAR(N) asm volatile("s_waitcnt vmcnt(" #N ") lgkmcnt(0)\n\ts_barrier":::"memory")

__device__ __forceinline__ void split3(float b,unsigned&h,unsigned&m,unsigned&l){
  h=cvtpk_s(b,0.f)&0xffffu; const float r1=b-__uint_as_float(h<<16);
  m=cvtpk_s(r1,0.f)&0xffffu; const float r2=r1-__uint_as_float(m<<16);
  l=cvtpk_s(r2,0.f)&0xffffu; }
__device__ __forceinline__ bf16x8 kbias_frag(float b,int hi){unsigned h,m,l;split3(b,h,m,l);u32x4 w;w.x=h|(m<<16);w.y=l|0x3F800000u;w.z=0x3F803F80u;w.w=0u;if(hi){w.x=0u;w.y=0u;w.z=0u;}return __builtin_bit_cast(bf16x8,w);}
__device__ __forceinline__ bf16x8 qref_frag(float x,int hi){unsigned h,m,l;split3(x,h,m,l);u32x4 w;w.x=0x3F803F80u;w.y=0x3F80u|(h<<16);w.z=m|(l<<16);w.w=0u;if(hi){w.x=0u;w.y=0u;w.z=0u;}return __builtin_bit_cast(bf16x8,w);}
typedef unsigned u32x2_t __attribute__((ext_vector_type(2)));
__device__ __forceinline__ bf16x8 mkfrag(u32x2_t e,unsigned zc){u32x4 w;w.x=e.x;w.y=e.y;w.z=zc;w.w=0u;return __builtin_bit_cast(bf16x8,w);}
__device__ __forceinline__ void fox_bias_table(int b,int h,const float*LF,char*shm){
  int tid_=threadIdx.x; asm volatile("":"+v"(tid_)); const int tid=tid_,lane=tid&63,wid=__builtin_amdgcn_readfirstlane(tid>>6);
  const float*lf=LF+((long)b*NHEAD+h)*SEQ; float*wt=(float*)(shm+LDS_WS); u32x2_t*KB8=(u32x2_t*)(shm+LDS_KB);
  f32x4_t va=*(const f32x4_t*)(lf+8*tid),vb=*(const f32x4_t*)(lf+8*tid+4);
  va[1]+=va[0];va[2]+=va[1];va[3]+=va[2];vb[0]+=va[3];vb[1]+=vb[0];vb[2]+=vb[1];vb[3]+=vb[2];
  const float tot=vb[3]; float inc=tot;
  #pragma unroll
  for(int o_=1;o_<64;o_<<=1){const float nn=__shfl_up(inc,o_);if(lane>=o_)inc+=nn;}
  __syncthreads();
  if(lane==63)wt[wid*64]=inc;
  __syncthreads();
  float base=inc-tot;
  #pragma unroll
  for(int w_=0;w_<NW;++w_){const float x_=wt[w_*64]; if(w_<wid)base+=x_;}
  const float cv[8]={va[0]+base,va[1]+base,va[2]+base,va[3]+base,vb[0]+base,vb[1]+base,vb[2]+base,vb[3]+base};
  #pragma unroll
  for(int j=0;j<8;++j){unsigned hh,mm,ll;split3(-cv[j],hh,mm,ll);KB8[8*tid+j]=(u32x2_t){hh|(mm<<16),ll|0x3F800000u};}
  if(tid==0){KB8[SEQ]=(u32x2_t){0u,0u};KB8[SEQ+1]=(u32x2_t){0u,0u};}
  __syncthreads();
}
__device__ __forceinline__ void qkt(f32x16&p0,f32x16&p1,const char*Kslot,const bf16x8*qr,bf16x8 kb0,bf16x8 kb1,bf16x8 qx,int r32,int hi){
  const f32x16 negm=f32x16{};
  const char*kb=Kslot+hi*1024+r32*16;
  #pragma unroll
  for(int d0=0;d0<4;++d0){
    const bf16x8 b0=*reinterpret_cast<const bf16x8*>(kb+d0*2048);
    const bf16x8 b1=*reinterpret_cast<const bf16x8*>(kb+d0*2048+512);
    if(d0==0){p0=__builtin_amdgcn_mfma_f32_32x32x16_bf16(b0,qr[0],negm,0,0,0);p1=__builtin_amdgcn_mfma_f32_32x32x16_bf16(b1,qr[0],negm,0,0,0);}
    else{p0=__builtin_amdgcn_mfma_f32_32x32x16_bf16(b0,qr[d0],p0,0,0,0);p1=__builtin_amdgcn_mfma_f32_32x32x16_bf16(b1,qr[d0],p1,0,0,0);}}
  p0=__builtin_amdgcn_mfma_f32_32x32x16_bf16(kb0,qx,p0,0,0,0);p1=__builtin_amdgcn_mfma_f32_32x32x16_bf16(kb1,qx,p1,0,0,0);
}
typedef __attribute__((address_space(3))) const char* lds_cptr;
typedef short v4i16_t __attribute__((ext_vector_type(4)));
__device__ __forceinline__ void kload8(bf16x8*kf,lds_cptr kp){
  kf[0]=*(const __attribute__((address_space(3))) bf16x8*)(kp);      kf[1]=*(const __attribute__((address_space(3))) bf16x8*)(kp+512);
  kf[2]=*(const __attribute__((address_space(3))) bf16x8*)(kp+2048); kf[3]=*(const __attribute__((address_space(3))) bf16x8*)(kp+2560);
  kf[4]=*(const __attribute__((address_space(3))) bf16x8*)(kp+4096); kf[5]=*(const __attribute__((address_space(3))) bf16x8*)(kp+4608);
  kf[6]=*(const __attribute__((address_space(3))) bf16x8*)(kp+6144); kf[7]=*(const __attribute__((address_space(3))) bf16x8*)(kp+6656);
}
__device__ __forceinline__ void kload2(bf16x8*kf,lds_cptr kp,int j){ kf[2*j]=*(const __attribute__((address_space(3))) bf16x8*)(kp+j*2048); kf[2*j+1]=*(const __attribute__((address_space(3))) bf16x8*)(kp+j*2048+512); }
__device__ __forceinline__ s16x4 vtr(lds_cptr p){ return __builtin_bit_cast(s16x4,__builtin_amdgcn_ds_read_tr16_b64_v4i16((__attribute__((address_space(3))) v4i16_t*)p)); }
__device__ __forceinline__ float rowmax(const f32x16&p0,const f32x16&p1){
  float a=max3f(p0[0],p0[1],p1[0]),b=max3f(p0[2],p0[3],p1[1]);a=max3f(a,p1[2],p1[3]);
  #pragma unroll
  for(int r=4;r<16;r+=4){a=max3f(a,p0[r],p0[r+1]);b=max3f(b,p0[r+2],p0[r+3]);a=max3f(a,p1[r],p1[r+1]);b=max3f(b,p1[r+2],p1[r+3]);}
  const float m=max2f(a,b);
  auto rr=__builtin_amdgcn_permlane32_swap(__float_as_uint(m),__float_as_uint(m),false,false);
  return max2f(__uint_as_float(rr[0]),__uint_as_float(rr[1]));
}
__device__ __forceinline__ void pv(f32x16*o,int vb,bf16x8 pa0,bf16x8 pa1,bf16x8 pa2,bf16x8 pa3){
  #pragma unroll
  for(int d0=0;d0<2;++d0){s16x4 lo[4],hi[4];
    #pragma unroll
    for(int ks=0;ks<4;++ks){
      asm volatile("ds_read_b64_tr_b16 %0,%1 offset:%c2":"=&v"(lo[ks]):"v"(vb),"i"(d0*4096+ks*1024):"memory");
      asm volatile("ds_read_b64_tr_b16 %0,%1 offset:%c2":"=&v"(hi[ks]):"v"(vb),"i"(d0*4096+ks*1024+512):"memory");}
    asm volatile("s_waitcnt lgkmcnt(0)":::"memory");SBAR();
    #define PK(k) (bf16x8){lo[k][0],lo[k][1],lo[k][2],lo[k][3],hi[k][0],hi[k][1],hi[k][2],hi[k][3]}
    o[d0]=__builtin_amdgcn_mfma_f32_32x32x16_bf16(pa0,PK(0),o[d0],0,0,0);
    o[d0]=__builtin_amdgcn_mfma_f32_32x32x16_bf16(pa1,PK(1),o[d0],0,0,0);
    o[d0]=__builtin_amdgcn_mfma_f32_32x32x16_bf16(pa2,PK(2),o[d0],0,0,0);
    o[d0]=__builtin_amdgcn_mfma_f32_32x32x16_bf16(pa3,PK(3),o[d0],0,0,0);
    #undef PK
  }
}

#ifndef ATTN_STORE16
#define ATTN_STORE16(p,v) (*(u32x4*)(p)=(v))
#endif
template<int THRL> __device__ __forceinline__ void attn_unit(int b,int h,int qb,const bf16*Q,const bf16* K,const bf16* V,bf16*O,const float*LF,char*shm){
  int tid_=threadIdx.x; asm volatile("":"+v"(tid_));
  const int tid=tid_,lane=tid&63,r32=lane&31,hi=lane>>5; const int wid=__builtin_amdgcn_readfirstlane(tid>>6);
  const long rowbase=(long)b*SEQ; const int q0=qb*QB;
  const char*KBt=shm+LDS_KB; const unsigned kb_o0=hi?(unsigned)SEQ*8u:(unsigned)r32*8u, kb_o1=hi?(unsigned)SEQ*8u:(unsigned)(r32+32)*8u, kb_str=hi?0u:512u, zc=hi?0u:0x3F803F80u;
  const bf16*Qw=Q+(rowbase+q0+wid*QBLK)*DM+h*D;
  const bf16*Kh=K+rowbase*DM+h*D,*Vh=V+rowbase*DM+h*D;
  const unsigned lds0=(unsigned)(uintptr_t)shm;
  float*wsf=(float*)(shm+LDS_WS)+wid*64;
  const bf16*ksrc=Kh+(long)lane*DM+wid*8;
  const bf16*vsrc=Vh+(long)(16*(wid&3)+(lane>>2))*DM+(wid>>2)*32+(lane&3)*8;
  const unsigned kdst=lds0+LDS_K+wid*1024, vdst=lds0+LDS_V+wid*1024;
  #define DMA_K(t,slot) glds16(ksrc+(long)(t)*KVBLK*DM,(unsigned)__builtin_amdgcn_readfirstlane(kdst+(slot)))
  #define DMA_V(t,slot) glds16(vsrc+(long)(t)*KVBLK*DM,(unsigned)__builtin_amdgcn_readfirstlane(vdst+(slot)))
  const int vb0=(int)(lds0+LDS_V)+((lane>>4)&1)*32+(lane&3)*8+(4*hi+((lane&15)>>2))*64;
  const char*Kbase=shm+LDS_K; bf16x8 kf[8];
  const lds_cptr shm3=(lds_cptr)shm; const lds_cptr kp0=shm3+LDS_K+hi*1024+r32*16; const lds_cptr vp0=shm3+LDS_V+((lane>>4)&1)*32+(lane&3)*8+(4*hi+((lane&15)>>2))*64;
  const int NT=(q0+QB)/KVBLK;
  DMA_K(0,0);DMA_V(0,0);DMA_K(1,SLOTB);
  bf16x8 qr[4];
  #pragma unroll
  for(int d0=0;d0<4;++d0)qr[d0]=*reinterpret_cast<const bf16x8*>(&Qw[(long)r32*DM+d0*16+hi*8]);
  float mhat; { const u32x2_t eq=*(const u32x2_t*)(KBt+(unsigned)(q0+wid*QBLK+r32)*8u); mhat=__uint_as_float(eq.x<<16)+__uint_as_float(eq.x&0xffff0000u)+__uint_as_float(eq.y<<16); }
  float l_reg=0.f;f32x16 o[2];o[0]=f32x16{};o[1]=f32x16{};const f32x16 negm=f32x16{};
  bf16x8 qx=qref_frag(-mhat,hi);
  const int qrel=wid*QBLK+r32;
  #define CMASK(P0,P1,t) do{int jb_=(t)-(NT-4); if(jb_>=0)cmask(P0,P1,jb_,qrel,hi);}while(0)
  bool resc=false;
  #define START(P0,P1) do{ const float rm=rowmax(P0,P1); resc=false; \
    { const float dl=__builtin_fmaxf(rm,0.f); mhat=fadd_s(mhat,dl); \
      _Pragma("unroll") for(int r=0;r<16;++r){P0[r]=fsub_s(P0[r],dl);P1[r]=fsub_s(P1[r],dl);} \
      qx=qref_frag(-mhat,hi); } \
    _Pragma("unroll") for(int r=0;r<16;++r)P0[r]=__builtin_amdgcn_exp2f(P0[r]); }while(0)
  #define RESC() do{ if(resc){ asm volatile("s_waitcnt lgkmcnt(0)":::"memory"); \
      _Pragma("unroll") for(int d_=0;d_<2;++d_) _Pragma("unroll") for(int r=0;r<16;++r)o[d_][r]*=wsf[crow(r,hi)]; } }while(0)
  f32x16 pA0,pA1,pB0,pB1;
  int sl_prev=0,sl_cur=0,sl_next=SLOTB;
  #define ROT() do{sl_prev=sl_cur;sl_cur=sl_next;sl_next=(sl_next==(NSLOT-1)*SLOTB)?0:sl_next+SLOTB;}while(0)
  DMA_K(2,2*SLOTB);
  WAIT_BAR(3);
  qkt(pA0,pA1,Kbase,qr,mkfrag(*(const u32x2_t*)(KBt+kb_o0),zc),mkfrag(*(const u32x2_t*)(KBt+kb_o1),zc),qx,r32,hi);asm volatile("s_nop 15\n\ts_nop 7":"+v"(pA0),"+v"(pA1));CMASK(pA0,pA1,0);
  START(pA0,pA1);
  _Pragma("unroll") for(int r=0;r<16;++r)pA1[r]=__builtin_amdgcn_exp2f(pA1[r]);
  WAIT_BAR(0);
  DMA_K(3,0);DMA_V(1,SLOTB);
  ROT();
  kload8(kf,kp0+sl_cur);
  WAIT_BAR(2);
  s16x4 vlo[8],vhi[8]; u32x4 pw0,pw1,pw2,pw3;
  #define PKW(P,B) cvtpk_s(P[B],P[B+1])
  #define PAF(k) __builtin_bit_cast(bf16x8,pw##k)
  #define VFR(i) (bf16x8){vlo[i][0],vlo[i][1],vlo[i][2],vlo[i][3],vhi[i][0],vhi[i][1],vhi[i][2],vhi[i][3]}
  #define PIN(x) asm volatile("":"+v"(x))
  #define MX3(a,b,c) __builtin_fmaxf(__builtin_fmaxf((a),(b)),(c))
  #define GAPA(MF,A0,A1,A2,A3,W0,W1,PW) do{ MF; sacc+=A0; sacc+=A1; sacc+=A2; sacc+=A3; PIN(sacc); W0; W1; PIN(PW); SBAR(); }while(0)
  #define EX(v) __builtin_amdgcn_exp2f(v)
  #define GAPB(MF,X,B) do{ MF; X[B]=EX(X[B]); X[B+1]=EX(X[B+1]); X[B+2]=EX(X[B+2]); X[B+3]=EX(X[B+3]); PIN(X); SBAR(); }while(0)
  #define VRD(i) do{ vlo[i]=vtr(vp_+(((i)>>2)*4096+((i)&3)*1024)); vhi[i]=vtr(vp_+(((i)>>2)*4096+((i)&3)*1024+512)); }while(0)
  #define KRD(G,j) do{ if(G){ kload2(kf,kp0+sl_next,j); SBAR(); } }while(0)
  #define STEP(C0,C1,P0,P1,t,GK,GV,GL) do{ SBAR(); \
    const lds_cptr vp_=vp0+sl_prev; const u32x2_t e0_=*(const u32x2_t*)(KBt+kb_o0+(unsigned)(t)*kb_str),e1_=*(const u32x2_t*)(KBt+kb_o1+(unsigned)(t)*kb_str); \
    VRD(0); SBAR(); float sacc=(P0[0]+P0[1]); \
    GAPA(C0=__builtin_amdgcn_mfma_f32_32x32x16_bf16(kf[0],qr[0],negm,0,0,0), P0[2],P0[3],P0[4],P0[5],     pw0[0]=PKW(P0,0), pw0[1]=PKW(P0,2), pw0); \
    VRD(4); SBAR(); GAPA(C1=__builtin_amdgcn_mfma_f32_32x32x16_bf16(kf[1],qr[0],negm,0,0,0), P0[6],P0[7],P0[8],P0[9],     pw0[2]=PKW(P0,4), pw0[3]=PKW(P0,6), pw0); \
    VRD(1); SBAR(); GAPA(C0=__builtin_amdgcn_mfma_f32_32x32x16_bf16(kf[2],qr[1],C0,0,0,0),   P0[10],P0[11],P0[12],P0[13], pw1[0]=PKW(P0,8), pw1[1]=PKW(P0,10), pw1); \
    VRD(5); SBAR(); GAPA(C1=__builtin_amdgcn_mfma_f32_32x32x16_bf16(kf[3],qr[1],C1,0,0,0),   P0[14],P0[15],P1[0],P1[1],   pw1[2]=PKW(P0,12),pw1[3]=PKW(P0,14), pw1); \
    VRD(2); SBAR(); GAPA(C0=__builtin_amdgcn_mfma_f32_32x32x16_bf16(kf[4],qr[2],C0,0,0,0),   P1[2],P1[3],P1[4],P1[5],     pw2[0]=PKW(P1,0), pw2[1]=PKW(P1,2), pw2); \
    VRD(6); SBAR(); GAPA(C1=__builtin_amdgcn_mfma_f32_32x32x16_bf16(kf[5],qr[2],C1,0,0,0),   P1[6],P1[7],P1[8],P1[9],     pw2[2]=PKW(P1,4), pw2[3]=PKW(P1,6), pw2); \
    VRD(3); SBAR(); GAPA(C0=__builtin_amdgcn_mfma_f32_32x32x16_bf16(kf[6],qr[3],C0,0,0,0),   P1[10],P1[11],P1[12],P1[13], pw3[0]=PKW(P1,8), pw3[1]=PKW(P1,10), pw3); \
    VRD(7); SBAR(); GAPA(C1=__builtin_amdgcn_mfma_f32_32x32x16_bf16(kf[7],qr[3],C1,0,0,0),   P1[14],P1[15],0.f,0.f,       pw3[2]=PKW(P1,12),pw3[3]=PKW(P1,14), pw3); \
    { const bf16x8 kb0_=mkfrag(e0_,zc),kb1_=mkfrag(e1_,zc); C0=__builtin_amdgcn_mfma_f32_32x32x16_bf16(kb0_,qx,C0,0,0,0); C1=__builtin_amdgcn_mfma_f32_32x32x16_bf16(kb1_,qx,C1,0,0,0); } SBAR(); \
    l_reg+=sacc; \
    if(GK){DMA_K((t)+3,sl_cur);} if(GV){DMA_V((t)+1,sl_next);} \
    CMASK(C0,C1,t); \
    { float a=MX3(C0[0],C0[1],C1[0]),b=MX3(C0[2],C0[3],C1[1]); a=MX3(a,C1[2],C1[3]); \
      _Pragma("unroll") for(int r=4;r<16;r+=4){a=MX3(a,C0[r],C0[r+1]);b=MX3(b,C0[r+2],C0[r+3]);a=MX3(a,C1[r],C1[r+1]);b=MX3(b,C1[r+2],C1[r+3]);} \
      float rm=__builtin_fmaxf(a,b); { auto rr=__builtin_amdgcn_permlane32_swap(__float_as_uint(rm),__float_as_uint(rm),false,false); rm=__builtin_fmaxf(__uint_as_float(rr[0]),__uint_as_float(rr[1])); } \
      resc=false; \
      if(__builtin_expect(__any(rm>(float)THRL),0)){ const float dl=__builtin_fmaxf(rm,0.f); mhat+=dl; \
        _Pragma("unroll") for(int r=0;r<16;++r){C0[r]-=dl;C1[r]-=dl;} \
        qx=qref_frag(-mhat,hi); \
        const float f=__builtin_amdgcn_exp2f(-dl); l_reg*=f; if(hi==0)wsf[r32]=f; resc=true; } } \
    SBAR(); \
    GAPB(o[0]=__builtin_amdgcn_mfma_f32_32x32x16_bf16(PAF(0),VFR(0),o[0],0,0,0), C0,0); \
    GAPB(o[1]=__builtin_amdgcn_mfma_f32_32x32x16_bf16(PAF(0),VFR(4),o[1],0,0,0), C0,4); \
    KRD(GL,0); GAPB(o[0]=__builtin_amdgcn_mfma_f32_32x32x16_bf16(PAF(1),VFR(1),o[0],0,0,0), C0,8); \
    KRD(GL,1); GAPB(o[1]=__builtin_amdgcn_mfma_f32_32x32x16_bf16(PAF(1),VFR(5),o[1],0,0,0), C0,12); \
    KRD(GL,2); GAPB(o[0]=__builtin_amdgcn_mfma_f32_32x32x16_bf16(PAF(2),VFR(2),o[0],0,0,0), C1,0); \
    KRD(GL,3); GAPB(o[1]=__builtin_amdgcn_mfma_f32_32x32x16_bf16(PAF(2),VFR(6),o[1],0,0,0), C1,4); \
    GAPB(o[0]=__builtin_amdgcn_mfma_f32_32x32x16_bf16(PAF(3),VFR(3),o[0],0,0,0), C1,8); \
    GAPB(o[1]=__builtin_amdgcn_mfma_f32_32x32x16_bf16(PAF(3),VFR(7),o[1],0,0,0), C1,12); \
    }while(0)
  int t=1;
  #undef CMASK
  #define CMASK(P0,P1,t) do{}while(0)
  for(;t+5<NT;t+=2){
    STEP(pB0,pB1,pA0,pA1,t,true,true,true);     WAIT_BAR(2); RESC(); ROT();
    STEP(pA0,pA1,pB0,pB1,t+1,true,true,true);   WAIT_BAR(2); RESC(); ROT();
  }
  #undef CMASK
  #define CMASK(P0,P1,t) do{int jb_=(t)-(NT-4); if(jb_>=0)cmask(P0,P1,jb_,qrel,hi);}while(0)
  #define ENDW(tt) do{ if((tt)+3<NT){WAIT_BAR(2);} else if((tt)+2<NT){WAIT_BAR(1);} else {WAIT_BAR(0);} }while(0)
  for(;t+1<NT;t+=2){
    STEP(pB0,pB1,pA0,pA1,t,(t+3<NT),(t+1<NT),(t+1<NT));       ENDW(t);   RESC(); ROT();
    STEP(pA0,pA1,pB0,pB1,t+1,(t+4<NT),(t+2<NT),(t+2<NT));     ENDW(t+1); RESC(); ROT();
  }
  STEP(pB0,pB1,pA0,pA1,NT-1,false,false,false); RESC();
  { float sacc=pB0[0]+pB0[1]; _Pragma("unroll") for(int r=2;r<16;++r)sacc+=pB0[r]; _Pragma("unroll") for(int r=0;r<16;++r)sacc+=pB1[r]; l_reg+=sacc;
    pw0=(u32x4){PKW(pB0,0),PKW(pB0,2),PKW(pB0,4),PKW(pB0,6)};pw1=(u32x4){PKW(pB0,8),PKW(pB0,10),PKW(pB0,12),PKW(pB0,14)};pw2=(u32x4){PKW(pB1,0),PKW(pB1,2),PKW(pB1,4),PKW(pB1,6)};pw3=(u32x4){PKW(pB1,8),PKW(pB1,10),PKW(pB1,12),PKW(pB1,14)};
    SBAR(); pv(o,vb0+sl_cur,PAF(0),PAF(1),PAF(2),PAF(3)); }
  #undef PKW
  #undef PAF
  #undef VFR
  #undef PIN
  #undef MX3
  #undef GAPA
  #undef GAPB
  #undef EX
  #undef VRD
  #undef KRD
  #undef STEP
  #undef ENDW
  {auto rr=__builtin_amdgcn_permlane32_swap(__float_as_uint(l_reg),__float_as_uint(l_reg),false,false);l_reg=__uint_as_float(rr[0])+__uint_as_float(rr[1]);}
  if(hi==0)wsf[32+r32]=l_reg;asm volatile("s_waitcnt lgkmcnt(0)":::"memory");
  float rli[16];
  #pragma unroll
  for(int r=0;r<16;++r)rli[r]=__builtin_amdgcn_rcpf(wsf[32+crow(r,hi)]);
  bf16*Ow=O+(rowbase+q0+wid*QBLK)*OPITCH+h*D;
  { bf16*stg=(bf16*)(shm+LDS_OST)+wid*2048;
    #pragma unroll
    for(int r=0;r<16;++r){const int orow=crow(r,hi);
      #pragma unroll
      for(int d0=0;d0<2;++d0)stg[orow*64+d0*32+r32]=__float2bfloat16(o[d0][r]*rli[r]);}
    asm volatile("s_waitcnt lgkmcnt(0)":::"memory");
    #pragma unroll
    for(int i=0;i<4;++i){const int row=i*8+(lane>>3),ch=lane&7; const u32x4 v=*(const u32x4*)(stg+row*64+ch*8); ATTN_STORE16(Ow+(long)row*OPITCH+ch*8,v);} }
  asm volatile("s_waitcnt lgkmcnt(0)\n\ts_barrier":::"memory");
  #undef DMA_K
  #undef DMA_V
  #undef CMASK
  #undef START
  #undef RESC
  #undef ROT
}
constexpr int ATTN_LDS_BYTES=LDS_BYTES;
struct AttnTensors { const bf16* Q; const bf16* K; const bf16* V; bf16* O; const float* LF; };
struct AttnUnit { int bh; int qb; };
struct StaticOrder {
  int vcu,grid;
  __device__ __forceinline__ explicit StaticOrder(int grid_,int block):vcu((grid_%8==0)?(block%8)*(grid_/8)+block/8:block),grid(grid_){}
  __device__ __forceinline__ bool next(int i,AttnUnit&u)const{
    if(grid==256){ if(i>=4)return false; const int s=vcu&3; u.bh=vcu>>2; u.qb=(i==0)?s:(i==1)?7-s:(i==2)?8+s:15-s; return true; }
    const int L=i*grid+vcu; if(L>=BATCH*NHEAD*NQB)return false; u.bh=L/NQB; u.qb=L%NQB; return true; }
  __device__ __forceinline__ void a_ready(const AttnUnit&)const{}
  __device__ __forceinline__ void done(const AttnUnit&)const{}
};
template<class Sched,int THRL=8> __device__ __forceinline__ void attn_phase(char*lds,const AttnTensors&T,const Sched&S){
  AttnUnit u; int cur_bh=-1;
  for(int i=0;S.next(i,u);++i){ S.a_ready(u); if(u.bh!=cur_bh){ fox_bias_table(u.bh/NHEAD,u.bh%NHEAD,T.LF,lds); cur_bh=u.bh; }
    attn_unit<THRL>(u.bh/NHEAD,u.bh%NHEAD,u.qb,T.Q,T.K,T.V,T.O,T.LF,lds); S.done(u); }
}
#undef SBAR
#undef WAIT_BAR
}
namespace fx {
using namespace nv;
typedef unsigned short bf16;
typedef unsigned v4u __attribute__((ext_vector_type(4)));
typedef float f32x4 __attribute__((ext_vector_type(4)));
constexpr float C2 = 0.125f * 1.4426950408889634f;
constexpr int NIN = 3328;
constexpr int QKVP = 3072;
constexpr int P_FQ = 0, P_FK = 512, P_FV = 1024, P_GQ = 1536, P_GK = 1792, P_GV = 2048, P_GR = 2560;
__device__ __forceinline__ int inproj_src(int d) {
    if (d < 1536) return d;
    if (d < 1792) return O_GQ + (d - 1536);
    if (d < 2048) return O_GK + (d - 1792);
    if (d < 2560) return O_GV + (d - 2048);
    if (d < 3072) return O_GR + (d - 2560);
    if (d < 3080) return O_FF + (d - 3072);
    if (d < 3096) return O_GA + (d - 3080);
    return -1;
}
__device__ __forceinline__ unsigned f2bf(float f) { unsigned u = __builtin_bit_cast(unsigned, f); return (u + 0x7fffu + ((u >> 16) & 1u)) >> 16; }
__device__ __forceinline__ unsigned pk2(float lo, float hi) { return f2bf(lo) | (f2bf(hi) << 16); }
__device__ __forceinline__ float bf2f(unsigned short h) { return __builtin_bit_cast(float, (unsigned)h << 16); }
__device__ __forceinline__ float wave_sum(float v) {
#pragma unroll
    for (int o = 1; o < 64; o <<= 1) v += __shfl_xor(v, o);
    return v;
}
#define FX_LDS_WAIT() asm volatile("s_waitcnt lgkmcnt(0)" ::: "memory")

template <class Map> __device__ __forceinline__ void transpose_item(const float* __restrict__ W, int K, int N, bf16* WT, LAS float* scr, int kb, int nb, int lane, Map srcmap) {
    const int k0 = 64 * kb, n0 = 32 * nb;
    const int src = srcmap(n0 + (lane & 31));
#pragma unroll 8
    for (int i = 0; i < 32; ++i) { const int kk = 2 * i + (lane >> 5); scr[kk * 33 + (lane & 31)] = (src >= 0) ? W[(size_t)(k0 + kk) * N + src] : 0.f; }
    FX_LDS_WAIT(); asm volatile("" ::: "memory");
    const int c = lane & 7;
#pragma unroll
    for (int j = 0; j < 4; ++j) { const int n = (lane >> 3) + 8 * j; const LAS float* s = scr + (8 * c) * 33 + n;
        v4u o; o.x = pk2(s[0 * 33], s[1 * 33]); o.y = pk2(s[2 * 33], s[3 * 33]); o.z = pk2(s[4 * 33], s[5 * 33]); o.w = pk2(s[6 * 33], s[7 * 33]);
        *(GAS v4u*)(WT + (size_t)(n0 + n) * K + k0 + 8 * c) = o; }
    FX_LDS_WAIT(); asm volatile("" ::: "memory");
}

__device__ __forceinline__ void ln_row_bf16(const float* xrow, const float* __restrict__ g, const float* __restrict__ b, bf16* orow, float* frow, float* st, int lane) {
    const GAS f32x4* xr = (const GAS f32x4*)xrow + lane;
    f32x4 v[4]; float s = 0.f;
#pragma unroll
    for (int j = 0; j < 4; ++j) { v[j] = xr[64 * j]; s += (v[j].x + v[j].y) + (v[j].z + v[j].w); }
    const float mean = wave_sum(s) * (1.f / D); float s2 = 0.f;
#pragma unroll
    for (int j = 0; j < 4; ++j) { v[j] = v[j] - mean; s2 += (v[j].x * v[j].x + v[j].y * v[j].y) + (v[j].z * v[j].z + v[j].w * v[j].w); }
    const float rstd = 1.f / sqrtf(wave_sum(s2) * (1.f / D) + LN_EPS);
    if (st && lane == 0) { st[0] = mean; st[1] = rstd; }
    GAS unsigned long long* o8 = (GAS unsigned long long*)orow + lane;
#pragma unroll
    for (int j = 0; j < 4; ++j) {
        const f32x4 gg = ((const f32x4*)g)[lane + 64 * j], bb = ((const f32x4*)b)[lane + 64 * j];
        const f32x4 o = v[j] * rstd * gg + bb;
        o8[64 * j] = (unsigned long long)pk2(o.x, o.y) | ((unsigned long long)pk2(o.z, o.w) << 32);
        if (frow) ((GAS f32x4*)frow)[lane + 64 * j] = o;
    }
}

struct CvItem { const float* W; bf16* WT; int N, K, k0, n0, s0; };
__device__ __forceinline__ void cv_load(const CvItem& it, f32x4 (&v)[8], int lane) {
    const float* p = it.W + (size_t)(it.k0 + (lane >> 3)) * it.N + it.s0 + 4 * (lane & 7);
#pragma unroll
    for (int i = 0; i < 8; ++i) v[i] = __builtin_nontemporal_load((const f32x4*)(p + (size_t)(8 * i) * it.N));
}
__device__ __forceinline__ void cv_finish(const CvItem& it, const f32x4 (&v)[8], LAS float* scr, int lane) {
    const int rr = lane >> 3, cq = lane & 7;
#pragma unroll
    for (int i = 0; i < 8; ++i) { LAS float* d = scr + (8 * i + rr) * 33 + 4 * cq; d[0] = v[i][0]; d[1] = v[i][1]; d[2] = v[i][2]; d[3] = v[i][3]; }
    FX_LDS_WAIT(); asm volatile("" ::: "memory");
    const int c = lane & 7;
#pragma unroll
    for (int j = 0; j < 4; ++j) { const int n = (lane >> 3) + 8 * j; const LAS float* s = scr + (8 * c) * 33 + n;
        v4u o; o.x = pk2(s[0 * 33], s[1 * 33]); o.y = pk2(s[2 * 33], s[3 * 33]); o.z = pk2(s[4 * 33], s[5 * 33]); o.w = pk2(s[6 * 33], s[7 * 33]);
        *(GAS v4u*)(it.WT + (size_t)(it.n0 + n) * it.K + it.k0 + 8 * c) = o; }
    FX_LDS_WAIT(); asm volatile("" ::: "memory");
}

template <int NR> __device__ __forceinline__ void ln_rows_bf16(const float* xrows, const float* __restrict__ g, const float* __restrict__ b, bf16* orows, int lane) {
    f32x4 v[NR][4];
#pragma unroll
    for (int r = 0; r < NR; ++r)
#pragma unroll
        for (int j = 0; j < 4; ++j) v[r][j] = ((const GAS f32x4*)(xrows + (size_t)r * D))[lane + 64 * j];
    f32x4 gg[4], bb[4];
#pragma unroll
    for (int j = 0; j < 4; ++j) { gg[j] = ((const f32x4*)g)[lane + 64 * j]; bb[j] = ((const f32x4*)b)[lane + 64 * j]; }
#pragma unroll
    for (int r = 0; r < NR; ++r) {
        float s = 0.f;
#pragma unroll
        for (int j = 0; j < 4; ++j) s += (v[r][j].x + v[r][j].y) + (v[r][j].z + v[r][j].w);
        const float mean = wave_sum(s) * (1.f / D); float s2 = 0.f;
#pragma unroll
        for (int j = 0; j < 4; ++j) { v[r][j] = v[r][j] - mean; s2 += (v[r][j].x * v[r][j].x + v[r][j].y * v[r][j].y) + (v[r][j].z * v[r][j].z + v[r][j].w * v[r][j].w); }
        const float rstd = 1.f / sqrtf(wave_sum(s2) * (1.f / D) + LN_EPS);
        GAS unsigned long long* o8 = (GAS unsigned long long*)(orows + (size_t)r * D) + lane;
#pragma unroll
        for (int j = 0; j < 4; ++j) { const f32x4 o = v[r][j] * rstd * gg[j] + bb[j];
            o8[64 * j] = (unsigned long long)pk2(o.x, o.y) | ((unsigned long long)pk2(o.z, o.w) << 32); }
    }
}
}

namespace pg8 {
struct EpiInProj {
    static constexpr bool PERM = true, AFTER_DRAIN = false;
    bf16_t* QKV; float* FG; float* LF; const float* bfg;
    __device__ __forceinline__ void operator()(const f32x4 (&acc)[2][2][4][2], const Unit& u, int wr, int wc, int fr, int fq) const {
        const int row0 = u.pm * BM + wr * 64 + fr;
        if (u.pn < 12) {
            const float sc = (u.pn < 2) ? fx::C2 : 1.f;
            const int col0 = u.pn * BM + wc * 32 + 8 * fq;
#pragma unroll
            for (int ai = 0; ai < 2; ++ai)
#pragma unroll
                for (int m = 0; m < 4; ++m) { bf16_t* rowp = QKV + (size_t)(row0 + ai * HALF + m * 16) * fx::QKVP + col0;
#pragma unroll
                    for (int bj = 0; bj < 2; ++bj) { const f32x4 v0 = acc[ai][bj][m][0] * sc, v1 = acc[ai][bj][m][1] * sc;
                        u32x4 w; w.x = cvt_pk_bf16(v0[0], v0[1]); w.y = cvt_pk_bf16(v0[2], v0[3]); w.z = cvt_pk_bf16(v1[0], v1[1]); w.w = cvt_pk_bf16(v1[2], v1[3]);
                        *(u32x4*)(rowp + bj * HALF) = w; } }
        } else if (wc == 0 && fq < 3) {
#pragma unroll
            for (int ai = 0; ai < 2; ++ai)
#pragma unroll
                for (int m = 0; m < 4; ++m) { const int row = row0 + ai * HALF + m * 16; float* p = FG + (size_t)row * 32 + 8 * fq;
                    *(f32x4*)p = acc[ai][0][m][0]; *(f32x4*)(p + 4) = acc[ai][0][m][1];
                    if (fq == 0) { const int b = row >> 12, s = row & 4095;
#pragma unroll
                        for (int n = 0; n < 2; ++n)
#pragma unroll
                            for (int i = 0; i < 4; ++i) { const int h = 4 * n + i; LF[(size_t)(b * 8 + h) * nv::S + s] = 1.4426950408889634f * nv::logsigmoidf(acc[ai][0][m][n][i] + bfg[h]); } } }
        }
    }
};
}
namespace gl {
using namespace nv;
typedef unsigned short bf16;
typedef short bf16x8 __attribute__((ext_vector_type(8)));
typedef float f32x4 __attribute__((ext_vector_type(4)));
typedef unsigned u32x4 __attribute__((ext_vector_type(4)));
typedef unsigned u32x2 __attribute__((ext_vector_type(2)));
constexpr int NCH = S / 64;
constexpr int NUNIT = B * GH * NCH;
constexpr int LS = 72;
constexpr int L_WGU = 0, L_BG = 4096, L_QP = 8192, L_KP = L_QP + 64 * LS * 2, L_KPT = L_KP + 64 * LS * 2, L_VT = L_KPT + 64 * LS * 2, L_PP = L_VT + 128 * LS * 2, L_WT = L_PP + 64 * LS * 2, L_END = L_WT + 2048;
static_assert(L_END <= 131072, "gla prep LDS");
constexpr int C_ST = 0, C_PART = 128 * LS * 2, C_END = C_PART + 2 * 8 * 64 * 4;
constexpr size_t QPG_B = 64 * 64 * 2, OI_B = 8 * 4 * 64 * 16, UU_B = OI_B, DEC_B = 256;

__device__ __forceinline__ unsigned pkbf(float lo, float hi) { typedef float f2 __attribute__((ext_vector_type(2))); typedef __bf16 b2 __attribute__((ext_vector_type(2))); f2 v = {lo, hi}; b2 r = __builtin_convertvector(v, b2); return __builtin_bit_cast(unsigned, r); }
__device__ __forceinline__ float bf2f(unsigned short h) { return __builtin_bit_cast(float, (unsigned)h << 16); }
__device__ __forceinline__ float bflo(unsigned w) { return __builtin_bit_cast(float, w << 16); }
__device__ __forceinline__ float bfhi(unsigned w) { return __builtin_bit_cast(float, w & 0xffff0000u); }
__device__ __forceinline__ float fast_logsig2(float x) { return -__builtin_amdgcn_logf(1.f + __builtin_amdgcn_exp2f(-1.4426950408889634f * x)); }

__device__ __forceinline__ void prep_unit(int unit, const bf16* QKV, const float* FG, const float* __restrict__ wgu, const float* __restrict__ bgate,
                                          unsigned char* QPG, unsigned char* OI, unsigned char* UU, float* DEC, unsigned char* lds, int& cur_h) {
    int tid_ = threadIdx.x; asm volatile("" : "+v"(tid_));
    const int tid = tid_, lane = tid & 63, wid = __builtin_amdgcn_readfirstlane(tid >> 6), l15 = lane & 15, g = lane >> 4;
    const int n = unit % NCH, bh = unit / NCH, h = bh % GH, b = bh / GH;
    const size_t row0 = (size_t)b * S + (size_t)n * 64;
    float* WGU = (float*)(lds + L_WGU); float* BG = (float*)(lds + L_BG); float* WT = (float*)(lds + L_WT);
    bf16* QP = (bf16*)(lds + L_QP); bf16* KP = (bf16*)(lds + L_KP); bf16* KPT = (bf16*)(lds + L_KPT); bf16* VT = (bf16*)(lds + L_VT); bf16* PP = (bf16*)(lds + L_PP);
    if (cur_h != h) { __syncthreads(); for (int i = tid; i < 16 * 64; i += 512) WGU[i] = wgu[(i >> 6) * 256 + h * 64 + (i & 63)]; if (tid < 64) BG[tid] = bgate[h * 64 + tid]; cur_h = h; __syncthreads(); }
    const int t = tid >> 3, oc = tid & 7, d0 = oc * 8;
    float la[8];
    { const float* gp = FG + (row0 + t) * 32 + 8;
      f32x4 ga4[4];
#pragma unroll
      for (int i = 0; i < 4; ++i) ga4[i] = *(const f32x4*)(gp + 4 * i);
#pragma unroll
      for (int j = 0; j < 8; ++j) la[j] = BG[d0 + j];
#pragma unroll
      for (int r = 0; r < 16; ++r) { const float gv = ga4[r >> 2][r & 3]; const f32x4 w0 = *(const f32x4*)(WGU + r * 64 + d0), w1 = *(const f32x4*)(WGU + r * 64 + d0 + 4);
#pragma unroll
          for (int j = 0; j < 4; ++j) { la[j] += gv * w0[j]; la[4 + j] += gv * w1[j]; } }
#pragma unroll
      for (int j = 0; j < 8; ++j) la[j] = fast_logsig2(la[j]) * (1.f / 16.f); }
    const u32x4 qv = *(const u32x4*)(QKV + (row0 + t) * fx::QKVP + fx::P_GQ + h * 64 + d0);
    const u32x4 kv = *(const u32x4*)(QKV + (row0 + t) * fx::QKVP + fx::P_GK + h * 64 + d0);
    const u32x4 vv0 = *(const u32x4*)(QKV + (row0 + t) * fx::QKVP + fx::P_GV + h * 128 + oc * 16);
    const u32x4 vv1 = *(const u32x4*)(QKV + (row0 + t) * fx::QKVP + fx::P_GV + h * 128 + oc * 16 + 8);
#pragma unroll
    for (int off = 8; off < 64; off <<= 1) {
#pragma unroll
        for (int j = 0; j < 8; ++j) { const float o = __shfl_up(la[j], off); if (lane >= off) la[j] += o; } }
    if (lane >= 56) {
#pragma unroll
        for (int j = 0; j < 8; ++j) WT[wid * 64 + d0 + j] = la[j]; }
    __syncthreads();
    float bl[8];
#pragma unroll
    for (int j = 0; j < 8; ++j) bl[j] = 0.f;
#pragma unroll
    for (int w = 0; w < 8; ++w) {
        const f32x4 a0 = *(const f32x4*)(WT + w * 64 + d0), a1 = *(const f32x4*)(WT + w * 64 + d0 + 4);
#pragma unroll
        for (int j = 0; j < 4; ++j) { bl[j] += a0[j]; bl[4 + j] += a1[j]; if (w < wid) { la[j] += a0[j]; la[4 + j] += a1[j]; } } }
    {
        const unsigned qw[4] = {qv.x, qv.y, qv.z, qv.w}, kw[4] = {kv.x, kv.y, kv.z, kv.w};
        float qf[8], kf[8];
#pragma unroll
        for (int i = 0; i < 4; ++i) { qf[2 * i] = bflo(qw[i]); qf[2 * i + 1] = bfhi(qw[i]); kf[2 * i] = bflo(kw[i]); kf[2 * i + 1] = bfhi(kw[i]); }
        float qp[8], kp[8], kpp[8];
#pragma unroll
        for (int j = 0; j < 8; ++j) { const float bb = la[j], bbl = bl[j];
            qp[j] = qf[j] * (0.125f * __builtin_amdgcn_exp2f(bb)); kp[j] = kf[j] * __builtin_amdgcn_exp2f(-bb); kpp[j] = kf[j] * __builtin_amdgcn_exp2f(bbl - bb); }
        u32x4 qo, ko; qo.x = pkbf(qp[0], qp[1]); qo.y = pkbf(qp[2], qp[3]); qo.z = pkbf(qp[4], qp[5]); qo.w = pkbf(qp[6], qp[7]);
        ko.x = pkbf(kp[0], kp[1]); ko.y = pkbf(kp[2], kp[3]); ko.z = pkbf(kp[4], kp[5]); ko.w = pkbf(kp[6], kp[7]);
        *(u32x4*)(QP + t * LS + d0) = qo; *(u32x4*)(KP + t * LS + d0) = ko;
        *(u32x4*)(QPG + (size_t)unit * QPG_B + (size_t)(t * 64 + d0) * 2) = qo;
#pragma unroll
        for (int j = 0; j < 8; ++j) KPT[(d0 + j) * LS + t] = (bf16)(pkbf(kpp[j], 0.f) & 0xffffu);
        const unsigned vw[8] = {vv0.x, vv0.y, vv0.z, vv0.w, vv1.x, vv1.y, vv1.z, vv1.w};
#pragma unroll
        for (int i = 0; i < 8; ++i) { VT[(oc * 16 + 2 * i) * LS + t] = (bf16)(vw[i] & 0xffffu); VT[(oc * 16 + 2 * i + 1) * LS + t] = (bf16)(vw[i] >> 16); }
        if (t == 0) {
#pragma unroll
            for (int j = 0; j < 8; ++j) DEC[(size_t)unit * 64 + d0 + j] = __builtin_amdgcn_exp2f(bl[j]); }
    }
    __syncthreads();
    { const int ti = wid >> 1;
#pragma unroll
      for (int q2 = 0; q2 < 2; ++q2) { const int sj = 2 * (wid & 1) + q2;
          f32x4 acc = {0.f, 0.f, 0.f, 0.f};
          if (sj <= ti) {
#pragma unroll
              for (int ks = 0; ks < 2; ++ks) { const bf16x8 a = *(const bf16x8*)(QP + (16 * ti + l15) * LS + 32 * ks + 8 * g), bb = *(const bf16x8*)(KP + (16 * sj + l15) * LS + 32 * ks + 8 * g);
                  acc = __builtin_amdgcn_mfma_f32_16x16x32_bf16(a, bb, acc, 0, 0, 0); }
              if (sj == ti) {
#pragma unroll
                  for (int r = 0; r < 4; ++r) if (l15 > 4 * g + r) acc[r] = 0.f; }
          }
#pragma unroll
          for (int r = 0; r < 4; ++r) PP[(16 * ti + 4 * g + r) * LS + 16 * sj + l15] = (bf16)(pkbf(acc[r], 0.f) & 0xffffu);
      } }
    __syncthreads();
    { bf16x8 vb[2];
#pragma unroll
      for (int ks = 0; ks < 2; ++ks) vb[ks] = *(const bf16x8*)(VT + (16 * wid + l15) * LS + 32 * ks + 8 * g);
#pragma unroll
      for (int m = 0; m < 4; ++m) { f32x4 acc = {0.f, 0.f, 0.f, 0.f};
#pragma unroll
          for (int ks = 0; ks < 2; ++ks) { const bf16x8 a = *(const bf16x8*)(PP + (16 * m + l15) * LS + 32 * ks + 8 * g); acc = __builtin_amdgcn_mfma_f32_16x16x32_bf16(a, vb[ks], acc, 0, 0, 0); }
          *(f32x4*)(OI + (size_t)unit * OI_B + (size_t)((wid * 4 + m) * 64 + lane) * 16) = acc; }
#pragma unroll
      for (int db = 0; db < 4; ++db) { f32x4 acc = {0.f, 0.f, 0.f, 0.f};
#pragma unroll
          for (int ks = 0; ks < 2; ++ks) { const bf16x8 a = *(const bf16x8*)(KPT + (16 * db + l15) * LS + 32 * ks + 8 * g); acc = __builtin_amdgcn_mfma_f32_16x16x32_bf16(a, vb[ks], acc, 0, 0, 0); }
          *(f32x4*)(UU + (size_t)unit * UU_B + (size_t)((wid * 4 + db) * 64 + lane) * 16) = acc; }
    }
}

constexpr size_t STG_B = 128 * 64 * 2;
__device__ __forceinline__ void scan_wave(int gwave, const unsigned char* UU, const float* DEC, unsigned char* STG, int lane) {
    const int bh = gwave >> 5, w = (gwave >> 2) & 7, db = gwave & 3, l15 = lane & 15, g = lane >> 4;
    f32x4 Sv = {0.f, 0.f, 0.f, 0.f};
    const size_t u0 = (size_t)bh * NCH;
    for (int n0 = 0; n0 < NCH; n0 += 8) {
        f32x4 Uf[8], dv[8];
#pragma unroll
        for (int j = 0; j < 8; ++j) { const size_t unit = u0 + n0 + j;
            Uf[j] = *(const f32x4*)(UU + unit * UU_B + (size_t)((w * 4 + db) * 64 + lane) * 16);
            dv[j] = *(const f32x4*)(DEC + unit * 64 + 16 * db + 4 * g); }
#pragma unroll
        for (int j = 0; j < 8; ++j) { const size_t unit = u0 + n0 + j;
            *(u32x2*)(STG + unit * STG_B + (size_t)((16 * w + l15) * 64 + 16 * db + 4 * g) * 2) = (u32x2){pkbf(Sv[0], Sv[1]), pkbf(Sv[2], Sv[3])};
            Sv = dv[j] * Sv + Uf[j]; }
    }
}

constexpr int GS = 136;
constexpr int PO_GR = 0, PO_YT = 64 * GS * 2, PO_PART = 2 * 64 * GS * 2, PO_END = PO_PART + 8 * 64 * 4;
__device__ __forceinline__ void post_unit(int unit, const bf16* QKV, const unsigned char* QPG, const unsigned char* OI, const unsigned char* STG, const float* __restrict__ gnorm, bf16* Y, unsigned char* lds) {
    int tid_ = threadIdx.x; asm volatile("" : "+v"(tid_));
    const int tid = tid_, lane = tid & 63, wid = __builtin_amdgcn_readfirstlane(tid >> 6), l15 = lane & 15, g = lane >> 4;
    const int n = unit % NCH, bh = unit / NCH, h = bh % GH, b = bh / GH;
    const size_t row0 = (size_t)b * S + (size_t)n * 64;
    bf16* GRs = (bf16*)(lds + PO_GR); bf16* YT = (bf16*)(lds + PO_YT); float* PART = (float*)(lds + PO_PART);
    const int t = tid >> 3, oc = tid & 7, e = 16 * wid + l15;
    const u32x4 g0 = *(const u32x4*)(QKV + (row0 + t) * fx::QKVP + fx::P_GR + h * 128 + oc * 16), g1 = *(const u32x4*)(QKV + (row0 + t) * fx::QKVP + fx::P_GR + h * 128 + oc * 16 + 8);
    f32x4 o[4]; bf16x8 qa[4][2], sb[2];
#pragma unroll
    for (int m = 0; m < 4; ++m) { o[m] = *(const f32x4*)(OI + (size_t)unit * OI_B + (size_t)((wid * 4 + m) * 64 + lane) * 16);
#pragma unroll
        for (int ks = 0; ks < 2; ++ks) qa[m][ks] = *(const bf16x8*)(QPG + (size_t)unit * QPG_B + (size_t)((16 * m + l15) * 64 + 32 * ks + 8 * g) * 2); }
#pragma unroll
    for (int ks = 0; ks < 2; ++ks) sb[ks] = *(const bf16x8*)(STG + (size_t)unit * STG_B + (size_t)(e * 64 + 32 * ks + 8 * g) * 2);
    const float gn = gnorm[e];
    *(u32x4*)(GRs + t * GS + oc * 16) = g0; *(u32x4*)(GRs + t * GS + oc * 16 + 8) = g1;
#pragma unroll
    for (int m = 0; m < 4; ++m)
#pragma unroll
        for (int ks = 0; ks < 2; ++ks) o[m] = __builtin_amdgcn_mfma_f32_16x16x32_bf16(qa[m][ks], sb[ks], o[m], 0, 0, 0);
#pragma unroll
    for (int m = 0; m < 4; ++m) { f32x4 q = o[m] * o[m];
#pragma unroll
        for (int off = 1; off < 16; off <<= 1) { q[0] += __shfl_xor(q[0], off); q[1] += __shfl_xor(q[1], off); q[2] += __shfl_xor(q[2], off); q[3] += __shfl_xor(q[3], off); }
        if (l15 == 0) *(f32x4*)(PART + wid * 64 + 16 * m + 4 * g) = q; }
    __syncthreads();
#pragma unroll
    for (int m = 0; m < 4; ++m) { f32x4 tot = {0.f, 0.f, 0.f, 0.f};
#pragma unroll
        for (int w = 0; w < 8; ++w) tot += *(const f32x4*)(PART + w * 64 + 16 * m + 4 * g);
#pragma unroll
        for (int r = 0; r < 4; ++r) { const int tt = 16 * m + 4 * g + r; const float rs = rsqrtf(tot[r] * (1.f / GV) + LN_EPS); const float gr = bf2f(GRs[tt * GS + e]);
            const float v = o[m][r] * rs * gn * (gr / (1.f + __expf(-gr)));
            YT[tt * GS + e] = (bf16)(pkbf(v, 0.f) & 0xffffu); } }
    __syncthreads();
    { const u32x4 y0 = *(const u32x4*)(YT + t * GS + oc * 16), y1 = *(const u32x4*)(YT + t * GS + oc * 16 + 8);
      *(u32x4*)(Y + (row0 + t) * D + 512 + h * GV + oc * 16) = y0; *(u32x4*)(Y + (row0 + t) * D + 512 + h * GV + oc * 16 + 8) = y1; }
    __syncthreads();
}
}
namespace mo {
using namespace nv;
typedef unsigned short bf16;
typedef float f32x4 __attribute__((ext_vector_type(4)));
typedef unsigned u32x4 __attribute__((ext_vector_type(4)));
constexpr int CAP = 8192;
constexpr int NEX = NE + 1;
constexpr int YSH = T * TOPK;
constexpr int L_TB = 132096, L_YB = L_TB + 1040, L_CN = L_YB + 1040;
typedef LAS int* lint;

__device__ __forceinline__ void moe_tables(const int* counts, lint tb, lint yb, lint cn, int lane) {
    int c[4], nt[4]; int st = 0, sy = 0, pt[4], py[4];
#pragma unroll
    for (int i = 0; i < 4; ++i) { c[i] = counts[lane * 4 + i]; c[i] = c[i] > CAP ? CAP : c[i]; nt[i] = (c[i] + 255) >> 8; pt[i] = st; py[i] = sy; st += nt[i]; sy += c[i]; }
    int it = st, iy = sy;
    for (int o = 1; o < 64; o <<= 1) { const int a = __shfl_up(it, o), b = __shfl_up(iy, o); if (lane >= o) { it += a; iy += b; } }
    const int bt = it - st, by = iy - sy;
#pragma unroll
    for (int i = 0; i < 4; ++i) { tb[lane * 4 + i] = bt + pt[i]; yb[lane * 4 + i] = by + py[i]; cn[lane * 4 + i] = c[i]; }
    if (lane == 63) { tb[256] = it; tb[257] = it + T / 256; yb[256] = YSH; cn[256] = T; }
}

__device__ __forceinline__ void route_token2(const float* LG, const float* __restrict__ rbias, int* lcnt, int* TK, float* TW, int t0, int lane) {
    const int l32 = lane & 31, hb = lane & 32, t = t0 + (lane >> 5);
    const float4 la = ((const float4*)(LG + (size_t)t * NE))[2 * l32], lb = ((const float4*)(LG + (size_t)t * NE))[2 * l32 + 1];
    const float4 ra = ((const float4*)rbias)[2 * l32], rb = ((const float4*)rbias)[2 * l32 + 1];
    const float lg[8] = {la.x, la.y, la.z, la.w, lb.x, lb.y, lb.z, lb.w}, rbv[8] = {ra.x, ra.y, ra.z, ra.w, rb.x, rb.y, rb.z, rb.w};
    float sc[8], bv[8];
#pragma unroll
    for (int i = 0; i < 8; ++i) { sc[i] = 1.f / (1.f + expf(-lg[i])); bv[i] = sc[i] + rbv[i]; }
    float m1 = fmaxf(bv[0], bv[1]), m2 = fminf(bv[0], bv[1]);
#pragma unroll
    for (int i = 2; i < 8; ++i) { const float n1 = fmaxf(m1, bv[i]); m2 = fmaxf(fminf(m1, bv[i]), m2); m1 = n1; }
#pragma unroll
    for (int o = 1; o < 4; o <<= 1) { const float p1 = __shfl_xor(m1, o), p2 = __shfl_xor(m2, o); const float n1 = fmaxf(m1, p1); m2 = fmaxf(fminf(m1, p1), fmaxf(m2, p2)); m1 = n1; }
    const float gs = m1 + m2;
    const int myg = l32 >> 2;
    int rank = 0;
#pragma unroll
    for (int g2 = 0; g2 < NG; ++g2) { const float og = __shfl(gs, hb + g2 * 4); if (og > gs || (og == gs && g2 < myg)) ++rank; }
    const bool sel = rank < 4;
    float mv[8];
#pragma unroll
    for (int i = 0; i < 8; ++i) mv[i] = sel ? bv[i] : -INFINITY;
    int mye = 0; float myw = 0.f; float wsum = 0.f;
#pragma unroll
    for (int k = 0; k < TOPK; ++k) {
        float bvv = mv[0]; int bi = 0;
#pragma unroll
        for (int i = 1; i < 8; ++i) if (mv[i] > bvv) { bvv = mv[i]; bi = i; }
        int gi = l32 * 8 + bi;
#pragma unroll
        for (int o = 16; o > 0; o >>= 1) { const float ov = __shfl_xor(bvv, o); const int oi = __shfl_xor(gi, o); if (ov > bvv || (ov == bvv && oi < gi)) { bvv = ov; gi = oi; } }
        const int ol = gi >> 3, oi = gi & 7;
        float s_own = sc[0];
#pragma unroll
        for (int i = 1; i < 8; ++i) s_own = (oi == i) ? sc[i] : s_own;
        const float sw = __shfl(s_own, hb + ol);
        if (l32 == ol) {
#pragma unroll
            for (int i = 0; i < 8; ++i) if (oi == i) mv[i] = -INFINITY; }
        if (l32 == k) { mye = gi; myw = sw; } wsum += sw;
    }
    if (l32 < TOPK) { const int lp = atomicAdd(&lcnt[mye], 1); TK[t * TOPK + l32] = mye | (lp << 9); TW[t * TOPK + l32] = myw * (2.5f / wsum); }
}
__device__ __forceinline__ void route_finish2(const int* lbase, int* list_tok, float* list_gate, int* TK, const float* TW, int t0, int lane) {
    const int l32 = lane & 31, t = t0 + (lane >> 5);
    if (l32 < TOPK) { const int tk = TK[t * TOPK + l32]; const int e = tk & 511, pos = lbase[e] + (tk >> 9);
        if (pos < CAP) { list_tok[e * CAP + pos] = t; list_gate[e * CAP + pos] = TW[t * TOPK + l32]; }
        TK[t * TOPK + l32] = e | (pos << 9); }
}

constexpr float YSC = 16.f;
__device__ __forceinline__ void combine_token(const bf16* H1, const unsigned char* Y, const int* TK, lint yb, const float* __restrict__ g, const float* __restrict__ b, float* out, int t, int lane) {
    typedef float f2 __attribute__((ext_vector_type(2)));
    float v[16], s[16];
    { const u32x4 a = *(const u32x4*)(H1 + (size_t)t * D + 16 * lane), c = *(const u32x4*)(H1 + (size_t)t * D + 16 * lane + 8);
      const unsigned w[8] = {a.x, a.y, a.z, a.w, c.x, c.y, c.z, c.w};
#pragma unroll
      for (int i = 0; i < 8; ++i) { v[2 * i] = ALPHA * __builtin_bit_cast(float, w[i] << 16); v[2 * i + 1] = ALPHA * __builtin_bit_cast(float, w[i] & 0xffff0000u); } }
#pragma unroll
    for (int i = 0; i < 16; ++i) s[i] = 0.f;
    int tk = (lane < TOPK) ? TK[t * TOPK + lane] : 0;
#pragma unroll
    for (int k = 0; k <= TOPK; ++k) {
        size_t yrow;
        if (k < TOPK) { const int x = __shfl(tk, k); yrow = (size_t)(yb[x & 511] + (x >> 9)); } else yrow = (size_t)YSH + t;
        const u32x4 a = *(const u32x4*)(Y + yrow * D + 16 * lane);
        const int w[4] = {(int)a.x, (int)a.y, (int)a.z, (int)a.w};
#pragma unroll
        for (int i = 0; i < 4; ++i) { const f2 lo = __builtin_amdgcn_cvt_pk_f32_fp8(w[i], false), hi = __builtin_amdgcn_cvt_pk_f32_fp8(w[i], true);
            s[4 * i] += lo[0]; s[4 * i + 1] += lo[1]; s[4 * i + 2] += hi[0]; s[4 * i + 3] += hi[1]; }
    }
    float sm = 0.f;
#pragma unroll
    for (int i = 0; i < 16; ++i) { v[i] += s[i] * (1.f / YSC); sm += v[i]; }
    const float mean = fx::wave_sum(sm) * (1.f / D); float q = 0.f;
#pragma unroll
    for (int i = 0; i < 16; ++i) { v[i] -= mean; q += v[i] * v[i]; }
    const float rstd = 1.f / sqrtf(fx::wave_sum(q) * (1.f / D) + LN_EPS);
#pragma unroll
    for (int i = 0; i < 4; ++i) { const f32x4 gg = *(const f32x4*)(g + 16 * lane + 4 * i), bb = *(const f32x4*)(b + 16 * lane + 4 * i);
        f32x4 o; o[0] = v[4 * i] * rstd * gg[0] + bb[0]; o[1] = v[4 * i + 1] * rstd * gg[1] + bb[1]; o[2] = v[4 * i + 2] * rstd * gg[2] + bb[2]; o[3] = v[4 * i + 3] * rstd * gg[3] + bb[3];
        *(f32x4*)(out + (size_t)t * D + 16 * lane + 4 * i) = o; }
}
}

namespace pg8 {
struct RouterSched {
    int rb; const bf16_t* Bt;
    __device__ __forceinline__ bool next(int i, Unit2& u) const { if (i > 0) return false; u.pm = rb; u.pn = 0; u.e = 0; u.cnt = 128; u.jt = 0; return true; }
    __device__ __forceinline__ int arow(const Unit2& u, int r) const { return u.pm * 128 + r; }
    __device__ __forceinline__ size_t aoff(const Unit2&) const { return 0; }
    __device__ __forceinline__ const char* bptr(const Unit2&) const { return (const char*)Bt; }
};
struct EpiLogits {
    static constexpr bool PERM = false, AFTER_DRAIN = false;
    float* LG;
    __device__ __forceinline__ void operator()(const f32x4 (&acc)[2][2][4][2], const Unit2& u, int wr, int wc, int fr, int fq) const {
        const int row0 = u.pm * 128 + wr * 64 + fr, col0 = wc * 32 + 4 * fq;
#pragma unroll
        for (int m = 0; m < 4; ++m) { float* rowp = LG + (size_t)(row0 + m * 16) * nv::NE + col0;
#pragma unroll
            for (int bj = 0; bj < 2; ++bj)
#pragma unroll
                for (int n = 0; n < 2; ++n) *(f32x4*)(rowp + bj * HALF + n * 16) = acc[0][bj][m][n]; }
    }
};
template <int PH> struct MoeSched {
    int G, vcu, nrt; mo::lint tb; mo::lint cn; const int* list_tok; const bf16_t* W;
    static constexpr int NC = PH == 0 ? 2 : 4;
    __device__ __forceinline__ bool next(int i, Unit2& u) const {
        const int L = i * G + vcu; if (L >= nrt * NC) return false;
        const int rt = L / NC, c = L % NC;
        int lo = 0, hi = 256;
        while (lo < hi) { const int mid = (lo + hi + 1) >> 1; if (tb[mid] <= rt) lo = mid; else hi = mid - 1; }
        const int e = lo, jt = rt - tb[e]; const int total = cn[e];
        const int rem = total - 256 * jt;
        u.pm = rt; u.pn = c; u.e = __builtin_amdgcn_readfirstlane(e); u.jt = __builtin_amdgcn_readfirstlane(jt); u.cnt = __builtin_amdgcn_readfirstlane(rem < 256 ? rem : 256); return true;
    }
    __device__ __forceinline__ int arow(const Unit2& u, int r) const {
        if (PH == 1) return u.pm * BM + r;
        if (u.e == 256) return u.jt * BM + r;
        return (r < u.cnt) ? list_tok[u.e * mo::CAP + u.jt * BM + r] : 0;
    }
    __device__ __forceinline__ size_t aoff(const Unit2&) const { return 0; }
    __device__ __forceinline__ const char* bptr(const Unit2& u) const {
        return PH == 0 ? (const char*)(W + ((size_t)u.e * 512 + 256 * u.pn) * 1024) : (const char*)(W + ((size_t)u.e * 1024 + 256 * u.pn) * 256);
    }
};
struct EpiSwiGLU {
    static constexpr bool PERM = true, AFTER_DRAIN = false;
    bf16_t* H; const float* list_gate;
    __device__ __forceinline__ void operator()(const f32x4 (&acc)[2][2][4][2], const Unit2& u, int wr, int wc, int fr, int fq) const {
        const int col0 = u.pn * 128 + wc * 32 + 8 * fq;
#pragma unroll
        for (int ai = 0; ai < 2; ++ai)
#pragma unroll
            for (int m = 0; m < 4; ++m) { const int r = ai * HALF + wr * 64 + m * 16 + fr;
                float gt = 1.f; if (u.e < 256) gt = (r < u.cnt) ? list_gate[u.e * mo::CAP + u.jt * BM + r] : 0.f;
                float hv[8];
#pragma unroll
                for (int n = 0; n < 2; ++n)
#pragma unroll
                    for (int i = 0; i < 4; ++i) { const float gg = acc[ai][0][m][n][i], uu = acc[ai][1][m][n][i]; hv[4 * n + i] = gt * uu * (gg / (1.f + __expf(-gg))); }
                u32x4 w; w.x = cvt_pk_bf16(hv[0], hv[1]); w.y = cvt_pk_bf16(hv[2], hv[3]); w.z = cvt_pk_bf16(hv[4], hv[5]); w.w = cvt_pk_bf16(hv[6], hv[7]);
                *(u32x4*)(H + (size_t)(u.pm * BM + r) * 256 + col0) = w; }
    }
};
struct EpiDown {
    static constexpr bool PERM = true, AFTER_DRAIN = false;
    unsigned char* Y; mo::lint yb;
    __device__ __forceinline__ void operator()(const f32x4 (&acc)[2][2][4][2], const Unit2& u, int wr, int wc, int fr, int fq) const {
        typedef unsigned u32x2v __attribute__((ext_vector_type(2)));
        const int col0 = u.pn * BM + wc * 32 + 8 * fq; const int ybase = yb[u.e] + u.jt * BM;
#pragma unroll
        for (int ai = 0; ai < 2; ++ai)
#pragma unroll
            for (int m = 0; m < 4; ++m) { const int r = ai * HALF + wr * 64 + m * 16 + fr;
                if (r < u.cnt) { unsigned char* rowp = Y + (size_t)(ybase + r) * nv::D + col0;
#pragma unroll
                    for (int bj = 0; bj < 2; ++bj) { const f32x4 v0 = acc[ai][bj][m][0] * mo::YSC, v1 = acc[ai][bj][m][1] * mo::YSC;
                        int w0 = __builtin_amdgcn_cvt_pk_fp8_f32(v0[0], v0[1], 0, false); w0 = __builtin_amdgcn_cvt_pk_fp8_f32(v0[2], v0[3], w0, true);
                        int w1 = __builtin_amdgcn_cvt_pk_fp8_f32(v1[0], v1[1], 0, false); w1 = __builtin_amdgcn_cvt_pk_fp8_f32(v1[2], v1[3], w1, true);
                        *(u32x2v*)(rowp + bj * HALF) = (u32x2v){(unsigned)w0, (unsigned)w1}; } } }
    }
};
}
constexpr int NTHR = 512;
constexpr int LDS_BYTES = 147456;
constexpr int MISC_OFF = 131072 + 320;
constexpr size_t MiB = 1u << 20;
constexpr size_t CTL_ZERO_BYTES = 1 * MiB;
constexpr int CW_BAR = 4096;
constexpr int CW_MOE = 16384;
constexpr int NPHASE = 10;
constexpr size_t WS_H1 = 1, WS_WR = 65, WS_STATS = 66, WS_LF = 67, WS_FG = 68, WS_WO = 72, WS_WIN = 74, WS_TK = 81, WS_LTOK = 83, WS_LGATE = 91,
                 WS_WED = 100, WS_HID = 230, WS_GLA = 230, WS_WEG = 416, WS_XN = 673, WS_YBF = 673, WS_QKV = 737, WS_Z1 = 737, WS_LG = 865, WS_Y = 416, WS_END = 992;

struct Args { const float* in[21]; float* out; unsigned char* ws; int ph_lo, ph_hi, li, pad; };

__global__ void __launch_bounds__(NTHR, 2) mega_fwd(Args a) {
    using namespace nv;
    extern __shared__ __attribute__((aligned(16))) unsigned char lds[];
    const int G = gridDim.x, bx = blockIdx.x;
    const int vcu = (G % 8 == 0) ? (bx % 8) * (G / 8) + bx / 8 : bx;
    int tid, lane, wave, vw;
#define DERIVE() do { int t_ = threadIdx.x; asm volatile("" : "+v"(t_)); tid = t_; lane = tid & 63; wave = __builtin_amdgcn_readfirstlane(tid >> 6); vw = vcu * 8 + wave; } while (0)
    DERIVE();
    volatile LAS unsigned* MISC = (volatile LAS unsigned*)((LAS unsigned char*)lds + MISC_OFF);
    for (int u = tid; u < (LDS_BYTES - 131072) / 4; u += NTHR) ((LAS unsigned*)((LAS unsigned char*)lds + 131072))[u] = 0u;
    __syncthreads();
    unsigned char* ws = a.ws;
    unsigned* ctl = (unsigned*)ws;
    XcdBarrier bar = xcd_barrier_post(ctl + CW_BAR + a.li * XCD_BAR_WORDS, MISC + 8);
    const float* x = a.in[0];
    const float* ln_in_g = a.in[1]; const float* ln_in_b = a.in[2];
    const float* w_in = a.in[3]; const float* b_fgate = a.in[4];
    const float* w_gate_up = a.in[5]; const float* b_gate = a.in[6]; const float* g_gla = a.in[7];
    const float* w_out = a.in[8]; const float* ln1_g = a.in[9]; const float* ln1_b = a.in[10];
    const float* w_router = a.in[11]; const float* rbias = a.in[12];
    const float* w_eg = a.in[13]; const float* w_eu = a.in[14]; const float* w_ed = a.in[15];
    const float* w_sg = a.in[16]; const float* w_su = a.in[17]; const float* w_sd = a.in[18];
    const float* ln2_g = a.in[19]; const float* ln2_b = a.in[20];
    float* out = a.out;
    int* counts = (int*)(ctl + CW_MOE);
    fx::bf16* H1 = (fx::bf16*)(ws + WS_H1 * MiB);
    fx::bf16* WrT = (fx::bf16*)(ws + WS_WR * MiB);
    float* stats = (float*)(ws + WS_STATS * MiB);
    float* LF = (float*)(ws + WS_LF * MiB);
    float* FG = (float*)(ws + WS_FG * MiB);
    fx::bf16* WoT = (fx::bf16*)(ws + WS_WO * MiB);
    fx::bf16* WinT = (fx::bf16*)(ws + WS_WIN * MiB);
    int* TK = (int*)(ws + WS_TK * MiB);
    float* TW = (float*)(ws + (WS_TK + 1) * MiB);
    int* list_tok = (int*)(ws + WS_LTOK * MiB);
    float* list_gate = (float*)(ws + WS_LGATE * MiB);
    fx::bf16* WedT = (fx::bf16*)(ws + WS_WED * MiB);
    fx::bf16* HID = (fx::bf16*)(ws + WS_HID * MiB);
    unsigned char* QPG = ws + WS_GLA * MiB; unsigned char* OIb = ws + (WS_GLA + 16) * MiB; unsigned char* UUb = ws + (WS_GLA + 80) * MiB; float* DECb = (float*)(ws + (WS_GLA + 144) * MiB); unsigned char* STGb = ws + (WS_GLA + 145) * MiB;
    fx::bf16* WegT = (fx::bf16*)(ws + WS_WEG * MiB);
    fx::bf16* XN = (fx::bf16*)(ws + WS_XN * MiB);
    fx::bf16* Ybf = (fx::bf16*)(ws + WS_YBF * MiB);
    fx::bf16* QKV = (fx::bf16*)(ws + WS_QKV * MiB);
    float* z1 = (float*)(ws + WS_Z1 * MiB);
    float* LG = (float*)(ws + WS_LG * MiB);
    unsigned char* YA = ws + WS_Y * MiB;
    mo::lint tb = (mo::lint)((LAS unsigned char*)lds + mo::L_TB), yb = (mo::lint)((LAS unsigned char*)lds + mo::L_YB), cn = (mo::lint)((LAS unsigned char*)lds + mo::L_CN);

    const int lo = a.ph_lo, hi = a.ph_hi;
#define IN(k) (lo <= (k) && (k) < hi)
#define SEAM(k) do { if (IN(k) && IN((k) + 1)) xcd_barrier(bar); DERIVE(); } while (0)
    const int GW = G * 8;

    if (IN(0)) {
        LAS float* scr = (LAS float*)((LAS unsigned char*)lds + wave * 16384);
        constexpr int I_IN = 16 * (fx::NIN / 32), I_OUT = 16 * 32, I_R = 16 * 8, I_SMALL = I_IN + I_OUT + I_R, I_EG = mo::NEX * 256, I_ED = mo::NEX * 128, I_EXP = I_EG + I_ED;
        for (int it = vw; it < I_SMALL; it += GW) {
            int r = it;
            if (r < I_IN) { fx::transpose_item(w_in, D, INW, WinT, scr, r / (fx::NIN / 32), r % (fx::NIN / 32), lane, [](int d) { return fx::inproj_src(d); }); continue; } r -= I_IN;
            if (r < I_OUT) { fx::transpose_item(w_out, D, D, WoT, scr, r / 32, r % 32, lane, [](int d) { return d; }); continue; } r -= I_OUT;
            fx::transpose_item(w_router, D, NE, WrT, scr, r / 8, r % 8, lane, [](int d) { return d; });
        }
        for (int r = vw; r < T; r += GW) fx::ln_row_bf16(x + (size_t)r * D, ln_in_g, ln_in_b, XN + (size_t)r * D, nullptr, stats + 2 * (size_t)r, lane);
#define CV_DECODE(r_, I) do { int r = (r_); if (r < I_EG) { const int e = r >> 8, kb = (r >> 4) & 15, nb = r & 15, c = nb >> 3, sub = nb & 7; \
            I.W = (e < NE) ? ((sub < 4 ? w_eg : w_eu) + (size_t)e * D * ED) : (sub < 4 ? w_sg : w_su); I.WT = WegT + (size_t)e * 512 * D; I.N = ED; I.K = D; I.k0 = 64 * kb; I.n0 = 32 * nb; I.s0 = 128 * c + 32 * (sub & 3); } \
          else { r -= I_EG; const int e = r >> 7, kb = (r >> 5) & 3, nb = r & 31; I.W = (e < NE) ? (w_ed + (size_t)e * ED * D) : w_sd; I.WT = WedT + (size_t)e * D * ED; I.N = D; I.K = ED; I.k0 = 64 * kb; I.n0 = 32 * nb; I.s0 = 32 * nb; } } while (0)
        { int it = vw; fx::CvItem cur, nx; fx::f32x4 v[8], w[8];
          if (it < I_EXP) { CV_DECODE(it, cur); fx::cv_load(cur, v, lane); }
          while (it < I_EXP) { const int itn = it + GW; if (itn < I_EXP) { CV_DECODE(itn, nx); fx::cv_load(nx, w, lane); }
              fx::cv_finish(cur, v, scr, lane); cur = nx;
#pragma unroll
              for (int i = 0; i < 8; ++i) v[i] = w[i];
              it = itn; } }
#undef CV_DECODE
    }
    SEAM(0);
    if (IN(1)) {
        pg8::Gemm g{XN, WinT, T, fx::NIN, D, D}; pg8::StaticOrder S; S.init(T, fx::NIN, G, bx);
        pg8::EpiInProj E{QKV, FG, LF, b_fgate};
        pg8::gemm_phase<pg8::EpiInProj, pg8::StaticOrder, true, true>((LAS unsigned char*)lds, g, S, E);
    }
    SEAM(1);
    if (IN(2)) {
        int cur_h = -1;
        if (gl::NUNIT % G == 0) { const int per = gl::NUNIT / G; for (int i = 0; i < per; ++i) gl::prep_unit(vcu * per + i, QKV, FG, w_gate_up, b_gate, QPG, OIb, UUb, DECb, lds, cur_h); }
        else for (int u = vcu; u < gl::NUNIT; u += G) gl::prep_unit(u, QKV, FG, w_gate_up, b_gate, QPG, OIb, UUb, DECb, lds, cur_h);
    }
    SEAM(2);
    if (IN(3)) {
        if (bx < 128) gl::scan_wave(bx * 8 + wave, UUb, DECb, STGb, lane);
    }
    SEAM(3);
    if (IN(4)) {
#ifdef POST_TWICE
        for (int i = 0; i < 8; ++i) gl::post_unit(vcu * 8 + i, QKV, QPG, OIb, STGb, g_gla, Ybf, lds);
#endif
        if (gl::NUNIT % G == 0) { const int per = gl::NUNIT / G; for (int i = 0; i < per; ++i) gl::post_unit(vcu * per + i, QKV, QPG, OIb, STGb, g_gla, Ybf, lds); }
        else for (int u = vcu; u < gl::NUNIT; u += G) gl::post_unit(u, QKV, QPG, OIb, STGb, g_gla, Ybf, lds);
        { const attn_body::AttnTensors AT{(const attn_body::bf16*)(QKV + fx::P_FQ), (const attn_body::bf16*)(QKV + fx::P_FK), (const attn_body::bf16*)(QKV + fx::P_FV), (attn_body::bf16*)Ybf, LF};
          const attn_body::StaticOrder SO(G, bx);
          attn_body::attn_phase<attn_body::StaticOrder>((char*)lds, AT, SO);
#ifdef FOX_TWICE
          attn_body::attn_phase<attn_body::StaticOrder>((char*)lds, AT, SO);
#endif
          }
    }
    SEAM(4);
    if (IN(5)) {
        pg8::DenseSched DS; DS.so.init(T, D, G, bx); DS.Bt = WoT; DS.ldb = D;
        pg8::EpiResid E{z1, D, x, stats, ln_in_g, ln_in_b, ALPHA};
        pg8::gemm_phase2<pg8::EpiResid, pg8::DenseSched>((LAS unsigned char*)lds, Ybf, D, D, D, DS, E);
    }
    SEAM(5);
    if (IN(6)) {
        int* lcnt = (int*)(lds + 136192); int* lbase = lcnt + 256;
        for (int rb = vcu; rb < T / 128; rb += G) {
            if (tid < 256) lcnt[tid] = 0;
            for (int r = wave * 16; r < wave * 16 + 16; r += 4) fx::ln_rows_bf16<4>(z1 + (size_t)(rb * 128 + r) * D, ln1_g, ln1_b, H1 + (size_t)(rb * 128 + r) * D, lane);
            asm volatile("s_waitcnt vmcnt(0)" ::: "memory"); __syncthreads();
            { pg8::RouterSched RS{rb, WrT}; pg8::EpiLogits E{LG};
              pg8::gemm_phase2<pg8::EpiLogits, pg8::RouterSched>((LAS unsigned char*)lds, H1, D, D, D, RS, E); }
            DERIVE();
            for (int t = rb * 128 + wave * 2; t < rb * 128 + 128; t += 16) mo::route_token2(LG, rbias, lcnt, TK, TW, t, lane);
            __syncthreads();
            if (tid < 256) { const int c = lcnt[tid]; lbase[tid] = c ? atomicAdd(&counts[tid], c) : 0; }
            __syncthreads();
            for (int t = rb * 128 + wave * 2; t < rb * 128 + 128; t += 16) mo::route_finish2(lbase, list_tok, list_gate, TK, TW, t, lane);
            __syncthreads();
        }
    }
    SEAM(6);
    if (IN(7)) {
        if (wave == 0) mo::moe_tables(counts, tb, yb, cn, lane);
        __syncthreads();
        pg8::MoeSched<0> MS{G, vcu, tb[257], tb, cn, list_tok, WegT}; pg8::EpiSwiGLU E{HID, list_gate};
        pg8::gemm_phase2<pg8::EpiSwiGLU, pg8::MoeSched<0>>((LAS unsigned char*)lds, H1, D, D, D, MS, E);
    }
    SEAM(7);
    if (IN(8)) {
        if (wave == 0) mo::moe_tables(counts, tb, yb, cn, lane);
        __syncthreads();
        pg8::MoeSched<1> MS{G, vcu, tb[257], tb, cn, list_tok, WedT}; pg8::EpiDown E{YA, yb};
        pg8::gemm_phase2<pg8::EpiDown, pg8::MoeSched<1>>((LAS unsigned char*)lds, HID, ED, ED, ED, MS, E);
    }
    SEAM(8);
    if (IN(9)) {
        if (wave == 0) mo::moe_tables(counts, tb, yb, cn, lane);
        __syncthreads();
        for (int t = vw; t < T; t += GW) mo::combine_token(H1, YA, TK, yb, ln2_g, ln2_b, out, t, lane);
    }
#undef IN
#undef SEAM
}

extern "C" void kernel_launch(void* const* d_in, const int* in_sizes, int n_in, void* d_out, int out_size, void* d_ws, size_t ws_size, hipStream_t stream) {
    static int grid = 0;
    if (grid == 0) {
        if (n_in != 21 || out_size != nv::T * nv::D || ws_size < WS_END * MiB) { fprintf(stderr, "kernel_launch: unexpected shapes n_in=%d out=%d ws=%zu\n", n_in, out_size, ws_size); grid = -1; return; }
        int dev = 0, cus = 0;
        if (hipGetDevice(&dev) != hipSuccess || hipDeviceGetAttribute(&cus, hipDeviceAttributeMultiprocessorCount, dev) != hipSuccess) { grid = -1; return; }
        if (hipFuncSetAttribute((const void*)mega_fwd, hipFuncAttributeMaxDynamicSharedMemorySize, LDS_BYTES) != hipSuccess) { fprintf(stderr, "kernel_launch: hipFuncSetAttribute failed\n"); grid = -1; return; }
        grid = cus;
    }
    if (grid < 0) return;
    if (hipMemsetAsync(d_ws, 0, CTL_ZERO_BYTES, stream) != hipSuccess) return;
    Args a{};
    for (int i = 0; i < 21; ++i) a.in[i] = (const float*)d_in[i];
    a.out = (float*)d_out; a.ws = (unsigned char*)d_ws; a.ph_lo = 0; a.ph_hi = NPHASE; a.li = 0;
#ifdef REPEAT_PH
    a.ph_hi = REPEAT_PH + 1; hipLaunchKernelGGL(mega_fwd, dim3(grid), dim3(NTHR), LDS_BYTES, stream, a);
    a.ph_lo = REPEAT_PH; a.ph_hi = NPHASE; a.li = 1;
#endif
    hipLaunchKernelGGL(mega_fwd, dim3(grid), dim3(NTHR), LDS_BYTES, stream, a);
}
```

```cpp
#include <hip/hip_runtime.h>
#include <cstdio>
#include <cstdint>
#include <cmath>

#define LAS __attribute__((address_space(3)))
#define GAS __attribute__((address_space(1)))

#define XB_TMO      128
#define XB_XCNT(j)  (256  + 64 * (j))
#define XB_XSUB(j)  (1280 + 64 * (j))
#define XB_XGEN(j)  (2304 + 64 * (j))
#define XB_TOP      3328
#define XB_TOPGEN   3392
#define XCD_BAR_WORDS 3456
#define XB_SPIN_CAP (1u << 27)
__device__ __forceinline__ unsigned xb_ld(unsigned* p)              { return __hip_atomic_load(p, __ATOMIC_RELAXED, __HIP_MEMORY_SCOPE_AGENT); }
__device__ __forceinline__ unsigned xb_add(unsigned* p, unsigned v) { return __hip_atomic_fetch_add(p, v, __ATOMIC_RELAXED, __HIP_MEMORY_SCOPE_AGENT); }
__device__ __forceinline__ unsigned xb_xcc_id() { return (unsigned)__builtin_amdgcn_s_getreg((3 << 11) | 20) & 0xFu; }
#define XB_SPIN(cond, bar) do { unsigned _sp = 0; while (cond) { __builtin_amdgcn_s_sleep(1); \
    if ((++_sp & 255u) == 0u) { if (xb_ld(&(bar)[XB_TMO])) break; if (_sp > XB_SPIN_CAP) { atomicAdd(&(bar)[XB_TMO], 1u); break; } } } } while (0)
struct XcdBarrier { unsigned* bar; unsigned x; volatile LAS unsigned* st; };
__device__ __forceinline__ XcdBarrier xcd_barrier_post(unsigned* bar, volatile LAS unsigned* st) {
    XcdBarrier b; b.bar = bar; b.x = xb_xcc_id(); b.st = st;
    if (threadIdx.x == 0) (void)xb_add(&bar[XB_XCNT(b.x)], 1u);
    return b;
}
__device__ __forceinline__ void xcd_barrier_complete(unsigned* bar, unsigned x, unsigned& nloc, unsigned& nx) {
    const unsigned G = gridDim.x * gridDim.y * gridDim.z;
    unsigned sum, cnt, mine, sp = 0u;
    for (;;) {
        sum = 0u; cnt = 0u; mine = 0u;
#pragma unroll
        for (unsigned j = 0; j < 16; ++j) { const unsigned c = xb_ld(&bar[XB_XCNT(j)]); sum += c; cnt += (c > 0u) ? 1u : 0u; mine = (j == x) ? c : mine; }
        if (sum == G) break;
        __builtin_amdgcn_s_sleep(1);
        if ((++sp & 255u) == 0u) { if (xb_ld(&bar[XB_TMO])) break; if (sp > XB_SPIN_CAP) { atomicAdd(&bar[XB_TMO], 1u); break; } }
    }
    nloc = mine > 0u ? mine : 1u; nx = cnt > 0u ? cnt : 1u;
}
__device__ __forceinline__ void xcd_barrier(const XcdBarrier& b) {
    asm volatile("s_waitcnt vmcnt(0)" ::: "memory");
    __syncthreads();
    if (threadIdx.x == 0) {
        unsigned* bar = b.bar;
        __builtin_amdgcn_s_waitcnt(0);
        unsigned nloc = b.st[0], nx = b.st[1];
        if (nloc == 0u) { xcd_barrier_complete(bar, b.x, nloc, nx); b.st[0] = nloc; b.st[1] = nx; }
        const unsigned old = xb_add(&bar[XB_XSUB(b.x)], 1u);
        const unsigned gen = old / nloc;
        if (old + 1u == (gen + 1u) * nloc) {
            __builtin_amdgcn_fence(__ATOMIC_RELEASE, "agent");
            asm volatile("s_waitcnt vmcnt(0)" ::: "memory");
            const unsigned og = xb_add(&bar[XB_TOP], 1u);
            const unsigned tg = og / nx;
            if (og + 1u == (tg + 1u) * nx) xb_add(&bar[XB_TOPGEN], 1u);
            else XB_SPIN(xb_ld(&bar[XB_TOPGEN]) == tg, bar);
            __builtin_amdgcn_fence(__ATOMIC_ACQUIRE, "agent");
            xb_add(&bar[XB_XGEN(b.x)], 1u);
            asm volatile("s_waitcnt vmcnt(0)" ::: "memory");
        } else {
            XB_SPIN(xb_ld(&bar[XB_XGEN(b.x)]) == gen, bar);
            __builtin_amdgcn_fence(__ATOMIC_ACQUIRE, "agent");
            asm volatile("s_waitcnt vmcnt(0)" ::: "memory");
        }
    }
    __syncthreads();
}
namespace pg8 {
#define PG8_LAS __attribute__((address_space(3)))
typedef unsigned short bf16_t;
typedef short bf16x8 __attribute__((ext_vector_type(8)));
typedef float f32x4 __attribute__((ext_vector_type(4)));
typedef unsigned u32x4 __attribute__((ext_vector_type(4)));
constexpr int BM = 256, BK = 64, HALF = 128, HTB = HALF * BK * 2  , STAGE_BYTES = 8 * HTB, NXCD = 8, WGM = 8;

__host__ __device__ __forceinline__ int lds_byte(int r, int c) { const int st = (r >> 4) * 2 + (c >> 5), rr = r & 15, cc = c & 31, ob = rr * 64 + cc * 2; return st * 1024 + (ob ^ (((ob >> 9) & 1) << 5)); }
__host__ __device__ __forceinline__ void stage_rc(int b, int& R, int& C) { const int st = b / 1024, sb = b % 1024, swz = sb ^ (((sb >> 9) & 1) << 5); R = (st >> 1) * 16 + swz / 64; C = (st & 1) * 32 + (swz % 64) / 2; }
__host__ __device__ __forceinline__ int perm32(int rho) { const int n = rho >> 4, i = rho & 15; return 8 * (i >> 2) + 4 * n + (i & 3); }

struct Unit { int pm, pn; };
struct Gemm { const bf16_t* A; const bf16_t* Bt; int M, N, K, lda; };

struct StaticOrder {
    int nM, nN, nwg, G, c;
    __host__ __device__ void init(int M, int N, int G_, int c_) { nM = M / BM; nN = N / BM; nwg = nM * nN; G = G_; c = c_; }
    __host__ __device__ bool next(int i, Unit& u) const {
        const long L = (long)i * G + c; if (L >= nwg) return false;
        int wgid = (int)L; { const int q = nwg / NXCD, r = nwg % NXCD, xcd = wgid % NXCD, off = wgid / NXCD; wgid = (xcd < r ? xcd * (q + 1) : r * (q + 1) + (xcd - r) * q) + off; }
        const int nig = WGM * nN, gid = wgid / nig, fm = gid * WGM, gsz = (nM - fm) < WGM ? (nM - fm) : WGM;
        u.pm = fm + ((wgid % nig) % gsz); u.pn = (wgid % nig) / gsz; return true;
    }
    __device__ __forceinline__ void a_ready(const Unit&) const {}
    __device__ __forceinline__ void done(const Unit&) const {}
};

__device__ __forceinline__ unsigned cvt_pk_bf16(float lo, float hi) { unsigned r; asm volatile("v_cvt_pk_bf16_f32 %0, %1, %2" : "=v"(r) : "v"(lo), "v"(hi)); return r; }
typedef float f32x2 __attribute__((ext_vector_type(2)));
__device__ __forceinline__ f32x2 gelu_pk(f32x2 v) {
    const f32x2 av = __builtin_elementwise_abs(v), d = av * 0.2316418882f + 1.0f;
    f32x2 t; t.x = __builtin_amdgcn_rcpf(d.x); t.y = __builtin_amdgcn_rcpf(d.y);
    f32x2 q = t * 0.5307027145f + (-0.7265760135f); q = q * t + 0.7107068705f; q = q * t + (-0.142248368f); q = q * t + 0.127414796f; q = q * t;
    const f32x2 s = (v * v) * (-0.72134752044f);
    f32x2 e; e.x = __builtin_amdgcn_exp2f(s.x); e.y = __builtin_amdgcn_exp2f(s.y);
    const f32x2 m = v * (q * e), r = v - m;
    f32x2 o; o.x = v.x < 0.f ? m.x : r.x; o.y = v.y < 0.f ? m.y : r.y; return o;
}

template <int ACT  > struct EpiBf16 {
    static constexpr bool PERM = true, AFTER_DRAIN = false; static_assert(ACT == 0 || ACT == 1, "EpiBf16: ACT is 0 (none) or 1 (gelu_pk)");
    bf16_t* O; int ldc; const float* bias; int split_cols; size_t split_stride; float scale0;
    __device__ __forceinline__ void operator()(const f32x4 (&acc)[2][2][4][2], const Unit& u, int wr, int wc, int fr, int fq) const {
        const int row0 = u.pm * BM + wr * 64 + fr; int colt = u.pn * BM; bf16_t* base = O;
        float sc = 1.f; if (split_cols) { const int t = colt / split_cols; base += (size_t)t * split_stride; colt -= t * split_cols; if (t == 0) sc = scale0; }
        const int col0 = colt + wc * 32 + 8 * fq, bcol0 = u.pn * BM + wc * 32 + 8 * fq;
        f32x4 bv[2][2];
#pragma unroll
        for (int bj = 0; bj < 2; ++bj)
#pragma unroll
            for (int n = 0; n < 2; ++n) bv[bj][n] = bias ? *(const f32x4*)(bias + bcol0 + bj * HALF + 4 * n) : (f32x4){0.f, 0.f, 0.f, 0.f};
#pragma unroll
        for (int ai = 0; ai < 2; ++ai)
#pragma unroll
            for (int m = 0; m < 4; ++m) { bf16_t* rowp = base + (size_t)(row0 + ai * HALF + m * 16) * ldc + col0;
#pragma unroll
                for (int bj = 0; bj < 2; ++bj) { f32x4 v0 = acc[ai][bj][m][0] + bv[bj][0], v1 = acc[ai][bj][m][1] + bv[bj][1];
                    if (ACT == 1) { f32x2 a = gelu_pk((f32x2){v0[0], v0[1]}), b = gelu_pk((f32x2){v0[2], v0[3]}), c = gelu_pk((f32x2){v1[0], v1[1]}), d = gelu_pk((f32x2){v1[2], v1[3]});
                        v0 = (f32x4){a.x, a.y, b.x, b.y}; v1 = (f32x4){c.x, c.y, d.x, d.y}; }
                    v0 = v0 * sc; v1 = v1 * sc; u32x4 w; w.x = cvt_pk_bf16(v0[0], v0[1]); w.y = cvt_pk_bf16(v0[2], v0[3]); w.z = cvt_pk_bf16(v1[0], v1[1]); w.w = cvt_pk_bf16(v1[2], v1[3]);
                    *(u32x4*)(rowp + bj * HALF) = w; } }
    }
};

template <class Epi, class Sched, bool ALIGN_EPI = false, bool SP2 = false>
__device__ __forceinline__ void gemm_phase(PG8_LAS unsigned char* lds, const Gemm g, const Sched& S, const Epi& E) {
    const int tid = threadIdx.x, wid = __builtin_amdgcn_readfirstlane(tid >> 6), lane = tid & 63, wr = wid >> 2, wc = wid & 3, fr = lane & 15, fq = lane >> 4;
    const int K = g.K, nt = K / BK;
    unsigned voffA[2], voffB[2];
#pragma unroll
    for (int i = 0; i < 2; ++i) { int R, C; stage_rc(tid * 16 + i * 8192, R, C); const int Rb = Epi::PERM ? ((R & ~31) + perm32(R & 31)) : R;
        voffA[i] = (unsigned)(R * g.lda + C) * 2u; voffB[i] = (unsigned)(Rb * K + C) * 2u; }
    const size_t kstep = (size_t)(BK * 2);
    const size_t hstepA = (size_t)HALF * g.lda * 2, hstepB = (size_t)HALF * K * 2;
    const size_t tstepA = 2 * hstepA, tstepB = 2 * hstepB;
    const unsigned ldsw = (unsigned)wid * 1024u;
    const int aoff = lds_byte(wr * 64 + fr, fq * 8), boff = lds_byte(wc * 32 + fr, fq * 8);
#define PG8_SA(b, h) (((b) * 2 + (h)) * HTB)
#define PG8_SB(b, h) ((4 + (b) * 2 + (h)) * HTB)
#define PG8_STAGE(bufoff, gbase, voff) do { _Pragma("unroll") for (int _i = 0; _i < 2; ++_i) \
        __builtin_amdgcn_global_load_lds((const unsigned*)((const char*)(gbase) + (voff)[_i]), (PG8_LAS unsigned*)(lds + (bufoff) + ldsw + _i * 8192), 16, 0, 0); } while (0)
#define PG8_LDA(dst, b, h) do { _Pragma("unroll") for (int m = 0; m < 4; ++m) _Pragma("unroll") for (int k = 0; k < 2; ++k) dst[m][k] = *(const PG8_LAS bf16x8*)(lds + PG8_SA(b, h) + aoff + m * 2048 + k * 1024); } while (0)
#define PG8_LDB(dst, b, h) do { _Pragma("unroll") for (int n = 0; n < 2; ++n) _Pragma("unroll") for (int k = 0; k < 2; ++k) dst[n][k] = *(const PG8_LAS bf16x8*)(lds + PG8_SB(b, h) + boff + n * 2048 + k * 1024); } while (0)
#define PG8_MMA(ai, bj, At, Bt) do { __builtin_amdgcn_s_setprio(1); _Pragma("unroll") for (int m = 0; m < 4; ++m) _Pragma("unroll") for (int n = 0; n < 2; ++n) _Pragma("unroll") for (int k = 0; k < 2; ++k) \
        acc[ai][bj][m][n] = __builtin_amdgcn_mfma_f32_16x16x32_bf16(Bt[n][k], At[m][k], acc[ai][bj][m][n], 0, 0, 0); __builtin_amdgcn_s_setprio(0); } while (0)
#define PG8_WAIT_V(n) asm volatile("s_waitcnt vmcnt(" #n ")" ::: "memory")
#define PG8_WAIT_L(n) asm volatile("s_waitcnt lgkmcnt(" #n ")" ::: "memory")
#define PG8_BAR __builtin_amdgcn_s_barrier()
#define PG8_SCHED __builtin_amdgcn_sched_barrier(0)
    Unit cur, nxt; int ui = 0;
    if (!S.next(0, cur)) return;
    f32x4 acc[2][2][4][2];
#pragma unroll
    for (int a = 0; a < 2; ++a)
#pragma unroll
        for (int b = 0; b < 2; ++b)
#pragma unroll
            for (int m = 0; m < 4; ++m)
#pragma unroll
                for (int n = 0; n < 2; ++n) acc[a][b][m][n] = (f32x4){0.f, 0.f, 0.f, 0.f};
    bf16x8 At[4][2], B0[2][2], B1[2][2];
    const char* cA = (const char*)g.A + (size_t)cur.pm * tstepA; const char* cB = (const char*)g.Bt + (size_t)cur.pn * tstepB;
    S.a_ready(cur);
    if constexpr (SP2) {
        PG8_STAGE(PG8_SB(0, 0), cB, voffB); PG8_STAGE(PG8_SB(0, 1), cB + hstepB, voffB); PG8_STAGE(PG8_SA(0, 0), cA, voffA); PG8_STAGE(PG8_SA(0, 1), cA + hstepA, voffA);
        if (wr == 1) PG8_BAR;
        PG8_WAIT_V(2); PG8_BAR;
        PG8_STAGE(PG8_SB(1, 0), cB + kstep, voffB); PG8_STAGE(PG8_SA(1, 0), cA + kstep, voffA); PG8_STAGE(PG8_SB(1, 1), cB + hstepB + kstep, voffB);
        PG8_WAIT_V(6); PG8_BAR;
    } else {
        PG8_STAGE(PG8_SB(0, 0), cB, voffB); PG8_STAGE(PG8_SA(0, 0), cA, voffA); PG8_STAGE(PG8_SB(0, 1), cB + hstepB, voffB); PG8_STAGE(PG8_SA(0, 1), cA + hstepA, voffA);
        if (wr == 1) PG8_BAR;
        PG8_WAIT_V(4); PG8_BAR;
        PG8_STAGE(PG8_SB(1, 0), cB + kstep, voffB); PG8_STAGE(PG8_SA(1, 0), cA + kstep, voffA); PG8_STAGE(PG8_SB(1, 1), cB + hstepB + kstep, voffB);
        PG8_WAIT_V(6); PG8_BAR;
    }
    for (;;) {
        const bool has_next = S.next(ui + 1, nxt);
        const char* nA = has_next ? (const char*)g.A + (size_t)nxt.pm * tstepA : cA; const char* nB = has_next ? (const char*)g.Bt + (size_t)nxt.pn * tstepB : cB;
        for (int t = 0; t < nt; t += 2) {
            const bool last = (t == nt - 2);
            const char* a1 = cA + (size_t)(t + 1) * kstep;
            const char* a2 = last ? nA : cA + (size_t)(t + 2) * kstep; const char* b2 = last ? nB : cB + (size_t)(t + 2) * kstep;
            const char* a3 = a2 + kstep; const char* b3 = b2 + kstep;
            if (last && has_next) S.a_ready(nxt);
            if constexpr (SP2) {
            PG8_LDB(B0, 0, 0); PG8_LDB(B1, 0, 1); PG8_SCHED; PG8_LDA(At, 0, 0); PG8_STAGE(PG8_SA(1, 1), a1 + hstepA, voffA);
            PG8_WAIT_V(8); PG8_WAIT_L(0); PG8_BAR; PG8_MMA(0, 0, At, B0); PG8_MMA(0, 1, At, B1); PG8_BAR; PG8_SCHED;
            PG8_LDA(At, 0, 1); PG8_STAGE(PG8_SB(0, 0), b2, voffB); PG8_STAGE(PG8_SB(0, 1), b2 + hstepB, voffB); PG8_STAGE(PG8_SA(0, 0), a2, voffA);
            PG8_WAIT_V(8); PG8_WAIT_L(0); PG8_BAR; PG8_MMA(1, 0, At, B0); PG8_MMA(1, 1, At, B1); PG8_BAR; PG8_SCHED;
            PG8_LDB(B0, 1, 0); PG8_LDB(B1, 1, 1); PG8_SCHED; PG8_LDA(At, 1, 0); PG8_STAGE(PG8_SA(0, 1), a2 + hstepA, voffA);
            PG8_WAIT_V(8); PG8_WAIT_L(0); PG8_BAR; PG8_MMA(0, 0, At, B0); PG8_MMA(0, 1, At, B1); PG8_BAR; PG8_SCHED;
            PG8_LDA(At, 1, 1); PG8_STAGE(PG8_SB(1, 0), b3, voffB); PG8_STAGE(PG8_SB(1, 1), b3 + hstepB, voffB); PG8_STAGE(PG8_SA(1, 0), a3, voffA);
            PG8_WAIT_V(8); PG8_WAIT_L(0); PG8_BAR; PG8_MMA(1, 0, At, B0); PG8_MMA(1, 1, At, B1); PG8_BAR; PG8_SCHED;
            } else {
            PG8_LDB(B0, 0, 0); PG8_SCHED; PG8_LDA(At, 0, 0); PG8_STAGE(PG8_SA(1, 1), a1 + hstepA, voffA);
            PG8_WAIT_L(8); PG8_BAR; PG8_WAIT_L(0); PG8_MMA(0, 0, At, B0); PG8_BAR; PG8_SCHED;
            PG8_LDB(B1, 0, 1); PG8_STAGE(PG8_SB(0, 0), b2, voffB);
            PG8_BAR; PG8_WAIT_L(0); PG8_MMA(0, 1, At, B1); PG8_BAR;
            PG8_LDA(At, 0, 1); PG8_STAGE(PG8_SA(0, 0), a2, voffA);
            PG8_BAR; PG8_WAIT_L(0); PG8_MMA(1, 0, At, B0); PG8_BAR; PG8_SCHED;
            PG8_STAGE(PG8_SB(0, 1), b2 + hstepB, voffB);
            PG8_WAIT_V(6); PG8_BAR; PG8_MMA(1, 1, At, B1); PG8_BAR;
            PG8_LDB(B0, 1, 0); PG8_SCHED; PG8_LDA(At, 1, 0); PG8_STAGE(PG8_SA(0, 1), a2 + hstepA, voffA);
            PG8_WAIT_L(8); PG8_BAR; PG8_WAIT_L(0); PG8_MMA(0, 0, At, B0); PG8_BAR; PG8_SCHED;
            PG8_LDB(B1, 1, 1); PG8_STAGE(PG8_SB(1, 0), b3, voffB);
            PG8_BAR; PG8_WAIT_L(0); PG8_MMA(0, 1, At, B1); PG8_BAR;
            PG8_LDA(At, 1, 1); PG8_STAGE(PG8_SA(1, 0), a3, voffA);
            PG8_BAR; PG8_WAIT_L(0); PG8_MMA(1, 0, At, B0); PG8_BAR; PG8_SCHED;
            PG8_STAGE(PG8_SB(1, 1), b3 + hstepB, voffB);
            PG8_WAIT_V(6); PG8_BAR; PG8_MMA(1, 1, At, B1); PG8_BAR;
            }
        }
        if constexpr (ALIGN_EPI) { if (wr == 0) PG8_BAR; }
        if constexpr (!Epi::AFTER_DRAIN) { E(acc, cur, wr, wc, fr, fq); S.done(cur); }
        if (!has_next) break;
#pragma unroll
        for (int a = 0; a < 2; ++a)
#pragma unroll
            for (int b = 0; b < 2; ++b)
#pragma unroll
                for (int m = 0; m < 4; ++m)
#pragma unroll
                    for (int n = 0; n < 2; ++n) acc[a][b][m][n] = (f32x4){0.f, 0.f, 0.f, 0.f};
        cur = nxt; cA = nA; cB = nB; ++ui;
        if constexpr (ALIGN_EPI) { if (wr == 1) PG8_BAR; }
    }
    PG8_WAIT_V(0);
    if constexpr (!ALIGN_EPI) { if (wr == 0) PG8_BAR; }
    PG8_BAR;
    if constexpr (Epi::AFTER_DRAIN) { E.fused(acc, cur, wr, wc, fr, fq, lds, wid, lane); S.done(cur); }
#undef PG8_SA
#undef PG8_SB
#undef PG8_STAGE
#undef PG8_LDA
#undef PG8_LDB
#undef PG8_MMA
#undef PG8_WAIT_V
#undef PG8_WAIT_L
#undef PG8_BAR
#undef PG8_SCHED
}
}
namespace pg8 {
struct Unit2 { int pm, pn, e, cnt, jt; };
template <class Epi, class Sched>
__device__ __forceinline__ void gemm_phase2(PG8_LAS unsigned char* lds, const bf16_t* Abase, int lda, int ldb, int K, const Sched& S, const Epi& E) {
    int tid_ = threadIdx.x; asm volatile("" : "+v"(tid_));
    const int tid = tid_, wid = __builtin_amdgcn_readfirstlane(tid >> 6), lane = tid & 63, wr = wid >> 2, wc = wid & 3, fr = lane & 15, fq = lane >> 4;
    int K_ = K; asm volatile("" : "+s"(K_));
    const int nt = K_ / BK;
    unsigned voffB[2];
#pragma unroll
    for (int i = 0; i < 2; ++i) { int R, C; stage_rc(tid * 16 + i * 8192, R, C); const int Rb = Epi::PERM ? ((R & ~31) + perm32(R & 31)) : R; voffB[i] = (unsigned)(Rb * ldb + C) * 2u; }
    const unsigned lda2 = (unsigned)lda * 2u;
#define PG8_AOFFS(U, o0, o1) do { int t2_ = threadIdx.x; asm volatile("" : "+v"(t2_)); _Pragma("unroll") for (int i_ = 0; i_ < 2; ++i_) { int R_, C_; stage_rc(t2_ * 16 + i_ * 8192, R_, C_); \
        o0[i_] = (unsigned)S.arow(U, R_) * lda2 + (unsigned)C_ * 2u; o1[i_] = (unsigned)S.arow(U, HALF + R_) * lda2 + (unsigned)C_ * 2u; } } while (0)
    const size_t kstep = (size_t)(BK * 2);
    const size_t hstepB = (size_t)HALF * ldb * 2;
    const unsigned ldsw = (unsigned)wid * 1024u;
    const int aoff = lds_byte(wr * 64 + fr, fq * 8), boff = lds_byte(wc * 32 + fr, fq * 8);
#define PG8_SA(b, h) (((b) * 2 + (h)) * HTB)
#define PG8_SB(b, h) ((4 + (b) * 2 + (h)) * HTB)
#define PG8_STAGE(bufoff, gbase, voff) do { _Pragma("unroll") for (int _i = 0; _i < 2; ++_i) \
        __builtin_amdgcn_global_load_lds((const unsigned*)((const char*)(gbase) + (voff)[_i]), (PG8_LAS unsigned*)(lds + (bufoff) + ldsw + _i * 8192), 16, 0, 0); } while (0)
#define PG8_LDA(dst, b, h) do { _Pragma("unroll") for (int m = 0; m < 4; ++m) _Pragma("unroll") for (int k = 0; k < 2; ++k) dst[m][k] = *(const PG8_LAS bf16x8*)(lds + PG8_SA(b, h) + aoff + m * 2048 + k * 1024); } while (0)
#define PG8_LDB(dst, b, h) do { _Pragma("unroll") for (int n = 0; n < 2; ++n) _Pragma("unroll") for (int k = 0; k < 2; ++k) dst[n][k] = *(const PG8_LAS bf16x8*)(lds + PG8_SB(b, h) + boff + n * 2048 + k * 1024); } while (0)
#define PG8_MMA(ai, bj, At, Bt) do { __builtin_amdgcn_s_setprio(1); _Pragma("unroll") for (int m = 0; m < 4; ++m) _Pragma("unroll") for (int n = 0; n < 2; ++n) _Pragma("unroll") for (int k = 0; k < 2; ++k) \
        acc[ai][bj][m][n] = __builtin_amdgcn_mfma_f32_16x16x32_bf16(Bt[n][k], At[m][k], acc[ai][bj][m][n], 0, 0, 0); __builtin_amdgcn_s_setprio(0); } while (0)
#define PG8_WAIT_V(n) asm volatile("s_waitcnt vmcnt(" #n ")" ::: "memory")
#define PG8_WAIT_L(n) asm volatile("s_waitcnt lgkmcnt(" #n ")" ::: "memory")
#define PG8_BAR __builtin_amdgcn_s_barrier()
#define PG8_SCHED __builtin_amdgcn_sched_barrier(0)
    Unit2 cur, nxt; int ui = 0;
    if (!S.next(0, cur)) return;
    f32x4 acc[2][2][4][2];
#pragma unroll
    for (int a = 0; a < 2; ++a)
#pragma unroll
        for (int b = 0; b < 2; ++b)
#pragma unroll
            for (int m = 0; m < 4; ++m)
#pragma unroll
                for (int n = 0; n < 2; ++n) acc[a][b][m][n] = (f32x4){0.f, 0.f, 0.f, 0.f};
    bf16x8 At[4][2], B0[2][2], B1[2][2];
    unsigned cv0[2], cv1[2], nv0[2], nv1[2];
    PG8_AOFFS(cur, cv0, cv1);
    const char* cA = (const char*)Abase + S.aoff(cur); const char* cB = S.bptr(cur);
    PG8_STAGE(PG8_SB(0, 0), cB, voffB); PG8_STAGE(PG8_SB(0, 1), cB + hstepB, voffB); PG8_STAGE(PG8_SA(0, 0), cA, cv0); PG8_STAGE(PG8_SA(0, 1), cA, cv1);
    if (wr == 1) PG8_BAR;
    PG8_WAIT_V(2); PG8_BAR;
    PG8_STAGE(PG8_SB(1, 0), cB + kstep, voffB); PG8_STAGE(PG8_SA(1, 0), cA + kstep, cv0); PG8_STAGE(PG8_SB(1, 1), cB + hstepB + kstep, voffB);
    PG8_WAIT_V(6); PG8_BAR;
    for (;;) {
        const bool has_next = S.next(ui + 1, nxt);
        const char* nA = has_next ? (const char*)Abase + S.aoff(nxt) : cA; const char* nB = has_next ? S.bptr(nxt) : cB;
#pragma unroll
        for (int i = 0; i < 2; ++i) { nv0[i] = cv0[i]; nv1[i] = cv1[i]; }
        if (has_next) PG8_AOFFS(nxt, nv0, nv1);
        for (int t = 0; t < nt; t += 2) {
            const bool last = (t == nt - 2);
            const char* a1 = cA + (size_t)(t + 1) * kstep;
            const char* a2 = last ? nA : cA + (size_t)(t + 2) * kstep; const char* b2 = last ? nB : cB + (size_t)(t + 2) * kstep;
            const char* a3 = a2 + kstep; const char* b3 = b2 + kstep;
            unsigned s0[2] = {cv0[0], cv0[1]}, s1[2] = {cv1[0], cv1[1]};
            if (last) { asm volatile("" ::: "memory"); s0[0] = nv0[0]; s0[1] = nv0[1]; s1[0] = nv1[0]; s1[1] = nv1[1]; }
            PG8_LDB(B0, 0, 0); PG8_LDB(B1, 0, 1); PG8_SCHED; PG8_LDA(At, 0, 0); PG8_STAGE(PG8_SA(1, 1), a1, cv1);
            PG8_WAIT_V(8); PG8_WAIT_L(0); PG8_BAR; PG8_MMA(0, 0, At, B0); PG8_MMA(0, 1, At, B1); PG8_BAR; PG8_SCHED;
            PG8_LDA(At, 0, 1); PG8_STAGE(PG8_SB(0, 0), b2, voffB); PG8_STAGE(PG8_SB(0, 1), b2 + hstepB, voffB); PG8_STAGE(PG8_SA(0, 0), a2, s0);
            PG8_WAIT_V(8); PG8_WAIT_L(0); PG8_BAR; PG8_MMA(1, 0, At, B0); PG8_MMA(1, 1, At, B1); PG8_BAR; PG8_SCHED;
            PG8_LDB(B0, 1, 0); PG8_LDB(B1, 1, 1); PG8_SCHED; PG8_LDA(At, 1, 0); PG8_STAGE(PG8_SA(0, 1), a2, s1);
            PG8_WAIT_V(8); PG8_WAIT_L(0); PG8_BAR; PG8_MMA(0, 0, At, B0); PG8_MMA(0, 1, At, B1); PG8_BAR; PG8_SCHED;
            PG8_LDA(At, 1, 1); PG8_STAGE(PG8_SB(1, 0), b3, voffB); PG8_STAGE(PG8_SB(1, 1), b3 + hstepB, voffB); PG8_STAGE(PG8_SA(1, 0), a3, s0);
            PG8_WAIT_V(8); PG8_WAIT_L(0); PG8_BAR; PG8_MMA(1, 0, At, B0); PG8_MMA(1, 1, At, B1); PG8_BAR; PG8_SCHED;
        }
        if (wr == 0) PG8_BAR;
        { Unit2 eu = cur; asm volatile("" : "+s"(eu.pm), "+s"(eu.pn), "+s"(eu.e), "+s"(eu.cnt), "+s"(eu.jt));
          E(acc, eu, wr, wc, fr, fq);
          }
        if (!has_next) break;
#pragma unroll
        for (int a = 0; a < 2; ++a)
#pragma unroll
            for (int b = 0; b < 2; ++b)
#pragma unroll
                for (int m = 0; m < 4; ++m)
#pragma unroll
                    for (int n = 0; n < 2; ++n) acc[a][b][m][n] = (f32x4){0.f, 0.f, 0.f, 0.f};
        cur = nxt; cA = nA; cB = nB; ++ui;
#pragma unroll
        for (int i = 0; i < 2; ++i) { cv0[i] = nv0[i]; cv1[i] = nv1[i]; }
        if (wr == 1) PG8_BAR;
    }
    PG8_WAIT_V(0);
    PG8_BAR;
#undef PG8_AOFFS
#undef PG8_SA
#undef PG8_SB
#undef PG8_STAGE
#undef PG8_LDA
#undef PG8_LDB
#undef PG8_MMA
#undef PG8_WAIT_V
#undef PG8_WAIT_L
#undef PG8_BAR
#undef PG8_SCHED
}

struct DenseSched {
    StaticOrder so; const bf16_t* Bt; int ldb;
    __device__ __forceinline__ bool next(int i, Unit2& u) const { Unit t; if (!so.next(i, t)) return false; u.pm = t.pm; u.pn = t.pn; u.e = 0; u.cnt = 256; u.jt = 0; return true; }
    __device__ __forceinline__ int arow(const Unit2& u, int r) const { return u.pm * BM + r; }
    __device__ __forceinline__ size_t aoff(const Unit2&) const { return 0; }
    __device__ __forceinline__ const char* bptr(const Unit2& u) const { return (const char*)(Bt + (size_t)u.pn * BM * ldb); }
};
struct EpiPlainBf16 {
    static constexpr bool PERM = true, AFTER_DRAIN = false;
    bf16_t* O; int ldc;
    __device__ __forceinline__ void operator()(const f32x4 (&acc)[2][2][4][2], const Unit2& u, int wr, int wc, int fr, int fq) const {
        const int row0 = u.pm * BM + wr * 64 + fr, col0 = u.pn * BM + wc * 32 + 8 * fq;
#pragma unroll
        for (int ai = 0; ai < 2; ++ai)
#pragma unroll
            for (int m = 0; m < 4; ++m) { bf16_t* rowp = O + (size_t)(row0 + ai * HALF + m * 16) * ldc + col0;
#pragma unroll
                for (int bj = 0; bj < 2; ++bj) { const f32x4 v0 = acc[ai][bj][m][0], v1 = acc[ai][bj][m][1];
                    u32x4 w; w.x = cvt_pk_bf16(v0[0], v0[1]); w.y = cvt_pk_bf16(v0[2], v0[3]); w.z = cvt_pk_bf16(v1[0], v1[1]); w.w = cvt_pk_bf16(v1[2], v1[3]);
                    *(u32x4*)(rowp + bj * HALF) = w; } }
    }
};
}
namespace nv {
constexpr int D = 1024, B = 8, S = 4096, T = B * S;
constexpr int FH = 8, FD = 64, GH = 4, GK = 64, GV = 128, RANK = 16;
constexpr int INW = 3096;
constexpr int O_FQ = 0, O_FK = 512, O_FV = 1024, O_FF = 1536, O_GQ = 1544, O_GK = 1800, O_GV = 2056, O_GA = 2568, O_GR = 2584;
constexpr int NE = 256, NG = 8, TOPK = 8, ED = 256;
constexpr float LN_EPS = 1e-5f;
constexpr float ALPHA = 1.189207115002721f;
constexpr int PADR = 64;
constexpr int APAD = T * TOPK + NE * PADR;

__device__ __forceinline__ float logsigmoidf(float x) { return fminf(x, 0.f) - log1pf(expf(-fabsf(x))); }
__device__ __forceinline__ float siluf(float x) { return x / (1.f + expf(-x)); }


__device__ __forceinline__ void ln_row(const float* in1, float a, const float* in2, const float* __restrict__ g, const float* __restrict__ b, float* out, int r, int tid, float* sh) {
    float4 v = ((const float4*)(in1 + (size_t)r * D))[tid];
    v.x *= a; v.y *= a; v.z *= a; v.w *= a;
    if (in2) { const float4 w = ((const float4*)(in2 + (size_t)r * D))[tid]; v.x += w.x; v.y += w.y; v.z += w.z; v.w += w.w; }
    float s = v.x + v.y + v.z + v.w;
    for (int o = 32; o > 0; o >>= 1) s += __shfl_xor(s, o);
    __syncthreads();
    if ((tid & 63) == 0) sh[tid >> 6] = s;
    __syncthreads();
    const float mean = (sh[0] + sh[1] + sh[2] + sh[3]) * (1.f / D);
    v.x -= mean; v.y -= mean; v.z -= mean; v.w -= mean;
    float q = v.x * v.x + v.y * v.y + v.z * v.z + v.w * v.w;
    for (int o = 32; o > 0; o >>= 1) q += __shfl_xor(q, o);
    if ((tid & 63) == 0) sh[4 + (tid >> 6)] = q;
    __syncthreads();
    const float rstd = rsqrtf((sh[4] + sh[5] + sh[6] + sh[7]) * (1.f / D) + LN_EPS);
    const float4 gg = ((const float4*)g)[tid], bb = ((const float4*)b)[tid];
    float4 o4; o4.x = v.x * rstd * gg.x + bb.x; o4.y = v.y * rstd * gg.y + bb.y; o4.z = v.z * rstd * gg.z + bb.z; o4.w = v.w * rstd * gg.w + bb.w;
    ((float4*)(out + (size_t)r * D))[tid] = o4;
}

__device__ __forceinline__ void gemm_tile(const float* A, const float* Bm, float* C, int N, int K, int lda, int ldb, int ldc, int tile_x, int tile_y, int tid, float* sh) {
    float (*As)[68] = (float (*)[68])sh;
    float (*Bs)[68] = (float (*)[68])(sh + 16 * 68);
    const int tx = tid & 15, ty = tid >> 4;
    const int row0 = tile_y * 64, col0 = tile_x * 64;
    float acc[4][4] = {};
    const int ar = tid >> 2, ak = (tid & 3) * 4;
    const int bk = tid >> 4, bc = (tid & 15) * 4;
    const bool bok = (col0 + bc) < N;
    for (int k0 = 0; k0 < K; k0 += 16) {
        const float4 av = *(const float4*)(A + (size_t)(row0 + ar) * lda + k0 + ak);
        float4 bv = make_float4(0.f, 0.f, 0.f, 0.f);
        if (bok) bv = *(const float4*)(Bm + (size_t)(k0 + bk) * ldb + col0 + bc);
        __syncthreads();
        As[ak + 0][ar] = av.x; As[ak + 1][ar] = av.y; As[ak + 2][ar] = av.z; As[ak + 3][ar] = av.w;
        *(float4*)&Bs[bk][bc] = bv;
        __syncthreads();
#pragma unroll
        for (int k = 0; k < 16; ++k) {
            const float4 a4 = *(const float4*)&As[k][ty * 4];
            const float4 b4 = *(const float4*)&Bs[k][tx * 4];
            const float aa[4] = {a4.x, a4.y, a4.z, a4.w}, bb[4] = {b4.x, b4.y, b4.z, b4.w};
#pragma unroll
            for (int i = 0; i < 4; ++i)
#pragma unroll
                for (int j = 0; j < 4; ++j) acc[i][j] += aa[i] * bb[j];
        }
    }
    if (col0 + tx * 4 < N) {
#pragma unroll
        for (int i = 0; i < 4; ++i)
            *(float4*)(C + (size_t)(row0 + ty * 4 + i) * ldc + col0 + tx * 4) = make_float4(acc[i][0], acc[i][1], acc[i][2], acc[i][3]);
    }
}
__device__ __forceinline__ void gemm_phase(const float* A, const float* Bm, float* C, int M, int N, int K, int lda, int ldb, int ldc, int half, int tid, float* sh) {
    const int ntx = (N + 63) / 64, nty = M / 64, ntile = ntx * nty, G2 = gridDim.x * 2;
    for (int t0 = blockIdx.x * 2; t0 < ntile; t0 += G2) {
        int tl = t0 + half; if (tl >= ntile) tl = ntile - 1;
        gemm_tile(A, Bm, C, N, K, lda, ldb, ldc, tl % ntx, tl / ntx, tid, sh);
    }
}

__device__ __forceinline__ void fox_prep(const float* proj, const float* __restrict__ bf, float* cbuf, int bh, int lane) {
    const int b = bh / FH, h = bh % FH;
    const float bias = bf[h];
    float s = 0.f;
    for (int i = 0; i < 64; ++i) { const int t = lane * 64 + i; s += logsigmoidf(proj[(size_t)(b * S + t) * INW + O_FF + h] + bias); }
    float inc = s;
    for (int o = 1; o < 64; o <<= 1) { const float n = __shfl_up(inc, o); if (lane >= o) inc += n; }
    float run = inc - s;
    for (int i = 0; i < 64; ++i) { const int t = lane * 64 + i; run += logsigmoidf(proj[(size_t)(b * S + t) * INW + O_FF + h] + bias); cbuf[(size_t)bh * S + t] = run; }
}

__device__ __forceinline__ void fox_attn(const float* proj, const float* cbuf, float* y, int blk, int lane) {
    const int qb = blk % (S / 64), bh = blk / (S / 64), b = bh / FH, h = bh % FH;
    const int t = qb * 64 + lane;
    const float* qp = proj + (size_t)(b * S + t) * INW + O_FQ + h * FD;
    float q[64], o[64];
#pragma unroll
    for (int d = 0; d < 64; ++d) { q[d] = qp[d] * 0.125f; o[d] = 0.f; }
    const float ct = cbuf[(size_t)bh * S + t];
    float m = -INFINITY, l = 0.f;
    const int smax = qb * 64 + 63;
    for (int s = 0; s <= smax; ++s) {
        const float* kp = proj + (size_t)(b * S + s) * INW + O_FK + h * FD;
        const float* vp = proj + (size_t)(b * S + s) * INW + O_FV + h * FD;
        float dot = 0.f;
#pragma unroll
        for (int d = 0; d < 64; ++d) dot += q[d] * kp[d];
        const float x = dot + (ct - cbuf[(size_t)bh * S + s]);
        if (s <= t) {
            if (x > m) { const float al = expf(m - x); l *= al;
#pragma unroll
                for (int d = 0; d < 64; ++d) o[d] *= al;
                m = x; }
            const float p = expf(x - m); l += p;
#pragma unroll
            for (int d = 0; d < 64; ++d) o[d] += p * vp[d];
        }
    }
    const float il = 1.f / l;
    float* yp = y + (size_t)(b * S + t) * D + h * FD;
#pragma unroll
    for (int d = 0; d < 64; ++d) yp[d] = o[d] * il;
}

__device__ __forceinline__ void gla_prep(const float* proj, const float* __restrict__ wgu, const float* __restrict__ bg, float* abuf, int t, int j) {
    const float* ga = proj + (size_t)t * INW + O_GA;
    float s = bg[j];
#pragma unroll
    for (int r = 0; r < RANK; ++r) s += ga[r] * wgu[r * 256 + j];
    abuf[(size_t)t * 256 + j] = expf(logsigmoidf(s) * (1.f / 16.f));
}

__device__ __forceinline__ void gla_rec(const float* proj, const float* abuf, float* glao, int bh, int e) {
    const int b = bh / GH, h = bh % GH;
    float st[64];
#pragma unroll
    for (int d = 0; d < 64; ++d) st[d] = 0.f;
    for (int s = 0; s < S; ++s) {
        const size_t t = (size_t)b * S + s;
        const float* qp = proj + t * INW + O_GQ + h * GK;
        const float* kp = proj + t * INW + O_GK + h * GK;
        const float* ap = abuf + t * 256 + h * GK;
        const float v = proj[t * INW + O_GV + h * GV + e];
        float o = 0.f;
#pragma unroll
        for (int d = 0; d < 64; ++d) { st[d] = ap[d] * st[d] + kp[d] * v; o += qp[d] * st[d]; }
        glao[t * 512 + h * GV + e] = o * 0.125f;
    }
}

__device__ __forceinline__ void gla_post(const float* glao, const float* proj, const float* __restrict__ g, float* y, int w, int lane) {
    const int t = w >> 2, h = w & 3;
    const float o0 = glao[(size_t)t * 512 + h * GV + lane], o1 = glao[(size_t)t * 512 + h * GV + 64 + lane];
    float ss = o0 * o0 + o1 * o1;
    for (int o = 32; o > 0; o >>= 1) ss += __shfl_xor(ss, o);
    const float r = rsqrtf(ss * (1.f / GV) + LN_EPS);
    const float g0 = proj[(size_t)t * INW + O_GR + h * GV + lane], g1 = proj[(size_t)t * INW + O_GR + h * GV + 64 + lane];
    y[(size_t)t * D + 512 + h * GV + lane] = o0 * r * g[lane] * siluf(g0);
    y[(size_t)t * D + 512 + h * GV + 64 + lane] = o1 * r * g[64 + lane] * siluf(g1);
}

__device__ __forceinline__ void route_token(const float* logits, const float* __restrict__ rbias, int* top_e, float* top_w, int* top_pos, int* counts, int t, int lane) {
    const float4 lg = ((const float4*)(logits + (size_t)t * NE))[lane];
    const float4 rb = ((const float4*)rbias)[lane];
    float sc[4] = {1.f / (1.f + expf(-lg.x)), 1.f / (1.f + expf(-lg.y)), 1.f / (1.f + expf(-lg.z)), 1.f / (1.f + expf(-lg.w))};
    float bv[4] = {sc[0] + rb.x, sc[1] + rb.y, sc[2] + rb.z, sc[3] + rb.w};
    float m1 = fmaxf(bv[0], bv[1]), m2 = fminf(bv[0], bv[1]);
    { const float a = fmaxf(bv[2], bv[3]), c = fminf(bv[2], bv[3]); const float n1 = fmaxf(m1, a); m2 = fmaxf(fminf(m1, a), fmaxf(m2, c)); m1 = n1; }
    for (int o = 1; o < 8; o <<= 1) { const float p1 = __shfl_xor(m1, o), p2 = __shfl_xor(m2, o); const float n1 = fmaxf(m1, p1); m2 = fmaxf(fminf(m1, p1), fmaxf(m2, p2)); m1 = n1; }
    const float gs = m1 + m2;
    const int myg = lane >> 3;
    int rank = 0;
#pragma unroll
    for (int g2 = 0; g2 < NG; ++g2) { const float og = __shfl(gs, g2 * 8); if (og > gs || (og == gs && g2 < myg)) ++rank; }
    const bool sel = rank < 4;
    float mv[4];
#pragma unroll
    for (int i = 0; i < 4; ++i) mv[i] = sel ? bv[i] : -INFINITY;
    int we[TOPK]; float ws[TOPK]; float wsum = 0.f;
#pragma unroll
    for (int k = 0; k < TOPK; ++k) {
        float bvv = mv[0]; int bi = 0;
#pragma unroll
        for (int i = 1; i < 4; ++i) if (mv[i] > bvv) { bvv = mv[i]; bi = i; }
        int gi = lane * 4 + bi;
        for (int o = 32; o > 0; o >>= 1) { const float ov = __shfl_xor(bvv, o); const int oi = __shfl_xor(gi, o); if (ov > bvv || (ov == bvv && oi < gi)) { bvv = ov; gi = oi; } }
        const int ol = gi >> 2, oi = gi & 3;
        const float s_own = (oi == 0) ? sc[0] : (oi == 1) ? sc[1] : (oi == 2) ? sc[2] : sc[3];
        const float sw = __shfl(s_own, ol);
        if (lane == ol) { if (oi == 0) mv[0] = -INFINITY; else if (oi == 1) mv[1] = -INFINITY; else if (oi == 2) mv[2] = -INFINITY; else mv[3] = -INFINITY; }
        we[k] = gi; ws[k] = sw; wsum += sw;
    }
    if (lane == 0) {
        const float inv = 2.5f / wsum;
#pragma unroll
        for (int k = 0; k < TOPK; ++k) {
            top_e[t * TOPK + k] = we[k]; top_w[t * TOPK + k] = ws[k] * inv;
            top_pos[t * TOPK + k] = atomicAdd(&counts[we[k]], 1);
        }
    }
}

__device__ __forceinline__ void moe_offsets(const int* counts, int* off, int* blk_exp, int* nblk, int lane) {
    int pc[4], st[4]; int tot = 0;
#pragma unroll
    for (int i = 0; i < 4; ++i) { pc[i] = (counts[lane * 4 + i] + PADR - 1) / PADR * PADR; st[i] = tot; tot += pc[i]; }
    int inc = tot;
    for (int o = 1; o < 64; o <<= 1) { const int n = __shfl_up(inc, o); if (lane >= o) inc += n; }
    const int base = inc - tot;
#pragma unroll
    for (int i = 0; i < 4; ++i) { const int start = base + st[i]; off[lane * 4 + i] = start; for (int k = start / PADR; k < (start + pc[i]) / PADR; ++k) blk_exp[k] = lane * 4 + i; }
    if (lane == 63) nblk[0] = inc / PADR;
}

__device__ __forceinline__ void moe_scatter(const int* top_e, const float* top_w, const int* top_pos, const int* off, int* row_tok, float* row_gate, int* slot_of, int a) {
    const int slot = off[top_e[a]] + top_pos[a];
    row_tok[slot] = a / TOPK; row_gate[slot] = top_w[a]; slot_of[a] = slot;
}

__device__ __forceinline__ void moe_hidden(const float* h1, const float* __restrict__ wg, const float* __restrict__ wu, const int* row_tok, const float* row_gate, const int* blk_exp, const int* nblk,
                                           float* hidden, int g16, int j, float* sh) {
    const bool active = g16 * 16 < nblk[0] * PADR;
    float (*xs)[D] = (float (*)[D])sh;
    __syncthreads();
    if (active) for (int r = 0; r < 16; ++r) { const int tok = row_tok[g16 * 16 + r]; ((float4*)xs[r])[j] = ((const float4*)(h1 + (size_t)tok * D))[j]; }
    __syncthreads();
    if (!active) return;
    const int e = blk_exp[(g16 * 16) / PADR];
    float ag[16], au[16];
#pragma unroll
    for (int r = 0; r < 16; ++r) { ag[r] = 0.f; au[r] = 0.f; }
    const float* wgp = wg + (size_t)e * D * ED + j; const float* wup = wu + (size_t)e * D * ED + j;
    for (int d = 0; d < D; d += 4) {
        const float g0 = wgp[(size_t)(d + 0) * ED], g1 = wgp[(size_t)(d + 1) * ED], g2 = wgp[(size_t)(d + 2) * ED], g3 = wgp[(size_t)(d + 3) * ED];
        const float u0 = wup[(size_t)(d + 0) * ED], u1 = wup[(size_t)(d + 1) * ED], u2 = wup[(size_t)(d + 2) * ED], u3 = wup[(size_t)(d + 3) * ED];
#pragma unroll
        for (int r = 0; r < 16; ++r) { const float4 x = *(const float4*)&xs[r][d];
            ag[r] += x.x * g0 + x.y * g1 + x.z * g2 + x.w * g3; au[r] += x.x * u0 + x.y * u1 + x.z * u2 + x.w * u3; }
    }
#pragma unroll
    for (int r = 0; r < 16; ++r) hidden[(size_t)(g16 * 16 + r) * ED + j] = row_gate[g16 * 16 + r] * siluf(ag[r]) * au[r];
}

__device__ __forceinline__ void moe_down(const float* hidden, const float* __restrict__ wd, const int* top_e, const int* slot_of, float* ffn, int t, int i, float* sh) {
    float4 acc = ((float4*)(ffn + (size_t)t * D))[i];
    for (int k = 0; k < TOPK; ++k) {
        const int e = top_e[t * TOPK + k], slot = slot_of[t * TOPK + k];
        __syncthreads();
        sh[i] = hidden[(size_t)slot * ED + i];
        __syncthreads();
        const float4* wp = (const float4*)(wd + (size_t)e * ED * D) + i;
        for (int j = 0; j < ED; ++j) { const float4 w = wp[(size_t)j * (D / 4)]; const float hv = sh[j]; acc.x += hv * w.x; acc.y += hv * w.y; acc.z += hv * w.z; acc.w += hv * w.w; }
    }
    ((float4*)(ffn + (size_t)t * D))[i] = acc;
}
}
#include <hip/hip_bf16.h>
#include <cmath>
namespace attn_body {
using bf16=__hip_bfloat16;
using bf16x8=__attribute__((ext_vector_type(8)))short;
using s16x4=__attribute__((ext_vector_type(4)))short;
using f32x16=__attribute__((ext_vector_type(16)))float;
using u32x4=__attribute__((ext_vector_type(4)))unsigned;
constexpr int BATCH=8,NHEAD=8,SEQ=4096,D=64,DM=3072,OPITCH=1024;
constexpr int NW=8,QBLK=32,QB=QBLK*NW,KVBLK=64,NQB=SEQ/QB;
constexpr int ATTN_PITCH=DM, ATTN_UNIT_ROWS=QB;
__device__ __forceinline__ int crow(int r,int hi){return (r&3)+8*(r>>2)+4*hi;}
#define SBAR() __builtin_amdgcn_sched_barrier(0)
__device__ __forceinline__ void cmask(f32x16&p0,f32x16&p1,int jb,int qrel,int hi){
  const float NEG=-INFINITY; int kb=64*jb+4*hi;
  #pragma unroll
  for(int r=0;r<16;++r){int kv=kb+(r&3)+8*(r>>2); if(kv>qrel)p0[r]=NEG; if(kv+32>qrel)p1[r]=NEG;}
}

constexpr int NSLOT=3, SLOTB=8192;
constexpr int LDS_K=0, LDS_V=NSLOT*SLOTB, LDS_WS=2*NSLOT*SLOTB, LDS_OST=LDS_WS+NW*64*4, LDS_KB=LDS_OST+NW*4096, LDS_BYTES=LDS_KB+(SEQ+2)*8;
constexpr float C2=0.125f*1.4426950408889634f;
__device__ __forceinline__ void glds16(const void*gsrc,unsigned lds_dst){unsigned keep;
  asm volatile("s_mov_b32 %0, m0\n\ts_mov_b32 m0, %2\n\ts_nop 0\n\tglobal_load_lds_dwordx4 %1, off\n\ts_mov_b32 m0, %0":"=&s"(keep):"v"(gsrc),"s"(lds_dst):"memory");}
__device__ __forceinline__ float max3f(float a,float b,float c){float r;asm("v_max3_f32 %0, %1, %2, %3":"=v"(r):"v"(a),"v"(b),"v"(c));return r;}
__device__ __forceinline__ float max2f(float a,float b){float r;asm("v_max_f32_e32 %0, %1, %2":"=v"(r):"v"(a),"v"(b));return r;}
__device__ __forceinline__ float fadd_s(float a,float b){float r;asm("v_add_f32_e32 %0, %1, %2":"=v"(r):"v"(a),"v"(b));return r;}
__device__ __forceinline__ float fsub_s(float a,float b){float r;asm("v_sub_f32_e32 %0, %1, %2":"=v"(r):"v"(a),"v"(b));return r;}
typedef float f32x2_t __attribute__((ext_vector_type(2))); typedef float f32x4_t __attribute__((ext_vector_type(4))); typedef __bf16 bf16x2_t __attribute__((ext_vector_type(2)));
__device__ __forceinline__ unsigned cvtpk_s(float lo,float hi){f32x2_t v={lo,hi};bf16x2_t b=__builtin_convertvector(v,bf16x2_t);return __builtin_bit_cast(unsigned,b);}
#define WAIT_BAR(N) asm volatile("s_waitcnt vmcnt(" #N ") lgkmcnt(0)\n\ts_barrier":::"memory")

__device__ __forceinline__ void split3(float b,unsigned&h,unsigned&m,unsigned&l){
  h=cvtpk_s(b,0.f)&0xffffu; const float r1=b-__uint_as_float(h<<16);
  m=cvtpk_s(r1,0.f)&0xffffu; const float r2=r1-__uint_as_float(m<<16);
  l=cvtpk_s(r2,0.f)&0xffffu; }
__device__ __forceinline__ bf16x8 kbias_frag(float b,int hi){unsigned h,m,l;split3(b,h,m,l);u32x4 w;w.x=h|(m<<16);w.y=l|0x3F800000u;w.z=0x3F803F80u;w.w=0u;if(hi){w.x=0u;w.y=0u;w.z=0u;}return __builtin_bit_cast(bf16x8,w);}
__device__ __forceinline__ bf16x8 qref_frag(float x,int hi){unsigned h,m,l;split3(x,h,m,l);u32x4 w;w.x=0x3F803F80u;w.y=0x3F80u|(h<<16);w.z=m|(l<<16);w.w=0u;if(hi){w.x=0u;w.y=0u;w.z=0u;}return __builtin_bit_cast(bf16x8,w);}
typedef unsigned u32x2_t __attribute__((ext_vector_type(2)));
__device__ __forceinline__ bf16x8 mkfrag(u32x2_t e,unsigned zc){u32x4 w;w.x=e.x;w.y=e.y;w.z=zc;w.w=0u;return __builtin_bit_cast(bf16x8,w);}
__device__ __forceinline__ void fox_bias_table(int b,int h,const float*LF,char*shm){
  int tid_=threadIdx.x; asm volatile("":"+v"(tid_)); const int tid=tid_,lane=tid&63,wid=__builtin_amdgcn_readfirstlane(tid>>6);
  const float*lf=LF+((long)b*NHEAD+h)*SEQ; float*wt=(float*)(shm+LDS_WS); u32x2_t*KB8=(u32x2_t*)(shm+LDS_KB);
  f32x4_t va=*(const f32x4_t*)(lf+8*tid),vb=*(const f32x4_t*)(lf+8*tid+4);
  va[1]+=va[0];va[2]+=va[1];va[3]+=va[2];vb[0]+=va[3];vb[1]+=vb[0];vb[2]+=vb[1];vb[3]+=vb[2];
  const float tot=vb[3]; float inc=tot;
  #pragma unroll
  for(int o_=1;o_<64;o_<<=1){const float nn=__shfl_up(inc,o_);if(lane>=o_)inc+=nn;}
  __syncthreads();
  if(lane==63)wt[wid*64]=inc;
  __syncthreads();
  float base=inc-tot;
  #pragma unroll
  for(int w_=0;w_<NW;++w_){const float x_=wt[w_*64]; if(w_<wid)base+=x_;}
  const float cv[8]={va[0]+base,va[1]+base,va[2]+base,va[3]+base,vb[0]+base,vb[1]+base,vb[2]+base,vb[3]+base};
  #pragma unroll
  for(int j=0;j<8;++j){unsigned hh,mm,ll;split3(-cv[j],hh,mm,ll);KB8[8*tid+j]=(u32x2_t){hh|(mm<<16),ll|0x3F800000u};}
  if(tid==0){KB8[SEQ]=(u32x2_t){0u,0u};KB8[SEQ+1]=(u32x2_t){0u,0u};}
  __syncthreads();
}
__device__ __forceinline__ void qkt(f32x16&p0,f32x16&p1,const char*Kslot,const bf16x8*qr,bf16x8 kb0,bf16x8 kb1,bf16x8 qx,int r32,int hi){
  const f32x16 negm=f32x16{};
  const char*kb=Kslot+hi*1024+r32*16;
  #pragma unroll
  for(int d0=0;d0<4;++d0){
    const bf16x8 b0=*reinterpret_cast<const bf16x8*>(kb+d0*2048);
    const bf16x8 b1=*reinterpret_cast<const bf16x8*>(kb+d0*2048+512);
    if(d0==0){p0=__builtin_amdgcn_mfma_f32_32x32x16_bf16(b0,qr[0],negm,0,0,0);p1=__builtin_amdgcn_mfma_f32_32x32x16_bf16(b1,qr[0],negm,0,0,0);}
    else{p0=__builtin_amdgcn_mfma_f32_32x32x16_bf16(b0,qr[d0],p0,0,0,0);p1=__builtin_amdgcn_mfma_f32_32x32x16_bf16(b1,qr[d0],p1,0,0,0);}}
  p0=__builtin_amdgcn_mfma_f32_32x32x16_bf16(kb0,qx,p0,0,0,0);p1=__builtin_amdgcn_mfma_f32_32x32x16_bf16(kb1,qx,p1,0,0,0);
}
typedef __attribute__((address_space(3))) const char* lds_cptr;
typedef short v4i16_t __attribute__((ext_vector_type(4)));
__device__ __forceinline__ void kload8(bf16x8*kf,lds_cptr kp){
  kf[0]=*(const __attribute__((address_space(3))) bf16x8*)(kp);      kf[1]=*(const __attribute__((address_space(3))) bf16x8*)(kp+512);
  kf[2]=*(const __attribute__((address_space(3))) bf16x8*)(kp+2048); kf[3]=*(const __attribute__((address_space(3))) bf16x8*)(kp+2560);
  kf[4]=*(const __attribute__((address_space(3))) bf16x8*)(kp+4096); kf[5]=*(const __attribute__((address_space(3))) bf16x8*)(kp+4608);
  kf[6]=*(const __attribute__((address_space(3))) bf16x8*)(kp+6144); kf[7]=*(const __attribute__((address_space(3))) bf16x8*)(kp+6656);
}
__device__ __forceinline__ void kload2(bf16x8*kf,lds_cptr kp,int j){ kf[2*j]=*(const __attribute__((address_space(3))) bf16x8*)(kp+j*2048); kf[2*j+1]=*(const __attribute__((address_space(3))) bf16x8*)(kp+j*2048+512); }
__device__ __forceinline__ s16x4 vtr(lds_cptr p){ return __builtin_bit_cast(s16x4,__builtin_amdgcn_ds_read_tr16_b64_v4i16((__attribute__((address_space(3))) v4i16_t*)p)); }
__device__ __forceinline__ float rowmax(const f32x16&p0,const f32x16&p1){
  float a=max3f(p0[0],p0[1],p1[0]),b=max3f(p0[2],p0[3],p1[1]);a=max3f(a,p1[2],p1[3]);
  #pragma unroll
  for(int r=4;r<16;r+=4){a=max3f(a,p0[r],p0[r+1]);b=max3f(b,p0[r+2],p0[r+3]);a=max3f(a,p1[r],p1[r+1]);b=max3f(b,p1[r+2],p1[r+3]);}
  const float m=max2f(a,b);
  auto rr=__builtin_amdgcn_permlane32_swap(__float_as_uint(m),__float_as_uint(m),false,false);
  return max2f(__uint_as_float(rr[0]),__uint_as_float(rr[1]));
}
__device__ __forceinline__ void pv(f32x16*o,int vb,bf16x8 pa0,bf16x8 pa1,bf16x8 pa2,bf16x8 pa3){
  #pragma unroll
  for(int d0=0;d0<2;++d0){s16x4 lo[4],hi[4];
    #pragma unroll
    for(int ks=0;ks<4;++ks){
      asm volatile("ds_read_b64_tr_b16 %0,%1 offset:%c2":"=&v"(lo[ks]):"v"(vb),"i"(d0*4096+ks*1024):"memory");
      asm volatile("ds_read_b64_tr_b16 %0,%1 offset:%c2":"=&v"(hi[ks]):"v"(vb),"i"(d0*4096+ks*1024+512):"memory");}
    asm volatile("s_waitcnt lgkmcnt(0)":::"memory");SBAR();
    #define PK(k) (bf16x8){lo[k][0],lo[k][1],lo[k][2],lo[k][3],hi[k][0],hi[k][1],hi[k][2],hi[k][3]}
    o[d0]=__builtin_amdgcn_mfma_f32_32x32x16_bf16(pa0,PK(0),o[d0],0,0,0);
    o[d0]=__builtin_amdgcn_mfma_f32_32x32x16_bf16(pa1,PK(1),o[d0],0,0,0);
    o[d0]=__builtin_amdgcn_mfma_f32_32x32x16_bf16(pa2,PK(2),o[d0],0,0,0);
    o[d0]=__builtin_amdgcn_mfma_f32_32x32x16_bf16(pa3,PK(3),o[d0],0,0,0);
    #undef PK
  }
}

#ifndef ATTN_STORE16
#define ATTN_STORE16(p,v) (*(u32x4*)(p)=(v))
#endif
template<int THRL> __device__ __forceinline__ void attn_unit(int b,int h,int qb,const bf16*Q,const bf16* K,const bf16* V,bf16*O,const float*LF,char*shm){
  int tid_=threadIdx.x; asm volatile("":"+v"(tid_));
  const int tid=tid_,lane=tid&63,r32=lane&31,hi=lane>>5; const int wid=__builtin_amdgcn_readfirstlane(tid>>6);
  const long rowbase=(long)b*SEQ; const int q0=qb*QB;
  const char*KBt=shm+LDS_KB; const unsigned kb_o0=hi?(unsigned)SEQ*8u:(unsigned)r32*8u, kb_o1=hi?(unsigned)SEQ*8u:(unsigned)(r32+32)*8u, kb_str=hi?0u:512u, zc=hi?0u:0x3F803F80u;
  const bf16*Qw=Q+(rowbase+q0+wid*QBLK)*DM+h*D;
  const bf16*Kh=K+rowbase*DM+h*D,*Vh=V+rowbase*DM+h*D;
  const unsigned lds0=(unsigned)(uintptr_t)shm;
  float*wsf=(float*)(shm+LDS_WS)+wid*64;
  const bf16*ksrc=Kh+(long)lane*DM+wid*8;
  const bf16*vsrc=Vh+(long)(16*(wid&3)+(lane>>2))*DM+(wid>>2)*32+(lane&3)*8;
  const unsigned kdst=lds0+LDS_K+wid*1024, vdst=lds0+LDS_V+wid*1024;
  #define DMA_K(t,slot) glds16(ksrc+(long)(t)*KVBLK*DM,(unsigned)__builtin_amdgcn_readfirstlane(kdst+(slot)))
  #define DMA_V(t,slot) glds16(vsrc+(long)(t)*KVBLK*DM,(unsigned)__builtin_amdgcn_readfirstlane(vdst+(slot)))
  const int vb0=(int)(lds0+LDS_V)+((lane>>4)&1)*32+(lane&3)*8+(4*hi+((lane&15)>>2))*64;
  const char*Kbase=shm+LDS_K; bf16x8 kf[8];
  const lds_cptr shm3=(lds_cptr)shm; const lds_cptr kp0=shm3+LDS_K+hi*1024+r32*16; const lds_cptr vp0=shm3+LDS_V+((lane>>4)&1)*32+(lane&3)*8+(4*hi+((lane&15)>>2))*64;
  const int NT=(q0+QB)/KVBLK;
  DMA_K(0,0);DMA_V(0,0);DMA_K(1,SLOTB);
  bf16x8 qr[4];
  #pragma unroll
  for(int d0=0;d0<4;++d0)qr[d0]=*reinterpret_cast<const bf16x8*>(&Qw[(long)r32*DM+d0*16+hi*8]);
  float mhat; { const u32x2_t eq=*(const u32x2_t*)(KBt+(unsigned)(q0+wid*QBLK+r32)*8u); mhat=__uint_as_float(eq.x<<16)+__uint_as_float(eq.x&0xffff0000u)+__uint_as_float(eq.y<<16); }
  float l_reg=0.f;f32x16 o[2];o[0]=f32x16{};o[1]=f32x16{};const f32x16 negm=f32x16{};
  bf16x8 qx=qref_frag(-mhat,hi);
  const int qrel=wid*QBLK+r32;
  #define CMASK(P0,P1,t) do{int jb_=(t)-(NT-4); if(jb_>=0)cmask(P0,P1,jb_,qrel,hi);}while(0)
  bool resc=false;
  #define START(P0,P1) do{ const float rm=rowmax(P0,P1); resc=false; \
    { const float dl=__builtin_fmaxf(rm,0.f); mhat=fadd_s(mhat,dl); \
      _Pragma("unroll") for(int r=0;r<16;++r){P0[r]=fsub_s(P0[r],dl);P1[r]=fsub_s(P1[r],dl);} \
      qx=qref_frag(-mhat,hi); } \
    _Pragma("unroll") for(int r=0;r<16;++r)P0[r]=__builtin_amdgcn_exp2f(P0[r]); }while(0)
  #define RESC() do{ if(resc){ asm volatile("s_waitcnt lgkmcnt(0)":::"memory"); \
      _Pragma("unroll") for(int d_=0;d_<2;++d_) _Pragma("unroll") for(int r=0;r<16;++r)o[d_][r]*=wsf[crow(r,hi)]; } }while(0)
  f32x16 pA0,pA1,pB0,pB1;
  int sl_prev=0,sl_cur=0,sl_next=SLOTB;
  #define ROT() do{sl_prev=sl_cur;sl_cur=sl_next;sl_next=(sl_next==(NSLOT-1)*SLOTB)?0:sl_next+SLOTB;}while(0)
  DMA_K(2,2*SLOTB);
  WAIT_BAR(3);
  qkt(pA0,pA1,Kbase,qr,mkfrag(*(const u32x2_t*)(KBt+kb_o0),zc),mkfrag(*(const u32x2_t*)(KBt+kb_o1),zc),qx,r32,hi);asm volatile("s_nop 15\n\ts_nop 7":"+v"(pA0),"+v"(pA1));CMASK(pA0,pA1,0);
  START(pA0,pA1);
  _Pragma("unroll") for(int r=0;r<16;++r)pA1[r]=__builtin_amdgcn_exp2f(pA1[r]);
  WAIT_BAR(0);
  DMA_K(3,0);DMA_V(1,SLOTB);
  ROT();
  kload8(kf,kp0+sl_cur);
  WAIT_BAR(2);
  s16x4 vlo[8],vhi[8]; u32x4 pw0,pw1,pw2,pw3;
  #define PKW(P,B) cvtpk_s(P[B],P[B+1])
  #define PAF(k) __builtin_bit_cast(bf16x8,pw##k)
  #define VFR(i) (bf16x8){vlo[i][0],vlo[i][1],vlo[i][2],vlo[i][3],vhi[i][0],vhi[i][1],vhi[i][2],vhi[i][3]}
  #define PIN(x) asm volatile("":"+v"(x))
  #define MX3(a,b,c) __builtin_fmaxf(__builtin_fmaxf((a),(b)),(c))
  #define GAPA(MF,A0,A1,A2,A3,W0,W1,PW) do{ MF; sacc+=A0; sacc+=A1; sacc+=A2; sacc+=A3; PIN(sacc); W0; W1; PIN(PW); SBAR(); }while(0)
  #define EX(v) __builtin_amdgcn_exp2f(v)
  #define GAPB(MF,X,B) do{ MF; X[B]=EX(X[B]); X[B+1]=EX(X[B+1]); X[B+2]=EX(X[B+2]); X[B+3]=EX(X[B+3]); PIN(X); SBAR(); }while(0)
  #define VRD(i) do{ vlo[i]=vtr(vp_+(((i)>>2)*4096+((i)&3)*1024)); vhi[i]=vtr(vp_+(((i)>>2)*4096+((i)&3)*1024+512)); }while(0)
  #define KRD(G,j) do{ if(G){ kload2(kf,kp0+sl_next,j); SBAR(); } }while(0)
  #define STEP(C0,C1,P0,P1,t,GK,GV,GL) do{ SBAR(); \
    const lds_cptr vp_=vp0+sl_prev; const u32x2_t e0_=*(const u32x2_t*)(KBt+kb_o0+(unsigned)(t)*kb_str),e1_=*(const u32x2_t*)(KBt+kb_o1+(unsigned)(t)*kb_str); \
    VRD(0); SBAR(); float sacc=(P0[0]+P0[1]); \
    GAPA(C0=__builtin_amdgcn_mfma_f32_32x32x16_bf16(kf[0],qr[0],negm,0,0,0), P0[2],P0[3],P0[4],P0[5],     pw0[0]=PKW(P0,0), pw0[1]=PKW(P0,2), pw0); \
    VRD(4); SBAR(); GAPA(C1=__builtin_amdgcn_mfma_f32_32x32x16_bf16(kf[1],qr[0],negm,0,0,0), P0[6],P0[7],P0[8],P0[9],     pw0[2]=PKW(P0,4), pw0[3]=PKW(P0,6), pw0); \
    VRD(1); SBAR(); GAPA(C0=__builtin_amdgcn_mfma_f32_32x32x16_bf16(kf[2],qr[1],C0,0,0,0),   P0[10],P0[11],P0[12],P0[13], pw1[0]=PKW(P0,8), pw1[1]=PKW(P0,10), pw1); \
    VRD(5); SBAR(); GAPA(C1=__builtin_amdgcn_mfma_f32_32x32x16_bf16(kf[3],qr[1],C1,0,0,0),   P0[14],P0[15],P1[0],P1[1],   pw1[2]=PKW(P0,12),pw1[3]=PKW(P0,14), pw1); \
    VRD(2); SBAR(); GAPA(C0=__builtin_amdgcn_mfma_f32_32x32x16_bf16(kf[4],qr[2],C0,0,0,0),   P1[2],P1[3],P1[4],P1[5],     pw2[0]=PKW(P1,0), pw2[1]=PKW(P1,2), pw2); \
    VRD(6); SBAR(); GAPA(C1=__builtin_amdgcn_mfma_f32_32x32x16_bf16(kf[5],qr[2],C1,0,0,0),   P1[6],P1[7],P1[8],P1[9],     pw2[2]=PKW(P1,4), pw2[3]=PKW(P1,6), pw2); \
    VRD(3); SBAR(); GAPA(C0=__builtin_amdgcn_mfma_f32_32x32x16_bf16(kf[6],qr[3],C0,0,0,0),   P1[10],P1[11],P1[12],P1[13], pw3[0]=PKW(P1,8), pw3[1]=PKW(P1,10), pw3); \
    VRD(7); SBAR(); GAPA(C1=__builtin_amdgcn_mfma_f32_32x32x16_bf16(kf[7],qr[3],C1,0,0,0),   P1[14],P1[15],0.f,0.f,       pw3[2]=PKW(P1,12),pw3[3]=PKW(P1,14), pw3); \
    { const bf16x8 kb0_=mkfrag(e0_,zc),kb1_=mkfrag(e1_,zc); C0=__builtin_amdgcn_mfma_f32_32x32x16_bf16(kb0_,qx,C0,0,0,0); C1=__builtin_amdgcn_mfma_f32_32x32x16_bf16(kb1_,qx,C1,0,0,0); } SBAR(); \
    l_reg+=sacc; \
    if(GK){DMA_K((t)+3,sl_cur);} if(GV){DMA_V((t)+1,sl_next);} \
    CMASK(C0,C1,t); \
    { float a=MX3(C0[0],C0[1],C1[0]),b=MX3(C0[2],C0[3],C1[1]); a=MX3(a,C1[2],C1[3]); \
      _Pragma("unroll") for(int r=4;r<16;r+=4){a=MX3(a,C0[r],C0[r+1]);b=MX3(b,C0[r+2],C0[r+3]);a=MX3(a,C1[r],C1[r+1]);b=MX3(b,C1[r+2],C1[r+3]);} \
      float rm=__builtin_fmaxf(a,b); { auto rr=__builtin_amdgcn_permlane32_swap(__float_as_uint(rm),__float_as_uint(rm),false,false); rm=__builtin_fmaxf(__uint_as_float(rr[0]),__uint_as_float(rr[1])); } \
      resc=false; \
      if(__builtin_expect(__any(rm>(float)THRL),0)){ const float dl=__builtin_fmaxf(rm,0.f); mhat+=dl; \
        _Pragma("unroll") for(int r=0;r<16;++r){C0[r]-=dl;C1[r]-=dl;} \
        qx=qref_frag(-mhat,hi); \
        const float f=__builtin_amdgcn_exp2f(-dl); l_reg*=f; if(hi==0)wsf[r32]=f; resc=true; } } \
    SBAR(); \
    GAPB(o[0]=__builtin_amdgcn_mfma_f32_32x32x16_bf16(PAF(0),VFR(0),o[0],0,0,0), C0,0); \
    GAPB(o[1]=__builtin_amdgcn_mfma_f32_32x32x16_bf16(PAF(0),VFR(4),o[1],0,0,0), C0,4); \
    KRD(GL,0); GAPB(o[0]=__builtin_amdgcn_mfma_f32_32x32x16_bf16(PAF(1),VFR(1),o[0],0,0,0), C0,8); \
    KRD(GL,1); GAPB(o[1]=__builtin_amdgcn_mfma_f32_32x32x16_bf16(PAF(1),VFR(5),o[1],0,0,0), C0,12); \
    KRD(GL,2); GAPB(o[0]=__builtin_amdgcn_mfma_f32_32x32x16_bf16(PAF(2),VFR(2),o[0],0,0,0), C1,0); \
    KRD(GL,3); GAPB(o[1]=__builtin_amdgcn_mfma_f32_32x32x16_bf16(PAF(2),VFR(6),o[1],0,0,0), C1,4); \
    GAPB(o[0]=__builtin_amdgcn_mfma_f32_32x32x16_bf16(PAF(3),VFR(3),o[0],0,0,0), C1,8); \
    GAPB(o[1]=__builtin_amdgcn_mfma_f32_32x32x16_bf16(PAF(3),VFR(7),o[1],0,0,0), C1,12); \
    }while(0)
  int t=1;
  #undef CMASK
  #define CMASK(P0,P1,t) do{}while(0)
  for(;t+5<NT;t+=2){
    STEP(pB0,pB1,pA0,pA1,t,true,true,true);     WAIT_BAR(2); RESC(); ROT();
    STEP(pA0,pA1,pB0,pB1,t+1,true,true,true);   WAIT_BAR(2); RESC(); ROT();
  }
  #undef CMASK
  #define CMASK(P0,P1,t) do{int jb_=(t)-(NT-4); if(jb_>=0)cmask(P0,P1,jb_,qrel,hi);}while(0)
  #define ENDW(tt) do{ if((tt)+3<NT){WAIT_BAR(2);} else if((tt)+2<NT){WAIT_BAR(1);} else {WAIT_BAR(0);} }while(0)
  for(;t+1<NT;t+=2){
    STEP(pB0,pB1,pA0,pA1,t,(t+3<NT),(t+1<NT),(t+1<NT));       ENDW(t);   RESC(); ROT();
    STEP(pA0,pA1,pB0,pB1,t+1,(t+4<NT),(t+2<NT),(t+2<NT));     ENDW(t+1); RESC(); ROT();
  }
  STEP(pB0,pB1,pA0,pA1,NT-1,false,false,false); RESC();
  { float sacc=pB0[0]+pB0[1]; _Pragma("unroll") for(int r=2;r<16;++r)sacc+=pB0[r]; _Pragma("unroll") for(int r=0;r<16;++r)sacc+=pB1[r]; l_reg+=sacc;
    pw0=(u32x4){PKW(pB0,0),PKW(pB0,2),PKW(pB0,4),PKW(pB0,6)};pw1=(u32x4){PKW(pB0,8),PKW(pB0,10),PKW(pB0,12),PKW(pB0,14)};pw2=(u32x4){PKW(pB1,0),PKW(pB1,2),PKW(pB1,4),PKW(pB1,6)};pw3=(u32x4){PKW(pB1,8),PKW(pB1,10),PKW(pB1,12),PKW(pB1,14)};
    SBAR(); pv(o,vb0+sl_cur,PAF(0),PAF(1),PAF(2),PAF(3)); }
  #undef PKW
  #undef PAF
  #undef VFR
  #undef PIN
  #undef MX3
  #undef GAPA
  #undef GAPB
  #undef EX
  #undef VRD
  #undef KRD
  #undef STEP
  #undef ENDW
  {auto rr=__builtin_amdgcn_permlane32_swap(__float_as_uint(l_reg),__float_as_uint(l_reg),false,false);l_reg=__uint_as_float(rr[0])+__uint_as_float(rr[1]);}
  if(hi==0)wsf[32+r32]=l_reg;asm volatile("s_waitcnt lgkmcnt(0)":::"memory");
  float rli[16];
  #pragma unroll
  for(int r=0;r<16;++r)rli[r]=__builtin_amdgcn_rcpf(wsf[32+crow(r,hi)]);
  bf16*Ow=O+(rowbase+q0+wid*QBLK)*OPITCH+h*D;
  { bf16*stg=(bf16*)(shm+LDS_OST)+wid*2048;
    #pragma unroll
    for(int r=0;r<16;++r){const int orow=crow(r,hi);
      #pragma unroll
      for(int d0=0;d0<2;++d0)stg[orow*64+d0*32+r32]=__float2bfloat16(o[d0][r]*rli[r]);}
    asm volatile("s_waitcnt lgkmcnt(0)":::"memory");
    #pragma unroll
    for(int i=0;i<4;++i){const int row=i*8+(lane>>3),ch=lane&7; const u32x4 v=*(const u32x4*)(stg+row*64+ch*8); ATTN_STORE16(Ow+(long)row*OPITCH+ch*8,v);} }
  asm volatile("s_waitcnt lgkmcnt(0)\n\ts_barrier":::"memory");
  #undef DMA_K
  #undef DMA_V
  #undef CMASK
  #undef START
  #undef RESC
  #undef ROT
}
constexpr int ATTN_LDS_BYTES=LDS_BYTES;
struct AttnTensors { const bf16* Q; const bf16* K; const bf16* V; bf16* O; const float* LF; };
struct AttnUnit { int bh; int qb; };
struct StaticOrder {
  int vcu,grid;
  __device__ __forceinline__ explicit StaticOrder(int grid_,int block):vcu((grid_%8==0)?(block%8)*(grid_/8)+block/8:block),grid(grid_){}
  __device__ __forceinline__ bool next(int i,AttnUnit&u)const{
    if(grid==256){ if(i>=4)return false; const int s=vcu&3; u.bh=vcu>>2; u.qb=(i==0)?s:(i==1)?7-s:(i==2)?8+s:15-s; return true; }
    const int L=i*grid+vcu; if(L>=BATCH*NHEAD*NQB)return false; u.bh=L/NQB; u.qb=L%NQB; return true; }
  __device__ __forceinline__ void a_ready(const AttnUnit&)const{}
  __device__ __forceinline__ void done(const AttnUnit&)const{}
};
template<class Sched,int THRL=8> __device__ __forceinline__ void attn_phase(char*lds,const AttnTensors&T,const Sched&S){
  AttnUnit u; int cur_bh=-1;
  for(int i=0;S.next(i,u);++i){ S.a_ready(u); if(u.bh!=cur_bh){ fox_bias_table(u.bh/NHEAD,u.bh%NHEAD,T.LF,lds); cur_bh=u.bh; }
    attn_unit<THRL>(u.bh/NHEAD,u.bh%NHEAD,u.qb,T.Q,T.K,T.V,T.O,T.LF,lds); S.done(u); }
}
#undef SBAR
#undef WAIT_BAR
}
namespace fx {
using namespace nv;
typedef unsigned short bf16;
typedef unsigned v4u __attribute__((ext_vector_type(4)));
typedef float f32x4 __attribute__((ext_vector_type(4)));
constexpr float C2 = 0.125f * 1.4426950408889634f;
constexpr int NIN = 3328;
constexpr int QKVP = 3072;
constexpr int P_FQ = 0, P_FK = 512, P_FV = 1024, P_GQ = 1536, P_GK = 1792, P_GV = 2048, P_GR = 2560;
__device__ __forceinline__ int inproj_src(int d) {
    if (d < 1536) return d;
    if (d < 1792) return O_GQ + (d - 1536);
    if (d < 2048) return O_GK + (d - 1792);
    if (d < 2560) return O_GV + (d - 2048);
    if (d < 3072) return O_GR + (d - 2560);
    if (d < 3080) return O_FF + (d - 3072);
    if (d < 3096) return O_GA + (d - 3080);
    return -1;
}
__device__ __forceinline__ unsigned f2bf(float f) { unsigned u = __builtin_bit_cast(unsigned, f); return (u + 0x7fffu + ((u >> 16) & 1u)) >> 16; }
__device__ __forceinline__ unsigned pk2(float lo, float hi) { return f2bf(lo) | (f2bf(hi) << 16); }
__device__ __forceinline__ float bf2f(unsigned short h) { return __builtin_bit_cast(float, (unsigned)h << 16); }
__device__ __forceinline__ float wave_sum(float v) {
#pragma unroll
    for (int o = 1; o < 64; o <<= 1) v += __shfl_xor(v, o);
    return v;
}
#define FX_LDS_WAIT() asm volatile("s_waitcnt lgkmcnt(0)" ::: "memory")

template <class Map> __device__ __forceinline__ void transpose_item(const float* __restrict__ W, int K, int N, bf16* WT, LAS float* scr, int kb, int nb, int lane, Map srcmap) {
    const int k0 = 64 * kb, n0 = 32 * nb;
    const int src = srcmap(n0 + (lane & 31));
#pragma unroll 8
    for (int i = 0; i < 32; ++i) { const int kk = 2 * i + (lane >> 5); scr[kk * 33 + (lane & 31)] = (src >= 0) ? W[(size_t)(k0 + kk) * N + src] : 0.f; }
    FX_LDS_WAIT(); asm volatile("" ::: "memory");
    const int c = lane & 7;
#pragma unroll
    for (int j = 0; j < 4; ++j) { const int n = (lane >> 3) + 8 * j; const LAS float* s = scr + (8 * c) * 33 + n;
        v4u o; o.x = pk2(s[0 * 33], s[1 * 33]); o.y = pk2(s[2 * 33], s[3 * 33]); o.z = pk2(s[4 * 33], s[5 * 33]); o.w = pk2(s[6 * 33], s[7 * 33]);
        *(GAS v4u*)(WT + (size_t)(n0 + n) * K + k0 + 8 * c) = o; }
    FX_LDS_WAIT(); asm volatile("" ::: "memory");
}

__device__ __forceinline__ void ln_row_bf16(const float* xrow, const float* __restrict__ g, const float* __restrict__ b, bf16* orow, float* frow, float* st, int lane) {
    const GAS f32x4* xr = (const GAS f32x4*)xrow + lane;
    f32x4 v[4]; float s = 0.f;
#pragma unroll
    for (int j = 0; j < 4; ++j) { v[j] = xr[64 * j]; s += (v[j].x + v[j].y) + (v[j].z + v[j].w); }
    const float mean = wave_sum(s) * (1.f / D); float s2 = 0.f;
#pragma unroll
    for (int j = 0; j < 4; ++j) { v[j] = v[j] - mean; s2 += (v[j].x * v[j].x + v[j].y * v[j].y) + (v[j].z * v[j].z + v[j].w * v[j].w); }
    const float rstd = 1.f / sqrtf(wave_sum(s2) * (1.f / D) + LN_EPS);
    if (st && lane == 0) { st[0] = mean; st[1] = rstd; }
    GAS unsigned long long* o8 = (GAS unsigned long long*)orow + lane;
#pragma unroll
    for (int j = 0; j < 4; ++j) {
        const f32x4 gg = ((const f32x4*)g)[lane + 64 * j], bb = ((const f32x4*)b)[lane + 64 * j];
        const f32x4 o = v[j] * rstd * gg + bb;
        o8[64 * j] = (unsigned long long)pk2(o.x, o.y) | ((unsigned long long)pk2(o.z, o.w) << 32);
        if (frow) ((GAS f32x4*)frow)[lane + 64 * j] = o;
    }
}

struct CvItem { const float* W; bf16* WT; int N, K, k0, n0, s0; };
__device__ __forceinline__ void cv_load(const CvItem& it, f32x4 (&v)[8], int lane) {
    const float* p = it.W + (size_t)(it.k0 + (lane >> 3)) * it.N + it.s0 + 4 * (lane & 7);
#pragma unroll
    for (int i = 0; i < 8; ++i) v[i] = __builtin_nontemporal_load((const f32x4*)(p + (size_t)(8 * i) * it.N));
}
__device__ __forceinline__ void cv_finish(const CvItem& it, const f32x4 (&v)[8], LAS float* scr, int lane) {
    const int rr = lane >> 3, cq = lane & 7;
#pragma unroll
    for (int i = 0; i < 8; ++i) { LAS float* d = scr + (8 * i + rr) * 33 + 4 * cq; d[0] = v[i][0]; d[1] = v[i][1]; d[2] = v[i][2]; d[3] = v[i][3]; }
    FX_LDS_WAIT(); asm volatile("" ::: "memory");
    const int c = lane & 7;
#pragma unroll
    for (int j = 0; j < 4; ++j) { const int n = (lane >> 3) + 8 * j; const LAS float* s = scr + (8 * c) * 33 + n;
        v4u o; o.x = pk2(s[0 * 33], s[1 * 33]); o.y = pk2(s[2 * 33], s[3 * 33]); o.z = pk2(s[4 * 33], s[5 * 33]); o.w = pk2(s[6 * 33], s[7 * 33]);
        __builtin_nontemporal_store(o, (GAS v4u*)(it.WT + (size_t)(it.n0 + n) * it.K + it.k0 + 8 * c)); }
    FX_LDS_WAIT(); asm volatile("" ::: "memory");
}

template <int NR> __device__ __forceinline__ void ln_rows_bf16(const float* xrows, const float* __restrict__ g, const float* __restrict__ b, bf16* orows, int lane) {
    f32x4 v[NR][4];
#pragma unroll
    for (int r = 0; r < NR; ++r)
#pragma unroll
        for (int j = 0; j < 4; ++j) v[r][j] = ((const GAS f32x4*)(xrows + (size_t)r * D))[lane + 64 * j];
    f32x4 gg[4], bb[4];
#pragma unroll
    for (int j = 0; j < 4; ++j) { gg[j] = ((const f32x4*)g)[lane + 64 * j]; bb[j] = ((const f32x4*)b)[lane + 64 * j]; }
#pragma unroll
    for (int r = 0; r < NR; ++r) {
        float s = 0.f;
#pragma unroll
        for (int j = 0; j < 4; ++j) s += (v[r][j].x + v[r][j].y) + (v[r][j].z + v[r][j].w);
        const float mean = wave_sum(s) * (1.f / D); float s2 = 0.f;
#pragma unroll
        for (int j = 0; j < 4; ++j) { v[r][j] = v[r][j] - mean; s2 += (v[r][j].x * v[r][j].x + v[r][j].y * v[r][j].y) + (v[r][j].z * v[r][j].z + v[r][j].w * v[r][j].w); }
        const float rstd = 1.f / sqrtf(wave_sum(s2) * (1.f / D) + LN_EPS);
        GAS unsigned long long* o8 = (GAS unsigned long long*)(orows + (size_t)r * D) + lane;
#pragma unroll
        for (int j = 0; j < 4; ++j) { const f32x4 o = v[r][j] * rstd * gg[j] + bb[j];
            o8[64 * j] = (unsigned long long)pk2(o.x, o.y) | ((unsigned long long)pk2(o.z, o.w) << 32); }
    }
}

template <int NR> __device__ __forceinline__ void ln1_rows_bf16(const float* xrows, const float* st, const float* __restrict__ gi, const float* __restrict__ bi, const bf16* mixrows,
                                                               const float* __restrict__ g1, const float* __restrict__ b1, bf16* orows, float alpha, int lane) {
    f32x4 v[NR][4]; unsigned long long mx[NR][4]; float mean0[NR], rstd0[NR];
#pragma unroll
    for (int r = 0; r < NR; ++r) { mean0[r] = st[2 * r]; rstd0[r] = st[2 * r + 1];
#pragma unroll
        for (int j = 0; j < 4; ++j) { v[r][j] = ((const GAS f32x4*)(xrows + (size_t)r * D))[lane + 64 * j]; mx[r][j] = ((const GAS unsigned long long*)(mixrows + (size_t)r * D))[lane + 64 * j]; } }
    f32x4 gi4[4], bi4[4];
#pragma unroll
    for (int j = 0; j < 4; ++j) { gi4[j] = ((const f32x4*)gi)[lane + 64 * j] * alpha; bi4[j] = ((const f32x4*)bi)[lane + 64 * j] * alpha; }
#pragma unroll
    for (int r = 0; r < NR; ++r) {
        float s = 0.f;
#pragma unroll
        for (int j = 0; j < 4; ++j) { const unsigned lo = (unsigned)mx[r][j], hi = (unsigned)(mx[r][j] >> 32);
            f32x4 mv; mv.x = __builtin_bit_cast(float, lo << 16); mv.y = __builtin_bit_cast(float, lo & 0xffff0000u); mv.z = __builtin_bit_cast(float, hi << 16); mv.w = __builtin_bit_cast(float, hi & 0xffff0000u);
            v[r][j] = ((v[r][j] - mean0[r]) * rstd0[r]) * gi4[j] + bi4[j] + mv;
            s += (v[r][j].x + v[r][j].y) + (v[r][j].z + v[r][j].w); }
        const float mean = wave_sum(s) * (1.f / D); float s2 = 0.f;
#pragma unroll
        for (int j = 0; j < 4; ++j) { v[r][j] = v[r][j] - mean; s2 += (v[r][j].x * v[r][j].x + v[r][j].y * v[r][j].y) + (v[r][j].z * v[r][j].z + v[r][j].w * v[r][j].w); }
        const float rstd = 1.f / sqrtf(wave_sum(s2) * (1.f / D) + LN_EPS);
        GAS unsigned long long* o8 = (GAS unsigned long long*)(orows + (size_t)r * D) + lane;
#pragma unroll
        for (int j = 0; j < 4; ++j) { const f32x4 gg = ((const f32x4*)g1)[lane + 64 * j], bb = ((const f32x4*)b1)[lane + 64 * j]; const f32x4 o = v[r][j] * rstd * gg + bb;
            o8[64 * j] = (unsigned long long)pk2(o.x, o.y) | ((unsigned long long)pk2(o.z, o.w) << 32); }
    }
}
}

namespace pg8 {
struct EpiInProj {
    static constexpr bool PERM = true, AFTER_DRAIN = false;
    bf16_t* QKV; float* FG; float* LF; const float* bfg;
    __device__ __forceinline__ void operator()(const f32x4 (&acc)[2][2][4][2], const Unit& u, int wr, int wc, int fr, int fq) const {
        const int row0 = u.pm * BM + wr * 64 + fr;
        if (u.pn < 12) {
            const float sc = (u.pn < 2) ? fx::C2 : 1.f;
            const int col0 = u.pn * BM + wc * 32 + 8 * fq;
#pragma unroll
            for (int ai = 0; ai < 2; ++ai)
#pragma unroll
                for (int m = 0; m < 4; ++m) { bf16_t* rowp = QKV + (size_t)(row0 + ai * HALF + m * 16) * fx::QKVP + col0;
#pragma unroll
                    for (int bj = 0; bj < 2; ++bj) { const f32x4 v0 = acc[ai][bj][m][0] * sc, v1 = acc[ai][bj][m][1] * sc;
                        u32x4 w; w.x = cvt_pk_bf16(v0[0], v0[1]); w.y = cvt_pk_bf16(v0[2], v0[3]); w.z = cvt_pk_bf16(v1[0], v1[1]); w.w = cvt_pk_bf16(v1[2], v1[3]);
                        *(u32x4*)(rowp + bj * HALF) = w; } }
        } else if (wc == 0 && fq < 3) {
#pragma unroll
            for (int ai = 0; ai < 2; ++ai)
#pragma unroll
                for (int m = 0; m < 4; ++m) { const int row = row0 + ai * HALF + m * 16; float* p = FG + (size_t)row * 32 + 8 * fq;
                    *(f32x4*)p = acc[ai][0][m][0]; *(f32x4*)(p + 4) = acc[ai][0][m][1];
                    if (fq == 0) { const int b = row >> 12, s = row & 4095;
#pragma unroll
                        for (int n = 0; n < 2; ++n)
#pragma unroll
                            for (int i = 0; i < 4; ++i) { const int h = 4 * n + i; LF[(size_t)(b * 8 + h) * nv::S + s] = 1.4426950408889634f * nv::logsigmoidf(acc[ai][0][m][n][i] + bfg[h]); } } }
        }
    }
};
}
namespace gl {
using namespace nv;
typedef unsigned short bf16;
typedef short bf16x8 __attribute__((ext_vector_type(8)));
typedef float f32x4 __attribute__((ext_vector_type(4)));
typedef unsigned u32x4 __attribute__((ext_vector_type(4)));
typedef unsigned u32x2 __attribute__((ext_vector_type(2)));
constexpr int NCH = S / 64;
constexpr int NUNIT = B * GH * NCH;
constexpr int LS = 72;
constexpr int L_WGU = 0, L_BG = 4096, L_QP = 8192, L_KP = L_QP + 64 * LS * 2, L_KPT = L_KP + 64 * LS * 2, L_VT = L_KPT + 64 * LS * 2, L_PP = L_VT + 128 * LS * 2, L_WT = L_PP + 64 * LS * 2, L_END = L_WT + 2048;
static_assert(L_END <= 131072, "gla prep LDS");
constexpr int C_ST = 0, C_PART = 128 * LS * 2, C_END = C_PART + 2 * 8 * 64 * 4;
constexpr size_t QPG_B = 64 * 64 * 2, OI_B = 8 * 4 * 64 * 16, UU_B = OI_B, DEC_B = 256;

__device__ __forceinline__ unsigned pkbf(float lo, float hi) { typedef float f2 __attribute__((ext_vector_type(2))); typedef __bf16 b2 __attribute__((ext_vector_type(2))); f2 v = {lo, hi}; b2 r = __builtin_convertvector(v, b2); return __builtin_bit_cast(unsigned, r); }
__device__ __forceinline__ float bf2f(unsigned short h) { return __builtin_bit_cast(float, (unsigned)h << 16); }
__device__ __forceinline__ float bflo(unsigned w) { return __builtin_bit_cast(float, w << 16); }
__device__ __forceinline__ float bfhi(unsigned w) { return __builtin_bit_cast(float, w & 0xffff0000u); }
__device__ __forceinline__ float fast_logsig2(float x) { return -__builtin_amdgcn_logf(1.f + __builtin_amdgcn_exp2f(-1.4426950408889634f * x)); }

__device__ __forceinline__ void prep_unit(int unit, const bf16* QKV, const float* FG, const float* __restrict__ wgu, const float* __restrict__ bgate,
                                          unsigned char* QPG, unsigned char* OI, unsigned char* UU, float* DEC, unsigned char* lds, int& cur_h) {
    int tid_ = threadIdx.x; asm volatile("" : "+v"(tid_));
    const int tid = tid_, lane = tid & 63, wid = __builtin_amdgcn_readfirstlane(tid >> 6), l15 = lane & 15, g = lane >> 4;
    const int n = unit % NCH, bh = unit / NCH, h = bh % GH, b = bh / GH;
    const size_t row0 = (size_t)b * S + (size_t)n * 64;
    float* WGU = (float*)(lds + L_WGU); float* BG = (float*)(lds + L_BG); float* WT = (float*)(lds + L_WT);
    bf16* QP = (bf16*)(lds + L_QP); bf16* KP = (bf16*)(lds + L_KP); bf16* KPT = (bf16*)(lds + L_KPT); bf16* VT = (bf16*)(lds + L_VT); bf16* PP = (bf16*)(lds + L_PP);
    if (cur_h != h) { __syncthreads(); for (int i = tid; i < 16 * 64; i += 512) WGU[i] = wgu[(i >> 6) * 256 + h * 64 + (i & 63)]; if (tid < 64) BG[tid] = bgate[h * 64 + tid]; cur_h = h; __syncthreads(); }
    const int t = tid >> 3, oc = tid & 7, d0 = oc * 8;
    float la[8];
    { const float* gp = FG + (row0 + t) * 32 + 8;
      f32x4 ga4[4];
#pragma unroll
      for (int i = 0; i < 4; ++i) ga4[i] = *(const f32x4*)(gp + 4 * i);
#pragma unroll
      for (int j = 0; j < 8; ++j) la[j] = BG[d0 + j];
#pragma unroll
      for (int r = 0; r < 16; ++r) { const float gv = ga4[r >> 2][r & 3]; const f32x4 w0 = *(const f32x4*)(WGU + r * 64 + d0), w1 = *(const f32x4*)(WGU + r * 64 + d0 + 4);
#pragma unroll
          for (int j = 0; j < 4; ++j) { la[j] += gv * w0[j]; la[4 + j] += gv * w1[j]; } }
#pragma unroll
      for (int j = 0; j < 8; ++j) la[j] = fast_logsig2(la[j]) * (1.f / 16.f); }
    const u32x4 qv = *(const u32x4*)(QKV + (row0 + t) * fx::QKVP + fx::P_GQ + h * 64 + d0);
    const u32x4 kv = *(const u32x4*)(QKV + (row0 + t) * fx::QKVP + fx::P_GK + h * 64 + d0);
    const u32x4 vv0 = *(const u32x4*)(QKV + (row0 + t) * fx::QKVP + fx::P_GV + h * 128 + oc * 16);
    const u32x4 vv1 = *(const u32x4*)(QKV + (row0 + t) * fx::QKVP + fx::P_GV + h * 128 + oc * 16 + 8);
#pragma unroll
    for (int off = 8; off < 64; off <<= 1) {
#pragma unroll
        for (int j = 0; j < 8; ++j) { const float o = __shfl_up(la[j], off); if (lane >= off) la[j] += o; } }
    if (lane >= 56) {
#pragma unroll
        for (int j = 0; j < 8; ++j) WT[wid * 64 + d0 + j] = la[j]; }
    __syncthreads();
    float bl[8];
#pragma unroll
    for (int j = 0; j < 8; ++j) bl[j] = 0.f;
#pragma unroll
    for (int w = 0; w < 8; ++w) {
        const f32x4 a0 = *(const f32x4*)(WT + w * 64 + d0), a1 = *(const f32x4*)(WT + w * 64 + d0 + 4);
#pragma unroll
        for (int j = 0; j < 4; ++j) { bl[j] += a0[j]; bl[4 + j] += a1[j]; if (w < wid) { la[j] += a0[j]; la[4 + j] += a1[j]; } } }
    {
        const unsigned qw[4] = {qv.x, qv.y, qv.z, qv.w}, kw[4] = {kv.x, kv.y, kv.z, kv.w};
        float qf[8], kf[8];
#pragma unroll
        for (int i = 0; i < 4; ++i) { qf[2 * i] = bflo(qw[i]); qf[2 * i + 1] = bfhi(qw[i]); kf[2 * i] = bflo(kw[i]); kf[2 * i + 1] = bfhi(kw[i]); }
        float qp[8], kp[8], kpp[8];
#pragma unroll
        for (int j = 0; j < 8; ++j) { const float bb = la[j], bbl = bl[j];
            qp[j] = qf[j] * (0.125f * __builtin_amdgcn_exp2f(bb)); kp[j] = kf[j] * __builtin_amdgcn_exp2f(-bb); kpp[j] = kf[j] * __builtin_amdgcn_exp2f(bbl - bb); }
        u32x4 qo, ko; qo.x = pkbf(qp[0], qp[1]); qo.y = pkbf(qp[2], qp[3]); qo.z = pkbf(qp[4], qp[5]); qo.w = pkbf(qp[6], qp[7]);
        ko.x = pkbf(kp[0], kp[1]); ko.y = pkbf(kp[2], kp[3]); ko.z = pkbf(kp[4], kp[5]); ko.w = pkbf(kp[6], kp[7]);
        *(u32x4*)(QP + t * LS + d0) = qo; *(u32x4*)(KP + t * LS + d0) = ko;
        *(u32x4*)(QPG + (size_t)unit * QPG_B + (size_t)(t * 64 + d0) * 2) = qo;
#pragma unroll
        for (int j = 0; j < 8; ++j) KPT[(d0 + j) * LS + t] = (bf16)(pkbf(kpp[j], 0.f) & 0xffffu);
        const unsigned vw[8] = {vv0.x, vv0.y, vv0.z, vv0.w, vv1.x, vv1.y, vv1.z, vv1.w};
#pragma unroll
        for (int i = 0; i < 8; ++i) { VT[(oc * 16 + 2 * i) * LS + t] = (bf16)(vw[i] & 0xffffu); VT[(oc * 16 + 2 * i + 1) * LS + t] = (bf16)(vw[i] >> 16); }
        if (t == 0) {
#pragma unroll
            for (int j = 0; j < 8; ++j) DEC[(size_t)unit * 64 + d0 + j] = __builtin_amdgcn_exp2f(bl[j]); }
    }
    __syncthreads();
    { const int ti = wid >> 1;
#pragma unroll
      for (int q2 = 0; q2 < 2; ++q2) { const int sj = 2 * (wid & 1) + q2;
          f32x4 acc = {0.f, 0.f, 0.f, 0.f};
          if (sj <= ti) {
#pragma unroll
              for (int ks = 0; ks < 2; ++ks) { const bf16x8 a = *(const bf16x8*)(QP + (16 * ti + l15) * LS + 32 * ks + 8 * g), bb = *(const bf16x8*)(KP + (16 * sj + l15) * LS + 32 * ks + 8 * g);
                  acc = __builtin_amdgcn_mfma_f32_16x16x32_bf16(a, bb, acc, 0, 0, 0); }
              if (sj == ti) {
#pragma unroll
                  for (int r = 0; r < 4; ++r) if (l15 > 4 * g + r) acc[r] = 0.f; }
          }
#pragma unroll
          for (int r = 0; r < 4; ++r) PP[(16 * ti + 4 * g + r) * LS + 16 * sj + l15] = (bf16)(pkbf(acc[r], 0.f) & 0xffffu);
      } }
    __syncthreads();
    { bf16x8 vb[2];
#pragma unroll
      for (int ks = 0; ks < 2; ++ks) vb[ks] = *(const bf16x8*)(VT + (16 * wid + l15) * LS + 32 * ks + 8 * g);
#pragma unroll
      for (int m = 0; m < 4; ++m) { f32x4 acc = {0.f, 0.f, 0.f, 0.f};
#pragma unroll
          for (int ks = 0; ks < 2; ++ks) { const bf16x8 a = *(const bf16x8*)(PP + (16 * m + l15) * LS + 32 * ks + 8 * g); acc = __builtin_amdgcn_mfma_f32_16x16x32_bf16(a, vb[ks], acc, 0, 0, 0); }
          *(f32x4*)(OI + (size_t)unit * OI_B + (size_t)((wid * 4 + m) * 64 + lane) * 16) = acc; }
#pragma unroll
      for (int db = 0; db < 4; ++db) { f32x4 acc = {0.f, 0.f, 0.f, 0.f};
#pragma unroll
          for (int ks = 0; ks < 2; ++ks) { const bf16x8 a = *(const bf16x8*)(KPT + (16 * db + l15) * LS + 32 * ks + 8 * g); acc = __builtin_amdgcn_mfma_f32_16x16x32_bf16(a, vb[ks], acc, 0, 0, 0); }
          *(f32x4*)(UU + (size_t)unit * UU_B + (size_t)((wid * 4 + db) * 64 + lane) * 16) = acc; }
    }
}

constexpr size_t STG_B = 128 * 64 * 2;
__device__ __forceinline__ void scan_wave(int gwave, const unsigned char* UU, const float* DEC, unsigned char* STG, int lane) {
    const int bh = gwave >> 5, w = (gwave >> 2) & 7, db = gwave & 3, l15 = lane & 15, g = lane >> 4;
    f32x4 Sv = {0.f, 0.f, 0.f, 0.f};
    const size_t u0 = (size_t)bh * NCH;
    for (int n0 = 0; n0 < NCH; n0 += 8) {
        f32x4 Uf[8], dv[8];
#pragma unroll
        for (int j = 0; j < 8; ++j) { const size_t unit = u0 + n0 + j;
            Uf[j] = *(const f32x4*)(UU + unit * UU_B + (size_t)((w * 4 + db) * 64 + lane) * 16);
            dv[j] = *(const f32x4*)(DEC + unit * 64 + 16 * db + 4 * g); }
#pragma unroll
        for (int j = 0; j < 8; ++j) { const size_t unit = u0 + n0 + j;
            *(u32x2*)(STG + unit * STG_B + (size_t)((16 * w + l15) * 64 + 16 * db + 4 * g) * 2) = (u32x2){pkbf(Sv[0], Sv[1]), pkbf(Sv[2], Sv[3])};
            Sv = dv[j] * Sv + Uf[j]; }
    }
}

constexpr int GS = 136;
constexpr int PO_GR = 0, PO_YT = 64 * GS * 2, PO_PART = 2 * 64 * GS * 2, PO_END = PO_PART + 8 * 64 * 4;
__device__ __forceinline__ void post_unit(int unit, const bf16* QKV, const unsigned char* QPG, const unsigned char* OI, const unsigned char* STG, const float* __restrict__ gnorm, bf16* Y, unsigned char* lds) {
    int tid_ = threadIdx.x; asm volatile("" : "+v"(tid_));
    const int tid = tid_, lane = tid & 63, wid = __builtin_amdgcn_readfirstlane(tid >> 6), l15 = lane & 15, g = lane >> 4;
    const int n = unit % NCH, bh = unit / NCH, h = bh % GH, b = bh / GH;
    const size_t row0 = (size_t)b * S + (size_t)n * 64;
    bf16* GRs = (bf16*)(lds + PO_GR); bf16* YT = (bf16*)(lds + PO_YT); float* PART = (float*)(lds + PO_PART);
    const int t = tid >> 3, oc = tid & 7, e = 16 * wid + l15;
    const u32x4 g0 = *(const u32x4*)(QKV + (row0 + t) * fx::QKVP + fx::P_GR + h * 128 + oc * 16), g1 = *(const u32x4*)(QKV + (row0 + t) * fx::QKVP + fx::P_GR + h * 128 + oc * 16 + 8);
    f32x4 o[4]; bf16x8 qa[4][2], sb[2];
#pragma unroll
    for (int m = 0; m < 4; ++m) { o[m] = *(const f32x4*)(OI + (size_t)unit * OI_B + (size_t)((wid * 4 + m) * 64 + lane) * 16);
#pragma unroll
        for (int ks = 0; ks < 2; ++ks) qa[m][ks] = *(const bf16x8*)(QPG + (size_t)unit * QPG_B + (size_t)((16 * m + l15) * 64 + 32 * ks + 8 * g) * 2); }
#pragma unroll
    for (int ks = 0; ks < 2; ++ks) sb[ks] = *(const bf16x8*)(STG + (size_t)unit * STG_B + (size_t)(e * 64 + 32 * ks + 8 * g) * 2);
    const float gn = gnorm[e];
    *(u32x4*)(GRs + t * GS + oc * 16) = g0; *(u32x4*)(GRs + t * GS + oc * 16 + 8) = g1;
#pragma unroll
    for (int m = 0; m < 4; ++m)
#pragma unroll
        for (int ks = 0; ks < 2; ++ks) o[m] = __builtin_amdgcn_mfma_f32_16x16x32_bf16(qa[m][ks], sb[ks], o[m], 0, 0, 0);
#pragma unroll
    for (int m = 0; m < 4; ++m) { f32x4 q = o[m] * o[m];
#pragma unroll
        for (int off = 1; off < 16; off <<= 1) { q[0] += __shfl_xor(q[0], off); q[1] += __shfl_xor(q[1], off); q[2] += __shfl_xor(q[2], off); q[3] += __shfl_xor(q[3], off); }
        if (l15 == 0) *(f32x4*)(PART + wid * 64 + 16 * m + 4 * g) = q; }
    __syncthreads();
#pragma unroll
    for (int m = 0; m < 4; ++m) { f32x4 tot = {0.f, 0.f, 0.f, 0.f};
#pragma unroll
        for (int w = 0; w < 8; ++w) tot += *(const f32x4*)(PART + w * 64 + 16 * m + 4 * g);
#pragma unroll
        for (int r = 0; r < 4; ++r) { const int tt = 16 * m + 4 * g + r; const float rs = rsqrtf(tot[r] * (1.f / GV) + LN_EPS); const float gr = bf2f(GRs[tt * GS + e]);
            const float v = o[m][r] * rs * gn * (gr * __builtin_amdgcn_rcpf(1.f + __builtin_amdgcn_exp2f(-1.4426950408889634f * gr)));
            YT[tt * GS + e] = (bf16)(pkbf(v, 0.f) & 0xffffu); } }
    __syncthreads();
    { const u32x4 y0 = *(const u32x4*)(YT + t * GS + oc * 16), y1 = *(const u32x4*)(YT + t * GS + oc * 16 + 8);
      *(u32x4*)(Y + (row0 + t) * D + 512 + h * GV + oc * 16) = y0; *(u32x4*)(Y + (row0 + t) * D + 512 + h * GV + oc * 16 + 8) = y1; }
    __syncthreads();
}
}
namespace mo {
using namespace nv;
typedef unsigned short bf16;
typedef float f32x4 __attribute__((ext_vector_type(4)));
typedef unsigned u32x4 __attribute__((ext_vector_type(4)));
constexpr int CAP = 8192;
constexpr int NEX = NE + 1;
constexpr int YSH = T * TOPK;
constexpr int L_TB = 132096, L_YB = L_TB + 1040, L_CN = L_YB + 1040;
typedef LAS int* lint;

__device__ __forceinline__ void moe_tables(const int* counts, lint tb, lint yb, lint cn, int lane) {
    int c[4], nt[4]; int st = 0, sy = 0, pt[4], py[4];
#pragma unroll
    for (int i = 0; i < 4; ++i) { c[i] = counts[lane * 4 + i]; c[i] = c[i] > CAP ? CAP : c[i]; nt[i] = (c[i] + 255) >> 8; pt[i] = st; py[i] = sy; st += nt[i]; sy += c[i]; }
    int it = st, iy = sy;
    for (int o = 1; o < 64; o <<= 1) { const int a = __shfl_up(it, o), b = __shfl_up(iy, o); if (lane >= o) { it += a; iy += b; } }
    const int bt = it - st, by = iy - sy;
#pragma unroll
    for (int i = 0; i < 4; ++i) { tb[lane * 4 + i] = bt + pt[i]; yb[lane * 4 + i] = by + py[i]; cn[lane * 4 + i] = c[i]; }
    if (lane == 63) { tb[256] = it; tb[257] = it + T / 256; yb[256] = YSH; cn[256] = T; }
}

__device__ __forceinline__ void route_token2(const float* LG, const float* __restrict__ rbias, int* lcnt, int* TK, float* TW, int t0, int lane) {
    const int l32 = lane & 31, hb = lane & 32, t = t0 + (lane >> 5);
    const float4 la = ((const float4*)(LG + (size_t)t * NE))[2 * l32], lb = ((const float4*)(LG + (size_t)t * NE))[2 * l32 + 1];
    const float4 ra = ((const float4*)rbias)[2 * l32], rb = ((const float4*)rbias)[2 * l32 + 1];
    const float lg[8] = {la.x, la.y, la.z, la.w, lb.x, lb.y, lb.z, lb.w}, rbv[8] = {ra.x, ra.y, ra.z, ra.w, rb.x, rb.y, rb.z, rb.w};
    float sc[8], bv[8];
#pragma unroll
    for (int i = 0; i < 8; ++i) { sc[i] = 1.f / (1.f + expf(-lg[i])); bv[i] = sc[i] + rbv[i]; }
    float m1 = fmaxf(bv[0], bv[1]), m2 = fminf(bv[0], bv[1]);
#pragma unroll
    for (int i = 2; i < 8; ++i) { const float n1 = fmaxf(m1, bv[i]); m2 = fmaxf(fminf(m1, bv[i]), m2); m1 = n1; }
#pragma unroll
    for (int o = 1; o < 4; o <<= 1) { const float p1 = __shfl_xor(m1, o), p2 = __shfl_xor(m2, o); const float n1 = fmaxf(m1, p1); m2 = fmaxf(fminf(m1, p1), fmaxf(m2, p2)); m1 = n1; }
    const float gs = m1 + m2;
    const int myg = l32 >> 2;
    int rank = 0;
#pragma unroll
    for (int g2 = 0; g2 < NG; ++g2) { const float og = __shfl(gs, hb + g2 * 4); if (og > gs || (og == gs && g2 < myg)) ++rank; }
    const bool sel = rank < 4;
    float mv[8];
#pragma unroll
    for (int i = 0; i < 8; ++i) mv[i] = sel ? bv[i] : -INFINITY;
    int mye = 0; float myw = 0.f; float wsum = 0.f;
#pragma unroll
    for (int k = 0; k < TOPK; ++k) {
        float bvv = mv[0]; int bi = 0;
#pragma unroll
        for (int i = 1; i < 8; ++i) if (mv[i] > bvv) { bvv = mv[i]; bi = i; }
        int gi = l32 * 8 + bi;
#pragma unroll
        for (int o = 16; o > 0; o >>= 1) { const float ov = __shfl_xor(bvv, o); const int oi = __shfl_xor(gi, o); if (ov > bvv || (ov == bvv && oi < gi)) { bvv = ov; gi = oi; } }
        const int ol = gi >> 3, oi = gi & 7;
        float s_own = sc[0];
#pragma unroll
        for (int i = 1; i < 8; ++i) s_own = (oi == i) ? sc[i] : s_own;
        const float sw = __shfl(s_own, hb + ol);
        if (l32 == ol) {
#pragma unroll
            for (int i = 0; i < 8; ++i) if (oi == i) mv[i] = -INFINITY; }
        if (l32 == k) { mye = gi; myw = sw; } wsum += sw;
    }
    if (l32 < TOPK) { const int lp = atomicAdd(&lcnt[mye], 1); TK[t * TOPK + l32] = mye | (lp << 9); TW[t * TOPK + l32] = myw * (2.5f / wsum); }
}
__device__ __forceinline__ void route_finish2(const int* lbase, int* list_tok, float* list_gate, int* TK, const float* TW, int t0, int lane) {
    const int l32 = lane & 31, t = t0 + (lane >> 5);
    if (l32 < TOPK) { const int tk = TK[t * TOPK + l32]; const int e = tk & 511, pos = lbase[e] + (tk >> 9);
        if (pos < CAP) { list_tok[e * CAP + pos] = t; list_gate[e * CAP + pos] = TW[t * TOPK + l32]; }
        TK[t * TOPK + l32] = e | (pos << 9); }
}

constexpr float YSC = 16.f;
__device__ __forceinline__ void combine_token(const bf16* H1, const unsigned char* Y, const int* TK, lint yb, const float* __restrict__ g, const float* __restrict__ b, float* out, int t, int lane) {
    typedef float f2 __attribute__((ext_vector_type(2)));
    float v[16], s[16];
    { const u32x4 a = *(const u32x4*)(H1 + (size_t)t * D + 16 * lane), c = *(const u32x4*)(H1 + (size_t)t * D + 16 * lane + 8);
      const unsigned w[8] = {a.x, a.y, a.z, a.w, c.x, c.y, c.z, c.w};
#pragma unroll
      for (int i = 0; i < 8; ++i) { v[2 * i] = ALPHA * __builtin_bit_cast(float, w[i] << 16); v[2 * i + 1] = ALPHA * __builtin_bit_cast(float, w[i] & 0xffff0000u); } }
#pragma unroll
    for (int i = 0; i < 16; ++i) s[i] = 0.f;
    int tk = (lane < TOPK) ? TK[t * TOPK + lane] : 0;
#pragma unroll
    for (int k = 0; k <= TOPK; ++k) {
        size_t yrow;
        if (k < TOPK) { const int x = __shfl(tk, k); yrow = (size_t)(yb[x & 511] + (x >> 9)); } else yrow = (size_t)YSH + t;
        const u32x4 a = *(const u32x4*)(Y + yrow * D + 16 * lane);
        const int w[4] = {(int)a.x, (int)a.y, (int)a.z, (int)a.w};
#pragma unroll
        for (int i = 0; i < 4; ++i) { const f2 lo = __builtin_amdgcn_cvt_pk_f32_fp8(w[i], false), hi = __builtin_amdgcn_cvt_pk_f32_fp8(w[i], true);
            s[4 * i] += lo[0]; s[4 * i + 1] += lo[1]; s[4 * i + 2] += hi[0]; s[4 * i + 3] += hi[1]; }
    }
    float sm = 0.f;
#pragma unroll
    for (int i = 0; i < 16; ++i) { v[i] += s[i] * (1.f / YSC); sm += v[i]; }
    const float mean = fx::wave_sum(sm) * (1.f / D); float q = 0.f;
#pragma unroll
    for (int i = 0; i < 16; ++i) { v[i] -= mean; q += v[i] * v[i]; }
    const float rstd = 1.f / sqrtf(fx::wave_sum(q) * (1.f / D) + LN_EPS);
#pragma unroll
    for (int i = 0; i < 4; ++i) { const f32x4 gg = *(const f32x4*)(g + 16 * lane + 4 * i), bb = *(const f32x4*)(b + 16 * lane + 4 * i);
        f32x4 o; o[0] = v[4 * i] * rstd * gg[0] + bb[0]; o[1] = v[4 * i + 1] * rstd * gg[1] + bb[1]; o[2] = v[4 * i + 2] * rstd * gg[2] + bb[2]; o[3] = v[4 * i + 3] * rstd * gg[3] + bb[3];
        *(f32x4*)(out + (size_t)t * D + 16 * lane + 4 * i) = o; }
}
}

namespace pg8 {
struct RouterSched {
    int rb; const bf16_t* Bt;
    __device__ __forceinline__ bool next(int i, Unit2& u) const { if (i > 0) return false; u.pm = rb; u.pn = 0; u.e = 0; u.cnt = 128; u.jt = 0; return true; }
    __device__ __forceinline__ int arow(const Unit2& u, int r) const { return u.pm * 128 + r; }
    __device__ __forceinline__ size_t aoff(const Unit2&) const { return 0; }
    __device__ __forceinline__ const char* bptr(const Unit2&) const { return (const char*)Bt; }
};
struct EpiLogits {
    static constexpr bool PERM = false, AFTER_DRAIN = false;
    float* LG;
    __device__ __forceinline__ void operator()(const f32x4 (&acc)[2][2][4][2], const Unit2& u, int wr, int wc, int fr, int fq) const {
        const int row0 = u.pm * 128 + wr * 64 + fr, col0 = wc * 32 + 4 * fq;
#pragma unroll
        for (int m = 0; m < 4; ++m) { float* rowp = LG + (size_t)(row0 + m * 16) * nv::NE + col0;
#pragma unroll
            for (int bj = 0; bj < 2; ++bj)
#pragma unroll
                for (int n = 0; n < 2; ++n) *(f32x4*)(rowp + bj * HALF + n * 16) = acc[0][bj][m][n]; }
    }
};
template <int PH> struct MoeSched {
    int G, vcu, nrt; mo::lint tb; mo::lint cn; const int* list_tok; const bf16_t* W;
    static constexpr int NC = PH == 0 ? 2 : 4;
    __device__ __forceinline__ bool next(int i, Unit2& u) const {
        const int L = i * G + vcu; if (L >= nrt * NC) return false;
        const int rt = L / NC, c = L % NC;
        int lo = 0, hi = 256;
        while (lo < hi) { const int mid = (lo + hi + 1) >> 1; if (tb[mid] <= rt) lo = mid; else hi = mid - 1; }
        const int e = lo, jt = rt - tb[e]; const int total = cn[e];
        const int rem = total - 256 * jt;
        u.pm = rt; u.pn = c; u.e = __builtin_amdgcn_readfirstlane(e); u.jt = __builtin_amdgcn_readfirstlane(jt); u.cnt = __builtin_amdgcn_readfirstlane(rem < 256 ? rem : 256); return true;
    }
    __device__ __forceinline__ int arow(const Unit2& u, int r) const {
        if (PH == 1) return u.pm * BM + r;
        if (u.e == 256) return u.jt * BM + r;
        return (r < u.cnt) ? list_tok[u.e * mo::CAP + u.jt * BM + r] : 0;
    }
    __device__ __forceinline__ size_t aoff(const Unit2&) const { return 0; }
    __device__ __forceinline__ const char* bptr(const Unit2& u) const {
        return PH == 0 ? (const char*)(W + ((size_t)u.e * 512 + 256 * u.pn) * 1024) : (const char*)(W + ((size_t)u.e * 1024 + 256 * u.pn) * 256);
    }
};
struct EpiSwiGLU {
    static constexpr bool PERM = true, AFTER_DRAIN = false;
    bf16_t* H; const float* list_gate;
    __device__ __forceinline__ void operator()(const f32x4 (&acc)[2][2][4][2], const Unit2& u, int wr, int wc, int fr, int fq) const {
        const int col0 = u.pn * 128 + wc * 32 + 8 * fq;
#pragma unroll
        for (int ai = 0; ai < 2; ++ai)
#pragma unroll
            for (int m = 0; m < 4; ++m) { const int r = ai * HALF + wr * 64 + m * 16 + fr;
                float gt = 1.f; if (u.e < 256) gt = (r < u.cnt) ? list_gate[u.e * mo::CAP + u.jt * BM + r] : 0.f;
                float hv[8];
#pragma unroll
                for (int n = 0; n < 2; ++n)
#pragma unroll
                    for (int i = 0; i < 4; ++i) { const float gg = acc[ai][0][m][n][i], uu = acc[ai][1][m][n][i]; hv[4 * n + i] = gt * uu * (gg * __builtin_amdgcn_rcpf(1.f + __builtin_amdgcn_exp2f(-1.4426950408889634f * gg))); }
                u32x4 w; w.x = cvt_pk_bf16(hv[0], hv[1]); w.y = cvt_pk_bf16(hv[2], hv[3]); w.z = cvt_pk_bf16(hv[4], hv[5]); w.w = cvt_pk_bf16(hv[6], hv[7]);
                *(u32x4*)(H + (size_t)(u.pm * BM + r) * 256 + col0) = w; }
    }
};
struct EpiDown {
    static constexpr bool PERM = true, AFTER_DRAIN = false;
    unsigned char* Y; mo::lint yb;
    __device__ __forceinline__ void operator()(const f32x4 (&acc)[2][2][4][2], const Unit2& u, int wr, int wc, int fr, int fq) const {
        typedef unsigned u32x2v __attribute__((ext_vector_type(2)));
        const int col0 = u.pn * BM + wc * 32 + 8 * fq; const int ybase = yb[u.e] + u.jt * BM;
#pragma unroll
        for (int ai = 0; ai < 2; ++ai)
#pragma unroll
            for (int m = 0; m < 4; ++m) { const int r = ai * HALF + wr * 64 + m * 16 + fr;
                if (r < u.cnt) { unsigned char* rowp = Y + (size_t)(ybase + r) * nv::D + col0;
#pragma unroll
                    for (int bj = 0; bj < 2; ++bj) { const f32x4 v0 = acc[ai][bj][m][0] * mo::YSC, v1 = acc[ai][bj][m][1] * mo::YSC;
                        int w0 = __builtin_amdgcn_cvt_pk_fp8_f32(v0[0], v0[1], 0, false); w0 = __builtin_amdgcn_cvt_pk_fp8_f32(v0[2], v0[3], w0, true);
                        int w1 = __builtin_amdgcn_cvt_pk_fp8_f32(v1[0], v1[1], 0, false); w1 = __builtin_amdgcn_cvt_pk_fp8_f32(v1[2], v1[3], w1, true);
                        *(u32x2v*)(rowp + bj * HALF) = (u32x2v){(unsigned)w0, (unsigned)w1}; } } }
    }
};
}
constexpr int NTHR = 512;
constexpr int LDS_BYTES = 147456;
constexpr int MISC_OFF = 131072 + 320;
constexpr size_t MiB = 1u << 20;
constexpr size_t CTL_ZERO_BYTES = 1 * MiB;
constexpr int CW_BAR = 4096;
constexpr int CW_MOE = 16384;
constexpr int NPHASE = 10;
constexpr size_t WS_H1 = 1, WS_WR = 65, WS_STATS = 66, WS_LF = 67, WS_FG = 68, WS_WO = 72, WS_WIN = 74, WS_TK = 81, WS_LTOK = 83, WS_LGATE = 91,
                 WS_WED = 100, WS_HID = 230, WS_GLA = 230, WS_WEG = 416, WS_XN = 673, WS_YBF = 673, WS_QKV = 737, WS_Z1 = 737, WS_LG = 865, WS_Y = 416, WS_END = 992;

struct Args { const float* in[21]; float* out; unsigned char* ws; int ph_lo, ph_hi, li, pad; };

__global__ void __launch_bounds__(NTHR, 2) mega_fwd(Args a) {
    using namespace nv;
    extern __shared__ __attribute__((aligned(16))) unsigned char lds[];
    const int G = gridDim.x, bx = blockIdx.x;
    const int vcu = (G % 8 == 0) ? (bx % 8) * (G / 8) + bx / 8 : bx;
    int tid, lane, wave, vw;
#define DERIVE() do { int t_ = threadIdx.x; asm volatile("" : "+v"(t_)); tid = t_; lane = tid & 63; wave = __builtin_amdgcn_readfirstlane(tid >> 6); vw = vcu * 8 + wave; } while (0)
    DERIVE();
    volatile LAS unsigned* MISC = (volatile LAS unsigned*)((LAS unsigned char*)lds + MISC_OFF);
    for (int u = tid; u < (LDS_BYTES - 131072) / 4; u += NTHR) ((LAS unsigned*)((LAS unsigned char*)lds + 131072))[u] = 0u;
    __syncthreads();
    unsigned char* ws = a.ws;
    unsigned* ctl = (unsigned*)ws;
    XcdBarrier bar = xcd_barrier_post(ctl + CW_BAR + a.li * XCD_BAR_WORDS, MISC + 8);
    const float* x = a.in[0];
    const float* ln_in_g = a.in[1]; const float* ln_in_b = a.in[2];
    const float* w_in = a.in[3]; const float* b_fgate = a.in[4];
    const float* w_gate_up = a.in[5]; const float* b_gate = a.in[6]; const float* g_gla = a.in[7];
    const float* w_out = a.in[8]; const float* ln1_g = a.in[9]; const float* ln1_b = a.in[10];
    const float* w_router = a.in[11]; const float* rbias = a.in[12];
    const float* w_eg = a.in[13]; const float* w_eu = a.in[14]; const float* w_ed = a.in[15];
    const float* w_sg = a.in[16]; const float* w_su = a.in[17]; const float* w_sd = a.in[18];
    const float* ln2_g = a.in[19]; const float* ln2_b = a.in[20];
    float* out = a.out;
    int* counts = (int*)(ctl + CW_MOE);
    fx::bf16* H1 = (fx::bf16*)(ws + WS_H1 * MiB);
    fx::bf16* WrT = (fx::bf16*)(ws + WS_WR * MiB);
    float* stats = (float*)(ws + WS_STATS * MiB);
    float* LF = (float*)(ws + WS_LF * MiB);
    float* FG = (float*)(ws + WS_FG * MiB);
    fx::bf16* WoT = (fx::bf16*)(ws + WS_WO * MiB);
    fx::bf16* WinT = (fx::bf16*)(ws + WS_WIN * MiB);
    int* TK = (int*)(ws + WS_TK * MiB);
    float* TW = (float*)(ws + (WS_TK + 1) * MiB);
    int* list_tok = (int*)(ws + WS_LTOK * MiB);
    float* list_gate = (float*)(ws + WS_LGATE * MiB);
    fx::bf16* WedT = (fx::bf16*)(ws + WS_WED * MiB);
    fx::bf16* HID = (fx::bf16*)(ws + WS_HID * MiB);
    unsigned char* QPG = ws + WS_GLA * MiB; unsigned char* OIb = ws + (WS_GLA + 16) * MiB; unsigned char* UUb = ws + (WS_GLA + 80) * MiB; float* DECb = (float*)(ws + (WS_GLA + 144) * MiB); unsigned char* STGb = ws + (WS_GLA + 145) * MiB;
    fx::bf16* WegT = (fx::bf16*)(ws + WS_WEG * MiB);
    fx::bf16* XN = (fx::bf16*)(ws + WS_XN * MiB);
    fx::bf16* Ybf = (fx::bf16*)(ws + WS_YBF * MiB);
    fx::bf16* QKV = (fx::bf16*)(ws + WS_QKV * MiB);
    fx::bf16* MIX = (fx::bf16*)(ws + WS_Z1 * MiB);
    float* LG = (float*)(ws + WS_LG * MiB);
    unsigned char* YA = ws + WS_Y * MiB;
    mo::lint tb = (mo::lint)((LAS unsigned char*)lds + mo::L_TB), yb = (mo::lint)((LAS unsigned char*)lds + mo::L_YB), cn = (mo::lint)((LAS unsigned char*)lds + mo::L_CN);

    const int lo = a.ph_lo, hi = a.ph_hi;
#define IN(k) (lo <= (k) && (k) < hi)
#define SEAM(k) do { if (IN(k) && IN((k) + 1)) xcd_barrier(bar); DERIVE(); } while (0)
    const int GW = G * 8;
#ifndef STG7
#define STG7 0
#endif
#ifndef STG8
#define STG8 0
#endif
#define STAGGER(q) do { if ((q) > 0) { const unsigned long long t0_ = __builtin_amdgcn_s_memrealtime(); const unsigned long long d_ = (unsigned long long)((vcu & 3) * (q)); while (__builtin_amdgcn_s_memrealtime() - t0_ < d_) __builtin_amdgcn_s_sleep(8); } } while (0)

    if (IN(0)) {
        LAS float* scr = (LAS float*)((LAS unsigned char*)lds + wave * 16384);
        constexpr int I_IN = 16 * (fx::NIN / 32), I_OUT = 16 * 32, I_R = 16 * 8, I_SMALL = I_IN + I_OUT + I_R, I_EG = mo::NEX * 256, I_ED = mo::NEX * 128, I_EXP = I_EG + I_ED;
        for (int it = vw; it < I_SMALL; it += GW) {
            int r = it;
            if (r < I_IN) { fx::transpose_item(w_in, D, INW, WinT, scr, r / (fx::NIN / 32), r % (fx::NIN / 32), lane, [](int d) { return fx::inproj_src(d); }); continue; } r -= I_IN;
            if (r < I_OUT) { fx::transpose_item(w_out, D, D, WoT, scr, r / 32, r % 32, lane, [](int d) { return d; }); continue; } r -= I_OUT;
            fx::transpose_item(w_router, D, NE, WrT, scr, r / 8, r % 8, lane, [](int d) { return d; });
        }
        for (int r = vw; r < T; r += GW) fx::ln_row_bf16(x + (size_t)r * D, ln_in_g, ln_in_b, XN + (size_t)r * D, nullptr, stats + 2 * (size_t)r, lane);
#define CV_DECODE(r_, I) do { int r = (r_); if (r < I_EG) { const int e = r >> 8, kb = (r >> 4) & 15, nb = r & 15, c = nb >> 3, sub = nb & 7; \
            I.W = (e < NE) ? ((sub < 4 ? w_eg : w_eu) + (size_t)e * D * ED) : (sub < 4 ? w_sg : w_su); I.WT = WegT + (size_t)e * 512 * D; I.N = ED; I.K = D; I.k0 = 64 * kb; I.n0 = 32 * nb; I.s0 = 128 * c + 32 * (sub & 3); } \
          else { r -= I_EG; const int e = r >> 7, kb = (r >> 5) & 3, nb = r & 31; I.W = (e < NE) ? (w_ed + (size_t)e * ED * D) : w_sd; I.WT = WedT + (size_t)e * D * ED; I.N = D; I.K = ED; I.k0 = 64 * kb; I.n0 = 32 * nb; I.s0 = 32 * nb; } } while (0)
        { int it = vw; fx::CvItem cur, nx; fx::f32x4 v[8], w[8];
          if (it < I_EXP) { CV_DECODE(it, cur); fx::cv_load(cur, v, lane); }
          while (it < I_EXP) { const int itn = it + GW; if (itn < I_EXP) { CV_DECODE(itn, nx); fx::cv_load(nx, w, lane); }
              fx::cv_finish(cur, v, scr, lane); cur = nx;
#pragma unroll
              for (int i = 0; i < 8; ++i) v[i] = w[i];
              it = itn; } }
#undef CV_DECODE
    }
    SEAM(0);
    if (IN(1)) {
        pg8::Gemm g{XN, WinT, T, fx::NIN, D, D}; pg8::StaticOrder S; S.init(T, fx::NIN, G, bx);
        pg8::EpiInProj E{QKV, FG, LF, b_fgate};
        pg8::gemm_phase<pg8::EpiInProj, pg8::StaticOrder, true, true>((LAS unsigned char*)lds, g, S, E);
    }
    SEAM(1);
    if (IN(2)) {
        int cur_h = -1;
        if (gl::NUNIT % G == 0) { const int per = gl::NUNIT / G; for (int i = 0; i < per; ++i) gl::prep_unit(vcu * per + i, QKV, FG, w_gate_up, b_gate, QPG, OIb, UUb, DECb, lds, cur_h); }
        else for (int u = vcu; u < gl::NUNIT; u += G) gl::prep_unit(u, QKV, FG, w_gate_up, b_gate, QPG, OIb, UUb, DECb, lds, cur_h);
    }
    SEAM(2);
    if (IN(3)) {
        if (bx < 128) gl::scan_wave(bx * 8 + wave, UUb, DECb, STGb, lane);
    }
    SEAM(3);
    if (IN(4)) {
#ifdef POST_TWICE
        for (int i = 0; i < 8; ++i) gl::post_unit(vcu * 8 + i, QKV, QPG, OIb, STGb, g_gla, Ybf, lds);
#endif
        if (gl::NUNIT % G == 0) { const int per = gl::NUNIT / G; for (int i = 0; i < per; ++i) gl::post_unit(vcu * per + i, QKV, QPG, OIb, STGb, g_gla, Ybf, lds); }
        else for (int u = vcu; u < gl::NUNIT; u += G) gl::post_unit(u, QKV, QPG, OIb, STGb, g_gla, Ybf, lds);
        { const attn_body::AttnTensors AT{(const attn_body::bf16*)(QKV + fx::P_FQ), (const attn_body::bf16*)(QKV + fx::P_FK), (const attn_body::bf16*)(QKV + fx::P_FV), (attn_body::bf16*)Ybf, LF};
          const attn_body::StaticOrder SO(G, bx);
          attn_body::attn_phase<attn_body::StaticOrder>((char*)lds, AT, SO);
#ifdef FOX_TWICE
          attn_body::attn_phase<attn_body::StaticOrder>((char*)lds, AT, SO);
#endif
          }
    }
    SEAM(4);
    if (IN(5)) {
        pg8::DenseSched DS; DS.so.init(T, D, G, bx); DS.Bt = WoT; DS.ldb = D;
        pg8::EpiPlainBf16 E{MIX, D};
        pg8::gemm_phase2<pg8::EpiPlainBf16, pg8::DenseSched>((LAS unsigned char*)lds, Ybf, D, D, D, DS, E);
    }
    SEAM(5);
    if (IN(6)) {
        int* lcnt = (int*)(lds + 136192); int* lbase = lcnt + 256;
        for (int rb = vcu; rb < T / 128; rb += G) {
            if (tid < 256) lcnt[tid] = 0;
            for (int r = wave * 16; r < wave * 16 + 16; r += 4) { const size_t row = (size_t)rb * 128 + r;
                fx::ln1_rows_bf16<4>(x + row * D, stats + 2 * row, ln_in_g, ln_in_b, MIX + row * D, ln1_g, ln1_b, H1 + row * D, ALPHA, lane); }
            asm volatile("s_waitcnt vmcnt(0)" ::: "memory"); __syncthreads();
            { pg8::RouterSched RS{rb, WrT}; pg8::EpiLogits E{LG};
              pg8::gemm_phase2<pg8::EpiLogits, pg8::RouterSched>((LAS unsigned char*)lds, H1, D, D, D, RS, E); }
            DERIVE();
            for (int t = rb * 128 + wave * 2; t < rb * 128 + 128; t += 16) mo::route_token2(LG, rbias, lcnt, TK, TW, t, lane);
            __syncthreads();
            if (tid < 256) { const int c = lcnt[tid]; lbase[tid] = c ? atomicAdd(&counts[tid], c) : 0; }
            __syncthreads();
            for (int t = rb * 128 + wave * 2; t < rb * 128 + 128; t += 16) mo::route_finish2(lbase, list_tok, list_gate, TK, TW, t, lane);
            __syncthreads();
        }
    }
    SEAM(6);
    if (IN(7)) {
        if (wave == 0) mo::moe_tables(counts, tb, yb, cn, lane);
        __syncthreads();
        STAGGER(STG7);
        pg8::MoeSched<0> MS{G, vcu, tb[257], tb, cn, list_tok, WegT}; pg8::EpiSwiGLU E{HID, list_gate};
        pg8::gemm_phase2<pg8::EpiSwiGLU, pg8::MoeSched<0>>((LAS unsigned char*)lds, H1, D, D, D, MS, E);
    }
    SEAM(7);
    if (IN(8)) {
        if (wave == 0) mo::moe_tables(counts, tb, yb, cn, lane);
        __syncthreads();
        STAGGER(STG8);
        pg8::MoeSched<1> MS{G, vcu, tb[257], tb, cn, list_tok, WedT}; pg8::EpiDown E{YA, yb};
        pg8::gemm_phase2<pg8::EpiDown, pg8::MoeSched<1>>((LAS unsigned char*)lds, HID, ED, ED, ED, MS, E);
    }
    SEAM(8);
    if (IN(9)) {
        if (wave == 0) mo::moe_tables(counts, tb, yb, cn, lane);
        __syncthreads();
        for (int t = vw; t < T; t += GW) mo::combine_token(H1, YA, TK, yb, ln2_g, ln2_b, out, t, lane);
    }
#undef IN
#undef SEAM
}

extern "C" void kernel_launch(void* const* d_in, const int* in_sizes, int n_in, void* d_out, int out_size, void* d_ws, size_t ws_size, hipStream_t stream) {
    static int grid = 0;
    if (grid == 0) {
        if (n_in != 21 || out_size != nv::T * nv::D || ws_size < WS_END * MiB) { fprintf(stderr, "kernel_launch: unexpected shapes n_in=%d out=%d ws=%zu\n", n_in, out_size, ws_size); grid = -1; return; }
        int dev = 0, cus = 0;
        if (hipGetDevice(&dev) != hipSuccess || hipDeviceGetAttribute(&cus, hipDeviceAttributeMultiprocessorCount, dev) != hipSuccess) { grid = -1; return; }
        if (hipFuncSetAttribute((const void*)mega_fwd, hipFuncAttributeMaxDynamicSharedMemorySize, LDS_BYTES) != hipSuccess) { fprintf(stderr, "kernel_launch: hipFuncSetAttribute failed\n"); grid = -1; return; }
        grid = cus;
    }
    if (grid < 0) return;
    if (hipMemsetAsync(d_ws, 0, CTL_ZERO_BYTES, stream) != hipSuccess) return;
    Args a{};
    for (int i = 0; i < 21; ++i) a.in[i] = (const float*)d_in[i];
    a.out = (float*)d_out; a.ws = (unsigned char*)d_ws; a.ph_lo = 0; a.ph_hi = NPHASE; a.li = 0;
#ifdef REPEAT_PH
    a.ph_hi = REPEAT_PH + 1; hipLaunchKernelGGL(mega_fwd, dim3(grid), dim3(NTHR), LDS_BYTES, stream, a);
    if (REPEAT_PH == 6) hipMemsetAsync((char*)d_ws + CW_MOE * 4, 0, 4096, stream);
    a.ph_lo = REPEAT_PH; a.ph_hi = NPHASE; a.li = 1;
#endif
    hipLaunchKernelGGL(mega_fwd, dim3(grid), dim3(NTHR), LDS_BYTES, stream, a);
}
```

```cpp
#include <hip/hip_runtime.h>
#include <cstdio>
#include <cstdint>
#include <cmath>

#define LAS __attribute__((address_space(3)))
#define GAS __attribute__((address_space(1)))

#define XB_TMO      128
#define XB_XCNT(j)  (256  + 64 * (j))
#define XB_XSUB(j)  (1280 + 64 * (j))
#define XB_XGEN(j)  (2304 + 64 * (j))
#define XB_TOP      3328
#define XB_TOPGEN   3392
#define XCD_BAR_WORDS 3456
#define XB_SPIN_CAP (1u << 27)
__device__ __forceinline__ unsigned xb_ld(unsigned* p)              { return __hip_atomic_load(p, __ATOMIC_RELAXED, __HIP_MEMORY_SCOPE_AGENT); }
__device__ __forceinline__ unsigned xb_add(unsigned* p, unsigned v) { return __hip_atomic_fetch_add(p, v, __ATOMIC_RELAXED, __HIP_MEMORY_SCOPE_AGENT); }
__device__ __forceinline__ unsigned xb_xcc_id() { return (unsigned)__builtin_amdgcn_s_getreg((3 << 11) | 20) & 0xFu; }
#define XB_SPIN(cond, bar) do { unsigned _sp = 0; while (cond) { __builtin_amdgcn_s_sleep(1); \
    if ((++_sp & 255u) == 0u) { if (xb_ld(&(bar)[XB_TMO])) break; if (_sp > XB_SPIN_CAP) { atomicAdd(&(bar)[XB_TMO], 1u); break; } } } } while (0)
struct XcdBarrier { unsigned* bar; unsigned x; volatile LAS unsigned* st; };
__device__ __forceinline__ XcdBarrier xcd_barrier_post(unsigned* bar, volatile LAS unsigned* st) {
    XcdBarrier b; b.bar = bar; b.x = xb_xcc_id(); b.st = st;
    if (threadIdx.x == 0) (void)xb_add(&bar[XB_XCNT(b.x)], 1u);
    return b;
}
__device__ __forceinline__ void xcd_barrier_complete(unsigned* bar, unsigned x, unsigned& nloc, unsigned& nx) {
    const unsigned G = gridDim.x * gridDim.y * gridDim.z;
    unsigned sum, cnt, mine, sp = 0u;
    for (;;) {
        sum = 0u; cnt = 0u; mine = 0u;
#pragma unroll
        for (unsigned j = 0; j < 16; ++j) { const unsigned c = xb_ld(&bar[XB_XCNT(j)]); sum += c; cnt += (c > 0u) ? 1u : 0u; mine = (j == x) ? c : mine; }
        if (sum == G) break;
        __builtin_amdgcn_s_sleep(1);
        if ((++sp & 255u) == 0u) { if (xb_ld(&bar[XB_TMO])) break; if (sp > XB_SPIN_CAP) { atomicAdd(&bar[XB_TMO], 1u); break; } }
    }
    nloc = mine > 0u ? mine : 1u; nx = cnt > 0u ? cnt : 1u;
}
__device__ __forceinline__ void xcd_barrier(const XcdBarrier& b) {
    asm volatile("s_waitcnt vmcnt(0)" ::: "memory");
    __syncthreads();
    if (threadIdx.x == 0) {
        unsigned* bar = b.bar;
        __builtin_amdgcn_s_waitcnt(0);
        unsigned nloc = b.st[0], nx = b.st[1];
        if (nloc == 0u) { xcd_barrier_complete(bar, b.x, nloc, nx); b.st[0] = nloc; b.st[1] = nx; }
        const unsigned old = xb_add(&bar[XB_XSUB(b.x)], 1u);
        const unsigned gen = old / nloc;
        if (old + 1u == (gen + 1u) * nloc) {
            __builtin_amdgcn_fence(__ATOMIC_RELEASE, "agent");
            asm volatile("s_waitcnt vmcnt(0)" ::: "memory");
            const unsigned og = xb_add(&bar[XB_TOP], 1u);
            const unsigned tg = og / nx;
            if (og + 1u == (tg + 1u) * nx) xb_add(&bar[XB_TOPGEN], 1u);
            else XB_SPIN(xb_ld(&bar[XB_TOPGEN]) == tg, bar);
            __builtin_amdgcn_fence(__ATOMIC_ACQUIRE, "agent");
            xb_add(&bar[XB_XGEN(b.x)], 1u);
            asm volatile("s_waitcnt vmcnt(0)" ::: "memory");
        } else {
            XB_SPIN(xb_ld(&bar[XB_XGEN(b.x)]) == gen, bar);
            __builtin_amdgcn_fence(__ATOMIC_ACQUIRE, "agent");
            asm volatile("s_waitcnt vmcnt(0)" ::: "memory");
        }
    }
    __syncthreads();
}
namespace pg8 {
#define PG8_LAS __attribute__((address_space(3)))
typedef unsigned short bf16_t;
typedef short bf16x8 __attribute__((ext_vector_type(8)));
typedef float f32x4 __attribute__((ext_vector_type(4)));
typedef unsigned u32x4 __attribute__((ext_vector_type(4)));
constexpr int BM = 256, BK = 64, HALF = 128, HTB = HALF * BK * 2  , STAGE_BYTES = 8 * HTB, NXCD = 8, WGM = 8;

__host__ __device__ __forceinline__ int lds_byte(int r, int c) { const int st = (r >> 4) * 2 + (c >> 5), rr = r & 15, cc = c & 31, ob = rr * 64 + cc * 2; return st * 1024 + (ob ^ (((ob >> 9) & 1) << 5)); }
__host__ __device__ __forceinline__ void stage_rc(int b, int& R, int& C) { const int st = b / 1024, sb = b % 1024, swz = sb ^ (((sb >> 9) & 1) << 5); R = (st >> 1) * 16 + swz / 64; C = (st & 1) * 32 + (swz % 64) / 2; }
__host__ __device__ __forceinline__ int perm32(int rho) { const int n = rho >> 4, i = rho & 15; return 8 * (i >> 2) + 4 * n + (i & 3); }

struct Unit { int pm, pn; };
struct Gemm { const bf16_t* A; const bf16_t* Bt; int M, N, K, lda; };

struct StaticOrder {
    int nM, nN, nwg, G, c;
    __host__ __device__ void init(int M, int N, int G_, int c_) { nM = M / BM; nN = N / BM; nwg = nM * nN; G = G_; c = c_; }
    __host__ __device__ bool next(int i, Unit& u) const {
        const long L = (long)i * G + c; if (L >= nwg) return false;
        int wgid = (int)L; { const int q = nwg / NXCD, r = nwg % NXCD, xcd = wgid % NXCD, off = wgid / NXCD; wgid = (xcd < r ? xcd * (q + 1) : r * (q + 1) + (xcd - r) * q) + off; }
        const int nig = WGM * nN, gid = wgid / nig, fm = gid * WGM, gsz = (nM - fm) < WGM ? (nM - fm) : WGM;
        u.pm = fm + ((wgid % nig) % gsz); u.pn = (wgid % nig) / gsz; return true;
    }
    __device__ __forceinline__ void a_ready(const Unit&) const {}
    __device__ __forceinline__ void done(const Unit&) const {}
};

__device__ __forceinline__ unsigned cvt_pk_bf16(float lo, float hi) { unsigned r; asm volatile("v_cvt_pk_bf16_f32 %0, %1, %2" : "=v"(r) : "v"(lo), "v"(hi)); return r; }
typedef float f32x2 __attribute__((ext_vector_type(2)));
__device__ __forceinline__ f32x2 gelu_pk(f32x2 v) {
    const f32x2 av = __builtin_elementwise_abs(v), d = av * 0.2316418882f + 1.0f;
    f32x2 t; t.x = __builtin_amdgcn_rcpf(d.x); t.y = __builtin_amdgcn_rcpf(d.y);
    f32x2 q = t * 0.5307027145f + (-0.7265760135f); q = q * t + 0.7107068705f; q = q * t + (-0.142248368f); q = q * t + 0.127414796f; q = q * t;
    const f32x2 s = (v * v) * (-0.72134752044f);
    f32x2 e; e.x = __builtin_amdgcn_exp2f(s.x); e.y = __builtin_amdgcn_exp2f(s.y);
    const f32x2 m = v * (q * e), r = v - m;
    f32x2 o; o.x = v.x < 0.f ? m.x : r.x; o.y = v.y < 0.f ? m.y : r.y; return o;
}

template <int ACT  > struct EpiBf16 {
    static constexpr bool PERM = true, AFTER_DRAIN = false; static_assert(ACT == 0 || ACT == 1, "EpiBf16: ACT is 0 (none) or 1 (gelu_pk)");
    bf16_t* O; int ldc; const float* bias; int split_cols; size_t split_stride; float scale0;
    __device__ __forceinline__ void operator()(const f32x4 (&acc)[2][2][4][2], const Unit& u, int wr, int wc, int fr, int fq) const {
        const int row0 = u.pm * BM + wr * 64 + fr; int colt = u.pn * BM; bf16_t* base = O;
        float sc = 1.f; if (split_cols) { const int t = colt / split_cols; base += (size_t)t * split_stride; colt -= t * split_cols; if (t == 0) sc = scale0; }
        const int col0 = colt + wc * 32 + 8 * fq, bcol0 = u.pn * BM + wc * 32 + 8 * fq;
        f32x4 bv[2][2];
#pragma unroll
        for (int bj = 0; bj < 2; ++bj)
#pragma unroll
            for (int n = 0; n < 2; ++n) bv[bj][n] = bias ? *(const f32x4*)(bias + bcol0 + bj * HALF + 4 * n) : (f32x4){0.f, 0.f, 0.f, 0.f};
#pragma unroll
        for (int ai = 0; ai < 2; ++ai)
#pragma unroll
            for (int m = 0; m < 4; ++m) { bf16_t* rowp = base + (size_t)(row0 + ai * HALF + m * 16) * ldc + col0;
#pragma unroll
                for (int bj = 0; bj < 2; ++bj) { f32x4 v0 = acc[ai][bj][m][0] + bv[bj][0], v1 = acc[ai][bj][m][1] + bv[bj][1];
                    if (ACT == 1) { f32x2 a = gelu_pk((f32x2){v0[0], v0[1]}), b = gelu_pk((f32x2){v0[2], v0[3]}), c = gelu_pk((f32x2){v1[0], v1[1]}), d = gelu_pk((f32x2){v1[2], v1[3]});
                        v0 = (f32x4){a.x, a.y, b.x, b.y}; v1 = (f32x4){c.x, c.y, d.x, d.y}; }
                    v0 = v0 * sc; v1 = v1 * sc; u32x4 w; w.x = cvt_pk_bf16(v0[0], v0[1]); w.y = cvt_pk_bf16(v0[2], v0[3]); w.z = cvt_pk_bf16(v1[0], v1[1]); w.w = cvt_pk_bf16(v1[2], v1[3]);
                    *(u32x4*)(rowp + bj * HALF) = w; } }
    }
};

template <class Epi, class Sched, bool ALIGN_EPI = false, bool SP2 = false>
__device__ __forceinline__ void gemm_phase(PG8_LAS unsigned char* lds, const Gemm g, const Sched& S, const Epi& E) {
    const int tid = threadIdx.x, wid = __builtin_amdgcn_readfirstlane(tid >> 6), lane = tid & 63, wr = wid >> 2, wc = wid & 3, fr = lane & 15, fq = lane >> 4;
    const int K = g.K, nt = K / BK;
    unsigned voffA[2], voffB[2];
#pragma unroll
    for (int i = 0; i < 2; ++i) { int R, C; stage_rc(tid * 16 + i * 8192, R, C); const int Rb = Epi::PERM ? ((R & ~31) + perm32(R & 31)) : R;
        voffA[i] = (unsigned)(R * g.lda + C) * 2u; voffB[i] = (unsigned)(Rb * K + C) * 2u; }
    const size_t kstep = (size_t)(BK * 2);
    const size_t hstepA = (size_t)HALF * g.lda * 2, hstepB = (size_t)HALF * K * 2;
    const size_t tstepA = 2 * hstepA, tstepB = 2 * hstepB;
    const unsigned ldsw = (unsigned)wid * 1024u;
    const int aoff = lds_byte(wr * 64 + fr, fq * 8), boff = lds_byte(wc * 32 + fr, fq * 8);
#define PG8_SA(b, h) (((b) * 2 + (h)) * HTB)
#define PG8_SB(b, h) ((4 + (b) * 2 + (h)) * HTB)
#define PG8_STAGE(bufoff, gbase, voff) do { _Pragma("unroll") for (int _i = 0; _i < 2; ++_i) \
        __builtin_amdgcn_global_load_lds((const unsigned*)((const char*)(gbase) + (voff)[_i]), (PG8_LAS unsigned*)(lds + (bufoff) + ldsw + _i * 8192), 16, 0, 0); } while (0)
#define PG8_LDA(dst, b, h) do { _Pragma("unroll") for (int m = 0; m < 4; ++m) _Pragma("unroll") for (int k = 0; k < 2; ++k) dst[m][k] = *(const PG8_LAS bf16x8*)(lds + PG8_SA(b, h) + aoff + m * 2048 + k * 1024); } while (0)
#define PG8_LDB(dst, b, h) do { _Pragma("unroll") for (int n = 0; n < 2; ++n) _Pragma("unroll") for (int k = 0; k < 2; ++k) dst[n][k] = *(const PG8_LAS bf16x8*)(lds + PG8_SB(b, h) + boff + n * 2048 + k * 1024); } while (0)
#define PG8_MMA(ai, bj, At, Bt) do { __builtin_amdgcn_s_setprio(1); _Pragma("unroll") for (int m = 0; m < 4; ++m) _Pragma("unroll") for (int n = 0; n < 2; ++n) _Pragma("unroll") for (int k = 0; k < 2; ++k) \
        acc[ai][bj][m][n] = __builtin_amdgcn_mfma_f32_16x16x32_bf16(Bt[n][k], At[m][k], acc[ai][bj][m][n], 0, 0, 0); __builtin_amdgcn_s_setprio(0); } while (0)
#define PG8_WAIT_V(n) asm volatile("s_waitcnt vmcnt(" #n ")" ::: "memory")
#define PG8_WAIT_L(n) asm volatile("s_waitcnt lgkmcnt(" #n ")" ::: "memory")
#define PG8_BAR __builtin_amdgcn_s_barrier()
#define PG8_SCHED __builtin_amdgcn_sched_barrier(0)
    Unit cur, nxt; int ui = 0;
    if (!S.next(0, cur)) return;
    f32x4 acc[2][2][4][2];
#pragma unroll
    for (int a = 0; a < 2; ++a)
#pragma unroll
        for (int b = 0; b < 2; ++b)
#pragma unroll
            for (int m = 0; m < 4; ++m)
#pragma unroll
                for (int n = 0; n < 2; ++n) acc[a][b][m][n] = (f32x4){0.f, 0.f, 0.f, 0.f};
    bf16x8 At[4][2], B0[2][2], B1[2][2];
    const char* cA = (const char*)g.A + (size_t)cur.pm * tstepA; const char* cB = (const char*)g.Bt + (size_t)cur.pn * tstepB;
    S.a_ready(cur);
    if constexpr (SP2) {
        PG8_STAGE(PG8_SB(0, 0), cB, voffB); PG8_STAGE(PG8_SB(0, 1), cB + hstepB, voffB); PG8_STAGE(PG8_SA(0, 0), cA, voffA); PG8_STAGE(PG8_SA(0, 1), cA + hstepA, voffA);
        if (wr == 1) PG8_BAR;
        PG8_WAIT_V(2); PG8_BAR;
        PG8_STAGE(PG8_SB(1, 0), cB + kstep, voffB); PG8_STAGE(PG8_SA(1, 0), cA + kstep, voffA); PG8_STAGE(PG8_SB(1, 1), cB + hstepB + kstep, voffB);
        PG8_WAIT_V(6); PG8_BAR;
    } else {
        PG8_STAGE(PG8_SB(0, 0), cB, voffB); PG8_STAGE(PG8_SA(0, 0), cA, voffA); PG8_STAGE(PG8_SB(0, 1), cB + hstepB, voffB); PG8_STAGE(PG8_SA(0, 1), cA + hstepA, voffA);
        if (wr == 1) PG8_BAR;
        PG8_WAIT_V(4); PG8_BAR;
        PG8_STAGE(PG8_SB(1, 0), cB + kstep, voffB); PG8_STAGE(PG8_SA(1, 0), cA + kstep, voffA); PG8_STAGE(PG8_SB(1, 1), cB + hstepB + kstep, voffB);
        PG8_WAIT_V(6); PG8_BAR;
    }
    for (;;) {
        const bool has_next = S.next(ui + 1, nxt);
        const char* nA = has_next ? (const char*)g.A + (size_t)nxt.pm * tstepA : cA; const char* nB = has_next ? (const char*)g.Bt + (size_t)nxt.pn * tstepB : cB;
        for (int t = 0; t < nt; t += 2) {
            const bool last = (t == nt - 2);
            const char* a1 = cA + (size_t)(t + 1) * kstep;
            const char* a2 = last ? nA : cA + (size_t)(t + 2) * kstep; const char* b2 = last ? nB : cB + (size_t)(t + 2) * kstep;
            const char* a3 = a2 + kstep; const char* b3 = b2 + kstep;
            if (last && has_next) S.a_ready(nxt);
            if constexpr (SP2) {
            PG8_LDB(B0, 0, 0); PG8_LDB(B1, 0, 1); PG8_SCHED; PG8_LDA(At, 0, 0); PG8_STAGE(PG8_SA(1, 1), a1 + hstepA, voffA);
            PG8_WAIT_V(8); PG8_WAIT_L(0); PG8_BAR; PG8_MMA(0, 0, At, B0); PG8_MMA(0, 1, At, B1); PG8_BAR; PG8_SCHED;
            PG8_LDA(At, 0, 1); PG8_STAGE(PG8_SB(0, 0), b2, voffB); PG8_STAGE(PG8_SB(0, 1), b2 + hstepB, voffB); PG8_STAGE(PG8_SA(0, 0), a2, voffA);
            PG8_WAIT_V(8); PG8_WAIT_L(0); PG8_BAR; PG8_MMA(1, 0, At, B0); PG8_MMA(1, 1, At, B1); PG8_BAR; PG8_SCHED;
            PG8_LDB(B0, 1, 0); PG8_LDB(B1, 1, 1); PG8_SCHED; PG8_LDA(At, 1, 0); PG8_STAGE(PG8_SA(0, 1), a2 + hstepA, voffA);
            PG8_WAIT_V(8); PG8_WAIT_L(0); PG8_BAR; PG8_MMA(0, 0, At, B0); PG8_MMA(0, 1, At, B1); PG8_BAR; PG8_SCHED;
            PG8_LDA(At, 1, 1); PG8_STAGE(PG8_SB(1, 0), b3, voffB); PG8_STAGE(PG8_SB(1, 1), b3 + hstepB, voffB); PG8_STAGE(PG8_SA(1, 0), a3, voffA);
            PG8_WAIT_V(8); PG8_WAIT_L(0); PG8_BAR; PG8_MMA(1, 0, At, B0); PG8_MMA(1, 1, At, B1); PG8_BAR; PG8_SCHED;
            } else {
            PG8_LDB(B0, 0, 0); PG8_SCHED; PG8_LDA(At, 0, 0); PG8_STAGE(PG8_SA(1, 1), a1 + hstepA, voffA);
            PG8_WAIT_L(8); PG8_BAR; PG8_WAIT_L(0); PG8_MMA(0, 0, At, B0); PG8_BAR; PG8_SCHED;
            PG8_LDB(B1, 0, 1); PG8_STAGE(PG8_SB(0, 0), b2, voffB);
            PG8_BAR; PG8_WAIT_L(0); PG8_MMA(0, 1, At, B1); PG8_BAR;
            PG8_LDA(At, 0, 1); PG8_STAGE(PG8_SA(0, 0), a2, voffA);
            PG8_BAR; PG8_WAIT_L(0); PG8_MMA(1, 0, At, B0); PG8_BAR; PG8_SCHED;
            PG8_STAGE(PG8_SB(0, 1), b2 + hstepB, voffB);
            PG8_WAIT_V(6); PG8_BAR; PG8_MMA(1, 1, At, B1); PG8_BAR;
            PG8_LDB(B0, 1, 0); PG8_SCHED; PG8_LDA(At, 1, 0); PG8_STAGE(PG8_SA(0, 1), a2 + hstepA, voffA);
            PG8_WAIT_L(8); PG8_BAR; PG8_WAIT_L(0); PG8_MMA(0, 0, At, B0); PG8_BAR; PG8_SCHED;
            PG8_LDB(B1, 1, 1); PG8_STAGE(PG8_SB(1, 0), b3, voffB);
            PG8_BAR; PG8_WAIT_L(0); PG8_MMA(0, 1, At, B1); PG8_BAR;
            PG8_LDA(At, 1, 1); PG8_STAGE(PG8_SA(1, 0), a3, voffA);
            PG8_BAR; PG8_WAIT_L(0); PG8_MMA(1, 0, At, B0); PG8_BAR; PG8_SCHED;
            PG8_STAGE(PG8_SB(1, 1), b3 + hstepB, voffB);
            PG8_WAIT_V(6); PG8_BAR; PG8_MMA(1, 1, At, B1); PG8_BAR;
            }
        }
        if constexpr (ALIGN_EPI) { if (wr == 0) PG8_BAR; }
        if constexpr (!Epi::AFTER_DRAIN) { E(acc, cur, wr, wc, fr, fq); S.done(cur); }
        if (!has_next) break;
#pragma unroll
        for (int a = 0; a < 2; ++a)
#pragma unroll
            for (int b = 0; b < 2; ++b)
#pragma unroll
                for (int m = 0; m < 4; ++m)
#pragma unroll
                    for (int n = 0; n < 2; ++n) acc[a][b][m][n] = (f32x4){0.f, 0.f, 0.f, 0.f};
        cur = nxt; cA = nA; cB = nB; ++ui;
        if constexpr (ALIGN_EPI) { if (wr == 1) PG8_BAR; }
    }
    PG8_WAIT_V(0);
    if constexpr (!ALIGN_EPI) { if (wr == 0) PG8_BAR; }
    PG8_BAR;
    if constexpr (Epi::AFTER_DRAIN) { E.fused(acc, cur, wr, wc, fr, fq, lds, wid, lane); S.done(cur); }
#undef PG8_SA
#undef PG8_SB
#undef PG8_STAGE
#undef PG8_LDA
#undef PG8_LDB
#undef PG8_MMA
#undef PG8_WAIT_V
#undef PG8_WAIT_L
#undef PG8_BAR
#undef PG8_SCHED
}
}
namespace pg8 {
struct Unit2 { int pm, pn, e, cnt, jt; };
template <class Epi, class Sched>
__device__ __forceinline__ void gemm_phase2(PG8_LAS unsigned char* lds, const bf16_t* Abase, int lda, int ldb, int K, const Sched& S, const Epi& E) {
    int tid_ = threadIdx.x; asm volatile("" : "+v"(tid_));
    const int tid = tid_, wid = __builtin_amdgcn_readfirstlane(tid >> 6), lane = tid & 63, wr = wid >> 2, wc = wid & 3, fr = lane & 15, fq = lane >> 4;
    int K_ = K; asm volatile("" : "+s"(K_));
    const int nt = K_ / BK;
    unsigned voffB[2];
#pragma unroll
    for (int i = 0; i < 2; ++i) { int R, C; stage_rc(tid * 16 + i * 8192, R, C); const int Rb = Epi::PERM ? ((R & ~31) + perm32(R & 31)) : R; voffB[i] = (unsigned)(Rb * ldb + C) * 2u; }
    const unsigned lda2 = (unsigned)lda * 2u;
#define PG8_AOFFS(U, o0, o1) do { int t2_ = threadIdx.x; asm volatile("" : "+v"(t2_)); _Pragma("unroll") for (int i_ = 0; i_ < 2; ++i_) { int R_, C_; stage_rc(t2_ * 16 + i_ * 8192, R_, C_); \
        o0[i_] = (unsigned)S.arow(U, R_) * lda2 + (unsigned)C_ * 2u; o1[i_] = (unsigned)S.arow(U, HALF + R_) * lda2 + (unsigned)C_ * 2u; } } while (0)
    const size_t kstep = (size_t)(BK * 2);
    const size_t hstepB = (size_t)HALF * ldb * 2;
    const unsigned ldsw = (unsigned)wid * 1024u;
    const int aoff = lds_byte(wr * 64 + fr, fq * 8), boff = lds_byte(wc * 32 + fr, fq * 8);
#define PG8_SA(b, h) (((b) * 2 + (h)) * HTB)
#define PG8_SB(b, h) ((4 + (b) * 2 + (h)) * HTB)
#define PG8_STAGE(bufoff, gbase, voff) do { _Pragma("unroll") for (int _i = 0; _i < 2; ++_i) \
        __builtin_amdgcn_global_load_lds((const unsigned*)((const char*)(gbase) + (voff)[_i]), (PG8_LAS unsigned*)(lds + (bufoff) + ldsw + _i * 8192), 16, 0, 0); } while (0)
#define PG8_LDA(dst, b, h) do { _Pragma("unroll") for (int m = 0; m < 4; ++m) _Pragma("unroll") for (int k = 0; k < 2; ++k) dst[m][k] = *(const PG8_LAS bf16x8*)(lds + PG8_SA(b, h) + aoff + m * 2048 + k * 1024); } while (0)
#define PG8_LDB(dst, b, h) do { _Pragma("unroll") for (int n = 0; n < 2; ++n) _Pragma("unroll") for (int k = 0; k < 2; ++k) dst[n][k] = *(const PG8_LAS bf16x8*)(lds + PG8_SB(b, h) + boff + n * 2048 + k * 1024); } while (0)
#define PG8_MMA(ai, bj, At, Bt) do { __builtin_amdgcn_s_setprio(1); _Pragma("unroll") for (int m = 0; m < 4; ++m) _Pragma("unroll") for (int n = 0; n < 2; ++n) _Pragma("unroll") for (int k = 0; k < 2; ++k) \
        acc[ai][bj][m][n] = __builtin_amdgcn_mfma_f32_16x16x32_bf16(Bt[n][k], At[m][k], acc[ai][bj][m][n], 0, 0, 0); __builtin_amdgcn_s_setprio(0); } while (0)
#define PG8_WAIT_V(n) asm volatile("s_waitcnt vmcnt(" #n ")" ::: "memory")
#define PG8_WAIT_L(n) asm volatile("s_waitcnt lgkmcnt(" #n ")" ::: "memory")
#define PG8_BAR __builtin_amdgcn_s_barrier()
#define PG8_SCHED __builtin_amdgcn_sched_barrier(0)
    Unit2 cur, nxt; int ui = 0;
    if (!S.next(0, cur)) return;
    f32x4 acc[2][2][4][2];
#pragma unroll
    for (int a = 0; a < 2; ++a)
#pragma unroll
        for (int b = 0; b < 2; ++b)
#pragma unroll
            for (int m = 0; m < 4; ++m)
#pragma unroll
                for (int n = 0; n < 2; ++n) acc[a][b][m][n] = (f32x4){0.f, 0.f, 0.f, 0.f};
    bf16x8 At[4][2], B0[2][2], B1[2][2];
    unsigned cv0[2], cv1[2], nv0[2], nv1[2];
    PG8_AOFFS(cur, cv0, cv1);
    const char* cA = (const char*)Abase + S.aoff(cur); const char* cB = S.bptr(cur);
    PG8_STAGE(PG8_SB(0, 0), cB, voffB); PG8_STAGE(PG8_SB(0, 1), cB + hstepB, voffB); PG8_STAGE(PG8_SA(0, 0), cA, cv0); PG8_STAGE(PG8_SA(0, 1), cA, cv1);
    if (wr == 1) PG8_BAR;
    PG8_WAIT_V(2); PG8_BAR;
    PG8_STAGE(PG8_SB(1, 0), cB + kstep, voffB); PG8_STAGE(PG8_SA(1, 0), cA + kstep, cv0); PG8_STAGE(PG8_SB(1, 1), cB + hstepB + kstep, voffB);
    PG8_WAIT_V(6); PG8_BAR;
    for (;;) {
        const bool has_next = S.next(ui + 1, nxt);
        const char* nA = has_next ? (const char*)Abase + S.aoff(nxt) : cA; const char* nB = has_next ? S.bptr(nxt) : cB;
#pragma unroll
        for (int i = 0; i < 2; ++i) { nv0[i] = cv0[i]; nv1[i] = cv1[i]; }
        if (has_next) PG8_AOFFS(nxt, nv0, nv1);
        for (int t = 0; t < nt; t += 2) {
            const bool last = (t == nt - 2);
            const char* a1 = cA + (size_t)(t + 1) * kstep;
            const char* a2 = last ? nA : cA + (size_t)(t + 2) * kstep; const char* b2 = last ? nB : cB + (size_t)(t + 2) * kstep;
            const char* a3 = a2 + kstep; const char* b3 = b2 + kstep;
            unsigned s0[2] = {cv0[0], cv0[1]}, s1[2] = {cv1[0], cv1[1]};
            if (last) { asm volatile("" ::: "memory"); s0[0] = nv0[0]; s0[1] = nv0[1]; s1[0] = nv1[0]; s1[1] = nv1[1]; }
            PG8_LDB(B0, 0, 0); PG8_LDB(B1, 0, 1); PG8_SCHED; PG8_LDA(At, 0, 0); PG8_STAGE(PG8_SA(1, 1), a1, cv1);
            PG8_WAIT_V(8); PG8_WAIT_L(0); PG8_BAR; PG8_MMA(0, 0, At, B0); PG8_MMA(0, 1, At, B1); PG8_BAR; PG8_SCHED;
            PG8_LDA(At, 0, 1); PG8_STAGE(PG8_SB(0, 0), b2, voffB); PG8_STAGE(PG8_SB(0, 1), b2 + hstepB, voffB); PG8_STAGE(PG8_SA(0, 0), a2, s0);
            PG8_WAIT_V(8); PG8_WAIT_L(0); PG8_BAR; PG8_MMA(1, 0, At, B0); PG8_MMA(1, 1, At, B1); PG8_BAR; PG8_SCHED;
            PG8_LDB(B0, 1, 0); PG8_LDB(B1, 1, 1); PG8_SCHED; PG8_LDA(At, 1, 0); PG8_STAGE(PG8_SA(0, 1), a2, s1);
            PG8_WAIT_V(8); PG8_WAIT_L(0); PG8_BAR; PG8_MMA(0, 0, At, B0); PG8_MMA(0, 1, At, B1); PG8_BAR; PG8_SCHED;
            PG8_LDA(At, 1, 1); PG8_STAGE(PG8_SB(1, 0), b3, voffB); PG8_STAGE(PG8_SB(1, 1), b3 + hstepB, voffB); PG8_STAGE(PG8_SA(1, 0), a3, s0);
            PG8_WAIT_V(8); PG8_WAIT_L(0); PG8_BAR; PG8_MMA(1, 0, At, B0); PG8_MMA(1, 1, At, B1); PG8_BAR; PG8_SCHED;
        }
        if (wr == 0) PG8_BAR;
        { Unit2 eu = cur; asm volatile("" : "+s"(eu.pm), "+s"(eu.pn), "+s"(eu.e), "+s"(eu.cnt), "+s"(eu.jt));
          E(acc, eu, wr, wc, fr, fq);
          }
        if (!has_next) break;
#pragma unroll
        for (int a = 0; a < 2; ++a)
#pragma unroll
            for (int b = 0; b < 2; ++b)
#pragma unroll
                for (int m = 0; m < 4; ++m)
#pragma unroll
                    for (int n = 0; n < 2; ++n) acc[a][b][m][n] = (f32x4){0.f, 0.f, 0.f, 0.f};
        cur = nxt; cA = nA; cB = nB; ++ui;
#pragma unroll
        for (int i = 0; i < 2; ++i) { cv0[i] = nv0[i]; cv1[i] = nv1[i]; }
        if (wr == 1) PG8_BAR;
    }
    PG8_WAIT_V(0);
    PG8_BAR;
#undef PG8_AOFFS
#undef PG8_SA
#undef PG8_SB
#undef PG8_STAGE
#undef PG8_LDA
#undef PG8_LDB
#undef PG8_MMA
#undef PG8_WAIT_V
#undef PG8_WAIT_L
#undef PG8_BAR
#undef PG8_SCHED
}

struct DenseSched {
    StaticOrder so; const bf16_t* Bt; int ldb;
    __device__ __forceinline__ bool next(int i, Unit2& u) const { Unit t; if (!so.next(i, t)) return false; u.pm = t.pm; u.pn = t.pn; u.e = 0; u.cnt = 256; u.jt = 0; return true; }
    __device__ __forceinline__ int arow(const Unit2& u, int r) const { return u.pm * BM + r; }
    __device__ __forceinline__ size_t aoff(const Unit2&) const { return 0; }
    __device__ __forceinline__ const char* bptr(const Unit2& u) const { return (const char*)(Bt + (size_t)u.pn * BM * ldb); }
};
struct EpiPlainBf16 {
    static constexpr bool PERM = true, AFTER_DRAIN = false;
    bf16_t* O; int ldc;
    __device__ __forceinline__ void operator()(const f32x4 (&acc)[2][2][4][2], const Unit2& u, int wr, int wc, int fr, int fq) const {
        const int row0 = u.pm * BM + wr * 64 + fr, col0 = u.pn * BM + wc * 32 + 8 * fq;
#pragma unroll
        for (int ai = 0; ai < 2; ++ai)
#pragma unroll
            for (int m = 0; m < 4; ++m) { bf16_t* rowp = O + (size_t)(row0 + ai * HALF + m * 16) * ldc + col0;
#pragma unroll
                for (int bj = 0; bj < 2; ++bj) { const f32x4 v0 = acc[ai][bj][m][0], v1 = acc[ai][bj][m][1];
                    u32x4 w; w.x = cvt_pk_bf16(v0[0], v0[1]); w.y = cvt_pk_bf16(v0[2], v0[3]); w.z = cvt_pk_bf16(v1[0], v1[1]); w.w = cvt_pk_bf16(v1[2], v1[3]);
                    *(u32x4*)(rowp + bj * HALF) = w; } }
    }
};
}
namespace nv {
constexpr int D = 1024, B = 8, S = 4096, T = B * S;
constexpr int FH = 8, FD = 64, GH = 4, GK = 64, GV = 128, RANK = 16;
constexpr int INW = 3096;
constexpr int O_FQ = 0, O_FK = 512, O_FV = 1024, O_FF = 1536, O_GQ = 1544, O_GK = 1800, O_GV = 2056, O_GA = 2568, O_GR = 2584;
constexpr int NE = 256, NG = 8, TOPK = 8, ED = 256;
constexpr float LN_EPS = 1e-5f;
constexpr float ALPHA = 1.189207115002721f;
constexpr int PADR = 64;
constexpr int APAD = T * TOPK + NE * PADR;

__device__ __forceinline__ float logsigmoidf(float x) { return fminf(x, 0.f) - log1pf(expf(-fabsf(x))); }
__device__ __forceinline__ float siluf(float x) { return x / (1.f + expf(-x)); }


__device__ __forceinline__ void ln_row(const float* in1, float a, const float* in2, const float* __restrict__ g, const float* __restrict__ b, float* out, int r, int tid, float* sh) {
    float4 v = ((const float4*)(in1 + (size_t)r * D))[tid];
    v.x *= a; v.y *= a; v.z *= a; v.w *= a;
    if (in2) { const float4 w = ((const float4*)(in2 + (size_t)r * D))[tid]; v.x += w.x; v.y += w.y; v.z += w.z; v.w += w.w; }
    float s = v.x + v.y + v.z + v.w;
    for (int o = 32; o > 0; o >>= 1) s += __shfl_xor(s, o);
    __syncthreads();
    if ((tid & 63) == 0) sh[tid >> 6] = s;
    __syncthreads();
    const float mean = (sh[0] + sh[1] + sh[2] + sh[3]) * (1.f / D);
    v.x -= mean; v.y -= mean; v.z -= mean; v.w -= mean;
    float q = v.x * v.x + v.y * v.y + v.z * v.z + v.w * v.w;
    for (int o = 32; o > 0; o >>= 1) q += __shfl_xor(q, o);
    if ((tid & 63) == 0) sh[4 + (tid >> 6)] = q;
    __syncthreads();
    const float rstd = rsqrtf((sh[4] + sh[5] + sh[6] + sh[7]) * (1.f / D) + LN_EPS);
    const float4 gg = ((const float4*)g)[tid], bb = ((const float4*)b)[tid];
    float4 o4; o4.x = v.x * rstd * gg.x + bb.x; o4.y = v.y * rstd * gg.y + bb.y; o4.z = v.z * rstd * gg.z + bb.z; o4.w = v.w * rstd * gg.w + bb.w;
    ((float4*)(out + (size_t)r * D))[tid] = o4;
}

__device__ __forceinline__ void gemm_tile(const float* A, const float* Bm, float* C, int N, int K, int lda, int ldb, int ldc, int tile_x, int tile_y, int tid, float* sh) {
    float (*As)[68] = (float (*)[68])sh;
    float (*Bs)[68] = (float (*)[68])(sh + 16 * 68);
    const int tx = tid & 15, ty = tid >> 4;
    const int row0 = tile_y * 64, col0 = tile_x * 64;
    float acc[4][4] = {};
    const int ar = tid >> 2, ak = (tid & 3) * 4;
    const int bk = tid >> 4, bc = (tid & 15) * 4;
    const bool bok = (col0 + bc) < N;
    for (int k0 = 0; k0 < K; k0 += 16) {
        const float4 av = *(const float4*)(A + (size_t)(row0 + ar) * lda + k0 + ak);
        float4 bv = make_float4(0.f, 0.f, 0.f, 0.f);
        if (bok) bv = *(const float4*)(Bm + (size_t)(k0 + bk) * ldb + col0 + bc);
        __syncthreads();
        As[ak + 0][ar] = av.x; As[ak + 1][ar] = av.y; As[ak + 2][ar] = av.z; As[ak + 3][ar] = av.w;
        *(float4*)&Bs[bk][bc] = bv;
        __syncthreads();
#pragma unroll
        for (int k = 0; k < 16; ++k) {
            const float4 a4 = *(const float4*)&As[k][ty * 4];
            const float4 b4 = *(const float4*)&Bs[k][tx * 4];
            const float aa[4] = {a4.x, a4.y, a4.z, a4.w}, bb[4] = {b4.x, b4.y, b4.z, b4.w};
#pragma unroll
            for (int i = 0; i < 4; ++i)
#pragma unroll
                for (int j = 0; j < 4; ++j) acc[i][j] += aa[i] * bb[j];
        }
    }
    if (col0 + tx * 4 < N) {
#pragma unroll
        for (int i = 0; i < 4; ++i)
            *(float4*)(C + (size_t)(row0 + ty * 4 + i) * ldc + col0 + tx * 4) = make_float4(acc[i][0], acc[i][1], acc[i][2], acc[i][3]);
    }
}
__device__ __forceinline__ void gemm_phase(const float* A, const float* Bm, float* C, int M, int N, int K, int lda, int ldb, int ldc, int half, int tid, float* sh) {
    const int ntx = (N + 63) / 64, nty = M / 64, ntile = ntx * nty, G2 = gridDim.x * 2;
    for (int t0 = blockIdx.x * 2; t0 < ntile; t0 += G2) {
        int tl = t0 + half; if (tl >= ntile) tl = ntile - 1;
        gemm_tile(A, Bm, C, N, K, lda, ldb, ldc, tl % ntx, tl / ntx, tid, sh);
    }
}

__device__ __forceinline__ void fox_prep(const float* proj, const float* __restrict__ bf, float* cbuf, int bh, int lane) {
    const int b = bh / FH, h = bh % FH;
    const float bias = bf[h];
    float s = 0.f;
    for (int i = 0; i < 64; ++i) { const int t = lane * 64 + i; s += logsigmoidf(proj[(size_t)(b * S + t) * INW + O_FF + h] + bias); }
    float inc = s;
    for (int o = 1; o < 64; o <<= 1) { const float n = __shfl_up(inc, o); if (lane >= o) inc += n; }
    float run = inc - s;
    for (int i = 0; i < 64; ++i) { const int t = lane * 64 + i; run += logsigmoidf(proj[(size_t)(b * S + t) * INW + O_FF + h] + bias); cbuf[(size_t)bh * S + t] = run; }
}

__device__ __forceinline__ void fox_attn(const float* proj, const float* cbuf, float* y, int blk, int lane) {
    const int qb = blk % (S / 64), bh = blk / (S / 64), b = bh / FH, h = bh % FH;
    const int t = qb * 64 + lane;
    const float* qp = proj + (size_t)(b * S + t) * INW + O_FQ + h * FD;
    float q[64], o[64];
#pragma unroll
    for (int d = 0; d < 64; ++d) { q[d] = qp[d] * 0.125f; o[d] = 0.f; }
    const float ct = cbuf[(size_t)bh * S + t];
    float m = -INFINITY, l = 0.f;
    const int smax = qb * 64 + 63;
    for (int s = 0; s <= smax; ++s) {
        const float* kp = proj + (size_t)(b * S + s) * INW + O_FK + h * FD;
        const float* vp = proj + (size_t)(b * S + s) * INW + O_FV + h * FD;
        float dot = 0.f;
#pragma unroll
        for (int d = 0; d < 64; ++d) dot += q[d] * kp[d];
        const float x = dot + (ct - cbuf[(size_t)bh * S + s]);
        if (s <= t) {
            if (x > m) { const float al = expf(m - x); l *= al;
#pragma unroll
                for (int d = 0; d < 64; ++d) o[d] *= al;
                m = x; }
            const float p = expf(x - m); l += p;
#pragma unroll
            for (int d = 0; d < 64; ++d) o[d] += p * vp[d];
        }
    }
    const float il = 1.f / l;
    float* yp = y + (size_t)(b * S + t) * D + h * FD;
#pragma unroll
    for (int d = 0; d < 64; ++d) yp[d] = o[d] * il;
}

__device__ __forceinline__ void gla_prep(const float* proj, const float* __restrict__ wgu, const float* __restrict__ bg, float* abuf, int t, int j) {
    const float* ga = proj + (size_t)t * INW + O_GA;
    float s = bg[j];
#pragma unroll
    for (int r = 0; r < RANK; ++r) s += ga[r] * wgu[r * 256 + j];
    abuf[(size_t)t * 256 + j] = expf(logsigmoidf(s) * (1.f / 16.f));
}

__device__ __forceinline__ void gla_rec(const float* proj, const float* abuf, float* glao, int bh, int e) {
    const int b = bh / GH, h = bh % GH;
    float st[64];
#pragma unroll
    for (int d = 0; d < 64; ++d) st[d] = 0.f;
    for (int s = 0; s < S; ++s) {
        const size_t t = (size_t)b * S + s;
        const float* qp = proj + t * INW + O_GQ + h * GK;
        const float* kp = proj + t * INW + O_GK + h * GK;
        const float* ap = abuf + t * 256 + h * GK;
        const float v = proj[t * INW + O_GV + h * GV + e];
        float o = 0.f;
#pragma unroll
        for (int d = 0; d < 64; ++d) { st[d] = ap[d] * st[d] + kp[d] * v; o += qp[d] * st[d]; }
        glao[t * 512 + h * GV + e] = o * 0.125f;
    }
}

__device__ __forceinline__ void gla_post(const float* glao, const float* proj, const float* __restrict__ g, float* y, int w, int lane) {
    const int t = w >> 2, h = w & 3;
    const float o0 = glao[(size_t)t * 512 + h * GV + lane], o1 = glao[(size_t)t * 512 + h * GV + 64 + lane];
    float ss = o0 * o0 + o1 * o1;
    for (int o = 32; o > 0; o >>= 1) ss += __shfl_xor(ss, o);
    const float r = rsqrtf(ss * (1.f / GV) + LN_EPS);
    const float g0 = proj[(size_t)t * INW + O_GR + h * GV + lane], g1 = proj[(size_t)t * INW + O_GR + h * GV + 64 + lane];
    y[(size_t)t * D + 512 + h * GV + lane] = o0 * r * g[lane] * siluf(g0);
    y[(size_t)t * D + 512 + h * GV + 64 + lane] = o1 * r * g[64 + lane] * siluf(g1);
}

__device__ __forceinline__ void route_token(const float* logits, const float* __restrict__ rbias, int* top_e, float* top_w, int* top_pos, int* counts, int t, int lane) {
    const float4 lg = ((const float4*)(logits + (size_t)t * NE))[lane];
    const float4 rb = ((const float4*)rbias)[lane];
    float sc[4] = {1.f / (1.f + expf(-lg.x)), 1.f / (1.f + expf(-lg.y)), 1.f / (1.f + expf(-lg.z)), 1.f / (1.f + expf(-lg.w))};
    float bv[4] = {sc[0] + rb.x, sc[1] + rb.y, sc[2] + rb.z, sc[3] + rb.w};
    float m1 = fmaxf(bv[0], bv[1]), m2 = fminf(bv[0], bv[1]);
    { const float a = fmaxf(bv[2], bv[3]), c = fminf(bv[2], bv[3]); const float n1 = fmaxf(m1, a); m2 = fmaxf(fminf(m1, a), fmaxf(m2, c)); m1 = n1; }
    for (int o = 1; o < 8; o <<= 1) { const float p1 = __shfl_xor(m1, o), p2 = __shfl_xor(m2, o); const float n1 = fmaxf(m1, p1); m2 = fmaxf(fminf(m1, p1), fmaxf(m2, p2)); m1 = n1; }
    const float gs = m1 + m2;
    const int myg = lane >> 3;
    int rank = 0;
#pragma unroll
    for (int g2 = 0; g2 < NG; ++g2) { const float og = __shfl(gs, g2 * 8); if (og > gs || (og == gs && g2 < myg)) ++rank; }
    const bool sel = rank < 4;
    float mv[4];
#pragma unroll
    for (int i = 0; i < 4; ++i) mv[i] = sel ? bv[i] : -INFINITY;
    int we[TOPK]; float ws[TOPK]; float wsum = 0.f;
#pragma unroll
    for (int k = 0; k < TOPK; ++k) {
        float bvv = mv[0]; int bi = 0;
#pragma unroll
        for (int i = 1; i < 4; ++i) if (mv[i] > bvv) { bvv = mv[i]; bi = i; }
        int gi = lane * 4 + bi;
        for (int o = 32; o > 0; o >>= 1) { const float ov = __shfl_xor(bvv, o); const int oi = __shfl_xor(gi, o); if (ov > bvv || (ov == bvv && oi < gi)) { bvv = ov; gi = oi; } }
        const int ol = gi >> 2, oi = gi & 3;
        const float s_own = (oi == 0) ? sc[0] : (oi == 1) ? sc[1] : (oi == 2) ? sc[2] : sc[3];
        const float sw = __shfl(s_own, ol);
        if (lane == ol) { if (oi == 0) mv[0] = -INFINITY; else if (oi == 1) mv[1] = -INFINITY; else if (oi == 2) mv[2] = -INFINITY; else mv[3] = -INFINITY; }
        we[k] = gi; ws[k] = sw; wsum += sw;
    }
    if (lane == 0) {
        const float inv = 2.5f / wsum;
#pragma unroll
        for (int k = 0; k < TOPK; ++k) {
            top_e[t * TOPK + k] = we[k]; top_w[t * TOPK + k] = ws[k] * inv;
            top_pos[t * TOPK + k] = atomicAdd(&counts[we[k]], 1);
        }
    }
}

__device__ __forceinline__ void moe_offsets(const int* counts, int* off, int* blk_exp, int* nblk, int lane) {
    int pc[4], st[4]; int tot = 0;
#pragma unroll
    for (int i = 0; i < 4; ++i) { pc[i] = (counts[lane * 4 + i] + PADR - 1) / PADR * PADR; st[i] = tot; tot += pc[i]; }
    int inc = tot;
    for (int o = 1; o < 64; o <<= 1) { const int n = __shfl_up(inc, o); if (lane >= o) inc += n; }
    const int base = inc - tot;
#pragma unroll
    for (int i = 0; i < 4; ++i) { const int start = base + st[i]; off[lane * 4 + i] = start; for (int k = start / PADR; k < (start + pc[i]) / PADR; ++k) blk_exp[k] = lane * 4 + i; }
    if (lane == 63) nblk[0] = inc / PADR;
}

__device__ __forceinline__ void moe_scatter(const int* top_e, const float* top_w, const int* top_pos, const int* off, int* row_tok, float* row_gate, int* slot_of, int a) {
    const int slot = off[top_e[a]] + top_pos[a];
    row_tok[slot] = a / TOPK; row_gate[slot] = top_w[a]; slot_of[a] = slot;
}

__device__ __forceinline__ void moe_hidden(const float* h1, const float* __restrict__ wg, const float* __restrict__ wu, const int* row_tok, const float* row_gate, const int* blk_exp, const int* nblk,
                                           float* hidden, int g16, int j, float* sh) {
    const bool active = g16 * 16 < nblk[0] * PADR;
    float (*xs)[D] = (float (*)[D])sh;
    __syncthreads();
    if (active) for (int r = 0; r < 16; ++r) { const int tok = row_tok[g16 * 16 + r]; ((float4*)xs[r])[j] = ((const float4*)(h1 + (size_t)tok * D))[j]; }
    __syncthreads();
    if (!active) return;
    const int e = blk_exp[(g16 * 16) / PADR];
    float ag[16], au[16];
#pragma unroll
    for (int r = 0; r < 16; ++r) { ag[r] = 0.f; au[r] = 0.f; }
    const float* wgp = wg + (size_t)e * D * ED + j; const float* wup = wu + (size_t)e * D * ED + j;
    for (int d = 0; d < D; d += 4) {
        const float g0 = wgp[(size_t)(d + 0) * ED], g1 = wgp[(size_t)(d + 1) * ED], g2 = wgp[(size_t)(d + 2) * ED], g3 = wgp[(size_t)(d + 3) * ED];
        const float u0 = wup[(size_t)(d + 0) * ED], u1 = wup[(size_t)(d + 1) * ED], u2 = wup[(size_t)(d + 2) * ED], u3 = wup[(size_t)(d + 3) * ED];
#pragma unroll
        for (int r = 0; r < 16; ++r) { const float4 x = *(const float4*)&xs[r][d];
            ag[r] += x.x * g0 + x.y * g1 + x.z * g2 + x.w * g3; au[r] += x.x * u0 + x.y * u1 + x.z * u2 + x.w * u3; }
    }
#pragma unroll
    for (int r = 0; r < 16; ++r) hidden[(size_t)(g16 * 16 + r) * ED + j] = row_gate[g16 * 16 + r] * siluf(ag[r]) * au[r];
}

__device__ __forceinline__ void moe_down(const float* hidden, const float* __restrict__ wd, const int* top_e, const int* slot_of, float* ffn, int t, int i, float* sh) {
    float4 acc = ((float4*)(ffn + (size_t)t * D))[i];
    for (int k = 0; k < TOPK; ++k) {
        const int e = top_e[t * TOPK + k], slot = slot_of[t * TOPK + k];
        __syncthreads();
        sh[i] = hidden[(size_t)slot * ED + i];
        __syncthreads();
        const float4* wp = (const float4*)(wd + (size_t)e * ED * D) + i;
        for (int j = 0; j < ED; ++j) { const float4 w = wp[(size_t)j * (D / 4)]; const float hv = sh[j]; acc.x += hv * w.x; acc.y += hv * w.y; acc.z += hv * w.z; acc.w += hv * w.w; }
    }
    ((float4*)(ffn + (size_t)t * D))[i] = acc;
}
}
#include <hip/hip_bf16.h>
#include <cmath>
namespace attn_body {
using bf16=__hip_bfloat16;
using bf16x8=__attribute__((ext_vector_type(8)))short;
using s16x4=__attribute__((ext_vector_type(4)))short;
using f32x16=__attribute__((ext_vector_type(16)))float;
using u32x4=__attribute__((ext_vector_type(4)))unsigned;
constexpr int BATCH=8,NHEAD=8,SEQ=4096,D=64,DM=3072,OPITCH=1024;
constexpr int NW=8,QBLK=32,QB=QBLK*NW,KVBLK=64,NQB=SEQ/QB;
constexpr int ATTN_PITCH=DM, ATTN_UNIT_ROWS=QB;
__device__ __forceinline__ int crow(int r,int hi){return (r&3)+8*(r>>2)+4*hi;}
#define SBAR() __builtin_amdgcn_sched_barrier(0)
__device__ __forceinline__ void cmask(f32x16&p0,f32x16&p1,int jb,int qrel,int hi){
  const float NEG=-INFINITY; int kb=64*jb+4*hi;
  #pragma unroll
  for(int r=0;r<16;++r){int kv=kb+(r&3)+8*(r>>2); if(kv>qrel)p0[r]=NEG; if(kv+32>qrel)p1[r]=NEG;}
}

constexpr int NSLOT=3, SLOTB=8192;
constexpr int LDS_K=0, LDS_V=NSLOT*SLOTB, LDS_WS=2*NSLOT*SLOTB, LDS_OST=LDS_WS+NW*64*4, LDS_KB=LDS_OST+NW*4096, LDS_BYTES=LDS_KB+(SEQ+2)*8;
constexpr float C2=0.125f*1.4426950408889634f;
__device__ __forceinline__ void glds16(const void*gsrc,unsigned lds_dst){unsigned keep;
  asm volatile("s_mov_b32 %0, m0\n\ts_mov_b32 m0, %2\n\ts_nop 0\n\tglobal_load_lds_dwordx4 %1, off\n\ts_mov_b32 m0, %0":"=&s"(keep):"v"(gsrc),"s"(lds_dst):"memory");}
__device__ __forceinline__ float max3f(float a,float b,float c){float r;asm("v_max3_f32 %0, %1, %2, %3":"=v"(r):"v"(a),"v"(b),"v"(c));return r;}
__device__ __forceinline__ float max2f(float a,float b){float r;asm("v_max_f32_e32 %0, %1, %2":"=v"(r):"v"(a),"v"(b));return r;}
__device__ __forceinline__ float fadd_s(float a,float b){float r;asm("v_add_f32_e32 %0, %1, %2":"=v"(r):"v"(a),"v"(b));return r;}
__device__ __forceinline__ float fsub_s(float a,float b){float r;asm("v_sub_f32_e32 %0, %1, %2":"=v"(r):"v"(a),"v"(b));return r;}
typedef float f32x2_t __attribute__((ext_vector_type(2))); typedef float f32x4_t __attribute__((ext_vector_type(4))); typedef __bf16 bf16x2_t __attribute__((ext_vector_type(2)));
__device__ __forceinline__ unsigned cvtpk_s(float lo,float hi){f32x2_t v={lo,hi};bf16x2_t b=__builtin_convertvector(v,bf16x2_t);return __builtin_bit_cast(unsigned,b);}
#define WAIT_BAR(N) asm volatile("s_waitcnt vmcnt(" #N ") lgkmcnt(0)\n\ts_barrier":::"memory")

__device__ __forceinline__ void split3(float b,unsigned&h,unsigned&m,unsigned&l){
  h=cvtpk_s(b,0.f)&0xffffu; const float r1=b-__uint_as_float(h<<16);
  m=cvtpk_s(r1,0.f)&0xffffu; const float r2=r1-__uint_as_float(m<<16);
  l=cvtpk_s(r2,0.f)&0xffffu; }
__device__ __forceinline__ bf16x8 kbias_frag(float b,int hi){unsigned h,m,l;split3(b,h,m,l);u32x4 w;w.x=h|(m<<16);w.y=l|0x3F800000u;w.z=0x3F803F80u;w.w=0u;if(hi){w.x=0u;w.y=0u;w.z=0u;}return __builtin_bit_cast(bf16x8,w);}
__device__ __forceinline__ bf16x8 qref_frag(float x,int hi){unsigned h,m,l;split3(x,h,m,l);u32x4 w;w.x=0x3F803F80u;w.y=0x3F80u|(h<<16);w.z=m|(l<<16);w.w=0u;if(hi){w.x=0u;w.y=0u;w.z=0u;}return __builtin_bit_cast(bf16x8,w);}
typedef unsigned u32x2_t __attribute__((ext_vector_type(2)));
__device__ __forceinline__ bf16x8 mkfrag(u32x2_t e,unsigned zc){u32x4 w;w.x=e.x;w.y=e.y;w.z=zc;w.w=0u;return __builtin_bit_cast(bf16x8,w);}
__device__ __forceinline__ void fox_bias_table(int b,int h,const float*LF,char*shm){
  int tid_=threadIdx.x; asm volatile("":"+v"(tid_)); const int tid=tid_,lane=tid&63,wid=__builtin_amdgcn_readfirstlane(tid>>6);
  const float*lf=LF+((long)b*NHEAD+h)*SEQ; float*wt=(float*)(shm+LDS_WS); u32x2_t*KB8=(u32x2_t*)(shm+LDS_KB);
  f32x4_t va=*(const f32x4_t*)(lf+8*tid),vb=*(const f32x4_t*)(lf+8*tid+4);
  va[1]+=va[0];va[2]+=va[1];va[3]+=va[2];vb[0]+=va[3];vb[1]+=vb[0];vb[2]+=vb[1];vb[3]+=vb[2];
  const float tot=vb[3]; float inc=tot;
  #pragma unroll
  for(int o_=1;o_<64;o_<<=1){const float nn=__shfl_up(inc,o_);if(lane>=o_)inc+=nn;}
  __syncthreads();
  if(lane==63)wt[wid*64]=inc;
  __syncthreads();
  float base=inc-tot;
  #pragma unroll
  for(int w_=0;w_<NW;++w_){const float x_=wt[w_*64]; if(w_<wid)base+=x_;}
  const float cv[8]={va[0]+base,va[1]+base,va[2]+base,va[3]+base,vb[0]+base,vb[1]+base,vb[2]+base,vb[3]+base};
  #pragma unroll
  for(int j=0;j<8;++j){unsigned hh,mm,ll;split3(-cv[j],hh,mm,ll);KB8[8*tid+j]=(u32x2_t){hh|(mm<<16),ll|0x3F800000u};}
  if(tid==0){KB8[SEQ]=(u32x2_t){0u,0u};KB8[SEQ+1]=(u32x2_t){0u,0u};}
  __syncthreads();
}
__device__ __forceinline__ void qkt(f32x16&p0,f32x16&p1,const char*Kslot,const bf16x8*qr,bf16x8 kb0,bf16x8 kb1,bf16x8 qx,int r32,int hi){
  const f32x16 negm=f32x16{};
  const char*kb=Kslot+hi*1024+r32*16;
  #pragma unroll
  for(int d0=0;d0<4;++d0){
    const bf16x8 b0=*reinterpret_cast<const bf16x8*>(kb+d0*2048);
    const bf16x8 b1=*reinterpret_cast<const bf16x8*>(kb+d0*2048+512);
    if(d0==0){p0=__builtin_amdgcn_mfma_f32_32x32x16_bf16(b0,qr[0],negm,0,0,0);p1=__builtin_amdgcn_mfma_f32_32x32x16_bf16(b1,qr[0],negm,0,0,0);}
    else{p0=__builtin_amdgcn_mfma_f32_32x32x16_bf16(b0,qr[d0],p0,0,0,0);p1=__builtin_amdgcn_mfma_f32_32x32x16_bf16(b1,qr[d0],p1,0,0,0);}}
  p0=__builtin_amdgcn_mfma_f32_32x32x16_bf16(kb0,qx,p0,0,0,0);p1=__builtin_amdgcn_mfma_f32_32x32x16_bf16(kb1,qx,p1,0,0,0);
}
typedef __attribute__((address_space(3))) const char* lds_cptr;
typedef short v4i16_t __attribute__((ext_vector_type(4)));
__device__ __forceinline__ void kload8(bf16x8*kf,lds_cptr kp){
  kf[0]=*(const __attribute__((address_space(3))) bf16x8*)(kp);      kf[1]=*(const __attribute__((address_space(3))) bf16x8*)(kp+512);
  kf[2]=*(const __attribute__((address_space(3))) bf16x8*)(kp+2048); kf[3]=*(const __attribute__((address_space(3))) bf16x8*)(kp+2560);
  kf[4]=*(const __attribute__((address_space(3))) bf16x8*)(kp+4096); kf[5]=*(const __attribute__((address_space(3))) bf16x8*)(kp+4608);
  kf[6]=*(const __attribute__((address_space(3))) bf16x8*)(kp+6144); kf[7]=*(const __attribute__((address_space(3))) bf16x8*)(kp+6656);
}
__device__ __forceinline__ void kload2(bf16x8*kf,lds_cptr kp,int j){ kf[2*j]=*(const __attribute__((address_space(3))) bf16x8*)(kp+j*2048); kf[2*j+1]=*(const __attribute__((address_space(3))) bf16x8*)(kp+j*2048+512); }
__device__ __forceinline__ s16x4 vtr(lds_cptr p){ return __builtin_bit_cast(s16x4,__builtin_amdgcn_ds_read_tr16_b64_v4i16((__attribute__((address_space(3))) v4i16_t*)p)); }
__device__ __forceinline__ float rowmax(const f32x16&p0,const f32x16&p1){
  float a=max3f(p0[0],p0[1],p1[0]),b=max3f(p0[2],p0[3],p1[1]);a=max3f(a,p1[2],p1[3]);
  #pragma unroll
  for(int r=4;r<16;r+=4){a=max3f(a,p0[r],p0[r+1]);b=max3f(b,p0[r+2],p0[r+3]);a=max3f(a,p1[r],p1[r+1]);b=max3f(b,p1[r+2],p1[r+3]);}
  const float m=max2f(a,b);
  auto rr=__builtin_amdgcn_permlane32_swap(__float_as_uint(m),__float_as_uint(m),false,false);
  return max2f(__uint_as_float(rr[0]),__uint_as_float(rr[1]));
}
__device__ __forceinline__ void pv(f32x16*o,int vb,bf16x8 pa0,bf16x8 pa1,bf16x8 pa2,bf16x8 pa3){
  #pragma unroll
  for(int d0=0;d0<2;++d0){s16x4 lo[4],hi[4];
    #pragma unroll
    for(int ks=0;ks<4;++ks){
      asm volatile("ds_read_b64_tr_b16 %0,%1 offset:%c2":"=&v"(lo[ks]):"v"(vb),"i"(d0*4096+ks*1024):"memory");
      asm volatile("ds_read_b64_tr_b16 %0,%1 offset:%c2":"=&v"(hi[ks]):"v"(vb),"i"(d0*4096+ks*1024+512):"memory");}
    asm volatile("s_waitcnt lgkmcnt(0)":::"memory");SBAR();
    #define PK(k) (bf16x8){lo[k][0],lo[k][1],lo[k][2],lo[k][3],hi[k][0],hi[k][1],hi[k][2],hi[k][3]}
    o[d0]=__builtin_amdgcn_mfma_f32_32x32x16_bf16(pa0,PK(0),o[d0],0,0,0);
    o[d0]=__builtin_amdgcn_mfma_f32_32x32x16_bf16(pa1,PK(1),o[d0],0,0,0);
    o[d0]=__builtin_amdgcn_mfma_f32_32x32x16_bf16(pa2,PK(2),o[d0],0,0,0);
    o[d0]=__builtin_amdgcn_mfma_f32_32x32x16_bf16(pa3,PK(3),o[d0],0,0,0);
    #undef PK
  }
}

#ifndef ATTN_STORE16
#define ATTN_STORE16(p,v) (*(u32x4*)(p)=(v))
#endif
template<int THRL> __device__ __forceinline__ void attn_unit(int b,int h,int qb,const bf16*Q,const bf16* K,const bf16* V,bf16*O,const float*LF,const unsigned*NRM,char*shm){
  int tid_=threadIdx.x; asm volatile("":"+v"(tid_));
  const int tid=tid_,lane=tid&63,r32=lane&31,hi=lane>>5; const int wid=__builtin_amdgcn_readfirstlane(tid>>6);
  const long rowbase=(long)b*SEQ; const int q0=qb*QB;
  const char*KBt0=shm+LDS_KB;
  int t0;
  { const int NT0=(q0+QB)/KVBLK; const unsigned*nr=NRM+(b*NHEAD+h)*4;
    const float qn2=__uint_as_float(nr[0])+__uint_as_float(nr[1]), kn2=__uint_as_float(nr[2])+__uint_as_float(nr[3]);
    const float thr=-(50.f+2.04f*sqrtf(qn2*kn2));
    const u32x2_t eq0=*(const u32x2_t*)(KBt0+(unsigned)q0*8u); const float bq0=__uint_as_float(eq0.x<<16)+__uint_as_float(eq0.x&0xffff0000u)+__uint_as_float(eq0.y<<16);
    bool ok=(2*lane<=NT0-4);
    if(ok&&lane>0){ const u32x2_t el=*(const u32x2_t*)(KBt0+(unsigned)(128*lane-1)*8u); const float bl=__uint_as_float(el.x<<16)+__uint_as_float(el.x&0xffff0000u)+__uint_as_float(el.y<<16); ok=(bl-bq0<thr); }
    const unsigned long long mk=__ballot(ok); const unsigned long long low=~mk; const int cnt=(low==0ull)?64:__builtin_ctzll(low);
    t0=__builtin_amdgcn_readfirstlane(2*(cnt-1)); }
  const char*KBt=KBt0+(hi?0:t0*512); const unsigned kb_o0=hi?(unsigned)SEQ*8u:(unsigned)r32*8u, kb_o1=hi?(unsigned)SEQ*8u:(unsigned)(r32+32)*8u, kb_str=hi?0u:512u, zc=hi?0u:0x3F803F80u;
  const bf16*Qw=Q+(rowbase+q0+wid*QBLK)*DM+h*D;
  const bf16*Kh=K+(rowbase+(long)t0*KVBLK)*DM+h*D,*Vh=V+(rowbase+(long)t0*KVBLK)*DM+h*D;
  const unsigned lds0=(unsigned)(uintptr_t)shm;
  float*wsf=(float*)(shm+LDS_WS)+wid*64;
  const bf16*ksrc=Kh+(long)lane*DM+wid*8;
  const bf16*vsrc=Vh+(long)(16*(wid&3)+(lane>>2))*DM+(wid>>2)*32+(lane&3)*8;
  const unsigned kdst=lds0+LDS_K+wid*1024, vdst=lds0+LDS_V+wid*1024;
  #define DMA_K(t,slot) glds16(ksrc+(long)(t)*KVBLK*DM,(unsigned)__builtin_amdgcn_readfirstlane(kdst+(slot)))
  #define DMA_V(t,slot) glds16(vsrc+(long)(t)*KVBLK*DM,(unsigned)__builtin_amdgcn_readfirstlane(vdst+(slot)))
  const int vb0=(int)(lds0+LDS_V)+((lane>>4)&1)*32+(lane&3)*8+(4*hi+((lane&15)>>2))*64;
  const char*Kbase=shm+LDS_K; bf16x8 kf[8];
  const lds_cptr shm3=(lds_cptr)shm; const lds_cptr kp0=shm3+LDS_K+hi*1024+r32*16; const lds_cptr vp0=shm3+LDS_V+((lane>>4)&1)*32+(lane&3)*8+(4*hi+((lane&15)>>2))*64;
  const int NT=(q0+QB)/KVBLK-t0;
  DMA_K(0,0);DMA_V(0,0);DMA_K(1,SLOTB);
  bf16x8 qr[4];
  #pragma unroll
  for(int d0=0;d0<4;++d0)qr[d0]=*reinterpret_cast<const bf16x8*>(&Qw[(long)r32*DM+d0*16+hi*8]);
  float mhat; { const u32x2_t eq=*(const u32x2_t*)(KBt0+(unsigned)(q0+wid*QBLK+r32)*8u); mhat=__uint_as_float(eq.x<<16)+__uint_as_float(eq.x&0xffff0000u)+__uint_as_float(eq.y<<16); }
  float l_reg=0.f;f32x16 o[2];o[0]=f32x16{};o[1]=f32x16{};const f32x16 negm=f32x16{};
  bf16x8 qx=qref_frag(-mhat,hi);
  const int qrel=wid*QBLK+r32;
  #define CMASK(P0,P1,t) do{int jb_=(t)-(NT-4); if(jb_>=0)cmask(P0,P1,jb_,qrel,hi);}while(0)
  bool resc=false;
  #define START(P0,P1) do{ const float rm=rowmax(P0,P1); resc=false; \
    { const float dl=__builtin_fmaxf(rm,0.f); mhat=fadd_s(mhat,dl); \
      _Pragma("unroll") for(int r=0;r<16;++r){P0[r]=fsub_s(P0[r],dl);P1[r]=fsub_s(P1[r],dl);} \
      qx=qref_frag(-mhat,hi); } \
    _Pragma("unroll") for(int r=0;r<16;++r)P0[r]=__builtin_amdgcn_exp2f(P0[r]); }while(0)
  #define RESC() do{ if(resc){ asm volatile("s_waitcnt lgkmcnt(0)":::"memory"); \
      _Pragma("unroll") for(int d_=0;d_<2;++d_) _Pragma("unroll") for(int r=0;r<16;++r)o[d_][r]*=wsf[crow(r,hi)]; } }while(0)
  f32x16 pA0,pA1,pB0,pB1;
  int sl_prev=0,sl_cur=0,sl_next=SLOTB;
  #define ROT() do{sl_prev=sl_cur;sl_cur=sl_next;sl_next=(sl_next==(NSLOT-1)*SLOTB)?0:sl_next+SLOTB;}while(0)
  DMA_K(2,2*SLOTB);
  WAIT_BAR(3);
  qkt(pA0,pA1,Kbase,qr,mkfrag(*(const u32x2_t*)(KBt+kb_o0),zc),mkfrag(*(const u32x2_t*)(KBt+kb_o1),zc),qx,r32,hi);asm volatile("s_nop 15\n\ts_nop 7":"+v"(pA0),"+v"(pA1));CMASK(pA0,pA1,0);
  START(pA0,pA1);
  _Pragma("unroll") for(int r=0;r<16;++r)pA1[r]=__builtin_amdgcn_exp2f(pA1[r]);
  WAIT_BAR(0);
  DMA_K(3,0);DMA_V(1,SLOTB);
  ROT();
  kload8(kf,kp0+sl_cur);
  WAIT_BAR(2);
  s16x4 vlo[8],vhi[8]; u32x4 pw0,pw1,pw2,pw3;
  #define PKW(P,B) cvtpk_s(P[B],P[B+1])
  #define PAF(k) __builtin_bit_cast(bf16x8,pw##k)
  #define VFR(i) (bf16x8){vlo[i][0],vlo[i][1],vlo[i][2],vlo[i][3],vhi[i][0],vhi[i][1],vhi[i][2],vhi[i][3]}
  #define PIN(x) asm volatile("":"+v"(x))
  #define MX3(a,b,c) __builtin_fmaxf(__builtin_fmaxf((a),(b)),(c))
  #define GAPA(MF,A0,A1,A2,A3,W0,W1,PW) do{ MF; sacc+=A0; sacc+=A1; sacc+=A2; sacc+=A3; PIN(sacc); W0; W1; PIN(PW); SBAR(); }while(0)
  #define EX(v) __builtin_amdgcn_exp2f(v)
  #define GAPB(MF,X,B) do{ MF; X[B]=EX(X[B]); X[B+1]=EX(X[B+1]); X[B+2]=EX(X[B+2]); X[B+3]=EX(X[B+3]); PIN(X); SBAR(); }while(0)
  #define VRD(i) do{ vlo[i]=vtr(vp_+(((i)>>2)*4096+((i)&3)*1024)); vhi[i]=vtr(vp_+(((i)>>2)*4096+((i)&3)*1024+512)); }while(0)
  #define KRD(G,j) do{ if(G){ kload2(kf,kp0+sl_next,j); SBAR(); } }while(0)
  #define STEP(C0,C1,P0,P1,t,GK,GV,GL) do{ SBAR(); \
    const lds_cptr vp_=vp0+sl_prev; const u32x2_t e0_=*(const u32x2_t*)(KBt+kb_o0+(unsigned)(t)*kb_str),e1_=*(const u32x2_t*)(KBt+kb_o1+(unsigned)(t)*kb_str); \
    VRD(0); SBAR(); float sacc=(P0[0]+P0[1]); \
    GAPA(C0=__builtin_amdgcn_mfma_f32_32x32x16_bf16(kf[0],qr[0],negm,0,0,0), P0[2],P0[3],P0[4],P0[5],     pw0[0]=PKW(P0,0), pw0[1]=PKW(P0,2), pw0); \
    VRD(4); SBAR(); GAPA(C1=__builtin_amdgcn_mfma_f32_32x32x16_bf16(kf[1],qr[0],negm,0,0,0), P0[6],P0[7],P0[8],P0[9],     pw0[2]=PKW(P0,4), pw0[3]=PKW(P0,6), pw0); \
    VRD(1); SBAR(); GAPA(C0=__builtin_amdgcn_mfma_f32_32x32x16_bf16(kf[2],qr[1],C0,0,0,0),   P0[10],P0[11],P0[12],P0[13], pw1[0]=PKW(P0,8), pw1[1]=PKW(P0,10), pw1); \
    VRD(5); SBAR(); GAPA(C1=__builtin_amdgcn_mfma_f32_32x32x16_bf16(kf[3],qr[1],C1,0,0,0),   P0[14],P0[15],P1[0],P1[1],   pw1[2]=PKW(P0,12),pw1[3]=PKW(P0,14), pw1); \
    VRD(2); SBAR(); GAPA(C0=__builtin_amdgcn_mfma_f32_32x32x16_bf16(kf[4],qr[2],C0,0,0,0),   P1[2],P1[3],P1[4],P1[5],     pw2[0]=PKW(P1,0), pw2[1]=PKW(P1,2), pw2); \
    VRD(6); SBAR(); GAPA(C1=__builtin_amdgcn_mfma_f32_32x32x16_bf16(kf[5],qr[2],C1,0,0,0),   P1[6],P1[7],P1[8],P1[9],     pw2[2]=PKW(P1,4), pw2[3]=PKW(P1,6), pw2); \
    VRD(3); SBAR(); GAPA(C0=__builtin_amdgcn_mfma_f32_32x32x16_bf16(kf[6],qr[3],C0,0,0,0),   P1[10],P1[11],P1[12],P1[13], pw3[0]=PKW(P1,8), pw3[1]=PKW(P1,10), pw3); \
    VRD(7); SBAR(); GAPA(C1=__builtin_amdgcn_mfma_f32_32x32x16_bf16(kf[7],qr[3],C1,0,0,0),   P1[14],P1[15],0.f,0.f,       pw3[2]=PKW(P1,12),pw3[3]=PKW(P1,14), pw3); \
    { const bf16x8 kb0_=mkfrag(e0_,zc),kb1_=mkfrag(e1_,zc); C0=__builtin_amdgcn_mfma_f32_32x32x16_bf16(kb0_,qx,C0,0,0,0); C1=__builtin_amdgcn_mfma_f32_32x32x16_bf16(kb1_,qx,C1,0,0,0); } SBAR(); \
    l_reg+=sacc; \
    if(GK){DMA_K((t)+3,sl_cur);} if(GV){DMA_V((t)+1,sl_next);} \
    CMASK(C0,C1,t); \
    { float a=MX3(C0[0],C0[1],C1[0]),b=MX3(C0[2],C0[3],C1[1]); a=MX3(a,C1[2],C1[3]); \
      _Pragma("unroll") for(int r=4;r<16;r+=4){a=MX3(a,C0[r],C0[r+1]);b=MX3(b,C0[r+2],C0[r+3]);a=MX3(a,C1[r],C1[r+1]);b=MX3(b,C1[r+2],C1[r+3]);} \
      float rm=__builtin_fmaxf(a,b); { auto rr=__builtin_amdgcn_permlane32_swap(__float_as_uint(rm),__float_as_uint(rm),false,false); rm=__builtin_fmaxf(__uint_as_float(rr[0]),__uint_as_float(rr[1])); } \
      resc=false; \
      if(__builtin_expect(__any(rm>(float)THRL),0)){ const float dl=__builtin_fmaxf(rm,0.f); mhat+=dl; \
        _Pragma("unroll") for(int r=0;r<16;++r){C0[r]-=dl;C1[r]-=dl;} \
        qx=qref_frag(-mhat,hi); \
        const float f=__builtin_amdgcn_exp2f(-dl); l_reg*=f; if(hi==0)wsf[r32]=f; resc=true; } } \
    SBAR(); \
    GAPB(o[0]=__builtin_amdgcn_mfma_f32_32x32x16_bf16(PAF(0),VFR(0),o[0],0,0,0), C0,0); \
    GAPB(o[1]=__builtin_amdgcn_mfma_f32_32x32x16_bf16(PAF(0),VFR(4),o[1],0,0,0), C0,4); \
    KRD(GL,0); GAPB(o[0]=__builtin_amdgcn_mfma_f32_32x32x16_bf16(PAF(1),VFR(1),o[0],0,0,0), C0,8); \
    KRD(GL,1); GAPB(o[1]=__builtin_amdgcn_mfma_f32_32x32x16_bf16(PAF(1),VFR(5),o[1],0,0,0), C0,12); \
    KRD(GL,2); GAPB(o[0]=__builtin_amdgcn_mfma_f32_32x32x16_bf16(PAF(2),VFR(2),o[0],0,0,0), C1,0); \
    KRD(GL,3); GAPB(o[1]=__builtin_amdgcn_mfma_f32_32x32x16_bf16(PAF(2),VFR(6),o[1],0,0,0), C1,4); \
    GAPB(o[0]=__builtin_amdgcn_mfma_f32_32x32x16_bf16(PAF(3),VFR(3),o[0],0,0,0), C1,8); \
    GAPB(o[1]=__builtin_amdgcn_mfma_f32_32x32x16_bf16(PAF(3),VFR(7),o[1],0,0,0), C1,12); \
    }while(0)
  int t=1;
  #undef CMASK
  #define CMASK(P0,P1,t) do{}while(0)
  for(;t+5<NT;t+=2){
    STEP(pB0,pB1,pA0,pA1,t,true,true,true);     WAIT_BAR(2); RESC(); ROT();
    STEP(pA0,pA1,pB0,pB1,t+1,true,true,true);   WAIT_BAR(2); RESC(); ROT();
  }
  #undef CMASK
  #define CMASK(P0,P1,t) do{int jb_=(t)-(NT-4); if(jb_>=0)cmask(P0,P1,jb_,qrel,hi);}while(0)
  #define ENDW(tt) do{ if((tt)+3<NT){WAIT_BAR(2);} else if((tt)+2<NT){WAIT_BAR(1);} else {WAIT_BAR(0);} }while(0)
  for(;t+1<NT;t+=2){
    STEP(pB0,pB1,pA0,pA1,t,(t+3<NT),(t+1<NT),(t+1<NT));       ENDW(t);   RESC(); ROT();
    STEP(pA0,pA1,pB0,pB1,t+1,(t+4<NT),(t+2<NT),(t+2<NT));     ENDW(t+1); RESC(); ROT();
  }
  STEP(pB0,pB1,pA0,pA1,NT-1,false,false,false); RESC();
  { float sacc=pB0[0]+pB0[1]; _Pragma("unroll") for(int r=2;r<16;++r)sacc+=pB0[r]; _Pragma("unroll") for(int r=0;r<16;++r)sacc+=pB1[r]; l_reg+=sacc;
    pw0=(u32x4){PKW(pB0,0),PKW(pB0,2),PKW(pB0,4),PKW(pB0,6)};pw1=(u32x4){PKW(pB0,8),PKW(pB0,10),PKW(pB0,12),PKW(pB0,14)};pw2=(u32x4){PKW(pB1,0),PKW(pB1,2),PKW(pB1,4),PKW(pB1,6)};pw3=(u32x4){PKW(pB1,8),PKW(pB1,10),PKW(pB1,12),PKW(pB1,14)};
    SBAR(); pv(o,vb0+sl_cur,PAF(0),PAF(1),PAF(2),PAF(3)); }
  #undef PKW
  #undef PAF
  #undef VFR
  #undef PIN
  #undef MX3
  #undef GAPA
  #undef GAPB
  #undef EX
  #undef VRD
  #undef KRD
  #undef STEP
  #undef ENDW
  {auto rr=__builtin_amdgcn_permlane32_swap(__float_as_uint(l_reg),__float_as_uint(l_reg),false,false);l_reg=__uint_as_float(rr[0])+__uint_as_float(rr[1]);}
  if(hi==0)wsf[32+r32]=l_reg;asm volatile("s_waitcnt lgkmcnt(0)":::"memory");
  float rli[16];
  #pragma unroll
  for(int r=0;r<16;++r)rli[r]=__builtin_amdgcn_rcpf(wsf[32+crow(r,hi)]);
  bf16*Ow=O+(rowbase+q0+wid*QBLK)*OPITCH+h*D;
  { bf16*stg=(bf16*)(shm+LDS_OST)+wid*2048;
    #pragma unroll
    for(int r=0;r<16;++r){const int orow=crow(r,hi);
      #pragma unroll
      for(int d0=0;d0<2;++d0)stg[orow*64+d0*32+r32]=__float2bfloat16(o[d0][r]*rli[r]);}
    asm volatile("s_waitcnt lgkmcnt(0)":::"memory");
    #pragma unroll
    for(int i=0;i<4;++i){const int row=i*8+(lane>>3),ch=lane&7; const u32x4 v=*(const u32x4*)(stg+row*64+ch*8); ATTN_STORE16(Ow+(long)row*OPITCH+ch*8,v);} }
  asm volatile("s_waitcnt lgkmcnt(0)\n\ts_barrier":::"memory");
  #undef DMA_K
  #undef DMA_V
  #undef CMASK
  #undef START
  #undef RESC
  #undef ROT
}
constexpr int ATTN_LDS_BYTES=LDS_BYTES;
struct AttnTensors { const bf16* Q; const bf16* K; const bf16* V; bf16* O; const float* LF; const unsigned* NRM; };
struct AttnUnit { int bh; int qb; };
struct StaticOrder {
  int vcu,grid;
  __device__ __forceinline__ explicit StaticOrder(int grid_,int block):vcu((grid_%8==0)?(block%8)*(grid_/8)+block/8:block),grid(grid_){}
  __device__ __forceinline__ bool next(int i,AttnUnit&u)const{
    if(grid==256){ if(i>=4)return false; const int s=vcu&3; u.bh=vcu>>2; u.qb=(i==0)?s:(i==1)?7-s:(i==2)?8+s:15-s; return true; }
    const int L=i*grid+vcu; if(L>=BATCH*NHEAD*NQB)return false; u.bh=L/NQB; u.qb=L%NQB; return true; }
  __device__ __forceinline__ void a_ready(const AttnUnit&)const{}
  __device__ __forceinline__ void done(const AttnUnit&)const{}
};
template<class Sched,int THRL=8> __device__ __forceinline__ void attn_phase(char*lds,const AttnTensors&T,const Sched&S){
  AttnUnit u; int cur_bh=-1;
  for(int i=0;S.next(i,u);++i){ S.a_ready(u); if(u.bh!=cur_bh){ fox_bias_table(u.bh/NHEAD,u.bh%NHEAD,T.LF,lds); cur_bh=u.bh; }
    attn_unit<THRL>(u.bh/NHEAD,u.bh%NHEAD,u.qb,T.Q,T.K,T.V,T.O,T.LF,T.NRM,lds); S.done(u); }
}
template<int THRL=8> __device__ __forceinline__ void attn_phase_dyn(char*lds,const AttnTensors&T,unsigned*qhead,volatile int*slot){
  int cur_bh=-1; const int NU=BATCH*NHEAD*NQB;
  if(threadIdx.x==0) slot[0]=(int)__hip_atomic_fetch_add(qhead,1u,__ATOMIC_RELAXED,__HIP_MEMORY_SCOPE_AGENT);
  __syncthreads();
  int idx=__builtin_amdgcn_readfirstlane(slot[0]);
  while(idx<NU){
    __syncthreads();
    if(threadIdx.x==0) slot[0]=(int)__hip_atomic_fetch_add(qhead,1u,__ATOMIC_RELAXED,__HIP_MEMORY_SCOPE_AGENT);
    const int qb=NQB-1-idx/(BATCH*NHEAD), bh=idx%(BATCH*NHEAD);
    if(bh!=cur_bh){ fox_bias_table(bh/NHEAD,bh%NHEAD,T.LF,lds); cur_bh=bh; }
    attn_unit<THRL>(bh/NHEAD,bh%NHEAD,qb,T.Q,T.K,T.V,T.O,T.LF,T.NRM,lds);
    __syncthreads();
    idx=__builtin_amdgcn_readfirstlane(slot[0]);
  }
}
#undef SBAR
#undef WAIT_BAR
}
namespace fx {
using namespace nv;
typedef unsigned short bf16;
typedef unsigned v4u __attribute__((ext_vector_type(4)));
typedef float f32x4 __attribute__((ext_vector_type(4)));
constexpr float C2 = 0.125f * 1.4426950408889634f;
constexpr int NIN = 3328;
constexpr int QKVP = 3072;
constexpr int P_FQ = 0, P_FK = 512, P_FV = 1024, P_GQ = 1536, P_GK = 1792, P_GV = 2048, P_GR = 2560;
__device__ __forceinline__ int inproj_src(int d) {
    if (d < 1536) return d;
    if (d < 1792) return O_GQ + (d - 1536);
    if (d < 2048) return O_GK + (d - 1792);
    if (d < 2560) return O_GV + (d - 2048);
    if (d < 3072) return O_GR + (d - 2560);
    if (d < 3080) return O_FF + (d - 3072);
    if (d < 3096) return O_GA + (d - 3080);
    return -1;
}
__device__ __forceinline__ unsigned f2bf(float f) { unsigned u = __builtin_bit_cast(unsigned, f); return (u + 0x7fffu + ((u >> 16) & 1u)) >> 16; }
__device__ __forceinline__ unsigned pk2(float lo, float hi) { return f2bf(lo) | (f2bf(hi) << 16); }
__device__ __forceinline__ float bf2f(unsigned short h) { return __builtin_bit_cast(float, (unsigned)h << 16); }
__device__ __forceinline__ float wave_sum(float v) {
#pragma unroll
    for (int o = 1; o < 64; o <<= 1) v += __shfl_xor(v, o);
    return v;
}
#define FX_LDS_WAIT() asm volatile("s_waitcnt lgkmcnt(0)" ::: "memory")

template <class Map> __device__ __forceinline__ void transpose_item(const float* __restrict__ W, int K, int N, bf16* WT, LAS float* scr, int kb, int nb, int lane, Map srcmap) {
    const int k0 = 64 * kb, n0 = 32 * nb;
    const int src = srcmap(n0 + (lane & 31));
#pragma unroll 8
    for (int i = 0; i < 32; ++i) { const int kk = 2 * i + (lane >> 5); scr[kk * 33 + (lane & 31)] = (src >= 0) ? W[(size_t)(k0 + kk) * N + src] : 0.f; }
    FX_LDS_WAIT(); asm volatile("" ::: "memory");
    const int c = lane & 7;
#pragma unroll
    for (int j = 0; j < 4; ++j) { const int n = (lane >> 3) + 8 * j; const LAS float* s = scr + (8 * c) * 33 + n;
        v4u o; o.x = pk2(s[0 * 33], s[1 * 33]); o.y = pk2(s[2 * 33], s[3 * 33]); o.z = pk2(s[4 * 33], s[5 * 33]); o.w = pk2(s[6 * 33], s[7 * 33]);
        *(GAS v4u*)(WT + (size_t)(n0 + n) * K + k0 + 8 * c) = o; }
    FX_LDS_WAIT(); asm volatile("" ::: "memory");
}

__device__ __forceinline__ void ln_row_bf16(const float* xrow, const float* __restrict__ g, const float* __restrict__ b, bf16* orow, float* frow, float* st, int lane) {
    const GAS f32x4* xr = (const GAS f32x4*)xrow + lane;
    f32x4 v[4]; float s = 0.f;
#pragma unroll
    for (int j = 0; j < 4; ++j) { v[j] = xr[64 * j]; s += (v[j].x + v[j].y) + (v[j].z + v[j].w); }
    const float mean = wave_sum(s) * (1.f / D); float s2 = 0.f;
#pragma unroll
    for (int j = 0; j < 4; ++j) { v[j] = v[j] - mean; s2 += (v[j].x * v[j].x + v[j].y * v[j].y) + (v[j].z * v[j].z + v[j].w * v[j].w); }
    const float rstd = 1.f / sqrtf(wave_sum(s2) * (1.f / D) + LN_EPS);
    if (st && lane == 0) { st[0] = mean; st[1] = rstd; }
    GAS unsigned long long* o8 = (GAS unsigned long long*)orow + lane;
#pragma unroll
    for (int j = 0; j < 4; ++j) {
        const f32x4 gg = ((const f32x4*)g)[lane + 64 * j], bb = ((const f32x4*)b)[lane + 64 * j];
        const f32x4 o = v[j] * rstd * gg + bb;
        o8[64 * j] = (unsigned long long)pk2(o.x, o.y) | ((unsigned long long)pk2(o.z, o.w) << 32);
        if (frow) ((GAS f32x4*)frow)[lane + 64 * j] = o;
    }
}

struct CvItem { const float* W; bf16* WT; int N, K, k0, n0, s0; };
__device__ __forceinline__ void cv_load(const CvItem& it, f32x4 (&v)[8], int lane) {
    const float* p = it.W + (size_t)(it.k0 + (lane >> 3)) * it.N + it.s0 + 4 * (lane & 7);
#pragma unroll
    for (int i = 0; i < 8; ++i) v[i] = __builtin_nontemporal_load((const f32x4*)(p + (size_t)(8 * i) * it.N));
}
__device__ __forceinline__ void cv_finish(const CvItem& it, const f32x4 (&v)[8], LAS float* scr, int lane) {
    const int rr = lane >> 3, cq = lane & 7;
#pragma unroll
    for (int i = 0; i < 8; ++i) { LAS float* d = scr + (8 * i + rr) * 33 + 4 * cq; d[0] = v[i][0]; d[1] = v[i][1]; d[2] = v[i][2]; d[3] = v[i][3]; }
    FX_LDS_WAIT(); asm volatile("" ::: "memory");
    const int c = lane & 7;
#pragma unroll
    for (int j = 0; j < 4; ++j) { const int n = (lane >> 3) + 8 * j; const LAS float* s = scr + (8 * c) * 33 + n;
        v4u o; o.x = pk2(s[0 * 33], s[1 * 33]); o.y = pk2(s[2 * 33], s[3 * 33]); o.z = pk2(s[4 * 33], s[5 * 33]); o.w = pk2(s[6 * 33], s[7 * 33]);
        __builtin_nontemporal_store(o, (GAS v4u*)(it.WT + (size_t)(it.n0 + n) * it.K + it.k0 + 8 * c)); }
    FX_LDS_WAIT(); asm volatile("" ::: "memory");
}

template <int NR> __device__ __forceinline__ void ln_rows_bf16(const float* xrows, const float* __restrict__ g, const float* __restrict__ b, bf16* orows, int lane) {
    f32x4 v[NR][4];
#pragma unroll
    for (int r = 0; r < NR; ++r)
#pragma unroll
        for (int j = 0; j < 4; ++j) v[r][j] = ((const GAS f32x4*)(xrows + (size_t)r * D))[lane + 64 * j];
    f32x4 gg[4], bb[4];
#pragma unroll
    for (int j = 0; j < 4; ++j) { gg[j] = ((const f32x4*)g)[lane + 64 * j]; bb[j] = ((const f32x4*)b)[lane + 64 * j]; }
#pragma unroll
    for (int r = 0; r < NR; ++r) {
        float s = 0.f;
#pragma unroll
        for (int j = 0; j < 4; ++j) s += (v[r][j].x + v[r][j].y) + (v[r][j].z + v[r][j].w);
        const float mean = wave_sum(s) * (1.f / D); float s2 = 0.f;
#pragma unroll
        for (int j = 0; j < 4; ++j) { v[r][j] = v[r][j] - mean; s2 += (v[r][j].x * v[r][j].x + v[r][j].y * v[r][j].y) + (v[r][j].z * v[r][j].z + v[r][j].w * v[r][j].w); }
        const float rstd = 1.f / sqrtf(wave_sum(s2) * (1.f / D) + LN_EPS);
        GAS unsigned long long* o8 = (GAS unsigned long long*)(orows + (size_t)r * D) + lane;
#pragma unroll
        for (int j = 0; j < 4; ++j) { const f32x4 o = v[r][j] * rstd * gg[j] + bb[j];
            o8[64 * j] = (unsigned long long)pk2(o.x, o.y) | ((unsigned long long)pk2(o.z, o.w) << 32); }
    }
}

template <int NR> __device__ __forceinline__ void ln1_rows_bf16(const float* xrows, const float* st, const float* __restrict__ gi, const float* __restrict__ bi, const bf16* mixrows,
                                                               const float* __restrict__ g1, const float* __restrict__ b1, bf16* orows, float alpha, int lane) {
    f32x4 v[NR][4]; unsigned long long mx[NR][4]; float mean0[NR], rstd0[NR];
#pragma unroll
    for (int r = 0; r < NR; ++r) { mean0[r] = st[2 * r]; rstd0[r] = st[2 * r + 1];
#pragma unroll
        for (int j = 0; j < 4; ++j) { v[r][j] = ((const GAS f32x4*)(xrows + (size_t)r * D))[lane + 64 * j]; mx[r][j] = ((const GAS unsigned long long*)(mixrows + (size_t)r * D))[lane + 64 * j]; } }
    f32x4 gi4[4], bi4[4];
#pragma unroll
    for (int j = 0; j < 4; ++j) { gi4[j] = ((const f32x4*)gi)[lane + 64 * j] * alpha; bi4[j] = ((const f32x4*)bi)[lane + 64 * j] * alpha; }
#pragma unroll
    for (int r = 0; r < NR; ++r) {
        float s = 0.f;
#pragma unroll
        for (int j = 0; j < 4; ++j) { const unsigned lo = (unsigned)mx[r][j], hi = (unsigned)(mx[r][j] >> 32);
            f32x4 mv; mv.x = __builtin_bit_cast(float, lo << 16); mv.y = __builtin_bit_cast(float, lo & 0xffff0000u); mv.z = __builtin_bit_cast(float, hi << 16); mv.w = __builtin_bit_cast(float, hi & 0xffff0000u);
            v[r][j] = ((v[r][j] - mean0[r]) * rstd0[r]) * gi4[j] + bi4[j] + mv;
            s += (v[r][j].x + v[r][j].y) + (v[r][j].z + v[r][j].w); }
        const float mean = wave_sum(s) * (1.f / D); float s2 = 0.f;
#pragma unroll
        for (int j = 0; j < 4; ++j) { v[r][j] = v[r][j] - mean; s2 += (v[r][j].x * v[r][j].x + v[r][j].y * v[r][j].y) + (v[r][j].z * v[r][j].z + v[r][j].w * v[r][j].w); }
        const float rstd = 1.f / sqrtf(wave_sum(s2) * (1.f / D) + LN_EPS);
        GAS unsigned long long* o8 = (GAS unsigned long long*)(orows + (size_t)r * D) + lane;
#pragma unroll
        for (int j = 0; j < 4; ++j) { const f32x4 gg = ((const f32x4*)g1)[lane + 64 * j], bb = ((const f32x4*)b1)[lane + 64 * j]; const f32x4 o = v[r][j] * rstd * gg + bb;
            o8[64 * j] = (unsigned long long)pk2(o.x, o.y) | ((unsigned long long)pk2(o.z, o.w) << 32); }
    }
}
}

namespace pg8 {
struct EpiInProj {
    static constexpr bool PERM = true, AFTER_DRAIN = false;
    bf16_t* QKV; float* FG; float* LF; const float* bfg; unsigned* NRM;
    __device__ __forceinline__ void operator()(const f32x4 (&acc)[2][2][4][2], const Unit& u, int wr, int wc, int fr, int fq) const {
        const int row0 = u.pm * BM + wr * 64 + fr;
        if (u.pn < 12) {
            const float sc = (u.pn < 2) ? fx::C2 : 1.f;
            const int col0 = u.pn * BM + wc * 32 + 8 * fq;
            float nmax[2] = {0.f, 0.f};
#pragma unroll
            for (int ai = 0; ai < 2; ++ai)
#pragma unroll
                for (int m = 0; m < 4; ++m) { bf16_t* rowp = QKV + (size_t)(row0 + ai * HALF + m * 16) * fx::QKVP + col0;
#pragma unroll
                    for (int bj = 0; bj < 2; ++bj) { const f32x4 v0 = acc[ai][bj][m][0] * sc, v1 = acc[ai][bj][m][1] * sc;
                        u32x4 w; w.x = cvt_pk_bf16(v0[0], v0[1]); w.y = cvt_pk_bf16(v0[2], v0[3]); w.z = cvt_pk_bf16(v1[0], v1[1]); w.w = cvt_pk_bf16(v1[2], v1[3]);
                        *(u32x4*)(rowp + bj * HALF) = w;
                        if (u.pn < 4) { const f32x4 q0 = v0 * v0, q1 = v1 * v1; float s = (q0[0] + q0[1]) + (q0[2] + q0[3]) + (q1[0] + q1[1]) + (q1[2] + q1[3]);
                            s += __shfl_xor(s, 16); s += __shfl_xor(s, 32);
                            nmax[bj] = fmaxf(nmax[bj], s); } } }
            if (u.pn < 4) {
#pragma unroll
                for (int bj = 0; bj < 2; ++bj) { float s = nmax[bj];
#pragma unroll
                    for (int o = 1; o < 16; o <<= 1) s = fmaxf(s, __shfl_xor(s, o));
                    if (fr == 0 && fq == 0) { const int b = (u.pm * BM) >> 12, head = 4 * (u.pn & 1) + 2 * bj + (wc >> 1);
                        atomicMax(NRM + (b * 8 + head) * 4 + (u.pn >= 2 ? 2 : 0) + (wc & 1), __builtin_bit_cast(unsigned, s)); } }
            }
        } else if (wc == 0 && fq < 3) {
#pragma unroll
            for (int ai = 0; ai < 2; ++ai)
#pragma unroll
                for (int m = 0; m < 4; ++m) { const int row = row0 + ai * HALF + m * 16; float* p = FG + (size_t)row * 32 + 8 * fq;
                    *(f32x4*)p = acc[ai][0][m][0]; *(f32x4*)(p + 4) = acc[ai][0][m][1];
                    if (fq == 0) { const int b = row >> 12, s = row & 4095;
#pragma unroll
                        for (int n = 0; n < 2; ++n)
#pragma unroll
                            for (int i = 0; i < 4; ++i) { const int h = 4 * n + i; LF[(size_t)(b * 8 + h) * nv::S + s] = 1.4426950408889634f * nv::logsigmoidf(acc[ai][0][m][n][i] + bfg[h]); } } }
        }
    }
};
}
namespace gl {
using namespace nv;
typedef unsigned short bf16;
typedef short bf16x8 __attribute__((ext_vector_type(8)));
typedef float f32x4 __attribute__((ext_vector_type(4)));
typedef unsigned u32x4 __attribute__((ext_vector_type(4)));
typedef unsigned u32x2 __attribute__((ext_vector_type(2)));
constexpr int NCH = S / 64;
constexpr int NUNIT = B * GH * NCH;
constexpr int LS = 72;
constexpr int L_WGU = 0, L_BG = 4096, L_QP = 8192, L_KP = L_QP + 64 * LS * 2, L_KPT = L_KP + 64 * LS * 2, L_VT = L_KPT + 64 * LS * 2, L_PP = L_VT + 128 * LS * 2, L_WT = L_PP + 64 * LS * 2, L_END = L_WT + 2048;
static_assert(L_END <= 131072, "gla prep LDS");
constexpr int C_ST = 0, C_PART = 128 * LS * 2, C_END = C_PART + 2 * 8 * 64 * 4;
constexpr size_t QPG_B = 64 * 64 * 2, OI_B = 8 * 4 * 64 * 16, UU_B = OI_B, DEC_B = 256;

__device__ __forceinline__ unsigned pkbf(float lo, float hi) { typedef float f2 __attribute__((ext_vector_type(2))); typedef __bf16 b2 __attribute__((ext_vector_type(2))); f2 v = {lo, hi}; b2 r = __builtin_convertvector(v, b2); return __builtin_bit_cast(unsigned, r); }
__device__ __forceinline__ float bf2f(unsigned short h) { return __builtin_bit_cast(float, (unsigned)h << 16); }
__device__ __forceinline__ float bflo(unsigned w) { return __builtin_bit_cast(float, w << 16); }
__device__ __forceinline__ float bfhi(unsigned w) { return __builtin_bit_cast(float, w & 0xffff0000u); }
__device__ __forceinline__ float fast_logsig2(float x) { return -__builtin_amdgcn_logf(1.f + __builtin_amdgcn_exp2f(-1.4426950408889634f * x)); }

__device__ __forceinline__ void prep_unit(int unit, const bf16* QKV, const float* FG, const float* __restrict__ wgu, const float* __restrict__ bgate,
                                          unsigned char* QPG, unsigned char* OI, unsigned char* UU, float* DEC, unsigned char* lds, int& cur_h) {
    int tid_ = threadIdx.x; asm volatile("" : "+v"(tid_));
    const int tid = tid_, lane = tid & 63, wid = __builtin_amdgcn_readfirstlane(tid >> 6), l15 = lane & 15, g = lane >> 4;
    const int n = unit % NCH, bh = unit / NCH, h = bh % GH, b = bh / GH;
    const size_t row0 = (size_t)b * S + (size_t)n * 64;
    float* WGU = (float*)(lds + L_WGU); float* BG = (float*)(lds + L_BG); float* WT = (float*)(lds + L_WT);
    bf16* QP = (bf16*)(lds + L_QP); bf16* KP = (bf16*)(lds + L_KP); bf16* KPT = (bf16*)(lds + L_KPT); bf16* VT = (bf16*)(lds + L_VT); bf16* PP = (bf16*)(lds + L_PP);
    if (cur_h != h) { __syncthreads(); for (int i = tid; i < 16 * 64; i += 512) WGU[i] = wgu[(i >> 6) * 256 + h * 64 + (i & 63)]; if (tid < 64) BG[tid] = bgate[h * 64 + tid]; cur_h = h; __syncthreads(); }
    const int t = tid >> 3, oc = tid & 7, d0 = oc * 8;
    float la[8];
    { const float* gp = FG + (row0 + t) * 32 + 8;
      f32x4 ga4[4];
#pragma unroll
      for (int i = 0; i < 4; ++i) ga4[i] = *(const f32x4*)(gp + 4 * i);
#pragma unroll
      for (int j = 0; j < 8; ++j) la[j] = BG[d0 + j];
#pragma unroll
      for (int r = 0; r < 16; ++r) { const float gv = ga4[r >> 2][r & 3]; const f32x4 w0 = *(const f32x4*)(WGU + r * 64 + d0), w1 = *(const f32x4*)(WGU + r * 64 + d0 + 4);
#pragma unroll
          for (int j = 0; j < 4; ++j) { la[j] += gv * w0[j]; la[4 + j] += gv * w1[j]; } }
#pragma unroll
      for (int j = 0; j < 8; ++j) la[j] = fast_logsig2(la[j]) * (1.f / 16.f); }
    const u32x4 qv = *(const u32x4*)(QKV + (row0 + t) * fx::QKVP + fx::P_GQ + h * 64 + d0);
    const u32x4 kv = *(const u32x4*)(QKV + (row0 + t) * fx::QKVP + fx::P_GK + h * 64 + d0);
    const u32x4 vv0 = *(const u32x4*)(QKV + (row0 + t) * fx::QKVP + fx::P_GV + h * 128 + oc * 16);
    const u32x4 vv1 = *(const u32x4*)(QKV + (row0 + t) * fx::QKVP + fx::P_GV + h * 128 + oc * 16 + 8);
#pragma unroll
    for (int off = 8; off < 64; off <<= 1) {
#pragma unroll
        for (int j = 0; j < 8; ++j) { const float o = __shfl_up(la[j], off); if (lane >= off) la[j] += o; } }
    if (lane >= 56) {
#pragma unroll
        for (int j = 0; j < 8; ++j) WT[wid * 64 + d0 + j] = la[j]; }
    __syncthreads();
    float bl[8];
#pragma unroll
    for (int j = 0; j < 8; ++j) bl[j] = 0.f;
#pragma unroll
    for (int w = 0; w < 8; ++w) {
        const f32x4 a0 = *(const f32x4*)(WT + w * 64 + d0), a1 = *(const f32x4*)(WT + w * 64 + d0 + 4);
#pragma unroll
        for (int j = 0; j < 4; ++j) { bl[j] += a0[j]; bl[4 + j] += a1[j]; if (w < wid) { la[j] += a0[j]; la[4 + j] += a1[j]; } } }
    {
        const unsigned qw[4] = {qv.x, qv.y, qv.z, qv.w}, kw[4] = {kv.x, kv.y, kv.z, kv.w};
        float qf[8], kf[8];
#pragma unroll
        for (int i = 0; i < 4; ++i) { qf[2 * i] = bflo(qw[i]); qf[2 * i + 1] = bfhi(qw[i]); kf[2 * i] = bflo(kw[i]); kf[2 * i + 1] = bfhi(kw[i]); }
        float qp[8], kp[8], kpp[8];
#pragma unroll
        for (int j = 0; j < 8; ++j) { const float bb = la[j], bbl = bl[j];
            qp[j] = qf[j] * (0.125f * __builtin_amdgcn_exp2f(bb)); kp[j] = kf[j] * __builtin_amdgcn_exp2f(-bb); kpp[j] = kf[j] * __builtin_amdgcn_exp2f(bbl - bb); }
        u32x4 qo, ko; qo.x = pkbf(qp[0], qp[1]); qo.y = pkbf(qp[2], qp[3]); qo.z = pkbf(qp[4], qp[5]); qo.w = pkbf(qp[6], qp[7]);
        ko.x = pkbf(kp[0], kp[1]); ko.y = pkbf(kp[2], kp[3]); ko.z = pkbf(kp[4], kp[5]); ko.w = pkbf(kp[6], kp[7]);
        *(u32x4*)(QP + t * LS + d0) = qo; *(u32x4*)(KP + t * LS + d0) = ko;
        *(u32x4*)(QPG + (size_t)unit * QPG_B + (size_t)(t * 64 + d0) * 2) = qo;
#pragma unroll
        for (int j = 0; j < 8; ++j) KPT[(d0 + j) * LS + t] = (bf16)(pkbf(kpp[j], 0.f) & 0xffffu);
        const unsigned vw[8] = {vv0.x, vv0.y, vv0.z, vv0.w, vv1.x, vv1.y, vv1.z, vv1.w};
#pragma unroll
        for (int i = 0; i < 8; ++i) { VT[(oc * 16 + 2 * i) * LS + t] = (bf16)(vw[i] & 0xffffu); VT[(oc * 16 + 2 * i + 1) * LS + t] = (bf16)(vw[i] >> 16); }
        if (t == 0) {
#pragma unroll
            for (int j = 0; j < 8; ++j) DEC[(size_t)unit * 64 + d0 + j] = __builtin_amdgcn_exp2f(bl[j]); }
    }
    __syncthreads();
    { const int ti = wid >> 1;
#pragma unroll
      for (int q2 = 0; q2 < 2; ++q2) { const int sj = 2 * (wid & 1) + q2;
          f32x4 acc = {0.f, 0.f, 0.f, 0.f};
          if (sj <= ti) {
#pragma unroll
              for (int ks = 0; ks < 2; ++ks) { const bf16x8 a = *(const bf16x8*)(QP + (16 * ti + l15) * LS + 32 * ks + 8 * g), bb = *(const bf16x8*)(KP + (16 * sj + l15) * LS + 32 * ks + 8 * g);
                  acc = __builtin_amdgcn_mfma_f32_16x16x32_bf16(a, bb, acc, 0, 0, 0); }
              if (sj == ti) {
#pragma unroll
                  for (int r = 0; r < 4; ++r) if (l15 > 4 * g + r) acc[r] = 0.f; }
          }
#pragma unroll
          for (int r = 0; r < 4; ++r) PP[(16 * ti + 4 * g + r) * LS + 16 * sj + l15] = (bf16)(pkbf(acc[r], 0.f) & 0xffffu);
      } }
    __syncthreads();
    { bf16x8 vb[2];
#pragma unroll
      for (int ks = 0; ks < 2; ++ks) vb[ks] = *(const bf16x8*)(VT + (16 * wid + l15) * LS + 32 * ks + 8 * g);
#pragma unroll
      for (int m = 0; m < 4; ++m) { f32x4 acc = {0.f, 0.f, 0.f, 0.f};
#pragma unroll
          for (int ks = 0; ks < 2; ++ks) { const bf16x8 a = *(const bf16x8*)(PP + (16 * m + l15) * LS + 32 * ks + 8 * g); acc = __builtin_amdgcn_mfma_f32_16x16x32_bf16(a, vb[ks], acc, 0, 0, 0); }
          *(f32x4*)(OI + (size_t)unit * OI_B + (size_t)((wid * 4 + m) * 64 + lane) * 16) = acc; }
#pragma unroll
      for (int db = 0; db < 4; ++db) { f32x4 acc = {0.f, 0.f, 0.f, 0.f};
#pragma unroll
          for (int ks = 0; ks < 2; ++ks) { const bf16x8 a = *(const bf16x8*)(KPT + (16 * db + l15) * LS + 32 * ks + 8 * g); acc = __builtin_amdgcn_mfma_f32_16x16x32_bf16(a, vb[ks], acc, 0, 0, 0); }
          *(f32x4*)(UU + (size_t)unit * UU_B + (size_t)((wid * 4 + db) * 64 + lane) * 16) = acc; }
    }
}

constexpr int GS = 136;
constexpr int PO_GR = 0, PO_YT = 64 * GS * 2, PO_PART = 2 * 64 * GS * 2, PO_ST = PO_PART + 8 * 64 * 4, PO_END = PO_ST + 128 * LS * 2;
__device__ __forceinline__ void post_block(int u0, int NB, const bf16* QKV, const unsigned char* QPG, const unsigned char* OI, const unsigned char* UU, const float* DEC, const float* __restrict__ gnorm, bf16* Y, unsigned char* lds) {
    int tid_ = threadIdx.x; asm volatile("" : "+v"(tid_));
    const int tid = tid_, lane = tid & 63, wid = __builtin_amdgcn_readfirstlane(tid >> 6), l15 = lane & 15, g = lane >> 4;
    const int n0 = u0 % NCH, bh = u0 / NCH, h = bh % GH, b = bh / GH;
    bf16* GRs = (bf16*)(lds + PO_GR); bf16* YT = (bf16*)(lds + PO_YT); float* PART = (float*)(lds + PO_PART); bf16* ST = (bf16*)(lds + PO_ST);
    const int t = tid >> 3, oc = tid & 7, e = 16 * wid + l15;
    const float gn = gnorm[e];
    f32x4 Sa[4];
#pragma unroll
    for (int db = 0; db < 4; ++db) Sa[db] = (f32x4){0.f, 0.f, 0.f, 0.f};
    const size_t ub = (size_t)bh * NCH;
    for (int n = 0; n < n0; n += 4) {
        f32x4 Uf[4][4], dv[4][4];
#pragma unroll
        for (int j = 0; j < 4; ++j)
#pragma unroll
            for (int db = 0; db < 4; ++db) { Uf[j][db] = *(const f32x4*)(UU + (ub + n + j) * UU_B + (size_t)((wid * 4 + db) * 64 + lane) * 16); dv[j][db] = *(const f32x4*)(DEC + (ub + n + j) * 64 + 16 * db + 4 * g); }
#pragma unroll
        for (int j = 0; j < 4; ++j)
#pragma unroll
            for (int db = 0; db < 4; ++db) Sa[db] = dv[j][db] * Sa[db] + Uf[j][db];
    }
    for (int i = 0; i < NB; ++i) {
        const int unit = u0 + i; const size_t row0 = (size_t)b * S + (size_t)(n0 + i) * 64;
        const u32x4 g0 = *(const u32x4*)(QKV + (row0 + t) * fx::QKVP + fx::P_GR + h * 128 + oc * 16), g1 = *(const u32x4*)(QKV + (row0 + t) * fx::QKVP + fx::P_GR + h * 128 + oc * 16 + 8);
        f32x4 o[4], Uf[4], dv[4]; bf16x8 qa[4][2], sb[2];
#pragma unroll
        for (int m = 0; m < 4; ++m) { o[m] = *(const f32x4*)(OI + (size_t)unit * OI_B + (size_t)((wid * 4 + m) * 64 + lane) * 16);
            Uf[m] = *(const f32x4*)(UU + (size_t)unit * UU_B + (size_t)((wid * 4 + m) * 64 + lane) * 16); dv[m] = *(const f32x4*)(DEC + (size_t)unit * 64 + 16 * m + 4 * g);
#pragma unroll
            for (int ks = 0; ks < 2; ++ks) qa[m][ks] = *(const bf16x8*)(QPG + (size_t)unit * QPG_B + (size_t)((16 * m + l15) * 64 + 32 * ks + 8 * g) * 2); }
#pragma unroll
        for (int db = 0; db < 4; ++db) *(u32x2*)(ST + e * LS + 16 * db + 4 * g) = (u32x2){pkbf(Sa[db][0], Sa[db][1]), pkbf(Sa[db][2], Sa[db][3])};
#pragma unroll
        for (int ks = 0; ks < 2; ++ks) sb[ks] = *(const bf16x8*)(ST + e * LS + 32 * ks + 8 * g);
        *(u32x4*)(GRs + t * GS + oc * 16) = g0; *(u32x4*)(GRs + t * GS + oc * 16 + 8) = g1;
#pragma unroll
        for (int m = 0; m < 4; ++m)
#pragma unroll
            for (int ks = 0; ks < 2; ++ks) o[m] = __builtin_amdgcn_mfma_f32_16x16x32_bf16(qa[m][ks], sb[ks], o[m], 0, 0, 0);
#pragma unroll
        for (int m = 0; m < 4; ++m) { f32x4 q = o[m] * o[m];
#pragma unroll
            for (int off = 1; off < 16; off <<= 1) { q[0] += __shfl_xor(q[0], off); q[1] += __shfl_xor(q[1], off); q[2] += __shfl_xor(q[2], off); q[3] += __shfl_xor(q[3], off); }
            if (l15 == 0) *(f32x4*)(PART + wid * 64 + 16 * m + 4 * g) = q; }
#pragma unroll
        for (int db = 0; db < 4; ++db) Sa[db] = dv[db] * Sa[db] + Uf[db];
        __syncthreads();
#pragma unroll
        for (int m = 0; m < 4; ++m) { f32x4 tot = {0.f, 0.f, 0.f, 0.f};
#pragma unroll
            for (int w = 0; w < 8; ++w) tot += *(const f32x4*)(PART + w * 64 + 16 * m + 4 * g);
#pragma unroll
            for (int r = 0; r < 4; ++r) { const int tt = 16 * m + 4 * g + r; const float rs = rsqrtf(tot[r] * (1.f / GV) + LN_EPS); const float gr = bf2f(GRs[tt * GS + e]);
                const float v = o[m][r] * rs * gn * (gr * __builtin_amdgcn_rcpf(1.f + __builtin_amdgcn_exp2f(-1.4426950408889634f * gr)));
                YT[tt * GS + e] = (bf16)(pkbf(v, 0.f) & 0xffffu); } }
        __syncthreads();
        { const u32x4 y0 = *(const u32x4*)(YT + t * GS + oc * 16), y1 = *(const u32x4*)(YT + t * GS + oc * 16 + 8);
          *(u32x4*)(Y + (row0 + t) * D + 512 + h * GV + oc * 16) = y0; *(u32x4*)(Y + (row0 + t) * D + 512 + h * GV + oc * 16 + 8) = y1; }
        __syncthreads();
    }
}
}
namespace mo {
using namespace nv;
typedef unsigned short bf16;
typedef float f32x4 __attribute__((ext_vector_type(4)));
typedef unsigned u32x4 __attribute__((ext_vector_type(4)));
constexpr int CAP = 8192;
constexpr int NEX = NE + 1;
constexpr int YSH = T * TOPK;
constexpr int L_TB = 132096, L_YB = L_TB + 1040, L_CN = L_YB + 1040;
typedef LAS int* lint;

__device__ __forceinline__ void moe_tables(const int* counts, lint tb, lint yb, lint cn, int lane) {
    int c[4], nt[4]; int st = 0, sy = 0, pt[4], py[4];
#pragma unroll
    for (int i = 0; i < 4; ++i) { c[i] = counts[lane * 4 + i]; c[i] = c[i] > CAP ? CAP : c[i]; nt[i] = (c[i] + 255) >> 8; pt[i] = st; py[i] = sy; st += nt[i]; sy += c[i]; }
    int it = st, iy = sy;
    for (int o = 1; o < 64; o <<= 1) { const int a = __shfl_up(it, o), b = __shfl_up(iy, o); if (lane >= o) { it += a; iy += b; } }
    const int bt = it - st, by = iy - sy;
#pragma unroll
    for (int i = 0; i < 4; ++i) { tb[lane * 4 + i] = bt + pt[i]; yb[lane * 4 + i] = by + py[i]; cn[lane * 4 + i] = c[i]; }
    if (lane == 63) { tb[256] = it; tb[257] = it + T / 256; yb[256] = YSH; cn[256] = T; }
}

__device__ __forceinline__ void route_token2(const float* LG, const float* __restrict__ rbias, int* lcnt, int* TK, float* TW, int t0, int lane) {
    const int l32 = lane & 31, hb = lane & 32, t = t0 + (lane >> 5);
    const float4 la = ((const float4*)(LG + (size_t)t * NE))[2 * l32], lb = ((const float4*)(LG + (size_t)t * NE))[2 * l32 + 1];
    const float4 ra = ((const float4*)rbias)[2 * l32], rb = ((const float4*)rbias)[2 * l32 + 1];
    const float lg[8] = {la.x, la.y, la.z, la.w, lb.x, lb.y, lb.z, lb.w}, rbv[8] = {ra.x, ra.y, ra.z, ra.w, rb.x, rb.y, rb.z, rb.w};
    float sc[8], bv[8];
#pragma unroll
    for (int i = 0; i < 8; ++i) { sc[i] = 1.f / (1.f + expf(-lg[i])); bv[i] = sc[i] + rbv[i]; }
    float m1 = fmaxf(bv[0], bv[1]), m2 = fminf(bv[0], bv[1]);
#pragma unroll
    for (int i = 2; i < 8; ++i) { const float n1 = fmaxf(m1, bv[i]); m2 = fmaxf(fminf(m1, bv[i]), m2); m1 = n1; }
#pragma unroll
    for (int o = 1; o < 4; o <<= 1) { const float p1 = __shfl_xor(m1, o), p2 = __shfl_xor(m2, o); const float n1 = fmaxf(m1, p1); m2 = fmaxf(fminf(m1, p1), fmaxf(m2, p2)); m1 = n1; }
    const float gs = m1 + m2;
    const int myg = l32 >> 2;
    int rank = 0;
#pragma unroll
    for (int g2 = 0; g2 < NG; ++g2) { const float og = __shfl(gs, hb + g2 * 4); if (og > gs || (og == gs && g2 < myg)) ++rank; }
    const bool sel = rank < 4;
    float mv[8];
#pragma unroll
    for (int i = 0; i < 8; ++i) mv[i] = sel ? bv[i] : -INFINITY;
    int mye = 0; float myw = 0.f; float wsum = 0.f;
#pragma unroll
    for (int k = 0; k < TOPK; ++k) {
        float bvv = mv[0]; int bi = 0;
#pragma unroll
        for (int i = 1; i < 8; ++i) if (mv[i] > bvv) { bvv = mv[i]; bi = i; }
        int gi = l32 * 8 + bi;
#pragma unroll
        for (int o = 16; o > 0; o >>= 1) { const float ov = __shfl_xor(bvv, o); const int oi = __shfl_xor(gi, o); if (ov > bvv || (ov == bvv && oi < gi)) { bvv = ov; gi = oi; } }
        const int ol = gi >> 3, oi = gi & 7;
        float s_own = sc[0];
#pragma unroll
        for (int i = 1; i < 8; ++i) s_own = (oi == i) ? sc[i] : s_own;
        const float sw = __shfl(s_own, hb + ol);
        if (l32 == ol) {
#pragma unroll
            for (int i = 0; i < 8; ++i) if (oi == i) mv[i] = -INFINITY; }
        if (l32 == k) { mye = gi; myw = sw; } wsum += sw;
    }
    if (l32 < TOPK) { const int lp = atomicAdd(&lcnt[mye], 1); TK[t * TOPK + l32] = mye | (lp << 9); TW[t * TOPK + l32] = myw * (2.5f / wsum); }
}
__device__ __forceinline__ void route_finish2(const int* lbase, int* list_tok, float* list_gate, int* TK, const float* TW, int t0, int lane) {
    const int l32 = lane & 31, t = t0 + (lane >> 5);
    if (l32 < TOPK) { const int tk = TK[t * TOPK + l32]; const int e = tk & 511, pos = lbase[e] + (tk >> 9);
        if (pos < CAP) { list_tok[e * CAP + pos] = t; list_gate[e * CAP + pos] = TW[t * TOPK + l32]; }
        TK[t * TOPK + l32] = e | (pos << 9); }
}

constexpr float YSC = 16.f;
__device__ __forceinline__ void combine_token(const bf16* H1, const unsigned char* Y, const int* TK, lint yb, const float* __restrict__ g, const float* __restrict__ b, float* out, int t, int lane) {
    typedef float f2 __attribute__((ext_vector_type(2)));
    float v[16], s[16];
    { const u32x4 a = *(const u32x4*)(H1 + (size_t)t * D + 16 * lane), c = *(const u32x4*)(H1 + (size_t)t * D + 16 * lane + 8);
      const unsigned w[8] = {a.x, a.y, a.z, a.w, c.x, c.y, c.z, c.w};
#pragma unroll
      for (int i = 0; i < 8; ++i) { v[2 * i] = ALPHA * __builtin_bit_cast(float, w[i] << 16); v[2 * i + 1] = ALPHA * __builtin_bit_cast(float, w[i] & 0xffff0000u); } }
#pragma unroll
    for (int i = 0; i < 16; ++i) s[i] = 0.f;
    int tk = (lane < TOPK) ? TK[t * TOPK + lane] : 0;
#pragma unroll
    for (int k = 0; k <= TOPK; ++k) {
        size_t yrow;
        if (k < TOPK) { const int x = __shfl(tk, k); yrow = (size_t)(yb[x & 511] + (x >> 9)); } else yrow = (size_t)YSH + t;
        const u32x4 a = *(const u32x4*)(Y + yrow * D + 16 * lane);
        const int w[4] = {(int)a.x, (int)a.y, (int)a.z, (int)a.w};
#pragma unroll
        for (int i = 0; i < 4; ++i) { const f2 lo = __builtin_amdgcn_cvt_pk_f32_fp8(w[i], false), hi = __builtin_amdgcn_cvt_pk_f32_fp8(w[i], true);
            s[4 * i] += lo[0]; s[4 * i + 1] += lo[1]; s[4 * i + 2] += hi[0]; s[4 * i + 3] += hi[1]; }
    }
    float sm = 0.f;
#pragma unroll
    for (int i = 0; i < 16; ++i) { v[i] += s[i] * (1.f / YSC); sm += v[i]; }
    const float mean = fx::wave_sum(sm) * (1.f / D); float q = 0.f;
#pragma unroll
    for (int i = 0; i < 16; ++i) { v[i] -= mean; q += v[i] * v[i]; }
    const float rstd = 1.f / sqrtf(fx::wave_sum(q) * (1.f / D) + LN_EPS);
#pragma unroll
    for (int i = 0; i < 4; ++i) { const f32x4 gg = *(const f32x4*)(g + 16 * lane + 4 * i), bb = *(const f32x4*)(b + 16 * lane + 4 * i);
        f32x4 o; o[0] = v[4 * i] * rstd * gg[0] + bb[0]; o[1] = v[4 * i + 1] * rstd * gg[1] + bb[1]; o[2] = v[4 * i + 2] * rstd * gg[2] + bb[2]; o[3] = v[4 * i + 3] * rstd * gg[3] + bb[3];
        *(f32x4*)(out + (size_t)t * D + 16 * lane + 4 * i) = o; }
}
}

namespace pg8 {
struct RouterSched {
    int rb; const bf16_t* Bt;
    __device__ __forceinline__ bool next(int i, Unit2& u) const { if (i > 0) return false; u.pm = rb; u.pn = 0; u.e = 0; u.cnt = 128; u.jt = 0; return true; }
    __device__ __forceinline__ int arow(const Unit2& u, int r) const { return u.pm * 128 + r; }
    __device__ __forceinline__ size_t aoff(const Unit2&) const { return 0; }
    __device__ __forceinline__ const char* bptr(const Unit2&) const { return (const char*)Bt; }
};
struct EpiLogits {
    static constexpr bool PERM = false, AFTER_DRAIN = false;
    float* LG;
    __device__ __forceinline__ void operator()(const f32x4 (&acc)[2][2][4][2], const Unit2& u, int wr, int wc, int fr, int fq) const {
        const int row0 = u.pm * 128 + wr * 64 + fr, col0 = wc * 32 + 4 * fq;
#pragma unroll
        for (int m = 0; m < 4; ++m) { float* rowp = LG + (size_t)(row0 + m * 16) * nv::NE + col0;
#pragma unroll
            for (int bj = 0; bj < 2; ++bj)
#pragma unroll
                for (int n = 0; n < 2; ++n) *(f32x4*)(rowp + bj * HALF + n * 16) = acc[0][bj][m][n]; }
    }
};
template <int PH> struct MoeSched {
    int G, vcu, nrt; mo::lint tb; mo::lint cn; const int* list_tok; const bf16_t* W;
    static constexpr int NC = PH == 0 ? 2 : 4;
    __device__ __forceinline__ bool next(int i, Unit2& u) const {
        const int L = i * G + vcu; if (L >= nrt * NC) return false;
        const int rt = L / NC, c = L % NC;
        int lo = 0, hi = 256;
        while (lo < hi) { const int mid = (lo + hi + 1) >> 1; if (tb[mid] <= rt) lo = mid; else hi = mid - 1; }
        const int e = lo, jt = rt - tb[e]; const int total = cn[e];
        const int rem = total - 256 * jt;
        u.pm = rt; u.pn = c; u.e = __builtin_amdgcn_readfirstlane(e); u.jt = __builtin_amdgcn_readfirstlane(jt); u.cnt = __builtin_amdgcn_readfirstlane(rem < 256 ? rem : 256); return true;
    }
    __device__ __forceinline__ int arow(const Unit2& u, int r) const {
        if (PH == 1) return u.pm * BM + r;
        if (u.e == 256) return u.jt * BM + r;
        return (r < u.cnt) ? list_tok[u.e * mo::CAP + u.jt * BM + r] : 0;
    }
    __device__ __forceinline__ size_t aoff(const Unit2&) const { return 0; }
    __device__ __forceinline__ const char* bptr(const Unit2& u) const {
        return PH == 0 ? (const char*)(W + ((size_t)u.e * 512 + 256 * u.pn) * 1024) : (const char*)(W + ((size_t)u.e * 1024 + 256 * u.pn) * 256);
    }
};
struct EpiSwiGLU {
    static constexpr bool PERM = true, AFTER_DRAIN = false;
    bf16_t* H; const float* list_gate;
    __device__ __forceinline__ void operator()(const f32x4 (&acc)[2][2][4][2], const Unit2& u, int wr, int wc, int fr, int fq) const {
        const int col0 = u.pn * 128 + wc * 32 + 8 * fq;
#pragma unroll
        for (int ai = 0; ai < 2; ++ai)
#pragma unroll
            for (int m = 0; m < 4; ++m) { const int r = ai * HALF + wr * 64 + m * 16 + fr;
                float gt = 1.f; if (u.e < 256) gt = (r < u.cnt) ? list_gate[u.e * mo::CAP + u.jt * BM + r] : 0.f;
                float hv[8];
#pragma unroll
                for (int n = 0; n < 2; ++n)
#pragma unroll
                    for (int i = 0; i < 4; ++i) { const float gg = acc[ai][0][m][n][i], uu = acc[ai][1][m][n][i]; hv[4 * n + i] = gt * uu * (gg * __builtin_amdgcn_rcpf(1.f + __builtin_amdgcn_exp2f(-1.4426950408889634f * gg))); }
                u32x4 w; w.x = cvt_pk_bf16(hv[0], hv[1]); w.y = cvt_pk_bf16(hv[2], hv[3]); w.z = cvt_pk_bf16(hv[4], hv[5]); w.w = cvt_pk_bf16(hv[6], hv[7]);
                *(u32x4*)(H + (size_t)(u.pm * BM + r) * 256 + col0) = w; }
    }
};
struct EpiDown {
    static constexpr bool PERM = true, AFTER_DRAIN = false;
    unsigned char* Y; mo::lint yb;
    __device__ __forceinline__ void operator()(const f32x4 (&acc)[2][2][4][2], const Unit2& u, int wr, int wc, int fr, int fq) const {
        typedef unsigned u32x2v __attribute__((ext_vector_type(2)));
        const int col0 = u.pn * BM + wc * 32 + 8 * fq; const int ybase = yb[u.e] + u.jt * BM;
#pragma unroll
        for (int ai = 0; ai < 2; ++ai)
#pragma unroll
            for (int m = 0; m < 4; ++m) { const int r = ai * HALF + wr * 64 + m * 16 + fr;
                if (r < u.cnt) { unsigned char* rowp = Y + (size_t)(ybase + r) * nv::D + col0;
#pragma unroll
                    for (int bj = 0; bj < 2; ++bj) { const f32x4 v0 = acc[ai][bj][m][0] * mo::YSC, v1 = acc[ai][bj][m][1] * mo::YSC;
                        int w0 = __builtin_amdgcn_cvt_pk_fp8_f32(v0[0], v0[1], 0, false); w0 = __builtin_amdgcn_cvt_pk_fp8_f32(v0[2], v0[3], w0, true);
                        int w1 = __builtin_amdgcn_cvt_pk_fp8_f32(v1[0], v1[1], 0, false); w1 = __builtin_amdgcn_cvt_pk_fp8_f32(v1[2], v1[3], w1, true);
                        *(u32x2v*)(rowp + bj * HALF) = (u32x2v){(unsigned)w0, (unsigned)w1}; } } }
    }
};
}
constexpr int NTHR = 512;
constexpr int LDS_BYTES = 147456;
constexpr int MISC_OFF = 131072 + 320;
constexpr size_t MiB = 1u << 20;
constexpr size_t CTL_ZERO_BYTES = 1 * MiB;
constexpr int CW_BAR = 4096;
constexpr int CW_MOE = 16384;
constexpr int CW_FOXQ = 20992;
constexpr int CW_NRM = 20480;
constexpr int NPHASE = 9;
constexpr size_t WS_H1 = 1, WS_WR = 65, WS_STATS = 66, WS_LF = 67, WS_FG = 68, WS_WO = 72, WS_WIN = 74, WS_TK = 81, WS_LTOK = 83, WS_LGATE = 91,
                 WS_WED = 100, WS_HID = 230, WS_GLA = 230, WS_WEG = 416, WS_XN = 673, WS_YBF = 673, WS_QKV = 737, WS_Z1 = 737, WS_LG = 865, WS_Y = 416, WS_END = 992;

struct Args { const float* in[21]; float* out; unsigned char* ws; int ph_lo, ph_hi, li, pad; };

__global__ void __launch_bounds__(NTHR, 2) mega_fwd(Args a) {
    using namespace nv;
    extern __shared__ __attribute__((aligned(16))) unsigned char lds[];
    const int G = gridDim.x, bx = blockIdx.x;
    const int vcu = (G % 8 == 0) ? (bx % 8) * (G / 8) + bx / 8 : bx;
    int tid, lane, wave, vw;
#define DERIVE() do { int t_ = threadIdx.x; asm volatile("" : "+v"(t_)); tid = t_; lane = tid & 63; wave = __builtin_amdgcn_readfirstlane(tid >> 6); vw = vcu * 8 + wave; } while (0)
    DERIVE();
    volatile LAS unsigned* MISC = (volatile LAS unsigned*)((LAS unsigned char*)lds + MISC_OFF);
    for (int u = tid; u < (LDS_BYTES - 131072) / 4; u += NTHR) ((LAS unsigned*)((LAS unsigned char*)lds + 131072))[u] = 0u;
    __syncthreads();
    unsigned char* ws = a.ws;
    unsigned* ctl = (unsigned*)ws;
    XcdBarrier bar = xcd_barrier_post(ctl + CW_BAR + a.li * XCD_BAR_WORDS, MISC + 8);
    const float* x = a.in[0];
    const float* ln_in_g = a.in[1]; const float* ln_in_b = a.in[2];
    const float* w_in = a.in[3]; const float* b_fgate = a.in[4];
    const float* w_gate_up = a.in[5]; const float* b_gate = a.in[6]; const float* g_gla = a.in[7];
    const float* w_out = a.in[8]; const float* ln1_g = a.in[9]; const float* ln1_b = a.in[10];
    const float* w_router = a.in[11]; const float* rbias = a.in[12];
    const float* w_eg = a.in[13]; const float* w_eu = a.in[14]; const float* w_ed = a.in[15];
    const float* w_sg = a.in[16]; const float* w_su = a.in[17]; const float* w_sd = a.in[18];
    const float* ln2_g = a.in[19]; const float* ln2_b = a.in[20];
    float* out = a.out;
    int* counts = (int*)(ctl + CW_MOE);
    fx::bf16* H1 = (fx::bf16*)(ws + WS_H1 * MiB);
    fx::bf16* WrT = (fx::bf16*)(ws + WS_WR * MiB);
    float* stats = (float*)(ws + WS_STATS * MiB);
    float* LF = (float*)(ws + WS_LF * MiB);
    float* FG = (float*)(ws + WS_FG * MiB);
    fx::bf16* WoT = (fx::bf16*)(ws + WS_WO * MiB);
    fx::bf16* WinT = (fx::bf16*)(ws + WS_WIN * MiB);
    int* TK = (int*)(ws + WS_TK * MiB);
    float* TW = (float*)(ws + (WS_TK + 1) * MiB);
    int* list_tok = (int*)(ws + WS_LTOK * MiB);
    float* list_gate = (float*)(ws + WS_LGATE * MiB);
    fx::bf16* WedT = (fx::bf16*)(ws + WS_WED * MiB);
    fx::bf16* HID = (fx::bf16*)(ws + WS_HID * MiB);
    unsigned char* QPG = ws + WS_GLA * MiB; unsigned char* OIb = ws + (WS_GLA + 16) * MiB; unsigned char* UUb = ws + (WS_GLA + 80) * MiB; float* DECb = (float*)(ws + (WS_GLA + 144) * MiB); unsigned char* STGb = ws + (WS_GLA + 145) * MiB;
    fx::bf16* WegT = (fx::bf16*)(ws + WS_WEG * MiB);
    fx::bf16* XN = (fx::bf16*)(ws + WS_XN * MiB);
    fx::bf16* Ybf = (fx::bf16*)(ws + WS_YBF * MiB);
    fx::bf16* QKV = (fx::bf16*)(ws + WS_QKV * MiB);
    fx::bf16* MIX = (fx::bf16*)(ws + WS_Z1 * MiB);
    float* LG = (float*)(ws + WS_LG * MiB);
    unsigned char* YA = ws + WS_Y * MiB;
    mo::lint tb = (mo::lint)((LAS unsigned char*)lds + mo::L_TB), yb = (mo::lint)((LAS unsigned char*)lds + mo::L_YB), cn = (mo::lint)((LAS unsigned char*)lds + mo::L_CN);

    const int lo = a.ph_lo, hi = a.ph_hi;
#define IN(k) (lo <= (k) && (k) < hi)
#define SEAM(k) do { if (IN(k) && IN((k) + 1)) xcd_barrier(bar); DERIVE(); } while (0)
    const int GW = G * 8;
#ifndef STG7
#define STG7 0
#endif
#ifndef STG8
#define STG8 0
#endif
#define STAGGER(q) do { if ((q) > 0) { const unsigned long long t0_ = __builtin_amdgcn_s_memrealtime(); const unsigned long long d_ = (unsigned long long)((vcu & 3) * (q)); while (__builtin_amdgcn_s_memrealtime() - t0_ < d_) __builtin_amdgcn_s_sleep(8); } } while (0)

    if (IN(0)) {
        LAS float* scr = (LAS float*)((LAS unsigned char*)lds + wave * 16384);
        constexpr int I_IN = 16 * (fx::NIN / 32), I_OUT = 16 * 32, I_R = 16 * 8, I_SMALL = I_IN + I_OUT + I_R, I_EG = mo::NEX * 256, I_ED = mo::NEX * 128, I_EXP = I_EG + I_ED;
        for (int it = vw; it < I_SMALL; it += GW) {
            int r = it;
            if (r < I_IN) { fx::transpose_item(w_in, D, INW, WinT, scr, r / (fx::NIN / 32), r % (fx::NIN / 32), lane, [](int d) { return fx::inproj_src(d); }); continue; } r -= I_IN;
            if (r < I_OUT) { fx::transpose_item(w_out, D, D, WoT, scr, r / 32, r % 32, lane, [](int d) { return d; }); continue; } r -= I_OUT;
            fx::transpose_item(w_router, D, NE, WrT, scr, r / 8, r % 8, lane, [](int d) { return d; });
        }
        for (int r = vw; r < T; r += GW) fx::ln_row_bf16(x + (size_t)r * D, ln_in_g, ln_in_b, XN + (size_t)r * D, nullptr, stats + 2 * (size_t)r, lane);
#define CV_DECODE(r_, I) do { int r = (r_); if (r < I_EG) { const int e = r >> 8, kb = (r >> 4) & 15, nb = r & 15, c = nb >> 3, sub = nb & 7; \
            I.W = (e < NE) ? ((sub < 4 ? w_eg : w_eu) + (size_t)e * D * ED) : (sub < 4 ? w_sg : w_su); I.WT = WegT + (size_t)e * 512 * D; I.N = ED; I.K = D; I.k0 = 64 * kb; I.n0 = 32 * nb; I.s0 = 128 * c + 32 * (sub & 3); } \
          else { r -= I_EG; const int e = r >> 7, kb = (r >> 5) & 3, nb = r & 31; I.W = (e < NE) ? (w_ed + (size_t)e * ED * D) : w_sd; I.WT = WedT + (size_t)e * D * ED; I.N = D; I.K = ED; I.k0 = 64 * kb; I.n0 = 32 * nb; I.s0 = 32 * nb; } } while (0)
        { int it = vw; fx::CvItem cur, nx; fx::f32x4 v[8], w[8];
          if (it < I_EXP) { CV_DECODE(it, cur); fx::cv_load(cur, v, lane); }
          while (it < I_EXP) { const int itn = it + GW; if (itn < I_EXP) { CV_DECODE(itn, nx); fx::cv_load(nx, w, lane); }
              fx::cv_finish(cur, v, scr, lane); cur = nx;
#pragma unroll
              for (int i = 0; i < 8; ++i) v[i] = w[i];
              it = itn; } }
#undef CV_DECODE
    }
    SEAM(0);
    if (IN(1)) {
        pg8::Gemm g{XN, WinT, T, fx::NIN, D, D}; pg8::StaticOrder S; S.init(T, fx::NIN, G, bx);
        pg8::EpiInProj E{QKV, FG, LF, b_fgate, ctl + CW_NRM};
        pg8::gemm_phase<pg8::EpiInProj, pg8::StaticOrder, true, true>((LAS unsigned char*)lds, g, S, E);
    }
    SEAM(1);
    if (IN(2)) {
        int cur_h = -1;
        if (gl::NUNIT % G == 0) { const int per = gl::NUNIT / G; for (int i = 0; i < per; ++i) gl::prep_unit(vcu * per + i, QKV, FG, w_gate_up, b_gate, QPG, OIb, UUb, DECb, lds, cur_h); }
        else for (int u = vcu; u < gl::NUNIT; u += G) gl::prep_unit(u, QKV, FG, w_gate_up, b_gate, QPG, OIb, UUb, DECb, lds, cur_h);
    }
    SEAM(2);
    if (IN(3)) {
        for (int blk = vcu; blk < gl::NUNIT / 8; blk += G) gl::post_block(blk * 8, 8, QKV, QPG, OIb, UUb, DECb, g_gla, Ybf, lds);
        { const attn_body::AttnTensors AT{(const attn_body::bf16*)(QKV + fx::P_FQ), (const attn_body::bf16*)(QKV + fx::P_FK), (const attn_body::bf16*)(QKV + fx::P_FV), (attn_body::bf16*)Ybf, LF, ctl + CW_NRM};
          attn_body::attn_phase_dyn<8>((char*)lds, AT, ctl + CW_FOXQ, (volatile int*)(lds + 140288)); }
    }
    SEAM(3);
    if (IN(4)) {
        pg8::DenseSched DS; DS.so.init(T, D, G, bx); DS.Bt = WoT; DS.ldb = D;
        pg8::EpiPlainBf16 E{MIX, D};
        pg8::gemm_phase2<pg8::EpiPlainBf16, pg8::DenseSched>((LAS unsigned char*)lds, Ybf, D, D, D, DS, E);
    }
    SEAM(4);
    if (IN(5)) {
        int* lcnt = (int*)(lds + 136192); int* lbase = lcnt + 256;
        for (int rb = vcu; rb < T / 128; rb += G) {
            if (tid < 256) lcnt[tid] = 0;
            for (int r = wave * 16; r < wave * 16 + 16; r += 4) { const size_t row = (size_t)rb * 128 + r;
                fx::ln1_rows_bf16<4>(x + row * D, stats + 2 * row, ln_in_g, ln_in_b, MIX + row * D, ln1_g, ln1_b, H1 + row * D, ALPHA, lane); }
            asm volatile("s_waitcnt vmcnt(0)" ::: "memory"); __syncthreads();
            { pg8::RouterSched RS{rb, WrT}; pg8::EpiLogits E{LG};
              pg8::gemm_phase2<pg8::EpiLogits, pg8::RouterSched>((LAS unsigned char*)lds, H1, D, D, D, RS, E); }
            DERIVE();
            for (int t = rb * 128 + wave * 2; t < rb * 128 + 128; t += 16) mo::route_token2(LG, rbias, lcnt, TK, TW, t, lane);
            __syncthreads();
            if (tid < 256) { const int c = lcnt[tid]; lbase[tid] = c ? atomicAdd(&counts[tid], c) : 0; }
            __syncthreads();
            for (int t = rb * 128 + wave * 2; t < rb * 128 + 128; t += 16) mo::route_finish2(lbase, list_tok, list_gate, TK, TW, t, lane);
            __syncthreads();
        }
    }
    SEAM(5);
    if (IN(6)) {
        if (wave == 0) mo::moe_tables(counts, tb, yb, cn, lane);
        __syncthreads();
        STAGGER(STG7);
        pg8::MoeSched<0> MS{G, vcu, tb[257], tb, cn, list_tok, WegT}; pg8::EpiSwiGLU E{HID, list_gate};
        pg8::gemm_phase2<pg8::EpiSwiGLU, pg8::MoeSched<0>>((LAS unsigned char*)lds, H1, D, D, D, MS, E);
    }
    SEAM(6);
    if (IN(7)) {
        if (wave == 0) mo::moe_tables(counts, tb, yb, cn, lane);
        __syncthreads();
        STAGGER(STG8);
        pg8::MoeSched<1> MS{G, vcu, tb[257], tb, cn, list_tok, WedT}; pg8::EpiDown E{YA, yb};
        pg8::gemm_phase2<pg8::EpiDown, pg8::MoeSched<1>>((LAS unsigned char*)lds, HID, ED, ED, ED, MS, E);
    }
    SEAM(7);
    if (IN(8)) {
        if (wave == 0) mo::moe_tables(counts, tb, yb, cn, lane);
        __syncthreads();
        for (int t = vw; t < T; t += GW) mo::combine_token(H1, YA, TK, yb, ln2_g, ln2_b, out, t, lane);
    }
#undef IN
#undef SEAM
}

extern "C" void kernel_launch(void* const* d_in, const int* in_sizes, int n_in, void* d_out, int out_size, void* d_ws, size_t ws_size, hipStream_t stream) {
    static int grid = 0;
    if (grid == 0) {
        if (n_in != 21 || out_size != nv::T * nv::D || ws_size < WS_END * MiB) { fprintf(stderr, "kernel_launch: unexpected shapes n_in=%d out=%d ws=%zu\n", n_in, out_size, ws_size); grid = -1; return; }
        int dev = 0, cus = 0;
        if (hipGetDevice(&dev) != hipSuccess || hipDeviceGetAttribute(&cus, hipDeviceAttributeMultiprocessorCount, dev) != hipSuccess) { grid = -1; return; }
        if (hipFuncSetAttribute((const void*)mega_fwd, hipFuncAttributeMaxDynamicSharedMemorySize, LDS_BYTES) != hipSuccess) { fprintf(stderr, "kernel_launch: hipFuncSetAttribute failed\n"); grid = -1; return; }
        grid = cus;
    }
    if (grid < 0) return;
    if (hipMemsetAsync(d_ws, 0, CTL_ZERO_BYTES, stream) != hipSuccess) return;
    Args a{};
    for (int i = 0; i < 21; ++i) a.in[i] = (const float*)d_in[i];
    a.out = (float*)d_out; a.ws = (unsigned char*)d_ws; a.ph_lo = 0; a.ph_hi = NPHASE; a.li = 0;
#ifdef REPEAT_PH
    a.ph_hi = REPEAT_PH + 1; hipLaunchKernelGGL(mega_fwd, dim3(grid), dim3(NTHR), LDS_BYTES, stream, a);
    if (REPEAT_PH == 5) hipMemsetAsync((char*)d_ws + CW_MOE * 4, 0, 4096, stream);
    a.ph_lo = REPEAT_PH; a.ph_hi = NPHASE; a.li = 1;
#endif
    hipLaunchKernelGGL(mega_fwd, dim3(grid), dim3(NTHR), LDS_BYTES, stream, a);
}
```

```cpp
#include <hip/hip_runtime.h>
#include <cstdio>
#include <cstdint>
#include <cmath>

#define LAS __attribute__((address_space(3)))
#define GAS __attribute__((address_space(1)))

#define XB_TMO      128
#define XB_XCNT(j)  (256  + 64 * (j))
#define XB_XSUB(j)  (1280 + 64 * (j))
#define XB_XGEN(j)  (2304 + 64 * (j))
#define XB_TOP      3328
#define XB_TOPGEN   3392
#define XCD_BAR_WORDS 3456
#define XB_SPIN_CAP (1u << 27)
__device__ __forceinline__ unsigned xb_ld(unsigned* p)              { return __hip_atomic_load(p, __ATOMIC_RELAXED, __HIP_MEMORY_SCOPE_AGENT); }
__device__ __forceinline__ unsigned xb_add(unsigned* p, unsigned v) { return __hip_atomic_fetch_add(p, v, __ATOMIC_RELAXED, __HIP_MEMORY_SCOPE_AGENT); }
__device__ __forceinline__ unsigned xb_xcc_id() { return (unsigned)__builtin_amdgcn_s_getreg((3 << 11) | 20) & 0xFu; }
#define XB_SPIN(cond, bar) do { unsigned _sp = 0; while (cond) { __builtin_amdgcn_s_sleep(1); \
    if ((++_sp & 255u) == 0u) { if (xb_ld(&(bar)[XB_TMO])) break; if (_sp > XB_SPIN_CAP) { atomicAdd(&(bar)[XB_TMO], 1u); break; } } } } while (0)
struct XcdBarrier { unsigned* bar; unsigned x; volatile LAS unsigned* st; };
__device__ __forceinline__ XcdBarrier xcd_barrier_post(unsigned* bar, volatile LAS unsigned* st) {
    XcdBarrier b; b.bar = bar; b.x = xb_xcc_id(); b.st = st;
    if (threadIdx.x == 0) (void)xb_add(&bar[XB_XCNT(b.x)], 1u);
    return b;
}
__device__ __forceinline__ void xcd_barrier_complete(unsigned* bar, unsigned x, unsigned& nloc, unsigned& nx) {
    const unsigned G = gridDim.x * gridDim.y * gridDim.z;
    unsigned sum, cnt, mine, sp = 0u;
    for (;;) {
        sum = 0u; cnt = 0u; mine = 0u;
#pragma unroll
        for (unsigned j = 0; j < 16; ++j) { const unsigned c = xb_ld(&bar[XB_XCNT(j)]); sum += c; cnt += (c > 0u) ? 1u : 0u; mine = (j == x) ? c : mine; }
        if (sum == G) break;
        __builtin_amdgcn_s_sleep(1);
        if ((++sp & 255u) == 0u) { if (xb_ld(&bar[XB_TMO])) break; if (sp > XB_SPIN_CAP) { atomicAdd(&bar[XB_TMO], 1u); break; } }
    }
    nloc = mine > 0u ? mine : 1u; nx = cnt > 0u ? cnt : 1u;
}
__device__ __forceinline__ void xcd_barrier(const XcdBarrier& b) {
    asm volatile("s_waitcnt vmcnt(0)" ::: "memory");
    __syncthreads();
    if (threadIdx.x == 0) {
        unsigned* bar = b.bar;
        __builtin_amdgcn_s_waitcnt(0);
        unsigned nloc = b.st[0], nx = b.st[1];
        if (nloc == 0u) { xcd_barrier_complete(bar, b.x, nloc, nx); b.st[0] = nloc; b.st[1] = nx; }
        const unsigned old = xb_add(&bar[XB_XSUB(b.x)], 1u);
        const unsigned gen = old / nloc;
        if (old + 1u == (gen + 1u) * nloc) {
            __builtin_amdgcn_fence(__ATOMIC_RELEASE, "agent");
            asm volatile("s_waitcnt vmcnt(0)" ::: "memory");
            const unsigned og = xb_add(&bar[XB_TOP], 1u);
            const unsigned tg = og / nx;
            if (og + 1u == (tg + 1u) * nx) xb_add(&bar[XB_TOPGEN], 1u);
            else XB_SPIN(xb_ld(&bar[XB_TOPGEN]) == tg, bar);
            __builtin_amdgcn_fence(__ATOMIC_ACQUIRE, "agent");
            xb_add(&bar[XB_XGEN(b.x)], 1u);
            asm volatile("s_waitcnt vmcnt(0)" ::: "memory");
        } else {
            XB_SPIN(xb_ld(&bar[XB_XGEN(b.x)]) == gen, bar);
            __builtin_amdgcn_fence(__ATOMIC_ACQUIRE, "agent");
            asm volatile("s_waitcnt vmcnt(0)" ::: "memory");
        }
    }
    __syncthreads();
}
namespace pg8 {
#define PG8_LAS __attribute__((address_space(3)))
typedef unsigned short bf16_t;
typedef short bf16x8 __attribute__((ext_vector_type(8)));
typedef float f32x4 __attribute__((ext_vector_type(4)));
typedef unsigned u32x4 __attribute__((ext_vector_type(4)));
constexpr int BM = 256, BK = 64, HALF = 128, HTB = HALF * BK * 2  , STAGE_BYTES = 8 * HTB, NXCD = 8, WGM = 8;

__host__ __device__ __forceinline__ int lds_byte(int r, int c) { const int st = (r >> 4) * 2 + (c >> 5), rr = r & 15, cc = c & 31, ob = rr * 64 + cc * 2; return st * 1024 + (ob ^ (((ob >> 9) & 1) << 5)); }
__host__ __device__ __forceinline__ void stage_rc(int b, int& R, int& C) { const int st = b / 1024, sb = b % 1024, swz = sb ^ (((sb >> 9) & 1) << 5); R = (st >> 1) * 16 + swz / 64; C = (st & 1) * 32 + (swz % 64) / 2; }
__host__ __device__ __forceinline__ int perm32(int rho) { const int n = rho >> 4, i = rho & 15; return 8 * (i >> 2) + 4 * n + (i & 3); }

struct Unit { int pm, pn; };
struct Gemm { const bf16_t* A; const bf16_t* Bt; int M, N, K, lda; };

struct StaticOrder {
    int nM, nN, nwg, G, c;
    __host__ __device__ void init(int M, int N, int G_, int c_) { nM = M / BM; nN = N / BM; nwg = nM * nN; G = G_; c = c_; }
    __host__ __device__ bool next(int i, Unit& u) const {
        const long L = (long)i * G + c; if (L >= nwg) return false;
        int wgid = (int)L; { const int q = nwg / NXCD, r = nwg % NXCD, xcd = wgid % NXCD, off = wgid / NXCD; wgid = (xcd < r ? xcd * (q + 1) : r * (q + 1) + (xcd - r) * q) + off; }
        const int nig = WGM * nN, gid = wgid / nig, fm = gid * WGM, gsz = (nM - fm) < WGM ? (nM - fm) : WGM;
        u.pm = fm + ((wgid % nig) % gsz); u.pn = (wgid % nig) / gsz; return true;
    }
    __device__ __forceinline__ void a_ready(const Unit&) const {}
    __device__ __forceinline__ void done(const Unit&) const {}
};

__device__ __forceinline__ unsigned cvt_pk_bf16(float lo, float hi) { unsigned r; asm volatile("v_cvt_pk_bf16_f32 %0, %1, %2" : "=v"(r) : "v"(lo), "v"(hi)); return r; }
typedef float f32x2 __attribute__((ext_vector_type(2)));
__device__ __forceinline__ f32x2 gelu_pk(f32x2 v) {
    const f32x2 av = __builtin_elementwise_abs(v), d = av * 0.2316418882f + 1.0f;
    f32x2 t; t.x = __builtin_amdgcn_rcpf(d.x); t.y = __builtin_amdgcn_rcpf(d.y);
    f32x2 q = t * 0.5307027145f + (-0.7265760135f); q = q * t + 0.7107068705f; q = q * t + (-0.142248368f); q = q * t + 0.127414796f; q = q * t;
    const f32x2 s = (v * v) * (-0.72134752044f);
    f32x2 e; e.x = __builtin_amdgcn_exp2f(s.x); e.y = __builtin_amdgcn_exp2f(s.y);
    const f32x2 m = v * (q * e), r = v - m;
    f32x2 o; o.x = v.x < 0.f ? m.x : r.x; o.y = v.y < 0.f ? m.y : r.y; return o;
}

template <int ACT  > struct EpiBf16 {
    static constexpr bool PERM = true, AFTER_DRAIN = false; static_assert(ACT == 0 || ACT == 1, "EpiBf16: ACT is 0 (none) or 1 (gelu_pk)");
    bf16_t* O; int ldc; const float* bias; int split_cols; size_t split_stride; float scale0;
    __device__ __forceinline__ void operator()(const f32x4 (&acc)[2][2][4][2], const Unit& u, int wr, int wc, int fr, int fq) const {
        const int row0 = u.pm * BM + wr * 64 + fr; int colt = u.pn * BM; bf16_t* base = O;
        float sc = 1.f; if (split_cols) { const int t = colt / split_cols; base += (size_t)t * split_stride; colt -= t * split_cols; if (t == 0) sc = scale0; }
        const int col0 = colt + wc * 32 + 8 * fq, bcol0 = u.pn * BM + wc * 32 + 8 * fq;
        f32x4 bv[2][2];
#pragma unroll
        for (int bj = 0; bj < 2; ++bj)
#pragma unroll
            for (int n = 0; n < 2; ++n) bv[bj][n] = bias ? *(const f32x4*)(bias + bcol0 + bj * HALF + 4 * n) : (f32x4){0.f, 0.f, 0.f, 0.f};
#pragma unroll
        for (int ai = 0; ai < 2; ++ai)
#pragma unroll
            for (int m = 0; m < 4; ++m) { bf16_t* rowp = base + (size_t)(row0 + ai * HALF + m * 16) * ldc + col0;
#pragma unroll
                for (int bj = 0; bj < 2; ++bj) { f32x4 v0 = acc[ai][bj][m][0] + bv[bj][0], v1 = acc[ai][bj][m][1] + bv[bj][1];
                    if (ACT == 1) { f32x2 a = gelu_pk((f32x2){v0[0], v0[1]}), b = gelu_pk((f32x2){v0[2], v0[3]}), c = gelu_pk((f32x2){v1[0], v1[1]}), d = gelu_pk((f32x2){v1[2], v1[3]});
                        v0 = (f32x4){a.x, a.y, b.x, b.y}; v1 = (f32x4){c.x, c.y, d.x, d.y}; }
                    v0 = v0 * sc; v1 = v1 * sc; u32x4 w; w.x = cvt_pk_bf16(v0[0], v0[1]); w.y = cvt_pk_bf16(v0[2], v0[3]); w.z = cvt_pk_bf16(v1[0], v1[1]); w.w = cvt_pk_bf16(v1[2], v1[3]);
                    *(u32x4*)(rowp + bj * HALF) = w; } }
    }
};

template <class Epi, class Sched, bool ALIGN_EPI = false, bool SP2 = false>
__device__ __forceinline__ void gemm_phase(PG8_LAS unsigned char* lds, const Gemm g, const Sched& S, const Epi& E) {
    const int tid = threadIdx.x, wid = __builtin_amdgcn_readfirstlane(tid >> 6), lane = tid & 63, wr = wid >> 2, wc = wid & 3, fr = lane & 15, fq = lane >> 4;
    const int K = g.K, nt = K / BK;
    unsigned voffA[2], voffB[2];
#pragma unroll
    for (int i = 0; i < 2; ++i) { int R, C; stage_rc(tid * 16 + i * 8192, R, C); const int Rb = Epi::PERM ? ((R & ~31) + perm32(R & 31)) : R;
        voffA[i] = (unsigned)(R * g.lda + C) * 2u; voffB[i] = (unsigned)(Rb * K + C) * 2u; }
    const size_t kstep = (size_t)(BK * 2);
    const size_t hstepA = (size_t)HALF * g.lda * 2, hstepB = (size_t)HALF * K * 2;
    const size_t tstepA = 2 * hstepA, tstepB = 2 * hstepB;
    const unsigned ldsw = (unsigned)wid * 1024u;
    const int aoff = lds_byte(wr * 64 + fr, fq * 8), boff = lds_byte(wc * 32 + fr, fq * 8);
#define PG8_SA(b, h) (((b) * 2 + (h)) * HTB)
#define PG8_SB(b, h) ((4 + (b) * 2 + (h)) * HTB)
#define PG8_STAGE(bufoff, gbase, voff) do { _Pragma("unroll") for (int _i = 0; _i < 2; ++_i) \
        __builtin_amdgcn_global_load_lds((const unsigned*)((const char*)(gbase) + (voff)[_i]), (PG8_LAS unsigned*)(lds + (bufoff) + ldsw + _i * 8192), 16, 0, 0); } while (0)
#define PG8_LDA(dst, b, h) do { _Pragma("unroll") for (int m = 0; m < 4; ++m) _Pragma("unroll") for (int k = 0; k < 2; ++k) dst[m][k] = *(const PG8_LAS bf16x8*)(lds + PG8_SA(b, h) + aoff + m * 2048 + k * 1024); } while (0)
#define PG8_LDB(dst, b, h) do { _Pragma("unroll") for (int n = 0; n < 2; ++n) _Pragma("unroll") for (int k = 0; k < 2; ++k) dst[n][k] = *(const PG8_LAS bf16x8*)(lds + PG8_SB(b, h) + boff + n * 2048 + k * 1024); } while (0)
#define PG8_MMA(ai, bj, At, Bt) do { __builtin_amdgcn_s_setprio(1); _Pragma("unroll") for (int m = 0; m < 4; ++m) _Pragma("unroll") for (int n = 0; n < 2; ++n) _Pragma("unroll") for (int k = 0; k < 2; ++k) \
        acc[ai][bj][m][n] = __builtin_amdgcn_mfma_f32_16x16x32_bf16(Bt[n][k], At[m][k], acc[ai][bj][m][n], 0, 0, 0); __builtin_amdgcn_s_setprio(0); } while (0)
#define PG8_WAIT_V(n) asm volatile("s_waitcnt vmcnt(" #n ")" ::: "memory")
#define PG8_WAIT_L(n) asm volatile("s_waitcnt lgkmcnt(" #n ")" ::: "memory")
#define PG8_BAR __builtin_amdgcn_s_barrier()
#define PG8_SCHED __builtin_amdgcn_sched_barrier(0)
    Unit cur, nxt; int ui = 0;
    if (!S.next(0, cur)) return;
    f32x4 acc[2][2][4][2];
#pragma unroll
    for (int a = 0; a < 2; ++a)
#pragma unroll
        for (int b = 0; b < 2; ++b)
#pragma unroll
            for (int m = 0; m < 4; ++m)
#pragma unroll
                for (int n = 0; n < 2; ++n) acc[a][b][m][n] = (f32x4){0.f, 0.f, 0.f, 0.f};
    bf16x8 At[4][2], B0[2][2], B1[2][2];
    const char* cA = (const char*)g.A + (size_t)cur.pm * tstepA; const char* cB = (const char*)g.Bt + (size_t)cur.pn * tstepB;
    S.a_ready(cur);
    if constexpr (SP2) {
        PG8_STAGE(PG8_SB(0, 0), cB, voffB); PG8_STAGE(PG8_SB(0, 1), cB + hstepB, voffB); PG8_STAGE(PG8_SA(0, 0), cA, voffA); PG8_STAGE(PG8_SA(0, 1), cA + hstepA, voffA);
        if (wr == 1) PG8_BAR;
        PG8_WAIT_V(2); PG8_BAR;
        PG8_STAGE(PG8_SB(1, 0), cB + kstep, voffB); PG8_STAGE(PG8_SA(1, 0), cA + kstep, voffA); PG8_STAGE(PG8_SB(1, 1), cB + hstepB + kstep, voffB);
        PG8_WAIT_V(6); PG8_BAR;
    } else {
        PG8_STAGE(PG8_SB(0, 0), cB, voffB); PG8_STAGE(PG8_SA(0, 0), cA, voffA); PG8_STAGE(PG8_SB(0, 1), cB + hstepB, voffB); PG8_STAGE(PG8_SA(0, 1), cA + hstepA, voffA);
        if (wr == 1) PG8_BAR;
        PG8_WAIT_V(4); PG8_BAR;
        PG8_STAGE(PG8_SB(1, 0), cB + kstep, voffB); PG8_STAGE(PG8_SA(1, 0), cA + kstep, voffA); PG8_STAGE(PG8_SB(1, 1), cB + hstepB + kstep, voffB);
        PG8_WAIT_V(6); PG8_BAR;
    }
    for (;;) {
        const bool has_next = S.next(ui + 1, nxt);
        const char* nA = has_next ? (const char*)g.A + (size_t)nxt.pm * tstepA : cA; const char* nB = has_next ? (const char*)g.Bt + (size_t)nxt.pn * tstepB : cB;
        for (int t = 0; t < nt; t += 2) {
            const bool last = (t == nt - 2);
            const char* a1 = cA + (size_t)(t + 1) * kstep;
            const char* a2 = last ? nA : cA + (size_t)(t + 2) * kstep; const char* b2 = last ? nB : cB + (size_t)(t + 2) * kstep;
            const char* a3 = a2 + kstep; const char* b3 = b2 + kstep;
            if (last && has_next) S.a_ready(nxt);
            if constexpr (SP2) {
            PG8_LDB(B0, 0, 0); PG8_LDB(B1, 0, 1); PG8_SCHED; PG8_LDA(At, 0, 0); PG8_STAGE(PG8_SA(1, 1), a1 + hstepA, voffA);
            PG8_WAIT_V(8); PG8_WAIT_L(0); PG8_BAR; PG8_MMA(0, 0, At, B0); PG8_MMA(0, 1, At, B1); PG8_BAR; PG8_SCHED;
            PG8_LDA(At, 0, 1); PG8_STAGE(PG8_SB(0, 0), b2, voffB); PG8_STAGE(PG8_SB(0, 1), b2 + hstepB, voffB); PG8_STAGE(PG8_SA(0, 0), a2, voffA);
            PG8_WAIT_V(8); PG8_WAIT_L(0); PG8_BAR; PG8_MMA(1, 0, At, B0); PG8_MMA(1, 1, At, B1); PG8_BAR; PG8_SCHED;
            PG8_LDB(B0, 1, 0); PG8_LDB(B1, 1, 1); PG8_SCHED; PG8_LDA(At, 1, 0); PG8_STAGE(PG8_SA(0, 1), a2 + hstepA, voffA);
            PG8_WAIT_V(8); PG8_WAIT_L(0); PG8_BAR; PG8_MMA(0, 0, At, B0); PG8_MMA(0, 1, At, B1); PG8_BAR; PG8_SCHED;
            PG8_LDA(At, 1, 1); PG8_STAGE(PG8_SB(1, 0), b3, voffB); PG8_STAGE(PG8_SB(1, 1), b3 + hstepB, voffB); PG8_STAGE(PG8_SA(1, 0), a3, voffA);
            PG8_WAIT_V(8); PG8_WAIT_L(0); PG8_BAR; PG8_MMA(1, 0, At, B0); PG8_MMA(1, 1, At, B1); PG8_BAR; PG8_SCHED;
            } else {
            PG8_LDB(B0, 0, 0); PG8_SCHED; PG8_LDA(At, 0, 0); PG8_STAGE(PG8_SA(1, 1), a1 + hstepA, voffA);
            PG8_WAIT_L(8); PG8_BAR; PG8_WAIT_L(0); PG8_MMA(0, 0, At, B0); PG8_BAR; PG8_SCHED;
            PG8_LDB(B1, 0, 1); PG8_STAGE(PG8_SB(0, 0), b2, voffB);
            PG8_BAR; PG8_WAIT_L(0); PG8_MMA(0, 1, At, B1); PG8_BAR;
            PG8_LDA(At, 0, 1); PG8_STAGE(PG8_SA(0, 0), a2, voffA);
            PG8_BAR; PG8_WAIT_L(0); PG8_MMA(1, 0, At, B0); PG8_BAR; PG8_SCHED;
            PG8_STAGE(PG8_SB(0, 1), b2 + hstepB, voffB);
            PG8_WAIT_V(6); PG8_BAR; PG8_MMA(1, 1, At, B1); PG8_BAR;
            PG8_LDB(B0, 1, 0); PG8_SCHED; PG8_LDA(At, 1, 0); PG8_STAGE(PG8_SA(0, 1), a2 + hstepA, voffA);
            PG8_WAIT_L(8); PG8_BAR; PG8_WAIT_L(0); PG8_MMA(0, 0, At, B0); PG8_BAR; PG8_SCHED;
            PG8_LDB(B1, 1, 1); PG8_STAGE(PG8_SB(1, 0), b3, voffB);
            PG8_BAR; PG8_WAIT_L(0); PG8_MMA(0, 1, At, B1); PG8_BAR;
            PG8_LDA(At, 1, 1); PG8_STAGE(PG8_SA(1, 0), a3, voffA);
            PG8_BAR; PG8_WAIT_L(0); PG8_MMA(1, 0, At, B0); PG8_BAR; PG8_SCHED;
            PG8_STAGE(PG8_SB(1, 1), b3 + hstepB, voffB);
            PG8_WAIT_V(6); PG8_BAR; PG8_MMA(1, 1, At, B1); PG8_BAR;
            }
        }
        if constexpr (ALIGN_EPI) { if (wr == 0) PG8_BAR; }
        if constexpr (!Epi::AFTER_DRAIN) { E(acc, cur, wr, wc, fr, fq); S.done(cur); }
        if (!has_next) break;
#pragma unroll
        for (int a = 0; a < 2; ++a)
#pragma unroll
            for (int b = 0; b < 2; ++b)
#pragma unroll
                for (int m = 0; m < 4; ++m)
#pragma unroll
                    for (int n = 0; n < 2; ++n) acc[a][b][m][n] = (f32x4){0.f, 0.f, 0.f, 0.f};
        cur = nxt; cA = nA; cB = nB; ++ui;
        if constexpr (ALIGN_EPI) { if (wr == 1) PG8_BAR; }
    }
    PG8_WAIT_V(0);
    if constexpr (!ALIGN_EPI) { if (wr == 0) PG8_BAR; }
    PG8_BAR;
    if constexpr (Epi::AFTER_DRAIN) { E.fused(acc, cur, wr, wc, fr, fq, lds, wid, lane); S.done(cur); }
#undef PG8_SA
#undef PG8_SB
#undef PG8_STAGE
#undef PG8_LDA
#undef PG8_LDB
#undef PG8_MMA
#undef PG8_WAIT_V
#undef PG8_WAIT_L
#undef PG8_BAR
#undef PG8_SCHED
}
}
namespace pg8 {
struct Unit2 { int pm, pn, e, cnt, jt; };
template <class Epi, class Sched>
__device__ __forceinline__ void gemm_phase2(PG8_LAS unsigned char* lds, const bf16_t* Abase, int lda, int ldb, int K, const Sched& S, const Epi& E) {
    int tid_ = threadIdx.x; asm volatile("" : "+v"(tid_));
    const int tid = tid_, wid = __builtin_amdgcn_readfirstlane(tid >> 6), lane = tid & 63, wr = wid >> 2, wc = wid & 3, fr = lane & 15, fq = lane >> 4;
    int K_ = K; asm volatile("" : "+s"(K_));
    const int nt = K_ / BK;
    unsigned voffB[2];
#pragma unroll
    for (int i = 0; i < 2; ++i) { int R, C; stage_rc(tid * 16 + i * 8192, R, C); const int Rb = Epi::PERM ? ((R & ~31) + perm32(R & 31)) : R; voffB[i] = (unsigned)(Rb * ldb + C) * 2u; }
    const unsigned lda2 = (unsigned)lda * 2u;
#define PG8_AOFFS(U, o0, o1) do { int t2_ = threadIdx.x; asm volatile("" : "+v"(t2_)); _Pragma("unroll") for (int i_ = 0; i_ < 2; ++i_) { int R_, C_; stage_rc(t2_ * 16 + i_ * 8192, R_, C_); \
        o0[i_] = (unsigned)S.arow(U, R_) * lda2 + (unsigned)C_ * 2u; o1[i_] = (unsigned)S.arow(U, HALF + R_) * lda2 + (unsigned)C_ * 2u; } } while (0)
    const size_t kstep = (size_t)(BK * 2);
    const size_t hstepB = (size_t)HALF * ldb * 2;
    const unsigned ldsw = (unsigned)wid * 1024u;
    const int aoff = lds_byte(wr * 64 + fr, fq * 8), boff = lds_byte(wc * 32 + fr, fq * 8);
#define PG8_SA(b, h) (((b) * 2 + (h)) * HTB)
#define PG8_SB(b, h) ((4 + (b) * 2 + (h)) * HTB)
#define PG8_STAGE(bufoff, gbase, voff) do { _Pragma("unroll") for (int _i = 0; _i < 2; ++_i) \
        __builtin_amdgcn_global_load_lds((const unsigned*)((const char*)(gbase) + (voff)[_i]), (PG8_LAS unsigned*)(lds + (bufoff) + ldsw + _i * 8192), 16, 0, 0); } while (0)
#define PG8_LDA(dst, b, h) do { _Pragma("unroll") for (int m = 0; m < 4; ++m) _Pragma("unroll") for (int k = 0; k < 2; ++k) dst[m][k] = *(const PG8_LAS bf16x8*)(lds + PG8_SA(b, h) + aoff + m * 2048 + k * 1024); } while (0)
#define PG8_LDB(dst, b, h) do { _Pragma("unroll") for (int n = 0; n < 2; ++n) _Pragma("unroll") for (int k = 0; k < 2; ++k) dst[n][k] = *(const PG8_LAS bf16x8*)(lds + PG8_SB(b, h) + boff + n * 2048 + k * 1024); } while (0)
#define PG8_MMA(ai, bj, At, Bt) do { __builtin_amdgcn_s_setprio(1); _Pragma("unroll") for (int m = 0; m < 4; ++m) _Pragma("unroll") for (int n = 0; n < 2; ++n) _Pragma("unroll") for (int k = 0; k < 2; ++k) \
        acc[ai][bj][m][n] = __builtin_amdgcn_mfma_f32_16x16x32_bf16(Bt[n][k], At[m][k], acc[ai][bj][m][n], 0, 0, 0); __builtin_amdgcn_s_setprio(0); } while (0)
#define PG8_WAIT_V(n) asm volatile("s_waitcnt vmcnt(" #n ")" ::: "memory")
#define PG8_WAIT_L(n) asm volatile("s_waitcnt lgkmcnt(" #n ")" ::: "memory")
#define PG8_BAR __builtin_amdgcn_s_barrier()
#define PG8_SCHED __builtin_amdgcn_sched_barrier(0)
    Unit2 cur, nxt; int ui = 0;
    if (!S.next(0, cur)) return;
    f32x4 acc[2][2][4][2];
#pragma unroll
    for (int a = 0; a < 2; ++a)
#pragma unroll
        for (int b = 0; b < 2; ++b)
#pragma unroll
            for (int m = 0; m < 4; ++m)
#pragma unroll
                for (int n = 0; n < 2; ++n) acc[a][b][m][n] = (f32x4){0.f, 0.f, 0.f, 0.f};
    bf16x8 At[4][2], B0[2][2], B1[2][2];
    unsigned cv0[2], cv1[2], nv0[2], nv1[2];
    PG8_AOFFS(cur, cv0, cv1);
    const char* cA = (const char*)Abase + S.aoff(cur); const char* cB = S.bptr(cur);
    PG8_STAGE(PG8_SB(0, 0), cB, voffB); PG8_STAGE(PG8_SB(0, 1), cB + hstepB, voffB); PG8_STAGE(PG8_SA(0, 0), cA, cv0); PG8_STAGE(PG8_SA(0, 1), cA, cv1);
    if (wr == 1) PG8_BAR;
    PG8_WAIT_V(2); PG8_BAR;
    PG8_STAGE(PG8_SB(1, 0), cB + kstep, voffB); PG8_STAGE(PG8_SA(1, 0), cA + kstep, cv0); PG8_STAGE(PG8_SB(1, 1), cB + hstepB + kstep, voffB);
    PG8_WAIT_V(6); PG8_BAR;
    for (;;) {
        const bool has_next = S.next(ui + 1, nxt);
        const char* nA = has_next ? (const char*)Abase + S.aoff(nxt) : cA; const char* nB = has_next ? S.bptr(nxt) : cB;
#pragma unroll
        for (int i = 0; i < 2; ++i) { nv0[i] = cv0[i]; nv1[i] = cv1[i]; }
        if (has_next) PG8_AOFFS(nxt, nv0, nv1);
        const bool act0 = cur.cnt > wr * 64, act1 = cur.cnt > HALF + wr * 64;
        for (int t = 0; t < nt; t += 2) {
            const bool last = (t == nt - 2);
            const char* a1 = cA + (size_t)(t + 1) * kstep;
            const char* a2 = last ? nA : cA + (size_t)(t + 2) * kstep; const char* b2 = last ? nB : cB + (size_t)(t + 2) * kstep;
            const char* a3 = a2 + kstep; const char* b3 = b2 + kstep;
            unsigned s0[2] = {cv0[0], cv0[1]}, s1[2] = {cv1[0], cv1[1]};
            if (last) { asm volatile("" ::: "memory"); s0[0] = nv0[0]; s0[1] = nv0[1]; s1[0] = nv1[0]; s1[1] = nv1[1]; }
            PG8_LDB(B0, 0, 0); PG8_LDB(B1, 0, 1); PG8_SCHED; PG8_LDA(At, 0, 0); PG8_STAGE(PG8_SA(1, 1), a1, cv1);
            PG8_WAIT_V(8); PG8_WAIT_L(0); PG8_BAR; if (act0) { PG8_MMA(0, 0, At, B0); PG8_MMA(0, 1, At, B1); } PG8_BAR; PG8_SCHED;
            PG8_LDA(At, 0, 1); PG8_STAGE(PG8_SB(0, 0), b2, voffB); PG8_STAGE(PG8_SB(0, 1), b2 + hstepB, voffB); PG8_STAGE(PG8_SA(0, 0), a2, s0);
            PG8_WAIT_V(8); PG8_WAIT_L(0); PG8_BAR; if (act1) { PG8_MMA(1, 0, At, B0); PG8_MMA(1, 1, At, B1); } PG8_BAR; PG8_SCHED;
            PG8_LDB(B0, 1, 0); PG8_LDB(B1, 1, 1); PG8_SCHED; PG8_LDA(At, 1, 0); PG8_STAGE(PG8_SA(0, 1), a2, s1);
            PG8_WAIT_V(8); PG8_WAIT_L(0); PG8_BAR; if (act0) { PG8_MMA(0, 0, At, B0); PG8_MMA(0, 1, At, B1); } PG8_BAR; PG8_SCHED;
            PG8_LDA(At, 1, 1); PG8_STAGE(PG8_SB(1, 0), b3, voffB); PG8_STAGE(PG8_SB(1, 1), b3 + hstepB, voffB); PG8_STAGE(PG8_SA(1, 0), a3, s0);
            PG8_WAIT_V(8); PG8_WAIT_L(0); PG8_BAR; if (act1) { PG8_MMA(1, 0, At, B0); PG8_MMA(1, 1, At, B1); } PG8_BAR; PG8_SCHED;
        }
        if (wr == 0) PG8_BAR;
        { Unit2 eu = cur; asm volatile("" : "+s"(eu.pm), "+s"(eu.pn), "+s"(eu.e), "+s"(eu.cnt), "+s"(eu.jt));
          E(acc, eu, wr, wc, fr, fq);
          }
        if (!has_next) break;
#pragma unroll
        for (int a = 0; a < 2; ++a)
#pragma unroll
            for (int b = 0; b < 2; ++b)
#pragma unroll
                for (int m = 0; m < 4; ++m)
#pragma unroll
                    for (int n = 0; n < 2; ++n) acc[a][b][m][n] = (f32x4){0.f, 0.f, 0.f, 0.f};
        cur = nxt; cA = nA; cB = nB; ++ui;
#pragma unroll
        for (int i = 0; i < 2; ++i) { cv0[i] = nv0[i]; cv1[i] = nv1[i]; }
        if (wr == 1) PG8_BAR;
    }
    PG8_WAIT_V(0);
    PG8_BAR;
#undef PG8_AOFFS
#undef PG8_SA
#undef PG8_SB
#undef PG8_STAGE
#undef PG8_LDA
#undef PG8_LDB
#undef PG8_MMA
#undef PG8_WAIT_V
#undef PG8_WAIT_L
#undef PG8_BAR
#undef PG8_SCHED
}

struct DenseSched {
    StaticOrder so; const bf16_t* Bt; int ldb;
    __device__ __forceinline__ bool next(int i, Unit2& u) const { Unit t; if (!so.next(i, t)) return false; u.pm = t.pm; u.pn = t.pn; u.e = 0; u.cnt = 256; u.jt = 0; return true; }
    __device__ __forceinline__ int arow(const Unit2& u, int r) const { return u.pm * BM + r; }
    __device__ __forceinline__ size_t aoff(const Unit2&) const { return 0; }
    __device__ __forceinline__ const char* bptr(const Unit2& u) const { return (const char*)(Bt + (size_t)u.pn * BM * ldb); }
};
struct EpiPlainBf16 {
    static constexpr bool PERM = true, AFTER_DRAIN = false;
    bf16_t* O; int ldc;
    __device__ __forceinline__ void operator()(const f32x4 (&acc)[2][2][4][2], const Unit2& u, int wr, int wc, int fr, int fq) const {
        const int row0 = u.pm * BM + wr * 64 + fr, col0 = u.pn * BM + wc * 32 + 8 * fq;
#pragma unroll
        for (int ai = 0; ai < 2; ++ai)
#pragma unroll
            for (int m = 0; m < 4; ++m) { bf16_t* rowp = O + (size_t)(row0 + ai * HALF + m * 16) * ldc + col0;
#pragma unroll
                for (int bj = 0; bj < 2; ++bj) { const f32x4 v0 = acc[ai][bj][m][0], v1 = acc[ai][bj][m][1];
                    u32x4 w; w.x = cvt_pk_bf16(v0[0], v0[1]); w.y = cvt_pk_bf16(v0[2], v0[3]); w.z = cvt_pk_bf16(v1[0], v1[1]); w.w = cvt_pk_bf16(v1[2], v1[3]);
                    *(u32x4*)(rowp + bj * HALF) = w; } }
    }
};
}
namespace nv {
constexpr int D = 1024, B = 8, S = 4096, T = B * S;
constexpr int FH = 8, FD = 64, GH = 4, GK = 64, GV = 128, RANK = 16;
constexpr int INW = 3096;
constexpr int O_FQ = 0, O_FK = 512, O_FV = 1024, O_FF = 1536, O_GQ = 1544, O_GK = 1800, O_GV = 2056, O_GA = 2568, O_GR = 2584;
constexpr int NE = 256, NG = 8, TOPK = 8, ED = 256;
constexpr float LN_EPS = 1e-5f;
constexpr float ALPHA = 1.189207115002721f;
constexpr int PADR = 64;
constexpr int APAD = T * TOPK + NE * PADR;

__device__ __forceinline__ float logsigmoidf(float x) { return fminf(x, 0.f) - log1pf(expf(-fabsf(x))); }
__device__ __forceinline__ float siluf(float x) { return x / (1.f + expf(-x)); }


__device__ __forceinline__ void ln_row(const float* in1, float a, const float* in2, const float* __restrict__ g, const float* __restrict__ b, float* out, int r, int tid, float* sh) {
    float4 v = ((const float4*)(in1 + (size_t)r * D))[tid];
    v.x *= a; v.y *= a; v.z *= a; v.w *= a;
    if (in2) { const float4 w = ((const float4*)(in2 + (size_t)r * D))[tid]; v.x += w.x; v.y += w.y; v.z += w.z; v.w += w.w; }
    float s = v.x + v.y + v.z + v.w;
    for (int o = 32; o > 0; o >>= 1) s += __shfl_xor(s, o);
    __syncthreads();
    if ((tid & 63) == 0) sh[tid >> 6] = s;
    __syncthreads();
    const float mean = (sh[0] + sh[1] + sh[2] + sh[3]) * (1.f / D);
    v.x -= mean; v.y -= mean; v.z -= mean; v.w -= mean;
    float q = v.x * v.x + v.y * v.y + v.z * v.z + v.w * v.w;
    for (int o = 32; o > 0; o >>= 1) q += __shfl_xor(q, o);
    if ((tid & 63) == 0) sh[4 + (tid >> 6)] = q;
    __syncthreads();
    const float rstd = rsqrtf((sh[4] + sh[5] + sh[6] + sh[7]) * (1.f / D) + LN_EPS);
    const float4 gg = ((const float4*)g)[tid], bb = ((const float4*)b)[tid];
    float4 o4; o4.x = v.x * rstd * gg.x + bb.x; o4.y = v.y * rstd * gg.y + bb.y; o4.z = v.z * rstd * gg.z + bb.z; o4.w = v.w * rstd * gg.w + bb.w;
    ((float4*)(out + (size_t)r * D))[tid] = o4;
}

__device__ __forceinline__ void gemm_tile(const float* A, const float* Bm, float* C, int N, int K, int lda, int ldb, int ldc, int tile_x, int tile_y, int tid, float* sh) {
    float (*As)[68] = (float (*)[68])sh;
    float (*Bs)[68] = (float (*)[68])(sh + 16 * 68);
    const int tx = tid & 15, ty = tid >> 4;
    const int row0 = tile_y * 64, col0 = tile_x * 64;
    float acc[4][4] = {};
    const int ar = tid >> 2, ak = (tid & 3) * 4;
    const int bk = tid >> 4, bc = (tid & 15) * 4;
    const bool bok = (col0 + bc) < N;
    for (int k0 = 0; k0 < K; k0 += 16) {
        const float4 av = *(const float4*)(A + (size_t)(row0 + ar) * lda + k0 + ak);
        float4 bv = make_float4(0.f, 0.f, 0.f, 0.f);
        if (bok) bv = *(const float4*)(Bm + (size_t)(k0 + bk) * ldb + col0 + bc);
        __syncthreads();
        As[ak + 0][ar] = av.x; As[ak + 1][ar] = av.y; As[ak + 2][ar] = av.z; As[ak + 3][ar] = av.w;
        *(float4*)&Bs[bk][bc] = bv;
        __syncthreads();
#pragma unroll
        for (int k = 0; k < 16; ++k) {
            const float4 a4 = *(const float4*)&As[k][ty * 4];
            const float4 b4 = *(const float4*)&Bs[k][tx * 4];
            const float aa[4] = {a4.x, a4.y, a4.z, a4.w}, bb[4] = {b4.x, b4.y, b4.z, b4.w};
#pragma unroll
            for (int i = 0; i < 4; ++i)
#pragma unroll
                for (int j = 0; j < 4; ++j) acc[i][j] += aa[i] * bb[j];
        }
    }
    if (col0 + tx * 4 < N) {
#pragma unroll
        for (int i = 0; i < 4; ++i)
            *(float4*)(C + (size_t)(row0 + ty * 4 + i) * ldc + col0 + tx * 4) = make_float4(acc[i][0], acc[i][1], acc[i][2], acc[i][3]);
    }
}
__device__ __forceinline__ void gemm_phase(const float* A, const float* Bm, float* C, int M, int N, int K, int lda, int ldb, int ldc, int half, int tid, float* sh) {
    const int ntx = (N + 63) / 64, nty = M / 64, ntile = ntx * nty, G2 = gridDim.x * 2;
    for (int t0 = blockIdx.x * 2; t0 < ntile; t0 += G2) {
        int tl = t0 + half; if (tl >= ntile) tl = ntile - 1;
        gemm_tile(A, Bm, C, N, K, lda, ldb, ldc, tl % ntx, tl / ntx, tid, sh);
    }
}

__device__ __forceinline__ void fox_prep(const float* proj, const float* __restrict__ bf, float* cbuf, int bh, int lane) {
    const int b = bh / FH, h = bh % FH;
    const float bias = bf[h];
    float s = 0.f;
    for (int i = 0; i < 64; ++i) { const int t = lane * 64 + i; s += logsigmoidf(proj[(size_t)(b * S + t) * INW + O_FF + h] + bias); }
    float inc = s;
    for (int o = 1; o < 64; o <<= 1) { const float n = __shfl_up(inc, o); if (lane >= o) inc += n; }
    float run = inc - s;
    for (int i = 0; i < 64; ++i) { const int t = lane * 64 + i; run += logsigmoidf(proj[(size_t)(b * S + t) * INW + O_FF + h] + bias); cbuf[(size_t)bh * S + t] = run; }
}

__device__ __forceinline__ void fox_attn(const float* proj, const float* cbuf, float* y, int blk, int lane) {
    const int qb = blk % (S / 64), bh = blk / (S / 64), b = bh / FH, h = bh % FH;
    const int t = qb * 64 + lane;
    const float* qp = proj + (size_t)(b * S + t) * INW + O_FQ + h * FD;
    float q[64], o[64];
#pragma unroll
    for (int d = 0; d < 64; ++d) { q[d] = qp[d] * 0.125f; o[d] = 0.f; }
    const float ct = cbuf[(size_t)bh * S + t];
    float m = -INFINITY, l = 0.f;
    const int smax = qb * 64 + 63;
    for (int s = 0; s <= smax; ++s) {
        const float* kp = proj + (size_t)(b * S + s) * INW + O_FK + h * FD;
        const float* vp = proj + (size_t)(b * S + s) * INW + O_FV + h * FD;
        float dot = 0.f;
#pragma unroll
        for (int d = 0; d < 64; ++d) dot += q[d] * kp[d];
        const float x = dot + (ct - cbuf[(size_t)bh * S + s]);
        if (s <= t) {
            if (x > m) { const float al = expf(m - x); l *= al;
#pragma unroll
                for (int d = 0; d < 64; ++d) o[d] *= al;
                m = x; }
            const float p = expf(x - m); l += p;
#pragma unroll
            for (int d = 0; d < 64; ++d) o[d] += p * vp[d];
        }
    }
    const float il = 1.f / l;
    float* yp = y + (size_t)(b * S + t) * D + h * FD;
#pragma unroll
    for (int d = 0; d < 64; ++d) yp[d] = o[d] * il;
}

__device__ __forceinline__ void gla_prep(const float* proj, const float* __restrict__ wgu, const float* __restrict__ bg, float* abuf, int t, int j) {
    const float* ga = proj + (size_t)t * INW + O_GA;
    float s = bg[j];
#pragma unroll
    for (int r = 0; r < RANK; ++r) s += ga[r] * wgu[r * 256 + j];
    abuf[(size_t)t * 256 + j] = expf(logsigmoidf(s) * (1.f / 16.f));
}

__device__ __forceinline__ void gla_rec(const float* proj, const float* abuf, float* glao, int bh, int e) {
    const int b = bh / GH, h = bh % GH;
    float st[64];
#pragma unroll
    for (int d = 0; d < 64; ++d) st[d] = 0.f;
    for (int s = 0; s < S; ++s) {
        const size_t t = (size_t)b * S + s;
        const float* qp = proj + t * INW + O_GQ + h * GK;
        const float* kp = proj + t * INW + O_GK + h * GK;
        const float* ap = abuf + t * 256 + h * GK;
        const float v = proj[t * INW + O_GV + h * GV + e];
        float o = 0.f;
#pragma unroll
        for (int d = 0; d < 64; ++d) { st[d] = ap[d] * st[d] + kp[d] * v; o += qp[d] * st[d]; }
        glao[t * 512 + h * GV + e] = o * 0.125f;
    }
}

__device__ __forceinline__ void gla_post(const float* glao, const float* proj, const float* __restrict__ g, float* y, int w, int lane) {
    const int t = w >> 2, h = w & 3;
    const float o0 = glao[(size_t)t * 512 + h * GV + lane], o1 = glao[(size_t)t * 512 + h * GV + 64 + lane];
    float ss = o0 * o0 + o1 * o1;
    for (int o = 32; o > 0; o >>= 1) ss += __shfl_xor(ss, o);
    const float r = rsqrtf(ss * (1.f / GV) + LN_EPS);
    const float g0 = proj[(size_t)t * INW + O_GR + h * GV + lane], g1 = proj[(size_t)t * INW + O_GR + h * GV + 64 + lane];
    y[(size_t)t * D + 512 + h * GV + lane] = o0 * r * g[lane] * siluf(g0);
    y[(size_t)t * D + 512 + h * GV + 64 + lane] = o1 * r * g[64 + lane] * siluf(g1);
}

__device__ __forceinline__ void route_token(const float* logits, const float* __restrict__ rbias, int* top_e, float* top_w, int* top_pos, int* counts, int t, int lane) {
    const float4 lg = ((const float4*)(logits + (size_t)t * NE))[lane];
    const float4 rb = ((const float4*)rbias)[lane];
    float sc[4] = {1.f / (1.f + expf(-lg.x)), 1.f / (1.f + expf(-lg.y)), 1.f / (1.f + expf(-lg.z)), 1.f / (1.f + expf(-lg.w))};
    float bv[4] = {sc[0] + rb.x, sc[1] + rb.y, sc[2] + rb.z, sc[3] + rb.w};
    float m1 = fmaxf(bv[0], bv[1]), m2 = fminf(bv[0], bv[1]);
    { const float a = fmaxf(bv[2], bv[3]), c = fminf(bv[2], bv[3]); const float n1 = fmaxf(m1, a); m2 = fmaxf(fminf(m1, a), fmaxf(m2, c)); m1 = n1; }
    for (int o = 1; o < 8; o <<= 1) { const float p1 = __shfl_xor(m1, o), p2 = __shfl_xor(m2, o); const float n1 = fmaxf(m1, p1); m2 = fmaxf(fminf(m1, p1), fmaxf(m2, p2)); m1 = n1; }
    const float gs = m1 + m2;
    const int myg = lane >> 3;
    int rank = 0;
#pragma unroll
    for (int g2 = 0; g2 < NG; ++g2) { const float og = __shfl(gs, g2 * 8); if (og > gs || (og == gs && g2 < myg)) ++rank; }
    const bool sel = rank < 4;
    float mv[4];
#pragma unroll
    for (int i = 0; i < 4; ++i) mv[i] = sel ? bv[i] : -INFINITY;
    int we[TOPK]; float ws[TOPK]; float wsum = 0.f;
#pragma unroll
    for (int k = 0; k < TOPK; ++k) {
        float bvv = mv[0]; int bi = 0;
#pragma unroll
        for (int i = 1; i < 4; ++i) if (mv[i] > bvv) { bvv = mv[i]; bi = i; }
        int gi = lane * 4 + bi;
        for (int o = 32; o > 0; o >>= 1) { const float ov = __shfl_xor(bvv, o); const int oi = __shfl_xor(gi, o); if (ov > bvv || (ov == bvv && oi < gi)) { bvv = ov; gi = oi; } }
        const int ol = gi >> 2, oi = gi & 3;
        const float s_own = (oi == 0) ? sc[0] : (oi == 1) ? sc[1] : (oi == 2) ? sc[2] : sc[3];
        const float sw = __shfl(s_own, ol);
        if (lane == ol) { if (oi == 0) mv[0] = -INFINITY; else if (oi == 1) mv[1] = -INFINITY; else if (oi == 2) mv[2] = -INFINITY; else mv[3] = -INFINITY; }
        we[k] = gi; ws[k] = sw; wsum += sw;
    }
    if (lane == 0) {
        const float inv = 2.5f / wsum;
#pragma unroll
        for (int k = 0; k < TOPK; ++k) {
            top_e[t * TOPK + k] = we[k]; top_w[t * TOPK + k] = ws[k] * inv;
            top_pos[t * TOPK + k] = atomicAdd(&counts[we[k]], 1);
        }
    }
}

__device__ __forceinline__ void moe_offsets(const int* counts, int* off, int* blk_exp, int* nblk, int lane) {
    int pc[4], st[4]; int tot = 0;
#pragma unroll
    for (int i = 0; i < 4; ++i) { pc[i] = (counts[lane * 4 + i] + PADR - 1) / PADR * PADR; st[i] = tot; tot += pc[i]; }
    int inc = tot;
    for (int o = 1; o < 64; o <<= 1) { const int n = __shfl_up(inc, o); if (lane >= o) inc += n; }
    const int base = inc - tot;
#pragma unroll
    for (int i = 0; i < 4; ++i) { const int start = base + st[i]; off[lane * 4 + i] = start; for (int k = start / PADR; k < (start + pc[i]) / PADR; ++k) blk_exp[k] = lane * 4 + i; }
    if (lane == 63) nblk[0] = inc / PADR;
}

__device__ __forceinline__ void moe_scatter(const int* top_e, const float* top_w, const int* top_pos, const int* off, int* row_tok, float* row_gate, int* slot_of, int a) {
    const int slot = off[top_e[a]] + top_pos[a];
    row_tok[slot] = a / TOPK; row_gate[slot] = top_w[a]; slot_of[a] = slot;
}

__device__ __forceinline__ void moe_hidden(const float* h1, const float* __restrict__ wg, const float* __restrict__ wu, const int* row_tok, const float* row_gate, const int* blk_exp, const int* nblk,
                                           float* hidden, int g16, int j, float* sh) {
    const bool active = g16 * 16 < nblk[0] * PADR;
    float (*xs)[D] = (float (*)[D])sh;
    __syncthreads();
    if (active) for (int r = 0; r < 16; ++r) { const int tok = row_tok[g16 * 16 + r]; ((float4*)xs[r])[j] = ((const float4*)(h1 + (size_t)tok * D))[j]; }
    __syncthreads();
    if (!active) return;
    const int e = blk_exp[(g16 * 16) / PADR];
    float ag[16], au[16];
#pragma unroll
    for (int r = 0; r < 16; ++r) { ag[r] = 0.f; au[r] = 0.f; }
    const float* wgp = wg + (size_t)e * D * ED + j; const float* wup = wu + (size_t)e * D * ED + j;
    for (int d = 0; d < D; d += 4) {
        const float g0 = wgp[(size_t)(d + 0) * ED], g1 = wgp[(size_t)(d + 1) * ED], g2 = wgp[(size_t)(d + 2) * ED], g3 = wgp[(size_t)(d + 3) * ED];
        const float u0 = wup[(size_t)(d + 0) * ED], u1 = wup[(size_t)(d + 1) * ED], u2 = wup[(size_t)(d + 2) * ED], u3 = wup[(size_t)(d + 3) * ED];
#pragma unroll
        for (int r = 0; r < 16; ++r) { const float4 x = *(const float4*)&xs[r][d];
            ag[r] += x.x * g0 + x.y * g1 + x.z * g2 + x.w * g3; au[r] += x.x * u0 + x.y * u1 + x.z * u2 + x.w * u3; }
    }
#pragma unroll
    for (int r = 0; r < 16; ++r) hidden[(size_t)(g16 * 16 + r) * ED + j] = row_gate[g16 * 16 + r] * siluf(ag[r]) * au[r];
}

__device__ __forceinline__ void moe_down(const float* hidden, const float* __restrict__ wd, const int* top_e, const int* slot_of, float* ffn, int t, int i, float* sh) {
    float4 acc = ((float4*)(ffn + (size_t)t * D))[i];
    for (int k = 0; k < TOPK; ++k) {
        const int e = top_e[t * TOPK + k], slot = slot_of[t * TOPK + k];
        __syncthreads();
        sh[i] = hidden[(size_t)slot * ED + i];
        __syncthreads();
        const float4* wp = (const float4*)(wd + (size_t)e * ED * D) + i;
        for (int j = 0; j < ED; ++j) { const float4 w = wp[(size_t)j * (D / 4)]; const float hv = sh[j]; acc.x += hv * w.x; acc.y += hv * w.y; acc.z += hv * w.z; acc.w += hv * w.w; }
    }
    ((float4*)(ffn + (size_t)t * D))[i] = acc;
}
}
#include <hip/hip_bf16.h>
#include <cmath>
namespace attn_body {
using bf16=__hip_bfloat16;
using bf16x8=__attribute__((ext_vector_type(8)))short;
using s16x4=__attribute__((ext_vector_type(4)))short;
using f32x16=__attribute__((ext_vector_type(16)))float;
using u32x4=__attribute__((ext_vector_type(4)))unsigned;
constexpr int BATCH=8,NHEAD=8,SEQ=4096,D=64,DM=3072,OPITCH=1024;
constexpr int NW=8,QBLK=32,QB=QBLK*NW,KVBLK=64,NQB=SEQ/QB;
constexpr int ATTN_PITCH=DM, ATTN_UNIT_ROWS=QB;
__device__ __forceinline__ int crow(int r,int hi){return (r&3)+8*(r>>2)+4*hi;}
#define SBAR() __builtin_amdgcn_sched_barrier(0)
__device__ __forceinline__ void cmask(f32x16&p0,f32x16&p1,int jb,int qrel,int hi){
  const float NEG=-INFINITY; int kb=64*jb+4*hi;
  #pragma unroll
  for(int r=0;r<16;++r){int kv=kb+(r&3)+8*(r>>2); if(kv>qrel)p0[r]=NEG; if(kv+32>qrel)p1[r]=NEG;}
}

constexpr int NSLOT=3, SLOTB=8192;
constexpr int LDS_K=0, LDS_V=NSLOT*SLOTB, LDS_WS=2*NSLOT*SLOTB, LDS_OST=LDS_WS+NW*64*4, LDS_KB=LDS_OST+NW*4096, LDS_BYTES=LDS_KB+(SEQ+2)*8;
constexpr float C2=0.125f*1.4426950408889634f;
__device__ __forceinline__ void glds16(const void*gsrc,unsigned lds_dst){unsigned keep;
  asm volatile("s_mov_b32 %0, m0\n\ts_mov_b32 m0, %2\n\ts_nop 0\n\tglobal_load_lds_dwordx4 %1, off\n\ts_mov_b32 m0, %0":"=&s"(keep):"v"(gsrc),"s"(lds_dst):"memory");}
__device__ __forceinline__ float max3f(float a,float b,float c){float r;asm("v_max3_f32 %0, %1, %2, %3":"=v"(r):"v"(a),"v"(b),"v"(c));return r;}
__device__ __forceinline__ float max2f(float a,float b){float r;asm("v_max_f32_e32 %0, %1, %2":"=v"(r):"v"(a),"v"(b));return r;}
__device__ __forceinline__ float fadd_s(float a,float b){float r;asm("v_add_f32_e32 %0, %1, %2":"=v"(r):"v"(a),"v"(b));return r;}
__device__ __forceinline__ float fsub_s(float a,float b){float r;asm("v_sub_f32_e32 %0, %1, %2":"=v"(r):"v"(a),"v"(b));return r;}
typedef float f32x2_t __attribute__((ext_vector_type(2))); typedef float f32x4_t __attribute__((ext_vector_type(4))); typedef __bf16 bf16x2_t __attribute__((ext_vector_type(2)));
__device__ __forceinline__ unsigned cvtpk_s(float lo,float hi){f32x2_t v={lo,hi};bf16x2_t b=__builtin_convertvector(v,bf16x2_t);return __builtin_bit_cast(unsigned,b);}
#define WAIT_BAR(N) asm volatile("s_waitcnt vmcnt(" #N ") lgkmcnt(0)\n\ts_barrier":::"memory")

__device__ __forceinline__ void split3(float b,unsigned&h,unsigned&m,unsigned&l){
  h=cvtpk_s(b,0.f)&0xffffu; const float r1=b-__uint_as_float(h<<16);
  m=cvtpk_s(r1,0.f)&0xffffu; const float r2=r1-__uint_as_float(m<<16);
  l=cvtpk_s(r2,0.f)&0xffffu; }
__device__ __forceinline__ bf16x8 kbias_frag(float b,int hi){unsigned h,m,l;split3(b,h,m,l);u32x4 w;w.x=h|(m<<16);w.y=l|0x3F800000u;w.z=0x3F803F80u;w.w=0u;if(hi){w.x=0u;w.y=0u;w.z=0u;}return __builtin_bit_cast(bf16x8,w);}
__device__ __forceinline__ bf16x8 qref_frag(float x,int hi){unsigned h,m,l;split3(x,h,m,l);u32x4 w;w.x=0x3F803F80u;w.y=0x3F80u|(h<<16);w.z=m|(l<<16);w.w=0u;if(hi){w.x=0u;w.y=0u;w.z=0u;}return __builtin_bit_cast(bf16x8,w);}
typedef unsigned u32x2_t __attribute__((ext_vector_type(2)));
__device__ __forceinline__ bf16x8 mkfrag(u32x2_t e,unsigned zc){u32x4 w;w.x=e.x;w.y=e.y;w.z=zc;w.w=0u;return __builtin_bit_cast(bf16x8,w);}
__device__ __forceinline__ void fox_bias_table(int b,int h,const float*LF,char*shm){
  int tid_=threadIdx.x; asm volatile("":"+v"(tid_)); const int tid=tid_,lane=tid&63,wid=__builtin_amdgcn_readfirstlane(tid>>6);
  const float*lf=LF+((long)b*NHEAD+h)*SEQ; float*wt=(float*)(shm+LDS_WS); u32x2_t*KB8=(u32x2_t*)(shm+LDS_KB);
  f32x4_t va=*(const f32x4_t*)(lf+8*tid),vb=*(const f32x4_t*)(lf+8*tid+4);
  va[1]+=va[0];va[2]+=va[1];va[3]+=va[2];vb[0]+=va[3];vb[1]+=vb[0];vb[2]+=vb[1];vb[3]+=vb[2];
  const float tot=vb[3]; float inc=tot;
  #pragma unroll
  for(int o_=1;o_<64;o_<<=1){const float nn=__shfl_up(inc,o_);if(lane>=o_)inc+=nn;}
  __syncthreads();
  if(lane==63)wt[wid*64]=inc;
  __syncthreads();
  float base=inc-tot;
  #pragma unroll
  for(int w_=0;w_<NW;++w_){const float x_=wt[w_*64]; if(w_<wid)base+=x_;}
  const float cv[8]={va[0]+base,va[1]+base,va[2]+base,va[3]+base,vb[0]+base,vb[1]+base,vb[2]+base,vb[3]+base};
  #pragma unroll
  for(int j=0;j<8;++j){unsigned hh,mm,ll;split3(-cv[j],hh,mm,ll);KB8[8*tid+j]=(u32x2_t){hh|(mm<<16),ll|0x3F800000u};}
  if(tid==0){KB8[SEQ]=(u32x2_t){0u,0u};KB8[SEQ+1]=(u32x2_t){0u,0u};}
  __syncthreads();
}
__device__ __forceinline__ void qkt(f32x16&p0,f32x16&p1,const char*Kslot,const bf16x8*qr,bf16x8 kb0,bf16x8 kb1,bf16x8 qx,int r32,int hi){
  const f32x16 negm=f32x16{};
  const char*kb=Kslot+hi*1024+r32*16;
  #pragma unroll
  for(int d0=0;d0<4;++d0){
    const bf16x8 b0=*reinterpret_cast<const bf16x8*>(kb+d0*2048);
    const bf16x8 b1=*reinterpret_cast<const bf16x8*>(kb+d0*2048+512);
    if(d0==0){p0=__builtin_amdgcn_mfma_f32_32x32x16_bf16(b0,qr[0],negm,0,0,0);p1=__builtin_amdgcn_mfma_f32_32x32x16_bf16(b1,qr[0],negm,0,0,0);}
    else{p0=__builtin_amdgcn_mfma_f32_32x32x16_bf16(b0,qr[d0],p0,0,0,0);p1=__builtin_amdgcn_mfma_f32_32x32x16_bf16(b1,qr[d0],p1,0,0,0);}}
  p0=__builtin_amdgcn_mfma_f32_32x32x16_bf16(kb0,qx,p0,0,0,0);p1=__builtin_amdgcn_mfma_f32_32x32x16_bf16(kb1,qx,p1,0,0,0);
}
typedef __attribute__((address_space(3))) const char* lds_cptr;
typedef short v4i16_t __attribute__((ext_vector_type(4)));
__device__ __forceinline__ void kload8(bf16x8*kf,lds_cptr kp){
  kf[0]=*(const __attribute__((address_space(3))) bf16x8*)(kp);      kf[1]=*(const __attribute__((address_space(3))) bf16x8*)(kp+512);
  kf[2]=*(const __attribute__((address_space(3))) bf16x8*)(kp+2048); kf[3]=*(const __attribute__((address_space(3))) bf16x8*)(kp+2560);
  kf[4]=*(const __attribute__((address_space(3))) bf16x8*)(kp+4096); kf[5]=*(const __attribute__((address_space(3))) bf16x8*)(kp+4608);
  kf[6]=*(const __attribute__((address_space(3))) bf16x8*)(kp+6144); kf[7]=*(const __attribute__((address_space(3))) bf16x8*)(kp+6656);
}
__device__ __forceinline__ void kload2(bf16x8*kf,lds_cptr kp,int j){ kf[2*j]=*(const __attribute__((address_space(3))) bf16x8*)(kp+j*2048); kf[2*j+1]=*(const __attribute__((address_space(3))) bf16x8*)(kp+j*2048+512); }
__device__ __forceinline__ s16x4 vtr(lds_cptr p){ return __builtin_bit_cast(s16x4,__builtin_amdgcn_ds_read_tr16_b64_v4i16((__attribute__((address_space(3))) v4i16_t*)p)); }
__device__ __forceinline__ float rowmax(const f32x16&p0,const f32x16&p1){
  float a=max3f(p0[0],p0[1],p1[0]),b=max3f(p0[2],p0[3],p1[1]);a=max3f(a,p1[2],p1[3]);
  #pragma unroll
  for(int r=4;r<16;r+=4){a=max3f(a,p0[r],p0[r+1]);b=max3f(b,p0[r+2],p0[r+3]);a=max3f(a,p1[r],p1[r+1]);b=max3f(b,p1[r+2],p1[r+3]);}
  const float m=max2f(a,b);
  auto rr=__builtin_amdgcn_permlane32_swap(__float_as_uint(m),__float_as_uint(m),false,false);
  return max2f(__uint_as_float(rr[0]),__uint_as_float(rr[1]));
}
__device__ __forceinline__ void pv(f32x16*o,int vb,bf16x8 pa0,bf16x8 pa1,bf16x8 pa2,bf16x8 pa3){
  #pragma unroll
  for(int d0=0;d0<2;++d0){s16x4 lo[4],hi[4];
    #pragma unroll
    for(int ks=0;ks<4;++ks){
      asm volatile("ds_read_b64_tr_b16 %0,%1 offset:%c2":"=&v"(lo[ks]):"v"(vb),"i"(d0*4096+ks*1024):"memory");
      asm volatile("ds_read_b64_tr_b16 %0,%1 offset:%c2":"=&v"(hi[ks]):"v"(vb),"i"(d0*4096+ks*1024+512):"memory");}
    asm volatile("s_waitcnt lgkmcnt(0)":::"memory");SBAR();
    #define PK(k) (bf16x8){lo[k][0],lo[k][1],lo[k][2],lo[k][3],hi[k][0],hi[k][1],hi[k][2],hi[k][3]}
    o[d0]=__builtin_amdgcn_mfma_f32_32x32x16_bf16(pa0,PK(0),o[d0],0,0,0);
    o[d0]=__builtin_amdgcn_mfma_f32_32x32x16_bf16(pa1,PK(1),o[d0],0,0,0);
    o[d0]=__builtin_amdgcn_mfma_f32_32x32x16_bf16(pa2,PK(2),o[d0],0,0,0);
    o[d0]=__builtin_amdgcn_mfma_f32_32x32x16_bf16(pa3,PK(3),o[d0],0,0,0);
    #undef PK
  }
}

#ifndef ATTN_STORE16
#define ATTN_STORE16(p,v) (*(u32x4*)(p)=(v))
#endif
template<int THRL> __device__ __forceinline__ void attn_unit(int b,int h,int qb,const bf16*Q,const bf16* K,const bf16* V,bf16*O,const float*LF,const unsigned*NRM,char*shm){
  int tid_=threadIdx.x; asm volatile("":"+v"(tid_));
  const int tid=tid_,lane=tid&63,r32=lane&31,hi=lane>>5; const int wid=__builtin_amdgcn_readfirstlane(tid>>6);
  const long rowbase=(long)b*SEQ; const int q0=qb*QB;
  const char*KBt0=shm+LDS_KB;
  int t0;
  { const int NT0=(q0+QB)/KVBLK; const unsigned*nr=NRM+(b*NHEAD+h)*4;
    const float qn2=__uint_as_float(nr[0])+__uint_as_float(nr[1]), kn2=__uint_as_float(nr[2])+__uint_as_float(nr[3]);
    const float thr=-(50.f+2.04f*sqrtf(qn2*kn2));
    const u32x2_t eq0=*(const u32x2_t*)(KBt0+(unsigned)q0*8u); const float bq0=__uint_as_float(eq0.x<<16)+__uint_as_float(eq0.x&0xffff0000u)+__uint_as_float(eq0.y<<16);
    bool ok=(2*lane<=NT0-4);
    if(ok&&lane>0){ const u32x2_t el=*(const u32x2_t*)(KBt0+(unsigned)(128*lane-1)*8u); const float bl=__uint_as_float(el.x<<16)+__uint_as_float(el.x&0xffff0000u)+__uint_as_float(el.y<<16); ok=(bl-bq0<thr); }
    const unsigned long long mk=__ballot(ok); const unsigned long long low=~mk; const int cnt=(low==0ull)?64:__builtin_ctzll(low);
    t0=__builtin_amdgcn_readfirstlane(2*(cnt-1)); }
  const char*KBt=KBt0+(hi?0:t0*512); const unsigned kb_o0=hi?(unsigned)SEQ*8u:(unsigned)r32*8u, kb_o1=hi?(unsigned)SEQ*8u:(unsigned)(r32+32)*8u, kb_str=hi?0u:512u, zc=hi?0u:0x3F803F80u;
  const bf16*Qw=Q+(rowbase+q0+wid*QBLK)*DM+h*D;
  const bf16*Kh=K+(rowbase+(long)t0*KVBLK)*DM+h*D,*Vh=V+(rowbase+(long)t0*KVBLK)*DM+h*D;
  const unsigned lds0=(unsigned)(uintptr_t)shm;
  float*wsf=(float*)(shm+LDS_WS)+wid*64;
  const bf16*ksrc=Kh+(long)lane*DM+wid*8;
  const bf16*vsrc=Vh+(long)(16*(wid&3)+(lane>>2))*DM+(wid>>2)*32+(lane&3)*8;
  const unsigned kdst=lds0+LDS_K+wid*1024, vdst=lds0+LDS_V+wid*1024;
  #define DMA_K(t,slot) glds16(ksrc+(long)(t)*KVBLK*DM,(unsigned)__builtin_amdgcn_readfirstlane(kdst+(slot)))
  #define DMA_V(t,slot) glds16(vsrc+(long)(t)*KVBLK*DM,(unsigned)__builtin_amdgcn_readfirstlane(vdst+(slot)))
  const int vb0=(int)(lds0+LDS_V)+((lane>>4)&1)*32+(lane&3)*8+(4*hi+((lane&15)>>2))*64;
  const char*Kbase=shm+LDS_K; bf16x8 kf[8];
  const lds_cptr shm3=(lds_cptr)shm; const lds_cptr kp0=shm3+LDS_K+hi*1024+r32*16; const lds_cptr vp0=shm3+LDS_V+((lane>>4)&1)*32+(lane&3)*8+(4*hi+((lane&15)>>2))*64;
  const int NT=(q0+QB)/KVBLK-t0;
  DMA_K(0,0);DMA_V(0,0);DMA_K(1,SLOTB);
  bf16x8 qr[4];
  #pragma unroll
  for(int d0=0;d0<4;++d0)qr[d0]=*reinterpret_cast<const bf16x8*>(&Qw[(long)r32*DM+d0*16+hi*8]);
  float mhat; { const u32x2_t eq=*(const u32x2_t*)(KBt0+(unsigned)(q0+wid*QBLK+r32)*8u); mhat=__uint_as_float(eq.x<<16)+__uint_as_float(eq.x&0xffff0000u)+__uint_as_float(eq.y<<16); }
  float l_reg=0.f;f32x16 o[2];o[0]=f32x16{};o[1]=f32x16{};const f32x16 negm=f32x16{};
  bf16x8 qx=qref_frag(-mhat,hi);
  const int qrel=wid*QBLK+r32;
  #define CMASK(P0,P1,t) do{int jb_=(t)-(NT-4); if(jb_>=0)cmask(P0,P1,jb_,qrel,hi);}while(0)
  bool resc=false;
  #define START(P0,P1) do{ const float rm=rowmax(P0,P1); resc=false; \
    { const float dl=__builtin_fmaxf(rm,0.f); mhat=fadd_s(mhat,dl); \
      _Pragma("unroll") for(int r=0;r<16;++r){P0[r]=fsub_s(P0[r],dl);P1[r]=fsub_s(P1[r],dl);} \
      qx=qref_frag(-mhat,hi); } \
    _Pragma("unroll") for(int r=0;r<16;++r)P0[r]=__builtin_amdgcn_exp2f(P0[r]); }while(0)
  #define RESC() do{ if(resc){ asm volatile("s_waitcnt lgkmcnt(0)":::"memory"); \
      _Pragma("unroll") for(int d_=0;d_<2;++d_) _Pragma("unroll") for(int r=0;r<16;++r)o[d_][r]*=wsf[crow(r,hi)]; } }while(0)
  f32x16 pA0,pA1,pB0,pB1;
  int sl_prev=0,sl_cur=0,sl_next=SLOTB;
  #define ROT() do{sl_prev=sl_cur;sl_cur=sl_next;sl_next=(sl_next==(NSLOT-1)*SLOTB)?0:sl_next+SLOTB;}while(0)
  DMA_K(2,2*SLOTB);
  WAIT_BAR(3);
  qkt(pA0,pA1,Kbase,qr,mkfrag(*(const u32x2_t*)(KBt+kb_o0),zc),mkfrag(*(const u32x2_t*)(KBt+kb_o1),zc),qx,r32,hi);asm volatile("s_nop 15\n\ts_nop 7":"+v"(pA0),"+v"(pA1));CMASK(pA0,pA1,0);
  START(pA0,pA1);
  _Pragma("unroll") for(int r=0;r<16;++r)pA1[r]=__builtin_amdgcn_exp2f(pA1[r]);
  WAIT_BAR(0);
  DMA_K(3,0);DMA_V(1,SLOTB);
  ROT();
  kload8(kf,kp0+sl_cur);
  WAIT_BAR(2);
  s16x4 vlo[8],vhi[8]; u32x4 pw0,pw1,pw2,pw3;
  #define PKW(P,B) cvtpk_s(P[B],P[B+1])
  #define PAF(k) __builtin_bit_cast(bf16x8,pw##k)
  #define VFR(i) (bf16x8){vlo[i][0],vlo[i][1],vlo[i][2],vlo[i][3],vhi[i][0],vhi[i][1],vhi[i][2],vhi[i][3]}
  #define PIN(x) asm volatile("":"+v"(x))
  #define MX3(a,b,c) __builtin_fmaxf(__builtin_fmaxf((a),(b)),(c))
  #define GAPA(MF,A0,A1,A2,A3,W0,W1,PW) do{ MF; sacc+=A0; sacc+=A1; sacc+=A2; sacc+=A3; PIN(sacc); W0; W1; PIN(PW); SBAR(); }while(0)
  #define EX(v) __builtin_amdgcn_exp2f(v)
  #define GAPB(MF,X,B) do{ MF; X[B]=EX(X[B]); X[B+1]=EX(X[B+1]); X[B+2]=EX(X[B+2]); X[B+3]=EX(X[B+3]); PIN(X); SBAR(); }while(0)
  #define VRD(i) do{ vlo[i]=vtr(vp_+(((i)>>2)*4096+((i)&3)*1024)); vhi[i]=vtr(vp_+(((i)>>2)*4096+((i)&3)*1024+512)); }while(0)
  #define KRD(G,j) do{ if(G){ kload2(kf,kp0+sl_next,j); SBAR(); } }while(0)
  #define STEP(C0,C1,P0,P1,t,GK,GV,GL) do{ SBAR(); \
    const lds_cptr vp_=vp0+sl_prev; const u32x2_t e0_=*(const u32x2_t*)(KBt+kb_o0+(unsigned)(t)*kb_str),e1_=*(const u32x2_t*)(KBt+kb_o1+(unsigned)(t)*kb_str); \
    VRD(0); SBAR(); float sacc=(P0[0]+P0[1]); \
    GAPA(C0=__builtin_amdgcn_mfma_f32_32x32x16_bf16(kf[0],qr[0],negm,0,0,0), P0[2],P0[3],P0[4],P0[5],     pw0[0]=PKW(P0,0), pw0[1]=PKW(P0,2), pw0); \
    VRD(4); SBAR(); GAPA(C1=__builtin_amdgcn_mfma_f32_32x32x16_bf16(kf[1],qr[0],negm,0,0,0), P0[6],P0[7],P0[8],P0[9],     pw0[2]=PKW(P0,4), pw0[3]=PKW(P0,6), pw0); \
    VRD(1); SBAR(); GAPA(C0=__builtin_amdgcn_mfma_f32_32x32x16_bf16(kf[2],qr[1],C0,0,0,0),   P0[10],P0[11],P0[12],P0[13], pw1[0]=PKW(P0,8), pw1[1]=PKW(P0,10), pw1); \
    VRD(5); SBAR(); GAPA(C1=__builtin_amdgcn_mfma_f32_32x32x16_bf16(kf[3],qr[1],C1,0,0,0),   P0[14],P0[15],P1[0],P1[1],   pw1[2]=PKW(P0,12),pw1[3]=PKW(P0,14), pw1); \
    VRD(2); SBAR(); GAPA(C0=__builtin_amdgcn_mfma_f32_32x32x16_bf16(kf[4],qr[2],C0,0,0,0),   P1[2],P1[3],P1[4],P1[5],     pw2[0]=PKW(P1,0), pw2[1]=PKW(P1,2), pw2); \
    VRD(6); SBAR(); GAPA(C1=__builtin_amdgcn_mfma_f32_32x32x16_bf16(kf[5],qr[2],C1,0,0,0),   P1[6],P1[7],P1[8],P1[9],     pw2[2]=PKW(P1,4), pw2[3]=PKW(P1,6), pw2); \
    VRD(3); SBAR(); GAPA(C0=__builtin_amdgcn_mfma_f32_32x32x16_bf16(kf[6],qr[3],C0,0,0,0),   P1[10],P1[11],P1[12],P1[13], pw3[0]=PKW(P1,8), pw3[1]=PKW(P1,10), pw3); \
    VRD(7); SBAR(); GAPA(C1=__builtin_amdgcn_mfma_f32_32x32x16_bf16(kf[7],qr[3],C1,0,0,0),   P1[14],P1[15],0.f,0.f,       pw3[2]=PKW(P1,12),pw3[3]=PKW(P1,14), pw3); \
    { const bf16x8 kb0_=mkfrag(e0_,zc),kb1_=mkfrag(e1_,zc); C0=__builtin_amdgcn_mfma_f32_32x32x16_bf16(kb0_,qx,C0,0,0,0); C1=__builtin_amdgcn_mfma_f32_32x32x16_bf16(kb1_,qx,C1,0,0,0); } SBAR(); \
    l_reg+=sacc; \
    if(GK){DMA_K((t)+3,sl_cur);} if(GV){DMA_V((t)+1,sl_next);} \
    CMASK(C0,C1,t); \
    { float a=MX3(C0[0],C0[1],C1[0]),b=MX3(C0[2],C0[3],C1[1]); a=MX3(a,C1[2],C1[3]); \
      _Pragma("unroll") for(int r=4;r<16;r+=4){a=MX3(a,C0[r],C0[r+1]);b=MX3(b,C0[r+2],C0[r+3]);a=MX3(a,C1[r],C1[r+1]);b=MX3(b,C1[r+2],C1[r+3]);} \
      float rm=__builtin_fmaxf(a,b); { auto rr=__builtin_amdgcn_permlane32_swap(__float_as_uint(rm),__float_as_uint(rm),false,false); rm=__builtin_fmaxf(__uint_as_float(rr[0]),__uint_as_float(rr[1])); } \
      resc=false; \
      if(__builtin_expect(__any(rm>(float)THRL),0)){ const float dl=__builtin_fmaxf(rm,0.f); mhat+=dl; \
        _Pragma("unroll") for(int r=0;r<16;++r){C0[r]-=dl;C1[r]-=dl;} \
        qx=qref_frag(-mhat,hi); \
        const float f=__builtin_amdgcn_exp2f(-dl); l_reg*=f; if(hi==0)wsf[r32]=f; resc=true; } } \
    SBAR(); \
    GAPB(o[0]=__builtin_amdgcn_mfma_f32_32x32x16_bf16(PAF(0),VFR(0),o[0],0,0,0), C0,0); \
    GAPB(o[1]=__builtin_amdgcn_mfma_f32_32x32x16_bf16(PAF(0),VFR(4),o[1],0,0,0), C0,4); \
    KRD(GL,0); GAPB(o[0]=__builtin_amdgcn_mfma_f32_32x32x16_bf16(PAF(1),VFR(1),o[0],0,0,0), C0,8); \
    KRD(GL,1); GAPB(o[1]=__builtin_amdgcn_mfma_f32_32x32x16_bf16(PAF(1),VFR(5),o[1],0,0,0), C0,12); \
    KRD(GL,2); GAPB(o[0]=__builtin_amdgcn_mfma_f32_32x32x16_bf16(PAF(2),VFR(2),o[0],0,0,0), C1,0); \
    KRD(GL,3); GAPB(o[1]=__builtin_amdgcn_mfma_f32_32x32x16_bf16(PAF(2),VFR(6),o[1],0,0,0), C1,4); \
    GAPB(o[0]=__builtin_amdgcn_mfma_f32_32x32x16_bf16(PAF(3),VFR(3),o[0],0,0,0), C1,8); \
    GAPB(o[1]=__builtin_amdgcn_mfma_f32_32x32x16_bf16(PAF(3),VFR(7),o[1],0,0,0), C1,12); \
    }while(0)
  int t=1;
  #undef CMASK
  #define CMASK(P0,P1,t) do{}while(0)
  for(;t+5<NT;t+=2){
    STEP(pB0,pB1,pA0,pA1,t,true,true,true);     WAIT_BAR(2); RESC(); ROT();
    STEP(pA0,pA1,pB0,pB1,t+1,true,true,true);   WAIT_BAR(2); RESC(); ROT();
  }
  #undef CMASK
  #define CMASK(P0,P1,t) do{int jb_=(t)-(NT-4); if(jb_>=0)cmask(P0,P1,jb_,qrel,hi);}while(0)
  #define ENDW(tt) do{ if((tt)+3<NT){WAIT_BAR(2);} else if((tt)+2<NT){WAIT_BAR(1);} else {WAIT_BAR(0);} }while(0)
  for(;t+1<NT;t+=2){
    STEP(pB0,pB1,pA0,pA1,t,(t+3<NT),(t+1<NT),(t+1<NT));       ENDW(t);   RESC(); ROT();
    STEP(pA0,pA1,pB0,pB1,t+1,(t+4<NT),(t+2<NT),(t+2<NT));     ENDW(t+1); RESC(); ROT();
  }
  STEP(pB0,pB1,pA0,pA1,NT-1,false,false,false); RESC();
  { float sacc=pB0[0]+pB0[1]; _Pragma("unroll") for(int r=2;r<16;++r)sacc+=pB0[r]; _Pragma("unroll") for(int r=0;r<16;++r)sacc+=pB1[r]; l_reg+=sacc;
    pw0=(u32x4){PKW(pB0,0),PKW(pB0,2),PKW(pB0,4),PKW(pB0,6)};pw1=(u32x4){PKW(pB0,8),PKW(pB0,10),PKW(pB0,12),PKW(pB0,14)};pw2=(u32x4){PKW(pB1,0),PKW(pB1,2),PKW(pB1,4),PKW(pB1,6)};pw3=(u32x4){PKW(pB1,8),PKW(pB1,10),PKW(pB1,12),PKW(pB1,14)};
    SBAR(); pv(o,vb0+sl_cur,PAF(0),PAF(1),PAF(2),PAF(3)); }
  #undef PKW
  #undef PAF
  #undef VFR
  #undef PIN
  #undef MX3
  #undef GAPA
  #undef GAPB
  #undef EX
  #undef VRD
  #undef KRD
  #undef STEP
  #undef ENDW
  {auto rr=__builtin_amdgcn_permlane32_swap(__float_as_uint(l_reg),__float_as_uint(l_reg),false,false);l_reg=__uint_as_float(rr[0])+__uint_as_float(rr[1]);}
  if(hi==0)wsf[32+r32]=l_reg;asm volatile("s_waitcnt lgkmcnt(0)":::"memory");
  float rli[16];
  #pragma unroll
  for(int r=0;r<16;++r)rli[r]=__builtin_amdgcn_rcpf(wsf[32+crow(r,hi)]);
  bf16*Ow=O+(rowbase+q0+wid*QBLK)*OPITCH+h*D;
  { bf16*stg=(bf16*)(shm+LDS_OST)+wid*2048;
    #pragma unroll
    for(int r=0;r<16;++r){const int orow=crow(r,hi);
      #pragma unroll
      for(int d0=0;d0<2;++d0)stg[orow*64+d0*32+r32]=__float2bfloat16(o[d0][r]*rli[r]);}
    asm volatile("s_waitcnt lgkmcnt(0)":::"memory");
    #pragma unroll
    for(int i=0;i<4;++i){const int row=i*8+(lane>>3),ch=lane&7; const u32x4 v=*(const u32x4*)(stg+row*64+ch*8); ATTN_STORE16(Ow+(long)row*OPITCH+ch*8,v);} }
  asm volatile("s_waitcnt lgkmcnt(0)\n\ts_barrier":::"memory");
  #undef DMA_K
  #undef DMA_V
  #undef CMASK
  #undef START
  #undef RESC
  #undef ROT
}
constexpr int ATTN_LDS_BYTES=LDS_BYTES;
struct AttnTensors { const bf16* Q; const bf16* K; const bf16* V; bf16* O; const float* LF; const unsigned* NRM; };
struct AttnUnit { int bh; int qb; };
struct StaticOrder {
  int vcu,grid;
  __device__ __forceinline__ explicit StaticOrder(int grid_,int block):vcu((grid_%8==0)?(block%8)*(grid_/8)+block/8:block),grid(grid_){}
  __device__ __forceinline__ bool next(int i,AttnUnit&u)const{
    if(grid==256){ if(i>=4)return false; const int s=vcu&3; u.bh=vcu>>2; u.qb=(i==0)?s:(i==1)?7-s:(i==2)?8+s:15-s; return true; }
    const int L=i*grid+vcu; if(L>=BATCH*NHEAD*NQB)return false; u.bh=L/NQB; u.qb=L%NQB; return true; }
  __device__ __forceinline__ void a_ready(const AttnUnit&)const{}
  __device__ __forceinline__ void done(const AttnUnit&)const{}
};
template<class Sched,int THRL=8> __device__ __forceinline__ void attn_phase(char*lds,const AttnTensors&T,const Sched&S){
  AttnUnit u; int cur_bh=-1;
  for(int i=0;S.next(i,u);++i){ S.a_ready(u); if(u.bh!=cur_bh){ fox_bias_table(u.bh/NHEAD,u.bh%NHEAD,T.LF,lds); cur_bh=u.bh; }
    attn_unit<THRL>(u.bh/NHEAD,u.bh%NHEAD,u.qb,T.Q,T.K,T.V,T.O,T.LF,T.NRM,lds); S.done(u); }
}
template<int THRL=8> __device__ __forceinline__ void attn_phase_dyn(char*lds,const AttnTensors&T,unsigned*qhead,volatile int*slot){
  int cur_bh=-1; const int NU=BATCH*NHEAD*NQB;
  if(threadIdx.x==0) slot[0]=(int)__hip_atomic_fetch_add(qhead,1u,__ATOMIC_RELAXED,__HIP_MEMORY_SCOPE_AGENT);
  __syncthreads();
  int idx=__builtin_amdgcn_readfirstlane(slot[0]);
  while(idx<NU){
    __syncthreads();
    if(threadIdx.x==0) slot[0]=(int)__hip_atomic_fetch_add(qhead,1u,__ATOMIC_RELAXED,__HIP_MEMORY_SCOPE_AGENT);
    const int qb=NQB-1-idx/(BATCH*NHEAD), bh=idx%(BATCH*NHEAD);
    if(bh!=cur_bh){ fox_bias_table(bh/NHEAD,bh%NHEAD,T.LF,lds); cur_bh=bh; }
    attn_unit<THRL>(bh/NHEAD,bh%NHEAD,qb,T.Q,T.K,T.V,T.O,T.LF,T.NRM,lds);
    __syncthreads();
    idx=__builtin_amdgcn_readfirstlane(slot[0]);
  }
}
#undef SBAR
#undef WAIT_BAR
}
namespace fx {
using namespace nv;
typedef unsigned short bf16;
typedef unsigned v4u __attribute__((ext_vector_type(4)));
typedef float f32x4 __attribute__((ext_vector_type(4)));
constexpr float C2 = 0.125f * 1.4426950408889634f;
constexpr int NIN = 3328;
constexpr int QKVP = 3072;
constexpr int P_FQ = 0, P_FK = 512, P_FV = 1024, P_GQ = 1536, P_GK = 1792, P_GV = 2048, P_GR = 2560;
__device__ __forceinline__ int inproj_src(int d) {
    if (d < 1536) return d;
    if (d < 1792) return O_GQ + (d - 1536);
    if (d < 2048) return O_GK + (d - 1792);
    if (d < 2560) return O_GV + (d - 2048);
    if (d < 3072) return O_GR + (d - 2560);
    if (d < 3080) return O_FF + (d - 3072);
    if (d < 3096) return O_GA + (d - 3080);
    return -1;
}
__device__ __forceinline__ unsigned f2bf(float f) { unsigned u = __builtin_bit_cast(unsigned, f); return (u + 0x7fffu + ((u >> 16) & 1u)) >> 16; }
__device__ __forceinline__ unsigned pk2(float lo, float hi) { return f2bf(lo) | (f2bf(hi) << 16); }
__device__ __forceinline__ float bf2f(unsigned short h) { return __builtin_bit_cast(float, (unsigned)h << 16); }
__device__ __forceinline__ float wave_sum(float v) {
#pragma unroll
    for (int o = 1; o < 64; o <<= 1) v += __shfl_xor(v, o);
    return v;
}
#define FX_LDS_WAIT() asm volatile("s_waitcnt lgkmcnt(0)" ::: "memory")

template <class Map> __device__ __forceinline__ void transpose_item(const float* __restrict__ W, int K, int N, bf16* WT, LAS float* scr, int kb, int nb, int lane, Map srcmap) {
    const int k0 = 64 * kb, n0 = 32 * nb;
    const int src = srcmap(n0 + (lane & 31));
#pragma unroll 8
    for (int i = 0; i < 32; ++i) { const int kk = 2 * i + (lane >> 5); scr[kk * 33 + (lane & 31)] = (src >= 0) ? W[(size_t)(k0 + kk) * N + src] : 0.f; }
    FX_LDS_WAIT(); asm volatile("" ::: "memory");
    const int c = lane & 7;
#pragma unroll
    for (int j = 0; j < 4; ++j) { const int n = (lane >> 3) + 8 * j; const LAS float* s = scr + (8 * c) * 33 + n;
        v4u o; o.x = pk2(s[0 * 33], s[1 * 33]); o.y = pk2(s[2 * 33], s[3 * 33]); o.z = pk2(s[4 * 33], s[5 * 33]); o.w = pk2(s[6 * 33], s[7 * 33]);
        *(GAS v4u*)(WT + (size_t)(n0 + n) * K + k0 + 8 * c) = o; }
    FX_LDS_WAIT(); asm volatile("" ::: "memory");
}

__device__ __forceinline__ void ln_row_bf16(const float* xrow, const float* __restrict__ g, const float* __restrict__ b, bf16* orow, float* frow, float* st, int lane) {
    const GAS f32x4* xr = (const GAS f32x4*)xrow + lane;
    f32x4 v[4]; float s = 0.f;
#pragma unroll
    for (int j = 0; j < 4; ++j) { v[j] = xr[64 * j]; s += (v[j].x + v[j].y) + (v[j].z + v[j].w); }
    const float mean = wave_sum(s) * (1.f / D); float s2 = 0.f;
#pragma unroll
    for (int j = 0; j < 4; ++j) { v[j] = v[j] - mean; s2 += (v[j].x * v[j].x + v[j].y * v[j].y) + (v[j].z * v[j].z + v[j].w * v[j].w); }
    const float rstd = 1.f / sqrtf(wave_sum(s2) * (1.f / D) + LN_EPS);
    if (st && lane == 0) { st[0] = mean; st[1] = rstd; }
    GAS unsigned long long* o8 = (GAS unsigned long long*)orow + lane;
#pragma unroll
    for (int j = 0; j < 4; ++j) {
        const f32x4 gg = ((const f32x4*)g)[lane + 64 * j], bb = ((const f32x4*)b)[lane + 64 * j];
        const f32x4 o = v[j] * rstd * gg + bb;
        o8[64 * j] = (unsigned long long)pk2(o.x, o.y) | ((unsigned long long)pk2(o.z, o.w) << 32);
        if (frow) ((GAS f32x4*)frow)[lane + 64 * j] = o;
    }
}

struct CvItem { const float* W; bf16* WT; int N, K, k0, n0, s0; };
__device__ __forceinline__ void cv_load(const CvItem& it, f32x4 (&v)[8], int lane) {
    const float* p = it.W + (size_t)(it.k0 + (lane >> 3)) * it.N + it.s0 + 4 * (lane & 7);
#pragma unroll
    for (int i = 0; i < 8; ++i) v[i] = __builtin_nontemporal_load((const f32x4*)(p + (size_t)(8 * i) * it.N));
}
__device__ __forceinline__ void cv_finish(const CvItem& it, const f32x4 (&v)[8], LAS float* scr, int lane) {
    const int rr = lane >> 3, cq = lane & 7;
#pragma unroll
    for (int i = 0; i < 8; ++i) { LAS float* d = scr + (8 * i + rr) * 33 + 4 * cq; d[0] = v[i][0]; d[1] = v[i][1]; d[2] = v[i][2]; d[3] = v[i][3]; }
    FX_LDS_WAIT(); asm volatile("" ::: "memory");
    const int c = lane & 7;
#pragma unroll
    for (int j = 0; j < 4; ++j) { const int n = (lane >> 3) + 8 * j; const LAS float* s = scr + (8 * c) * 33 + n;
        v4u o; o.x = pk2(s[0 * 33], s[1 * 33]); o.y = pk2(s[2 * 33], s[3 * 33]); o.z = pk2(s[4 * 33], s[5 * 33]); o.w = pk2(s[6 * 33], s[7 * 33]);
        __builtin_nontemporal_store(o, (GAS v4u*)(it.WT + (size_t)(it.n0 + n) * it.K + it.k0 + 8 * c)); }
    FX_LDS_WAIT(); asm volatile("" ::: "memory");
}

template <int NR> __device__ __forceinline__ void ln_rows_bf16(const float* xrows, const float* __restrict__ g, const float* __restrict__ b, bf16* orows, int lane) {
    f32x4 v[NR][4];
#pragma unroll
    for (int r = 0; r < NR; ++r)
#pragma unroll
        for (int j = 0; j < 4; ++j) v[r][j] = ((const GAS f32x4*)(xrows + (size_t)r * D))[lane + 64 * j];
    f32x4 gg[4], bb[4];
#pragma unroll
    for (int j = 0; j < 4; ++j) { gg[j] = ((const f32x4*)g)[lane + 64 * j]; bb[j] = ((const f32x4*)b)[lane + 64 * j]; }
#pragma unroll
    for (int r = 0; r < NR; ++r) {
        float s = 0.f;
#pragma unroll
        for (int j = 0; j < 4; ++j) s += (v[r][j].x + v[r][j].y) + (v[r][j].z + v[r][j].w);
        const float mean = wave_sum(s) * (1.f / D); float s2 = 0.f;
#pragma unroll
        for (int j = 0; j < 4; ++j) { v[r][j] = v[r][j] - mean; s2 += (v[r][j].x * v[r][j].x + v[r][j].y * v[r][j].y) + (v[r][j].z * v[r][j].z + v[r][j].w * v[r][j].w); }
        const float rstd = 1.f / sqrtf(wave_sum(s2) * (1.f / D) + LN_EPS);
        GAS unsigned long long* o8 = (GAS unsigned long long*)(orows + (size_t)r * D) + lane;
#pragma unroll
        for (int j = 0; j < 4; ++j) { const f32x4 o = v[r][j] * rstd * gg[j] + bb[j];
            o8[64 * j] = (unsigned long long)pk2(o.x, o.y) | ((unsigned long long)pk2(o.z, o.w) << 32); }
    }
}

template <int NR> __device__ __forceinline__ void ln1_rows_bf16(const float* xrows, const float* st, const float* __restrict__ gi, const float* __restrict__ bi, const bf16* mixrows,
                                                               const float* __restrict__ g1, const float* __restrict__ b1, bf16* orows, float alpha, int lane) {
    f32x4 v[NR][4]; unsigned long long mx[NR][4]; float mean0[NR], rstd0[NR];
#pragma unroll
    for (int r = 0; r < NR; ++r) { mean0[r] = st[2 * r]; rstd0[r] = st[2 * r + 1];
#pragma unroll
        for (int j = 0; j < 4; ++j) { v[r][j] = ((const GAS f32x4*)(xrows + (size_t)r * D))[lane + 64 * j]; mx[r][j] = ((const GAS unsigned long long*)(mixrows + (size_t)r * D))[lane + 64 * j]; } }
    f32x4 gi4[4], bi4[4];
#pragma unroll
    for (int j = 0; j < 4; ++j) { gi4[j] = ((const f32x4*)gi)[lane + 64 * j] * alpha; bi4[j] = ((const f32x4*)bi)[lane + 64 * j] * alpha; }
#pragma unroll
    for (int r = 0; r < NR; ++r) {
        float s = 0.f;
#pragma unroll
        for (int j = 0; j < 4; ++j) { const unsigned lo = (unsigned)mx[r][j], hi = (unsigned)(mx[r][j] >> 32);
            f32x4 mv; mv.x = __builtin_bit_cast(float, lo << 16); mv.y = __builtin_bit_cast(float, lo & 0xffff0000u); mv.z = __builtin_bit_cast(float, hi << 16); mv.w = __builtin_bit_cast(float, hi & 0xffff0000u);
            v[r][j] = ((v[r][j] - mean0[r]) * rstd0[r]) * gi4[j] + bi4[j] + mv;
            s += (v[r][j].x + v[r][j].y) + (v[r][j].z + v[r][j].w); }
        const float mean = wave_sum(s) * (1.f / D); float s2 = 0.f;
#pragma unroll
        for (int j = 0; j < 4; ++j) { v[r][j] = v[r][j] - mean; s2 += (v[r][j].x * v[r][j].x + v[r][j].y * v[r][j].y) + (v[r][j].z * v[r][j].z + v[r][j].w * v[r][j].w); }
        const float rstd = 1.f / sqrtf(wave_sum(s2) * (1.f / D) + LN_EPS);
        GAS unsigned long long* o8 = (GAS unsigned long long*)(orows + (size_t)r * D) + lane;
#pragma unroll
        for (int j = 0; j < 4; ++j) { const f32x4 gg = ((const f32x4*)g1)[lane + 64 * j], bb = ((const f32x4*)b1)[lane + 64 * j]; const f32x4 o = v[r][j] * rstd * gg + bb;
            o8[64 * j] = (unsigned long long)pk2(o.x, o.y) | ((unsigned long long)pk2(o.z, o.w) << 32); }
    }
}
}

namespace pg8 {
struct EpiInProj {
    static constexpr bool PERM = true, AFTER_DRAIN = false;
    bf16_t* QKV; float* FG; float* LF; const float* bfg; unsigned* NRM;
    __device__ __forceinline__ void operator()(const f32x4 (&acc)[2][2][4][2], const Unit& u, int wr, int wc, int fr, int fq) const {
        const int row0 = u.pm * BM + wr * 64 + fr;
        if (u.pn < 12) {
            const float sc = (u.pn < 2) ? fx::C2 : 1.f;
            const int col0 = u.pn * BM + wc * 32 + 8 * fq;
            float nmax[2] = {0.f, 0.f};
#pragma unroll
            for (int ai = 0; ai < 2; ++ai)
#pragma unroll
                for (int m = 0; m < 4; ++m) { bf16_t* rowp = QKV + (size_t)(row0 + ai * HALF + m * 16) * fx::QKVP + col0;
#pragma unroll
                    for (int bj = 0; bj < 2; ++bj) { const f32x4 v0 = acc[ai][bj][m][0] * sc, v1 = acc[ai][bj][m][1] * sc;
                        u32x4 w; w.x = cvt_pk_bf16(v0[0], v0[1]); w.y = cvt_pk_bf16(v0[2], v0[3]); w.z = cvt_pk_bf16(v1[0], v1[1]); w.w = cvt_pk_bf16(v1[2], v1[3]);
                        *(u32x4*)(rowp + bj * HALF) = w;
                        if (u.pn < 4) { const f32x4 q0 = v0 * v0, q1 = v1 * v1; float s = (q0[0] + q0[1]) + (q0[2] + q0[3]) + (q1[0] + q1[1]) + (q1[2] + q1[3]);
                            s += __shfl_xor(s, 16); s += __shfl_xor(s, 32);
                            nmax[bj] = fmaxf(nmax[bj], s); } } }
            if (u.pn < 4) {
#pragma unroll
                for (int bj = 0; bj < 2; ++bj) { float s = nmax[bj];
#pragma unroll
                    for (int o = 1; o < 16; o <<= 1) s = fmaxf(s, __shfl_xor(s, o));
                    if (fr == 0 && fq == 0) { const int b = (u.pm * BM) >> 12, head = 4 * (u.pn & 1) + 2 * bj + (wc >> 1);
                        atomicMax(NRM + (b * 8 + head) * 4 + (u.pn >= 2 ? 2 : 0) + (wc & 1), __builtin_bit_cast(unsigned, s)); } }
            }
        } else if (wc == 0 && fq < 3) {
#pragma unroll
            for (int ai = 0; ai < 2; ++ai)
#pragma unroll
                for (int m = 0; m < 4; ++m) { const int row = row0 + ai * HALF + m * 16; float* p = FG + (size_t)row * 32 + 8 * fq;
                    *(f32x4*)p = acc[ai][0][m][0]; *(f32x4*)(p + 4) = acc[ai][0][m][1];
                    if (fq == 0) { const int b = row >> 12, s = row & 4095;
#pragma unroll
                        for (int n = 0; n < 2; ++n)
#pragma unroll
                            for (int i = 0; i < 4; ++i) { const int h = 4 * n + i; LF[(size_t)(b * 8 + h) * nv::S + s] = 1.4426950408889634f * nv::logsigmoidf(acc[ai][0][m][n][i] + bfg[h]); } } }
        }
    }
};
}
namespace gl {
using namespace nv;
typedef unsigned short bf16;
typedef short bf16x8 __attribute__((ext_vector_type(8)));
typedef float f32x4 __attribute__((ext_vector_type(4)));
typedef unsigned u32x4 __attribute__((ext_vector_type(4)));
typedef unsigned u32x2 __attribute__((ext_vector_type(2)));
constexpr int NCH = S / 64;
constexpr int NUNIT = B * GH * NCH;
constexpr int LS = 72;
constexpr int L_WGU = 0, L_BG = 4096, L_QP = 8192, L_KP = L_QP + 64 * LS * 2, L_KPT = L_KP + 64 * LS * 2, L_VT = L_KPT + 64 * LS * 2, L_PP = L_VT + 128 * LS * 2, L_WT = L_PP + 64 * LS * 2, L_END = L_WT + 2048;
static_assert(L_END <= 131072, "gla prep LDS");
constexpr int C_ST = 0, C_PART = 128 * LS * 2, C_END = C_PART + 2 * 8 * 64 * 4;
constexpr size_t QPG_B = 64 * 64 * 2, OI_B = 8 * 4 * 64 * 16, UU_B = OI_B, DEC_B = 256;

__device__ __forceinline__ unsigned pkbf(float lo, float hi) { typedef float f2 __attribute__((ext_vector_type(2))); typedef __bf16 b2 __attribute__((ext_vector_type(2))); f2 v = {lo, hi}; b2 r = __builtin_convertvector(v, b2); return __builtin_bit_cast(unsigned, r); }
__device__ __forceinline__ float bf2f(unsigned short h) { return __builtin_bit_cast(float, (unsigned)h << 16); }
__device__ __forceinline__ float bflo(unsigned w) { return __builtin_bit_cast(float, w << 16); }
__device__ __forceinline__ float bfhi(unsigned w) { return __builtin_bit_cast(float, w & 0xffff0000u); }
__device__ __forceinline__ float fast_logsig2(float x) { return -__builtin_amdgcn_logf(1.f + __builtin_amdgcn_exp2f(-1.4426950408889634f * x)); }

__device__ __forceinline__ void prep_unit(int unit, const bf16* QKV, const float* FG, const float* __restrict__ wgu, const float* __restrict__ bgate,
                                          unsigned char* QPG, unsigned char* OI, unsigned char* UU, float* DEC, unsigned char* lds, int& cur_h) {
    int tid_ = threadIdx.x; asm volatile("" : "+v"(tid_));
    const int tid = tid_, lane = tid & 63, wid = __builtin_amdgcn_readfirstlane(tid >> 6), l15 = lane & 15, g = lane >> 4;
    const int n = unit % NCH, bh = unit / NCH, h = bh % GH, b = bh / GH;
    const size_t row0 = (size_t)b * S + (size_t)n * 64;
    float* WGU = (float*)(lds + L_WGU); float* BG = (float*)(lds + L_BG); float* WT = (float*)(lds + L_WT);
    bf16* QP = (bf16*)(lds + L_QP); bf16* KP = (bf16*)(lds + L_KP); bf16* KPT = (bf16*)(lds + L_KPT); bf16* VT = (bf16*)(lds + L_VT); bf16* PP = (bf16*)(lds + L_PP);
    if (cur_h != h) { __syncthreads(); for (int i = tid; i < 16 * 64; i += 512) WGU[i] = wgu[(i >> 6) * 256 + h * 64 + (i & 63)]; if (tid < 64) BG[tid] = bgate[h * 64 + tid]; cur_h = h; __syncthreads(); }
    const int t = tid >> 3, oc = tid & 7, d0 = oc * 8;
    float la[8];
    { const float* gp = FG + (row0 + t) * 32 + 8;
      f32x4 ga4[4];
#pragma unroll
      for (int i = 0; i < 4; ++i) ga4[i] = *(const f32x4*)(gp + 4 * i);
#pragma unroll
      for (int j = 0; j < 8; ++j) la[j] = BG[d0 + j];
#pragma unroll
      for (int r = 0; r < 16; ++r) { const float gv = ga4[r >> 2][r & 3]; const f32x4 w0 = *(const f32x4*)(WGU + r * 64 + d0), w1 = *(const f32x4*)(WGU + r * 64 + d0 + 4);
#pragma unroll
          for (int j = 0; j < 4; ++j) { la[j] += gv * w0[j]; la[4 + j] += gv * w1[j]; } }
#pragma unroll
      for (int j = 0; j < 8; ++j) la[j] = fast_logsig2(la[j]) * (1.f / 16.f); }
    const u32x4 qv = *(const u32x4*)(QKV + (row0 + t) * fx::QKVP + fx::P_GQ + h * 64 + d0);
    const u32x4 kv = *(const u32x4*)(QKV + (row0 + t) * fx::QKVP + fx::P_GK + h * 64 + d0);
    const u32x4 vv0 = *(const u32x4*)(QKV + (row0 + t) * fx::QKVP + fx::P_GV + h * 128 + oc * 16);
    const u32x4 vv1 = *(const u32x4*)(QKV + (row0 + t) * fx::QKVP + fx::P_GV + h * 128 + oc * 16 + 8);
#pragma unroll
    for (int off = 8; off < 64; off <<= 1) {
#pragma unroll
        for (int j = 0; j < 8; ++j) { const float o = __shfl_up(la[j], off); if (lane >= off) la[j] += o; } }
    if (lane >= 56) {
#pragma unroll
        for (int j = 0; j < 8; ++j) WT[wid * 64 + d0 + j] = la[j]; }
    __syncthreads();
    float bl[8];
#pragma unroll
    for (int j = 0; j < 8; ++j) bl[j] = 0.f;
#pragma unroll
    for (int w = 0; w < 8; ++w) {
        const f32x4 a0 = *(const f32x4*)(WT + w * 64 + d0), a1 = *(const f32x4*)(WT + w * 64 + d0 + 4);
#pragma unroll
        for (int j = 0; j < 4; ++j) { bl[j] += a0[j]; bl[4 + j] += a1[j]; if (w < wid) { la[j] += a0[j]; la[4 + j] += a1[j]; } } }
    {
        const unsigned qw[4] = {qv.x, qv.y, qv.z, qv.w}, kw[4] = {kv.x, kv.y, kv.z, kv.w};
        float qf[8], kf[8];
#pragma unroll
        for (int i = 0; i < 4; ++i) { qf[2 * i] = bflo(qw[i]); qf[2 * i + 1] = bfhi(qw[i]); kf[2 * i] = bflo(kw[i]); kf[2 * i + 1] = bfhi(kw[i]); }
        float qp[8], kp[8], kpp[8];
#pragma unroll
        for (int j = 0; j < 8; ++j) { const float bb = la[j], bbl = bl[j];
            qp[j] = qf[j] * (0.125f * __builtin_amdgcn_exp2f(bb)); kp[j] = kf[j] * __builtin_amdgcn_exp2f(-bb); kpp[j] = kf[j] * __builtin_amdgcn_exp2f(bbl - bb); }
        u32x4 qo, ko; qo.x = pkbf(qp[0], qp[1]); qo.y = pkbf(qp[2], qp[3]); qo.z = pkbf(qp[4], qp[5]); qo.w = pkbf(qp[6], qp[7]);
        ko.x = pkbf(kp[0], kp[1]); ko.y = pkbf(kp[2], kp[3]); ko.z = pkbf(kp[4], kp[5]); ko.w = pkbf(kp[6], kp[7]);
        *(u32x4*)(QP + t * LS + d0) = qo; *(u32x4*)(KP + t * LS + d0) = ko;
        *(u32x4*)(QPG + (size_t)unit * QPG_B + (size_t)(t * 64 + d0) * 2) = qo;
#pragma unroll
        for (int j = 0; j < 8; ++j) KPT[(d0 + j) * LS + t] = (bf16)(pkbf(kpp[j], 0.f) & 0xffffu);
        const unsigned vw[8] = {vv0.x, vv0.y, vv0.z, vv0.w, vv1.x, vv1.y, vv1.z, vv1.w};
#pragma unroll
        for (int i = 0; i < 8; ++i) { VT[(oc * 16 + 2 * i) * LS + t] = (bf16)(vw[i] & 0xffffu); VT[(oc * 16 + 2 * i + 1) * LS + t] = (bf16)(vw[i] >> 16); }
        if (t == 0) {
#pragma unroll
            for (int j = 0; j < 8; ++j) DEC[(size_t)unit * 64 + d0 + j] = __builtin_amdgcn_exp2f(bl[j]); }
    }
    __syncthreads();
    { const int ti = wid >> 1;
#pragma unroll
      for (int q2 = 0; q2 < 2; ++q2) { const int sj = 2 * (wid & 1) + q2;
          f32x4 acc = {0.f, 0.f, 0.f, 0.f};
          if (sj <= ti) {
#pragma unroll
              for (int ks = 0; ks < 2; ++ks) { const bf16x8 a = *(const bf16x8*)(QP + (16 * ti + l15) * LS + 32 * ks + 8 * g), bb = *(const bf16x8*)(KP + (16 * sj + l15) * LS + 32 * ks + 8 * g);
                  acc = __builtin_amdgcn_mfma_f32_16x16x32_bf16(a, bb, acc, 0, 0, 0); }
              if (sj == ti) {
#pragma unroll
                  for (int r = 0; r < 4; ++r) if (l15 > 4 * g + r) acc[r] = 0.f; }
          }
#pragma unroll
          for (int r = 0; r < 4; ++r) PP[(16 * ti + 4 * g + r) * LS + 16 * sj + l15] = (bf16)(pkbf(acc[r], 0.f) & 0xffffu);
      } }
    __syncthreads();
    { bf16x8 vb[2];
#pragma unroll
      for (int ks = 0; ks < 2; ++ks) vb[ks] = *(const bf16x8*)(VT + (16 * wid + l15) * LS + 32 * ks + 8 * g);
#pragma unroll
      for (int m = 0; m < 4; ++m) { f32x4 acc = {0.f, 0.f, 0.f, 0.f};
#pragma unroll
          for (int ks = 0; ks < 2; ++ks) { const bf16x8 a = *(const bf16x8*)(PP + (16 * m + l15) * LS + 32 * ks + 8 * g); acc = __builtin_amdgcn_mfma_f32_16x16x32_bf16(a, vb[ks], acc, 0, 0, 0); }
          *(f32x4*)(OI + (size_t)unit * OI_B + (size_t)((wid * 4 + m) * 64 + lane) * 16) = acc; }
#pragma unroll
      for (int db = 0; db < 4; ++db) { f32x4 acc = {0.f, 0.f, 0.f, 0.f};
#pragma unroll
          for (int ks = 0; ks < 2; ++ks) { const bf16x8 a = *(const bf16x8*)(KPT + (16 * db + l15) * LS + 32 * ks + 8 * g); acc = __builtin_amdgcn_mfma_f32_16x16x32_bf16(a, vb[ks], acc, 0, 0, 0); }
          *(f32x4*)(UU + (size_t)unit * UU_B + (size_t)((wid * 4 + db) * 64 + lane) * 16) = acc; }
    }
}

constexpr int GS = 136;
constexpr int PO_GR = 0, PO_YT = 64 * GS * 2, PO_PART = 2 * 64 * GS * 2, PO_ST = PO_PART + 8 * 64 * 4, PO_END = PO_ST + 128 * LS * 2;
__device__ __forceinline__ void post_block(int u0, int NB, const bf16* QKV, const unsigned char* QPG, const unsigned char* OI, const unsigned char* UU, const float* DEC, const float* __restrict__ gnorm, bf16* Y, unsigned char* lds) {
    int tid_ = threadIdx.x; asm volatile("" : "+v"(tid_));
    const int tid = tid_, lane = tid & 63, wid = __builtin_amdgcn_readfirstlane(tid >> 6), l15 = lane & 15, g = lane >> 4;
    const int n0 = u0 % NCH, bh = u0 / NCH, h = bh % GH, b = bh / GH;
    bf16* GRs = (bf16*)(lds + PO_GR); bf16* YT = (bf16*)(lds + PO_YT); float* PART = (float*)(lds + PO_PART); bf16* ST = (bf16*)(lds + PO_ST);
    const int t = tid >> 3, oc = tid & 7, e = 16 * wid + l15;
    const float gn = gnorm[e];
    f32x4 Sa[4];
#pragma unroll
    for (int db = 0; db < 4; ++db) Sa[db] = (f32x4){0.f, 0.f, 0.f, 0.f};
    const size_t ub = (size_t)bh * NCH;
    for (int n = 0; n < n0; n += 4) {
        f32x4 Uf[4][4], dv[4][4];
#pragma unroll
        for (int j = 0; j < 4; ++j)
#pragma unroll
            for (int db = 0; db < 4; ++db) { Uf[j][db] = *(const f32x4*)(UU + (ub + n + j) * UU_B + (size_t)((wid * 4 + db) * 64 + lane) * 16); dv[j][db] = *(const f32x4*)(DEC + (ub + n + j) * 64 + 16 * db + 4 * g); }
#pragma unroll
        for (int j = 0; j < 4; ++j)
#pragma unroll
            for (int db = 0; db < 4; ++db) Sa[db] = dv[j][db] * Sa[db] + Uf[j][db];
    }
    for (int i = 0; i < NB; ++i) {
        const int unit = u0 + i; const size_t row0 = (size_t)b * S + (size_t)(n0 + i) * 64;
        const u32x4 g0 = *(const u32x4*)(QKV + (row0 + t) * fx::QKVP + fx::P_GR + h * 128 + oc * 16), g1 = *(const u32x4*)(QKV + (row0 + t) * fx::QKVP + fx::P_GR + h * 128 + oc * 16 + 8);
        f32x4 o[4], Uf[4], dv[4]; bf16x8 qa[4][2], sb[2];
#pragma unroll
        for (int m = 0; m < 4; ++m) { o[m] = *(const f32x4*)(OI + (size_t)unit * OI_B + (size_t)((wid * 4 + m) * 64 + lane) * 16);
            Uf[m] = *(const f32x4*)(UU + (size_t)unit * UU_B + (size_t)((wid * 4 + m) * 64 + lane) * 16); dv[m] = *(const f32x4*)(DEC + (size_t)unit * 64 + 16 * m + 4 * g);
#pragma unroll
            for (int ks = 0; ks < 2; ++ks) qa[m][ks] = *(const bf16x8*)(QPG + (size_t)unit * QPG_B + (size_t)((16 * m + l15) * 64 + 32 * ks + 8 * g) * 2); }
#pragma unroll
        for (int db = 0; db < 4; ++db) *(u32x2*)(ST + e * LS + 16 * db + 4 * g) = (u32x2){pkbf(Sa[db][0], Sa[db][1]), pkbf(Sa[db][2], Sa[db][3])};
#pragma unroll
        for (int ks = 0; ks < 2; ++ks) sb[ks] = *(const bf16x8*)(ST + e * LS + 32 * ks + 8 * g);
        *(u32x4*)(GRs + t * GS + oc * 16) = g0; *(u32x4*)(GRs + t * GS + oc * 16 + 8) = g1;
#pragma unroll
        for (int m = 0; m < 4; ++m)
#pragma unroll
            for (int ks = 0; ks < 2; ++ks) o[m] = __builtin_amdgcn_mfma_f32_16x16x32_bf16(qa[m][ks], sb[ks], o[m], 0, 0, 0);
#pragma unroll
        for (int m = 0; m < 4; ++m) { f32x4 q = o[m] * o[m];
#pragma unroll
            for (int off = 1; off < 16; off <<= 1) { q[0] += __shfl_xor(q[0], off); q[1] += __shfl_xor(q[1], off); q[2] += __shfl_xor(q[2], off); q[3] += __shfl_xor(q[3], off); }
            if (l15 == 0) *(f32x4*)(PART + wid * 64 + 16 * m + 4 * g) = q; }
#pragma unroll
        for (int db = 0; db < 4; ++db) Sa[db] = dv[db] * Sa[db] + Uf[db];
        __syncthreads();
#pragma unroll
        for (int m = 0; m < 4; ++m) { f32x4 tot = {0.f, 0.f, 0.f, 0.f};
#pragma unroll
            for (int w = 0; w < 8; ++w) tot += *(const f32x4*)(PART + w * 64 + 16 * m + 4 * g);
#pragma unroll
            for (int r = 0; r < 4; ++r) { const int tt = 16 * m + 4 * g + r; const float rs = rsqrtf(tot[r] * (1.f / GV) + LN_EPS); const float gr = bf2f(GRs[tt * GS + e]);
                const float v = o[m][r] * rs * gn * (gr * __builtin_amdgcn_rcpf(1.f + __builtin_amdgcn_exp2f(-1.4426950408889634f * gr)));
                YT[tt * GS + e] = (bf16)(pkbf(v, 0.f) & 0xffffu); } }
        __syncthreads();
        { const u32x4 y0 = *(const u32x4*)(YT + t * GS + oc * 16), y1 = *(const u32x4*)(YT + t * GS + oc * 16 + 8);
          *(u32x4*)(Y + (row0 + t) * D + 512 + h * GV + oc * 16) = y0; *(u32x4*)(Y + (row0 + t) * D + 512 + h * GV + oc * 16 + 8) = y1; }
        __syncthreads();
    }
}
}
namespace mo {
using namespace nv;
typedef unsigned short bf16;
typedef float f32x4 __attribute__((ext_vector_type(4)));
typedef unsigned u32x4 __attribute__((ext_vector_type(4)));
constexpr int CAP = 8192;
constexpr int NEX = NE + 1;
constexpr int YSH = T * TOPK;
constexpr int L_TB = 132096, L_YB = L_TB + 1040, L_CN = L_YB + 1040;
typedef LAS int* lint;


constexpr int I_EG = NEX * 256, I_ED = NEX * 128, I_EXP = I_EG + I_ED;
struct ExpW { const float* eg; const float* eu; const float* ed; const float* sg; const float* su; const float* sd; bf16* WegT; bf16* WedT; };
__device__ __forceinline__ void cv_decode(int r, const ExpW& X, fx::CvItem& I) {
    if (r < I_EG) { const int e = r >> 8, kb = (r >> 4) & 15, nb = r & 15, c = nb >> 3, sub = nb & 7;
        I.W = (e < NE) ? ((sub < 4 ? X.eg : X.eu) + (size_t)e * D * ED) : (sub < 4 ? X.sg : X.su); I.WT = X.WegT + (size_t)e * 512 * D; I.N = ED; I.K = D; I.k0 = 64 * kb; I.n0 = 32 * nb; I.s0 = 128 * c + 32 * (sub & 3); }
    else { r -= I_EG; const int e = r >> 7, kb = (r >> 5) & 3, nb = r & 31; I.W = (e < NE) ? (X.ed + (size_t)e * ED * D) : X.sd; I.WT = X.WedT + (size_t)e * D * ED; I.N = D; I.K = ED; I.k0 = 64 * kb; I.n0 = 32 * nb; I.s0 = 32 * nb; }
}
__device__ __forceinline__ void expert_conv(const ExpW& X, LAS float* scr, int it0, int step, int lane) {
    int it = it0; fx::CvItem cur, nx; fx::f32x4 v[8], w[8];
    if (it < I_EXP) { cv_decode(it, X, cur); fx::cv_load(cur, v, lane); }
    while (it < I_EXP) { const int itn = it + step; if (itn < I_EXP) { cv_decode(itn, X, nx); fx::cv_load(nx, w, lane); }
        fx::cv_finish(cur, v, scr, lane); cur = nx;
#pragma unroll
        for (int i = 0; i < 8; ++i) v[i] = w[i];
        it = itn; }
}

__device__ __forceinline__ void moe_tables(const int* counts, lint tb, lint yb, lint cn, int lane) {
    int c[4], nt[4]; int st = 0, sy = 0, pt[4], py[4];
#pragma unroll
    for (int i = 0; i < 4; ++i) { c[i] = counts[lane * 4 + i]; c[i] = c[i] > CAP ? CAP : c[i]; nt[i] = (c[i] + 255) >> 8; pt[i] = st; py[i] = sy; st += nt[i]; sy += c[i]; }
    int it = st, iy = sy;
    for (int o = 1; o < 64; o <<= 1) { const int a = __shfl_up(it, o), b = __shfl_up(iy, o); if (lane >= o) { it += a; iy += b; } }
    const int bt = it - st, by = iy - sy;
#pragma unroll
    for (int i = 0; i < 4; ++i) { tb[lane * 4 + i] = bt + pt[i]; yb[lane * 4 + i] = by + py[i]; cn[lane * 4 + i] = c[i]; }
    if (lane == 63) { tb[256] = it; tb[257] = it + T / 256; yb[256] = YSH; cn[256] = T; }
}

__device__ __forceinline__ void route_token2(const float* LG, const float* __restrict__ rbias, int* lcnt, int* TK, float* TW, int t0, int lane) {
    const int l32 = lane & 31, hb = lane & 32, t = t0 + (lane >> 5);
    const float4 la = ((const float4*)(LG + (size_t)t * NE))[2 * l32], lb = ((const float4*)(LG + (size_t)t * NE))[2 * l32 + 1];
    const float4 ra = ((const float4*)rbias)[2 * l32], rb = ((const float4*)rbias)[2 * l32 + 1];
    const float lg[8] = {la.x, la.y, la.z, la.w, lb.x, lb.y, lb.z, lb.w}, rbv[8] = {ra.x, ra.y, ra.z, ra.w, rb.x, rb.y, rb.z, rb.w};
    float sc[8], bv[8];
#pragma unroll
    for (int i = 0; i < 8; ++i) { sc[i] = 1.f / (1.f + expf(-lg[i])); bv[i] = sc[i] + rbv[i]; }
    float m1 = fmaxf(bv[0], bv[1]), m2 = fminf(bv[0], bv[1]);
#pragma unroll
    for (int i = 2; i < 8; ++i) { const float n1 = fmaxf(m1, bv[i]); m2 = fmaxf(fminf(m1, bv[i]), m2); m1 = n1; }
#pragma unroll
    for (int o = 1; o < 4; o <<= 1) { const float p1 = __shfl_xor(m1, o), p2 = __shfl_xor(m2, o); const float n1 = fmaxf(m1, p1); m2 = fmaxf(fminf(m1, p1), fmaxf(m2, p2)); m1 = n1; }
    const float gs = m1 + m2;
    const int myg = l32 >> 2;
    int rank = 0;
#pragma unroll
    for (int g2 = 0; g2 < NG; ++g2) { const float og = __shfl(gs, hb + g2 * 4); if (og > gs || (og == gs && g2 < myg)) ++rank; }
    const bool sel = rank < 4;
    float mv[8];
#pragma unroll
    for (int i = 0; i < 8; ++i) mv[i] = sel ? bv[i] : -INFINITY;
    int mye = 0; float myw = 0.f; float wsum = 0.f;
#pragma unroll
    for (int k = 0; k < TOPK; ++k) {
        float bvv = mv[0]; int bi = 0;
#pragma unroll
        for (int i = 1; i < 8; ++i) if (mv[i] > bvv) { bvv = mv[i]; bi = i; }
        int gi = l32 * 8 + bi;
#pragma unroll
        for (int o = 16; o > 0; o >>= 1) { const float ov = __shfl_xor(bvv, o); const int oi = __shfl_xor(gi, o); if (ov > bvv || (ov == bvv && oi < gi)) { bvv = ov; gi = oi; } }
        const int ol = gi >> 3, oi = gi & 7;
        float s_own = sc[0];
#pragma unroll
        for (int i = 1; i < 8; ++i) s_own = (oi == i) ? sc[i] : s_own;
        const float sw = __shfl(s_own, hb + ol);
        if (l32 == ol) {
#pragma unroll
            for (int i = 0; i < 8; ++i) if (oi == i) mv[i] = -INFINITY; }
        if (l32 == k) { mye = gi; myw = sw; } wsum += sw;
    }
    if (l32 < TOPK) { const int lp = atomicAdd(&lcnt[mye], 1); TK[t * TOPK + l32] = mye | (lp << 9); TW[t * TOPK + l32] = myw * (2.5f / wsum); }
}
__device__ __forceinline__ void route_finish2(const int* lbase, int* list_tok, float* list_gate, int* TK, const float* TW, int t0, int lane) {
    const int l32 = lane & 31, t = t0 + (lane >> 5);
    if (l32 < TOPK) { const int tk = TK[t * TOPK + l32]; const int e = tk & 511, pos = lbase[e] + (tk >> 9);
        if (pos < CAP) { list_tok[e * CAP + pos] = t; list_gate[e * CAP + pos] = TW[t * TOPK + l32]; }
        TK[t * TOPK + l32] = e | (pos << 9); }
}

constexpr float YSC = 16.f;
__device__ __forceinline__ void combine_token(const bf16* H1, const unsigned char* Y, const int* TK, lint yb, const float* __restrict__ g, const float* __restrict__ b, float* out, int t, int lane) {
    typedef float f2 __attribute__((ext_vector_type(2)));
    float v[16], s[16];
    { const u32x4 a = *(const u32x4*)(H1 + (size_t)t * D + 16 * lane), c = *(const u32x4*)(H1 + (size_t)t * D + 16 * lane + 8);
      const unsigned w[8] = {a.x, a.y, a.z, a.w, c.x, c.y, c.z, c.w};
#pragma unroll
      for (int i = 0; i < 8; ++i) { v[2 * i] = ALPHA * __builtin_bit_cast(float, w[i] << 16); v[2 * i + 1] = ALPHA * __builtin_bit_cast(float, w[i] & 0xffff0000u); } }
#pragma unroll
    for (int i = 0; i < 16; ++i) s[i] = 0.f;
    int tk = (lane < TOPK) ? TK[t * TOPK + lane] : 0;
#pragma unroll
    for (int k = 0; k <= TOPK; ++k) {
        size_t yrow;
        if (k < TOPK) { const int x = __shfl(tk, k); yrow = (size_t)(yb[x & 511] + (x >> 9)); } else yrow = (size_t)YSH + t;
        const u32x4 a = *(const u32x4*)(Y + yrow * D + 16 * lane);
        const int w[4] = {(int)a.x, (int)a.y, (int)a.z, (int)a.w};
#pragma unroll
        for (int i = 0; i < 4; ++i) { const f2 lo = __builtin_amdgcn_cvt_pk_f32_fp8(w[i], false), hi = __builtin_amdgcn_cvt_pk_f32_fp8(w[i], true);
            s[4 * i] += lo[0]; s[4 * i + 1] += lo[1]; s[4 * i + 2] += hi[0]; s[4 * i + 3] += hi[1]; }
    }
    float sm = 0.f;
#pragma unroll
    for (int i = 0; i < 16; ++i) { v[i] += s[i] * (1.f / YSC); sm += v[i]; }
    const float mean = fx::wave_sum(sm) * (1.f / D); float q = 0.f;
#pragma unroll
    for (int i = 0; i < 16; ++i) { v[i] -= mean; q += v[i] * v[i]; }
    const float rstd = 1.f / sqrtf(fx::wave_sum(q) * (1.f / D) + LN_EPS);
#pragma unroll
    for (int i = 0; i < 4; ++i) { const f32x4 gg = *(const f32x4*)(g + 16 * lane + 4 * i), bb = *(const f32x4*)(b + 16 * lane + 4 * i);
        f32x4 o; o[0] = v[4 * i] * rstd * gg[0] + bb[0]; o[1] = v[4 * i + 1] * rstd * gg[1] + bb[1]; o[2] = v[4 * i + 2] * rstd * gg[2] + bb[2]; o[3] = v[4 * i + 3] * rstd * gg[3] + bb[3];
        *(f32x4*)(out + (size_t)t * D + 16 * lane + 4 * i) = o; }
}
}

namespace pg8 {
struct RouterSched {
    int rb; const bf16_t* Bt;
    __device__ __forceinline__ bool next(int i, Unit2& u) const { if (i > 0) return false; u.pm = rb; u.pn = 0; u.e = 0; u.cnt = 128; u.jt = 0; return true; }
    __device__ __forceinline__ int arow(const Unit2& u, int r) const { return u.pm * 128 + r; }
    __device__ __forceinline__ size_t aoff(const Unit2&) const { return 0; }
    __device__ __forceinline__ const char* bptr(const Unit2&) const { return (const char*)Bt; }
};
struct EpiLogits {
    static constexpr bool PERM = false, AFTER_DRAIN = false;
    float* LG;
    __device__ __forceinline__ void operator()(const f32x4 (&acc)[2][2][4][2], const Unit2& u, int wr, int wc, int fr, int fq) const {
        const int row0 = u.pm * 128 + wr * 64 + fr, col0 = wc * 32 + 4 * fq;
#pragma unroll
        for (int m = 0; m < 4; ++m) { float* rowp = LG + (size_t)(row0 + m * 16) * nv::NE + col0;
#pragma unroll
            for (int bj = 0; bj < 2; ++bj)
#pragma unroll
                for (int n = 0; n < 2; ++n) *(f32x4*)(rowp + bj * HALF + n * 16) = acc[0][bj][m][n]; }
    }
};
template <int PH> struct MoeSched {
    int G, vcu, nrt; mo::lint tb; mo::lint cn; const int* list_tok; const bf16_t* W;
    static constexpr int NC = PH == 0 ? 2 : 4;
    __device__ __forceinline__ bool next(int i, Unit2& u) const {
        const int L = i * G + vcu; if (L >= nrt * NC) return false;
        const int rt = L / NC, c = L % NC;
        int lo = 0, hi = 256;
        while (lo < hi) { const int mid = (lo + hi + 1) >> 1; if (tb[mid] <= rt) lo = mid; else hi = mid - 1; }
        const int e = lo, jt = rt - tb[e]; const int total = cn[e];
        const int rem = total - 256 * jt;
        u.pm = rt; u.pn = c; u.e = __builtin_amdgcn_readfirstlane(e); u.jt = __builtin_amdgcn_readfirstlane(jt); u.cnt = __builtin_amdgcn_readfirstlane(rem < 256 ? rem : 256); return true;
    }
    __device__ __forceinline__ int arow(const Unit2& u, int r) const {
        if (PH == 1) return u.pm * BM + r;
        if (u.e == 256) return u.jt * BM + r;
        return (r < u.cnt) ? list_tok[u.e * mo::CAP + u.jt * BM + r] : 0;
    }
    __device__ __forceinline__ size_t aoff(const Unit2&) const { return 0; }
    __device__ __forceinline__ const char* bptr(const Unit2& u) const {
        return PH == 0 ? (const char*)(W + ((size_t)u.e * 512 + 256 * u.pn) * 1024) : (const char*)(W + ((size_t)u.e * 1024 + 256 * u.pn) * 256);
    }
};
struct EpiSwiGLU {
    static constexpr bool PERM = true, AFTER_DRAIN = false;
    bf16_t* H; const float* list_gate;
    __device__ __forceinline__ void operator()(const f32x4 (&acc)[2][2][4][2], const Unit2& u, int wr, int wc, int fr, int fq) const {
        const int col0 = u.pn * 128 + wc * 32 + 8 * fq;
#pragma unroll
        for (int ai = 0; ai < 2; ++ai)
#pragma unroll
            for (int m = 0; m < 4; ++m) { const int r = ai * HALF + wr * 64 + m * 16 + fr;
                float gt = 1.f; if (u.e < 256) gt = (r < u.cnt) ? list_gate[u.e * mo::CAP + u.jt * BM + r] : 0.f;
                float hv[8];
#pragma unroll
                for (int n = 0; n < 2; ++n)
#pragma unroll
                    for (int i = 0; i < 4; ++i) { const float gg = acc[ai][0][m][n][i], uu = acc[ai][1][m][n][i]; hv[4 * n + i] = gt * uu * (gg * __builtin_amdgcn_rcpf(1.f + __builtin_amdgcn_exp2f(-1.4426950408889634f * gg))); }
                u32x4 w; w.x = cvt_pk_bf16(hv[0], hv[1]); w.y = cvt_pk_bf16(hv[2], hv[3]); w.z = cvt_pk_bf16(hv[4], hv[5]); w.w = cvt_pk_bf16(hv[6], hv[7]);
                *(u32x4*)(H + (size_t)(u.pm * BM + r) * 256 + col0) = w; }
    }
};
struct EpiDown {
    static constexpr bool PERM = true, AFTER_DRAIN = false;
    unsigned char* Y; mo::lint yb;
    __device__ __forceinline__ void operator()(const f32x4 (&acc)[2][2][4][2], const Unit2& u, int wr, int wc, int fr, int fq) const {
        typedef unsigned u32x2v __attribute__((ext_vector_type(2)));
        const int col0 = u.pn * BM + wc * 32 + 8 * fq; const int ybase = yb[u.e] + u.jt * BM;
#pragma unroll
        for (int ai = 0; ai < 2; ++ai)
#pragma unroll
            for (int m = 0; m < 4; ++m) { const int r = ai * HALF + wr * 64 + m * 16 + fr;
                if (r < u.cnt) { unsigned char* rowp = Y + (size_t)(ybase + r) * nv::D + col0;
#pragma unroll
                    for (int bj = 0; bj < 2; ++bj) { const f32x4 v0 = acc[ai][bj][m][0] * mo::YSC, v1 = acc[ai][bj][m][1] * mo::YSC;
                        int w0 = __builtin_amdgcn_cvt_pk_fp8_f32(v0[0], v0[1], 0, false); w0 = __builtin_amdgcn_cvt_pk_fp8_f32(v0[2], v0[3], w0, true);
                        int w1 = __builtin_amdgcn_cvt_pk_fp8_f32(v1[0], v1[1], 0, false); w1 = __builtin_amdgcn_cvt_pk_fp8_f32(v1[2], v1[3], w1, true);
                        *(u32x2v*)(rowp + bj * HALF) = (u32x2v){(unsigned)w0, (unsigned)w1}; } } }
    }
};
}
constexpr int NTHR = 512;
constexpr int LDS_BYTES = 147456;
constexpr int MISC_OFF = 131072 + 320;
constexpr size_t MiB = 1u << 20;
constexpr size_t CTL_ZERO_BYTES = 1 * MiB;
constexpr int CW_BAR = 4096;
constexpr int CW_MOE = 16384;
constexpr int CW_FOXQ = 20992;
constexpr int CW_NRM = 20480;
constexpr int NPHASE = 9;
constexpr size_t WS_H1 = 1, WS_WR = 65, WS_STATS = 66, WS_LF = 67, WS_FG = 68, WS_WO = 72, WS_WIN = 74, WS_TK = 81, WS_LTOK = 83, WS_LGATE = 91,
                 WS_WED = 100, WS_HID = 230, WS_GLA = 230, WS_WEG = 416, WS_XN = 673, WS_YBF = 673, WS_QKV = 737, WS_Z1 = 737, WS_LG = 865, WS_Y = 416, WS_END = 992;

struct Args { const float* in[21]; float* out; unsigned char* ws; int ph_lo, ph_hi, li, pad; };

__global__ void __launch_bounds__(NTHR, 2) mega_fwd(Args a) {
    using namespace nv;
    extern __shared__ __attribute__((aligned(16))) unsigned char lds[];
    const int G = gridDim.x, bx = blockIdx.x;
    const int vcu = (G % 8 == 0) ? (bx % 8) * (G / 8) + bx / 8 : bx;
    int tid, lane, wave, vw;
#define DERIVE() do { int t_ = threadIdx.x; asm volatile("" : "+v"(t_)); tid = t_; lane = tid & 63; wave = __builtin_amdgcn_readfirstlane(tid >> 6); vw = vcu * 8 + wave; } while (0)
    DERIVE();
    volatile LAS unsigned* MISC = (volatile LAS unsigned*)((LAS unsigned char*)lds + MISC_OFF);
    for (int u = tid; u < (LDS_BYTES - 131072) / 4; u += NTHR) ((LAS unsigned*)((LAS unsigned char*)lds + 131072))[u] = 0u;
    __syncthreads();
    unsigned char* ws = a.ws;
    unsigned* ctl = (unsigned*)ws;
    XcdBarrier bar = xcd_barrier_post(ctl + CW_BAR + a.li * XCD_BAR_WORDS, MISC + 8);
    const float* x = a.in[0];
    const float* ln_in_g = a.in[1]; const float* ln_in_b = a.in[2];
    const float* w_in = a.in[3]; const float* b_fgate = a.in[4];
    const float* w_gate_up = a.in[5]; const float* b_gate = a.in[6]; const float* g_gla = a.in[7];
    const float* w_out = a.in[8]; const float* ln1_g = a.in[9]; const float* ln1_b = a.in[10];
    const float* w_router = a.in[11]; const float* rbias = a.in[12];
    const float* w_eg = a.in[13]; const float* w_eu = a.in[14]; const float* w_ed = a.in[15];
    const float* w_sg = a.in[16]; const float* w_su = a.in[17]; const float* w_sd = a.in[18];
    const float* ln2_g = a.in[19]; const float* ln2_b = a.in[20];
    float* out = a.out;
    int* counts = (int*)(ctl + CW_MOE);
    fx::bf16* H1 = (fx::bf16*)(ws + WS_H1 * MiB);
    fx::bf16* WrT = (fx::bf16*)(ws + WS_WR * MiB);
    float* stats = (float*)(ws + WS_STATS * MiB);
    float* LF = (float*)(ws + WS_LF * MiB);
    float* FG = (float*)(ws + WS_FG * MiB);
    fx::bf16* WoT = (fx::bf16*)(ws + WS_WO * MiB);
    fx::bf16* WinT = (fx::bf16*)(ws + WS_WIN * MiB);
    int* TK = (int*)(ws + WS_TK * MiB);
    float* TW = (float*)(ws + (WS_TK + 1) * MiB);
    int* list_tok = (int*)(ws + WS_LTOK * MiB);
    float* list_gate = (float*)(ws + WS_LGATE * MiB);
    fx::bf16* WedT = (fx::bf16*)(ws + WS_WED * MiB);
    fx::bf16* HID = (fx::bf16*)(ws + WS_HID * MiB);
    unsigned char* QPG = ws + WS_GLA * MiB; unsigned char* OIb = ws + (WS_GLA + 16) * MiB; unsigned char* UUb = ws + (WS_GLA + 80) * MiB; float* DECb = (float*)(ws + (WS_GLA + 144) * MiB); unsigned char* STGb = ws + (WS_GLA + 145) * MiB;
    fx::bf16* WegT = (fx::bf16*)(ws + WS_WEG * MiB);
    fx::bf16* XN = (fx::bf16*)(ws + WS_XN * MiB);
    fx::bf16* Ybf = (fx::bf16*)(ws + WS_YBF * MiB);
    fx::bf16* QKV = (fx::bf16*)(ws + WS_QKV * MiB);
    fx::bf16* MIX = (fx::bf16*)(ws + WS_Z1 * MiB);
    float* LG = (float*)(ws + WS_LG * MiB);
    unsigned char* YA = ws + WS_Y * MiB;
    mo::lint tb = (mo::lint)((LAS unsigned char*)lds + mo::L_TB), yb = (mo::lint)((LAS unsigned char*)lds + mo::L_YB), cn = (mo::lint)((LAS unsigned char*)lds + mo::L_CN);

    const int lo = a.ph_lo, hi = a.ph_hi;
#define IN(k) (lo <= (k) && (k) < hi)
#define SEAM(k) do { if (IN(k) && IN((k) + 1)) xcd_barrier(bar); DERIVE(); } while (0)
    const int GW = G * 8;
#ifndef STG7
#define STG7 0
#endif
#ifndef STG8
#define STG8 0
#endif
#define STAGGER(q) do { if ((q) > 0) { const unsigned long long t0_ = __builtin_amdgcn_s_memrealtime(); const unsigned long long d_ = (unsigned long long)((vcu & 3) * (q)); while (__builtin_amdgcn_s_memrealtime() - t0_ < d_) __builtin_amdgcn_s_sleep(8); } } while (0)

    if (IN(0)) {
        LAS float* scr = (LAS float*)((LAS unsigned char*)lds + wave * 16384);
        constexpr int I_IN = 16 * (fx::NIN / 32), I_OUT = 16 * 32, I_R = 16 * 8, I_SMALL = I_IN + I_OUT + I_R;
        for (int it = vw; it < I_SMALL; it += GW) {
            int r = it;
            if (r < I_IN) { fx::transpose_item(w_in, D, INW, WinT, scr, r / (fx::NIN / 32), r % (fx::NIN / 32), lane, [](int d) { return fx::inproj_src(d); }); continue; } r -= I_IN;
            if (r < I_OUT) { fx::transpose_item(w_out, D, D, WoT, scr, r / 32, r % 32, lane, [](int d) { return d; }); continue; } r -= I_OUT;
            fx::transpose_item(w_router, D, NE, WrT, scr, r / 8, r % 8, lane, [](int d) { return d; });
        }
        for (int r = vw; r < T; r += GW) fx::ln_row_bf16(x + (size_t)r * D, ln_in_g, ln_in_b, XN + (size_t)r * D, nullptr, stats + 2 * (size_t)r, lane);
    }
    SEAM(0);
    if (IN(1)) {
        const mo::ExpW XW{w_eg, w_eu, w_ed, w_sg, w_su, w_sd, WegT, WedT};
        if (vcu & 1) { mo::expert_conv(XW, (LAS float*)((LAS unsigned char*)lds + wave * 16384), vw, GW, lane); __syncthreads(); DERIVE(); }
        { pg8::Gemm g{XN, WinT, T, fx::NIN, D, D}; pg8::StaticOrder S; S.init(T, fx::NIN, G, bx);
          pg8::EpiInProj E{QKV, FG, LF, b_fgate, ctl + CW_NRM};
          pg8::gemm_phase<pg8::EpiInProj, pg8::StaticOrder, true, true>((LAS unsigned char*)lds, g, S, E); DERIVE(); }
        if (!(vcu & 1)) { mo::expert_conv(XW, (LAS float*)((LAS unsigned char*)lds + wave * 16384), vw, GW, lane); __syncthreads(); }
    }
    SEAM(1);
    if (IN(2)) {
        int cur_h = -1;
        if (gl::NUNIT % G == 0) { const int per = gl::NUNIT / G; for (int i = 0; i < per; ++i) gl::prep_unit(vcu * per + i, QKV, FG, w_gate_up, b_gate, QPG, OIb, UUb, DECb, lds, cur_h); }
        else for (int u = vcu; u < gl::NUNIT; u += G) gl::prep_unit(u, QKV, FG, w_gate_up, b_gate, QPG, OIb, UUb, DECb, lds, cur_h);
    }
    SEAM(2);
    if (IN(3)) {
        for (int blk = vcu; blk < gl::NUNIT / 8; blk += G) gl::post_block(blk * 8, 8, QKV, QPG, OIb, UUb, DECb, g_gla, Ybf, lds);
        { const attn_body::AttnTensors AT{(const attn_body::bf16*)(QKV + fx::P_FQ), (const attn_body::bf16*)(QKV + fx::P_FK), (const attn_body::bf16*)(QKV + fx::P_FV), (attn_body::bf16*)Ybf, LF, ctl + CW_NRM};
          attn_body::attn_phase_dyn<8>((char*)lds, AT, ctl + CW_FOXQ, (volatile int*)(lds + 140288)); }
    }
    SEAM(3);
    if (IN(4)) {
        pg8::DenseSched DS; DS.so.init(T, D, G, bx); DS.Bt = WoT; DS.ldb = D;
        pg8::EpiPlainBf16 E{MIX, D};
        pg8::gemm_phase2<pg8::EpiPlainBf16, pg8::DenseSched>((LAS unsigned char*)lds, Ybf, D, D, D, DS, E);
    }
    SEAM(4);
    if (IN(5)) {
        int* lcnt = (int*)(lds + 136192); int* lbase = lcnt + 256;
        for (int rb = vcu; rb < T / 128; rb += G) {
            if (tid < 256) lcnt[tid] = 0;
            for (int r = wave * 16; r < wave * 16 + 16; r += 4) { const size_t row = (size_t)rb * 128 + r;
                fx::ln1_rows_bf16<4>(x + row * D, stats + 2 * row, ln_in_g, ln_in_b, MIX + row * D, ln1_g, ln1_b, H1 + row * D, ALPHA, lane); }
            asm volatile("s_waitcnt vmcnt(0)" ::: "memory"); __syncthreads();
            { pg8::RouterSched RS{rb, WrT}; pg8::EpiLogits E{LG};
              pg8::gemm_phase2<pg8::EpiLogits, pg8::RouterSched>((LAS unsigned char*)lds, H1, D, D, D, RS, E); }
            DERIVE();
            for (int t = rb * 128 + wave * 2; t < rb * 128 + 128; t += 16) mo::route_token2(LG, rbias, lcnt, TK, TW, t, lane);
            __syncthreads();
            if (tid < 256) { const int c = lcnt[tid]; lbase[tid] = c ? atomicAdd(&counts[tid], c) : 0; }
            __syncthreads();
            for (int t = rb * 128 + wave * 2; t < rb * 128 + 128; t += 16) mo::route_finish2(lbase, list_tok, list_gate, TK, TW, t, lane);
            __syncthreads();
        }
    }
    SEAM(5);
    if (IN(6)) {
        if (wave == 0) mo::moe_tables(counts, tb, yb, cn, lane);
        __syncthreads();
        STAGGER(STG7);
        pg8::MoeSched<0> MS{G, vcu, tb[257], tb, cn, list_tok, WegT}; pg8::EpiSwiGLU E{HID, list_gate};
        pg8::gemm_phase2<pg8::EpiSwiGLU, pg8::MoeSched<0>>((LAS unsigned char*)lds, H1, D, D, D, MS, E);
    }
    SEAM(6);
    if (IN(7)) {
        if (wave == 0) mo::moe_tables(counts, tb, yb, cn, lane);
        __syncthreads();
        STAGGER(STG8);
        pg8::MoeSched<1> MS{G, vcu, tb[257], tb, cn, list_tok, WedT}; pg8::EpiDown E{YA, yb};
        pg8::gemm_phase2<pg8::EpiDown, pg8::MoeSched<1>>((LAS unsigned char*)lds, HID, ED, ED, ED, MS, E);
    }
    SEAM(7);
    if (IN(8)) {
        if (wave == 0) mo::moe_tables(counts, tb, yb, cn, lane);
        __syncthreads();
        for (int t = vw; t < T; t += GW) mo::combine_token(H1, YA, TK, yb, ln2_g, ln2_b, out, t, lane);
    }
#undef IN
#undef SEAM
}

extern "C" void kernel_launch(void* const* d_in, const int* in_sizes, int n_in, void* d_out, int out_size, void* d_ws, size_t ws_size, hipStream_t stream) {
    static int grid = 0;
    if (grid == 0) {
        if (n_in != 21 || out_size != nv::T * nv::D || ws_size < WS_END * MiB) { fprintf(stderr, "kernel_launch: unexpected shapes n_in=%d out=%d ws=%zu\n", n_in, out_size, ws_size); grid = -1; return; }
        int dev = 0, cus = 0;
        if (hipGetDevice(&dev) != hipSuccess || hipDeviceGetAttribute(&cus, hipDeviceAttributeMultiprocessorCount, dev) != hipSuccess) { grid = -1; return; }
        if (hipFuncSetAttribute((const void*)mega_fwd, hipFuncAttributeMaxDynamicSharedMemorySize, LDS_BYTES) != hipSuccess) { fprintf(stderr, "kernel_launch: hipFuncSetAttribute failed\n"); grid = -1; return; }
        grid = cus;
    }
    if (grid < 0) return;
    if (hipMemsetAsync(d_ws, 0, CTL_ZERO_BYTES, stream) != hipSuccess) return;
    Args a{};
    for (int i = 0; i < 21; ++i) a.in[i] = (const float*)d_in[i];
    a.out = (float*)d_out; a.ws = (unsigned char*)d_ws; a.ph_lo = 0; a.ph_hi = NPHASE; a.li = 0;
#ifdef REPEAT_PH
    a.ph_hi = REPEAT_PH + 1; hipLaunchKernelGGL(mega_fwd, dim3(grid), dim3(NTHR), LDS_BYTES, stream, a);
    if (REPEAT_PH == 5) hipMemsetAsync((char*)d_ws + CW_MOE * 4, 0, 4096, stream);
    a.ph_lo = REPEAT_PH; a.ph_hi = NPHASE; a.li = 1;
#endif
    hipLaunchKernelGGL(mega_fwd, dim3(grid), dim3(NTHR), LDS_BYTES, stream, a);
}
```

```cpp
#include <hip/hip_runtime.h>
#include <cstdio>
#include <cstdint>
#include <cmath>

#define LAS __attribute__((address_space(3)))
#define GAS __attribute__((address_space(1)))

#define XB_TMO      128
#define XB_XCNT(j)  (256  + 64 * (j))
#define XB_XSUB(j)  (1280 + 64 * (j))
#define XB_XGEN(j)  (2304 + 64 * (j))
#define XB_TOP      3328
#define XB_TOPGEN   3392
#define XCD_BAR_WORDS 3456
#define XB_SPIN_CAP (1u << 27)
__device__ __forceinline__ unsigned xb_ld(unsigned* p)              { return __hip_atomic_load(p, __ATOMIC_RELAXED, __HIP_MEMORY_SCOPE_AGENT); }
__device__ __forceinline__ unsigned xb_add(unsigned* p, unsigned v) { return __hip_atomic_fetch_add(p, v, __ATOMIC_RELAXED, __HIP_MEMORY_SCOPE_AGENT); }
__device__ __forceinline__ unsigned xb_xcc_id() { return (unsigned)__builtin_amdgcn_s_getreg((3 << 11) | 20) & 0xFu; }
#define XB_SPIN(cond, bar) do { unsigned _sp = 0; while (cond) { __builtin_amdgcn_s_sleep(1); \
    if ((++_sp & 255u) == 0u) { if (xb_ld(&(bar)[XB_TMO])) break; if (_sp > XB_SPIN_CAP) { atomicAdd(&(bar)[XB_TMO], 1u); break; } } } } while (0)
struct XcdBarrier { unsigned* bar; unsigned x; volatile LAS unsigned* st; };
__device__ __forceinline__ XcdBarrier xcd_barrier_post(unsigned* bar, volatile LAS unsigned* st) {
    XcdBarrier b; b.bar = bar; b.x = xb_xcc_id(); b.st = st;
    if (threadIdx.x == 0) (void)xb_add(&bar[XB_XCNT(b.x)], 1u);
    return b;
}
__device__ __forceinline__ void xcd_barrier_complete(unsigned* bar, unsigned x, unsigned& nloc, unsigned& nx) {
    const unsigned G = gridDim.x * gridDim.y * gridDim.z;
    unsigned sum, cnt, mine, sp = 0u;
    for (;;) {
        sum = 0u; cnt = 0u; mine = 0u;
#pragma unroll
        for (unsigned j = 0; j < 16; ++j) { const unsigned c = xb_ld(&bar[XB_XCNT(j)]); sum += c; cnt += (c > 0u) ? 1u : 0u; mine = (j == x) ? c : mine; }
        if (sum == G) break;
        __builtin_amdgcn_s_sleep(1);
        if ((++sp & 255u) == 0u) { if (xb_ld(&bar[XB_TMO])) break; if (sp > XB_SPIN_CAP) { atomicAdd(&bar[XB_TMO], 1u); break; } }
    }
    nloc = mine > 0u ? mine : 1u; nx = cnt > 0u ? cnt : 1u;
}
__device__ __forceinline__ void xcd_barrier(const XcdBarrier& b) {
    asm volatile("s_waitcnt vmcnt(0)" ::: "memory");
    __syncthreads();
    if (threadIdx.x == 0) {
        unsigned* bar = b.bar;
        __builtin_amdgcn_s_waitcnt(0);
        unsigned nloc = b.st[0], nx = b.st[1];
        if (nloc == 0u) { xcd_barrier_complete(bar, b.x, nloc, nx); b.st[0] = nloc; b.st[1] = nx; }
        const unsigned old = xb_add(&bar[XB_XSUB(b.x)], 1u);
        const unsigned gen = old / nloc;
        if (old + 1u == (gen + 1u) * nloc) {
            __builtin_amdgcn_fence(__ATOMIC_RELEASE, "agent");
            asm volatile("s_waitcnt vmcnt(0)" ::: "memory");
            const unsigned og = xb_add(&bar[XB_TOP], 1u);
            const unsigned tg = og / nx;
            if (og + 1u == (tg + 1u) * nx) xb_add(&bar[XB_TOPGEN], 1u);
            else XB_SPIN(xb_ld(&bar[XB_TOPGEN]) == tg, bar);
            __builtin_amdgcn_fence(__ATOMIC_ACQUIRE, "agent");
            xb_add(&bar[XB_XGEN(b.x)], 1u);
            asm volatile("s_waitcnt vmcnt(0)" ::: "memory");
        } else {
            XB_SPIN(xb_ld(&bar[XB_XGEN(b.x)]) == gen, bar);
            __builtin_amdgcn_fence(__ATOMIC_ACQUIRE, "agent");
            asm volatile("s_waitcnt vmcnt(0)" ::: "memory");
        }
    }
    __syncthreads();
}
namespace pg8 {
#define PG8_LAS __attribute__((address_space(3)))
typedef unsigned short bf16_t;
typedef short bf16x8 __attribute__((ext_vector_type(8)));
typedef float f32x4 __attribute__((ext_vector_type(4)));
typedef unsigned u32x4 __attribute__((ext_vector_type(4)));
constexpr int BM = 256, BK = 64, HALF = 128, HTB = HALF * BK * 2  , STAGE_BYTES = 8 * HTB, NXCD = 8, WGM = 8;

__host__ __device__ __forceinline__ int lds_byte(int r, int c) { const int st = (r >> 4) * 2 + (c >> 5), rr = r & 15, cc = c & 31, ob = rr * 64 + cc * 2; return st * 1024 + (ob ^ (((ob >> 9) & 1) << 5)); }
__host__ __device__ __forceinline__ void stage_rc(int b, int& R, int& C) { const int st = b / 1024, sb = b % 1024, swz = sb ^ (((sb >> 9) & 1) << 5); R = (st >> 1) * 16 + swz / 64; C = (st & 1) * 32 + (swz % 64) / 2; }
__host__ __device__ __forceinline__ int perm32(int rho) { const int n = rho >> 4, i = rho & 15; return 8 * (i >> 2) + 4 * n + (i & 3); }

struct Unit { int pm, pn; };
struct Gemm { const bf16_t* A; const bf16_t* Bt; int M, N, K, lda; };

struct StaticOrder {
    int nM, nN, nwg, G, c;
    __host__ __device__ void init(int M, int N, int G_, int c_) { nM = M / BM; nN = N / BM; nwg = nM * nN; G = G_; c = c_; }
    __host__ __device__ bool next(int i, Unit& u) const {
        const long L = (long)i * G + c; if (L >= nwg) return false;
        int wgid = (int)L; { const int q = nwg / NXCD, r = nwg % NXCD, xcd = wgid % NXCD, off = wgid / NXCD; wgid = (xcd < r ? xcd * (q + 1) : r * (q + 1) + (xcd - r) * q) + off; }
        const int nig = WGM * nN, gid = wgid / nig, fm = gid * WGM, gsz = (nM - fm) < WGM ? (nM - fm) : WGM;
        u.pm = fm + ((wgid % nig) % gsz); u.pn = (wgid % nig) / gsz; return true;
    }
    __device__ __forceinline__ void a_ready(const Unit&) const {}
    __device__ __forceinline__ void done(const Unit&) const {}
};

struct RangeOrder {
    StaticOrder so; int i0, n;
    __host__ __device__ bool next(int i, Unit& u) const { return i < n && so.next(i0 + i, u); }
    __device__ __forceinline__ void a_ready(const Unit&) const {}
    __device__ __forceinline__ void done(const Unit&) const {}
};
__device__ __forceinline__ unsigned cvt_pk_bf16(float lo, float hi) { unsigned r; asm volatile("v_cvt_pk_bf16_f32 %0, %1, %2" : "=v"(r) : "v"(lo), "v"(hi)); return r; }
typedef float f32x2 __attribute__((ext_vector_type(2)));
__device__ __forceinline__ f32x2 gelu_pk(f32x2 v) {
    const f32x2 av = __builtin_elementwise_abs(v), d = av * 0.2316418882f + 1.0f;
    f32x2 t; t.x = __builtin_amdgcn_rcpf(d.x); t.y = __builtin_amdgcn_rcpf(d.y);
    f32x2 q = t * 0.5307027145f + (-0.7265760135f); q = q * t + 0.7107068705f; q = q * t + (-0.142248368f); q = q * t + 0.127414796f; q = q * t;
    const f32x2 s = (v * v) * (-0.72134752044f);
    f32x2 e; e.x = __builtin_amdgcn_exp2f(s.x); e.y = __builtin_amdgcn_exp2f(s.y);
    const f32x2 m = v * (q * e), r = v - m;
    f32x2 o; o.x = v.x < 0.f ? m.x : r.x; o.y = v.y < 0.f ? m.y : r.y; return o;
}

template <int ACT  > struct EpiBf16 {
    static constexpr bool PERM = true, AFTER_DRAIN = false; static_assert(ACT == 0 || ACT == 1, "EpiBf16: ACT is 0 (none) or 1 (gelu_pk)");
    bf16_t* O; int ldc; const float* bias; int split_cols; size_t split_stride; float scale0;
    __device__ __forceinline__ void operator()(const f32x4 (&acc)[2][2][4][2], const Unit& u, int wr, int wc, int fr, int fq) const {
        const int row0 = u.pm * BM + wr * 64 + fr; int colt = u.pn * BM; bf16_t* base = O;
        float sc = 1.f; if (split_cols) { const int t = colt / split_cols; base += (size_t)t * split_stride; colt -= t * split_cols; if (t == 0) sc = scale0; }
        const int col0 = colt + wc * 32 + 8 * fq, bcol0 = u.pn * BM + wc * 32 + 8 * fq;
        f32x4 bv[2][2];
#pragma unroll
        for (int bj = 0; bj < 2; ++bj)
#pragma unroll
            for (int n = 0; n < 2; ++n) bv[bj][n] = bias ? *(const f32x4*)(bias + bcol0 + bj * HALF + 4 * n) : (f32x4){0.f, 0.f, 0.f, 0.f};
#pragma unroll
        for (int ai = 0; ai < 2; ++ai)
#pragma unroll
            for (int m = 0; m < 4; ++m) { bf16_t* rowp = base + (size_t)(row0 + ai * HALF + m * 16) * ldc + col0;
#pragma unroll
                for (int bj = 0; bj < 2; ++bj) { f32x4 v0 = acc[ai][bj][m][0] + bv[bj][0], v1 = acc[ai][bj][m][1] + bv[bj][1];
                    if (ACT == 1) { f32x2 a = gelu_pk((f32x2){v0[0], v0[1]}), b = gelu_pk((f32x2){v0[2], v0[3]}), c = gelu_pk((f32x2){v1[0], v1[1]}), d = gelu_pk((f32x2){v1[2], v1[3]});
                        v0 = (f32x4){a.x, a.y, b.x, b.y}; v1 = (f32x4){c.x, c.y, d.x, d.y}; }
                    v0 = v0 * sc; v1 = v1 * sc; u32x4 w; w.x = cvt_pk_bf16(v0[0], v0[1]); w.y = cvt_pk_bf16(v0[2], v0[3]); w.z = cvt_pk_bf16(v1[0], v1[1]); w.w = cvt_pk_bf16(v1[2], v1[3]);
                    *(u32x4*)(rowp + bj * HALF) = w; } }
    }
};

template <class Epi, class Sched, bool ALIGN_EPI = false, bool SP2 = false>
__device__ __forceinline__ void gemm_phase(PG8_LAS unsigned char* lds, const Gemm g, const Sched& S, const Epi& E) {
    const int tid = threadIdx.x, wid = __builtin_amdgcn_readfirstlane(tid >> 6), lane = tid & 63, wr = wid >> 2, wc = wid & 3, fr = lane & 15, fq = lane >> 4;
    const int K = g.K, nt = K / BK;
    unsigned voffA[2], voffB[2];
#pragma unroll
    for (int i = 0; i < 2; ++i) { int R, C; stage_rc(tid * 16 + i * 8192, R, C); const int Rb = Epi::PERM ? ((R & ~31) + perm32(R & 31)) : R;
        voffA[i] = (unsigned)(R * g.lda + C) * 2u; voffB[i] = (unsigned)(Rb * K + C) * 2u; }
    const size_t kstep = (size_t)(BK * 2);
    const size_t hstepA = (size_t)HALF * g.lda * 2, hstepB = (size_t)HALF * K * 2;
    const size_t tstepA = 2 * hstepA, tstepB = 2 * hstepB;
    const unsigned ldsw = (unsigned)wid * 1024u;
    const int aoff = lds_byte(wr * 64 + fr, fq * 8), boff = lds_byte(wc * 32 + fr, fq * 8);
#define PG8_SA(b, h) (((b) * 2 + (h)) * HTB)
#define PG8_SB(b, h) ((4 + (b) * 2 + (h)) * HTB)
#define PG8_STAGE(bufoff, gbase, voff) do { _Pragma("unroll") for (int _i = 0; _i < 2; ++_i) \
        __builtin_amdgcn_global_load_lds((const unsigned*)((const char*)(gbase) + (voff)[_i]), (PG8_LAS unsigned*)(lds + (bufoff) + ldsw + _i * 8192), 16, 0, 0); } while (0)
#define PG8_LDA(dst, b, h) do { _Pragma("unroll") for (int m = 0; m < 4; ++m) _Pragma("unroll") for (int k = 0; k < 2; ++k) dst[m][k] = *(const PG8_LAS bf16x8*)(lds + PG8_SA(b, h) + aoff + m * 2048 + k * 1024); } while (0)
#define PG8_LDB(dst, b, h) do { _Pragma("unroll") for (int n = 0; n < 2; ++n) _Pragma("unroll") for (int k = 0; k < 2; ++k) dst[n][k] = *(const PG8_LAS bf16x8*)(lds + PG8_SB(b, h) + boff + n * 2048 + k * 1024); } while (0)
#define PG8_MMA(ai, bj, At, Bt) do { __builtin_amdgcn_s_setprio(1); _Pragma("unroll") for (int m = 0; m < 4; ++m) _Pragma("unroll") for (int n = 0; n < 2; ++n) _Pragma("unroll") for (int k = 0; k < 2; ++k) \
        acc[ai][bj][m][n] = __builtin_amdgcn_mfma_f32_16x16x32_bf16(Bt[n][k], At[m][k], acc[ai][bj][m][n], 0, 0, 0); __builtin_amdgcn_s_setprio(0); } while (0)
#define PG8_WAIT_V(n) asm volatile("s_waitcnt vmcnt(" #n ")" ::: "memory")
#define PG8_WAIT_L(n) asm volatile("s_waitcnt lgkmcnt(" #n ")" ::: "memory")
#define PG8_BAR __builtin_amdgcn_s_barrier()
#define PG8_SCHED __builtin_amdgcn_sched_barrier(0)
    Unit cur, nxt; int ui = 0;
    if (!S.next(0, cur)) return;
    f32x4 acc[2][2][4][2];
#pragma unroll
    for (int a = 0; a < 2; ++a)
#pragma unroll
        for (int b = 0; b < 2; ++b)
#pragma unroll
            for (int m = 0; m < 4; ++m)
#pragma unroll
                for (int n = 0; n < 2; ++n) acc[a][b][m][n] = (f32x4){0.f, 0.f, 0.f, 0.f};
    bf16x8 At[4][2], B0[2][2], B1[2][2];
    const char* cA = (const char*)g.A + (size_t)cur.pm * tstepA; const char* cB = (const char*)g.Bt + (size_t)cur.pn * tstepB;
    S.a_ready(cur);
    if constexpr (SP2) {
        PG8_STAGE(PG8_SB(0, 0), cB, voffB); PG8_STAGE(PG8_SB(0, 1), cB + hstepB, voffB); PG8_STAGE(PG8_SA(0, 0), cA, voffA); PG8_STAGE(PG8_SA(0, 1), cA + hstepA, voffA);
        if (wr == 1) PG8_BAR;
        PG8_WAIT_V(2); PG8_BAR;
        PG8_STAGE(PG8_SB(1, 0), cB + kstep, voffB); PG8_STAGE(PG8_SA(1, 0), cA + kstep, voffA); PG8_STAGE(PG8_SB(1, 1), cB + hstepB + kstep, voffB);
        PG8_WAIT_V(6); PG8_BAR;
    } else {
        PG8_STAGE(PG8_SB(0, 0), cB, voffB); PG8_STAGE(PG8_SA(0, 0), cA, voffA); PG8_STAGE(PG8_SB(0, 1), cB + hstepB, voffB); PG8_STAGE(PG8_SA(0, 1), cA + hstepA, voffA);
        if (wr == 1) PG8_BAR;
        PG8_WAIT_V(4); PG8_BAR;
        PG8_STAGE(PG8_SB(1, 0), cB + kstep, voffB); PG8_STAGE(PG8_SA(1, 0), cA + kstep, voffA); PG8_STAGE(PG8_SB(1, 1), cB + hstepB + kstep, voffB);
        PG8_WAIT_V(6); PG8_BAR;
    }
    for (;;) {
        const bool has_next = S.next(ui + 1, nxt);
        const char* nA = has_next ? (const char*)g.A + (size_t)nxt.pm * tstepA : cA; const char* nB = has_next ? (const char*)g.Bt + (size_t)nxt.pn * tstepB : cB;
        for (int t = 0; t < nt; t += 2) {
            const bool last = (t == nt - 2);
            const char* a1 = cA + (size_t)(t + 1) * kstep;
            const char* a2 = last ? nA : cA + (size_t)(t + 2) * kstep; const char* b2 = last ? nB : cB + (size_t)(t + 2) * kstep;
            const char* a3 = a2 + kstep; const char* b3 = b2 + kstep;
            if (last && has_next) S.a_ready(nxt);
            if constexpr (SP2) {
            PG8_LDB(B0, 0, 0); PG8_LDB(B1, 0, 1); PG8_SCHED; PG8_LDA(At, 0, 0); PG8_STAGE(PG8_SA(1, 1), a1 + hstepA, voffA);
            PG8_WAIT_V(8); PG8_WAIT_L(0); PG8_BAR; PG8_MMA(0, 0, At, B0); PG8_MMA(0, 1, At, B1); PG8_BAR; PG8_SCHED;
            PG8_LDA(At, 0, 1); PG8_STAGE(PG8_SB(0, 0), b2, voffB); PG8_STAGE(PG8_SB(0, 1), b2 + hstepB, voffB); PG8_STAGE(PG8_SA(0, 0), a2, voffA);
            PG8_WAIT_V(8); PG8_WAIT_L(0); PG8_BAR; PG8_MMA(1, 0, At, B0); PG8_MMA(1, 1, At, B1); PG8_BAR; PG8_SCHED;
            PG8_LDB(B0, 1, 0); PG8_LDB(B1, 1, 1); PG8_SCHED; PG8_LDA(At, 1, 0); PG8_STAGE(PG8_SA(0, 1), a2 + hstepA, voffA);
            PG8_WAIT_V(8); PG8_WAIT_L(0); PG8_BAR; PG8_MMA(0, 0, At, B0); PG8_MMA(0, 1, At, B1); PG8_BAR; PG8_SCHED;
            PG8_LDA(At, 1, 1); PG8_STAGE(PG8_SB(1, 0), b3, voffB); PG8_STAGE(PG8_SB(1, 1), b3 + hstepB, voffB); PG8_STAGE(PG8_SA(1, 0), a3, voffA);
            PG8_WAIT_V(8); PG8_WAIT_L(0); PG8_BAR; PG8_MMA(1, 0, At, B0); PG8_MMA(1, 1, At, B1); PG8_BAR; PG8_SCHED;
            } else {
            PG8_LDB(B0, 0, 0); PG8_SCHED; PG8_LDA(At, 0, 0); PG8_STAGE(PG8_SA(1, 1), a1 + hstepA, voffA);
            PG8_WAIT_L(8); PG8_BAR; PG8_WAIT_L(0); PG8_MMA(0, 0, At, B0); PG8_BAR; PG8_SCHED;
            PG8_LDB(B1, 0, 1); PG8_STAGE(PG8_SB(0, 0), b2, voffB);
            PG8_BAR; PG8_WAIT_L(0); PG8_MMA(0, 1, At, B1); PG8_BAR;
            PG8_LDA(At, 0, 1); PG8_STAGE(PG8_SA(0, 0), a2, voffA);
            PG8_BAR; PG8_WAIT_L(0); PG8_MMA(1, 0, At, B0); PG8_BAR; PG8_SCHED;
            PG8_STAGE(PG8_SB(0, 1), b2 + hstepB, voffB);
            PG8_WAIT_V(6); PG8_BAR; PG8_MMA(1, 1, At, B1); PG8_BAR;
            PG8_LDB(B0, 1, 0); PG8_SCHED; PG8_LDA(At, 1, 0); PG8_STAGE(PG8_SA(0, 1), a2 + hstepA, voffA);
            PG8_WAIT_L(8); PG8_BAR; PG8_WAIT_L(0); PG8_MMA(0, 0, At, B0); PG8_BAR; PG8_SCHED;
            PG8_LDB(B1, 1, 1); PG8_STAGE(PG8_SB(1, 0), b3, voffB);
            PG8_BAR; PG8_WAIT_L(0); PG8_MMA(0, 1, At, B1); PG8_BAR;
            PG8_LDA(At, 1, 1); PG8_STAGE(PG8_SA(1, 0), a3, voffA);
            PG8_BAR; PG8_WAIT_L(0); PG8_MMA(1, 0, At, B0); PG8_BAR; PG8_SCHED;
            PG8_STAGE(PG8_SB(1, 1), b3 + hstepB, voffB);
            PG8_WAIT_V(6); PG8_BAR; PG8_MMA(1, 1, At, B1); PG8_BAR;
            }
        }
        if constexpr (ALIGN_EPI) { if (wr == 0) PG8_BAR; }
        if constexpr (!Epi::AFTER_DRAIN) { E(acc, cur, wr, wc, fr, fq); S.done(cur); }
        if (!has_next) break;
#pragma unroll
        for (int a = 0; a < 2; ++a)
#pragma unroll
            for (int b = 0; b < 2; ++b)
#pragma unroll
                for (int m = 0; m < 4; ++m)
#pragma unroll
                    for (int n = 0; n < 2; ++n) acc[a][b][m][n] = (f32x4){0.f, 0.f, 0.f, 0.f};
        cur = nxt; cA = nA; cB = nB; ++ui;
        if constexpr (ALIGN_EPI) { if (wr == 1) PG8_BAR; }
    }
    PG8_WAIT_V(0);
    if constexpr (!ALIGN_EPI) { if (wr == 0) PG8_BAR; }
    PG8_BAR;
    if constexpr (Epi::AFTER_DRAIN) { E.fused(acc, cur, wr, wc, fr, fq, lds, wid, lane); S.done(cur); }
#undef PG8_SA
#undef PG8_SB
#undef PG8_STAGE
#undef PG8_LDA
#undef PG8_LDB
#undef PG8_MMA
#undef PG8_WAIT_V
#undef PG8_WAIT_L
#undef PG8_BAR
#undef PG8_SCHED
}
}
namespace pg8 {
struct Unit2 { int pm, pn, e, cnt, jt, ui; };
template <class Epi, class Sched>
__device__ __forceinline__ void gemm_phase2(PG8_LAS unsigned char* lds, const bf16_t* Abase, int lda, int ldb, int K, const Sched& S, const Epi& E) {
    int tid_ = threadIdx.x; asm volatile("" : "+v"(tid_));
    const int tid = tid_, wid = __builtin_amdgcn_readfirstlane(tid >> 6), lane = tid & 63, wr = wid >> 2, wc = wid & 3, fr = lane & 15, fq = lane >> 4;
    int K_ = K; asm volatile("" : "+s"(K_));
    const int nt = K_ / BK;
    unsigned voffB[2];
#pragma unroll
    for (int i = 0; i < 2; ++i) { int R, C; stage_rc(tid * 16 + i * 8192, R, C); const int Rb = Epi::PERM ? ((R & ~31) + perm32(R & 31)) : R; voffB[i] = (unsigned)(Rb * ldb + C) * 2u; }
    const unsigned lda2 = (unsigned)lda * 2u;
#define PG8_AOFFS(U, o0, o1) do { int t2_ = threadIdx.x; asm volatile("" : "+v"(t2_)); _Pragma("unroll") for (int i_ = 0; i_ < 2; ++i_) { int R_, C_; stage_rc(t2_ * 16 + i_ * 8192, R_, C_); \
        o0[i_] = (unsigned)S.arow(U, R_) * lda2 + (unsigned)C_ * 2u; o1[i_] = (unsigned)S.arow(U, HALF + R_) * lda2 + (unsigned)C_ * 2u; } } while (0)
    const size_t kstep = (size_t)(BK * 2);
    const size_t hstepB = (size_t)HALF * ldb * 2;
    const unsigned ldsw = (unsigned)wid * 1024u;
    const int aoff = lds_byte(wr * 64 + fr, fq * 8), boff = lds_byte(wc * 32 + fr, fq * 8);
#define PG8_SA(b, h) (((b) * 2 + (h)) * HTB)
#define PG8_SB(b, h) ((4 + (b) * 2 + (h)) * HTB)
#define PG8_STAGE(bufoff, gbase, voff) do { _Pragma("unroll") for (int _i = 0; _i < 2; ++_i) \
        __builtin_amdgcn_global_load_lds((const unsigned*)((const char*)(gbase) + (voff)[_i]), (PG8_LAS unsigned*)(lds + (bufoff) + ldsw + _i * 8192), 16, 0, 0); } while (0)
#define PG8_LDA(dst, b, h) do { _Pragma("unroll") for (int m = 0; m < 4; ++m) _Pragma("unroll") for (int k = 0; k < 2; ++k) dst[m][k] = *(const PG8_LAS bf16x8*)(lds + PG8_SA(b, h) + aoff + m * 2048 + k * 1024); } while (0)
#define PG8_LDB(dst, b, h) do { _Pragma("unroll") for (int n = 0; n < 2; ++n) _Pragma("unroll") for (int k = 0; k < 2; ++k) dst[n][k] = *(const PG8_LAS bf16x8*)(lds + PG8_SB(b, h) + boff + n * 2048 + k * 1024); } while (0)
#define PG8_MMA(ai, bj, At, Bt) do { __builtin_amdgcn_s_setprio(1); _Pragma("unroll") for (int m = 0; m < 4; ++m) _Pragma("unroll") for (int n = 0; n < 2; ++n) _Pragma("unroll") for (int k = 0; k < 2; ++k) \
        acc[ai][bj][m][n] = __builtin_amdgcn_mfma_f32_16x16x32_bf16(Bt[n][k], At[m][k], acc[ai][bj][m][n], 0, 0, 0); __builtin_amdgcn_s_setprio(0); } while (0)
#define PG8_WAIT_V(n) asm volatile("s_waitcnt vmcnt(" #n ")" ::: "memory")
#define PG8_WAIT_L(n) asm volatile("s_waitcnt lgkmcnt(" #n ")" ::: "memory")
#define PG8_BAR __builtin_amdgcn_s_barrier()
#define PG8_SCHED __builtin_amdgcn_sched_barrier(0)
    Unit2 cur, nxt; int ui = 0;
    if (!S.next(0, cur)) return;
    f32x4 acc[2][2][4][2];
#pragma unroll
    for (int a = 0; a < 2; ++a)
#pragma unroll
        for (int b = 0; b < 2; ++b)
#pragma unroll
            for (int m = 0; m < 4; ++m)
#pragma unroll
                for (int n = 0; n < 2; ++n) acc[a][b][m][n] = (f32x4){0.f, 0.f, 0.f, 0.f};
    bf16x8 At[4][2], B0[2][2], B1[2][2];
    unsigned cv0[2], cv1[2], nv0[2], nv1[2];
    PG8_AOFFS(cur, cv0, cv1);
    const char* cA = (const char*)Abase + S.aoff(cur); const char* cB = S.bptr(cur);
    PG8_STAGE(PG8_SB(0, 0), cB, voffB); PG8_STAGE(PG8_SB(0, 1), cB + hstepB, voffB); PG8_STAGE(PG8_SA(0, 0), cA, cv0); PG8_STAGE(PG8_SA(0, 1), cA, cv1);
    if (wr == 1) PG8_BAR;
    PG8_WAIT_V(2); PG8_BAR;
    PG8_STAGE(PG8_SB(1, 0), cB + kstep, voffB); PG8_STAGE(PG8_SA(1, 0), cA + kstep, cv0); PG8_STAGE(PG8_SB(1, 1), cB + hstepB + kstep, voffB);
    PG8_WAIT_V(6); PG8_BAR;
    for (;;) {
        const bool has_next = S.next(ui + 1, nxt);
        const char* nA = has_next ? (const char*)Abase + S.aoff(nxt) : cA; const char* nB = has_next ? S.bptr(nxt) : cB;
#pragma unroll
        for (int i = 0; i < 2; ++i) { nv0[i] = cv0[i]; nv1[i] = cv1[i]; }
        if (has_next) PG8_AOFFS(nxt, nv0, nv1);
        const bool act0 = cur.cnt > wr * 64, act1 = cur.cnt > HALF + wr * 64;
        for (int t = 0; t < nt; t += 2) {
            const bool last = (t == nt - 2);
            const char* a1 = cA + (size_t)(t + 1) * kstep;
            const char* a2 = last ? nA : cA + (size_t)(t + 2) * kstep; const char* b2 = last ? nB : cB + (size_t)(t + 2) * kstep;
            const char* a3 = a2 + kstep; const char* b3 = b2 + kstep;
            unsigned s0[2] = {cv0[0], cv0[1]}, s1[2] = {cv1[0], cv1[1]};
            if (last) { asm volatile("" ::: "memory"); s0[0] = nv0[0]; s0[1] = nv0[1]; s1[0] = nv1[0]; s1[1] = nv1[1]; }
            PG8_LDB(B0, 0, 0); PG8_LDB(B1, 0, 1); PG8_SCHED; PG8_LDA(At, 0, 0); PG8_STAGE(PG8_SA(1, 1), a1, cv1);
            PG8_WAIT_V(8); PG8_WAIT_L(0); PG8_BAR; if (act0) { PG8_MMA(0, 0, At, B0); PG8_MMA(0, 1, At, B1); } PG8_BAR; PG8_SCHED;
            PG8_LDA(At, 0, 1); PG8_STAGE(PG8_SB(0, 0), b2, voffB); PG8_STAGE(PG8_SB(0, 1), b2 + hstepB, voffB); PG8_STAGE(PG8_SA(0, 0), a2, s0);
            PG8_WAIT_V(8); PG8_WAIT_L(0); PG8_BAR; if (act1) { PG8_MMA(1, 0, At, B0); PG8_MMA(1, 1, At, B1); } PG8_BAR; PG8_SCHED;
            PG8_LDB(B0, 1, 0); PG8_LDB(B1, 1, 1); PG8_SCHED; PG8_LDA(At, 1, 0); PG8_STAGE(PG8_SA(0, 1), a2, s1);
            PG8_WAIT_V(8); PG8_WAIT_L(0); PG8_BAR; if (act0) { PG8_MMA(0, 0, At, B0); PG8_MMA(0, 1, At, B1); } PG8_BAR; PG8_SCHED;
            PG8_LDA(At, 1, 1); PG8_STAGE(PG8_SB(1, 0), b3, voffB); PG8_STAGE(PG8_SB(1, 1), b3 + hstepB, voffB); PG8_STAGE(PG8_SA(1, 0), a3, s0);
            PG8_WAIT_V(8); PG8_WAIT_L(0); PG8_BAR; if (act1) { PG8_MMA(1, 0, At, B0); PG8_MMA(1, 1, At, B1); } PG8_BAR; PG8_SCHED;
        }
        if (wr == 0) PG8_BAR;
        { Unit2 eu = cur; asm volatile("" : "+s"(eu.pm), "+s"(eu.pn), "+s"(eu.e), "+s"(eu.cnt), "+s"(eu.jt), "+s"(eu.ui));
          E(acc, eu, wr, wc, fr, fq);
          }
        if (!has_next) break;
#pragma unroll
        for (int a = 0; a < 2; ++a)
#pragma unroll
            for (int b = 0; b < 2; ++b)
#pragma unroll
                for (int m = 0; m < 4; ++m)
#pragma unroll
                    for (int n = 0; n < 2; ++n) acc[a][b][m][n] = (f32x4){0.f, 0.f, 0.f, 0.f};
        cur = nxt; cA = nA; cB = nB; ++ui;
#pragma unroll
        for (int i = 0; i < 2; ++i) { cv0[i] = nv0[i]; cv1[i] = nv1[i]; }
        if (wr == 1) PG8_BAR;
    }
    PG8_WAIT_V(0);
    PG8_BAR;
#undef PG8_AOFFS
#undef PG8_SA
#undef PG8_SB
#undef PG8_STAGE
#undef PG8_LDA
#undef PG8_LDB
#undef PG8_MMA
#undef PG8_WAIT_V
#undef PG8_WAIT_L
#undef PG8_BAR
#undef PG8_SCHED
}

struct DenseSched {
    StaticOrder so; const bf16_t* Bt; int ldb;
    __device__ __forceinline__ bool next(int i, Unit2& u) const { Unit t; if (!so.next(i, t)) return false; u.pm = t.pm; u.pn = t.pn; u.e = 0; u.cnt = 256; u.jt = 0; u.ui = i; return true; }
    __device__ __forceinline__ int arow(const Unit2& u, int r) const { return u.pm * BM + r; }
    __device__ __forceinline__ size_t aoff(const Unit2&) const { return 0; }
    __device__ __forceinline__ const char* bptr(const Unit2& u) const { return (const char*)(Bt + (size_t)u.pn * BM * ldb); }
};
struct EpiPlainBf16 {
    static constexpr bool PERM = true, AFTER_DRAIN = false;
    bf16_t* O; int ldc;
    __device__ __forceinline__ void operator()(const f32x4 (&acc)[2][2][4][2], const Unit2& u, int wr, int wc, int fr, int fq) const {
        const int row0 = u.pm * BM + wr * 64 + fr, col0 = u.pn * BM + wc * 32 + 8 * fq;
#pragma unroll
        for (int ai = 0; ai < 2; ++ai)
#pragma unroll
            for (int m = 0; m < 4; ++m) { bf16_t* rowp = O + (size_t)(row0 + ai * HALF + m * 16) * ldc + col0;
#pragma unroll
                for (int bj = 0; bj < 2; ++bj) { const f32x4 v0 = acc[ai][bj][m][0], v1 = acc[ai][bj][m][1];
                    u32x4 w; w.x = cvt_pk_bf16(v0[0], v0[1]); w.y = cvt_pk_bf16(v0[2], v0[3]); w.z = cvt_pk_bf16(v1[0], v1[1]); w.w = cvt_pk_bf16(v1[2], v1[3]);
                    *(u32x4*)(rowp + bj * HALF) = w; } }
    }
};
}
namespace nv {
constexpr int D = 1024, B = 8, S = 4096, T = B * S;
constexpr int FH = 8, FD = 64, GH = 4, GK = 64, GV = 128, RANK = 16;
constexpr int INW = 3096;
constexpr int O_FQ = 0, O_FK = 512, O_FV = 1024, O_FF = 1536, O_GQ = 1544, O_GK = 1800, O_GV = 2056, O_GA = 2568, O_GR = 2584;
constexpr int NE = 256, NG = 8, TOPK = 8, ED = 256;
constexpr float LN_EPS = 1e-5f;
constexpr float ALPHA = 1.189207115002721f;
constexpr int PADR = 64;
constexpr int APAD = T * TOPK + NE * PADR;

__device__ __forceinline__ float logsigmoidf(float x) { return fminf(x, 0.f) - log1pf(expf(-fabsf(x))); }
__device__ __forceinline__ float siluf(float x) { return x / (1.f + expf(-x)); }


__device__ __forceinline__ void ln_row(const float* in1, float a, const float* in2, const float* __restrict__ g, const float* __restrict__ b, float* out, int r, int tid, float* sh) {
    float4 v = ((const float4*)(in1 + (size_t)r * D))[tid];
    v.x *= a; v.y *= a; v.z *= a; v.w *= a;
    if (in2) { const float4 w = ((const float4*)(in2 + (size_t)r * D))[tid]; v.x += w.x; v.y += w.y; v.z += w.z; v.w += w.w; }
    float s = v.x + v.y + v.z + v.w;
    for (int o = 32; o > 0; o >>= 1) s += __shfl_xor(s, o);
    __syncthreads();
    if ((tid & 63) == 0) sh[tid >> 6] = s;
    __syncthreads();
    const float mean = (sh[0] + sh[1] + sh[2] + sh[3]) * (1.f / D);
    v.x -= mean; v.y -= mean; v.z -= mean; v.w -= mean;
    float q = v.x * v.x + v.y * v.y + v.z * v.z + v.w * v.w;
    for (int o = 32; o > 0; o >>= 1) q += __shfl_xor(q, o);
    if ((tid & 63) == 0) sh[4 + (tid >> 6)] = q;
    __syncthreads();
    const float rstd = rsqrtf((sh[4] + sh[5] + sh[6] + sh[7]) * (1.f / D) + LN_EPS);
    const float4 gg = ((const float4*)g)[tid], bb = ((const float4*)b)[tid];
    float4 o4; o4.x = v.x * rstd * gg.x + bb.x; o4.y = v.y * rstd * gg.y + bb.y; o4.z = v.z * rstd * gg.z + bb.z; o4.w = v.w * rstd * gg.w + bb.w;
    ((float4*)(out + (size_t)r * D))[tid] = o4;
}

__device__ __forceinline__ void gemm_tile(const float* A, const float* Bm, float* C, int N, int K, int lda, int ldb, int ldc, int tile_x, int tile_y, int tid, float* sh) {
    float (*As)[68] = (float (*)[68])sh;
    float (*Bs)[68] = (float (*)[68])(sh + 16 * 68);
    const int tx = tid & 15, ty = tid >> 4;
    const int row0 = tile_y * 64, col0 = tile_x * 64;
    float acc[4][4] = {};
    const int ar = tid >> 2, ak = (tid & 3) * 4;
    const int bk = tid >> 4, bc = (tid & 15) * 4;
    const bool bok = (col0 + bc) < N;
    for (int k0 = 0; k0 < K; k0 += 16) {
        const float4 av = *(const float4*)(A + (size_t)(row0 + ar) * lda + k0 + ak);
        float4 bv = make_float4(0.f, 0.f, 0.f, 0.f);
        if (bok) bv = *(const float4*)(Bm + (size_t)(k0 + bk) * ldb + col0 + bc);
        __syncthreads();
        As[ak + 0][ar] = av.x; As[ak + 1][ar] = av.y; As[ak + 2][ar] = av.z; As[ak + 3][ar] = av.w;
        *(float4*)&Bs[bk][bc] = bv;
        __syncthreads();
#pragma unroll
        for (int k = 0; k < 16; ++k) {
            const float4 a4 = *(const float4*)&As[k][ty * 4];
            const float4 b4 = *(const float4*)&Bs[k][tx * 4];
            const float aa[4] = {a4.x, a4.y, a4.z, a4.w}, bb[4] = {b4.x, b4.y, b4.z, b4.w};
#pragma unroll
            for (int i = 0; i < 4; ++i)
#pragma unroll
                for (int j = 0; j < 4; ++j) acc[i][j] += aa[i] * bb[j];
        }
    }
    if (col0 + tx * 4 < N) {
#pragma unroll
        for (int i = 0; i < 4; ++i)
            *(float4*)(C + (size_t)(row0 + ty * 4 + i) * ldc + col0 + tx * 4) = make_float4(acc[i][0], acc[i][1], acc[i][2], acc[i][3]);
    }
}
__device__ __forceinline__ void gemm_phase(const float* A, const float* Bm, float* C, int M, int N, int K, int lda, int ldb, int ldc, int half, int tid, float* sh) {
    const int ntx = (N + 63) / 64, nty = M / 64, ntile = ntx * nty, G2 = gridDim.x * 2;
    for (int t0 = blockIdx.x * 2; t0 < ntile; t0 += G2) {
        int tl = t0 + half; if (tl >= ntile) tl = ntile - 1;
        gemm_tile(A, Bm, C, N, K, lda, ldb, ldc, tl % ntx, tl / ntx, tid, sh);
    }
}

__device__ __forceinline__ void fox_prep(const float* proj, const float* __restrict__ bf, float* cbuf, int bh, int lane) {
    const int b = bh / FH, h = bh % FH;
    const float bias = bf[h];
    float s = 0.f;
    for (int i = 0; i < 64; ++i) { const int t = lane * 64 + i; s += logsigmoidf(proj[(size_t)(b * S + t) * INW + O_FF + h] + bias); }
    float inc = s;
    for (int o = 1; o < 64; o <<= 1) { const float n = __shfl_up(inc, o); if (lane >= o) inc += n; }
    float run = inc - s;
    for (int i = 0; i < 64; ++i) { const int t = lane * 64 + i; run += logsigmoidf(proj[(size_t)(b * S + t) * INW + O_FF + h] + bias); cbuf[(size_t)bh * S + t] = run; }
}

__device__ __forceinline__ void fox_attn(const float* proj, const float* cbuf, float* y, int blk, int lane) {
    const int qb = blk % (S / 64), bh = blk / (S / 64), b = bh / FH, h = bh % FH;
    const int t = qb * 64 + lane;
    const float* qp = proj + (size_t)(b * S + t) * INW + O_FQ + h * FD;
    float q[64], o[64];
#pragma unroll
    for (int d = 0; d < 64; ++d) { q[d] = qp[d] * 0.125f; o[d] = 0.f; }
    const float ct = cbuf[(size_t)bh * S + t];
    float m = -INFINITY, l = 0.f;
    const int smax = qb * 64 + 63;
    for (int s = 0; s <= smax; ++s) {
        const float* kp = proj + (size_t)(b * S + s) * INW + O_FK + h * FD;
        const float* vp = proj + (size_t)(b * S + s) * INW + O_FV + h * FD;
        float dot = 0.f;
#pragma unroll
        for (int d = 0; d < 64; ++d) dot += q[d] * kp[d];
        const float x = dot + (ct - cbuf[(size_t)bh * S + s]);
        if (s <= t) {
            if (x > m) { const float al = expf(m - x); l *= al;
#pragma unroll
                for (int d = 0; d < 64; ++d) o[d] *= al;
                m = x; }
            const float p = expf(x - m); l += p;
#pragma unroll
            for (int d = 0; d < 64; ++d) o[d] += p * vp[d];
        }
    }
    const float il = 1.f / l;
    float* yp = y + (size_t)(b * S + t) * D + h * FD;
#pragma unroll
    for (int d = 0; d < 64; ++d) yp[d] = o[d] * il;
}

__device__ __forceinline__ void gla_prep(const float* proj, const float* __restrict__ wgu, const float* __restrict__ bg, float* abuf, int t, int j) {
    const float* ga = proj + (size_t)t * INW + O_GA;
    float s = bg[j];
#pragma unroll
    for (int r = 0; r < RANK; ++r) s += ga[r] * wgu[r * 256 + j];
    abuf[(size_t)t * 256 + j] = expf(logsigmoidf(s) * (1.f / 16.f));
}

__device__ __forceinline__ void gla_rec(const float* proj, const float* abuf, float* glao, int bh, int e) {
    const int b = bh / GH, h = bh % GH;
    float st[64];
#pragma unroll
    for (int d = 0; d < 64; ++d) st[d] = 0.f;
    for (int s = 0; s < S; ++s) {
        const size_t t = (size_t)b * S + s;
        const float* qp = proj + t * INW + O_GQ + h * GK;
        const float* kp = proj + t * INW + O_GK + h * GK;
        const float* ap = abuf + t * 256 + h * GK;
        const float v = proj[t * INW + O_GV + h * GV + e];
        float o = 0.f;
#pragma unroll
        for (int d = 0; d < 64; ++d) { st[d] = ap[d] * st[d] + kp[d] * v; o += qp[d] * st[d]; }
        glao[t * 512 + h * GV + e] = o * 0.125f;
    }
}

__device__ __forceinline__ void gla_post(const float* glao, const float* proj, const float* __restrict__ g, float* y, int w, int lane) {
    const int t = w >> 2, h = w & 3;
    const float o0 = glao[(size_t)t * 512 + h * GV + lane], o1 = glao[(size_t)t * 512 + h * GV + 64 + lane];
    float ss = o0 * o0 + o1 * o1;
    for (int o = 32; o > 0; o >>= 1) ss += __shfl_xor(ss, o);
    const float r = rsqrtf(ss * (1.f / GV) + LN_EPS);
    const float g0 = proj[(size_t)t * INW + O_GR + h * GV + lane], g1 = proj[(size_t)t * INW + O_GR + h * GV + 64 + lane];
    y[(size_t)t * D + 512 + h * GV + lane] = o0 * r * g[lane] * siluf(g0);
    y[(size_t)t * D + 512 + h * GV + 64 + lane] = o1 * r * g[64 + lane] * siluf(g1);
}

__device__ __forceinline__ void route_token(const float* logits, const float* __restrict__ rbias, int* top_e, float* top_w, int* top_pos, int* counts, int t, int lane) {
    const float4 lg = ((const float4*)(logits + (size_t)t * NE))[lane];
    const float4 rb = ((const float4*)rbias)[lane];
    float sc[4] = {1.f / (1.f + expf(-lg.x)), 1.f / (1.f + expf(-lg.y)), 1.f / (1.f + expf(-lg.z)), 1.f / (1.f + expf(-lg.w))};
    float bv[4] = {sc[0] + rb.x, sc[1] + rb.y, sc[2] + rb.z, sc[3] + rb.w};
    float m1 = fmaxf(bv[0], bv[1]), m2 = fminf(bv[0], bv[1]);
    { const float a = fmaxf(bv[2], bv[3]), c = fminf(bv[2], bv[3]); const float n1 = fmaxf(m1, a); m2 = fmaxf(fminf(m1, a), fmaxf(m2, c)); m1 = n1; }
    for (int o = 1; o < 8; o <<= 1) { const float p1 = __shfl_xor(m1, o), p2 = __shfl_xor(m2, o); const float n1 = fmaxf(m1, p1); m2 = fmaxf(fminf(m1, p1), fmaxf(m2, p2)); m1 = n1; }
    const float gs = m1 + m2;
    const int myg = lane >> 3;
    int rank = 0;
#pragma unroll
    for (int g2 = 0; g2 < NG; ++g2) { const float og = __shfl(gs, g2 * 8); if (og > gs || (og == gs && g2 < myg)) ++rank; }
    const bool sel = rank < 4;
    float mv[4];
#pragma unroll
    for (int i = 0; i < 4; ++i) mv[i] = sel ? bv[i] : -INFINITY;
    int we[TOPK]; float ws[TOPK]; float wsum = 0.f;
#pragma unroll
    for (int k = 0; k < TOPK; ++k) {
        float bvv = mv[0]; int bi = 0;
#pragma unroll
        for (int i = 1; i < 4; ++i) if (mv[i] > bvv) { bvv = mv[i]; bi = i; }
        int gi = lane * 4 + bi;
        for (int o = 32; o > 0; o >>= 1) { const float ov = __shfl_xor(bvv, o); const int oi = __shfl_xor(gi, o); if (ov > bvv || (ov == bvv && oi < gi)) { bvv = ov; gi = oi; } }
        const int ol = gi >> 2, oi = gi & 3;
        const float s_own = (oi == 0) ? sc[0] : (oi == 1) ? sc[1] : (oi == 2) ? sc[2] : sc[3];
        const float sw = __shfl(s_own, ol);
        if (lane == ol) { if (oi == 0) mv[0] = -INFINITY; else if (oi == 1) mv[1] = -INFINITY; else if (oi == 2) mv[2] = -INFINITY; else mv[3] = -INFINITY; }
        we[k] = gi; ws[k] = sw; wsum += sw;
    }
    if (lane == 0) {
        const float inv = 2.5f / wsum;
#pragma unroll
        for (int k = 0; k < TOPK; ++k) {
            top_e[t * TOPK + k] = we[k]; top_w[t * TOPK + k] = ws[k] * inv;
            top_pos[t * TOPK + k] = atomicAdd(&counts[we[k]], 1);
        }
    }
}

__device__ __forceinline__ void moe_offsets(const int* counts, int* off, int* blk_exp, int* nblk, int lane) {
    int pc[4], st[4]; int tot = 0;
#pragma unroll
    for (int i = 0; i < 4; ++i) { pc[i] = (counts[lane * 4 + i] + PADR - 1) / PADR * PADR; st[i] = tot; tot += pc[i]; }
    int inc = tot;
    for (int o = 1; o < 64; o <<= 1) { const int n = __shfl_up(inc, o); if (lane >= o) inc += n; }
    const int base = inc - tot;
#pragma unroll
    for (int i = 0; i < 4; ++i) { const int start = base + st[i]; off[lane * 4 + i] = start; for (int k = start / PADR; k < (start + pc[i]) / PADR; ++k) blk_exp[k] = lane * 4 + i; }
    if (lane == 63) nblk[0] = inc / PADR;
}

__device__ __forceinline__ void moe_scatter(const int* top_e, const float* top_w, const int* top_pos, const int* off, int* row_tok, float* row_gate, int* slot_of, int a) {
    const int slot = off[top_e[a]] + top_pos[a];
    row_tok[slot] = a / TOPK; row_gate[slot] = top_w[a]; slot_of[a] = slot;
}

__device__ __forceinline__ void moe_hidden(const float* h1, const float* __restrict__ wg, const float* __restrict__ wu, const int* row_tok, const float* row_gate, const int* blk_exp, const int* nblk,
                                           float* hidden, int g16, int j, float* sh) {
    const bool active = g16 * 16 < nblk[0] * PADR;
    float (*xs)[D] = (float (*)[D])sh;
    __syncthreads();
    if (active) for (int r = 0; r < 16; ++r) { const int tok = row_tok[g16 * 16 + r]; ((float4*)xs[r])[j] = ((const float4*)(h1 + (size_t)tok * D))[j]; }
    __syncthreads();
    if (!active) return;
    const int e = blk_exp[(g16 * 16) / PADR];
    float ag[16], au[16];
#pragma unroll
    for (int r = 0; r < 16; ++r) { ag[r] = 0.f; au[r] = 0.f; }
    const float* wgp = wg + (size_t)e * D * ED + j; const float* wup = wu + (size_t)e * D * ED + j;
    for (int d = 0; d < D; d += 4) {
        const float g0 = wgp[(size_t)(d + 0) * ED], g1 = wgp[(size_t)(d + 1) * ED], g2 = wgp[(size_t)(d + 2) * ED], g3 = wgp[(size_t)(d + 3) * ED];
        const float u0 = wup[(size_t)(d + 0) * ED], u1 = wup[(size_t)(d + 1) * ED], u2 = wup[(size_t)(d + 2) * ED], u3 = wup[(size_t)(d + 3) * ED];
#pragma unroll
        for (int r = 0; r < 16; ++r) { const float4 x = *(const float4*)&xs[r][d];
            ag[r] += x.x * g0 + x.y * g1 + x.z * g2 + x.w * g3; au[r] += x.x * u0 + x.y * u1 + x.z * u2 + x.w * u3; }
    }
#pragma unroll
    for (int r = 0; r < 16; ++r) hidden[(size_t)(g16 * 16 + r) * ED + j] = row_gate[g16 * 16 + r] * siluf(ag[r]) * au[r];
}

__device__ __forceinline__ void moe_down(const float* hidden, const float* __restrict__ wd, const int* top_e, const int* slot_of, float* ffn, int t, int i, float* sh) {
    float4 acc = ((float4*)(ffn + (size_t)t * D))[i];
    for (int k = 0; k < TOPK; ++k) {
        const int e = top_e[t * TOPK + k], slot = slot_of[t * TOPK + k];
        __syncthreads();
        sh[i] = hidden[(size_t)slot * ED + i];
        __syncthreads();
        const float4* wp = (const float4*)(wd + (size_t)e * ED * D) + i;
        for (int j = 0; j < ED; ++j) { const float4 w = wp[(size_t)j * (D / 4)]; const float hv = sh[j]; acc.x += hv * w.x; acc.y += hv * w.y; acc.z += hv * w.z; acc.w += hv * w.w; }
    }
    ((float4*)(ffn + (size_t)t * D))[i] = acc;
}
}
#include <hip/hip_bf16.h>
#include <cmath>
namespace attn_body {
using bf16=__hip_bfloat16;
using bf16x8=__attribute__((ext_vector_type(8)))short;
using s16x4=__attribute__((ext_vector_type(4)))short;
using f32x16=__attribute__((ext_vector_type(16)))float;
using u32x4=__attribute__((ext_vector_type(4)))unsigned;
constexpr int BATCH=8,NHEAD=8,SEQ=4096,D=64,DM=3072,OPITCH=1024;
constexpr int NW=8,QBLK=32,QB=QBLK*NW,KVBLK=64,NQB=SEQ/QB;
constexpr int ATTN_PITCH=DM, ATTN_UNIT_ROWS=QB;
__device__ __forceinline__ int crow(int r,int hi){return (r&3)+8*(r>>2)+4*hi;}
#define SBAR() __builtin_amdgcn_sched_barrier(0)
__device__ __forceinline__ void cmask(f32x16&p0,f32x16&p1,int jb,int qrel,int hi){
  const float NEG=-INFINITY; int kb=64*jb+4*hi;
  #pragma unroll
  for(int r=0;r<16;++r){int kv=kb+(r&3)+8*(r>>2); if(kv>qrel)p0[r]=NEG; if(kv+32>qrel)p1[r]=NEG;}
}

constexpr int NSLOT=3, SLOTB=8192;
constexpr int LDS_K=0, LDS_V=NSLOT*SLOTB, LDS_WS=2*NSLOT*SLOTB, LDS_OST=LDS_WS+NW*64*4, LDS_KB=LDS_OST+NW*4096, LDS_BYTES=LDS_KB+(SEQ+2)*8;
constexpr float C2=0.125f*1.4426950408889634f;
__device__ __forceinline__ void glds16(const void*gsrc,unsigned lds_dst){unsigned keep;
  asm volatile("s_mov_b32 %0, m0\n\ts_mov_b32 m0, %2\n\ts_nop 0\n\tglobal_load_lds_dwordx4 %1, off\n\ts_mov_b32 m0, %0":"=&s"(keep):"v"(gsrc),"s"(lds_dst):"memory");}
__device__ __forceinline__ float max3f(float a,float b,float c){float r;asm("v_max3_f32 %0, %1, %2, %3":"=v"(r):"v"(a),"v"(b),"v"(c));return r;}
__device__ __forceinline__ float max2f(float a,float b){float r;asm("v_max_f32_e32 %0, %1, %2":"=v"(r):"v"(a),"v"(b));return r;}
__device__ __forceinline__ float fadd_s(float a,float b){float r;asm("v_add_f32_e32 %0, %1, %2":"=v"(r):"v"(a),"v"(b));return r;}
__device__ __forceinline__ float fsub_s(float a,float b){float r;asm("v_sub_f32_e32 %0, %1, %2":"=v"(r):"v"(a),"v"(b));return r;}
typedef float f32x2_t __attribute__((ext_vector_type(2))); typedef float f32x4_t __attribute__((ext_vector_type(4))); typedef __bf16 bf16x2_t __attribute__((ext_vector_type(2)));
__device__ __forceinline__ unsigned cvtpk_s(float lo,float hi){f32x2_t v={lo,hi};bf16x2_t b=__builtin_convertvector(v,bf16x2_t);return __builtin_bit_cast(unsigned,b);}
#define WAIT_BAR(N) asm volatile("s_waitcnt vmcnt(" #N ") lgkmcnt(0)\n\ts_barrier":::"memory")

__device__ __forceinline__ void split3(float b,unsigned&h,unsigned&m,unsigned&l){
  h=cvtpk_s(b,0.f)&0xffffu; const float r1=b-__uint_as_float(h<<16);
  m=cvtpk_s(r1,0.f)&0xffffu; const float r2=r1-__uint_as_float(m<<16);
  l=cvtpk_s(r2,0.f)&0xffffu; }
__device__ __forceinline__ bf16x8 kbias_frag(float b,int hi){unsigned h,m,l;split3(b,h,m,l);u32x4 w;w.x=h|(m<<16);w.y=l|0x3F800000u;w.z=0x3F803F80u;w.w=0u;if(hi){w.x=0u;w.y=0u;w.z=0u;}return __builtin_bit_cast(bf16x8,w);}
__device__ __forceinline__ bf16x8 qref_frag(float x,int hi){unsigned h,m,l;split3(x,h,m,l);u32x4 w;w.x=0x3F803F80u;w.y=0x3F80u|(h<<16);w.z=m|(l<<16);w.w=0u;if(hi){w.x=0u;w.y=0u;w.z=0u;}return __builtin_bit_cast(bf16x8,w);}
typedef unsigned u32x2_t __attribute__((ext_vector_type(2)));
__device__ __forceinline__ bf16x8 mkfrag(u32x2_t e,unsigned zc){u32x4 w;w.x=e.x;w.y=e.y;w.z=zc;w.w=0u;return __builtin_bit_cast(bf16x8,w);}
__device__ __forceinline__ void fox_bias_table(int b,int h,const float*LF,char*shm){
  int tid_=threadIdx.x; asm volatile("":"+v"(tid_)); const int tid=tid_,lane=tid&63,wid=__builtin_amdgcn_readfirstlane(tid>>6);
  const float*lf=LF+((long)b*NHEAD+h)*SEQ; float*wt=(float*)(shm+LDS_WS); u32x2_t*KB8=(u32x2_t*)(shm+LDS_KB);
  f32x4_t va=*(const f32x4_t*)(lf+8*tid),vb=*(const f32x4_t*)(lf+8*tid+4);
  va[1]+=va[0];va[2]+=va[1];va[3]+=va[2];vb[0]+=va[3];vb[1]+=vb[0];vb[2]+=vb[1];vb[3]+=vb[2];
  const float tot=vb[3]; float inc=tot;
  #pragma unroll
  for(int o_=1;o_<64;o_<<=1){const float nn=__shfl_up(inc,o_);if(lane>=o_)inc+=nn;}
  __syncthreads();
  if(lane==63)wt[wid*64]=inc;
  __syncthreads();
  float base=inc-tot;
  #pragma unroll
  for(int w_=0;w_<NW;++w_){const float x_=wt[w_*64]; if(w_<wid)base+=x_;}
  const float cv[8]={va[0]+base,va[1]+base,va[2]+base,va[3]+base,vb[0]+base,vb[1]+base,vb[2]+base,vb[3]+base};
  #pragma unroll
  for(int j=0;j<8;++j){unsigned hh,mm,ll;split3(-cv[j],hh,mm,ll);KB8[8*tid+j]=(u32x2_t){hh|(mm<<16),ll|0x3F800000u};}
  if(tid==0){KB8[SEQ]=(u32x2_t){0u,0u};KB8[SEQ+1]=(u32x2_t){0u,0u};}
  __syncthreads();
}
__device__ __forceinline__ void qkt(f32x16&p0,f32x16&p1,const char*Kslot,const bf16x8*qr,bf16x8 kb0,bf16x8 kb1,bf16x8 qx,int r32,int hi){
  const f32x16 negm=f32x16{};
  const char*kb=Kslot+hi*1024+r32*16;
  #pragma unroll
  for(int d0=0;d0<4;++d0){
    const bf16x8 b0=*reinterpret_cast<const bf16x8*>(kb+d0*2048);
    const bf16x8 b1=*reinterpret_cast<const bf16x8*>(kb+d0*2048+512);
    if(d0==0){p0=__builtin_amdgcn_mfma_f32_32x32x16_bf16(b0,qr[0],negm,0,0,0);p1=__builtin_amdgcn_mfma_f32_32x32x16_bf16(b1,qr[0],negm,0,0,0);}
    else{p0=__builtin_amdgcn_mfma_f32_32x32x16_bf16(b0,qr[d0],p0,0,0,0);p1=__builtin_amdgcn_mfma_f32_32x32x16_bf16(b1,qr[d0],p1,0,0,0);}}
  p0=__builtin_amdgcn_mfma_f32_32x32x16_bf16(kb0,qx,p0,0,0,0);p1=__builtin_amdgcn_mfma_f32_32x32x16_bf16(kb1,qx,p1,0,0,0);
}
typedef __attribute__((address_space(3))) const char* lds_cptr;
typedef short v4i16_t __attribute__((ext_vector_type(4)));
__device__ __forceinline__ void kload8(bf16x8*kf,lds_cptr kp){
  kf[0]=*(const __attribute__((address_space(3))) bf16x8*)(kp);      kf[1]=*(const __attribute__((address_space(3))) bf16x8*)(kp+512);
  kf[2]=*(const __attribute__((address_space(3))) bf16x8*)(kp+2048); kf[3]=*(const __attribute__((address_space(3))) bf16x8*)(kp+2560);
  kf[4]=*(const __attribute__((address_space(3))) bf16x8*)(kp+4096); kf[5]=*(const __attribute__((address_space(3))) bf16x8*)(kp+4608);
  kf[6]=*(const __attribute__((address_space(3))) bf16x8*)(kp+6144); kf[7]=*(const __attribute__((address_space(3))) bf16x8*)(kp+6656);
}
__device__ __forceinline__ void kload2(bf16x8*kf,lds_cptr kp,int j){ kf[2*j]=*(const __attribute__((address_space(3))) bf16x8*)(kp+j*2048); kf[2*j+1]=*(const __attribute__((address_space(3))) bf16x8*)(kp+j*2048+512); }
__device__ __forceinline__ s16x4 vtr(lds_cptr p){ return __builtin_bit_cast(s16x4,__builtin_amdgcn_ds_read_tr16_b64_v4i16((__attribute__((address_space(3))) v4i16_t*)p)); }
__device__ __forceinline__ float rowmax(const f32x16&p0,const f32x16&p1){
  float a=max3f(p0[0],p0[1],p1[0]),b=max3f(p0[2],p0[3],p1[1]);a=max3f(a,p1[2],p1[3]);
  #pragma unroll
  for(int r=4;r<16;r+=4){a=max3f(a,p0[r],p0[r+1]);b=max3f(b,p0[r+2],p0[r+3]);a=max3f(a,p1[r],p1[r+1]);b=max3f(b,p1[r+2],p1[r+3]);}
  const float m=max2f(a,b);
  auto rr=__builtin_amdgcn_permlane32_swap(__float_as_uint(m),__float_as_uint(m),false,false);
  return max2f(__uint_as_float(rr[0]),__uint_as_float(rr[1]));
}
__device__ __forceinline__ void pv(f32x16*o,int vb,bf16x8 pa0,bf16x8 pa1,bf16x8 pa2,bf16x8 pa3){
  #pragma unroll
  for(int d0=0;d0<2;++d0){s16x4 lo[4],hi[4];
    #pragma unroll
    for(int ks=0;ks<4;++ks){
      asm volatile("ds_read_b64_tr_b16 %0,%1 offset:%c2":"=&v"(lo[ks]):"v"(vb),"i"(d0*4096+ks*1024):"memory");
      asm volatile("ds_read_b64_tr_b16 %0,%1 offset:%c2":"=&v"(hi[ks]):"v"(vb),"i"(d0*4096+ks*1024+512):"memory");}
    asm volatile("s_waitcnt lgkmcnt(0)":::"memory");SBAR();
    #define PK(k) (bf16x8){lo[k][0],lo[k][1],lo[k][2],lo[k][3],hi[k][0],hi[k][1],hi[k][2],hi[k][3]}
    o[d0]=__builtin_amdgcn_mfma_f32_32x32x16_bf16(pa0,PK(0),o[d0],0,0,0);
    o[d0]=__builtin_amdgcn_mfma_f32_32x32x16_bf16(pa1,PK(1),o[d0],0,0,0);
    o[d0]=__builtin_amdgcn_mfma_f32_32x32x16_bf16(pa2,PK(2),o[d0],0,0,0);
    o[d0]=__builtin_amdgcn_mfma_f32_32x32x16_bf16(pa3,PK(3),o[d0],0,0,0);
    #undef PK
  }
}

#ifndef ATTN_STORE16
#define ATTN_STORE16(p,v) (*(u32x4*)(p)=(v))
#endif
template<int THRL> __device__ __forceinline__ void attn_unit(int b,int h,int qb,const bf16*Q,const bf16* K,const bf16* V,bf16*O,const float*LF,const unsigned*NRM,char*shm){
  int tid_=threadIdx.x; asm volatile("":"+v"(tid_));
  const int tid=tid_,lane=tid&63,r32=lane&31,hi=lane>>5; const int wid=__builtin_amdgcn_readfirstlane(tid>>6);
  const long rowbase=(long)b*SEQ; const int q0=qb*QB;
  const char*KBt0=shm+LDS_KB;
  int t0;
  { const int NT0=(q0+QB)/KVBLK; const unsigned*nr=NRM+(b*NHEAD+h)*4;
    const float qn2=__uint_as_float(nr[0])+__uint_as_float(nr[1]), kn2=__uint_as_float(nr[2])+__uint_as_float(nr[3]);
    const float thr=-(50.f+2.04f*sqrtf(qn2*kn2));
    const u32x2_t eq0=*(const u32x2_t*)(KBt0+(unsigned)q0*8u); const float bq0=__uint_as_float(eq0.x<<16)+__uint_as_float(eq0.x&0xffff0000u)+__uint_as_float(eq0.y<<16);
    bool ok=(2*lane<=NT0-4);
    if(ok&&lane>0){ const u32x2_t el=*(const u32x2_t*)(KBt0+(unsigned)(128*lane-1)*8u); const float bl=__uint_as_float(el.x<<16)+__uint_as_float(el.x&0xffff0000u)+__uint_as_float(el.y<<16); ok=(bl-bq0<thr); }
    const unsigned long long mk=__ballot(ok); const unsigned long long low=~mk; const int cnt=(low==0ull)?64:__builtin_ctzll(low);
    t0=__builtin_amdgcn_readfirstlane(2*(cnt-1)); }
  const char*KBt=KBt0+(hi?0:t0*512); const unsigned kb_o0=hi?(unsigned)SEQ*8u:(unsigned)r32*8u, kb_o1=hi?(unsigned)SEQ*8u:(unsigned)(r32+32)*8u, kb_str=hi?0u:512u, zc=hi?0u:0x3F803F80u;
  const bf16*Qw=Q+(rowbase+q0+wid*QBLK)*DM+h*D;
  const bf16*Kh=K+(rowbase+(long)t0*KVBLK)*DM+h*D,*Vh=V+(rowbase+(long)t0*KVBLK)*DM+h*D;
  const unsigned lds0=(unsigned)(uintptr_t)shm;
  float*wsf=(float*)(shm+LDS_WS)+wid*64;
  const bf16*ksrc=Kh+(long)lane*DM+wid*8;
  const bf16*vsrc=Vh+(long)(16*(wid&3)+(lane>>2))*DM+(wid>>2)*32+(lane&3)*8;
  const unsigned kdst=lds0+LDS_K+wid*1024, vdst=lds0+LDS_V+wid*1024;
  #define DMA_K(t,slot) glds16(ksrc+(long)(t)*KVBLK*DM,(unsigned)__builtin_amdgcn_readfirstlane(kdst+(slot)))
  #define DMA_V(t,slot) glds16(vsrc+(long)(t)*KVBLK*DM,(unsigned)__builtin_amdgcn_readfirstlane(vdst+(slot)))
  const int vb0=(int)(lds0+LDS_V)+((lane>>4)&1)*32+(lane&3)*8+(4*hi+((lane&15)>>2))*64;
  const char*Kbase=shm+LDS_K; bf16x8 kf[8];
  const lds_cptr shm3=(lds_cptr)shm; const lds_cptr kp0=shm3+LDS_K+hi*1024+r32*16; const lds_cptr vp0=shm3+LDS_V+((lane>>4)&1)*32+(lane&3)*8+(4*hi+((lane&15)>>2))*64;
  const int NT=(q0+QB)/KVBLK-t0;
  DMA_K(0,0);DMA_V(0,0);DMA_K(1,SLOTB);
  bf16x8 qr[4];
  #pragma unroll
  for(int d0=0;d0<4;++d0)qr[d0]=*reinterpret_cast<const bf16x8*>(&Qw[(long)r32*DM+d0*16+hi*8]);
  float mhat; { const u32x2_t eq=*(const u32x2_t*)(KBt0+(unsigned)(q0+wid*QBLK+r32)*8u); mhat=__uint_as_float(eq.x<<16)+__uint_as_float(eq.x&0xffff0000u)+__uint_as_float(eq.y<<16); }
  float l_reg=0.f;f32x16 o[2];o[0]=f32x16{};o[1]=f32x16{};const f32x16 negm=f32x16{};
  bf16x8 qx=qref_frag(-mhat,hi);
  const int qrel=wid*QBLK+r32;
  #define CMASK(P0,P1,t) do{int jb_=(t)-(NT-4); if(jb_>=0)cmask(P0,P1,jb_,qrel,hi);}while(0)
  bool resc=false;
  #define START(P0,P1) do{ const float rm=rowmax(P0,P1); resc=false; \
    { const float dl=__builtin_fmaxf(rm,0.f); mhat=fadd_s(mhat,dl); \
      _Pragma("unroll") for(int r=0;r<16;++r){P0[r]=fsub_s(P0[r],dl);P1[r]=fsub_s(P1[r],dl);} \
      qx=qref_frag(-mhat,hi); } \
    _Pragma("unroll") for(int r=0;r<16;++r)P0[r]=__builtin_amdgcn_exp2f(P0[r]); }while(0)
  #define RESC() do{ if(resc){ asm volatile("s_waitcnt lgkmcnt(0)":::"memory"); \
      _Pragma("unroll") for(int d_=0;d_<2;++d_) _Pragma("unroll") for(int r=0;r<16;++r)o[d_][r]*=wsf[crow(r,hi)]; } }while(0)
  f32x16 pA0,pA1,pB0,pB1;
  int sl_prev=0,sl_cur=0,sl_next=SLOTB;
  #define ROT() do{sl_prev=sl_cur;sl_cur=sl_next;sl_next=(sl_next==(NSLOT-1)*SLOTB)?0:sl_next+SLOTB;}while(0)
  DMA_K(2,2*SLOTB);
  WAIT_BAR(3);
  qkt(pA0,pA1,Kbase,qr,mkfrag(*(const u32x2_t*)(KBt+kb_o0),zc),mkfrag(*(const u32x2_t*)(KBt+kb_o1),zc),qx,r32,hi);asm volatile("s_nop 15\n\ts_nop 7":"+v"(pA0),"+v"(pA1));CMASK(pA0,pA1,0);
  START(pA0,pA1);
  _Pragma("unroll") for(int r=0;r<16;++r)pA1[r]=__builtin_amdgcn_exp2f(pA1[r]);
  WAIT_BAR(0);
  DMA_K(3,0);DMA_V(1,SLOTB);
  ROT();
  kload8(kf,kp0+sl_cur);
  WAIT_BAR(2);
  s16x4 vlo[8],vhi[8]; u32x4 pw0,pw1,pw2,pw3;
  #define PKW(P,B) cvtpk_s(P[B],P[B+1])
  #define PAF(k) __builtin_bit_cast(bf16x8,pw##k)
  #define VFR(i) (bf16x8){vlo[i][0],vlo[i][1],vlo[i][2],vlo[i][3],vhi[i][0],vhi[i][1],vhi[i][2],vhi[i][3]}
  #define PIN(x) asm volatile("":"+v"(x))
  #define MX3(a,b,c) __builtin_fmaxf(__builtin_fmaxf((a),(b)),(c))
  #define GAPA(MF,A0,A1,A2,A3,W0,W1,PW) do{ MF; sacc+=A0; sacc+=A1; sacc+=A2; sacc+=A3; PIN(sacc); W0; W1; PIN(PW); SBAR(); }while(0)
  #define EX(v) __builtin_amdgcn_exp2f(v)
  #define GAPB(MF,X,B) do{ MF; X[B]=EX(X[B]); X[B+1]=EX(X[B+1]); X[B+2]=EX(X[B+2]); X[B+3]=EX(X[B+3]); PIN(X); SBAR(); }while(0)
  #define VRD(i) do{ vlo[i]=vtr(vp_+(((i)>>2)*4096+((i)&3)*1024)); vhi[i]=vtr(vp_+(((i)>>2)*4096+((i)&3)*1024+512)); }while(0)
  #define KRD(G,j) do{ if(G){ kload2(kf,kp0+sl_next,j); SBAR(); } }while(0)
  #define STEP(C0,C1,P0,P1,t,GK,GV,GL) do{ SBAR(); \
    const lds_cptr vp_=vp0+sl_prev; const u32x2_t e0_=*(const u32x2_t*)(KBt+kb_o0+(unsigned)(t)*kb_str),e1_=*(const u32x2_t*)(KBt+kb_o1+(unsigned)(t)*kb_str); \
    VRD(0); SBAR(); float sacc=(P0[0]+P0[1]); \
    GAPA(C0=__builtin_amdgcn_mfma_f32_32x32x16_bf16(kf[0],qr[0],negm,0,0,0), P0[2],P0[3],P0[4],P0[5],     pw0[0]=PKW(P0,0), pw0[1]=PKW(P0,2), pw0); \
    VRD(4); SBAR(); GAPA(C1=__builtin_amdgcn_mfma_f32_32x32x16_bf16(kf[1],qr[0],negm,0,0,0), P0[6],P0[7],P0[8],P0[9],     pw0[2]=PKW(P0,4), pw0[3]=PKW(P0,6), pw0); \
    VRD(1); SBAR(); GAPA(C0=__builtin_amdgcn_mfma_f32_32x32x16_bf16(kf[2],qr[1],C0,0,0,0),   P0[10],P0[11],P0[12],P0[13], pw1[0]=PKW(P0,8), pw1[1]=PKW(P0,10), pw1); \
    VRD(5); SBAR(); GAPA(C1=__builtin_amdgcn_mfma_f32_32x32x16_bf16(kf[3],qr[1],C1,0,0,0),   P0[14],P0[15],P1[0],P1[1],   pw1[2]=PKW(P0,12),pw1[3]=PKW(P0,14), pw1); \
    VRD(2); SBAR(); GAPA(C0=__builtin_amdgcn_mfma_f32_32x32x16_bf16(kf[4],qr[2],C0,0,0,0),   P1[2],P1[3],P1[4],P1[5],     pw2[0]=PKW(P1,0), pw2[1]=PKW(P1,2), pw2); \
    VRD(6); SBAR(); GAPA(C1=__builtin_amdgcn_mfma_f32_32x32x16_bf16(kf[5],qr[2],C1,0,0,0),   P1[6],P1[7],P1[8],P1[9],     pw2[2]=PKW(P1,4), pw2[3]=PKW(P1,6), pw2); \
    VRD(3); SBAR(); GAPA(C0=__builtin_amdgcn_mfma_f32_32x32x16_bf16(kf[6],qr[3],C0,0,0,0),   P1[10],P1[11],P1[12],P1[13], pw3[0]=PKW(P1,8), pw3[1]=PKW(P1,10), pw3); \
    VRD(7); SBAR(); GAPA(C1=__builtin_amdgcn_mfma_f32_32x32x16_bf16(kf[7],qr[3],C1,0,0,0),   P1[14],P1[15],0.f,0.f,       pw3[2]=PKW(P1,12),pw3[3]=PKW(P1,14), pw3); \
    { const bf16x8 kb0_=mkfrag(e0_,zc),kb1_=mkfrag(e1_,zc); C0=__builtin_amdgcn_mfma_f32_32x32x16_bf16(kb0_,qx,C0,0,0,0); C1=__builtin_amdgcn_mfma_f32_32x32x16_bf16(kb1_,qx,C1,0,0,0); } SBAR(); \
    l_reg+=sacc; \
    if(GK){DMA_K((t)+3,sl_cur);} if(GV){DMA_V((t)+1,sl_next);} \
    CMASK(C0,C1,t); \
    { float a=MX3(C0[0],C0[1],C1[0]),b=MX3(C0[2],C0[3],C1[1]); a=MX3(a,C1[2],C1[3]); \
      _Pragma("unroll") for(int r=4;r<16;r+=4){a=MX3(a,C0[r],C0[r+1]);b=MX3(b,C0[r+2],C0[r+3]);a=MX3(a,C1[r],C1[r+1]);b=MX3(b,C1[r+2],C1[r+3]);} \
      float rm=__builtin_fmaxf(a,b); { auto rr=__builtin_amdgcn_permlane32_swap(__float_as_uint(rm),__float_as_uint(rm),false,false); rm=__builtin_fmaxf(__uint_as_float(rr[0]),__uint_as_float(rr[1])); } \
      resc=false; \
      if(__builtin_expect(__any(rm>(float)THRL),0)){ const float dl=__builtin_fmaxf(rm,0.f); mhat+=dl; \
        _Pragma("unroll") for(int r=0;r<16;++r){C0[r]-=dl;C1[r]-=dl;} \
        qx=qref_frag(-mhat,hi); \
        const float f=__builtin_amdgcn_exp2f(-dl); l_reg*=f; if(hi==0)wsf[r32]=f; resc=true; } } \
    SBAR(); \
    GAPB(o[0]=__builtin_amdgcn_mfma_f32_32x32x16_bf16(PAF(0),VFR(0),o[0],0,0,0), C0,0); \
    GAPB(o[1]=__builtin_amdgcn_mfma_f32_32x32x16_bf16(PAF(0),VFR(4),o[1],0,0,0), C0,4); \
    KRD(GL,0); GAPB(o[0]=__builtin_amdgcn_mfma_f32_32x32x16_bf16(PAF(1),VFR(1),o[0],0,0,0), C0,8); \
    KRD(GL,1); GAPB(o[1]=__builtin_amdgcn_mfma_f32_32x32x16_bf16(PAF(1),VFR(5),o[1],0,0,0), C0,12); \
    KRD(GL,2); GAPB(o[0]=__builtin_amdgcn_mfma_f32_32x32x16_bf16(PAF(2),VFR(2),o[0],0,0,0), C1,0); \
    KRD(GL,3); GAPB(o[1]=__builtin_amdgcn_mfma_f32_32x32x16_bf16(PAF(2),VFR(6),o[1],0,0,0), C1,4); \
    GAPB(o[0]=__builtin_amdgcn_mfma_f32_32x32x16_bf16(PAF(3),VFR(3),o[0],0,0,0), C1,8); \
    GAPB(o[1]=__builtin_amdgcn_mfma_f32_32x32x16_bf16(PAF(3),VFR(7),o[1],0,0,0), C1,12); \
    }while(0)
  int t=1;
  #undef CMASK
  #define CMASK(P0,P1,t) do{}while(0)
  for(;t+5<NT;t+=2){
    STEP(pB0,pB1,pA0,pA1,t,true,true,true);     WAIT_BAR(2); RESC(); ROT();
    STEP(pA0,pA1,pB0,pB1,t+1,true,true,true);   WAIT_BAR(2); RESC(); ROT();
  }
  #undef CMASK
  #define CMASK(P0,P1,t) do{int jb_=(t)-(NT-4); if(jb_>=0)cmask(P0,P1,jb_,qrel,hi);}while(0)
  #define ENDW(tt) do{ if((tt)+3<NT){WAIT_BAR(2);} else if((tt)+2<NT){WAIT_BAR(1);} else {WAIT_BAR(0);} }while(0)
  for(;t+1<NT;t+=2){
    STEP(pB0,pB1,pA0,pA1,t,(t+3<NT),(t+1<NT),(t+1<NT));       ENDW(t);   RESC(); ROT();
    STEP(pA0,pA1,pB0,pB1,t+1,(t+4<NT),(t+2<NT),(t+2<NT));     ENDW(t+1); RESC(); ROT();
  }
  STEP(pB0,pB1,pA0,pA1,NT-1,false,false,false); RESC();
  { float sacc=pB0[0]+pB0[1]; _Pragma("unroll") for(int r=2;r<16;++r)sacc+=pB0[r]; _Pragma("unroll") for(int r=0;r<16;++r)sacc+=pB1[r]; l_reg+=sacc;
    pw0=(u32x4){PKW(pB0,0),PKW(pB0,2),PKW(pB0,4),PKW(pB0,6)};pw1=(u32x4){PKW(pB0,8),PKW(pB0,10),PKW(pB0,12),PKW(pB0,14)};pw2=(u32x4){PKW(pB1,0),PKW(pB1,2),PKW(pB1,4),PKW(pB1,6)};pw3=(u32x4){PKW(pB1,8),PKW(pB1,10),PKW(pB1,12),PKW(pB1,14)};
    SBAR(); pv(o,vb0+sl_cur,PAF(0),PAF(1),PAF(2),PAF(3)); }
  #undef PKW
  #undef PAF
  #undef VFR
  #undef PIN
  #undef MX3
  #undef GAPA
  #undef GAPB
  #undef EX
  #undef VRD
  #undef KRD
  #undef STEP
  #undef ENDW
  {auto rr=__builtin_amdgcn_permlane32_swap(__float_as_uint(l_reg),__float_as_uint(l_reg),false,false);l_reg=__uint_as_float(rr[0])+__uint_as_float(rr[1]);}
  if(hi==0)wsf[32+r32]=l_reg;asm volatile("s_waitcnt lgkmcnt(0)":::"memory");
  float rli[16];
  #pragma unroll
  for(int r=0;r<16;++r)rli[r]=__builtin_amdgcn_rcpf(wsf[32+crow(r,hi)]);
  bf16*Ow=O+(rowbase+q0+wid*QBLK)*OPITCH+h*D;
  { bf16*stg=(bf16*)(shm+LDS_OST)+wid*2048;
    #pragma unroll
    for(int r=0;r<16;++r){const int orow=crow(r,hi);
      #pragma unroll
      for(int d0=0;d0<2;++d0)stg[orow*64+d0*32+r32]=__float2bfloat16(o[d0][r]*rli[r]);}
    asm volatile("s_waitcnt lgkmcnt(0)":::"memory");
    #pragma unroll
    for(int i=0;i<4;++i){const int row=i*8+(lane>>3),ch=lane&7; const u32x4 v=*(const u32x4*)(stg+row*64+ch*8); ATTN_STORE16(Ow+(long)row*OPITCH+ch*8,v);} }
  asm volatile("s_waitcnt lgkmcnt(0)\n\ts_barrier":::"memory");
  #undef DMA_K
  #undef DMA_V
  #undef CMASK
  #undef START
  #undef RESC
  #undef ROT
}
constexpr int ATTN_LDS_BYTES=LDS_BYTES;
struct AttnTensors { const bf16* Q; const bf16* K; const bf16* V; bf16* O; const float* LF; const unsigned* NRM; };
struct AttnUnit { int bh; int qb; };
struct StaticOrder {
  int vcu,grid;
  __device__ __forceinline__ explicit StaticOrder(int grid_,int block):vcu((grid_%8==0)?(block%8)*(grid_/8)+block/8:block),grid(grid_){}
  __device__ __forceinline__ bool next(int i,AttnUnit&u)const{
    if(grid==256){ if(i>=4)return false; const int s=vcu&3; u.bh=vcu>>2; u.qb=(i==0)?s:(i==1)?7-s:(i==2)?8+s:15-s; return true; }
    const int L=i*grid+vcu; if(L>=BATCH*NHEAD*NQB)return false; u.bh=L/NQB; u.qb=L%NQB; return true; }
  __device__ __forceinline__ void a_ready(const AttnUnit&)const{}
  __device__ __forceinline__ void done(const AttnUnit&)const{}
};
template<class Sched,int THRL=8> __device__ __forceinline__ void attn_phase(char*lds,const AttnTensors&T,const Sched&S){
  AttnUnit u; int cur_bh=-1;
  for(int i=0;S.next(i,u);++i){ S.a_ready(u); if(u.bh!=cur_bh){ fox_bias_table(u.bh/NHEAD,u.bh%NHEAD,T.LF,lds); cur_bh=u.bh; }
    attn_unit<THRL>(u.bh/NHEAD,u.bh%NHEAD,u.qb,T.Q,T.K,T.V,T.O,T.LF,T.NRM,lds); S.done(u); }
}
template<int THRL=8> __device__ __forceinline__ void attn_phase_dyn(char*lds,const AttnTensors&T,unsigned*qhead,volatile int*slot){
  int cur_bh=-1; const int NU=BATCH*NHEAD*NQB;
  if(threadIdx.x==0) slot[0]=(int)__hip_atomic_fetch_add(qhead,1u,__ATOMIC_RELAXED,__HIP_MEMORY_SCOPE_AGENT);
  __syncthreads();
  int idx=__builtin_amdgcn_readfirstlane(slot[0]);
  while(idx<NU){
    __syncthreads();
    if(threadIdx.x==0) slot[0]=(int)__hip_atomic_fetch_add(qhead,1u,__ATOMIC_RELAXED,__HIP_MEMORY_SCOPE_AGENT);
    const int qb=NQB-1-idx/(BATCH*NHEAD), bh=idx%(BATCH*NHEAD);
    if(bh!=cur_bh){ fox_bias_table(bh/NHEAD,bh%NHEAD,T.LF,lds); cur_bh=bh; }
    attn_unit<THRL>(bh/NHEAD,bh%NHEAD,qb,T.Q,T.K,T.V,T.O,T.LF,T.NRM,lds);
    __syncthreads();
    idx=__builtin_amdgcn_readfirstlane(slot[0]);
  }
}
#undef SBAR
#undef WAIT_BAR
}
namespace fx {
using namespace nv;
typedef unsigned short bf16;
typedef unsigned v4u __attribute__((ext_vector_type(4)));
typedef float f32x4 __attribute__((ext_vector_type(4)));
constexpr float C2 = 0.125f * 1.4426950408889634f;
constexpr int NIN = 3328;
constexpr int QKVP = 3072;
constexpr int P_FQ = 0, P_FK = 512, P_FV = 1024, P_GQ = 1536, P_GK = 1792, P_GV = 2048, P_GR = 2560;
__device__ __forceinline__ int inproj_src(int d) {
    if (d < 1536) return d;
    if (d < 1792) return O_GQ + (d - 1536);
    if (d < 2048) return O_GK + (d - 1792);
    if (d < 2560) return O_GV + (d - 2048);
    if (d < 3072) return O_GR + (d - 2560);
    if (d < 3080) return O_FF + (d - 3072);
    if (d < 3096) return O_GA + (d - 3080);
    return -1;
}
__device__ __forceinline__ unsigned f2bf(float f) { unsigned u = __builtin_bit_cast(unsigned, f); return (u + 0x7fffu + ((u >> 16) & 1u)) >> 16; }
__device__ __forceinline__ unsigned pk2(float lo, float hi) { return f2bf(lo) | (f2bf(hi) << 16); }
__device__ __forceinline__ float bf2f(unsigned short h) { return __builtin_bit_cast(float, (unsigned)h << 16); }
__device__ __forceinline__ float wave_sum(float v) {
#pragma unroll
    for (int o = 1; o < 64; o <<= 1) v += __shfl_xor(v, o);
    return v;
}
#define FX_LDS_WAIT() asm volatile("s_waitcnt lgkmcnt(0)" ::: "memory")

template <class Map> __device__ __forceinline__ void transpose_item(const float* __restrict__ W, int K, int N, bf16* WT, LAS float* scr, int kb, int nb, int lane, Map srcmap) {
    const int k0 = 64 * kb, n0 = 32 * nb;
    const int src = srcmap(n0 + (lane & 31));
#pragma unroll 8
    for (int i = 0; i < 32; ++i) { const int kk = 2 * i + (lane >> 5); scr[kk * 33 + (lane & 31)] = (src >= 0) ? W[(size_t)(k0 + kk) * N + src] : 0.f; }
    FX_LDS_WAIT(); asm volatile("" ::: "memory");
    const int c = lane & 7;
#pragma unroll
    for (int j = 0; j < 4; ++j) { const int n = (lane >> 3) + 8 * j; const LAS float* s = scr + (8 * c) * 33 + n;
        v4u o; o.x = pk2(s[0 * 33], s[1 * 33]); o.y = pk2(s[2 * 33], s[3 * 33]); o.z = pk2(s[4 * 33], s[5 * 33]); o.w = pk2(s[6 * 33], s[7 * 33]);
        *(GAS v4u*)(WT + (size_t)(n0 + n) * K + k0 + 8 * c) = o; }
    FX_LDS_WAIT(); asm volatile("" ::: "memory");
}

__device__ __forceinline__ void ln_row_bf16(const float* xrow, const float* __restrict__ g, const float* __restrict__ b, bf16* orow, float* frow, float* st, int lane) {
    const GAS f32x4* xr = (const GAS f32x4*)xrow + lane;
    f32x4 v[4]; float s = 0.f;
#pragma unroll
    for (int j = 0; j < 4; ++j) { v[j] = xr[64 * j]; s += (v[j].x + v[j].y) + (v[j].z + v[j].w); }
    const float mean = wave_sum(s) * (1.f / D); float s2 = 0.f;
#pragma unroll
    for (int j = 0; j < 4; ++j) { v[j] = v[j] - mean; s2 += (v[j].x * v[j].x + v[j].y * v[j].y) + (v[j].z * v[j].z + v[j].w * v[j].w); }
    const float rstd = 1.f / sqrtf(wave_sum(s2) * (1.f / D) + LN_EPS);
    if (st && lane == 0) { st[0] = mean; st[1] = rstd; }
    GAS unsigned long long* o8 = (GAS unsigned long long*)orow + lane;
#pragma unroll
    for (int j = 0; j < 4; ++j) {
        const f32x4 gg = ((const f32x4*)g)[lane + 64 * j], bb = ((const f32x4*)b)[lane + 64 * j];
        const f32x4 o = v[j] * rstd * gg + bb;
        o8[64 * j] = (unsigned long long)pk2(o.x, o.y) | ((unsigned long long)pk2(o.z, o.w) << 32);
        if (frow) ((GAS f32x4*)frow)[lane + 64 * j] = o;
    }
}

struct CvItem { const float* W; bf16* WT; int N, K, k0, n0, s0; };
__device__ __forceinline__ void cv_load(const CvItem& it, f32x4 (&v)[8], int lane) {
    const float* p = it.W + (size_t)(it.k0 + (lane >> 3)) * it.N + it.s0 + 4 * (lane & 7);
#pragma unroll
    for (int i = 0; i < 8; ++i) v[i] = __builtin_nontemporal_load((const f32x4*)(p + (size_t)(8 * i) * it.N));
}
__device__ __forceinline__ void cv_finish(const CvItem& it, const f32x4 (&v)[8], LAS float* scr, int lane) {
    const int rr = lane >> 3, cq = lane & 7;
#pragma unroll
    for (int i = 0; i < 8; ++i) { LAS float* d = scr + (8 * i + rr) * 33 + 4 * cq; d[0] = v[i][0]; d[1] = v[i][1]; d[2] = v[i][2]; d[3] = v[i][3]; }
    FX_LDS_WAIT(); asm volatile("" ::: "memory");
    const int c = lane & 7;
#pragma unroll
    for (int j = 0; j < 4; ++j) { const int n = (lane >> 3) + 8 * j; const LAS float* s = scr + (8 * c) * 33 + n;
        v4u o; o.x = pk2(s[0 * 33], s[1 * 33]); o.y = pk2(s[2 * 33], s[3 * 33]); o.z = pk2(s[4 * 33], s[5 * 33]); o.w = pk2(s[6 * 33], s[7 * 33]);
        __builtin_nontemporal_store(o, (GAS v4u*)(it.WT + (size_t)(it.n0 + n) * it.K + it.k0 + 8 * c)); }
    FX_LDS_WAIT(); asm volatile("" ::: "memory");
}

template <int NR> __device__ __forceinline__ void ln_rows_bf16(const float* xrows, const float* __restrict__ g, const float* __restrict__ b, bf16* orows, int lane) {
    f32x4 v[NR][4];
#pragma unroll
    for (int r = 0; r < NR; ++r)
#pragma unroll
        for (int j = 0; j < 4; ++j) v[r][j] = ((const GAS f32x4*)(xrows + (size_t)r * D))[lane + 64 * j];
    f32x4 gg[4], bb[4];
#pragma unroll
    for (int j = 0; j < 4; ++j) { gg[j] = ((const f32x4*)g)[lane + 64 * j]; bb[j] = ((const f32x4*)b)[lane + 64 * j]; }
#pragma unroll
    for (int r = 0; r < NR; ++r) {
        float s = 0.f;
#pragma unroll
        for (int j = 0; j < 4; ++j) s += (v[r][j].x + v[r][j].y) + (v[r][j].z + v[r][j].w);
        const float mean = wave_sum(s) * (1.f / D); float s2 = 0.f;
#pragma unroll
        for (int j = 0; j < 4; ++j) { v[r][j] = v[r][j] - mean; s2 += (v[r][j].x * v[r][j].x + v[r][j].y * v[r][j].y) + (v[r][j].z * v[r][j].z + v[r][j].w * v[r][j].w); }
        const float rstd = 1.f / sqrtf(wave_sum(s2) * (1.f / D) + LN_EPS);
        GAS unsigned long long* o8 = (GAS unsigned long long*)(orows + (size_t)r * D) + lane;
#pragma unroll
        for (int j = 0; j < 4; ++j) { const f32x4 o = v[r][j] * rstd * gg[j] + bb[j];
            o8[64 * j] = (unsigned long long)pk2(o.x, o.y) | ((unsigned long long)pk2(o.z, o.w) << 32); }
    }
}

template <int NR> __device__ __forceinline__ void ln1_rows_bf16(const float* xrows, const float* st, const float* __restrict__ gi, const float* __restrict__ bi, const bf16* mixrows,
                                                               const float* __restrict__ g1, const float* __restrict__ b1, bf16* orows, float alpha, int lane) {
    f32x4 v[NR][4]; unsigned long long mx[NR][4]; float mean0[NR], rstd0[NR];
#pragma unroll
    for (int r = 0; r < NR; ++r) { mean0[r] = st[2 * r]; rstd0[r] = st[2 * r + 1];
#pragma unroll
        for (int j = 0; j < 4; ++j) { v[r][j] = ((const GAS f32x4*)(xrows + (size_t)r * D))[lane + 64 * j]; mx[r][j] = ((const GAS unsigned long long*)(mixrows + (size_t)r * D))[lane + 64 * j]; } }
    f32x4 gi4[4], bi4[4];
#pragma unroll
    for (int j = 0; j < 4; ++j) { gi4[j] = ((const f32x4*)gi)[lane + 64 * j] * alpha; bi4[j] = ((const f32x4*)bi)[lane + 64 * j] * alpha; }
#pragma unroll
    for (int r = 0; r < NR; ++r) {
        float s = 0.f;
#pragma unroll
        for (int j = 0; j < 4; ++j) { const unsigned lo = (unsigned)mx[r][j], hi = (unsigned)(mx[r][j] >> 32);
            f32x4 mv; mv.x = __builtin_bit_cast(float, lo << 16); mv.y = __builtin_bit_cast(float, lo & 0xffff0000u); mv.z = __builtin_bit_cast(float, hi << 16); mv.w = __builtin_bit_cast(float, hi & 0xffff0000u);
            v[r][j] = ((v[r][j] - mean0[r]) * rstd0[r]) * gi4[j] + bi4[j] + mv;
            s += (v[r][j].x + v[r][j].y) + (v[r][j].z + v[r][j].w); }
        const float mean = wave_sum(s) * (1.f / D); float s2 = 0.f;
#pragma unroll
        for (int j = 0; j < 4; ++j) { v[r][j] = v[r][j] - mean; s2 += (v[r][j].x * v[r][j].x + v[r][j].y * v[r][j].y) + (v[r][j].z * v[r][j].z + v[r][j].w * v[r][j].w); }
        const float rstd = 1.f / sqrtf(wave_sum(s2) * (1.f / D) + LN_EPS);
        GAS unsigned long long* o8 = (GAS unsigned long long*)(orows + (size_t)r * D) + lane;
#pragma unroll
        for (int j = 0; j < 4; ++j) { const f32x4 gg = ((const f32x4*)g1)[lane + 64 * j], bb = ((const f32x4*)b1)[lane + 64 * j]; const f32x4 o = v[r][j] * rstd * gg + bb;
            o8[64 * j] = (unsigned long long)pk2(o.x, o.y) | ((unsigned long long)pk2(o.z, o.w) << 32); }
    }
}
}

namespace pg8 {
struct EpiInProj {
    static constexpr bool PERM = true, AFTER_DRAIN = false;
    bf16_t* QKV; float* FG; float* LF; const float* bfg; unsigned* NRM;
    __device__ __forceinline__ void operator()(const f32x4 (&acc)[2][2][4][2], const Unit& u, int wr, int wc, int fr, int fq) const {
        const int row0 = u.pm * BM + wr * 64 + fr;
        if (u.pn < 12) {
            const float sc = (u.pn < 2) ? fx::C2 : 1.f;
            const int col0 = u.pn * BM + wc * 32 + 8 * fq;
            float nmax[2] = {0.f, 0.f};
#pragma unroll
            for (int ai = 0; ai < 2; ++ai)
#pragma unroll
                for (int m = 0; m < 4; ++m) { bf16_t* rowp = QKV + (size_t)(row0 + ai * HALF + m * 16) * fx::QKVP + col0;
#pragma unroll
                    for (int bj = 0; bj < 2; ++bj) { const f32x4 v0 = acc[ai][bj][m][0] * sc, v1 = acc[ai][bj][m][1] * sc;
                        u32x4 w; w.x = cvt_pk_bf16(v0[0], v0[1]); w.y = cvt_pk_bf16(v0[2], v0[3]); w.z = cvt_pk_bf16(v1[0], v1[1]); w.w = cvt_pk_bf16(v1[2], v1[3]);
                        *(u32x4*)(rowp + bj * HALF) = w;
                        if (u.pn < 4) { const f32x4 q0 = v0 * v0, q1 = v1 * v1; float s = (q0[0] + q0[1]) + (q0[2] + q0[3]) + (q1[0] + q1[1]) + (q1[2] + q1[3]);
                            s += __shfl_xor(s, 16); s += __shfl_xor(s, 32);
                            nmax[bj] = fmaxf(nmax[bj], s); } } }
            if (u.pn < 4) {
#pragma unroll
                for (int bj = 0; bj < 2; ++bj) { float s = nmax[bj];
#pragma unroll
                    for (int o = 1; o < 16; o <<= 1) s = fmaxf(s, __shfl_xor(s, o));
                    if (fr == 0 && fq == 0) { const int b = (u.pm * BM) >> 12, head = 4 * (u.pn & 1) + 2 * bj + (wc >> 1);
                        atomicMax(NRM + (b * 8 + head) * 4 + (u.pn >= 2 ? 2 : 0) + (wc & 1), __builtin_bit_cast(unsigned, s)); } }
            }
        } else if (wc == 0 && fq < 3) {
#pragma unroll
            for (int ai = 0; ai < 2; ++ai)
#pragma unroll
                for (int m = 0; m < 4; ++m) { const int row = row0 + ai * HALF + m * 16; float* p = FG + (size_t)row * 32 + 8 * fq;
                    *(f32x4*)p = acc[ai][0][m][0]; *(f32x4*)(p + 4) = acc[ai][0][m][1];
                    if (fq == 0) { const int b = row >> 12, s = row & 4095;
#pragma unroll
                        for (int n = 0; n < 2; ++n)
#pragma unroll
                            for (int i = 0; i < 4; ++i) { const int h = 4 * n + i; LF[(size_t)(b * 8 + h) * nv::S + s] = 1.4426950408889634f * nv::logsigmoidf(acc[ai][0][m][n][i] + bfg[h]); } } }
        }
    }
};
}
namespace gl {
using namespace nv;
typedef unsigned short bf16;
typedef short bf16x8 __attribute__((ext_vector_type(8)));
typedef float f32x4 __attribute__((ext_vector_type(4)));
typedef unsigned u32x4 __attribute__((ext_vector_type(4)));
typedef unsigned u32x2 __attribute__((ext_vector_type(2)));
constexpr int NCH = S / 64;
constexpr int NUNIT = B * GH * NCH;
constexpr int LS = 72;
constexpr int L_WGU = 0, L_BG = 4096, L_QP = 8192, L_KP = L_QP + 64 * LS * 2, L_KPT = L_KP + 64 * LS * 2, L_VT = L_KPT + 64 * LS * 2, L_PP = L_VT + 128 * LS * 2, L_WT = L_PP + 64 * LS * 2, L_END = L_WT + 2048;
static_assert(L_END <= 131072, "gla prep LDS");
constexpr int C_ST = 0, C_PART = 128 * LS * 2, C_END = C_PART + 2 * 8 * 64 * 4;
constexpr size_t QPG_B = 64 * 64 * 2, OI_B = 8 * 4 * 64 * 16, UU_B = OI_B, DEC_B = 256;

__device__ __forceinline__ unsigned pkbf(float lo, float hi) { typedef float f2 __attribute__((ext_vector_type(2))); typedef __bf16 b2 __attribute__((ext_vector_type(2))); f2 v = {lo, hi}; b2 r = __builtin_convertvector(v, b2); return __builtin_bit_cast(unsigned, r); }
__device__ __forceinline__ float bf2f(unsigned short h) { return __builtin_bit_cast(float, (unsigned)h << 16); }
__device__ __forceinline__ float bflo(unsigned w) { return __builtin_bit_cast(float, w << 16); }
__device__ __forceinline__ float bfhi(unsigned w) { return __builtin_bit_cast(float, w & 0xffff0000u); }
__device__ __forceinline__ float fast_logsig2(float x) { return -__builtin_amdgcn_logf(1.f + __builtin_amdgcn_exp2f(-1.4426950408889634f * x)); }

__device__ __forceinline__ void prep_unit(int unit, const bf16* QKV, const float* FG, const float* __restrict__ wgu, const float* __restrict__ bgate,
                                          unsigned char* QPG, unsigned char* OI, unsigned char* UU, float* DEC, unsigned char* lds, int& cur_h) {
    int tid_ = threadIdx.x; asm volatile("" : "+v"(tid_));
    const int tid = tid_, lane = tid & 63, wid = __builtin_amdgcn_readfirstlane(tid >> 6), l15 = lane & 15, g = lane >> 4;
    const int n = unit % NCH, bh = unit / NCH, h = bh % GH, b = bh / GH;
    const size_t row0 = (size_t)b * S + (size_t)n * 64;
    float* WGU = (float*)(lds + L_WGU); float* BG = (float*)(lds + L_BG); float* WT = (float*)(lds + L_WT);
    bf16* QP = (bf16*)(lds + L_QP); bf16* KP = (bf16*)(lds + L_KP); bf16* KPT = (bf16*)(lds + L_KPT); bf16* VT = (bf16*)(lds + L_VT); bf16* PP = (bf16*)(lds + L_PP);
    if (cur_h != h) { __syncthreads(); for (int i = tid; i < 16 * 64; i += 512) WGU[i] = wgu[(i >> 6) * 256 + h * 64 + (i & 63)]; if (tid < 64) BG[tid] = bgate[h * 64 + tid]; cur_h = h; __syncthreads(); }
    const int t = tid >> 3, oc = tid & 7, d0 = oc * 8;
    float la[8];
    { const float* gp = FG + (row0 + t) * 32 + 8;
      f32x4 ga4[4];
#pragma unroll
      for (int i = 0; i < 4; ++i) ga4[i] = *(const f32x4*)(gp + 4 * i);
#pragma unroll
      for (int j = 0; j < 8; ++j) la[j] = BG[d0 + j];
#pragma unroll
      for (int r = 0; r < 16; ++r) { const float gv = ga4[r >> 2][r & 3]; const f32x4 w0 = *(const f32x4*)(WGU + r * 64 + d0), w1 = *(const f32x4*)(WGU + r * 64 + d0 + 4);
#pragma unroll
          for (int j = 0; j < 4; ++j) { la[j] += gv * w0[j]; la[4 + j] += gv * w1[j]; } }
#pragma unroll
      for (int j = 0; j < 8; ++j) la[j] = fast_logsig2(la[j]) * (1.f / 16.f); }
    const u32x4 qv = *(const u32x4*)(QKV + (row0 + t) * fx::QKVP + fx::P_GQ + h * 64 + d0);
    const u32x4 kv = *(const u32x4*)(QKV + (row0 + t) * fx::QKVP + fx::P_GK + h * 64 + d0);
    const u32x4 vv0 = *(const u32x4*)(QKV + (row0 + t) * fx::QKVP + fx::P_GV + h * 128 + oc * 16);
    const u32x4 vv1 = *(const u32x4*)(QKV + (row0 + t) * fx::QKVP + fx::P_GV + h * 128 + oc * 16 + 8);
#pragma unroll
    for (int off = 8; off < 64; off <<= 1) {
#pragma unroll
        for (int j = 0; j < 8; ++j) { const float o = __shfl_up(la[j], off); if (lane >= off) la[j] += o; } }
    if (lane >= 56) {
#pragma unroll
        for (int j = 0; j < 8; ++j) WT[wid * 64 + d0 + j] = la[j]; }
    __syncthreads();
    float bl[8];
#pragma unroll
    for (int j = 0; j < 8; ++j) bl[j] = 0.f;
#pragma unroll
    for (int w = 0; w < 8; ++w) {
        const f32x4 a0 = *(const f32x4*)(WT + w * 64 + d0), a1 = *(const f32x4*)(WT + w * 64 + d0 + 4);
#pragma unroll
        for (int j = 0; j < 4; ++j) { bl[j] += a0[j]; bl[4 + j] += a1[j]; if (w < wid) { la[j] += a0[j]; la[4 + j] += a1[j]; } } }
    {
        const unsigned qw[4] = {qv.x, qv.y, qv.z, qv.w}, kw[4] = {kv.x, kv.y, kv.z, kv.w};
        float qf[8], kf[8];
#pragma unroll
        for (int i = 0; i < 4; ++i) { qf[2 * i] = bflo(qw[i]); qf[2 * i + 1] = bfhi(qw[i]); kf[2 * i] = bflo(kw[i]); kf[2 * i + 1] = bfhi(kw[i]); }
        float qp[8], kp[8], kpp[8];
#pragma unroll
        for (int j = 0; j < 8; ++j) { const float bb = la[j], bbl = bl[j];
            qp[j] = qf[j] * (0.125f * __builtin_amdgcn_exp2f(bb)); kp[j] = kf[j] * __builtin_amdgcn_exp2f(-bb); kpp[j] = kf[j] * __builtin_amdgcn_exp2f(bbl - bb); }
        u32x4 qo, ko; qo.x = pkbf(qp[0], qp[1]); qo.y = pkbf(qp[2], qp[3]); qo.z = pkbf(qp[4], qp[5]); qo.w = pkbf(qp[6], qp[7]);
        ko.x = pkbf(kp[0], kp[1]); ko.y = pkbf(kp[2], kp[3]); ko.z = pkbf(kp[4], kp[5]); ko.w = pkbf(kp[6], kp[7]);
        *(u32x4*)(QP + t * LS + d0) = qo; *(u32x4*)(KP + t * LS + d0) = ko;
        *(u32x4*)(QPG + (size_t)unit * QPG_B + (size_t)(t * 64 + d0) * 2) = qo;
#pragma unroll
        for (int j = 0; j < 8; ++j) KPT[(d0 + j) * LS + t] = (bf16)(pkbf(kpp[j], 0.f) & 0xffffu);
        const unsigned vw[8] = {vv0.x, vv0.y, vv0.z, vv0.w, vv1.x, vv1.y, vv1.z, vv1.w};
#pragma unroll
        for (int i = 0; i < 8; ++i) { VT[(oc * 16 + 2 * i) * LS + t] = (bf16)(vw[i] & 0xffffu); VT[(oc * 16 + 2 * i + 1) * LS + t] = (bf16)(vw[i] >> 16); }
        if (t == 0) {
#pragma unroll
            for (int j = 0; j < 8; ++j) DEC[(size_t)unit * 64 + d0 + j] = __builtin_amdgcn_exp2f(bl[j]); }
    }
    __syncthreads();
    { const int ti = wid >> 1;
#pragma unroll
      for (int q2 = 0; q2 < 2; ++q2) { const int sj = 2 * (wid & 1) + q2;
          f32x4 acc = {0.f, 0.f, 0.f, 0.f};
          if (sj <= ti) {
#pragma unroll
              for (int ks = 0; ks < 2; ++ks) { const bf16x8 a = *(const bf16x8*)(QP + (16 * ti + l15) * LS + 32 * ks + 8 * g), bb = *(const bf16x8*)(KP + (16 * sj + l15) * LS + 32 * ks + 8 * g);
                  acc = __builtin_amdgcn_mfma_f32_16x16x32_bf16(a, bb, acc, 0, 0, 0); }
              if (sj == ti) {
#pragma unroll
                  for (int r = 0; r < 4; ++r) if (l15 > 4 * g + r) acc[r] = 0.f; }
          }
#pragma unroll
          for (int r = 0; r < 4; ++r) PP[(16 * ti + 4 * g + r) * LS + 16 * sj + l15] = (bf16)(pkbf(acc[r], 0.f) & 0xffffu);
      } }
    __syncthreads();
    { bf16x8 vb[2];
#pragma unroll
      for (int ks = 0; ks < 2; ++ks) vb[ks] = *(const bf16x8*)(VT + (16 * wid + l15) * LS + 32 * ks + 8 * g);
#pragma unroll
      for (int m = 0; m < 4; ++m) { f32x4 acc = {0.f, 0.f, 0.f, 0.f};
#pragma unroll
          for (int ks = 0; ks < 2; ++ks) { const bf16x8 a = *(const bf16x8*)(PP + (16 * m + l15) * LS + 32 * ks + 8 * g); acc = __builtin_amdgcn_mfma_f32_16x16x32_bf16(a, vb[ks], acc, 0, 0, 0); }
          *(f32x4*)(OI + (size_t)unit * OI_B + (size_t)((wid * 4 + m) * 64 + lane) * 16) = acc; }
#pragma unroll
      for (int db = 0; db < 4; ++db) { f32x4 acc = {0.f, 0.f, 0.f, 0.f};
#pragma unroll
          for (int ks = 0; ks < 2; ++ks) { const bf16x8 a = *(const bf16x8*)(KPT + (16 * db + l15) * LS + 32 * ks + 8 * g); acc = __builtin_amdgcn_mfma_f32_16x16x32_bf16(a, vb[ks], acc, 0, 0, 0); }
          *(f32x4*)(UU + (size_t)unit * UU_B + (size_t)((wid * 4 + db) * 64 + lane) * 16) = acc; }
    }
}

constexpr int GS = 136;
constexpr int PO_GR = 0, PO_YT = 64 * GS * 2, PO_PART = 2 * 64 * GS * 2, PO_ST = PO_PART + 8 * 64 * 4, PO_END = PO_ST + 128 * LS * 2;
__device__ __forceinline__ void post_block(int u0, int NB, const bf16* QKV, const unsigned char* QPG, const unsigned char* OI, const unsigned char* UU, const float* DEC, const float* __restrict__ gnorm, bf16* Y, unsigned char* lds) {
    int tid_ = threadIdx.x; asm volatile("" : "+v"(tid_));
    const int tid = tid_, lane = tid & 63, wid = __builtin_amdgcn_readfirstlane(tid >> 6), l15 = lane & 15, g = lane >> 4;
    const int n0 = u0 % NCH, bh = u0 / NCH, h = bh % GH, b = bh / GH;
    bf16* GRs = (bf16*)(lds + PO_GR); bf16* YT = (bf16*)(lds + PO_YT); float* PART = (float*)(lds + PO_PART); bf16* ST = (bf16*)(lds + PO_ST);
    const int t = tid >> 3, oc = tid & 7, e = 16 * wid + l15;
    const float gn = gnorm[e];
    f32x4 Sa[4];
#pragma unroll
    for (int db = 0; db < 4; ++db) Sa[db] = (f32x4){0.f, 0.f, 0.f, 0.f};
    const size_t ub = (size_t)bh * NCH;
    for (int n = 0; n < n0; n += 4) {
        f32x4 Uf[4][4], dv[4][4];
#pragma unroll
        for (int j = 0; j < 4; ++j)
#pragma unroll
            for (int db = 0; db < 4; ++db) { Uf[j][db] = *(const f32x4*)(UU + (ub + n + j) * UU_B + (size_t)((wid * 4 + db) * 64 + lane) * 16); dv[j][db] = *(const f32x4*)(DEC + (ub + n + j) * 64 + 16 * db + 4 * g); }
#pragma unroll
        for (int j = 0; j < 4; ++j)
#pragma unroll
            for (int db = 0; db < 4; ++db) Sa[db] = dv[j][db] * Sa[db] + Uf[j][db];
    }
    for (int i = 0; i < NB; ++i) {
        const int unit = u0 + i; const size_t row0 = (size_t)b * S + (size_t)(n0 + i) * 64;
        const u32x4 g0 = *(const u32x4*)(QKV + (row0 + t) * fx::QKVP + fx::P_GR + h * 128 + oc * 16), g1 = *(const u32x4*)(QKV + (row0 + t) * fx::QKVP + fx::P_GR + h * 128 + oc * 16 + 8);
        f32x4 o[4], Uf[4], dv[4]; bf16x8 qa[4][2], sb[2];
#pragma unroll
        for (int m = 0; m < 4; ++m) { o[m] = *(const f32x4*)(OI + (size_t)unit * OI_B + (size_t)((wid * 4 + m) * 64 + lane) * 16);
            Uf[m] = *(const f32x4*)(UU + (size_t)unit * UU_B + (size_t)((wid * 4 + m) * 64 + lane) * 16); dv[m] = *(const f32x4*)(DEC + (size_t)unit * 64 + 16 * m + 4 * g);
#pragma unroll
            for (int ks = 0; ks < 2; ++ks) qa[m][ks] = *(const bf16x8*)(QPG + (size_t)unit * QPG_B + (size_t)((16 * m + l15) * 64 + 32 * ks + 8 * g) * 2); }
#pragma unroll
        for (int db = 0; db < 4; ++db) *(u32x2*)(ST + e * LS + 16 * db + 4 * g) = (u32x2){pkbf(Sa[db][0], Sa[db][1]), pkbf(Sa[db][2], Sa[db][3])};
#pragma unroll
        for (int ks = 0; ks < 2; ++ks) sb[ks] = *(const bf16x8*)(ST + e * LS + 32 * ks + 8 * g);
        *(u32x4*)(GRs + t * GS + oc * 16) = g0; *(u32x4*)(GRs + t * GS + oc * 16 + 8) = g1;
#pragma unroll
        for (int m = 0; m < 4; ++m)
#pragma unroll
            for (int ks = 0; ks < 2; ++ks) o[m] = __builtin_amdgcn_mfma_f32_16x16x32_bf16(qa[m][ks], sb[ks], o[m], 0, 0, 0);
#pragma unroll
        for (int m = 0; m < 4; ++m) { f32x4 q = o[m] * o[m];
#pragma unroll
            for (int off = 1; off < 16; off <<= 1) { q[0] += __shfl_xor(q[0], off); q[1] += __shfl_xor(q[1], off); q[2] += __shfl_xor(q[2], off); q[3] += __shfl_xor(q[3], off); }
            if (l15 == 0) *(f32x4*)(PART + wid * 64 + 16 * m + 4 * g) = q; }
#pragma unroll
        for (int db = 0; db < 4; ++db) Sa[db] = dv[db] * Sa[db] + Uf[db];
        __syncthreads();
#pragma unroll
        for (int m = 0; m < 4; ++m) { f32x4 tot = {0.f, 0.f, 0.f, 0.f};
#pragma unroll
            for (int w = 0; w < 8; ++w) tot += *(const f32x4*)(PART + w * 64 + 16 * m + 4 * g);
#pragma unroll
            for (int r = 0; r < 4; ++r) { const int tt = 16 * m + 4 * g + r; const float rs = rsqrtf(tot[r] * (1.f / GV) + LN_EPS); const float gr = bf2f(GRs[tt * GS + e]);
                const float v = o[m][r] * rs * gn * (gr * __builtin_amdgcn_rcpf(1.f + __builtin_amdgcn_exp2f(-1.4426950408889634f * gr)));
                YT[tt * GS + e] = (bf16)(pkbf(v, 0.f) & 0xffffu); } }
        __syncthreads();
        { const u32x4 y0 = *(const u32x4*)(YT + t * GS + oc * 16), y1 = *(const u32x4*)(YT + t * GS + oc * 16 + 8);
          *(u32x4*)(Y + (row0 + t) * D + 512 + h * GV + oc * 16) = y0; *(u32x4*)(Y + (row0 + t) * D + 512 + h * GV + oc * 16 + 8) = y1; }
        __syncthreads();
    }
}
}
namespace mo {
using namespace nv;
typedef unsigned short bf16;
typedef float f32x4 __attribute__((ext_vector_type(4)));
typedef unsigned u32x4 __attribute__((ext_vector_type(4)));
constexpr int CAP = 8192;
constexpr int NEX = NE + 1;
constexpr int YSH = T * TOPK;
constexpr int L_TB = 132096, L_YB = L_TB + 1040, L_CN = L_YB + 1040, L_UT = 138240, L_RG = 141312;
typedef LAS int* lint;


constexpr int I_EG = NEX * 256, I_ED = NEX * 128, I_EXP = I_EG + I_ED;
struct ExpW { const float* eg; const float* eu; const float* ed; const float* sg; const float* su; const float* sd; bf16* WegT; bf16* WedT; };
__device__ __forceinline__ void cv_decode(int r, const ExpW& X, fx::CvItem& I) {
    if (r < I_EG) { const int e = r >> 8, kb = (r >> 4) & 15, nb = r & 15, c = nb >> 3, sub = nb & 7;
        I.W = (e < NE) ? ((sub < 4 ? X.eg : X.eu) + (size_t)e * D * ED) : (sub < 4 ? X.sg : X.su); I.WT = X.WegT + (size_t)e * 512 * D; I.N = ED; I.K = D; I.k0 = 64 * kb; I.n0 = 32 * nb; I.s0 = 128 * c + 32 * (sub & 3); }
    else { r -= I_EG; const int e = r >> 7, kb = (r >> 5) & 3, nb = r & 31; I.W = (e < NE) ? (X.ed + (size_t)e * ED * D) : X.sd; I.WT = X.WedT + (size_t)e * D * ED; I.N = D; I.K = ED; I.k0 = 64 * kb; I.n0 = 32 * nb; I.s0 = 32 * nb; }
}
__device__ __forceinline__ void expert_conv(const ExpW& X, LAS float* scr, int it0, int step, int lane) {
    int it = it0; fx::CvItem cur, nx; fx::f32x4 v[8], w[8];
    if (it < I_EXP) { cv_decode(it, X, cur); fx::cv_load(cur, v, lane); }
    while (it < I_EXP) { const int itn = it + step; if (itn < I_EXP) { cv_decode(itn, X, nx); fx::cv_load(nx, w, lane); }
        fx::cv_finish(cur, v, scr, lane); cur = nx;
#pragma unroll
        for (int i = 0; i < 8; ++i) v[i] = w[i];
        it = itn; }
}

__device__ __forceinline__ void moe_tables(const int* counts, lint tb, lint yb, lint cn, int lane) {
    int c[4], nt[4]; int st = 0, sy = 0, pt[4], py[4];
#pragma unroll
    for (int i = 0; i < 4; ++i) { c[i] = counts[lane * 4 + i]; c[i] = c[i] > CAP ? CAP : c[i]; nt[i] = (c[i] + 255) >> 8; pt[i] = st; py[i] = sy; st += nt[i]; sy += c[i]; }
    int it = st, iy = sy;
    for (int o = 1; o < 64; o <<= 1) { const int a = __shfl_up(it, o), b = __shfl_up(iy, o); if (lane >= o) { it += a; iy += b; } }
    const int bt = it - st, by = iy - sy;
#pragma unroll
    for (int i = 0; i < 4; ++i) { tb[lane * 4 + i] = bt + pt[i]; yb[lane * 4 + i] = by + py[i]; cn[lane * 4 + i] = c[i]; }
    if (lane == 63) { tb[256] = it; tb[257] = it + T / 256; yb[256] = YSH; cn[256] = T; }
}

__device__ __forceinline__ void route_token2(const float* LG, const float* __restrict__ rbias, int* lcnt, int* TK, float* TW, int t0, int lane) {
    const int l32 = lane & 31, hb = lane & 32, t = t0 + (lane >> 5);
    const float4 la = ((const float4*)(LG + (size_t)t * NE))[2 * l32], lb = ((const float4*)(LG + (size_t)t * NE))[2 * l32 + 1];
    const float4 ra = ((const float4*)rbias)[2 * l32], rb = ((const float4*)rbias)[2 * l32 + 1];
    const float lg[8] = {la.x, la.y, la.z, la.w, lb.x, lb.y, lb.z, lb.w}, rbv[8] = {ra.x, ra.y, ra.z, ra.w, rb.x, rb.y, rb.z, rb.w};
    float sc[8], bv[8];
#pragma unroll
    for (int i = 0; i < 8; ++i) { sc[i] = 1.f / (1.f + expf(-lg[i])); bv[i] = sc[i] + rbv[i]; }
    float m1 = fmaxf(bv[0], bv[1]), m2 = fminf(bv[0], bv[1]);
#pragma unroll
    for (int i = 2; i < 8; ++i) { const float n1 = fmaxf(m1, bv[i]); m2 = fmaxf(fminf(m1, bv[i]), m2); m1 = n1; }
#pragma unroll
    for (int o = 1; o < 4; o <<= 1) { const float p1 = __shfl_xor(m1, o), p2 = __shfl_xor(m2, o); const float n1 = fmaxf(m1, p1); m2 = fmaxf(fminf(m1, p1), fmaxf(m2, p2)); m1 = n1; }
    const float gs = m1 + m2;
    const int myg = l32 >> 2;
    int rank = 0;
#pragma unroll
    for (int g2 = 0; g2 < NG; ++g2) { const float og = __shfl(gs, hb + g2 * 4); if (og > gs || (og == gs && g2 < myg)) ++rank; }
    const bool sel = rank < 4;
    float mv[8];
#pragma unroll
    for (int i = 0; i < 8; ++i) mv[i] = sel ? bv[i] : -INFINITY;
    int mye = 0; float myw = 0.f; float wsum = 0.f;
#pragma unroll
    for (int k = 0; k < TOPK; ++k) {
        float bvv = mv[0]; int bi = 0;
#pragma unroll
        for (int i = 1; i < 8; ++i) if (mv[i] > bvv) { bvv = mv[i]; bi = i; }
        int gi = l32 * 8 + bi;
#pragma unroll
        for (int o = 16; o > 0; o >>= 1) { const float ov = __shfl_xor(bvv, o); const int oi = __shfl_xor(gi, o); if (ov > bvv || (ov == bvv && oi < gi)) { bvv = ov; gi = oi; } }
        const int ol = gi >> 3, oi = gi & 7;
        float s_own = sc[0];
#pragma unroll
        for (int i = 1; i < 8; ++i) s_own = (oi == i) ? sc[i] : s_own;
        const float sw = __shfl(s_own, hb + ol);
        if (l32 == ol) {
#pragma unroll
            for (int i = 0; i < 8; ++i) if (oi == i) mv[i] = -INFINITY; }
        if (l32 == k) { mye = gi; myw = sw; } wsum += sw;
    }
    if (l32 < TOPK) { const int lp = atomicAdd(&lcnt[mye], 1); TK[t * TOPK + l32] = mye | (lp << 9); TW[t * TOPK + l32] = myw * (2.5f / wsum); }
}
__device__ __forceinline__ void route_finish2(const int* lbase, int* list_tok, float* list_gate, int* TK, const float* TW, int t0, int lane) {
    const int l32 = lane & 31, t = t0 + (lane >> 5);
    if (l32 < TOPK) { const int tk = TK[t * TOPK + l32]; const int e = tk & 511, pos = lbase[e] + (tk >> 9);
        if (pos < CAP) { list_tok[e * CAP + pos] = t; list_gate[e * CAP + pos] = TW[t * TOPK + l32]; }
        TK[t * TOPK + l32] = e | (pos << 9); }
}

constexpr float YSC = 16.f;
__device__ __forceinline__ void combine_token(const bf16* H1, const unsigned char* Y, const int* TK, lint yb, const float* __restrict__ g, const float* __restrict__ b, float* out, int t, int lane) {
    typedef float f2 __attribute__((ext_vector_type(2)));
    float v[16], s[16];
    { const u32x4 a = *(const u32x4*)(H1 + (size_t)t * D + 16 * lane), c = *(const u32x4*)(H1 + (size_t)t * D + 16 * lane + 8);
      const unsigned w[8] = {a.x, a.y, a.z, a.w, c.x, c.y, c.z, c.w};
#pragma unroll
      for (int i = 0; i < 8; ++i) { v[2 * i] = ALPHA * __builtin_bit_cast(float, w[i] << 16); v[2 * i + 1] = ALPHA * __builtin_bit_cast(float, w[i] & 0xffff0000u); } }
#pragma unroll
    for (int i = 0; i < 16; ++i) s[i] = 0.f;
    int tk = (lane < TOPK) ? TK[t * TOPK + lane] : 0;
#pragma unroll
    for (int k = 0; k <= TOPK; ++k) {
        size_t yrow;
        if (k < TOPK) { const int x = __shfl(tk, k); yrow = (size_t)(yb[x & 511] + (x >> 9)); } else yrow = (size_t)YSH + t;
        const u32x4 a = *(const u32x4*)(Y + yrow * D + 16 * lane);
        const int w[4] = {(int)a.x, (int)a.y, (int)a.z, (int)a.w};
#pragma unroll
        for (int i = 0; i < 4; ++i) { const f2 lo = __builtin_amdgcn_cvt_pk_f32_fp8(w[i], false), hi = __builtin_amdgcn_cvt_pk_f32_fp8(w[i], true);
            s[4 * i] += lo[0]; s[4 * i + 1] += lo[1]; s[4 * i + 2] += hi[0]; s[4 * i + 3] += hi[1]; }
    }
    float sm = 0.f;
#pragma unroll
    for (int i = 0; i < 16; ++i) { v[i] += s[i] * (1.f / YSC); sm += v[i]; }
    const float mean = fx::wave_sum(sm) * (1.f / D); float q = 0.f;
#pragma unroll
    for (int i = 0; i < 16; ++i) { v[i] -= mean; q += v[i] * v[i]; }
    const float rstd = 1.f / sqrtf(fx::wave_sum(q) * (1.f / D) + LN_EPS);
#pragma unroll
    for (int i = 0; i < 4; ++i) { const f32x4 gg = *(const f32x4*)(g + 16 * lane + 4 * i), bb = *(const f32x4*)(b + 16 * lane + 4 * i);
        f32x4 o; o[0] = v[4 * i] * rstd * gg[0] + bb[0]; o[1] = v[4 * i + 1] * rstd * gg[1] + bb[1]; o[2] = v[4 * i + 2] * rstd * gg[2] + bb[2]; o[3] = v[4 * i + 3] * rstd * gg[3] + bb[3];
        *(f32x4*)(out + (size_t)t * D + 16 * lane + 4 * i) = o; }
}
}

namespace pg8 {
struct RouterSched {
    int rb; const bf16_t* Bt;
    __device__ __forceinline__ bool next(int i, Unit2& u) const { if (i > 0) return false; u.pm = rb; u.pn = 0; u.e = 0; u.cnt = 128; u.jt = 0; u.ui = 0; return true; }
    __device__ __forceinline__ int arow(const Unit2& u, int r) const { return u.pm * 128 + r; }
    __device__ __forceinline__ size_t aoff(const Unit2&) const { return 0; }
    __device__ __forceinline__ const char* bptr(const Unit2&) const { return (const char*)Bt; }
};
struct EpiLogits {
    static constexpr bool PERM = false, AFTER_DRAIN = false;
    float* LG;
    __device__ __forceinline__ void operator()(const f32x4 (&acc)[2][2][4][2], const Unit2& u, int wr, int wc, int fr, int fq) const {
        const int row0 = u.pm * 128 + wr * 64 + fr, col0 = wc * 32 + 4 * fq;
#pragma unroll
        for (int m = 0; m < 4; ++m) { float* rowp = LG + (size_t)(row0 + m * 16) * nv::NE + col0;
#pragma unroll
            for (int bj = 0; bj < 2; ++bj)
#pragma unroll
                for (int n = 0; n < 2; ++n) *(f32x4*)(rowp + bj * HALF + n * 16) = acc[0][bj][m][n]; }
    }
};
template <int PH> struct MoeSched {
    int G, vcu, nrt; mo::lint tb; mo::lint cn; const int* list_tok; const bf16_t* W; mo::lint ut; mo::lint rg;
    static constexpr int NC = PH == 0 ? 2 : 4;
    static constexpr int MAXU = 64;
    __device__ __forceinline__ void build(int lane) const {
        const int L = lane * G + vcu;
        if (lane < MAXU && L < nrt * NC) {
            const int rt = L / NC, c = L % NC;
            int lo = 0, hi = 256;
            while (lo < hi) { const int mid = (lo + hi + 1) >> 1; if (tb[mid] <= rt) lo = mid; else hi = mid - 1; }
            const int e = lo, jt = rt - tb[e], rem = cn[e] - 256 * jt;
            ut[4 * lane] = rt; ut[4 * lane + 1] = c; ut[4 * lane + 2] = e | (jt << 9); ut[4 * lane + 3] = rem < 256 ? rem : 256;
        }
    }
    __device__ __forceinline__ bool next(int i, Unit2& u) const {
        const int L = i * G + vcu; if (i >= MAXU || L >= nrt * NC) return false;
        const int x = ut[4 * i + 2];
        u.pm = __builtin_amdgcn_readfirstlane(ut[4 * i]); u.pn = __builtin_amdgcn_readfirstlane(ut[4 * i + 1]); u.e = __builtin_amdgcn_readfirstlane(x & 511); u.jt = __builtin_amdgcn_readfirstlane(x >> 9);
        u.cnt = __builtin_amdgcn_readfirstlane(ut[4 * i + 3]); u.ui = i; return true;
    }
    __device__ __forceinline__ void fill_rows(const float* list_gate, int tid) const {
        for (int i = 0; i < MAXU; ++i) { const int L = i * G + vcu; if (L >= nrt * NC) break;
            const int x = ut[4 * i + 2], e = x & 511, jt = x >> 9, cnt = ut[4 * i + 3];
            if (tid < 256) { const int r = tid; unsigned v;
                if (e == 256) v = (unsigned)(jt * BM + r) | (0x4180u << 16);
                else if (r < cnt) { const float gsc = mo::YSC * list_gate[e * mo::CAP + jt * BM + r]; v = (unsigned)list_tok[e * mo::CAP + jt * BM + r] | (fx::f2bf(gsc) << 16); }
                else v = 0u;
                rg[i * 256 + r] = (int)v; } }
    }
    __device__ __forceinline__ int arow(const Unit2& u, int r) const {
        if (PH == 1) return u.pm * BM + r;
        return rg[u.ui * 256 + r] & 0x7fff;
    }
    __device__ __forceinline__ size_t aoff(const Unit2&) const { return 0; }
    __device__ __forceinline__ const char* bptr(const Unit2& u) const {
        return PH == 0 ? (const char*)(W + ((size_t)u.e * 512 + 256 * u.pn) * 1024) : (const char*)(W + ((size_t)u.e * 1024 + 256 * u.pn) * 256);
    }
};
struct EpiSwiGLU {
    static constexpr bool PERM = true, AFTER_DRAIN = false;
    bf16_t* H; mo::lint rg; int skip;
    __device__ __forceinline__ void operator()(const f32x4 (&acc)[2][2][4][2], const Unit2& u, int wr, int wc, int fr, int fq) const {
        if (skip) return;
        const int col0 = u.pn * 128 + wc * 32 + 8 * fq;
#pragma unroll
        for (int ai = 0; ai < 2; ++ai)
#pragma unroll
            for (int m = 0; m < 4; ++m) { const int r = ai * HALF + wr * 64 + m * 16 + fr;
                const float gt = __builtin_bit_cast(float, (unsigned)rg[u.ui * 256 + r] & 0xffff0000u);
                float hv[8];
#pragma unroll
                for (int n = 0; n < 2; ++n)
#pragma unroll
                    for (int i = 0; i < 4; ++i) { const float gg = acc[ai][0][m][n][i], uu = acc[ai][1][m][n][i]; hv[4 * n + i] = gt * uu * (gg * __builtin_amdgcn_rcpf(1.f + __builtin_amdgcn_exp2f(-1.4426950408889634f * gg))); }
                u32x4 w; w.x = cvt_pk_bf16(hv[0], hv[1]); w.y = cvt_pk_bf16(hv[2], hv[3]); w.z = cvt_pk_bf16(hv[4], hv[5]); w.w = cvt_pk_bf16(hv[6], hv[7]);
                *(u32x4*)(H + (size_t)(u.pm * BM + r) * 256 + col0) = w; }
    }
};
struct EpiDown {
    static constexpr bool PERM = true, AFTER_DRAIN = false;
    unsigned char* Y; mo::lint yb; int skip;
    __device__ __forceinline__ void operator()(const f32x4 (&acc)[2][2][4][2], const Unit2& u, int wr, int wc, int fr, int fq) const {
        if (skip) return;
        typedef unsigned u32x2v __attribute__((ext_vector_type(2)));
        const int col0 = u.pn * BM + wc * 32 + 8 * fq; const int ybase = yb[u.e] + u.jt * BM;
#pragma unroll
        for (int ai = 0; ai < 2; ++ai)
#pragma unroll
            for (int m = 0; m < 4; ++m) { const int r = ai * HALF + wr * 64 + m * 16 + fr;
                if (r < u.cnt) { unsigned char* rowp = Y + (size_t)(ybase + r) * nv::D + col0;
#pragma unroll
                    for (int bj = 0; bj < 2; ++bj) { const f32x4 v0 = acc[ai][bj][m][0], v1 = acc[ai][bj][m][1];
                        int w0 = __builtin_amdgcn_cvt_pk_fp8_f32(v0[0], v0[1], 0, false); w0 = __builtin_amdgcn_cvt_pk_fp8_f32(v0[2], v0[3], w0, true);
                        int w1 = __builtin_amdgcn_cvt_pk_fp8_f32(v1[0], v1[1], 0, false); w1 = __builtin_amdgcn_cvt_pk_fp8_f32(v1[2], v1[3], w1, true);
                        *(u32x2v*)(rowp + bj * HALF) = (u32x2v){(unsigned)w0, (unsigned)w1}; } } }
    }
};
}
constexpr int NTHR = 512;
constexpr int LDS_BYTES = 163840;
constexpr int MISC_OFF = 131072 + 320;
constexpr size_t MiB = 1u << 20;
constexpr size_t CTL_ZERO_BYTES = 96 * 1024;
constexpr int CW_BAR = 4096;
constexpr int CW_MOE = 16384;
constexpr int CW_FOXQ = 20992;
constexpr int CW_NRM = 20480;
constexpr int NPHASE = 9;
constexpr size_t WS_H1 = 1, WS_WR = 65, WS_STATS = 66, WS_LF = 67, WS_FG = 68, WS_WO = 72, WS_WIN = 74, WS_TK = 81, WS_LTOK = 83, WS_LGATE = 91,
                 WS_WED = 100, WS_HID = 230, WS_GLA = 230, WS_WEG = 416, WS_XN = 673, WS_YBF = 673, WS_QKV = 737, WS_Z1 = 737, WS_LG = 865, WS_Y = 416, WS_END = 992;

struct Args { const float* in[21]; float* out; unsigned char* ws; int ph_lo, ph_hi, li, pad; };

__global__ void __launch_bounds__(NTHR, 2) mega_fwd(Args a) {
    using namespace nv;
    extern __shared__ __attribute__((aligned(16))) unsigned char lds[];
    const int G = gridDim.x, bx = blockIdx.x;
    const int vcu = (G % 8 == 0) ? (bx % 8) * (G / 8) + bx / 8 : bx;
    int tid, lane, wave, vw;
#define DERIVE() do { int t_ = threadIdx.x; asm volatile("" : "+v"(t_)); tid = t_; lane = tid & 63; wave = __builtin_amdgcn_readfirstlane(tid >> 6); vw = vcu * 8 + wave; } while (0)
    DERIVE();
    volatile LAS unsigned* MISC = (volatile LAS unsigned*)((LAS unsigned char*)lds + MISC_OFF);
    for (int u = tid; u < (LDS_BYTES - 131072) / 4; u += NTHR) ((LAS unsigned*)((LAS unsigned char*)lds + 131072))[u] = 0u;
    __syncthreads();
    unsigned char* ws = a.ws;
    unsigned* ctl = (unsigned*)ws;
    XcdBarrier bar = xcd_barrier_post(ctl + CW_BAR + a.li * XCD_BAR_WORDS, MISC + 8);
    const float* x = a.in[0];
    const float* ln_in_g = a.in[1]; const float* ln_in_b = a.in[2];
    const float* w_in = a.in[3]; const float* b_fgate = a.in[4];
    const float* w_gate_up = a.in[5]; const float* b_gate = a.in[6]; const float* g_gla = a.in[7];
    const float* w_out = a.in[8]; const float* ln1_g = a.in[9]; const float* ln1_b = a.in[10];
    const float* w_router = a.in[11]; const float* rbias = a.in[12];
    const float* w_eg = a.in[13]; const float* w_eu = a.in[14]; const float* w_ed = a.in[15];
    const float* w_sg = a.in[16]; const float* w_su = a.in[17]; const float* w_sd = a.in[18];
    const float* ln2_g = a.in[19]; const float* ln2_b = a.in[20];
    float* out = a.out;
    int* counts = (int*)(ctl + CW_MOE);
    fx::bf16* H1 = (fx::bf16*)(ws + WS_H1 * MiB);
    fx::bf16* WrT = (fx::bf16*)(ws + WS_WR * MiB);
    float* stats = (float*)(ws + WS_STATS * MiB);
    float* LF = (float*)(ws + WS_LF * MiB);
    float* FG = (float*)(ws + WS_FG * MiB);
    fx::bf16* WoT = (fx::bf16*)(ws + WS_WO * MiB);
    fx::bf16* WinT = (fx::bf16*)(ws + WS_WIN * MiB);
    int* TK = (int*)(ws + WS_TK * MiB);
    float* TW = (float*)(ws + (WS_TK + 1) * MiB);
    int* list_tok = (int*)(ws + WS_LTOK * MiB);
    float* list_gate = (float*)(ws + WS_LGATE * MiB);
    fx::bf16* WedT = (fx::bf16*)(ws + WS_WED * MiB);
    fx::bf16* HID = (fx::bf16*)(ws + WS_HID * MiB);
    unsigned char* QPG = ws + WS_GLA * MiB; unsigned char* OIb = ws + (WS_GLA + 16) * MiB; unsigned char* UUb = ws + (WS_GLA + 80) * MiB; float* DECb = (float*)(ws + (WS_GLA + 144) * MiB); unsigned char* STGb = ws + (WS_GLA + 145) * MiB;
    fx::bf16* WegT = (fx::bf16*)(ws + WS_WEG * MiB);
    fx::bf16* XN = (fx::bf16*)(ws + WS_XN * MiB);
    fx::bf16* Ybf = (fx::bf16*)(ws + WS_YBF * MiB);
    fx::bf16* QKV = (fx::bf16*)(ws + WS_QKV * MiB);
    fx::bf16* MIX = (fx::bf16*)(ws + WS_Z1 * MiB);
    float* LG = (float*)(ws + WS_LG * MiB);
    unsigned char* YA = ws + WS_Y * MiB;
    mo::lint tb = (mo::lint)((LAS unsigned char*)lds + mo::L_TB), yb = (mo::lint)((LAS unsigned char*)lds + mo::L_YB), cn = (mo::lint)((LAS unsigned char*)lds + mo::L_CN), ut = (mo::lint)((LAS unsigned char*)lds + mo::L_UT), rg = (mo::lint)((LAS unsigned char*)lds + mo::L_RG);

    const int lo = a.ph_lo, hi = a.ph_hi;
#define IN(k) (lo <= (k) && (k) < hi)
#define SEAM(k) do { if (IN(k) && IN((k) + 1)) xcd_barrier(bar); DERIVE(); } while (0)
    const int GW = G * 8;
#ifndef STG7
#define STG7 0
#endif
#ifndef STG8
#define STG8 0
#endif
#define STAGGER(q) do { if ((q) > 0) { const unsigned long long t0_ = __builtin_amdgcn_s_memrealtime(); const unsigned long long d_ = (unsigned long long)((vcu & 3) * (q)); while (__builtin_amdgcn_s_memrealtime() - t0_ < d_) __builtin_amdgcn_s_sleep(8); } } while (0)

    if (IN(0)) {
        LAS float* scr = (LAS float*)((LAS unsigned char*)lds + wave * 16384);
        constexpr int I_IN = 16 * (fx::NIN / 32), I_OUT = 16 * 32, I_R = 16 * 8, I_SMALL = I_IN + I_OUT + I_R;
        for (int it = vw; it < I_SMALL; it += GW) {
            int r = it;
            if (r < I_IN) { fx::transpose_item(w_in, D, INW, WinT, scr, r / (fx::NIN / 32), r % (fx::NIN / 32), lane, [](int d) { return fx::inproj_src(d); }); continue; } r -= I_IN;
            if (r < I_OUT) { fx::transpose_item(w_out, D, D, WoT, scr, r / 32, r % 32, lane, [](int d) { return d; }); continue; } r -= I_OUT;
            fx::transpose_item(w_router, D, NE, WrT, scr, r / 8, r % 8, lane, [](int d) { return d; });
        }
        for (int r = vw; r < T; r += GW) fx::ln_row_bf16(x + (size_t)r * D, ln_in_g, ln_in_b, XN + (size_t)r * D, nullptr, stats + 2 * (size_t)r, lane);
    }
    SEAM(0);
    if (IN(1)) {
        const mo::ExpW XW{w_eg, w_eu, w_ed, w_sg, w_su, w_sd, WegT, WedT};
#ifndef MIXG
#define MIXG 2
#endif
        { const int slot = vcu % MIXG; pg8::StaticOrder S; S.init(T, fx::NIN, G, bx);
          const int nun = (S.nwg - bx + G - 1) / G, nb = (MIXG > 1) ? nun * slot / (MIXG - 1) : nun;
          pg8::Gemm g{XN, WinT, T, fx::NIN, D, D}; pg8::EpiInProj E{QKV, FG, LF, b_fgate, ctl + CW_NRM};
          if (nb > 0) { pg8::RangeOrder R{S, 0, nb}; pg8::gemm_phase<pg8::EpiInProj, pg8::RangeOrder, true, true>((LAS unsigned char*)lds, g, R, E); DERIVE(); }
          mo::expert_conv(XW, (LAS float*)((LAS unsigned char*)lds + wave * 16384), vw, GW, lane); __syncthreads(); DERIVE();
          if (nb < nun) { pg8::RangeOrder R{S, nb, nun - nb}; pg8::gemm_phase<pg8::EpiInProj, pg8::RangeOrder, true, true>((LAS unsigned char*)lds, g, R, E); } }
    }
    SEAM(1);
    if (IN(2)) {
        int cur_h = -1;
        if (gl::NUNIT % G == 0) { const int per = gl::NUNIT / G; for (int i = 0; i < per; ++i) gl::prep_unit(vcu * per + i, QKV, FG, w_gate_up, b_gate, QPG, OIb, UUb, DECb, lds, cur_h); }
        else for (int u = vcu; u < gl::NUNIT; u += G) gl::prep_unit(u, QKV, FG, w_gate_up, b_gate, QPG, OIb, UUb, DECb, lds, cur_h);
    }
    SEAM(2);
    if (IN(3)) {
        for (int blk = vcu; blk < gl::NUNIT / 8; blk += G) gl::post_block(blk * 8, 8, QKV, QPG, OIb, UUb, DECb, g_gla, Ybf, lds);
        { const attn_body::AttnTensors AT{(const attn_body::bf16*)(QKV + fx::P_FQ), (const attn_body::bf16*)(QKV + fx::P_FK), (const attn_body::bf16*)(QKV + fx::P_FV), (attn_body::bf16*)Ybf, LF, ctl + CW_NRM};
          attn_body::attn_phase_dyn<8>((char*)lds, AT, ctl + CW_FOXQ, (volatile int*)(lds + 140288)); }
    }
    SEAM(3);
    if (IN(4)) {
        pg8::DenseSched DS; DS.so.init(T, D, G, bx); DS.Bt = WoT; DS.ldb = D;
        pg8::EpiPlainBf16 E{MIX, D};
        pg8::gemm_phase2<pg8::EpiPlainBf16, pg8::DenseSched>((LAS unsigned char*)lds, Ybf, D, D, D, DS, E);
    }
    SEAM(4);
    if (IN(5)) {
        int* lcnt = (int*)(lds + 136192); int* lbase = lcnt + 256;
        for (int rb = vcu; rb < T / 128; rb += G) {
            if (tid < 256) lcnt[tid] = 0;
            for (int r = wave * 16; r < wave * 16 + 16; r += 4) { const size_t row = (size_t)rb * 128 + r;
                fx::ln1_rows_bf16<4>(x + row * D, stats + 2 * row, ln_in_g, ln_in_b, MIX + row * D, ln1_g, ln1_b, H1 + row * D, ALPHA, lane); }
            asm volatile("s_waitcnt vmcnt(0)" ::: "memory"); __syncthreads();
            { pg8::RouterSched RS{rb, WrT}; pg8::EpiLogits E{LG};
              pg8::gemm_phase2<pg8::EpiLogits, pg8::RouterSched>((LAS unsigned char*)lds, H1, D, D, D, RS, E); }
            DERIVE();
            for (int t = rb * 128 + wave * 2; t < rb * 128 + 128; t += 16) mo::route_token2(LG, rbias, lcnt, TK, TW, t, lane);
            __syncthreads();
            if (tid < 256) { const int c = lcnt[tid]; lbase[tid] = c ? atomicAdd(&counts[tid], c) : 0; }
            __syncthreads();
            for (int t = rb * 128 + wave * 2; t < rb * 128 + 128; t += 16) mo::route_finish2(lbase, list_tok, list_gate, TK, TW, t, lane);
            __syncthreads();
        }
    }
    SEAM(5);
    if (IN(6)) {
        if (wave == 0) mo::moe_tables(counts, tb, yb, cn, lane);
        __syncthreads();
        STAGGER(STG7);
        pg8::MoeSched<0> MS{G, vcu, tb[257], tb, cn, list_tok, WegT, ut, rg}; if (wave == 0) MS.build(lane); __syncthreads(); MS.fill_rows(list_gate, tid); __syncthreads(); pg8::EpiSwiGLU E{HID, rg, a.pad};
        pg8::gemm_phase2<pg8::EpiSwiGLU, pg8::MoeSched<0>>((LAS unsigned char*)lds, H1, D, D, D, MS, E);
    }
    SEAM(6);
    if (IN(7)) {
        if (wave == 0) mo::moe_tables(counts, tb, yb, cn, lane);
        __syncthreads();
        STAGGER(STG8);
        pg8::MoeSched<1> MS{G, vcu, tb[257], tb, cn, list_tok, WedT, ut, rg}; if (wave == 0) MS.build(lane); __syncthreads(); pg8::EpiDown E{YA, yb, a.pad};
        pg8::gemm_phase2<pg8::EpiDown, pg8::MoeSched<1>>((LAS unsigned char*)lds, HID, ED, ED, ED, MS, E);
    }
    SEAM(7);
    if (IN(8)) {
        if (wave == 0) mo::moe_tables(counts, tb, yb, cn, lane);
        __syncthreads();
        for (int t = vw; t < T; t += GW) mo::combine_token(H1, YA, TK, yb, ln2_g, ln2_b, out, t, lane);
    }
#undef IN
#undef SEAM
}

extern "C" void kernel_launch(void* const* d_in, const int* in_sizes, int n_in, void* d_out, int out_size, void* d_ws, size_t ws_size, hipStream_t stream) {
    static int grid = 0;
    if (grid == 0) {
        if (n_in != 21 || out_size != nv::T * nv::D || ws_size < WS_END * MiB) { fprintf(stderr, "kernel_launch: unexpected shapes n_in=%d out=%d ws=%zu\n", n_in, out_size, ws_size); grid = -1; return; }
        int dev = 0, cus = 0;
        if (hipGetDevice(&dev) != hipSuccess || hipDeviceGetAttribute(&cus, hipDeviceAttributeMultiprocessorCount, dev) != hipSuccess) { grid = -1; return; }
        if (hipFuncSetAttribute((const void*)mega_fwd, hipFuncAttributeMaxDynamicSharedMemorySize, LDS_BYTES) != hipSuccess) { fprintf(stderr, "kernel_launch: hipFuncSetAttribute failed\n"); grid = -1; return; }
        grid = cus;
    }
    if (grid < 0) return;
    if (hipMemsetAsync(d_ws, 0, CTL_ZERO_BYTES, stream) != hipSuccess) return;
    Args a{};
    for (int i = 0; i < 21; ++i) a.in[i] = (const float*)d_in[i];
    a.out = (float*)d_out; a.ws = (unsigned char*)d_ws; a.ph_lo = 0; a.ph_hi = NPHASE; a.li = 0;
#ifdef REPEAT_PH
    a.ph_hi = REPEAT_PH + 1; hipLaunchKernelGGL(mega_fwd, dim3(grid), dim3(NTHR), LDS_BYTES, stream, a);
    if (REPEAT_PH == 5) hipMemsetAsync((char*)d_ws + CW_MOE * 4, 0, 4096, stream);
    a.ph_lo = REPEAT_PH; a.ph_hi = NPHASE; a.li = 1;
#ifdef REPEAT_NOEPI
    a.ph_hi = REPEAT_PH + 1; a.pad = 1; hipLaunchKernelGGL(mega_fwd, dim3(grid), dim3(NTHR), LDS_BYTES, stream, a); a.pad = 0; a.ph_lo = REPEAT_PH + 1; a.ph_hi = NPHASE; a.li = 2;
#endif
#endif
    hipLaunchKernelGGL(mega_fwd, dim3(grid), dim3(NTHR), LDS_BYTES, stream, a);
}
```

```cpp
#include <hip/hip_runtime.h>
#include <cstdio>
#include <cstdint>
#include <cmath>

#define LAS __attribute__((address_space(3)))
#define GAS __attribute__((address_space(1)))

#define XB_TMO      128
#define XB_XCNT(j)  (256  + 64 * (j))
#define XB_XSUB(j)  (1280 + 64 * (j))
#define XB_XGEN(j)  (2304 + 64 * (j))
#define XB_TOP      3328
#define XB_TOPGEN   3392
#define XCD_BAR_WORDS 3456
#define XB_SPIN_CAP (1u << 27)
__device__ __forceinline__ unsigned xb_ld(unsigned* p)              { return __hip_atomic_load(p, __ATOMIC_RELAXED, __HIP_MEMORY_SCOPE_AGENT); }
__device__ __forceinline__ unsigned xb_add(unsigned* p, unsigned v) { return __hip_atomic_fetch_add(p, v, __ATOMIC_RELAXED, __HIP_MEMORY_SCOPE_AGENT); }
__device__ __forceinline__ unsigned xb_xcc_id() { return (unsigned)__builtin_amdgcn_s_getreg((3 << 11) | 20) & 0xFu; }
#define XB_SPIN(cond, bar) do { unsigned _sp = 0; while (cond) { __builtin_amdgcn_s_sleep(1); \
    if ((++_sp & 255u) == 0u) { if (xb_ld(&(bar)[XB_TMO])) break; if (_sp > XB_SPIN_CAP) { atomicAdd(&(bar)[XB_TMO], 1u); break; } } } } while (0)
struct XcdBarrier { unsigned* bar; unsigned x; volatile LAS unsigned* st; };
__device__ __forceinline__ XcdBarrier xcd_barrier_post(unsigned* bar, volatile LAS unsigned* st) {
    XcdBarrier b; b.bar = bar; b.x = xb_xcc_id(); b.st = st;
    if (threadIdx.x == 0) (void)xb_add(&bar[XB_XCNT(b.x)], 1u);
    return b;
}
__device__ __forceinline__ void xcd_barrier_complete(unsigned* bar, unsigned x, unsigned& nloc, unsigned& nx) {
    const unsigned G = gridDim.x * gridDim.y * gridDim.z;
    unsigned sum, cnt, mine, sp = 0u;
    for (;;) {
        sum = 0u; cnt = 0u; mine = 0u;
#pragma unroll
        for (unsigned j = 0; j < 16; ++j) { const unsigned c = xb_ld(&bar[XB_XCNT(j)]); sum += c; cnt += (c > 0u) ? 1u : 0u; mine = (j == x) ? c : mine; }
        if (sum == G) break;
        __builtin_amdgcn_s_sleep(1);
        if ((++sp & 255u) == 0u) { if (xb_ld(&bar[XB_TMO])) break; if (sp > XB_SPIN_CAP) { atomicAdd(&bar[XB_TMO], 1u); break; } }
    }
    nloc = mine > 0u ? mine : 1u; nx = cnt > 0u ? cnt : 1u;
}
__device__ __forceinline__ void xcd_barrier(const XcdBarrier& b) {
    asm volatile("s_waitcnt vmcnt(0)" ::: "memory");
    __syncthreads();
    if (threadIdx.x == 0) {
        unsigned* bar = b.bar;
        __builtin_amdgcn_s_waitcnt(0);
        unsigned nloc = b.st[0], nx = b.st[1];
        if (nloc == 0u) { xcd_barrier_complete(bar, b.x, nloc, nx); b.st[0] = nloc; b.st[1] = nx; }
        const unsigned old = xb_add(&bar[XB_XSUB(b.x)], 1u);
        const unsigned gen = old / nloc;
        if (old + 1u == (gen + 1u) * nloc) {
            __builtin_amdgcn_fence(__ATOMIC_RELEASE, "agent");
            asm volatile("s_waitcnt vmcnt(0)" ::: "memory");
            const unsigned og = xb_add(&bar[XB_TOP], 1u);
            const unsigned tg = og / nx;
            if (og + 1u == (tg + 1u) * nx) xb_add(&bar[XB_TOPGEN], 1u);
            else XB_SPIN(xb_ld(&bar[XB_TOPGEN]) == tg, bar);
            __builtin_amdgcn_fence(__ATOMIC_ACQUIRE, "agent");
            xb_add(&bar[XB_XGEN(b.x)], 1u);
            asm volatile("s_waitcnt vmcnt(0)" ::: "memory");
        } else {
            XB_SPIN(xb_ld(&bar[XB_XGEN(b.x)]) == gen, bar);
            __builtin_amdgcn_fence(__ATOMIC_ACQUIRE, "agent");
            asm volatile("s_waitcnt vmcnt(0)" ::: "memory");
        }
    }
    __syncthreads();
}
namespace pg8 {
#define PG8_LAS __attribute__((address_space(3)))
typedef unsigned short bf16_t;
typedef short bf16x8 __attribute__((ext_vector_type(8)));
typedef float f32x4 __attribute__((ext_vector_type(4)));
typedef unsigned u32x4 __attribute__((ext_vector_type(4)));
constexpr int BM = 256, BK = 64, HALF = 128, HTB = HALF * BK * 2  , STAGE_BYTES = 8 * HTB, NXCD = 8, WGM = 8;

__host__ __device__ __forceinline__ int lds_byte(int r, int c) { const int st = (r >> 4) * 2 + (c >> 5), rr = r & 15, cc = c & 31, ob = rr * 64 + cc * 2; return st * 1024 + (ob ^ (((ob >> 9) & 1) << 5)); }
__host__ __device__ __forceinline__ void stage_rc(int b, int& R, int& C) { const int st = b / 1024, sb = b % 1024, swz = sb ^ (((sb >> 9) & 1) << 5); R = (st >> 1) * 16 + swz / 64; C = (st & 1) * 32 + (swz % 64) / 2; }
__host__ __device__ __forceinline__ int perm32(int rho) { const int n = rho >> 4, i = rho & 15; return 8 * (i >> 2) + 4 * n + (i & 3); }

struct Unit { int pm, pn; };
struct Gemm { const bf16_t* A; const bf16_t* Bt; int M, N, K, lda; };

struct StaticOrder {
    int nM, nN, nwg, G, c;
    __host__ __device__ void init(int M, int N, int G_, int c_) { nM = M / BM; nN = N / BM; nwg = nM * nN; G = G_; c = c_; }
    __host__ __device__ bool next(int i, Unit& u) const {
        const long L = (long)i * G + c; if (L >= nwg) return false;
        int wgid = (int)L; { const int q = nwg / NXCD, r = nwg % NXCD, xcd = wgid % NXCD, off = wgid / NXCD; wgid = (xcd < r ? xcd * (q + 1) : r * (q + 1) + (xcd - r) * q) + off; }
        const int nig = WGM * nN, gid = wgid / nig, fm = gid * WGM, gsz = (nM - fm) < WGM ? (nM - fm) : WGM;
        u.pm = fm + ((wgid % nig) % gsz); u.pn = (wgid % nig) / gsz; return true;
    }
    __device__ __forceinline__ void a_ready(const Unit&) const {}
    __device__ __forceinline__ void done(const Unit&) const {}
};

struct RangeOrder {
    StaticOrder so; int i0, n;
    __host__ __device__ bool next(int i, Unit& u) const { return i < n && so.next(i0 + i, u); }
    __device__ __forceinline__ void a_ready(const Unit&) const {}
    __device__ __forceinline__ void done(const Unit&) const {}
};
__device__ __forceinline__ unsigned cvt_pk_bf16(float lo, float hi) { unsigned r; asm volatile("v_cvt_pk_bf16_f32 %0, %1, %2" : "=v"(r) : "v"(lo), "v"(hi)); return r; }
typedef float f32x2 __attribute__((ext_vector_type(2)));
__device__ __forceinline__ f32x2 gelu_pk(f32x2 v) {
    const f32x2 av = __builtin_elementwise_abs(v), d = av * 0.2316418882f + 1.0f;
    f32x2 t; t.x = __builtin_amdgcn_rcpf(d.x); t.y = __builtin_amdgcn_rcpf(d.y);
    f32x2 q = t * 0.5307027145f + (-0.7265760135f); q = q * t + 0.7107068705f; q = q * t + (-0.142248368f); q = q * t + 0.127414796f; q = q * t;
    const f32x2 s = (v * v) * (-0.72134752044f);
    f32x2 e; e.x = __builtin_amdgcn_exp2f(s.x); e.y = __builtin_amdgcn_exp2f(s.y);
    const f32x2 m = v * (q * e), r = v - m;
    f32x2 o; o.x = v.x < 0.f ? m.x : r.x; o.y = v.y < 0.f ? m.y : r.y; return o;
}

template <int ACT  > struct EpiBf16 {
    static constexpr bool PERM = true, AFTER_DRAIN = false; static_assert(ACT == 0 || ACT == 1, "EpiBf16: ACT is 0 (none) or 1 (gelu_pk)");
    bf16_t* O; int ldc; const float* bias; int split_cols; size_t split_stride; float scale0;
    __device__ __forceinline__ void operator()(const f32x4 (&acc)[2][2][4][2], const Unit& u, int wr, int wc, int fr, int fq) const {
        const int row0 = u.pm * BM + wr * 64 + fr; int colt = u.pn * BM; bf16_t* base = O;
        float sc = 1.f; if (split_cols) { const int t = colt / split_cols; base += (size_t)t * split_stride; colt -= t * split_cols; if (t == 0) sc = scale0; }
        const int col0 = colt + wc * 32 + 8 * fq, bcol0 = u.pn * BM + wc * 32 + 8 * fq;
        f32x4 bv[2][2];
#pragma unroll
        for (int bj = 0; bj < 2; ++bj)
#pragma unroll
            for (int n = 0; n < 2; ++n) bv[bj][n] = bias ? *(const f32x4*)(bias + bcol0 + bj * HALF + 4 * n) : (f32x4){0.f, 0.f, 0.f, 0.f};
#pragma unroll
        for (int ai = 0; ai < 2; ++ai)
#pragma unroll
            for (int m = 0; m < 4; ++m) { bf16_t* rowp = base + (size_t)(row0 + ai * HALF + m * 16) * ldc + col0;
#pragma unroll
                for (int bj = 0; bj < 2; ++bj) { f32x4 v0 = acc[ai][bj][m][0] + bv[bj][0], v1 = acc[ai][bj][m][1] + bv[bj][1];
                    if (ACT == 1) { f32x2 a = gelu_pk((f32x2){v0[0], v0[1]}), b = gelu_pk((f32x2){v0[2], v0[3]}), c = gelu_pk((f32x2){v1[0], v1[1]}), d = gelu_pk((f32x2){v1[2], v1[3]});
                        v0 = (f32x4){a.x, a.y, b.x, b.y}; v1 = (f32x4){c.x, c.y, d.x, d.y}; }
                    v0 = v0 * sc; v1 = v1 * sc; u32x4 w; w.x = cvt_pk_bf16(v0[0], v0[1]); w.y = cvt_pk_bf16(v0[2], v0[3]); w.z = cvt_pk_bf16(v1[0], v1[1]); w.w = cvt_pk_bf16(v1[2], v1[3]);
                    *(u32x4*)(rowp + bj * HALF) = w; } }
    }
};

template <class Epi, class Sched, bool ALIGN_EPI = false, bool SP2 = false>
__device__ __forceinline__ void gemm_phase(PG8_LAS unsigned char* lds, const Gemm g, const Sched& S, const Epi& E) {
    const int tid = threadIdx.x, wid = __builtin_amdgcn_readfirstlane(tid >> 6), lane = tid & 63, wr = wid >> 2, wc = wid & 3, fr = lane & 15, fq = lane >> 4;
    const int K = g.K, nt = K / BK;
    unsigned voffA[2], voffB[2];
#pragma unroll
    for (int i = 0; i < 2; ++i) { int R, C; stage_rc(tid * 16 + i * 8192, R, C); const int Rb = Epi::PERM ? ((R & ~31) + perm32(R & 31)) : R;
        voffA[i] = (unsigned)(R * g.lda + C) * 2u; voffB[i] = (unsigned)(Rb * K + C) * 2u; }
    const size_t kstep = (size_t)(BK * 2);
    const size_t hstepA = (size_t)HALF * g.lda * 2, hstepB = (size_t)HALF * K * 2;
    const size_t tstepA = 2 * hstepA, tstepB = 2 * hstepB;
    const unsigned ldsw = (unsigned)wid * 1024u;
    const int aoff = lds_byte(wr * 64 + fr, fq * 8), boff = lds_byte(wc * 32 + fr, fq * 8);
#define PG8_SA(b, h) (((b) * 2 + (h)) * HTB)
#define PG8_SB(b, h) ((4 + (b) * 2 + (h)) * HTB)
#define PG8_STAGE(bufoff, gbase, voff) do { _Pragma("unroll") for (int _i = 0; _i < 2; ++_i) \
        __builtin_amdgcn_global_load_lds((const unsigned*)((const char*)(gbase) + (voff)[_i]), (PG8_LAS unsigned*)(lds + (bufoff) + ldsw + _i * 8192), 16, 0, 0); } while (0)
#define PG8_LDA(dst, b, h) do { _Pragma("unroll") for (int m = 0; m < 4; ++m) _Pragma("unroll") for (int k = 0; k < 2; ++k) dst[m][k] = *(const PG8_LAS bf16x8*)(lds + PG8_SA(b, h) + aoff + m * 2048 + k * 1024); } while (0)
#define PG8_LDB(dst, b, h) do { _Pragma("unroll") for (int n = 0; n < 2; ++n) _Pragma("unroll") for (int k = 0; k < 2; ++k) dst[n][k] = *(const PG8_LAS bf16x8*)(lds + PG8_SB(b, h) + boff + n * 2048 + k * 1024); } while (0)
#define PG8_MMA(ai, bj, At, Bt) do { __builtin_amdgcn_s_setprio(1); _Pragma("unroll") for (int m = 0; m < 4; ++m) _Pragma("unroll") for (int n = 0; n < 2; ++n) _Pragma("unroll") for (int k = 0; k < 2; ++k) \
        acc[ai][bj][m][n] = __builtin_amdgcn_mfma_f32_16x16x32_bf16(Bt[n][k], At[m][k], acc[ai][bj][m][n], 0, 0, 0); __builtin_amdgcn_s_setprio(0); } while (0)
#define PG8_WAIT_V(n) asm volatile("s_waitcnt vmcnt(" #n ")" ::: "memory")
#define PG8_WAIT_L(n) asm volatile("s_waitcnt lgkmcnt(" #n ")" ::: "memory")
#define PG8_BAR __builtin_amdgcn_s_barrier()
#define PG8_SCHED __builtin_amdgcn_sched_barrier(0)
    Unit cur, nxt; int ui = 0;
    if (!S.next(0, cur)) return;
    f32x4 acc[2][2][4][2];
#pragma unroll
    for (int a = 0; a < 2; ++a)
#pragma unroll
        for (int b = 0; b < 2; ++b)
#pragma unroll
            for (int m = 0; m < 4; ++m)
#pragma unroll
                for (int n = 0; n < 2; ++n) acc[a][b][m][n] = (f32x4){0.f, 0.f, 0.f, 0.f};
    bf16x8 At[4][2], B0[2][2], B1[2][2];
    const char* cA = (const char*)g.A + (size_t)cur.pm * tstepA; const char* cB = (const char*)g.Bt + (size_t)cur.pn * tstepB;
    S.a_ready(cur);
    if constexpr (SP2) {
        PG8_STAGE(PG8_SB(0, 0), cB, voffB); PG8_STAGE(PG8_SB(0, 1), cB + hstepB, voffB); PG8_STAGE(PG8_SA(0, 0), cA, voffA); PG8_STAGE(PG8_SA(0, 1), cA + hstepA, voffA);
        if (wr == 1) PG8_BAR;
        PG8_WAIT_V(2); PG8_BAR;
        PG8_STAGE(PG8_SB(1, 0), cB + kstep, voffB); PG8_STAGE(PG8_SA(1, 0), cA + kstep, voffA); PG8_STAGE(PG8_SB(1, 1), cB + hstepB + kstep, voffB);
        PG8_WAIT_V(6); PG8_BAR;
    } else {
        PG8_STAGE(PG8_SB(0, 0), cB, voffB); PG8_STAGE(PG8_SA(0, 0), cA, voffA); PG8_STAGE(PG8_SB(0, 1), cB + hstepB, voffB); PG8_STAGE(PG8_SA(0, 1), cA + hstepA, voffA);
        if (wr == 1) PG8_BAR;
        PG8_WAIT_V(4); PG8_BAR;
        PG8_STAGE(PG8_SB(1, 0), cB + kstep, voffB); PG8_STAGE(PG8_SA(1, 0), cA + kstep, voffA); PG8_STAGE(PG8_SB(1, 1), cB + hstepB + kstep, voffB);
        PG8_WAIT_V(6); PG8_BAR;
    }
    for (;;) {
        const bool has_next = S.next(ui + 1, nxt);
        const char* nA = has_next ? (const char*)g.A + (size_t)nxt.pm * tstepA : cA; const char* nB = has_next ? (const char*)g.Bt + (size_t)nxt.pn * tstepB : cB;
        for (int t = 0; t < nt; t += 2) {
            const bool last = (t == nt - 2);
            const char* a1 = cA + (size_t)(t + 1) * kstep;
            const char* a2 = last ? nA : cA + (size_t)(t + 2) * kstep; const char* b2 = last ? nB : cB + (size_t)(t + 2) * kstep;
            const char* a3 = a2 + kstep; const char* b3 = b2 + kstep;
            if (last && has_next) S.a_ready(nxt);
            if constexpr (SP2) {
            PG8_LDB(B0, 0, 0); PG8_LDB(B1, 0, 1); PG8_SCHED; PG8_LDA(At, 0, 0); PG8_STAGE(PG8_SA(1, 1), a1 + hstepA, voffA);
            PG8_WAIT_V(8); PG8_WAIT_L(0); PG8_BAR; PG8_MMA(0, 0, At, B0); PG8_MMA(0, 1, At, B1); PG8_BAR; PG8_SCHED;
            PG8_LDA(At, 0, 1); PG8_STAGE(PG8_SB(0, 0), b2, voffB); PG8_STAGE(PG8_SB(0, 1), b2 + hstepB, voffB); PG8_STAGE(PG8_SA(0, 0), a2, voffA);
            PG8_WAIT_V(8); PG8_WAIT_L(0); PG8_BAR; PG8_MMA(1, 0, At, B0); PG8_MMA(1, 1, At, B1); PG8_BAR; PG8_SCHED;
            PG8_LDB(B0, 1, 0); PG8_LDB(B1, 1, 1); PG8_SCHED; PG8_LDA(At, 1, 0); PG8_STAGE(PG8_SA(0, 1), a2 + hstepA, voffA);
            PG8_WAIT_V(8); PG8_WAIT_L(0); PG8_BAR; PG8_MMA(0, 0, At, B0); PG8_MMA(0, 1, At, B1); PG8_BAR; PG8_SCHED;
            PG8_LDA(At, 1, 1); PG8_STAGE(PG8_SB(1, 0), b3, voffB); PG8_STAGE(PG8_SB(1, 1), b3 + hstepB, voffB); PG8_STAGE(PG8_SA(1, 0), a3, voffA);
            PG8_WAIT_V(8); PG8_WAIT_L(0); PG8_BAR; PG8_MMA(1, 0, At, B0); PG8_MMA(1, 1, At, B1); PG8_BAR; PG8_SCHED;
            } else {
            PG8_LDB(B0, 0, 0); PG8_SCHED; PG8_LDA(At, 0, 0); PG8_STAGE(PG8_SA(1, 1), a1 + hstepA, voffA);
            PG8_WAIT_L(8); PG8_BAR; PG8_WAIT_L(0); PG8_MMA(0, 0, At, B0); PG8_BAR; PG8_SCHED;
            PG8_LDB(B1, 0, 1); PG8_STAGE(PG8_SB(0, 0), b2, voffB);
            PG8_BAR; PG8_WAIT_L(0); PG8_MMA(0, 1, At, B1); PG8_BAR;
            PG8_LDA(At, 0, 1); PG8_STAGE(PG8_SA(0, 0), a2, voffA);
            PG8_BAR; PG8_WAIT_L(0); PG8_MMA(1, 0, At, B0); PG8_BAR; PG8_SCHED;
            PG8_STAGE(PG8_SB(0, 1), b2 + hstepB, voffB);
            PG8_WAIT_V(6); PG8_BAR; PG8_MMA(1, 1, At, B1); PG8_BAR;
            PG8_LDB(B0, 1, 0); PG8_SCHED; PG8_LDA(At, 1, 0); PG8_STAGE(PG8_SA(0, 1), a2 + hstepA, voffA);
            PG8_WAIT_L(8); PG8_BAR; PG8_WAIT_L(0); PG8_MMA(0, 0, At, B0); PG8_BAR; PG8_SCHED;
            PG8_LDB(B1, 1, 1); PG8_STAGE(PG8_SB(1, 0), b3, voffB);
            PG8_BAR; PG8_WAIT_L(0); PG8_MMA(0, 1, At, B1); PG8_BAR;
            PG8_LDA(At, 1, 1); PG8_STAGE(PG8_SA(1, 0), a3, voffA);
            PG8_BAR; PG8_WAIT_L(0); PG8_MMA(1, 0, At, B0); PG8_BAR; PG8_SCHED;
            PG8_STAGE(PG8_SB(1, 1), b3 + hstepB, voffB);
            PG8_WAIT_V(6); PG8_BAR; PG8_MMA(1, 1, At, B1); PG8_BAR;
            }
        }
        if constexpr (ALIGN_EPI) { if (wr == 0) PG8_BAR; }
        if constexpr (!Epi::AFTER_DRAIN) { E(acc, cur, wr, wc, fr, fq); S.done(cur); }
        if (!has_next) break;
#pragma unroll
        for (int a = 0; a < 2; ++a)
#pragma unroll
            for (int b = 0; b < 2; ++b)
#pragma unroll
                for (int m = 0; m < 4; ++m)
#pragma unroll
                    for (int n = 0; n < 2; ++n) acc[a][b][m][n] = (f32x4){0.f, 0.f, 0.f, 0.f};
        cur = nxt; cA = nA; cB = nB; ++ui;
        if constexpr (ALIGN_EPI) { if (wr == 1) PG8_BAR; }
    }
    PG8_WAIT_V(0);
    if constexpr (!ALIGN_EPI) { if (wr == 0) PG8_BAR; }
    PG8_BAR;
    if constexpr (Epi::AFTER_DRAIN) { E.fused(acc, cur, wr, wc, fr, fq, lds, wid, lane); S.done(cur); }
#undef PG8_SA
#undef PG8_SB
#undef PG8_STAGE
#undef PG8_LDA
#undef PG8_LDB
#undef PG8_MMA
#undef PG8_WAIT_V
#undef PG8_WAIT_L
#undef PG8_BAR
#undef PG8_SCHED
}
}
namespace pg8 {
struct Unit2 { int pm, pn, e, cnt, jt, ui; };
template <class Epi, class Sched>
__device__ __forceinline__ void gemm_phase2(PG8_LAS unsigned char* lds, const bf16_t* Abase, int lda, int ldb, int K, const Sched& S, const Epi& E, int kstepA_ = BK * 2) {
    int tid_ = threadIdx.x; asm volatile("" : "+v"(tid_));
    const int tid = tid_, wid = __builtin_amdgcn_readfirstlane(tid >> 6), lane = tid & 63, wr = wid >> 2, wc = wid & 3, fr = lane & 15, fq = lane >> 4;
    int K_ = K; asm volatile("" : "+s"(K_));
    const int nt = K_ / BK;
    unsigned voffB[2];
#pragma unroll
    for (int i = 0; i < 2; ++i) { int R, C; stage_rc(tid * 16 + i * 8192, R, C); const int Rb = Epi::PERM ? ((R & ~31) + perm32(R & 31)) : R; voffB[i] = (unsigned)(Rb * ldb + C) * 2u; }
    const unsigned lda2 = (unsigned)lda * 2u;
#define PG8_AOFFS(U, o0, o1) do { int t2_ = threadIdx.x; asm volatile("" : "+v"(t2_)); _Pragma("unroll") for (int i_ = 0; i_ < 2; ++i_) { int R_, C_; stage_rc(t2_ * 16 + i_ * 8192, R_, C_); \
        o0[i_] = (unsigned)S.arow(U, R_) * lda2 + (unsigned)C_ * 2u; o1[i_] = (unsigned)S.arow(U, HALF + R_) * lda2 + (unsigned)C_ * 2u; } } while (0)
    const size_t kstep = (size_t)(BK * 2), kstepA = (size_t)kstepA_;
    const size_t hstepB = (size_t)HALF * ldb * 2;
    const unsigned ldsw = (unsigned)wid * 1024u;
    const int aoff = lds_byte(wr * 64 + fr, fq * 8), boff = lds_byte(wc * 32 + fr, fq * 8);
#define PG8_SA(b, h) (((b) * 2 + (h)) * HTB)
#define PG8_SB(b, h) ((4 + (b) * 2 + (h)) * HTB)
#define PG8_STAGE(bufoff, gbase, voff) do { _Pragma("unroll") for (int _i = 0; _i < 2; ++_i) \
        __builtin_amdgcn_global_load_lds((const unsigned*)((const char*)(gbase) + (voff)[_i]), (PG8_LAS unsigned*)(lds + (bufoff) + ldsw + _i * 8192), 16, 0, 0); } while (0)
#define PG8_LDA(dst, b, h) do { _Pragma("unroll") for (int m = 0; m < 4; ++m) _Pragma("unroll") for (int k = 0; k < 2; ++k) dst[m][k] = *(const PG8_LAS bf16x8*)(lds + PG8_SA(b, h) + aoff + m * 2048 + k * 1024); } while (0)
#define PG8_LDB(dst, b, h) do { _Pragma("unroll") for (int n = 0; n < 2; ++n) _Pragma("unroll") for (int k = 0; k < 2; ++k) dst[n][k] = *(const PG8_LAS bf16x8*)(lds + PG8_SB(b, h) + boff + n * 2048 + k * 1024); } while (0)
#define PG8_MMA(ai, bj, At, Bt) do { __builtin_amdgcn_s_setprio(1); _Pragma("unroll") for (int m = 0; m < 4; ++m) _Pragma("unroll") for (int n = 0; n < 2; ++n) _Pragma("unroll") for (int k = 0; k < 2; ++k) \
        acc[ai][bj][m][n] = __builtin_amdgcn_mfma_f32_16x16x32_bf16(Bt[n][k], At[m][k], acc[ai][bj][m][n], 0, 0, 0); __builtin_amdgcn_s_setprio(0); } while (0)
#define PG8_WAIT_V(n) asm volatile("s_waitcnt vmcnt(" #n ")" ::: "memory")
#define PG8_WAIT_L(n) asm volatile("s_waitcnt lgkmcnt(" #n ")" ::: "memory")
#define PG8_BAR __builtin_amdgcn_s_barrier()
#define PG8_SCHED __builtin_amdgcn_sched_barrier(0)
    Unit2 cur, nxt; int ui = 0;
    if (!S.next(0, cur)) return;
    f32x4 acc[2][2][4][2];
#pragma unroll
    for (int a = 0; a < 2; ++a)
#pragma unroll
        for (int b = 0; b < 2; ++b)
#pragma unroll
            for (int m = 0; m < 4; ++m)
#pragma unroll
                for (int n = 0; n < 2; ++n) acc[a][b][m][n] = (f32x4){0.f, 0.f, 0.f, 0.f};
    bf16x8 At[4][2], B0[2][2], B1[2][2];
    unsigned cv0[2], cv1[2], nv0[2], nv1[2];
    PG8_AOFFS(cur, cv0, cv1);
    const char* cA = (const char*)Abase + S.aoff(cur); const char* cB = S.bptr(cur);
    PG8_STAGE(PG8_SB(0, 0), cB, voffB); PG8_STAGE(PG8_SB(0, 1), cB + hstepB, voffB); PG8_STAGE(PG8_SA(0, 0), cA, cv0); PG8_STAGE(PG8_SA(0, 1), cA, cv1);
    if (wr == 1) PG8_BAR;
    PG8_WAIT_V(2); PG8_BAR;
    PG8_STAGE(PG8_SB(1, 0), cB + kstep, voffB); PG8_STAGE(PG8_SA(1, 0), cA + kstepA, cv0); PG8_STAGE(PG8_SB(1, 1), cB + hstepB + kstep, voffB);
    PG8_WAIT_V(6); PG8_BAR;
    for (;;) {
        const bool has_next = S.next(ui + 1, nxt);
        const char* nA = has_next ? (const char*)Abase + S.aoff(nxt) : cA; const char* nB = has_next ? S.bptr(nxt) : cB;
#pragma unroll
        for (int i = 0; i < 2; ++i) { nv0[i] = cv0[i]; nv1[i] = cv1[i]; }
        if (has_next) PG8_AOFFS(nxt, nv0, nv1);
        const bool act0 = cur.cnt > wr * 64, act1 = cur.cnt > HALF + wr * 64;
        for (int t = 0; t < nt; t += 2) {
            const bool last = (t == nt - 2);
            const char* a1 = cA + (size_t)(t + 1) * kstepA;
            const char* a2 = last ? nA : cA + (size_t)(t + 2) * kstepA; const char* b2 = last ? nB : cB + (size_t)(t + 2) * kstep;
            const char* a3 = a2 + kstepA; const char* b3 = b2 + kstep;
            unsigned s0[2] = {cv0[0], cv0[1]}, s1[2] = {cv1[0], cv1[1]};
            if (last) { asm volatile("" ::: "memory"); s0[0] = nv0[0]; s0[1] = nv0[1]; s1[0] = nv1[0]; s1[1] = nv1[1]; }
            PG8_LDB(B0, 0, 0); PG8_LDB(B1, 0, 1); PG8_SCHED; PG8_LDA(At, 0, 0); PG8_STAGE(PG8_SA(1, 1), a1, cv1);
            PG8_WAIT_V(8); PG8_WAIT_L(0); PG8_BAR; if (act0) { PG8_MMA(0, 0, At, B0); PG8_MMA(0, 1, At, B1); } PG8_BAR; PG8_SCHED;
            PG8_LDA(At, 0, 1); PG8_STAGE(PG8_SB(0, 0), b2, voffB); PG8_STAGE(PG8_SB(0, 1), b2 + hstepB, voffB); PG8_STAGE(PG8_SA(0, 0), a2, s0);
            PG8_WAIT_V(8); PG8_WAIT_L(0); PG8_BAR; if (act1) { PG8_MMA(1, 0, At, B0); PG8_MMA(1, 1, At, B1); } PG8_BAR; PG8_SCHED;
            PG8_LDB(B0, 1, 0); PG8_LDB(B1, 1, 1); PG8_SCHED; PG8_LDA(At, 1, 0); PG8_STAGE(PG8_SA(0, 1), a2, s1);
            PG8_WAIT_V(8); PG8_WAIT_L(0); PG8_BAR; if (act0) { PG8_MMA(0, 0, At, B0); PG8_MMA(0, 1, At, B1); } PG8_BAR; PG8_SCHED;
            PG8_LDA(At, 1, 1); PG8_STAGE(PG8_SB(1, 0), b3, voffB); PG8_STAGE(PG8_SB(1, 1), b3 + hstepB, voffB); PG8_STAGE(PG8_SA(1, 0), a3, s0);
            PG8_WAIT_V(8); PG8_WAIT_L(0); PG8_BAR; if (act1) { PG8_MMA(1, 0, At, B0); PG8_MMA(1, 1, At, B1); } PG8_BAR; PG8_SCHED;
        }
        if (wr == 0) PG8_BAR;
        { Unit2 eu = cur; asm volatile("" : "+s"(eu.pm), "+s"(eu.pn), "+s"(eu.e), "+s"(eu.cnt), "+s"(eu.jt), "+s"(eu.ui));
          E(acc, eu, wr, wc, fr, fq);
          }
        if (!has_next) break;
#pragma unroll
        for (int a = 0; a < 2; ++a)
#pragma unroll
            for (int b = 0; b < 2; ++b)
#pragma unroll
                for (int m = 0; m < 4; ++m)
#pragma unroll
                    for (int n = 0; n < 2; ++n) acc[a][b][m][n] = (f32x4){0.f, 0.f, 0.f, 0.f};
        cur = nxt; cA = nA; cB = nB; ++ui;
#pragma unroll
        for (int i = 0; i < 2; ++i) { cv0[i] = nv0[i]; cv1[i] = nv1[i]; }
        if (wr == 1) PG8_BAR;
    }
    PG8_WAIT_V(0);
    PG8_BAR;
#undef PG8_AOFFS
#undef PG8_SA
#undef PG8_SB
#undef PG8_STAGE
#undef PG8_LDA
#undef PG8_LDB
#undef PG8_MMA
#undef PG8_WAIT_V
#undef PG8_WAIT_L
#undef PG8_BAR
#undef PG8_SCHED
}

struct DenseSched {
    StaticOrder so; const bf16_t* Bt; int ldb;
    __device__ __forceinline__ bool next(int i, Unit2& u) const { Unit t; if (!so.next(i, t)) return false; u.pm = t.pm; u.pn = t.pn; u.e = 0; u.cnt = 256; u.jt = 0; u.ui = i; return true; }
    __device__ __forceinline__ int arow(const Unit2& u, int r) const { return u.pm * BM + r; }
    __device__ __forceinline__ size_t aoff(const Unit2&) const { return 0; }
    __device__ __forceinline__ const char* bptr(const Unit2& u) const { return (const char*)(Bt + (size_t)u.pn * BM * ldb); }
};
struct EpiPlainBf16 {
    static constexpr bool PERM = true, AFTER_DRAIN = false;
    bf16_t* O; int ldc;
    __device__ __forceinline__ void operator()(const f32x4 (&acc)[2][2][4][2], const Unit2& u, int wr, int wc, int fr, int fq) const {
        const int row0 = u.pm * BM + wr * 64 + fr, col0 = u.pn * BM + wc * 32 + 8 * fq;
#pragma unroll
        for (int ai = 0; ai < 2; ++ai)
#pragma unroll
            for (int m = 0; m < 4; ++m) { bf16_t* rowp = O + (size_t)(row0 + ai * HALF + m * 16) * ldc + col0;
#pragma unroll
                for (int bj = 0; bj < 2; ++bj) { const f32x4 v0 = acc[ai][bj][m][0], v1 = acc[ai][bj][m][1];
                    u32x4 w; w.x = cvt_pk_bf16(v0[0], v0[1]); w.y = cvt_pk_bf16(v0[2], v0[3]); w.z = cvt_pk_bf16(v1[0], v1[1]); w.w = cvt_pk_bf16(v1[2], v1[3]);
                    *(u32x4*)(rowp + bj * HALF) = w; } }
    }
};
}
namespace nv {
constexpr int D = 1024, B = 8, S = 4096, T = B * S;
constexpr int FH = 8, FD = 64, GH = 4, GK = 64, GV = 128, RANK = 16;
constexpr int INW = 3096;
constexpr int O_FQ = 0, O_FK = 512, O_FV = 1024, O_FF = 1536, O_GQ = 1544, O_GK = 1800, O_GV = 2056, O_GA = 2568, O_GR = 2584;
constexpr int NE = 256, NG = 8, TOPK = 8, ED = 256;
constexpr float LN_EPS = 1e-5f;
constexpr float ALPHA = 1.189207115002721f;
constexpr int PADR = 64;
constexpr int APAD = T * TOPK + NE * PADR;

__device__ __forceinline__ float logsigmoidf(float x) { return fminf(x, 0.f) - log1pf(expf(-fabsf(x))); }
__device__ __forceinline__ float siluf(float x) { return x / (1.f + expf(-x)); }


__device__ __forceinline__ void ln_row(const float* in1, float a, const float* in2, const float* __restrict__ g, const float* __restrict__ b, float* out, int r, int tid, float* sh) {
    float4 v = ((const float4*)(in1 + (size_t)r * D))[tid];
    v.x *= a; v.y *= a; v.z *= a; v.w *= a;
    if (in2) { const float4 w = ((const float4*)(in2 + (size_t)r * D))[tid]; v.x += w.x; v.y += w.y; v.z += w.z; v.w += w.w; }
    float s = v.x + v.y + v.z + v.w;
    for (int o = 32; o > 0; o >>= 1) s += __shfl_xor(s, o);
    __syncthreads();
    if ((tid & 63) == 0) sh[tid >> 6] = s;
    __syncthreads();
    const float mean = (sh[0] + sh[1] + sh[2] + sh[3]) * (1.f / D);
    v.x -= mean; v.y -= mean; v.z -= mean; v.w -= mean;
    float q = v.x * v.x + v.y * v.y + v.z * v.z + v.w * v.w;
    for (int o = 32; o > 0; o >>= 1) q += __shfl_xor(q, o);
    if ((tid & 63) == 0) sh[4 + (tid >> 6)] = q;
    __syncthreads();
    const float rstd = rsqrtf((sh[4] + sh[5] + sh[6] + sh[7]) * (1.f / D) + LN_EPS);
    const float4 gg = ((const float4*)g)[tid], bb = ((const float4*)b)[tid];
    float4 o4; o4.x = v.x * rstd * gg.x + bb.x; o4.y = v.y * rstd * gg.y + bb.y; o4.z = v.z * rstd * gg.z + bb.z; o4.w = v.w * rstd * gg.w + bb.w;
    ((float4*)(out + (size_t)r * D))[tid] = o4;
}

__device__ __forceinline__ void gemm_tile(const float* A, const float* Bm, float* C, int N, int K, int lda, int ldb, int ldc, int tile_x, int tile_y, int tid, float* sh) {
    float (*As)[68] = (float (*)[68])sh;
    float (*Bs)[68] = (float (*)[68])(sh + 16 * 68);
    const int tx = tid & 15, ty = tid >> 4;
    const int row0 = tile_y * 64, col0 = tile_x * 64;
    float acc[4][4] = {};
    const int ar = tid >> 2, ak = (tid & 3) * 4;
    const int bk = tid >> 4, bc = (tid & 15) * 4;
    const bool bok = (col0 + bc) < N;
    for (int k0 = 0; k0 < K; k0 += 16) {
        const float4 av = *(const float4*)(A + (size_t)(row0 + ar) * lda + k0 + ak);
        float4 bv = make_float4(0.f, 0.f, 0.f, 0.f);
        if (bok) bv = *(const float4*)(Bm + (size_t)(k0 + bk) * ldb + col0 + bc);
        __syncthreads();
        As[ak + 0][ar] = av.x; As[ak + 1][ar] = av.y; As[ak + 2][ar] = av.z; As[ak + 3][ar] = av.w;
        *(float4*)&Bs[bk][bc] = bv;
        __syncthreads();
#pragma unroll
        for (int k = 0; k < 16; ++k) {
            const float4 a4 = *(const float4*)&As[k][ty * 4];
            const float4 b4 = *(const float4*)&Bs[k][tx * 4];
            const float aa[4] = {a4.x, a4.y, a4.z, a4.w}, bb[4] = {b4.x, b4.y, b4.z, b4.w};
#pragma unroll
            for (int i = 0; i < 4; ++i)
#pragma unroll
                for (int j = 0; j < 4; ++j) acc[i][j] += aa[i] * bb[j];
        }
    }
    if (col0 + tx * 4 < N) {
#pragma unroll
        for (int i = 0; i < 4; ++i)
            *(float4*)(C + (size_t)(row0 + ty * 4 + i) * ldc + col0 + tx * 4) = make_float4(acc[i][0], acc[i][1], acc[i][2], acc[i][3]);
    }
}
__device__ __forceinline__ void gemm_phase(const float* A, const float* Bm, float* C, int M, int N, int K, int lda, int ldb, int ldc, int half, int tid, float* sh) {
    const int ntx = (N + 63) / 64, nty = M / 64, ntile = ntx * nty, G2 = gridDim.x * 2;
    for (int t0 = blockIdx.x * 2; t0 < ntile; t0 += G2) {
        int tl = t0 + half; if (tl >= ntile) tl = ntile - 1;
        gemm_tile(A, Bm, C, N, K, lda, ldb, ldc, tl % ntx, tl / ntx, tid, sh);
    }
}

__device__ __forceinline__ void fox_prep(const float* proj, const float* __restrict__ bf, float* cbuf, int bh, int lane) {
    const int b = bh / FH, h = bh % FH;
    const float bias = bf[h];
    float s = 0.f;
    for (int i = 0; i < 64; ++i) { const int t = lane * 64 + i; s += logsigmoidf(proj[(size_t)(b * S + t) * INW + O_FF + h] + bias); }
    float inc = s;
    for (int o = 1; o < 64; o <<= 1) { const float n = __shfl_up(inc, o); if (lane >= o) inc += n; }
    float run = inc - s;
    for (int i = 0; i < 64; ++i) { const int t = lane * 64 + i; run += logsigmoidf(proj[(size_t)(b * S + t) * INW + O_FF + h] + bias); cbuf[(size_t)bh * S + t] = run; }
}

__device__ __forceinline__ void fox_attn(const float* proj, const float* cbuf, float* y, int blk, int lane) {
    const int qb = blk % (S / 64), bh = blk / (S / 64), b = bh / FH, h = bh % FH;
    const int t = qb * 64 + lane;
    const float* qp = proj + (size_t)(b * S + t) * INW + O_FQ + h * FD;
    float q[64], o[64];
#pragma unroll
    for (int d = 0; d < 64; ++d) { q[d] = qp[d] * 0.125f; o[d] = 0.f; }
    const float ct = cbuf[(size_t)bh * S + t];
    float m = -INFINITY, l = 0.f;
    const int smax = qb * 64 + 63;
    for (int s = 0; s <= smax; ++s) {
        const float* kp = proj + (size_t)(b * S + s) * INW + O_FK + h * FD;
        const float* vp = proj + (size_t)(b * S + s) * INW + O_FV + h * FD;
        float dot = 0.f;
#pragma unroll
        for (int d = 0; d < 64; ++d) dot += q[d] * kp[d];
        const float x = dot + (ct - cbuf[(size_t)bh * S + s]);
        if (s <= t) {
            if (x > m) { const float al = expf(m - x); l *= al;
#pragma unroll
                for (int d = 0; d < 64; ++d) o[d] *= al;
                m = x; }
            const float p = expf(x - m); l += p;
#pragma unroll
            for (int d = 0; d < 64; ++d) o[d] += p * vp[d];
        }
    }
    const float il = 1.f / l;
    float* yp = y + (size_t)(b * S + t) * D + h * FD;
#pragma unroll
    for (int d = 0; d < 64; ++d) yp[d] = o[d] * il;
}

__device__ __forceinline__ void gla_prep(const float* proj, const float* __restrict__ wgu, const float* __restrict__ bg, float* abuf, int t, int j) {
    const float* ga = proj + (size_t)t * INW + O_GA;
    float s = bg[j];
#pragma unroll
    for (int r = 0; r < RANK; ++r) s += ga[r] * wgu[r * 256 + j];
    abuf[(size_t)t * 256 + j] = expf(logsigmoidf(s) * (1.f / 16.f));
}

__device__ __forceinline__ void gla_rec(const float* proj, const float* abuf, float* glao, int bh, int e) {
    const int b = bh / GH, h = bh % GH;
    float st[64];
#pragma unroll
    for (int d = 0; d < 64; ++d) st[d] = 0.f;
    for (int s = 0; s < S; ++s) {
        const size_t t = (size_t)b * S + s;
        const float* qp = proj + t * INW + O_GQ + h * GK;
        const float* kp = proj + t * INW + O_GK + h * GK;
        const float* ap = abuf + t * 256 + h * GK;
        const float v = proj[t * INW + O_GV + h * GV + e];
        float o = 0.f;
#pragma unroll
        for (int d = 0; d < 64; ++d) { st[d] = ap[d] * st[d] + kp[d] * v; o += qp[d] * st[d]; }
        glao[t * 512 + h * GV + e] = o * 0.125f;
    }
}

__device__ __forceinline__ void gla_post(const float* glao, const float* proj, const float* __restrict__ g, float* y, int w, int lane) {
    const int t = w >> 2, h = w & 3;
    const float o0 = glao[(size_t)t * 512 + h * GV + lane], o1 = glao[(size_t)t * 512 + h * GV + 64 + lane];
    float ss = o0 * o0 + o1 * o1;
    for (int o = 32; o > 0; o >>= 1) ss += __shfl_xor(ss, o);
    const float r = rsqrtf(ss * (1.f / GV) + LN_EPS);
    const float g0 = proj[(size_t)t * INW + O_GR + h * GV + lane], g1 = proj[(size_t)t * INW + O_GR + h * GV + 64 + lane];
    y[(size_t)t * D + 512 + h * GV + lane] = o0 * r * g[lane] * siluf(g0);
    y[(size_t)t * D + 512 + h * GV + 64 + lane] = o1 * r * g[64 + lane] * siluf(g1);
}

__device__ __forceinline__ void route_token(const float* logits, const float* __restrict__ rbias, int* top_e, float* top_w, int* top_pos, int* counts, int t, int lane) {
    const float4 lg = ((const float4*)(logits + (size_t)t * NE))[lane];
    const float4 rb = ((const float4*)rbias)[lane];
    float sc[4] = {1.f / (1.f + expf(-lg.x)), 1.f / (1.f + expf(-lg.y)), 1.f / (1.f + expf(-lg.z)), 1.f / (1.f + expf(-lg.w))};
    float bv[4] = {sc[0] + rb.x, sc[1] + rb.y, sc[2] + rb.z, sc[3] + rb.w};
    float m1 = fmaxf(bv[0], bv[1]), m2 = fminf(bv[0], bv[1]);
    { const float a = fmaxf(bv[2], bv[3]), c = fminf(bv[2], bv[3]); const float n1 = fmaxf(m1, a); m2 = fmaxf(fminf(m1, a), fmaxf(m2, c)); m1 = n1; }
    for (int o = 1; o < 8; o <<= 1) { const float p1 = __shfl_xor(m1, o), p2 = __shfl_xor(m2, o); const float n1 = fmaxf(m1, p1); m2 = fmaxf(fminf(m1, p1), fmaxf(m2, p2)); m1 = n1; }
    const float gs = m1 + m2;
    const int myg = lane >> 3;
    int rank = 0;
#pragma unroll
    for (int g2 = 0; g2 < NG; ++g2) { const float og = __shfl(gs, g2 * 8); if (og > gs || (og == gs && g2 < myg)) ++rank; }
    const bool sel = rank < 4;
    float mv[4];
#pragma unroll
    for (int i = 0; i < 4; ++i) mv[i] = sel ? bv[i] : -INFINITY;
    int we[TOPK]; float ws[TOPK]; float wsum = 0.f;
#pragma unroll
    for (int k = 0; k < TOPK; ++k) {
        float bvv = mv[0]; int bi = 0;
#pragma unroll
        for (int i = 1; i < 4; ++i) if (mv[i] > bvv) { bvv = mv[i]; bi = i; }
        int gi = lane * 4 + bi;
        for (int o = 32; o > 0; o >>= 1) { const float ov = __shfl_xor(bvv, o); const int oi = __shfl_xor(gi, o); if (ov > bvv || (ov == bvv && oi < gi)) { bvv = ov; gi = oi; } }
        const int ol = gi >> 2, oi = gi & 3;
        const float s_own = (oi == 0) ? sc[0] : (oi == 1) ? sc[1] : (oi == 2) ? sc[2] : sc[3];
        const float sw = __shfl(s_own, ol);
        if (lane == ol) { if (oi == 0) mv[0] = -INFINITY; else if (oi == 1) mv[1] = -INFINITY; else if (oi == 2) mv[2] = -INFINITY; else mv[3] = -INFINITY; }
        we[k] = gi; ws[k] = sw; wsum += sw;
    }
    if (lane == 0) {
        const float inv = 2.5f / wsum;
#pragma unroll
        for (int k = 0; k < TOPK; ++k) {
            top_e[t * TOPK + k] = we[k]; top_w[t * TOPK + k] = ws[k] * inv;
            top_pos[t * TOPK + k] = atomicAdd(&counts[we[k]], 1);
        }
    }
}

__device__ __forceinline__ void moe_offsets(const int* counts, int* off, int* blk_exp, int* nblk, int lane) {
    int pc[4], st[4]; int tot = 0;
#pragma unroll
    for (int i = 0; i < 4; ++i) { pc[i] = (counts[lane * 4 + i] + PADR - 1) / PADR * PADR; st[i] = tot; tot += pc[i]; }
    int inc = tot;
    for (int o = 1; o < 64; o <<= 1) { const int n = __shfl_up(inc, o); if (lane >= o) inc += n; }
    const int base = inc - tot;
#pragma unroll
    for (int i = 0; i < 4; ++i) { const int start = base + st[i]; off[lane * 4 + i] = start; for (int k = start / PADR; k < (start + pc[i]) / PADR; ++k) blk_exp[k] = lane * 4 + i; }
    if (lane == 63) nblk[0] = inc / PADR;
}

__device__ __forceinline__ void moe_scatter(const int* top_e, const float* top_w, const int* top_pos, const int* off, int* row_tok, float* row_gate, int* slot_of, int a) {
    const int slot = off[top_e[a]] + top_pos[a];
    row_tok[slot] = a / TOPK; row_gate[slot] = top_w[a]; slot_of[a] = slot;
}

__device__ __forceinline__ void moe_hidden(const float* h1, const float* __restrict__ wg, const float* __restrict__ wu, const int* row_tok, const float* row_gate, const int* blk_exp, const int* nblk,
                                           float* hidden, int g16, int j, float* sh) {
    const bool active = g16 * 16 < nblk[0] * PADR;
    float (*xs)[D] = (float (*)[D])sh;
    __syncthreads();
    if (active) for (int r = 0; r < 16; ++r) { const int tok = row_tok[g16 * 16 + r]; ((float4*)xs[r])[j] = ((const float4*)(h1 + (size_t)tok * D))[j]; }
    __syncthreads();
    if (!active) return;
    const int e = blk_exp[(g16 * 16) / PADR];
    float ag[16], au[16];
#pragma unroll
    for (int r = 0; r < 16; ++r) { ag[r] = 0.f; au[r] = 0.f; }
    const float* wgp = wg + (size_t)e * D * ED + j; const float* wup = wu + (size_t)e * D * ED + j;
    for (int d = 0; d < D; d += 4) {
        const float g0 = wgp[(size_t)(d + 0) * ED], g1 = wgp[(size_t)(d + 1) * ED], g2 = wgp[(size_t)(d + 2) * ED], g3 = wgp[(size_t)(d + 3) * ED];
        const float u0 = wup[(size_t)(d + 0) * ED], u1 = wup[(size_t)(d + 1) * ED], u2 = wup[(size_t)(d + 2) * ED], u3 = wup[(size_t)(d + 3) * ED];
#pragma unroll
        for (int r = 0; r < 16; ++r) { const float4 x = *(const float4*)&xs[r][d];
            ag[r] += x.x * g0 + x.y * g1 + x.z * g2 + x.w * g3; au[r] += x.x * u0 + x.y * u1 + x.z * u2 + x.w * u3; }
    }
#pragma unroll
    for (int r = 0; r < 16; ++r) hidden[(size_t)(g16 * 16 + r) * ED + j] = row_gate[g16 * 16 + r] * siluf(ag[r]) * au[r];
}

__device__ __forceinline__ void moe_down(const float* hidden, const float* __restrict__ wd, const int* top_e, const int* slot_of, float* ffn, int t, int i, float* sh) {
    float4 acc = ((float4*)(ffn + (size_t)t * D))[i];
    for (int k = 0; k < TOPK; ++k) {
        const int e = top_e[t * TOPK + k], slot = slot_of[t * TOPK + k];
        __syncthreads();
        sh[i] = hidden[(size_t)slot * ED + i];
        __syncthreads();
        const float4* wp = (const float4*)(wd + (size_t)e * ED * D) + i;
        for (int j = 0; j < ED; ++j) { const float4 w = wp[(size_t)j * (D / 4)]; const float hv = sh[j]; acc.x += hv * w.x; acc.y += hv * w.y; acc.z += hv * w.z; acc.w += hv * w.w; }
    }
    ((float4*)(ffn + (size_t)t * D))[i] = acc;
}
}
#include <hip/hip_bf16.h>
#include <cmath>
namespace attn_body {
using bf16=__hip_bfloat16;
using bf16x8=__attribute__((ext_vector_type(8)))short;
using s16x4=__attribute__((ext_vector_type(4)))short;
using f32x16=__attribute__((ext_vector_type(16)))float;
using u32x4=__attribute__((ext_vector_type(4)))unsigned;
constexpr int BATCH=8,NHEAD=8,SEQ=4096,D=64,DM=3072,OPITCH=1024;
constexpr int NW=8,QBLK=32,QB=QBLK*NW,KVBLK=64,NQB=SEQ/QB;
constexpr int ATTN_PITCH=DM, ATTN_UNIT_ROWS=QB;
__device__ __forceinline__ int crow(int r,int hi){return (r&3)+8*(r>>2)+4*hi;}
#define SBAR() __builtin_amdgcn_sched_barrier(0)
__device__ __forceinline__ void cmask(f32x16&p0,f32x16&p1,int jb,int qrel,int hi){
  const float NEG=-INFINITY; int kb=64*jb+4*hi;
  #pragma unroll
  for(int r=0;r<16;++r){int kv=kb+(r&3)+8*(r>>2); if(kv>qrel)p0[r]=NEG; if(kv+32>qrel)p1[r]=NEG;}
}

constexpr int NSLOT=3, SLOTB=8192;
constexpr int LDS_K=0, LDS_V=NSLOT*SLOTB, LDS_WS=2*NSLOT*SLOTB, LDS_OST=LDS_WS+NW*64*4, LDS_KB=LDS_OST+NW*4096, LDS_BYTES=LDS_KB+(SEQ+2)*8;
constexpr float C2=0.125f*1.4426950408889634f;
__device__ __forceinline__ void glds16(const void*gsrc,unsigned lds_dst){unsigned keep;
  asm volatile("s_mov_b32 %0, m0\n\ts_mov_b32 m0, %2\n\ts_nop 0\n\tglobal_load_lds_dwordx4 %1, off\n\ts_mov_b32 m0, %0":"=&s"(keep):"v"(gsrc),"s"(lds_dst):"memory");}
__device__ __forceinline__ float max3f(float a,float b,float c){float r;asm("v_max3_f32 %0, %1, %2, %3":"=v"(r):"v"(a),"v"(b),"v"(c));return r;}
__device__ __forceinline__ float max2f(float a,float b){float r;asm("v_max_f32_e32 %0, %1, %2":"=v"(r):"v"(a),"v"(b));return r;}
__device__ __forceinline__ float fadd_s(float a,float b){float r;asm("v_add_f32_e32 %0, %1, %2":"=v"(r):"v"(a),"v"(b));return r;}
__device__ __forceinline__ float fsub_s(float a,float b){float r;asm("v_sub_f32_e32 %0, %1, %2":"=v"(r):"v"(a),"v"(b));return r;}
typedef float f32x2_t __attribute__((ext_vector_type(2))); typedef float f32x4_t __attribute__((ext_vector_type(4))); typedef __bf16 bf16x2_t __attribute__((ext_vector_type(2)));
__device__ __forceinline__ unsigned cvtpk_s(float lo,float hi){f32x2_t v={lo,hi};bf16x2_t b=__builtin_convertvector(v,bf16x2_t);return __builtin_bit_cast(unsigned,b);}
#define WAIT_BAR(N) asm volatile("s_waitcnt vmcnt(" #N ") lgkmcnt(0)\n\ts_barrier":::"memory")

__device__ __forceinline__ void split3(float b,unsigned&h,unsigned&m,unsigned&l){
  h=cvtpk_s(b,0.f)&0xffffu; const float r1=b-__uint_as_float(h<<16);
  m=cvtpk_s(r1,0.f)&0xffffu; const float r2=r1-__uint_as_float(m<<16);
  l=cvtpk_s(r2,0.f)&0xffffu; }
__device__ __forceinline__ bf16x8 kbias_frag(float b,int hi){unsigned h,m,l;split3(b,h,m,l);u32x4 w;w.x=h|(m<<16);w.y=l|0x3F800000u;w.z=0x3F803F80u;w.w=0u;if(hi){w.x=0u;w.y=0u;w.z=0u;}return __builtin_bit_cast(bf16x8,w);}
__device__ __forceinline__ bf16x8 qref_frag(float x,int hi){unsigned h,m,l;split3(x,h,m,l);u32x4 w;w.x=0x3F803F80u;w.y=0x3F80u|(h<<16);w.z=m|(l<<16);w.w=0u;if(hi){w.x=0u;w.y=0u;w.z=0u;}return __builtin_bit_cast(bf16x8,w);}
typedef unsigned u32x2_t __attribute__((ext_vector_type(2)));
__device__ __forceinline__ bf16x8 mkfrag(u32x2_t e,unsigned zc){u32x4 w;w.x=e.x;w.y=e.y;w.z=zc;w.w=0u;return __builtin_bit_cast(bf16x8,w);}
__device__ __forceinline__ void fox_bias_table(int b,int h,const float*LF,char*shm){
  int tid_=threadIdx.x; asm volatile("":"+v"(tid_)); const int tid=tid_,lane=tid&63,wid=__builtin_amdgcn_readfirstlane(tid>>6);
  const float*lf=LF+((long)b*NHEAD+h)*SEQ; float*wt=(float*)(shm+LDS_WS); u32x2_t*KB8=(u32x2_t*)(shm+LDS_KB);
  f32x4_t va=*(const f32x4_t*)(lf+8*tid),vb=*(const f32x4_t*)(lf+8*tid+4);
  va[1]+=va[0];va[2]+=va[1];va[3]+=va[2];vb[0]+=va[3];vb[1]+=vb[0];vb[2]+=vb[1];vb[3]+=vb[2];
  const float tot=vb[3]; float inc=tot;
  #pragma unroll
  for(int o_=1;o_<64;o_<<=1){const float nn=__shfl_up(inc,o_);if(lane>=o_)inc+=nn;}
  __syncthreads();
  if(lane==63)wt[wid*64]=inc;
  __syncthreads();
  float base=inc-tot;
  #pragma unroll
  for(int w_=0;w_<NW;++w_){const float x_=wt[w_*64]; if(w_<wid)base+=x_;}
  const float cv[8]={va[0]+base,va[1]+base,va[2]+base,va[3]+base,vb[0]+base,vb[1]+base,vb[2]+base,vb[3]+base};
  #pragma unroll
  for(int j=0;j<8;++j){unsigned hh,mm,ll;split3(-cv[j],hh,mm,ll);KB8[8*tid+j]=(u32x2_t){hh|(mm<<16),ll|0x3F800000u};}
  if(tid==0){KB8[SEQ]=(u32x2_t){0u,0u};KB8[SEQ+1]=(u32x2_t){0u,0u};}
  __syncthreads();
}
__device__ __forceinline__ void qkt(f32x16&p0,f32x16&p1,const char*Kslot,const bf16x8*qr,bf16x8 kb0,bf16x8 kb1,bf16x8 qx,int r32,int hi){
  const f32x16 negm=f32x16{};
  const char*kb=Kslot+hi*1024+r32*16;
  #pragma unroll
  for(int d0=0;d0<4;++d0){
    const bf16x8 b0=*reinterpret_cast<const bf16x8*>(kb+d0*2048);
    const bf16x8 b1=*reinterpret_cast<const bf16x8*>(kb+d0*2048+512);
    if(d0==0){p0=__builtin_amdgcn_mfma_f32_32x32x16_bf16(b0,qr[0],negm,0,0,0);p1=__builtin_amdgcn_mfma_f32_32x32x16_bf16(b1,qr[0],negm,0,0,0);}
    else{p0=__builtin_amdgcn_mfma_f32_32x32x16_bf16(b0,qr[d0],p0,0,0,0);p1=__builtin_amdgcn_mfma_f32_32x32x16_bf16(b1,qr[d0],p1,0,0,0);}}
  p0=__builtin_amdgcn_mfma_f32_32x32x16_bf16(kb0,qx,p0,0,0,0);p1=__builtin_amdgcn_mfma_f32_32x32x16_bf16(kb1,qx,p1,0,0,0);
}
typedef __attribute__((address_space(3))) const char* lds_cptr;
typedef short v4i16_t __attribute__((ext_vector_type(4)));
__device__ __forceinline__ void kload8(bf16x8*kf,lds_cptr kp){
  kf[0]=*(const __attribute__((address_space(3))) bf16x8*)(kp);      kf[1]=*(const __attribute__((address_space(3))) bf16x8*)(kp+512);
  kf[2]=*(const __attribute__((address_space(3))) bf16x8*)(kp+2048); kf[3]=*(const __attribute__((address_space(3))) bf16x8*)(kp+2560);
  kf[4]=*(const __attribute__((address_space(3))) bf16x8*)(kp+4096); kf[5]=*(const __attribute__((address_space(3))) bf16x8*)(kp+4608);
  kf[6]=*(const __attribute__((address_space(3))) bf16x8*)(kp+6144); kf[7]=*(const __attribute__((address_space(3))) bf16x8*)(kp+6656);
}
__device__ __forceinline__ void kload2(bf16x8*kf,lds_cptr kp,int j){ kf[2*j]=*(const __attribute__((address_space(3))) bf16x8*)(kp+j*2048); kf[2*j+1]=*(const __attribute__((address_space(3))) bf16x8*)(kp+j*2048+512); }
__device__ __forceinline__ s16x4 vtr(lds_cptr p){ return __builtin_bit_cast(s16x4,__builtin_amdgcn_ds_read_tr16_b64_v4i16((__attribute__((address_space(3))) v4i16_t*)p)); }
__device__ __forceinline__ float rowmax(const f32x16&p0,const f32x16&p1){
  float a=max3f(p0[0],p0[1],p1[0]),b=max3f(p0[2],p0[3],p1[1]);a=max3f(a,p1[2],p1[3]);
  #pragma unroll
  for(int r=4;r<16;r+=4){a=max3f(a,p0[r],p0[r+1]);b=max3f(b,p0[r+2],p0[r+3]);a=max3f(a,p1[r],p1[r+1]);b=max3f(b,p1[r+2],p1[r+3]);}
  const float m=max2f(a,b);
  auto rr=__builtin_amdgcn_permlane32_swap(__float_as_uint(m),__float_as_uint(m),false,false);
  return max2f(__uint_as_float(rr[0]),__uint_as_float(rr[1]));
}
__device__ __forceinline__ void pv(f32x16*o,int vb,bf16x8 pa0,bf16x8 pa1,bf16x8 pa2,bf16x8 pa3){
  #pragma unroll
  for(int d0=0;d0<2;++d0){s16x4 lo[4],hi[4];
    #pragma unroll
    for(int ks=0;ks<4;++ks){
      asm volatile("ds_read_b64_tr_b16 %0,%1 offset:%c2":"=&v"(lo[ks]):"v"(vb),"i"(d0*4096+ks*1024):"memory");
      asm volatile("ds_read_b64_tr_b16 %0,%1 offset:%c2":"=&v"(hi[ks]):"v"(vb),"i"(d0*4096+ks*1024+512):"memory");}
    asm volatile("s_waitcnt lgkmcnt(0)":::"memory");SBAR();
    #define PK(k) (bf16x8){lo[k][0],lo[k][1],lo[k][2],lo[k][3],hi[k][0],hi[k][1],hi[k][2],hi[k][3]}
    o[d0]=__builtin_amdgcn_mfma_f32_32x32x16_bf16(pa0,PK(0),o[d0],0,0,0);
    o[d0]=__builtin_amdgcn_mfma_f32_32x32x16_bf16(pa1,PK(1),o[d0],0,0,0);
    o[d0]=__builtin_amdgcn_mfma_f32_32x32x16_bf16(pa2,PK(2),o[d0],0,0,0);
    o[d0]=__builtin_amdgcn_mfma_f32_32x32x16_bf16(pa3,PK(3),o[d0],0,0,0);
    #undef PK
  }
}

#ifndef ATTN_STORE16
#define ATTN_STORE16(p,v) (*(u32x4*)(p)=(v))
#endif
template<int THRL> __device__ __forceinline__ void attn_unit(int b,int h,int qb,const bf16*Q,const bf16* K,const bf16* V,bf16*O,const float*LF,const unsigned*NRM,char*shm){
  int tid_=threadIdx.x; asm volatile("":"+v"(tid_));
  const int tid=tid_,lane=tid&63,r32=lane&31,hi=lane>>5; const int wid=__builtin_amdgcn_readfirstlane(tid>>6);
  const long rowbase=(long)b*SEQ; const int q0=qb*QB;
  const char*KBt0=shm+LDS_KB;
  int t0;
  { const int NT0=(q0+QB)/KVBLK; const unsigned*nr=NRM+(b*NHEAD+h)*4;
    const float qn2=__uint_as_float(nr[0])+__uint_as_float(nr[1]), kn2=__uint_as_float(nr[2])+__uint_as_float(nr[3]);
    const float thr=-(50.f+2.04f*sqrtf(qn2*kn2));
    const u32x2_t eq0=*(const u32x2_t*)(KBt0+(unsigned)q0*8u); const float bq0=__uint_as_float(eq0.x<<16)+__uint_as_float(eq0.x&0xffff0000u)+__uint_as_float(eq0.y<<16);
    bool ok=(2*lane<=NT0-4);
    if(ok&&lane>0){ const u32x2_t el=*(const u32x2_t*)(KBt0+(unsigned)(128*lane-1)*8u); const float bl=__uint_as_float(el.x<<16)+__uint_as_float(el.x&0xffff0000u)+__uint_as_float(el.y<<16); ok=(bl-bq0<thr); }
    const unsigned long long mk=__ballot(ok); const unsigned long long low=~mk; const int cnt=(low==0ull)?64:__builtin_ctzll(low);
    t0=__builtin_amdgcn_readfirstlane(2*(cnt-1)); }
  const char*KBt=KBt0+(hi?0:t0*512); const unsigned kb_o0=hi?(unsigned)SEQ*8u:(unsigned)r32*8u, kb_o1=hi?(unsigned)SEQ*8u:(unsigned)(r32+32)*8u, kb_str=hi?0u:512u, zc=hi?0u:0x3F803F80u;
  const bf16*Qw=Q+(rowbase+q0+wid*QBLK)*DM+h*D;
  const bf16*Kh=K+(rowbase+(long)t0*KVBLK)*DM+h*D,*Vh=V+(rowbase+(long)t0*KVBLK)*DM+h*D;
  const unsigned lds0=(unsigned)(uintptr_t)shm;
  float*wsf=(float*)(shm+LDS_WS)+wid*64;
  const bf16*ksrc=Kh+(long)lane*DM+wid*8;
  const bf16*vsrc=Vh+(long)(16*(wid&3)+(lane>>2))*DM+(wid>>2)*32+(lane&3)*8;
  const unsigned kdst=lds0+LDS_K+wid*1024, vdst=lds0+LDS_V+wid*1024;
  #define DMA_K(t,slot) glds16(ksrc+(long)(t)*KVBLK*DM,(unsigned)__builtin_amdgcn_readfirstlane(kdst+(slot)))
  #define DMA_V(t,slot) glds16(vsrc+(long)(t)*KVBLK*DM,(unsigned)__builtin_amdgcn_readfirstlane(vdst+(slot)))
  const int vb0=(int)(lds0+LDS_V)+((lane>>4)&1)*32+(lane&3)*8+(4*hi+((lane&15)>>2))*64;
  const char*Kbase=shm+LDS_K; bf16x8 kf[8];
  const lds_cptr shm3=(lds_cptr)shm; const lds_cptr kp0=shm3+LDS_K+hi*1024+r32*16; const lds_cptr vp0=shm3+LDS_V+((lane>>4)&1)*32+(lane&3)*8+(4*hi+((lane&15)>>2))*64;
  const int NT=(q0+QB)/KVBLK-t0;
  DMA_K(0,0);DMA_V(0,0);DMA_K(1,SLOTB);
  bf16x8 qr[4];
  #pragma unroll
  for(int d0=0;d0<4;++d0)qr[d0]=*reinterpret_cast<const bf16x8*>(&Qw[(long)r32*DM+d0*16+hi*8]);
  float mhat; { const u32x2_t eq=*(const u32x2_t*)(KBt0+(unsigned)(q0+wid*QBLK+r32)*8u); mhat=__uint_as_float(eq.x<<16)+__uint_as_float(eq.x&0xffff0000u)+__uint_as_float(eq.y<<16); }
  float l_reg=0.f;f32x16 o[2];o[0]=f32x16{};o[1]=f32x16{};const f32x16 negm=f32x16{};
  bf16x8 qx=qref_frag(-mhat,hi);
  const int qrel=wid*QBLK+r32;
  #define CMASK(P0,P1,t) do{int jb_=(t)-(NT-4); if(jb_>=0)cmask(P0,P1,jb_,qrel,hi);}while(0)
  bool resc=false;
  #define START(P0,P1) do{ const float rm=rowmax(P0,P1); resc=false; \
    { const float dl=__builtin_fmaxf(rm,0.f); mhat=fadd_s(mhat,dl); \
      _Pragma("unroll") for(int r=0;r<16;++r){P0[r]=fsub_s(P0[r],dl);P1[r]=fsub_s(P1[r],dl);} \
      qx=qref_frag(-mhat,hi); } \
    _Pragma("unroll") for(int r=0;r<16;++r)P0[r]=__builtin_amdgcn_exp2f(P0[r]); }while(0)
  #define RESC() do{ if(resc){ asm volatile("s_waitcnt lgkmcnt(0)":::"memory"); \
      _Pragma("unroll") for(int d_=0;d_<2;++d_) _Pragma("unroll") for(int r=0;r<16;++r)o[d_][r]*=wsf[crow(r,hi)]; } }while(0)
  f32x16 pA0,pA1,pB0,pB1;
  int sl_prev=0,sl_cur=0,sl_next=SLOTB;
  #define ROT() do{sl_prev=sl_cur;sl_cur=sl_next;sl_next=(sl_next==(NSLOT-1)*SLOTB)?0:sl_next+SLOTB;}while(0)
  DMA_K(2,2*SLOTB);
  WAIT_BAR(3);
  qkt(pA0,pA1,Kbase,qr,mkfrag(*(const u32x2_t*)(KBt+kb_o0),zc),mkfrag(*(const u32x2_t*)(KBt+kb_o1),zc),qx,r32,hi);asm volatile("s_nop 15\n\ts_nop 7":"+v"(pA0),"+v"(pA1));CMASK(pA0,pA1,0);
  START(pA0,pA1);
  _Pragma("unroll") for(int r=0;r<16;++r)pA1[r]=__builtin_amdgcn_exp2f(pA1[r]);
  WAIT_BAR(0);
  DMA_K(3,0);DMA_V(1,SLOTB);
  ROT();
  kload8(kf,kp0+sl_cur);
  WAIT_BAR(2);
  s16x4 vlo[8],vhi[8]; u32x4 pw0,pw1,pw2,pw3;
  #define PKW(P,B) cvtpk_s(P[B],P[B+1])
  #define PAF(k) __builtin_bit_cast(bf16x8,pw##k)
  #define VFR(i) (bf16x8){vlo[i][0],vlo[i][1],vlo[i][2],vlo[i][3],vhi[i][0],vhi[i][1],vhi[i][2],vhi[i][3]}
  #define PIN(x) asm volatile("":"+v"(x))
  #define MX3(a,b,c) __builtin_fmaxf(__builtin_fmaxf((a),(b)),(c))
  #define GAPA(MF,A0,A1,A2,A3,W0,W1,PW) do{ MF; sacc+=A0; sacc+=A1; sacc+=A2; sacc+=A3; PIN(sacc); W0; W1; PIN(PW); SBAR(); }while(0)
  #define EX(v) __builtin_amdgcn_exp2f(v)
  #define GAPB(MF,X,B) do{ MF; X[B]=EX(X[B]); X[B+1]=EX(X[B+1]); X[B+2]=EX(X[B+2]); X[B+3]=EX(X[B+3]); PIN(X); SBAR(); }while(0)
  #define VRD(i) do{ vlo[i]=vtr(vp_+(((i)>>2)*4096+((i)&3)*1024)); vhi[i]=vtr(vp_+(((i)>>2)*4096+((i)&3)*1024+512)); }while(0)
  #define KRD(G,j) do{ if(G){ kload2(kf,kp0+sl_next,j); SBAR(); } }while(0)
  #define STEP(C0,C1,P0,P1,t,GK,GV,GL) do{ SBAR(); \
    const lds_cptr vp_=vp0+sl_prev; const u32x2_t e0_=*(const u32x2_t*)(KBt+kb_o0+(unsigned)(t)*kb_str),e1_=*(const u32x2_t*)(KBt+kb_o1+(unsigned)(t)*kb_str); \
    VRD(0); SBAR(); float sacc=(P0[0]+P0[1]); \
    GAPA(C0=__builtin_amdgcn_mfma_f32_32x32x16_bf16(kf[0],qr[0],negm,0,0,0), P0[2],P0[3],P0[4],P0[5],     pw0[0]=PKW(P0,0), pw0[1]=PKW(P0,2), pw0); \
    VRD(4); SBAR(); GAPA(C1=__builtin_amdgcn_mfma_f32_32x32x16_bf16(kf[1],qr[0],negm,0,0,0), P0[6],P0[7],P0[8],P0[9],     pw0[2]=PKW(P0,4), pw0[3]=PKW(P0,6), pw0); \
    VRD(1); SBAR(); GAPA(C0=__builtin_amdgcn_mfma_f32_32x32x16_bf16(kf[2],qr[1],C0,0,0,0),   P0[10],P0[11],P0[12],P0[13], pw1[0]=PKW(P0,8), pw1[1]=PKW(P0,10), pw1); \
    VRD(5); SBAR(); GAPA(C1=__builtin_amdgcn_mfma_f32_32x32x16_bf16(kf[3],qr[1],C1,0,0,0),   P0[14],P0[15],P1[0],P1[1],   pw1[2]=PKW(P0,12),pw1[3]=PKW(P0,14), pw1); \
    VRD(2); SBAR(); GAPA(C0=__builtin_amdgcn_mfma_f32_32x32x16_bf16(kf[4],qr[2],C0,0,0,0),   P1[2],P1[3],P1[4],P1[5],     pw2[0]=PKW(P1,0), pw2[1]=PKW(P1,2), pw2); \
    VRD(6); SBAR(); GAPA(C1=__builtin_amdgcn_mfma_f32_32x32x16_bf16(kf[5],qr[2],C1,0,0,0),   P1[6],P1[7],P1[8],P1[9],     pw2[2]=PKW(P1,4), pw2[3]=PKW(P1,6), pw2); \
    VRD(3); SBAR(); GAPA(C0=__builtin_amdgcn_mfma_f32_32x32x16_bf16(kf[6],qr[3],C0,0,0,0),   P1[10],P1[11],P1[12],P1[13], pw3[0]=PKW(P1,8), pw3[1]=PKW(P1,10), pw3); \
    VRD(7); SBAR(); GAPA(C1=__builtin_amdgcn_mfma_f32_32x32x16_bf16(kf[7],qr[3],C1,0,0,0),   P1[14],P1[15],0.f,0.f,       pw3[2]=PKW(P1,12),pw3[3]=PKW(P1,14), pw3); \
    { const bf16x8 kb0_=mkfrag(e0_,zc),kb1_=mkfrag(e1_,zc); C0=__builtin_amdgcn_mfma_f32_32x32x16_bf16(kb0_,qx,C0,0,0,0); C1=__builtin_amdgcn_mfma_f32_32x32x16_bf16(kb1_,qx,C1,0,0,0); } SBAR(); \
    l_reg+=sacc; \
    if(GK){DMA_K((t)+3,sl_cur);} if(GV){DMA_V((t)+1,sl_next);} \
    CMASK(C0,C1,t); \
    { float a=MX3(C0[0],C0[1],C1[0]),b=MX3(C0[2],C0[3],C1[1]); a=MX3(a,C1[2],C1[3]); \
      _Pragma("unroll") for(int r=4;r<16;r+=4){a=MX3(a,C0[r],C0[r+1]);b=MX3(b,C0[r+2],C0[r+3]);a=MX3(a,C1[r],C1[r+1]);b=MX3(b,C1[r+2],C1[r+3]);} \
      float rm=__builtin_fmaxf(a,b); { auto rr=__builtin_amdgcn_permlane32_swap(__float_as_uint(rm),__float_as_uint(rm),false,false); rm=__builtin_fmaxf(__uint_as_float(rr[0]),__uint_as_float(rr[1])); } \
      resc=false; \
      if(__builtin_expect(__any(rm>(float)THRL),0)){ const float dl=__builtin_fmaxf(rm,0.f); mhat+=dl; \
        _Pragma("unroll") for(int r=0;r<16;++r){C0[r]-=dl;C1[r]-=dl;} \
        qx=qref_frag(-mhat,hi); \
        const float f=__builtin_amdgcn_exp2f(-dl); l_reg*=f; if(hi==0)wsf[r32]=f; resc=true; } } \
    SBAR(); \
    GAPB(o[0]=__builtin_amdgcn_mfma_f32_32x32x16_bf16(PAF(0),VFR(0),o[0],0,0,0), C0,0); \
    GAPB(o[1]=__builtin_amdgcn_mfma_f32_32x32x16_bf16(PAF(0),VFR(4),o[1],0,0,0), C0,4); \
    KRD(GL,0); GAPB(o[0]=__builtin_amdgcn_mfma_f32_32x32x16_bf16(PAF(1),VFR(1),o[0],0,0,0), C0,8); \
    KRD(GL,1); GAPB(o[1]=__builtin_amdgcn_mfma_f32_32x32x16_bf16(PAF(1),VFR(5),o[1],0,0,0), C0,12); \
    KRD(GL,2); GAPB(o[0]=__builtin_amdgcn_mfma_f32_32x32x16_bf16(PAF(2),VFR(2),o[0],0,0,0), C1,0); \
    KRD(GL,3); GAPB(o[1]=__builtin_amdgcn_mfma_f32_32x32x16_bf16(PAF(2),VFR(6),o[1],0,0,0), C1,4); \
    GAPB(o[0]=__builtin_amdgcn_mfma_f32_32x32x16_bf16(PAF(3),VFR(3),o[0],0,0,0), C1,8); \
    GAPB(o[1]=__builtin_amdgcn_mfma_f32_32x32x16_bf16(PAF(3),VFR(7),o[1],0,0,0), C1,12); \
    }while(0)
  int t=1;
  #undef CMASK
  #define CMASK(P0,P1,t) do{}while(0)
  for(;t+5<NT;t+=2){
    STEP(pB0,pB1,pA0,pA1,t,true,true,true);     WAIT_BAR(2); RESC(); ROT();
    STEP(pA0,pA1,pB0,pB1,t+1,true,true,true);   WAIT_BAR(2); RESC(); ROT();
  }
  #undef CMASK
  #define CMASK(P0,P1,t) do{int jb_=(t)-(NT-4); if(jb_>=0)cmask(P0,P1,jb_,qrel,hi);}while(0)
  #define ENDW(tt) do{ if((tt)+3<NT){WAIT_BAR(2);} else if((tt)+2<NT){WAIT_BAR(1);} else {WAIT_BAR(0);} }while(0)
  for(;t+1<NT;t+=2){
    STEP(pB0,pB1,pA0,pA1,t,(t+3<NT),(t+1<NT),(t+1<NT));       ENDW(t);   RESC(); ROT();
    STEP(pA0,pA1,pB0,pB1,t+1,(t+4<NT),(t+2<NT),(t+2<NT));     ENDW(t+1); RESC(); ROT();
  }
  STEP(pB0,pB1,pA0,pA1,NT-1,false,false,false); RESC();
  { float sacc=pB0[0]+pB0[1]; _Pragma("unroll") for(int r=2;r<16;++r)sacc+=pB0[r]; _Pragma("unroll") for(int r=0;r<16;++r)sacc+=pB1[r]; l_reg+=sacc;
    pw0=(u32x4){PKW(pB0,0),PKW(pB0,2),PKW(pB0,4),PKW(pB0,6)};pw1=(u32x4){PKW(pB0,8),PKW(pB0,10),PKW(pB0,12),PKW(pB0,14)};pw2=(u32x4){PKW(pB1,0),PKW(pB1,2),PKW(pB1,4),PKW(pB1,6)};pw3=(u32x4){PKW(pB1,8),PKW(pB1,10),PKW(pB1,12),PKW(pB1,14)};
    SBAR(); pv(o,vb0+sl_cur,PAF(0),PAF(1),PAF(2),PAF(3)); }
  #undef PKW
  #undef PAF
  #undef VFR
  #undef PIN
  #undef MX3
  #undef GAPA
  #undef GAPB
  #undef EX
  #undef VRD
  #undef KRD
  #undef STEP
  #undef ENDW
  {auto rr=__builtin_amdgcn_permlane32_swap(__float_as_uint(l_reg),__float_as_uint(l_reg),false,false);l_reg=__uint_as_float(rr[0])+__uint_as_float(rr[1]);}
  if(hi==0)wsf[32+r32]=l_reg;asm volatile("s_waitcnt lgkmcnt(0)":::"memory");
  float rli[16];
  #pragma unroll
  for(int r=0;r<16;++r)rli[r]=__builtin_amdgcn_rcpf(wsf[32+crow(r,hi)]);
  bf16*Ow=O+(rowbase+q0+wid*QBLK)*OPITCH+h*D;
  { bf16*stg=(bf16*)(shm+LDS_OST)+wid*2048;
    #pragma unroll
    for(int r=0;r<16;++r){const int orow=crow(r,hi);
      #pragma unroll
      for(int d0=0;d0<2;++d0)stg[orow*64+d0*32+r32]=__float2bfloat16(o[d0][r]*rli[r]);}
    asm volatile("s_waitcnt lgkmcnt(0)":::"memory");
    #pragma unroll
    for(int i=0;i<4;++i){const int row=i*8+(lane>>3),ch=lane&7; const u32x4 v=*(const u32x4*)(stg+row*64+ch*8); ATTN_STORE16(Ow+(long)row*OPITCH+ch*8,v);} }
  asm volatile("s_waitcnt lgkmcnt(0)\n\ts_barrier":::"memory");
  #undef DMA_K
  #undef DMA_V
  #undef CMASK
  #undef START
  #undef RESC
  #undef ROT
}
constexpr int ATTN_LDS_BYTES=LDS_BYTES;
struct AttnTensors { const bf16* Q; const bf16* K; const bf16* V; bf16* O; const float* LF; const unsigned* NRM; };
struct AttnUnit { int bh; int qb; };
struct StaticOrder {
  int vcu,grid;
  __device__ __forceinline__ explicit StaticOrder(int grid_,int block):vcu((grid_%8==0)?(block%8)*(grid_/8)+block/8:block),grid(grid_){}
  __device__ __forceinline__ bool next(int i,AttnUnit&u)const{
    if(grid==256){ if(i>=4)return false; const int s=vcu&3; u.bh=vcu>>2; u.qb=(i==0)?s:(i==1)?7-s:(i==2)?8+s:15-s; return true; }
    const int L=i*grid+vcu; if(L>=BATCH*NHEAD*NQB)return false; u.bh=L/NQB; u.qb=L%NQB; return true; }
  __device__ __forceinline__ void a_ready(const AttnUnit&)const{}
  __device__ __forceinline__ void done(const AttnUnit&)const{}
};
template<class Sched,int THRL=8> __device__ __forceinline__ void attn_phase(char*lds,const AttnTensors&T,const Sched&S){
  AttnUnit u; int cur_bh=-1;
  for(int i=0;S.next(i,u);++i){ S.a_ready(u); if(u.bh!=cur_bh){ fox_bias_table(u.bh/NHEAD,u.bh%NHEAD,T.LF,lds); cur_bh=u.bh; }
    attn_unit<THRL>(u.bh/NHEAD,u.bh%NHEAD,u.qb,T.Q,T.K,T.V,T.O,T.LF,T.NRM,lds); S.done(u); }
}
template<int THRL=8> __device__ __forceinline__ void attn_phase_dyn(char*lds,const AttnTensors&T,unsigned*qhead,volatile int*slot){
  int cur_bh=-1; const int NU=BATCH*NHEAD*NQB;
  if(threadIdx.x==0) slot[0]=(int)__hip_atomic_fetch_add(qhead,1u,__ATOMIC_RELAXED,__HIP_MEMORY_SCOPE_AGENT);
  __syncthreads();
  int idx=__builtin_amdgcn_readfirstlane(slot[0]);
  while(idx<NU){
    __syncthreads();
    if(threadIdx.x==0) slot[0]=(int)__hip_atomic_fetch_add(qhead,1u,__ATOMIC_RELAXED,__HIP_MEMORY_SCOPE_AGENT);
    const int qb=NQB-1-idx/(BATCH*NHEAD), bh=idx%(BATCH*NHEAD);
    if(bh!=cur_bh){ fox_bias_table(bh/NHEAD,bh%NHEAD,T.LF,lds); cur_bh=bh; }
    attn_unit<THRL>(bh/NHEAD,bh%NHEAD,qb,T.Q,T.K,T.V,T.O,T.LF,T.NRM,lds);
    __syncthreads();
    idx=__builtin_amdgcn_readfirstlane(slot[0]);
  }
}
#undef SBAR
#undef WAIT_BAR
}
namespace fx {
using namespace nv;
typedef unsigned short bf16;
typedef unsigned v4u __attribute__((ext_vector_type(4)));
typedef float f32x4 __attribute__((ext_vector_type(4)));
constexpr float C2 = 0.125f * 1.4426950408889634f;
constexpr int NIN = 3328;
constexpr int QKVP = 3072;
constexpr int P_FQ = 0, P_FK = 512, P_FV = 1024, P_GQ = 1536, P_GK = 1792, P_GV = 2048, P_GR = 2560;
__device__ __forceinline__ int inproj_src(int d) {
    if (d < 1536) return d;
    if (d < 1792) return O_GQ + (d - 1536);
    if (d < 2048) return O_GK + (d - 1792);
    if (d < 2560) return O_GV + (d - 2048);
    if (d < 3072) return O_GR + (d - 2560);
    if (d < 3080) return O_FF + (d - 3072);
    if (d < 3096) return O_GA + (d - 3080);
    return -1;
}
__device__ __forceinline__ unsigned f2bf(float f) { unsigned u = __builtin_bit_cast(unsigned, f); return (u + 0x7fffu + ((u >> 16) & 1u)) >> 16; }
__device__ __forceinline__ unsigned pk2(float lo, float hi) { return f2bf(lo) | (f2bf(hi) << 16); }
__device__ __forceinline__ float bf2f(unsigned short h) { return __builtin_bit_cast(float, (unsigned)h << 16); }
__device__ __forceinline__ float wave_sum(float v) {
#pragma unroll
    for (int o = 1; o < 64; o <<= 1) v += __shfl_xor(v, o);
    return v;
}
#define FX_LDS_WAIT() asm volatile("s_waitcnt lgkmcnt(0)" ::: "memory")

template <class Map> __device__ __forceinline__ void transpose_item(const float* __restrict__ W, int K, int N, bf16* WT, LAS float* scr, int kb, int nb, int lane, Map srcmap) {
    const int k0 = 64 * kb, n0 = 32 * nb;
    const int src = srcmap(n0 + (lane & 31));
#pragma unroll 8
    for (int i = 0; i < 32; ++i) { const int kk = 2 * i + (lane >> 5); scr[kk * 33 + (lane & 31)] = (src >= 0) ? W[(size_t)(k0 + kk) * N + src] : 0.f; }
    FX_LDS_WAIT(); asm volatile("" ::: "memory");
    const int c = lane & 7;
#pragma unroll
    for (int j = 0; j < 4; ++j) { const int n = (lane >> 3) + 8 * j; const LAS float* s = scr + (8 * c) * 33 + n;
        v4u o; o.x = pk2(s[0 * 33], s[1 * 33]); o.y = pk2(s[2 * 33], s[3 * 33]); o.z = pk2(s[4 * 33], s[5 * 33]); o.w = pk2(s[6 * 33], s[7 * 33]);
        *(GAS v4u*)(WT + (size_t)(n0 + n) * K + k0 + 8 * c) = o; }
    FX_LDS_WAIT(); asm volatile("" ::: "memory");
}

__device__ __forceinline__ void ln_row_bf16(const float* xrow, const float* __restrict__ g, const float* __restrict__ b, bf16* orow, float* frow, float* st, int lane) {
    const GAS f32x4* xr = (const GAS f32x4*)xrow + lane;
    f32x4 v[4]; float s = 0.f;
#pragma unroll
    for (int j = 0; j < 4; ++j) { v[j] = xr[64 * j]; s += (v[j].x + v[j].y) + (v[j].z + v[j].w); }
    const float mean = wave_sum(s) * (1.f / D); float s2 = 0.f;
#pragma unroll
    for (int j = 0; j < 4; ++j) { v[j] = v[j] - mean; s2 += (v[j].x * v[j].x + v[j].y * v[j].y) + (v[j].z * v[j].z + v[j].w * v[j].w); }
    const float rstd = 1.f / sqrtf(wave_sum(s2) * (1.f / D) + LN_EPS);
    if (st && lane == 0) { st[0] = mean; st[1] = rstd; }
    GAS unsigned long long* o8 = (GAS unsigned long long*)orow + lane;
#pragma unroll
    for (int j = 0; j < 4; ++j) {
        const f32x4 gg = ((const f32x4*)g)[lane + 64 * j], bb = ((const f32x4*)b)[lane + 64 * j];
        const f32x4 o = v[j] * rstd * gg + bb;
        o8[64 * j] = (unsigned long long)pk2(o.x, o.y) | ((unsigned long long)pk2(o.z, o.w) << 32);
        if (frow) ((GAS f32x4*)frow)[lane + 64 * j] = o;
    }
}

struct CvItem { const float* W; bf16* WT; int N, K, k0, n0, s0; };
__device__ __forceinline__ void cv_load(const CvItem& it, f32x4 (&v)[8], int lane) {
    const float* p = it.W + (size_t)(it.k0 + (lane >> 3)) * it.N + it.s0 + 4 * (lane & 7);
#pragma unroll
    for (int i = 0; i < 8; ++i) v[i] = __builtin_nontemporal_load((const f32x4*)(p + (size_t)(8 * i) * it.N));
}
__device__ __forceinline__ void cv_finish(const CvItem& it, const f32x4 (&v)[8], LAS float* scr, int lane) {
    const int rr = lane >> 3, cq = lane & 7;
#pragma unroll
    for (int i = 0; i < 8; ++i) { LAS float* d = scr + (8 * i + rr) * 33 + 4 * cq; d[0] = v[i][0]; d[1] = v[i][1]; d[2] = v[i][2]; d[3] = v[i][3]; }
    FX_LDS_WAIT(); asm volatile("" ::: "memory");
    const int c = lane & 7;
#pragma unroll
    for (int j = 0; j < 4; ++j) { const int n = (lane >> 3) + 8 * j; const LAS float* s = scr + (8 * c) * 33 + n;
        v4u o; o.x = pk2(s[0 * 33], s[1 * 33]); o.y = pk2(s[2 * 33], s[3 * 33]); o.z = pk2(s[4 * 33], s[5 * 33]); o.w = pk2(s[6 * 33], s[7 * 33]);
        __builtin_nontemporal_store(o, (GAS v4u*)(it.WT + (size_t)(it.n0 + n) * it.K + it.k0 + 8 * c)); }
    FX_LDS_WAIT(); asm volatile("" ::: "memory");
}

template <int NR> __device__ __forceinline__ void ln_rows_bf16(const float* xrows, const float* __restrict__ g, const float* __restrict__ b, bf16* orows, int lane) {
    f32x4 v[NR][4];
#pragma unroll
    for (int r = 0; r < NR; ++r)
#pragma unroll
        for (int j = 0; j < 4; ++j) v[r][j] = ((const GAS f32x4*)(xrows + (size_t)r * D))[lane + 64 * j];
    f32x4 gg[4], bb[4];
#pragma unroll
    for (int j = 0; j < 4; ++j) { gg[j] = ((const f32x4*)g)[lane + 64 * j]; bb[j] = ((const f32x4*)b)[lane + 64 * j]; }
#pragma unroll
    for (int r = 0; r < NR; ++r) {
        float s = 0.f;
#pragma unroll
        for (int j = 0; j < 4; ++j) s += (v[r][j].x + v[r][j].y) + (v[r][j].z + v[r][j].w);
        const float mean = wave_sum(s) * (1.f / D); float s2 = 0.f;
#pragma unroll
        for (int j = 0; j < 4; ++j) { v[r][j] = v[r][j] - mean; s2 += (v[r][j].x * v[r][j].x + v[r][j].y * v[r][j].y) + (v[r][j].z * v[r][j].z + v[r][j].w * v[r][j].w); }
        const float rstd = 1.f / sqrtf(wave_sum(s2) * (1.f / D) + LN_EPS);
        GAS unsigned long long* o8 = (GAS unsigned long long*)(orows + (size_t)r * D) + lane;
#pragma unroll
        for (int j = 0; j < 4; ++j) { const f32x4 o = v[r][j] * rstd * gg[j] + bb[j];
            o8[64 * j] = (unsigned long long)pk2(o.x, o.y) | ((unsigned long long)pk2(o.z, o.w) << 32); }
    }
}

template <int NR> __device__ __forceinline__ void ln1_rows_bf16(const float* xrows, const float* st, const float* __restrict__ gi, const float* __restrict__ bi, const bf16* mixrows,
                                                               const float* __restrict__ g1, const float* __restrict__ b1, bf16* orows, float alpha, int lane) {
    f32x4 v[NR][4]; unsigned long long mx[NR][4]; float mean0[NR], rstd0[NR];
#pragma unroll
    for (int r = 0; r < NR; ++r) { mean0[r] = st[2 * r]; rstd0[r] = st[2 * r + 1];
#pragma unroll
        for (int j = 0; j < 4; ++j) { v[r][j] = ((const GAS f32x4*)(xrows + (size_t)r * D))[lane + 64 * j]; mx[r][j] = ((const GAS unsigned long long*)(mixrows + (size_t)r * D))[lane + 64 * j]; } }
    f32x4 gi4[4], bi4[4];
#pragma unroll
    for (int j = 0; j < 4; ++j) { gi4[j] = ((const f32x4*)gi)[lane + 64 * j] * alpha; bi4[j] = ((const f32x4*)bi)[lane + 64 * j] * alpha; }
#pragma unroll
    for (int r = 0; r < NR; ++r) {
        float s = 0.f;
#pragma unroll
        for (int j = 0; j < 4; ++j) { const unsigned lo = (unsigned)mx[r][j], hi = (unsigned)(mx[r][j] >> 32);
            f32x4 mv; mv.x = __builtin_bit_cast(float, lo << 16); mv.y = __builtin_bit_cast(float, lo & 0xffff0000u); mv.z = __builtin_bit_cast(float, hi << 16); mv.w = __builtin_bit_cast(float, hi & 0xffff0000u);
            v[r][j] = ((v[r][j] - mean0[r]) * rstd0[r]) * gi4[j] + bi4[j] + mv;
            s += (v[r][j].x + v[r][j].y) + (v[r][j].z + v[r][j].w); }
        const float mean = wave_sum(s) * (1.f / D); float s2 = 0.f;
#pragma unroll
        for (int j = 0; j < 4; ++j) { v[r][j] = v[r][j] - mean; s2 += (v[r][j].x * v[r][j].x + v[r][j].y * v[r][j].y) + (v[r][j].z * v[r][j].z + v[r][j].w * v[r][j].w); }
        const float rstd = 1.f / sqrtf(wave_sum(s2) * (1.f / D) + LN_EPS);
        GAS unsigned long long* o8 = (GAS unsigned long long*)(orows + (size_t)r * D) + lane;
#pragma unroll
        for (int j = 0; j < 4; ++j) { const f32x4 gg = ((const f32x4*)g1)[lane + 64 * j], bb = ((const f32x4*)b1)[lane + 64 * j]; const f32x4 o = v[r][j] * rstd * gg + bb;
            o8[64 * j] = (unsigned long long)pk2(o.x, o.y) | ((unsigned long long)pk2(o.z, o.w) << 32); }
    }
}
}

namespace pg8 {
struct EpiInProj {
    static constexpr bool PERM = true, AFTER_DRAIN = false;
    bf16_t* QKV; float* FG; float* LF; const float* bfg; unsigned* NRM;
    __device__ __forceinline__ void operator()(const f32x4 (&acc)[2][2][4][2], const Unit& u, int wr, int wc, int fr, int fq) const {
        const int row0 = u.pm * BM + wr * 64 + fr;
        if (u.pn < 12) {
            const float sc = (u.pn < 2) ? fx::C2 : 1.f;
            const int col0 = u.pn * BM + wc * 32 + 8 * fq;
            float nmax[2] = {0.f, 0.f};
#pragma unroll
            for (int ai = 0; ai < 2; ++ai)
#pragma unroll
                for (int m = 0; m < 4; ++m) { bf16_t* rowp = QKV + (size_t)(row0 + ai * HALF + m * 16) * fx::QKVP + col0;
#pragma unroll
                    for (int bj = 0; bj < 2; ++bj) { const f32x4 v0 = acc[ai][bj][m][0] * sc, v1 = acc[ai][bj][m][1] * sc;
                        u32x4 w; w.x = cvt_pk_bf16(v0[0], v0[1]); w.y = cvt_pk_bf16(v0[2], v0[3]); w.z = cvt_pk_bf16(v1[0], v1[1]); w.w = cvt_pk_bf16(v1[2], v1[3]);
                        *(u32x4*)(rowp + bj * HALF) = w;
                        if (u.pn < 4) { const f32x4 q0 = v0 * v0, q1 = v1 * v1; float s = (q0[0] + q0[1]) + (q0[2] + q0[3]) + (q1[0] + q1[1]) + (q1[2] + q1[3]);
                            s += __shfl_xor(s, 16); s += __shfl_xor(s, 32);
                            nmax[bj] = fmaxf(nmax[bj], s); } } }
            if (u.pn < 4) {
#pragma unroll
                for (int bj = 0; bj < 2; ++bj) { float s = nmax[bj];
#pragma unroll
                    for (int o = 1; o < 16; o <<= 1) s = fmaxf(s, __shfl_xor(s, o));
                    if (fr == 0 && fq == 0) { const int b = (u.pm * BM) >> 12, head = 4 * (u.pn & 1) + 2 * bj + (wc >> 1);
                        atomicMax(NRM + (b * 8 + head) * 4 + (u.pn >= 2 ? 2 : 0) + (wc & 1), __builtin_bit_cast(unsigned, s)); } }
            }
        } else if (wc == 0 && fq < 3) {
#pragma unroll
            for (int ai = 0; ai < 2; ++ai)
#pragma unroll
                for (int m = 0; m < 4; ++m) { const int row = row0 + ai * HALF + m * 16; float* p = FG + (size_t)row * 32 + 8 * fq;
                    *(f32x4*)p = acc[ai][0][m][0]; *(f32x4*)(p + 4) = acc[ai][0][m][1];
                    if (fq == 0) { const int b = row >> 12, s = row & 4095;
#pragma unroll
                        for (int n = 0; n < 2; ++n)
#pragma unroll
                            for (int i = 0; i < 4; ++i) { const int h = 4 * n + i; LF[(size_t)(b * 8 + h) * nv::S + s] = 1.4426950408889634f * nv::logsigmoidf(acc[ai][0][m][n][i] + bfg[h]); } } }
        }
    }
};
}
namespace gl {
using namespace nv;
typedef unsigned short bf16;
typedef short bf16x8 __attribute__((ext_vector_type(8)));
typedef float f32x4 __attribute__((ext_vector_type(4)));
typedef unsigned u32x4 __attribute__((ext_vector_type(4)));
typedef unsigned u32x2 __attribute__((ext_vector_type(2)));
constexpr int NCH = S / 64;
constexpr int NUNIT = B * GH * NCH;
constexpr int LS = 72;
constexpr int L_WGU = 0, L_BG = 4096, L_QP = 8192, L_KP = L_QP + 64 * LS * 2, L_KPT = L_KP + 64 * LS * 2, L_VT = L_KPT + 64 * LS * 2, L_PP = L_VT + 128 * LS * 2, L_WT = L_PP + 64 * LS * 2, L_END = L_WT + 2048;
static_assert(L_END <= 131072, "gla prep LDS");
constexpr int C_ST = 0, C_PART = 128 * LS * 2, C_END = C_PART + 2 * 8 * 64 * 4;
constexpr size_t QPG_B = 64 * 64 * 2, OI_B = 8 * 4 * 64 * 16, UU_B = OI_B, DEC_B = 256;

__device__ __forceinline__ unsigned pkbf(float lo, float hi) { typedef float f2 __attribute__((ext_vector_type(2))); typedef __bf16 b2 __attribute__((ext_vector_type(2))); f2 v = {lo, hi}; b2 r = __builtin_convertvector(v, b2); return __builtin_bit_cast(unsigned, r); }
__device__ __forceinline__ float bf2f(unsigned short h) { return __builtin_bit_cast(float, (unsigned)h << 16); }
__device__ __forceinline__ float bflo(unsigned w) { return __builtin_bit_cast(float, w << 16); }
__device__ __forceinline__ float bfhi(unsigned w) { return __builtin_bit_cast(float, w & 0xffff0000u); }
__device__ __forceinline__ float fast_logsig2(float x) { return -__builtin_amdgcn_logf(1.f + __builtin_amdgcn_exp2f(-1.4426950408889634f * x)); }

__device__ __forceinline__ void prep_unit(int unit, const bf16* QKV, const float* FG, const float* __restrict__ wgu, const float* __restrict__ bgate,
                                          unsigned char* QPG, unsigned char* OI, unsigned char* UU, float* DEC, unsigned char* lds, int& cur_h) {
    int tid_ = threadIdx.x; asm volatile("" : "+v"(tid_));
    const int tid = tid_, lane = tid & 63, wid = __builtin_amdgcn_readfirstlane(tid >> 6), l15 = lane & 15, g = lane >> 4;
    const int n = unit % NCH, bh = unit / NCH, h = bh % GH, b = bh / GH;
    const size_t row0 = (size_t)b * S + (size_t)n * 64;
    float* WGU = (float*)(lds + L_WGU); float* BG = (float*)(lds + L_BG); float* WT = (float*)(lds + L_WT);
    bf16* QP = (bf16*)(lds + L_QP); bf16* KP = (bf16*)(lds + L_KP); bf16* KPT = (bf16*)(lds + L_KPT); bf16* VT = (bf16*)(lds + L_VT); bf16* PP = (bf16*)(lds + L_PP);
    if (cur_h != h) { __syncthreads(); for (int i = tid; i < 16 * 64; i += 512) WGU[i] = wgu[(i >> 6) * 256 + h * 64 + (i & 63)]; if (tid < 64) BG[tid] = bgate[h * 64 + tid]; cur_h = h; __syncthreads(); }
    const int t = tid >> 3, oc = tid & 7, d0 = oc * 8;
    float la[8];
    { const float* gp = FG + (row0 + t) * 32 + 8;
      f32x4 ga4[4];
#pragma unroll
      for (int i = 0; i < 4; ++i) ga4[i] = *(const f32x4*)(gp + 4 * i);
#pragma unroll
      for (int j = 0; j < 8; ++j) la[j] = BG[d0 + j];
#pragma unroll
      for (int r = 0; r < 16; ++r) { const float gv = ga4[r >> 2][r & 3]; const f32x4 w0 = *(const f32x4*)(WGU + r * 64 + d0), w1 = *(const f32x4*)(WGU + r * 64 + d0 + 4);
#pragma unroll
          for (int j = 0; j < 4; ++j) { la[j] += gv * w0[j]; la[4 + j] += gv * w1[j]; } }
#pragma unroll
      for (int j = 0; j < 8; ++j) la[j] = fast_logsig2(la[j]) * (1.f / 16.f); }
    const u32x4 qv = *(const u32x4*)(QKV + (row0 + t) * fx::QKVP + fx::P_GQ + h * 64 + d0);
    const u32x4 kv = *(const u32x4*)(QKV + (row0 + t) * fx::QKVP + fx::P_GK + h * 64 + d0);
    const u32x4 vv0 = *(const u32x4*)(QKV + (row0 + t) * fx::QKVP + fx::P_GV + h * 128 + oc * 16);
    const u32x4 vv1 = *(const u32x4*)(QKV + (row0 + t) * fx::QKVP + fx::P_GV + h * 128 + oc * 16 + 8);
#pragma unroll
    for (int off = 8; off < 64; off <<= 1) {
#pragma unroll
        for (int j = 0; j < 8; ++j) { const float o = __shfl_up(la[j], off); if (lane >= off) la[j] += o; } }
    if (lane >= 56) {
#pragma unroll
        for (int j = 0; j < 8; ++j) WT[wid * 64 + d0 + j] = la[j]; }
    __syncthreads();
    float bl[8];
#pragma unroll
    for (int j = 0; j < 8; ++j) bl[j] = 0.f;
#pragma unroll
    for (int w = 0; w < 8; ++w) {
        const f32x4 a0 = *(const f32x4*)(WT + w * 64 + d0), a1 = *(const f32x4*)(WT + w * 64 + d0 + 4);
#pragma unroll
        for (int j = 0; j < 4; ++j) { bl[j] += a0[j]; bl[4 + j] += a1[j]; if (w < wid) { la[j] += a0[j]; la[4 + j] += a1[j]; } } }
    {
        const unsigned qw[4] = {qv.x, qv.y, qv.z, qv.w}, kw[4] = {kv.x, kv.y, kv.z, kv.w};
        float qf[8], kf[8];
#pragma unroll
        for (int i = 0; i < 4; ++i) { qf[2 * i] = bflo(qw[i]); qf[2 * i + 1] = bfhi(qw[i]); kf[2 * i] = bflo(kw[i]); kf[2 * i + 1] = bfhi(kw[i]); }
        float qp[8], kp[8], kpp[8];
#pragma unroll
        for (int j = 0; j < 8; ++j) { const float bb = la[j], bbl = bl[j];
            qp[j] = qf[j] * (0.125f * __builtin_amdgcn_exp2f(bb)); kp[j] = kf[j] * __builtin_amdgcn_exp2f(-bb); kpp[j] = kf[j] * __builtin_amdgcn_exp2f(bbl - bb); }
        u32x4 qo, ko; qo.x = pkbf(qp[0], qp[1]); qo.y = pkbf(qp[2], qp[3]); qo.z = pkbf(qp[4], qp[5]); qo.w = pkbf(qp[6], qp[7]);
        ko.x = pkbf(kp[0], kp[1]); ko.y = pkbf(kp[2], kp[3]); ko.z = pkbf(kp[4], kp[5]); ko.w = pkbf(kp[6], kp[7]);
        *(u32x4*)(QP + t * LS + d0) = qo; *(u32x4*)(KP + t * LS + d0) = ko;
        *(u32x4*)(QPG + (size_t)unit * QPG_B + (size_t)(t * 64 + d0) * 2) = qo;
#pragma unroll
        for (int j = 0; j < 8; ++j) KPT[(d0 + j) * LS + t] = (bf16)(pkbf(kpp[j], 0.f) & 0xffffu);
        const unsigned vw[8] = {vv0.x, vv0.y, vv0.z, vv0.w, vv1.x, vv1.y, vv1.z, vv1.w};
#pragma unroll
        for (int i = 0; i < 8; ++i) { VT[(oc * 16 + 2 * i) * LS + t] = (bf16)(vw[i] & 0xffffu); VT[(oc * 16 + 2 * i + 1) * LS + t] = (bf16)(vw[i] >> 16); }
        if (t == 0) {
#pragma unroll
            for (int j = 0; j < 8; ++j) DEC[(size_t)unit * 64 + d0 + j] = __builtin_amdgcn_exp2f(bl[j]); }
    }
    __syncthreads();
    { const int ti = wid >> 1;
#pragma unroll
      for (int q2 = 0; q2 < 2; ++q2) { const int sj = 2 * (wid & 1) + q2;
          f32x4 acc = {0.f, 0.f, 0.f, 0.f};
          if (sj <= ti) {
#pragma unroll
              for (int ks = 0; ks < 2; ++ks) { const bf16x8 a = *(const bf16x8*)(QP + (16 * ti + l15) * LS + 32 * ks + 8 * g), bb = *(const bf16x8*)(KP + (16 * sj + l15) * LS + 32 * ks + 8 * g);
                  acc = __builtin_amdgcn_mfma_f32_16x16x32_bf16(a, bb, acc, 0, 0, 0); }
              if (sj == ti) {
#pragma unroll
                  for (int r = 0; r < 4; ++r) if (l15 > 4 * g + r) acc[r] = 0.f; }
          }
#pragma unroll
          for (int r = 0; r < 4; ++r) PP[(16 * ti + 4 * g + r) * LS + 16 * sj + l15] = (bf16)(pkbf(acc[r], 0.f) & 0xffffu);
      } }
    __syncthreads();
    { bf16x8 vb[2];
#pragma unroll
      for (int ks = 0; ks < 2; ++ks) vb[ks] = *(const bf16x8*)(VT + (16 * wid + l15) * LS + 32 * ks + 8 * g);
#pragma unroll
      for (int m = 0; m < 4; ++m) { f32x4 acc = {0.f, 0.f, 0.f, 0.f};
#pragma unroll
          for (int ks = 0; ks < 2; ++ks) { const bf16x8 a = *(const bf16x8*)(PP + (16 * m + l15) * LS + 32 * ks + 8 * g); acc = __builtin_amdgcn_mfma_f32_16x16x32_bf16(a, vb[ks], acc, 0, 0, 0); }
          *(f32x4*)(OI + (size_t)unit * OI_B + (size_t)((wid * 4 + m) * 64 + lane) * 16) = acc; }
#pragma unroll
      for (int db = 0; db < 4; ++db) { f32x4 acc = {0.f, 0.f, 0.f, 0.f};
#pragma unroll
          for (int ks = 0; ks < 2; ++ks) { const bf16x8 a = *(const bf16x8*)(KPT + (16 * db + l15) * LS + 32 * ks + 8 * g); acc = __builtin_amdgcn_mfma_f32_16x16x32_bf16(a, vb[ks], acc, 0, 0, 0); }
          *(f32x4*)(UU + (size_t)unit * UU_B + (size_t)((wid * 4 + db) * 64 + lane) * 16) = acc; }
    }
}

constexpr int GS = 136;
constexpr int PO_GR = 0, PO_YT = 64 * GS * 2, PO_PART = 2 * 64 * GS * 2, PO_ST = PO_PART + 8 * 64 * 4, PO_END = PO_ST + 128 * LS * 2;
__device__ __forceinline__ void post_block(int u0, int NB, const bf16* QKV, const unsigned char* QPG, const unsigned char* OI, const unsigned char* UU, const float* DEC, const float* __restrict__ gnorm, bf16* Y, unsigned char* lds) {
    int tid_ = threadIdx.x; asm volatile("" : "+v"(tid_));
    const int tid = tid_, lane = tid & 63, wid = __builtin_amdgcn_readfirstlane(tid >> 6), l15 = lane & 15, g = lane >> 4;
    const int n0 = u0 % NCH, bh = u0 / NCH, h = bh % GH, b = bh / GH;
    bf16* GRs = (bf16*)(lds + PO_GR); bf16* YT = (bf16*)(lds + PO_YT); float* PART = (float*)(lds + PO_PART); bf16* ST = (bf16*)(lds + PO_ST);
    const int t = tid >> 3, oc = tid & 7, e = 16 * wid + l15;
    const float gn = gnorm[e];
    f32x4 Sa[4];
#pragma unroll
    for (int db = 0; db < 4; ++db) Sa[db] = (f32x4){0.f, 0.f, 0.f, 0.f};
    const size_t ub = (size_t)bh * NCH;
    for (int n = 0; n < n0; n += 4) {
        f32x4 Uf[4][4], dv[4][4];
#pragma unroll
        for (int j = 0; j < 4; ++j)
#pragma unroll
            for (int db = 0; db < 4; ++db) { Uf[j][db] = *(const f32x4*)(UU + (ub + n + j) * UU_B + (size_t)((wid * 4 + db) * 64 + lane) * 16); dv[j][db] = *(const f32x4*)(DEC + (ub + n + j) * 64 + 16 * db + 4 * g); }
#pragma unroll
        for (int j = 0; j < 4; ++j)
#pragma unroll
            for (int db = 0; db < 4; ++db) Sa[db] = dv[j][db] * Sa[db] + Uf[j][db];
    }
    for (int i = 0; i < NB; ++i) {
        const int unit = u0 + i; const size_t row0 = (size_t)b * S + (size_t)(n0 + i) * 64;
        const u32x4 g0 = *(const u32x4*)(QKV + (row0 + t) * fx::QKVP + fx::P_GR + h * 128 + oc * 16), g1 = *(const u32x4*)(QKV + (row0 + t) * fx::QKVP + fx::P_GR + h * 128 + oc * 16 + 8);
        f32x4 o[4], Uf[4], dv[4]; bf16x8 qa[4][2], sb[2];
#pragma unroll
        for (int m = 0; m < 4; ++m) { o[m] = *(const f32x4*)(OI + (size_t)unit * OI_B + (size_t)((wid * 4 + m) * 64 + lane) * 16);
            Uf[m] = *(const f32x4*)(UU + (size_t)unit * UU_B + (size_t)((wid * 4 + m) * 64 + lane) * 16); dv[m] = *(const f32x4*)(DEC + (size_t)unit * 64 + 16 * m + 4 * g);
#pragma unroll
            for (int ks = 0; ks < 2; ++ks) qa[m][ks] = *(const bf16x8*)(QPG + (size_t)unit * QPG_B + (size_t)((16 * m + l15) * 64 + 32 * ks + 8 * g) * 2); }
#pragma unroll
        for (int db = 0; db < 4; ++db) *(u32x2*)(ST + e * LS + 16 * db + 4 * g) = (u32x2){pkbf(Sa[db][0], Sa[db][1]), pkbf(Sa[db][2], Sa[db][3])};
#pragma unroll
        for (int ks = 0; ks < 2; ++ks) sb[ks] = *(const bf16x8*)(ST + e * LS + 32 * ks + 8 * g);
        *(u32x4*)(GRs + t * GS + oc * 16) = g0; *(u32x4*)(GRs + t * GS + oc * 16 + 8) = g1;
#pragma unroll
        for (int m = 0; m < 4; ++m)
#pragma unroll
            for (int ks = 0; ks < 2; ++ks) o[m] = __builtin_amdgcn_mfma_f32_16x16x32_bf16(qa[m][ks], sb[ks], o[m], 0, 0, 0);
#pragma unroll
        for (int m = 0; m < 4; ++m) { f32x4 q = o[m] * o[m];
#pragma unroll
            for (int off = 1; off < 16; off <<= 1) { q[0] += __shfl_xor(q[0], off); q[1] += __shfl_xor(q[1], off); q[2] += __shfl_xor(q[2], off); q[3] += __shfl_xor(q[3], off); }
            if (l15 == 0) *(f32x4*)(PART + wid * 64 + 16 * m + 4 * g) = q; }
#pragma unroll
        for (int db = 0; db < 4; ++db) Sa[db] = dv[db] * Sa[db] + Uf[db];
        __syncthreads();
#pragma unroll
        for (int m = 0; m < 4; ++m) { f32x4 tot = {0.f, 0.f, 0.f, 0.f};
#pragma unroll
            for (int w = 0; w < 8; ++w) tot += *(const f32x4*)(PART + w * 64 + 16 * m + 4 * g);
#pragma unroll
            for (int r = 0; r < 4; ++r) { const int tt = 16 * m + 4 * g + r; const float rs = rsqrtf(tot[r] * (1.f / GV) + LN_EPS); const float gr = bf2f(GRs[tt * GS + e]);
                const float v = o[m][r] * rs * gn * (gr * __builtin_amdgcn_rcpf(1.f + __builtin_amdgcn_exp2f(-1.4426950408889634f * gr)));
                YT[tt * GS + e] = (bf16)(pkbf(v, 0.f) & 0xffffu); } }
        __syncthreads();
        { const u32x4 y0 = *(const u32x4*)(YT + t * GS + oc * 16), y1 = *(const u32x4*)(YT + t * GS + oc * 16 + 8);
          *(u32x4*)(Y + (row0 + t) * D + 512 + h * GV + oc * 16) = y0; *(u32x4*)(Y + (row0 + t) * D + 512 + h * GV + oc * 16 + 8) = y1; }
        __syncthreads();
    }
}
}
namespace mo {
using namespace nv;
typedef unsigned short bf16;
typedef float f32x4 __attribute__((ext_vector_type(4)));
typedef unsigned u32x4 __attribute__((ext_vector_type(4)));
constexpr int CAP = 8192;
constexpr int NEX = NE + 1;
constexpr int YSH = T * TOPK;
constexpr int L_TB = 132096, L_YB = L_TB + 1040, L_CN = L_YB + 1040, L_UT = 138240, L_RG = 141312;
typedef LAS int* lint;


constexpr int I_EG = NEX * 256, I_ED = NEX * 128, I_EXP = I_EG + I_ED;
struct ExpW { const float* eg; const float* eu; const float* ed; const float* sg; const float* su; const float* sd; bf16* WegT; bf16* WedT; };
__device__ __forceinline__ void cv_decode(int r, const ExpW& X, fx::CvItem& I) {
    if (r < I_EG) { const int e = r >> 8, kb = (r >> 4) & 15, nb = r & 15, c = nb >> 3, sub = nb & 7;
        I.W = (e < NE) ? ((sub < 4 ? X.eg : X.eu) + (size_t)e * D * ED) : (sub < 4 ? X.sg : X.su); I.WT = X.WegT + (size_t)e * 512 * D; I.N = ED; I.K = D; I.k0 = 64 * kb; I.n0 = 32 * nb; I.s0 = 128 * c + 32 * (sub & 3); }
    else { r -= I_EG; const int e = r >> 7, kb = (r >> 5) & 3, nb = r & 31; I.W = (e < NE) ? (X.ed + (size_t)e * ED * D) : X.sd; I.WT = X.WedT + (size_t)e * D * ED; I.N = D; I.K = ED; I.k0 = 64 * kb; I.n0 = 32 * nb; I.s0 = 32 * nb; }
}
__device__ __forceinline__ void expert_conv(const ExpW& X, LAS float* scr, int it0, int step, int lane) {
    int it = it0; fx::CvItem cur, nx; fx::f32x4 v[8], w[8];
    if (it < I_EXP) { cv_decode(it, X, cur); fx::cv_load(cur, v, lane); }
    while (it < I_EXP) { const int itn = it + step; if (itn < I_EXP) { cv_decode(itn, X, nx); fx::cv_load(nx, w, lane); }
        fx::cv_finish(cur, v, scr, lane); cur = nx;
#pragma unroll
        for (int i = 0; i < 8; ++i) v[i] = w[i];
        it = itn; }
}

__device__ __forceinline__ void moe_tables(const int* counts, lint tb, lint yb, lint cn, int lane) {
    int c[4], nt[4]; int st = 0, sy = 0, pt[4], py[4];
#pragma unroll
    for (int i = 0; i < 4; ++i) { c[i] = counts[lane * 4 + i]; c[i] = c[i] > CAP ? CAP : c[i]; nt[i] = (c[i] + 255) >> 8; pt[i] = st; py[i] = sy; st += nt[i]; sy += c[i]; }
    int it = st, iy = sy;
    for (int o = 1; o < 64; o <<= 1) { const int a = __shfl_up(it, o), b = __shfl_up(iy, o); if (lane >= o) { it += a; iy += b; } }
    const int bt = it - st, by = iy - sy;
#pragma unroll
    for (int i = 0; i < 4; ++i) { tb[lane * 4 + i] = bt + pt[i]; yb[lane * 4 + i] = by + py[i]; cn[lane * 4 + i] = c[i]; }
    if (lane == 63) { tb[256] = it; tb[257] = it + T / 256; yb[256] = YSH; cn[256] = T; }
}

__device__ __forceinline__ void route_token2(const float* LG, const float* __restrict__ rbias, int* lcnt, int* TK, float* TW, int t0, int lane) {
    const int l32 = lane & 31, hb = lane & 32, t = t0 + (lane >> 5);
    const float4 la = ((const float4*)(LG + (size_t)t * NE))[2 * l32], lb = ((const float4*)(LG + (size_t)t * NE))[2 * l32 + 1];
    const float4 ra = ((const float4*)rbias)[2 * l32], rb = ((const float4*)rbias)[2 * l32 + 1];
    const float lg[8] = {la.x, la.y, la.z, la.w, lb.x, lb.y, lb.z, lb.w}, rbv[8] = {ra.x, ra.y, ra.z, ra.w, rb.x, rb.y, rb.z, rb.w};
    float sc[8], bv[8];
#pragma unroll
    for (int i = 0; i < 8; ++i) { sc[i] = 1.f / (1.f + expf(-lg[i])); bv[i] = sc[i] + rbv[i]; }
    float m1 = fmaxf(bv[0], bv[1]), m2 = fminf(bv[0], bv[1]);
#pragma unroll
    for (int i = 2; i < 8; ++i) { const float n1 = fmaxf(m1, bv[i]); m2 = fmaxf(fminf(m1, bv[i]), m2); m1 = n1; }
#pragma unroll
    for (int o = 1; o < 4; o <<= 1) { const float p1 = __shfl_xor(m1, o), p2 = __shfl_xor(m2, o); const float n1 = fmaxf(m1, p1); m2 = fmaxf(fminf(m1, p1), fmaxf(m2, p2)); m1 = n1; }
    const float gs = m1 + m2;
    const int myg = l32 >> 2;
    int rank = 0;
#pragma unroll
    for (int g2 = 0; g2 < NG; ++g2) { const float og = __shfl(gs, hb + g2 * 4); if (og > gs || (og == gs && g2 < myg)) ++rank; }
    const bool sel = rank < 4;
    float mv[8];
#pragma unroll
    for (int i = 0; i < 8; ++i) mv[i] = sel ? bv[i] : -INFINITY;
    int mye = 0; float myw = 0.f; float wsum = 0.f;
#pragma unroll
    for (int k = 0; k < TOPK; ++k) {
        float bvv = mv[0]; int bi = 0;
#pragma unroll
        for (int i = 1; i < 8; ++i) if (mv[i] > bvv) { bvv = mv[i]; bi = i; }
        int gi = l32 * 8 + bi;
#pragma unroll
        for (int o = 16; o > 0; o >>= 1) { const float ov = __shfl_xor(bvv, o); const int oi = __shfl_xor(gi, o); if (ov > bvv || (ov == bvv && oi < gi)) { bvv = ov; gi = oi; } }
        const int ol = gi >> 3, oi = gi & 7;
        float s_own = sc[0];
#pragma unroll
        for (int i = 1; i < 8; ++i) s_own = (oi == i) ? sc[i] : s_own;
        const float sw = __shfl(s_own, hb + ol);
        if (l32 == ol) {
#pragma unroll
            for (int i = 0; i < 8; ++i) if (oi == i) mv[i] = -INFINITY; }
        if (l32 == k) { mye = gi; myw = sw; } wsum += sw;
    }
    if (l32 < TOPK) { const int lp = atomicAdd(&lcnt[mye], 1); TK[t * TOPK + l32] = mye | (lp << 9); TW[t * TOPK + l32] = myw * (2.5f / wsum); }
}
__device__ __forceinline__ void route_finish2(const int* lbase, int* list_tok, float* list_gate, int* TK, const float* TW, int t0, int lane) {
    const int l32 = lane & 31, t = t0 + (lane >> 5);
    if (l32 < TOPK) { const int tk = TK[t * TOPK + l32]; const int e = tk & 511, pos = lbase[e] + (tk >> 9);
        if (pos < CAP) { list_tok[e * CAP + pos] = t; list_gate[e * CAP + pos] = TW[t * TOPK + l32]; }
        TK[t * TOPK + l32] = e | (pos << 9); }
}

constexpr float YSC = 16.f;
__device__ __forceinline__ void combine_token(const bf16* H1, const unsigned char* Y, const int* TK, lint yb, const float* __restrict__ g, const float* __restrict__ b, float* out, int t, int lane) {
    typedef float f2 __attribute__((ext_vector_type(2)));
    float v[16], s[16];
    { const u32x4 a = *(const u32x4*)(H1 + (size_t)t * D + 16 * lane), c = *(const u32x4*)(H1 + (size_t)t * D + 16 * lane + 8);
      const unsigned w[8] = {a.x, a.y, a.z, a.w, c.x, c.y, c.z, c.w};
#pragma unroll
      for (int i = 0; i < 8; ++i) { v[2 * i] = ALPHA * __builtin_bit_cast(float, w[i] << 16); v[2 * i + 1] = ALPHA * __builtin_bit_cast(float, w[i] & 0xffff0000u); } }
#pragma unroll
    for (int i = 0; i < 16; ++i) s[i] = 0.f;
    int tk = (lane < TOPK) ? TK[t * TOPK + lane] : 0;
#pragma unroll
    for (int k = 0; k <= TOPK; ++k) {
        size_t yrow;
        if (k < TOPK) { const int x = __shfl(tk, k); yrow = (size_t)(yb[x & 511] + (x >> 9)); } else yrow = (size_t)YSH + t;
        const u32x4 a = *(const u32x4*)(Y + yrow * D + 16 * lane);
        const int w[4] = {(int)a.x, (int)a.y, (int)a.z, (int)a.w};
#pragma unroll
        for (int i = 0; i < 4; ++i) { const f2 lo = __builtin_amdgcn_cvt_pk_f32_fp8(w[i], false), hi = __builtin_amdgcn_cvt_pk_f32_fp8(w[i], true);
            s[4 * i] += lo[0]; s[4 * i + 1] += lo[1]; s[4 * i + 2] += hi[0]; s[4 * i + 3] += hi[1]; }
    }
    float sm = 0.f;
#pragma unroll
    for (int i = 0; i < 16; ++i) { v[i] += s[i] * (1.f / YSC); sm += v[i]; }
    const float mean = fx::wave_sum(sm) * (1.f / D); float q = 0.f;
#pragma unroll
    for (int i = 0; i < 16; ++i) { v[i] -= mean; q += v[i] * v[i]; }
    const float rstd = 1.f / sqrtf(fx::wave_sum(q) * (1.f / D) + LN_EPS);
#pragma unroll
    for (int i = 0; i < 4; ++i) { const f32x4 gg = *(const f32x4*)(g + 16 * lane + 4 * i), bb = *(const f32x4*)(b + 16 * lane + 4 * i);
        f32x4 o; o[0] = v[4 * i] * rstd * gg[0] + bb[0]; o[1] = v[4 * i + 1] * rstd * gg[1] + bb[1]; o[2] = v[4 * i + 2] * rstd * gg[2] + bb[2]; o[3] = v[4 * i + 3] * rstd * gg[3] + bb[3];
        *(f32x4*)(out + (size_t)t * D + 16 * lane + 4 * i) = o; }
}
}

namespace pg8 {
struct RouterSched {
    int rb; const bf16_t* Bt;
    __device__ __forceinline__ bool next(int i, Unit2& u) const { if (i > 0) return false; u.pm = rb; u.pn = 0; u.e = 0; u.cnt = 128; u.jt = 0; u.ui = 0; return true; }
    __device__ __forceinline__ int arow(const Unit2& u, int r) const { return u.pm * 128 + r; }
    __device__ __forceinline__ size_t aoff(const Unit2&) const { return 0; }
    __device__ __forceinline__ const char* bptr(const Unit2&) const { return (const char*)Bt; }
};
struct EpiLogits {
    static constexpr bool PERM = false, AFTER_DRAIN = false;
    float* LG;
    __device__ __forceinline__ void operator()(const f32x4 (&acc)[2][2][4][2], const Unit2& u, int wr, int wc, int fr, int fq) const {
        const int row0 = u.pm * 128 + wr * 64 + fr, col0 = wc * 32 + 4 * fq;
#pragma unroll
        for (int m = 0; m < 4; ++m) { float* rowp = LG + (size_t)(row0 + m * 16) * nv::NE + col0;
#pragma unroll
            for (int bj = 0; bj < 2; ++bj)
#pragma unroll
                for (int n = 0; n < 2; ++n) *(f32x4*)(rowp + bj * HALF + n * 16) = acc[0][bj][m][n]; }
    }
};
template <int PH> struct MoeSched {
    int G, vcu, nrt; mo::lint tb; mo::lint cn; const int* list_tok; const bf16_t* W; mo::lint ut; mo::lint rg;
    static constexpr int NC = PH == 0 ? 2 : 4;
    static constexpr int MAXU = 64;
    __device__ __forceinline__ void build(int lane) const {
        const int L = lane * G + vcu;
        if (lane < MAXU && L < nrt * NC) {
            const int rt = L / NC, c = L % NC;
            int lo = 0, hi = 256;
            while (lo < hi) { const int mid = (lo + hi + 1) >> 1; if (tb[mid] <= rt) lo = mid; else hi = mid - 1; }
            const int e = lo, jt = rt - tb[e], rem = cn[e] - 256 * jt;
            ut[4 * lane] = rt; ut[4 * lane + 1] = c; ut[4 * lane + 2] = e | (jt << 9); ut[4 * lane + 3] = rem < 256 ? rem : 256;
        }
    }
    __device__ __forceinline__ bool next(int i, Unit2& u) const {
        const int L = i * G + vcu; if (i >= MAXU || L >= nrt * NC) return false;
        const int x = ut[4 * i + 2];
        u.pm = __builtin_amdgcn_readfirstlane(ut[4 * i]); u.pn = __builtin_amdgcn_readfirstlane(ut[4 * i + 1]); u.e = __builtin_amdgcn_readfirstlane(x & 511); u.jt = __builtin_amdgcn_readfirstlane(x >> 9);
        u.cnt = __builtin_amdgcn_readfirstlane(ut[4 * i + 3]); u.ui = i; return true;
    }
    __device__ __forceinline__ void fill_rows(const float* list_gate, int tid) const {
        for (int i = 0; i < MAXU; ++i) { const int L = i * G + vcu; if (L >= nrt * NC) break;
            const int x = ut[4 * i + 2], e = x & 511, jt = x >> 9, cnt = ut[4 * i + 3];
            if (tid < 256) { const int r = tid; unsigned v;
                if (e == 256) v = (unsigned)(jt * BM + r) | (0x4180u << 16);
                else if (r < cnt) { const float gsc = mo::YSC * list_gate[e * mo::CAP + jt * BM + r]; v = (unsigned)list_tok[e * mo::CAP + jt * BM + r] | (fx::f2bf(gsc) << 16); }
                else v = 0u;
                rg[i * 256 + r] = (int)v; } }
    }
    __device__ __forceinline__ int arow(const Unit2& u, int r) const {
        if (PH == 1) return u.pm * BM + r;
        return rg[u.ui * 256 + r] & 0x7fff;
    }
    __device__ __forceinline__ size_t aoff(const Unit2& u) const { return PH == 1 ? (size_t)u.pm * (131072 - 32768) : 0; }
    __device__ __forceinline__ const char* bptr(const Unit2& u) const {
        return PH == 0 ? (const char*)(W + ((size_t)u.e * 512 + 256 * u.pn) * 1024) : (const char*)(W + ((size_t)u.e * 1024 + 256 * u.pn) * 256);
    }
};
struct EpiSwiGLU {
    static constexpr bool PERM = true, AFTER_DRAIN = false;
    bf16_t* H; mo::lint rg; int skip;
    __device__ __forceinline__ void operator()(const f32x4 (&acc)[2][2][4][2], const Unit2& u, int wr, int wc, int fr, int fq) const {
        if (skip) return;
        const int col0 = u.pn * 128 + wc * 32 + 8 * fq;
#pragma unroll
        for (int ai = 0; ai < 2; ++ai)
#pragma unroll
            for (int m = 0; m < 4; ++m) { const int r = ai * HALF + wr * 64 + m * 16 + fr;
                const float gt = __builtin_bit_cast(float, (unsigned)rg[u.ui * 256 + r] & 0xffff0000u);
                float hv[8];
#pragma unroll
                for (int n = 0; n < 2; ++n)
#pragma unroll
                    for (int i = 0; i < 4; ++i) { const float gg = acc[ai][0][m][n][i], uu = acc[ai][1][m][n][i]; hv[4 * n + i] = gt * uu * (gg * __builtin_amdgcn_rcpf(1.f + __builtin_amdgcn_exp2f(-1.4426950408889634f * gg))); }
                u32x4 w; w.x = cvt_pk_bf16(hv[0], hv[1]); w.y = cvt_pk_bf16(hv[2], hv[3]); w.z = cvt_pk_bf16(hv[4], hv[5]); w.w = cvt_pk_bf16(hv[6], hv[7]);
                *(u32x4*)(H + (size_t)u.pm * 65536 + (size_t)(col0 >> 6) * 16384 + r * 64 + (col0 & 63)) = w; }
    }
};
struct EpiDown {
    static constexpr bool PERM = true, AFTER_DRAIN = false;
    unsigned char* Y; mo::lint yb; int skip;
    __device__ __forceinline__ void operator()(const f32x4 (&acc)[2][2][4][2], const Unit2& u, int wr, int wc, int fr, int fq) const {
        if (skip) return;
        typedef unsigned u32x2v __attribute__((ext_vector_type(2)));
        const int col0 = u.pn * BM + wc * 32 + 8 * fq; const int ybase = yb[u.e] + u.jt * BM;
#pragma unroll
        for (int ai = 0; ai < 2; ++ai)
#pragma unroll
            for (int m = 0; m < 4; ++m) { const int r = ai * HALF + wr * 64 + m * 16 + fr;
                if (r < u.cnt) { unsigned char* rowp = Y + (size_t)(ybase + r) * nv::D + col0;
#pragma unroll
                    for (int bj = 0; bj < 2; ++bj) { const f32x4 v0 = acc[ai][bj][m][0], v1 = acc[ai][bj][m][1];
                        int w0 = __builtin_amdgcn_cvt_pk_fp8_f32(v0[0], v0[1], 0, false); w0 = __builtin_amdgcn_cvt_pk_fp8_f32(v0[2], v0[3], w0, true);
                        int w1 = __builtin_amdgcn_cvt_pk_fp8_f32(v1[0], v1[1], 0, false); w1 = __builtin_amdgcn_cvt_pk_fp8_f32(v1[2], v1[3], w1, true);
                        *(u32x2v*)(rowp + bj * HALF) = (u32x2v){(unsigned)w0, (unsigned)w1}; } } }
    }
};
}
constexpr int NTHR = 512;
constexpr int LDS_BYTES = 163840;
constexpr int MISC_OFF = 131072 + 320;
constexpr size_t MiB = 1u << 20;
constexpr size_t CTL_ZERO_BYTES = 96 * 1024;
constexpr int CW_BAR = 4096;
constexpr int CW_MOE = 16384;
constexpr int CW_FOXQ = 20992;
constexpr int CW_NRM = 20480;
constexpr int NPHASE = 9;
constexpr size_t WS_H1 = 1, WS_WR = 65, WS_STATS = 66, WS_LF = 67, WS_FG = 68, WS_WO = 72, WS_WIN = 74, WS_TK = 81, WS_LTOK = 83, WS_LGATE = 91,
                 WS_WED = 100, WS_HID = 230, WS_GLA = 230, WS_WEG = 416, WS_XN = 673, WS_YBF = 673, WS_QKV = 737, WS_Z1 = 737, WS_LG = 865, WS_Y = 416, WS_END = 992;

struct Args { const float* in[21]; float* out; unsigned char* ws; int ph_lo, ph_hi, li, pad; };

__global__ void __launch_bounds__(NTHR, 2) mega_fwd(Args a) {
    using namespace nv;
    extern __shared__ __attribute__((aligned(16))) unsigned char lds[];
    const int G = gridDim.x, bx = blockIdx.x;
    const int vcu = (G % 8 == 0) ? (bx % 8) * (G / 8) + bx / 8 : bx;
    int tid, lane, wave, vw;
#define DERIVE() do { int t_ = threadIdx.x; asm volatile("" : "+v"(t_)); tid = t_; lane = tid & 63; wave = __builtin_amdgcn_readfirstlane(tid >> 6); vw = vcu * 8 + wave; } while (0)
    DERIVE();
    volatile LAS unsigned* MISC = (volatile LAS unsigned*)((LAS unsigned char*)lds + MISC_OFF);
    for (int u = tid; u < (LDS_BYTES - 131072) / 4; u += NTHR) ((LAS unsigned*)((LAS unsigned char*)lds + 131072))[u] = 0u;
    __syncthreads();
    unsigned char* ws = a.ws;
    unsigned* ctl = (unsigned*)ws;
    XcdBarrier bar = xcd_barrier_post(ctl + CW_BAR + a.li * XCD_BAR_WORDS, MISC + 8);
    const float* x = a.in[0];
    const float* ln_in_g = a.in[1]; const float* ln_in_b = a.in[2];
    const float* w_in = a.in[3]; const float* b_fgate = a.in[4];
    const float* w_gate_up = a.in[5]; const float* b_gate = a.in[6]; const float* g_gla = a.in[7];
    const float* w_out = a.in[8]; const float* ln1_g = a.in[9]; const float* ln1_b = a.in[10];
    const float* w_router = a.in[11]; const float* rbias = a.in[12];
    const float* w_eg = a.in[13]; const float* w_eu = a.in[14]; const float* w_ed = a.in[15];
    const float* w_sg = a.in[16]; const float* w_su = a.in[17]; const float* w_sd = a.in[18];
    const float* ln2_g = a.in[19]; const float* ln2_b = a.in[20];
    float* out = a.out;
    int* counts = (int*)(ctl + CW_MOE);
    fx::bf16* H1 = (fx::bf16*)(ws + WS_H1 * MiB);
    fx::bf16* WrT = (fx::bf16*)(ws + WS_WR * MiB);
    float* stats = (float*)(ws + WS_STATS * MiB);
    float* LF = (float*)(ws + WS_LF * MiB);
    float* FG = (float*)(ws + WS_FG * MiB);
    fx::bf16* WoT = (fx::bf16*)(ws + WS_WO * MiB);
    fx::bf16* WinT = (fx::bf16*)(ws + WS_WIN * MiB);
    int* TK = (int*)(ws + WS_TK * MiB);
    float* TW = (float*)(ws + (WS_TK + 1) * MiB);
    int* list_tok = (int*)(ws + WS_LTOK * MiB);
    float* list_gate = (float*)(ws + WS_LGATE * MiB);
    fx::bf16* WedT = (fx::bf16*)(ws + WS_WED * MiB);
    fx::bf16* HID = (fx::bf16*)(ws + WS_HID * MiB);
    unsigned char* QPG = ws + WS_GLA * MiB; unsigned char* OIb = ws + (WS_GLA + 16) * MiB; unsigned char* UUb = ws + (WS_GLA + 80) * MiB; float* DECb = (float*)(ws + (WS_GLA + 144) * MiB); unsigned char* STGb = ws + (WS_GLA + 145) * MiB;
    fx::bf16* WegT = (fx::bf16*)(ws + WS_WEG * MiB);
    fx::bf16* XN = (fx::bf16*)(ws + WS_XN * MiB);
    fx::bf16* Ybf = (fx::bf16*)(ws + WS_YBF * MiB);
    fx::bf16* QKV = (fx::bf16*)(ws + WS_QKV * MiB);
    fx::bf16* MIX = (fx::bf16*)(ws + WS_Z1 * MiB);
    float* LG = (float*)(ws + WS_LG * MiB);
    unsigned char* YA = ws + WS_Y * MiB;
    mo::lint tb = (mo::lint)((LAS unsigned char*)lds + mo::L_TB), yb = (mo::lint)((LAS unsigned char*)lds + mo::L_YB), cn = (mo::lint)((LAS unsigned char*)lds + mo::L_CN), ut = (mo::lint)((LAS unsigned char*)lds + mo::L_UT), rg = (mo::lint)((LAS unsigned char*)lds + mo::L_RG);

    const int lo = a.ph_lo, hi = a.ph_hi;
#define IN(k) (lo <= (k) && (k) < hi)
#define SEAM(k) do { if (IN(k) && IN((k) + 1)) xcd_barrier(bar); DERIVE(); } while (0)
    const int GW = G * 8;
#ifndef STG7
#define STG7 0
#endif
#ifndef STG8
#define STG8 0
#endif
#define STAGGER(q) do { if ((q) > 0) { const unsigned long long t0_ = __builtin_amdgcn_s_memrealtime(); const unsigned long long d_ = (unsigned long long)((vcu & 3) * (q)); while (__builtin_amdgcn_s_memrealtime() - t0_ < d_) __builtin_amdgcn_s_sleep(8); } } while (0)

    if (IN(0)) {
        LAS float* scr = (LAS float*)((LAS unsigned char*)lds + wave * 16384);
        constexpr int I_IN = 16 * (fx::NIN / 32), I_OUT = 16 * 32, I_R = 16 * 8, I_SMALL = I_IN + I_OUT + I_R;
        for (int it = vw; it < I_SMALL; it += GW) {
            int r = it;
            if (r < I_IN) { fx::transpose_item(w_in, D, INW, WinT, scr, r / (fx::NIN / 32), r % (fx::NIN / 32), lane, [](int d) { return fx::inproj_src(d); }); continue; } r -= I_IN;
            if (r < I_OUT) { fx::transpose_item(w_out, D, D, WoT, scr, r / 32, r % 32, lane, [](int d) { return d; }); continue; } r -= I_OUT;
            fx::transpose_item(w_router, D, NE, WrT, scr, r / 8, r % 8, lane, [](int d) { return d; });
        }
        for (int r = vw; r < T; r += GW) fx::ln_row_bf16(x + (size_t)r * D, ln_in_g, ln_in_b, XN + (size_t)r * D, nullptr, stats + 2 * (size_t)r, lane);
    }
    SEAM(0);
    if (IN(1)) {
        const mo::ExpW XW{w_eg, w_eu, w_ed, w_sg, w_su, w_sd, WegT, WedT};
#ifndef MIXG
#define MIXG 2
#endif
        { const int slot = vcu % MIXG; pg8::StaticOrder S; S.init(T, fx::NIN, G, bx);
          const int nun = (S.nwg - bx + G - 1) / G, nb = (MIXG > 1) ? nun * slot / (MIXG - 1) : nun;
          pg8::Gemm g{XN, WinT, T, fx::NIN, D, D}; pg8::EpiInProj E{QKV, FG, LF, b_fgate, ctl + CW_NRM};
          if (nb > 0) { pg8::RangeOrder R{S, 0, nb}; pg8::gemm_phase<pg8::EpiInProj, pg8::RangeOrder, true, true>((LAS unsigned char*)lds, g, R, E); DERIVE(); }
          mo::expert_conv(XW, (LAS float*)((LAS unsigned char*)lds + wave * 16384), vw, GW, lane); __syncthreads(); DERIVE();
          if (nb < nun) { pg8::RangeOrder R{S, nb, nun - nb}; pg8::gemm_phase<pg8::EpiInProj, pg8::RangeOrder, true, true>((LAS unsigned char*)lds, g, R, E); } }
    }
    SEAM(1);
    if (IN(2)) {
        int cur_h = -1;
        if (gl::NUNIT % G == 0) { const int per = gl::NUNIT / G; for (int i = 0; i < per; ++i) gl::prep_unit(vcu * per + i, QKV, FG, w_gate_up, b_gate, QPG, OIb, UUb, DECb, lds, cur_h); }
        else for (int u = vcu; u < gl::NUNIT; u += G) gl::prep_unit(u, QKV, FG, w_gate_up, b_gate, QPG, OIb, UUb, DECb, lds, cur_h);
    }
    SEAM(2);
    if (IN(3)) {
        for (int blk = vcu; blk < gl::NUNIT / 8; blk += G) gl::post_block(blk * 8, 8, QKV, QPG, OIb, UUb, DECb, g_gla, Ybf, lds);
        { const attn_body::AttnTensors AT{(const attn_body::bf16*)(QKV + fx::P_FQ), (const attn_body::bf16*)(QKV + fx::P_FK), (const attn_body::bf16*)(QKV + fx::P_FV), (attn_body::bf16*)Ybf, LF, ctl + CW_NRM};
          attn_body::attn_phase_dyn<8>((char*)lds, AT, ctl + CW_FOXQ, (volatile int*)(lds + 140288)); }
    }
    SEAM(3);
    if (IN(4)) {
        pg8::DenseSched DS; DS.so.init(T, D, G, bx); DS.Bt = WoT; DS.ldb = D;
        pg8::EpiPlainBf16 E{MIX, D};
        pg8::gemm_phase2<pg8::EpiPlainBf16, pg8::DenseSched>((LAS unsigned char*)lds, Ybf, D, D, D, DS, E);
    }
    SEAM(4);
    if (IN(5)) {
        int* lcnt = (int*)(lds + 136192); int* lbase = lcnt + 256;
        for (int rb = vcu; rb < T / 128; rb += G) {
            if (tid < 256) lcnt[tid] = 0;
            for (int r = wave * 16; r < wave * 16 + 16; r += 4) { const size_t row = (size_t)rb * 128 + r;
                fx::ln1_rows_bf16<4>(x + row * D, stats + 2 * row, ln_in_g, ln_in_b, MIX + row * D, ln1_g, ln1_b, H1 + row * D, ALPHA, lane); }
            asm volatile("s_waitcnt vmcnt(0)" ::: "memory"); __syncthreads();
            { pg8::RouterSched RS{rb, WrT}; pg8::EpiLogits E{LG};
              pg8::gemm_phase2<pg8::EpiLogits, pg8::RouterSched>((LAS unsigned char*)lds, H1, D, D, D, RS, E); }
            DERIVE();
            for (int t = rb * 128 + wave * 2; t < rb * 128 + 128; t += 16) mo::route_token2(LG, rbias, lcnt, TK, TW, t, lane);
            __syncthreads();
            if (tid < 256) { const int c = lcnt[tid]; lbase[tid] = c ? atomicAdd(&counts[tid], c) : 0; }
            __syncthreads();
            for (int t = rb * 128 + wave * 2; t < rb * 128 + 128; t += 16) mo::route_finish2(lbase, list_tok, list_gate, TK, TW, t, lane);
            __syncthreads();
        }
    }
    SEAM(5);
    if (IN(6)) {
        if (wave == 0) mo::moe_tables(counts, tb, yb, cn, lane);
        __syncthreads();
        STAGGER(STG7);
        pg8::MoeSched<0> MS{G, vcu, tb[257], tb, cn, list_tok, WegT, ut, rg}; if (wave == 0) MS.build(lane); __syncthreads(); MS.fill_rows(list_gate, tid); __syncthreads(); pg8::EpiSwiGLU E{HID, rg, a.pad};
        pg8::gemm_phase2<pg8::EpiSwiGLU, pg8::MoeSched<0>>((LAS unsigned char*)lds, H1, D, D, D, MS, E);
    }
    SEAM(6);
    if (IN(7)) {
        if (wave == 0) mo::moe_tables(counts, tb, yb, cn, lane);
        __syncthreads();
        STAGGER(STG8);
        pg8::MoeSched<1> MS{G, vcu, tb[257], tb, cn, list_tok, WedT, ut, rg}; if (wave == 0) MS.build(lane); __syncthreads(); pg8::EpiDown E{YA, yb, a.pad};
        pg8::gemm_phase2<pg8::EpiDown, pg8::MoeSched<1>>((LAS unsigned char*)lds, HID, 64, ED, ED, MS, E, 32768);
    }
    SEAM(7);
    if (IN(8)) {
        if (wave == 0) mo::moe_tables(counts, tb, yb, cn, lane);
        __syncthreads();
        for (int t = vw; t < T; t += GW) mo::combine_token(H1, YA, TK, yb, ln2_g, ln2_b, out, t, lane);
    }
#undef IN
#undef SEAM
}

extern "C" void kernel_launch(void* const* d_in, const int* in_sizes, int n_in, void* d_out, int out_size, void* d_ws, size_t ws_size, hipStream_t stream) {
    static int grid = 0;
    if (grid == 0) {
        if (n_in != 21 || out_size != nv::T * nv::D || ws_size < WS_END * MiB) { fprintf(stderr, "kernel_launch: unexpected shapes n_in=%d out=%d ws=%zu\n", n_in, out_size, ws_size); grid = -1; return; }
        int dev = 0, cus = 0;
        if (hipGetDevice(&dev) != hipSuccess || hipDeviceGetAttribute(&cus, hipDeviceAttributeMultiprocessorCount, dev) != hipSuccess) { grid = -1; return; }
        if (hipFuncSetAttribute((const void*)mega_fwd, hipFuncAttributeMaxDynamicSharedMemorySize, LDS_BYTES) != hipSuccess) { fprintf(stderr, "kernel_launch: hipFuncSetAttribute failed\n"); grid = -1; return; }
        grid = cus;
    }
    if (grid < 0) return;
    if (hipMemsetAsync(d_ws, 0, CTL_ZERO_BYTES, stream) != hipSuccess) return;
    Args a{};
    for (int i = 0; i < 21; ++i) a.in[i] = (const float*)d_in[i];
    a.out = (float*)d_out; a.ws = (unsigned char*)d_ws; a.ph_lo = 0; a.ph_hi = NPHASE; a.li = 0;
#ifdef REPEAT_PH
    a.ph_hi = REPEAT_PH + 1; hipLaunchKernelGGL(mega_fwd, dim3(grid), dim3(NTHR), LDS_BYTES, stream, a);
    if (REPEAT_PH == 5) hipMemsetAsync((char*)d_ws + CW_MOE * 4, 0, 4096, stream);
    a.ph_lo = REPEAT_PH; a.ph_hi = NPHASE; a.li = 1;
#ifdef REPEAT_NOEPI
    a.ph_hi = REPEAT_PH + 1; a.pad = 1; hipLaunchKernelGGL(mega_fwd, dim3(grid), dim3(NTHR), LDS_BYTES, stream, a); a.pad = 0; a.ph_lo = REPEAT_PH + 1; a.ph_hi = NPHASE; a.li = 2;
#endif
#endif
    hipLaunchKernelGGL(mega_fwd, dim3(grid), dim3(NTHR), LDS_BYTES, stream, a);
}
```

```cpp
#include <hip/hip_runtime.h>
#include <cstdio>
#include <cstdint>
#include <cmath>

#define LAS __attribute__((address_space(3)))
#define GAS __attribute__((address_space(1)))

#define XB_TMO      128
#define XB_XCNT(j)  (256  + 64 * (j))
#define XB_XSUB(j)  (1280 + 64 * (j))
#define XB_XGEN(j)  (2304 + 64 * (j))
#define XB_TOP      3328
#define XB_TOPGEN   3392
#define XCD_BAR_WORDS 3456
#define XB_SPIN_CAP (1u << 27)
__device__ __forceinline__ unsigned xb_ld(unsigned* p)              { return __hip_atomic_load(p, __ATOMIC_RELAXED, __HIP_MEMORY_SCOPE_AGENT); }
__device__ __forceinline__ unsigned xb_add(unsigned* p, unsigned v) { return __hip_atomic_fetch_add(p, v, __ATOMIC_RELAXED, __HIP_MEMORY_SCOPE_AGENT); }
__device__ __forceinline__ unsigned xb_xcc_id() { return (unsigned)__builtin_amdgcn_s_getreg((3 << 11) | 20) & 0xFu; }
#define XB_SPIN(cond, bar) do { unsigned _sp = 0; while (cond) { __builtin_amdgcn_s_sleep(1); \
    if ((++_sp & 255u) == 0u) { if (xb_ld(&(bar)[XB_TMO])) break; if (_sp > XB_SPIN_CAP) { atomicAdd(&(bar)[XB_TMO], 1u); break; } } } } while (0)
struct XcdBarrier { unsigned* bar; unsigned x; volatile LAS unsigned* st; };
__device__ __forceinline__ XcdBarrier xcd_barrier_post(unsigned* bar, volatile LAS unsigned* st) {
    XcdBarrier b; b.bar = bar; b.x = xb_xcc_id(); b.st = st;
    if (threadIdx.x == 0) (void)xb_add(&bar[XB_XCNT(b.x)], 1u);
    return b;
}
__device__ __forceinline__ void xcd_barrier_complete(unsigned* bar, unsigned x, unsigned& nloc, unsigned& nx) {
    const unsigned G = gridDim.x * gridDim.y * gridDim.z;
    unsigned sum, cnt, mine, sp = 0u;
    for (;;) {
        sum = 0u; cnt = 0u; mine = 0u;
#pragma unroll
        for (unsigned j = 0; j < 16; ++j) { const unsigned c = xb_ld(&bar[XB_XCNT(j)]); sum += c; cnt += (c > 0u) ? 1u : 0u; mine = (j == x) ? c : mine; }
        if (sum == G) break;
        __builtin_amdgcn_s_sleep(1);
        if ((++sp & 255u) == 0u) { if (xb_ld(&bar[XB_TMO])) break; if (sp > XB_SPIN_CAP) { atomicAdd(&bar[XB_TMO], 1u); break; } }
    }
    nloc = mine > 0u ? mine : 1u; nx = cnt > 0u ? cnt : 1u;
}
__device__ __forceinline__ void xcd_barrier(const XcdBarrier& b) {
    asm volatile("s_waitcnt vmcnt(0)" ::: "memory");
    __syncthreads();
    if (threadIdx.x == 0) {
        unsigned* bar = b.bar;
        __builtin_amdgcn_s_waitcnt(0);
        unsigned nloc = b.st[0], nx = b.st[1];
        if (nloc == 0u) { xcd_barrier_complete(bar, b.x, nloc, nx); b.st[0] = nloc; b.st[1] = nx; }
        const unsigned old = xb_add(&bar[XB_XSUB(b.x)], 1u);
        const unsigned gen = old / nloc;
        if (old + 1u == (gen + 1u) * nloc) {
            __builtin_amdgcn_fence(__ATOMIC_RELEASE, "agent");
            asm volatile("s_waitcnt vmcnt(0)" ::: "memory");
            const unsigned og = xb_add(&bar[XB_TOP], 1u);
            const unsigned tg = og / nx;
            if (og + 1u == (tg + 1u) * nx) xb_add(&bar[XB_TOPGEN], 1u);
            else XB_SPIN(xb_ld(&bar[XB_TOPGEN]) == tg, bar);
            __builtin_amdgcn_fence(__ATOMIC_ACQUIRE, "agent");
            xb_add(&bar[XB_XGEN(b.x)], 1u);
            asm volatile("s_waitcnt vmcnt(0)" ::: "memory");
        } else {
            XB_SPIN(xb_ld(&bar[XB_XGEN(b.x)]) == gen, bar);
            __builtin_amdgcn_fence(__ATOMIC_ACQUIRE, "agent");
            asm volatile("s_waitcnt vmcnt(0)" ::: "memory");
        }
    }
    __syncthreads();
}
namespace pg8 {
#define PG8_LAS __attribute__((address_space(3)))
typedef unsigned short bf16_t;
typedef short bf16x8 __attribute__((ext_vector_type(8)));
typedef float f32x4 __attribute__((ext_vector_type(4)));
typedef unsigned u32x4 __attribute__((ext_vector_type(4)));
constexpr int BM = 256, BK = 64, HALF = 128, HTB = HALF * BK * 2  , STAGE_BYTES = 8 * HTB, NXCD = 8, WGM = 8;

__host__ __device__ __forceinline__ int lds_byte(int r, int c) { const int st = (r >> 4) * 2 + (c >> 5), rr = r & 15, cc = c & 31, ob = rr * 64 + cc * 2; return st * 1024 + (ob ^ (((ob >> 9) & 1) << 5)); }
__host__ __device__ __forceinline__ void stage_rc(int b, int& R, int& C) { const int st = b / 1024, sb = b % 1024, swz = sb ^ (((sb >> 9) & 1) << 5); R = (st >> 1) * 16 + swz / 64; C = (st & 1) * 32 + (swz % 64) / 2; }
__host__ __device__ __forceinline__ int perm32(int rho) { const int n = rho >> 4, i = rho & 15; return 8 * (i >> 2) + 4 * n + (i & 3); }

struct Unit { int pm, pn; };
struct Gemm { const bf16_t* A; const bf16_t* Bt; int M, N, K, lda; };

struct StaticOrder {
    int nM, nN, nwg, G, c;
    __host__ __device__ void init(int M, int N, int G_, int c_) { nM = M / BM; nN = N / BM; nwg = nM * nN; G = G_; c = c_; }
    __host__ __device__ bool next(int i, Unit& u) const {
        const long L = (long)i * G + c; if (L >= nwg) return false;
        int wgid = (int)L; { const int q = nwg / NXCD, r = nwg % NXCD, xcd = wgid % NXCD, off = wgid / NXCD; wgid = (xcd < r ? xcd * (q + 1) : r * (q + 1) + (xcd - r) * q) + off; }
        const int nig = WGM * nN, gid = wgid / nig, fm = gid * WGM, gsz = (nM - fm) < WGM ? (nM - fm) : WGM;
        u.pm = fm + ((wgid % nig) % gsz); u.pn = (wgid % nig) / gsz; return true;
    }
    __device__ __forceinline__ void a_ready(const Unit&) const {}
    __device__ __forceinline__ void done(const Unit&) const {}
};

struct RangeOrder {
    StaticOrder so; int i0, n;
    __host__ __device__ bool next(int i, Unit& u) const { return i < n && so.next(i0 + i, u); }
    __device__ __forceinline__ void a_ready(const Unit&) const {}
    __device__ __forceinline__ void done(const Unit&) const {}
};
__device__ __forceinline__ unsigned cvt_pk_bf16(float lo, float hi) { unsigned r; asm volatile("v_cvt_pk_bf16_f32 %0, %1, %2" : "=v"(r) : "v"(lo), "v"(hi)); return r; }
typedef float f32x2 __attribute__((ext_vector_type(2)));
__device__ __forceinline__ f32x2 gelu_pk(f32x2 v) {
    const f32x2 av = __builtin_elementwise_abs(v), d = av * 0.2316418882f + 1.0f;
    f32x2 t; t.x = __builtin_amdgcn_rcpf(d.x); t.y = __builtin_amdgcn_rcpf(d.y);
    f32x2 q = t * 0.5307027145f + (-0.7265760135f); q = q * t + 0.7107068705f; q = q * t + (-0.142248368f); q = q * t + 0.127414796f; q = q * t;
    const f32x2 s = (v * v) * (-0.72134752044f);
    f32x2 e; e.x = __builtin_amdgcn_exp2f(s.x); e.y = __builtin_amdgcn_exp2f(s.y);
    const f32x2 m = v * (q * e), r = v - m;
    f32x2 o; o.x = v.x < 0.f ? m.x : r.x; o.y = v.y < 0.f ? m.y : r.y; return o;
}

template <int ACT  > struct EpiBf16 {
    static constexpr bool PERM = true, AFTER_DRAIN = false; static_assert(ACT == 0 || ACT == 1, "EpiBf16: ACT is 0 (none) or 1 (gelu_pk)");
    bf16_t* O; int ldc; const float* bias; int split_cols; size_t split_stride; float scale0;
    __device__ __forceinline__ void operator()(const f32x4 (&acc)[2][2][4][2], const Unit& u, int wr, int wc, int fr, int fq) const {
        const int row0 = u.pm * BM + wr * 64 + fr; int colt = u.pn * BM; bf16_t* base = O;
        float sc = 1.f; if (split_cols) { const int t = colt / split_cols; base += (size_t)t * split_stride; colt -= t * split_cols; if (t == 0) sc = scale0; }
        const int col0 = colt + wc * 32 + 8 * fq, bcol0 = u.pn * BM + wc * 32 + 8 * fq;
        f32x4 bv[2][2];
#pragma unroll
        for (int bj = 0; bj < 2; ++bj)
#pragma unroll
            for (int n = 0; n < 2; ++n) bv[bj][n] = bias ? *(const f32x4*)(bias + bcol0 + bj * HALF + 4 * n) : (f32x4){0.f, 0.f, 0.f, 0.f};
#pragma unroll
        for (int ai = 0; ai < 2; ++ai)
#pragma unroll
            for (int m = 0; m < 4; ++m) { bf16_t* rowp = base + (size_t)(row0 + ai * HALF + m * 16) * ldc + col0;
#pragma unroll
                for (int bj = 0; bj < 2; ++bj) { f32x4 v0 = acc[ai][bj][m][0] + bv[bj][0], v1 = acc[ai][bj][m][1] + bv[bj][1];
                    if (ACT == 1) { f32x2 a = gelu_pk((f32x2){v0[0], v0[1]}), b = gelu_pk((f32x2){v0[2], v0[3]}), c = gelu_pk((f32x2){v1[0], v1[1]}), d = gelu_pk((f32x2){v1[2], v1[3]});
                        v0 = (f32x4){a.x, a.y, b.x, b.y}; v1 = (f32x4){c.x, c.y, d.x, d.y}; }
                    v0 = v0 * sc; v1 = v1 * sc; u32x4 w; w.x = cvt_pk_bf16(v0[0], v0[1]); w.y = cvt_pk_bf16(v0[2], v0[3]); w.z = cvt_pk_bf16(v1[0], v1[1]); w.w = cvt_pk_bf16(v1[2], v1[3]);
                    *(u32x4*)(rowp + bj * HALF) = w; } }
    }
};

template <class Epi, class Sched, bool ALIGN_EPI = false, bool SP2 = false>
__device__ __forceinline__ void gemm_phase(PG8_LAS unsigned char* lds, const Gemm g, const Sched& S, const Epi& E) {
    const int tid = threadIdx.x, wid = __builtin_amdgcn_readfirstlane(tid >> 6), lane = tid & 63, wr = wid >> 2, wc = wid & 3, fr = lane & 15, fq = lane >> 4;
    const int K = g.K, nt = K / BK;
    unsigned voffA[2], voffB[2];
#pragma unroll
    for (int i = 0; i < 2; ++i) { int R, C; stage_rc(tid * 16 + i * 8192, R, C); const int Rb = Epi::PERM ? ((R & ~31) + perm32(R & 31)) : R;
        voffA[i] = (unsigned)(R * g.lda + C) * 2u; voffB[i] = (unsigned)(Rb * K + C) * 2u; }
    const size_t kstep = (size_t)(BK * 2);
    const size_t hstepA = (size_t)HALF * g.lda * 2, hstepB = (size_t)HALF * K * 2;
    const size_t tstepA = 2 * hstepA, tstepB = 2 * hstepB;
    const unsigned ldsw = (unsigned)wid * 1024u;
    const int aoff = lds_byte(wr * 64 + fr, fq * 8), boff = lds_byte(wc * 32 + fr, fq * 8);
#define PG8_SA(b, h) (((b) * 2 + (h)) * HTB)
#define PG8_SB(b, h) ((4 + (b) * 2 + (h)) * HTB)
#define PG8_STAGE(bufoff, gbase, voff) do { _Pragma("unroll") for (int _i = 0; _i < 2; ++_i) \
        __builtin_amdgcn_global_load_lds((const unsigned*)((const char*)(gbase) + (voff)[_i]), (PG8_LAS unsigned*)(lds + (bufoff) + ldsw + _i * 8192), 16, 0, 0); } while (0)
#define PG8_LDA(dst, b, h) do { _Pragma("unroll") for (int m = 0; m < 4; ++m) _Pragma("unroll") for (int k = 0; k < 2; ++k) dst[m][k] = *(const PG8_LAS bf16x8*)(lds + PG8_SA(b, h) + aoff + m * 2048 + k * 1024); } while (0)
#define PG8_LDB(dst, b, h) do { _Pragma("unroll") for (int n = 0; n < 2; ++n) _Pragma("unroll") for (int k = 0; k < 2; ++k) dst[n][k] = *(const PG8_LAS bf16x8*)(lds + PG8_SB(b, h) + boff + n * 2048 + k * 1024); } while (0)
#define PG8_MMA(ai, bj, At, Bt) do { __builtin_amdgcn_s_setprio(1); _Pragma("unroll") for (int m = 0; m < 4; ++m) _Pragma("unroll") for (int n = 0; n < 2; ++n) _Pragma("unroll") for (int k = 0; k < 2; ++k) \
        acc[ai][bj][m][n] = __builtin_amdgcn_mfma_f32_16x16x32_bf16(Bt[n][k], At[m][k], acc[ai][bj][m][n], 0, 0, 0); __builtin_amdgcn_s_setprio(0); } while (0)
#define PG8_WAIT_V(n) asm volatile("s_waitcnt vmcnt(" #n ")" ::: "memory")
#define PG8_WAIT_L(n) asm volatile("s_waitcnt lgkmcnt(" #n ")" ::: "memory")
#define PG8_BAR __builtin_amdgcn_s_barrier()
#define PG8_SCHED __builtin_amdgcn_sched_barrier(0)
    Unit cur, nxt; int ui = 0;
    if (!S.next(0, cur)) return;
    f32x4 acc[2][2][4][2];
#pragma unroll
    for (int a = 0; a < 2; ++a)
#pragma unroll
        for (int b = 0; b < 2; ++b)
#pragma unroll
            for (int m = 0; m < 4; ++m)
#pragma unroll
                for (int n = 0; n < 2; ++n) acc[a][b][m][n] = (f32x4){0.f, 0.f, 0.f, 0.f};
    bf16x8 At[4][2], B0[2][2], B1[2][2];
    const char* cA = (const char*)g.A + (size_t)cur.pm * tstepA; const char* cB = (const char*)g.Bt + (size_t)cur.pn * tstepB;
    S.a_ready(cur);
    if constexpr (SP2) {
        PG8_STAGE(PG8_SB(0, 0), cB, voffB); PG8_STAGE(PG8_SB(0, 1), cB + hstepB, voffB); PG8_STAGE(PG8_SA(0, 0), cA, voffA); PG8_STAGE(PG8_SA(0, 1), cA + hstepA, voffA);
        if (wr == 1) PG8_BAR;
        PG8_WAIT_V(2); PG8_BAR;
        PG8_STAGE(PG8_SB(1, 0), cB + kstep, voffB); PG8_STAGE(PG8_SA(1, 0), cA + kstep, voffA); PG8_STAGE(PG8_SB(1, 1), cB + hstepB + kstep, voffB);
        PG8_WAIT_V(6); PG8_BAR;
    } else {
        PG8_STAGE(PG8_SB(0, 0), cB, voffB); PG8_STAGE(PG8_SA(0, 0), cA, voffA); PG8_STAGE(PG8_SB(0, 1), cB + hstepB, voffB); PG8_STAGE(PG8_SA(0, 1), cA + hstepA, voffA);
        if (wr == 1) PG8_BAR;
        PG8_WAIT_V(4); PG8_BAR;
        PG8_STAGE(PG8_SB(1, 0), cB + kstep, voffB); PG8_STAGE(PG8_SA(1, 0), cA + kstep, voffA); PG8_STAGE(PG8_SB(1, 1), cB + hstepB + kstep, voffB);
        PG8_WAIT_V(6); PG8_BAR;
    }
    for (;;) {
        const bool has_next = S.next(ui + 1, nxt);
        const char* nA = has_next ? (const char*)g.A + (size_t)nxt.pm * tstepA : cA; const char* nB = has_next ? (const char*)g.Bt + (size_t)nxt.pn * tstepB : cB;
        for (int t = 0; t < nt; t += 2) {
            const bool last = (t == nt - 2);
            const char* a1 = cA + (size_t)(t + 1) * kstep;
            const char* a2 = last ? nA : cA + (size_t)(t + 2) * kstep; const char* b2 = last ? nB : cB + (size_t)(t + 2) * kstep;
            const char* a3 = a2 + kstep; const char* b3 = b2 + kstep;
            if (last && has_next) S.a_ready(nxt);
            if constexpr (SP2) {
            PG8_LDB(B0, 0, 0); PG8_LDB(B1, 0, 1); PG8_SCHED; PG8_LDA(At, 0, 0); PG8_STAGE(PG8_SA(1, 1), a1 + hstepA, voffA);
            PG8_WAIT_V(8); PG8_WAIT_L(0); PG8_BAR; PG8_MMA(0, 0, At, B0); PG8_MMA(0, 1, At, B1); PG8_BAR; PG8_SCHED;
            PG8_LDA(At, 0, 1); PG8_STAGE(PG8_SB(0, 0), b2, voffB); PG8_STAGE(PG8_SB(0, 1), b2 + hstepB, voffB); PG8_STAGE(PG8_SA(0, 0), a2, voffA);
            PG8_WAIT_V(8); PG8_WAIT_L(0); PG8_BAR; PG8_MMA(1, 0, At, B0); PG8_MMA(1, 1, At, B1); PG8_BAR; PG8_SCHED;
            PG8_LDB(B0, 1, 0); PG8_LDB(B1, 1, 1); PG8_SCHED; PG8_LDA(At, 1, 0); PG8_STAGE(PG8_SA(0, 1), a2 + hstepA, voffA);
            PG8_WAIT_V(8); PG8_WAIT_L(0); PG8_BAR; PG8_MMA(0, 0, At, B0); PG8_MMA(0, 1, At, B1); PG8_BAR; PG8_SCHED;
            PG8_LDA(At, 1, 1); PG8_STAGE(PG8_SB(1, 0), b3, voffB); PG8_STAGE(PG8_SB(1, 1), b3 + hstepB, voffB); PG8_STAGE(PG8_SA(1, 0), a3, voffA);
            PG8_WAIT_V(8); PG8_WAIT_L(0); PG8_BAR; PG8_MMA(1, 0, At, B0); PG8_MMA(1, 1, At, B1); PG8_BAR; PG8_SCHED;
            } else {
            PG8_LDB(B0, 0, 0); PG8_SCHED; PG8_LDA(At, 0, 0); PG8_STAGE(PG8_SA(1, 1), a1 + hstepA, voffA);
            PG8_WAIT_L(8); PG8_BAR; PG8_WAIT_L(0); PG8_MMA(0, 0, At, B0); PG8_BAR; PG8_SCHED;
            PG8_LDB(B1, 0, 1); PG8_STAGE(PG8_SB(0, 0), b2, voffB);
            PG8_BAR; PG8_WAIT_L(0); PG8_MMA(0, 1, At, B1); PG8_BAR;
            PG8_LDA(At, 0, 1); PG8_STAGE(PG8_SA(0, 0), a2, voffA);
            PG8_BAR; PG8_WAIT_L(0); PG8_MMA(1, 0, At, B0); PG8_BAR; PG8_SCHED;
            PG8_STAGE(PG8_SB(0, 1), b2 + hstepB, voffB);
            PG8_WAIT_V(6); PG8_BAR; PG8_MMA(1, 1, At, B1); PG8_BAR;
            PG8_LDB(B0, 1, 0); PG8_SCHED; PG8_LDA(At, 1, 0); PG8_STAGE(PG8_SA(0, 1), a2 + hstepA, voffA);
            PG8_WAIT_L(8); PG8_BAR; PG8_WAIT_L(0); PG8_MMA(0, 0, At, B0); PG8_BAR; PG8_SCHED;
            PG8_LDB(B1, 1, 1); PG8_STAGE(PG8_SB(1, 0), b3, voffB);
            PG8_BAR; PG8_WAIT_L(0); PG8_MMA(0, 1, At, B1); PG8_BAR;
            PG8_LDA(At, 1, 1); PG8_STAGE(PG8_SA(1, 0), a3, voffA);
            PG8_BAR; PG8_WAIT_L(0); PG8_MMA(1, 0, At, B0); PG8_BAR; PG8_SCHED;
            PG8_STAGE(PG8_SB(1, 1), b3 + hstepB, voffB);
            PG8_WAIT_V(6); PG8_BAR; PG8_MMA(1, 1, At, B1); PG8_BAR;
            }
        }
        if constexpr (ALIGN_EPI) { if (wr == 0) PG8_BAR; }
        if constexpr (!Epi::AFTER_DRAIN) { E(acc, cur, wr, wc, fr, fq); S.done(cur); }
        if (!has_next) break;
#pragma unroll
        for (int a = 0; a < 2; ++a)
#pragma unroll
            for (int b = 0; b < 2; ++b)
#pragma unroll
                for (int m = 0; m < 4; ++m)
#pragma unroll
                    for (int n = 0; n < 2; ++n) acc[a][b][m][n] = (f32x4){0.f, 0.f, 0.f, 0.f};
        cur = nxt; cA = nA; cB = nB; ++ui;
        if constexpr (ALIGN_EPI) { if (wr == 1) PG8_BAR; }
    }
    PG8_WAIT_V(0);
    if constexpr (!ALIGN_EPI) { if (wr == 0) PG8_BAR; }
    PG8_BAR;
    if constexpr (Epi::AFTER_DRAIN) { E.fused(acc, cur, wr, wc, fr, fq, lds, wid, lane); S.done(cur); }
#undef PG8_SA
#undef PG8_SB
#undef PG8_STAGE
#undef PG8_LDA
#undef PG8_LDB
#undef PG8_MMA
#undef PG8_WAIT_V
#undef PG8_WAIT_L
#undef PG8_BAR
#undef PG8_SCHED
}
}
namespace pg8 {
struct Unit2 { int pm, pn, e, cnt, jt, ui; };
template <class Epi, class Sched>
__device__ __forceinline__ void gemm_phase2(PG8_LAS unsigned char* lds, const bf16_t* Abase, int lda, int ldb, int K, const Sched& S, const Epi& E, int kstepA_ = BK * 2) {
    int tid_ = threadIdx.x; asm volatile("" : "+v"(tid_));
    const int tid = tid_, wid = __builtin_amdgcn_readfirstlane(tid >> 6), lane = tid & 63, wr = wid >> 2, wc = wid & 3, fr = lane & 15, fq = lane >> 4;
    int K_ = K; asm volatile("" : "+s"(K_));
    const int nt = K_ / BK;
    unsigned voffB[2];
#pragma unroll
    for (int i = 0; i < 2; ++i) { int R, C; stage_rc(tid * 16 + i * 8192, R, C); const int Rb = Epi::PERM ? ((R & ~31) + perm32(R & 31)) : R; voffB[i] = (unsigned)(Rb * ldb + C) * 2u; }
    const unsigned lda2 = (unsigned)lda * 2u;
#define PG8_AOFFS(U, o0, o1) do { int t2_ = threadIdx.x; asm volatile("" : "+v"(t2_)); _Pragma("unroll") for (int i_ = 0; i_ < 2; ++i_) { int R_, C_; stage_rc(t2_ * 16 + i_ * 8192, R_, C_); \
        o0[i_] = (unsigned)S.arow(U, R_) * lda2 + (unsigned)C_ * 2u; o1[i_] = (unsigned)S.arow(U, HALF + R_) * lda2 + (unsigned)C_ * 2u; } } while (0)
    const size_t kstep = (size_t)(BK * 2), kstepA = (size_t)kstepA_;
    const size_t hstepB = (size_t)HALF * ldb * 2;
    const unsigned ldsw = (unsigned)wid * 1024u;
    const int aoff = lds_byte(wr * 64 + fr, fq * 8), boff = lds_byte(wc * 32 + fr, fq * 8);
#define PG8_SA(b, h) (((b) * 2 + (h)) * HTB)
#define PG8_SB(b, h) ((4 + (b) * 2 + (h)) * HTB)
#define PG8_STAGE(bufoff, gbase, voff) do { _Pragma("unroll") for (int _i = 0; _i < 2; ++_i) \
        __builtin_amdgcn_global_load_lds((const unsigned*)((const char*)(gbase) + (voff)[_i]), (PG8_LAS unsigned*)(lds + (bufoff) + ldsw + _i * 8192), 16, 0, 0); } while (0)
#define PG8_LDA(dst, b, h) do { _Pragma("unroll") for (int m = 0; m < 4; ++m) _Pragma("unroll") for (int k = 0; k < 2; ++k) dst[m][k] = *(const PG8_LAS bf16x8*)(lds + PG8_SA(b, h) + aoff + m * 2048 + k * 1024); } while (0)
#define PG8_LDB(dst, b, h) do { _Pragma("unroll") for (int n = 0; n < 2; ++n) _Pragma("unroll") for (int k = 0; k < 2; ++k) dst[n][k] = *(const PG8_LAS bf16x8*)(lds + PG8_SB(b, h) + boff + n * 2048 + k * 1024); } while (0)
#define PG8_MMA(ai, bj, At, Bt) do { __builtin_amdgcn_s_setprio(1); _Pragma("unroll") for (int m = 0; m < 4; ++m) _Pragma("unroll") for (int n = 0; n < 2; ++n) _Pragma("unroll") for (int k = 0; k < 2; ++k) \
        acc[ai][bj][m][n] = __builtin_amdgcn_mfma_f32_16x16x32_bf16(Bt[n][k], At[m][k], acc[ai][bj][m][n], 0, 0, 0); __builtin_amdgcn_s_setprio(0); } while (0)
#define PG8_WAIT_V(n) asm volatile("s_waitcnt vmcnt(" #n ")" ::: "memory")
#define PG8_WAIT_L(n) asm volatile("s_waitcnt lgkmcnt(" #n ")" ::: "memory")
#define PG8_BAR __builtin_amdgcn_s_barrier()
#define PG8_SCHED __builtin_amdgcn_sched_barrier(0)
    Unit2 cur, nxt; int ui = 0;
    if (!S.next(0, cur)) return;
    f32x4 acc[2][2][4][2];
#pragma unroll
    for (int a = 0; a < 2; ++a)
#pragma unroll
        for (int b = 0; b < 2; ++b)
#pragma unroll
            for (int m = 0; m < 4; ++m)
#pragma unroll
                for (int n = 0; n < 2; ++n) acc[a][b][m][n] = (f32x4){0.f, 0.f, 0.f, 0.f};
    bf16x8 At[4][2], B0[2][2], B1[2][2];
    unsigned cv0[2], cv1[2], nv0[2], nv1[2];
    PG8_AOFFS(cur, cv0, cv1);
    const char* cA = (const char*)Abase + S.aoff(cur); const char* cB = S.bptr(cur);
    PG8_STAGE(PG8_SB(0, 0), cB, voffB); PG8_STAGE(PG8_SB(0, 1), cB + hstepB, voffB); PG8_STAGE(PG8_SA(0, 0), cA, cv0); PG8_STAGE(PG8_SA(0, 1), cA, cv1);
    if (wr == 1) PG8_BAR;
    PG8_WAIT_V(2); PG8_BAR;
    PG8_STAGE(PG8_SB(1, 0), cB + kstep, voffB); PG8_STAGE(PG8_SA(1, 0), cA + kstepA, cv0); PG8_STAGE(PG8_SB(1, 1), cB + hstepB + kstep, voffB);
    PG8_WAIT_V(6); PG8_BAR;
    for (;;) {
        const bool has_next = S.next(ui + 1, nxt);
        const char* nA = has_next ? (const char*)Abase + S.aoff(nxt) : cA; const char* nB = has_next ? S.bptr(nxt) : cB;
#pragma unroll
        for (int i = 0; i < 2; ++i) { nv0[i] = cv0[i]; nv1[i] = cv1[i]; }
        if (has_next) PG8_AOFFS(nxt, nv0, nv1);
        const bool act0 = cur.cnt > wr * 64, act1 = cur.cnt > HALF + wr * 64;
        for (int t = 0; t < nt; t += 2) {
            const bool last = (t == nt - 2);
            const char* a1 = cA + (size_t)(t + 1) * kstepA;
            const char* a2 = last ? nA : cA + (size_t)(t + 2) * kstepA; const char* b2 = last ? nB : cB + (size_t)(t + 2) * kstep;
            const char* a3 = a2 + kstepA; const char* b3 = b2 + kstep;
            unsigned s0[2] = {cv0[0], cv0[1]}, s1[2] = {cv1[0], cv1[1]};
            if (last) { asm volatile("" ::: "memory"); s0[0] = nv0[0]; s0[1] = nv0[1]; s1[0] = nv1[0]; s1[1] = nv1[1]; }
            PG8_LDB(B0, 0, 0); PG8_LDB(B1, 0, 1); PG8_SCHED; PG8_LDA(At, 0, 0); PG8_STAGE(PG8_SA(1, 1), a1, cv1);
            PG8_WAIT_V(8); PG8_WAIT_L(0); PG8_BAR; if (act0) { PG8_MMA(0, 0, At, B0); PG8_MMA(0, 1, At, B1); } PG8_BAR; PG8_SCHED;
            PG8_LDA(At, 0, 1); PG8_STAGE(PG8_SB(0, 0), b2, voffB); PG8_STAGE(PG8_SB(0, 1), b2 + hstepB, voffB); PG8_STAGE(PG8_SA(0, 0), a2, s0);
            PG8_WAIT_V(8); PG8_WAIT_L(0); PG8_BAR; if (act1) { PG8_MMA(1, 0, At, B0); PG8_MMA(1, 1, At, B1); } PG8_BAR; PG8_SCHED;
            PG8_LDB(B0, 1, 0); PG8_LDB(B1, 1, 1); PG8_SCHED; PG8_LDA(At, 1, 0); PG8_STAGE(PG8_SA(0, 1), a2, s1);
            PG8_WAIT_V(8); PG8_WAIT_L(0); PG8_BAR; if (act0) { PG8_MMA(0, 0, At, B0); PG8_MMA(0, 1, At, B1); } PG8_BAR; PG8_SCHED;
            PG8_LDA(At, 1, 1); PG8_STAGE(PG8_SB(1, 0), b3, voffB); PG8_STAGE(PG8_SB(1, 1), b3 + hstepB, voffB); PG8_STAGE(PG8_SA(1, 0), a3, s0);
            PG8_WAIT_V(8); PG8_WAIT_L(0); PG8_BAR; if (act1) { PG8_MMA(1, 0, At, B0); PG8_MMA(1, 1, At, B1); } PG8_BAR; PG8_SCHED;
        }
        if (wr == 0) PG8_BAR;
        { Unit2 eu = cur; asm volatile("" : "+s"(eu.pm), "+s"(eu.pn), "+s"(eu.e), "+s"(eu.cnt), "+s"(eu.jt), "+s"(eu.ui));
          E(acc, eu, wr, wc, fr, fq);
          }
        if (!has_next) break;
#pragma unroll
        for (int a = 0; a < 2; ++a)
#pragma unroll
            for (int b = 0; b < 2; ++b)
#pragma unroll
                for (int m = 0; m < 4; ++m)
#pragma unroll
                    for (int n = 0; n < 2; ++n) acc[a][b][m][n] = (f32x4){0.f, 0.f, 0.f, 0.f};
        cur = nxt; cA = nA; cB = nB; ++ui;
#pragma unroll
        for (int i = 0; i < 2; ++i) { cv0[i] = nv0[i]; cv1[i] = nv1[i]; }
        if (wr == 1) PG8_BAR;
    }
    PG8_WAIT_V(0);
    PG8_BAR;
#undef PG8_AOFFS
#undef PG8_SA
#undef PG8_SB
#undef PG8_STAGE
#undef PG8_LDA
#undef PG8_LDB
#undef PG8_MMA
#undef PG8_WAIT_V
#undef PG8_WAIT_L
#undef PG8_BAR
#undef PG8_SCHED
}

struct DenseSched {
    StaticOrder so; const bf16_t* Bt; int ldb;
    __device__ __forceinline__ bool next(int i, Unit2& u) const { Unit t; if (!so.next(i, t)) return false; u.pm = t.pm; u.pn = t.pn; u.e = 0; u.cnt = 256; u.jt = 0; u.ui = i; return true; }
    __device__ __forceinline__ int arow(const Unit2& u, int r) const { return u.pm * BM + r; }
    __device__ __forceinline__ size_t aoff(const Unit2&) const { return 0; }
    __device__ __forceinline__ const char* bptr(const Unit2& u) const { return (const char*)(Bt + (size_t)u.pn * BM * ldb); }
};
struct EpiPlainBf16 {
    static constexpr bool PERM = true, AFTER_DRAIN = false;
    bf16_t* O; int ldc;
    __device__ __forceinline__ void operator()(const f32x4 (&acc)[2][2][4][2], const Unit2& u, int wr, int wc, int fr, int fq) const {
        const int row0 = u.pm * BM + wr * 64 + fr, col0 = u.pn * BM + wc * 32 + 8 * fq;
#pragma unroll
        for (int ai = 0; ai < 2; ++ai)
#pragma unroll
            for (int m = 0; m < 4; ++m) { bf16_t* rowp = O + (size_t)(row0 + ai * HALF + m * 16) * ldc + col0;
#pragma unroll
                for (int bj = 0; bj < 2; ++bj) { const f32x4 v0 = acc[ai][bj][m][0], v1 = acc[ai][bj][m][1];
                    u32x4 w; w.x = cvt_pk_bf16(v0[0], v0[1]); w.y = cvt_pk_bf16(v0[2], v0[3]); w.z = cvt_pk_bf16(v1[0], v1[1]); w.w = cvt_pk_bf16(v1[2], v1[3]);
                    *(u32x4*)(rowp + bj * HALF) = w; } }
    }
};
}
namespace nv {
constexpr int D = 1024, B = 8, S = 4096, T = B * S;
constexpr int FH = 8, FD = 64, GH = 4, GK = 64, GV = 128, RANK = 16;
constexpr int INW = 3096;
constexpr int O_FQ = 0, O_FK = 512, O_FV = 1024, O_FF = 1536, O_GQ = 1544, O_GK = 1800, O_GV = 2056, O_GA = 2568, O_GR = 2584;
constexpr int NE = 256, NG = 8, TOPK = 8, ED = 256;
constexpr float LN_EPS = 1e-5f;
constexpr float ALPHA = 1.189207115002721f;
constexpr int PADR = 64;
constexpr int APAD = T * TOPK + NE * PADR;

__device__ __forceinline__ float logsigmoidf(float x) { return fminf(x, 0.f) - log1pf(expf(-fabsf(x))); }
__device__ __forceinline__ float siluf(float x) { return x / (1.f + expf(-x)); }


__device__ __forceinline__ void ln_row(const float* in1, float a, const float* in2, const float* __restrict__ g, const float* __restrict__ b, float* out, int r, int tid, float* sh) {
    float4 v = ((const float4*)(in1 + (size_t)r * D))[tid];
    v.x *= a; v.y *= a; v.z *= a; v.w *= a;
    if (in2) { const float4 w = ((const float4*)(in2 + (size_t)r * D))[tid]; v.x += w.x; v.y += w.y; v.z += w.z; v.w += w.w; }
    float s = v.x + v.y + v.z + v.w;
    for (int o = 32; o > 0; o >>= 1) s += __shfl_xor(s, o);
    __syncthreads();
    if ((tid & 63) == 0) sh[tid >> 6] = s;
    __syncthreads();
    const float mean = (sh[0] + sh[1] + sh[2] + sh[3]) * (1.f / D);
    v.x -= mean; v.y -= mean; v.z -= mean; v.w -= mean;
    float q = v.x * v.x + v.y * v.y + v.z * v.z + v.w * v.w;
    for (int o = 32; o > 0; o >>= 1) q += __shfl_xor(q, o);
    if ((tid & 63) == 0) sh[4 + (tid >> 6)] = q;
    __syncthreads();
    const float rstd = rsqrtf((sh[4] + sh[5] + sh[6] + sh[7]) * (1.f / D) + LN_EPS);
    const float4 gg = ((const float4*)g)[tid], bb = ((const float4*)b)[tid];
    float4 o4; o4.x = v.x * rstd * gg.x + bb.x; o4.y = v.y * rstd * gg.y + bb.y; o4.z = v.z * rstd * gg.z + bb.z; o4.w = v.w * rstd * gg.w + bb.w;
    ((float4*)(out + (size_t)r * D))[tid] = o4;
}

__device__ __forceinline__ void gemm_tile(const float* A, const float* Bm, float* C, int N, int K, int lda, int ldb, int ldc, int tile_x, int tile_y, int tid, float* sh) {
    float (*As)[68] = (float (*)[68])sh;
    float (*Bs)[68] = (float (*)[68])(sh + 16 * 68);
    const int tx = tid & 15, ty = tid >> 4;
    const int row0 = tile_y * 64, col0 = tile_x * 64;
    float acc[4][4] = {};
    const int ar = tid >> 2, ak = (tid & 3) * 4;
    const int bk = tid >> 4, bc = (tid & 15) * 4;
    const bool bok = (col0 + bc) < N;
    for (int k0 = 0; k0 < K; k0 += 16) {
        const float4 av = *(const float4*)(A + (size_t)(row0 + ar) * lda + k0 + ak);
        float4 bv = make_float4(0.f, 0.f, 0.f, 0.f);
        if (bok) bv = *(const float4*)(Bm + (size_t)(k0 + bk) * ldb + col0 + bc);
        __syncthreads();
        As[ak + 0][ar] = av.x; As[ak + 1][ar] = av.y; As[ak + 2][ar] = av.z; As[ak + 3][ar] = av.w;
        *(float4*)&Bs[bk][bc] = bv;
        __syncthreads();
#pragma unroll
        for (int k = 0; k < 16; ++k) {
            const float4 a4 = *(const float4*)&As[k][ty * 4];
            const float4 b4 = *(const float4*)&Bs[k][tx * 4];
            const float aa[4] = {a4.x, a4.y, a4.z, a4.w}, bb[4] = {b4.x, b4.y, b4.z, b4.w};
#pragma unroll
            for (int i = 0; i < 4; ++i)
#pragma unroll
                for (int j = 0; j < 4; ++j) acc[i][j] += aa[i] * bb[j];
        }
    }
    if (col0 + tx * 4 < N) {
#pragma unroll
        for (int i = 0; i < 4; ++i)
            *(float4*)(C + (size_t)(row0 + ty * 4 + i) * ldc + col0 + tx * 4) = make_float4(acc[i][0], acc[i][1], acc[i][2], acc[i][3]);
    }
}
__device__ __forceinline__ void gemm_phase(const float* A, const float* Bm, float* C, int M, int N, int K, int lda, int ldb, int ldc, int half, int tid, float* sh) {
    const int ntx = (N + 63) / 64, nty = M / 64, ntile = ntx * nty, G2 = gridDim.x * 2;
    for (int t0 = blockIdx.x * 2; t0 < ntile; t0 += G2) {
        int tl = t0 + half; if (tl >= ntile) tl = ntile - 1;
        gemm_tile(A, Bm, C, N, K, lda, ldb, ldc, tl % ntx, tl / ntx, tid, sh);
    }
}

__device__ __forceinline__ void fox_prep(const float* proj, const float* __restrict__ bf, float* cbuf, int bh, int lane) {
    const int b = bh / FH, h = bh % FH;
    const float bias = bf[h];
    float s = 0.f;
    for (int i = 0; i < 64; ++i) { const int t = lane * 64 + i; s += logsigmoidf(proj[(size_t)(b * S + t) * INW + O_FF + h] + bias); }
    float inc = s;
    for (int o = 1; o < 64; o <<= 1) { const float n = __shfl_up(inc, o); if (lane >= o) inc += n; }
    float run = inc - s;
    for (int i = 0; i < 64; ++i) { const int t = lane * 64 + i; run += logsigmoidf(proj[(size_t)(b * S + t) * INW + O_FF + h] + bias); cbuf[(size_t)bh * S + t] = run; }
}

__device__ __forceinline__ void fox_attn(const float* proj, const float* cbuf, float* y, int blk, int lane) {
    const int qb = blk % (S / 64), bh = blk / (S / 64), b = bh / FH, h = bh % FH;
    const int t = qb * 64 + lane;
    const float* qp = proj + (size_t)(b * S + t) * INW + O_FQ + h * FD;
    float q[64], o[64];
#pragma unroll
    for (int d = 0; d < 64; ++d) { q[d] = qp[d] * 0.125f; o[d] = 0.f; }
    const float ct = cbuf[(size_t)bh * S + t];
    float m = -INFINITY, l = 0.f;
    const int smax = qb * 64 + 63;
    for (int s = 0; s <= smax; ++s) {
        const float* kp = proj + (size_t)(b * S + s) * INW + O_FK + h * FD;
        const float* vp = proj + (size_t)(b * S + s) * INW + O_FV + h * FD;
        float dot = 0.f;
#pragma unroll
        for (int d = 0; d < 64; ++d) dot += q[d] * kp[d];
        const float x = dot + (ct - cbuf[(size_t)bh * S + s]);
        if (s <= t) {
            if (x > m) { const float al = expf(m - x); l *= al;
#pragma unroll
                for (int d = 0; d < 64; ++d) o[d] *= al;
                m = x; }
            const float p = expf(x - m); l += p;
#pragma unroll
            for (int d = 0; d < 64; ++d) o[d] += p * vp[d];
        }
    }
    const float il = 1.f / l;
    float* yp = y + (size_t)(b * S + t) * D + h * FD;
#pragma unroll
    for (int d = 0; d < 64; ++d) yp[d] = o[d] * il;
}

__device__ __forceinline__ void gla_prep(const float* proj, const float* __restrict__ wgu, const float* __restrict__ bg, float* abuf, int t, int j) {
    const float* ga = proj + (size_t)t * INW + O_GA;
    float s = bg[j];
#pragma unroll
    for (int r = 0; r < RANK; ++r) s += ga[r] * wgu[r * 256 + j];
    abuf[(size_t)t * 256 + j] = expf(logsigmoidf(s) * (1.f / 16.f));
}

__device__ __forceinline__ void gla_rec(const float* proj, const float* abuf, float* glao, int bh, int e) {
    const int b = bh / GH, h = bh % GH;
    float st[64];
#pragma unroll
    for (int d = 0; d < 64; ++d) st[d] = 0.f;
    for (int s = 0; s < S; ++s) {
        const size_t t = (size_t)b * S + s;
        const float* qp = proj + t * INW + O_GQ + h * GK;
        const float* kp = proj + t * INW + O_GK + h * GK;
        const float* ap = abuf + t * 256 + h * GK;
        const float v = proj[t * INW + O_GV + h * GV + e];
        float o = 0.f;
#pragma unroll
        for (int d = 0; d < 64; ++d) { st[d] = ap[d] * st[d] + kp[d] * v; o += qp[d] * st[d]; }
        glao[t * 512 + h * GV + e] = o * 0.125f;
    }
}

__device__ __forceinline__ void gla_post(const float* glao, const float* proj, const float* __restrict__ g, float* y, int w, int lane) {
    const int t = w >> 2, h = w & 3;
    const float o0 = glao[(size_t)t * 512 + h * GV + lane], o1 = glao[(size_t)t * 512 + h * GV + 64 + lane];
    float ss = o0 * o0 + o1 * o1;
    for (int o = 32; o > 0; o >>= 1) ss += __shfl_xor(ss, o);
    const float r = rsqrtf(ss * (1.f / GV) + LN_EPS);
    const float g0 = proj[(size_t)t * INW + O_GR + h * GV + lane], g1 = proj[(size_t)t * INW + O_GR + h * GV + 64 + lane];
    y[(size_t)t * D + 512 + h * GV + lane] = o0 * r * g[lane] * siluf(g0);
    y[(size_t)t * D + 512 + h * GV + 64 + lane] = o1 * r * g[64 + lane] * siluf(g1);
}

__device__ __forceinline__ void route_token(const float* logits, const float* __restrict__ rbias, int* top_e, float* top_w, int* top_pos, int* counts, int t, int lane) {
    const float4 lg = ((const float4*)(logits + (size_t)t * NE))[lane];
    const float4 rb = ((const float4*)rbias)[lane];
    float sc[4] = {1.f / (1.f + expf(-lg.x)), 1.f / (1.f + expf(-lg.y)), 1.f / (1.f + expf(-lg.z)), 1.f / (1.f + expf(-lg.w))};
    float bv[4] = {sc[0] + rb.x, sc[1] + rb.y, sc[2] + rb.z, sc[3] + rb.w};
    float m1 = fmaxf(bv[0], bv[1]), m2 = fminf(bv[0], bv[1]);
    { const float a = fmaxf(bv[2], bv[3]), c = fminf(bv[2], bv[3]); const float n1 = fmaxf(m1, a); m2 = fmaxf(fminf(m1, a), fmaxf(m2, c)); m1 = n1; }
    for (int o = 1; o < 8; o <<= 1) { const float p1 = __shfl_xor(m1, o), p2 = __shfl_xor(m2, o); const float n1 = fmaxf(m1, p1); m2 = fmaxf(fminf(m1, p1), fmaxf(m2, p2)); m1 = n1; }
    const float gs = m1 + m2;
    const int myg = lane >> 3;
    int rank = 0;
#pragma unroll
    for (int g2 = 0; g2 < NG; ++g2) { const float og = __shfl(gs, g2 * 8); if (og > gs || (og == gs && g2 < myg)) ++rank; }
    const bool sel = rank < 4;
    float mv[4];
#pragma unroll
    for (int i = 0; i < 4; ++i) mv[i] = sel ? bv[i] : -INFINITY;
    int we[TOPK]; float ws[TOPK]; float wsum = 0.f;
#pragma unroll
    for (int k = 0; k < TOPK; ++k) {
        float bvv = mv[0]; int bi = 0;
#pragma unroll
        for (int i = 1; i < 4; ++i) if (mv[i] > bvv) { bvv = mv[i]; bi = i; }
        int gi = lane * 4 + bi;
        for (int o = 32; o > 0; o >>= 1) { const float ov = __shfl_xor(bvv, o); const int oi = __shfl_xor(gi, o); if (ov > bvv || (ov == bvv && oi < gi)) { bvv = ov; gi = oi; } }
        const int ol = gi >> 2, oi = gi & 3;
        const float s_own = (oi == 0) ? sc[0] : (oi == 1) ? sc[1] : (oi == 2) ? sc[2] : sc[3];
        const float sw = __shfl(s_own, ol);
        if (lane == ol) { if (oi == 0) mv[0] = -INFINITY; else if (oi == 1) mv[1] = -INFINITY; else if (oi == 2) mv[2] = -INFINITY; else mv[3] = -INFINITY; }
        we[k] = gi; ws[k] = sw; wsum += sw;
    }
    if (lane == 0) {
        const float inv = 2.5f / wsum;
#pragma unroll
        for (int k = 0; k < TOPK; ++k) {
            top_e[t * TOPK + k] = we[k]; top_w[t * TOPK + k] = ws[k] * inv;
            top_pos[t * TOPK + k] = atomicAdd(&counts[we[k]], 1);
        }
    }
}

__device__ __forceinline__ void moe_offsets(const int* counts, int* off, int* blk_exp, int* nblk, int lane) {
    int pc[4], st[4]; int tot = 0;
#pragma unroll
    for (int i = 0; i < 4; ++i) { pc[i] = (counts[lane * 4 + i] + PADR - 1) / PADR * PADR; st[i] = tot; tot += pc[i]; }
    int inc = tot;
    for (int o = 1; o < 64; o <<= 1) { const int n = __shfl_up(inc, o); if (lane >= o) inc += n; }
    const int base = inc - tot;
#pragma unroll
    for (int i = 0; i < 4; ++i) { const int start = base + st[i]; off[lane * 4 + i] = start; for (int k = start / PADR; k < (start + pc[i]) / PADR; ++k) blk_exp[k] = lane * 4 + i; }
    if (lane == 63) nblk[0] = inc / PADR;
}

__device__ __forceinline__ void moe_scatter(const int* top_e, const float* top_w, const int* top_pos, const int* off, int* row_tok, float* row_gate, int* slot_of, int a) {
    const int slot = off[top_e[a]] + top_pos[a];
    row_tok[slot] = a / TOPK; row_gate[slot] = top_w[a]; slot_of[a] = slot;
}

__device__ __forceinline__ void moe_hidden(const float* h1, const float* __restrict__ wg, const float* __restrict__ wu, const int* row_tok, const float* row_gate, const int* blk_exp, const int* nblk,
                                           float* hidden, int g16, int j, float* sh) {
    const bool active = g16 * 16 < nblk[0] * PADR;
    float (*xs)[D] = (float (*)[D])sh;
    __syncthreads();
    if (active) for (int r = 0; r < 16; ++r) { const int tok = row_tok[g16 * 16 + r]; ((float4*)xs[r])[j] = ((const float4*)(h1 + (size_t)tok * D))[j]; }
    __syncthreads();
    if (!active) return;
    const int e = blk_exp[(g16 * 16) / PADR];
    float ag[16], au[16];
#pragma unroll
    for (int r = 0; r < 16; ++r) { ag[r] = 0.f; au[r] = 0.f; }
    const float* wgp = wg + (size_t)e * D * ED + j; const float* wup = wu + (size_t)e * D * ED + j;
    for (int d = 0; d < D; d += 4) {
        const float g0 = wgp[(size_t)(d + 0) * ED], g1 = wgp[(size_t)(d + 1) * ED], g2 = wgp[(size_t)(d + 2) * ED], g3 = wgp[(size_t)(d + 3) * ED];
        const float u0 = wup[(size_t)(d + 0) * ED], u1 = wup[(size_t)(d + 1) * ED], u2 = wup[(size_t)(d + 2) * ED], u3 = wup[(size_t)(d + 3) * ED];
#pragma unroll
        for (int r = 0; r < 16; ++r) { const float4 x = *(const float4*)&xs[r][d];
            ag[r] += x.x * g0 + x.y * g1 + x.z * g2 + x.w * g3; au[r] += x.x * u0 + x.y * u1 + x.z * u2 + x.w * u3; }
    }
#pragma unroll
    for (int r = 0; r < 16; ++r) hidden[(size_t)(g16 * 16 + r) * ED + j] = row_gate[g16 * 16 + r] * siluf(ag[r]) * au[r];
}

__device__ __forceinline__ void moe_down(const float* hidden, const float* __restrict__ wd, const int* top_e, const int* slot_of, float* ffn, int t, int i, float* sh) {
    float4 acc = ((float4*)(ffn + (size_t)t * D))[i];
    for (int k = 0; k < TOPK; ++k) {
        const int e = top_e[t * TOPK + k], slot = slot_of[t * TOPK + k];
        __syncthreads();
        sh[i] = hidden[(size_t)slot * ED + i];
        __syncthreads();
        const float4* wp = (const float4*)(wd + (size_t)e * ED * D) + i;
        for (int j = 0; j < ED; ++j) { const float4 w = wp[(size_t)j * (D / 4)]; const float hv = sh[j]; acc.x += hv * w.x; acc.y += hv * w.y; acc.z += hv * w.z; acc.w += hv * w.w; }
    }
    ((float4*)(ffn + (size_t)t * D))[i] = acc;
}
}
#include <hip/hip_bf16.h>
#include <cmath>
namespace attn_body {
using bf16=__hip_bfloat16;
using bf16x8=__attribute__((ext_vector_type(8)))short;
using s16x4=__attribute__((ext_vector_type(4)))short;
using f32x16=__attribute__((ext_vector_type(16)))float;
using u32x4=__attribute__((ext_vector_type(4)))unsigned;
constexpr int BATCH=8,NHEAD=8,SEQ=4096,D=64,DM=3072,OPITCH=1024;
constexpr int NW=8,QBLK=32,QB=QBLK*NW,KVBLK=64,NQB=SEQ/QB;
constexpr int ATTN_PITCH=DM, ATTN_UNIT_ROWS=QB;
__device__ __forceinline__ int crow(int r,int hi){return (r&3)+8*(r>>2)+4*hi;}
#define SBAR() __builtin_amdgcn_sched_barrier(0)
__device__ __forceinline__ void cmask(f32x16&p0,f32x16&p1,int jb,int qrel,int hi){
  const float NEG=-INFINITY; int kb=64*jb+4*hi;
  #pragma unroll
  for(int r=0;r<16;++r){int kv=kb+(r&3)+8*(r>>2); if(kv>qrel)p0[r]=NEG; if(kv+32>qrel)p1[r]=NEG;}
}

constexpr int NSLOT=3, SLOTB=8192;
constexpr int LDS_K=0, LDS_V=NSLOT*SLOTB, LDS_WS=2*NSLOT*SLOTB, LDS_OST=LDS_WS+NW*64*4, LDS_KB=LDS_OST+NW*4096, LDS_BYTES=LDS_KB+(SEQ+2)*8;
constexpr float C2=0.125f*1.4426950408889634f;
__device__ __forceinline__ void glds16(const void*gsrc,unsigned lds_dst){unsigned keep;
  asm volatile("s_mov_b32 %0, m0\n\ts_mov_b32 m0, %2\n\ts_nop 0\n\tglobal_load_lds_dwordx4 %1, off\n\ts_mov_b32 m0, %0":"=&s"(keep):"v"(gsrc),"s"(lds_dst):"memory");}
__device__ __forceinline__ float max3f(float a,float b,float c){float r;asm("v_max3_f32 %0, %1, %2, %3":"=v"(r):"v"(a),"v"(b),"v"(c));return r;}
__device__ __forceinline__ float max2f(float a,float b){float r;asm("v_max_f32_e32 %0, %1, %2":"=v"(r):"v"(a),"v"(b));return r;}
__device__ __forceinline__ float fadd_s(float a,float b){float r;asm("v_add_f32_e32 %0, %1, %2":"=v"(r):"v"(a),"v"(b));return r;}
__device__ __forceinline__ float fsub_s(float a,float b){float r;asm("v_sub_f32_e32 %0, %1, %2":"=v"(r):"v"(a),"v"(b));return r;}
typedef float f32x2_t __attribute__((ext_vector_type(2))); typedef float f32x4_t __attribute__((ext_vector_type(4))); typedef __bf16 bf16x2_t __attribute__((ext_vector_type(2)));
__device__ __forceinline__ unsigned cvtpk_s(float lo,float hi){f32x2_t v={lo,hi};bf16x2_t b=__builtin_convertvector(v,bf16x2_t);return __builtin_bit_cast(unsigned,b);}
#define WAIT_BAR(N) asm volatile("s_waitcnt vmcnt(" #N ") lgkmcnt(0)\n\ts_barrier":::"memory")

__device__ __forceinline__ void split3(float b,unsigned&h,unsigned&m,unsigned&l){
  h=cvtpk_s(b,0.f)&0xffffu; const float r1=b-__uint_as_float(h<<16);
  m=cvtpk_s(r1,0.f)&0xffffu; const float r2=r1-__uint_as_float(m<<16);
  l=cvtpk_s(r2,0.f)&0xffffu; }
__device__ __forceinline__ bf16x8 kbias_frag(float b,int hi){unsigned h,m,l;split3(b,h,m,l);u32x4 w;w.x=h|(m<<16);w.y=l|0x3F800000u;w.z=0x3F803F80u;w.w=0u;if(hi){w.x=0u;w.y=0u;w.z=0u;}return __builtin_bit_cast(bf16x8,w);}
__device__ __forceinline__ bf16x8 qref_frag(float x,int hi){unsigned h,m,l;split3(x,h,m,l);u32x4 w;w.x=0x3F803F80u;w.y=0x3F80u|(h<<16);w.z=m|(l<<16);w.w=0u;if(hi){w.x=0u;w.y=0u;w.z=0u;}return __builtin_bit_cast(bf16x8,w);}
typedef unsigned u32x2_t __attribute__((ext_vector_type(2)));
__device__ __forceinline__ bf16x8 mkfrag(u32x2_t e,unsigned zc){u32x4 w;w.x=e.x;w.y=e.y;w.z=zc;w.w=0u;return __builtin_bit_cast(bf16x8,w);}
__device__ __forceinline__ void fox_bias_table(int b,int h,const float*LF,char*shm){
  int tid_=threadIdx.x; asm volatile("":"+v"(tid_)); const int tid=tid_,lane=tid&63,wid=__builtin_amdgcn_readfirstlane(tid>>6);
  const float*lf=LF+((long)b*NHEAD+h)*SEQ; float*wt=(float*)(shm+LDS_WS); u32x2_t*KB8=(u32x2_t*)(shm+LDS_KB);
  f32x4_t va=*(const f32x4_t*)(lf+8*tid),vb=*(const f32x4_t*)(lf+8*tid+4);
  va[1]+=va[0];va[2]+=va[1];va[3]+=va[2];vb[0]+=va[3];vb[1]+=vb[0];vb[2]+=vb[1];vb[3]+=vb[2];
  const float tot=vb[3]; float inc=tot;
  #pragma unroll
  for(int o_=1;o_<64;o_<<=1){const float nn=__shfl_up(inc,o_);if(lane>=o_)inc+=nn;}
  __syncthreads();
  if(lane==63)wt[wid*64]=inc;
  __syncthreads();
  float base=inc-tot;
  #pragma unroll
  for(int w_=0;w_<NW;++w_){const float x_=wt[w_*64]; if(w_<wid)base+=x_;}
  const float cv[8]={va[0]+base,va[1]+base,va[2]+base,va[3]+base,vb[0]+base,vb[1]+base,vb[2]+base,vb[3]+base};
  #pragma unroll
  for(int j=0;j<8;++j){unsigned hh,mm,ll;split3(-cv[j],hh,mm,ll);KB8[8*tid+j]=(u32x2_t){hh|(mm<<16),ll|0x3F800000u};}
  if(tid==0){KB8[SEQ]=(u32x2_t){0u,0u};KB8[SEQ+1]=(u32x2_t){0u,0u};}
  __syncthreads();
}
__device__ __forceinline__ void qkt(f32x16&p0,f32x16&p1,const char*Kslot,const bf16x8*qr,bf16x8 kb0,bf16x8 kb1,bf16x8 qx,int r32,int hi){
  const f32x16 negm=f32x16{};
  const char*kb=Kslot+hi*1024+r32*16;
  #pragma unroll
  for(int d0=0;d0<4;++d0){
    const bf16x8 b0=*reinterpret_cast<const bf16x8*>(kb+d0*2048);
    const bf16x8 b1=*reinterpret_cast<const bf16x8*>(kb+d0*2048+512);
    if(d0==0){p0=__builtin_amdgcn_mfma_f32_32x32x16_bf16(b0,qr[0],negm,0,0,0);p1=__builtin_amdgcn_mfma_f32_32x32x16_bf16(b1,qr[0],negm,0,0,0);}
    else{p0=__builtin_amdgcn_mfma_f32_32x32x16_bf16(b0,qr[d0],p0,0,0,0);p1=__builtin_amdgcn_mfma_f32_32x32x16_bf16(b1,qr[d0],p1,0,0,0);}}
  p0=__builtin_amdgcn_mfma_f32_32x32x16_bf16(kb0,qx,p0,0,0,0);p1=__builtin_amdgcn_mfma_f32_32x32x16_bf16(kb1,qx,p1,0,0,0);
}
typedef __attribute__((address_space(3))) const char* lds_cptr;
typedef short v4i16_t __attribute__((ext_vector_type(4)));
__device__ __forceinline__ void kload8(bf16x8*kf,lds_cptr kp){
  kf[0]=*(const __attribute__((address_space(3))) bf16x8*)(kp);      kf[1]=*(const __attribute__((address_space(3))) bf16x8*)(kp+512);
  kf[2]=*(const __attribute__((address_space(3))) bf16x8*)(kp+2048); kf[3]=*(const __attribute__((address_space(3))) bf16x8*)(kp+2560);
  kf[4]=*(const __attribute__((address_space(3))) bf16x8*)(kp+4096); kf[5]=*(const __attribute__((address_space(3))) bf16x8*)(kp+4608);
  kf[6]=*(const __attribute__((address_space(3))) bf16x8*)(kp+6144); kf[7]=*(const __attribute__((address_space(3))) bf16x8*)(kp+6656);
}
__device__ __forceinline__ void kload2(bf16x8*kf,lds_cptr kp,int j){ kf[2*j]=*(const __attribute__((address_space(3))) bf16x8*)(kp+j*2048); kf[2*j+1]=*(const __attribute__((address_space(3))) bf16x8*)(kp+j*2048+512); }
__device__ __forceinline__ s16x4 vtr(lds_cptr p){ return __builtin_bit_cast(s16x4,__builtin_amdgcn_ds_read_tr16_b64_v4i16((__attribute__((address_space(3))) v4i16_t*)p)); }
__device__ __forceinline__ float rowmax(const f32x16&p0,const f32x16&p1){
  float a=max3f(p0[0],p0[1],p1[0]),b=max3f(p0[2],p0[3],p1[1]);a=max3f(a,p1[2],p1[3]);
  #pragma unroll
  for(int r=4;r<16;r+=4){a=max3f(a,p0[r],p0[r+1]);b=max3f(b,p0[r+2],p0[r+3]);a=max3f(a,p1[r],p1[r+1]);b=max3f(b,p1[r+2],p1[r+3]);}
  const float m=max2f(a,b);
  auto rr=__builtin_amdgcn_permlane32_swap(__float_as_uint(m),__float_as_uint(m),false,false);
  return max2f(__uint_as_float(rr[0]),__uint_as_float(rr[1]));
}
__device__ __forceinline__ void pv(f32x16*o,int vb,bf16x8 pa0,bf16x8 pa1,bf16x8 pa2,bf16x8 pa3){
  #pragma unroll
  for(int d0=0;d0<2;++d0){s16x4 lo[4],hi[4];
    #pragma unroll
    for(int ks=0;ks<4;++ks){
      asm volatile("ds_read_b64_tr_b16 %0,%1 offset:%c2":"=&v"(lo[ks]):"v"(vb),"i"(d0*4096+ks*1024):"memory");
      asm volatile("ds_read_b64_tr_b16 %0,%1 offset:%c2":"=&v"(hi[ks]):"v"(vb),"i"(d0*4096+ks*1024+512):"memory");}
    asm volatile("s_waitcnt lgkmcnt(0)":::"memory");SBAR();
    #define PK(k) (bf16x8){lo[k][0],lo[k][1],lo[k][2],lo[k][3],hi[k][0],hi[k][1],hi[k][2],hi[k][3]}
    o[d0]=__builtin_amdgcn_mfma_f32_32x32x16_bf16(pa0,PK(0),o[d0],0,0,0);
    o[d0]=__builtin_amdgcn_mfma_f32_32x32x16_bf16(pa1,PK(1),o[d0],0,0,0);
    o[d0]=__builtin_amdgcn_mfma_f32_32x32x16_bf16(pa2,PK(2),o[d0],0,0,0);
    o[d0]=__builtin_amdgcn_mfma_f32_32x32x16_bf16(pa3,PK(3),o[d0],0,0,0);
    #undef PK
  }
}

#ifndef ATTN_STORE16
#define ATTN_STORE16(p,v) (*(u32x4*)(p)=(v))
#endif
template<int THRL> __device__ __forceinline__ void attn_unit(int b,int h,int qb,const bf16*Q,const bf16* K,const bf16* V,bf16*O,const float*LF,const unsigned*NRM,char*shm){
  int tid_=threadIdx.x; asm volatile("":"+v"(tid_));
  const int tid=tid_,lane=tid&63,r32=lane&31,hi=lane>>5; const int wid=__builtin_amdgcn_readfirstlane(tid>>6);
  const long rowbase=(long)b*SEQ; const int q0=qb*QB;
  const char*KBt0=shm+LDS_KB;
  int t0;
  { const int NT0=(q0+QB)/KVBLK; const unsigned*nr=NRM+(b*NHEAD+h)*4;
    const float qn2=__uint_as_float(nr[0])+__uint_as_float(nr[1]), kn2=__uint_as_float(nr[2])+__uint_as_float(nr[3]);
    const float thr=-(50.f+2.04f*sqrtf(qn2*kn2));
    const u32x2_t eq0=*(const u32x2_t*)(KBt0+(unsigned)q0*8u); const float bq0=__uint_as_float(eq0.x<<16)+__uint_as_float(eq0.x&0xffff0000u)+__uint_as_float(eq0.y<<16);
    bool ok=(2*lane<=NT0-4);
    if(ok&&lane>0){ const u32x2_t el=*(const u32x2_t*)(KBt0+(unsigned)(128*lane-1)*8u); const float bl=__uint_as_float(el.x<<16)+__uint_as_float(el.x&0xffff0000u)+__uint_as_float(el.y<<16); ok=(bl-bq0<thr); }
    const unsigned long long mk=__ballot(ok); const unsigned long long low=~mk; const int cnt=(low==0ull)?64:__builtin_ctzll(low);
    t0=__builtin_amdgcn_readfirstlane(2*(cnt-1)); }
  const char*KBt=KBt0+(hi?0:t0*512); const unsigned kb_o0=hi?(unsigned)SEQ*8u:(unsigned)r32*8u, kb_o1=hi?(unsigned)SEQ*8u:(unsigned)(r32+32)*8u, kb_str=hi?0u:512u, zc=hi?0u:0x3F803F80u;
  const bf16*Qw=Q+(rowbase+q0+wid*QBLK)*DM+h*D;
  const bf16*Kh=K+(rowbase+(long)t0*KVBLK)*DM+h*D,*Vh=V+(rowbase+(long)t0*KVBLK)*DM+h*D;
  const unsigned lds0=(unsigned)(uintptr_t)shm;
  float*wsf=(float*)(shm+LDS_WS)+wid*64;
  const bf16*ksrc=Kh+(long)lane*DM+wid*8;
  const bf16*vsrc=Vh+(long)(16*(wid&3)+(lane>>2))*DM+(wid>>2)*32+(lane&3)*8;
  const unsigned kdst=lds0+LDS_K+wid*1024, vdst=lds0+LDS_V+wid*1024;
  #define DMA_K(t,slot) glds16(ksrc+(long)(t)*KVBLK*DM,(unsigned)__builtin_amdgcn_readfirstlane(kdst+(slot)))
  #define DMA_V(t,slot) glds16(vsrc+(long)(t)*KVBLK*DM,(unsigned)__builtin_amdgcn_readfirstlane(vdst+(slot)))
  const int vb0=(int)(lds0+LDS_V)+((lane>>4)&1)*32+(lane&3)*8+(4*hi+((lane&15)>>2))*64;
  const char*Kbase=shm+LDS_K; bf16x8 kf[8];
  const lds_cptr shm3=(lds_cptr)shm; const lds_cptr kp0=shm3+LDS_K+hi*1024+r32*16; const lds_cptr vp0=shm3+LDS_V+((lane>>4)&1)*32+(lane&3)*8+(4*hi+((lane&15)>>2))*64;
  const int NT=(q0+QB)/KVBLK-t0;
  DMA_K(0,0);DMA_V(0,0);DMA_K(1,SLOTB);
  bf16x8 qr[4];
  #pragma unroll
  for(int d0=0;d0<4;++d0)qr[d0]=*reinterpret_cast<const bf16x8*>(&Qw[(long)r32*DM+d0*16+hi*8]);
  float mhat; { const u32x2_t eq=*(const u32x2_t*)(KBt0+(unsigned)(q0+wid*QBLK+r32)*8u); mhat=__uint_as_float(eq.x<<16)+__uint_as_float(eq.x&0xffff0000u)+__uint_as_float(eq.y<<16); }
  float l_reg=0.f;f32x16 o[2];o[0]=f32x16{};o[1]=f32x16{};const f32x16 negm=f32x16{};
  bf16x8 qx=qref_frag(-mhat,hi);
  const int qrel=wid*QBLK+r32;
  #define CMASK(P0,P1,t) do{int jb_=(t)-(NT-4); if(jb_>=0)cmask(P0,P1,jb_,qrel,hi);}while(0)
  bool resc=false;
  #define START(P0,P1) do{ const float rm=rowmax(P0,P1); resc=false; \
    { const float dl=__builtin_fmaxf(rm,0.f); mhat=fadd_s(mhat,dl); \
      _Pragma("unroll") for(int r=0;r<16;++r){P0[r]=fsub_s(P0[r],dl);P1[r]=fsub_s(P1[r],dl);} \
      qx=qref_frag(-mhat,hi); } \
    _Pragma("unroll") for(int r=0;r<16;++r)P0[r]=__builtin_amdgcn_exp2f(P0[r]); }while(0)
  #define RESC() do{ if(resc){ asm volatile("s_waitcnt lgkmcnt(0)":::"memory"); \
      _Pragma("unroll") for(int d_=0;d_<2;++d_) _Pragma("unroll") for(int r=0;r<16;++r)o[d_][r]*=wsf[crow(r,hi)]; } }while(0)
  f32x16 pA0,pA1,pB0,pB1;
  int sl_prev=0,sl_cur=0,sl_next=SLOTB;
  #define ROT() do{sl_prev=sl_cur;sl_cur=sl_next;sl_next=(sl_next==(NSLOT-1)*SLOTB)?0:sl_next+SLOTB;}while(0)
  DMA_K(2,2*SLOTB);
  WAIT_BAR(3);
  qkt(pA0,pA1,Kbase,qr,mkfrag(*(const u32x2_t*)(KBt+kb_o0),zc),mkfrag(*(const u32x2_t*)(KBt+kb_o1),zc),qx,r32,hi);asm volatile("s_nop 15\n\ts_nop 7":"+v"(pA0),"+v"(pA1));CMASK(pA0,pA1,0);
  START(pA0,pA1);
  _Pragma("unroll") for(int r=0;r<16;++r)pA1[r]=__builtin_amdgcn_exp2f(pA1[r]);
  WAIT_BAR(0);
  DMA_K(3,0);DMA_V(1,SLOTB);
  ROT();
  kload8(kf,kp0+sl_cur);
  WAIT_BAR(2);
  s16x4 vlo[8],vhi[8]; u32x4 pw0,pw1,pw2,pw3;
  #define PKW(P,B) cvtpk_s(P[B],P[B+1])
  #define PAF(k) __builtin_bit_cast(bf16x8,pw##k)
  #define VFR(i) (bf16x8){vlo[i][0],vlo[i][1],vlo[i][2],vlo[i][3],vhi[i][0],vhi[i][1],vhi[i][2],vhi[i][3]}
  #define PIN(x) asm volatile("":"+v"(x))
  #define MX3(a,b,c) __builtin_fmaxf(__builtin_fmaxf((a),(b)),(c))
  #define GAPA(MF,A0,A1,A2,A3,W0,W1,PW) do{ MF; sacc+=A0; sacc+=A1; sacc+=A2; sacc+=A3; PIN(sacc); W0; W1; PIN(PW); SBAR(); }while(0)
  #define EX(v) __builtin_amdgcn_exp2f(v)
  #define GAPB(MF,X,B) do{ MF; X[B]=EX(X[B]); X[B+1]=EX(X[B+1]); X[B+2]=EX(X[B+2]); X[B+3]=EX(X[B+3]); PIN(X); SBAR(); }while(0)
  #define VRD(i) do{ vlo[i]=vtr(vp_+(((i)>>2)*4096+((i)&3)*1024)); vhi[i]=vtr(vp_+(((i)>>2)*4096+((i)&3)*1024+512)); }while(0)
  #define KRD(G,j) do{ if(G){ kload2(kf,kp0+sl_next,j); SBAR(); } }while(0)
  #define STEP(C0,C1,P0,P1,t,GK,GV,GL) do{ SBAR(); \
    const lds_cptr vp_=vp0+sl_prev; const u32x2_t e0_=*(const u32x2_t*)(KBt+kb_o0+(unsigned)(t)*kb_str),e1_=*(const u32x2_t*)(KBt+kb_o1+(unsigned)(t)*kb_str); \
    VRD(0); SBAR(); float sacc=(P0[0]+P0[1]); \
    GAPA(C0=__builtin_amdgcn_mfma_f32_32x32x16_bf16(kf[0],qr[0],negm,0,0,0), P0[2],P0[3],P0[4],P0[5],     pw0[0]=PKW(P0,0), pw0[1]=PKW(P0,2), pw0); \
    VRD(4); SBAR(); GAPA(C1=__builtin_amdgcn_mfma_f32_32x32x16_bf16(kf[1],qr[0],negm,0,0,0), P0[6],P0[7],P0[8],P0[9],     pw0[2]=PKW(P0,4), pw0[3]=PKW(P0,6), pw0); \
    VRD(1); SBAR(); GAPA(C0=__builtin_amdgcn_mfma_f32_32x32x16_bf16(kf[2],qr[1],C0,0,0,0),   P0[10],P0[11],P0[12],P0[13], pw1[0]=PKW(P0,8), pw1[1]=PKW(P0,10), pw1); \
    VRD(5); SBAR(); GAPA(C1=__builtin_amdgcn_mfma_f32_32x32x16_bf16(kf[3],qr[1],C1,0,0,0),   P0[14],P0[15],P1[0],P1[1],   pw1[2]=PKW(P0,12),pw1[3]=PKW(P0,14), pw1); \
    VRD(2); SBAR(); GAPA(C0=__builtin_amdgcn_mfma_f32_32x32x16_bf16(kf[4],qr[2],C0,0,0,0),   P1[2],P1[3],P1[4],P1[5],     pw2[0]=PKW(P1,0), pw2[1]=PKW(P1,2), pw2); \
    VRD(6); SBAR(); GAPA(C1=__builtin_amdgcn_mfma_f32_32x32x16_bf16(kf[5],qr[2],C1,0,0,0),   P1[6],P1[7],P1[8],P1[9],     pw2[2]=PKW(P1,4), pw2[3]=PKW(P1,6), pw2); \
    VRD(3); SBAR(); GAPA(C0=__builtin_amdgcn_mfma_f32_32x32x16_bf16(kf[6],qr[3],C0,0,0,0),   P1[10],P1[11],P1[12],P1[13], pw3[0]=PKW(P1,8), pw3[1]=PKW(P1,10), pw3); \
    VRD(7); SBAR(); GAPA(C1=__builtin_amdgcn_mfma_f32_32x32x16_bf16(kf[7],qr[3],C1,0,0,0),   P1[14],P1[15],0.f,0.f,       pw3[2]=PKW(P1,12),pw3[3]=PKW(P1,14), pw3); \
    { const bf16x8 kb0_=mkfrag(e0_,zc),kb1_=mkfrag(e1_,zc); C0=__builtin_amdgcn_mfma_f32_32x32x16_bf16(kb0_,qx,C0,0,0,0); C1=__builtin_amdgcn_mfma_f32_32x32x16_bf16(kb1_,qx,C1,0,0,0); } SBAR(); \
    l_reg+=sacc; \
    if(GK){DMA_K((t)+3,sl_cur);} if(GV){DMA_V((t)+1,sl_next);} \
    CMASK(C0,C1,t); \
    { float a=MX3(C0[0],C0[1],C1[0]),b=MX3(C0[2],C0[3],C1[1]); a=MX3(a,C1[2],C1[3]); \
      _Pragma("unroll") for(int r=4;r<16;r+=4){a=MX3(a,C0[r],C0[r+1]);b=MX3(b,C0[r+2],C0[r+3]);a=MX3(a,C1[r],C1[r+1]);b=MX3(b,C1[r+2],C1[r+3]);} \
      float rm=__builtin_fmaxf(a,b); { auto rr=__builtin_amdgcn_permlane32_swap(__float_as_uint(rm),__float_as_uint(rm),false,false); rm=__builtin_fmaxf(__uint_as_float(rr[0]),__uint_as_float(rr[1])); } \
      resc=false; \
      if(__builtin_expect(__any(rm>(float)THRL),0)){ const float dl=__builtin_fmaxf(rm,0.f); mhat+=dl; \
        _Pragma("unroll") for(int r=0;r<16;++r){C0[r]-=dl;C1[r]-=dl;} \
        qx=qref_frag(-mhat,hi); \
        const float f=__builtin_amdgcn_exp2f(-dl); l_reg*=f; if(hi==0)wsf[r32]=f; resc=true; } } \
    SBAR(); \
    GAPB(o[0]=__builtin_amdgcn_mfma_f32_32x32x16_bf16(PAF(0),VFR(0),o[0],0,0,0), C0,0); \
    GAPB(o[1]=__builtin_amdgcn_mfma_f32_32x32x16_bf16(PAF(0),VFR(4),o[1],0,0,0), C0,4); \
    KRD(GL,0); GAPB(o[0]=__builtin_amdgcn_mfma_f32_32x32x16_bf16(PAF(1),VFR(1),o[0],0,0,0), C0,8); \
    KRD(GL,1); GAPB(o[1]=__builtin_amdgcn_mfma_f32_32x32x16_bf16(PAF(1),VFR(5),o[1],0,0,0), C0,12); \
    KRD(GL,2); GAPB(o[0]=__builtin_amdgcn_mfma_f32_32x32x16_bf16(PAF(2),VFR(2),o[0],0,0,0), C1,0); \
    KRD(GL,3); GAPB(o[1]=__builtin_amdgcn_mfma_f32_32x32x16_bf16(PAF(2),VFR(6),o[1],0,0,0), C1,4); \
    GAPB(o[0]=__builtin_amdgcn_mfma_f32_32x32x16_bf16(PAF(3),VFR(3),o[0],0,0,0), C1,8); \
    GAPB(o[1]=__builtin_amdgcn_mfma_f32_32x32x16_bf16(PAF(3),VFR(7),o[1],0,0,0), C1,12); \
    }while(0)
  int t=1;
  #undef CMASK
  #define CMASK(P0,P1,t) do{}while(0)
  for(;t+5<NT;t+=2){
    STEP(pB0,pB1,pA0,pA1,t,true,true,true);     WAIT_BAR(2); RESC(); ROT();
    STEP(pA0,pA1,pB0,pB1,t+1,true,true,true);   WAIT_BAR(2); RESC(); ROT();
  }
  #undef CMASK
  #define CMASK(P0,P1,t) do{int jb_=(t)-(NT-4); if(jb_>=0)cmask(P0,P1,jb_,qrel,hi);}while(0)
  #define ENDW(tt) do{ if((tt)+3<NT){WAIT_BAR(2);} else if((tt)+2<NT){WAIT_BAR(1);} else {WAIT_BAR(0);} }while(0)
  for(;t+1<NT;t+=2){
    STEP(pB0,pB1,pA0,pA1,t,(t+3<NT),(t+1<NT),(t+1<NT));       ENDW(t);   RESC(); ROT();
    STEP(pA0,pA1,pB0,pB1,t+1,(t+4<NT),(t+2<NT),(t+2<NT));     ENDW(t+1); RESC(); ROT();
  }
  STEP(pB0,pB1,pA0,pA1,NT-1,false,false,false); RESC();
  { float sacc=pB0[0]+pB0[1]; _Pragma("unroll") for(int r=2;r<16;++r)sacc+=pB0[r]; _Pragma("unroll") for(int r=0;r<16;++r)sacc+=pB1[r]; l_reg+=sacc;
    pw0=(u32x4){PKW(pB0,0),PKW(pB0,2),PKW(pB0,4),PKW(pB0,6)};pw1=(u32x4){PKW(pB0,8),PKW(pB0,10),PKW(pB0,12),PKW(pB0,14)};pw2=(u32x4){PKW(pB1,0),PKW(pB1,2),PKW(pB1,4),PKW(pB1,6)};pw3=(u32x4){PKW(pB1,8),PKW(pB1,10),PKW(pB1,12),PKW(pB1,14)};
    SBAR(); pv(o,vb0+sl_cur,PAF(0),PAF(1),PAF(2),PAF(3)); }
  #undef PKW
  #undef PAF
  #undef VFR
  #undef PIN
  #undef MX3
  #undef GAPA
  #undef GAPB
  #undef EX
  #undef VRD
  #undef KRD
  #undef STEP
  #undef ENDW
  {auto rr=__builtin_amdgcn_permlane32_swap(__float_as_uint(l_reg),__float_as_uint(l_reg),false,false);l_reg=__uint_as_float(rr[0])+__uint_as_float(rr[1]);}
  if(hi==0)wsf[32+r32]=l_reg;asm volatile("s_waitcnt lgkmcnt(0)":::"memory");
  float rli[16];
  #pragma unroll
  for(int r=0;r<16;++r)rli[r]=__builtin_amdgcn_rcpf(wsf[32+crow(r,hi)]);
  bf16*Ow=O+(rowbase+q0+wid*QBLK)*OPITCH+h*D;
  { bf16*stg=(bf16*)(shm+LDS_OST)+wid*2048;
    #pragma unroll
    for(int r=0;r<16;++r){const int orow=crow(r,hi);
      #pragma unroll
      for(int d0=0;d0<2;++d0)stg[orow*64+d0*32+r32]=__float2bfloat16(o[d0][r]*rli[r]);}
    asm volatile("s_waitcnt lgkmcnt(0)":::"memory");
    #pragma unroll
    for(int i=0;i<4;++i){const int row=i*8+(lane>>3),ch=lane&7; const u32x4 v=*(const u32x4*)(stg+row*64+ch*8); ATTN_STORE16(Ow+(long)row*OPITCH+ch*8,v);} }
  asm volatile("s_waitcnt lgkmcnt(0)\n\ts_barrier":::"memory");
  #undef DMA_K
  #undef DMA_V
  #undef CMASK
  #undef START
  #undef RESC
  #undef ROT
}
constexpr int ATTN_LDS_BYTES=LDS_BYTES;
struct AttnTensors { const bf16* Q; const bf16* K; const bf16* V; bf16* O; const float* LF; const unsigned* NRM; };
struct AttnUnit { int bh; int qb; };
struct StaticOrder {
  int vcu,grid;
  __device__ __forceinline__ explicit StaticOrder(int grid_,int block):vcu((grid_%8==0)?(block%8)*(grid_/8)+block/8:block),grid(grid_){}
  __device__ __forceinline__ bool next(int i,AttnUnit&u)const{
    if(grid==256){ if(i>=4)return false; const int s=vcu&3; u.bh=vcu>>2; u.qb=(i==0)?s:(i==1)?7-s:(i==2)?8+s:15-s; return true; }
    const int L=i*grid+vcu; if(L>=BATCH*NHEAD*NQB)return false; u.bh=L/NQB; u.qb=L%NQB; return true; }
  __device__ __forceinline__ void a_ready(const AttnUnit&)const{}
  __device__ __forceinline__ void done(const AttnUnit&)const{}
};
template<class Sched,int THRL=8> __device__ __forceinline__ void attn_phase(char*lds,const AttnTensors&T,const Sched&S){
  AttnUnit u; int cur_bh=-1;
  for(int i=0;S.next(i,u);++i){ S.a_ready(u); if(u.bh!=cur_bh){ fox_bias_table(u.bh/NHEAD,u.bh%NHEAD,T.LF,lds); cur_bh=u.bh; }
    attn_unit<THRL>(u.bh/NHEAD,u.bh%NHEAD,u.qb,T.Q,T.K,T.V,T.O,T.LF,T.NRM,lds); S.done(u); }
}
template<int THRL=8> __device__ __forceinline__ void attn_phase_dyn(char*lds,const AttnTensors&T,unsigned*qhead,volatile int*slot){
  int cur_bh=-1; const int NU=BATCH*NHEAD*NQB;
  if(threadIdx.x==0) slot[0]=(int)__hip_atomic_fetch_add(qhead,1u,__ATOMIC_RELAXED,__HIP_MEMORY_SCOPE_AGENT);
  __syncthreads();
  int idx=__builtin_amdgcn_readfirstlane(slot[0]);
  while(idx<NU){
    __syncthreads();
    if(threadIdx.x==0) slot[0]=(int)__hip_atomic_fetch_add(qhead,1u,__ATOMIC_RELAXED,__HIP_MEMORY_SCOPE_AGENT);
    const int qb=NQB-1-idx/(BATCH*NHEAD), bh=idx%(BATCH*NHEAD);
    if(bh!=cur_bh){ fox_bias_table(bh/NHEAD,bh%NHEAD,T.LF,lds); cur_bh=bh; }
    attn_unit<THRL>(bh/NHEAD,bh%NHEAD,qb,T.Q,T.K,T.V,T.O,T.LF,T.NRM,lds);
    __syncthreads();
    idx=__builtin_amdgcn_readfirstlane(slot[0]);
  }
}
#undef SBAR
#undef WAIT_BAR
}
namespace fx {
using namespace nv;
typedef unsigned short bf16;
typedef unsigned v4u __attribute__((ext_vector_type(4)));
typedef float f32x4 __attribute__((ext_vector_type(4)));
constexpr float C2 = 0.125f * 1.4426950408889634f;
constexpr int NIN = 3328;
constexpr int QKVP = 3072;
constexpr int P_FQ = 0, P_FK = 512, P_FV = 1024, P_GQ = 1536, P_GK = 1792, P_GV = 2048, P_GR = 2560;
__device__ __forceinline__ int inproj_src(int d) {
    if (d < 1536) return d;
    if (d < 1792) return O_GQ + (d - 1536);
    if (d < 2048) return O_GK + (d - 1792);
    if (d < 2560) return O_GV + (d - 2048);
    if (d < 3072) return O_GR + (d - 2560);
    if (d < 3080) return O_FF + (d - 3072);
    if (d < 3096) return O_GA + (d - 3080);
    return -1;
}
__device__ __forceinline__ unsigned f2bf(float f) { unsigned u = __builtin_bit_cast(unsigned, f); return (u + 0x7fffu + ((u >> 16) & 1u)) >> 16; }
__device__ __forceinline__ unsigned pk2(float lo, float hi) { return f2bf(lo) | (f2bf(hi) << 16); }
__device__ __forceinline__ float bf2f(unsigned short h) { return __builtin_bit_cast(float, (unsigned)h << 16); }
__device__ __forceinline__ float wave_sum(float v) {
#pragma unroll
    for (int o = 1; o < 64; o <<= 1) v += __shfl_xor(v, o);
    return v;
}
#define FX_LDS_WAIT() asm volatile("s_waitcnt lgkmcnt(0)" ::: "memory")

template <class Map> __device__ __forceinline__ void transpose_item(const float* __restrict__ W, int K, int N, bf16* WT, LAS float* scr, int kb, int nb, int lane, Map srcmap) {
    const int k0 = 64 * kb, n0 = 32 * nb;
    const int src = srcmap(n0 + (lane & 31));
#pragma unroll 8
    for (int i = 0; i < 32; ++i) { const int kk = 2 * i + (lane >> 5); scr[kk * 33 + (lane & 31)] = (src >= 0) ? W[(size_t)(k0 + kk) * N + src] : 0.f; }
    FX_LDS_WAIT(); asm volatile("" ::: "memory");
    const int c = lane & 7;
#pragma unroll
    for (int j = 0; j < 4; ++j) { const int n = (lane >> 3) + 8 * j; const LAS float* s = scr + (8 * c) * 33 + n;
        v4u o; o.x = pk2(s[0 * 33], s[1 * 33]); o.y = pk2(s[2 * 33], s[3 * 33]); o.z = pk2(s[4 * 33], s[5 * 33]); o.w = pk2(s[6 * 33], s[7 * 33]);
        *(GAS v4u*)(WT + (size_t)(n0 + n) * K + k0 + 8 * c) = o; }
    FX_LDS_WAIT(); asm volatile("" ::: "memory");
}

__device__ __forceinline__ void ln_row_bf16(const float* xrow, const float* __restrict__ g, const float* __restrict__ b, bf16* orow, float* frow, float* st, int lane) {
    const GAS f32x4* xr = (const GAS f32x4*)xrow + lane;
    f32x4 v[4]; float s = 0.f;
#pragma unroll
    for (int j = 0; j < 4; ++j) { v[j] = xr[64 * j]; s += (v[j].x + v[j].y) + (v[j].z + v[j].w); }
    const float mean = wave_sum(s) * (1.f / D); float s2 = 0.f;
#pragma unroll
    for (int j = 0; j < 4; ++j) { v[j] = v[j] - mean; s2 += (v[j].x * v[j].x + v[j].y * v[j].y) + (v[j].z * v[j].z + v[j].w * v[j].w); }
    const float rstd = 1.f / sqrtf(wave_sum(s2) * (1.f / D) + LN_EPS);
    if (st && lane == 0) { st[0] = mean; st[1] = rstd; }
    GAS unsigned long long* o8 = (GAS unsigned long long*)orow + lane;
#pragma unroll
    for (int j = 0; j < 4; ++j) {
        const f32x4 gg = ((const f32x4*)g)[lane + 64 * j], bb = ((const f32x4*)b)[lane + 64 * j];
        const f32x4 o = v[j] * rstd * gg + bb;
        o8[64 * j] = (unsigned long long)pk2(o.x, o.y) | ((unsigned long long)pk2(o.z, o.w) << 32);
        if (frow) ((GAS f32x4*)frow)[lane + 64 * j] = o;
    }
}

struct CvItem { const float* W; bf16* WT; int N, K, k0, n0, s0; };
__device__ __forceinline__ void cv_load(const CvItem& it, f32x4 (&v)[8], int lane) {
    const float* p = it.W + (size_t)(it.k0 + (lane >> 3)) * it.N + it.s0 + 4 * (lane & 7);
#pragma unroll
    for (int i = 0; i < 8; ++i) v[i] = __builtin_nontemporal_load((const f32x4*)(p + (size_t)(8 * i) * it.N));
}
__device__ __forceinline__ void cv_finish(const CvItem& it, const f32x4 (&v)[8], LAS float* scr, int lane) {
    const int rr = lane >> 3, cq = lane & 7;
#pragma unroll
    for (int i = 0; i < 8; ++i) { LAS float* d = scr + (8 * i + rr) * 33 + 4 * cq; d[0] = v[i][0]; d[1] = v[i][1]; d[2] = v[i][2]; d[3] = v[i][3]; }
    FX_LDS_WAIT(); asm volatile("" ::: "memory");
    const int c = lane & 7;
#pragma unroll
    for (int j = 0; j < 4; ++j) { const int n = (lane >> 3) + 8 * j; const LAS float* s = scr + (8 * c) * 33 + n;
        v4u o; o.x = pk2(s[0 * 33], s[1 * 33]); o.y = pk2(s[2 * 33], s[3 * 33]); o.z = pk2(s[4 * 33], s[5 * 33]); o.w = pk2(s[6 * 33], s[7 * 33]);
        __builtin_nontemporal_store(o, (GAS v4u*)(it.WT + (size_t)(it.n0 + n) * it.K + it.k0 + 8 * c)); }
    FX_LDS_WAIT(); asm volatile("" ::: "memory");
}

template <int NR> __device__ __forceinline__ void ln_rows_bf16(const float* xrows, const float* __restrict__ g, const float* __restrict__ b, bf16* orows, int lane) {
    f32x4 v[NR][4];
#pragma unroll
    for (int r = 0; r < NR; ++r)
#pragma unroll
        for (int j = 0; j < 4; ++j) v[r][j] = ((const GAS f32x4*)(xrows + (size_t)r * D))[lane + 64 * j];
    f32x4 gg[4], bb[4];
#pragma unroll
    for (int j = 0; j < 4; ++j) { gg[j] = ((const f32x4*)g)[lane + 64 * j]; bb[j] = ((const f32x4*)b)[lane + 64 * j]; }
#pragma unroll
    for (int r = 0; r < NR; ++r) {
        float s = 0.f;
#pragma unroll
        for (int j = 0; j < 4; ++j) s += (v[r][j].x + v[r][j].y) + (v[r][j].z + v[r][j].w);
        const float mean = wave_sum(s) * (1.f / D); float s2 = 0.f;
#pragma unroll
        for (int j = 0; j < 4; ++j) { v[r][j] = v[r][j] - mean; s2 += (v[r][j].x * v[r][j].x + v[r][j].y * v[r][j].y) + (v[r][j].z * v[r][j].z + v[r][j].w * v[r][j].w); }
        const float rstd = 1.f / sqrtf(wave_sum(s2) * (1.f / D) + LN_EPS);
        GAS unsigned long long* o8 = (GAS unsigned long long*)(orows + (size_t)r * D) + lane;
#pragma unroll
        for (int j = 0; j < 4; ++j) { const f32x4 o = v[r][j] * rstd * gg[j] + bb[j];
            o8[64 * j] = (unsigned long long)pk2(o.x, o.y) | ((unsigned long long)pk2(o.z, o.w) << 32); }
    }
}

template <int NR> __device__ __forceinline__ void ln1_rows_bf16(const float* xrows, const float* st, const float* __restrict__ gi, const float* __restrict__ bi, const bf16* mixrows,
                                                               const float* __restrict__ g1, const float* __restrict__ b1, bf16* orows, float alpha, int lane) {
    f32x4 v[NR][4]; unsigned long long mx[NR][4]; float mean0[NR], rstd0[NR];
#pragma unroll
    for (int r = 0; r < NR; ++r) { mean0[r] = st[2 * r]; rstd0[r] = st[2 * r + 1];
#pragma unroll
        for (int j = 0; j < 4; ++j) { v[r][j] = ((const GAS f32x4*)(xrows + (size_t)r * D))[lane + 64 * j]; mx[r][j] = ((const GAS unsigned long long*)(mixrows + (size_t)r * D))[lane + 64 * j]; } }
    f32x4 gi4[4], bi4[4];
#pragma unroll
    for (int j = 0; j < 4; ++j) { gi4[j] = ((const f32x4*)gi)[lane + 64 * j] * alpha; bi4[j] = ((const f32x4*)bi)[lane + 64 * j] * alpha; }
#pragma unroll
    for (int r = 0; r < NR; ++r) {
        float s = 0.f;
#pragma unroll
        for (int j = 0; j < 4; ++j) { const unsigned lo = (unsigned)mx[r][j], hi = (unsigned)(mx[r][j] >> 32);
            f32x4 mv; mv.x = __builtin_bit_cast(float, lo << 16); mv.y = __builtin_bit_cast(float, lo & 0xffff0000u); mv.z = __builtin_bit_cast(float, hi << 16); mv.w = __builtin_bit_cast(float, hi & 0xffff0000u);
            v[r][j] = ((v[r][j] - mean0[r]) * rstd0[r]) * gi4[j] + bi4[j] + mv;
            s += (v[r][j].x + v[r][j].y) + (v[r][j].z + v[r][j].w); }
        const float mean = wave_sum(s) * (1.f / D); float s2 = 0.f;
#pragma unroll
        for (int j = 0; j < 4; ++j) { v[r][j] = v[r][j] - mean; s2 += (v[r][j].x * v[r][j].x + v[r][j].y * v[r][j].y) + (v[r][j].z * v[r][j].z + v[r][j].w * v[r][j].w); }
        const float rstd = 1.f / sqrtf(wave_sum(s2) * (1.f / D) + LN_EPS);
        GAS unsigned long long* o8 = (GAS unsigned long long*)(orows + (size_t)r * D) + lane;
#pragma unroll
        for (int j = 0; j < 4; ++j) { const f32x4 gg = ((const f32x4*)g1)[lane + 64 * j], bb = ((const f32x4*)b1)[lane + 64 * j]; const f32x4 o = v[r][j] * rstd * gg + bb;
            o8[64 * j] = (unsigned long long)pk2(o.x, o.y) | ((unsigned long long)pk2(o.z, o.w) << 32); }
    }
}
}

namespace pg8 {
struct EpiInProj {
    static constexpr bool PERM = true, AFTER_DRAIN = false;
    bf16_t* QKV; float* FG; float* LF; const float* bfg; unsigned* NRM;
    __device__ __forceinline__ void operator()(const f32x4 (&acc)[2][2][4][2], const Unit& u, int wr, int wc, int fr, int fq) const {
        const int row0 = u.pm * BM + wr * 64 + fr;
        if (u.pn < 12) {
            const float sc = (u.pn < 2) ? fx::C2 : 1.f;
            const int col0 = u.pn * BM + wc * 32 + 8 * fq;
            float nmax[2] = {0.f, 0.f};
#pragma unroll
            for (int ai = 0; ai < 2; ++ai)
#pragma unroll
                for (int m = 0; m < 4; ++m) { bf16_t* rowp = QKV + (size_t)(row0 + ai * HALF + m * 16) * fx::QKVP + col0;
#pragma unroll
                    for (int bj = 0; bj < 2; ++bj) { const f32x4 v0 = acc[ai][bj][m][0] * sc, v1 = acc[ai][bj][m][1] * sc;
                        u32x4 w; w.x = cvt_pk_bf16(v0[0], v0[1]); w.y = cvt_pk_bf16(v0[2], v0[3]); w.z = cvt_pk_bf16(v1[0], v1[1]); w.w = cvt_pk_bf16(v1[2], v1[3]);
                        *(u32x4*)(rowp + bj * HALF) = w;
                        if (u.pn < 4) { const f32x4 q0 = v0 * v0, q1 = v1 * v1; float s = (q0[0] + q0[1]) + (q0[2] + q0[3]) + (q1[0] + q1[1]) + (q1[2] + q1[3]);
                            s += __shfl_xor(s, 16); s += __shfl_xor(s, 32);
                            nmax[bj] = fmaxf(nmax[bj], s); } } }
            if (u.pn < 4) {
#pragma unroll
                for (int bj = 0; bj < 2; ++bj) { float s = nmax[bj];
#pragma unroll
                    for (int o = 1; o < 16; o <<= 1) s = fmaxf(s, __shfl_xor(s, o));
                    if (fr == 0 && fq == 0) { const int b = (u.pm * BM) >> 12, head = 4 * (u.pn & 1) + 2 * bj + (wc >> 1);
                        atomicMax(NRM + (b * 8 + head) * 4 + (u.pn >= 2 ? 2 : 0) + (wc & 1), __builtin_bit_cast(unsigned, s)); } }
            }
        } else if (wc == 0 && fq < 3) {
#pragma unroll
            for (int ai = 0; ai < 2; ++ai)
#pragma unroll
                for (int m = 0; m < 4; ++m) { const int row = row0 + ai * HALF + m * 16; float* p = FG + (size_t)row * 32 + 8 * fq;
                    *(f32x4*)p = acc[ai][0][m][0]; *(f32x4*)(p + 4) = acc[ai][0][m][1];
                    if (fq == 0) { const int b = row >> 12, s = row & 4095;
#pragma unroll
                        for (int n = 0; n < 2; ++n)
#pragma unroll
                            for (int i = 0; i < 4; ++i) { const int h = 4 * n + i; LF[(size_t)(b * 8 + h) * nv::S + s] = 1.4426950408889634f * nv::logsigmoidf(acc[ai][0][m][n][i] + bfg[h]); } } }
        }
    }
};
}
namespace gl {
using namespace nv;
typedef unsigned short bf16;
typedef short bf16x8 __attribute__((ext_vector_type(8)));
typedef float f32x4 __attribute__((ext_vector_type(4)));
typedef unsigned u32x4 __attribute__((ext_vector_type(4)));
typedef unsigned u32x2 __attribute__((ext_vector_type(2)));
constexpr int NCH = S / 64;
constexpr int NUNIT = B * GH * NCH;
constexpr int LS = 72;
constexpr int L_WGU = 0, L_BG = 4096, L_DECS = 4352, L_QP = 8192, L_KP = L_QP + 64 * LS * 2, L_KPT = L_KP + 64 * LS * 2, L_VT = L_KPT + 64 * LS * 2, L_PP = L_VT + 128 * LS * 2, L_WT = L_PP + 64 * LS * 2, L_END = L_WT + 2048;
static_assert(L_END <= 131072, "gla prep LDS");
constexpr int C_ST = 0, C_PART = 128 * LS * 2, C_END = C_PART + 2 * 8 * 64 * 4;
constexpr size_t QPG_B = 64 * 64 * 2, OI_B = 8 * 4 * 64 * 16, UU_B = OI_B, DEC_B = 256;

__device__ __forceinline__ unsigned pkbf(float lo, float hi) { typedef float f2 __attribute__((ext_vector_type(2))); typedef __bf16 b2 __attribute__((ext_vector_type(2))); f2 v = {lo, hi}; b2 r = __builtin_convertvector(v, b2); return __builtin_bit_cast(unsigned, r); }
__device__ __forceinline__ float bf2f(unsigned short h) { return __builtin_bit_cast(float, (unsigned)h << 16); }
__device__ __forceinline__ float bflo(unsigned w) { return __builtin_bit_cast(float, w << 16); }
__device__ __forceinline__ float bfhi(unsigned w) { return __builtin_bit_cast(float, w & 0xffff0000u); }
__device__ __forceinline__ float fast_logsig2(float x) { return -__builtin_amdgcn_logf(1.f + __builtin_amdgcn_exp2f(-1.4426950408889634f * x)); }

__device__ __forceinline__ void prep_unit(int unit, const bf16* QKV, const float* FG, const float* __restrict__ wgu, const float* __restrict__ bgate,
                                          unsigned char* QPG, unsigned char* OI, unsigned char* UU, float* DEC, unsigned char* lds, int& cur_h, f32x4 (&Sagg)[4], f32x4 (&Dagg)[4]) {
    int tid_ = threadIdx.x; asm volatile("" : "+v"(tid_));
    const int tid = tid_, lane = tid & 63, wid = __builtin_amdgcn_readfirstlane(tid >> 6), l15 = lane & 15, g = lane >> 4;
    const int n = unit % NCH, bh = unit / NCH, h = bh % GH, b = bh / GH;
    const size_t row0 = (size_t)b * S + (size_t)n * 64;
    float* WGU = (float*)(lds + L_WGU); float* BG = (float*)(lds + L_BG); float* WT = (float*)(lds + L_WT);
    bf16* QP = (bf16*)(lds + L_QP); bf16* KP = (bf16*)(lds + L_KP); bf16* KPT = (bf16*)(lds + L_KPT); bf16* VT = (bf16*)(lds + L_VT); bf16* PP = (bf16*)(lds + L_PP);
    if (cur_h != h) { __syncthreads(); for (int i = tid; i < 16 * 64; i += 512) WGU[i] = wgu[(i >> 6) * 256 + h * 64 + (i & 63)]; if (tid < 64) BG[tid] = bgate[h * 64 + tid]; cur_h = h; __syncthreads(); }
    const int t = tid >> 3, oc = tid & 7, d0 = oc * 8;
    float la[8];
    { const float* gp = FG + (row0 + t) * 32 + 8;
      f32x4 ga4[4];
#pragma unroll
      for (int i = 0; i < 4; ++i) ga4[i] = *(const f32x4*)(gp + 4 * i);
#pragma unroll
      for (int j = 0; j < 8; ++j) la[j] = BG[d0 + j];
#pragma unroll
      for (int r = 0; r < 16; ++r) { const float gv = ga4[r >> 2][r & 3]; const f32x4 w0 = *(const f32x4*)(WGU + r * 64 + d0), w1 = *(const f32x4*)(WGU + r * 64 + d0 + 4);
#pragma unroll
          for (int j = 0; j < 4; ++j) { la[j] += gv * w0[j]; la[4 + j] += gv * w1[j]; } }
#pragma unroll
      for (int j = 0; j < 8; ++j) la[j] = fast_logsig2(la[j]) * (1.f / 16.f); }
    const u32x4 qv = *(const u32x4*)(QKV + (row0 + t) * fx::QKVP + fx::P_GQ + h * 64 + d0);
    const u32x4 kv = *(const u32x4*)(QKV + (row0 + t) * fx::QKVP + fx::P_GK + h * 64 + d0);
    const u32x4 vv0 = *(const u32x4*)(QKV + (row0 + t) * fx::QKVP + fx::P_GV + h * 128 + oc * 16);
    const u32x4 vv1 = *(const u32x4*)(QKV + (row0 + t) * fx::QKVP + fx::P_GV + h * 128 + oc * 16 + 8);
#pragma unroll
    for (int off = 8; off < 64; off <<= 1) {
#pragma unroll
        for (int j = 0; j < 8; ++j) { const float o = __shfl_up(la[j], off); if (lane >= off) la[j] += o; } }
    if (lane >= 56) {
#pragma unroll
        for (int j = 0; j < 8; ++j) WT[wid * 64 + d0 + j] = la[j]; }
    __syncthreads();
    float bl[8];
#pragma unroll
    for (int j = 0; j < 8; ++j) bl[j] = 0.f;
#pragma unroll
    for (int w = 0; w < 8; ++w) {
        const f32x4 a0 = *(const f32x4*)(WT + w * 64 + d0), a1 = *(const f32x4*)(WT + w * 64 + d0 + 4);
#pragma unroll
        for (int j = 0; j < 4; ++j) { bl[j] += a0[j]; bl[4 + j] += a1[j]; if (w < wid) { la[j] += a0[j]; la[4 + j] += a1[j]; } } }
    {
        const unsigned qw[4] = {qv.x, qv.y, qv.z, qv.w}, kw[4] = {kv.x, kv.y, kv.z, kv.w};
        float qf[8], kf[8];
#pragma unroll
        for (int i = 0; i < 4; ++i) { qf[2 * i] = bflo(qw[i]); qf[2 * i + 1] = bfhi(qw[i]); kf[2 * i] = bflo(kw[i]); kf[2 * i + 1] = bfhi(kw[i]); }
        float qp[8], kp[8], kpp[8];
#pragma unroll
        for (int j = 0; j < 8; ++j) { const float bb = la[j], bbl = bl[j];
            qp[j] = qf[j] * (0.125f * __builtin_amdgcn_exp2f(bb)); kp[j] = kf[j] * __builtin_amdgcn_exp2f(-bb); kpp[j] = kf[j] * __builtin_amdgcn_exp2f(bbl - bb); }
        u32x4 qo, ko; qo.x = pkbf(qp[0], qp[1]); qo.y = pkbf(qp[2], qp[3]); qo.z = pkbf(qp[4], qp[5]); qo.w = pkbf(qp[6], qp[7]);
        ko.x = pkbf(kp[0], kp[1]); ko.y = pkbf(kp[2], kp[3]); ko.z = pkbf(kp[4], kp[5]); ko.w = pkbf(kp[6], kp[7]);
        *(u32x4*)(QP + t * LS + d0) = qo; *(u32x4*)(KP + t * LS + d0) = ko;
        *(u32x4*)(QPG + (size_t)unit * QPG_B + (size_t)(t * 64 + d0) * 2) = qo;
#pragma unroll
        for (int j = 0; j < 8; ++j) KPT[(d0 + j) * LS + t] = (bf16)(pkbf(kpp[j], 0.f) & 0xffffu);
        const unsigned vw[8] = {vv0.x, vv0.y, vv0.z, vv0.w, vv1.x, vv1.y, vv1.z, vv1.w};
#pragma unroll
        for (int i = 0; i < 8; ++i) { VT[(oc * 16 + 2 * i) * LS + t] = (bf16)(vw[i] & 0xffffu); VT[(oc * 16 + 2 * i + 1) * LS + t] = (bf16)(vw[i] >> 16); }
        if (t == 0) {
#pragma unroll
            for (int j = 0; j < 8; ++j) { const float dc = __builtin_amdgcn_exp2f(bl[j]); DEC[(size_t)unit * 64 + d0 + j] = dc; ((float*)(lds + L_DECS))[d0 + j] = dc; } }
    }
    __syncthreads();
    { const int ti = wid >> 1;
#pragma unroll
      for (int q2 = 0; q2 < 2; ++q2) { const int sj = 2 * (wid & 1) + q2;
          f32x4 acc = {0.f, 0.f, 0.f, 0.f};
          if (sj <= ti) {
#pragma unroll
              for (int ks = 0; ks < 2; ++ks) { const bf16x8 a = *(const bf16x8*)(QP + (16 * ti + l15) * LS + 32 * ks + 8 * g), bb = *(const bf16x8*)(KP + (16 * sj + l15) * LS + 32 * ks + 8 * g);
                  acc = __builtin_amdgcn_mfma_f32_16x16x32_bf16(a, bb, acc, 0, 0, 0); }
              if (sj == ti) {
#pragma unroll
                  for (int r = 0; r < 4; ++r) if (l15 > 4 * g + r) acc[r] = 0.f; }
          }
#pragma unroll
          for (int r = 0; r < 4; ++r) PP[(16 * ti + 4 * g + r) * LS + 16 * sj + l15] = (bf16)(pkbf(acc[r], 0.f) & 0xffffu);
      } }
    __syncthreads();
    { bf16x8 vb[2];
#pragma unroll
      for (int ks = 0; ks < 2; ++ks) vb[ks] = *(const bf16x8*)(VT + (16 * wid + l15) * LS + 32 * ks + 8 * g);
#pragma unroll
      for (int m = 0; m < 4; ++m) { f32x4 acc = {0.f, 0.f, 0.f, 0.f};
#pragma unroll
          for (int ks = 0; ks < 2; ++ks) { const bf16x8 a = *(const bf16x8*)(PP + (16 * m + l15) * LS + 32 * ks + 8 * g); acc = __builtin_amdgcn_mfma_f32_16x16x32_bf16(a, vb[ks], acc, 0, 0, 0); }
          *(f32x4*)(OI + (size_t)unit * OI_B + (size_t)((wid * 4 + m) * 64 + lane) * 16) = acc; }
#pragma unroll
      for (int db = 0; db < 4; ++db) { f32x4 acc = {0.f, 0.f, 0.f, 0.f};
#pragma unroll
          for (int ks = 0; ks < 2; ++ks) { const bf16x8 a = *(const bf16x8*)(KPT + (16 * db + l15) * LS + 32 * ks + 8 * g); acc = __builtin_amdgcn_mfma_f32_16x16x32_bf16(a, vb[ks], acc, 0, 0, 0); }
          *(f32x4*)(UU + (size_t)unit * UU_B + (size_t)((wid * 4 + db) * 64 + lane) * 16) = acc;
          const f32x4 dcv = *(const f32x4*)((const float*)(lds + L_DECS) + 16 * db + 4 * g);
          Sagg[db] = dcv * Sagg[db] + acc; Dagg[db] = Dagg[db] * dcv; }
    }
}


__device__ __forceinline__ void prep_block(int blk, const bf16* QKV, const float* FG, const float* __restrict__ wgu, const float* __restrict__ bgate,
                                           unsigned char* QPG, unsigned char* OI, unsigned char* UU, float* DEC, unsigned char* AGG, float* DAGG, unsigned char* lds, int& cur_h) {
    f32x4 Sagg[4], Dagg[4];
#pragma unroll
    for (int db = 0; db < 4; ++db) { Sagg[db] = (f32x4){0.f, 0.f, 0.f, 0.f}; Dagg[db] = (f32x4){1.f, 1.f, 1.f, 1.f}; }
    for (int i = 0; i < 8; ++i) prep_unit(blk * 8 + i, QKV, FG, wgu, bgate, QPG, OI, UU, DEC, lds, cur_h, Sagg, Dagg);
    int tid_ = threadIdx.x; asm volatile("" : "+v"(tid_));
    const int lane = tid_ & 63, wid = __builtin_amdgcn_readfirstlane(tid_ >> 6), l15 = lane & 15, g = lane >> 4;
#pragma unroll
    for (int db = 0; db < 4; ++db) { *(f32x4*)(AGG + (size_t)blk * UU_B + (size_t)((wid * 4 + db) * 64 + lane) * 16) = Sagg[db];
        if (wid == 0 && l15 == 0) *(f32x4*)(DAGG + (size_t)blk * 64 + 16 * db + 4 * g) = Dagg[db]; }
}
constexpr int GS = 136;
constexpr int PO_GR = 0, PO_YT = 64 * GS * 2, PO_PART = 2 * 64 * GS * 2, PO_ST = PO_PART + 8 * 64 * 4, PO_END = PO_ST + 128 * LS * 2;
__device__ __forceinline__ void post_block(int u0, int NB, const bf16* QKV, const unsigned char* QPG, const unsigned char* OI, const unsigned char* UU, const float* DEC, const unsigned char* AGG, const float* DAGG, const float* __restrict__ gnorm, bf16* Y, unsigned char* lds) {
    int tid_ = threadIdx.x; asm volatile("" : "+v"(tid_));
    const int tid = tid_, lane = tid & 63, wid = __builtin_amdgcn_readfirstlane(tid >> 6), l15 = lane & 15, g = lane >> 4;
    const int n0 = u0 % NCH, bh = u0 / NCH, h = bh % GH, b = bh / GH;
    bf16* GRs = (bf16*)(lds + PO_GR); bf16* YT = (bf16*)(lds + PO_YT); float* PART = (float*)(lds + PO_PART); bf16* ST = (bf16*)(lds + PO_ST);
    const int t = tid >> 3, oc = tid & 7, e = 16 * wid + l15;
    const float gn = gnorm[e];
    f32x4 Sa[4];
#pragma unroll
    for (int db = 0; db < 4; ++db) Sa[db] = (f32x4){0.f, 0.f, 0.f, 0.f};
    { const int seg0 = bh * (NCH / 8), nseg = n0 / 8;
      for (int i = 0; i < nseg; ++i) {
          f32x4 Ua[4], Da[4];
#pragma unroll
          for (int db = 0; db < 4; ++db) { Ua[db] = *(const f32x4*)(AGG + (size_t)(seg0 + i) * UU_B + (size_t)((wid * 4 + db) * 64 + lane) * 16); Da[db] = *(const f32x4*)(DAGG + (size_t)(seg0 + i) * 64 + 16 * db + 4 * g); }
#pragma unroll
          for (int db = 0; db < 4; ++db) Sa[db] = Da[db] * Sa[db] + Ua[db]; } }
    for (int i = 0; i < NB; ++i) {
        const int unit = u0 + i; const size_t row0 = (size_t)b * S + (size_t)(n0 + i) * 64;
        const u32x4 g0 = *(const u32x4*)(QKV + (row0 + t) * fx::QKVP + fx::P_GR + h * 128 + oc * 16), g1 = *(const u32x4*)(QKV + (row0 + t) * fx::QKVP + fx::P_GR + h * 128 + oc * 16 + 8);
        f32x4 o[4], Uf[4], dv[4]; bf16x8 qa[4][2], sb[2];
#pragma unroll
        for (int m = 0; m < 4; ++m) { o[m] = *(const f32x4*)(OI + (size_t)unit * OI_B + (size_t)((wid * 4 + m) * 64 + lane) * 16);
            Uf[m] = *(const f32x4*)(UU + (size_t)unit * UU_B + (size_t)((wid * 4 + m) * 64 + lane) * 16); dv[m] = *(const f32x4*)(DEC + (size_t)unit * 64 + 16 * m + 4 * g);
#pragma unroll
            for (int ks = 0; ks < 2; ++ks) qa[m][ks] = *(const bf16x8*)(QPG + (size_t)unit * QPG_B + (size_t)((16 * m + l15) * 64 + 32 * ks + 8 * g) * 2); }
#pragma unroll
        for (int db = 0; db < 4; ++db) *(u32x2*)(ST + e * LS + 16 * db + 4 * g) = (u32x2){pkbf(Sa[db][0], Sa[db][1]), pkbf(Sa[db][2], Sa[db][3])};
#pragma unroll
        for (int ks = 0; ks < 2; ++ks) sb[ks] = *(const bf16x8*)(ST + e * LS + 32 * ks + 8 * g);
        *(u32x4*)(GRs + t * GS + oc * 16) = g0; *(u32x4*)(GRs + t * GS + oc * 16 + 8) = g1;
#pragma unroll
        for (int m = 0; m < 4; ++m)
#pragma unroll
            for (int ks = 0; ks < 2; ++ks) o[m] = __builtin_amdgcn_mfma_f32_16x16x32_bf16(qa[m][ks], sb[ks], o[m], 0, 0, 0);
#pragma unroll
        for (int m = 0; m < 4; ++m) { f32x4 q = o[m] * o[m];
#pragma unroll
            for (int off = 1; off < 16; off <<= 1) { q[0] += __shfl_xor(q[0], off); q[1] += __shfl_xor(q[1], off); q[2] += __shfl_xor(q[2], off); q[3] += __shfl_xor(q[3], off); }
            if (l15 == 0) *(f32x4*)(PART + wid * 64 + 16 * m + 4 * g) = q; }
#pragma unroll
        for (int db = 0; db < 4; ++db) Sa[db] = dv[db] * Sa[db] + Uf[db];
        __syncthreads();
#pragma unroll
        for (int m = 0; m < 4; ++m) { f32x4 tot = {0.f, 0.f, 0.f, 0.f};
#pragma unroll
            for (int w = 0; w < 8; ++w) tot += *(const f32x4*)(PART + w * 64 + 16 * m + 4 * g);
#pragma unroll
            for (int r = 0; r < 4; ++r) { const int tt = 16 * m + 4 * g + r; const float rs = rsqrtf(tot[r] * (1.f / GV) + LN_EPS); const float gr = bf2f(GRs[tt * GS + e]);
                const float v = o[m][r] * rs * gn * (gr * __builtin_amdgcn_rcpf(1.f + __builtin_amdgcn_exp2f(-1.4426950408889634f * gr)));
                YT[tt * GS + e] = (bf16)(pkbf(v, 0.f) & 0xffffu); } }
        __syncthreads();
        { const u32x4 y0 = *(const u32x4*)(YT + t * GS + oc * 16), y1 = *(const u32x4*)(YT + t * GS + oc * 16 + 8);
          *(u32x4*)(Y + (row0 + t) * D + 512 + h * GV + oc * 16) = y0; *(u32x4*)(Y + (row0 + t) * D + 512 + h * GV + oc * 16 + 8) = y1; }
        __syncthreads();
    }
}
}
namespace mo {
using namespace nv;
typedef unsigned short bf16;
typedef float f32x4 __attribute__((ext_vector_type(4)));
typedef unsigned u32x4 __attribute__((ext_vector_type(4)));
constexpr int CAP = 8192;
constexpr int NEX = NE + 1;
constexpr int YSH = T * TOPK;
constexpr int L_TB = 132096, L_YB = L_TB + 1040, L_CN = L_YB + 1040, L_UT = 138240, L_RG = 141312;
typedef LAS int* lint;


constexpr int I_EG = NEX * 256, I_ED = NEX * 128, I_EXP = I_EG + I_ED;
struct ExpW { const float* eg; const float* eu; const float* ed; const float* sg; const float* su; const float* sd; bf16* WegT; bf16* WedT; };
__device__ __forceinline__ void cv_decode(int r, const ExpW& X, fx::CvItem& I) {
    if (r < I_EG) { const int e = r >> 8, kb = (r >> 4) & 15, nb = r & 15, c = nb >> 3, sub = nb & 7;
        I.W = (e < NE) ? ((sub < 4 ? X.eg : X.eu) + (size_t)e * D * ED) : (sub < 4 ? X.sg : X.su); I.WT = X.WegT + (size_t)e * 512 * D; I.N = ED; I.K = D; I.k0 = 64 * kb; I.n0 = 32 * nb; I.s0 = 128 * c + 32 * (sub & 3); }
    else { r -= I_EG; const int e = r >> 7, kb = (r >> 5) & 3, nb = r & 31; I.W = (e < NE) ? (X.ed + (size_t)e * ED * D) : X.sd; I.WT = X.WedT + (size_t)e * D * ED; I.N = D; I.K = ED; I.k0 = 64 * kb; I.n0 = 32 * nb; I.s0 = 32 * nb; }
}
__device__ __forceinline__ void expert_conv(const ExpW& X, LAS float* scr, int it0, int step, int lane) {
    int it = it0; fx::CvItem cur, nx; fx::f32x4 v[8], w[8];
    if (it < I_EXP) { cv_decode(it, X, cur); fx::cv_load(cur, v, lane); }
    while (it < I_EXP) { const int itn = it + step; if (itn < I_EXP) { cv_decode(itn, X, nx); fx::cv_load(nx, w, lane); }
        fx::cv_finish(cur, v, scr, lane); cur = nx;
#pragma unroll
        for (int i = 0; i < 8; ++i) v[i] = w[i];
        it = itn; }
}

__device__ __forceinline__ void moe_tables(const int* counts, lint tb, lint yb, lint cn, int lane) {
    int c[4], nt[4]; int st = 0, sy = 0, pt[4], py[4];
#pragma unroll
    for (int i = 0; i < 4; ++i) { c[i] = counts[lane * 4 + i]; c[i] = c[i] > CAP ? CAP : c[i]; nt[i] = (c[i] + 255) >> 8; pt[i] = st; py[i] = sy; st += nt[i]; sy += c[i]; }
    int it = st, iy = sy;
    for (int o = 1; o < 64; o <<= 1) { const int a = __shfl_up(it, o), b = __shfl_up(iy, o); if (lane >= o) { it += a; iy += b; } }
    const int bt = it - st, by = iy - sy;
#pragma unroll
    for (int i = 0; i < 4; ++i) { tb[lane * 4 + i] = bt + pt[i]; yb[lane * 4 + i] = by + py[i]; cn[lane * 4 + i] = c[i]; }
    if (lane == 63) { tb[256] = it; tb[257] = it + T / 256; yb[256] = YSH; cn[256] = T; }
}

__device__ __forceinline__ void route_token2(const float* LG, const float* __restrict__ rbias, int* lcnt, int* TK, float* TW, int t0, int lane) {
    const int l32 = lane & 31, hb = lane & 32, t = t0 + (lane >> 5);
    const float4 la = ((const float4*)(LG + (size_t)t * NE))[2 * l32], lb = ((const float4*)(LG + (size_t)t * NE))[2 * l32 + 1];
    const float4 ra = ((const float4*)rbias)[2 * l32], rb = ((const float4*)rbias)[2 * l32 + 1];
    const float lg[8] = {la.x, la.y, la.z, la.w, lb.x, lb.y, lb.z, lb.w}, rbv[8] = {ra.x, ra.y, ra.z, ra.w, rb.x, rb.y, rb.z, rb.w};
    float sc[8], bv[8];
#pragma unroll
    for (int i = 0; i < 8; ++i) { sc[i] = 1.f / (1.f + expf(-lg[i])); bv[i] = sc[i] + rbv[i]; }
    float m1 = fmaxf(bv[0], bv[1]), m2 = fminf(bv[0], bv[1]);
#pragma unroll
    for (int i = 2; i < 8; ++i) { const float n1 = fmaxf(m1, bv[i]); m2 = fmaxf(fminf(m1, bv[i]), m2); m1 = n1; }
#pragma unroll
    for (int o = 1; o < 4; o <<= 1) { const float p1 = __shfl_xor(m1, o), p2 = __shfl_xor(m2, o); const float n1 = fmaxf(m1, p1); m2 = fmaxf(fminf(m1, p1), fmaxf(m2, p2)); m1 = n1; }
    const float gs = m1 + m2;
    const int myg = l32 >> 2;
    int rank = 0;
#pragma unroll
    for (int g2 = 0; g2 < NG; ++g2) { const float og = __shfl(gs, hb + g2 * 4); if (og > gs || (og == gs && g2 < myg)) ++rank; }
    const bool sel = rank < 4;
    float mv[8];
#pragma unroll
    for (int i = 0; i < 8; ++i) mv[i] = sel ? bv[i] : -INFINITY;
    int mye = 0; float myw = 0.f; float wsum = 0.f;
#pragma unroll
    for (int k = 0; k < TOPK; ++k) {
        float bvv = mv[0]; int bi = 0;
#pragma unroll
        for (int i = 1; i < 8; ++i) if (mv[i] > bvv) { bvv = mv[i]; bi = i; }
        int gi = l32 * 8 + bi;
#pragma unroll
        for (int o = 16; o > 0; o >>= 1) { const float ov = __shfl_xor(bvv, o); const int oi = __shfl_xor(gi, o); if (ov > bvv || (ov == bvv && oi < gi)) { bvv = ov; gi = oi; } }
        const int ol = gi >> 3, oi = gi & 7;
        float s_own = sc[0];
#pragma unroll
        for (int i = 1; i < 8; ++i) s_own = (oi == i) ? sc[i] : s_own;
        const float sw = __shfl(s_own, hb + ol);
        if (l32 == ol) {
#pragma unroll
            for (int i = 0; i < 8; ++i) if (oi == i) mv[i] = -INFINITY; }
        if (l32 == k) { mye = gi; myw = sw; } wsum += sw;
    }
    if (l32 < TOPK) { const int lp = atomicAdd(&lcnt[mye], 1); TK[t * TOPK + l32] = mye | (lp << 9); TW[t * TOPK + l32] = myw * (2.5f / wsum); }
}
__device__ __forceinline__ void route_finish2(const int* lbase, int* list_tok, float* list_gate, int* TK, const float* TW, int t0, int lane) {
    const int l32 = lane & 31, t = t0 + (lane >> 5);
    if (l32 < TOPK) { const int tk = TK[t * TOPK + l32]; const int e = tk & 511, pos = lbase[e] + (tk >> 9);
        if (pos < CAP) { list_tok[e * CAP + pos] = t; list_gate[e * CAP + pos] = TW[t * TOPK + l32]; }
        TK[t * TOPK + l32] = e | (pos << 9); }
}

constexpr float YSC = 16.f;
__device__ __forceinline__ void combine_token(const bf16* H1, const unsigned char* Y, const int* TK, lint yb, const float* __restrict__ g, const float* __restrict__ b, float* out, int t, int lane) {
    typedef float f2 __attribute__((ext_vector_type(2)));
    float v[16], s[16];
    { const u32x4 a = *(const u32x4*)(H1 + (size_t)t * D + 16 * lane), c = *(const u32x4*)(H1 + (size_t)t * D + 16 * lane + 8);
      const unsigned w[8] = {a.x, a.y, a.z, a.w, c.x, c.y, c.z, c.w};
#pragma unroll
      for (int i = 0; i < 8; ++i) { v[2 * i] = ALPHA * __builtin_bit_cast(float, w[i] << 16); v[2 * i + 1] = ALPHA * __builtin_bit_cast(float, w[i] & 0xffff0000u); } }
#pragma unroll
    for (int i = 0; i < 16; ++i) s[i] = 0.f;
    int tk = (lane < TOPK) ? TK[t * TOPK + lane] : 0;
#pragma unroll
    for (int k = 0; k <= TOPK; ++k) {
        size_t yrow;
        if (k < TOPK) { const int x = __shfl(tk, k); yrow = (size_t)(yb[x & 511] + (x >> 9)); } else yrow = (size_t)YSH + t;
        const u32x4 a = *(const u32x4*)(Y + yrow * D + 16 * lane);
        const int w[4] = {(int)a.x, (int)a.y, (int)a.z, (int)a.w};
#pragma unroll
        for (int i = 0; i < 4; ++i) { const f2 lo = __builtin_amdgcn_cvt_pk_f32_fp8(w[i], false), hi = __builtin_amdgcn_cvt_pk_f32_fp8(w[i], true);
            s[4 * i] += lo[0]; s[4 * i + 1] += lo[1]; s[4 * i + 2] += hi[0]; s[4 * i + 3] += hi[1]; }
    }
    float sm = 0.f;
#pragma unroll
    for (int i = 0; i < 16; ++i) { v[i] += s[i] * (1.f / YSC); sm += v[i]; }
    const float mean = fx::wave_sum(sm) * (1.f / D); float q = 0.f;
#pragma unroll
    for (int i = 0; i < 16; ++i) { v[i] -= mean; q += v[i] * v[i]; }
    const float rstd = 1.f / sqrtf(fx::wave_sum(q) * (1.f / D) + LN_EPS);
#pragma unroll
    for (int i = 0; i < 4; ++i) { const f32x4 gg = *(const f32x4*)(g + 16 * lane + 4 * i), bb = *(const f32x4*)(b + 16 * lane + 4 * i);
        f32x4 o; o[0] = v[4 * i] * rstd * gg[0] + bb[0]; o[1] = v[4 * i + 1] * rstd * gg[1] + bb[1]; o[2] = v[4 * i + 2] * rstd * gg[2] + bb[2]; o[3] = v[4 * i + 3] * rstd * gg[3] + bb[3];
        *(f32x4*)(out + (size_t)t * D + 16 * lane + 4 * i) = o; }
}
}

namespace pg8 {
struct RouterSched {
    int rb; const bf16_t* Bt;
    __device__ __forceinline__ bool next(int i, Unit2& u) const { if (i > 0) return false; u.pm = rb; u.pn = 0; u.e = 0; u.cnt = 128; u.jt = 0; u.ui = 0; return true; }
    __device__ __forceinline__ int arow(const Unit2& u, int r) const { return u.pm * 128 + r; }
    __device__ __forceinline__ size_t aoff(const Unit2&) const { return 0; }
    __device__ __forceinline__ const char* bptr(const Unit2&) const { return (const char*)Bt; }
};
struct EpiLogits {
    static constexpr bool PERM = false, AFTER_DRAIN = false;
    float* LG;
    __device__ __forceinline__ void operator()(const f32x4 (&acc)[2][2][4][2], const Unit2& u, int wr, int wc, int fr, int fq) const {
        const int row0 = u.pm * 128 + wr * 64 + fr, col0 = wc * 32 + 4 * fq;
#pragma unroll
        for (int m = 0; m < 4; ++m) { float* rowp = LG + (size_t)(row0 + m * 16) * nv::NE + col0;
#pragma unroll
            for (int bj = 0; bj < 2; ++bj)
#pragma unroll
                for (int n = 0; n < 2; ++n) *(f32x4*)(rowp + bj * HALF + n * 16) = acc[0][bj][m][n]; }
    }
};
template <int PH> struct MoeSched {
    int G, vcu, nrt; mo::lint tb; mo::lint cn; const int* list_tok; const bf16_t* W; mo::lint ut; mo::lint rg;
    static constexpr int NC = PH == 0 ? 2 : 4;
    static constexpr int MAXU = 64;
    __device__ __forceinline__ void build(int lane) const {
        const int L = lane * G + vcu;
        if (lane < MAXU && L < nrt * NC) {
            const int rt = L / NC, c = L % NC;
            int lo = 0, hi = 256;
            while (lo < hi) { const int mid = (lo + hi + 1) >> 1; if (tb[mid] <= rt) lo = mid; else hi = mid - 1; }
            const int e = lo, jt = rt - tb[e], rem = cn[e] - 256 * jt;
            ut[4 * lane] = rt; ut[4 * lane + 1] = c; ut[4 * lane + 2] = e | (jt << 9); ut[4 * lane + 3] = rem < 256 ? rem : 256;
        }
    }
    __device__ __forceinline__ bool next(int i, Unit2& u) const {
        const int L = i * G + vcu; if (i >= MAXU || L >= nrt * NC) return false;
        const int x = ut[4 * i + 2];
        u.pm = __builtin_amdgcn_readfirstlane(ut[4 * i]); u.pn = __builtin_amdgcn_readfirstlane(ut[4 * i + 1]); u.e = __builtin_amdgcn_readfirstlane(x & 511); u.jt = __builtin_amdgcn_readfirstlane(x >> 9);
        u.cnt = __builtin_amdgcn_readfirstlane(ut[4 * i + 3]); u.ui = i; return true;
    }
    __device__ __forceinline__ void fill_rows(const float* list_gate, int tid) const {
        for (int i = 0; i < MAXU; ++i) { const int L = i * G + vcu; if (L >= nrt * NC) break;
            const int x = ut[4 * i + 2], e = x & 511, jt = x >> 9, cnt = ut[4 * i + 3];
            if (tid < 256) { const int r = tid; unsigned v;
                if (e == 256) v = (unsigned)(jt * BM + r) | (0x4180u << 16);
                else if (r < cnt) { const float gsc = mo::YSC * list_gate[e * mo::CAP + jt * BM + r]; v = (unsigned)list_tok[e * mo::CAP + jt * BM + r] | (fx::f2bf(gsc) << 16); }
                else v = 0u;
                rg[i * 256 + r] = (int)v; } }
    }
    __device__ __forceinline__ int arow(const Unit2& u, int r) const {
        if (PH == 1) return u.pm * BM + r;
        return rg[u.ui * 256 + r] & 0x7fff;
    }
    __device__ __forceinline__ size_t aoff(const Unit2& u) const { return PH == 1 ? (size_t)u.pm * (131072 - 32768) : 0; }
    __device__ __forceinline__ const char* bptr(const Unit2& u) const {
        return PH == 0 ? (const char*)(W + ((size_t)u.e * 512 + 256 * u.pn) * 1024) : (const char*)(W + ((size_t)u.e * 1024 + 256 * u.pn) * 256);
    }
};
struct EpiSwiGLU {
    static constexpr bool PERM = true, AFTER_DRAIN = false;
    bf16_t* H; mo::lint rg; int skip;
    __device__ __forceinline__ void operator()(const f32x4 (&acc)[2][2][4][2], const Unit2& u, int wr, int wc, int fr, int fq) const {
        if (skip) return;
        const int col0 = u.pn * 128 + wc * 32 + 8 * fq;
#pragma unroll
        for (int ai = 0; ai < 2; ++ai)
#pragma unroll
            for (int m = 0; m < 4; ++m) { const int r = ai * HALF + wr * 64 + m * 16 + fr;
                const float gt = __builtin_bit_cast(float, (unsigned)rg[u.ui * 256 + r] & 0xffff0000u);
                float hv[8];
#pragma unroll
                for (int n = 0; n < 2; ++n)
#pragma unroll
                    for (int i = 0; i < 4; ++i) { const float gg = acc[ai][0][m][n][i], uu = acc[ai][1][m][n][i]; hv[4 * n + i] = gt * uu * (gg * __builtin_amdgcn_rcpf(1.f + __builtin_amdgcn_exp2f(-1.4426950408889634f * gg))); }
                u32x4 w; w.x = cvt_pk_bf16(hv[0], hv[1]); w.y = cvt_pk_bf16(hv[2], hv[3]); w.z = cvt_pk_bf16(hv[4], hv[5]); w.w = cvt_pk_bf16(hv[6], hv[7]);
                *(u32x4*)(H + (size_t)u.pm * 65536 + (size_t)(col0 >> 6) * 16384 + r * 64 + (col0 & 63)) = w; }
    }
};
struct EpiDown {
    static constexpr bool PERM = true, AFTER_DRAIN = false;
    unsigned char* Y; mo::lint yb; int skip;
    __device__ __forceinline__ void operator()(const f32x4 (&acc)[2][2][4][2], const Unit2& u, int wr, int wc, int fr, int fq) const {
        if (skip) return;
        typedef unsigned u32x2v __attribute__((ext_vector_type(2)));
        const int col0 = u.pn * BM + wc * 32 + 8 * fq; const int ybase = yb[u.e] + u.jt * BM;
#pragma unroll
        for (int ai = 0; ai < 2; ++ai)
#pragma unroll
            for (int m = 0; m < 4; ++m) { const int r = ai * HALF + wr * 64 + m * 16 + fr;
                if (r < u.cnt) { unsigned char* rowp = Y + (size_t)(ybase + r) * nv::D + col0;
#pragma unroll
                    for (int bj = 0; bj < 2; ++bj) { const f32x4 v0 = acc[ai][bj][m][0], v1 = acc[ai][bj][m][1];
                        int w0 = __builtin_amdgcn_cvt_pk_fp8_f32(v0[0], v0[1], 0, false); w0 = __builtin_amdgcn_cvt_pk_fp8_f32(v0[2], v0[3], w0, true);
                        int w1 = __builtin_amdgcn_cvt_pk_fp8_f32(v1[0], v1[1], 0, false); w1 = __builtin_amdgcn_cvt_pk_fp8_f32(v1[2], v1[3], w1, true);
                        *(u32x2v*)(rowp + bj * HALF) = (u32x2v){(unsigned)w0, (unsigned)w1}; } } }
    }
};
}
constexpr int NTHR = 512;
constexpr int LDS_BYTES = 163840;
constexpr int MISC_OFF = 131072 + 320;
constexpr size_t MiB = 1u << 20;
constexpr size_t CTL_ZERO_BYTES = 96 * 1024;
constexpr int CW_BAR = 4096;
constexpr int CW_MOE = 16384;
constexpr int CW_FOXQ = 20992;
constexpr int CW_NRM = 20480;
constexpr int NPHASE = 9;
constexpr size_t WS_H1 = 1, WS_WR = 65, WS_STATS = 66, WS_LF = 67, WS_FG = 68, WS_WO = 72, WS_WIN = 74, WS_TK = 81, WS_LTOK = 83, WS_LGATE = 91,
                 WS_WED = 100, WS_HID = 230, WS_GLA = 230, WS_WEG = 416, WS_XN = 673, WS_YBF = 673, WS_QKV = 737, WS_Z1 = 737, WS_LG = 865, WS_Y = 416, WS_END = 992;

struct Args { const float* in[21]; float* out; unsigned char* ws; int ph_lo, ph_hi, li, pad; };

__global__ void __launch_bounds__(NTHR, 2) mega_fwd(Args a) {
    using namespace nv;
    extern __shared__ __attribute__((aligned(16))) unsigned char lds[];
    const int G = gridDim.x, bx = blockIdx.x;
    const int vcu = (G % 8 == 0) ? (bx % 8) * (G / 8) + bx / 8 : bx;
    int tid, lane, wave, vw;
#define DERIVE() do { int t_ = threadIdx.x; asm volatile("" : "+v"(t_)); tid = t_; lane = tid & 63; wave = __builtin_amdgcn_readfirstlane(tid >> 6); vw = vcu * 8 + wave; } while (0)
    DERIVE();
    volatile LAS unsigned* MISC = (volatile LAS unsigned*)((LAS unsigned char*)lds + MISC_OFF);
    for (int u = tid; u < (LDS_BYTES - 131072) / 4; u += NTHR) ((LAS unsigned*)((LAS unsigned char*)lds + 131072))[u] = 0u;
    __syncthreads();
    unsigned char* ws = a.ws;
    unsigned* ctl = (unsigned*)ws;
    XcdBarrier bar = xcd_barrier_post(ctl + CW_BAR + a.li * XCD_BAR_WORDS, MISC + 8);
    const float* x = a.in[0];
    const float* ln_in_g = a.in[1]; const float* ln_in_b = a.in[2];
    const float* w_in = a.in[3]; const float* b_fgate = a.in[4];
    const float* w_gate_up = a.in[5]; const float* b_gate = a.in[6]; const float* g_gla = a.in[7];
    const float* w_out = a.in[8]; const float* ln1_g = a.in[9]; const float* ln1_b = a.in[10];
    const float* w_router = a.in[11]; const float* rbias = a.in[12];
    const float* w_eg = a.in[13]; const float* w_eu = a.in[14]; const float* w_ed = a.in[15];
    const float* w_sg = a.in[16]; const float* w_su = a.in[17]; const float* w_sd = a.in[18];
    const float* ln2_g = a.in[19]; const float* ln2_b = a.in[20];
    float* out = a.out;
    int* counts = (int*)(ctl + CW_MOE);
    fx::bf16* H1 = (fx::bf16*)(ws + WS_H1 * MiB);
    fx::bf16* WrT = (fx::bf16*)(ws + WS_WR * MiB);
    float* stats = (float*)(ws + WS_STATS * MiB);
    float* LF = (float*)(ws + WS_LF * MiB);
    float* FG = (float*)(ws + WS_FG * MiB);
    fx::bf16* WoT = (fx::bf16*)(ws + WS_WO * MiB);
    fx::bf16* WinT = (fx::bf16*)(ws + WS_WIN * MiB);
    int* TK = (int*)(ws + WS_TK * MiB);
    float* TW = (float*)(ws + (WS_TK + 1) * MiB);
    int* list_tok = (int*)(ws + WS_LTOK * MiB);
    float* list_gate = (float*)(ws + WS_LGATE * MiB);
    fx::bf16* WedT = (fx::bf16*)(ws + WS_WED * MiB);
    fx::bf16* HID = (fx::bf16*)(ws + WS_HID * MiB);
    unsigned char* QPG = ws + WS_GLA * MiB; unsigned char* OIb = ws + (WS_GLA + 16) * MiB; unsigned char* UUb = ws + (WS_GLA + 80) * MiB; float* DECb = (float*)(ws + (WS_GLA + 144) * MiB); unsigned char* AGGb = ws + (WS_GLA + 145) * MiB; float* DAGGb = (float*)(ws + (WS_GLA + 153) * MiB);
    fx::bf16* WegT = (fx::bf16*)(ws + WS_WEG * MiB);
    fx::bf16* XN = (fx::bf16*)(ws + WS_XN * MiB);
    fx::bf16* Ybf = (fx::bf16*)(ws + WS_YBF * MiB);
    fx::bf16* QKV = (fx::bf16*)(ws + WS_QKV * MiB);
    fx::bf16* MIX = (fx::bf16*)(ws + WS_Z1 * MiB);
    float* LG = (float*)(ws + WS_LG * MiB);
    unsigned char* YA = ws + WS_Y * MiB;
    mo::lint tb = (mo::lint)((LAS unsigned char*)lds + mo::L_TB), yb = (mo::lint)((LAS unsigned char*)lds + mo::L_YB), cn = (mo::lint)((LAS unsigned char*)lds + mo::L_CN), ut = (mo::lint)((LAS unsigned char*)lds + mo::L_UT), rg = (mo::lint)((LAS unsigned char*)lds + mo::L_RG);

    const int lo = a.ph_lo, hi = a.ph_hi;
#define IN(k) (lo <= (k) && (k) < hi)
#define SEAM(k) do { if (IN(k) && IN((k) + 1)) xcd_barrier(bar); DERIVE(); } while (0)
    const int GW = G * 8;
#ifndef STG7
#define STG7 0
#endif
#ifndef STG8
#define STG8 0
#endif
#define STAGGER(q) do { if ((q) > 0) { const unsigned long long t0_ = __builtin_amdgcn_s_memrealtime(); const unsigned long long d_ = (unsigned long long)((vcu & 3) * (q)); while (__builtin_amdgcn_s_memrealtime() - t0_ < d_) __builtin_amdgcn_s_sleep(8); } } while (0)

    if (IN(0)) {
        LAS float* scr = (LAS float*)((LAS unsigned char*)lds + wave * 16384);
        constexpr int I_IN = 16 * (fx::NIN / 32), I_OUT = 16 * 32, I_R = 16 * 8, I_SMALL = I_IN + I_OUT + I_R;
        for (int it = vw; it < I_SMALL; it += GW) {
            int r = it;
            if (r < I_IN) { fx::transpose_item(w_in, D, INW, WinT, scr, r / (fx::NIN / 32), r % (fx::NIN / 32), lane, [](int d) { return fx::inproj_src(d); }); continue; } r -= I_IN;
            if (r < I_OUT) { fx::transpose_item(w_out, D, D, WoT, scr, r / 32, r % 32, lane, [](int d) { return d; }); continue; } r -= I_OUT;
            fx::transpose_item(w_router, D, NE, WrT, scr, r / 8, r % 8, lane, [](int d) { return d; });
        }
        for (int r = vw; r < T; r += GW) fx::ln_row_bf16(x + (size_t)r * D, ln_in_g, ln_in_b, XN + (size_t)r * D, nullptr, stats + 2 * (size_t)r, lane);
    }
    SEAM(0);
    if (IN(1)) {
        const mo::ExpW XW{w_eg, w_eu, w_ed, w_sg, w_su, w_sd, WegT, WedT};
#ifndef MIXG
#define MIXG 2
#endif
        { const int slot = vcu % MIXG; pg8::StaticOrder S; S.init(T, fx::NIN, G, bx);
          const int nun = (S.nwg - bx + G - 1) / G, nb = (MIXG > 1) ? nun * slot / (MIXG - 1) : nun;
          pg8::Gemm g{XN, WinT, T, fx::NIN, D, D}; pg8::EpiInProj E{QKV, FG, LF, b_fgate, ctl + CW_NRM};
          if (nb > 0) { pg8::RangeOrder R{S, 0, nb}; pg8::gemm_phase<pg8::EpiInProj, pg8::RangeOrder, true, true>((LAS unsigned char*)lds, g, R, E); DERIVE(); }
          mo::expert_conv(XW, (LAS float*)((LAS unsigned char*)lds + wave * 16384), vw, GW, lane); __syncthreads(); DERIVE();
          if (nb < nun) { pg8::RangeOrder R{S, nb, nun - nb}; pg8::gemm_phase<pg8::EpiInProj, pg8::RangeOrder, true, true>((LAS unsigned char*)lds, g, R, E); } }
    }
    SEAM(1);
    if (IN(2)) {
        int cur_h = -1;
        for (int blk = vcu; blk < gl::NUNIT / 8; blk += G) gl::prep_block(blk, QKV, FG, w_gate_up, b_gate, QPG, OIb, UUb, DECb, AGGb, DAGGb, lds, cur_h);
    }
    SEAM(2);
    if (IN(3)) {
        for (int blk = vcu; blk < gl::NUNIT / 8; blk += G) gl::post_block(blk * 8, 8, QKV, QPG, OIb, UUb, DECb, AGGb, DAGGb, g_gla, Ybf, lds);
        { const attn_body::AttnTensors AT{(const attn_body::bf16*)(QKV + fx::P_FQ), (const attn_body::bf16*)(QKV + fx::P_FK), (const attn_body::bf16*)(QKV + fx::P_FV), (attn_body::bf16*)Ybf, LF, ctl + CW_NRM};
          attn_body::attn_phase_dyn<8>((char*)lds, AT, ctl + CW_FOXQ, (volatile int*)(lds + 140288)); }
    }
    SEAM(3);
    if (IN(4)) {
        pg8::DenseSched DS; DS.so.init(T, D, G, bx); DS.Bt = WoT; DS.ldb = D;
        pg8::EpiPlainBf16 E{MIX, D};
        pg8::gemm_phase2<pg8::EpiPlainBf16, pg8::DenseSched>((LAS unsigned char*)lds, Ybf, D, D, D, DS, E);
    }
    SEAM(4);
    if (IN(5)) {
        int* lcnt = (int*)(lds + 136192); int* lbase = lcnt + 256;
        for (int rb = vcu; rb < T / 128; rb += G) {
            if (tid < 256) lcnt[tid] = 0;
            for (int r = wave * 16; r < wave * 16 + 16; r += 4) { const size_t row = (size_t)rb * 128 + r;
                fx::ln1_rows_bf16<4>(x + row * D, stats + 2 * row, ln_in_g, ln_in_b, MIX + row * D, ln1_g, ln1_b, H1 + row * D, ALPHA, lane); }
            asm volatile("s_waitcnt vmcnt(0)" ::: "memory"); __syncthreads();
            { pg8::RouterSched RS{rb, WrT}; pg8::EpiLogits E{LG};
              pg8::gemm_phase2<pg8::EpiLogits, pg8::RouterSched>((LAS unsigned char*)lds, H1, D, D, D, RS, E); }
            DERIVE();
            for (int t = rb * 128 + wave * 2; t < rb * 128 + 128; t += 16) mo::route_token2(LG, rbias, lcnt, TK, TW, t, lane);
            __syncthreads();
            if (tid < 256) { const int c = lcnt[tid]; lbase[tid] = c ? atomicAdd(&counts[tid], c) : 0; }
            __syncthreads();
            for (int t = rb * 128 + wave * 2; t < rb * 128 + 128; t += 16) mo::route_finish2(lbase, list_tok, list_gate, TK, TW, t, lane);
            __syncthreads();
        }
    }
    SEAM(5);
    if (IN(6)) {
        if (wave == 0) mo::moe_tables(counts, tb, yb, cn, lane);
        __syncthreads();
        STAGGER(STG7);
        pg8::MoeSched<0> MS{G, vcu, tb[257], tb, cn, list_tok, WegT, ut, rg}; if (wave == 0) MS.build(lane); __syncthreads(); MS.fill_rows(list_gate, tid); __syncthreads(); pg8::EpiSwiGLU E{HID, rg, a.pad};
        pg8::gemm_phase2<pg8::EpiSwiGLU, pg8::MoeSched<0>>((LAS unsigned char*)lds, H1, D, D, D, MS, E);
    }
    SEAM(6);
    if (IN(7)) {
        if (wave == 0) mo::moe_tables(counts, tb, yb, cn, lane);
        __syncthreads();
        STAGGER(STG8);
        pg8::MoeSched<1> MS{G, vcu, tb[257], tb, cn, list_tok, WedT, ut, rg}; if (wave == 0) MS.build(lane); __syncthreads(); pg8::EpiDown E{YA, yb, a.pad};
        pg8::gemm_phase2<pg8::EpiDown, pg8::MoeSched<1>>((LAS unsigned char*)lds, HID, 64, ED, ED, MS, E, 32768);
    }
    SEAM(7);
    if (IN(8)) {
        if (wave == 0) mo::moe_tables(counts, tb, yb, cn, lane);
        __syncthreads();
        for (int t = vw; t < T; t += GW) mo::combine_token(H1, YA, TK, yb, ln2_g, ln2_b, out, t, lane);
    }
#undef IN
#undef SEAM
}

extern "C" void kernel_launch(void* const* d_in, const int* in_sizes, int n_in, void* d_out, int out_size, void* d_ws, size_t ws_size, hipStream_t stream) {
    static int grid = 0;
    if (grid == 0) {
        if (n_in != 21 || out_size != nv::T * nv::D || ws_size < WS_END * MiB) { fprintf(stderr, "kernel_launch: unexpected shapes n_in=%d out=%d ws=%zu\n", n_in, out_size, ws_size); grid = -1; return; }
        int dev = 0, cus = 0;
        if (hipGetDevice(&dev) != hipSuccess || hipDeviceGetAttribute(&cus, hipDeviceAttributeMultiprocessorCount, dev) != hipSuccess) { grid = -1; return; }
        if (hipFuncSetAttribute((const void*)mega_fwd, hipFuncAttributeMaxDynamicSharedMemorySize, LDS_BYTES) != hipSuccess) { fprintf(stderr, "kernel_launch: hipFuncSetAttribute failed\n"); grid = -1; return; }
        grid = cus;
    }
    if (grid < 0) return;
    if (hipMemsetAsync(d_ws, 0, CTL_ZERO_BYTES, stream) != hipSuccess) return;
    Args a{};
    for (int i = 0; i < 21; ++i) a.in[i] = (const float*)d_in[i];
    a.out = (float*)d_out; a.ws = (unsigned char*)d_ws; a.ph_lo = 0; a.ph_hi = NPHASE; a.li = 0;
#ifdef REPEAT_PH
    a.ph_hi = REPEAT_PH + 1; hipLaunchKernelGGL(mega_fwd, dim3(grid), dim3(NTHR), LDS_BYTES, stream, a);
    if (REPEAT_PH == 3) hipMemsetAsync((char*)d_ws + CW_FOXQ * 4, 0, 256, stream);
    if (REPEAT_PH == 5) hipMemsetAsync((char*)d_ws + CW_MOE * 4, 0, 4096, stream);
    a.ph_lo = REPEAT_PH; a.ph_hi = NPHASE; a.li = 1;
#ifdef REPEAT_NOEPI
    a.ph_hi = REPEAT_PH + 1; a.pad = 1; hipLaunchKernelGGL(mega_fwd, dim3(grid), dim3(NTHR), LDS_BYTES, stream, a); a.pad = 0; a.ph_lo = REPEAT_PH + 1; a.ph_hi = NPHASE; a.li = 2;
#endif
#endif
    hipLaunchKernelGGL(mega_fwd, dim3(grid), dim3(NTHR), LDS_BYTES, stream, a);
}
```

```cpp
#include <hip/hip_runtime.h>
#include <cstdio>
#include <cstdint>
#include <cmath>

#define LAS __attribute__((address_space(3)))
#define GAS __attribute__((address_space(1)))

#define XB_TMO      128
#define XB_XCNT(j)  (256  + 64 * (j))
#define XB_XSUB(j)  (1280 + 64 * (j))
#define XB_XGEN(j)  (2304 + 64 * (j))
#define XB_TOP      3328
#define XB_TOPGEN   3392
#define XCD_BAR_WORDS 3456
#define XB_SPIN_CAP (1u << 27)
__device__ __forceinline__ unsigned xb_ld(unsigned* p)              { return __hip_atomic_load(p, __ATOMIC_RELAXED, __HIP_MEMORY_SCOPE_AGENT); }
__device__ __forceinline__ unsigned xb_add(unsigned* p, unsigned v) { return __hip_atomic_fetch_add(p, v, __ATOMIC_RELAXED, __HIP_MEMORY_SCOPE_AGENT); }
__device__ __forceinline__ unsigned xb_xcc_id() { return (unsigned)__builtin_amdgcn_s_getreg((3 << 11) | 20) & 0xFu; }
#define XB_SPIN(cond, bar) do { unsigned _sp = 0; while (cond) { __builtin_amdgcn_s_sleep(1); \
    if ((++_sp & 255u) == 0u) { if (xb_ld(&(bar)[XB_TMO])) break; if (_sp > XB_SPIN_CAP) { atomicAdd(&(bar)[XB_TMO], 1u); break; } } } } while (0)
struct XcdBarrier { unsigned* bar; unsigned x; volatile LAS unsigned* st; };
__device__ __forceinline__ XcdBarrier xcd_barrier_post(unsigned* bar, volatile LAS unsigned* st) {
    XcdBarrier b; b.bar = bar; b.x = xb_xcc_id(); b.st = st;
    if (threadIdx.x == 0) (void)xb_add(&bar[XB_XCNT(b.x)], 1u);
    return b;
}
__device__ __forceinline__ void xcd_barrier_complete(unsigned* bar, unsigned x, unsigned& nloc, unsigned& nx) {
    const unsigned G = gridDim.x * gridDim.y * gridDim.z;
    unsigned sum, cnt, mine, sp = 0u;
    for (;;) {
        sum = 0u; cnt = 0u; mine = 0u;
#pragma unroll
        for (unsigned j = 0; j < 16; ++j) { const unsigned c = xb_ld(&bar[XB_XCNT(j)]); sum += c; cnt += (c > 0u) ? 1u : 0u; mine = (j == x) ? c : mine; }
        if (sum == G) break;
        __builtin_amdgcn_s_sleep(1);
        if ((++sp & 255u) == 0u) { if (xb_ld(&bar[XB_TMO])) break; if (sp > XB_SPIN_CAP) { atomicAdd(&bar[XB_TMO], 1u); break; } }
    }
    nloc = mine > 0u ? mine : 1u; nx = cnt > 0u ? cnt : 1u;
}
__device__ __forceinline__ void xcd_barrier(const XcdBarrier& b) {
    asm volatile("s_waitcnt vmcnt(0)" ::: "memory");
    __syncthreads();
    if (threadIdx.x == 0) {
        unsigned* bar = b.bar;
        __builtin_amdgcn_s_waitcnt(0);
        unsigned nloc = b.st[0], nx = b.st[1];
        if (nloc == 0u) { xcd_barrier_complete(bar, b.x, nloc, nx); b.st[0] = nloc; b.st[1] = nx; }
        const unsigned old = xb_add(&bar[XB_XSUB(b.x)], 1u);
        const unsigned gen = old / nloc;
        if (old + 1u == (gen + 1u) * nloc) {
            __builtin_amdgcn_fence(__ATOMIC_RELEASE, "agent");
            asm volatile("s_waitcnt vmcnt(0)" ::: "memory");
            const unsigned og = xb_add(&bar[XB_TOP], 1u);
            const unsigned tg = og / nx;
            if (og + 1u == (tg + 1u) * nx) xb_add(&bar[XB_TOPGEN], 1u);
            else XB_SPIN(xb_ld(&bar[XB_TOPGEN]) == tg, bar);
            __builtin_amdgcn_fence(__ATOMIC_ACQUIRE, "agent");
            xb_add(&bar[XB_XGEN(b.x)], 1u);
            asm volatile("s_waitcnt vmcnt(0)" ::: "memory");
        } else {
            XB_SPIN(xb_ld(&bar[XB_XGEN(b.x)]) == gen, bar);
            __builtin_amdgcn_fence(__ATOMIC_ACQUIRE, "agent");
            asm volatile("s_waitcnt vmcnt(0)" ::: "memory");
        }
    }
    __syncthreads();
}
namespace pg8 {
#define PG8_LAS __attribute__((address_space(3)))
typedef unsigned short bf16_t;
typedef short bf16x8 __attribute__((ext_vector_type(8)));
typedef float f32x4 __attribute__((ext_vector_type(4)));
typedef unsigned u32x4 __attribute__((ext_vector_type(4)));
constexpr int BM = 256, BK = 64, HALF = 128, HTB = HALF * BK * 2  , STAGE_BYTES = 8 * HTB, NXCD = 8, WGM = 8;

__host__ __device__ __forceinline__ int lds_byte(int r, int c) { const int st = (r >> 4) * 2 + (c >> 5), rr = r & 15, cc = c & 31, ob = rr * 64 + cc * 2; return st * 1024 + (ob ^ (((ob >> 9) & 1) << 5)); }
__host__ __device__ __forceinline__ void stage_rc(int b, int& R, int& C) { const int st = b / 1024, sb = b % 1024, swz = sb ^ (((sb >> 9) & 1) << 5); R = (st >> 1) * 16 + swz / 64; C = (st & 1) * 32 + (swz % 64) / 2; }
__host__ __device__ __forceinline__ int perm32(int rho) { const int n = rho >> 4, i = rho & 15; return 8 * (i >> 2) + 4 * n + (i & 3); }

struct Unit { int pm, pn; };
struct Gemm { const bf16_t* A; const bf16_t* Bt; int M, N, K, lda; };

struct StaticOrder {
    int nM, nN, nwg, G, c;
    __host__ __device__ void init(int M, int N, int G_, int c_) { nM = M / BM; nN = N / BM; nwg = nM * nN; G = G_; c = c_; }
    __host__ __device__ bool next(int i, Unit& u) const {
        const long L = (long)i * G + c; if (L >= nwg) return false;
        int wgid = (int)L; { const int q = nwg / NXCD, r = nwg % NXCD, xcd = wgid % NXCD, off = wgid / NXCD; wgid = (xcd < r ? xcd * (q + 1) : r * (q + 1) + (xcd - r) * q) + off; }
        const int nig = WGM * nN, gid = wgid / nig, fm = gid * WGM, gsz = (nM - fm) < WGM ? (nM - fm) : WGM;
        u.pm = fm + ((wgid % nig) % gsz); u.pn = (wgid % nig) / gsz; return true;
    }
    __device__ __forceinline__ void a_ready(const Unit&) const {}
    __device__ __forceinline__ void done(const Unit&) const {}
};

struct RangeOrder {
    StaticOrder so; int i0, n;
    __host__ __device__ bool next(int i, Unit& u) const { return i < n && so.next(i0 + i, u); }
    __device__ __forceinline__ void a_ready(const Unit&) const {}
    __device__ __forceinline__ void done(const Unit&) const {}
};
__device__ __forceinline__ unsigned cvt_pk_bf16(float lo, float hi) { unsigned r; asm volatile("v_cvt_pk_bf16_f32 %0, %1, %2" : "=v"(r) : "v"(lo), "v"(hi)); return r; }
typedef float f32x2 __attribute__((ext_vector_type(2)));
__device__ __forceinline__ f32x2 gelu_pk(f32x2 v) {
    const f32x2 av = __builtin_elementwise_abs(v), d = av * 0.2316418882f + 1.0f;
    f32x2 t; t.x = __builtin_amdgcn_rcpf(d.x); t.y = __builtin_amdgcn_rcpf(d.y);
    f32x2 q = t * 0.5307027145f + (-0.7265760135f); q = q * t + 0.7107068705f; q = q * t + (-0.142248368f); q = q * t + 0.127414796f; q = q * t;
    const f32x2 s = (v * v) * (-0.72134752044f);
    f32x2 e; e.x = __builtin_amdgcn_exp2f(s.x); e.y = __builtin_amdgcn_exp2f(s.y);
    const f32x2 m = v * (q * e), r = v - m;
    f32x2 o; o.x = v.x < 0.f ? m.x : r.x; o.y = v.y < 0.f ? m.y : r.y; return o;
}

template <int ACT  > struct EpiBf16 {
    static constexpr bool PERM = true, AFTER_DRAIN = false; static_assert(ACT == 0 || ACT == 1, "EpiBf16: ACT is 0 (none) or 1 (gelu_pk)");
    bf16_t* O; int ldc; const float* bias; int split_cols; size_t split_stride; float scale0;
    __device__ __forceinline__ void operator()(const f32x4 (&acc)[2][2][4][2], const Unit& u, int wr, int wc, int fr, int fq) const {
        const int row0 = u.pm * BM + wr * 64 + fr; int colt = u.pn * BM; bf16_t* base = O;
        float sc = 1.f; if (split_cols) { const int t = colt / split_cols; base += (size_t)t * split_stride; colt -= t * split_cols; if (t == 0) sc = scale0; }
        const int col0 = colt + wc * 32 + 8 * fq, bcol0 = u.pn * BM + wc * 32 + 8 * fq;
        f32x4 bv[2][2];
#pragma unroll
        for (int bj = 0; bj < 2; ++bj)
#pragma unroll
            for (int n = 0; n < 2; ++n) bv[bj][n] = bias ? *(const f32x4*)(bias + bcol0 + bj * HALF + 4 * n) : (f32x4){0.f, 0.f, 0.f, 0.f};
#pragma unroll
        for (int ai = 0; ai < 2; ++ai)
#pragma unroll
            for (int m = 0; m < 4; ++m) { bf16_t* rowp = base + (size_t)(row0 + ai * HALF + m * 16) * ldc + col0;
#pragma unroll
                for (int bj = 0; bj < 2; ++bj) { f32x4 v0 = acc[ai][bj][m][0] + bv[bj][0], v1 = acc[ai][bj][m][1] + bv[bj][1];
                    if (ACT == 1) { f32x2 a = gelu_pk((f32x2){v0[0], v0[1]}), b = gelu_pk((f32x2){v0[2], v0[3]}), c = gelu_pk((f32x2){v1[0], v1[1]}), d = gelu_pk((f32x2){v1[2], v1[3]});
                        v0 = (f32x4){a.x, a.y, b.x, b.y}; v1 = (f32x4){c.x, c.y, d.x, d.y}; }
                    v0 = v0 * sc; v1 = v1 * sc; u32x4 w; w.x = cvt_pk_bf16(v0[0], v0[1]); w.y = cvt_pk_bf16(v0[2], v0[3]); w.z = cvt_pk_bf16(v1[0], v1[1]); w.w = cvt_pk_bf16(v1[2], v1[3]);
                    *(u32x4*)(rowp + bj * HALF) = w; } }
    }
};

template <class Epi, class Sched, bool ALIGN_EPI = false, bool SP2 = false>
__device__ __forceinline__ void gemm_phase(PG8_LAS unsigned char* lds, const Gemm g, const Sched& S, const Epi& E) {
    const int tid = threadIdx.x, wid = __builtin_amdgcn_readfirstlane(tid >> 6), lane = tid & 63, wr = wid >> 2, wc = wid & 3, fr = lane & 15, fq = lane >> 4;
    const int K = g.K, nt = K / BK;
    unsigned voffA[2], voffB[2];
#pragma unroll
    for (int i = 0; i < 2; ++i) { int R, C; stage_rc(tid * 16 + i * 8192, R, C); const int Rb = Epi::PERM ? ((R & ~31) + perm32(R & 31)) : R;
        voffA[i] = (unsigned)(R * g.lda + C) * 2u; voffB[i] = (unsigned)(Rb * K + C) * 2u; }
    const size_t kstep = (size_t)(BK * 2);
    const size_t hstepA = (size_t)HALF * g.lda * 2, hstepB = (size_t)HALF * K * 2;
    const size_t tstepA = 2 * hstepA, tstepB = 2 * hstepB;
    const unsigned ldsw = (unsigned)wid * 1024u;
    const int aoff = lds_byte(wr * 64 + fr, fq * 8), boff = lds_byte(wc * 32 + fr, fq * 8);
#define PG8_SA(b, h) (((b) * 2 + (h)) * HTB)
#define PG8_SB(b, h) ((4 + (b) * 2 + (h)) * HTB)
#define PG8_STAGE(bufoff, gbase, voff) do { _Pragma("unroll") for (int _i = 0; _i < 2; ++_i) \
        __builtin_amdgcn_global_load_lds((const unsigned*)((const char*)(gbase) + (voff)[_i]), (PG8_LAS unsigned*)(lds + (bufoff) + ldsw + _i * 8192), 16, 0, 0); } while (0)
#define PG8_LDA(dst, b, h) do { _Pragma("unroll") for (int m = 0; m < 4; ++m) _Pragma("unroll") for (int k = 0; k < 2; ++k) dst[m][k] = *(const PG8_LAS bf16x8*)(lds + PG8_SA(b, h) + aoff + m * 2048 + k * 1024); } while (0)
#define PG8_LDB(dst, b, h) do { _Pragma("unroll") for (int n = 0; n < 2; ++n) _Pragma("unroll") for (int k = 0; k < 2; ++k) dst[n][k] = *(const PG8_LAS bf16x8*)(lds + PG8_SB(b, h) + boff + n * 2048 + k * 1024); } while (0)
#define PG8_MMA(ai, bj, At, Bt) do { __builtin_amdgcn_s_setprio(1); _Pragma("unroll") for (int m = 0; m < 4; ++m) _Pragma("unroll") for (int n = 0; n < 2; ++n) _Pragma("unroll") for (int k = 0; k < 2; ++k) \
        acc[ai][bj][m][n] = __builtin_amdgcn_mfma_f32_16x16x32_bf16(Bt[n][k], At[m][k], acc[ai][bj][m][n], 0, 0, 0); __builtin_amdgcn_s_setprio(0); } while (0)
#define PG8_WAIT_V(n) asm volatile("s_waitcnt vmcnt(" #n ")" ::: "memory")
#define PG8_WAIT_L(n) asm volatile("s_waitcnt lgkmcnt(" #n ")" ::: "memory")
#define PG8_BAR __builtin_amdgcn_s_barrier()
#define PG8_SCHED __builtin_amdgcn_sched_barrier(0)
    Unit cur, nxt; int ui = 0;
    if (!S.next(0, cur)) return;
    f32x4 acc[2][2][4][2];
#pragma unroll
    for (int a = 0; a < 2; ++a)
#pragma unroll
        for (int b = 0; b < 2; ++b)
#pragma unroll
            for (int m = 0; m < 4; ++m)
#pragma unroll
                for (int n = 0; n < 2; ++n) acc[a][b][m][n] = (f32x4){0.f, 0.f, 0.f, 0.f};
    bf16x8 At[4][2], B0[2][2], B1[2][2];
    const char* cA = (const char*)g.A + (size_t)cur.pm * tstepA; const char* cB = (const char*)g.Bt + (size_t)cur.pn * tstepB;
    S.a_ready(cur);
    if constexpr (SP2) {
        PG8_STAGE(PG8_SB(0, 0), cB, voffB); PG8_STAGE(PG8_SB(0, 1), cB + hstepB, voffB); PG8_STAGE(PG8_SA(0, 0), cA, voffA); PG8_STAGE(PG8_SA(0, 1), cA + hstepA, voffA);
        if (wr == 1) PG8_BAR;
        PG8_WAIT_V(2); PG8_BAR;
        PG8_STAGE(PG8_SB(1, 0), cB + kstep, voffB); PG8_STAGE(PG8_SA(1, 0), cA + kstep, voffA); PG8_STAGE(PG8_SB(1, 1), cB + hstepB + kstep, voffB);
        PG8_WAIT_V(6); PG8_BAR;
    } else {
        PG8_STAGE(PG8_SB(0, 0), cB, voffB); PG8_STAGE(PG8_SA(0, 0), cA, voffA); PG8_STAGE(PG8_SB(0, 1), cB + hstepB, voffB); PG8_STAGE(PG8_SA(0, 1), cA + hstepA, voffA);
        if (wr == 1) PG8_BAR;
        PG8_WAIT_V(4); PG8_BAR;
        PG8_STAGE(PG8_SB(1, 0), cB + kstep, voffB); PG8_STAGE(PG8_SA(1, 0), cA + kstep, voffA); PG8_STAGE(PG8_SB(1, 1), cB + hstepB + kstep, voffB);
        PG8_WAIT_V(6); PG8_BAR;
    }
    for (;;) {
        const bool has_next = S.next(ui + 1, nxt);
        const char* nA = has_next ? (const char*)g.A + (size_t)nxt.pm * tstepA : cA; const char* nB = has_next ? (const char*)g.Bt + (size_t)nxt.pn * tstepB : cB;
        for (int t = 0; t < nt; t += 2) {
            const bool last = (t == nt - 2);
            const char* a1 = cA + (size_t)(t + 1) * kstep;
            const char* a2 = last ? nA : cA + (size_t)(t + 2) * kstep; const char* b2 = last ? nB : cB + (size_t)(t + 2) * kstep;
            const char* a3 = a2 + kstep; const char* b3 = b2 + kstep;
            if (last && has_next) S.a_ready(nxt);
            if constexpr (SP2) {
            PG8_LDB(B0, 0, 0); PG8_LDB(B1, 0, 1); PG8_SCHED; PG8_LDA(At, 0, 0); PG8_STAGE(PG8_SA(1, 1), a1 + hstepA, voffA);
            PG8_WAIT_V(8); PG8_WAIT_L(0); PG8_BAR; PG8_MMA(0, 0, At, B0); PG8_MMA(0, 1, At, B1); PG8_BAR; PG8_SCHED;
            PG8_LDA(At, 0, 1); PG8_STAGE(PG8_SB(0, 0), b2, voffB); PG8_STAGE(PG8_SB(0, 1), b2 + hstepB, voffB); PG8_STAGE(PG8_SA(0, 0), a2, voffA);
            PG8_WAIT_V(8); PG8_WAIT_L(0); PG8_BAR; PG8_MMA(1, 0, At, B0); PG8_MMA(1, 1, At, B1); PG8_BAR; PG8_SCHED;
            PG8_LDB(B0, 1, 0); PG8_LDB(B1, 1, 1); PG8_SCHED; PG8_LDA(At, 1, 0); PG8_STAGE(PG8_SA(0, 1), a2 + hstepA, voffA);
            PG8_WAIT_V(8); PG8_WAIT_L(0); PG8_BAR; PG8_MMA(0, 0, At, B0); PG8_MMA(0, 1, At, B1); PG8_BAR; PG8_SCHED;
            PG8_LDA(At, 1, 1); PG8_STAGE(PG8_SB(1, 0), b3, voffB); PG8_STAGE(PG8_SB(1, 1), b3 + hstepB, voffB); PG8_STAGE(PG8_SA(1, 0), a3, voffA);
            PG8_WAIT_V(8); PG8_WAIT_L(0); PG8_BAR; PG8_MMA(1, 0, At, B0); PG8_MMA(1, 1, At, B1); PG8_BAR; PG8_SCHED;
            } else {
            PG8_LDB(B0, 0, 0); PG8_SCHED; PG8_LDA(At, 0, 0); PG8_STAGE(PG8_SA(1, 1), a1 + hstepA, voffA);
            PG8_WAIT_L(8); PG8_BAR; PG8_WAIT_L(0); PG8_MMA(0, 0, At, B0); PG8_BAR; PG8_SCHED;
            PG8_LDB(B1, 0, 1); PG8_STAGE(PG8_SB(0, 0), b2, voffB);
            PG8_BAR; PG8_WAIT_L(0); PG8_MMA(0, 1, At, B1); PG8_BAR;
            PG8_LDA(At, 0, 1); PG8_STAGE(PG8_SA(0, 0), a2, voffA);
            PG8_BAR; PG8_WAIT_L(0); PG8_MMA(1, 0, At, B0); PG8_BAR; PG8_SCHED;
            PG8_STAGE(PG8_SB(0, 1), b2 + hstepB, voffB);
            PG8_WAIT_V(6); PG8_BAR; PG8_MMA(1, 1, At, B1); PG8_BAR;
            PG8_LDB(B0, 1, 0); PG8_SCHED; PG8_LDA(At, 1, 0); PG8_STAGE(PG8_SA(0, 1), a2 + hstepA, voffA);
            PG8_WAIT_L(8); PG8_BAR; PG8_WAIT_L(0); PG8_MMA(0, 0, At, B0); PG8_BAR; PG8_SCHED;
            PG8_LDB(B1, 1, 1); PG8_STAGE(PG8_SB(1, 0), b3, voffB);
            PG8_BAR; PG8_WAIT_L(0); PG8_MMA(0, 1, At, B1); PG8_BAR;
            PG8_LDA(At, 1, 1); PG8_STAGE(PG8_SA(1, 0), a3, voffA);
            PG8_BAR; PG8_WAIT_L(0); PG8_MMA(1, 0, At, B0); PG8_BAR; PG8_SCHED;
            PG8_STAGE(PG8_SB(1, 1), b3 + hstepB, voffB);
            PG8_WAIT_V(6); PG8_BAR; PG8_MMA(1, 1, At, B1); PG8_BAR;
            }
        }
        if constexpr (ALIGN_EPI) { if (wr == 0) PG8_BAR; }
        if constexpr (!Epi::AFTER_DRAIN) { E(acc, cur, wr, wc, fr, fq); S.done(cur); }
        if (!has_next) break;
#pragma unroll
        for (int a = 0; a < 2; ++a)
#pragma unroll
            for (int b = 0; b < 2; ++b)
#pragma unroll
                for (int m = 0; m < 4; ++m)
#pragma unroll
                    for (int n = 0; n < 2; ++n) acc[a][b][m][n] = (f32x4){0.f, 0.f, 0.f, 0.f};
        cur = nxt; cA = nA; cB = nB; ++ui;
        if constexpr (ALIGN_EPI) { if (wr == 1) PG8_BAR; }
    }
    PG8_WAIT_V(0);
    if constexpr (!ALIGN_EPI) { if (wr == 0) PG8_BAR; }
    PG8_BAR;
    if constexpr (Epi::AFTER_DRAIN) { E.fused(acc, cur, wr, wc, fr, fq, lds, wid, lane); S.done(cur); }
#undef PG8_SA
#undef PG8_SB
#undef PG8_STAGE
#undef PG8_LDA
#undef PG8_LDB
#undef PG8_MMA
#undef PG8_WAIT_V
#undef PG8_WAIT_L
#undef PG8_BAR
#undef PG8_SCHED
}
}
namespace pg8 {
struct Unit2 { int pm, pn, e, cnt, jt, ui; };
template <class Epi, class Sched>
__device__ __forceinline__ void gemm_phase2(PG8_LAS unsigned char* lds, const bf16_t* Abase, int lda, int ldb, int K, const Sched& S, const Epi& E, int kstepA_ = BK * 2) {
    int tid_ = threadIdx.x; asm volatile("" : "+v"(tid_));
    const int tid = tid_, wid = __builtin_amdgcn_readfirstlane(tid >> 6), lane = tid & 63, wr = wid >> 2, wc = wid & 3, fr = lane & 15, fq = lane >> 4;
    int K_ = K; asm volatile("" : "+s"(K_));
    const int nt = K_ / BK;
    unsigned voffB[2];
#pragma unroll
    for (int i = 0; i < 2; ++i) { int R, C; stage_rc(tid * 16 + i * 8192, R, C); const int Rb = Epi::PERM ? ((R & ~31) + perm32(R & 31)) : R; voffB[i] = (unsigned)(Rb * ldb + C) * 2u; }
    const unsigned lda2 = (unsigned)lda * 2u;
#define PG8_AOFFS(U, o0, o1) do { int t2_ = threadIdx.x; asm volatile("" : "+v"(t2_)); _Pragma("unroll") for (int i_ = 0; i_ < 2; ++i_) { int R_, C_; stage_rc(t2_ * 16 + i_ * 8192, R_, C_); \
        o0[i_] = (unsigned)S.arow(U, R_) * lda2 + (unsigned)C_ * 2u; o1[i_] = (unsigned)S.arow(U, HALF + R_) * lda2 + (unsigned)C_ * 2u; } } while (0)
    const size_t kstep = (size_t)(BK * 2), kstepA = (size_t)kstepA_;
    const size_t hstepB = (size_t)HALF * ldb * 2;
    const unsigned ldsw = (unsigned)wid * 1024u;
    const int aoff = lds_byte(wr * 64 + fr, fq * 8), boff = lds_byte(wc * 32 + fr, fq * 8);
#define PG8_SA(b, h) (((b) * 2 + (h)) * HTB)
#define PG8_SB(b, h) ((4 + (b) * 2 + (h)) * HTB)
#define PG8_STAGE(bufoff, gbase, voff) do { _Pragma("unroll") for (int _i = 0; _i < 2; ++_i) \
        __builtin_amdgcn_global_load_lds((const unsigned*)((const char*)(gbase) + (voff)[_i]), (PG8_LAS unsigned*)(lds + (bufoff) + ldsw + _i * 8192), 16, 0, 0); } while (0)
#define PG8_LDA(dst, b, h) do { _Pragma("unroll") for (int m = 0; m < 4; ++m) _Pragma("unroll") for (int k = 0; k < 2; ++k) dst[m][k] = *(const PG8_LAS bf16x8*)(lds + PG8_SA(b, h) + aoff + m * 2048 + k * 1024); } while (0)
#define PG8_LDB(dst, b, h) do { _Pragma("unroll") for (int n = 0; n < 2; ++n) _Pragma("unroll") for (int k = 0; k < 2; ++k) dst[n][k] = *(const PG8_LAS bf16x8*)(lds + PG8_SB(b, h) + boff + n * 2048 + k * 1024); } while (0)
#define PG8_MMA(ai, bj, At, Bt) do { __builtin_amdgcn_s_setprio(1); _Pragma("unroll") for (int m = 0; m < 4; ++m) _Pragma("unroll") for (int n = 0; n < 2; ++n) _Pragma("unroll") for (int k = 0; k < 2; ++k) \
        acc[ai][bj][m][n] = __builtin_amdgcn_mfma_f32_16x16x32_bf16(Bt[n][k], At[m][k], acc[ai][bj][m][n], 0, 0, 0); __builtin_amdgcn_s_setprio(0); } while (0)
#define PG8_WAIT_V(n) asm volatile("s_waitcnt vmcnt(" #n ")" ::: "memory")
#define PG8_WAIT_L(n) asm volatile("s_waitcnt lgkmcnt(" #n ")" ::: "memory")
#define PG8_BAR __builtin_amdgcn_s_barrier()
#define PG8_SCHED __builtin_amdgcn_sched_barrier(0)
    Unit2 cur, nxt; int ui = 0;
    if (!S.next(0, cur)) return;
    f32x4 acc[2][2][4][2];
#pragma unroll
    for (int a = 0; a < 2; ++a)
#pragma unroll
        for (int b = 0; b < 2; ++b)
#pragma unroll
            for (int m = 0; m < 4; ++m)
#pragma unroll
                for (int n = 0; n < 2; ++n) acc[a][b][m][n] = (f32x4){0.f, 0.f, 0.f, 0.f};
    bf16x8 At[4][2], B0[2][2], B1[2][2];
    unsigned cv0[2], cv1[2], nv0[2], nv1[2];
    PG8_AOFFS(cur, cv0, cv1);
    const char* cA = (const char*)Abase + S.aoff(cur); const char* cB = S.bptr(cur);
    PG8_STAGE(PG8_SB(0, 0), cB, voffB); PG8_STAGE(PG8_SB(0, 1), cB + hstepB, voffB); PG8_STAGE(PG8_SA(0, 0), cA, cv0); PG8_STAGE(PG8_SA(0, 1), cA, cv1);
    if (wr == 1) PG8_BAR;
    PG8_WAIT_V(2); PG8_BAR;
    PG8_STAGE(PG8_SB(1, 0), cB + kstep, voffB); PG8_STAGE(PG8_SA(1, 0), cA + kstepA, cv0); PG8_STAGE(PG8_SB(1, 1), cB + hstepB + kstep, voffB);
    PG8_WAIT_V(6); PG8_BAR;
    for (;;) {
        const bool has_next = S.next(ui + 1, nxt);
        const char* nA = has_next ? (const char*)Abase + S.aoff(nxt) : cA; const char* nB = has_next ? S.bptr(nxt) : cB;
#pragma unroll
        for (int i = 0; i < 2; ++i) { nv0[i] = cv0[i]; nv1[i] = cv1[i]; }
        if (has_next) PG8_AOFFS(nxt, nv0, nv1);
        const bool act0 = cur.cnt > wr * 64, act1 = cur.cnt > HALF + wr * 64;
        for (int t = 0; t < nt; t += 2) {
            const bool last = (t == nt - 2);
            const char* a1 = cA + (size_t)(t + 1) * kstepA;
            const char* a2 = last ? nA : cA + (size_t)(t + 2) * kstepA; const char* b2 = last ? nB : cB + (size_t)(t + 2) * kstep;
            const char* a3 = a2 + kstepA; const char* b3 = b2 + kstep;
            unsigned s0[2] = {cv0[0], cv0[1]}, s1[2] = {cv1[0], cv1[1]};
            if (last) { asm volatile("" ::: "memory"); s0[0] = nv0[0]; s0[1] = nv0[1]; s1[0] = nv1[0]; s1[1] = nv1[1]; }
            PG8_LDB(B0, 0, 0); PG8_LDB(B1, 0, 1); PG8_SCHED; PG8_LDA(At, 0, 0); PG8_STAGE(PG8_SA(1, 1), a1, cv1);
            PG8_WAIT_V(8); PG8_WAIT_L(0); PG8_BAR; if (act0) { PG8_MMA(0, 0, At, B0); PG8_MMA(0, 1, At, B1); } PG8_BAR; PG8_SCHED;
            PG8_LDA(At, 0, 1); PG8_STAGE(PG8_SB(0, 0), b2, voffB); PG8_STAGE(PG8_SB(0, 1), b2 + hstepB, voffB); PG8_STAGE(PG8_SA(0, 0), a2, s0);
            PG8_WAIT_V(8); PG8_WAIT_L(0); PG8_BAR; if (act1) { PG8_MMA(1, 0, At, B0); PG8_MMA(1, 1, At, B1); } PG8_BAR; PG8_SCHED;
            PG8_LDB(B0, 1, 0); PG8_LDB(B1, 1, 1); PG8_SCHED; PG8_LDA(At, 1, 0); PG8_STAGE(PG8_SA(0, 1), a2, s1);
            PG8_WAIT_V(8); PG8_WAIT_L(0); PG8_BAR; if (act0) { PG8_MMA(0, 0, At, B0); PG8_MMA(0, 1, At, B1); } PG8_BAR; PG8_SCHED;
            PG8_LDA(At, 1, 1); PG8_STAGE(PG8_SB(1, 0), b3, voffB); PG8_STAGE(PG8_SB(1, 1), b3 + hstepB, voffB); PG8_STAGE(PG8_SA(1, 0), a3, s0);
            PG8_WAIT_V(8); PG8_WAIT_L(0); PG8_BAR; if (act1) { PG8_MMA(1, 0, At, B0); PG8_MMA(1, 1, At, B1); } PG8_BAR; PG8_SCHED;
        }
        if (wr == 0) PG8_BAR;
        { Unit2 eu = cur; asm volatile("" : "+s"(eu.pm), "+s"(eu.pn), "+s"(eu.e), "+s"(eu.cnt), "+s"(eu.jt), "+s"(eu.ui));
          E(acc, eu, wr, wc, fr, fq);
          }
        if (!has_next) break;
#pragma unroll
        for (int a = 0; a < 2; ++a)
#pragma unroll
            for (int b = 0; b < 2; ++b)
#pragma unroll
                for (int m = 0; m < 4; ++m)
#pragma unroll
                    for (int n = 0; n < 2; ++n) acc[a][b][m][n] = (f32x4){0.f, 0.f, 0.f, 0.f};
        cur = nxt; cA = nA; cB = nB; ++ui;
#pragma unroll
        for (int i = 0; i < 2; ++i) { cv0[i] = nv0[i]; cv1[i] = nv1[i]; }
        if (wr == 1) PG8_BAR;
    }
    PG8_WAIT_V(0);
    PG8_BAR;
#undef PG8_AOFFS
#undef PG8_SA
#undef PG8_SB
#undef PG8_STAGE
#undef PG8_LDA
#undef PG8_LDB
#undef PG8_MMA
#undef PG8_WAIT_V
#undef PG8_WAIT_L
#undef PG8_BAR
#undef PG8_SCHED
}

struct DenseSched {
    StaticOrder so; const bf16_t* Bt; int ldb;
    __device__ __forceinline__ bool next(int i, Unit2& u) const { Unit t; if (!so.next(i, t)) return false; u.pm = t.pm; u.pn = t.pn; u.e = 0; u.cnt = 256; u.jt = 0; u.ui = i; return true; }
    __device__ __forceinline__ int arow(const Unit2& u, int r) const { return u.pm * BM + r; }
    __device__ __forceinline__ size_t aoff(const Unit2&) const { return 0; }
    __device__ __forceinline__ const char* bptr(const Unit2& u) const { return (const char*)(Bt + (size_t)u.pn * BM * ldb); }
};
struct EpiPlainBf16 {
    static constexpr bool PERM = true, AFTER_DRAIN = false;
    bf16_t* O; int ldc;
    __device__ __forceinline__ void operator()(const f32x4 (&acc)[2][2][4][2], const Unit2& u, int wr, int wc, int fr, int fq) const {
        const int row0 = u.pm * BM + wr * 64 + fr, col0 = u.pn * BM + wc * 32 + 8 * fq;
#pragma unroll
        for (int ai = 0; ai < 2; ++ai)
#pragma unroll
            for (int m = 0; m < 4; ++m) { bf16_t* rowp = O + (size_t)(row0 + ai * HALF + m * 16) * ldc + col0;
#pragma unroll
                for (int bj = 0; bj < 2; ++bj) { const f32x4 v0 = acc[ai][bj][m][0], v1 = acc[ai][bj][m][1];
                    u32x4 w; w.x = cvt_pk_bf16(v0[0], v0[1]); w.y = cvt_pk_bf16(v0[2], v0[3]); w.z = cvt_pk_bf16(v1[0], v1[1]); w.w = cvt_pk_bf16(v1[2], v1[3]);
                    *(u32x4*)(rowp + bj * HALF) = w; } }
    }
};
}
namespace nv {
constexpr int D = 1024, B = 8, S = 4096, T = B * S;
constexpr int FH = 8, FD = 64, GH = 4, GK = 64, GV = 128, RANK = 16;
constexpr int INW = 3096;
constexpr int O_FQ = 0, O_FK = 512, O_FV = 1024, O_FF = 1536, O_GQ = 1544, O_GK = 1800, O_GV = 2056, O_GA = 2568, O_GR = 2584;
constexpr int NE = 256, NG = 8, TOPK = 8, ED = 256;
constexpr float LN_EPS = 1e-5f;
constexpr float ALPHA = 1.189207115002721f;
constexpr int PADR = 64;
constexpr int APAD = T * TOPK + NE * PADR;

__device__ __forceinline__ float logsigmoidf(float x) { return fminf(x, 0.f) - log1pf(expf(-fabsf(x))); }
__device__ __forceinline__ float siluf(float x) { return x / (1.f + expf(-x)); }

}
#include <hip/hip_bf16.h>
#include <cmath>
namespace attn_body {
using bf16=__hip_bfloat16;
using bf16x8=__attribute__((ext_vector_type(8)))short;
using s16x4=__attribute__((ext_vector_type(4)))short;
using f32x16=__attribute__((ext_vector_type(16)))float;
using u32x4=__attribute__((ext_vector_type(4)))unsigned;
constexpr int BATCH=8,NHEAD=8,SEQ=4096,D=64,DM=3072,OPITCH=1024;
constexpr int NW=8,QBLK=32,QB=QBLK*NW,KVBLK=64,NQB=SEQ/QB;
constexpr int ATTN_PITCH=DM, ATTN_UNIT_ROWS=QB;
__device__ __forceinline__ int crow(int r,int hi){return (r&3)+8*(r>>2)+4*hi;}
#define SBAR() __builtin_amdgcn_sched_barrier(0)
__device__ __forceinline__ void cmask(f32x16&p0,f32x16&p1,int jb,int qrel,int hi){
  const float NEG=-INFINITY; int kb=64*jb+4*hi;
  #pragma unroll
  for(int r=0;r<16;++r){int kv=kb+(r&3)+8*(r>>2); if(kv>qrel)p0[r]=NEG; if(kv+32>qrel)p1[r]=NEG;}
}

constexpr int NSLOT=3, SLOTB=8192;
constexpr int LDS_K=0, LDS_V=NSLOT*SLOTB, LDS_WS=2*NSLOT*SLOTB, LDS_OST=LDS_WS+NW*64*4, LDS_KB=LDS_OST+NW*4096, LDS_BYTES=LDS_KB+(SEQ+2)*8;
constexpr float C2=0.125f*1.4426950408889634f;
__device__ __forceinline__ void glds16(const void*gsrc,unsigned lds_dst){unsigned keep;
  asm volatile("s_mov_b32 %0, m0\n\ts_mov_b32 m0, %2\n\ts_nop 0\n\tglobal_load_lds_dwordx4 %1, off\n\ts_mov_b32 m0, %0":"=&s"(keep):"v"(gsrc),"s"(lds_dst):"memory");}
__device__ __forceinline__ float max3f(float a,float b,float c){float r;asm("v_max3_f32 %0, %1, %2, %3":"=v"(r):"v"(a),"v"(b),"v"(c));return r;}
__device__ __forceinline__ float max2f(float a,float b){float r;asm("v_max_f32_e32 %0, %1, %2":"=v"(r):"v"(a),"v"(b));return r;}
__device__ __forceinline__ float fadd_s(float a,float b){float r;asm("v_add_f32_e32 %0, %1, %2":"=v"(r):"v"(a),"v"(b));return r;}
__device__ __forceinline__ float fsub_s(float a,float b){float r;asm("v_sub_f32_e32 %0, %1, %2":"=v"(r):"v"(a),"v"(b));return r;}
typedef float f32x2_t __attribute__((ext_vector_type(2))); typedef float f32x4_t __attribute__((ext_vector_type(4))); typedef __bf16 bf16x2_t __attribute__((ext_vector_type(2)));
__device__ __forceinline__ unsigned cvtpk_s(float lo,float hi){f32x2_t v={lo,hi};bf16x2_t b=__builtin_convertvector(v,bf16x2_t);return __builtin_bit_cast(unsigned,b);}
#define WAIT_BAR(N) asm volatile("s_waitcnt vmcnt(" #N ") lgkmcnt(0)\n\ts_barrier":::"memory")

__device__ __forceinline__ void split3(float b,unsigned&h,unsigned&m,unsigned&l){
  h=cvtpk_s(b,0.f)&0xffffu; const float r1=b-__uint_as_float(h<<16);
  m=cvtpk_s(r1,0.f)&0xffffu; const float r2=r1-__uint_as_float(m<<16);
  l=cvtpk_s(r2,0.f)&0xffffu; }
__device__ __forceinline__ bf16x8 kbias_frag(float b,int hi){unsigned h,m,l;split3(b,h,m,l);u32x4 w;w.x=h|(m<<16);w.y=l|0x3F800000u;w.z=0x3F803F80u;w.w=0u;if(hi){w.x=0u;w.y=0u;w.z=0u;}return __builtin_bit_cast(bf16x8,w);}
__device__ __forceinline__ bf16x8 qref_frag(float x,int hi){unsigned h,m,l;split3(x,h,m,l);u32x4 w;w.x=0x3F803F80u;w.y=0x3F80u|(h<<16);w.z=m|(l<<16);w.w=0u;if(hi){w.x=0u;w.y=0u;w.z=0u;}return __builtin_bit_cast(bf16x8,w);}
typedef unsigned u32x2_t __attribute__((ext_vector_type(2)));
__device__ __forceinline__ bf16x8 mkfrag(u32x2_t e,unsigned zc){u32x4 w;w.x=e.x;w.y=e.y;w.z=zc;w.w=0u;return __builtin_bit_cast(bf16x8,w);}
__device__ __forceinline__ void fox_bias_table(int b,int h,const float*LF,char*shm){
  int tid_=threadIdx.x; asm volatile("":"+v"(tid_)); const int tid=tid_,lane=tid&63,wid=__builtin_amdgcn_readfirstlane(tid>>6);
  const float*lf=LF+((long)b*NHEAD+h)*SEQ; float*wt=(float*)(shm+LDS_WS); u32x2_t*KB8=(u32x2_t*)(shm+LDS_KB);
  f32x4_t va=*(const f32x4_t*)(lf+8*tid),vb=*(const f32x4_t*)(lf+8*tid+4);
  va[1]+=va[0];va[2]+=va[1];va[3]+=va[2];vb[0]+=va[3];vb[1]+=vb[0];vb[2]+=vb[1];vb[3]+=vb[2];
  const float tot=vb[3]; float inc=tot;
  #pragma unroll
  for(int o_=1;o_<64;o_<<=1){const float nn=__shfl_up(inc,o_);if(lane>=o_)inc+=nn;}
  __syncthreads();
  if(lane==63)wt[wid*64]=inc;
  __syncthreads();
  float base=inc-tot;
  #pragma unroll
  for(int w_=0;w_<NW;++w_){const float x_=wt[w_*64]; if(w_<wid)base+=x_;}
  const float cv[8]={va[0]+base,va[1]+base,va[2]+base,va[3]+base,vb[0]+base,vb[1]+base,vb[2]+base,vb[3]+base};
  #pragma unroll
  for(int j=0;j<8;++j){unsigned hh,mm,ll;split3(-cv[j],hh,mm,ll);KB8[8*tid+j]=(u32x2_t){hh|(mm<<16),ll|0x3F800000u};}
  if(tid==0){KB8[SEQ]=(u32x2_t){0u,0u};KB8[SEQ+1]=(u32x2_t){0u,0u};}
  __syncthreads();
}
__device__ __forceinline__ void qkt(f32x16&p0,f32x16&p1,const char*Kslot,const bf16x8*qr,bf16x8 kb0,bf16x8 kb1,bf16x8 qx,int r32,int hi){
  const f32x16 negm=f32x16{};
  const char*kb=Kslot+hi*1024+r32*16;
  #pragma unroll
  for(int d0=0;d0<4;++d0){
    const bf16x8 b0=*reinterpret_cast<const bf16x8*>(kb+d0*2048);
    const bf16x8 b1=*reinterpret_cast<const bf16x8*>(kb+d0*2048+512);
    if(d0==0){p0=__builtin_amdgcn_mfma_f32_32x32x16_bf16(b0,qr[0],negm,0,0,0);p1=__builtin_amdgcn_mfma_f32_32x32x16_bf16(b1,qr[0],negm,0,0,0);}
    else{p0=__builtin_amdgcn_mfma_f32_32x32x16_bf16(b0,qr[d0],p0,0,0,0);p1=__builtin_amdgcn_mfma_f32_32x32x16_bf16(b1,qr[d0],p1,0,0,0);}}
  p0=__builtin_amdgcn_mfma_f32_32x32x16_bf16(kb0,qx,p0,0,0,0);p1=__builtin_amdgcn_mfma_f32_32x32x16_bf16(kb1,qx,p1,0,0,0);
}
typedef __attribute__((address_space(3))) const char* lds_cptr;
typedef short v4i16_t __attribute__((ext_vector_type(4)));
__device__ __forceinline__ void kload8(bf16x8*kf,lds_cptr kp){
  kf[0]=*(const __attribute__((address_space(3))) bf16x8*)(kp);      kf[1]=*(const __attribute__((address_space(3))) bf16x8*)(kp+512);
  kf[2]=*(const __attribute__((address_space(3))) bf16x8*)(kp+2048); kf[3]=*(const __attribute__((address_space(3))) bf16x8*)(kp+2560);
  kf[4]=*(const __attribute__((address_space(3))) bf16x8*)(kp+4096); kf[5]=*(const __attribute__((address_space(3))) bf16x8*)(kp+4608);
  kf[6]=*(const __attribute__((address_space(3))) bf16x8*)(kp+6144); kf[7]=*(const __attribute__((address_space(3))) bf16x8*)(kp+6656);
}
__device__ __forceinline__ void kload2(bf16x8*kf,lds_cptr kp,int j){ kf[2*j]=*(const __attribute__((address_space(3))) bf16x8*)(kp+j*2048); kf[2*j+1]=*(const __attribute__((address_space(3))) bf16x8*)(kp+j*2048+512); }
__device__ __forceinline__ s16x4 vtr(lds_cptr p){ return __builtin_bit_cast(s16x4,__builtin_amdgcn_ds_read_tr16_b64_v4i16((__attribute__((address_space(3))) v4i16_t*)p)); }
__device__ __forceinline__ float rowmax(const f32x16&p0,const f32x16&p1){
  float a=max3f(p0[0],p0[1],p1[0]),b=max3f(p0[2],p0[3],p1[1]);a=max3f(a,p1[2],p1[3]);
  #pragma unroll
  for(int r=4;r<16;r+=4){a=max3f(a,p0[r],p0[r+1]);b=max3f(b,p0[r+2],p0[r+3]);a=max3f(a,p1[r],p1[r+1]);b=max3f(b,p1[r+2],p1[r+3]);}
  const float m=max2f(a,b);
  auto rr=__builtin_amdgcn_permlane32_swap(__float_as_uint(m),__float_as_uint(m),false,false);
  return max2f(__uint_as_float(rr[0]),__uint_as_float(rr[1]));
}
__device__ __forceinline__ void pv(f32x16*o,int vb,bf16x8 pa0,bf16x8 pa1,bf16x8 pa2,bf16x8 pa3){
  #pragma unroll
  for(int d0=0;d0<2;++d0){s16x4 lo[4],hi[4];
    #pragma unroll
    for(int ks=0;ks<4;++ks){
      asm volatile("ds_read_b64_tr_b16 %0,%1 offset:%c2":"=&v"(lo[ks]):"v"(vb),"i"(d0*4096+ks*1024):"memory");
      asm volatile("ds_read_b64_tr_b16 %0,%1 offset:%c2":"=&v"(hi[ks]):"v"(vb),"i"(d0*4096+ks*1024+512):"memory");}
    asm volatile("s_waitcnt lgkmcnt(0)":::"memory");SBAR();
    #define PK(k) (bf16x8){lo[k][0],lo[k][1],lo[k][2],lo[k][3],hi[k][0],hi[k][1],hi[k][2],hi[k][3]}
    o[d0]=__builtin_amdgcn_mfma_f32_32x32x16_bf16(pa0,PK(0),o[d0],0,0,0);
    o[d0]=__builtin_amdgcn_mfma_f32_32x32x16_bf16(pa1,PK(1),o[d0],0,0,0);
    o[d0]=__builtin_amdgcn_mfma_f32_32x32x16_bf16(pa2,PK(2),o[d0],0,0,0);
    o[d0]=__builtin_amdgcn_mfma_f32_32x32x16_bf16(pa3,PK(3),o[d0],0,0,0);
    #undef PK
  }
}

#ifndef ATTN_STORE16
#define ATTN_STORE16(p,v) (*(u32x4*)(p)=(v))
#endif
template<int THRL> __device__ __forceinline__ void attn_unit(int b,int h,int qb,const bf16*Q,const bf16* K,const bf16* V,bf16*O,const float*LF,const unsigned*NRM,char*shm){
  int tid_=threadIdx.x; asm volatile("":"+v"(tid_));
  const int tid=tid_,lane=tid&63,r32=lane&31,hi=lane>>5; const int wid=__builtin_amdgcn_readfirstlane(tid>>6);
  const long rowbase=(long)b*SEQ; const int q0=qb*QB;
  const char*KBt0=shm+LDS_KB;
  int t0;
  { const int NT0=(q0+QB)/KVBLK; const unsigned*nr=NRM+(b*NHEAD+h)*4;
    const float qn2=__uint_as_float(nr[0])+__uint_as_float(nr[1]), kn2=__uint_as_float(nr[2])+__uint_as_float(nr[3]);
    const float thr=-(50.f+2.04f*sqrtf(qn2*kn2));
    const u32x2_t eq0=*(const u32x2_t*)(KBt0+(unsigned)q0*8u); const float bq0=__uint_as_float(eq0.x<<16)+__uint_as_float(eq0.x&0xffff0000u)+__uint_as_float(eq0.y<<16);
    bool ok=(2*lane<=NT0-4);
    if(ok&&lane>0){ const u32x2_t el=*(const u32x2_t*)(KBt0+(unsigned)(128*lane-1)*8u); const float bl=__uint_as_float(el.x<<16)+__uint_as_float(el.x&0xffff0000u)+__uint_as_float(el.y<<16); ok=(bl-bq0<thr); }
    const unsigned long long mk=__ballot(ok); const unsigned long long low=~mk; const int cnt=(low==0ull)?64:__builtin_ctzll(low);
    t0=__builtin_amdgcn_readfirstlane(2*(cnt-1)); }
  const char*KBt=KBt0+(hi?0:t0*512); const unsigned kb_o0=hi?(unsigned)SEQ*8u:(unsigned)r32*8u, kb_o1=hi?(unsigned)SEQ*8u:(unsigned)(r32+32)*8u, kb_str=hi?0u:512u, zc=hi?0u:0x3F803F80u;
  const bf16*Qw=Q+(rowbase+q0+wid*QBLK)*DM+h*D;
  const bf16*Kh=K+(rowbase+(long)t0*KVBLK)*DM+h*D,*Vh=V+(rowbase+(long)t0*KVBLK)*DM+h*D;
  const unsigned lds0=(unsigned)(uintptr_t)shm;
  float*wsf=(float*)(shm+LDS_WS)+wid*64;
  const bf16*ksrc=Kh+(long)lane*DM+wid*8;
  const bf16*vsrc=Vh+(long)(16*(wid&3)+(lane>>2))*DM+(wid>>2)*32+(lane&3)*8;
  const unsigned kdst=lds0+LDS_K+wid*1024, vdst=lds0+LDS_V+wid*1024;
  #define DMA_K(t,slot) glds16(ksrc+(long)(t)*KVBLK*DM,(unsigned)__builtin_amdgcn_readfirstlane(kdst+(slot)))
  #define DMA_V(t,slot) glds16(vsrc+(long)(t)*KVBLK*DM,(unsigned)__builtin_amdgcn_readfirstlane(vdst+(slot)))
  const int vb0=(int)(lds0+LDS_V)+((lane>>4)&1)*32+(lane&3)*8+(4*hi+((lane&15)>>2))*64;
  const char*Kbase=shm+LDS_K; bf16x8 kf[8];
  const lds_cptr shm3=(lds_cptr)shm; const lds_cptr kp0=shm3+LDS_K+hi*1024+r32*16; const lds_cptr vp0=shm3+LDS_V+((lane>>4)&1)*32+(lane&3)*8+(4*hi+((lane&15)>>2))*64;
  const int NT=(q0+QB)/KVBLK-t0;
  DMA_K(0,0);DMA_V(0,0);DMA_K(1,SLOTB);
  bf16x8 qr[4];
  #pragma unroll
  for(int d0=0;d0<4;++d0)qr[d0]=*reinterpret_cast<const bf16x8*>(&Qw[(long)r32*DM+d0*16+hi*8]);
  float mhat; { const u32x2_t eq=*(const u32x2_t*)(KBt0+(unsigned)(q0+wid*QBLK+r32)*8u); mhat=__uint_as_float(eq.x<<16)+__uint_as_float(eq.x&0xffff0000u)+__uint_as_float(eq.y<<16); }
  float l_reg=0.f;f32x16 o[2];o[0]=f32x16{};o[1]=f32x16{};const f32x16 negm=f32x16{};
  bf16x8 qx=qref_frag(-mhat,hi);
  const int qrel=wid*QBLK+r32;
  #define CMASK(P0,P1,t) do{int jb_=(t)-(NT-4); if(jb_>=0)cmask(P0,P1,jb_,qrel,hi);}while(0)
  bool resc=false;
  #define START(P0,P1) do{ const float rm=rowmax(P0,P1); resc=false; \
    { const float dl=__builtin_fmaxf(rm,0.f); mhat=fadd_s(mhat,dl); \
      _Pragma("unroll") for(int r=0;r<16;++r){P0[r]=fsub_s(P0[r],dl);P1[r]=fsub_s(P1[r],dl);} \
      qx=qref_frag(-mhat,hi); } \
    _Pragma("unroll") for(int r=0;r<16;++r)P0[r]=__builtin_amdgcn_exp2f(P0[r]); }while(0)
  #define RESC() do{ if(resc){ asm volatile("s_waitcnt lgkmcnt(0)":::"memory"); \
      _Pragma("unroll") for(int d_=0;d_<2;++d_) _Pragma("unroll") for(int r=0;r<16;++r)o[d_][r]*=wsf[crow(r,hi)]; } }while(0)
  f32x16 pA0,pA1,pB0,pB1;
  int sl_prev=0,sl_cur=0,sl_next=SLOTB;
  #define ROT() do{sl_prev=sl_cur;sl_cur=sl_next;sl_next=(sl_next==(NSLOT-1)*SLOTB)?0:sl_next+SLOTB;}while(0)
  DMA_K(2,2*SLOTB);
  WAIT_BAR(3);
  qkt(pA0,pA1,Kbase,qr,mkfrag(*(const u32x2_t*)(KBt+kb_o0),zc),mkfrag(*(const u32x2_t*)(KBt+kb_o1),zc),qx,r32,hi);asm volatile("s_nop 15\n\ts_nop 7":"+v"(pA0),"+v"(pA1));CMASK(pA0,pA1,0);
  START(pA0,pA1);
  _Pragma("unroll") for(int r=0;r<16;++r)pA1[r]=__builtin_amdgcn_exp2f(pA1[r]);
  WAIT_BAR(0);
  DMA_K(3,0);DMA_V(1,SLOTB);
  ROT();
  kload8(kf,kp0+sl_cur);
  WAIT_BAR(2);
  s16x4 vlo[8],vhi[8]; u32x4 pw0,pw1,pw2,pw3;
  #define PKW(P,B) cvtpk_s(P[B],P[B+1])
  #define PAF(k) __builtin_bit_cast(bf16x8,pw##k)
  #define VFR(i) (bf16x8){vlo[i][0],vlo[i][1],vlo[i][2],vlo[i][3],vhi[i][0],vhi[i][1],vhi[i][2],vhi[i][3]}
  #define PIN(x) asm volatile("":"+v"(x))
  #define MX3(a,b,c) __builtin_fmaxf(__builtin_fmaxf((a),(b)),(c))
  #define GAPA(MF,A0,A1,A2,A3,W0,W1,PW) do{ MF; sacc+=A0; sacc+=A1; sacc+=A2; sacc+=A3; PIN(sacc); W0; W1; PIN(PW); SBAR(); }while(0)
  #define EX(v) __builtin_amdgcn_exp2f(v)
  #define GAPB(MF,X,B) do{ MF; X[B]=EX(X[B]); X[B+1]=EX(X[B+1]); X[B+2]=EX(X[B+2]); X[B+3]=EX(X[B+3]); PIN(X); SBAR(); }while(0)
  #define VRD(i) do{ vlo[i]=vtr(vp_+(((i)>>2)*4096+((i)&3)*1024)); vhi[i]=vtr(vp_+(((i)>>2)*4096+((i)&3)*1024+512)); }while(0)
  #define KRD(G,j) do{ if(G){ kload2(kf,kp0+sl_next,j); SBAR(); } }while(0)
  #define STEP(C0,C1,P0,P1,t,GK,GV,GL) do{ SBAR(); \
    const lds_cptr vp_=vp0+sl_prev; const u32x2_t e0_=*(const u32x2_t*)(KBt+kb_o0+(unsigned)(t)*kb_str),e1_=*(const u32x2_t*)(KBt+kb_o1+(unsigned)(t)*kb_str); \
    VRD(0); SBAR(); float sacc=(P0[0]+P0[1]); \
    GAPA(C0=__builtin_amdgcn_mfma_f32_32x32x16_bf16(kf[0],qr[0],negm,0,0,0), P0[2],P0[3],P0[4],P0[5],     pw0[0]=PKW(P0,0), pw0[1]=PKW(P0,2), pw0); \
    VRD(4); SBAR(); GAPA(C1=__builtin_amdgcn_mfma_f32_32x32x16_bf16(kf[1],qr[0],negm,0,0,0), P0[6],P0[7],P0[8],P0[9],     pw0[2]=PKW(P0,4), pw0[3]=PKW(P0,6), pw0); \
    VRD(1); SBAR(); GAPA(C0=__builtin_amdgcn_mfma_f32_32x32x16_bf16(kf[2],qr[1],C0,0,0,0),   P0[10],P0[11],P0[12],P0[13], pw1[0]=PKW(P0,8), pw1[1]=PKW(P0,10), pw1); \
    VRD(5); SBAR(); GAPA(C1=__builtin_amdgcn_mfma_f32_32x32x16_bf16(kf[3],qr[1],C1,0,0,0),   P0[14],P0[15],P1[0],P1[1],   pw1[2]=PKW(P0,12),pw1[3]=PKW(P0,14), pw1); \
    VRD(2); SBAR(); GAPA(C0=__builtin_amdgcn_mfma_f32_32x32x16_bf16(kf[4],qr[2],C0,0,0,0),   P1[2],P1[3],P1[4],P1[5],     pw2[0]=PKW(P1,0), pw2[1]=PKW(P1,2), pw2); \
    VRD(6); SBAR(); GAPA(C1=__builtin_amdgcn_mfma_f32_32x32x16_bf16(kf[5],qr[2],C1,0,0,0),   P1[6],P1[7],P1[8],P1[9],     pw2[2]=PKW(P1,4), pw2[3]=PKW(P1,6), pw2); \
    VRD(3); SBAR(); GAPA(C0=__builtin_amdgcn_mfma_f32_32x32x16_bf16(kf[6],qr[3],C0,0,0,0),   P1[10],P1[11],P1[12],P1[13], pw3[0]=PKW(P1,8), pw3[1]=PKW(P1,10), pw3); \
    VRD(7); SBAR(); GAPA(C1=__builtin_amdgcn_mfma_f32_32x32x16_bf16(kf[7],qr[3],C1,0,0,0),   P1[14],P1[15],0.f,0.f,       pw3[2]=PKW(P1,12),pw3[3]=PKW(P1,14), pw3); \
    { const bf16x8 kb0_=mkfrag(e0_,zc),kb1_=mkfrag(e1_,zc); C0=__builtin_amdgcn_mfma_f32_32x32x16_bf16(kb0_,qx,C0,0,0,0); C1=__builtin_amdgcn_mfma_f32_32x32x16_bf16(kb1_,qx,C1,0,0,0); } SBAR(); \
    l_reg+=sacc; \
    if(GK){DMA_K((t)+3,sl_cur);} if(GV){DMA_V((t)+1,sl_next);} \
    CMASK(C0,C1,t); \
    { float a=MX3(C0[0],C0[1],C1[0]),b=MX3(C0[2],C0[3],C1[1]); a=MX3(a,C1[2],C1[3]); \
      _Pragma("unroll") for(int r=4;r<16;r+=4){a=MX3(a,C0[r],C0[r+1]);b=MX3(b,C0[r+2],C0[r+3]);a=MX3(a,C1[r],C1[r+1]);b=MX3(b,C1[r+2],C1[r+3]);} \
      float rm=__builtin_fmaxf(a,b); { auto rr=__builtin_amdgcn_permlane32_swap(__float_as_uint(rm),__float_as_uint(rm),false,false); rm=__builtin_fmaxf(__uint_as_float(rr[0]),__uint_as_float(rr[1])); } \
      resc=false; \
      if(__builtin_expect(__any(rm>(float)THRL),0)){ const float dl=__builtin_fmaxf(rm,0.f); mhat+=dl; \
        _Pragma("unroll") for(int r=0;r<16;++r){C0[r]-=dl;C1[r]-=dl;} \
        qx=qref_frag(-mhat,hi); \
        const float f=__builtin_amdgcn_exp2f(-dl); l_reg*=f; if(hi==0)wsf[r32]=f; resc=true; } } \
    SBAR(); \
    GAPB(o[0]=__builtin_amdgcn_mfma_f32_32x32x16_bf16(PAF(0),VFR(0),o[0],0,0,0), C0,0); \
    GAPB(o[1]=__builtin_amdgcn_mfma_f32_32x32x16_bf16(PAF(0),VFR(4),o[1],0,0,0), C0,4); \
    KRD(GL,0); GAPB(o[0]=__builtin_amdgcn_mfma_f32_32x32x16_bf16(PAF(1),VFR(1),o[0],0,0,0), C0,8); \
    KRD(GL,1); GAPB(o[1]=__builtin_amdgcn_mfma_f32_32x32x16_bf16(PAF(1),VFR(5),o[1],0,0,0), C0,12); \
    KRD(GL,2); GAPB(o[0]=__builtin_amdgcn_mfma_f32_32x32x16_bf16(PAF(2),VFR(2),o[0],0,0,0), C1,0); \
    KRD(GL,3); GAPB(o[1]=__builtin_amdgcn_mfma_f32_32x32x16_bf16(PAF(2),VFR(6),o[1],0,0,0), C1,4); \
    GAPB(o[0]=__builtin_amdgcn_mfma_f32_32x32x16_bf16(PAF(3),VFR(3),o[0],0,0,0), C1,8); \
    GAPB(o[1]=__builtin_amdgcn_mfma_f32_32x32x16_bf16(PAF(3),VFR(7),o[1],0,0,0), C1,12); \
    }while(0)
  int t=1;
  #undef CMASK
  #define CMASK(P0,P1,t) do{}while(0)
  for(;t+5<NT;t+=2){
    STEP(pB0,pB1,pA0,pA1,t,true,true,true);     WAIT_BAR(2); RESC(); ROT();
    STEP(pA0,pA1,pB0,pB1,t+1,true,true,true);   WAIT_BAR(2); RESC(); ROT();
  }
  #undef CMASK
  #define CMASK(P0,P1,t) do{int jb_=(t)-(NT-4); if(jb_>=0)cmask(P0,P1,jb_,qrel,hi);}while(0)
  #define ENDW(tt) do{ if((tt)+3<NT){WAIT_BAR(2);} else if((tt)+2<NT){WAIT_BAR(1);} else {WAIT_BAR(0);} }while(0)
  for(;t+1<NT;t+=2){
    STEP(pB0,pB1,pA0,pA1,t,(t+3<NT),(t+1<NT),(t+1<NT));       ENDW(t);   RESC(); ROT();
    STEP(pA0,pA1,pB0,pB1,t+1,(t+4<NT),(t+2<NT),(t+2<NT));     ENDW(t+1); RESC(); ROT();
  }
  STEP(pB0,pB1,pA0,pA1,NT-1,false,false,false); RESC();
  { float sacc=pB0[0]+pB0[1]; _Pragma("unroll") for(int r=2;r<16;++r)sacc+=pB0[r]; _Pragma("unroll") for(int r=0;r<16;++r)sacc+=pB1[r]; l_reg+=sacc;
    pw0=(u32x4){PKW(pB0,0),PKW(pB0,2),PKW(pB0,4),PKW(pB0,6)};pw1=(u32x4){PKW(pB0,8),PKW(pB0,10),PKW(pB0,12),PKW(pB0,14)};pw2=(u32x4){PKW(pB1,0),PKW(pB1,2),PKW(pB1,4),PKW(pB1,6)};pw3=(u32x4){PKW(pB1,8),PKW(pB1,10),PKW(pB1,12),PKW(pB1,14)};
    SBAR(); pv(o,vb0+sl_cur,PAF(0),PAF(1),PAF(2),PAF(3)); }
  #undef PKW
  #undef PAF
  #undef VFR
  #undef PIN
  #undef MX3
  #undef GAPA
  #undef GAPB
  #undef EX
  #undef VRD
  #undef KRD
  #undef STEP
  #undef ENDW
  {auto rr=__builtin_amdgcn_permlane32_swap(__float_as_uint(l_reg),__float_as_uint(l_reg),false,false);l_reg=__uint_as_float(rr[0])+__uint_as_float(rr[1]);}
  if(hi==0)wsf[32+r32]=l_reg;asm volatile("s_waitcnt lgkmcnt(0)":::"memory");
  float rli[16];
  #pragma unroll
  for(int r=0;r<16;++r)rli[r]=__builtin_amdgcn_rcpf(wsf[32+crow(r,hi)]);
  bf16*Ow=O+(rowbase+q0+wid*QBLK)*OPITCH+h*D;
  { bf16*stg=(bf16*)(shm+LDS_OST)+wid*2048;
    #pragma unroll
    for(int r=0;r<16;++r){const int orow=crow(r,hi);
      #pragma unroll
      for(int d0=0;d0<2;++d0)stg[orow*64+d0*32+r32]=__float2bfloat16(o[d0][r]*rli[r]);}
    asm volatile("s_waitcnt lgkmcnt(0)":::"memory");
    #pragma unroll
    for(int i=0;i<4;++i){const int row=i*8+(lane>>3),ch=lane&7; const u32x4 v=*(const u32x4*)(stg+row*64+ch*8); ATTN_STORE16(Ow+(long)row*OPITCH+ch*8,v);} }
  asm volatile("s_waitcnt lgkmcnt(0)\n\ts_barrier":::"memory");
  #undef DMA_K
  #undef DMA_V
  #undef CMASK
  #undef START
  #undef RESC
  #undef ROT
}
constexpr int ATTN_LDS_BYTES=LDS_BYTES;
struct AttnTensors { const bf16* Q; const bf16* K; const bf16* V; bf16* O; const float* LF; const unsigned* NRM; };
struct AttnUnit { int bh; int qb; };
struct StaticOrder {
  int vcu,grid;
  __device__ __forceinline__ explicit StaticOrder(int grid_,int block):vcu((grid_%8==0)?(block%8)*(grid_/8)+block/8:block),grid(grid_){}
  __device__ __forceinline__ bool next(int i,AttnUnit&u)const{
    if(grid==256){ if(i>=4)return false; const int s=vcu&3; u.bh=vcu>>2; u.qb=(i==0)?s:(i==1)?7-s:(i==2)?8+s:15-s; return true; }
    const int L=i*grid+vcu; if(L>=BATCH*NHEAD*NQB)return false; u.bh=L/NQB; u.qb=L%NQB; return true; }
  __device__ __forceinline__ void a_ready(const AttnUnit&)const{}
  __device__ __forceinline__ void done(const AttnUnit&)const{}
};
template<class Sched,int THRL=8> __device__ __forceinline__ void attn_phase(char*lds,const AttnTensors&T,const Sched&S){
  AttnUnit u; int cur_bh=-1;
  for(int i=0;S.next(i,u);++i){ S.a_ready(u); if(u.bh!=cur_bh){ fox_bias_table(u.bh/NHEAD,u.bh%NHEAD,T.LF,lds); cur_bh=u.bh; }
    attn_unit<THRL>(u.bh/NHEAD,u.bh%NHEAD,u.qb,T.Q,T.K,T.V,T.O,T.LF,T.NRM,lds); S.done(u); }
}
template<int THRL=8> __device__ __forceinline__ void attn_phase_dyn(char*lds,const AttnTensors&T,unsigned*qhead,volatile int*slot){
  int cur_bh=-1; const int NU=BATCH*NHEAD*NQB;
  if(threadIdx.x==0) slot[0]=(int)__hip_atomic_fetch_add(qhead,1u,__ATOMIC_RELAXED,__HIP_MEMORY_SCOPE_AGENT);
  __syncthreads();
  int idx=__builtin_amdgcn_readfirstlane(slot[0]);
  while(idx<NU){
    __syncthreads();
    if(threadIdx.x==0) slot[0]=(int)__hip_atomic_fetch_add(qhead,1u,__ATOMIC_RELAXED,__HIP_MEMORY_SCOPE_AGENT);
    const int qb=NQB-1-idx/(BATCH*NHEAD), bh=idx%(BATCH*NHEAD);
    if(bh!=cur_bh){ fox_bias_table(bh/NHEAD,bh%NHEAD,T.LF,lds); cur_bh=bh; }
    attn_unit<THRL>(bh/NHEAD,bh%NHEAD,qb,T.Q,T.K,T.V,T.O,T.LF,T.NRM,lds);
    __syncthreads();
    idx=__builtin_amdgcn_readfirstlane(slot[0]);
  }
}
#undef SBAR
#undef WAIT_BAR
}
namespace fx {
using namespace nv;
typedef unsigned short bf16;
typedef unsigned v4u __attribute__((ext_vector_type(4)));
typedef float f32x4 __attribute__((ext_vector_type(4)));
constexpr float C2 = 0.125f * 1.4426950408889634f;
constexpr int NIN = 3328;
constexpr int QKVP = 3072;
constexpr int P_FQ = 0, P_FK = 512, P_FV = 1024, P_GQ = 1536, P_GK = 1792, P_GV = 2048, P_GR = 2560;
__device__ __forceinline__ int inproj_src(int d) {
    if (d < 1536) return d;
    if (d < 1792) return O_GQ + (d - 1536);
    if (d < 2048) return O_GK + (d - 1792);
    if (d < 2560) return O_GV + (d - 2048);
    if (d < 3072) return O_GR + (d - 2560);
    if (d < 3080) return O_FF + (d - 3072);
    if (d < 3096) return O_GA + (d - 3080);
    return -1;
}
__device__ __forceinline__ unsigned f2bf(float f) { unsigned u = __builtin_bit_cast(unsigned, f); return (u + 0x7fffu + ((u >> 16) & 1u)) >> 16; }
__device__ __forceinline__ unsigned pk2(float lo, float hi) { return f2bf(lo) | (f2bf(hi) << 16); }
__device__ __forceinline__ float bf2f(unsigned short h) { return __builtin_bit_cast(float, (unsigned)h << 16); }
__device__ __forceinline__ float wave_sum(float v) {
#pragma unroll
    for (int o = 1; o < 64; o <<= 1) v += __shfl_xor(v, o);
    return v;
}
#define FX_LDS_WAIT() asm volatile("s_waitcnt lgkmcnt(0)" ::: "memory")

template <class Map> __device__ __forceinline__ void transpose_item(const float* __restrict__ W, int K, int N, bf16* WT, LAS float* scr, int kb, int nb, int lane, Map srcmap) {
    const int k0 = 64 * kb, n0 = 32 * nb;
    const int src = srcmap(n0 + (lane & 31));
#pragma unroll 8
    for (int i = 0; i < 32; ++i) { const int kk = 2 * i + (lane >> 5); scr[kk * 33 + (lane & 31)] = (src >= 0) ? W[(size_t)(k0 + kk) * N + src] : 0.f; }
    FX_LDS_WAIT(); asm volatile("" ::: "memory");
    const int c = lane & 7;
#pragma unroll
    for (int j = 0; j < 4; ++j) { const int n = (lane >> 3) + 8 * j; const LAS float* s = scr + (8 * c) * 33 + n;
        v4u o; o.x = pk2(s[0 * 33], s[1 * 33]); o.y = pk2(s[2 * 33], s[3 * 33]); o.z = pk2(s[4 * 33], s[5 * 33]); o.w = pk2(s[6 * 33], s[7 * 33]);
        *(GAS v4u*)(WT + (size_t)(n0 + n) * K + k0 + 8 * c) = o; }
    FX_LDS_WAIT(); asm volatile("" ::: "memory");
}

__device__ __forceinline__ void ln_row_bf16(const float* xrow, const float* __restrict__ g, const float* __restrict__ b, bf16* orow, float* frow, float* st, int lane) {
    const GAS f32x4* xr = (const GAS f32x4*)xrow + lane;
    f32x4 v[4]; float s = 0.f;
#pragma unroll
    for (int j = 0; j < 4; ++j) { v[j] = xr[64 * j]; s += (v[j].x + v[j].y) + (v[j].z + v[j].w); }
    const float mean = wave_sum(s) * (1.f / D); float s2 = 0.f;
#pragma unroll
    for (int j = 0; j < 4; ++j) { v[j] = v[j] - mean; s2 += (v[j].x * v[j].x + v[j].y * v[j].y) + (v[j].z * v[j].z + v[j].w * v[j].w); }
    const float rstd = 1.f / sqrtf(wave_sum(s2) * (1.f / D) + LN_EPS);
    if (st && lane == 0) { st[0] = mean; st[1] = rstd; }
    GAS unsigned long long* o8 = (GAS unsigned long long*)orow + lane;
#pragma unroll
    for (int j = 0; j < 4; ++j) {
        const f32x4 gg = ((const f32x4*)g)[lane + 64 * j], bb = ((const f32x4*)b)[lane + 64 * j];
        const f32x4 o = v[j] * rstd * gg + bb;
        o8[64 * j] = (unsigned long long)pk2(o.x, o.y) | ((unsigned long long)pk2(o.z, o.w) << 32);
        if (frow) ((GAS f32x4*)frow)[lane + 64 * j] = o;
    }
}

struct CvItem { const float* W; bf16* WT; int N, K, k0, n0, s0; };
__device__ __forceinline__ void cv_load(const CvItem& it, f32x4 (&v)[8], int lane) {
    const float* p = it.W + (size_t)(it.k0 + (lane >> 3)) * it.N + it.s0 + 4 * (lane & 7);
#pragma unroll
    for (int i = 0; i < 8; ++i) v[i] = __builtin_nontemporal_load((const f32x4*)(p + (size_t)(8 * i) * it.N));
}
__device__ __forceinline__ void cv_finish(const CvItem& it, const f32x4 (&v)[8], LAS float* scr, int lane) {
    const int rr = lane >> 3, cq = lane & 7;
#pragma unroll
    for (int i = 0; i < 8; ++i) { LAS float* d = scr + (8 * i + rr) * 33 + 4 * cq; d[0] = v[i][0]; d[1] = v[i][1]; d[2] = v[i][2]; d[3] = v[i][3]; }
    FX_LDS_WAIT(); asm volatile("" ::: "memory");
    const int c = lane & 7;
#pragma unroll
    for (int j = 0; j < 4; ++j) { const int n = (lane >> 3) + 8 * j; const LAS float* s = scr + (8 * c) * 33 + n;
        v4u o; o.x = pk2(s[0 * 33], s[1 * 33]); o.y = pk2(s[2 * 33], s[3 * 33]); o.z = pk2(s[4 * 33], s[5 * 33]); o.w = pk2(s[6 * 33], s[7 * 33]);
        __builtin_nontemporal_store(o, (GAS v4u*)(it.WT + (size_t)(it.n0 + n) * it.K + it.k0 + 8 * c)); }
    FX_LDS_WAIT(); asm volatile("" ::: "memory");
}

template <int NR> __device__ __forceinline__ void ln_rows_bf16(const float* xrows, const float* __restrict__ g, const float* __restrict__ b, bf16* orows, int lane) {
    f32x4 v[NR][4];
#pragma unroll
    for (int r = 0; r < NR; ++r)
#pragma unroll
        for (int j = 0; j < 4; ++j) v[r][j] = ((const GAS f32x4*)(xrows + (size_t)r * D))[lane + 64 * j];
    f32x4 gg[4], bb[4];
#pragma unroll
    for (int j = 0; j < 4; ++j) { gg[j] = ((const f32x4*)g)[lane + 64 * j]; bb[j] = ((const f32x4*)b)[lane + 64 * j]; }
#pragma unroll
    for (int r = 0; r < NR; ++r) {
        float s = 0.f;
#pragma unroll
        for (int j = 0; j < 4; ++j) s += (v[r][j].x + v[r][j].y) + (v[r][j].z + v[r][j].w);
        const float mean = wave_sum(s) * (1.f / D); float s2 = 0.f;
#pragma unroll
        for (int j = 0; j < 4; ++j) { v[r][j] = v[r][j] - mean; s2 += (v[r][j].x * v[r][j].x + v[r][j].y * v[r][j].y) + (v[r][j].z * v[r][j].z + v[r][j].w * v[r][j].w); }
        const float rstd = 1.f / sqrtf(wave_sum(s2) * (1.f / D) + LN_EPS);
        GAS unsigned long long* o8 = (GAS unsigned long long*)(orows + (size_t)r * D) + lane;
#pragma unroll
        for (int j = 0; j < 4; ++j) { const f32x4 o = v[r][j] * rstd * gg[j] + bb[j];
            o8[64 * j] = (unsigned long long)pk2(o.x, o.y) | ((unsigned long long)pk2(o.z, o.w) << 32); }
    }
}

template <int NR> __device__ __forceinline__ void ln1_rows_bf16(const float* xrows, const float* st, const float* __restrict__ gi, const float* __restrict__ bi, const bf16* mixrows,
                                                               const float* __restrict__ g1, const float* __restrict__ b1, bf16* orows, float alpha, int lane) {
    f32x4 v[NR][4]; unsigned long long mx[NR][4]; float mean0[NR], rstd0[NR];
#pragma unroll
    for (int r = 0; r < NR; ++r) { mean0[r] = st[2 * r]; rstd0[r] = st[2 * r + 1];
#pragma unroll
        for (int j = 0; j < 4; ++j) { v[r][j] = ((const GAS f32x4*)(xrows + (size_t)r * D))[lane + 64 * j]; mx[r][j] = ((const GAS unsigned long long*)(mixrows + (size_t)r * D))[lane + 64 * j]; } }
    f32x4 gi4[4], bi4[4];
#pragma unroll
    for (int j = 0; j < 4; ++j) { gi4[j] = ((const f32x4*)gi)[lane + 64 * j] * alpha; bi4[j] = ((const f32x4*)bi)[lane + 64 * j] * alpha; }
#pragma unroll
    for (int r = 0; r < NR; ++r) {
        float s = 0.f;
#pragma unroll
        for (int j = 0; j < 4; ++j) { const unsigned lo = (unsigned)mx[r][j], hi = (unsigned)(mx[r][j] >> 32);
            f32x4 mv; mv.x = __builtin_bit_cast(float, lo << 16); mv.y = __builtin_bit_cast(float, lo & 0xffff0000u); mv.z = __builtin_bit_cast(float, hi << 16); mv.w = __builtin_bit_cast(float, hi & 0xffff0000u);
            v[r][j] = ((v[r][j] - mean0[r]) * rstd0[r]) * gi4[j] + bi4[j] + mv;
            s += (v[r][j].x + v[r][j].y) + (v[r][j].z + v[r][j].w); }
        const float mean = wave_sum(s) * (1.f / D); float s2 = 0.f;
#pragma unroll
        for (int j = 0; j < 4; ++j) { v[r][j] = v[r][j] - mean; s2 += (v[r][j].x * v[r][j].x + v[r][j].y * v[r][j].y) + (v[r][j].z * v[r][j].z + v[r][j].w * v[r][j].w); }
        const float rstd = 1.f / sqrtf(wave_sum(s2) * (1.f / D) + LN_EPS);
        GAS unsigned long long* o8 = (GAS unsigned long long*)(orows + (size_t)r * D) + lane;
#pragma unroll
        for (int j = 0; j < 4; ++j) { const f32x4 gg = ((const f32x4*)g1)[lane + 64 * j], bb = ((const f32x4*)b1)[lane + 64 * j]; const f32x4 o = v[r][j] * rstd * gg + bb;
            o8[64 * j] = (unsigned long long)pk2(o.x, o.y) | ((unsigned long long)pk2(o.z, o.w) << 32); }
    }
}
}

namespace pg8 {
struct EpiInProj {
    static constexpr bool PERM = true, AFTER_DRAIN = false;
    bf16_t* QKV; float* FG; float* LF; const float* bfg; unsigned* NRM;
    __device__ __forceinline__ void operator()(const f32x4 (&acc)[2][2][4][2], const Unit& u, int wr, int wc, int fr, int fq) const {
        const int row0 = u.pm * BM + wr * 64 + fr;
        if (u.pn < 12) {
            const float sc = (u.pn < 2) ? fx::C2 : 1.f;
            const int col0 = u.pn * BM + wc * 32 + 8 * fq;
            float nmax[2] = {0.f, 0.f};
#pragma unroll
            for (int ai = 0; ai < 2; ++ai)
#pragma unroll
                for (int m = 0; m < 4; ++m) { bf16_t* rowp = QKV + (size_t)(row0 + ai * HALF + m * 16) * fx::QKVP + col0;
#pragma unroll
                    for (int bj = 0; bj < 2; ++bj) { const f32x4 v0 = acc[ai][bj][m][0] * sc, v1 = acc[ai][bj][m][1] * sc;
                        u32x4 w; w.x = cvt_pk_bf16(v0[0], v0[1]); w.y = cvt_pk_bf16(v0[2], v0[3]); w.z = cvt_pk_bf16(v1[0], v1[1]); w.w = cvt_pk_bf16(v1[2], v1[3]);
                        *(u32x4*)(rowp + bj * HALF) = w;
                        if (u.pn < 4) { const f32x4 q0 = v0 * v0, q1 = v1 * v1; float s = (q0[0] + q0[1]) + (q0[2] + q0[3]) + (q1[0] + q1[1]) + (q1[2] + q1[3]);
                            s += __shfl_xor(s, 16); s += __shfl_xor(s, 32);
                            nmax[bj] = fmaxf(nmax[bj], s); } } }
            if (u.pn < 4) {
#pragma unroll
                for (int bj = 0; bj < 2; ++bj) { float s = nmax[bj];
#pragma unroll
                    for (int o = 1; o < 16; o <<= 1) s = fmaxf(s, __shfl_xor(s, o));
                    if (fr == 0 && fq == 0) { const int b = (u.pm * BM) >> 12, head = 4 * (u.pn & 1) + 2 * bj + (wc >> 1);
                        atomicMax(NRM + (b * 8 + head) * 4 + (u.pn >= 2 ? 2 : 0) + (wc & 1), __builtin_bit_cast(unsigned, s)); } }
            }
        } else if (wc == 0 && fq < 3) {
#pragma unroll
            for (int ai = 0; ai < 2; ++ai)
#pragma unroll
                for (int m = 0; m < 4; ++m) { const int row = row0 + ai * HALF + m * 16; float* p = FG + (size_t)row * 32 + 8 * fq;
                    *(f32x4*)p = acc[ai][0][m][0]; *(f32x4*)(p + 4) = acc[ai][0][m][1];
                    if (fq == 0) { const int b = row >> 12, s = row & 4095;
#pragma unroll
                        for (int n = 0; n < 2; ++n)
#pragma unroll
                            for (int i = 0; i < 4; ++i) { const int h = 4 * n + i; LF[(size_t)(b * 8 + h) * nv::S + s] = 1.4426950408889634f * nv::logsigmoidf(acc[ai][0][m][n][i] + bfg[h]); } } }
        }
    }
};
}
namespace gl {
using namespace nv;
typedef unsigned short bf16;
typedef short bf16x8 __attribute__((ext_vector_type(8)));
typedef float f32x4 __attribute__((ext_vector_type(4)));
typedef unsigned u32x4 __attribute__((ext_vector_type(4)));
typedef unsigned u32x2 __attribute__((ext_vector_type(2)));
constexpr int NCH = S / 64;
constexpr int NUNIT = B * GH * NCH;
constexpr int LS = 72;
constexpr int L_WGU = 0, L_BG = 4096, L_DECS = 4352, L_QP = 8192, L_KP = L_QP + 64 * LS * 2, L_KPT = L_KP + 64 * LS * 2, L_VT = L_KPT + 64 * LS * 2, L_PP = L_VT + 128 * LS * 2, L_WT = L_PP + 64 * LS * 2, L_END = L_WT + 2048;
static_assert(L_END <= 131072, "gla prep LDS");
constexpr int C_ST = 0, C_PART = 128 * LS * 2, C_END = C_PART + 2 * 8 * 64 * 4;
constexpr size_t QPG_B = 64 * 64 * 2, OI_B = 8 * 4 * 64 * 16, UU_B = OI_B, DEC_B = 256;

__device__ __forceinline__ unsigned pkbf(float lo, float hi) { typedef float f2 __attribute__((ext_vector_type(2))); typedef __bf16 b2 __attribute__((ext_vector_type(2))); f2 v = {lo, hi}; b2 r = __builtin_convertvector(v, b2); return __builtin_bit_cast(unsigned, r); }
__device__ __forceinline__ float bf2f(unsigned short h) { return __builtin_bit_cast(float, (unsigned)h << 16); }
__device__ __forceinline__ float bflo(unsigned w) { return __builtin_bit_cast(float, w << 16); }
__device__ __forceinline__ float bfhi(unsigned w) { return __builtin_bit_cast(float, w & 0xffff0000u); }
__device__ __forceinline__ float fast_logsig2(float x) { return -__builtin_amdgcn_logf(1.f + __builtin_amdgcn_exp2f(-1.4426950408889634f * x)); }

__device__ __forceinline__ void prep_unit(int unit, const bf16* QKV, const float* FG, const float* __restrict__ wgu, const float* __restrict__ bgate,
                                          unsigned char* QPG, unsigned char* OI, unsigned char* UU, float* DEC, unsigned char* lds, int& cur_h, f32x4 (&Sagg)[4], f32x4 (&Dagg)[4]) {
    int tid_ = threadIdx.x; asm volatile("" : "+v"(tid_));
    const int tid = tid_, lane = tid & 63, wid = __builtin_amdgcn_readfirstlane(tid >> 6), l15 = lane & 15, g = lane >> 4;
    const int n = unit % NCH, bh = unit / NCH, h = bh % GH, b = bh / GH;
    const size_t row0 = (size_t)b * S + (size_t)n * 64;
    float* WGU = (float*)(lds + L_WGU); float* BG = (float*)(lds + L_BG); float* WT = (float*)(lds + L_WT);
    bf16* QP = (bf16*)(lds + L_QP); bf16* KP = (bf16*)(lds + L_KP); bf16* KPT = (bf16*)(lds + L_KPT); bf16* VT = (bf16*)(lds + L_VT); bf16* PP = (bf16*)(lds + L_PP);
    if (cur_h != h) { __syncthreads(); for (int i = tid; i < 16 * 64; i += 512) WGU[i] = wgu[(i >> 6) * 256 + h * 64 + (i & 63)]; if (tid < 64) BG[tid] = bgate[h * 64 + tid]; cur_h = h; __syncthreads(); }
    const int t = tid >> 3, oc = tid & 7, d0 = oc * 8;
    float la[8];
    { const float* gp = FG + (row0 + t) * 32 + 8;
      f32x4 ga4[4];
#pragma unroll
      for (int i = 0; i < 4; ++i) ga4[i] = *(const f32x4*)(gp + 4 * i);
#pragma unroll
      for (int j = 0; j < 8; ++j) la[j] = BG[d0 + j];
#pragma unroll
      for (int r = 0; r < 16; ++r) { const float gv = ga4[r >> 2][r & 3]; const f32x4 w0 = *(const f32x4*)(WGU + r * 64 + d0), w1 = *(const f32x4*)(WGU + r * 64 + d0 + 4);
#pragma unroll
          for (int j = 0; j < 4; ++j) { la[j] += gv * w0[j]; la[4 + j] += gv * w1[j]; } }
#pragma unroll
      for (int j = 0; j < 8; ++j) la[j] = fast_logsig2(la[j]) * (1.f / 16.f); }
    const u32x4 qv = *(const u32x4*)(QKV + (row0 + t) * fx::QKVP + fx::P_GQ + h * 64 + d0);
    const u32x4 kv = *(const u32x4*)(QKV + (row0 + t) * fx::QKVP + fx::P_GK + h * 64 + d0);
    const u32x4 vv0 = *(const u32x4*)(QKV + (row0 + t) * fx::QKVP + fx::P_GV + h * 128 + oc * 16);
    const u32x4 vv1 = *(const u32x4*)(QKV + (row0 + t) * fx::QKVP + fx::P_GV + h * 128 + oc * 16 + 8);
#pragma unroll
    for (int off = 8; off < 64; off <<= 1) {
#pragma unroll
        for (int j = 0; j < 8; ++j) { const float o = __shfl_up(la[j], off); if (lane >= off) la[j] += o; } }
    if (lane >= 56) {
#pragma unroll
        for (int j = 0; j < 8; ++j) WT[wid * 64 + d0 + j] = la[j]; }
    __syncthreads();
    float bl[8];
#pragma unroll
    for (int j = 0; j < 8; ++j) bl[j] = 0.f;
#pragma unroll
    for (int w = 0; w < 8; ++w) {
        const f32x4 a0 = *(const f32x4*)(WT + w * 64 + d0), a1 = *(const f32x4*)(WT + w * 64 + d0 + 4);
#pragma unroll
        for (int j = 0; j < 4; ++j) { bl[j] += a0[j]; bl[4 + j] += a1[j]; if (w < wid) { la[j] += a0[j]; la[4 + j] += a1[j]; } } }
    {
        const unsigned qw[4] = {qv.x, qv.y, qv.z, qv.w}, kw[4] = {kv.x, kv.y, kv.z, kv.w};
        float qf[8], kf[8];
#pragma unroll
        for (int i = 0; i < 4; ++i) { qf[2 * i] = bflo(qw[i]); qf[2 * i + 1] = bfhi(qw[i]); kf[2 * i] = bflo(kw[i]); kf[2 * i + 1] = bfhi(kw[i]); }
        float qp[8], kp[8], kpp[8];
#pragma unroll
        for (int j = 0; j < 8; ++j) { const float bb = la[j], bbl = bl[j];
            qp[j] = qf[j] * (0.125f * __builtin_amdgcn_exp2f(bb)); kp[j] = kf[j] * __builtin_amdgcn_exp2f(-bb); kpp[j] = kf[j] * __builtin_amdgcn_exp2f(bbl - bb); }
        u32x4 qo, ko; qo.x = pkbf(qp[0], qp[1]); qo.y = pkbf(qp[2], qp[3]); qo.z = pkbf(qp[4], qp[5]); qo.w = pkbf(qp[6], qp[7]);
        ko.x = pkbf(kp[0], kp[1]); ko.y = pkbf(kp[2], kp[3]); ko.z = pkbf(kp[4], kp[5]); ko.w = pkbf(kp[6], kp[7]);
        *(u32x4*)(QP + t * LS + d0) = qo; *(u32x4*)(KP + t * LS + d0) = ko;
        *(u32x4*)(QPG + (size_t)unit * QPG_B + (size_t)(t * 64 + d0) * 2) = qo;
#pragma unroll
        for (int j = 0; j < 8; ++j) KPT[(d0 + j) * LS + t] = (bf16)(pkbf(kpp[j], 0.f) & 0xffffu);
        const unsigned vw[8] = {vv0.x, vv0.y, vv0.z, vv0.w, vv1.x, vv1.y, vv1.z, vv1.w};
#pragma unroll
        for (int i = 0; i < 8; ++i) { VT[(oc * 16 + 2 * i) * LS + t] = (bf16)(vw[i] & 0xffffu); VT[(oc * 16 + 2 * i + 1) * LS + t] = (bf16)(vw[i] >> 16); }
        if (t == 0) {
#pragma unroll
            for (int j = 0; j < 8; ++j) { const float dc = __builtin_amdgcn_exp2f(bl[j]); DEC[(size_t)unit * 64 + d0 + j] = dc; ((float*)(lds + L_DECS))[d0 + j] = dc; } }
    }
    __syncthreads();
    { const int ti = wid >> 1;
#pragma unroll
      for (int q2 = 0; q2 < 2; ++q2) { const int sj = 2 * (wid & 1) + q2;
          f32x4 acc = {0.f, 0.f, 0.f, 0.f};
          if (sj <= ti) {
#pragma unroll
              for (int ks = 0; ks < 2; ++ks) { const bf16x8 a = *(const bf16x8*)(QP + (16 * ti + l15) * LS + 32 * ks + 8 * g), bb = *(const bf16x8*)(KP + (16 * sj + l15) * LS + 32 * ks + 8 * g);
                  acc = __builtin_amdgcn_mfma_f32_16x16x32_bf16(a, bb, acc, 0, 0, 0); }
              if (sj == ti) {
#pragma unroll
                  for (int r = 0; r < 4; ++r) if (l15 > 4 * g + r) acc[r] = 0.f; }
          }
#pragma unroll
          for (int r = 0; r < 4; ++r) PP[(16 * ti + 4 * g + r) * LS + 16 * sj + l15] = (bf16)(pkbf(acc[r], 0.f) & 0xffffu);
      } }
    __syncthreads();
    { bf16x8 vb[2];
#pragma unroll
      for (int ks = 0; ks < 2; ++ks) vb[ks] = *(const bf16x8*)(VT + (16 * wid + l15) * LS + 32 * ks + 8 * g);
#pragma unroll
      for (int m = 0; m < 4; ++m) { f32x4 acc = {0.f, 0.f, 0.f, 0.f};
#pragma unroll
          for (int ks = 0; ks < 2; ++ks) { const bf16x8 a = *(const bf16x8*)(PP + (16 * m + l15) * LS + 32 * ks + 8 * g); acc = __builtin_amdgcn_mfma_f32_16x16x32_bf16(a, vb[ks], acc, 0, 0, 0); }
          *(f32x4*)(OI + (size_t)unit * OI_B + (size_t)((wid * 4 + m) * 64 + lane) * 16) = acc; }
#pragma unroll
      for (int db = 0; db < 4; ++db) { f32x4 acc = {0.f, 0.f, 0.f, 0.f};
#pragma unroll
          for (int ks = 0; ks < 2; ++ks) { const bf16x8 a = *(const bf16x8*)(KPT + (16 * db + l15) * LS + 32 * ks + 8 * g); acc = __builtin_amdgcn_mfma_f32_16x16x32_bf16(a, vb[ks], acc, 0, 0, 0); }
          *(f32x4*)(UU + (size_t)unit * UU_B + (size_t)((wid * 4 + db) * 64 + lane) * 16) = acc;
          const f32x4 dcv = *(const f32x4*)((const float*)(lds + L_DECS) + 16 * db + 4 * g);
          Sagg[db] = dcv * Sagg[db] + acc; Dagg[db] = Dagg[db] * dcv; }
    }
}


__device__ __forceinline__ void prep_block(int blk, const bf16* QKV, const float* FG, const float* __restrict__ wgu, const float* __restrict__ bgate,
                                           unsigned char* QPG, unsigned char* OI, unsigned char* UU, float* DEC, unsigned char* AGG, float* DAGG, unsigned char* lds, int& cur_h) {
    f32x4 Sagg[4], Dagg[4];
#pragma unroll
    for (int db = 0; db < 4; ++db) { Sagg[db] = (f32x4){0.f, 0.f, 0.f, 0.f}; Dagg[db] = (f32x4){1.f, 1.f, 1.f, 1.f}; }
    for (int i = 0; i < 8; ++i) prep_unit(blk * 8 + i, QKV, FG, wgu, bgate, QPG, OI, UU, DEC, lds, cur_h, Sagg, Dagg);
    int tid_ = threadIdx.x; asm volatile("" : "+v"(tid_));
    const int lane = tid_ & 63, wid = __builtin_amdgcn_readfirstlane(tid_ >> 6), l15 = lane & 15, g = lane >> 4;
#pragma unroll
    for (int db = 0; db < 4; ++db) { *(f32x4*)(AGG + (size_t)blk * UU_B + (size_t)((wid * 4 + db) * 64 + lane) * 16) = Sagg[db];
        if (wid == 0 && l15 == 0) *(f32x4*)(DAGG + (size_t)blk * 64 + 16 * db + 4 * g) = Dagg[db]; }
}
constexpr int GS = 136;
constexpr int PO_GR = 0, PO_YT = 64 * GS * 2, PO_PART = 2 * 64 * GS * 2, PO_ST = PO_PART + 8 * 64 * 4, PO_END = PO_ST + 128 * LS * 2;
__device__ __forceinline__ void post_block(int u0, int NB, const bf16* QKV, const unsigned char* QPG, const unsigned char* OI, const unsigned char* UU, const float* DEC, const unsigned char* AGG, const float* DAGG, const float* __restrict__ gnorm, bf16* Y, unsigned char* lds) {
    int tid_ = threadIdx.x; asm volatile("" : "+v"(tid_));
    const int tid = tid_, lane = tid & 63, wid = __builtin_amdgcn_readfirstlane(tid >> 6), l15 = lane & 15, g = lane >> 4;
    const int n0 = u0 % NCH, bh = u0 / NCH, h = bh % GH, b = bh / GH;
    bf16* GRs = (bf16*)(lds + PO_GR); bf16* YT = (bf16*)(lds + PO_YT); float* PART = (float*)(lds + PO_PART); bf16* ST = (bf16*)(lds + PO_ST);
    const int t = tid >> 3, oc = tid & 7, e = 16 * wid + l15;
    const float gn = gnorm[e];
    f32x4 Sa[4];
#pragma unroll
    for (int db = 0; db < 4; ++db) Sa[db] = (f32x4){0.f, 0.f, 0.f, 0.f};
    { const int seg0 = bh * (NCH / 8), nseg = n0 / 8;
      for (int i = 0; i < nseg; ++i) {
          f32x4 Ua[4], Da[4];
#pragma unroll
          for (int db = 0; db < 4; ++db) { Ua[db] = *(const f32x4*)(AGG + (size_t)(seg0 + i) * UU_B + (size_t)((wid * 4 + db) * 64 + lane) * 16); Da[db] = *(const f32x4*)(DAGG + (size_t)(seg0 + i) * 64 + 16 * db + 4 * g); }
#pragma unroll
          for (int db = 0; db < 4; ++db) Sa[db] = Da[db] * Sa[db] + Ua[db]; } }
    for (int i = 0; i < NB; ++i) {
        const int unit = u0 + i; const size_t row0 = (size_t)b * S + (size_t)(n0 + i) * 64;
        const u32x4 g0 = *(const u32x4*)(QKV + (row0 + t) * fx::QKVP + fx::P_GR + h * 128 + oc * 16), g1 = *(const u32x4*)(QKV + (row0 + t) * fx::QKVP + fx::P_GR + h * 128 + oc * 16 + 8);
        f32x4 o[4], Uf[4], dv[4]; bf16x8 qa[4][2], sb[2];
#pragma unroll
        for (int m = 0; m < 4; ++m) { o[m] = *(const f32x4*)(OI + (size_t)unit * OI_B + (size_t)((wid * 4 + m) * 64 + lane) * 16);
            Uf[m] = *(const f32x4*)(UU + (size_t)unit * UU_B + (size_t)((wid * 4 + m) * 64 + lane) * 16); dv[m] = *(const f32x4*)(DEC + (size_t)unit * 64 + 16 * m + 4 * g);
#pragma unroll
            for (int ks = 0; ks < 2; ++ks) qa[m][ks] = *(const bf16x8*)(QPG + (size_t)unit * QPG_B + (size_t)((16 * m + l15) * 64 + 32 * ks + 8 * g) * 2); }
#pragma unroll
        for (int db = 0; db < 4; ++db) *(u32x2*)(ST + e * LS + 16 * db + 4 * g) = (u32x2){pkbf(Sa[db][0], Sa[db][1]), pkbf(Sa[db][2], Sa[db][3])};
#pragma unroll
        for (int ks = 0; ks < 2; ++ks) sb[ks] = *(const bf16x8*)(ST + e * LS + 32 * ks + 8 * g);
        *(u32x4*)(GRs + t * GS + oc * 16) = g0; *(u32x4*)(GRs + t * GS + oc * 16 + 8) = g1;
#pragma unroll
        for (int m = 0; m < 4; ++m)
#pragma unroll
            for (int ks = 0; ks < 2; ++ks) o[m] = __builtin_amdgcn_mfma_f32_16x16x32_bf16(qa[m][ks], sb[ks], o[m], 0, 0, 0);
#pragma unroll
        for (int m = 0; m < 4; ++m) { f32x4 q = o[m] * o[m];
#pragma unroll
            for (int off = 1; off < 16; off <<= 1) { q[0] += __shfl_xor(q[0], off); q[1] += __shfl_xor(q[1], off); q[2] += __shfl_xor(q[2], off); q[3] += __shfl_xor(q[3], off); }
            if (l15 == 0) *(f32x4*)(PART + wid * 64 + 16 * m + 4 * g) = q; }
#pragma unroll
        for (int db = 0; db < 4; ++db) Sa[db] = dv[db] * Sa[db] + Uf[db];
        __syncthreads();
#pragma unroll
        for (int m = 0; m < 4; ++m) { f32x4 tot = {0.f, 0.f, 0.f, 0.f};
#pragma unroll
            for (int w = 0; w < 8; ++w) tot += *(const f32x4*)(PART + w * 64 + 16 * m + 4 * g);
#pragma unroll
            for (int r = 0; r < 4; ++r) { const int tt = 16 * m + 4 * g + r; const float rs = rsqrtf(tot[r] * (1.f / GV) + LN_EPS); const float gr = bf2f(GRs[tt * GS + e]);
                const float v = o[m][r] * rs * gn * (gr * __builtin_amdgcn_rcpf(1.f + __builtin_amdgcn_exp2f(-1.4426950408889634f * gr)));
                YT[tt * GS + e] = (bf16)(pkbf(v, 0.f) & 0xffffu); } }
        __syncthreads();
        { const u32x4 y0 = *(const u32x4*)(YT + t * GS + oc * 16), y1 = *(const u32x4*)(YT + t * GS + oc * 16 + 8);
          *(u32x4*)(Y + (row0 + t) * D + 512 + h * GV + oc * 16) = y0; *(u32x4*)(Y + (row0 + t) * D + 512 + h * GV + oc * 16 + 8) = y1; }
        __syncthreads();
    }
}
}
namespace mo {
using namespace nv;
typedef unsigned short bf16;
typedef float f32x4 __attribute__((ext_vector_type(4)));
typedef unsigned u32x4 __attribute__((ext_vector_type(4)));
constexpr int CAP = 8192;
constexpr int NEX = NE + 1;
constexpr int YSH = T * TOPK;
constexpr int L_TB = 132096, L_YB = L_TB + 1040, L_CN = L_YB + 1040, L_UT = 138240, L_RG = 141312;
typedef LAS int* lint;


constexpr int I_EG = NEX * 256, I_ED = NEX * 128, I_EXP = I_EG + I_ED;
struct ExpW { const float* eg; const float* eu; const float* ed; const float* sg; const float* su; const float* sd; bf16* WegT; bf16* WedT; };
__device__ __forceinline__ void cv_decode(int r, const ExpW& X, fx::CvItem& I) {
    if (r < I_EG) { const int e = r >> 8, kb = (r >> 4) & 15, nb = r & 15, c = nb >> 3, sub = nb & 7;
        I.W = (e < NE) ? ((sub < 4 ? X.eg : X.eu) + (size_t)e * D * ED) : (sub < 4 ? X.sg : X.su); I.WT = X.WegT + (size_t)e * 512 * D; I.N = ED; I.K = D; I.k0 = 64 * kb; I.n0 = 32 * nb; I.s0 = 128 * c + 32 * (sub & 3); }
    else { r -= I_EG; const int e = r >> 7, kb = (r >> 5) & 3, nb = r & 31; I.W = (e < NE) ? (X.ed + (size_t)e * ED * D) : X.sd; I.WT = X.WedT + (size_t)e * D * ED; I.N = D; I.K = ED; I.k0 = 64 * kb; I.n0 = 32 * nb; I.s0 = 32 * nb; }
}
__device__ __forceinline__ void expert_conv(const ExpW& X, LAS float* scr, int it0, int step, int lane) {
    int it = it0; fx::CvItem cur, nx; fx::f32x4 v[8], w[8];
    if (it < I_EXP) { cv_decode(it, X, cur); fx::cv_load(cur, v, lane); }
    while (it < I_EXP) { const int itn = it + step; if (itn < I_EXP) { cv_decode(itn, X, nx); fx::cv_load(nx, w, lane); }
        fx::cv_finish(cur, v, scr, lane); cur = nx;
#pragma unroll
        for (int i = 0; i < 8; ++i) v[i] = w[i];
        it = itn; }
}

__device__ __forceinline__ void moe_tables(const int* counts, lint tb, lint yb, lint cn, int lane) {
    int c[4], nt[4]; int st = 0, sy = 0, pt[4], py[4];
#pragma unroll
    for (int i = 0; i < 4; ++i) { c[i] = counts[lane * 4 + i]; c[i] = c[i] > CAP ? CAP : c[i]; nt[i] = (c[i] + 255) >> 8; pt[i] = st; py[i] = sy; st += nt[i]; sy += c[i]; }
    int it = st, iy = sy;
    for (int o = 1; o < 64; o <<= 1) { const int a = __shfl_up(it, o), b = __shfl_up(iy, o); if (lane >= o) { it += a; iy += b; } }
    const int bt = it - st, by = iy - sy;
#pragma unroll
    for (int i = 0; i < 4; ++i) { tb[lane * 4 + i] = bt + pt[i]; yb[lane * 4 + i] = by + py[i]; cn[lane * 4 + i] = c[i]; }
    if (lane == 63) { tb[256] = it; tb[257] = it + T / 256; yb[256] = YSH; cn[256] = T; }
}

__device__ __forceinline__ void route_token2(const float* LG, const float* __restrict__ rbias, int* lcnt, int* TK, float* TW, int t0, int lane) {
    const int l32 = lane & 31, hb = lane & 32, t = t0 + (lane >> 5);
    const float4 la = ((const float4*)(LG + (size_t)t * NE))[2 * l32], lb = ((const float4*)(LG + (size_t)t * NE))[2 * l32 + 1];
    const float4 ra = ((const float4*)rbias)[2 * l32], rb = ((const float4*)rbias)[2 * l32 + 1];
    const float lg[8] = {la.x, la.y, la.z, la.w, lb.x, lb.y, lb.z, lb.w}, rbv[8] = {ra.x, ra.y, ra.z, ra.w, rb.x, rb.y, rb.z, rb.w};
    float sc[8], bv[8];
#pragma unroll
    for (int i = 0; i < 8; ++i) { sc[i] = 1.f / (1.f + expf(-lg[i])); bv[i] = sc[i] + rbv[i]; }
    float m1 = fmaxf(bv[0], bv[1]), m2 = fminf(bv[0], bv[1]);
#pragma unroll
    for (int i = 2; i < 8; ++i) { const float n1 = fmaxf(m1, bv[i]); m2 = fmaxf(fminf(m1, bv[i]), m2); m1 = n1; }
#pragma unroll
    for (int o = 1; o < 4; o <<= 1) { const float p1 = __shfl_xor(m1, o), p2 = __shfl_xor(m2, o); const float n1 = fmaxf(m1, p1); m2 = fmaxf(fminf(m1, p1), fmaxf(m2, p2)); m1 = n1; }
    const float gs = m1 + m2;
    const int myg = l32 >> 2;
    int rank = 0;
#pragma unroll
    for (int g2 = 0; g2 < NG; ++g2) { const float og = __shfl(gs, hb + g2 * 4); if (og > gs || (og == gs && g2 < myg)) ++rank; }
    const bool sel = rank < 4;
    float mv[8];
#pragma unroll
    for (int i = 0; i < 8; ++i) mv[i] = sel ? bv[i] : -INFINITY;
    int mye = 0; float myw = 0.f; float wsum = 0.f;
#pragma unroll
    for (int k = 0; k < TOPK; ++k) {
        float bvv = mv[0]; int bi = 0;
#pragma unroll
        for (int i = 1; i < 8; ++i) if (mv[i] > bvv) { bvv = mv[i]; bi = i; }
        int gi = l32 * 8 + bi;
#pragma unroll
        for (int o = 16; o > 0; o >>= 1) { const float ov = __shfl_xor(bvv, o); const int oi = __shfl_xor(gi, o); if (ov > bvv || (ov == bvv && oi < gi)) { bvv = ov; gi = oi; } }
        const int ol = gi >> 3, oi = gi & 7;
        float s_own = sc[0];
#pragma unroll
        for (int i = 1; i < 8; ++i) s_own = (oi == i) ? sc[i] : s_own;
        const float sw = __shfl(s_own, hb + ol);
        if (l32 == ol) {
#pragma unroll
            for (int i = 0; i < 8; ++i) if (oi == i) mv[i] = -INFINITY; }
        if (l32 == k) { mye = gi; myw = sw; } wsum += sw;
    }
    if (l32 < TOPK) { const int lp = atomicAdd(&lcnt[mye], 1); TK[t * TOPK + l32] = mye | (lp << 9); TW[t * TOPK + l32] = myw * (2.5f / wsum); }
}
__device__ __forceinline__ void route_finish2(const int* lbase, int* list_tok, float* list_gate, int* TK, const float* TW, int t0, int lane) {
    const int l32 = lane & 31, t = t0 + (lane >> 5);
    if (l32 < TOPK) { const int tk = TK[t * TOPK + l32]; const int e = tk & 511, pos = lbase[e] + (tk >> 9);
        if (pos < CAP) { list_tok[e * CAP + pos] = t; list_gate[e * CAP + pos] = TW[t * TOPK + l32]; }
        TK[t * TOPK + l32] = e | (pos << 9); }
}

constexpr float YSC = 16.f;
__device__ __forceinline__ void combine_token(const bf16* H1, const unsigned char* Y, const int* TK, lint yb, const float* __restrict__ g, const float* __restrict__ b, float* out, int t, int lane) {
    typedef float f2 __attribute__((ext_vector_type(2)));
    float v[16], s[16];
    { const u32x4 a = *(const u32x4*)(H1 + (size_t)t * D + 16 * lane), c = *(const u32x4*)(H1 + (size_t)t * D + 16 * lane + 8);
      const unsigned w[8] = {a.x, a.y, a.z, a.w, c.x, c.y, c.z, c.w};
#pragma unroll
      for (int i = 0; i < 8; ++i) { v[2 * i] = ALPHA * __builtin_bit_cast(float, w[i] << 16); v[2 * i + 1] = ALPHA * __builtin_bit_cast(float, w[i] & 0xffff0000u); } }
#pragma unroll
    for (int i = 0; i < 16; ++i) s[i] = 0.f;
    int tk = (lane < TOPK) ? TK[t * TOPK + lane] : 0;
#pragma unroll
    for (int k = 0; k <= TOPK; ++k) {
        size_t yrow;
        if (k < TOPK) { const int x = __shfl(tk, k); yrow = (size_t)(yb[x & 511] + (x >> 9)); } else yrow = (size_t)YSH + t;
        const u32x4 a = *(const u32x4*)(Y + yrow * D + 16 * lane);
        const int w[4] = {(int)a.x, (int)a.y, (int)a.z, (int)a.w};
#pragma unroll
        for (int i = 0; i < 4; ++i) { const f2 lo = __builtin_amdgcn_cvt_pk_f32_fp8(w[i], false), hi = __builtin_amdgcn_cvt_pk_f32_fp8(w[i], true);
            s[4 * i] += lo[0]; s[4 * i + 1] += lo[1]; s[4 * i + 2] += hi[0]; s[4 * i + 3] += hi[1]; }
    }
    float sm = 0.f;
#pragma unroll
    for (int i = 0; i < 16; ++i) { v[i] += s[i] * (1.f / YSC); sm += v[i]; }
    const float mean = fx::wave_sum(sm) * (1.f / D); float q = 0.f;
#pragma unroll
    for (int i = 0; i < 16; ++i) { v[i] -= mean; q += v[i] * v[i]; }
    const float rstd = 1.f / sqrtf(fx::wave_sum(q) * (1.f / D) + LN_EPS);
#pragma unroll
    for (int i = 0; i < 4; ++i) { const f32x4 gg = *(const f32x4*)(g + 16 * lane + 4 * i), bb = *(const f32x4*)(b + 16 * lane + 4 * i);
        f32x4 o; o[0] = v[4 * i] * rstd * gg[0] + bb[0]; o[1] = v[4 * i + 1] * rstd * gg[1] + bb[1]; o[2] = v[4 * i + 2] * rstd * gg[2] + bb[2]; o[3] = v[4 * i + 3] * rstd * gg[3] + bb[3];
        *(f32x4*)(out + (size_t)t * D + 16 * lane + 4 * i) = o; }
}
}

namespace pg8 {
struct RouterSched {
    int rb; const bf16_t* Bt;
    __device__ __forceinline__ bool next(int i, Unit2& u) const { if (i > 0) return false; u.pm = rb; u.pn = 0; u.e = 0; u.cnt = 128; u.jt = 0; u.ui = 0; return true; }
    __device__ __forceinline__ int arow(const Unit2& u, int r) const { return u.pm * 128 + r; }
    __device__ __forceinline__ size_t aoff(const Unit2&) const { return 0; }
    __device__ __forceinline__ const char* bptr(const Unit2&) const { return (const char*)Bt; }
};
struct EpiLogits {
    static constexpr bool PERM = false, AFTER_DRAIN = false;
    float* LG;
    __device__ __forceinline__ void operator()(const f32x4 (&acc)[2][2][4][2], const Unit2& u, int wr, int wc, int fr, int fq) const {
        const int row0 = u.pm * 128 + wr * 64 + fr, col0 = wc * 32 + 4 * fq;
#pragma unroll
        for (int m = 0; m < 4; ++m) { float* rowp = LG + (size_t)(row0 + m * 16) * nv::NE + col0;
#pragma unroll
            for (int bj = 0; bj < 2; ++bj)
#pragma unroll
                for (int n = 0; n < 2; ++n) *(f32x4*)(rowp + bj * HALF + n * 16) = acc[0][bj][m][n]; }
    }
};
template <int PH> struct MoeSched {
    int G, vcu, nrt; mo::lint tb; mo::lint cn; const int* list_tok; const bf16_t* W; mo::lint ut; mo::lint rg;
    static constexpr int NC = PH == 0 ? 2 : 4;
    static constexpr int MAXU = 64;
    __device__ __forceinline__ void build(int lane) const {
        const int L = lane * G + vcu;
        if (lane < MAXU && L < nrt * NC) {
            const int rt = L / NC, c = L % NC;
            int lo = 0, hi = 256;
            while (lo < hi) { const int mid = (lo + hi + 1) >> 1; if (tb[mid] <= rt) lo = mid; else hi = mid - 1; }
            const int e = lo, jt = rt - tb[e], rem = cn[e] - 256 * jt;
            ut[4 * lane] = rt; ut[4 * lane + 1] = c; ut[4 * lane + 2] = e | (jt << 9); ut[4 * lane + 3] = rem < 256 ? rem : 256;
        }
    }
    __device__ __forceinline__ bool next(int i, Unit2& u) const {
        const int L = i * G + vcu; if (i >= MAXU || L >= nrt * NC) return false;
        const int x = ut[4 * i + 2];
        u.pm = __builtin_amdgcn_readfirstlane(ut[4 * i]); u.pn = __builtin_amdgcn_readfirstlane(ut[4 * i + 1]); u.e = __builtin_amdgcn_readfirstlane(x & 511); u.jt = __builtin_amdgcn_readfirstlane(x >> 9);
        u.cnt = __builtin_amdgcn_readfirstlane(ut[4 * i + 3]); u.ui = i; return true;
    }
    __device__ __forceinline__ void fill_rows(const float* list_gate, int tid) const {
        for (int i = 0; i < MAXU; ++i) { const int L = i * G + vcu; if (L >= nrt * NC) break;
            const int x = ut[4 * i + 2], e = x & 511, jt = x >> 9, cnt = ut[4 * i + 3];
            if (tid < 256) { const int r = tid; unsigned v;
                if (e == 256) v = (unsigned)(jt * BM + r) | (0x4180u << 16);
                else if (r < cnt) { const float gsc = mo::YSC * list_gate[e * mo::CAP + jt * BM + r]; v = (unsigned)list_tok[e * mo::CAP + jt * BM + r] | (fx::f2bf(gsc) << 16); }
                else v = 0u;
                rg[i * 256 + r] = (int)v; } }
    }
    __device__ __forceinline__ int arow(const Unit2& u, int r) const {
        if (PH == 1) return u.pm * BM + r;
        return rg[u.ui * 256 + r] & 0x7fff;
    }
    __device__ __forceinline__ size_t aoff(const Unit2& u) const { return PH == 1 ? (size_t)u.pm * (131072 - 32768) : 0; }
    __device__ __forceinline__ const char* bptr(const Unit2& u) const {
        return PH == 0 ? (const char*)(W + ((size_t)u.e * 512 + 256 * u.pn) * 1024) : (const char*)(W + ((size_t)u.e * 1024 + 256 * u.pn) * 256);
    }
};
struct EpiSwiGLU {
    static constexpr bool PERM = true, AFTER_DRAIN = false;
    bf16_t* H; mo::lint rg; int skip;
    __device__ __forceinline__ void operator()(const f32x4 (&acc)[2][2][4][2], const Unit2& u, int wr, int wc, int fr, int fq) const {
        if (skip) return;
        const int col0 = u.pn * 128 + wc * 32 + 8 * fq;
#pragma unroll
        for (int ai = 0; ai < 2; ++ai)
#pragma unroll
            for (int m = 0; m < 4; ++m) { const int r = ai * HALF + wr * 64 + m * 16 + fr;
                const float gt = __builtin_bit_cast(float, (unsigned)rg[u.ui * 256 + r] & 0xffff0000u);
                float hv[8];
#pragma unroll
                for (int n = 0; n < 2; ++n)
#pragma unroll
                    for (int i = 0; i < 4; ++i) { const float gg = acc[ai][0][m][n][i], uu = acc[ai][1][m][n][i]; hv[4 * n + i] = gt * uu * (gg * __builtin_amdgcn_rcpf(1.f + __builtin_amdgcn_exp2f(-1.4426950408889634f * gg))); }
                u32x4 w; w.x = cvt_pk_bf16(hv[0], hv[1]); w.y = cvt_pk_bf16(hv[2], hv[3]); w.z = cvt_pk_bf16(hv[4], hv[5]); w.w = cvt_pk_bf16(hv[6], hv[7]);
                *(u32x4*)(H + (size_t)u.pm * 65536 + (size_t)(col0 >> 6) * 16384 + r * 64 + (col0 & 63)) = w; }
    }
};
struct EpiDown {
    static constexpr bool PERM = true, AFTER_DRAIN = false;
    unsigned char* Y; mo::lint yb; int skip;
    __device__ __forceinline__ void operator()(const f32x4 (&acc)[2][2][4][2], const Unit2& u, int wr, int wc, int fr, int fq) const {
        if (skip) return;
        typedef unsigned u32x2v __attribute__((ext_vector_type(2)));
        const int col0 = u.pn * BM + wc * 32 + 8 * fq; const int ybase = yb[u.e] + u.jt * BM;
#pragma unroll
        for (int ai = 0; ai < 2; ++ai)
#pragma unroll
            for (int m = 0; m < 4; ++m) { const int r = ai * HALF + wr * 64 + m * 16 + fr;
                if (r < u.cnt) { unsigned char* rowp = Y + (size_t)(ybase + r) * nv::D + col0;
#pragma unroll
                    for (int bj = 0; bj < 2; ++bj) { const f32x4 v0 = acc[ai][bj][m][0], v1 = acc[ai][bj][m][1];
                        int w0 = __builtin_amdgcn_cvt_pk_fp8_f32(v0[0], v0[1], 0, false); w0 = __builtin_amdgcn_cvt_pk_fp8_f32(v0[2], v0[3], w0, true);
                        int w1 = __builtin_amdgcn_cvt_pk_fp8_f32(v1[0], v1[1], 0, false); w1 = __builtin_amdgcn_cvt_pk_fp8_f32(v1[2], v1[3], w1, true);
                        *(u32x2v*)(rowp + bj * HALF) = (u32x2v){(unsigned)w0, (unsigned)w1}; } } }
    }
};
}
constexpr int NTHR = 512;
constexpr int LDS_BYTES = 163840;
constexpr int MISC_OFF = 131072 + 320;
constexpr size_t MiB = 1u << 20;
constexpr size_t CTL_ZERO_BYTES = 96 * 1024;
constexpr int CW_BAR = 4096;
constexpr int CW_MOE = 16384;
constexpr int CW_FOXQ = 20992;
constexpr int CW_NRM = 20480;
constexpr int NPHASE = 9;
constexpr size_t WS_H1 = 1, WS_WR = 65, WS_STATS = 66, WS_LF = 67, WS_FG = 68, WS_WO = 72, WS_WIN = 74, WS_TK = 81, WS_LTOK = 83, WS_LGATE = 91,
                 WS_WED = 100, WS_HID = 230, WS_GLA = 230, WS_WEG = 416, WS_XN = 673, WS_YBF = 673, WS_QKV = 737, WS_Z1 = 737, WS_LG = 865, WS_Y = 416, WS_END = 992;

struct Args { const float* in[21]; float* out; unsigned char* ws; int ph_lo, ph_hi, li, pad; };

__global__ void __launch_bounds__(NTHR, 2) mega_fwd(Args a) {
    using namespace nv;
    extern __shared__ __attribute__((aligned(16))) unsigned char lds[];
    const int G = gridDim.x, bx = blockIdx.x;
    const int vcu = (G % 8 == 0) ? (bx % 8) * (G / 8) + bx / 8 : bx;
    int tid, lane, wave, vw;
#define DERIVE() do { int t_ = threadIdx.x; asm volatile("" : "+v"(t_)); tid = t_; lane = tid & 63; wave = __builtin_amdgcn_readfirstlane(tid >> 6); vw = vcu * 8 + wave; } while (0)
    DERIVE();
    volatile LAS unsigned* MISC = (volatile LAS unsigned*)((LAS unsigned char*)lds + MISC_OFF);
    for (int u = tid; u < (LDS_BYTES - 131072) / 4; u += NTHR) ((LAS unsigned*)((LAS unsigned char*)lds + 131072))[u] = 0u;
    __syncthreads();
    unsigned char* ws = a.ws;
    unsigned* ctl = (unsigned*)ws;
    XcdBarrier bar = xcd_barrier_post(ctl + CW_BAR + a.li * XCD_BAR_WORDS, MISC + 8);
    const float* x = a.in[0];
    const float* ln_in_g = a.in[1]; const float* ln_in_b = a.in[2];
    const float* w_in = a.in[3]; const float* b_fgate = a.in[4];
    const float* w_gate_up = a.in[5]; const float* b_gate = a.in[6]; const float* g_gla = a.in[7];
    const float* w_out = a.in[8]; const float* ln1_g = a.in[9]; const float* ln1_b = a.in[10];
    const float* w_router = a.in[11]; const float* rbias = a.in[12];
    const float* w_eg = a.in[13]; const float* w_eu = a.in[14]; const float* w_ed = a.in[15];
    const float* w_sg = a.in[16]; const float* w_su = a.in[17]; const float* w_sd = a.in[18];
    const float* ln2_g = a.in[19]; const float* ln2_b = a.in[20];
    float* out = a.out;
    int* counts = (int*)(ctl + CW_MOE);
    fx::bf16* H1 = (fx::bf16*)(ws + WS_H1 * MiB);
    fx::bf16* WrT = (fx::bf16*)(ws + WS_WR * MiB);
    float* stats = (float*)(ws + WS_STATS * MiB);
    float* LF = (float*)(ws + WS_LF * MiB);
    float* FG = (float*)(ws + WS_FG * MiB);
    fx::bf16* WoT = (fx::bf16*)(ws + WS_WO * MiB);
    fx::bf16* WinT = (fx::bf16*)(ws + WS_WIN * MiB);
    int* TK = (int*)(ws + WS_TK * MiB);
    float* TW = (float*)(ws + (WS_TK + 1) * MiB);
    int* list_tok = (int*)(ws + WS_LTOK * MiB);
    float* list_gate = (float*)(ws + WS_LGATE * MiB);
    fx::bf16* WedT = (fx::bf16*)(ws + WS_WED * MiB);
    fx::bf16* HID = (fx::bf16*)(ws + WS_HID * MiB);
    unsigned char* QPG = ws + WS_GLA * MiB; unsigned char* OIb = ws + (WS_GLA + 16) * MiB; unsigned char* UUb = ws + (WS_GLA + 80) * MiB; float* DECb = (float*)(ws + (WS_GLA + 144) * MiB); unsigned char* AGGb = ws + (WS_GLA + 145) * MiB; float* DAGGb = (float*)(ws + (WS_GLA + 153) * MiB);
    fx::bf16* WegT = (fx::bf16*)(ws + WS_WEG * MiB);
    fx::bf16* XN = (fx::bf16*)(ws + WS_XN * MiB);
    fx::bf16* Ybf = (fx::bf16*)(ws + WS_YBF * MiB);
    fx::bf16* QKV = (fx::bf16*)(ws + WS_QKV * MiB);
    fx::bf16* MIX = (fx::bf16*)(ws + WS_Z1 * MiB);
    float* LG = (float*)(ws + WS_LG * MiB);
    unsigned char* YA = ws + WS_Y * MiB;
    mo::lint tb = (mo::lint)((LAS unsigned char*)lds + mo::L_TB), yb = (mo::lint)((LAS unsigned char*)lds + mo::L_YB), cn = (mo::lint)((LAS unsigned char*)lds + mo::L_CN), ut = (mo::lint)((LAS unsigned char*)lds + mo::L_UT), rg = (mo::lint)((LAS unsigned char*)lds + mo::L_RG);

    const int lo = a.ph_lo, hi = a.ph_hi;
#define IN(k) (lo <= (k) && (k) < hi)
#define SEAM(k) do { if (IN(k) && IN((k) + 1)) xcd_barrier(bar); DERIVE(); } while (0)
    const int GW = G * 8;
#ifndef STG7
#define STG7 0
#endif
#ifndef STG8
#define STG8 0
#endif
#define STAGGER(q) do { if ((q) > 0) { const unsigned long long t0_ = __builtin_amdgcn_s_memrealtime(); const unsigned long long d_ = (unsigned long long)((vcu & 3) * (q)); while (__builtin_amdgcn_s_memrealtime() - t0_ < d_) __builtin_amdgcn_s_sleep(8); } } while (0)

    if (IN(0)) {
        LAS float* scr = (LAS float*)((LAS unsigned char*)lds + wave * 16384);
        constexpr int I_IN = 16 * (fx::NIN / 32), I_OUT = 16 * 32, I_R = 16 * 8, I_SMALL = I_IN + I_OUT + I_R;
        for (int it = vw; it < I_SMALL; it += GW) {
            int r = it;
            if (r < I_IN) { fx::transpose_item(w_in, D, INW, WinT, scr, r / (fx::NIN / 32), r % (fx::NIN / 32), lane, [](int d) { return fx::inproj_src(d); }); continue; } r -= I_IN;
            if (r < I_OUT) { fx::transpose_item(w_out, D, D, WoT, scr, r / 32, r % 32, lane, [](int d) { return d; }); continue; } r -= I_OUT;
            fx::transpose_item(w_router, D, NE, WrT, scr, r / 8, r % 8, lane, [](int d) { return d; });
        }
        for (int r = vw; r < T; r += GW) fx::ln_row_bf16(x + (size_t)r * D, ln_in_g, ln_in_b, XN + (size_t)r * D, nullptr, stats + 2 * (size_t)r, lane);
    }
    SEAM(0);
    if (IN(1)) {
        const mo::ExpW XW{w_eg, w_eu, w_ed, w_sg, w_su, w_sd, WegT, WedT};
#ifndef MIXG
#define MIXG 2
#endif
        { const int slot = vcu % MIXG; pg8::StaticOrder S; S.init(T, fx::NIN, G, bx);
          const int nun = (S.nwg - bx + G - 1) / G, nb = (MIXG > 1) ? nun * slot / (MIXG - 1) : nun;
          pg8::Gemm g{XN, WinT, T, fx::NIN, D, D}; pg8::EpiInProj E{QKV, FG, LF, b_fgate, ctl + CW_NRM};
          if (nb > 0) { pg8::RangeOrder R{S, 0, nb}; pg8::gemm_phase<pg8::EpiInProj, pg8::RangeOrder, true, true>((LAS unsigned char*)lds, g, R, E); DERIVE(); }
          mo::expert_conv(XW, (LAS float*)((LAS unsigned char*)lds + wave * 16384), vw, GW, lane); __syncthreads(); DERIVE();
          if (nb < nun) { pg8::RangeOrder R{S, nb, nun - nb}; pg8::gemm_phase<pg8::EpiInProj, pg8::RangeOrder, true, true>((LAS unsigned char*)lds, g, R, E); } }
    }
    SEAM(1);
    if (IN(2)) {
        int cur_h = -1;
        for (int blk = vcu; blk < gl::NUNIT / 8; blk += G) gl::prep_block(blk, QKV, FG, w_gate_up, b_gate, QPG, OIb, UUb, DECb, AGGb, DAGGb, lds, cur_h);
    }
    SEAM(2);
    if (IN(3)) {
        for (int blk = vcu; blk < gl::NUNIT / 8; blk += G) gl::post_block(blk * 8, 8, QKV, QPG, OIb, UUb, DECb, AGGb, DAGGb, g_gla, Ybf, lds);
        { const attn_body::AttnTensors AT{(const attn_body::bf16*)(QKV + fx::P_FQ), (const attn_body::bf16*)(QKV + fx::P_FK), (const attn_body::bf16*)(QKV + fx::P_FV), (attn_body::bf16*)Ybf, LF, ctl + CW_NRM};
          attn_body::attn_phase_dyn<8>((char*)lds, AT, ctl + CW_FOXQ, (volatile int*)(lds + 140288)); }
    }
    SEAM(3);
    if (IN(4)) {
        pg8::DenseSched DS; DS.so.init(T, D, G, bx); DS.Bt = WoT; DS.ldb = D;
        pg8::EpiPlainBf16 E{MIX, D};
        pg8::gemm_phase2<pg8::EpiPlainBf16, pg8::DenseSched>((LAS unsigned char*)lds, Ybf, D, D, D, DS, E);
    }
    SEAM(4);
    if (IN(5)) {
        int* lcnt = (int*)(lds + 136192); int* lbase = lcnt + 256;
        for (int rb = vcu; rb < T / 128; rb += G) {
            if (tid < 256) lcnt[tid] = 0;
            for (int r = wave * 16; r < wave * 16 + 16; r += 4) { const size_t row = (size_t)rb * 128 + r;
                fx::ln1_rows_bf16<4>(x + row * D, stats + 2 * row, ln_in_g, ln_in_b, MIX + row * D, ln1_g, ln1_b, H1 + row * D, ALPHA, lane); }
            asm volatile("s_waitcnt vmcnt(0)" ::: "memory"); __syncthreads();
            { pg8::RouterSched RS{rb, WrT}; pg8::EpiLogits E{LG};
              pg8::gemm_phase2<pg8::EpiLogits, pg8::RouterSched>((LAS unsigned char*)lds, H1, D, D, D, RS, E); }
            DERIVE();
            for (int t = rb * 128 + wave * 2; t < rb * 128 + 128; t += 16) mo::route_token2(LG, rbias, lcnt, TK, TW, t, lane);
            __syncthreads();
            if (tid < 256) { const int c = lcnt[tid]; lbase[tid] = c ? atomicAdd(&counts[tid], c) : 0; }
            __syncthreads();
            for (int t = rb * 128 + wave * 2; t < rb * 128 + 128; t += 16) mo::route_finish2(lbase, list_tok, list_gate, TK, TW, t, lane);
            __syncthreads();
        }
    }
    SEAM(5);
    if (IN(6)) {
        if (wave == 0) mo::moe_tables(counts, tb, yb, cn, lane);
        __syncthreads();
        STAGGER(STG7);
        pg8::MoeSched<0> MS{G, vcu, tb[257], tb, cn, list_tok, WegT, ut, rg}; if (wave == 0) MS.build(lane); __syncthreads(); MS.fill_rows(list_gate, tid); __syncthreads(); pg8::EpiSwiGLU E{HID, rg, a.pad};
        pg8::gemm_phase2<pg8::EpiSwiGLU, pg8::MoeSched<0>>((LAS unsigned char*)lds, H1, D, D, D, MS, E);
    }
    SEAM(6);
    if (IN(7)) {
        if (wave == 0) mo::moe_tables(counts, tb, yb, cn, lane);
        __syncthreads();
        STAGGER(STG8);
        pg8::MoeSched<1> MS{G, vcu, tb[257], tb, cn, list_tok, WedT, ut, rg}; if (wave == 0) MS.build(lane); __syncthreads(); pg8::EpiDown E{YA, yb, a.pad};
        pg8::gemm_phase2<pg8::EpiDown, pg8::MoeSched<1>>((LAS unsigned char*)lds, HID, 64, ED, ED, MS, E, 32768);
    }
    SEAM(7);
    if (IN(8)) {
        if (wave == 0) mo::moe_tables(counts, tb, yb, cn, lane);
        __syncthreads();
        for (int t = vw; t < T; t += GW) mo::combine_token(H1, YA, TK, yb, ln2_g, ln2_b, out, t, lane);
    }
#undef IN
#undef SEAM
}

extern "C" void kernel_launch(void* const* d_in, const int* in_sizes, int n_in, void* d_out, int out_size, void* d_ws, size_t ws_size, hipStream_t stream) {
    static int grid = 0;
    if (grid == 0) {
        if (n_in != 21 || out_size != nv::T * nv::D || ws_size < WS_END * MiB) { fprintf(stderr, "kernel_launch: unexpected shapes n_in=%d out=%d ws=%zu\n", n_in, out_size, ws_size); grid = -1; return; }
        int dev = 0, cus = 0;
        if (hipGetDevice(&dev) != hipSuccess || hipDeviceGetAttribute(&cus, hipDeviceAttributeMultiprocessorCount, dev) != hipSuccess) { grid = -1; return; }
        if (hipFuncSetAttribute((const void*)mega_fwd, hipFuncAttributeMaxDynamicSharedMemorySize, LDS_BYTES) != hipSuccess) { fprintf(stderr, "kernel_launch: hipFuncSetAttribute failed\n"); grid = -1; return; }
        grid = cus;
    }
    if (grid < 0) return;
    if (hipMemsetAsync(d_ws, 0, CTL_ZERO_BYTES, stream) != hipSuccess) return;
    Args a{};
    for (int i = 0; i < 21; ++i) a.in[i] = (const float*)d_in[i];
    a.out = (float*)d_out; a.ws = (unsigned char*)d_ws; a.ph_lo = 0; a.ph_hi = NPHASE; a.li = 0;
#ifdef REPEAT_PH
    a.ph_hi = REPEAT_PH + 1; hipLaunchKernelGGL(mega_fwd, dim3(grid), dim3(NTHR), LDS_BYTES, stream, a);
    if (REPEAT_PH == 3) hipMemsetAsync((char*)d_ws + CW_FOXQ * 4, 0, 256, stream);
    if (REPEAT_PH == 5) hipMemsetAsync((char*)d_ws + CW_MOE * 4, 0, 4096, stream);
    a.ph_lo = REPEAT_PH; a.ph_hi = NPHASE; a.li = 1;
#ifdef REPEAT_NOEPI
    a.ph_hi = REPEAT_PH + 1; a.pad = 1; hipLaunchKernelGGL(mega_fwd, dim3(grid), dim3(NTHR), LDS_BYTES, stream, a); a.pad = 0; a.ph_lo = REPEAT_PH + 1; a.ph_hi = NPHASE; a.li = 2;
#endif
#endif
    hipLaunchKernelGGL(mega_fwd, dim3(grid), dim3(NTHR), LDS_BYTES, stream, a);
}
```

```cpp
#include <hip/hip_runtime.h>
#include <cstdio>
#include <cstdint>
#include <cmath>

#define LAS __attribute__((address_space(3)))
#define GAS __attribute__((address_space(1)))

#define XB_TMO      128
#define XB_XCNT(j)  (256  + 64 * (j))
#define XB_XSUB(j)  (1280 + 64 * (j))
#define XB_XGEN(j)  (2304 + 64 * (j))
#define XB_TOP      3328
#define XB_TOPGEN   3392
#define XCD_BAR_WORDS 3456
#define XB_SPIN_CAP (1u << 27)
__device__ __forceinline__ unsigned xb_ld(unsigned* p)              { return __hip_atomic_load(p, __ATOMIC_RELAXED, __HIP_MEMORY_SCOPE_AGENT); }
__device__ __forceinline__ unsigned xb_add(unsigned* p, unsigned v) { return __hip_atomic_fetch_add(p, v, __ATOMIC_RELAXED, __HIP_MEMORY_SCOPE_AGENT); }
__device__ __forceinline__ unsigned xb_xcc_id() { return (unsigned)__builtin_amdgcn_s_getreg((3 << 11) | 20) & 0xFu; }
#define XB_SPIN(cond, bar) do { unsigned _sp = 0; while (cond) { __builtin_amdgcn_s_sleep(1); \
    if ((++_sp & 255u) == 0u) { if (xb_ld(&(bar)[XB_TMO])) break; if (_sp > XB_SPIN_CAP) { atomicAdd(&(bar)[XB_TMO], 1u); break; } } } } while (0)
struct XcdBarrier { unsigned* bar; unsigned x; volatile LAS unsigned* st; };
__device__ __forceinline__ XcdBarrier xcd_barrier_post(unsigned* bar, volatile LAS unsigned* st) {
    XcdBarrier b; b.bar = bar; b.x = xb_xcc_id(); b.st = st;
    if (threadIdx.x == 0) (void)xb_add(&bar[XB_XCNT(b.x)], 1u);
    return b;
}
__device__ __forceinline__ void xcd_barrier_complete(unsigned* bar, unsigned x, unsigned& nloc, unsigned& nx) {
    const unsigned G = gridDim.x * gridDim.y * gridDim.z;
    unsigned sum, cnt, mine, sp = 0u;
    for (;;) {
        sum = 0u; cnt = 0u; mine = 0u;
#pragma unroll
        for (unsigned j = 0; j < 16; ++j) { const unsigned c = xb_ld(&bar[XB_XCNT(j)]); sum += c; cnt += (c > 0u) ? 1u : 0u; mine = (j == x) ? c : mine; }
        if (sum == G) break;
        __builtin_amdgcn_s_sleep(1);
        if ((++sp & 255u) == 0u) { if (xb_ld(&bar[XB_TMO])) break; if (sp > XB_SPIN_CAP) { atomicAdd(&bar[XB_TMO], 1u); break; } }
    }
    nloc = mine > 0u ? mine : 1u; nx = cnt > 0u ? cnt : 1u;
}
__device__ __forceinline__ void xcd_barrier(const XcdBarrier& b) {
    asm volatile("s_waitcnt vmcnt(0)" ::: "memory");
    __syncthreads();
    if (threadIdx.x == 0) {
        unsigned* bar = b.bar;
        __builtin_amdgcn_s_waitcnt(0);
        unsigned nloc = b.st[0], nx = b.st[1];
        if (nloc == 0u) { xcd_barrier_complete(bar, b.x, nloc, nx); b.st[0] = nloc; b.st[1] = nx; }
        const unsigned old = xb_add(&bar[XB_XSUB(b.x)], 1u);
        const unsigned gen = old / nloc;
        if (old + 1u == (gen + 1u) * nloc) {
            __builtin_amdgcn_fence(__ATOMIC_RELEASE, "agent");
            asm volatile("s_waitcnt vmcnt(0)" ::: "memory");
            const unsigned og = xb_add(&bar[XB_TOP], 1u);
            const unsigned tg = og / nx;
            if (og + 1u == (tg + 1u) * nx) xb_add(&bar[XB_TOPGEN], 1u);
            else XB_SPIN(xb_ld(&bar[XB_TOPGEN]) == tg, bar);
            __builtin_amdgcn_fence(__ATOMIC_ACQUIRE, "agent");
            xb_add(&bar[XB_XGEN(b.x)], 1u);
            asm volatile("s_waitcnt vmcnt(0)" ::: "memory");
        } else {
            XB_SPIN(xb_ld(&bar[XB_XGEN(b.x)]) == gen, bar);
            __builtin_amdgcn_fence(__ATOMIC_ACQUIRE, "agent");
            asm volatile("s_waitcnt vmcnt(0)" ::: "memory");
        }
    }
    __syncthreads();
}
namespace pg8 {
#define PG8_LAS __attribute__((address_space(3)))
typedef unsigned short bf16_t;
typedef short bf16x8 __attribute__((ext_vector_type(8)));
typedef float f32x4 __attribute__((ext_vector_type(4)));
typedef unsigned u32x4 __attribute__((ext_vector_type(4)));
constexpr int BM = 256, BK = 64, HALF = 128, HTB = HALF * BK * 2  , STAGE_BYTES = 8 * HTB, NXCD = 8, WGM = 8;

__host__ __device__ __forceinline__ int lds_byte(int r, int c) { const int st = (r >> 4) * 2 + (c >> 5), rr = r & 15, cc = c & 31, ob = rr * 64 + cc * 2; return st * 1024 + (ob ^ (((ob >> 9) & 1) << 5)); }
__host__ __device__ __forceinline__ void stage_rc(int b, int& R, int& C) { const int st = b / 1024, sb = b % 1024, swz = sb ^ (((sb >> 9) & 1) << 5); R = (st >> 1) * 16 + swz / 64; C = (st & 1) * 32 + (swz % 64) / 2; }
__host__ __device__ __forceinline__ int perm32(int rho) { const int n = rho >> 4, i = rho & 15; return 8 * (i >> 2) + 4 * n + (i & 3); }

struct Unit { int pm, pn; };
struct Gemm { const bf16_t* A; const bf16_t* Bt; int M, N, K, lda; };

struct StaticOrder {
    int nM, nN, nwg, G, c;
    __host__ __device__ void init(int M, int N, int G_, int c_) { nM = M / BM; nN = N / BM; nwg = nM * nN; G = G_; c = c_; }
    __host__ __device__ bool next(int i, Unit& u) const {
        const long L = (long)i * G + c; if (L >= nwg) return false;
        int wgid = (int)L; { const int q = nwg / NXCD, r = nwg % NXCD, xcd = wgid % NXCD, off = wgid / NXCD; wgid = (xcd < r ? xcd * (q + 1) : r * (q + 1) + (xcd - r) * q) + off; }
        const int nig = WGM * nN, gid = wgid / nig, fm = gid * WGM, gsz = (nM - fm) < WGM ? (nM - fm) : WGM;
        u.pm = fm + ((wgid % nig) % gsz); u.pn = (wgid % nig) / gsz; return true;
    }
    __device__ __forceinline__ void a_ready(const Unit&) const {}
    __device__ __forceinline__ void done(const Unit&) const {}
};

struct RangeOrder {
    StaticOrder so; int i0, n;
    __host__ __device__ bool next(int i, Unit& u) const { return i < n && so.next(i0 + i, u); }
    __device__ __forceinline__ void a_ready(const Unit&) const {}
    __device__ __forceinline__ void done(const Unit&) const {}
};
__device__ __forceinline__ unsigned cvt_pk_bf16(float lo, float hi) { unsigned r; asm volatile("v_cvt_pk_bf16_f32 %0, %1, %2" : "=v"(r) : "v"(lo), "v"(hi)); return r; }
typedef float f32x2 __attribute__((ext_vector_type(2)));
__device__ __forceinline__ f32x2 gelu_pk(f32x2 v) {
    const f32x2 av = __builtin_elementwise_abs(v), d = av * 0.2316418882f + 1.0f;
    f32x2 t; t.x = __builtin_amdgcn_rcpf(d.x); t.y = __builtin_amdgcn_rcpf(d.y);
    f32x2 q = t * 0.5307027145f + (-0.7265760135f); q = q * t + 0.7107068705f; q = q * t + (-0.142248368f); q = q * t + 0.127414796f; q = q * t;
    const f32x2 s = (v * v) * (-0.72134752044f);
    f32x2 e; e.x = __builtin_amdgcn_exp2f(s.x); e.y = __builtin_amdgcn_exp2f(s.y);
    const f32x2 m = v * (q * e), r = v - m;
    f32x2 o; o.x = v.x < 0.f ? m.x : r.x; o.y = v.y < 0.f ? m.y : r.y; return o;
}

template <int ACT  > struct EpiBf16 {
    static constexpr bool PERM = true, AFTER_DRAIN = false; static_assert(ACT == 0 || ACT == 1, "EpiBf16: ACT is 0 (none) or 1 (gelu_pk)");
    bf16_t* O; int ldc; const float* bias; int split_cols; size_t split_stride; float scale0;
    __device__ __forceinline__ void operator()(const f32x4 (&acc)[2][2][4][2], const Unit& u, int wr, int wc, int fr, int fq) const {
        const int row0 = u.pm * BM + wr * 64 + fr; int colt = u.pn * BM; bf16_t* base = O;
        float sc = 1.f; if (split_cols) { const int t = colt / split_cols; base += (size_t)t * split_stride; colt -= t * split_cols; if (t == 0) sc = scale0; }
        const int col0 = colt + wc * 32 + 8 * fq, bcol0 = u.pn * BM + wc * 32 + 8 * fq;
        f32x4 bv[2][2];
#pragma unroll
        for (int bj = 0; bj < 2; ++bj)
#pragma unroll
            for (int n = 0; n < 2; ++n) bv[bj][n] = bias ? *(const f32x4*)(bias + bcol0 + bj * HALF + 4 * n) : (f32x4){0.f, 0.f, 0.f, 0.f};
#pragma unroll
        for (int ai = 0; ai < 2; ++ai)
#pragma unroll
            for (int m = 0; m < 4; ++m) { bf16_t* rowp = base + (size_t)(row0 + ai * HALF + m * 16) * ldc + col0;
#pragma unroll
                for (int bj = 0; bj < 2; ++bj) { f32x4 v0 = acc[ai][bj][m][0] + bv[bj][0], v1 = acc[ai][bj][m][1] + bv[bj][1];
                    if (ACT == 1) { f32x2 a = gelu_pk((f32x2){v0[0], v0[1]}), b = gelu_pk((f32x2){v0[2], v0[3]}), c = gelu_pk((f32x2){v1[0], v1[1]}), d = gelu_pk((f32x2){v1[2], v1[3]});
                        v0 = (f32x4){a.x, a.y, b.x, b.y}; v1 = (f32x4){c.x, c.y, d.x, d.y}; }
                    v0 = v0 * sc; v1 = v1 * sc; u32x4 w; w.x = cvt_pk_bf16(v0[0], v0[1]); w.y = cvt_pk_bf16(v0[2], v0[3]); w.z = cvt_pk_bf16(v1[0], v1[1]); w.w = cvt_pk_bf16(v1[2], v1[3]);
                    *(u32x4*)(rowp + bj * HALF) = w; } }
    }
};

template <class Epi, class Sched, bool ALIGN_EPI = false, bool SP2 = false>
__device__ __forceinline__ void gemm_phase(PG8_LAS unsigned char* lds, const Gemm g, const Sched& S, const Epi& E) {
    const int tid = threadIdx.x, wid = __builtin_amdgcn_readfirstlane(tid >> 6), lane = tid & 63, wr = wid >> 2, wc = wid & 3, fr = lane & 15, fq = lane >> 4;
    const int K = g.K, nt = K / BK;
    unsigned voffA[2], voffB[2];
#pragma unroll
    for (int i = 0; i < 2; ++i) { int R, C; stage_rc(tid * 16 + i * 8192, R, C); const int Rb = Epi::PERM ? ((R & ~31) + perm32(R & 31)) : R;
        voffA[i] = (unsigned)(R * g.lda + C) * 2u; voffB[i] = (unsigned)(Rb * K + C) * 2u; }
    const size_t kstep = (size_t)(BK * 2);
    const size_t hstepA = (size_t)HALF * g.lda * 2, hstepB = (size_t)HALF * K * 2;
    const size_t tstepA = 2 * hstepA, tstepB = 2 * hstepB;
    const unsigned ldsw = (unsigned)wid * 1024u;
    const int aoff = lds_byte(wr * 64 + fr, fq * 8), boff = lds_byte(wc * 32 + fr, fq * 8);
#define PG8_SA(b, h) (((b) * 2 + (h)) * HTB)
#define PG8_SB(b, h) ((4 + (b) * 2 + (h)) * HTB)
#define PG8_STAGE(bufoff, gbase, voff) do { _Pragma("unroll") for (int _i = 0; _i < 2; ++_i) \
        __builtin_amdgcn_global_load_lds((const unsigned*)((const char*)(gbase) + (voff)[_i]), (PG8_LAS unsigned*)(lds + (bufoff) + ldsw + _i * 8192), 16, 0, 0); } while (0)
#define PG8_LDA(dst, b, h) do { _Pragma("unroll") for (int m = 0; m < 4; ++m) _Pragma("unroll") for (int k = 0; k < 2; ++k) dst[m][k] = *(const PG8_LAS bf16x8*)(lds + PG8_SA(b, h) + aoff + m * 2048 + k * 1024); } while (0)
#define PG8_LDB(dst, b, h) do { _Pragma("unroll") for (int n = 0; n < 2; ++n) _Pragma("unroll") for (int k = 0; k < 2; ++k) dst[n][k] = *(const PG8_LAS bf16x8*)(lds + PG8_SB(b, h) + boff + n * 2048 + k * 1024); } while (0)
#define PG8_MMA(ai, bj, At, Bt) do { __builtin_amdgcn_s_setprio(1); _Pragma("unroll") for (int m = 0; m < 4; ++m) _Pragma("unroll") for (int n = 0; n < 2; ++n) _Pragma("unroll") for (int k = 0; k < 2; ++k) \
        acc[ai][bj][m][n] = __builtin_amdgcn_mfma_f32_16x16x32_bf16(Bt[n][k], At[m][k], acc[ai][bj][m][n], 0, 0, 0); __builtin_amdgcn_s_setprio(0); } while (0)
#define PG8_WAIT_V(n) asm volatile("s_waitcnt vmcnt(" #n ")" ::: "memory")
#define PG8_WAIT_L(n) asm volatile("s_waitcnt lgkmcnt(" #n ")" ::: "memory")
#define PG8_BAR __builtin_amdgcn_s_barrier()
#define PG8_SCHED __builtin_amdgcn_sched_barrier(0)
    Unit cur, nxt; int ui = 0;
    if (!S.next(0, cur)) return;
    f32x4 acc[2][2][4][2];
#pragma unroll
    for (int a = 0; a < 2; ++a)
#pragma unroll
        for (int b = 0; b < 2; ++b)
#pragma unroll
            for (int m = 0; m < 4; ++m)
#pragma unroll
                for (int n = 0; n < 2; ++n) acc[a][b][m][n] = (f32x4){0.f, 0.f, 0.f, 0.f};
    bf16x8 At[4][2], B0[2][2], B1[2][2];
    const char* cA = (const char*)g.A + (size_t)cur.pm * tstepA; const char* cB = (const char*)g.Bt + (size_t)cur.pn * tstepB;
    S.a_ready(cur);
    if constexpr (SP2) {
        PG8_STAGE(PG8_SB(0, 0), cB, voffB); PG8_STAGE(PG8_SB(0, 1), cB + hstepB, voffB); PG8_STAGE(PG8_SA(0, 0), cA, voffA); PG8_STAGE(PG8_SA(0, 1), cA + hstepA, voffA);
        if (wr == 1) PG8_BAR;
        PG8_WAIT_V(2); PG8_BAR;
        PG8_STAGE(PG8_SB(1, 0), cB + kstep, voffB); PG8_STAGE(PG8_SA(1, 0), cA + kstep, voffA); PG8_STAGE(PG8_SB(1, 1), cB + hstepB + kstep, voffB);
        PG8_WAIT_V(6); PG8_BAR;
    } else {
        PG8_STAGE(PG8_SB(0, 0), cB, voffB); PG8_STAGE(PG8_SA(0, 0), cA, voffA); PG8_STAGE(PG8_SB(0, 1), cB + hstepB, voffB); PG8_STAGE(PG8_SA(0, 1), cA + hstepA, voffA);
        if (wr == 1) PG8_BAR;
        PG8_WAIT_V(4); PG8_BAR;
        PG8_STAGE(PG8_SB(1, 0), cB + kstep, voffB); PG8_STAGE(PG8_SA(1, 0), cA + kstep, voffA); PG8_STAGE(PG8_SB(1, 1), cB + hstepB + kstep, voffB);
        PG8_WAIT_V(6); PG8_BAR;
    }
    for (;;) {
        const bool has_next = S.next(ui + 1, nxt);
        const char* nA = has_next ? (const char*)g.A + (size_t)nxt.pm * tstepA : cA; const char* nB = has_next ? (const char*)g.Bt + (size_t)nxt.pn * tstepB : cB;
        for (int t = 0; t < nt; t += 2) {
            const bool last = (t == nt - 2);
            const char* a1 = cA + (size_t)(t + 1) * kstep;
            const char* a2 = last ? nA : cA + (size_t)(t + 2) * kstep; const char* b2 = last ? nB : cB + (size_t)(t + 2) * kstep;
            const char* a3 = a2 + kstep; const char* b3 = b2 + kstep;
            if (last && has_next) S.a_ready(nxt);
            if constexpr (SP2) {
            PG8_LDB(B0, 0, 0); PG8_LDB(B1, 0, 1); PG8_SCHED; PG8_LDA(At, 0, 0); PG8_STAGE(PG8_SA(1, 1), a1 + hstepA, voffA);
            PG8_WAIT_V(8); PG8_WAIT_L(0); PG8_BAR; PG8_MMA(0, 0, At, B0); PG8_MMA(0, 1, At, B1); PG8_BAR; PG8_SCHED;
            PG8_LDA(At, 0, 1); PG8_STAGE(PG8_SB(0, 0), b2, voffB); PG8_STAGE(PG8_SB(0, 1), b2 + hstepB, voffB); PG8_STAGE(PG8_SA(0, 0), a2, voffA);
            PG8_WAIT_V(8); PG8_WAIT_L(0); PG8_BAR; PG8_MMA(1, 0, At, B0); PG8_MMA(1, 1, At, B1); PG8_BAR; PG8_SCHED;
            PG8_LDB(B0, 1, 0); PG8_LDB(B1, 1, 1); PG8_SCHED; PG8_LDA(At, 1, 0); PG8_STAGE(PG8_SA(0, 1), a2 + hstepA, voffA);
            PG8_WAIT_V(8); PG8_WAIT_L(0); PG8_BAR; PG8_MMA(0, 0, At, B0); PG8_MMA(0, 1, At, B1); PG8_BAR; PG8_SCHED;
            PG8_LDA(At, 1, 1); PG8_STAGE(PG8_SB(1, 0), b3, voffB); PG8_STAGE(PG8_SB(1, 1), b3 + hstepB, voffB); PG8_STAGE(PG8_SA(1, 0), a3, voffA);
            PG8_WAIT_V(8); PG8_WAIT_L(0); PG8_BAR; PG8_MMA(1, 0, At, B0); PG8_MMA(1, 1, At, B1); PG8_BAR; PG8_SCHED;
            } else {
            PG8_LDB(B0, 0, 0); PG8_SCHED; PG8_LDA(At, 0, 0); PG8_STAGE(PG8_SA(1, 1), a1 + hstepA, voffA);
            PG8_WAIT_L(8); PG8_BAR; PG8_WAIT_L(0); PG8_MMA(0, 0, At, B0); PG8_BAR; PG8_SCHED;
            PG8_LDB(B1, 0, 1); PG8_STAGE(PG8_SB(0, 0), b2, voffB);
            PG8_BAR; PG8_WAIT_L(0); PG8_MMA(0, 1, At, B1); PG8_BAR;
            PG8_LDA(At, 0, 1); PG8_STAGE(PG8_SA(0, 0), a2, voffA);
            PG8_BAR; PG8_WAIT_L(0); PG8_MMA(1, 0, At, B0); PG8_BAR; PG8_SCHED;
            PG8_STAGE(PG8_SB(0, 1), b2 + hstepB, voffB);
            PG8_WAIT_V(6); PG8_BAR; PG8_MMA(1, 1, At, B1); PG8_BAR;
            PG8_LDB(B0, 1, 0); PG8_SCHED; PG8_LDA(At, 1, 0); PG8_STAGE(PG8_SA(0, 1), a2 + hstepA, voffA);
            PG8_WAIT_L(8); PG8_BAR; PG8_WAIT_L(0); PG8_MMA(0, 0, At, B0); PG8_BAR; PG8_SCHED;
            PG8_LDB(B1, 1, 1); PG8_STAGE(PG8_SB(1, 0), b3, voffB);
            PG8_BAR; PG8_WAIT_L(0); PG8_MMA(0, 1, At, B1); PG8_BAR;
            PG8_LDA(At, 1, 1); PG8_STAGE(PG8_SA(1, 0), a3, voffA);
            PG8_BAR; PG8_WAIT_L(0); PG8_MMA(1, 0, At, B0); PG8_BAR; PG8_SCHED;
            PG8_STAGE(PG8_SB(1, 1), b3 + hstepB, voffB);
            PG8_WAIT_V(6); PG8_BAR; PG8_MMA(1, 1, At, B1); PG8_BAR;
            }
        }
        if constexpr (ALIGN_EPI) { if (wr == 0) PG8_BAR; }
        if constexpr (!Epi::AFTER_DRAIN) { E(acc, cur, wr, wc, fr, fq); S.done(cur); }
        if (!has_next) break;
#pragma unroll
        for (int a = 0; a < 2; ++a)
#pragma unroll
            for (int b = 0; b < 2; ++b)
#pragma unroll
                for (int m = 0; m < 4; ++m)
#pragma unroll
                    for (int n = 0; n < 2; ++n) acc[a][b][m][n] = (f32x4){0.f, 0.f, 0.f, 0.f};
        cur = nxt; cA = nA; cB = nB; ++ui;
        if constexpr (ALIGN_EPI) { if (wr == 1) PG8_BAR; }
    }
    PG8_WAIT_V(0);
    if constexpr (!ALIGN_EPI) { if (wr == 0) PG8_BAR; }
    PG8_BAR;
    if constexpr (Epi::AFTER_DRAIN) { E.fused(acc, cur, wr, wc, fr, fq, lds, wid, lane); S.done(cur); }
#undef PG8_SA
#undef PG8_SB
#undef PG8_STAGE
#undef PG8_LDA
#undef PG8_LDB
#undef PG8_MMA
#undef PG8_WAIT_V
#undef PG8_WAIT_L
#undef PG8_BAR
#undef PG8_SCHED
}
}
namespace pg8 {
struct Unit2 { int pm, pn, e, cnt, jt, ui; };
template <class Epi, class Sched>
__device__ __forceinline__ void gemm_phase2(PG8_LAS unsigned char* lds, const bf16_t* Abase, int lda, int ldb, int K, const Sched& S, const Epi& E, int kstepA_ = BK * 2) {
    int tid_ = threadIdx.x; asm volatile("" : "+v"(tid_));
    const int tid = tid_, wid = __builtin_amdgcn_readfirstlane(tid >> 6), lane = tid & 63, wr = wid >> 2, wc = wid & 3, fr = lane & 15, fq = lane >> 4;
    int K_ = K; asm volatile("" : "+s"(K_));
    const int nt = K_ / BK;
    unsigned voffB[2];
#pragma unroll
    for (int i = 0; i < 2; ++i) { int R, C; stage_rc(tid * 16 + i * 8192, R, C); const int Rb = Epi::PERM ? ((R & ~31) + perm32(R & 31)) : R; voffB[i] = (unsigned)(Rb * ldb + C) * 2u; }
    const unsigned lda2 = (unsigned)lda * 2u;
#define PG8_AOFFS(U, o0, o1) do { int t2_ = threadIdx.x; asm volatile("" : "+v"(t2_)); _Pragma("unroll") for (int i_ = 0; i_ < 2; ++i_) { int R_, C_; stage_rc(t2_ * 16 + i_ * 8192, R_, C_); \
        o0[i_] = (unsigned)S.arow(U, R_) * lda2 + (unsigned)C_ * 2u; o1[i_] = (unsigned)S.arow(U, HALF + R_) * lda2 + (unsigned)C_ * 2u; } } while (0)
    const size_t kstep = (size_t)(BK * 2), kstepA = (size_t)kstepA_;
    const size_t hstepB = (size_t)HALF * ldb * 2;
    const unsigned ldsw = (unsigned)wid * 1024u;
    const int aoff = lds_byte(wr * 64 + fr, fq * 8), boff = lds_byte(wc * 32 + fr, fq * 8);
#define PG8_SA(b, h) (((b) * 2 + (h)) * HTB)
#define PG8_SB(b, h) ((4 + (b) * 2 + (h)) * HTB)
#define PG8_STAGE(bufoff, gbase, voff) do { _Pragma("unroll") for (int _i = 0; _i < 2; ++_i) \
        __builtin_amdgcn_global_load_lds((const unsigned*)((const char*)(gbase) + (voff)[_i]), (PG8_LAS unsigned*)(lds + (bufoff) + ldsw + _i * 8192), 16, 0, 0); } while (0)
#define PG8_LDA(dst, b, h) do { _Pragma("unroll") for (int m = 0; m < 4; ++m) _Pragma("unroll") for (int k = 0; k < 2; ++k) dst[m][k] = *(const PG8_LAS bf16x8*)(lds + PG8_SA(b, h) + aoff + m * 2048 + k * 1024); } while (0)
#define PG8_LDB(dst, b, h) do { _Pragma("unroll") for (int n = 0; n < 2; ++n) _Pragma("unroll") for (int k = 0; k < 2; ++k) dst[n][k] = *(const PG8_LAS bf16x8*)(lds + PG8_SB(b, h) + boff + n * 2048 + k * 1024); } while (0)
#define PG8_MMA(ai, bj, At, Bt) do { __builtin_amdgcn_s_setprio(1); _Pragma("unroll") for (int m = 0; m < 4; ++m) _Pragma("unroll") for (int n = 0; n < 2; ++n) _Pragma("unroll") for (int k = 0; k < 2; ++k) \
        acc[ai][bj][m][n] = __builtin_amdgcn_mfma_f32_16x16x32_bf16(Bt[n][k], At[m][k], acc[ai][bj][m][n], 0, 0, 0); __builtin_amdgcn_s_setprio(0); } while (0)
#define PG8_WAIT_V(n) asm volatile("s_waitcnt vmcnt(" #n ")" ::: "memory")
#define PG8_WAIT_L(n) asm volatile("s_waitcnt lgkmcnt(" #n ")" ::: "memory")
#define PG8_BAR __builtin_amdgcn_s_barrier()
#define PG8_SCHED __builtin_amdgcn_sched_barrier(0)
    Unit2 cur, nxt; int ui = 0;
    if (!S.next(0, cur)) return;
    f32x4 acc[2][2][4][2];
#pragma unroll
    for (int a = 0; a < 2; ++a)
#pragma unroll
        for (int b = 0; b < 2; ++b)
#pragma unroll
            for (int m = 0; m < 4; ++m)
#pragma unroll
                for (int n = 0; n < 2; ++n) acc[a][b][m][n] = (f32x4){0.f, 0.f, 0.f, 0.f};
    bf16x8 At[4][2], B0[2][2], B1[2][2];
    unsigned cv0[2], cv1[2], nv0[2], nv1[2];
    PG8_AOFFS(cur, cv0, cv1);
    const char* cA = (const char*)Abase + S.aoff(cur); const char* cB = S.bptr(cur);
    PG8_STAGE(PG8_SB(0, 0), cB, voffB); PG8_STAGE(PG8_SB(0, 1), cB + hstepB, voffB); PG8_STAGE(PG8_SA(0, 0), cA, cv0); PG8_STAGE(PG8_SA(0, 1), cA, cv1);
    if (wr == 1) PG8_BAR;
    PG8_WAIT_V(2); PG8_BAR;
    PG8_STAGE(PG8_SB(1, 0), cB + kstep, voffB); PG8_STAGE(PG8_SA(1, 0), cA + kstepA, cv0); PG8_STAGE(PG8_SB(1, 1), cB + hstepB + kstep, voffB);
    PG8_WAIT_V(6); PG8_BAR;
    for (;;) {
        const bool has_next = S.next(ui + 1, nxt);
        const char* nA = has_next ? (const char*)Abase + S.aoff(nxt) : cA; const char* nB = has_next ? S.bptr(nxt) : cB;
#pragma unroll
        for (int i = 0; i < 2; ++i) { nv0[i] = cv0[i]; nv1[i] = cv1[i]; }
        if (has_next) PG8_AOFFS(nxt, nv0, nv1);
        const bool act0 = cur.cnt > wr * 64, act1 = cur.cnt > HALF + wr * 64;
        for (int t = 0; t < nt; t += 2) {
            const bool last = (t == nt - 2);
            const char* a1 = cA + (size_t)(t + 1) * kstepA;
            const char* a2 = last ? nA : cA + (size_t)(t + 2) * kstepA; const char* b2 = last ? nB : cB + (size_t)(t + 2) * kstep;
            const char* a3 = a2 + kstepA; const char* b3 = b2 + kstep;
            unsigned s0[2] = {cv0[0], cv0[1]}, s1[2] = {cv1[0], cv1[1]};
            if (last) { asm volatile("" ::: "memory"); s0[0] = nv0[0]; s0[1] = nv0[1]; s1[0] = nv1[0]; s1[1] = nv1[1]; }
            PG8_LDB(B0, 0, 0); PG8_LDB(B1, 0, 1); PG8_SCHED; PG8_LDA(At, 0, 0); PG8_STAGE(PG8_SA(1, 1), a1, cv1);
            PG8_WAIT_V(8); PG8_WAIT_L(0); PG8_BAR; if (act0) { PG8_MMA(0, 0, At, B0); PG8_MMA(0, 1, At, B1); } PG8_BAR; PG8_SCHED;
            PG8_LDA(At, 0, 1); PG8_STAGE(PG8_SB(0, 0), b2, voffB); PG8_STAGE(PG8_SB(0, 1), b2 + hstepB, voffB); PG8_STAGE(PG8_SA(0, 0), a2, s0);
            PG8_WAIT_V(8); PG8_WAIT_L(0); PG8_BAR; if (act1) { PG8_MMA(1, 0, At, B0); PG8_MMA(1, 1, At, B1); } PG8_BAR; PG8_SCHED;
            PG8_LDB(B0, 1, 0); PG8_LDB(B1, 1, 1); PG8_SCHED; PG8_LDA(At, 1, 0); PG8_STAGE(PG8_SA(0, 1), a2, s1);
            PG8_WAIT_V(8); PG8_WAIT_L(0); PG8_BAR; if (act0) { PG8_MMA(0, 0, At, B0); PG8_MMA(0, 1, At, B1); } PG8_BAR; PG8_SCHED;
            PG8_LDA(At, 1, 1); PG8_STAGE(PG8_SB(1, 0), b3, voffB); PG8_STAGE(PG8_SB(1, 1), b3 + hstepB, voffB); PG8_STAGE(PG8_SA(1, 0), a3, s0);
            PG8_WAIT_V(8); PG8_WAIT_L(0); PG8_BAR; if (act1) { PG8_MMA(1, 0, At, B0); PG8_MMA(1, 1, At, B1); } PG8_BAR; PG8_SCHED;
        }
        if (wr == 0) PG8_BAR;
        { Unit2 eu = cur; asm volatile("" : "+s"(eu.pm), "+s"(eu.pn), "+s"(eu.e), "+s"(eu.cnt), "+s"(eu.jt), "+s"(eu.ui));
          E(acc, eu, wr, wc, fr, fq);
          }
        if (!has_next) break;
#pragma unroll
        for (int a = 0; a < 2; ++a)
#pragma unroll
            for (int b = 0; b < 2; ++b)
#pragma unroll
                for (int m = 0; m < 4; ++m)
#pragma unroll
                    for (int n = 0; n < 2; ++n) acc[a][b][m][n] = (f32x4){0.f, 0.f, 0.f, 0.f};
        cur = nxt; cA = nA; cB = nB; ++ui;
#pragma unroll
        for (int i = 0; i < 2; ++i) { cv0[i] = nv0[i]; cv1[i] = nv1[i]; }
        if (wr == 1) PG8_BAR;
    }
    PG8_WAIT_V(0);
    PG8_BAR;
#undef PG8_AOFFS
#undef PG8_SA
#undef PG8_SB
#undef PG8_STAGE
#undef PG8_LDA
#undef PG8_LDB
#undef PG8_MMA
#undef PG8_WAIT_V
#undef PG8_WAIT_L
#undef PG8_BAR
#undef PG8_SCHED
}

struct DenseSched {
    StaticOrder so; const bf16_t* Bt; int ldb;
    __device__ __forceinline__ bool next(int i, Unit2& u) const { Unit t; if (!so.next(i, t)) return false; u.pm = t.pm; u.pn = t.pn; u.e = 0; u.cnt = 256; u.jt = 0; u.ui = i; return true; }
    __device__ __forceinline__ int arow(const Unit2& u, int r) const { return u.pm * BM + r; }
    __device__ __forceinline__ size_t aoff(const Unit2&) const { return 0; }
    __device__ __forceinline__ const char* bptr(const Unit2& u) const { return (const char*)(Bt + (size_t)u.pn * BM * ldb); }
};
struct EpiPlainBf16 {
    static constexpr bool PERM = true, AFTER_DRAIN = false;
    bf16_t* O; int ldc;
    __device__ __forceinline__ void operator()(const f32x4 (&acc)[2][2][4][2], const Unit2& u, int wr, int wc, int fr, int fq) const {
        const int row0 = u.pm * BM + wr * 64 + fr, col0 = u.pn * BM + wc * 32 + 8 * fq;
#pragma unroll
        for (int ai = 0; ai < 2; ++ai)
#pragma unroll
            for (int m = 0; m < 4; ++m) { bf16_t* rowp = O + (size_t)(row0 + ai * HALF + m * 16) * ldc + col0;
#pragma unroll
                for (int bj = 0; bj < 2; ++bj) { const f32x4 v0 = acc[ai][bj][m][0], v1 = acc[ai][bj][m][1];
                    u32x4 w; w.x = cvt_pk_bf16(v0[0], v0[1]); w.y = cvt_pk_bf16(v0[2], v0[3]); w.z = cvt_pk_bf16(v1[0], v1[1]); w.w = cvt_pk_bf16(v1[2], v1[3]);
                    *(u32x4*)(rowp + bj * HALF) = w; } }
    }
};
}
namespace nv {
constexpr int D = 1024, B = 8, S = 4096, T = B * S;
constexpr int FH = 8, FD = 64, GH = 4, GK = 64, GV = 128, RANK = 16;
constexpr int INW = 3096;
constexpr int O_FQ = 0, O_FK = 512, O_FV = 1024, O_FF = 1536, O_GQ = 1544, O_GK = 1800, O_GV = 2056, O_GA = 2568, O_GR = 2584;
constexpr int NE = 256, NG = 8, TOPK = 8, ED = 256;
constexpr float LN_EPS = 1e-5f;
constexpr float ALPHA = 1.189207115002721f;
constexpr int PADR = 64;
constexpr int APAD = T * TOPK + NE * PADR;

__device__ __forceinline__ float logsigmoidf(float x) { return fminf(x, 0.f) - log1pf(expf(-fabsf(x))); }
__device__ __forceinline__ float siluf(float x) { return x / (1.f + expf(-x)); }

}
#include <hip/hip_bf16.h>
#include <cmath>
namespace attn_body {
using bf16=__hip_bfloat16;
using bf16x8=__attribute__((ext_vector_type(8)))short;
using s16x4=__attribute__((ext_vector_type(4)))short;
using f32x16=__attribute__((ext_vector_type(16)))float;
using u32x4=__attribute__((ext_vector_type(4)))unsigned;
constexpr int BATCH=8,NHEAD=8,SEQ=4096,D=64,DM=3072,OPITCH=1024;
constexpr int NW=8,QBLK=32,QB=QBLK*NW,KVBLK=64,NQB=SEQ/QB;
constexpr int ATTN_PITCH=DM, ATTN_UNIT_ROWS=QB;
__device__ __forceinline__ int crow(int r,int hi){return (r&3)+8*(r>>2)+4*hi;}
#define SBAR() __builtin_amdgcn_sched_barrier(0)
__device__ __forceinline__ void cmask(f32x16&p0,f32x16&p1,int jb,int qrel,int hi){
  const float NEG=-INFINITY; int kb=64*jb+4*hi;
  #pragma unroll
  for(int r=0;r<16;++r){int kv=kb+(r&3)+8*(r>>2); if(kv>qrel)p0[r]=NEG; if(kv+32>qrel)p1[r]=NEG;}
}

constexpr int NSLOT=3, SLOTB=8192;
constexpr int LDS_K=0, LDS_V=NSLOT*SLOTB, LDS_WS=2*NSLOT*SLOTB, LDS_OST=LDS_WS+NW*64*4, LDS_KB=LDS_OST+NW*4096, LDS_BYTES=LDS_KB+(SEQ+2)*8;
constexpr float C2=0.125f*1.4426950408889634f;
__device__ __forceinline__ void glds16(const void*gsrc,unsigned lds_dst){unsigned keep;
  asm volatile("s_mov_b32 %0, m0\n\ts_mov_b32 m0, %2\n\ts_nop 0\n\tglobal_load_lds_dwordx4 %1, off\n\ts_mov_b32 m0, %0":"=&s"(keep):"v"(gsrc),"s"(lds_dst):"memory");}
__device__ __forceinline__ float max3f(float a,float b,float c){float r;asm("v_max3_f32 %0, %1, %2, %3":"=v"(r):"v"(a),"v"(b),"v"(c));return r;}
__device__ __forceinline__ float max2f(float a,float b){float r;asm("v_max_f32_e32 %0, %1, %2":"=v"(r):"v"(a),"v"(b));return r;}
__device__ __forceinline__ float fadd_s(float a,float b){float r;asm("v_add_f32_e32 %0, %1, %2":"=v"(r):"v"(a),"v"(b));return r;}
__device__ __forceinline__ float fsub_s(float a,float b){float r;asm("v_sub_f32_e32 %0, %1, %2":"=v"(r):"v"(a),"v"(b));return r;}
typedef float f32x2_t __attribute__((ext_vector_type(2))); typedef float f32x4_t __attribute__((ext_vector_type(4))); typedef __bf16 bf16x2_t __attribute__((ext_vector_type(2)));
__device__ __forceinline__ unsigned cvtpk_s(float lo,float hi){f32x2_t v={lo,hi};bf16x2_t b=__builtin_convertvector(v,bf16x2_t);return __builtin_bit_cast(unsigned,b);}
#define WAIT_BAR(N) asm volatile("s_waitcnt vmcnt(" #N ") lgkmcnt(0)\n\ts_barrier":::"memory")

__device__ __forceinline__ void split3(float b,unsigned&h,unsigned&m,unsigned&l){
  h=cvtpk_s(b,0.f)&0xffffu; const float r1=b-__uint_as_float(h<<16);
  m=cvtpk_s(r1,0.f)&0xffffu; const float r2=r1-__uint_as_float(m<<16);
  l=cvtpk_s(r2,0.f)&0xffffu; }
__device__ __forceinline__ bf16x8 kbias_frag(float b,int hi){unsigned h,m,l;split3(b,h,m,l);u32x4 w;w.x=h|(m<<16);w.y=l|0x3F800000u;w.z=0x3F803F80u;w.w=0u;if(hi){w.x=0u;w.y=0u;w.z=0u;}return __builtin_bit_cast(bf16x8,w);}
__device__ __forceinline__ bf16x8 qref_frag(float x,int hi){unsigned h,m,l;split3(x,h,m,l);u32x4 w;w.x=0x3F803F80u;w.y=0x3F80u|(h<<16);w.z=m|(l<<16);w.w=0u;if(hi){w.x=0u;w.y=0u;w.z=0u;}return __builtin_bit_cast(bf16x8,w);}
typedef unsigned u32x2_t __attribute__((ext_vector_type(2)));
__device__ __forceinline__ bf16x8 mkfrag(u32x2_t e,unsigned zc){u32x4 w;w.x=e.x;w.y=e.y;w.z=zc;w.w=0u;return __builtin_bit_cast(bf16x8,w);}
__device__ __forceinline__ void fox_bias_table(int b,int h,const float*LF,char*shm){
  int tid_=threadIdx.x; asm volatile("":"+v"(tid_)); const int tid=tid_,lane=tid&63,wid=__builtin_amdgcn_readfirstlane(tid>>6);
  const float*lf=LF+((long)b*NHEAD+h)*SEQ; float*wt=(float*)(shm+LDS_WS); u32x2_t*KB8=(u32x2_t*)(shm+LDS_KB);
  f32x4_t va=*(const f32x4_t*)(lf+8*tid),vb=*(const f32x4_t*)(lf+8*tid+4);
  va[1]+=va[0];va[2]+=va[1];va[3]+=va[2];vb[0]+=va[3];vb[1]+=vb[0];vb[2]+=vb[1];vb[3]+=vb[2];
  const float tot=vb[3]; float inc=tot;
  #pragma unroll
  for(int o_=1;o_<64;o_<<=1){const float nn=__shfl_up(inc,o_);if(lane>=o_)inc+=nn;}
  __syncthreads();
  if(lane==63)wt[wid*64]=inc;
  __syncthreads();
  float base=inc-tot;
  #pragma unroll
  for(int w_=0;w_<NW;++w_){const float x_=wt[w_*64]; if(w_<wid)base+=x_;}
  const float cv[8]={va[0]+base,va[1]+base,va[2]+base,va[3]+base,vb[0]+base,vb[1]+base,vb[2]+base,vb[3]+base};
  #pragma unroll
  for(int j=0;j<8;++j){unsigned hh,mm,ll;split3(-cv[j],hh,mm,ll);KB8[8*tid+j]=(u32x2_t){hh|(mm<<16),ll|0x3F800000u};}
  if(tid==0){KB8[SEQ]=(u32x2_t){0u,0u};KB8[SEQ+1]=(u32x2_t){0u,0u};}
  __syncthreads();
}
__device__ __forceinline__ void qkt(f32x16&p0,f32x16&p1,const char*Kslot,const bf16x8*qr,bf16x8 kb0,bf16x8 kb1,bf16x8 qx,int r32,int hi){
  const f32x16 negm=f32x16{};
  const char*kb=Kslot+hi*1024+r32*16;
  #pragma unroll
  for(int d0=0;d0<4;++d0){
    const bf16x8 b0=*reinterpret_cast<const bf16x8*>(kb+d0*2048);
    const bf16x8 b1=*reinterpret_cast<const bf16x8*>(kb+d0*2048+512);
    if(d0==0){p0=__builtin_amdgcn_mfma_f32_32x32x16_bf16(b0,qr[0],negm,0,0,0);p1=__builtin_amdgcn_mfma_f32_32x32x16_bf16(b1,qr[0],negm,0,0,0);}
    else{p0=__builtin_amdgcn_mfma_f32_32x32x16_bf16(b0,qr[d0],p0,0,0,0);p1=__builtin_amdgcn_mfma_f32_32x32x16_bf16(b1,qr[d0],p1,0,0,0);}}
  p0=__builtin_amdgcn_mfma_f32_32x32x16_bf16(kb0,qx,p0,0,0,0);p1=__builtin_amdgcn_mfma_f32_32x32x16_bf16(kb1,qx,p1,0,0,0);
}
typedef __attribute__((address_space(3))) const char* lds_cptr;
typedef short v4i16_t __attribute__((ext_vector_type(4)));
__device__ __forceinline__ void kload8(bf16x8*kf,lds_cptr kp){
  kf[0]=*(const __attribute__((address_space(3))) bf16x8*)(kp);      kf[1]=*(const __attribute__((address_space(3))) bf16x8*)(kp+512);
  kf[2]=*(const __attribute__((address_space(3))) bf16x8*)(kp+2048); kf[3]=*(const __attribute__((address_space(3))) bf16x8*)(kp+2560);
  kf[4]=*(const __attribute__((address_space(3))) bf16x8*)(kp+4096); kf[5]=*(const __attribute__((address_space(3))) bf16x8*)(kp+4608);
  kf[6]=*(const __attribute__((address_space(3))) bf16x8*)(kp+6144); kf[7]=*(const __attribute__((address_space(3))) bf16x8*)(kp+6656);
}
__device__ __forceinline__ void kload2(bf16x8*kf,lds_cptr kp,int j){ kf[2*j]=*(const __attribute__((address_space(3))) bf16x8*)(kp+j*2048); kf[2*j+1]=*(const __attribute__((address_space(3))) bf16x8*)(kp+j*2048+512); }
__device__ __forceinline__ s16x4 vtr(lds_cptr p){ return __builtin_bit_cast(s16x4,__builtin_amdgcn_ds_read_tr16_b64_v4i16((__attribute__((address_space(3))) v4i16_t*)p)); }
__device__ __forceinline__ float rowmax(const f32x16&p0,const f32x16&p1){
  float a=max3f(p0[0],p0[1],p1[0]),b=max3f(p0[2],p0[3],p1[1]);a=max3f(a,p1[2],p1[3]);
  #pragma unroll
  for(int r=4;r<16;r+=4){a=max3f(a,p0[r],p0[r+1]);b=max3f(b,p0[r+2],p0[r+3]);a=max3f(a,p1[r],p1[r+1]);b=max3f(b,p1[r+2],p1[r+3]);}
  const float m=max2f(a,b);
  auto rr=__builtin_amdgcn_permlane32_swap(__float_as_uint(m),__float_as_uint(m),false,false);
  return max2f(__uint_as_float(rr[0]),__uint_as_float(rr[1]));
}
__device__ __forceinline__ void pv(f32x16*o,int vb,bf16x8 pa0,bf16x8 pa1,bf16x8 pa2,bf16x8 pa3){
  #pragma unroll
  for(int d0=0;d0<2;++d0){s16x4 lo[4],hi[4];
    #pragma unroll
    for(int ks=0;ks<4;++ks){
      asm volatile("ds_read_b64_tr_b16 %0,%1 offset:%c2":"=&v"(lo[ks]):"v"(vb),"i"(d0*4096+ks*1024):"memory");
      asm volatile("ds_read_b64_tr_b16 %0,%1 offset:%c2":"=&v"(hi[ks]):"v"(vb),"i"(d0*4096+ks*1024+512):"memory");}
    asm volatile("s_waitcnt lgkmcnt(0)":::"memory");SBAR();
    #define PK(k) (bf16x8){lo[k][0],lo[k][1],lo[k][2],lo[k][3],hi[k][0],hi[k][1],hi[k][2],hi[k][3]}
    o[d0]=__builtin_amdgcn_mfma_f32_32x32x16_bf16(pa0,PK(0),o[d0],0,0,0);
    o[d0]=__builtin_amdgcn_mfma_f32_32x32x16_bf16(pa1,PK(1),o[d0],0,0,0);
    o[d0]=__builtin_amdgcn_mfma_f32_32x32x16_bf16(pa2,PK(2),o[d0],0,0,0);
    o[d0]=__builtin_amdgcn_mfma_f32_32x32x16_bf16(pa3,PK(3),o[d0],0,0,0);
    #undef PK
  }
}

#ifndef ATTN_STORE16
#define ATTN_STORE16(p,v) (*(u32x4*)(p)=(v))
#endif
template<int THRL> __device__ __forceinline__ void attn_unit(int b,int h,int qb,const bf16*Q,const bf16* K,const bf16* V,bf16*O,const float*LF,const unsigned*NRM,char*shm){
  int tid_=threadIdx.x; asm volatile("":"+v"(tid_));
  const int tid=tid_,lane=tid&63,r32=lane&31,hi=lane>>5; const int wid=__builtin_amdgcn_readfirstlane(tid>>6);
  const long rowbase=(long)b*SEQ; const int q0=qb*QB;
  const char*KBt0=shm+LDS_KB;
  int t0;
  { const int NT0=(q0+QB)/KVBLK; const unsigned*nr=NRM+(b*NHEAD+h)*4;
    const float qn2=__uint_as_float(nr[0])+__uint_as_float(nr[1]), kn2=__uint_as_float(nr[2])+__uint_as_float(nr[3]);
    const float thr=-(50.f+2.04f*sqrtf(qn2*kn2));
    const u32x2_t eq0=*(const u32x2_t*)(KBt0+(unsigned)q0*8u); const float bq0=__uint_as_float(eq0.x<<16)+__uint_as_float(eq0.x&0xffff0000u)+__uint_as_float(eq0.y<<16);
    bool ok=(2*lane<=NT0-4);
    if(ok&&lane>0){ const u32x2_t el=*(const u32x2_t*)(KBt0+(unsigned)(128*lane-1)*8u); const float bl=__uint_as_float(el.x<<16)+__uint_as_float(el.x&0xffff0000u)+__uint_as_float(el.y<<16); ok=(bl-bq0<thr); }
    const unsigned long long mk=__ballot(ok); const unsigned long long low=~mk; const int cnt=(low==0ull)?64:__builtin_ctzll(low);
    t0=__builtin_amdgcn_readfirstlane(2*(cnt-1)); }
  const char*KBt=KBt0+(hi?0:t0*512); const unsigned kb_o0=hi?(unsigned)SEQ*8u:(unsigned)r32*8u, kb_o1=hi?(unsigned)SEQ*8u:(unsigned)(r32+32)*8u, kb_str=hi?0u:512u, zc=hi?0u:0x3F803F80u;
  const bf16*Qw=Q+(rowbase+q0+wid*QBLK)*DM+h*D;
  const bf16*Kh=K+(rowbase+(long)t0*KVBLK)*DM+h*D,*Vh=V+(rowbase+(long)t0*KVBLK)*DM+h*D;
  const unsigned lds0=(unsigned)(uintptr_t)shm;
  float*wsf=(float*)(shm+LDS_WS)+wid*64;
  const bf16*ksrc=Kh+(long)lane*DM+wid*8;
  const bf16*vsrc=Vh+(long)(16*(wid&3)+(lane>>2))*DM+(wid>>2)*32+(lane&3)*8;
  const unsigned kdst=lds0+LDS_K+wid*1024, vdst=lds0+LDS_V+wid*1024;
  #define DMA_K(t,slot) glds16(ksrc+(long)(t)*KVBLK*DM,(unsigned)__builtin_amdgcn_readfirstlane(kdst+(slot)))
  #define DMA_V(t,slot) glds16(vsrc+(long)(t)*KVBLK*DM,(unsigned)__builtin_amdgcn_readfirstlane(vdst+(slot)))
  const int vb0=(int)(lds0+LDS_V)+((lane>>4)&1)*32+(lane&3)*8+(4*hi+((lane&15)>>2))*64;
  const char*Kbase=shm+LDS_K; bf16x8 kf[8];
  const lds_cptr shm3=(lds_cptr)shm; const lds_cptr kp0=shm3+LDS_K+hi*1024+r32*16; const lds_cptr vp0=shm3+LDS_V+((lane>>4)&1)*32+(lane&3)*8+(4*hi+((lane&15)>>2))*64;
  const int NT=(q0+QB)/KVBLK-t0;
  DMA_K(0,0);DMA_V(0,0);DMA_K(1,SLOTB);
  bf16x8 qr[4];
  #pragma unroll
  for(int d0=0;d0<4;++d0)qr[d0]=*reinterpret_cast<const bf16x8*>(&Qw[(long)r32*DM+d0*16+hi*8]);
  float mhat; { const u32x2_t eq=*(const u32x2_t*)(KBt0+(unsigned)(q0+wid*QBLK+r32)*8u); mhat=__uint_as_float(eq.x<<16)+__uint_as_float(eq.x&0xffff0000u)+__uint_as_float(eq.y<<16); }
  float l_reg=0.f;f32x16 o[2];o[0]=f32x16{};o[1]=f32x16{};const f32x16 negm=f32x16{};
  bf16x8 qx=qref_frag(-mhat,hi);
  const int qrel=wid*QBLK+r32;
  #define CMASK(P0,P1,t) do{int jb_=(t)-(NT-4); if(jb_>=0)cmask(P0,P1,jb_,qrel,hi);}while(0)
  bool resc=false;
  #define START(P0,P1) do{ const float rm=rowmax(P0,P1); resc=false; \
    { const float dl=__builtin_fmaxf(rm,0.f); mhat=fadd_s(mhat,dl); \
      _Pragma("unroll") for(int r=0;r<16;++r){P0[r]=fsub_s(P0[r],dl);P1[r]=fsub_s(P1[r],dl);} \
      qx=qref_frag(-mhat,hi); } \
    _Pragma("unroll") for(int r=0;r<16;++r)P0[r]=__builtin_amdgcn_exp2f(P0[r]); }while(0)
  #define RESC() do{ if(resc){ asm volatile("s_waitcnt lgkmcnt(0)":::"memory"); \
      _Pragma("unroll") for(int d_=0;d_<2;++d_) _Pragma("unroll") for(int r=0;r<16;++r)o[d_][r]*=wsf[crow(r,hi)]; } }while(0)
  f32x16 pA0,pA1,pB0,pB1;
  int sl_prev=0,sl_cur=0,sl_next=SLOTB;
  #define ROT() do{sl_prev=sl_cur;sl_cur=sl_next;sl_next=(sl_next==(NSLOT-1)*SLOTB)?0:sl_next+SLOTB;}while(0)
  DMA_K(2,2*SLOTB);
  WAIT_BAR(3);
  qkt(pA0,pA1,Kbase,qr,mkfrag(*(const u32x2_t*)(KBt+kb_o0),zc),mkfrag(*(const u32x2_t*)(KBt+kb_o1),zc),qx,r32,hi);asm volatile("s_nop 15\n\ts_nop 7":"+v"(pA0),"+v"(pA1));CMASK(pA0,pA1,0);
  START(pA0,pA1);
  _Pragma("unroll") for(int r=0;r<16;++r)pA1[r]=__builtin_amdgcn_exp2f(pA1[r]);
  WAIT_BAR(0);
  DMA_K(3,0);DMA_V(1,SLOTB);
  ROT();
  kload8(kf,kp0+sl_cur);
  WAIT_BAR(2);
  s16x4 vlo[8],vhi[8]; u32x4 pw0,pw1,pw2,pw3;
  #define PKW(P,B) cvtpk_s(P[B],P[B+1])
  #define PAF(k) __builtin_bit_cast(bf16x8,pw##k)
  #define VFR(i) (bf16x8){vlo[i][0],vlo[i][1],vlo[i][2],vlo[i][3],vhi[i][0],vhi[i][1],vhi[i][2],vhi[i][3]}
  #define PIN(x) asm volatile("":"+v"(x))
  #define MX3(a,b,c) __builtin_fmaxf(__builtin_fmaxf((a),(b)),(c))
  #define GAPA(MF,A0,A1,A2,A3,W0,W1,PW) do{ MF; sacc+=A0; sacc+=A1; sacc+=A2; sacc+=A3; PIN(sacc); W0; W1; PIN(PW); SBAR(); }while(0)
  #define EX(v) __builtin_amdgcn_exp2f(v)
  #define GAPB(MF,X,B) do{ MF; X[B]=EX(X[B]); X[B+1]=EX(X[B+1]); X[B+2]=EX(X[B+2]); X[B+3]=EX(X[B+3]); PIN(X); SBAR(); }while(0)
  #define VRD(i) do{ vlo[i]=vtr(vp_+(((i)>>2)*4096+((i)&3)*1024)); vhi[i]=vtr(vp_+(((i)>>2)*4096+((i)&3)*1024+512)); }while(0)
  #define KRD(G,j) do{ if(G){ kload2(kf,kp0+sl_next,j); SBAR(); } }while(0)
  #define STEP(C0,C1,P0,P1,t,GK,GV,GL) do{ SBAR(); \
    const lds_cptr vp_=vp0+sl_prev; const u32x2_t e0_=*(const u32x2_t*)(KBt+kb_o0+(unsigned)(t)*kb_str),e1_=*(const u32x2_t*)(KBt+kb_o1+(unsigned)(t)*kb_str); \
    VRD(0); SBAR(); float sacc=(P0[0]+P0[1]); \
    GAPA(C0=__builtin_amdgcn_mfma_f32_32x32x16_bf16(kf[0],qr[0],negm,0,0,0), P0[2],P0[3],P0[4],P0[5],     pw0[0]=PKW(P0,0), pw0[1]=PKW(P0,2), pw0); \
    VRD(4); SBAR(); GAPA(C1=__builtin_amdgcn_mfma_f32_32x32x16_bf16(kf[1],qr[0],negm,0,0,0), P0[6],P0[7],P0[8],P0[9],     pw0[2]=PKW(P0,4), pw0[3]=PKW(P0,6), pw0); \
    VRD(1); SBAR(); GAPA(C0=__builtin_amdgcn_mfma_f32_32x32x16_bf16(kf[2],qr[1],C0,0,0,0),   P0[10],P0[11],P0[12],P0[13], pw1[0]=PKW(P0,8), pw1[1]=PKW(P0,10), pw1); \
    VRD(5); SBAR(); GAPA(C1=__builtin_amdgcn_mfma_f32_32x32x16_bf16(kf[3],qr[1],C1,0,0,0),   P0[14],P0[15],P1[0],P1[1],   pw1[2]=PKW(P0,12),pw1[3]=PKW(P0,14), pw1); \
    VRD(2); SBAR(); GAPA(C0=__builtin_amdgcn_mfma_f32_32x32x16_bf16(kf[4],qr[2],C0,0,0,0),   P1[2],P1[3],P1[4],P1[5],     pw2[0]=PKW(P1,0), pw2[1]=PKW(P1,2), pw2); \
    VRD(6); SBAR(); GAPA(C1=__builtin_amdgcn_mfma_f32_32x32x16_bf16(kf[5],qr[2],C1,0,0,0),   P1[6],P1[7],P1[8],P1[9],     pw2[2]=PKW(P1,4), pw2[3]=PKW(P1,6), pw2); \
    VRD(3); SBAR(); GAPA(C0=__builtin_amdgcn_mfma_f32_32x32x16_bf16(kf[6],qr[3],C0,0,0,0),   P1[10],P1[11],P1[12],P1[13], pw3[0]=PKW(P1,8), pw3[1]=PKW(P1,10), pw3); \
    VRD(7); SBAR(); GAPA(C1=__builtin_amdgcn_mfma_f32_32x32x16_bf16(kf[7],qr[3],C1,0,0,0),   P1[14],P1[15],0.f,0.f,       pw3[2]=PKW(P1,12),pw3[3]=PKW(P1,14), pw3); \
    { const bf16x8 kb0_=mkfrag(e0_,zc),kb1_=mkfrag(e1_,zc); C0=__builtin_amdgcn_mfma_f32_32x32x16_bf16(kb0_,qx,C0,0,0,0); C1=__builtin_amdgcn_mfma_f32_32x32x16_bf16(kb1_,qx,C1,0,0,0); } SBAR(); \
    l_reg+=sacc; \
    if(GK){DMA_K((t)+3,sl_cur);} if(GV){DMA_V((t)+1,sl_next);} \
    CMASK(C0,C1,t); \
    { float a=MX3(C0[0],C0[1],C1[0]),b=MX3(C0[2],C0[3],C1[1]); a=MX3(a,C1[2],C1[3]); \
      _Pragma("unroll") for(int r=4;r<16;r+=4){a=MX3(a,C0[r],C0[r+1]);b=MX3(b,C0[r+2],C0[r+3]);a=MX3(a,C1[r],C1[r+1]);b=MX3(b,C1[r+2],C1[r+3]);} \
      float rm=__builtin_fmaxf(a,b); { auto rr=__builtin_amdgcn_permlane32_swap(__float_as_uint(rm),__float_as_uint(rm),false,false); rm=__builtin_fmaxf(__uint_as_float(rr[0]),__uint_as_float(rr[1])); } \
      resc=false; \
      if(__builtin_expect(__any(rm>(float)THRL),0)){ const float dl=__builtin_fmaxf(rm,0.f); mhat+=dl; \
        _Pragma("unroll") for(int r=0;r<16;++r){C0[r]-=dl;C1[r]-=dl;} \
        qx=qref_frag(-mhat,hi); \
        const float f=__builtin_amdgcn_exp2f(-dl); l_reg*=f; if(hi==0)wsf[r32]=f; resc=true; } } \
    SBAR(); \
    GAPB(o[0]=__builtin_amdgcn_mfma_f32_32x32x16_bf16(PAF(0),VFR(0),o[0],0,0,0), C0,0); \
    GAPB(o[1]=__builtin_amdgcn_mfma_f32_32x32x16_bf16(PAF(0),VFR(4),o[1],0,0,0), C0,4); \
    KRD(GL,0); GAPB(o[0]=__builtin_amdgcn_mfma_f32_32x32x16_bf16(PAF(1),VFR(1),o[0],0,0,0), C0,8); \
    KRD(GL,1); GAPB(o[1]=__builtin_amdgcn_mfma_f32_32x32x16_bf16(PAF(1),VFR(5),o[1],0,0,0), C0,12); \
    KRD(GL,2); GAPB(o[0]=__builtin_amdgcn_mfma_f32_32x32x16_bf16(PAF(2),VFR(2),o[0],0,0,0), C1,0); \
    KRD(GL,3); GAPB(o[1]=__builtin_amdgcn_mfma_f32_32x32x16_bf16(PAF(2),VFR(6),o[1],0,0,0), C1,4); \
    GAPB(o[0]=__builtin_amdgcn_mfma_f32_32x32x16_bf16(PAF(3),VFR(3),o[0],0,0,0), C1,8); \
    GAPB(o[1]=__builtin_amdgcn_mfma_f32_32x32x16_bf16(PAF(3),VFR(7),o[1],0,0,0), C1,12); \
    }while(0)
  int t=1;
  #undef CMASK
  #define CMASK(P0,P1,t) do{}while(0)
  for(;t+5<NT;t+=2){
    STEP(pB0,pB1,pA0,pA1,t,true,true,true);     WAIT_BAR(2); RESC(); ROT();
    STEP(pA0,pA1,pB0,pB1,t+1,true,true,true);   WAIT_BAR(2); RESC(); ROT();
  }
  #undef CMASK
  #define CMASK(P0,P1,t) do{int jb_=(t)-(NT-4); if(jb_>=0)cmask(P0,P1,jb_,qrel,hi);}while(0)
  #define ENDW(tt) do{ if((tt)+3<NT){WAIT_BAR(2);} else if((tt)+2<NT){WAIT_BAR(1);} else {WAIT_BAR(0);} }while(0)
  for(;t+1<NT;t+=2){
    STEP(pB0,pB1,pA0,pA1,t,(t+3<NT),(t+1<NT),(t+1<NT));       ENDW(t);   RESC(); ROT();
    STEP(pA0,pA1,pB0,pB1,t+1,(t+4<NT),(t+2<NT),(t+2<NT));     ENDW(t+1); RESC(); ROT();
  }
  STEP(pB0,pB1,pA0,pA1,NT-1,false,false,false); RESC();
  { float sacc=pB0[0]+pB0[1]; _Pragma("unroll") for(int r=2;r<16;++r)sacc+=pB0[r]; _Pragma("unroll") for(int r=0;r<16;++r)sacc+=pB1[r]; l_reg+=sacc;
    pw0=(u32x4){PKW(pB0,0),PKW(pB0,2),PKW(pB0,4),PKW(pB0,6)};pw1=(u32x4){PKW(pB0,8),PKW(pB0,10),PKW(pB0,12),PKW(pB0,14)};pw2=(u32x4){PKW(pB1,0),PKW(pB1,2),PKW(pB1,4),PKW(pB1,6)};pw3=(u32x4){PKW(pB1,8),PKW(pB1,10),PKW(pB1,12),PKW(pB1,14)};
    SBAR(); pv(o,vb0+sl_cur,PAF(0),PAF(1),PAF(2),PAF(3)); }
  #undef PKW
  #undef PAF
  #undef VFR
  #undef PIN
  #undef MX3
  #undef GAPA
  #undef GAPB
  #undef EX
  #undef VRD
  #undef KRD
  #undef STEP
  #undef ENDW
  {auto rr=__builtin_amdgcn_permlane32_swap(__float_as_uint(l_reg),__float_as_uint(l_reg),false,false);l_reg=__uint_as_float(rr[0])+__uint_as_float(rr[1]);}
  if(hi==0)wsf[32+r32]=l_reg;asm volatile("s_waitcnt lgkmcnt(0)":::"memory");
  float rli[16];
  #pragma unroll
  for(int r=0;r<16;++r)rli[r]=__builtin_amdgcn_rcpf(wsf[32+crow(r,hi)]);
  bf16*Ow=O+(rowbase+q0+wid*QBLK)*OPITCH+h*D;
  { bf16*stg=(bf16*)(shm+LDS_OST)+wid*2048;
    #pragma unroll
    for(int r=0;r<16;++r){const int orow=crow(r,hi);
      #pragma unroll
      for(int d0=0;d0<2;++d0)stg[orow*64+d0*32+r32]=__float2bfloat16(o[d0][r]*rli[r]);}
    asm volatile("s_waitcnt lgkmcnt(0)":::"memory");
    #pragma unroll
    for(int i=0;i<4;++i){const int row=i*8+(lane>>3),ch=lane&7; const u32x4 v=*(const u32x4*)(stg+row*64+ch*8); ATTN_STORE16(Ow+(long)row*OPITCH+ch*8,v);} }
  asm volatile("s_waitcnt lgkmcnt(0)\n\ts_barrier":::"memory");
  #undef DMA_K
  #undef DMA_V
  #undef CMASK
  #undef START
  #undef RESC
  #undef ROT
}
constexpr int ATTN_LDS_BYTES=LDS_BYTES;
struct AttnTensors { const bf16* Q; const bf16* K; const bf16* V; bf16* O; const float* LF; const unsigned* NRM; };
struct AttnUnit { int bh; int qb; };
struct StaticOrder {
  int vcu,grid;
  __device__ __forceinline__ explicit StaticOrder(int grid_,int block):vcu((grid_%8==0)?(block%8)*(grid_/8)+block/8:block),grid(grid_){}
  __device__ __forceinline__ bool next(int i,AttnUnit&u)const{
    if(grid==256){ if(i>=4)return false; const int s=vcu&3; u.bh=vcu>>2; u.qb=(i==0)?s:(i==1)?7-s:(i==2)?8+s:15-s; return true; }
    const int L=i*grid+vcu; if(L>=BATCH*NHEAD*NQB)return false; u.bh=L/NQB; u.qb=L%NQB; return true; }
  __device__ __forceinline__ void a_ready(const AttnUnit&)const{}
  __device__ __forceinline__ void done(const AttnUnit&)const{}
};
template<class Sched,int THRL=8> __device__ __forceinline__ void attn_phase(char*lds,const AttnTensors&T,const Sched&S){
  AttnUnit u; int cur_bh=-1;
  for(int i=0;S.next(i,u);++i){ S.a_ready(u); if(u.bh!=cur_bh){ fox_bias_table(u.bh/NHEAD,u.bh%NHEAD,T.LF,lds); cur_bh=u.bh; }
    attn_unit<THRL>(u.bh/NHEAD,u.bh%NHEAD,u.qb,T.Q,T.K,T.V,T.O,T.LF,T.NRM,lds); S.done(u); }
}
template<int THRL=8> __device__ __forceinline__ void attn_phase_dyn(char*lds,const AttnTensors&T,unsigned*qheads,volatile int*slot,int grp){
  int cur_bh=-1; const int NU=NHEAD*NQB; unsigned*qhead=qheads+64*grp;
  if(threadIdx.x==0) slot[0]=(int)__hip_atomic_fetch_add(qhead,1u,__ATOMIC_RELAXED,__HIP_MEMORY_SCOPE_AGENT);
  __syncthreads();
  int idx=__builtin_amdgcn_readfirstlane(slot[0]);
  while(idx<NU){
    __syncthreads();
    if(threadIdx.x==0) slot[0]=(int)__hip_atomic_fetch_add(qhead,1u,__ATOMIC_RELAXED,__HIP_MEMORY_SCOPE_AGENT);
    const int qb=NQB-1-idx/NHEAD, bh=grp*NHEAD+idx%NHEAD;
    if(bh!=cur_bh){ fox_bias_table(bh/NHEAD,bh%NHEAD,T.LF,lds); cur_bh=bh; }
    attn_unit<THRL>(bh/NHEAD,bh%NHEAD,qb,T.Q,T.K,T.V,T.O,T.LF,T.NRM,lds);
    __syncthreads();
    idx=__builtin_amdgcn_readfirstlane(slot[0]);
  }
}
#undef SBAR
#undef WAIT_BAR
}
namespace fx {
using namespace nv;
typedef unsigned short bf16;
typedef unsigned v4u __attribute__((ext_vector_type(4)));
typedef float f32x4 __attribute__((ext_vector_type(4)));
constexpr float C2 = 0.125f * 1.4426950408889634f;
constexpr int NIN = 3328;
constexpr int QKVP = 3072;
constexpr int P_FQ = 0, P_FK = 512, P_FV = 1024, P_GQ = 1536, P_GK = 1792, P_GV = 2048, P_GR = 2560;
__device__ __forceinline__ int inproj_src(int d) {
    if (d < 1536) return d;
    if (d < 1792) return O_GQ + (d - 1536);
    if (d < 2048) return O_GK + (d - 1792);
    if (d < 2560) return O_GV + (d - 2048);
    if (d < 3072) return O_GR + (d - 2560);
    if (d < 3080) return O_FF + (d - 3072);
    if (d < 3096) return O_GA + (d - 3080);
    return -1;
}
__device__ __forceinline__ unsigned f2bf(float f) { unsigned u = __builtin_bit_cast(unsigned, f); return (u + 0x7fffu + ((u >> 16) & 1u)) >> 16; }
__device__ __forceinline__ unsigned pk2(float lo, float hi) { return f2bf(lo) | (f2bf(hi) << 16); }
__device__ __forceinline__ float bf2f(unsigned short h) { return __builtin_bit_cast(float, (unsigned)h << 16); }
__device__ __forceinline__ float wave_sum(float v) {
#pragma unroll
    for (int o = 1; o < 64; o <<= 1) v += __shfl_xor(v, o);
    return v;
}
#define FX_LDS_WAIT() asm volatile("s_waitcnt lgkmcnt(0)" ::: "memory")

template <class Map> __device__ __forceinline__ void transpose_item(const float* __restrict__ W, int K, int N, bf16* WT, LAS float* scr, int kb, int nb, int lane, Map srcmap) {
    const int k0 = 64 * kb, n0 = 32 * nb;
    const int src = srcmap(n0 + (lane & 31));
#pragma unroll 8
    for (int i = 0; i < 32; ++i) { const int kk = 2 * i + (lane >> 5); scr[kk * 33 + (lane & 31)] = (src >= 0) ? W[(size_t)(k0 + kk) * N + src] : 0.f; }
    FX_LDS_WAIT(); asm volatile("" ::: "memory");
    const int c = lane & 7;
#pragma unroll
    for (int j = 0; j < 4; ++j) { const int n = (lane >> 3) + 8 * j; const LAS float* s = scr + (8 * c) * 33 + n;
        v4u o; o.x = pk2(s[0 * 33], s[1 * 33]); o.y = pk2(s[2 * 33], s[3 * 33]); o.z = pk2(s[4 * 33], s[5 * 33]); o.w = pk2(s[6 * 33], s[7 * 33]);
        *(GAS v4u*)(WT + (size_t)(n0 + n) * K + k0 + 8 * c) = o; }
    FX_LDS_WAIT(); asm volatile("" ::: "memory");
}

__device__ __forceinline__ void ln_row_bf16(const float* xrow, const float* __restrict__ g, const float* __restrict__ b, bf16* orow, float* frow, float* st, int lane) {
    const GAS f32x4* xr = (const GAS f32x4*)xrow + lane;
    f32x4 v[4]; float s = 0.f;
#pragma unroll
    for (int j = 0; j < 4; ++j) { v[j] = xr[64 * j]; s += (v[j].x + v[j].y) + (v[j].z + v[j].w); }
    const float mean = wave_sum(s) * (1.f / D); float s2 = 0.f;
#pragma unroll
    for (int j = 0; j < 4; ++j) { v[j] = v[j] - mean; s2 += (v[j].x * v[j].x + v[j].y * v[j].y) + (v[j].z * v[j].z + v[j].w * v[j].w); }
    const float rstd = 1.f / sqrtf(wave_sum(s2) * (1.f / D) + LN_EPS);
    if (st && lane == 0) { st[0] = mean; st[1] = rstd; }
    GAS unsigned long long* o8 = (GAS unsigned long long*)orow + lane;
#pragma unroll
    for (int j = 0; j < 4; ++j) {
        const f32x4 gg = ((const f32x4*)g)[lane + 64 * j], bb = ((const f32x4*)b)[lane + 64 * j];
        const f32x4 o = v[j] * rstd * gg + bb;
        o8[64 * j] = (unsigned long long)pk2(o.x, o.y) | ((unsigned long long)pk2(o.z, o.w) << 32);
        if (frow) ((GAS f32x4*)frow)[lane + 64 * j] = o;
    }
}

struct CvItem { const float* W; bf16* WT; int N, K, k0, n0, s0; };
__device__ __forceinline__ void cv_load(const CvItem& it, f32x4 (&v)[8], int lane) {
    const float* p = it.W + (size_t)(it.k0 + (lane >> 3)) * it.N + it.s0 + 4 * (lane & 7);
#pragma unroll
    for (int i = 0; i < 8; ++i) v[i] = __builtin_nontemporal_load((const f32x4*)(p + (size_t)(8 * i) * it.N));
}
__device__ __forceinline__ void cv_finish(const CvItem& it, const f32x4 (&v)[8], LAS float* scr, int lane) {
    const int rr = lane >> 3, cq = lane & 7;
#pragma unroll
    for (int i = 0; i < 8; ++i) { LAS float* d = scr + (8 * i + rr) * 33 + 4 * cq; d[0] = v[i][0]; d[1] = v[i][1]; d[2] = v[i][2]; d[3] = v[i][3]; }
    FX_LDS_WAIT(); asm volatile("" ::: "memory");
    const int c = lane & 7;
#pragma unroll
    for (int j = 0; j < 4; ++j) { const int n = (lane >> 3) + 8 * j; const LAS float* s = scr + (8 * c) * 33 + n;
        v4u o; o.x = pk2(s[0 * 33], s[1 * 33]); o.y = pk2(s[2 * 33], s[3 * 33]); o.z = pk2(s[4 * 33], s[5 * 33]); o.w = pk2(s[6 * 33], s[7 * 33]);
        __builtin_nontemporal_store(o, (GAS v4u*)(it.WT + (size_t)(it.n0 + n) * it.K + it.k0 + 8 * c)); }
    FX_LDS_WAIT(); asm volatile("" ::: "memory");
}

template <int NR> __device__ __forceinline__ void ln_rows_bf16(const float* xrows, const float* __restrict__ g, const float* __restrict__ b, bf16* orows, int lane) {
    f32x4 v[NR][4];
#pragma unroll
    for (int r = 0; r < NR; ++r)
#pragma unroll
        for (int j = 0; j < 4; ++j) v[r][j] = ((const GAS f32x4*)(xrows + (size_t)r * D))[lane + 64 * j];
    f32x4 gg[4], bb[4];
#pragma unroll
    for (int j = 0; j < 4; ++j) { gg[j] = ((const f32x4*)g)[lane + 64 * j]; bb[j] = ((const f32x4*)b)[lane + 64 * j]; }
#pragma unroll
    for (int r = 0; r < NR; ++r) {
        float s = 0.f;
#pragma unroll
        for (int j = 0; j < 4; ++j) s += (v[r][j].x + v[r][j].y) + (v[r][j].z + v[r][j].w);
        const float mean = wave_sum(s) * (1.f / D); float s2 = 0.f;
#pragma unroll
        for (int j = 0; j < 4; ++j) { v[r][j] = v[r][j] - mean; s2 += (v[r][j].x * v[r][j].x + v[r][j].y * v[r][j].y) + (v[r][j].z * v[r][j].z + v[r][j].w * v[r][j].w); }
        const float rstd = 1.f / sqrtf(wave_sum(s2) * (1.f / D) + LN_EPS);
        GAS unsigned long long* o8 = (GAS unsigned long long*)(orows + (size_t)r * D) + lane;
#pragma unroll
        for (int j = 0; j < 4; ++j) { const f32x4 o = v[r][j] * rstd * gg[j] + bb[j];
            o8[64 * j] = (unsigned long long)pk2(o.x, o.y) | ((unsigned long long)pk2(o.z, o.w) << 32); }
    }
}

template <int NR> __device__ __forceinline__ void ln1_rows_bf16(const float* xrows, const float* st, const float* __restrict__ gi, const float* __restrict__ bi, const bf16* mixrows,
                                                               const float* __restrict__ g1, const float* __restrict__ b1, bf16* orows, float alpha, int lane) {
    f32x4 v[NR][4]; unsigned long long mx[NR][4]; float mean0[NR], rstd0[NR];
#pragma unroll
    for (int r = 0; r < NR; ++r) { mean0[r] = st[2 * r]; rstd0[r] = st[2 * r + 1];
#pragma unroll
        for (int j = 0; j < 4; ++j) { v[r][j] = ((const GAS f32x4*)(xrows + (size_t)r * D))[lane + 64 * j]; mx[r][j] = ((const GAS unsigned long long*)(mixrows + (size_t)r * D))[lane + 64 * j]; } }
    f32x4 gi4[4], bi4[4];
#pragma unroll
    for (int j = 0; j < 4; ++j) { gi4[j] = ((const f32x4*)gi)[lane + 64 * j] * alpha; bi4[j] = ((const f32x4*)bi)[lane + 64 * j] * alpha; }
#pragma unroll
    for (int r = 0; r < NR; ++r) {
        float s = 0.f;
#pragma unroll
        for (int j = 0; j < 4; ++j) { const unsigned lo = (unsigned)mx[r][j], hi = (unsigned)(mx[r][j] >> 32);
            f32x4 mv; mv.x = __builtin_bit_cast(float, lo << 16); mv.y = __builtin_bit_cast(float, lo & 0xffff0000u); mv.z = __builtin_bit_cast(float, hi << 16); mv.w = __builtin_bit_cast(float, hi & 0xffff0000u);
            v[r][j] = ((v[r][j] - mean0[r]) * rstd0[r]) * gi4[j] + bi4[j] + mv;
            s += (v[r][j].x + v[r][j].y) + (v[r][j].z + v[r][j].w); }
        const float mean = wave_sum(s) * (1.f / D); float s2 = 0.f;
#pragma unroll
        for (int j = 0; j < 4; ++j) { v[r][j] = v[r][j] - mean; s2 += (v[r][j].x * v[r][j].x + v[r][j].y * v[r][j].y) + (v[r][j].z * v[r][j].z + v[r][j].w * v[r][j].w); }
        const float rstd = 1.f / sqrtf(wave_sum(s2) * (1.f / D) + LN_EPS);
        GAS unsigned long long* o8 = (GAS unsigned long long*)(orows + (size_t)r * D) + lane;
#pragma unroll
        for (int j = 0; j < 4; ++j) { const f32x4 gg = ((const f32x4*)g1)[lane + 64 * j], bb = ((const f32x4*)b1)[lane + 64 * j]; const f32x4 o = v[r][j] * rstd * gg + bb;
            o8[64 * j] = (unsigned long long)pk2(o.x, o.y) | ((unsigned long long)pk2(o.z, o.w) << 32); }
    }
}
}

namespace pg8 {
struct EpiInProj {
    static constexpr bool PERM = true, AFTER_DRAIN = false;
    bf16_t* QKV; float* FG; float* LF; const float* bfg; unsigned* NRM;
    __device__ __forceinline__ void operator()(const f32x4 (&acc)[2][2][4][2], const Unit& u, int wr, int wc, int fr, int fq) const {
        const int row0 = u.pm * BM + wr * 64 + fr;
        if (u.pn < 12) {
            const float sc = (u.pn < 2) ? fx::C2 : 1.f;
            const int col0 = u.pn * BM + wc * 32 + 8 * fq;
            float nmax[2] = {0.f, 0.f};
#pragma unroll
            for (int ai = 0; ai < 2; ++ai)
#pragma unroll
                for (int m = 0; m < 4; ++m) { bf16_t* rowp = QKV + (size_t)(row0 + ai * HALF + m * 16) * fx::QKVP + col0;
#pragma unroll
                    for (int bj = 0; bj < 2; ++bj) { const f32x4 v0 = acc[ai][bj][m][0] * sc, v1 = acc[ai][bj][m][1] * sc;
                        u32x4 w; w.x = cvt_pk_bf16(v0[0], v0[1]); w.y = cvt_pk_bf16(v0[2], v0[3]); w.z = cvt_pk_bf16(v1[0], v1[1]); w.w = cvt_pk_bf16(v1[2], v1[3]);
                        *(u32x4*)(rowp + bj * HALF) = w;
                        if (u.pn < 4) { const f32x4 q0 = v0 * v0, q1 = v1 * v1; float s = (q0[0] + q0[1]) + (q0[2] + q0[3]) + (q1[0] + q1[1]) + (q1[2] + q1[3]);
                            s += __shfl_xor(s, 16); s += __shfl_xor(s, 32);
                            nmax[bj] = fmaxf(nmax[bj], s); } } }
            if (u.pn < 4) {
#pragma unroll
                for (int bj = 0; bj < 2; ++bj) { float s = nmax[bj];
#pragma unroll
                    for (int o = 1; o < 16; o <<= 1) s = fmaxf(s, __shfl_xor(s, o));
                    if (fr == 0 && fq == 0) { const int b = (u.pm * BM) >> 12, head = 4 * (u.pn & 1) + 2 * bj + (wc >> 1);
                        atomicMax(NRM + (b * 8 + head) * 4 + (u.pn >= 2 ? 2 : 0) + (wc & 1), __builtin_bit_cast(unsigned, s)); } }
            }
        } else if (wc == 0 && fq < 3) {
#pragma unroll
            for (int ai = 0; ai < 2; ++ai)
#pragma unroll
                for (int m = 0; m < 4; ++m) { const int row = row0 + ai * HALF + m * 16; float* p = FG + (size_t)row * 32 + 8 * fq;
                    *(f32x4*)p = acc[ai][0][m][0]; *(f32x4*)(p + 4) = acc[ai][0][m][1];
                    if (fq == 0) { const int b = row >> 12, s = row & 4095;
#pragma unroll
                        for (int n = 0; n < 2; ++n)
#pragma unroll
                            for (int i = 0; i < 4; ++i) { const int h = 4 * n + i; LF[(size_t)(b * 8 + h) * nv::S + s] = 1.4426950408889634f * nv::logsigmoidf(acc[ai][0][m][n][i] + bfg[h]); } } }
        }
    }
};
}
namespace gl {
using namespace nv;
typedef unsigned short bf16;
typedef short bf16x8 __attribute__((ext_vector_type(8)));
typedef float f32x4 __attribute__((ext_vector_type(4)));
typedef unsigned u32x4 __attribute__((ext_vector_type(4)));
typedef unsigned u32x2 __attribute__((ext_vector_type(2)));
constexpr int NCH = S / 64;
constexpr int NUNIT = B * GH * NCH;
constexpr int LS = 72;
constexpr int L_WGU = 0, L_BG = 4096, L_DECS = 4352, L_QP = 8192, L_KP = L_QP + 64 * LS * 2, L_KPT = L_KP + 64 * LS * 2, L_VT = L_KPT + 64 * LS * 2, L_PP = L_VT + 128 * LS * 2, L_WT = L_PP + 64 * LS * 2, L_END = L_WT + 2048;
static_assert(L_END <= 131072, "gla prep LDS");
constexpr int C_ST = 0, C_PART = 128 * LS * 2, C_END = C_PART + 2 * 8 * 64 * 4;
constexpr size_t QPG_B = 64 * 64 * 2, OI_B = 8 * 4 * 64 * 16, UU_B = OI_B, DEC_B = 256;

__device__ __forceinline__ unsigned pkbf(float lo, float hi) { typedef float f2 __attribute__((ext_vector_type(2))); typedef __bf16 b2 __attribute__((ext_vector_type(2))); f2 v = {lo, hi}; b2 r = __builtin_convertvector(v, b2); return __builtin_bit_cast(unsigned, r); }
__device__ __forceinline__ float bf2f(unsigned short h) { return __builtin_bit_cast(float, (unsigned)h << 16); }
__device__ __forceinline__ float bflo(unsigned w) { return __builtin_bit_cast(float, w << 16); }
__device__ __forceinline__ float bfhi(unsigned w) { return __builtin_bit_cast(float, w & 0xffff0000u); }
__device__ __forceinline__ float fast_logsig2(float x) { return -__builtin_amdgcn_logf(1.f + __builtin_amdgcn_exp2f(-1.4426950408889634f * x)); }

__device__ __forceinline__ void prep_unit(int unit, const bf16* QKV, const float* FG, const float* __restrict__ wgu, const float* __restrict__ bgate,
                                          unsigned char* QPG, unsigned char* OI, unsigned char* UU, float* DEC, unsigned char* lds, int& cur_h, f32x4 (&Sagg)[4], f32x4 (&Dagg)[4]) {
    int tid_ = threadIdx.x; asm volatile("" : "+v"(tid_));
    const int tid = tid_, lane = tid & 63, wid = __builtin_amdgcn_readfirstlane(tid >> 6), l15 = lane & 15, g = lane >> 4;
    const int n = unit % NCH, bh = unit / NCH, h = bh % GH, b = bh / GH;
    const size_t row0 = (size_t)b * S + (size_t)n * 64;
    float* WGU = (float*)(lds + L_WGU); float* BG = (float*)(lds + L_BG); float* WT = (float*)(lds + L_WT);
    bf16* QP = (bf16*)(lds + L_QP); bf16* KP = (bf16*)(lds + L_KP); bf16* KPT = (bf16*)(lds + L_KPT); bf16* VT = (bf16*)(lds + L_VT); bf16* PP = (bf16*)(lds + L_PP);
    if (cur_h != h) { __syncthreads(); for (int i = tid; i < 16 * 64; i += 512) WGU[i] = wgu[(i >> 6) * 256 + h * 64 + (i & 63)]; if (tid < 64) BG[tid] = bgate[h * 64 + tid]; cur_h = h; __syncthreads(); }
    const int t = tid >> 3, oc = tid & 7, d0 = oc * 8;
    float la[8];
    { const float* gp = FG + (row0 + t) * 32 + 8;
      f32x4 ga4[4];
#pragma unroll
      for (int i = 0; i < 4; ++i) ga4[i] = *(const f32x4*)(gp + 4 * i);
#pragma unroll
      for (int j = 0; j < 8; ++j) la[j] = BG[d0 + j];
#pragma unroll
      for (int r = 0; r < 16; ++r) { const float gv = ga4[r >> 2][r & 3]; const f32x4 w0 = *(const f32x4*)(WGU + r * 64 + d0), w1 = *(const f32x4*)(WGU + r * 64 + d0 + 4);
#pragma unroll
          for (int j = 0; j < 4; ++j) { la[j] += gv * w0[j]; la[4 + j] += gv * w1[j]; } }
#pragma unroll
      for (int j = 0; j < 8; ++j) la[j] = fast_logsig2(la[j]) * (1.f / 16.f); }
    const u32x4 qv = *(const u32x4*)(QKV + (row0 + t) * fx::QKVP + fx::P_GQ + h * 64 + d0);
    const u32x4 kv = *(const u32x4*)(QKV + (row0 + t) * fx::QKVP + fx::P_GK + h * 64 + d0);
    const u32x4 vv0 = *(const u32x4*)(QKV + (row0 + t) * fx::QKVP + fx::P_GV + h * 128 + oc * 16);
    const u32x4 vv1 = *(const u32x4*)(QKV + (row0 + t) * fx::QKVP + fx::P_GV + h * 128 + oc * 16 + 8);
#pragma unroll
    for (int off = 8; off < 64; off <<= 1) {
#pragma unroll
        for (int j = 0; j < 8; ++j) { const float o = __shfl_up(la[j], off); if (lane >= off) la[j] += o; } }
    if (lane >= 56) {
#pragma unroll
        for (int j = 0; j < 8; ++j) WT[wid * 64 + d0 + j] = la[j]; }
    __syncthreads();
    float bl[8];
#pragma unroll
    for (int j = 0; j < 8; ++j) bl[j] = 0.f;
#pragma unroll
    for (int w = 0; w < 8; ++w) {
        const f32x4 a0 = *(const f32x4*)(WT + w * 64 + d0), a1 = *(const f32x4*)(WT + w * 64 + d0 + 4);
#pragma unroll
        for (int j = 0; j < 4; ++j) { bl[j] += a0[j]; bl[4 + j] += a1[j]; if (w < wid) { la[j] += a0[j]; la[4 + j] += a1[j]; } } }
    {
        const unsigned qw[4] = {qv.x, qv.y, qv.z, qv.w}, kw[4] = {kv.x, kv.y, kv.z, kv.w};
        float qf[8], kf[8];
#pragma unroll
        for (int i = 0; i < 4; ++i) { qf[2 * i] = bflo(qw[i]); qf[2 * i + 1] = bfhi(qw[i]); kf[2 * i] = bflo(kw[i]); kf[2 * i + 1] = bfhi(kw[i]); }
        float qp[8], kp[8], kpp[8];
#pragma unroll
        for (int j = 0; j < 8; ++j) { const float bb = la[j], bbl = bl[j];
            qp[j] = qf[j] * (0.125f * __builtin_amdgcn_exp2f(bb)); kp[j] = kf[j] * __builtin_amdgcn_exp2f(-bb); kpp[j] = kf[j] * __builtin_amdgcn_exp2f(bbl - bb); }
        u32x4 qo, ko; qo.x = pkbf(qp[0], qp[1]); qo.y = pkbf(qp[2], qp[3]); qo.z = pkbf(qp[4], qp[5]); qo.w = pkbf(qp[6], qp[7]);
        ko.x = pkbf(kp[0], kp[1]); ko.y = pkbf(kp[2], kp[3]); ko.z = pkbf(kp[4], kp[5]); ko.w = pkbf(kp[6], kp[7]);
        *(u32x4*)(QP + t * LS + d0) = qo; *(u32x4*)(KP + t * LS + d0) = ko;
        *(u32x4*)(QPG + (size_t)unit * QPG_B + (size_t)(t * 64 + d0) * 2) = qo;
#pragma unroll
        for (int j = 0; j < 8; ++j) KPT[(d0 + j) * LS + t] = (bf16)(pkbf(kpp[j], 0.f) & 0xffffu);
        const unsigned vw[8] = {vv0.x, vv0.y, vv0.z, vv0.w, vv1.x, vv1.y, vv1.z, vv1.w};
#pragma unroll
        for (int i = 0; i < 8; ++i) { VT[(oc * 16 + 2 * i) * LS + t] = (bf16)(vw[i] & 0xffffu); VT[(oc * 16 + 2 * i + 1) * LS + t] = (bf16)(vw[i] >> 16); }
        if (t == 0) {
#pragma unroll
            for (int j = 0; j < 8; ++j) { const float dc = __builtin_amdgcn_exp2f(bl[j]); DEC[(size_t)unit * 64 + d0 + j] = dc; ((float*)(lds + L_DECS))[d0 + j] = dc; } }
    }
    __syncthreads();
    { const int ti = wid >> 1;
#pragma unroll
      for (int q2 = 0; q2 < 2; ++q2) { const int sj = 2 * (wid & 1) + q2;
          f32x4 acc = {0.f, 0.f, 0.f, 0.f};
          if (sj <= ti) {
#pragma unroll
              for (int ks = 0; ks < 2; ++ks) { const bf16x8 a = *(const bf16x8*)(QP + (16 * ti + l15) * LS + 32 * ks + 8 * g), bb = *(const bf16x8*)(KP + (16 * sj + l15) * LS + 32 * ks + 8 * g);
                  acc = __builtin_amdgcn_mfma_f32_16x16x32_bf16(a, bb, acc, 0, 0, 0); }
              if (sj == ti) {
#pragma unroll
                  for (int r = 0; r < 4; ++r) if (l15 > 4 * g + r) acc[r] = 0.f; }
          }
#pragma unroll
          for (int r = 0; r < 4; ++r) PP[(16 * ti + 4 * g + r) * LS + 16 * sj + l15] = (bf16)(pkbf(acc[r], 0.f) & 0xffffu);
      } }
    __syncthreads();
    { bf16x8 vb[2];
#pragma unroll
      for (int ks = 0; ks < 2; ++ks) vb[ks] = *(const bf16x8*)(VT + (16 * wid + l15) * LS + 32 * ks + 8 * g);
#pragma unroll
      for (int m = 0; m < 4; ++m) { f32x4 acc = {0.f, 0.f, 0.f, 0.f};
#pragma unroll
          for (int ks = 0; ks < 2; ++ks) { const bf16x8 a = *(const bf16x8*)(PP + (16 * m + l15) * LS + 32 * ks + 8 * g); acc = __builtin_amdgcn_mfma_f32_16x16x32_bf16(a, vb[ks], acc, 0, 0, 0); }
          *(f32x4*)(OI + (size_t)unit * OI_B + (size_t)((wid * 4 + m) * 64 + lane) * 16) = acc; }
#pragma unroll
      for (int db = 0; db < 4; ++db) { f32x4 acc = {0.f, 0.f, 0.f, 0.f};
#pragma unroll
          for (int ks = 0; ks < 2; ++ks) { const bf16x8 a = *(const bf16x8*)(KPT + (16 * db + l15) * LS + 32 * ks + 8 * g); acc = __builtin_amdgcn_mfma_f32_16x16x32_bf16(a, vb[ks], acc, 0, 0, 0); }
          *(f32x4*)(UU + (size_t)unit * UU_B + (size_t)((wid * 4 + db) * 64 + lane) * 16) = acc;
          const f32x4 dcv = *(const f32x4*)((const float*)(lds + L_DECS) + 16 * db + 4 * g);
          Sagg[db] = dcv * Sagg[db] + acc; Dagg[db] = Dagg[db] * dcv; }
    }
}


__device__ __forceinline__ void prep_block(int blk, const bf16* QKV, const float* FG, const float* __restrict__ wgu, const float* __restrict__ bgate,
                                           unsigned char* QPG, unsigned char* OI, unsigned char* UU, float* DEC, unsigned char* AGG, float* DAGG, unsigned char* lds, int& cur_h) {
    f32x4 Sagg[4], Dagg[4];
#pragma unroll
    for (int db = 0; db < 4; ++db) { Sagg[db] = (f32x4){0.f, 0.f, 0.f, 0.f}; Dagg[db] = (f32x4){1.f, 1.f, 1.f, 1.f}; }
    for (int i = 0; i < 8; ++i) prep_unit(blk * 8 + i, QKV, FG, wgu, bgate, QPG, OI, UU, DEC, lds, cur_h, Sagg, Dagg);
    int tid_ = threadIdx.x; asm volatile("" : "+v"(tid_));
    const int lane = tid_ & 63, wid = __builtin_amdgcn_readfirstlane(tid_ >> 6), l15 = lane & 15, g = lane >> 4;
#pragma unroll
    for (int db = 0; db < 4; ++db) { *(f32x4*)(AGG + (size_t)blk * UU_B + (size_t)((wid * 4 + db) * 64 + lane) * 16) = Sagg[db];
        if (wid == 0 && l15 == 0) *(f32x4*)(DAGG + (size_t)blk * 64 + 16 * db + 4 * g) = Dagg[db]; }
}
constexpr int GS = 136;
constexpr int PO_GR = 0, PO_YT = 64 * GS * 2, PO_PART = 2 * 64 * GS * 2, PO_ST = PO_PART + 8 * 64 * 4, PO_END = PO_ST + 128 * LS * 2;
__device__ __forceinline__ void post_block(int u0, int NB, const bf16* QKV, const unsigned char* QPG, const unsigned char* OI, const unsigned char* UU, const float* DEC, const unsigned char* AGG, const float* DAGG, const float* __restrict__ gnorm, bf16* Y, unsigned char* lds) {
    int tid_ = threadIdx.x; asm volatile("" : "+v"(tid_));
    const int tid = tid_, lane = tid & 63, wid = __builtin_amdgcn_readfirstlane(tid >> 6), l15 = lane & 15, g = lane >> 4;
    const int n0 = u0 % NCH, bh = u0 / NCH, h = bh % GH, b = bh / GH;
    bf16* GRs = (bf16*)(lds + PO_GR); bf16* YT = (bf16*)(lds + PO_YT); float* PART = (float*)(lds + PO_PART); bf16* ST = (bf16*)(lds + PO_ST);
    const int t = tid >> 3, oc = tid & 7, e = 16 * wid + l15;
    const float gn = gnorm[e];
    f32x4 Sa[4];
#pragma unroll
    for (int db = 0; db < 4; ++db) Sa[db] = (f32x4){0.f, 0.f, 0.f, 0.f};
    { const int seg0 = bh * (NCH / 8), nseg = n0 / 8;
      for (int i = 0; i < nseg; ++i) {
          f32x4 Ua[4], Da[4];
#pragma unroll
          for (int db = 0; db < 4; ++db) { Ua[db] = *(const f32x4*)(AGG + (size_t)(seg0 + i) * UU_B + (size_t)((wid * 4 + db) * 64 + lane) * 16); Da[db] = *(const f32x4*)(DAGG + (size_t)(seg0 + i) * 64 + 16 * db + 4 * g); }
#pragma unroll
          for (int db = 0; db < 4; ++db) Sa[db] = Da[db] * Sa[db] + Ua[db]; } }
    for (int i = 0; i < NB; ++i) {
        const int unit = u0 + i; const size_t row0 = (size_t)b * S + (size_t)(n0 + i) * 64;
        const u32x4 g0 = *(const u32x4*)(QKV + (row0 + t) * fx::QKVP + fx::P_GR + h * 128 + oc * 16), g1 = *(const u32x4*)(QKV + (row0 + t) * fx::QKVP + fx::P_GR + h * 128 + oc * 16 + 8);
        f32x4 o[4], Uf[4], dv[4]; bf16x8 qa[4][2], sb[2];
#pragma unroll
        for (int m = 0; m < 4; ++m) { o[m] = *(const f32x4*)(OI + (size_t)unit * OI_B + (size_t)((wid * 4 + m) * 64 + lane) * 16);
            Uf[m] = *(const f32x4*)(UU + (size_t)unit * UU_B + (size_t)((wid * 4 + m) * 64 + lane) * 16); dv[m] = *(const f32x4*)(DEC + (size_t)unit * 64 + 16 * m + 4 * g);
#pragma unroll
            for (int ks = 0; ks < 2; ++ks) qa[m][ks] = *(const bf16x8*)(QPG + (size_t)unit * QPG_B + (size_t)((16 * m + l15) * 64 + 32 * ks + 8 * g) * 2); }
#pragma unroll
        for (int db = 0; db < 4; ++db) *(u32x2*)(ST + e * LS + 16 * db + 4 * g) = (u32x2){pkbf(Sa[db][0], Sa[db][1]), pkbf(Sa[db][2], Sa[db][3])};
#pragma unroll
        for (int ks = 0; ks < 2; ++ks) sb[ks] = *(const bf16x8*)(ST + e * LS + 32 * ks + 8 * g);
        *(u32x4*)(GRs + t * GS + oc * 16) = g0; *(u32x4*)(GRs + t * GS + oc * 16 + 8) = g1;
#pragma unroll
        for (int m = 0; m < 4; ++m)
#pragma unroll
            for (int ks = 0; ks < 2; ++ks) o[m] = __builtin_amdgcn_mfma_f32_16x16x32_bf16(qa[m][ks], sb[ks], o[m], 0, 0, 0);
#pragma unroll
        for (int m = 0; m < 4; ++m) { f32x4 q = o[m] * o[m];
#pragma unroll
            for (int off = 1; off < 16; off <<= 1) { q[0] += __shfl_xor(q[0], off); q[1] += __shfl_xor(q[1], off); q[2] += __shfl_xor(q[2], off); q[3] += __shfl_xor(q[3], off); }
            if (l15 == 0) *(f32x4*)(PART + wid * 64 + 16 * m + 4 * g) = q; }
#pragma unroll
        for (int db = 0; db < 4; ++db) Sa[db] = dv[db] * Sa[db] + Uf[db];
        __syncthreads();
#pragma unroll
        for (int m = 0; m < 4; ++m) { f32x4 tot = {0.f, 0.f, 0.f, 0.f};
#pragma unroll
            for (int w = 0; w < 8; ++w) tot += *(const f32x4*)(PART + w * 64 + 16 * m + 4 * g);
#pragma unroll
            for (int r = 0; r < 4; ++r) { const int tt = 16 * m + 4 * g + r; const float rs = rsqrtf(tot[r] * (1.f / GV) + LN_EPS); const float gr = bf2f(GRs[tt * GS + e]);
                const float v = o[m][r] * rs * gn * (gr * __builtin_amdgcn_rcpf(1.f + __builtin_amdgcn_exp2f(-1.4426950408889634f * gr)));
                YT[tt * GS + e] = (bf16)(pkbf(v, 0.f) & 0xffffu); } }
        __syncthreads();
        { const u32x4 y0 = *(const u32x4*)(YT + t * GS + oc * 16), y1 = *(const u32x4*)(YT + t * GS + oc * 16 + 8);
          *(u32x4*)(Y + (row0 + t) * D + 512 + h * GV + oc * 16) = y0; *(u32x4*)(Y + (row0 + t) * D + 512 + h * GV + oc * 16 + 8) = y1; }
        __syncthreads();
    }
}
}
namespace mo {
using namespace nv;
typedef unsigned short bf16;
typedef float f32x4 __attribute__((ext_vector_type(4)));
typedef unsigned u32x4 __attribute__((ext_vector_type(4)));
constexpr int CAP = 8192;
constexpr int NEX = NE + 1;
constexpr int YSH = T * TOPK;
constexpr int L_TB = 132096, L_YB = L_TB + 1040, L_CN = L_YB + 1040, L_UT = 138240, L_RG = 141312;
typedef LAS int* lint;


constexpr int I_EG = NEX * 256, I_ED = NEX * 128, I_EXP = I_EG + I_ED;
struct ExpW { const float* eg; const float* eu; const float* ed; const float* sg; const float* su; const float* sd; bf16* WegT; bf16* WedT; };
__device__ __forceinline__ void cv_decode(int r, const ExpW& X, fx::CvItem& I) {
    if (r < I_EG) { const int e = r >> 8, kb = (r >> 4) & 15, nb = r & 15, c = nb >> 3, sub = nb & 7;
        I.W = (e < NE) ? ((sub < 4 ? X.eg : X.eu) + (size_t)e * D * ED) : (sub < 4 ? X.sg : X.su); I.WT = X.WegT + (size_t)e * 512 * D; I.N = ED; I.K = D; I.k0 = 64 * kb; I.n0 = 32 * nb; I.s0 = 128 * c + 32 * (sub & 3); }
    else { r -= I_EG; const int e = r >> 7, kb = (r >> 5) & 3, nb = r & 31; I.W = (e < NE) ? (X.ed + (size_t)e * ED * D) : X.sd; I.WT = X.WedT + (size_t)e * D * ED; I.N = D; I.K = ED; I.k0 = 64 * kb; I.n0 = 32 * nb; I.s0 = 32 * nb; }
}
__device__ __forceinline__ void expert_conv(const ExpW& X, LAS float* scr, int it0, int step, int lane) {
    int it = it0; fx::CvItem cur, nx; fx::f32x4 v[8], w[8];
    if (it < I_EXP) { cv_decode(it, X, cur); fx::cv_load(cur, v, lane); }
    while (it < I_EXP) { const int itn = it + step; if (itn < I_EXP) { cv_decode(itn, X, nx); fx::cv_load(nx, w, lane); }
        fx::cv_finish(cur, v, scr, lane); cur = nx;
#pragma unroll
        for (int i = 0; i < 8; ++i) v[i] = w[i];
        it = itn; }
}

__device__ __forceinline__ void moe_tables(const int* counts, lint tb, lint yb, lint cn, int lane) {
    int c[4], nt[4]; int st = 0, sy = 0, pt[4], py[4];
#pragma unroll
    for (int i = 0; i < 4; ++i) { c[i] = counts[lane * 4 + i]; c[i] = c[i] > CAP ? CAP : c[i]; nt[i] = (c[i] + 255) >> 8; pt[i] = st; py[i] = sy; st += nt[i]; sy += c[i]; }
    int it = st, iy = sy;
    for (int o = 1; o < 64; o <<= 1) { const int a = __shfl_up(it, o), b = __shfl_up(iy, o); if (lane >= o) { it += a; iy += b; } }
    const int bt = it - st, by = iy - sy;
#pragma unroll
    for (int i = 0; i < 4; ++i) { tb[lane * 4 + i] = bt + pt[i]; yb[lane * 4 + i] = by + py[i]; cn[lane * 4 + i] = c[i]; }
    if (lane == 63) { tb[256] = it; tb[257] = it + T / 256; yb[256] = YSH; cn[256] = T; }
}

__device__ __forceinline__ void route_token2(const float* LG, const float* __restrict__ rbias, int* lcnt, int* TK, float* TW, int t0, int lane) {
    const int l32 = lane & 31, hb = lane & 32, t = t0 + (lane >> 5);
    const float4 la = ((const float4*)(LG + (size_t)t * NE))[2 * l32], lb = ((const float4*)(LG + (size_t)t * NE))[2 * l32 + 1];
    const float4 ra = ((const float4*)rbias)[2 * l32], rb = ((const float4*)rbias)[2 * l32 + 1];
    const float lg[8] = {la.x, la.y, la.z, la.w, lb.x, lb.y, lb.z, lb.w}, rbv[8] = {ra.x, ra.y, ra.z, ra.w, rb.x, rb.y, rb.z, rb.w};
    float sc[8], bv[8];
#pragma unroll
    for (int i = 0; i < 8; ++i) { sc[i] = 1.f / (1.f + expf(-lg[i])); bv[i] = sc[i] + rbv[i]; }
    float m1 = fmaxf(bv[0], bv[1]), m2 = fminf(bv[0], bv[1]);
#pragma unroll
    for (int i = 2; i < 8; ++i) { const float n1 = fmaxf(m1, bv[i]); m2 = fmaxf(fminf(m1, bv[i]), m2); m1 = n1; }
#pragma unroll
    for (int o = 1; o < 4; o <<= 1) { const float p1 = __shfl_xor(m1, o), p2 = __shfl_xor(m2, o); const float n1 = fmaxf(m1, p1); m2 = fmaxf(fminf(m1, p1), fmaxf(m2, p2)); m1 = n1; }
    const float gs = m1 + m2;
    const int myg = l32 >> 2;
    int rank = 0;
#pragma unroll
    for (int g2 = 0; g2 < NG; ++g2) { const float og = __shfl(gs, hb + g2 * 4); if (og > gs || (og == gs && g2 < myg)) ++rank; }
    const bool sel = rank < 4;
    float mv[8];
#pragma unroll
    for (int i = 0; i < 8; ++i) mv[i] = sel ? bv[i] : -INFINITY;
    int mye = 0; float myw = 0.f; float wsum = 0.f;
#pragma unroll
    for (int k = 0; k < TOPK; ++k) {
        float bvv = mv[0]; int bi = 0;
#pragma unroll
        for (int i = 1; i < 8; ++i) if (mv[i] > bvv) { bvv = mv[i]; bi = i; }
        int gi = l32 * 8 + bi;
#pragma unroll
        for (int o = 16; o > 0; o >>= 1) { const float ov = __shfl_xor(bvv, o); const int oi = __shfl_xor(gi, o); if (ov > bvv || (ov == bvv && oi < gi)) { bvv = ov; gi = oi; } }
        const int ol = gi >> 3, oi = gi & 7;
        float s_own = sc[0];
#pragma unroll
        for (int i = 1; i < 8; ++i) s_own = (oi == i) ? sc[i] : s_own;
        const float sw = __shfl(s_own, hb + ol);
        if (l32 == ol) {
#pragma unroll
            for (int i = 0; i < 8; ++i) if (oi == i) mv[i] = -INFINITY; }
        if (l32 == k) { mye = gi; myw = sw; } wsum += sw;
    }
    if (l32 < TOPK) { const int lp = atomicAdd(&lcnt[mye], 1); TK[t * TOPK + l32] = mye | (lp << 9); TW[t * TOPK + l32] = myw * (2.5f / wsum); }
}
__device__ __forceinline__ void route_finish2(const int* lbase, int* list_tok, float* list_gate, int* TK, const float* TW, int t0, int lane) {
    const int l32 = lane & 31, t = t0 + (lane >> 5);
    if (l32 < TOPK) { const int tk = TK[t * TOPK + l32]; const int e = tk & 511, pos = lbase[e] + (tk >> 9);
        if (pos < CAP) { list_tok[e * CAP + pos] = t; list_gate[e * CAP + pos] = TW[t * TOPK + l32]; }
        TK[t * TOPK + l32] = e | (pos << 9); }
}

constexpr float YSC = 16.f;
__device__ __forceinline__ void combine_token(const bf16* H1, const unsigned char* Y, const int* TK, lint yb, const float* __restrict__ g, const float* __restrict__ b, float* out, int t, int lane) {
    typedef float f2 __attribute__((ext_vector_type(2)));
    float v[16], s[16];
    { const u32x4 a = *(const u32x4*)(H1 + (size_t)t * D + 16 * lane), c = *(const u32x4*)(H1 + (size_t)t * D + 16 * lane + 8);
      const unsigned w[8] = {a.x, a.y, a.z, a.w, c.x, c.y, c.z, c.w};
#pragma unroll
      for (int i = 0; i < 8; ++i) { v[2 * i] = ALPHA * __builtin_bit_cast(float, w[i] << 16); v[2 * i + 1] = ALPHA * __builtin_bit_cast(float, w[i] & 0xffff0000u); } }
#pragma unroll
    for (int i = 0; i < 16; ++i) s[i] = 0.f;
    int tk = (lane < TOPK) ? TK[t * TOPK + lane] : 0;
#pragma unroll
    for (int k = 0; k <= TOPK; ++k) {
        size_t yrow;
        if (k < TOPK) { const int x = __shfl(tk, k); yrow = (size_t)(yb[x & 511] + (x >> 9)); } else yrow = (size_t)YSH + t;
        const u32x4 a = *(const u32x4*)(Y + yrow * D + 16 * lane);
        const int w[4] = {(int)a.x, (int)a.y, (int)a.z, (int)a.w};
#pragma unroll
        for (int i = 0; i < 4; ++i) { const f2 lo = __builtin_amdgcn_cvt_pk_f32_fp8(w[i], false), hi = __builtin_amdgcn_cvt_pk_f32_fp8(w[i], true);
            s[4 * i] += lo[0]; s[4 * i + 1] += lo[1]; s[4 * i + 2] += hi[0]; s[4 * i + 3] += hi[1]; }
    }
    float sm = 0.f;
#pragma unroll
    for (int i = 0; i < 16; ++i) { v[i] += s[i] * (1.f / YSC); sm += v[i]; }
    const float mean = fx::wave_sum(sm) * (1.f / D); float q = 0.f;
#pragma unroll
    for (int i = 0; i < 16; ++i) { v[i] -= mean; q += v[i] * v[i]; }
    const float rstd = 1.f / sqrtf(fx::wave_sum(q) * (1.f / D) + LN_EPS);
#pragma unroll
    for (int i = 0; i < 4; ++i) { const f32x4 gg = *(const f32x4*)(g + 16 * lane + 4 * i), bb = *(const f32x4*)(b + 16 * lane + 4 * i);
        f32x4 o; o[0] = v[4 * i] * rstd * gg[0] + bb[0]; o[1] = v[4 * i + 1] * rstd * gg[1] + bb[1]; o[2] = v[4 * i + 2] * rstd * gg[2] + bb[2]; o[3] = v[4 * i + 3] * rstd * gg[3] + bb[3];
        *(f32x4*)(out + (size_t)t * D + 16 * lane + 4 * i) = o; }
}
}

namespace pg8 {
struct RouterSched {
    int rb; const bf16_t* Bt;
    __device__ __forceinline__ bool next(int i, Unit2& u) const { if (i > 0) return false; u.pm = rb; u.pn = 0; u.e = 0; u.cnt = 128; u.jt = 0; u.ui = 0; return true; }
    __device__ __forceinline__ int arow(const Unit2& u, int r) const { return u.pm * 128 + r; }
    __device__ __forceinline__ size_t aoff(const Unit2&) const { return 0; }
    __device__ __forceinline__ const char* bptr(const Unit2&) const { return (const char*)Bt; }
};
struct EpiLogits {
    static constexpr bool PERM = false, AFTER_DRAIN = false;
    float* LG;
    __device__ __forceinline__ void operator()(const f32x4 (&acc)[2][2][4][2], const Unit2& u, int wr, int wc, int fr, int fq) const {
        const int row0 = u.pm * 128 + wr * 64 + fr, col0 = wc * 32 + 4 * fq;
#pragma unroll
        for (int m = 0; m < 4; ++m) { float* rowp = LG + (size_t)(row0 + m * 16) * nv::NE + col0;
#pragma unroll
            for (int bj = 0; bj < 2; ++bj)
#pragma unroll
                for (int n = 0; n < 2; ++n) *(f32x4*)(rowp + bj * HALF + n * 16) = acc[0][bj][m][n]; }
    }
};
template <int PH> struct MoeSched {
    int G, vcu, nrt; mo::lint tb; mo::lint cn; const int* list_tok; const bf16_t* W; mo::lint ut; mo::lint rg;
    static constexpr int NC = PH == 0 ? 2 : 4;
    static constexpr int MAXU = 64;
    __device__ __forceinline__ void build(int lane) const {
        const int L = lane * G + vcu;
        if (lane < MAXU && L < nrt * NC) {
            const int rt = L / NC, c = L % NC;
            int lo = 0, hi = 256;
            while (lo < hi) { const int mid = (lo + hi + 1) >> 1; if (tb[mid] <= rt) lo = mid; else hi = mid - 1; }
            const int e = lo, jt = rt - tb[e], rem = cn[e] - 256 * jt;
            ut[4 * lane] = rt; ut[4 * lane + 1] = c; ut[4 * lane + 2] = e | (jt << 9); ut[4 * lane + 3] = rem < 256 ? rem : 256;
        }
    }
    __device__ __forceinline__ bool next(int i, Unit2& u) const {
        const int L = i * G + vcu; if (i >= MAXU || L >= nrt * NC) return false;
        const int x = ut[4 * i + 2];
        u.pm = __builtin_amdgcn_readfirstlane(ut[4 * i]); u.pn = __builtin_amdgcn_readfirstlane(ut[4 * i + 1]); u.e = __builtin_amdgcn_readfirstlane(x & 511); u.jt = __builtin_amdgcn_readfirstlane(x >> 9);
        u.cnt = __builtin_amdgcn_readfirstlane(ut[4 * i + 3]); u.ui = i; return true;
    }
    __device__ __forceinline__ void fill_rows(const float* list_gate, int tid) const {
        for (int i = 0; i < MAXU; ++i) { const int L = i * G + vcu; if (L >= nrt * NC) break;
            const int x = ut[4 * i + 2], e = x & 511, jt = x >> 9, cnt = ut[4 * i + 3];
            if (tid < 256) { const int r = tid; unsigned v;
                if (e == 256) v = (unsigned)(jt * BM + r) | (0x4180u << 16);
                else if (r < cnt) { const float gsc = mo::YSC * list_gate[e * mo::CAP + jt * BM + r]; v = (unsigned)list_tok[e * mo::CAP + jt * BM + r] | (fx::f2bf(gsc) << 16); }
                else v = 0u;
                rg[i * 256 + r] = (int)v; } }
    }
    __device__ __forceinline__ int arow(const Unit2& u, int r) const {
        if (PH == 1) return u.pm * BM + r;
        return rg[u.ui * 256 + r] & 0x7fff;
    }
    __device__ __forceinline__ size_t aoff(const Unit2& u) const { return PH == 1 ? (size_t)u.pm * (131072 - 32768) : 0; }
    __device__ __forceinline__ const char* bptr(const Unit2& u) const {
        return PH == 0 ? (const char*)(W + ((size_t)u.e * 512 + 256 * u.pn) * 1024) : (const char*)(W + ((size_t)u.e * 1024 + 256 * u.pn) * 256);
    }
};
struct EpiSwiGLU {
    static constexpr bool PERM = true, AFTER_DRAIN = false;
    bf16_t* H; mo::lint rg; int skip;
    __device__ __forceinline__ void operator()(const f32x4 (&acc)[2][2][4][2], const Unit2& u, int wr, int wc, int fr, int fq) const {
        if (skip) return;
        const int col0 = u.pn * 128 + wc * 32 + 8 * fq;
#pragma unroll
        for (int ai = 0; ai < 2; ++ai)
#pragma unroll
            for (int m = 0; m < 4; ++m) { const int r = ai * HALF + wr * 64 + m * 16 + fr;
                const float gt = __builtin_bit_cast(float, (unsigned)rg[u.ui * 256 + r] & 0xffff0000u);
                float hv[8];
#pragma unroll
                for (int n = 0; n < 2; ++n)
#pragma unroll
                    for (int i = 0; i < 4; ++i) { const float gg = acc[ai][0][m][n][i], uu = acc[ai][1][m][n][i]; hv[4 * n + i] = gt * uu * (gg * __builtin_amdgcn_rcpf(1.f + __builtin_amdgcn_exp2f(-1.4426950408889634f * gg))); }
                u32x4 w; w.x = cvt_pk_bf16(hv[0], hv[1]); w.y = cvt_pk_bf16(hv[2], hv[3]); w.z = cvt_pk_bf16(hv[4], hv[5]); w.w = cvt_pk_bf16(hv[6], hv[7]);
                *(u32x4*)(H + (size_t)u.pm * 65536 + (size_t)(col0 >> 6) * 16384 + r * 64 + (col0 & 63)) = w; }
    }
};
struct EpiDown {
    static constexpr bool PERM = true, AFTER_DRAIN = false;
    unsigned char* Y; mo::lint yb; int skip;
    __device__ __forceinline__ void operator()(const f32x4 (&acc)[2][2][4][2], const Unit2& u, int wr, int wc, int fr, int fq) const {
        if (skip) return;
        typedef unsigned u32x2v __attribute__((ext_vector_type(2)));
        const int col0 = u.pn * BM + wc * 32 + 8 * fq; const int ybase = yb[u.e] + u.jt * BM;
#pragma unroll
        for (int ai = 0; ai < 2; ++ai)
#pragma unroll
            for (int m = 0; m < 4; ++m) { const int r = ai * HALF + wr * 64 + m * 16 + fr;
                if (r < u.cnt) { unsigned char* rowp = Y + (size_t)(ybase + r) * nv::D + col0;
#pragma unroll
                    for (int bj = 0; bj < 2; ++bj) { const f32x4 v0 = acc[ai][bj][m][0], v1 = acc[ai][bj][m][1];
                        int w0 = __builtin_amdgcn_cvt_pk_fp8_f32(v0[0], v0[1], 0, false); w0 = __builtin_amdgcn_cvt_pk_fp8_f32(v0[2], v0[3], w0, true);
                        int w1 = __builtin_amdgcn_cvt_pk_fp8_f32(v1[0], v1[1], 0, false); w1 = __builtin_amdgcn_cvt_pk_fp8_f32(v1[2], v1[3], w1, true);
                        *(u32x2v*)(rowp + bj * HALF) = (u32x2v){(unsigned)w0, (unsigned)w1}; } } }
    }
};
}
constexpr int NTHR = 512;
constexpr int LDS_BYTES = 163840;
constexpr int MISC_OFF = 131072 + 320;
constexpr size_t MiB = 1u << 20;
constexpr size_t CTL_ZERO_BYTES = 96 * 1024;
constexpr int CW_BAR = 4096;
constexpr int CW_MOE = 16384;
constexpr int CW_FOXQ = 20992;
constexpr int CW_NRM = 20480;
constexpr int NPHASE = 9;
constexpr size_t WS_H1 = 1, WS_WR = 65, WS_STATS = 66, WS_LF = 67, WS_FG = 68, WS_WO = 72, WS_WIN = 74, WS_TK = 81, WS_LTOK = 83, WS_LGATE = 91,
                 WS_WED = 100, WS_HID = 230, WS_GLA = 230, WS_WEG = 416, WS_XN = 673, WS_YBF = 673, WS_QKV = 737, WS_Z1 = 737, WS_LG = 865, WS_Y = 416, WS_END = 992;

struct Args { const float* in[21]; float* out; unsigned char* ws; int ph_lo, ph_hi, li, pad; };

__global__ void __launch_bounds__(NTHR, 2) mega_fwd(Args a) {
    using namespace nv;
    extern __shared__ __attribute__((aligned(16))) unsigned char lds[];
    const int G = gridDim.x, bx = blockIdx.x;
    const int vcu = (G % 8 == 0) ? (bx % 8) * (G / 8) + bx / 8 : bx;
    int tid, lane, wave, vw;
#define DERIVE() do { int t_ = threadIdx.x; asm volatile("" : "+v"(t_)); tid = t_; lane = tid & 63; wave = __builtin_amdgcn_readfirstlane(tid >> 6); vw = vcu * 8 + wave; } while (0)
    DERIVE();
    volatile LAS unsigned* MISC = (volatile LAS unsigned*)((LAS unsigned char*)lds + MISC_OFF);
    for (int u = tid; u < (LDS_BYTES - 131072) / 4; u += NTHR) ((LAS unsigned*)((LAS unsigned char*)lds + 131072))[u] = 0u;
    __syncthreads();
    unsigned char* ws = a.ws;
    unsigned* ctl = (unsigned*)ws;
    XcdBarrier bar = xcd_barrier_post(ctl + CW_BAR + a.li * XCD_BAR_WORDS, MISC + 8);
    const float* x = a.in[0];
    const float* ln_in_g = a.in[1]; const float* ln_in_b = a.in[2];
    const float* w_in = a.in[3]; const float* b_fgate = a.in[4];
    const float* w_gate_up = a.in[5]; const float* b_gate = a.in[6]; const float* g_gla = a.in[7];
    const float* w_out = a.in[8]; const float* ln1_g = a.in[9]; const float* ln1_b = a.in[10];
    const float* w_router = a.in[11]; const float* rbias = a.in[12];
    const float* w_eg = a.in[13]; const float* w_eu = a.in[14]; const float* w_ed = a.in[15];
    const float* w_sg = a.in[16]; const float* w_su = a.in[17]; const float* w_sd = a.in[18];
    const float* ln2_g = a.in[19]; const float* ln2_b = a.in[20];
    float* out = a.out;
    int* counts = (int*)(ctl + CW_MOE);
    fx::bf16* H1 = (fx::bf16*)(ws + WS_H1 * MiB);
    fx::bf16* WrT = (fx::bf16*)(ws + WS_WR * MiB);
    float* stats = (float*)(ws + WS_STATS * MiB);
    float* LF = (float*)(ws + WS_LF * MiB);
    float* FG = (float*)(ws + WS_FG * MiB);
    fx::bf16* WoT = (fx::bf16*)(ws + WS_WO * MiB);
    fx::bf16* WinT = (fx::bf16*)(ws + WS_WIN * MiB);
    int* TK = (int*)(ws + WS_TK * MiB);
    float* TW = (float*)(ws + (WS_TK + 1) * MiB);
    int* list_tok = (int*)(ws + WS_LTOK * MiB);
    float* list_gate = (float*)(ws + WS_LGATE * MiB);
    fx::bf16* WedT = (fx::bf16*)(ws + WS_WED * MiB);
    fx::bf16* HID = (fx::bf16*)(ws + WS_HID * MiB);
    unsigned char* QPG = ws + WS_GLA * MiB; unsigned char* OIb = ws + (WS_GLA + 16) * MiB; unsigned char* UUb = ws + (WS_GLA + 80) * MiB; float* DECb = (float*)(ws + (WS_GLA + 144) * MiB); unsigned char* AGGb = ws + (WS_GLA + 145) * MiB; float* DAGGb = (float*)(ws + (WS_GLA + 153) * MiB);
    fx::bf16* WegT = (fx::bf16*)(ws + WS_WEG * MiB);
    fx::bf16* XN = (fx::bf16*)(ws + WS_XN * MiB);
    fx::bf16* Ybf = (fx::bf16*)(ws + WS_YBF * MiB);
    fx::bf16* QKV = (fx::bf16*)(ws + WS_QKV * MiB);
    fx::bf16* MIX = (fx::bf16*)(ws + WS_Z1 * MiB);
    float* LG = (float*)(ws + WS_LG * MiB);
    unsigned char* YA = ws + WS_Y * MiB;
    mo::lint tb = (mo::lint)((LAS unsigned char*)lds + mo::L_TB), yb = (mo::lint)((LAS unsigned char*)lds + mo::L_YB), cn = (mo::lint)((LAS unsigned char*)lds + mo::L_CN), ut = (mo::lint)((LAS unsigned char*)lds + mo::L_UT), rg = (mo::lint)((LAS unsigned char*)lds + mo::L_RG);

    const int lo = a.ph_lo, hi = a.ph_hi;
#define IN(k) (lo <= (k) && (k) < hi)
#define SEAM(k) do { if (IN(k) && IN((k) + 1)) xcd_barrier(bar); DERIVE(); } while (0)
    const int GW = G * 8;
#ifndef STG7
#define STG7 0
#endif
#ifndef STG8
#define STG8 0
#endif
#define STAGGER(q) do { if ((q) > 0) { const unsigned long long t0_ = __builtin_amdgcn_s_memrealtime(); const unsigned long long d_ = (unsigned long long)((vcu & 3) * (q)); while (__builtin_amdgcn_s_memrealtime() - t0_ < d_) __builtin_amdgcn_s_sleep(8); } } while (0)

    if (IN(0)) {
        LAS float* scr = (LAS float*)((LAS unsigned char*)lds + wave * 16384);
        constexpr int I_IN = 16 * (fx::NIN / 32), I_OUT = 16 * 32, I_R = 16 * 8, I_SMALL = I_IN + I_OUT + I_R;
        for (int it = vw; it < I_SMALL; it += GW) {
            int r = it;
            if (r < I_IN) { fx::transpose_item(w_in, D, INW, WinT, scr, r / (fx::NIN / 32), r % (fx::NIN / 32), lane, [](int d) { return fx::inproj_src(d); }); continue; } r -= I_IN;
            if (r < I_OUT) { fx::transpose_item(w_out, D, D, WoT, scr, r / 32, r % 32, lane, [](int d) { return d; }); continue; } r -= I_OUT;
            fx::transpose_item(w_router, D, NE, WrT, scr, r / 8, r % 8, lane, [](int d) { return d; });
        }
        for (int r = vw; r < T; r += GW) fx::ln_row_bf16(x + (size_t)r * D, ln_in_g, ln_in_b, XN + (size_t)r * D, nullptr, stats + 2 * (size_t)r, lane);
    }
    SEAM(0);
    if (IN(1)) {
        const mo::ExpW XW{w_eg, w_eu, w_ed, w_sg, w_su, w_sd, WegT, WedT};
#ifndef MIXG
#define MIXG 2
#endif
        { const int slot = vcu % MIXG; pg8::StaticOrder S; S.init(T, fx::NIN, G, bx);
          const int nun = (S.nwg - bx + G - 1) / G, nb = (MIXG > 1) ? nun * slot / (MIXG - 1) : nun;
          pg8::Gemm g{XN, WinT, T, fx::NIN, D, D}; pg8::EpiInProj E{QKV, FG, LF, b_fgate, ctl + CW_NRM};
          if (nb > 0) { pg8::RangeOrder R{S, 0, nb}; pg8::gemm_phase<pg8::EpiInProj, pg8::RangeOrder, true, true>((LAS unsigned char*)lds, g, R, E); DERIVE(); }
          mo::expert_conv(XW, (LAS float*)((LAS unsigned char*)lds + wave * 16384), vw, GW, lane); __syncthreads(); DERIVE();
          if (nb < nun) { pg8::RangeOrder R{S, nb, nun - nb}; pg8::gemm_phase<pg8::EpiInProj, pg8::RangeOrder, true, true>((LAS unsigned char*)lds, g, R, E); } }
    }
    SEAM(1);
    if (IN(2)) {
        int cur_h = -1;
        for (int blk = vcu; blk < gl::NUNIT / 8; blk += G) gl::prep_block(blk, QKV, FG, w_gate_up, b_gate, QPG, OIb, UUb, DECb, AGGb, DAGGb, lds, cur_h);
    }
    SEAM(2);
    if (IN(3)) {
        for (int blk = vcu; blk < gl::NUNIT / 8; blk += G) gl::post_block(blk * 8, 8, QKV, QPG, OIb, UUb, DECb, AGGb, DAGGb, g_gla, Ybf, lds);
        { const attn_body::AttnTensors AT{(const attn_body::bf16*)(QKV + fx::P_FQ), (const attn_body::bf16*)(QKV + fx::P_FK), (const attn_body::bf16*)(QKV + fx::P_FV), (attn_body::bf16*)Ybf, LF, ctl + CW_NRM};
          attn_body::attn_phase_dyn<8>((char*)lds, AT, ctl + CW_FOXQ, (volatile int*)(lds + 140288), (G % 8 == 0) ? vcu / (G / 8) : vcu % 8); }
    }
    SEAM(3);
    if (IN(4)) {
        pg8::DenseSched DS; DS.so.init(T, D, G, bx); DS.Bt = WoT; DS.ldb = D;
        pg8::EpiPlainBf16 E{MIX, D};
        pg8::gemm_phase2<pg8::EpiPlainBf16, pg8::DenseSched>((LAS unsigned char*)lds, Ybf, D, D, D, DS, E);
    }
    SEAM(4);
    if (IN(5)) {
        int* lcnt = (int*)(lds + 136192); int* lbase = lcnt + 256;
        for (int rb = vcu; rb < T / 128; rb += G) {
            if (tid < 256) lcnt[tid] = 0;
            for (int r = wave * 16; r < wave * 16 + 16; r += 4) { const size_t row = (size_t)rb * 128 + r;
                fx::ln1_rows_bf16<4>(x + row * D, stats + 2 * row, ln_in_g, ln_in_b, MIX + row * D, ln1_g, ln1_b, H1 + row * D, ALPHA, lane); }
            asm volatile("s_waitcnt vmcnt(0)" ::: "memory"); __syncthreads();
            { pg8::RouterSched RS{rb, WrT}; pg8::EpiLogits E{LG};
              pg8::gemm_phase2<pg8::EpiLogits, pg8::RouterSched>((LAS unsigned char*)lds, H1, D, D, D, RS, E); }
            DERIVE();
            for (int t = rb * 128 + wave * 2; t < rb * 128 + 128; t += 16) mo::route_token2(LG, rbias, lcnt, TK, TW, t, lane);
            __syncthreads();
            if (tid < 256) { const int c = lcnt[tid]; lbase[tid] = c ? atomicAdd(&counts[tid], c) : 0; }
            __syncthreads();
            for (int t = rb * 128 + wave * 2; t < rb * 128 + 128; t += 16) mo::route_finish2(lbase, list_tok, list_gate, TK, TW, t, lane);
            __syncthreads();
        }
    }
    SEAM(5);
    if (IN(6)) {
        if (wave == 0) mo::moe_tables(counts, tb, yb, cn, lane);
        __syncthreads();
        STAGGER(STG7);
        pg8::MoeSched<0> MS{G, vcu, tb[257], tb, cn, list_tok, WegT, ut, rg}; if (wave == 0) MS.build(lane); __syncthreads(); MS.fill_rows(list_gate, tid); __syncthreads(); pg8::EpiSwiGLU E{HID, rg, a.pad};
        pg8::gemm_phase2<pg8::EpiSwiGLU, pg8::MoeSched<0>>((LAS unsigned char*)lds, H1, D, D, D, MS, E);
    }
    SEAM(6);
    if (IN(7)) {
        if (wave == 0) mo::moe_tables(counts, tb, yb, cn, lane);
        __syncthreads();
        STAGGER(STG8);
        pg8::MoeSched<1> MS{G, vcu, tb[257], tb, cn, list_tok, WedT, ut, rg}; if (wave == 0) MS.build(lane); __syncthreads(); pg8::EpiDown E{YA, yb, a.pad};
        pg8::gemm_phase2<pg8::EpiDown, pg8::MoeSched<1>>((LAS unsigned char*)lds, HID, 64, ED, ED, MS, E, 32768);
    }
    SEAM(7);
    if (IN(8)) {
        if (wave == 0) mo::moe_tables(counts, tb, yb, cn, lane);
        __syncthreads();
        for (int t = vw; t < T; t += GW) mo::combine_token(H1, YA, TK, yb, ln2_g, ln2_b, out, t, lane);
    }
#undef IN
#undef SEAM
}

extern "C" void kernel_launch(void* const* d_in, const int* in_sizes, int n_in, void* d_out, int out_size, void* d_ws, size_t ws_size, hipStream_t stream) {
    static int grid = 0;
    if (grid == 0) {
        if (n_in != 21 || out_size != nv::T * nv::D || ws_size < WS_END * MiB) { fprintf(stderr, "kernel_launch: unexpected shapes n_in=%d out=%d ws=%zu\n", n_in, out_size, ws_size); grid = -1; return; }
        int dev = 0, cus = 0;
        if (hipGetDevice(&dev) != hipSuccess || hipDeviceGetAttribute(&cus, hipDeviceAttributeMultiprocessorCount, dev) != hipSuccess) { grid = -1; return; }
        if (hipFuncSetAttribute((const void*)mega_fwd, hipFuncAttributeMaxDynamicSharedMemorySize, LDS_BYTES) != hipSuccess) { fprintf(stderr, "kernel_launch: hipFuncSetAttribute failed\n"); grid = -1; return; }
        grid = cus;
    }
    if (grid < 0) return;
    if (hipMemsetAsync(d_ws, 0, CTL_ZERO_BYTES, stream) != hipSuccess) return;
    Args a{};
    for (int i = 0; i < 21; ++i) a.in[i] = (const float*)d_in[i];
    a.out = (float*)d_out; a.ws = (unsigned char*)d_ws; a.ph_lo = 0; a.ph_hi = NPHASE; a.li = 0;
#ifdef REPEAT_PH
    a.ph_hi = REPEAT_PH + 1; hipLaunchKernelGGL(mega_fwd, dim3(grid), dim3(NTHR), LDS_BYTES, stream, a);
    if (REPEAT_PH == 3) hipMemsetAsync((char*)d_ws + CW_FOXQ * 4, 0, 256, stream);
    if (REPEAT_PH == 5) hipMemsetAsync((char*)d_ws + CW_MOE * 4, 0, 4096, stream);
    a.ph_lo = REPEAT_PH; a.ph_hi = NPHASE; a.li = 1;
#ifdef REPEAT_NOEPI
    a.ph_hi = REPEAT_PH + 1; a.pad = 1; hipLaunchKernelGGL(mega_fwd, dim3(grid), dim3(NTHR), LDS_BYTES, stream, a); a.pad = 0; a.ph_lo = REPEAT_PH + 1; a.ph_hi = NPHASE; a.li = 2;
#endif
#endif
    hipLaunchKernelGGL(mega_fwd, dim3(grid), dim3(NTHR), LDS_BYTES, stream, a);
}
```

```cpp
#include <hip/hip_runtime.h>
#include <cstdio>
#include <cstdint>
#include <cmath>

#define LAS __attribute__((address_space(3)))
#define GAS __attribute__((address_space(1)))

#define XB_TMO      128
#define XB_XCNT(j)  (256  + 64 * (j))
#define XB_XSUB(j)  (1280 + 64 * (j))
#define XB_XGEN(j)  (2304 + 64 * (j))
#define XB_TOP      3328
#define XB_TOPGEN   3392
#define XCD_BAR_WORDS 3456
#define XB_SPIN_CAP (1u << 27)
__device__ __forceinline__ unsigned xb_ld(unsigned* p)              { return __hip_atomic_load(p, __ATOMIC_RELAXED, __HIP_MEMORY_SCOPE_AGENT); }
__device__ __forceinline__ unsigned xb_add(unsigned* p, unsigned v) { return __hip_atomic_fetch_add(p, v, __ATOMIC_RELAXED, __HIP_MEMORY_SCOPE_AGENT); }
__device__ __forceinline__ unsigned xb_xcc_id() { return (unsigned)__builtin_amdgcn_s_getreg((3 << 11) | 20) & 0xFu; }
#define XB_SPIN(cond, bar) do { unsigned _sp = 0; while (cond) { __builtin_amdgcn_s_sleep(1); \
    if ((++_sp & 255u) == 0u) { if (xb_ld(&(bar)[XB_TMO])) break; if (_sp > XB_SPIN_CAP) { atomicAdd(&(bar)[XB_TMO], 1u); break; } } } } while (0)
struct XcdBarrier { unsigned* bar; unsigned x; volatile LAS unsigned* st; };
__device__ __forceinline__ XcdBarrier xcd_barrier_post(unsigned* bar, volatile LAS unsigned* st) {
    XcdBarrier b; b.bar = bar; b.x = xb_xcc_id(); b.st = st;
    if (threadIdx.x == 0) (void)xb_add(&bar[XB_XCNT(b.x)], 1u);
    return b;
}
__device__ __forceinline__ void xcd_barrier_complete(unsigned* bar, unsigned x, unsigned& nloc, unsigned& nx) {
    const unsigned G = gridDim.x * gridDim.y * gridDim.z;
    unsigned sum, cnt, mine, sp = 0u;
    for (;;) {
        sum = 0u; cnt = 0u; mine = 0u;
#pragma unroll
        for (unsigned j = 0; j < 16; ++j) { const unsigned c = xb_ld(&bar[XB_XCNT(j)]); sum += c; cnt += (c > 0u) ? 1u : 0u; mine = (j == x) ? c : mine; }
        if (sum == G) break;
        __builtin_amdgcn_s_sleep(1);
        if ((++sp & 255u) == 0u) { if (xb_ld(&bar[XB_TMO])) break; if (sp > XB_SPIN_CAP) { atomicAdd(&bar[XB_TMO], 1u); break; } }
    }
    nloc = mine > 0u ? mine : 1u; nx = cnt > 0u ? cnt : 1u;
}
__device__ __forceinline__ void xcd_barrier(const XcdBarrier& b) {
    asm volatile("s_waitcnt vmcnt(0)" ::: "memory");
    __syncthreads();
    if (threadIdx.x == 0) {
        unsigned* bar = b.bar;
        __builtin_amdgcn_s_waitcnt(0);
        unsigned nloc = b.st[0], nx = b.st[1];
        if (nloc == 0u) { xcd_barrier_complete(bar, b.x, nloc, nx); b.st[0] = nloc; b.st[1] = nx; }
        const unsigned old = xb_add(&bar[XB_XSUB(b.x)], 1u);
        const unsigned gen = old / nloc;
        if (old + 1u == (gen + 1u) * nloc) {
            __builtin_amdgcn_fence(__ATOMIC_RELEASE, "agent");
            asm volatile("s_waitcnt vmcnt(0)" ::: "memory");
            const unsigned og = xb_add(&bar[XB_TOP], 1u);
            const unsigned tg = og / nx;
            if (og + 1u == (tg + 1u) * nx) xb_add(&bar[XB_TOPGEN], 1u);
            else XB_SPIN(xb_ld(&bar[XB_TOPGEN]) == tg, bar);
            __builtin_amdgcn_fence(__ATOMIC_ACQUIRE, "agent");
            xb_add(&bar[XB_XGEN(b.x)], 1u);
            asm volatile("s_waitcnt vmcnt(0)" ::: "memory");
        } else {
            XB_SPIN(xb_ld(&bar[XB_XGEN(b.x)]) == gen, bar);
            __builtin_amdgcn_fence(__ATOMIC_ACQUIRE, "agent");
            asm volatile("s_waitcnt vmcnt(0)" ::: "memory");
        }
    }
    __syncthreads();
}
namespace pg8 {
#define PG8_LAS __attribute__((address_space(3)))
typedef unsigned short bf16_t;
typedef short bf16x8 __attribute__((ext_vector_type(8)));
typedef float f32x4 __attribute__((ext_vector_type(4)));
typedef unsigned u32x4 __attribute__((ext_vector_type(4)));
constexpr int BM = 256, BK = 64, HALF = 128, HTB = HALF * BK * 2  , STAGE_BYTES = 8 * HTB, NXCD = 8, WGM = 8;

__host__ __device__ __forceinline__ int lds_byte(int r, int c) { const int st = (r >> 4) * 2 + (c >> 5), rr = r & 15, cc = c & 31, ob = rr * 64 + cc * 2; return st * 1024 + (ob ^ (((ob >> 9) & 1) << 5)); }
__host__ __device__ __forceinline__ void stage_rc(int b, int& R, int& C) { const int st = b / 1024, sb = b % 1024, swz = sb ^ (((sb >> 9) & 1) << 5); R = (st >> 1) * 16 + swz / 64; C = (st & 1) * 32 + (swz % 64) / 2; }
__host__ __device__ __forceinline__ int perm32(int rho) { const int n = rho >> 4, i = rho & 15; return 8 * (i >> 2) + 4 * n + (i & 3); }

struct Unit { int pm, pn; };
struct Gemm { const bf16_t* A; const bf16_t* Bt; int M, N, K, lda; };

struct StaticOrder {
    int nM, nN, nwg, G, c;
    __host__ __device__ void init(int M, int N, int G_, int c_) { nM = M / BM; nN = N / BM; nwg = nM * nN; G = G_; c = c_; }
    __host__ __device__ bool next(int i, Unit& u) const {
        const long L = (long)i * G + c; if (L >= nwg) return false;
        int wgid = (int)L; { const int q = nwg / NXCD, r = nwg % NXCD, xcd = wgid % NXCD, off = wgid / NXCD; wgid = (xcd < r ? xcd * (q + 1) : r * (q + 1) + (xcd - r) * q) + off; }
        const int nig = WGM * nN, gid = wgid / nig, fm = gid * WGM, gsz = (nM - fm) < WGM ? (nM - fm) : WGM;
        u.pm = fm + ((wgid % nig) % gsz); u.pn = (wgid % nig) / gsz; return true;
    }
    __device__ __forceinline__ void a_ready(const Unit&) const {}
    __device__ __forceinline__ void done(const Unit&) const {}
};

struct RangeOrder {
    StaticOrder so; int i0, n;
    __host__ __device__ bool next(int i, Unit& u) const { return i < n && so.next(i0 + i, u); }
    __device__ __forceinline__ void a_ready(const Unit&) const {}
    __device__ __forceinline__ void done(const Unit&) const {}
};
__device__ __forceinline__ unsigned cvt_pk_bf16(float lo, float hi) { unsigned r; asm volatile("v_cvt_pk_bf16_f32 %0, %1, %2" : "=v"(r) : "v"(lo), "v"(hi)); return r; }
typedef float f32x2 __attribute__((ext_vector_type(2)));
__device__ __forceinline__ f32x2 gelu_pk(f32x2 v) {
    const f32x2 av = __builtin_elementwise_abs(v), d = av * 0.2316418882f + 1.0f;
    f32x2 t; t.x = __builtin_amdgcn_rcpf(d.x); t.y = __builtin_amdgcn_rcpf(d.y);
    f32x2 q = t * 0.5307027145f + (-0.7265760135f); q = q * t + 0.7107068705f; q = q * t + (-0.142248368f); q = q * t + 0.127414796f; q = q * t;
    const f32x2 s = (v * v) * (-0.72134752044f);
    f32x2 e; e.x = __builtin_amdgcn_exp2f(s.x); e.y = __builtin_amdgcn_exp2f(s.y);
    const f32x2 m = v * (q * e), r = v - m;
    f32x2 o; o.x = v.x < 0.f ? m.x : r.x; o.y = v.y < 0.f ? m.y : r.y; return o;
}

template <int ACT  > struct EpiBf16 {
    static constexpr bool PERM = true, AFTER_DRAIN = false; static_assert(ACT == 0 || ACT == 1, "EpiBf16: ACT is 0 (none) or 1 (gelu_pk)");
    bf16_t* O; int ldc; const float* bias; int split_cols; size_t split_stride; float scale0;
    __device__ __forceinline__ void operator()(const f32x4 (&acc)[2][2][4][2], const Unit& u, int wr, int wc, int fr, int fq) const {
        const int row0 = u.pm * BM + wr * 64 + fr; int colt = u.pn * BM; bf16_t* base = O;
        float sc = 1.f; if (split_cols) { const int t = colt / split_cols; base += (size_t)t * split_stride; colt -= t * split_cols; if (t == 0) sc = scale0; }
        const int col0 = colt + wc * 32 + 8 * fq, bcol0 = u.pn * BM + wc * 32 + 8 * fq;
        f32x4 bv[2][2];
#pragma unroll
        for (int bj = 0; bj < 2; ++bj)
#pragma unroll
            for (int n = 0; n < 2; ++n) bv[bj][n] = bias ? *(const f32x4*)(bias + bcol0 + bj * HALF + 4 * n) : (f32x4){0.f, 0.f, 0.f, 0.f};
#pragma unroll
        for (int ai = 0; ai < 2; ++ai)
#pragma unroll
            for (int m = 0; m < 4; ++m) { bf16_t* rowp = base + (size_t)(row0 + ai * HALF + m * 16) * ldc + col0;
#pragma unroll
                for (int bj = 0; bj < 2; ++bj) { f32x4 v0 = acc[ai][bj][m][0] + bv[bj][0], v1 = acc[ai][bj][m][1] + bv[bj][1];
                    if (ACT == 1) { f32x2 a = gelu_pk((f32x2){v0[0], v0[1]}), b = gelu_pk((f32x2){v0[2], v0[3]}), c = gelu_pk((f32x2){v1[0], v1[1]}), d = gelu_pk((f32x2){v1[2], v1[3]});
                        v0 = (f32x4){a.x, a.y, b.x, b.y}; v1 = (f32x4){c.x, c.y, d.x, d.y}; }
                    v0 = v0 * sc; v1 = v1 * sc; u32x4 w; w.x = cvt_pk_bf16(v0[0], v0[1]); w.y = cvt_pk_bf16(v0[2], v0[3]); w.z = cvt_pk_bf16(v1[0], v1[1]); w.w = cvt_pk_bf16(v1[2], v1[3]);
                    *(u32x4*)(rowp + bj * HALF) = w; } }
    }
};

template <class Epi, class Sched, bool ALIGN_EPI = false, bool SP2 = false>
__device__ __forceinline__ void gemm_phase(PG8_LAS unsigned char* lds, const Gemm g, const Sched& S, const Epi& E) {
    const int tid = threadIdx.x, wid = __builtin_amdgcn_readfirstlane(tid >> 6), lane = tid & 63, wr = wid >> 2, wc = wid & 3, fr = lane & 15, fq = lane >> 4;
    const int K = g.K, nt = K / BK;
    unsigned voffA[2], voffB[2];
#pragma unroll
    for (int i = 0; i < 2; ++i) { int R, C; stage_rc(tid * 16 + i * 8192, R, C); const int Rb = Epi::PERM ? ((R & ~31) + perm32(R & 31)) : R;
        voffA[i] = (unsigned)(R * g.lda + C) * 2u; voffB[i] = (unsigned)(Rb * K + C) * 2u; }
    const size_t kstep = (size_t)(BK * 2);
    const size_t hstepA = (size_t)HALF * g.lda * 2, hstepB = (size_t)HALF * K * 2;
    const size_t tstepA = 2 * hstepA, tstepB = 2 * hstepB;
    const unsigned ldsw = (unsigned)wid * 1024u;
    const int aoff = lds_byte(wr * 64 + fr, fq * 8), boff = lds_byte(wc * 32 + fr, fq * 8);
#define PG8_SA(b, h) (((b) * 2 + (h)) * HTB)
#define PG8_SB(b, h) ((4 + (b) * 2 + (h)) * HTB)
#define PG8_STAGE(bufoff, gbase, voff) do { _Pragma("unroll") for (int _i = 0; _i < 2; ++_i) \
        __builtin_amdgcn_global_load_lds((const unsigned*)((const char*)(gbase) + (voff)[_i]), (PG8_LAS unsigned*)(lds + (bufoff) + ldsw + _i * 8192), 16, 0, 0); } while (0)
#define PG8_LDA(dst, b, h) do { _Pragma("unroll") for (int m = 0; m < 4; ++m) _Pragma("unroll") for (int k = 0; k < 2; ++k) dst[m][k] = *(const PG8_LAS bf16x8*)(lds + PG8_SA(b, h) + aoff + m * 2048 + k * 1024); } while (0)
#define PG8_LDB(dst, b, h) do { _Pragma("unroll") for (int n = 0; n < 2; ++n) _Pragma("unroll") for (int k = 0; k < 2; ++k) dst[n][k] = *(const PG8_LAS bf16x8*)(lds + PG8_SB(b, h) + boff + n * 2048 + k * 1024); } while (0)
#define PG8_MMA(ai, bj, At, Bt) do { __builtin_amdgcn_s_setprio(1); _Pragma("unroll") for (int m = 0; m < 4; ++m) _Pragma("unroll") for (int n = 0; n < 2; ++n) _Pragma("unroll") for (int k = 0; k < 2; ++k) \
        acc[ai][bj][m][n] = __builtin_amdgcn_mfma_f32_16x16x32_bf16(Bt[n][k], At[m][k], acc[ai][bj][m][n], 0, 0, 0); __builtin_amdgcn_s_setprio(0); } while (0)
#define PG8_WAIT_V(n) asm volatile("s_waitcnt vmcnt(" #n ")" ::: "memory")
#define PG8_WAIT_L(n) asm volatile("s_waitcnt lgkmcnt(" #n ")" ::: "memory")
#define PG8_BAR __builtin_amdgcn_s_barrier()
#define PG8_SCHED __builtin_amdgcn_sched_barrier(0)
    Unit cur, nxt; int ui = 0;
    if (!S.next(0, cur)) return;
    f32x4 acc[2][2][4][2];
#pragma unroll
    for (int a = 0; a < 2; ++a)
#pragma unroll
        for (int b = 0; b < 2; ++b)
#pragma unroll
            for (int m = 0; m < 4; ++m)
#pragma unroll
                for (int n = 0; n < 2; ++n) acc[a][b][m][n] = (f32x4){0.f, 0.f, 0.f, 0.f};
    bf16x8 At[4][2], B0[2][2], B1[2][2];
    const char* cA = (const char*)g.A + (size_t)cur.pm * tstepA; const char* cB = (const char*)g.Bt + (size_t)cur.pn * tstepB;
    S.a_ready(cur);
    if constexpr (SP2) {
        PG8_STAGE(PG8_SB(0, 0), cB, voffB); PG8_STAGE(PG8_SB(0, 1), cB + hstepB, voffB); PG8_STAGE(PG8_SA(0, 0), cA, voffA); PG8_STAGE(PG8_SA(0, 1), cA + hstepA, voffA);
        if (wr == 1) PG8_BAR;
        PG8_WAIT_V(2); PG8_BAR;
        PG8_STAGE(PG8_SB(1, 0), cB + kstep, voffB); PG8_STAGE(PG8_SA(1, 0), cA + kstep, voffA); PG8_STAGE(PG8_SB(1, 1), cB + hstepB + kstep, voffB);
        PG8_WAIT_V(6); PG8_BAR;
    } else {
        PG8_STAGE(PG8_SB(0, 0), cB, voffB); PG8_STAGE(PG8_SA(0, 0), cA, voffA); PG8_STAGE(PG8_SB(0, 1), cB + hstepB, voffB); PG8_STAGE(PG8_SA(0, 1), cA + hstepA, voffA);
        if (wr == 1) PG8_BAR;
        PG8_WAIT_V(4); PG8_BAR;
        PG8_STAGE(PG8_SB(1, 0), cB + kstep, voffB); PG8_STAGE(PG8_SA(1, 0), cA + kstep, voffA); PG8_STAGE(PG8_SB(1, 1), cB + hstepB + kstep, voffB);
        PG8_WAIT_V(6); PG8_BAR;
    }
    for (;;) {
        const bool has_next = S.next(ui + 1, nxt);
        const char* nA = has_next ? (const char*)g.A + (size_t)nxt.pm * tstepA : cA; const char* nB = has_next ? (const char*)g.Bt + (size_t)nxt.pn * tstepB : cB;
        for (int t = 0; t < nt; t += 2) {
            const bool last = (t == nt - 2);
            const char* a1 = cA + (size_t)(t + 1) * kstep;
            const char* a2 = last ? nA : cA + (size_t)(t + 2) * kstep; const char* b2 = last ? nB : cB + (size_t)(t + 2) * kstep;
            const char* a3 = a2 + kstep; const char* b3 = b2 + kstep;
            if (last && has_next) S.a_ready(nxt);
            if constexpr (SP2) {
            PG8_LDB(B0, 0, 0); PG8_LDB(B1, 0, 1); PG8_SCHED; PG8_LDA(At, 0, 0); PG8_STAGE(PG8_SA(1, 1), a1 + hstepA, voffA);
            PG8_WAIT_V(8); PG8_WAIT_L(0); PG8_BAR; PG8_MMA(0, 0, At, B0); PG8_MMA(0, 1, At, B1); PG8_BAR; PG8_SCHED;
            PG8_LDA(At, 0, 1); PG8_STAGE(PG8_SB(0, 0), b2, voffB); PG8_STAGE(PG8_SB(0, 1), b2 + hstepB, voffB); PG8_STAGE(PG8_SA(0, 0), a2, voffA);
            PG8_WAIT_V(8); PG8_WAIT_L(0); PG8_BAR; PG8_MMA(1, 0, At, B0); PG8_MMA(1, 1, At, B1); PG8_BAR; PG8_SCHED;
            PG8_LDB(B0, 1, 0); PG8_LDB(B1, 1, 1); PG8_SCHED; PG8_LDA(At, 1, 0); PG8_STAGE(PG8_SA(0, 1), a2 + hstepA, voffA);
            PG8_WAIT_V(8); PG8_WAIT_L(0); PG8_BAR; PG8_MMA(0, 0, At, B0); PG8_MMA(0, 1, At, B1); PG8_BAR; PG8_SCHED;
            PG8_LDA(At, 1, 1); PG8_STAGE(PG8_SB(1, 0), b3, voffB); PG8_STAGE(PG8_SB(1, 1), b3 + hstepB, voffB); PG8_STAGE(PG8_SA(1, 0), a3, voffA);
            PG8_WAIT_V(8); PG8_WAIT_L(0); PG8_BAR; PG8_MMA(1, 0, At, B0); PG8_MMA(1, 1, At, B1); PG8_BAR; PG8_SCHED;
            } else {
            PG8_LDB(B0, 0, 0); PG8_SCHED; PG8_LDA(At, 0, 0); PG8_STAGE(PG8_SA(1, 1), a1 + hstepA, voffA);
            PG8_WAIT_L(8); PG8_BAR; PG8_WAIT_L(0); PG8_MMA(0, 0, At, B0); PG8_BAR; PG8_SCHED;
            PG8_LDB(B1, 0, 1); PG8_STAGE(PG8_SB(0, 0), b2, voffB);
            PG8_BAR; PG8_WAIT_L(0); PG8_MMA(0, 1, At, B1); PG8_BAR;
            PG8_LDA(At, 0, 1); PG8_STAGE(PG8_SA(0, 0), a2, voffA);
            PG8_BAR; PG8_WAIT_L(0); PG8_MMA(1, 0, At, B0); PG8_BAR; PG8_SCHED;
            PG8_STAGE(PG8_SB(0, 1), b2 + hstepB, voffB);
            PG8_WAIT_V(6); PG8_BAR; PG8_MMA(1, 1, At, B1); PG8_BAR;
            PG8_LDB(B0, 1, 0); PG8_SCHED; PG8_LDA(At, 1, 0); PG8_STAGE(PG8_SA(0, 1), a2 + hstepA, voffA);
            PG8_WAIT_L(8); PG8_BAR; PG8_WAIT_L(0); PG8_MMA(0, 0, At, B0); PG8_BAR; PG8_SCHED;
            PG8_LDB(B1, 1, 1); PG8_STAGE(PG8_SB(1, 0), b3, voffB);
            PG8_BAR; PG8_WAIT_L(0); PG8_MMA(0, 1, At, B1); PG8_BAR;
            PG8_LDA(At, 1, 1); PG8_STAGE(PG8_SA(1, 0), a3, voffA);
            PG8_BAR; PG8_WAIT_L(0); PG8_MMA(1, 0, At, B0); PG8_BAR; PG8_SCHED;
            PG8_STAGE(PG8_SB(1, 1), b3 + hstepB, voffB);
            PG8_WAIT_V(6); PG8_BAR; PG8_MMA(1, 1, At, B1); PG8_BAR;
            }
        }
        if constexpr (ALIGN_EPI) { if (wr == 0) PG8_BAR; }
        if constexpr (!Epi::AFTER_DRAIN) { E(acc, cur, wr, wc, fr, fq); S.done(cur); }
        if (!has_next) break;
#pragma unroll
        for (int a = 0; a < 2; ++a)
#pragma unroll
            for (int b = 0; b < 2; ++b)
#pragma unroll
                for (int m = 0; m < 4; ++m)
#pragma unroll
                    for (int n = 0; n < 2; ++n) acc[a][b][m][n] = (f32x4){0.f, 0.f, 0.f, 0.f};
        cur = nxt; cA = nA; cB = nB; ++ui;
        if constexpr (ALIGN_EPI) { if (wr == 1) PG8_BAR; }
    }
    PG8_WAIT_V(0);
    if constexpr (!ALIGN_EPI) { if (wr == 0) PG8_BAR; }
    PG8_BAR;
    if constexpr (Epi::AFTER_DRAIN) { E.fused(acc, cur, wr, wc, fr, fq, lds, wid, lane); S.done(cur); }
#undef PG8_SA
#undef PG8_SB
#undef PG8_STAGE
#undef PG8_LDA
#undef PG8_LDB
#undef PG8_MMA
#undef PG8_WAIT_V
#undef PG8_WAIT_L
#undef PG8_BAR
#undef PG8_SCHED
}
}
namespace pg8 {
struct Unit2 { int pm, pn, e, cnt, jt, ui; };
template <class E, class = void> struct has_perm16 { static constexpr bool value = false; };
template <class E> struct has_perm16<E, decltype((void)E::PERM16)> { static constexpr bool value = E::PERM16; };
template <class E> constexpr bool perm16() { return has_perm16<E>::value; }
template <class Epi, class Sched>
__device__ __forceinline__ void gemm_phase2(PG8_LAS unsigned char* lds, const bf16_t* Abase, int lda, int ldb, int K, const Sched& S, const Epi& E, int kstepA_ = BK * 2) {
    int tid_ = threadIdx.x; asm volatile("" : "+v"(tid_));
    const int tid = tid_, wid = __builtin_amdgcn_readfirstlane(tid >> 6), lane = tid & 63, wr = wid >> 2, wc = wid & 3, fr = lane & 15, fq = lane >> 4;
    int K_ = K; asm volatile("" : "+s"(K_));
    const int nt = K_ / BK;
    unsigned voffB0[2], voffB1[2];
#pragma unroll
    for (int i = 0; i < 2; ++i) { int R, C; stage_rc(tid * 16 + i * 8192, R, C);
        if constexpr (perm16<Epi>()) { const int cb = 64 * (R >> 5) + 16 * ((R >> 2) & 3) + 4 * ((R >> 4) & 1) + (R & 3); voffB0[i] = (unsigned)(cb * ldb + C) * 2u; voffB1[i] = (unsigned)((cb + 8) * ldb + C) * 2u; }
        else { const int Rb = Epi::PERM ? ((R & ~31) + perm32(R & 31)) : R; voffB0[i] = (unsigned)(Rb * ldb + C) * 2u; voffB1[i] = voffB0[i] + (unsigned)(HALF * ldb * 2); } }
    const unsigned lda2 = (unsigned)lda * 2u;
#define PG8_AOFFS(U, o0, o1) do { int t2_ = threadIdx.x; asm volatile("" : "+v"(t2_)); _Pragma("unroll") for (int i_ = 0; i_ < 2; ++i_) { int R_, C_; stage_rc(t2_ * 16 + i_ * 8192, R_, C_); \
        o0[i_] = (unsigned)S.arow(U, R_) * lda2 + (unsigned)C_ * 2u; o1[i_] = (unsigned)S.arow(U, HALF + R_) * lda2 + (unsigned)C_ * 2u; } } while (0)
    const size_t kstep = (size_t)(BK * 2), kstepA = (size_t)kstepA_;
    const unsigned ldsw = (unsigned)wid * 1024u;
    const int aoff = lds_byte(wr * 64 + fr, fq * 8), boff = lds_byte(wc * 32 + fr, fq * 8);
#define PG8_SA(b, h) (((b) * 2 + (h)) * HTB)
#define PG8_SB(b, h) ((4 + (b) * 2 + (h)) * HTB)
#define PG8_STAGE(bufoff, gbase, voff) do { _Pragma("unroll") for (int _i = 0; _i < 2; ++_i) \
        __builtin_amdgcn_global_load_lds((const unsigned*)((const char*)(gbase) + (voff)[_i]), (PG8_LAS unsigned*)(lds + (bufoff) + ldsw + _i * 8192), 16, 0, 0); } while (0)
#define PG8_LDA(dst, b, h) do { _Pragma("unroll") for (int m = 0; m < 4; ++m) _Pragma("unroll") for (int k = 0; k < 2; ++k) dst[m][k] = *(const PG8_LAS bf16x8*)(lds + PG8_SA(b, h) + aoff + m * 2048 + k * 1024); } while (0)
#define PG8_LDB(dst, b, h) do { _Pragma("unroll") for (int n = 0; n < 2; ++n) _Pragma("unroll") for (int k = 0; k < 2; ++k) dst[n][k] = *(const PG8_LAS bf16x8*)(lds + PG8_SB(b, h) + boff + n * 2048 + k * 1024); } while (0)
#define PG8_MMA(ai, bj, At, Bt) do { __builtin_amdgcn_s_setprio(1); _Pragma("unroll") for (int m = 0; m < 4; ++m) _Pragma("unroll") for (int n = 0; n < 2; ++n) _Pragma("unroll") for (int k = 0; k < 2; ++k) \
        acc[ai][bj][m][n] = __builtin_amdgcn_mfma_f32_16x16x32_bf16(Bt[n][k], At[m][k], acc[ai][bj][m][n], 0, 0, 0); __builtin_amdgcn_s_setprio(0); } while (0)
#define PG8_WAIT_V(n) asm volatile("s_waitcnt vmcnt(" #n ")" ::: "memory")
#define PG8_WAIT_L(n) asm volatile("s_waitcnt lgkmcnt(" #n ")" ::: "memory")
#define PG8_BAR __builtin_amdgcn_s_barrier()
#define PG8_SCHED __builtin_amdgcn_sched_barrier(0)
    Unit2 cur, nxt; int ui = 0;
    if (!S.next(0, cur)) return;
    f32x4 acc[2][2][4][2];
#pragma unroll
    for (int a = 0; a < 2; ++a)
#pragma unroll
        for (int b = 0; b < 2; ++b)
#pragma unroll
            for (int m = 0; m < 4; ++m)
#pragma unroll
                for (int n = 0; n < 2; ++n) acc[a][b][m][n] = (f32x4){0.f, 0.f, 0.f, 0.f};
    bf16x8 At[4][2], B0[2][2], B1[2][2];
    unsigned cv0[2], cv1[2], nv0[2], nv1[2];
    PG8_AOFFS(cur, cv0, cv1);
    const char* cA = (const char*)Abase + S.aoff(cur); const char* cB = S.bptr(cur);
    PG8_STAGE(PG8_SB(0, 0), cB, voffB0); PG8_STAGE(PG8_SB(0, 1), cB, voffB1); PG8_STAGE(PG8_SA(0, 0), cA, cv0); PG8_STAGE(PG8_SA(0, 1), cA, cv1);
    if (wr == 1) PG8_BAR;
    PG8_WAIT_V(2); PG8_BAR;
    PG8_STAGE(PG8_SB(1, 0), cB + kstep, voffB0); PG8_STAGE(PG8_SA(1, 0), cA + kstepA, cv0); PG8_STAGE(PG8_SB(1, 1), cB + kstep, voffB1);
    PG8_WAIT_V(6); PG8_BAR;
    for (;;) {
        const bool has_next = S.next(ui + 1, nxt);
        const char* nA = has_next ? (const char*)Abase + S.aoff(nxt) : cA; const char* nB = has_next ? S.bptr(nxt) : cB;
#pragma unroll
        for (int i = 0; i < 2; ++i) { nv0[i] = cv0[i]; nv1[i] = cv1[i]; }
        if (has_next) PG8_AOFFS(nxt, nv0, nv1);
        const bool act0 = cur.cnt > wr * 64, act1 = cur.cnt > HALF + wr * 64;
        for (int t = 0; t < nt; t += 2) {
            const bool last = (t == nt - 2);
            const char* a1 = cA + (size_t)(t + 1) * kstepA;
            const char* a2 = last ? nA : cA + (size_t)(t + 2) * kstepA; const char* b2 = last ? nB : cB + (size_t)(t + 2) * kstep;
            const char* a3 = a2 + kstepA; const char* b3 = b2 + kstep;
            unsigned s0[2] = {cv0[0], cv0[1]}, s1[2] = {cv1[0], cv1[1]};
            if (last) { asm volatile("" ::: "memory"); s0[0] = nv0[0]; s0[1] = nv0[1]; s1[0] = nv1[0]; s1[1] = nv1[1]; }
            PG8_LDB(B0, 0, 0); PG8_LDB(B1, 0, 1); PG8_SCHED; PG8_LDA(At, 0, 0); PG8_STAGE(PG8_SA(1, 1), a1, cv1);
            PG8_WAIT_V(8); PG8_WAIT_L(0); PG8_BAR; if (act0) { PG8_MMA(0, 0, At, B0); PG8_MMA(0, 1, At, B1); } PG8_BAR; PG8_SCHED;
            PG8_LDA(At, 0, 1); PG8_STAGE(PG8_SB(0, 0), b2, voffB0); PG8_STAGE(PG8_SB(0, 1), b2, voffB1); PG8_STAGE(PG8_SA(0, 0), a2, s0);
            PG8_WAIT_V(8); PG8_WAIT_L(0); PG8_BAR; if (act1) { PG8_MMA(1, 0, At, B0); PG8_MMA(1, 1, At, B1); } PG8_BAR; PG8_SCHED;
            PG8_LDB(B0, 1, 0); PG8_LDB(B1, 1, 1); PG8_SCHED; PG8_LDA(At, 1, 0); PG8_STAGE(PG8_SA(0, 1), a2, s1);
            PG8_WAIT_V(8); PG8_WAIT_L(0); PG8_BAR; if (act0) { PG8_MMA(0, 0, At, B0); PG8_MMA(0, 1, At, B1); } PG8_BAR; PG8_SCHED;
            PG8_LDA(At, 1, 1); PG8_STAGE(PG8_SB(1, 0), b3, voffB0); PG8_STAGE(PG8_SB(1, 1), b3, voffB1); PG8_STAGE(PG8_SA(1, 0), a3, s0);
            PG8_WAIT_V(8); PG8_WAIT_L(0); PG8_BAR; if (act1) { PG8_MMA(1, 0, At, B0); PG8_MMA(1, 1, At, B1); } PG8_BAR; PG8_SCHED;
        }
        if (wr == 0) PG8_BAR;
        { Unit2 eu = cur; asm volatile("" : "+s"(eu.pm), "+s"(eu.pn), "+s"(eu.e), "+s"(eu.cnt), "+s"(eu.jt), "+s"(eu.ui));
          E(acc, eu, wr, wc, fr, fq);
          }
        if (!has_next) break;
#pragma unroll
        for (int a = 0; a < 2; ++a)
#pragma unroll
            for (int b = 0; b < 2; ++b)
#pragma unroll
                for (int m = 0; m < 4; ++m)
#pragma unroll
                    for (int n = 0; n < 2; ++n) acc[a][b][m][n] = (f32x4){0.f, 0.f, 0.f, 0.f};
        cur = nxt; cA = nA; cB = nB; ++ui;
#pragma unroll
        for (int i = 0; i < 2; ++i) { cv0[i] = nv0[i]; cv1[i] = nv1[i]; }
        if (wr == 1) PG8_BAR;
    }
    PG8_WAIT_V(0);
    PG8_BAR;
#undef PG8_AOFFS
#undef PG8_SA
#undef PG8_SB
#undef PG8_STAGE
#undef PG8_LDA
#undef PG8_LDB
#undef PG8_MMA
#undef PG8_WAIT_V
#undef PG8_WAIT_L
#undef PG8_BAR
#undef PG8_SCHED
}

struct DenseSched {
    StaticOrder so; const bf16_t* Bt; int ldb;
    __device__ __forceinline__ bool next(int i, Unit2& u) const { Unit t; if (!so.next(i, t)) return false; u.pm = t.pm; u.pn = t.pn; u.e = 0; u.cnt = 256; u.jt = 0; u.ui = i; return true; }
    __device__ __forceinline__ int arow(const Unit2& u, int r) const { return u.pm * BM + r; }
    __device__ __forceinline__ size_t aoff(const Unit2&) const { return 0; }
    __device__ __forceinline__ const char* bptr(const Unit2& u) const { return (const char*)(Bt + (size_t)u.pn * BM * ldb); }
};
struct EpiPlainBf16 {
    static constexpr bool PERM = true, AFTER_DRAIN = false;
    bf16_t* O; int ldc;
    __device__ __forceinline__ void operator()(const f32x4 (&acc)[2][2][4][2], const Unit2& u, int wr, int wc, int fr, int fq) const {
        const int row0 = u.pm * BM + wr * 64 + fr, col0 = u.pn * BM + wc * 32 + 8 * fq;
#pragma unroll
        for (int ai = 0; ai < 2; ++ai)
#pragma unroll
            for (int m = 0; m < 4; ++m) { bf16_t* rowp = O + (size_t)(row0 + ai * HALF + m * 16) * ldc + col0;
#pragma unroll
                for (int bj = 0; bj < 2; ++bj) { const f32x4 v0 = acc[ai][bj][m][0], v1 = acc[ai][bj][m][1];
                    u32x4 w; w.x = cvt_pk_bf16(v0[0], v0[1]); w.y = cvt_pk_bf16(v0[2], v0[3]); w.z = cvt_pk_bf16(v1[0], v1[1]); w.w = cvt_pk_bf16(v1[2], v1[3]);
                    *(u32x4*)(rowp + bj * HALF) = w; } }
    }
};
}
namespace nv {
constexpr int D = 1024, B = 8, S = 4096, T = B * S;
constexpr int FH = 8, FD = 64, GH = 4, GK = 64, GV = 128, RANK = 16;
constexpr int INW = 3096;
constexpr int O_FQ = 0, O_FK = 512, O_FV = 1024, O_FF = 1536, O_GQ = 1544, O_GK = 1800, O_GV = 2056, O_GA = 2568, O_GR = 2584;
constexpr int NE = 256, NG = 8, TOPK = 8, ED = 256;
constexpr float LN_EPS = 1e-5f;
constexpr float ALPHA = 1.189207115002721f;
constexpr int PADR = 64;
constexpr int APAD = T * TOPK + NE * PADR;

__device__ __forceinline__ float logsigmoidf(float x) { return fminf(x, 0.f) - log1pf(expf(-fabsf(x))); }
__device__ __forceinline__ float siluf(float x) { return x / (1.f + expf(-x)); }

}
#include <hip/hip_bf16.h>
#include <cmath>
namespace attn_body {
using bf16=__hip_bfloat16;
using bf16x8=__attribute__((ext_vector_type(8)))short;
using s16x4=__attribute__((ext_vector_type(4)))short;
using f32x16=__attribute__((ext_vector_type(16)))float;
using u32x4=__attribute__((ext_vector_type(4)))unsigned;
constexpr int BATCH=8,NHEAD=8,SEQ=4096,D=64,DM=3072,OPITCH=1024;
constexpr int NW=8,QBLK=32,QB=QBLK*NW,KVBLK=64,NQB=SEQ/QB;
constexpr int ATTN_PITCH=DM, ATTN_UNIT_ROWS=QB;
__device__ __forceinline__ int crow(int r,int hi){return (r&3)+8*(r>>2)+4*hi;}
#define SBAR() __builtin_amdgcn_sched_barrier(0)
__device__ __forceinline__ void cmask(f32x16&p0,f32x16&p1,int jb,int qrel,int hi){
  const float NEG=-INFINITY; int kb=64*jb+4*hi;
  #pragma unroll
  for(int r=0;r<16;++r){int kv=kb+(r&3)+8*(r>>2); if(kv>qrel)p0[r]=NEG; if(kv+32>qrel)p1[r]=NEG;}
}

constexpr int NSLOT=3, SLOTB=8192;
constexpr int LDS_K=0, LDS_V=NSLOT*SLOTB, LDS_WS=2*NSLOT*SLOTB, LDS_OST=LDS_WS+NW*64*4, LDS_KB=LDS_OST+NW*4096, LDS_BYTES=LDS_KB+(SEQ+2)*8;
constexpr float C2=0.125f*1.4426950408889634f;
__device__ __forceinline__ void glds16(const void*gsrc,unsigned lds_dst){unsigned keep;
  asm volatile("s_mov_b32 %0, m0\n\ts_mov_b32 m0, %2\n\ts_nop 0\n\tglobal_load_lds_dwordx4 %1, off\n\ts_mov_b32 m0, %0":"=&s"(keep):"v"(gsrc),"s"(lds_dst):"memory");}
__device__ __forceinline__ float max3f(float a,float b,float c){float r;asm("v_max3_f32 %0, %1, %2, %3":"=v"(r):"v"(a),"v"(b),"v"(c));return r;}
__device__ __forceinline__ float max2f(float a,float b){float r;asm("v_max_f32_e32 %0, %1, %2":"=v"(r):"v"(a),"v"(b));return r;}
__device__ __forceinline__ float fadd_s(float a,float b){float r;asm("v_add_f32_e32 %0, %1, %2":"=v"(r):"v"(a),"v"(b));return r;}
__device__ __forceinline__ float fsub_s(float a,float b){float r;asm("v_sub_f32_e32 %0, %1, %2":"=v"(r):"v"(a),"v"(b));return r;}
typedef float f32x2_t __attribute__((ext_vector_type(2))); typedef float f32x4_t __attribute__((ext_vector_type(4))); typedef __bf16 bf16x2_t __attribute__((ext_vector_type(2)));
__device__ __forceinline__ unsigned cvtpk_s(float lo,float hi){f32x2_t v={lo,hi};bf16x2_t b=__builtin_convertvector(v,bf16x2_t);return __builtin_bit_cast(unsigned,b);}
#define WAIT_BAR(N) asm volatile("s_waitcnt vmcnt(" #N ") lgkmcnt(0)\n\ts_barrier":::"memory")

__device__ __forceinline__ void split3(float b,unsigned&h,unsigned&m,unsigned&l){
  h=cvtpk_s(b,0.f)&0xffffu; const float r1=b-__uint_as_float(h<<16);
  m=cvtpk_s(r1,0.f)&0xffffu; const float r2=r1-__uint_as_float(m<<16);
  l=cvtpk_s(r2,0.f)&0xffffu; }
__device__ __forceinline__ bf16x8 kbias_frag(float b,int hi){unsigned h,m,l;split3(b,h,m,l);u32x4 w;w.x=h|(m<<16);w.y=l|0x3F800000u;w.z=0x3F803F80u;w.w=0u;if(hi){w.x=0u;w.y=0u;w.z=0u;}return __builtin_bit_cast(bf16x8,w);}
__device__ __forceinline__ bf16x8 qref_frag(float x,int hi){unsigned h,m,l;split3(x,h,m,l);u32x4 w;w.x=0x3F803F80u;w.y=0x3F80u|(h<<16);w.z=m|(l<<16);w.w=0u;if(hi){w.x=0u;w.y=0u;w.z=0u;}return __builtin_bit_cast(bf16x8,w);}
typedef unsigned u32x2_t __attribute__((ext_vector_type(2)));
__device__ __forceinline__ bf16x8 mkfrag(u32x2_t e,unsigned zc){u32x4 w;w.x=e.x;w.y=e.y;w.z=zc;w.w=0u;return __builtin_bit_cast(bf16x8,w);}
__device__ __forceinline__ void fox_bias_table(int b,int h,const float*LF,char*shm){
  int tid_=threadIdx.x; asm volatile("":"+v"(tid_)); const int tid=tid_,lane=tid&63,wid=__builtin_amdgcn_readfirstlane(tid>>6);
  const float*lf=LF+((long)b*NHEAD+h)*SEQ; float*wt=(float*)(shm+LDS_WS); u32x2_t*KB8=(u32x2_t*)(shm+LDS_KB);
  f32x4_t va=*(const f32x4_t*)(lf+8*tid),vb=*(const f32x4_t*)(lf+8*tid+4);
  va[1]+=va[0];va[2]+=va[1];va[3]+=va[2];vb[0]+=va[3];vb[1]+=vb[0];vb[2]+=vb[1];vb[3]+=vb[2];
  const float tot=vb[3]; float inc=tot;
  #pragma unroll
  for(int o_=1;o_<64;o_<<=1){const float nn=__shfl_up(inc,o_);if(lane>=o_)inc+=nn;}
  __syncthreads();
  if(lane==63)wt[wid*64]=inc;
  __syncthreads();
  float base=inc-tot;
  #pragma unroll
  for(int w_=0;w_<NW;++w_){const float x_=wt[w_*64]; if(w_<wid)base+=x_;}
  const float cv[8]={va[0]+base,va[1]+base,va[2]+base,va[3]+base,vb[0]+base,vb[1]+base,vb[2]+base,vb[3]+base};
  #pragma unroll
  for(int j=0;j<8;++j){unsigned hh,mm,ll;split3(-cv[j],hh,mm,ll);KB8[8*tid+j]=(u32x2_t){hh|(mm<<16),ll|0x3F800000u};}
  if(tid==0){KB8[SEQ]=(u32x2_t){0u,0u};KB8[SEQ+1]=(u32x2_t){0u,0u};}
  __syncthreads();
}
__device__ __forceinline__ void qkt(f32x16&p0,f32x16&p1,const char*Kslot,const bf16x8*qr,bf16x8 kb0,bf16x8 kb1,bf16x8 qx,int r32,int hi){
  const f32x16 negm=f32x16{};
  const char*kb=Kslot+hi*1024+r32*16;
  #pragma unroll
  for(int d0=0;d0<4;++d0){
    const bf16x8 b0=*reinterpret_cast<const bf16x8*>(kb+d0*2048);
    const bf16x8 b1=*reinterpret_cast<const bf16x8*>(kb+d0*2048+512);
    if(d0==0){p0=__builtin_amdgcn_mfma_f32_32x32x16_bf16(b0,qr[0],negm,0,0,0);p1=__builtin_amdgcn_mfma_f32_32x32x16_bf16(b1,qr[0],negm,0,0,0);}
    else{p0=__builtin_amdgcn_mfma_f32_32x32x16_bf16(b0,qr[d0],p0,0,0,0);p1=__builtin_amdgcn_mfma_f32_32x32x16_bf16(b1,qr[d0],p1,0,0,0);}}
  p0=__builtin_amdgcn_mfma_f32_32x32x16_bf16(kb0,qx,p0,0,0,0);p1=__builtin_amdgcn_mfma_f32_32x32x16_bf16(kb1,qx,p1,0,0,0);
}
typedef __attribute__((address_space(3))) const char* lds_cptr;
typedef short v4i16_t __attribute__((ext_vector_type(4)));
__device__ __forceinline__ void kload8(bf16x8*kf,lds_cptr kp){
  kf[0]=*(const __attribute__((address_space(3))) bf16x8*)(kp);      kf[1]=*(const __attribute__((address_space(3))) bf16x8*)(kp+512);
  kf[2]=*(const __attribute__((address_space(3))) bf16x8*)(kp+2048); kf[3]=*(const __attribute__((address_space(3))) bf16x8*)(kp+2560);
  kf[4]=*(const __attribute__((address_space(3))) bf16x8*)(kp+4096); kf[5]=*(const __attribute__((address_space(3))) bf16x8*)(kp+4608);
  kf[6]=*(const __attribute__((address_space(3))) bf16x8*)(kp+6144); kf[7]=*(const __attribute__((address_space(3))) bf16x8*)(kp+6656);
}
__device__ __forceinline__ void kload2(bf16x8*kf,lds_cptr kp,int j){ kf[2*j]=*(const __attribute__((address_space(3))) bf16x8*)(kp+j*2048); kf[2*j+1]=*(const __attribute__((address_space(3))) bf16x8*)(kp+j*2048+512); }
__device__ __forceinline__ s16x4 vtr(lds_cptr p){ return __builtin_bit_cast(s16x4,__builtin_amdgcn_ds_read_tr16_b64_v4i16((__attribute__((address_space(3))) v4i16_t*)p)); }
__device__ __forceinline__ float rowmax(const f32x16&p0,const f32x16&p1){
  float a=max3f(p0[0],p0[1],p1[0]),b=max3f(p0[2],p0[3],p1[1]);a=max3f(a,p1[2],p1[3]);
  #pragma unroll
  for(int r=4;r<16;r+=4){a=max3f(a,p0[r],p0[r+1]);b=max3f(b,p0[r+2],p0[r+3]);a=max3f(a,p1[r],p1[r+1]);b=max3f(b,p1[r+2],p1[r+3]);}
  const float m=max2f(a,b);
  auto rr=__builtin_amdgcn_permlane32_swap(__float_as_uint(m),__float_as_uint(m),false,false);
  return max2f(__uint_as_float(rr[0]),__uint_as_float(rr[1]));
}
__device__ __forceinline__ void pv(f32x16*o,int vb,bf16x8 pa0,bf16x8 pa1,bf16x8 pa2,bf16x8 pa3){
  #pragma unroll
  for(int d0=0;d0<2;++d0){s16x4 lo[4],hi[4];
    #pragma unroll
    for(int ks=0;ks<4;++ks){
      asm volatile("ds_read_b64_tr_b16 %0,%1 offset:%c2":"=&v"(lo[ks]):"v"(vb),"i"(d0*4096+ks*1024):"memory");
      asm volatile("ds_read_b64_tr_b16 %0,%1 offset:%c2":"=&v"(hi[ks]):"v"(vb),"i"(d0*4096+ks*1024+512):"memory");}
    asm volatile("s_waitcnt lgkmcnt(0)":::"memory");SBAR();
    #define PK(k) (bf16x8){lo[k][0],lo[k][1],lo[k][2],lo[k][3],hi[k][0],hi[k][1],hi[k][2],hi[k][3]}
    o[d0]=__builtin_amdgcn_mfma_f32_32x32x16_bf16(pa0,PK(0),o[d0],0,0,0);
    o[d0]=__builtin_amdgcn_mfma_f32_32x32x16_bf16(pa1,PK(1),o[d0],0,0,0);
    o[d0]=__builtin_amdgcn_mfma_f32_32x32x16_bf16(pa2,PK(2),o[d0],0,0,0);
    o[d0]=__builtin_amdgcn_mfma_f32_32x32x16_bf16(pa3,PK(3),o[d0],0,0,0);
    #undef PK
  }
}

#ifndef ATTN_STORE16
#define ATTN_STORE16(p,v) (*(u32x4*)(p)=(v))
#endif
template<int THRL> __device__ __forceinline__ void attn_unit(int b,int h,int qb,const bf16*Q,const bf16* K,const bf16* V,bf16*O,const float*LF,const unsigned*NRM,char*shm){
  int tid_=threadIdx.x; asm volatile("":"+v"(tid_));
  const int tid=tid_,lane=tid&63,r32=lane&31,hi=lane>>5; const int wid=__builtin_amdgcn_readfirstlane(tid>>6);
  const long rowbase=(long)b*SEQ; const int q0=qb*QB;
  const char*KBt0=shm+LDS_KB;
  int t0;
  { const int NT0=(q0+QB)/KVBLK; const unsigned*nr=NRM+(b*NHEAD+h)*4;
    const float qn2=__uint_as_float(nr[0])+__uint_as_float(nr[1]), kn2=__uint_as_float(nr[2])+__uint_as_float(nr[3]);
    const float thr=-(50.f+2.04f*sqrtf(qn2*kn2));
    const u32x2_t eq0=*(const u32x2_t*)(KBt0+(unsigned)q0*8u); const float bq0=__uint_as_float(eq0.x<<16)+__uint_as_float(eq0.x&0xffff0000u)+__uint_as_float(eq0.y<<16);
    bool ok=(2*lane<=NT0-4);
    if(ok&&lane>0){ const u32x2_t el=*(const u32x2_t*)(KBt0+(unsigned)(128*lane-1)*8u); const float bl=__uint_as_float(el.x<<16)+__uint_as_float(el.x&0xffff0000u)+__uint_as_float(el.y<<16); ok=(bl-bq0<thr); }
    const unsigned long long mk=__ballot(ok); const unsigned long long low=~mk; const int cnt=(low==0ull)?64:__builtin_ctzll(low);
    t0=__builtin_amdgcn_readfirstlane(2*(cnt-1)); }
  const char*KBt=KBt0+(hi?0:t0*512); const unsigned kb_o0=hi?(unsigned)SEQ*8u:(unsigned)r32*8u, kb_o1=hi?(unsigned)SEQ*8u:(unsigned)(r32+32)*8u, kb_str=hi?0u:512u, zc=hi?0u:0x3F803F80u;
  const bf16*Qw=Q+(rowbase+q0+wid*QBLK)*DM+h*D;
  const bf16*Kh=K+(rowbase+(long)t0*KVBLK)*DM+h*D,*Vh=V+(rowbase+(long)t0*KVBLK)*DM+h*D;
  const unsigned lds0=(unsigned)(uintptr_t)shm;
  float*wsf=(float*)(shm+LDS_WS)+wid*64;
  const bf16*ksrc=Kh+(long)lane*DM+wid*8;
  const bf16*vsrc=Vh+(long)(16*(wid&3)+(lane>>2))*DM+(wid>>2)*32+(lane&3)*8;
  const unsigned kdst=lds0+LDS_K+wid*1024, vdst=lds0+LDS_V+wid*1024;
  #define DMA_K(t,slot) glds16(ksrc+(long)(t)*KVBLK*DM,(unsigned)__builtin_amdgcn_readfirstlane(kdst+(slot)))
  #define DMA_V(t,slot) glds16(vsrc+(long)(t)*KVBLK*DM,(unsigned)__builtin_amdgcn_readfirstlane(vdst+(slot)))
  const int vb0=(int)(lds0+LDS_V)+((lane>>4)&1)*32+(lane&3)*8+(4*hi+((lane&15)>>2))*64;
  const char*Kbase=shm+LDS_K; bf16x8 kf[8];
  const lds_cptr shm3=(lds_cptr)shm; const lds_cptr kp0=shm3+LDS_K+hi*1024+r32*16; const lds_cptr vp0=shm3+LDS_V+((lane>>4)&1)*32+(lane&3)*8+(4*hi+((lane&15)>>2))*64;
  const int NT=(q0+QB)/KVBLK-t0;
  DMA_K(0,0);DMA_V(0,0);DMA_K(1,SLOTB);
  bf16x8 qr[4];
  #pragma unroll
  for(int d0=0;d0<4;++d0)qr[d0]=*reinterpret_cast<const bf16x8*>(&Qw[(long)r32*DM+d0*16+hi*8]);
  float mhat; { const u32x2_t eq=*(const u32x2_t*)(KBt0+(unsigned)(q0+wid*QBLK+r32)*8u); mhat=__uint_as_float(eq.x<<16)+__uint_as_float(eq.x&0xffff0000u)+__uint_as_float(eq.y<<16); }
  float l_reg=0.f;f32x16 o[2];o[0]=f32x16{};o[1]=f32x16{};const f32x16 negm=f32x16{};
  bf16x8 qx=qref_frag(-mhat,hi);
  const int qrel=wid*QBLK+r32;
  #define CMASK(P0,P1,t) do{int jb_=(t)-(NT-4); if(jb_>=0)cmask(P0,P1,jb_,qrel,hi);}while(0)
  bool resc=false;
  #define START(P0,P1) do{ const float rm=rowmax(P0,P1); resc=false; \
    { const float dl=__builtin_fmaxf(rm,0.f); mhat=fadd_s(mhat,dl); \
      _Pragma("unroll") for(int r=0;r<16;++r){P0[r]=fsub_s(P0[r],dl);P1[r]=fsub_s(P1[r],dl);} \
      qx=qref_frag(-mhat,hi); } \
    _Pragma("unroll") for(int r=0;r<16;++r)P0[r]=__builtin_amdgcn_exp2f(P0[r]); }while(0)
  #define RESC() do{ if(resc){ asm volatile("s_waitcnt lgkmcnt(0)":::"memory"); \
      _Pragma("unroll") for(int d_=0;d_<2;++d_) _Pragma("unroll") for(int r=0;r<16;++r)o[d_][r]*=wsf[crow(r,hi)]; } }while(0)
  f32x16 pA0,pA1,pB0,pB1;
  int sl_prev=0,sl_cur=0,sl_next=SLOTB;
  #define ROT() do{sl_prev=sl_cur;sl_cur=sl_next;sl_next=(sl_next==(NSLOT-1)*SLOTB)?0:sl_next+SLOTB;}while(0)
  DMA_K(2,2*SLOTB);
  WAIT_BAR(3);
  qkt(pA0,pA1,Kbase,qr,mkfrag(*(const u32x2_t*)(KBt+kb_o0),zc),mkfrag(*(const u32x2_t*)(KBt+kb_o1),zc),qx,r32,hi);asm volatile("s_nop 15\n\ts_nop 7":"+v"(pA0),"+v"(pA1));CMASK(pA0,pA1,0);
  START(pA0,pA1);
  _Pragma("unroll") for(int r=0;r<16;++r)pA1[r]=__builtin_amdgcn_exp2f(pA1[r]);
  WAIT_BAR(0);
  DMA_K(3,0);DMA_V(1,SLOTB);
  ROT();
  kload8(kf,kp0+sl_cur);
  WAIT_BAR(2);
  s16x4 vlo[8],vhi[8]; u32x4 pw0,pw1,pw2,pw3;
  #define PKW(P,B) cvtpk_s(P[B],P[B+1])
  #define PAF(k) __builtin_bit_cast(bf16x8,pw##k)
  #define VFR(i) (bf16x8){vlo[i][0],vlo[i][1],vlo[i][2],vlo[i][3],vhi[i][0],vhi[i][1],vhi[i][2],vhi[i][3]}
  #define PIN(x) asm volatile("":"+v"(x))
  #define MX3(a,b,c) __builtin_fmaxf(__builtin_fmaxf((a),(b)),(c))
  #define GAPA(MF,A0,A1,A2,A3,W0,W1,PW) do{ MF; sacc+=A0; sacc+=A1; sacc+=A2; sacc+=A3; PIN(sacc); W0; W1; PIN(PW); SBAR(); }while(0)
  #define EX(v) __builtin_amdgcn_exp2f(v)
  #define GAPB(MF,X,B) do{ MF; X[B]=EX(X[B]); X[B+1]=EX(X[B+1]); X[B+2]=EX(X[B+2]); X[B+3]=EX(X[B+3]); PIN(X); SBAR(); }while(0)
  #define VRD(i) do{ vlo[i]=vtr(vp_+(((i)>>2)*4096+((i)&3)*1024)); vhi[i]=vtr(vp_+(((i)>>2)*4096+((i)&3)*1024+512)); }while(0)
  #define KRD(G,j) do{ if(G){ kload2(kf,kp0+sl_next,j); SBAR(); } }while(0)
  #define STEP(C0,C1,P0,P1,t,GK,GV,GL) do{ SBAR(); \
    const lds_cptr vp_=vp0+sl_prev; const u32x2_t e0_=*(const u32x2_t*)(KBt+kb_o0+(unsigned)(t)*kb_str),e1_=*(const u32x2_t*)(KBt+kb_o1+(unsigned)(t)*kb_str); \
    VRD(0); SBAR(); float sacc=(P0[0]+P0[1]); \
    GAPA(C0=__builtin_amdgcn_mfma_f32_32x32x16_bf16(kf[0],qr[0],negm,0,0,0), P0[2],P0[3],P0[4],P0[5],     pw0[0]=PKW(P0,0), pw0[1]=PKW(P0,2), pw0); \
    VRD(4); SBAR(); GAPA(C1=__builtin_amdgcn_mfma_f32_32x32x16_bf16(kf[1],qr[0],negm,0,0,0), P0[6],P0[7],P0[8],P0[9],     pw0[2]=PKW(P0,4), pw0[3]=PKW(P0,6), pw0); \
    VRD(1); SBAR(); GAPA(C0=__builtin_amdgcn_mfma_f32_32x32x16_bf16(kf[2],qr[1],C0,0,0,0),   P0[10],P0[11],P0[12],P0[13], pw1[0]=PKW(P0,8), pw1[1]=PKW(P0,10), pw1); \
    VRD(5); SBAR(); GAPA(C1=__builtin_amdgcn_mfma_f32_32x32x16_bf16(kf[3],qr[1],C1,0,0,0),   P0[14],P0[15],P1[0],P1[1],   pw1[2]=PKW(P0,12),pw1[3]=PKW(P0,14), pw1); \
    VRD(2); SBAR(); GAPA(C0=__builtin_amdgcn_mfma_f32_32x32x16_bf16(kf[4],qr[2],C0,0,0,0),   P1[2],P1[3],P1[4],P1[5],     pw2[0]=PKW(P1,0), pw2[1]=PKW(P1,2), pw2); \
    VRD(6); SBAR(); GAPA(C1=__builtin_amdgcn_mfma_f32_32x32x16_bf16(kf[5],qr[2],C1,0,0,0),   P1[6],P1[7],P1[8],P1[9],     pw2[2]=PKW(P1,4), pw2[3]=PKW(P1,6), pw2); \
    VRD(3); SBAR(); GAPA(C0=__builtin_amdgcn_mfma_f32_32x32x16_bf16(kf[6],qr[3],C0,0,0,0),   P1[10],P1[11],P1[12],P1[13], pw3[0]=PKW(P1,8), pw3[1]=PKW(P1,10), pw3); \
    VRD(7); SBAR(); GAPA(C1=__builtin_amdgcn_mfma_f32_32x32x16_bf16(kf[7],qr[3],C1,0,0,0),   P1[14],P1[15],0.f,0.f,       pw3[2]=PKW(P1,12),pw3[3]=PKW(P1,14), pw3); \
    { const bf16x8 kb0_=mkfrag(e0_,zc),kb1_=mkfrag(e1_,zc); C0=__builtin_amdgcn_mfma_f32_32x32x16_bf16(kb0_,qx,C0,0,0,0); C1=__builtin_amdgcn_mfma_f32_32x32x16_bf16(kb1_,qx,C1,0,0,0); } SBAR(); \
    l_reg+=sacc; \
    if(GK){DMA_K((t)+3,sl_cur);} if(GV){DMA_V((t)+1,sl_next);} \
    CMASK(C0,C1,t); \
    { float a=MX3(C0[0],C0[1],C1[0]),b=MX3(C0[2],C0[3],C1[1]); a=MX3(a,C1[2],C1[3]); \
      _Pragma("unroll") for(int r=4;r<16;r+=4){a=MX3(a,C0[r],C0[r+1]);b=MX3(b,C0[r+2],C0[r+3]);a=MX3(a,C1[r],C1[r+1]);b=MX3(b,C1[r+2],C1[r+3]);} \
      float rm=__builtin_fmaxf(a,b); { auto rr=__builtin_amdgcn_permlane32_swap(__float_as_uint(rm),__float_as_uint(rm),false,false); rm=__builtin_fmaxf(__uint_as_float(rr[0]),__uint_as_float(rr[1])); } \
      resc=false; \
      if(__builtin_expect(__any(rm>(float)THRL),0)){ const float dl=__builtin_fmaxf(rm,0.f); mhat+=dl; \
        _Pragma("unroll") for(int r=0;r<16;++r){C0[r]-=dl;C1[r]-=dl;} \
        qx=qref_frag(-mhat,hi); \
        const float f=__builtin_amdgcn_exp2f(-dl); l_reg*=f; if(hi==0)wsf[r32]=f; resc=true; } } \
    SBAR(); \
    GAPB(o[0]=__builtin_amdgcn_mfma_f32_32x32x16_bf16(PAF(0),VFR(0),o[0],0,0,0), C0,0); \
    GAPB(o[1]=__builtin_amdgcn_mfma_f32_32x32x16_bf16(PAF(0),VFR(4),o[1],0,0,0), C0,4); \
    KRD(GL,0); GAPB(o[0]=__builtin_amdgcn_mfma_f32_32x32x16_bf16(PAF(1),VFR(1),o[0],0,0,0), C0,8); \
    KRD(GL,1); GAPB(o[1]=__builtin_amdgcn_mfma_f32_32x32x16_bf16(PAF(1),VFR(5),o[1],0,0,0), C0,12); \
    KRD(GL,2); GAPB(o[0]=__builtin_amdgcn_mfma_f32_32x32x16_bf16(PAF(2),VFR(2),o[0],0,0,0), C1,0); \
    KRD(GL,3); GAPB(o[1]=__builtin_amdgcn_mfma_f32_32x32x16_bf16(PAF(2),VFR(6),o[1],0,0,0), C1,4); \
    GAPB(o[0]=__builtin_amdgcn_mfma_f32_32x32x16_bf16(PAF(3),VFR(3),o[0],0,0,0), C1,8); \
    GAPB(o[1]=__builtin_amdgcn_mfma_f32_32x32x16_bf16(PAF(3),VFR(7),o[1],0,0,0), C1,12); \
    }while(0)
  int t=1;
  #undef CMASK
  #define CMASK(P0,P1,t) do{}while(0)
  for(;t+5<NT;t+=2){
    STEP(pB0,pB1,pA0,pA1,t,true,true,true);     WAIT_BAR(2); RESC(); ROT();
    STEP(pA0,pA1,pB0,pB1,t+1,true,true,true);   WAIT_BAR(2); RESC(); ROT();
  }
  #undef CMASK
  #define CMASK(P0,P1,t) do{int jb_=(t)-(NT-4); if(jb_>=0)cmask(P0,P1,jb_,qrel,hi);}while(0)
  #define ENDW(tt) do{ if((tt)+3<NT){WAIT_BAR(2);} else if((tt)+2<NT){WAIT_BAR(1);} else {WAIT_BAR(0);} }while(0)
  for(;t+1<NT;t+=2){
    STEP(pB0,pB1,pA0,pA1,t,(t+3<NT),(t+1<NT),(t+1<NT));       ENDW(t);   RESC(); ROT();
    STEP(pA0,pA1,pB0,pB1,t+1,(t+4<NT),(t+2<NT),(t+2<NT));     ENDW(t+1); RESC(); ROT();
  }
  STEP(pB0,pB1,pA0,pA1,NT-1,false,false,false); RESC();
  { float sacc=pB0[0]+pB0[1]; _Pragma("unroll") for(int r=2;r<16;++r)sacc+=pB0[r]; _Pragma("unroll") for(int r=0;r<16;++r)sacc+=pB1[r]; l_reg+=sacc;
    pw0=(u32x4){PKW(pB0,0),PKW(pB0,2),PKW(pB0,4),PKW(pB0,6)};pw1=(u32x4){PKW(pB0,8),PKW(pB0,10),PKW(pB0,12),PKW(pB0,14)};pw2=(u32x4){PKW(pB1,0),PKW(pB1,2),PKW(pB1,4),PKW(pB1,6)};pw3=(u32x4){PKW(pB1,8),PKW(pB1,10),PKW(pB1,12),PKW(pB1,14)};
    SBAR(); pv(o,vb0+sl_cur,PAF(0),PAF(1),PAF(2),PAF(3)); }
  #undef PKW
  #undef PAF
  #undef VFR
  #undef PIN
  #undef MX3
  #undef GAPA
  #undef GAPB
  #undef EX
  #undef VRD
  #undef KRD
  #undef STEP
  #undef ENDW
  {auto rr=__builtin_amdgcn_permlane32_swap(__float_as_uint(l_reg),__float_as_uint(l_reg),false,false);l_reg=__uint_as_float(rr[0])+__uint_as_float(rr[1]);}
  if(hi==0)wsf[32+r32]=l_reg;asm volatile("s_waitcnt lgkmcnt(0)":::"memory");
  float rli[16];
  #pragma unroll
  for(int r=0;r<16;++r)rli[r]=__builtin_amdgcn_rcpf(wsf[32+crow(r,hi)]);
  bf16*Ow=O+(rowbase+q0+wid*QBLK)*OPITCH+h*D;
  { bf16*stg=(bf16*)(shm+LDS_OST)+wid*2048;
    #pragma unroll
    for(int r=0;r<16;++r){const int orow=crow(r,hi);
      #pragma unroll
      for(int d0=0;d0<2;++d0)stg[orow*64+d0*32+r32]=__float2bfloat16(o[d0][r]*rli[r]);}
    asm volatile("s_waitcnt lgkmcnt(0)":::"memory");
    #pragma unroll
    for(int i=0;i<4;++i){const int row=i*8+(lane>>3),ch=lane&7; const u32x4 v=*(const u32x4*)(stg+row*64+ch*8); ATTN_STORE16(Ow+(long)row*OPITCH+ch*8,v);} }
  asm volatile("s_waitcnt lgkmcnt(0)\n\ts_barrier":::"memory");
  #undef DMA_K
  #undef DMA_V
  #undef CMASK
  #undef START
  #undef RESC
  #undef ROT
}
constexpr int ATTN_LDS_BYTES=LDS_BYTES;
struct AttnTensors { const bf16* Q; const bf16* K; const bf16* V; bf16* O; const float* LF; const unsigned* NRM; };
struct AttnUnit { int bh; int qb; };
struct StaticOrder {
  int vcu,grid;
  __device__ __forceinline__ explicit StaticOrder(int grid_,int block):vcu((grid_%8==0)?(block%8)*(grid_/8)+block/8:block),grid(grid_){}
  __device__ __forceinline__ bool next(int i,AttnUnit&u)const{
    if(grid==256){ if(i>=4)return false; const int s=vcu&3; u.bh=vcu>>2; u.qb=(i==0)?s:(i==1)?7-s:(i==2)?8+s:15-s; return true; }
    const int L=i*grid+vcu; if(L>=BATCH*NHEAD*NQB)return false; u.bh=L/NQB; u.qb=L%NQB; return true; }
  __device__ __forceinline__ void a_ready(const AttnUnit&)const{}
  __device__ __forceinline__ void done(const AttnUnit&)const{}
};
template<class Sched,int THRL=8> __device__ __forceinline__ void attn_phase(char*lds,const AttnTensors&T,const Sched&S){
  AttnUnit u; int cur_bh=-1;
  for(int i=0;S.next(i,u);++i){ S.a_ready(u); if(u.bh!=cur_bh){ fox_bias_table(u.bh/NHEAD,u.bh%NHEAD,T.LF,lds); cur_bh=u.bh; }
    attn_unit<THRL>(u.bh/NHEAD,u.bh%NHEAD,u.qb,T.Q,T.K,T.V,T.O,T.LF,T.NRM,lds); S.done(u); }
}
template<int THRL=8> __device__ __forceinline__ void attn_phase_dyn(char*lds,const AttnTensors&T,unsigned*qheads,volatile int*slot,int grp){
  int cur_bh=-1; const int NU=NHEAD*NQB; unsigned*qhead=qheads+64*grp;
  if(threadIdx.x==0) slot[0]=(int)__hip_atomic_fetch_add(qhead,1u,__ATOMIC_RELAXED,__HIP_MEMORY_SCOPE_AGENT);
  __syncthreads();
  int idx=__builtin_amdgcn_readfirstlane(slot[0]);
  while(idx<NU){
    __syncthreads();
    if(threadIdx.x==0) slot[0]=(int)__hip_atomic_fetch_add(qhead,1u,__ATOMIC_RELAXED,__HIP_MEMORY_SCOPE_AGENT);
    const int qb=NQB-1-idx/NHEAD, bh=grp*NHEAD+idx%NHEAD;
    if(bh!=cur_bh){ fox_bias_table(bh/NHEAD,bh%NHEAD,T.LF,lds); cur_bh=bh; }
    attn_unit<THRL>(bh/NHEAD,bh%NHEAD,qb,T.Q,T.K,T.V,T.O,T.LF,T.NRM,lds);
    __syncthreads();
    idx=__builtin_amdgcn_readfirstlane(slot[0]);
  }
}
#undef SBAR
#undef WAIT_BAR
}
namespace fx {
using namespace nv;
typedef unsigned short bf16;
typedef unsigned v4u __attribute__((ext_vector_type(4)));
typedef float f32x4 __attribute__((ext_vector_type(4)));
constexpr float C2 = 0.125f * 1.4426950408889634f;
constexpr int NIN = 3328;
constexpr int QKVP = 3072;
constexpr int P_FQ = 0, P_FK = 512, P_FV = 1024, P_GQ = 1536, P_GK = 1792, P_GV = 2048, P_GR = 2560;
__device__ __forceinline__ int inproj_src(int d) {
    if (d < 1536) return d;
    if (d < 1792) return O_GQ + (d - 1536);
    if (d < 2048) return O_GK + (d - 1792);
    if (d < 2560) return O_GV + (d - 2048);
    if (d < 3072) return O_GR + (d - 2560);
    if (d < 3080) return O_FF + (d - 3072);
    if (d < 3096) return O_GA + (d - 3080);
    return -1;
}
__device__ __forceinline__ unsigned f2bf(float f) { unsigned u = __builtin_bit_cast(unsigned, f); return (u + 0x7fffu + ((u >> 16) & 1u)) >> 16; }
__device__ __forceinline__ unsigned pk2(float lo, float hi) { return f2bf(lo) | (f2bf(hi) << 16); }
__device__ __forceinline__ float bf2f(unsigned short h) { return __builtin_bit_cast(float, (unsigned)h << 16); }
__device__ __forceinline__ float wave_sum(float v) {
#pragma unroll
    for (int o = 1; o < 64; o <<= 1) v += __shfl_xor(v, o);
    return v;
}
#define FX_LDS_WAIT() asm volatile("s_waitcnt lgkmcnt(0)" ::: "memory")

template <class Map> __device__ __forceinline__ void transpose_item(const float* __restrict__ W, int K, int N, bf16* WT, LAS float* scr, int kb, int nb, int lane, Map srcmap) {
    const int k0 = 64 * kb, n0 = 32 * nb;
    const int src = srcmap(n0 + (lane & 31));
#pragma unroll 8
    for (int i = 0; i < 32; ++i) { const int kk = 2 * i + (lane >> 5); scr[kk * 33 + (lane & 31)] = (src >= 0) ? W[(size_t)(k0 + kk) * N + src] : 0.f; }
    FX_LDS_WAIT(); asm volatile("" ::: "memory");
    const int c = lane & 7;
#pragma unroll
    for (int j = 0; j < 4; ++j) { const int n = (lane >> 3) + 8 * j; const LAS float* s = scr + (8 * c) * 33 + n;
        v4u o; o.x = pk2(s[0 * 33], s[1 * 33]); o.y = pk2(s[2 * 33], s[3 * 33]); o.z = pk2(s[4 * 33], s[5 * 33]); o.w = pk2(s[6 * 33], s[7 * 33]);
        *(GAS v4u*)(WT + (size_t)(n0 + n) * K + k0 + 8 * c) = o; }
    FX_LDS_WAIT(); asm volatile("" ::: "memory");
}

__device__ __forceinline__ void ln_row_bf16(const float* xrow, const float* __restrict__ g, const float* __restrict__ b, bf16* orow, float* frow, float* st, int lane) {
    const GAS f32x4* xr = (const GAS f32x4*)xrow + lane;
    f32x4 v[4]; float s = 0.f;
#pragma unroll
    for (int j = 0; j < 4; ++j) { v[j] = xr[64 * j]; s += (v[j].x + v[j].y) + (v[j].z + v[j].w); }
    const float mean = wave_sum(s) * (1.f / D); float s2 = 0.f;
#pragma unroll
    for (int j = 0; j < 4; ++j) { v[j] = v[j] - mean; s2 += (v[j].x * v[j].x + v[j].y * v[j].y) + (v[j].z * v[j].z + v[j].w * v[j].w); }
    const float rstd = 1.f / sqrtf(wave_sum(s2) * (1.f / D) + LN_EPS);
    if (st && lane == 0) { st[0] = mean; st[1] = rstd; }
    GAS unsigned long long* o8 = (GAS unsigned long long*)orow + lane;
#pragma unroll
    for (int j = 0; j < 4; ++j) {
        const f32x4 gg = ((const f32x4*)g)[lane + 64 * j], bb = ((const f32x4*)b)[lane + 64 * j];
        const f32x4 o = v[j] * rstd * gg + bb;
        o8[64 * j] = (unsigned long long)pk2(o.x, o.y) | ((unsigned long long)pk2(o.z, o.w) << 32);
        if (frow) ((GAS f32x4*)frow)[lane + 64 * j] = o;
    }
}

struct CvItem { const float* W; bf16* WT; int N, K, k0, n0, s0; };
__device__ __forceinline__ void cv_load(const CvItem& it, f32x4 (&v)[8], int lane) {
    const float* p = it.W + (size_t)(it.k0 + (lane >> 3)) * it.N + it.s0 + 4 * (lane & 7);
#pragma unroll
    for (int i = 0; i < 8; ++i) v[i] = __builtin_nontemporal_load((const f32x4*)(p + (size_t)(8 * i) * it.N));
}
__device__ __forceinline__ void cv_finish(const CvItem& it, const f32x4 (&v)[8], LAS float* scr, int lane) {
    const int rr = lane >> 3, cq = lane & 7;
#pragma unroll
    for (int i = 0; i < 8; ++i) { LAS float* d = scr + (8 * i + rr) * 33 + 4 * cq; d[0] = v[i][0]; d[1] = v[i][1]; d[2] = v[i][2]; d[3] = v[i][3]; }
    FX_LDS_WAIT(); asm volatile("" ::: "memory");
    const int c = lane & 7;
#pragma unroll
    for (int j = 0; j < 4; ++j) { const int n = (lane >> 3) + 8 * j; const LAS float* s = scr + (8 * c) * 33 + n;
        v4u o; o.x = pk2(s[0 * 33], s[1 * 33]); o.y = pk2(s[2 * 33], s[3 * 33]); o.z = pk2(s[4 * 33], s[5 * 33]); o.w = pk2(s[6 * 33], s[7 * 33]);
        __builtin_nontemporal_store(o, (GAS v4u*)(it.WT + (size_t)(it.n0 + n) * it.K + it.k0 + 8 * c)); }
    FX_LDS_WAIT(); asm volatile("" ::: "memory");
}

template <int NR> __device__ __forceinline__ void ln_rows_bf16(const float* xrows, const float* __restrict__ g, const float* __restrict__ b, bf16* orows, int lane) {
    f32x4 v[NR][4];
#pragma unroll
    for (int r = 0; r < NR; ++r)
#pragma unroll
        for (int j = 0; j < 4; ++j) v[r][j] = ((const GAS f32x4*)(xrows + (size_t)r * D))[lane + 64 * j];
    f32x4 gg[4], bb[4];
#pragma unroll
    for (int j = 0; j < 4; ++j) { gg[j] = ((const f32x4*)g)[lane + 64 * j]; bb[j] = ((const f32x4*)b)[lane + 64 * j]; }
#pragma unroll
    for (int r = 0; r < NR; ++r) {
        float s = 0.f;
#pragma unroll
        for (int j = 0; j < 4; ++j) s += (v[r][j].x + v[r][j].y) + (v[r][j].z + v[r][j].w);
        const float mean = wave_sum(s) * (1.f / D); float s2 = 0.f;
#pragma unroll
        for (int j = 0; j < 4; ++j) { v[r][j] = v[r][j] - mean; s2 += (v[r][j].x * v[r][j].x + v[r][j].y * v[r][j].y) + (v[r][j].z * v[r][j].z + v[r][j].w * v[r][j].w); }
        const float rstd = 1.f / sqrtf(wave_sum(s2) * (1.f / D) + LN_EPS);
        GAS unsigned long long* o8 = (GAS unsigned long long*)(orows + (size_t)r * D) + lane;
#pragma unroll
        for (int j = 0; j < 4; ++j) { const f32x4 o = v[r][j] * rstd * gg[j] + bb[j];
            o8[64 * j] = (unsigned long long)pk2(o.x, o.y) | ((unsigned long long)pk2(o.z, o.w) << 32); }
    }
}

template <int NR> __device__ __forceinline__ void ln1_rows_bf16(const float* xrows, const float* st, const float* __restrict__ gi, const float* __restrict__ bi, const bf16* mixrows,
                                                               const float* __restrict__ g1, const float* __restrict__ b1, bf16* orows, float alpha, int lane) {
    f32x4 v[NR][4]; unsigned long long mx[NR][4]; float mean0[NR], rstd0[NR];
#pragma unroll
    for (int r = 0; r < NR; ++r) { mean0[r] = st[2 * r]; rstd0[r] = st[2 * r + 1];
#pragma unroll
        for (int j = 0; j < 4; ++j) { v[r][j] = ((const GAS f32x4*)(xrows + (size_t)r * D))[lane + 64 * j]; mx[r][j] = ((const GAS unsigned long long*)(mixrows + (size_t)r * D))[lane + 64 * j]; } }
    f32x4 gi4[4], bi4[4];
#pragma unroll
    for (int j = 0; j < 4; ++j) { gi4[j] = ((const f32x4*)gi)[lane + 64 * j] * alpha; bi4[j] = ((const f32x4*)bi)[lane + 64 * j] * alpha; }
#pragma unroll
    for (int r = 0; r < NR; ++r) {
        float s = 0.f;
#pragma unroll
        for (int j = 0; j < 4; ++j) { const unsigned lo = (unsigned)mx[r][j], hi = (unsigned)(mx[r][j] >> 32);
            f32x4 mv; mv.x = __builtin_bit_cast(float, lo << 16); mv.y = __builtin_bit_cast(float, lo & 0xffff0000u); mv.z = __builtin_bit_cast(float, hi << 16); mv.w = __builtin_bit_cast(float, hi & 0xffff0000u);
            v[r][j] = ((v[r][j] - mean0[r]) * rstd0[r]) * gi4[j] + bi4[j] + mv;
            s += (v[r][j].x + v[r][j].y) + (v[r][j].z + v[r][j].w); }
        const float mean = wave_sum(s) * (1.f / D); float s2 = 0.f;
#pragma unroll
        for (int j = 0; j < 4; ++j) { v[r][j] = v[r][j] - mean; s2 += (v[r][j].x * v[r][j].x + v[r][j].y * v[r][j].y) + (v[r][j].z * v[r][j].z + v[r][j].w * v[r][j].w); }
        const float rstd = 1.f / sqrtf(wave_sum(s2) * (1.f / D) + LN_EPS);
        GAS unsigned long long* o8 = (GAS unsigned long long*)(orows + (size_t)r * D) + lane;
#pragma unroll
        for (int j = 0; j < 4; ++j) { const f32x4 gg = ((const f32x4*)g1)[lane + 64 * j], bb = ((const f32x4*)b1)[lane + 64 * j]; const f32x4 o = v[r][j] * rstd * gg + bb;
            o8[64 * j] = (unsigned long long)pk2(o.x, o.y) | ((unsigned long long)pk2(o.z, o.w) << 32); }
    }
}
}

namespace pg8 {
struct EpiInProj {
    static constexpr bool PERM = true, AFTER_DRAIN = false;
    bf16_t* QKV; float* FG; float* LF; const float* bfg; unsigned* NRM;
    __device__ __forceinline__ void operator()(const f32x4 (&acc)[2][2][4][2], const Unit& u, int wr, int wc, int fr, int fq) const {
        const int row0 = u.pm * BM + wr * 64 + fr;
        if (u.pn < 12) {
            const float sc = (u.pn < 2) ? fx::C2 : 1.f;
            const int col0 = u.pn * BM + wc * 32 + 8 * fq;
            float nmax[2] = {0.f, 0.f};
#pragma unroll
            for (int ai = 0; ai < 2; ++ai)
#pragma unroll
                for (int m = 0; m < 4; ++m) { bf16_t* rowp = QKV + (size_t)(row0 + ai * HALF + m * 16) * fx::QKVP + col0;
#pragma unroll
                    for (int bj = 0; bj < 2; ++bj) { const f32x4 v0 = acc[ai][bj][m][0] * sc, v1 = acc[ai][bj][m][1] * sc;
                        u32x4 w; w.x = cvt_pk_bf16(v0[0], v0[1]); w.y = cvt_pk_bf16(v0[2], v0[3]); w.z = cvt_pk_bf16(v1[0], v1[1]); w.w = cvt_pk_bf16(v1[2], v1[3]);
                        *(u32x4*)(rowp + bj * HALF) = w;
                        if (u.pn < 4) { const f32x4 q0 = v0 * v0, q1 = v1 * v1; float s = (q0[0] + q0[1]) + (q0[2] + q0[3]) + (q1[0] + q1[1]) + (q1[2] + q1[3]);
                            s += __shfl_xor(s, 16); s += __shfl_xor(s, 32);
                            nmax[bj] = fmaxf(nmax[bj], s); } } }
            if (u.pn < 4) {
#pragma unroll
                for (int bj = 0; bj < 2; ++bj) { float s = nmax[bj];
#pragma unroll
                    for (int o = 1; o < 16; o <<= 1) s = fmaxf(s, __shfl_xor(s, o));
                    if (fr == 0 && fq == 0) { const int b = (u.pm * BM) >> 12, head = 4 * (u.pn & 1) + 2 * bj + (wc >> 1);
                        atomicMax(NRM + (b * 8 + head) * 4 + (u.pn >= 2 ? 2 : 0) + (wc & 1), __builtin_bit_cast(unsigned, s)); } }
            }
        } else if (wc == 0 && fq < 3) {
#pragma unroll
            for (int ai = 0; ai < 2; ++ai)
#pragma unroll
                for (int m = 0; m < 4; ++m) { const int row = row0 + ai * HALF + m * 16; float* p = FG + (size_t)row * 32 + 8 * fq;
                    *(f32x4*)p = acc[ai][0][m][0]; *(f32x4*)(p + 4) = acc[ai][0][m][1];
                    if (fq == 0) { const int b = row >> 12, s = row & 4095;
#pragma unroll
                        for (int n = 0; n < 2; ++n)
#pragma unroll
                            for (int i = 0; i < 4; ++i) { const int h = 4 * n + i; LF[(size_t)(b * 8 + h) * nv::S + s] = 1.4426950408889634f * nv::logsigmoidf(acc[ai][0][m][n][i] + bfg[h]); } } }
        }
    }
};
}
namespace gl {
using namespace nv;
typedef unsigned short bf16;
typedef short bf16x8 __attribute__((ext_vector_type(8)));
typedef float f32x4 __attribute__((ext_vector_type(4)));
typedef unsigned u32x4 __attribute__((ext_vector_type(4)));
typedef unsigned u32x2 __attribute__((ext_vector_type(2)));
constexpr int NCH = S / 64;
constexpr int NUNIT = B * GH * NCH;
constexpr int LS = 72;
constexpr int L_WGU = 0, L_BG = 4096, L_DECS = 4352, L_QP = 8192, L_KP = L_QP + 64 * LS * 2, L_KPT = L_KP + 64 * LS * 2, L_VT = L_KPT + 64 * LS * 2, L_PP = L_VT + 128 * LS * 2, L_WT = L_PP + 64 * LS * 2, L_END = L_WT + 2048;
static_assert(L_END <= 131072, "gla prep LDS");
constexpr int C_ST = 0, C_PART = 128 * LS * 2, C_END = C_PART + 2 * 8 * 64 * 4;
constexpr size_t QPG_B = 64 * 64 * 2, OI_B = 8 * 4 * 64 * 16, UU_B = OI_B, DEC_B = 256;

__device__ __forceinline__ unsigned pkbf(float lo, float hi) { typedef float f2 __attribute__((ext_vector_type(2))); typedef __bf16 b2 __attribute__((ext_vector_type(2))); f2 v = {lo, hi}; b2 r = __builtin_convertvector(v, b2); return __builtin_bit_cast(unsigned, r); }
__device__ __forceinline__ float bf2f(unsigned short h) { return __builtin_bit_cast(float, (unsigned)h << 16); }
__device__ __forceinline__ float bflo(unsigned w) { return __builtin_bit_cast(float, w << 16); }
__device__ __forceinline__ float bfhi(unsigned w) { return __builtin_bit_cast(float, w & 0xffff0000u); }
__device__ __forceinline__ float fast_logsig2(float x) { return -__builtin_amdgcn_logf(1.f + __builtin_amdgcn_exp2f(-1.4426950408889634f * x)); }

__device__ __forceinline__ void prep_unit(int unit, const bf16* QKV, const float* FG, const float* __restrict__ wgu, const float* __restrict__ bgate,
                                          unsigned char* QPG, unsigned char* OI, unsigned char* UU, float* DEC, unsigned char* lds, int& cur_h, f32x4 (&Sagg)[4], f32x4 (&Dagg)[4]) {
    int tid_ = threadIdx.x; asm volatile("" : "+v"(tid_));
    const int tid = tid_, lane = tid & 63, wid = __builtin_amdgcn_readfirstlane(tid >> 6), l15 = lane & 15, g = lane >> 4;
    const int n = unit % NCH, bh = unit / NCH, h = bh % GH, b = bh / GH;
    const size_t row0 = (size_t)b * S + (size_t)n * 64;
    float* WGU = (float*)(lds + L_WGU); float* BG = (float*)(lds + L_BG); float* WT = (float*)(lds + L_WT);
    bf16* QP = (bf16*)(lds + L_QP); bf16* KP = (bf16*)(lds + L_KP); bf16* KPT = (bf16*)(lds + L_KPT); bf16* VT = (bf16*)(lds + L_VT); bf16* PP = (bf16*)(lds + L_PP);
    if (cur_h != h) { __syncthreads(); for (int i = tid; i < 16 * 64; i += 512) WGU[i] = wgu[(i >> 6) * 256 + h * 64 + (i & 63)]; if (tid < 64) BG[tid] = bgate[h * 64 + tid]; cur_h = h; __syncthreads(); }
    const int t = tid >> 3, oc = tid & 7, d0 = oc * 8;
    float la[8];
    { const float* gp = FG + (row0 + t) * 32 + 8;
      f32x4 ga4[4];
#pragma unroll
      for (int i = 0; i < 4; ++i) ga4[i] = *(const f32x4*)(gp + 4 * i);
#pragma unroll
      for (int j = 0; j < 8; ++j) la[j] = BG[d0 + j];
#pragma unroll
      for (int r = 0; r < 16; ++r) { const float gv = ga4[r >> 2][r & 3]; const f32x4 w0 = *(const f32x4*)(WGU + r * 64 + d0), w1 = *(const f32x4*)(WGU + r * 64 + d0 + 4);
#pragma unroll
          for (int j = 0; j < 4; ++j) { la[j] += gv * w0[j]; la[4 + j] += gv * w1[j]; } }
#pragma unroll
      for (int j = 0; j < 8; ++j) la[j] = fast_logsig2(la[j]) * (1.f / 16.f); }
    const u32x4 qv = *(const u32x4*)(QKV + (row0 + t) * fx::QKVP + fx::P_GQ + h * 64 + d0);
    const u32x4 kv = *(const u32x4*)(QKV + (row0 + t) * fx::QKVP + fx::P_GK + h * 64 + d0);
    const u32x4 vv0 = *(const u32x4*)(QKV + (row0 + t) * fx::QKVP + fx::P_GV + h * 128 + oc * 16);
    const u32x4 vv1 = *(const u32x4*)(QKV + (row0 + t) * fx::QKVP + fx::P_GV + h * 128 + oc * 16 + 8);
#pragma unroll
    for (int off = 8; off < 64; off <<= 1) {
#pragma unroll
        for (int j = 0; j < 8; ++j) { const float o = __shfl_up(la[j], off); if (lane >= off) la[j] += o; } }
    if (lane >= 56) {
#pragma unroll
        for (int j = 0; j < 8; ++j) WT[wid * 64 + d0 + j] = la[j]; }
    __syncthreads();
    float bl[8];
#pragma unroll
    for (int j = 0; j < 8; ++j) bl[j] = 0.f;
#pragma unroll
    for (int w = 0; w < 8; ++w) {
        const f32x4 a0 = *(const f32x4*)(WT + w * 64 + d0), a1 = *(const f32x4*)(WT + w * 64 + d0 + 4);
#pragma unroll
        for (int j = 0; j < 4; ++j) { bl[j] += a0[j]; bl[4 + j] += a1[j]; if (w < wid) { la[j] += a0[j]; la[4 + j] += a1[j]; } } }
    {
        const unsigned qw[4] = {qv.x, qv.y, qv.z, qv.w}, kw[4] = {kv.x, kv.y, kv.z, kv.w};
        float qf[8], kf[8];
#pragma unroll
        for (int i = 0; i < 4; ++i) { qf[2 * i] = bflo(qw[i]); qf[2 * i + 1] = bfhi(qw[i]); kf[2 * i] = bflo(kw[i]); kf[2 * i + 1] = bfhi(kw[i]); }
        float qp[8], kp[8], kpp[8];
#pragma unroll
        for (int j = 0; j < 8; ++j) { const float bb = la[j], bbl = bl[j];
            qp[j] = qf[j] * (0.125f * __builtin_amdgcn_exp2f(bb)); kp[j] = kf[j] * __builtin_amdgcn_exp2f(-bb); kpp[j] = kf[j] * __builtin_amdgcn_exp2f(bbl - bb); }
        u32x4 qo, ko; qo.x = pkbf(qp[0], qp[1]); qo.y = pkbf(qp[2], qp[3]); qo.z = pkbf(qp[4], qp[5]); qo.w = pkbf(qp[6], qp[7]);
        ko.x = pkbf(kp[0], kp[1]); ko.y = pkbf(kp[2], kp[3]); ko.z = pkbf(kp[4], kp[5]); ko.w = pkbf(kp[6], kp[7]);
        *(u32x4*)(QP + t * LS + d0) = qo; *(u32x4*)(KP + t * LS + d0) = ko;
        *(u32x4*)(QPG + (size_t)unit * QPG_B + (size_t)(t * 64 + d0) * 2) = qo;
#pragma unroll
        for (int j = 0; j < 8; ++j) KPT[(d0 + j) * LS + t] = (bf16)(pkbf(kpp[j], 0.f) & 0xffffu);
        const unsigned vw[8] = {vv0.x, vv0.y, vv0.z, vv0.w, vv1.x, vv1.y, vv1.z, vv1.w};
#pragma unroll
        for (int i = 0; i < 8; ++i) { VT[(oc * 16 + 2 * i) * LS + t] = (bf16)(vw[i] & 0xffffu); VT[(oc * 16 + 2 * i + 1) * LS + t] = (bf16)(vw[i] >> 16); }
        if (t == 0) {
#pragma unroll
            for (int j = 0; j < 8; ++j) { const float dc = __builtin_amdgcn_exp2f(bl[j]); DEC[(size_t)unit * 64 + d0 + j] = dc; ((float*)(lds + L_DECS))[d0 + j] = dc; } }
    }
    __syncthreads();
    { const int ti = wid >> 1;
#pragma unroll
      for (int q2 = 0; q2 < 2; ++q2) { const int sj = 2 * (wid & 1) + q2;
          f32x4 acc = {0.f, 0.f, 0.f, 0.f};
          if (sj <= ti) {
#pragma unroll
              for (int ks = 0; ks < 2; ++ks) { const bf16x8 a = *(const bf16x8*)(QP + (16 * ti + l15) * LS + 32 * ks + 8 * g), bb = *(const bf16x8*)(KP + (16 * sj + l15) * LS + 32 * ks + 8 * g);
                  acc = __builtin_amdgcn_mfma_f32_16x16x32_bf16(a, bb, acc, 0, 0, 0); }
              if (sj == ti) {
#pragma unroll
                  for (int r = 0; r < 4; ++r) if (l15 > 4 * g + r) acc[r] = 0.f; }
          }
#pragma unroll
          for (int r = 0; r < 4; ++r) PP[(16 * ti + 4 * g + r) * LS + 16 * sj + l15] = (bf16)(pkbf(acc[r], 0.f) & 0xffffu);
      } }
    __syncthreads();
    { bf16x8 vb[2];
#pragma unroll
      for (int ks = 0; ks < 2; ++ks) vb[ks] = *(const bf16x8*)(VT + (16 * wid + l15) * LS + 32 * ks + 8 * g);
#pragma unroll
      for (int m = 0; m < 4; ++m) { f32x4 acc = {0.f, 0.f, 0.f, 0.f};
#pragma unroll
          for (int ks = 0; ks < 2; ++ks) { const bf16x8 a = *(const bf16x8*)(PP + (16 * m + l15) * LS + 32 * ks + 8 * g); acc = __builtin_amdgcn_mfma_f32_16x16x32_bf16(a, vb[ks], acc, 0, 0, 0); }
          *(f32x4*)(OI + (size_t)unit * OI_B + (size_t)((wid * 4 + m) * 64 + lane) * 16) = acc; }
#pragma unroll
      for (int db = 0; db < 4; ++db) { f32x4 acc = {0.f, 0.f, 0.f, 0.f};
#pragma unroll
          for (int ks = 0; ks < 2; ++ks) { const bf16x8 a = *(const bf16x8*)(KPT + (16 * db + l15) * LS + 32 * ks + 8 * g); acc = __builtin_amdgcn_mfma_f32_16x16x32_bf16(a, vb[ks], acc, 0, 0, 0); }
          *(f32x4*)(UU + (size_t)unit * UU_B + (size_t)((wid * 4 + db) * 64 + lane) * 16) = acc;
          const f32x4 dcv = *(const f32x4*)((const float*)(lds + L_DECS) + 16 * db + 4 * g);
          Sagg[db] = dcv * Sagg[db] + acc; Dagg[db] = Dagg[db] * dcv; }
    }
}


__device__ __forceinline__ void prep_block(int blk, const bf16* QKV, const float* FG, const float* __restrict__ wgu, const float* __restrict__ bgate,
                                           unsigned char* QPG, unsigned char* OI, unsigned char* UU, float* DEC, unsigned char* AGG, float* DAGG, unsigned char* lds, int& cur_h) {
    f32x4 Sagg[4], Dagg[4];
#pragma unroll
    for (int db = 0; db < 4; ++db) { Sagg[db] = (f32x4){0.f, 0.f, 0.f, 0.f}; Dagg[db] = (f32x4){1.f, 1.f, 1.f, 1.f}; }
    for (int i = 0; i < 8; ++i) prep_unit(blk * 8 + i, QKV, FG, wgu, bgate, QPG, OI, UU, DEC, lds, cur_h, Sagg, Dagg);
    int tid_ = threadIdx.x; asm volatile("" : "+v"(tid_));
    const int lane = tid_ & 63, wid = __builtin_amdgcn_readfirstlane(tid_ >> 6), l15 = lane & 15, g = lane >> 4;
#pragma unroll
    for (int db = 0; db < 4; ++db) { *(f32x4*)(AGG + (size_t)blk * UU_B + (size_t)((wid * 4 + db) * 64 + lane) * 16) = Sagg[db];
        if (wid == 0 && l15 == 0) *(f32x4*)(DAGG + (size_t)blk * 64 + 16 * db + 4 * g) = Dagg[db]; }
}
constexpr int GS = 136;
constexpr int PO_GR = 0, PO_YT = 64 * GS * 2, PO_PART = 2 * 64 * GS * 2, PO_ST = PO_PART + 8 * 64 * 4, PO_END = PO_ST + 128 * LS * 2;
__device__ __forceinline__ void post_block(int u0, int NB, const bf16* QKV, const unsigned char* QPG, const unsigned char* OI, const unsigned char* UU, const float* DEC, const unsigned char* AGG, const float* DAGG, const float* __restrict__ gnorm, bf16* Y, unsigned char* lds) {
    int tid_ = threadIdx.x; asm volatile("" : "+v"(tid_));
    const int tid = tid_, lane = tid & 63, wid = __builtin_amdgcn_readfirstlane(tid >> 6), l15 = lane & 15, g = lane >> 4;
    const int n0 = u0 % NCH, bh = u0 / NCH, h = bh % GH, b = bh / GH;
    bf16* GRs = (bf16*)(lds + PO_GR); bf16* YT = (bf16*)(lds + PO_YT); float* PART = (float*)(lds + PO_PART); bf16* ST = (bf16*)(lds + PO_ST);
    const int t = tid >> 3, oc = tid & 7, e = 16 * wid + l15;
    const float gn = gnorm[e];
    f32x4 Sa[4];
#pragma unroll
    for (int db = 0; db < 4; ++db) Sa[db] = (f32x4){0.f, 0.f, 0.f, 0.f};
    { const int seg0 = bh * (NCH / 8), nseg = n0 / 8;
      for (int i = 0; i < nseg; ++i) {
          f32x4 Ua[4], Da[4];
#pragma unroll
          for (int db = 0; db < 4; ++db) { Ua[db] = *(const f32x4*)(AGG + (size_t)(seg0 + i) * UU_B + (size_t)((wid * 4 + db) * 64 + lane) * 16); Da[db] = *(const f32x4*)(DAGG + (size_t)(seg0 + i) * 64 + 16 * db + 4 * g); }
#pragma unroll
          for (int db = 0; db < 4; ++db) Sa[db] = Da[db] * Sa[db] + Ua[db]; } }
    for (int i = 0; i < NB; ++i) {
        const int unit = u0 + i; const size_t row0 = (size_t)b * S + (size_t)(n0 + i) * 64;
        const u32x4 g0 = *(const u32x4*)(QKV + (row0 + t) * fx::QKVP + fx::P_GR + h * 128 + oc * 16), g1 = *(const u32x4*)(QKV + (row0 + t) * fx::QKVP + fx::P_GR + h * 128 + oc * 16 + 8);
        f32x4 o[4], Uf[4], dv[4]; bf16x8 qa[4][2], sb[2];
#pragma unroll
        for (int m = 0; m < 4; ++m) { o[m] = *(const f32x4*)(OI + (size_t)unit * OI_B + (size_t)((wid * 4 + m) * 64 + lane) * 16);
            Uf[m] = *(const f32x4*)(UU + (size_t)unit * UU_B + (size_t)((wid * 4 + m) * 64 + lane) * 16); dv[m] = *(const f32x4*)(DEC + (size_t)unit * 64 + 16 * m + 4 * g);
#pragma unroll
            for (int ks = 0; ks < 2; ++ks) qa[m][ks] = *(const bf16x8*)(QPG + (size_t)unit * QPG_B + (size_t)((16 * m + l15) * 64 + 32 * ks + 8 * g) * 2); }
#pragma unroll
        for (int db = 0; db < 4; ++db) *(u32x2*)(ST + e * LS + 16 * db + 4 * g) = (u32x2){pkbf(Sa[db][0], Sa[db][1]), pkbf(Sa[db][2], Sa[db][3])};
#pragma unroll
        for (int ks = 0; ks < 2; ++ks) sb[ks] = *(const bf16x8*)(ST + e * LS + 32 * ks + 8 * g);
        *(u32x4*)(GRs + t * GS + oc * 16) = g0; *(u32x4*)(GRs + t * GS + oc * 16 + 8) = g1;
#pragma unroll
        for (int m = 0; m < 4; ++m)
#pragma unroll
            for (int ks = 0; ks < 2; ++ks) o[m] = __builtin_amdgcn_mfma_f32_16x16x32_bf16(qa[m][ks], sb[ks], o[m], 0, 0, 0);
#pragma unroll
        for (int m = 0; m < 4; ++m) { f32x4 q = o[m] * o[m];
#pragma unroll
            for (int off = 1; off < 16; off <<= 1) { q[0] += __shfl_xor(q[0], off); q[1] += __shfl_xor(q[1], off); q[2] += __shfl_xor(q[2], off); q[3] += __shfl_xor(q[3], off); }
            if (l15 == 0) *(f32x4*)(PART + wid * 64 + 16 * m + 4 * g) = q; }
#pragma unroll
        for (int db = 0; db < 4; ++db) Sa[db] = dv[db] * Sa[db] + Uf[db];
        __syncthreads();
#pragma unroll
        for (int m = 0; m < 4; ++m) { f32x4 tot = {0.f, 0.f, 0.f, 0.f};
#pragma unroll
            for (int w = 0; w < 8; ++w) tot += *(const f32x4*)(PART + w * 64 + 16 * m + 4 * g);
#pragma unroll
            for (int r = 0; r < 4; ++r) { const int tt = 16 * m + 4 * g + r; const float rs = rsqrtf(tot[r] * (1.f / GV) + LN_EPS); const float gr = bf2f(GRs[tt * GS + e]);
                const float v = o[m][r] * rs * gn * (gr * __builtin_amdgcn_rcpf(1.f + __builtin_amdgcn_exp2f(-1.4426950408889634f * gr)));
                YT[tt * GS + e] = (bf16)(pkbf(v, 0.f) & 0xffffu); } }
        __syncthreads();
        { const u32x4 y0 = *(const u32x4*)(YT + t * GS + oc * 16), y1 = *(const u32x4*)(YT + t * GS + oc * 16 + 8);
          *(u32x4*)(Y + (row0 + t) * D + 512 + h * GV + oc * 16) = y0; *(u32x4*)(Y + (row0 + t) * D + 512 + h * GV + oc * 16 + 8) = y1; }
        __syncthreads();
    }
}
}
namespace mo {
using namespace nv;
typedef unsigned short bf16;
typedef float f32x4 __attribute__((ext_vector_type(4)));
typedef unsigned u32x4 __attribute__((ext_vector_type(4)));
constexpr int CAP = 8192;
constexpr int NEX = NE + 1;
constexpr int YSH = T * TOPK;
constexpr int L_TB = 132096, L_YB = L_TB + 1040, L_CN = L_YB + 1040, L_UT = 138240, L_RG = 141312;
typedef LAS int* lint;


constexpr int I_EG = NEX * 256, I_ED = NEX * 128, I_EXP = I_EG + I_ED;
struct ExpW { const float* eg; const float* eu; const float* ed; const float* sg; const float* su; const float* sd; bf16* WegT; bf16* WedT; };
__device__ __forceinline__ void cv_decode(int r, const ExpW& X, fx::CvItem& I) {
    if (r < I_EG) { const int e = r >> 8, kb = (r >> 4) & 15, nb = r & 15, c = nb >> 3, sub = nb & 7;
        I.W = (e < NE) ? ((sub < 4 ? X.eg : X.eu) + (size_t)e * D * ED) : (sub < 4 ? X.sg : X.su); I.WT = X.WegT + (size_t)e * 512 * D; I.N = ED; I.K = D; I.k0 = 64 * kb; I.n0 = 32 * nb; I.s0 = 128 * c + 32 * (sub & 3); }
    else { r -= I_EG; const int e = r >> 7, kb = (r >> 5) & 3, nb = r & 31; I.W = (e < NE) ? (X.ed + (size_t)e * ED * D) : X.sd; I.WT = X.WedT + (size_t)e * D * ED; I.N = D; I.K = ED; I.k0 = 64 * kb; I.n0 = 32 * nb; I.s0 = 32 * nb; }
}
__device__ __forceinline__ void expert_conv(const ExpW& X, LAS float* scr, int it0, int step, int lane) {
    int it = it0; fx::CvItem cur, nx; fx::f32x4 v[8], w[8];
    if (it < I_EXP) { cv_decode(it, X, cur); fx::cv_load(cur, v, lane); }
    while (it < I_EXP) { const int itn = it + step; if (itn < I_EXP) { cv_decode(itn, X, nx); fx::cv_load(nx, w, lane); }
        fx::cv_finish(cur, v, scr, lane); cur = nx;
#pragma unroll
        for (int i = 0; i < 8; ++i) v[i] = w[i];
        it = itn; }
}

__device__ __forceinline__ void moe_tables(const int* counts, lint tb, lint yb, lint cn, int lane) {
    int c[4], nt[4]; int st = 0, sy = 0, pt[4], py[4];
#pragma unroll
    for (int i = 0; i < 4; ++i) { c[i] = counts[lane * 4 + i]; c[i] = c[i] > CAP ? CAP : c[i]; nt[i] = (c[i] + 255) >> 8; pt[i] = st; py[i] = sy; st += nt[i]; sy += c[i]; }
    int it = st, iy = sy;
    for (int o = 1; o < 64; o <<= 1) { const int a = __shfl_up(it, o), b = __shfl_up(iy, o); if (lane >= o) { it += a; iy += b; } }
    const int bt = it - st, by = iy - sy;
#pragma unroll
    for (int i = 0; i < 4; ++i) { tb[lane * 4 + i] = bt + pt[i]; yb[lane * 4 + i] = by + py[i]; cn[lane * 4 + i] = c[i]; }
    if (lane == 63) { tb[256] = it; tb[257] = it + T / 256; yb[256] = YSH; cn[256] = T; }
}

__device__ __forceinline__ void route_token2(const float* LG, const float* __restrict__ rbias, int* lcnt, int* TK, float* TW, int t0, int lane) {
    const int l32 = lane & 31, hb = lane & 32, t = t0 + (lane >> 5);
    const float4 la = ((const float4*)(LG + (size_t)t * NE))[2 * l32], lb = ((const float4*)(LG + (size_t)t * NE))[2 * l32 + 1];
    const float4 ra = ((const float4*)rbias)[2 * l32], rb = ((const float4*)rbias)[2 * l32 + 1];
    const float lg[8] = {la.x, la.y, la.z, la.w, lb.x, lb.y, lb.z, lb.w}, rbv[8] = {ra.x, ra.y, ra.z, ra.w, rb.x, rb.y, rb.z, rb.w};
    float sc[8], bv[8];
#pragma unroll
    for (int i = 0; i < 8; ++i) { sc[i] = 1.f / (1.f + expf(-lg[i])); bv[i] = sc[i] + rbv[i]; }
    float m1 = fmaxf(bv[0], bv[1]), m2 = fminf(bv[0], bv[1]);
#pragma unroll
    for (int i = 2; i < 8; ++i) { const float n1 = fmaxf(m1, bv[i]); m2 = fmaxf(fminf(m1, bv[i]), m2); m1 = n1; }
#pragma unroll
    for (int o = 1; o < 4; o <<= 1) { const float p1 = __shfl_xor(m1, o), p2 = __shfl_xor(m2, o); const float n1 = fmaxf(m1, p1); m2 = fmaxf(fminf(m1, p1), fmaxf(m2, p2)); m1 = n1; }
    const float gs = m1 + m2;
    const int myg = l32 >> 2;
    int rank = 0;
#pragma unroll
    for (int g2 = 0; g2 < NG; ++g2) { const float og = __shfl(gs, hb + g2 * 4); if (og > gs || (og == gs && g2 < myg)) ++rank; }
    const bool sel = rank < 4;
    float mv[8];
#pragma unroll
    for (int i = 0; i < 8; ++i) mv[i] = sel ? bv[i] : -INFINITY;
    int mye = 0; float myw = 0.f; float wsum = 0.f;
#pragma unroll
    for (int k = 0; k < TOPK; ++k) {
        float bvv = mv[0]; int bi = 0;
#pragma unroll
        for (int i = 1; i < 8; ++i) if (mv[i] > bvv) { bvv = mv[i]; bi = i; }
        int gi = l32 * 8 + bi;
#pragma unroll
        for (int o = 16; o > 0; o >>= 1) { const float ov = __shfl_xor(bvv, o); const int oi = __shfl_xor(gi, o); if (ov > bvv || (ov == bvv && oi < gi)) { bvv = ov; gi = oi; } }
        const int ol = gi >> 3, oi = gi & 7;
        float s_own = sc[0];
#pragma unroll
        for (int i = 1; i < 8; ++i) s_own = (oi == i) ? sc[i] : s_own;
        const float sw = __shfl(s_own, hb + ol);
        if (l32 == ol) {
#pragma unroll
            for (int i = 0; i < 8; ++i) if (oi == i) mv[i] = -INFINITY; }
        if (l32 == k) { mye = gi; myw = sw; } wsum += sw;
    }
    if (l32 < TOPK) { const int lp = atomicAdd(&lcnt[mye], 1); TK[t * TOPK + l32] = mye | (lp << 9); TW[t * TOPK + l32] = myw * (2.5f / wsum); }
}
__device__ __forceinline__ void route_finish2(const int* lbase, int* list_tok, float* list_gate, int* TK, const float* TW, int t0, int lane) {
    const int l32 = lane & 31, t = t0 + (lane >> 5);
    if (l32 < TOPK) { const int tk = TK[t * TOPK + l32]; const int e = tk & 511, pos = lbase[e] + (tk >> 9);
        if (pos < CAP) { list_tok[e * CAP + pos] = t; list_gate[e * CAP + pos] = TW[t * TOPK + l32]; }
        TK[t * TOPK + l32] = e | (pos << 9); }
}

constexpr float YSC = 16.f;
__device__ __forceinline__ void combine_token(const bf16* H1, const unsigned char* Y, const int* TK, lint yb, const float* __restrict__ g, const float* __restrict__ b, float* out, int t, int lane) {
    typedef float f2 __attribute__((ext_vector_type(2)));
    float v[16], s[16];
    { const u32x4 a = *(const u32x4*)(H1 + (size_t)t * D + 16 * lane), c = *(const u32x4*)(H1 + (size_t)t * D + 16 * lane + 8);
      const unsigned w[8] = {a.x, a.y, a.z, a.w, c.x, c.y, c.z, c.w};
#pragma unroll
      for (int i = 0; i < 8; ++i) { v[2 * i] = ALPHA * __builtin_bit_cast(float, w[i] << 16); v[2 * i + 1] = ALPHA * __builtin_bit_cast(float, w[i] & 0xffff0000u); } }
#pragma unroll
    for (int i = 0; i < 16; ++i) s[i] = 0.f;
    int tk = (lane < TOPK) ? TK[t * TOPK + lane] : 0;
#pragma unroll
    for (int k = 0; k <= TOPK; ++k) {
        size_t yrow;
        if (k < TOPK) { const int x = __shfl(tk, k); yrow = (size_t)(yb[x & 511] + (x >> 9)); } else yrow = (size_t)YSH + t;
        const u32x4 a = *(const u32x4*)(Y + yrow * D + 16 * lane);
        const int w[4] = {(int)a.x, (int)a.y, (int)a.z, (int)a.w};
#pragma unroll
        for (int i = 0; i < 4; ++i) { const f2 lo = __builtin_amdgcn_cvt_pk_f32_fp8(w[i], false), hi = __builtin_amdgcn_cvt_pk_f32_fp8(w[i], true);
            s[4 * i] += lo[0]; s[4 * i + 1] += lo[1]; s[4 * i + 2] += hi[0]; s[4 * i + 3] += hi[1]; }
    }
    float sm = 0.f;
#pragma unroll
    for (int i = 0; i < 16; ++i) { v[i] += s[i] * (1.f / YSC); sm += v[i]; }
    const float mean = fx::wave_sum(sm) * (1.f / D); float q = 0.f;
#pragma unroll
    for (int i = 0; i < 16; ++i) { v[i] -= mean; q += v[i] * v[i]; }
    const float rstd = 1.f / sqrtf(fx::wave_sum(q) * (1.f / D) + LN_EPS);
#pragma unroll
    for (int i = 0; i < 4; ++i) { const f32x4 gg = *(const f32x4*)(g + 16 * lane + 4 * i), bb = *(const f32x4*)(b + 16 * lane + 4 * i);
        f32x4 o; o[0] = v[4 * i] * rstd * gg[0] + bb[0]; o[1] = v[4 * i + 1] * rstd * gg[1] + bb[1]; o[2] = v[4 * i + 2] * rstd * gg[2] + bb[2]; o[3] = v[4 * i + 3] * rstd * gg[3] + bb[3];
        *(f32x4*)(out + (size_t)t * D + 16 * lane + 4 * i) = o; }
}
}

namespace pg8 {
struct RouterSched {
    int rb; const bf16_t* Bt;
    __device__ __forceinline__ bool next(int i, Unit2& u) const { if (i > 0) return false; u.pm = rb; u.pn = 0; u.e = 0; u.cnt = 128; u.jt = 0; u.ui = 0; return true; }
    __device__ __forceinline__ int arow(const Unit2& u, int r) const { return u.pm * 128 + r; }
    __device__ __forceinline__ size_t aoff(const Unit2&) const { return 0; }
    __device__ __forceinline__ const char* bptr(const Unit2&) const { return (const char*)Bt; }
};
struct EpiLogits {
    static constexpr bool PERM = false, AFTER_DRAIN = false;
    float* LG;
    __device__ __forceinline__ void operator()(const f32x4 (&acc)[2][2][4][2], const Unit2& u, int wr, int wc, int fr, int fq) const {
        const int row0 = u.pm * 128 + wr * 64 + fr, col0 = wc * 32 + 4 * fq;
#pragma unroll
        for (int m = 0; m < 4; ++m) { float* rowp = LG + (size_t)(row0 + m * 16) * nv::NE + col0;
#pragma unroll
            for (int bj = 0; bj < 2; ++bj)
#pragma unroll
                for (int n = 0; n < 2; ++n) *(f32x4*)(rowp + bj * HALF + n * 16) = acc[0][bj][m][n]; }
    }
};
template <int PH> struct MoeSched {
    int G, vcu, nrt; mo::lint tb; mo::lint cn; const int* list_tok; const bf16_t* W; mo::lint ut; mo::lint rg;
    static constexpr int NC = PH == 0 ? 2 : 4;
    static constexpr int MAXU = 64;
    __device__ __forceinline__ void build(int lane) const {
        const int L = lane * G + vcu;
        if (lane < MAXU && L < nrt * NC) {
            const int rt = L / NC, c = L % NC;
            int lo = 0, hi = 256;
            while (lo < hi) { const int mid = (lo + hi + 1) >> 1; if (tb[mid] <= rt) lo = mid; else hi = mid - 1; }
            const int e = lo, jt = rt - tb[e], rem = cn[e] - 256 * jt;
            ut[4 * lane] = rt; ut[4 * lane + 1] = c; ut[4 * lane + 2] = e | (jt << 9); ut[4 * lane + 3] = rem < 256 ? rem : 256;
        }
    }
    __device__ __forceinline__ bool next(int i, Unit2& u) const {
        const int L = i * G + vcu; if (i >= MAXU || L >= nrt * NC) return false;
        const int x = ut[4 * i + 2];
        u.pm = __builtin_amdgcn_readfirstlane(ut[4 * i]); u.pn = __builtin_amdgcn_readfirstlane(ut[4 * i + 1]); u.e = __builtin_amdgcn_readfirstlane(x & 511); u.jt = __builtin_amdgcn_readfirstlane(x >> 9);
        u.cnt = __builtin_amdgcn_readfirstlane(ut[4 * i + 3]); u.ui = i; return true;
    }
    __device__ __forceinline__ void fill_rows(const float* list_gate, int tid) const {
        for (int i = 0; i < MAXU; ++i) { const int L = i * G + vcu; if (L >= nrt * NC) break;
            const int x = ut[4 * i + 2], e = x & 511, jt = x >> 9, cnt = ut[4 * i + 3];
            if (tid < 256) { const int r = tid; unsigned v;
                if (e == 256) v = (unsigned)(jt * BM + r) | (0x4180u << 16);
                else if (r < cnt) { const float gsc = mo::YSC * list_gate[e * mo::CAP + jt * BM + r]; v = (unsigned)list_tok[e * mo::CAP + jt * BM + r] | (fx::f2bf(gsc) << 16); }
                else v = 0u;
                rg[i * 256 + r] = (int)v; } }
    }
    __device__ __forceinline__ int arow(const Unit2& u, int r) const {
        if (PH == 1) return u.pm * BM + r;
        return rg[u.ui * 256 + r] & 0x7fff;
    }
    __device__ __forceinline__ size_t aoff(const Unit2& u) const { return PH == 1 ? (size_t)u.pm * (131072 - 32768) : 0; }
    __device__ __forceinline__ const char* bptr(const Unit2& u) const {
        return PH == 0 ? (const char*)(W + ((size_t)u.e * 512 + 256 * u.pn) * 1024) : (const char*)(W + ((size_t)u.e * 1024 + 256 * u.pn) * 256);
    }
};
struct EpiSwiGLU {
    static constexpr bool PERM = true, AFTER_DRAIN = false;
    bf16_t* H; mo::lint rg; int skip;
    __device__ __forceinline__ void operator()(const f32x4 (&acc)[2][2][4][2], const Unit2& u, int wr, int wc, int fr, int fq) const {
        if (skip) return;
        const int col0 = u.pn * 128 + wc * 32 + 8 * fq;
#pragma unroll
        for (int ai = 0; ai < 2; ++ai)
#pragma unroll
            for (int m = 0; m < 4; ++m) { const int r = ai * HALF + wr * 64 + m * 16 + fr;
                const float gt = __builtin_bit_cast(float, (unsigned)rg[u.ui * 256 + r] & 0xffff0000u);
                float hv[8];
#pragma unroll
                for (int n = 0; n < 2; ++n)
#pragma unroll
                    for (int i = 0; i < 4; ++i) { const float gg = acc[ai][0][m][n][i], uu = acc[ai][1][m][n][i]; hv[4 * n + i] = gt * uu * (gg * __builtin_amdgcn_rcpf(1.f + __builtin_amdgcn_exp2f(-1.4426950408889634f * gg))); }
                u32x4 w; w.x = cvt_pk_bf16(hv[0], hv[1]); w.y = cvt_pk_bf16(hv[2], hv[3]); w.z = cvt_pk_bf16(hv[4], hv[5]); w.w = cvt_pk_bf16(hv[6], hv[7]);
                *(u32x4*)(H + (size_t)u.pm * 65536 + (size_t)(col0 >> 6) * 16384 + r * 64 + (col0 & 63)) = w; }
    }
};
struct EpiDown {
    static constexpr bool PERM = true, PERM16 = true, AFTER_DRAIN = false;
    unsigned char* Y; mo::lint yb; int skip;
    __device__ __forceinline__ void operator()(const f32x4 (&acc)[2][2][4][2], const Unit2& u, int wr, int wc, int fr, int fq) const {
        if (skip) return;
        const int col0 = u.pn * BM + wc * 64 + 16 * fq; const int ybase = yb[u.e] + u.jt * BM;
#pragma unroll
        for (int ai = 0; ai < 2; ++ai)
#pragma unroll
            for (int m = 0; m < 4; ++m) { const int r = ai * HALF + wr * 64 + m * 16 + fr;
                if (r < u.cnt) { u32x4 w; unsigned ww[4];
#pragma unroll
                    for (int bj = 0; bj < 2; ++bj)
#pragma unroll
                        for (int n = 0; n < 2; ++n) { const f32x4 v = acc[ai][bj][m][n]; int x = __builtin_amdgcn_cvt_pk_fp8_f32(v[0], v[1], 0, false); x = __builtin_amdgcn_cvt_pk_fp8_f32(v[2], v[3], x, true); ww[2 * bj + n] = (unsigned)x; }
                    w.x = ww[0]; w.y = ww[1]; w.z = ww[2]; w.w = ww[3];
                    *(u32x4*)(Y + (size_t)(ybase + r) * nv::D + col0) = w; } }
    }
};
}
constexpr int NTHR = 512;
constexpr int LDS_BYTES = 163840;
constexpr int MISC_OFF = 131072 + 320;
constexpr size_t MiB = 1u << 20;
constexpr size_t CTL_ZERO_BYTES = 96 * 1024;
constexpr int CW_BAR = 4096;
constexpr int CW_MOE = 16384;
constexpr int CW_FOXQ = 20992;
constexpr int CW_NRM = 20480;
constexpr int NPHASE = 9;
constexpr size_t WS_H1 = 1, WS_WR = 65, WS_STATS = 66, WS_LF = 67, WS_FG = 68, WS_WO = 72, WS_WIN = 74, WS_TK = 81, WS_LTOK = 83, WS_LGATE = 91,
                 WS_WED = 100, WS_HID = 230, WS_GLA = 230, WS_WEG = 416, WS_XN = 673, WS_YBF = 673, WS_QKV = 737, WS_Z1 = 737, WS_LG = 865, WS_Y = 416, WS_END = 992;

struct Args { const float* in[21]; float* out; unsigned char* ws; int ph_lo, ph_hi, li, pad; };

__global__ void __launch_bounds__(NTHR, 2) mega_fwd(Args a) {
    using namespace nv;
    extern __shared__ __attribute__((aligned(16))) unsigned char lds[];
    const int G = gridDim.x, bx = blockIdx.x;
    const int vcu = (G % 8 == 0) ? (bx % 8) * (G / 8) + bx / 8 : bx;
    int tid, lane, wave, vw;
#define DERIVE() do { int t_ = threadIdx.x; asm volatile("" : "+v"(t_)); tid = t_; lane = tid & 63; wave = __builtin_amdgcn_readfirstlane(tid >> 6); vw = vcu * 8 + wave; } while (0)
    DERIVE();
    volatile LAS unsigned* MISC = (volatile LAS unsigned*)((LAS unsigned char*)lds + MISC_OFF);
    for (int u = tid; u < (LDS_BYTES - 131072) / 4; u += NTHR) ((LAS unsigned*)((LAS unsigned char*)lds + 131072))[u] = 0u;
    __syncthreads();
    unsigned char* ws = a.ws;
    unsigned* ctl = (unsigned*)ws;
    XcdBarrier bar = xcd_barrier_post(ctl + CW_BAR + a.li * XCD_BAR_WORDS, MISC + 8);
    const float* x = a.in[0];
    const float* ln_in_g = a.in[1]; const float* ln_in_b = a.in[2];
    const float* w_in = a.in[3]; const float* b_fgate = a.in[4];
    const float* w_gate_up = a.in[5]; const float* b_gate = a.in[6]; const float* g_gla = a.in[7];
    const float* w_out = a.in[8]; const float* ln1_g = a.in[9]; const float* ln1_b = a.in[10];
    const float* w_router = a.in[11]; const float* rbias = a.in[12];
    const float* w_eg = a.in[13]; const float* w_eu = a.in[14]; const float* w_ed = a.in[15];
    const float* w_sg = a.in[16]; const float* w_su = a.in[17]; const float* w_sd = a.in[18];
    const float* ln2_g = a.in[19]; const float* ln2_b = a.in[20];
    float* out = a.out;
    int* counts = (int*)(ctl + CW_MOE);
    fx::bf16* H1 = (fx::bf16*)(ws + WS_H1 * MiB);
    fx::bf16* WrT = (fx::bf16*)(ws + WS_WR * MiB);
    float* stats = (float*)(ws + WS_STATS * MiB);
    float* LF = (float*)(ws + WS_LF * MiB);
    float* FG = (float*)(ws + WS_FG * MiB);
    fx::bf16* WoT = (fx::bf16*)(ws + WS_WO * MiB);
    fx::bf16* WinT = (fx::bf16*)(ws + WS_WIN * MiB);
    int* TK = (int*)(ws + WS_TK * MiB);
    float* TW = (float*)(ws + (WS_TK + 1) * MiB);
    int* list_tok = (int*)(ws + WS_LTOK * MiB);
    float* list_gate = (float*)(ws + WS_LGATE * MiB);
    fx::bf16* WedT = (fx::bf16*)(ws + WS_WED * MiB);
    fx::bf16* HID = (fx::bf16*)(ws + WS_HID * MiB);
    unsigned char* QPG = ws + WS_GLA * MiB; unsigned char* OIb = ws + (WS_GLA + 16) * MiB; unsigned char* UUb = ws + (WS_GLA + 80) * MiB; float* DECb = (float*)(ws + (WS_GLA + 144) * MiB); unsigned char* AGGb = ws + (WS_GLA + 145) * MiB; float* DAGGb = (float*)(ws + (WS_GLA + 153) * MiB);
    fx::bf16* WegT = (fx::bf16*)(ws + WS_WEG * MiB);
    fx::bf16* XN = (fx::bf16*)(ws + WS_XN * MiB);
    fx::bf16* Ybf = (fx::bf16*)(ws + WS_YBF * MiB);
    fx::bf16* QKV = (fx::bf16*)(ws + WS_QKV * MiB);
    fx::bf16* MIX = (fx::bf16*)(ws + WS_Z1 * MiB);
    float* LG = (float*)(ws + WS_LG * MiB);
    unsigned char* YA = ws + WS_Y * MiB;
    mo::lint tb = (mo::lint)((LAS unsigned char*)lds + mo::L_TB), yb = (mo::lint)((LAS unsigned char*)lds + mo::L_YB), cn = (mo::lint)((LAS unsigned char*)lds + mo::L_CN), ut = (mo::lint)((LAS unsigned char*)lds + mo::L_UT), rg = (mo::lint)((LAS unsigned char*)lds + mo::L_RG);

    const int lo = a.ph_lo, hi = a.ph_hi;
#define IN(k) (lo <= (k) && (k) < hi)
#define SEAM(k) do { if (IN(k) && IN((k) + 1)) xcd_barrier(bar); DERIVE(); } while (0)
    const int GW = G * 8;
#ifndef STG7
#define STG7 0
#endif
#ifndef STG8
#define STG8 0
#endif
#define STAGGER(q) do { if ((q) > 0) { const unsigned long long t0_ = __builtin_amdgcn_s_memrealtime(); const unsigned long long d_ = (unsigned long long)((vcu & 3) * (q)); while (__builtin_amdgcn_s_memrealtime() - t0_ < d_) __builtin_amdgcn_s_sleep(8); } } while (0)

    if (IN(0)) {
        LAS float* scr = (LAS float*)((LAS unsigned char*)lds + wave * 16384);
        constexpr int I_IN = 16 * (fx::NIN / 32), I_OUT = 16 * 32, I_R = 16 * 8, I_SMALL = I_IN + I_OUT + I_R;
        for (int it = vw; it < I_SMALL; it += GW) {
            int r = it;
            if (r < I_IN) { fx::transpose_item(w_in, D, INW, WinT, scr, r / (fx::NIN / 32), r % (fx::NIN / 32), lane, [](int d) { return fx::inproj_src(d); }); continue; } r -= I_IN;
            if (r < I_OUT) { fx::transpose_item(w_out, D, D, WoT, scr, r / 32, r % 32, lane, [](int d) { return d; }); continue; } r -= I_OUT;
            fx::transpose_item(w_router, D, NE, WrT, scr, r / 8, r % 8, lane, [](int d) { return d; });
        }
        for (int r = vw; r < T; r += GW) fx::ln_row_bf16(x + (size_t)r * D, ln_in_g, ln_in_b, XN + (size_t)r * D, nullptr, stats + 2 * (size_t)r, lane);
    }
    SEAM(0);
    if (IN(1)) {
        const mo::ExpW XW{w_eg, w_eu, w_ed, w_sg, w_su, w_sd, WegT, WedT};
#ifndef MIXG
#define MIXG 2
#endif
        { const int slot = vcu % MIXG; pg8::StaticOrder S; S.init(T, fx::NIN, G, bx);
          const int nun = (S.nwg - bx + G - 1) / G, nb = (MIXG > 1) ? nun * slot / (MIXG - 1) : nun;
          pg8::Gemm g{XN, WinT, T, fx::NIN, D, D}; pg8::EpiInProj E{QKV, FG, LF, b_fgate, ctl + CW_NRM};
          if (nb > 0) { pg8::RangeOrder R{S, 0, nb}; pg8::gemm_phase<pg8::EpiInProj, pg8::RangeOrder, true, true>((LAS unsigned char*)lds, g, R, E); DERIVE(); }
          mo::expert_conv(XW, (LAS float*)((LAS unsigned char*)lds + wave * 16384), vw, GW, lane); __syncthreads(); DERIVE();
          if (nb < nun) { pg8::RangeOrder R{S, nb, nun - nb}; pg8::gemm_phase<pg8::EpiInProj, pg8::RangeOrder, true, true>((LAS unsigned char*)lds, g, R, E); } }
    }
    SEAM(1);
    if (IN(2)) {
        int cur_h = -1;
        for (int blk = vcu; blk < gl::NUNIT / 8; blk += G) gl::prep_block(blk, QKV, FG, w_gate_up, b_gate, QPG, OIb, UUb, DECb, AGGb, DAGGb, lds, cur_h);
    }
    SEAM(2);
    if (IN(3)) {
        for (int blk = vcu; blk < gl::NUNIT / 8; blk += G) gl::post_block(blk * 8, 8, QKV, QPG, OIb, UUb, DECb, AGGb, DAGGb, g_gla, Ybf, lds);
        { const attn_body::AttnTensors AT{(const attn_body::bf16*)(QKV + fx::P_FQ), (const attn_body::bf16*)(QKV + fx::P_FK), (const attn_body::bf16*)(QKV + fx::P_FV), (attn_body::bf16*)Ybf, LF, ctl + CW_NRM};
          attn_body::attn_phase_dyn<8>((char*)lds, AT, ctl + CW_FOXQ, (volatile int*)(lds + 140288), (G % 8 == 0) ? vcu / (G / 8) : vcu % 8); }
    }
    SEAM(3);
    if (IN(4)) {
        pg8::DenseSched DS; DS.so.init(T, D, G, bx); DS.Bt = WoT; DS.ldb = D;
        pg8::EpiPlainBf16 E{MIX, D};
        pg8::gemm_phase2<pg8::EpiPlainBf16, pg8::DenseSched>((LAS unsigned char*)lds, Ybf, D, D, D, DS, E);
    }
    SEAM(4);
    if (IN(5)) {
        int* lcnt = (int*)(lds + 136192); int* lbase = lcnt + 256;
        for (int rb = vcu; rb < T / 128; rb += G) {
            if (tid < 256) lcnt[tid] = 0;
            for (int r = wave * 16; r < wave * 16 + 16; r += 4) { const size_t row = (size_t)rb * 128 + r;
                fx::ln1_rows_bf16<4>(x + row * D, stats + 2 * row, ln_in_g, ln_in_b, MIX + row * D, ln1_g, ln1_b, H1 + row * D, ALPHA, lane); }
            asm volatile("s_waitcnt vmcnt(0)" ::: "memory"); __syncthreads();
            { pg8::RouterSched RS{rb, WrT}; pg8::EpiLogits E{LG};
              pg8::gemm_phase2<pg8::EpiLogits, pg8::RouterSched>((LAS unsigned char*)lds, H1, D, D, D, RS, E); }
            DERIVE();
            for (int t = rb * 128 + wave * 2; t < rb * 128 + 128; t += 16) mo::route_token2(LG, rbias, lcnt, TK, TW, t, lane);
            __syncthreads();
            if (tid < 256) { const int c = lcnt[tid]; lbase[tid] = c ? atomicAdd(&counts[tid], c) : 0; }
            __syncthreads();
            for (int t = rb * 128 + wave * 2; t < rb * 128 + 128; t += 16) mo::route_finish2(lbase, list_tok, list_gate, TK, TW, t, lane);
            __syncthreads();
        }
    }
    SEAM(5);
    if (IN(6)) {
        if (wave == 0) mo::moe_tables(counts, tb, yb, cn, lane);
        __syncthreads();
        STAGGER(STG7);
        pg8::MoeSched<0> MS{G, vcu, tb[257], tb, cn, list_tok, WegT, ut, rg}; if (wave == 0) MS.build(lane); __syncthreads(); MS.fill_rows(list_gate, tid); __syncthreads(); pg8::EpiSwiGLU E{HID, rg, a.pad};
        pg8::gemm_phase2<pg8::EpiSwiGLU, pg8::MoeSched<0>>((LAS unsigned char*)lds, H1, D, D, D, MS, E);
    }
    SEAM(6);
    if (IN(7)) {
        if (wave == 0) mo::moe_tables(counts, tb, yb, cn, lane);
        __syncthreads();
        STAGGER(STG8);
        pg8::MoeSched<1> MS{G, vcu, tb[257], tb, cn, list_tok, WedT, ut, rg}; if (wave == 0) MS.build(lane); __syncthreads(); pg8::EpiDown E{YA, yb, a.pad};
        pg8::gemm_phase2<pg8::EpiDown, pg8::MoeSched<1>>((LAS unsigned char*)lds, HID, 64, ED, ED, MS, E, 32768);
    }
    SEAM(7);
    if (IN(8)) {
        if (wave == 0) mo::moe_tables(counts, tb, yb, cn, lane);
        __syncthreads();
        for (int t = vw; t < T; t += GW) mo::combine_token(H1, YA, TK, yb, ln2_g, ln2_b, out, t, lane);
    }
#undef IN
#undef SEAM
}

extern "C" void kernel_launch(void* const* d_in, const int* in_sizes, int n_in, void* d_out, int out_size, void* d_ws, size_t ws_size, hipStream_t stream) {
    static int grid = 0;
    if (grid == 0) {
        if (n_in != 21 || out_size != nv::T * nv::D || ws_size < WS_END * MiB) { fprintf(stderr, "kernel_launch: unexpected shapes n_in=%d out=%d ws=%zu\n", n_in, out_size, ws_size); grid = -1; return; }
        int dev = 0, cus = 0;
        if (hipGetDevice(&dev) != hipSuccess || hipDeviceGetAttribute(&cus, hipDeviceAttributeMultiprocessorCount, dev) != hipSuccess) { grid = -1; return; }
        if (hipFuncSetAttribute((const void*)mega_fwd, hipFuncAttributeMaxDynamicSharedMemorySize, LDS_BYTES) != hipSuccess) { fprintf(stderr, "kernel_launch: hipFuncSetAttribute failed\n"); grid = -1; return; }
        grid = cus;
    }
    if (grid < 0) return;
    if (hipMemsetAsync(d_ws, 0, CTL_ZERO_BYTES, stream) != hipSuccess) return;
    Args a{};
    for (int i = 0; i < 21; ++i) a.in[i] = (const float*)d_in[i];
    a.out = (float*)d_out; a.ws = (unsigned char*)d_ws; a.ph_lo = 0; a.ph_hi = NPHASE; a.li = 0;
#ifdef REPEAT_PH
    a.ph_hi = REPEAT_PH + 1; hipLaunchKernelGGL(mega_fwd, dim3(grid), dim3(NTHR), LDS_BYTES, stream, a);
    if (REPEAT_PH == 3) hipMemsetAsync((char*)d_ws + CW_FOXQ * 4, 0, 256, stream);
    if (REPEAT_PH == 5) hipMemsetAsync((char*)d_ws + CW_MOE * 4, 0, 4096, stream);
    a.ph_lo = REPEAT_PH; a.ph_hi = NPHASE; a.li = 1;
#ifdef REPEAT_NOEPI
    a.ph_hi = REPEAT_PH + 1; a.pad = 1; hipLaunchKernelGGL(mega_fwd, dim3(grid), dim3(NTHR), LDS_BYTES, stream, a); a.pad = 0; a.ph_lo = REPEAT_PH + 1; a.ph_hi = NPHASE; a.li = 2;
#endif
#endif
    hipLaunchKernelGGL(mega_fwd, dim3(grid), dim3(NTHR), LDS_BYTES, stream, a);
}
```

```cpp
#include <hip/hip_runtime.h>
#include <cstdio>
#include <cstdint>
#include <cmath>

#define LAS __attribute__((address_space(3)))
#define GAS __attribute__((address_space(1)))

#define XB_TMO      128
#define XB_XCNT(j)  (256  + 64 * (j))
#define XB_XSUB(j)  (1280 + 64 * (j))
#define XB_XGEN(j)  (2304 + 64 * (j))
#define XB_TOP      3328
#define XB_TOPGEN   3392
#define XCD_BAR_WORDS 3456
#define XB_SPIN_CAP (1u << 27)
__device__ __forceinline__ unsigned xb_ld(unsigned* p)              { return __hip_atomic_load(p, __ATOMIC_RELAXED, __HIP_MEMORY_SCOPE_AGENT); }
__device__ __forceinline__ unsigned xb_add(unsigned* p, unsigned v) { return __hip_atomic_fetch_add(p, v, __ATOMIC_RELAXED, __HIP_MEMORY_SCOPE_AGENT); }
__device__ __forceinline__ unsigned xb_xcc_id() { return (unsigned)__builtin_amdgcn_s_getreg((3 << 11) | 20) & 0xFu; }
#define XB_SPIN(cond, bar) do { unsigned _sp = 0; while (cond) { __builtin_amdgcn_s_sleep(1); \
    if ((++_sp & 255u) == 0u) { if (xb_ld(&(bar)[XB_TMO])) break; if (_sp > XB_SPIN_CAP) { atomicAdd(&(bar)[XB_TMO], 1u); break; } } } } while (0)
struct XcdBarrier { unsigned* bar; unsigned x; volatile LAS unsigned* st; };
__device__ __forceinline__ XcdBarrier xcd_barrier_post(unsigned* bar, volatile LAS unsigned* st) {
    XcdBarrier b; b.bar = bar; b.x = xb_xcc_id(); b.st = st;
    if (threadIdx.x == 0) (void)xb_add(&bar[XB_XCNT(b.x)], 1u);
    return b;
}
__device__ __forceinline__ void xcd_barrier_complete(unsigned* bar, unsigned x, unsigned& nloc, unsigned& nx) {
    const unsigned G = gridDim.x * gridDim.y * gridDim.z;
    unsigned sum, cnt, mine, sp = 0u;
    for (;;) {
        sum = 0u; cnt = 0u; mine = 0u;
#pragma unroll
        for (unsigned j = 0; j < 16; ++j) { const unsigned c = xb_ld(&bar[XB_XCNT(j)]); sum += c; cnt += (c > 0u) ? 1u : 0u; mine = (j == x) ? c : mine; }
        if (sum == G) break;
        __builtin_amdgcn_s_sleep(1);
        if ((++sp & 255u) == 0u) { if (xb_ld(&bar[XB_TMO])) break; if (sp > XB_SPIN_CAP) { atomicAdd(&bar[XB_TMO], 1u); break; } }
    }
    nloc = mine > 0u ? mine : 1u; nx = cnt > 0u ? cnt : 1u;
}
__device__ __forceinline__ void xcd_barrier(const XcdBarrier& b) {
    asm volatile("s_waitcnt vmcnt(0)" ::: "memory");
    __syncthreads();
    if (threadIdx.x == 0) {
        unsigned* bar = b.bar;
        __builtin_amdgcn_s_waitcnt(0);
        unsigned nloc = b.st[0], nx = b.st[1];
        if (nloc == 0u) { xcd_barrier_complete(bar, b.x, nloc, nx); b.st[0] = nloc; b.st[1] = nx; }
        const unsigned old = xb_add(&bar[XB_XSUB(b.x)], 1u);
        const unsigned gen = old / nloc;
        if (old + 1u == (gen + 1u) * nloc) {
            __builtin_amdgcn_fence(__ATOMIC_RELEASE, "agent");
            asm volatile("s_waitcnt vmcnt(0)" ::: "memory");
            const unsigned og = xb_add(&bar[XB_TOP], 1u);
            const unsigned tg = og / nx;
            if (og + 1u == (tg + 1u) * nx) xb_add(&bar[XB_TOPGEN], 1u);
            else XB_SPIN(xb_ld(&bar[XB_TOPGEN]) == tg, bar);
            __builtin_amdgcn_fence(__ATOMIC_ACQUIRE, "agent");
            xb_add(&bar[XB_XGEN(b.x)], 1u);
            asm volatile("s_waitcnt vmcnt(0)" ::: "memory");
        } else {
            XB_SPIN(xb_ld(&bar[XB_XGEN(b.x)]) == gen, bar);
            __builtin_amdgcn_fence(__ATOMIC_ACQUIRE, "agent");
            asm volatile("s_waitcnt vmcnt(0)" ::: "memory");
        }
    }
    __syncthreads();
}
namespace pg8 {
#define PG8_LAS __attribute__((address_space(3)))
typedef unsigned short bf16_t;
typedef short bf16x8 __attribute__((ext_vector_type(8)));
typedef float f32x4 __attribute__((ext_vector_type(4)));
typedef unsigned u32x4 __attribute__((ext_vector_type(4)));
constexpr int BM = 256, BK = 64, HALF = 128, HTB = HALF * BK * 2  , STAGE_BYTES = 8 * HTB, NXCD = 8, WGM = 8;

__host__ __device__ __forceinline__ int lds_byte(int r, int c) { const int st = (r >> 4) * 2 + (c >> 5), rr = r & 15, cc = c & 31, ob = rr * 64 + cc * 2; return st * 1024 + (ob ^ (((ob >> 9) & 1) << 5)); }
__host__ __device__ __forceinline__ void stage_rc(int b, int& R, int& C) { const int st = b / 1024, sb = b % 1024, swz = sb ^ (((sb >> 9) & 1) << 5); R = (st >> 1) * 16 + swz / 64; C = (st & 1) * 32 + (swz % 64) / 2; }
__host__ __device__ __forceinline__ int perm32(int rho) { const int n = rho >> 4, i = rho & 15; return 8 * (i >> 2) + 4 * n + (i & 3); }

struct Unit { int pm, pn; };
struct Gemm { const bf16_t* A; const bf16_t* Bt; int M, N, K, lda; };

struct StaticOrder {
    int nM, nN, nwg, G, c;
    __host__ __device__ void init(int M, int N, int G_, int c_) { nM = M / BM; nN = N / BM; nwg = nM * nN; G = G_; c = c_; }
    __host__ __device__ bool next(int i, Unit& u) const {
        const long L = (long)i * G + c; if (L >= nwg) return false;
        int wgid = (int)L; { const int q = nwg / NXCD, r = nwg % NXCD, xcd = wgid % NXCD, off = wgid / NXCD; wgid = (xcd < r ? xcd * (q + 1) : r * (q + 1) + (xcd - r) * q) + off; }
        const int nig = WGM * nN, gid = wgid / nig, fm = gid * WGM, gsz = (nM - fm) < WGM ? (nM - fm) : WGM;
        u.pm = fm + ((wgid % nig) % gsz); u.pn = (wgid % nig) / gsz; return true;
    }
    __device__ __forceinline__ void a_ready(const Unit&) const {}
    __device__ __forceinline__ void done(const Unit&) const {}
};

struct RangeOrder {
    StaticOrder so; int i0, n;
    __host__ __device__ bool next(int i, Unit& u) const { return i < n && so.next(i0 + i, u); }
    __device__ __forceinline__ void a_ready(const Unit&) const {}
    __device__ __forceinline__ void done(const Unit&) const {}
};
__device__ __forceinline__ unsigned cvt_pk_bf16(float lo, float hi) { unsigned r; asm volatile("v_cvt_pk_bf16_f32 %0, %1, %2" : "=v"(r) : "v"(lo), "v"(hi)); return r; }
typedef float f32x2 __attribute__((ext_vector_type(2)));
__device__ __forceinline__ f32x2 gelu_pk(f32x2 v) {
    const f32x2 av = __builtin_elementwise_abs(v), d = av * 0.2316418882f + 1.0f;
    f32x2 t; t.x = __builtin_amdgcn_rcpf(d.x); t.y = __builtin_amdgcn_rcpf(d.y);
    f32x2 q = t * 0.5307027145f + (-0.7265760135f); q = q * t + 0.7107068705f; q = q * t + (-0.142248368f); q = q * t + 0.127414796f; q = q * t;
    const f32x2 s = (v * v) * (-0.72134752044f);
    f32x2 e; e.x = __builtin_amdgcn_exp2f(s.x); e.y = __builtin_amdgcn_exp2f(s.y);
    const f32x2 m = v * (q * e), r = v - m;
    f32x2 o; o.x = v.x < 0.f ? m.x : r.x; o.y = v.y < 0.f ? m.y : r.y; return o;
}

template <int ACT  > struct EpiBf16 {
    static constexpr bool PERM = true, AFTER_DRAIN = false; static_assert(ACT == 0 || ACT == 1, "EpiBf16: ACT is 0 (none) or 1 (gelu_pk)");
    bf16_t* O; int ldc; const float* bias; int split_cols; size_t split_stride; float scale0;
    __device__ __forceinline__ void operator()(const f32x4 (&acc)[2][2][4][2], const Unit& u, int wr, int wc, int fr, int fq) const {
        const int row0 = u.pm * BM + wr * 64 + fr; int colt = u.pn * BM; bf16_t* base = O;
        float sc = 1.f; if (split_cols) { const int t = colt / split_cols; base += (size_t)t * split_stride; colt -= t * split_cols; if (t == 0) sc = scale0; }
        const int col0 = colt + wc * 32 + 8 * fq, bcol0 = u.pn * BM + wc * 32 + 8 * fq;
        f32x4 bv[2][2];
#pragma unroll
        for (int bj = 0; bj < 2; ++bj)
#pragma unroll
            for (int n = 0; n < 2; ++n) bv[bj][n] = bias ? *(const f32x4*)(bias + bcol0 + bj * HALF + 4 * n) : (f32x4){0.f, 0.f, 0.f, 0.f};
#pragma unroll
        for (int ai = 0; ai < 2; ++ai)
#pragma unroll
            for (int m = 0; m < 4; ++m) { bf16_t* rowp = base + (size_t)(row0 + ai * HALF + m * 16) * ldc + col0;
#pragma unroll
                for (int bj = 0; bj < 2; ++bj) { f32x4 v0 = acc[ai][bj][m][0] + bv[bj][0], v1 = acc[ai][bj][m][1] + bv[bj][1];
                    if (ACT == 1) { f32x2 a = gelu_pk((f32x2){v0[0], v0[1]}), b = gelu_pk((f32x2){v0[2], v0[3]}), c = gelu_pk((f32x2){v1[0], v1[1]}), d = gelu_pk((f32x2){v1[2], v1[3]});
                        v0 = (f32x4){a.x, a.y, b.x, b.y}; v1 = (f32x4){c.x, c.y, d.x, d.y}; }
                    v0 = v0 * sc; v1 = v1 * sc; u32x4 w; w.x = cvt_pk_bf16(v0[0], v0[1]); w.y = cvt_pk_bf16(v0[2], v0[3]); w.z = cvt_pk_bf16(v1[0], v1[1]); w.w = cvt_pk_bf16(v1[2], v1[3]);
                    *(u32x4*)(rowp + bj * HALF) = w; } }
    }
};

template <class Epi, class Sched, bool ALIGN_EPI = false, bool SP2 = false>
__device__ __forceinline__ void gemm_phase(PG8_LAS unsigned char* lds, const Gemm g, const Sched& S, const Epi& E) {
    const int tid = threadIdx.x, wid = __builtin_amdgcn_readfirstlane(tid >> 6), lane = tid & 63, wr = wid >> 2, wc = wid & 3, fr = lane & 15, fq = lane >> 4;
    const int K = g.K, nt = K / BK;
    unsigned voffA[2], voffB[2];
#pragma unroll
    for (int i = 0; i < 2; ++i) { int R, C; stage_rc(tid * 16 + i * 8192, R, C); const int Rb = Epi::PERM ? ((R & ~31) + perm32(R & 31)) : R;
        voffA[i] = (unsigned)(R * g.lda + C) * 2u; voffB[i] = (unsigned)(Rb * K + C) * 2u; }
    const size_t kstep = (size_t)(BK * 2);
    const size_t hstepA = (size_t)HALF * g.lda * 2, hstepB = (size_t)HALF * K * 2;
    const size_t tstepA = 2 * hstepA, tstepB = 2 * hstepB;
    const unsigned ldsw = (unsigned)wid * 1024u;
    const int aoff = lds_byte(wr * 64 + fr, fq * 8), boff = lds_byte(wc * 32 + fr, fq * 8);
#define PG8_SA(b, h) (((b) * 2 + (h)) * HTB)
#define PG8_SB(b, h) ((4 + (b) * 2 + (h)) * HTB)
#define PG8_STAGE(bufoff, gbase, voff) do { _Pragma("unroll") for (int _i = 0; _i < 2; ++_i) \
        __builtin_amdgcn_global_load_lds((const unsigned*)((const char*)(gbase) + (voff)[_i]), (PG8_LAS unsigned*)(lds + (bufoff) + ldsw + _i * 8192), 16, 0, 0); } while (0)
#define PG8_LDA(dst, b, h) do { _Pragma("unroll") for (int m = 0; m < 4; ++m) _Pragma("unroll") for (int k = 0; k < 2; ++k) dst[m][k] = *(const PG8_LAS bf16x8*)(lds + PG8_SA(b, h) + aoff + m * 2048 + k * 1024); } while (0)
#define PG8_LDB(dst, b, h) do { _Pragma("unroll") for (int n = 0; n < 2; ++n) _Pragma("unroll") for (int k = 0; k < 2; ++k) dst[n][k] = *(const PG8_LAS bf16x8*)(lds + PG8_SB(b, h) + boff + n * 2048 + k * 1024); } while (0)
#define PG8_MMA(ai, bj, At, Bt) do { __builtin_amdgcn_s_setprio(1); _Pragma("unroll") for (int m = 0; m < 4; ++m) _Pragma("unroll") for (int n = 0; n < 2; ++n) _Pragma("unroll") for (int k = 0; k < 2; ++k) \
        acc[ai][bj][m][n] = __builtin_amdgcn_mfma_f32_16x16x32_bf16(Bt[n][k], At[m][k], acc[ai][bj][m][n], 0, 0, 0); __builtin_amdgcn_s_setprio(0); } while (0)
#define PG8_WAIT_V(n) asm volatile("s_waitcnt vmcnt(" #n ")" ::: "memory")
#define PG8_WAIT_L(n) asm volatile("s_waitcnt lgkmcnt(" #n ")" ::: "memory")
#define PG8_BAR __builtin_amdgcn_s_barrier()
#define PG8_SCHED __builtin_amdgcn_sched_barrier(0)
    Unit cur, nxt; int ui = 0;
    if (!S.next(0, cur)) return;
    f32x4 acc[2][2][4][2];
#pragma unroll
    for (int a = 0; a < 2; ++a)
#pragma unroll
        for (int b = 0; b < 2; ++b)
#pragma unroll
            for (int m = 0; m < 4; ++m)
#pragma unroll
                for (int n = 0; n < 2; ++n) acc[a][b][m][n] = (f32x4){0.f, 0.f, 0.f, 0.f};
    bf16x8 At[4][2], B0[2][2], B1[2][2];
    const char* cA = (const char*)g.A + (size_t)cur.pm * tstepA; const char* cB = (const char*)g.Bt + (size_t)cur.pn * tstepB;
    S.a_ready(cur);
    if constexpr (SP2) {
        PG8_STAGE(PG8_SB(0, 0), cB, voffB); PG8_STAGE(PG8_SB(0, 1), cB + hstepB, voffB); PG8_STAGE(PG8_SA(0, 0), cA, voffA); PG8_STAGE(PG8_SA(0, 1), cA + hstepA, voffA);
        if (wr == 1) PG8_BAR;
        PG8_WAIT_V(2); PG8_BAR;
        PG8_STAGE(PG8_SB(1, 0), cB + kstep, voffB); PG8_STAGE(PG8_SA(1, 0), cA + kstep, voffA); PG8_STAGE(PG8_SB(1, 1), cB + hstepB + kstep, voffB);
        PG8_WAIT_V(6); PG8_BAR;
    } else {
        PG8_STAGE(PG8_SB(0, 0), cB, voffB); PG8_STAGE(PG8_SA(0, 0), cA, voffA); PG8_STAGE(PG8_SB(0, 1), cB + hstepB, voffB); PG8_STAGE(PG8_SA(0, 1), cA + hstepA, voffA);
        if (wr == 1) PG8_BAR;
        PG8_WAIT_V(4); PG8_BAR;
        PG8_STAGE(PG8_SB(1, 0), cB + kstep, voffB); PG8_STAGE(PG8_SA(1, 0), cA + kstep, voffA); PG8_STAGE(PG8_SB(1, 1), cB + hstepB + kstep, voffB);
        PG8_WAIT_V(6); PG8_BAR;
    }
    for (;;) {
        const bool has_next = S.next(ui + 1, nxt);
        const char* nA = has_next ? (const char*)g.A + (size_t)nxt.pm * tstepA : cA; const char* nB = has_next ? (const char*)g.Bt + (size_t)nxt.pn * tstepB : cB;
        for (int t = 0; t < nt; t += 2) {
            const bool last = (t == nt - 2);
            const char* a1 = cA + (size_t)(t + 1) * kstep;
            const char* a2 = last ? nA : cA + (size_t)(t + 2) * kstep; const char* b2 = last ? nB : cB + (size_t)(t + 2) * kstep;
            const char* a3 = a2 + kstep; const char* b3 = b2 + kstep;
            if (last && has_next) S.a_ready(nxt);
            if constexpr (SP2) {
            PG8_LDB(B0, 0, 0); PG8_LDB(B1, 0, 1); PG8_SCHED; PG8_LDA(At, 0, 0); PG8_STAGE(PG8_SA(1, 1), a1 + hstepA, voffA);
            PG8_WAIT_V(8); PG8_WAIT_L(0); PG8_BAR; PG8_MMA(0, 0, At, B0); PG8_MMA(0, 1, At, B1); PG8_BAR; PG8_SCHED;
            PG8_LDA(At, 0, 1); PG8_STAGE(PG8_SB(0, 0), b2, voffB); PG8_STAGE(PG8_SB(0, 1), b2 + hstepB, voffB); PG8_STAGE(PG8_SA(0, 0), a2, voffA);
            PG8_WAIT_V(8); PG8_WAIT_L(0); PG8_BAR; PG8_MMA(1, 0, At, B0); PG8_MMA(1, 1, At, B1); PG8_BAR; PG8_SCHED;
            PG8_LDB(B0, 1, 0); PG8_LDB(B1, 1, 1); PG8_SCHED; PG8_LDA(At, 1, 0); PG8_STAGE(PG8_SA(0, 1), a2 + hstepA, voffA);
            PG8_WAIT_V(8); PG8_WAIT_L(0); PG8_BAR; PG8_MMA(0, 0, At, B0); PG8_MMA(0, 1, At, B1); PG8_BAR; PG8_SCHED;
            PG8_LDA(At, 1, 1); PG8_STAGE(PG8_SB(1, 0), b3, voffB); PG8_STAGE(PG8_SB(1, 1), b3 + hstepB, voffB); PG8_STAGE(PG8_SA(1, 0), a3, voffA);
            PG8_WAIT_V(8); PG8_WAIT_L(0); PG8_BAR; PG8_MMA(1, 0, At, B0); PG8_MMA(1, 1, At, B1); PG8_BAR; PG8_SCHED;
            } else {
            PG8_LDB(B0, 0, 0); PG8_SCHED; PG8_LDA(At, 0, 0); PG8_STAGE(PG8_SA(1, 1), a1 + hstepA, voffA);
            PG8_WAIT_L(8); PG8_BAR; PG8_WAIT_L(0); PG8_MMA(0, 0, At, B0); PG8_BAR; PG8_SCHED;
            PG8_LDB(B1, 0, 1); PG8_STAGE(PG8_SB(0, 0), b2, voffB);
            PG8_BAR; PG8_WAIT_L(0); PG8_MMA(0, 1, At, B1); PG8_BAR;
            PG8_LDA(At, 0, 1); PG8_STAGE(PG8_SA(0, 0), a2, voffA);
            PG8_BAR; PG8_WAIT_L(0); PG8_MMA(1, 0, At, B0); PG8_BAR; PG8_SCHED;
            PG8_STAGE(PG8_SB(0, 1), b2 + hstepB, voffB);
            PG8_WAIT_V(6); PG8_BAR; PG8_MMA(1, 1, At, B1); PG8_BAR;
            PG8_LDB(B0, 1, 0); PG8_SCHED; PG8_LDA(At, 1, 0); PG8_STAGE(PG8_SA(0, 1), a2 + hstepA, voffA);
            PG8_WAIT_L(8); PG8_BAR; PG8_WAIT_L(0); PG8_MMA(0, 0, At, B0); PG8_BAR; PG8_SCHED;
            PG8_LDB(B1, 1, 1); PG8_STAGE(PG8_SB(1, 0), b3, voffB);
            PG8_BAR; PG8_WAIT_L(0); PG8_MMA(0, 1, At, B1); PG8_BAR;
            PG8_LDA(At, 1, 1); PG8_STAGE(PG8_SA(1, 0), a3, voffA);
            PG8_BAR; PG8_WAIT_L(0); PG8_MMA(1, 0, At, B0); PG8_BAR; PG8_SCHED;
            PG8_STAGE(PG8_SB(1, 1), b3 + hstepB, voffB);
            PG8_WAIT_V(6); PG8_BAR; PG8_MMA(1, 1, At, B1); PG8_BAR;
            }
        }
        if constexpr (ALIGN_EPI) { if (wr == 0) PG8_BAR; }
        if constexpr (!Epi::AFTER_DRAIN) { E(acc, cur, wr, wc, fr, fq); S.done(cur); }
        if (!has_next) break;
#pragma unroll
        for (int a = 0; a < 2; ++a)
#pragma unroll
            for (int b = 0; b < 2; ++b)
#pragma unroll
                for (int m = 0; m < 4; ++m)
#pragma unroll
                    for (int n = 0; n < 2; ++n) acc[a][b][m][n] = (f32x4){0.f, 0.f, 0.f, 0.f};
        cur = nxt; cA = nA; cB = nB; ++ui;
        if constexpr (ALIGN_EPI) { if (wr == 1) PG8_BAR; }
    }
    PG8_WAIT_V(0);
    if constexpr (!ALIGN_EPI) { if (wr == 0) PG8_BAR; }
    PG8_BAR;
    if constexpr (Epi::AFTER_DRAIN) { E.fused(acc, cur, wr, wc, fr, fq, lds, wid, lane); S.done(cur); }
#undef PG8_SA
#undef PG8_SB
#undef PG8_STAGE
#undef PG8_LDA
#undef PG8_LDB
#undef PG8_MMA
#undef PG8_WAIT_V
#undef PG8_WAIT_L
#undef PG8_BAR
#undef PG8_SCHED
}
}
namespace pg8 {
struct Unit2 { int pm, pn, e, cnt, jt, ui; };
template <class E, class = void> struct has_perm16 { static constexpr bool value = false; };
template <class E> struct has_perm16<E, decltype((void)E::PERM16)> { static constexpr bool value = E::PERM16; };
template <class E> constexpr bool perm16() { return has_perm16<E>::value; }
template <class Epi, class Sched>
__device__ __forceinline__ void gemm_phase2(PG8_LAS unsigned char* lds, const bf16_t* Abase, int lda, int ldb, int K, const Sched& S, const Epi& E, int kstepA_ = BK * 2) {
    int tid_ = threadIdx.x; asm volatile("" : "+v"(tid_));
    const int tid = tid_, wid = __builtin_amdgcn_readfirstlane(tid >> 6), lane = tid & 63, wr = wid >> 2, wc = wid & 3, fr = lane & 15, fq = lane >> 4;
    int K_ = K; asm volatile("" : "+s"(K_));
    const int nt = K_ / BK;
    unsigned voffB0[2], voffB1[2];
#pragma unroll
    for (int i = 0; i < 2; ++i) { int R, C; stage_rc(tid * 16 + i * 8192, R, C);
        if constexpr (perm16<Epi>()) { const int cb = 64 * (R >> 5) + 16 * ((R >> 2) & 3) + 4 * ((R >> 4) & 1) + (R & 3); voffB0[i] = (unsigned)(cb * ldb + C) * 2u; voffB1[i] = (unsigned)((cb + 8) * ldb + C) * 2u; }
        else { const int Rb = Epi::PERM ? ((R & ~31) + perm32(R & 31)) : R; voffB0[i] = (unsigned)(Rb * ldb + C) * 2u; voffB1[i] = voffB0[i] + (unsigned)(HALF * ldb * 2); } }
    const unsigned lda2 = (unsigned)lda * 2u;
#define PG8_AOFFS(U, o0, o1) do { int t2_ = threadIdx.x; asm volatile("" : "+v"(t2_)); _Pragma("unroll") for (int i_ = 0; i_ < 2; ++i_) { int R_, C_; stage_rc(t2_ * 16 + i_ * 8192, R_, C_); \
        o0[i_] = (unsigned)S.arow(U, R_) * lda2 + (unsigned)C_ * 2u; o1[i_] = (unsigned)S.arow(U, HALF + R_) * lda2 + (unsigned)C_ * 2u; } } while (0)
    const size_t kstep = (size_t)(BK * 2), kstepA = (size_t)kstepA_;
    const unsigned ldsw = (unsigned)wid * 1024u;
    const int aoff = lds_byte(wr * 64 + fr, fq * 8), boff = lds_byte(wc * 32 + fr, fq * 8);
#define PG8_SA(b, h) (((b) * 2 + (h)) * HTB)
#define PG8_SB(b, h) ((4 + (b) * 2 + (h)) * HTB)
#define PG8_STAGE(bufoff, gbase, voff) do { _Pragma("unroll") for (int _i = 0; _i < 2; ++_i) \
        __builtin_amdgcn_global_load_lds((const unsigned*)((const char*)(gbase) + (voff)[_i]), (PG8_LAS unsigned*)(lds + (bufoff) + ldsw + _i * 8192), 16, 0, 0); } while (0)
#define PG8_LDA(dst, b, h) do { _Pragma("unroll") for (int m = 0; m < 4; ++m) _Pragma("unroll") for (int k = 0; k < 2; ++k) dst[m][k] = *(const PG8_LAS bf16x8*)(lds + PG8_SA(b, h) + aoff + m * 2048 + k * 1024); } while (0)
#define PG8_LDB(dst, b, h) do { _Pragma("unroll") for (int n = 0; n < 2; ++n) _Pragma("unroll") for (int k = 0; k < 2; ++k) dst[n][k] = *(const PG8_LAS bf16x8*)(lds + PG8_SB(b, h) + boff + n * 2048 + k * 1024); } while (0)
#define PG8_MMA(ai, bj, At, Bt) do { __builtin_amdgcn_s_setprio(1); _Pragma("unroll") for (int m = 0; m < 4; ++m) _Pragma("unroll") for (int n = 0; n < 2; ++n) _Pragma("unroll") for (int k = 0; k < 2; ++k) \
        acc[ai][bj][m][n] = __builtin_amdgcn_mfma_f32_16x16x32_bf16(Bt[n][k], At[m][k], acc[ai][bj][m][n], 0, 0, 0); __builtin_amdgcn_s_setprio(0); } while (0)
#define PG8_WAIT_V(n) asm volatile("s_waitcnt vmcnt(" #n ")" ::: "memory")
#define PG8_WAIT_L(n) asm volatile("s_waitcnt lgkmcnt(" #n ")" ::: "memory")
#define PG8_BAR __builtin_amdgcn_s_barrier()
#define PG8_SCHED __builtin_amdgcn_sched_barrier(0)
    Unit2 cur, nxt; int ui = 0;
    if (!S.next(0, cur)) return;
    f32x4 acc[2][2][4][2];
#pragma unroll
    for (int a = 0; a < 2; ++a)
#pragma unroll
        for (int b = 0; b < 2; ++b)
#pragma unroll
            for (int m = 0; m < 4; ++m)
#pragma unroll
                for (int n = 0; n < 2; ++n) acc[a][b][m][n] = (f32x4){0.f, 0.f, 0.f, 0.f};
    bf16x8 At[4][2], B0[2][2], B1[2][2];
    unsigned cv0[2], cv1[2], nv0[2], nv1[2];
    PG8_AOFFS(cur, cv0, cv1);
    const char* cA = (const char*)Abase + S.aoff(cur); const char* cB = S.bptr(cur);
    PG8_STAGE(PG8_SB(0, 0), cB, voffB0); PG8_STAGE(PG8_SB(0, 1), cB, voffB1); PG8_STAGE(PG8_SA(0, 0), cA, cv0); PG8_STAGE(PG8_SA(0, 1), cA, cv1);
    if (wr == 1) PG8_BAR;
    PG8_WAIT_V(2); PG8_BAR;
    PG8_STAGE(PG8_SB(1, 0), cB + kstep, voffB0); PG8_STAGE(PG8_SA(1, 0), cA + kstepA, cv0); PG8_STAGE(PG8_SB(1, 1), cB + kstep, voffB1);
    PG8_WAIT_V(6); PG8_BAR;
    for (;;) {
        const bool has_next = S.next(ui + 1, nxt);
        const char* nA = has_next ? (const char*)Abase + S.aoff(nxt) : cA; const char* nB = has_next ? S.bptr(nxt) : cB;
#pragma unroll
        for (int i = 0; i < 2; ++i) { nv0[i] = cv0[i]; nv1[i] = cv1[i]; }
        if (has_next) PG8_AOFFS(nxt, nv0, nv1);
        const bool act0 = cur.cnt > wr * 64, act1 = cur.cnt > HALF + wr * 64;
        for (int t = 0; t < nt; t += 2) {
            const bool last = (t == nt - 2);
            const char* a1 = cA + (size_t)(t + 1) * kstepA;
            const char* a2 = last ? nA : cA + (size_t)(t + 2) * kstepA; const char* b2 = last ? nB : cB + (size_t)(t + 2) * kstep;
            const char* a3 = a2 + kstepA; const char* b3 = b2 + kstep;
            unsigned s0[2] = {cv0[0], cv0[1]}, s1[2] = {cv1[0], cv1[1]};
            if (last) { asm volatile("" ::: "memory"); s0[0] = nv0[0]; s0[1] = nv0[1]; s1[0] = nv1[0]; s1[1] = nv1[1]; }
            PG8_LDB(B0, 0, 0); PG8_LDB(B1, 0, 1); PG8_SCHED; PG8_LDA(At, 0, 0); PG8_STAGE(PG8_SA(1, 1), a1, cv1);
            PG8_WAIT_V(8); PG8_WAIT_L(0); PG8_BAR; if (act0) { PG8_MMA(0, 0, At, B0); PG8_MMA(0, 1, At, B1); } PG8_BAR; PG8_SCHED;
            PG8_LDA(At, 0, 1); PG8_STAGE(PG8_SB(0, 0), b2, voffB0); PG8_STAGE(PG8_SB(0, 1), b2, voffB1); PG8_STAGE(PG8_SA(0, 0), a2, s0);
            PG8_WAIT_V(8); PG8_WAIT_L(0); PG8_BAR; if (act1) { PG8_MMA(1, 0, At, B0); PG8_MMA(1, 1, At, B1); } PG8_BAR; PG8_SCHED;
            PG8_LDB(B0, 1, 0); PG8_LDB(B1, 1, 1); PG8_SCHED; PG8_LDA(At, 1, 0); PG8_STAGE(PG8_SA(0, 1), a2, s1);
            PG8_WAIT_V(8); PG8_WAIT_L(0); PG8_BAR; if (act0) { PG8_MMA(0, 0, At, B0); PG8_MMA(0, 1, At, B1); } PG8_BAR; PG8_SCHED;
            PG8_LDA(At, 1, 1); PG8_STAGE(PG8_SB(1, 0), b3, voffB0); PG8_STAGE(PG8_SB(1, 1), b3, voffB1); PG8_STAGE(PG8_SA(1, 0), a3, s0);
            PG8_WAIT_V(8); PG8_WAIT_L(0); PG8_BAR; if (act1) { PG8_MMA(1, 0, At, B0); PG8_MMA(1, 1, At, B1); } PG8_BAR; PG8_SCHED;
        }
        if (wr == 0) PG8_BAR;
        { Unit2 eu = cur; asm volatile("" : "+s"(eu.pm), "+s"(eu.pn), "+s"(eu.e), "+s"(eu.cnt), "+s"(eu.jt), "+s"(eu.ui));
          E(acc, eu, wr, wc, fr, fq);
          }
        if (!has_next) break;
#pragma unroll
        for (int a = 0; a < 2; ++a)
#pragma unroll
            for (int b = 0; b < 2; ++b)
#pragma unroll
                for (int m = 0; m < 4; ++m)
#pragma unroll
                    for (int n = 0; n < 2; ++n) acc[a][b][m][n] = (f32x4){0.f, 0.f, 0.f, 0.f};
        cur = nxt; cA = nA; cB = nB; ++ui;
#pragma unroll
        for (int i = 0; i < 2; ++i) { cv0[i] = nv0[i]; cv1[i] = nv1[i]; }
        if (wr == 1) PG8_BAR;
    }
    PG8_WAIT_V(0);
    PG8_BAR;
#undef PG8_AOFFS
#undef PG8_SA
#undef PG8_SB
#undef PG8_STAGE
#undef PG8_LDA
#undef PG8_LDB
#undef PG8_MMA
#undef PG8_WAIT_V
#undef PG8_WAIT_L
#undef PG8_BAR
#undef PG8_SCHED
}

struct DenseSched {
    StaticOrder so; const bf16_t* Bt; int ldb;
    __device__ __forceinline__ bool next(int i, Unit2& u) const { Unit t; if (!so.next(i, t)) return false; u.pm = t.pm; u.pn = t.pn; u.e = 0; u.cnt = 256; u.jt = 0; u.ui = i; return true; }
    __device__ __forceinline__ int arow(const Unit2& u, int r) const { return u.pm * BM + r; }
    __device__ __forceinline__ size_t aoff(const Unit2&) const { return 0; }
    __device__ __forceinline__ const char* bptr(const Unit2& u) const { return (const char*)(Bt + (size_t)u.pn * BM * ldb); }
};
struct EpiPlainBf16 {
    static constexpr bool PERM = true, AFTER_DRAIN = false;
    bf16_t* O; int ldc;
    __device__ __forceinline__ void operator()(const f32x4 (&acc)[2][2][4][2], const Unit2& u, int wr, int wc, int fr, int fq) const {
        const int row0 = u.pm * BM + wr * 64 + fr, col0 = u.pn * BM + wc * 32 + 8 * fq;
#pragma unroll
        for (int ai = 0; ai < 2; ++ai)
#pragma unroll
            for (int m = 0; m < 4; ++m) { bf16_t* rowp = O + (size_t)(row0 + ai * HALF + m * 16) * ldc + col0;
#pragma unroll
                for (int bj = 0; bj < 2; ++bj) { const f32x4 v0 = acc[ai][bj][m][0], v1 = acc[ai][bj][m][1];
                    u32x4 w; w.x = cvt_pk_bf16(v0[0], v0[1]); w.y = cvt_pk_bf16(v0[2], v0[3]); w.z = cvt_pk_bf16(v1[0], v1[1]); w.w = cvt_pk_bf16(v1[2], v1[3]);
                    *(u32x4*)(rowp + bj * HALF) = w; } }
    }
};
}
namespace nv {
constexpr int D = 1024, B = 8, S = 4096, T = B * S;
constexpr int FH = 8, FD = 64, GH = 4, GK = 64, GV = 128, RANK = 16;
constexpr int INW = 3096;
constexpr int O_FQ = 0, O_FK = 512, O_FV = 1024, O_FF = 1536, O_GQ = 1544, O_GK = 1800, O_GV = 2056, O_GA = 2568, O_GR = 2584;
constexpr int NE = 256, NG = 8, TOPK = 8, ED = 256;
constexpr float LN_EPS = 1e-5f;
constexpr float ALPHA = 1.189207115002721f;
constexpr int PADR = 64;
constexpr int APAD = T * TOPK + NE * PADR;

__device__ __forceinline__ float logsigmoidf(float x) { return fminf(x, 0.f) - log1pf(expf(-fabsf(x))); }
__device__ __forceinline__ float siluf(float x) { return x / (1.f + expf(-x)); }

}
#include <hip/hip_bf16.h>
#include <cmath>
namespace attn_body {
using bf16=__hip_bfloat16;
using bf16x8=__attribute__((ext_vector_type(8)))short;
using s16x4=__attribute__((ext_vector_type(4)))short;
using f32x16=__attribute__((ext_vector_type(16)))float;
using u32x4=__attribute__((ext_vector_type(4)))unsigned;
constexpr int BATCH=8,NHEAD=8,SEQ=4096,D=64,DM=3072,OPITCH=1024;
constexpr int NW=8,QBLK=32,QB=QBLK*NW,KVBLK=64,NQB=SEQ/QB;
constexpr int ATTN_PITCH=DM, ATTN_UNIT_ROWS=QB;
__device__ __forceinline__ int crow(int r,int hi){return (r&3)+8*(r>>2)+4*hi;}
#define SBAR() __builtin_amdgcn_sched_barrier(0)
__device__ __forceinline__ void cmask(f32x16&p0,f32x16&p1,int jb,int qrel,int hi){
  const float NEG=-INFINITY; int kb=64*jb+4*hi;
  #pragma unroll
  for(int r=0;r<16;++r){int kv=kb+(r&3)+8*(r>>2); if(kv>qrel)p0[r]=NEG; if(kv+32>qrel)p1[r]=NEG;}
}

constexpr int NSLOT=3, SLOTB=8192;
constexpr int LDS_K=0, LDS_V=NSLOT*SLOTB, LDS_WS=2*NSLOT*SLOTB, LDS_OST=LDS_WS+NW*64*4, LDS_KB=LDS_OST+NW*4096, LDS_BYTES=LDS_KB+(SEQ+2)*8;
constexpr float C2=0.125f*1.4426950408889634f;
__device__ __forceinline__ void glds16(const void*gsrc,unsigned lds_dst){unsigned keep;
  asm volatile("s_mov_b32 %0, m0\n\ts_mov_b32 m0, %2\n\ts_nop 0\n\tglobal_load_lds_dwordx4 %1, off\n\ts_mov_b32 m0, %0":"=&s"(keep):"v"(gsrc),"s"(lds_dst):"memory");}
__device__ __forceinline__ float max3f(float a,float b,float c){float r;asm("v_max3_f32 %0, %1, %2, %3":"=v"(r):"v"(a),"v"(b),"v"(c));return r;}
__device__ __forceinline__ float max2f(float a,float b){float r;asm("v_max_f32_e32 %0, %1, %2":"=v"(r):"v"(a),"v"(b));return r;}
__device__ __forceinline__ float fadd_s(float a,float b){float r;asm("v_add_f32_e32 %0, %1, %2":"=v"(r):"v"(a),"v"(b));return r;}
__device__ __forceinline__ float fsub_s(float a,float b){float r;asm("v_sub_f32_e32 %0, %1, %2":"=v"(r):"v"(a),"v"(b));return r;}
typedef float f32x2_t __attribute__((ext_vector_type(2))); typedef float f32x4_t __attribute__((ext_vector_type(4))); typedef __bf16 bf16x2_t __attribute__((ext_vector_type(2)));
__device__ __forceinline__ unsigned cvtpk_s(float lo,float hi){f32x2_t v={lo,hi};bf16x2_t b=__builtin_convertvector(v,bf16x2_t);return __builtin_bit_cast(unsigned,b);}
#define WAIT_BAR(N) asm volatile("s_waitcnt vmcnt(" #N ") lgkmcnt(0)\n\ts_barrier":::"memory")

__device__ __forceinline__ void split3(float b,unsigned&h,unsigned&m,unsigned&l){
  h=cvtpk_s(b,0.f)&0xffffu; const float r1=b-__uint_as_float(h<<16);
  m=cvtpk_s(r1,0.f)&0xffffu; const float r2=r1-__uint_as_float(m<<16);
  l=cvtpk_s(r2,0.f)&0xffffu; }
__device__ __forceinline__ bf16x8 kbias_frag(float b,int hi){unsigned h,m,l;split3(b,h,m,l);u32x4 w;w.x=h|(m<<16);w.y=l|0x3F800000u;w.z=0x3F803F80u;w.w=0u;if(hi){w.x=0u;w.y=0u;w.z=0u;}return __builtin_bit_cast(bf16x8,w);}
__device__ __forceinline__ bf16x8 qref_frag(float x,int hi){unsigned h,m,l;split3(x,h,m,l);u32x4 w;w.x=0x3F803F80u;w.y=0x3F80u|(h<<16);w.z=m|(l<<16);w.w=0u;if(hi){w.x=0u;w.y=0u;w.z=0u;}return __builtin_bit_cast(bf16x8,w);}
typedef unsigned u32x2_t __attribute__((ext_vector_type(2)));
__device__ __forceinline__ bf16x8 mkfrag(u32x2_t e,unsigned zc){u32x4 w;w.x=e.x;w.y=e.y;w.z=zc;w.w=0u;return __builtin_bit_cast(bf16x8,w);}
__device__ __forceinline__ void fox_bias_table(int b,int h,const float*LF,char*shm){
  int tid_=threadIdx.x; asm volatile("":"+v"(tid_)); const int tid=tid_,lane=tid&63,wid=__builtin_amdgcn_readfirstlane(tid>>6);
  const float*lf=LF+((long)b*NHEAD+h)*SEQ; float*wt=(float*)(shm+LDS_WS); u32x2_t*KB8=(u32x2_t*)(shm+LDS_KB);
  f32x4_t va=*(const f32x4_t*)(lf+8*tid),vb=*(const f32x4_t*)(lf+8*tid+4);
  va[1]+=va[0];va[2]+=va[1];va[3]+=va[2];vb[0]+=va[3];vb[1]+=vb[0];vb[2]+=vb[1];vb[3]+=vb[2];
  const float tot=vb[3]; float inc=tot;
  #pragma unroll
  for(int o_=1;o_<64;o_<<=1){const float nn=__shfl_up(inc,o_);if(lane>=o_)inc+=nn;}
  __syncthreads();
  if(lane==63)wt[wid*64]=inc;
  __syncthreads();
  float base=inc-tot;
  #pragma unroll
  for(int w_=0;w_<NW;++w_){const float x_=wt[w_*64]; if(w_<wid)base+=x_;}
  const float cv[8]={va[0]+base,va[1]+base,va[2]+base,va[3]+base,vb[0]+base,vb[1]+base,vb[2]+base,vb[3]+base};
  #pragma unroll
  for(int j=0;j<8;++j){unsigned hh,mm,ll;split3(-cv[j],hh,mm,ll);KB8[8*tid+j]=(u32x2_t){hh|(mm<<16),ll|0x3F800000u};}
  if(tid==0){KB8[SEQ]=(u32x2_t){0u,0u};KB8[SEQ+1]=(u32x2_t){0u,0u};}
  __syncthreads();
}
__device__ __forceinline__ void qkt(f32x16&p0,f32x16&p1,const char*Kslot,const bf16x8*qr,bf16x8 kb0,bf16x8 kb1,bf16x8 qx,int r32,int hi){
  const f32x16 negm=f32x16{};
  const char*kb=Kslot+hi*1024+r32*16;
  #pragma unroll
  for(int d0=0;d0<4;++d0){
    const bf16x8 b0=*reinterpret_cast<const bf16x8*>(kb+d0*2048);
    const bf16x8 b1=*reinterpret_cast<const bf16x8*>(kb+d0*2048+512);
    if(d0==0){p0=__builtin_amdgcn_mfma_f32_32x32x16_bf16(b0,qr[0],negm,0,0,0);p1=__builtin_amdgcn_mfma_f32_32x32x16_bf16(b1,qr[0],negm,0,0,0);}
    else{p0=__builtin_amdgcn_mfma_f32_32x32x16_bf16(b0,qr[d0],p0,0,0,0);p1=__builtin_amdgcn_mfma_f32_32x32x16_bf16(b1,qr[d0],p1,0,0,0);}}
  p0=__builtin_amdgcn_mfma_f32_32x32x16_bf16(kb0,qx,p0,0,0,0);p1=__builtin_amdgcn_mfma_f32_32x32x16_bf16(kb1,qx,p1,0,0,0);
}
typedef __attribute__((address_space(3))) const char* lds_cptr;
typedef short v4i16_t __attribute__((ext_vector_type(4)));
__device__ __forceinline__ void kload8(bf16x8*kf,lds_cptr kp){
  kf[0]=*(const __attribute__((address_space(3))) bf16x8*)(kp);      kf[1]=*(const __attribute__((address_space(3))) bf16x8*)(kp+512);
  kf[2]=*(const __attribute__((address_space(3))) bf16x8*)(kp+2048); kf[3]=*(const __attribute__((address_space(3))) bf16x8*)(kp+2560);
  kf[4]=*(const __attribute__((address_space(3))) bf16x8*)(kp+4096); kf[5]=*(const __attribute__((address_space(3))) bf16x8*)(kp+4608);
  kf[6]=*(const __attribute__((address_space(3))) bf16x8*)(kp+6144); kf[7]=*(const __attribute__((address_space(3))) bf16x8*)(kp+6656);
}
__device__ __forceinline__ void kload2(bf16x8*kf,lds_cptr kp,int j){ kf[2*j]=*(const __attribute__((address_space(3))) bf16x8*)(kp+j*2048); kf[2*j+1]=*(const __attribute__((address_space(3))) bf16x8*)(kp+j*2048+512); }
__device__ __forceinline__ s16x4 vtr(lds_cptr p){ return __builtin_bit_cast(s16x4,__builtin_amdgcn_ds_read_tr16_b64_v4i16((__attribute__((address_space(3))) v4i16_t*)p)); }
__device__ __forceinline__ float rowmax(const f32x16&p0,const f32x16&p1){
  float a=max3f(p0[0],p0[1],p1[0]),b=max3f(p0[2],p0[3],p1[1]);a=max3f(a,p1[2],p1[3]);
  #pragma unroll
  for(int r=4;r<16;r+=4){a=max3f(a,p0[r],p0[r+1]);b=max3f(b,p0[r+2],p0[r+3]);a=max3f(a,p1[r],p1[r+1]);b=max3f(b,p1[r+2],p1[r+3]);}
  const float m=max2f(a,b);
  auto rr=__builtin_amdgcn_permlane32_swap(__float_as_uint(m),__float_as_uint(m),false,false);
  return max2f(__uint_as_float(rr[0]),__uint_as_float(rr[1]));
}
__device__ __forceinline__ void pv(f32x16*o,int vb,bf16x8 pa0,bf16x8 pa1,bf16x8 pa2,bf16x8 pa3){
  #pragma unroll
  for(int d0=0;d0<2;++d0){s16x4 lo[4],hi[4];
    #pragma unroll
    for(int ks=0;ks<4;++ks){
      asm volatile("ds_read_b64_tr_b16 %0,%1 offset:%c2":"=&v"(lo[ks]):"v"(vb),"i"(d0*4096+ks*1024):"memory");
      asm volatile("ds_read_b64_tr_b16 %0,%1 offset:%c2":"=&v"(hi[ks]):"v"(vb),"i"(d0*4096+ks*1024+512):"memory");}
    asm volatile("s_waitcnt lgkmcnt(0)":::"memory");SBAR();
    #define PK(k) (bf16x8){lo[k][0],lo[k][1],lo[k][2],lo[k][3],hi[k][0],hi[k][1],hi[k][2],hi[k][3]}
    o[d0]=__builtin_amdgcn_mfma_f32_32x32x16_bf16(pa0,PK(0),o[d0],0,0,0);
    o[d0]=__builtin_amdgcn_mfma_f32_32x32x16_bf16(pa1,PK(1),o[d0],0,0,0);
    o[d0]=__builtin_amdgcn_mfma_f32_32x32x16_bf16(pa2,PK(2),o[d0],0,0,0);
    o[d0]=__builtin_amdgcn_mfma_f32_32x32x16_bf16(pa3,PK(3),o[d0],0,0,0);
    #undef PK
  }
}

#ifndef ATTN_STORE16
#define ATTN_STORE16(p,v) (*(u32x4*)(p)=(v))
#endif
template<int THRL> __device__ __forceinline__ void attn_unit(int b,int h,int qb,const bf16*Q,const bf16* K,const bf16* V,bf16*O,const float*LF,const unsigned*NRM,char*shm){
  int tid_=threadIdx.x; asm volatile("":"+v"(tid_));
  const int tid=tid_,lane=tid&63,r32=lane&31,hi=lane>>5; const int wid=__builtin_amdgcn_readfirstlane(tid>>6);
  const long rowbase=(long)b*SEQ; const int q0=qb*QB;
  const char*KBt0=shm+LDS_KB;
  int t0;
  { const int NT0=(q0+QB)/KVBLK; const unsigned*nr=NRM+(b*NHEAD+h)*4;
    const float qn2=__uint_as_float(nr[0])+__uint_as_float(nr[1]), kn2=__uint_as_float(nr[2])+__uint_as_float(nr[3]);
    const float thr=-(50.f+2.04f*sqrtf(qn2*kn2));
    const u32x2_t eq0=*(const u32x2_t*)(KBt0+(unsigned)q0*8u); const float bq0=__uint_as_float(eq0.x<<16)+__uint_as_float(eq0.x&0xffff0000u)+__uint_as_float(eq0.y<<16);
    bool ok=(2*lane<=NT0-4);
    if(ok&&lane>0){ const u32x2_t el=*(const u32x2_t*)(KBt0+(unsigned)(128*lane-1)*8u); const float bl=__uint_as_float(el.x<<16)+__uint_as_float(el.x&0xffff0000u)+__uint_as_float(el.y<<16); ok=(bl-bq0<thr); }
    const unsigned long long mk=__ballot(ok); const unsigned long long low=~mk; const int cnt=(low==0ull)?64:__builtin_ctzll(low);
    t0=__builtin_amdgcn_readfirstlane(2*(cnt-1)); }
  const char*KBt=KBt0+(hi?0:t0*512); const unsigned kb_o0=hi?(unsigned)SEQ*8u:(unsigned)r32*8u, kb_o1=hi?(unsigned)SEQ*8u:(unsigned)(r32+32)*8u, kb_str=hi?0u:512u, zc=hi?0u:0x3F803F80u;
  const bf16*Qw=Q+(rowbase+q0+wid*QBLK)*DM+h*D;
  const bf16*Kh=K+(rowbase+(long)t0*KVBLK)*DM+h*D,*Vh=V+(rowbase+(long)t0*KVBLK)*DM+h*D;
  const unsigned lds0=(unsigned)(uintptr_t)shm;
  float*wsf=(float*)(shm+LDS_WS)+wid*64;
  const bf16*ksrc=Kh+(long)lane*DM+wid*8;
  const bf16*vsrc=Vh+(long)(16*(wid&3)+(lane>>2))*DM+(wid>>2)*32+(lane&3)*8;
  const unsigned kdst=lds0+LDS_K+wid*1024, vdst=lds0+LDS_V+wid*1024;
  #define DMA_K(t,slot) glds16(ksrc+(long)(t)*KVBLK*DM,(unsigned)__builtin_amdgcn_readfirstlane(kdst+(slot)))
  #define DMA_V(t,slot) glds16(vsrc+(long)(t)*KVBLK*DM,(unsigned)__builtin_amdgcn_readfirstlane(vdst+(slot)))
  const int vb0=(int)(lds0+LDS_V)+((lane>>4)&1)*32+(lane&3)*8+(4*hi+((lane&15)>>2))*64;
  const char*Kbase=shm+LDS_K; bf16x8 kf[8];
  const lds_cptr shm3=(lds_cptr)shm; const lds_cptr kp0=shm3+LDS_K+hi*1024+r32*16; const lds_cptr vp0=shm3+LDS_V+((lane>>4)&1)*32+(lane&3)*8+(4*hi+((lane&15)>>2))*64;
  const int NT=(q0+QB)/KVBLK-t0;
  DMA_K(0,0);DMA_V(0,0);DMA_K(1,SLOTB);
  bf16x8 qr[4];
  #pragma unroll
  for(int d0=0;d0<4;++d0)qr[d0]=*reinterpret_cast<const bf16x8*>(&Qw[(long)r32*DM+d0*16+hi*8]);
  float mhat; { const u32x2_t eq=*(const u32x2_t*)(KBt0+(unsigned)(q0+wid*QBLK+r32)*8u); mhat=__uint_as_float(eq.x<<16)+__uint_as_float(eq.x&0xffff0000u)+__uint_as_float(eq.y<<16); }
  float l_reg=0.f;f32x16 o[2];o[0]=f32x16{};o[1]=f32x16{};const f32x16 negm=f32x16{};
  bf16x8 qx=qref_frag(-mhat,hi);
  const int qrel=wid*QBLK+r32;
  #define CMASK(P0,P1,t) do{int jb_=(t)-(NT-4); if(jb_>=0)cmask(P0,P1,jb_,qrel,hi);}while(0)
  bool resc=false;
  #define START(P0,P1) do{ const float rm=rowmax(P0,P1); resc=false; \
    { const float dl=__builtin_fmaxf(rm,0.f); mhat=fadd_s(mhat,dl); \
      _Pragma("unroll") for(int r=0;r<16;++r){P0[r]=fsub_s(P0[r],dl);P1[r]=fsub_s(P1[r],dl);} \
      qx=qref_frag(-mhat,hi); } \
    _Pragma("unroll") for(int r=0;r<16;++r)P0[r]=__builtin_amdgcn_exp2f(P0[r]); }while(0)
  #define RESC() do{ if(resc){ asm volatile("s_waitcnt lgkmcnt(0)":::"memory"); \
      _Pragma("unroll") for(int d_=0;d_<2;++d_) _Pragma("unroll") for(int r=0;r<16;++r)o[d_][r]*=wsf[crow(r,hi)]; } }while(0)
  f32x16 pA0,pA1,pB0,pB1;
  int sl_prev=0,sl_cur=0,sl_next=SLOTB;
  #define ROT() do{sl_prev=sl_cur;sl_cur=sl_next;sl_next=(sl_next==(NSLOT-1)*SLOTB)?0:sl_next+SLOTB;}while(0)
  DMA_K(2,2*SLOTB);
  WAIT_BAR(3);
  qkt(pA0,pA1,Kbase,qr,mkfrag(*(const u32x2_t*)(KBt+kb_o0),zc),mkfrag(*(const u32x2_t*)(KBt+kb_o1),zc),qx,r32,hi);asm volatile("s_nop 15\n\ts_nop 7":"+v"(pA0),"+v"(pA1));CMASK(pA0,pA1,0);
  START(pA0,pA1);
  _Pragma("unroll") for(int r=0;r<16;++r)pA1[r]=__builtin_amdgcn_exp2f(pA1[r]);
  WAIT_BAR(0);
  DMA_K(3,0);DMA_V(1,SLOTB);
  ROT();
  kload8(kf,kp0+sl_cur);
  WAIT_BAR(2);
  s16x4 vlo[8],vhi[8]; u32x4 pw0,pw1,pw2,pw3;
  #define PKW(P,B) cvtpk_s(P[B],P[B+1])
  #define PAF(k) __builtin_bit_cast(bf16x8,pw##k)
  #define VFR(i) (bf16x8){vlo[i][0],vlo[i][1],vlo[i][2],vlo[i][3],vhi[i][0],vhi[i][1],vhi[i][2],vhi[i][3]}
  #define PIN(x) asm volatile("":"+v"(x))
  #define MX3(a,b,c) __builtin_fmaxf(__builtin_fmaxf((a),(b)),(c))
  #define GAPA(MF,A0,A1,A2,A3,W0,W1,PW) do{ MF; sacc+=A0; sacc+=A1; sacc+=A2; sacc+=A3; PIN(sacc); W0; W1; PIN(PW); SBAR(); }while(0)
  #define EX(v) __builtin_amdgcn_exp2f(v)
  #define GAPB(MF,X,B) do{ MF; X[B]=EX(X[B]); X[B+1]=EX(X[B+1]); X[B+2]=EX(X[B+2]); X[B+3]=EX(X[B+3]); PIN(X); SBAR(); }while(0)
  #define VRD(i) do{ vlo[i]=vtr(vp_+(((i)>>2)*4096+((i)&3)*1024)); vhi[i]=vtr(vp_+(((i)>>2)*4096+((i)&3)*1024+512)); }while(0)
  #define KRD(G,j) do{ if(G){ kload2(kf,kp0+sl_next,j); SBAR(); } }while(0)
  #define STEP(C0,C1,P0,P1,t,GK,GV,GL) do{ SBAR(); \
    const lds_cptr vp_=vp0+sl_prev; const u32x2_t e0_=*(const u32x2_t*)(KBt+kb_o0+(unsigned)(t)*kb_str),e1_=*(const u32x2_t*)(KBt+kb_o1+(unsigned)(t)*kb_str); \
    VRD(0); SBAR(); float sacc=(P0[0]+P0[1]); \
    GAPA(C0=__builtin_amdgcn_mfma_f32_32x32x16_bf16(kf[0],qr[0],negm,0,0,0), P0[2],P0[3],P0[4],P0[5],     pw0[0]=PKW(P0,0), pw0[1]=PKW(P0,2), pw0); \
    VRD(4); SBAR(); GAPA(C1=__builtin_amdgcn_mfma_f32_32x32x16_bf16(kf[1],qr[0],negm,0,0,0), P0[6],P0[7],P0[8],P0[9],     pw0[2]=PKW(P0,4), pw0[3]=PKW(P0,6), pw0); \
    VRD(1); SBAR(); GAPA(C0=__builtin_amdgcn_mfma_f32_32x32x16_bf16(kf[2],qr[1],C0,0,0,0),   P0[10],P0[11],P0[12],P0[13], pw1[0]=PKW(P0,8), pw1[1]=PKW(P0,10), pw1); \
    VRD(5); SBAR(); GAPA(C1=__builtin_amdgcn_mfma_f32_32x32x16_bf16(kf[3],qr[1],C1,0,0,0),   P0[14],P0[15],P1[0],P1[1],   pw1[2]=PKW(P0,12),pw1[3]=PKW(P0,14), pw1); \
    VRD(2); SBAR(); GAPA(C0=__builtin_amdgcn_mfma_f32_32x32x16_bf16(kf[4],qr[2],C0,0,0,0),   P1[2],P1[3],P1[4],P1[5],     pw2[0]=PKW(P1,0), pw2[1]=PKW(P1,2), pw2); \
    VRD(6); SBAR(); GAPA(C1=__builtin_amdgcn_mfma_f32_32x32x16_bf16(kf[5],qr[2],C1,0,0,0),   P1[6],P1[7],P1[8],P1[9],     pw2[2]=PKW(P1,4), pw2[3]=PKW(P1,6), pw2); \
    VRD(3); SBAR(); GAPA(C0=__builtin_amdgcn_mfma_f32_32x32x16_bf16(kf[6],qr[3],C0,0,0,0),   P1[10],P1[11],P1[12],P1[13], pw3[0]=PKW(P1,8), pw3[1]=PKW(P1,10), pw3); \
    VRD(7); SBAR(); GAPA(C1=__builtin_amdgcn_mfma_f32_32x32x16_bf16(kf[7],qr[3],C1,0,0,0),   P1[14],P1[15],0.f,0.f,       pw3[2]=PKW(P1,12),pw3[3]=PKW(P1,14), pw3); \
    { const bf16x8 kb0_=mkfrag(e0_,zc),kb1_=mkfrag(e1_,zc); C0=__builtin_amdgcn_mfma_f32_32x32x16_bf16(kb0_,qx,C0,0,0,0); C1=__builtin_amdgcn_mfma_f32_32x32x16_bf16(kb1_,qx,C1,0,0,0); } SBAR(); \
    l_reg+=sacc; \
    if(GK){DMA_K((t)+3,sl_cur);} if(GV){DMA_V((t)+1,sl_next);} \
    CMASK(C0,C1,t); \
    { float a=MX3(C0[0],C0[1],C1[0]),b=MX3(C0[2],C0[3],C1[1]); a=MX3(a,C1[2],C1[3]); \
      _Pragma("unroll") for(int r=4;r<16;r+=4){a=MX3(a,C0[r],C0[r+1]);b=MX3(b,C0[r+2],C0[r+3]);a=MX3(a,C1[r],C1[r+1]);b=MX3(b,C1[r+2],C1[r+3]);} \
      float rm=__builtin_fmaxf(a,b); { auto rr=__builtin_amdgcn_permlane32_swap(__float_as_uint(rm),__float_as_uint(rm),false,false); rm=__builtin_fmaxf(__uint_as_float(rr[0]),__uint_as_float(rr[1])); } \
      resc=false; \
      if(__builtin_expect(__any(rm>(float)THRL),0)){ const float dl=__builtin_fmaxf(rm,0.f); mhat+=dl; \
        _Pragma("unroll") for(int r=0;r<16;++r){C0[r]-=dl;C1[r]-=dl;} \
        qx=qref_frag(-mhat,hi); \
        const float f=__builtin_amdgcn_exp2f(-dl); l_reg*=f; if(hi==0)wsf[r32]=f; resc=true; } } \
    SBAR(); \
    GAPB(o[0]=__builtin_amdgcn_mfma_f32_32x32x16_bf16(PAF(0),VFR(0),o[0],0,0,0), C0,0); \
    GAPB(o[1]=__builtin_amdgcn_mfma_f32_32x32x16_bf16(PAF(0),VFR(4),o[1],0,0,0), C0,4); \
    KRD(GL,0); GAPB(o[0]=__builtin_amdgcn_mfma_f32_32x32x16_bf16(PAF(1),VFR(1),o[0],0,0,0), C0,8); \
    KRD(GL,1); GAPB(o[1]=__builtin_amdgcn_mfma_f32_32x32x16_bf16(PAF(1),VFR(5),o[1],0,0,0), C0,12); \
    KRD(GL,2); GAPB(o[0]=__builtin_amdgcn_mfma_f32_32x32x16_bf16(PAF(2),VFR(2),o[0],0,0,0), C1,0); \
    KRD(GL,3); GAPB(o[1]=__builtin_amdgcn_mfma_f32_32x32x16_bf16(PAF(2),VFR(6),o[1],0,0,0), C1,4); \
    GAPB(o[0]=__builtin_amdgcn_mfma_f32_32x32x16_bf16(PAF(3),VFR(3),o[0],0,0,0), C1,8); \
    GAPB(o[1]=__builtin_amdgcn_mfma_f32_32x32x16_bf16(PAF(3),VFR(7),o[1],0,0,0), C1,12); \
    }while(0)
  int t=1;
  #undef CMASK
  #define CMASK(P0,P1,t) do{}while(0)
  for(;t+5<NT;t+=2){
    STEP(pB0,pB1,pA0,pA1,t,true,true,true);     WAIT_BAR(2); RESC(); ROT();
    STEP(pA0,pA1,pB0,pB1,t+1,true,true,true);   WAIT_BAR(2); RESC(); ROT();
  }
  #undef CMASK
  #define CMASK(P0,P1,t) do{int jb_=(t)-(NT-4); if(jb_>=0)cmask(P0,P1,jb_,qrel,hi);}while(0)
  #define ENDW(tt) do{ if((tt)+3<NT){WAIT_BAR(2);} else if((tt)+2<NT){WAIT_BAR(1);} else {WAIT_BAR(0);} }while(0)
  for(;t+1<NT;t+=2){
    STEP(pB0,pB1,pA0,pA1,t,(t+3<NT),(t+1<NT),(t+1<NT));       ENDW(t);   RESC(); ROT();
    STEP(pA0,pA1,pB0,pB1,t+1,(t+4<NT),(t+2<NT),(t+2<NT));     ENDW(t+1); RESC(); ROT();
  }
  STEP(pB0,pB1,pA0,pA1,NT-1,false,false,false); RESC();
  { float sacc=pB0[0]+pB0[1]; _Pragma("unroll") for(int r=2;r<16;++r)sacc+=pB0[r]; _Pragma("unroll") for(int r=0;r<16;++r)sacc+=pB1[r]; l_reg+=sacc;
    pw0=(u32x4){PKW(pB0,0),PKW(pB0,2),PKW(pB0,4),PKW(pB0,6)};pw1=(u32x4){PKW(pB0,8),PKW(pB0,10),PKW(pB0,12),PKW(pB0,14)};pw2=(u32x4){PKW(pB1,0),PKW(pB1,2),PKW(pB1,4),PKW(pB1,6)};pw3=(u32x4){PKW(pB1,8),PKW(pB1,10),PKW(pB1,12),PKW(pB1,14)};
    SBAR(); pv(o,vb0+sl_cur,PAF(0),PAF(1),PAF(2),PAF(3)); }
  #undef PKW
  #undef PAF
  #undef VFR
  #undef PIN
  #undef MX3
  #undef GAPA
  #undef GAPB
  #undef EX
  #undef VRD
  #undef KRD
  #undef STEP
  #undef ENDW
  {auto rr=__builtin_amdgcn_permlane32_swap(__float_as_uint(l_reg),__float_as_uint(l_reg),false,false);l_reg=__uint_as_float(rr[0])+__uint_as_float(rr[1]);}
  if(hi==0)wsf[32+r32]=l_reg;asm volatile("s_waitcnt lgkmcnt(0)":::"memory");
  float rli[16];
  #pragma unroll
  for(int r=0;r<16;++r)rli[r]=__builtin_amdgcn_rcpf(wsf[32+crow(r,hi)]);
  bf16*Ow=O+(rowbase+q0+wid*QBLK)*OPITCH+h*D;
  { bf16*stg=(bf16*)(shm+LDS_OST)+wid*2048;
    #pragma unroll
    for(int r=0;r<16;++r){const int orow=crow(r,hi);
      #pragma unroll
      for(int d0=0;d0<2;++d0)stg[orow*64+d0*32+r32]=__float2bfloat16(o[d0][r]*rli[r]);}
    asm volatile("s_waitcnt lgkmcnt(0)":::"memory");
    #pragma unroll
    for(int i=0;i<4;++i){const int row=i*8+(lane>>3),ch=lane&7; const u32x4 v=*(const u32x4*)(stg+row*64+ch*8); ATTN_STORE16(Ow+(long)row*OPITCH+ch*8,v);} }
  asm volatile("s_waitcnt lgkmcnt(0)\n\ts_barrier":::"memory");
  #undef DMA_K
  #undef DMA_V
  #undef CMASK
  #undef START
  #undef RESC
  #undef ROT
}
constexpr int ATTN_LDS_BYTES=LDS_BYTES;
struct AttnTensors { const bf16* Q; const bf16* K; const bf16* V; bf16* O; const float* LF; const unsigned* NRM; };
struct AttnUnit { int bh; int qb; };
struct StaticOrder {
  int vcu,grid;
  __device__ __forceinline__ explicit StaticOrder(int grid_,int block):vcu((grid_%8==0)?(block%8)*(grid_/8)+block/8:block),grid(grid_){}
  __device__ __forceinline__ bool next(int i,AttnUnit&u)const{
    if(grid==256){ if(i>=4)return false; const int s=vcu&3; u.bh=vcu>>2; u.qb=(i==0)?s:(i==1)?7-s:(i==2)?8+s:15-s; return true; }
    const int L=i*grid+vcu; if(L>=BATCH*NHEAD*NQB)return false; u.bh=L/NQB; u.qb=L%NQB; return true; }
  __device__ __forceinline__ void a_ready(const AttnUnit&)const{}
  __device__ __forceinline__ void done(const AttnUnit&)const{}
};
template<class Sched,int THRL=8> __device__ __forceinline__ void attn_phase(char*lds,const AttnTensors&T,const Sched&S){
  AttnUnit u; int cur_bh=-1;
  for(int i=0;S.next(i,u);++i){ S.a_ready(u); if(u.bh!=cur_bh){ fox_bias_table(u.bh/NHEAD,u.bh%NHEAD,T.LF,lds); cur_bh=u.bh; }
    attn_unit<THRL>(u.bh/NHEAD,u.bh%NHEAD,u.qb,T.Q,T.K,T.V,T.O,T.LF,T.NRM,lds); S.done(u); }
}
template<int THRL=8> __device__ __forceinline__ void attn_phase_dyn(char*lds,const AttnTensors&T,unsigned*qheads,volatile int*slot,int grp){
  int cur_bh=-1; const int NU=NHEAD*NQB; unsigned*qhead=qheads+64*grp;
  if(threadIdx.x==0) slot[0]=(int)__hip_atomic_fetch_add(qhead,1u,__ATOMIC_RELAXED,__HIP_MEMORY_SCOPE_AGENT);
  __syncthreads();
  int idx=__builtin_amdgcn_readfirstlane(slot[0]);
  while(idx<NU){
    __syncthreads();
    if(threadIdx.x==0) slot[0]=(int)__hip_atomic_fetch_add(qhead,1u,__ATOMIC_RELAXED,__HIP_MEMORY_SCOPE_AGENT);
    const int qb=NQB-1-idx/NHEAD, bh=grp*NHEAD+idx%NHEAD;
    if(bh!=cur_bh){ fox_bias_table(bh/NHEAD,bh%NHEAD,T.LF,lds); cur_bh=bh; }
    attn_unit<THRL>(bh/NHEAD,bh%NHEAD,qb,T.Q,T.K,T.V,T.O,T.LF,T.NRM,lds);
    __syncthreads();
    idx=__builtin_amdgcn_readfirstlane(slot[0]);
  }
}
#undef SBAR
#undef WAIT_BAR
}
namespace fx {
using namespace nv;
typedef unsigned short bf16;
typedef unsigned v4u __attribute__((ext_vector_type(4)));
typedef float f32x4 __attribute__((ext_vector_type(4)));
constexpr float C2 = 0.125f * 1.4426950408889634f;
constexpr int NIN = 3328;
constexpr int QKVP = 3072;
constexpr int P_FQ = 0, P_FK = 512, P_FV = 1024, P_GQ = 1536, P_GK = 1792, P_GV = 2048, P_GR = 2560;
__device__ __forceinline__ int inproj_src(int d) {
    if (d < 1536) return d;
    if (d < 1792) return O_GQ + (d - 1536);
    if (d < 2048) return O_GK + (d - 1792);
    if (d < 2560) return O_GV + (d - 2048);
    if (d < 3072) return O_GR + (d - 2560);
    if (d < 3080) return O_FF + (d - 3072);
    if (d < 3096) return O_GA + (d - 3080);
    return -1;
}
__device__ __forceinline__ unsigned f2bf(float f) { unsigned u = __builtin_bit_cast(unsigned, f); return (u + 0x7fffu + ((u >> 16) & 1u)) >> 16; }
__device__ __forceinline__ unsigned pk2(float lo, float hi) { return f2bf(lo) | (f2bf(hi) << 16); }
__device__ __forceinline__ float bf2f(unsigned short h) { return __builtin_bit_cast(float, (unsigned)h << 16); }
__device__ __forceinline__ float wave_sum(float v) {
#pragma unroll
    for (int o = 1; o < 64; o <<= 1) v += __shfl_xor(v, o);
    return v;
}
#define FX_LDS_WAIT() asm volatile("s_waitcnt lgkmcnt(0)" ::: "memory")

template <class Map> __device__ __forceinline__ void transpose_item(const float* __restrict__ W, int K, int N, bf16* WT, LAS float* scr, int kb, int nb, int lane, Map srcmap) {
    const int k0 = 64 * kb, n0 = 32 * nb;
    const int src = srcmap(n0 + (lane & 31));
#pragma unroll 8
    for (int i = 0; i < 32; ++i) { const int kk = 2 * i + (lane >> 5); scr[kk * 33 + (lane & 31)] = (src >= 0) ? W[(size_t)(k0 + kk) * N + src] : 0.f; }
    FX_LDS_WAIT(); asm volatile("" ::: "memory");
    const int c = lane & 7;
#pragma unroll
    for (int j = 0; j < 4; ++j) { const int n = (lane >> 3) + 8 * j; const LAS float* s = scr + (8 * c) * 33 + n;
        v4u o; o.x = pk2(s[0 * 33], s[1 * 33]); o.y = pk2(s[2 * 33], s[3 * 33]); o.z = pk2(s[4 * 33], s[5 * 33]); o.w = pk2(s[6 * 33], s[7 * 33]);
        *(GAS v4u*)(WT + (size_t)(n0 + n) * K + k0 + 8 * c) = o; }
    FX_LDS_WAIT(); asm volatile("" ::: "memory");
}

__device__ __forceinline__ void ln_row_bf16(const float* xrow, const float* __restrict__ g, const float* __restrict__ b, bf16* orow, float* frow, float* st, int lane) {
    const GAS f32x4* xr = (const GAS f32x4*)xrow + lane;
    f32x4 v[4]; float s = 0.f;
#pragma unroll
    for (int j = 0; j < 4; ++j) { v[j] = xr[64 * j]; s += (v[j].x + v[j].y) + (v[j].z + v[j].w); }
    const float mean = wave_sum(s) * (1.f / D); float s2 = 0.f;
#pragma unroll
    for (int j = 0; j < 4; ++j) { v[j] = v[j] - mean; s2 += (v[j].x * v[j].x + v[j].y * v[j].y) + (v[j].z * v[j].z + v[j].w * v[j].w); }
    const float rstd = 1.f / sqrtf(wave_sum(s2) * (1.f / D) + LN_EPS);
    if (st && lane == 0) { st[0] = mean; st[1] = rstd; }
    GAS unsigned long long* o8 = (GAS unsigned long long*)orow + lane;
#pragma unroll
    for (int j = 0; j < 4; ++j) {
        const f32x4 gg = ((const f32x4*)g)[lane + 64 * j], bb = ((const f32x4*)b)[lane + 64 * j];
        const f32x4 o = v[j] * rstd * gg + bb;
        o8[64 * j] = (unsigned long long)pk2(o.x, o.y) | ((unsigned long long)pk2(o.z, o.w) << 32);
        if (frow) ((GAS f32x4*)frow)[lane + 64 * j] = o;
    }
}

struct CvItem { const float* W; bf16* WT; int N, K, k0, n0, s0; };
__device__ __forceinline__ void cv_load(const CvItem& it, f32x4 (&v)[8], int lane) {
    const float* p = it.W + (size_t)(it.k0 + (lane >> 3)) * it.N + it.s0 + 4 * (lane & 7);
#pragma unroll
    for (int i = 0; i < 8; ++i) v[i] = __builtin_nontemporal_load((const f32x4*)(p + (size_t)(8 * i) * it.N));
}
__device__ __forceinline__ void cv_finish(const CvItem& it, const f32x4 (&v)[8], LAS float* scr, int lane) {
    const int rr = lane >> 3, cq = lane & 7;
#pragma unroll
    for (int i = 0; i < 8; ++i) { LAS float* d = scr + (8 * i + rr) * 33 + 4 * cq; d[0] = v[i][0]; d[1] = v[i][1]; d[2] = v[i][2]; d[3] = v[i][3]; }
    FX_LDS_WAIT(); asm volatile("" ::: "memory");
    const int c = lane & 7;
#pragma unroll
    for (int j = 0; j < 4; ++j) { const int n = (lane >> 3) + 8 * j; const LAS float* s = scr + (8 * c) * 33 + n;
        v4u o; o.x = pk2(s[0 * 33], s[1 * 33]); o.y = pk2(s[2 * 33], s[3 * 33]); o.z = pk2(s[4 * 33], s[5 * 33]); o.w = pk2(s[6 * 33], s[7 * 33]);
        __builtin_nontemporal_store(o, (GAS v4u*)(it.WT + (size_t)(it.n0 + n) * it.K + it.k0 + 8 * c)); }
    FX_LDS_WAIT(); asm volatile("" ::: "memory");
}

template <int NR> __device__ __forceinline__ void ln_rows_bf16(const float* xrows, const float* __restrict__ g, const float* __restrict__ b, bf16* orows, int lane, float* st = nullptr) {
    f32x4 v[NR][4];
#pragma unroll
    for (int r = 0; r < NR; ++r)
#pragma unroll
        for (int j = 0; j < 4; ++j) v[r][j] = ((const GAS f32x4*)(xrows + (size_t)r * D))[lane + 64 * j];
    f32x4 gg[4], bb[4];
#pragma unroll
    for (int j = 0; j < 4; ++j) { gg[j] = ((const f32x4*)g)[lane + 64 * j]; bb[j] = ((const f32x4*)b)[lane + 64 * j]; }
#pragma unroll
    for (int r = 0; r < NR; ++r) {
        float s = 0.f;
#pragma unroll
        for (int j = 0; j < 4; ++j) s += (v[r][j].x + v[r][j].y) + (v[r][j].z + v[r][j].w);
        const float mean = wave_sum(s) * (1.f / D); float s2 = 0.f;
#pragma unroll
        for (int j = 0; j < 4; ++j) { v[r][j] = v[r][j] - mean; s2 += (v[r][j].x * v[r][j].x + v[r][j].y * v[r][j].y) + (v[r][j].z * v[r][j].z + v[r][j].w * v[r][j].w); }
        const float rstd = 1.f / sqrtf(wave_sum(s2) * (1.f / D) + LN_EPS);
        if (st && lane == 0) { st[2 * r] = mean; st[2 * r + 1] = rstd; }
        GAS unsigned long long* o8 = (GAS unsigned long long*)(orows + (size_t)r * D) + lane;
#pragma unroll
        for (int j = 0; j < 4; ++j) { const f32x4 o = v[r][j] * rstd * gg[j] + bb[j];
            o8[64 * j] = (unsigned long long)pk2(o.x, o.y) | ((unsigned long long)pk2(o.z, o.w) << 32); }
    }
}

template <int NR> __device__ __forceinline__ void ln1_rows_bf16(const float* xrows, const float* st, const float* __restrict__ gi, const float* __restrict__ bi, const bf16* mixrows,
                                                               const float* __restrict__ g1, const float* __restrict__ b1, bf16* orows, float alpha, int lane) {
    f32x4 v[NR][4]; unsigned long long mx[NR][4]; float mean0[NR], rstd0[NR];
#pragma unroll
    for (int r = 0; r < NR; ++r) { mean0[r] = st[2 * r]; rstd0[r] = st[2 * r + 1];
#pragma unroll
        for (int j = 0; j < 4; ++j) { v[r][j] = ((const GAS f32x4*)(xrows + (size_t)r * D))[lane + 64 * j]; mx[r][j] = ((const GAS unsigned long long*)(mixrows + (size_t)r * D))[lane + 64 * j]; } }
    f32x4 gi4[4], bi4[4];
#pragma unroll
    for (int j = 0; j < 4; ++j) { gi4[j] = ((const f32x4*)gi)[lane + 64 * j] * alpha; bi4[j] = ((const f32x4*)bi)[lane + 64 * j] * alpha; }
#pragma unroll
    for (int r = 0; r < NR; ++r) {
        float s = 0.f;
#pragma unroll
        for (int j = 0; j < 4; ++j) { const unsigned lo = (unsigned)mx[r][j], hi = (unsigned)(mx[r][j] >> 32);
            f32x4 mv; mv.x = __builtin_bit_cast(float, lo << 16); mv.y = __builtin_bit_cast(float, lo & 0xffff0000u); mv.z = __builtin_bit_cast(float, hi << 16); mv.w = __builtin_bit_cast(float, hi & 0xffff0000u);
            v[r][j] = ((v[r][j] - mean0[r]) * rstd0[r]) * gi4[j] + bi4[j] + mv;
            s += (v[r][j].x + v[r][j].y) + (v[r][j].z + v[r][j].w); }
        const float mean = wave_sum(s) * (1.f / D); float s2 = 0.f;
#pragma unroll
        for (int j = 0; j < 4; ++j) { v[r][j] = v[r][j] - mean; s2 += (v[r][j].x * v[r][j].x + v[r][j].y * v[r][j].y) + (v[r][j].z * v[r][j].z + v[r][j].w * v[r][j].w); }
        const float rstd = 1.f / sqrtf(wave_sum(s2) * (1.f / D) + LN_EPS);
        GAS unsigned long long* o8 = (GAS unsigned long long*)(orows + (size_t)r * D) + lane;
#pragma unroll
        for (int j = 0; j < 4; ++j) { const f32x4 gg = ((const f32x4*)g1)[lane + 64 * j], bb = ((const f32x4*)b1)[lane + 64 * j]; const f32x4 o = v[r][j] * rstd * gg + bb;
            o8[64 * j] = (unsigned long long)pk2(o.x, o.y) | ((unsigned long long)pk2(o.z, o.w) << 32); }
    }
}
}

namespace pg8 {
struct EpiInProj {
    static constexpr bool PERM = true, AFTER_DRAIN = false;
    bf16_t* QKV; float* FG; float* LF; const float* bfg; unsigned* NRM;
    __device__ __forceinline__ void operator()(const f32x4 (&acc)[2][2][4][2], const Unit& u, int wr, int wc, int fr, int fq) const {
        const int row0 = u.pm * BM + wr * 64 + fr;
        if (u.pn < 12) {
            const float sc = (u.pn < 2) ? fx::C2 : 1.f;
            const int col0 = u.pn * BM + wc * 32 + 8 * fq;
            float nmax[2] = {0.f, 0.f};
#pragma unroll
            for (int ai = 0; ai < 2; ++ai)
#pragma unroll
                for (int m = 0; m < 4; ++m) { bf16_t* rowp = QKV + (size_t)(row0 + ai * HALF + m * 16) * fx::QKVP + col0;
#pragma unroll
                    for (int bj = 0; bj < 2; ++bj) { const f32x4 v0 = acc[ai][bj][m][0] * sc, v1 = acc[ai][bj][m][1] * sc;
                        u32x4 w; w.x = cvt_pk_bf16(v0[0], v0[1]); w.y = cvt_pk_bf16(v0[2], v0[3]); w.z = cvt_pk_bf16(v1[0], v1[1]); w.w = cvt_pk_bf16(v1[2], v1[3]);
                        *(u32x4*)(rowp + bj * HALF) = w;
                        if (u.pn < 4) { const f32x4 q0 = v0 * v0, q1 = v1 * v1; float s = (q0[0] + q0[1]) + (q0[2] + q0[3]) + (q1[0] + q1[1]) + (q1[2] + q1[3]);
                            s += __shfl_xor(s, 16); s += __shfl_xor(s, 32);
                            nmax[bj] = fmaxf(nmax[bj], s); } } }
            if (u.pn < 4) {
#pragma unroll
                for (int bj = 0; bj < 2; ++bj) { float s = nmax[bj];
#pragma unroll
                    for (int o = 1; o < 16; o <<= 1) s = fmaxf(s, __shfl_xor(s, o));
                    if (fr == 0 && fq == 0) { const int b = (u.pm * BM) >> 12, head = 4 * (u.pn & 1) + 2 * bj + (wc >> 1);
                        atomicMax(NRM + (b * 8 + head) * 4 + (u.pn >= 2 ? 2 : 0) + (wc & 1), __builtin_bit_cast(unsigned, s)); } }
            }
        } else if (wc == 0 && fq < 3) {
#pragma unroll
            for (int ai = 0; ai < 2; ++ai)
#pragma unroll
                for (int m = 0; m < 4; ++m) { const int row = row0 + ai * HALF + m * 16; float* p = FG + (size_t)row * 32 + 8 * fq;
                    *(f32x4*)p = acc[ai][0][m][0]; *(f32x4*)(p + 4) = acc[ai][0][m][1];
                    if (fq == 0) { const int b = row >> 12, s = row & 4095;
#pragma unroll
                        for (int n = 0; n < 2; ++n)
#pragma unroll
                            for (int i = 0; i < 4; ++i) { const int h = 4 * n + i; LF[(size_t)(b * 8 + h) * nv::S + s] = 1.4426950408889634f * nv::logsigmoidf(acc[ai][0][m][n][i] + bfg[h]); } } }
        }
    }
};
}
namespace gl {
using namespace nv;
typedef unsigned short bf16;
typedef short bf16x8 __attribute__((ext_vector_type(8)));
typedef float f32x4 __attribute__((ext_vector_type(4)));
typedef unsigned u32x4 __attribute__((ext_vector_type(4)));
typedef unsigned u32x2 __attribute__((ext_vector_type(2)));
constexpr int NCH = S / 64;
constexpr int NUNIT = B * GH * NCH;
constexpr int LS = 72;
constexpr int L_WGU = 0, L_BG = 4096, L_DECS = 4352, L_QP = 8192, L_KP = L_QP + 64 * LS * 2, L_KPT = L_KP + 64 * LS * 2, L_VT = L_KPT + 64 * LS * 2, L_PP = L_VT + 128 * LS * 2, L_WT = L_PP + 64 * LS * 2, L_END = L_WT + 2048;
static_assert(L_END <= 131072, "gla prep LDS");
constexpr int C_ST = 0, C_PART = 128 * LS * 2, C_END = C_PART + 2 * 8 * 64 * 4;
constexpr size_t QPG_B = 64 * 64 * 2, OI_B = 8 * 4 * 64 * 16, UU_B = OI_B, DEC_B = 256;

__device__ __forceinline__ unsigned pkbf(float lo, float hi) { typedef float f2 __attribute__((ext_vector_type(2))); typedef __bf16 b2 __attribute__((ext_vector_type(2))); f2 v = {lo, hi}; b2 r = __builtin_convertvector(v, b2); return __builtin_bit_cast(unsigned, r); }
__device__ __forceinline__ float bf2f(unsigned short h) { return __builtin_bit_cast(float, (unsigned)h << 16); }
__device__ __forceinline__ float bflo(unsigned w) { return __builtin_bit_cast(float, w << 16); }
__device__ __forceinline__ float bfhi(unsigned w) { return __builtin_bit_cast(float, w & 0xffff0000u); }
__device__ __forceinline__ float fast_logsig2(float x) { return -__builtin_amdgcn_logf(1.f + __builtin_amdgcn_exp2f(-1.4426950408889634f * x)); }

__device__ __forceinline__ void prep_unit(int unit, const bf16* QKV, const float* FG, const float* __restrict__ wgu, const float* __restrict__ bgate,
                                          unsigned char* QPG, unsigned char* OI, unsigned char* UU, float* DEC, unsigned char* lds, int& cur_h, f32x4 (&Sagg)[4], f32x4 (&Dagg)[4]) {
    int tid_ = threadIdx.x; asm volatile("" : "+v"(tid_));
    const int tid = tid_, lane = tid & 63, wid = __builtin_amdgcn_readfirstlane(tid >> 6), l15 = lane & 15, g = lane >> 4;
    const int n = unit % NCH, bh = unit / NCH, h = bh % GH, b = bh / GH;
    const size_t row0 = (size_t)b * S + (size_t)n * 64;
    float* WGU = (float*)(lds + L_WGU); float* BG = (float*)(lds + L_BG); float* WT = (float*)(lds + L_WT);
    bf16* QP = (bf16*)(lds + L_QP); bf16* KP = (bf16*)(lds + L_KP); bf16* KPT = (bf16*)(lds + L_KPT); bf16* VT = (bf16*)(lds + L_VT); bf16* PP = (bf16*)(lds + L_PP);
    if (cur_h != h) { __syncthreads(); for (int i = tid; i < 16 * 64; i += 512) WGU[i] = wgu[(i >> 6) * 256 + h * 64 + (i & 63)]; if (tid < 64) BG[tid] = bgate[h * 64 + tid]; cur_h = h; __syncthreads(); }
    const int t = tid >> 3, oc = tid & 7, d0 = oc * 8;
    float la[8];
    { const float* gp = FG + (row0 + t) * 32 + 8;
      f32x4 ga4[4];
#pragma unroll
      for (int i = 0; i < 4; ++i) ga4[i] = *(const f32x4*)(gp + 4 * i);
#pragma unroll
      for (int j = 0; j < 8; ++j) la[j] = BG[d0 + j];
#pragma unroll
      for (int r = 0; r < 16; ++r) { const float gv = ga4[r >> 2][r & 3]; const f32x4 w0 = *(const f32x4*)(WGU + r * 64 + d0), w1 = *(const f32x4*)(WGU + r * 64 + d0 + 4);
#pragma unroll
          for (int j = 0; j < 4; ++j) { la[j] += gv * w0[j]; la[4 + j] += gv * w1[j]; } }
#pragma unroll
      for (int j = 0; j < 8; ++j) la[j] = fast_logsig2(la[j]) * (1.f / 16.f); }
    const u32x4 qv = *(const u32x4*)(QKV + (row0 + t) * fx::QKVP + fx::P_GQ + h * 64 + d0);
    const u32x4 kv = *(const u32x4*)(QKV + (row0 + t) * fx::QKVP + fx::P_GK + h * 64 + d0);
    const u32x4 vv0 = *(const u32x4*)(QKV + (row0 + t) * fx::QKVP + fx::P_GV + h * 128 + oc * 16);
    const u32x4 vv1 = *(const u32x4*)(QKV + (row0 + t) * fx::QKVP + fx::P_GV + h * 128 + oc * 16 + 8);
#pragma unroll
    for (int off = 8; off < 64; off <<= 1) {
#pragma unroll
        for (int j = 0; j < 8; ++j) { const float o = __shfl_up(la[j], off); if (lane >= off) la[j] += o; } }
    if (lane >= 56) {
#pragma unroll
        for (int j = 0; j < 8; ++j) WT[wid * 64 + d0 + j] = la[j]; }
    __syncthreads();
    float bl[8];
#pragma unroll
    for (int j = 0; j < 8; ++j) bl[j] = 0.f;
#pragma unroll
    for (int w = 0; w < 8; ++w) {
        const f32x4 a0 = *(const f32x4*)(WT + w * 64 + d0), a1 = *(const f32x4*)(WT + w * 64 + d0 + 4);
#pragma unroll
        for (int j = 0; j < 4; ++j) { bl[j] += a0[j]; bl[4 + j] += a1[j]; if (w < wid) { la[j] += a0[j]; la[4 + j] += a1[j]; } } }
    {
        const unsigned qw[4] = {qv.x, qv.y, qv.z, qv.w}, kw[4] = {kv.x, kv.y, kv.z, kv.w};
        float qf[8], kf[8];
#pragma unroll
        for (int i = 0; i < 4; ++i) { qf[2 * i] = bflo(qw[i]); qf[2 * i + 1] = bfhi(qw[i]); kf[2 * i] = bflo(kw[i]); kf[2 * i + 1] = bfhi(kw[i]); }
        float qp[8], kp[8], kpp[8];
#pragma unroll
        for (int j = 0; j < 8; ++j) { const float bb = la[j], bbl = bl[j];
            qp[j] = qf[j] * (0.125f * __builtin_amdgcn_exp2f(bb)); kp[j] = kf[j] * __builtin_amdgcn_exp2f(-bb); kpp[j] = kf[j] * __builtin_amdgcn_exp2f(bbl - bb); }
        u32x4 qo, ko; qo.x = pkbf(qp[0], qp[1]); qo.y = pkbf(qp[2], qp[3]); qo.z = pkbf(qp[4], qp[5]); qo.w = pkbf(qp[6], qp[7]);
        ko.x = pkbf(kp[0], kp[1]); ko.y = pkbf(kp[2], kp[3]); ko.z = pkbf(kp[4], kp[5]); ko.w = pkbf(kp[6], kp[7]);
        *(u32x4*)(QP + t * LS + d0) = qo; *(u32x4*)(KP + t * LS + d0) = ko;
        *(u32x4*)(QPG + (size_t)unit * QPG_B + (size_t)(t * 64 + d0) * 2) = qo;
#pragma unroll
        for (int j = 0; j < 8; ++j) KPT[(d0 + j) * LS + t] = (bf16)(pkbf(kpp[j], 0.f) & 0xffffu);
        const unsigned vw[8] = {vv0.x, vv0.y, vv0.z, vv0.w, vv1.x, vv1.y, vv1.z, vv1.w};
#pragma unroll
        for (int i = 0; i < 8; ++i) { VT[(oc * 16 + 2 * i) * LS + t] = (bf16)(vw[i] & 0xffffu); VT[(oc * 16 + 2 * i + 1) * LS + t] = (bf16)(vw[i] >> 16); }
        if (t == 0) {
#pragma unroll
            for (int j = 0; j < 8; ++j) { const float dc = __builtin_amdgcn_exp2f(bl[j]); DEC[(size_t)unit * 64 + d0 + j] = dc; ((float*)(lds + L_DECS))[d0 + j] = dc; } }
    }
    __syncthreads();
    { const int ti = wid >> 1;
#pragma unroll
      for (int q2 = 0; q2 < 2; ++q2) { const int sj = 2 * (wid & 1) + q2;
          f32x4 acc = {0.f, 0.f, 0.f, 0.f};
          if (sj <= ti) {
#pragma unroll
              for (int ks = 0; ks < 2; ++ks) { const bf16x8 a = *(const bf16x8*)(QP + (16 * ti + l15) * LS + 32 * ks + 8 * g), bb = *(const bf16x8*)(KP + (16 * sj + l15) * LS + 32 * ks + 8 * g);
                  acc = __builtin_amdgcn_mfma_f32_16x16x32_bf16(a, bb, acc, 0, 0, 0); }
              if (sj == ti) {
#pragma unroll
                  for (int r = 0; r < 4; ++r) if (l15 > 4 * g + r) acc[r] = 0.f; }
          }
#pragma unroll
          for (int r = 0; r < 4; ++r) PP[(16 * ti + 4 * g + r) * LS + 16 * sj + l15] = (bf16)(pkbf(acc[r], 0.f) & 0xffffu);
      } }
    __syncthreads();
    { bf16x8 vb[2];
#pragma unroll
      for (int ks = 0; ks < 2; ++ks) vb[ks] = *(const bf16x8*)(VT + (16 * wid + l15) * LS + 32 * ks + 8 * g);
#pragma unroll
      for (int m = 0; m < 4; ++m) { f32x4 acc = {0.f, 0.f, 0.f, 0.f};
#pragma unroll
          for (int ks = 0; ks < 2; ++ks) { const bf16x8 a = *(const bf16x8*)(PP + (16 * m + l15) * LS + 32 * ks + 8 * g); acc = __builtin_amdgcn_mfma_f32_16x16x32_bf16(a, vb[ks], acc, 0, 0, 0); }
          *(f32x4*)(OI + (size_t)unit * OI_B + (size_t)((wid * 4 + m) * 64 + lane) * 16) = acc; }
#pragma unroll
      for (int db = 0; db < 4; ++db) { f32x4 acc = {0.f, 0.f, 0.f, 0.f};
#pragma unroll
          for (int ks = 0; ks < 2; ++ks) { const bf16x8 a = *(const bf16x8*)(KPT + (16 * db + l15) * LS + 32 * ks + 8 * g); acc = __builtin_amdgcn_mfma_f32_16x16x32_bf16(a, vb[ks], acc, 0, 0, 0); }
          *(f32x4*)(UU + (size_t)unit * UU_B + (size_t)((wid * 4 + db) * 64 + lane) * 16) = acc;
          const f32x4 dcv = *(const f32x4*)((const float*)(lds + L_DECS) + 16 * db + 4 * g);
          Sagg[db] = dcv * Sagg[db] + acc; Dagg[db] = Dagg[db] * dcv; }
    }
}


__device__ __forceinline__ void prep_block(int blk, const bf16* QKV, const float* FG, const float* __restrict__ wgu, const float* __restrict__ bgate,
                                           unsigned char* QPG, unsigned char* OI, unsigned char* UU, float* DEC, unsigned char* AGG, float* DAGG, unsigned char* lds, int& cur_h) {
    f32x4 Sagg[4], Dagg[4];
#pragma unroll
    for (int db = 0; db < 4; ++db) { Sagg[db] = (f32x4){0.f, 0.f, 0.f, 0.f}; Dagg[db] = (f32x4){1.f, 1.f, 1.f, 1.f}; }
    for (int i = 0; i < 8; ++i) prep_unit(blk * 8 + i, QKV, FG, wgu, bgate, QPG, OI, UU, DEC, lds, cur_h, Sagg, Dagg);
    int tid_ = threadIdx.x; asm volatile("" : "+v"(tid_));
    const int lane = tid_ & 63, wid = __builtin_amdgcn_readfirstlane(tid_ >> 6), l15 = lane & 15, g = lane >> 4;
#pragma unroll
    for (int db = 0; db < 4; ++db) { *(f32x4*)(AGG + (size_t)blk * UU_B + (size_t)((wid * 4 + db) * 64 + lane) * 16) = Sagg[db];
        if (wid == 0 && l15 == 0) *(f32x4*)(DAGG + (size_t)blk * 64 + 16 * db + 4 * g) = Dagg[db]; }
}
constexpr int GS = 136;
constexpr int PO_GR = 0, PO_YT = 64 * GS * 2, PO_PART = 2 * 64 * GS * 2, PO_ST = PO_PART + 8 * 64 * 4, PO_END = PO_ST + 128 * LS * 2;
__device__ __forceinline__ void post_block(int u0, int NB, const bf16* QKV, const unsigned char* QPG, const unsigned char* OI, const unsigned char* UU, const float* DEC, const unsigned char* AGG, const float* DAGG, const float* __restrict__ gnorm, bf16* Y, unsigned char* lds) {
    int tid_ = threadIdx.x; asm volatile("" : "+v"(tid_));
    const int tid = tid_, lane = tid & 63, wid = __builtin_amdgcn_readfirstlane(tid >> 6), l15 = lane & 15, g = lane >> 4;
    const int n0 = u0 % NCH, bh = u0 / NCH, h = bh % GH, b = bh / GH;
    bf16* GRs = (bf16*)(lds + PO_GR); bf16* YT = (bf16*)(lds + PO_YT); float* PART = (float*)(lds + PO_PART); bf16* ST = (bf16*)(lds + PO_ST);
    const int t = tid >> 3, oc = tid & 7, e = 16 * wid + l15;
    const float gn = gnorm[e];
    f32x4 Sa[4];
#pragma unroll
    for (int db = 0; db < 4; ++db) Sa[db] = (f32x4){0.f, 0.f, 0.f, 0.f};
    { const int seg0 = bh * (NCH / 8), nseg = n0 / 8;
      for (int i = 0; i < nseg; ++i) {
          f32x4 Ua[4], Da[4];
#pragma unroll
          for (int db = 0; db < 4; ++db) { Ua[db] = *(const f32x4*)(AGG + (size_t)(seg0 + i) * UU_B + (size_t)((wid * 4 + db) * 64 + lane) * 16); Da[db] = *(const f32x4*)(DAGG + (size_t)(seg0 + i) * 64 + 16 * db + 4 * g); }
#pragma unroll
          for (int db = 0; db < 4; ++db) Sa[db] = Da[db] * Sa[db] + Ua[db]; } }
    for (int i = 0; i < NB; ++i) {
        const int unit = u0 + i; const size_t row0 = (size_t)b * S + (size_t)(n0 + i) * 64;
        const u32x4 g0 = *(const u32x4*)(QKV + (row0 + t) * fx::QKVP + fx::P_GR + h * 128 + oc * 16), g1 = *(const u32x4*)(QKV + (row0 + t) * fx::QKVP + fx::P_GR + h * 128 + oc * 16 + 8);
        f32x4 o[4], Uf[4], dv[4]; bf16x8 qa[4][2], sb[2];
#pragma unroll
        for (int m = 0; m < 4; ++m) { o[m] = *(const f32x4*)(OI + (size_t)unit * OI_B + (size_t)((wid * 4 + m) * 64 + lane) * 16);
            Uf[m] = *(const f32x4*)(UU + (size_t)unit * UU_B + (size_t)((wid * 4 + m) * 64 + lane) * 16); dv[m] = *(const f32x4*)(DEC + (size_t)unit * 64 + 16 * m + 4 * g);
#pragma unroll
            for (int ks = 0; ks < 2; ++ks) qa[m][ks] = *(const bf16x8*)(QPG + (size_t)unit * QPG_B + (size_t)((16 * m + l15) * 64 + 32 * ks + 8 * g) * 2); }
#pragma unroll
        for (int db = 0; db < 4; ++db) *(u32x2*)(ST + e * LS + 16 * db + 4 * g) = (u32x2){pkbf(Sa[db][0], Sa[db][1]), pkbf(Sa[db][2], Sa[db][3])};
#pragma unroll
        for (int ks = 0; ks < 2; ++ks) sb[ks] = *(const bf16x8*)(ST + e * LS + 32 * ks + 8 * g);
        *(u32x4*)(GRs + t * GS + oc * 16) = g0; *(u32x4*)(GRs + t * GS + oc * 16 + 8) = g1;
#pragma unroll
        for (int m = 0; m < 4; ++m)
#pragma unroll
            for (int ks = 0; ks < 2; ++ks) o[m] = __builtin_amdgcn_mfma_f32_16x16x32_bf16(qa[m][ks], sb[ks], o[m], 0, 0, 0);
#pragma unroll
        for (int m = 0; m < 4; ++m) { f32x4 q = o[m] * o[m];
#pragma unroll
            for (int off = 1; off < 16; off <<= 1) { q[0] += __shfl_xor(q[0], off); q[1] += __shfl_xor(q[1], off); q[2] += __shfl_xor(q[2], off); q[3] += __shfl_xor(q[3], off); }
            if (l15 == 0) *(f32x4*)(PART + wid * 64 + 16 * m + 4 * g) = q; }
#pragma unroll
        for (int db = 0; db < 4; ++db) Sa[db] = dv[db] * Sa[db] + Uf[db];
        __syncthreads();
#pragma unroll
        for (int m = 0; m < 4; ++m) { f32x4 tot = {0.f, 0.f, 0.f, 0.f};
#pragma unroll
            for (int w = 0; w < 8; ++w) tot += *(const f32x4*)(PART + w * 64 + 16 * m + 4 * g);
#pragma unroll
            for (int r = 0; r < 4; ++r) { const int tt = 16 * m + 4 * g + r; const float rs = rsqrtf(tot[r] * (1.f / GV) + LN_EPS); const float gr = bf2f(GRs[tt * GS + e]);
                const float v = o[m][r] * rs * gn * (gr * __builtin_amdgcn_rcpf(1.f + __builtin_amdgcn_exp2f(-1.4426950408889634f * gr)));
                YT[tt * GS + e] = (bf16)(pkbf(v, 0.f) & 0xffffu); } }
        __syncthreads();
        { const u32x4 y0 = *(const u32x4*)(YT + t * GS + oc * 16), y1 = *(const u32x4*)(YT + t * GS + oc * 16 + 8);
          *(u32x4*)(Y + (row0 + t) * D + 512 + h * GV + oc * 16) = y0; *(u32x4*)(Y + (row0 + t) * D + 512 + h * GV + oc * 16 + 8) = y1; }
        __syncthreads();
    }
}
}
namespace mo {
using namespace nv;
typedef unsigned short bf16;
typedef float f32x4 __attribute__((ext_vector_type(4)));
typedef unsigned u32x4 __attribute__((ext_vector_type(4)));
constexpr int CAP = 8192;
constexpr int NEX = NE + 1;
constexpr int YSH = T * TOPK;
constexpr int L_TB = 132096, L_YB = L_TB + 1040, L_CN = L_YB + 1040, L_UT = 138240, L_RG = 141312;
typedef LAS int* lint;


constexpr int I_EG = NEX * 256, I_ED = NEX * 128, I_EXP = I_EG + I_ED;
struct ExpW { const float* eg; const float* eu; const float* ed; const float* sg; const float* su; const float* sd; bf16* WegT; bf16* WedT; };
__device__ __forceinline__ void cv_decode(int r, const ExpW& X, fx::CvItem& I) {
    if (r < I_EG) { const int e = r >> 8, kb = (r >> 4) & 15, nb = r & 15, c = nb >> 3, sub = nb & 7;
        I.W = (e < NE) ? ((sub < 4 ? X.eg : X.eu) + (size_t)e * D * ED) : (sub < 4 ? X.sg : X.su); I.WT = X.WegT + (size_t)e * 512 * D; I.N = ED; I.K = D; I.k0 = 64 * kb; I.n0 = 32 * nb; I.s0 = 128 * c + 32 * (sub & 3); }
    else { r -= I_EG; const int e = r >> 7, kb = (r >> 5) & 3, nb = r & 31; I.W = (e < NE) ? (X.ed + (size_t)e * ED * D) : X.sd; I.WT = X.WedT + (size_t)e * D * ED; I.N = D; I.K = ED; I.k0 = 64 * kb; I.n0 = 32 * nb; I.s0 = 32 * nb; }
}
__device__ __forceinline__ void expert_conv(const ExpW& X, LAS float* scr, int it0, int step, int lane) {
    int it = it0; fx::CvItem cur, nx; fx::f32x4 v[8], w[8];
    if (it < I_EXP) { cv_decode(it, X, cur); fx::cv_load(cur, v, lane); }
    while (it < I_EXP) { const int itn = it + step; if (itn < I_EXP) { cv_decode(itn, X, nx); fx::cv_load(nx, w, lane); }
        fx::cv_finish(cur, v, scr, lane); cur = nx;
#pragma unroll
        for (int i = 0; i < 8; ++i) v[i] = w[i];
        it = itn; }
}

__device__ __forceinline__ void moe_tables(const int* counts, lint tb, lint yb, lint cn, int lane) {
    int c[4], nt[4]; int st = 0, sy = 0, pt[4], py[4];
#pragma unroll
    for (int i = 0; i < 4; ++i) { c[i] = counts[lane * 4 + i]; c[i] = c[i] > CAP ? CAP : c[i]; nt[i] = (c[i] + 255) >> 8; pt[i] = st; py[i] = sy; st += nt[i]; sy += c[i]; }
    int it = st, iy = sy;
    for (int o = 1; o < 64; o <<= 1) { const int a = __shfl_up(it, o), b = __shfl_up(iy, o); if (lane >= o) { it += a; iy += b; } }
    const int bt = it - st, by = iy - sy;
#pragma unroll
    for (int i = 0; i < 4; ++i) { tb[lane * 4 + i] = bt + pt[i]; yb[lane * 4 + i] = by + py[i]; cn[lane * 4 + i] = c[i]; }
    if (lane == 63) { tb[256] = it; tb[257] = it + T / 256; yb[256] = YSH; cn[256] = T; }
}

__device__ __forceinline__ void route_token2(const float* LG, const float* __restrict__ rbias, int* lcnt, int* TK, float* TW, int t0, int lane) {
    const int l32 = lane & 31, hb = lane & 32, t = t0 + (lane >> 5);
    const float4 la = ((const float4*)(LG + (size_t)t * NE))[2 * l32], lb = ((const float4*)(LG + (size_t)t * NE))[2 * l32 + 1];
    const float4 ra = ((const float4*)rbias)[2 * l32], rb = ((const float4*)rbias)[2 * l32 + 1];
    const float lg[8] = {la.x, la.y, la.z, la.w, lb.x, lb.y, lb.z, lb.w}, rbv[8] = {ra.x, ra.y, ra.z, ra.w, rb.x, rb.y, rb.z, rb.w};
    float sc[8], bv[8];
#pragma unroll
    for (int i = 0; i < 8; ++i) { sc[i] = 1.f / (1.f + expf(-lg[i])); bv[i] = sc[i] + rbv[i]; }
    float m1 = fmaxf(bv[0], bv[1]), m2 = fminf(bv[0], bv[1]);
#pragma unroll
    for (int i = 2; i < 8; ++i) { const float n1 = fmaxf(m1, bv[i]); m2 = fmaxf(fminf(m1, bv[i]), m2); m1 = n1; }
#pragma unroll
    for (int o = 1; o < 4; o <<= 1) { const float p1 = __shfl_xor(m1, o), p2 = __shfl_xor(m2, o); const float n1 = fmaxf(m1, p1); m2 = fmaxf(fminf(m1, p1), fmaxf(m2, p2)); m1 = n1; }
    const float gs = m1 + m2;
    const int myg = l32 >> 2;
    int rank = 0;
#pragma unroll
    for (int g2 = 0; g2 < NG; ++g2) { const float og = __shfl(gs, hb + g2 * 4); if (og > gs || (og == gs && g2 < myg)) ++rank; }
    const bool sel = rank < 4;
    float mv[8];
#pragma unroll
    for (int i = 0; i < 8; ++i) mv[i] = sel ? bv[i] : -INFINITY;
    int mye = 0; float myw = 0.f; float wsum = 0.f;
#pragma unroll
    for (int k = 0; k < TOPK; ++k) {
        float bvv = mv[0]; int bi = 0;
#pragma unroll
        for (int i = 1; i < 8; ++i) if (mv[i] > bvv) { bvv = mv[i]; bi = i; }
        int gi = l32 * 8 + bi;
#pragma unroll
        for (int o = 16; o > 0; o >>= 1) { const float ov = __shfl_xor(bvv, o); const int oi = __shfl_xor(gi, o); if (ov > bvv || (ov == bvv && oi < gi)) { bvv = ov; gi = oi; } }
        const int ol = gi >> 3, oi = gi & 7;
        float s_own = sc[0];
#pragma unroll
        for (int i = 1; i < 8; ++i) s_own = (oi == i) ? sc[i] : s_own;
        const float sw = __shfl(s_own, hb + ol);
        if (l32 == ol) {
#pragma unroll
            for (int i = 0; i < 8; ++i) if (oi == i) mv[i] = -INFINITY; }
        if (l32 == k) { mye = gi; myw = sw; } wsum += sw;
    }
    if (l32 < TOPK) { const int lp = atomicAdd(&lcnt[mye], 1); TK[t * TOPK + l32] = mye | (lp << 9); TW[t * TOPK + l32] = myw * (2.5f / wsum); }
}
__device__ __forceinline__ void route_finish2(const int* lbase, int* list_tok, float* list_gate, int* TK, const float* TW, int t0, int lane) {
    const int l32 = lane & 31, t = t0 + (lane >> 5);
    if (l32 < TOPK) { const int tk = TK[t * TOPK + l32]; const int e = tk & 511, pos = lbase[e] + (tk >> 9);
        if (pos < CAP) { list_tok[e * CAP + pos] = t; list_gate[e * CAP + pos] = TW[t * TOPK + l32]; }
        TK[t * TOPK + l32] = e | (pos << 9); }
}

constexpr float YSC = 16.f;
__device__ __forceinline__ void combine_token(const bf16* H1, const unsigned char* Y, const int* TK, lint yb, const float* __restrict__ g, const float* __restrict__ b, float* out, int t, int lane) {
    typedef float f2 __attribute__((ext_vector_type(2)));
    float v[16], s[16];
    { const u32x4 a = *(const u32x4*)(H1 + (size_t)t * D + 16 * lane), c = *(const u32x4*)(H1 + (size_t)t * D + 16 * lane + 8);
      const unsigned w[8] = {a.x, a.y, a.z, a.w, c.x, c.y, c.z, c.w};
#pragma unroll
      for (int i = 0; i < 8; ++i) { v[2 * i] = ALPHA * __builtin_bit_cast(float, w[i] << 16); v[2 * i + 1] = ALPHA * __builtin_bit_cast(float, w[i] & 0xffff0000u); } }
#pragma unroll
    for (int i = 0; i < 16; ++i) s[i] = 0.f;
    int tk = (lane < TOPK) ? TK[t * TOPK + lane] : 0;
#pragma unroll
    for (int k = 0; k <= TOPK; ++k) {
        size_t yrow;
        if (k < TOPK) { const int x = __shfl(tk, k); yrow = (size_t)(yb[x & 511] + (x >> 9)); } else yrow = (size_t)YSH + t;
        const u32x4 a = *(const u32x4*)(Y + yrow * D + 16 * lane);
        const int w[4] = {(int)a.x, (int)a.y, (int)a.z, (int)a.w};
#pragma unroll
        for (int i = 0; i < 4; ++i) { const f2 lo = __builtin_amdgcn_cvt_pk_f32_fp8(w[i], false), hi = __builtin_amdgcn_cvt_pk_f32_fp8(w[i], true);
            s[4 * i] += lo[0]; s[4 * i + 1] += lo[1]; s[4 * i + 2] += hi[0]; s[4 * i + 3] += hi[1]; }
    }
    float sm = 0.f;
#pragma unroll
    for (int i = 0; i < 16; ++i) { v[i] += s[i] * (1.f / YSC); sm += v[i]; }
    const float mean = fx::wave_sum(sm) * (1.f / D); float q = 0.f;
#pragma unroll
    for (int i = 0; i < 16; ++i) { v[i] -= mean; q += v[i] * v[i]; }
    const float rstd = 1.f / sqrtf(fx::wave_sum(q) * (1.f / D) + LN_EPS);
#pragma unroll
    for (int i = 0; i < 4; ++i) { const f32x4 gg = *(const f32x4*)(g + 16 * lane + 4 * i), bb = *(const f32x4*)(b + 16 * lane + 4 * i);
        f32x4 o; o[0] = v[4 * i] * rstd * gg[0] + bb[0]; o[1] = v[4 * i + 1] * rstd * gg[1] + bb[1]; o[2] = v[4 * i + 2] * rstd * gg[2] + bb[2]; o[3] = v[4 * i + 3] * rstd * gg[3] + bb[3];
        *(f32x4*)(out + (size_t)t * D + 16 * lane + 4 * i) = o; }
}
}

namespace pg8 {
struct RouterSched {
    int rb; const bf16_t* Bt;
    __device__ __forceinline__ bool next(int i, Unit2& u) const { if (i > 0) return false; u.pm = rb; u.pn = 0; u.e = 0; u.cnt = 128; u.jt = 0; u.ui = 0; return true; }
    __device__ __forceinline__ int arow(const Unit2& u, int r) const { return u.pm * 128 + r; }
    __device__ __forceinline__ size_t aoff(const Unit2&) const { return 0; }
    __device__ __forceinline__ const char* bptr(const Unit2&) const { return (const char*)Bt; }
};
struct EpiLogits {
    static constexpr bool PERM = false, AFTER_DRAIN = false;
    float* LG;
    __device__ __forceinline__ void operator()(const f32x4 (&acc)[2][2][4][2], const Unit2& u, int wr, int wc, int fr, int fq) const {
        const int row0 = u.pm * 128 + wr * 64 + fr, col0 = wc * 32 + 4 * fq;
#pragma unroll
        for (int m = 0; m < 4; ++m) { float* rowp = LG + (size_t)(row0 + m * 16) * nv::NE + col0;
#pragma unroll
            for (int bj = 0; bj < 2; ++bj)
#pragma unroll
                for (int n = 0; n < 2; ++n) *(f32x4*)(rowp + bj * HALF + n * 16) = acc[0][bj][m][n]; }
    }
};
template <int PH> struct MoeSched {
    int G, vcu, nrt; mo::lint tb; mo::lint cn; const int* list_tok; const bf16_t* W; mo::lint ut; mo::lint rg;
    static constexpr int NC = PH == 0 ? 2 : 4;
    static constexpr int MAXU = 64;
    __device__ __forceinline__ void build(int lane) const {
        const int L = lane * G + vcu;
        if (lane < MAXU && L < nrt * NC) {
            const int rt = L / NC, c = L % NC;
            int lo = 0, hi = 256;
            while (lo < hi) { const int mid = (lo + hi + 1) >> 1; if (tb[mid] <= rt) lo = mid; else hi = mid - 1; }
            const int e = lo, jt = rt - tb[e], rem = cn[e] - 256 * jt;
            ut[4 * lane] = rt; ut[4 * lane + 1] = c; ut[4 * lane + 2] = e | (jt << 9); ut[4 * lane + 3] = rem < 256 ? rem : 256;
        }
    }
    __device__ __forceinline__ bool next(int i, Unit2& u) const {
        const int L = i * G + vcu; if (i >= MAXU || L >= nrt * NC) return false;
        const int x = ut[4 * i + 2];
        u.pm = __builtin_amdgcn_readfirstlane(ut[4 * i]); u.pn = __builtin_amdgcn_readfirstlane(ut[4 * i + 1]); u.e = __builtin_amdgcn_readfirstlane(x & 511); u.jt = __builtin_amdgcn_readfirstlane(x >> 9);
        u.cnt = __builtin_amdgcn_readfirstlane(ut[4 * i + 3]); u.ui = i; return true;
    }
    __device__ __forceinline__ void fill_rows(const float* list_gate, int tid) const {
        for (int i = 0; i < MAXU; ++i) { const int L = i * G + vcu; if (L >= nrt * NC) break;
            const int x = ut[4 * i + 2], e = x & 511, jt = x >> 9, cnt = ut[4 * i + 3];
            if (tid < 256) { const int r = tid; unsigned v;
                if (e == 256) v = (unsigned)(jt * BM + r) | (0x4180u << 16);
                else if (r < cnt) { const float gsc = mo::YSC * list_gate[e * mo::CAP + jt * BM + r]; v = (unsigned)list_tok[e * mo::CAP + jt * BM + r] | (fx::f2bf(gsc) << 16); }
                else v = 0u;
                rg[i * 256 + r] = (int)v; } }
    }
    __device__ __forceinline__ int arow(const Unit2& u, int r) const {
        if (PH == 1) return u.pm * BM + r;
        return rg[u.ui * 256 + r] & 0x7fff;
    }
    __device__ __forceinline__ size_t aoff(const Unit2& u) const { return PH == 1 ? (size_t)u.pm * (131072 - 32768) : 0; }
    __device__ __forceinline__ const char* bptr(const Unit2& u) const {
        return PH == 0 ? (const char*)(W + ((size_t)u.e * 512 + 256 * u.pn) * 1024) : (const char*)(W + ((size_t)u.e * 1024 + 256 * u.pn) * 256);
    }
};
struct EpiSwiGLU {
    static constexpr bool PERM = true, AFTER_DRAIN = false;
    bf16_t* H; mo::lint rg; int skip;
    __device__ __forceinline__ void operator()(const f32x4 (&acc)[2][2][4][2], const Unit2& u, int wr, int wc, int fr, int fq) const {
        if (skip) return;
        const int col0 = u.pn * 128 + wc * 32 + 8 * fq;
#pragma unroll
        for (int ai = 0; ai < 2; ++ai)
#pragma unroll
            for (int m = 0; m < 4; ++m) { const int r = ai * HALF + wr * 64 + m * 16 + fr;
                const float gt = __builtin_bit_cast(float, (unsigned)rg[u.ui * 256 + r] & 0xffff0000u);
                float hv[8];
#pragma unroll
                for (int n = 0; n < 2; ++n)
#pragma unroll
                    for (int i = 0; i < 4; ++i) { const float gg = acc[ai][0][m][n][i], uu = acc[ai][1][m][n][i]; hv[4 * n + i] = gt * uu * (gg * __builtin_amdgcn_rcpf(1.f + __builtin_amdgcn_exp2f(-1.4426950408889634f * gg))); }
                u32x4 w; w.x = cvt_pk_bf16(hv[0], hv[1]); w.y = cvt_pk_bf16(hv[2], hv[3]); w.z = cvt_pk_bf16(hv[4], hv[5]); w.w = cvt_pk_bf16(hv[6], hv[7]);
                *(u32x4*)(H + (size_t)u.pm * 65536 + (size_t)(col0 >> 6) * 16384 + r * 64 + (col0 & 63)) = w; }
    }
};
struct EpiDown {
    static constexpr bool PERM = true, PERM16 = true, AFTER_DRAIN = false;
    unsigned char* Y; mo::lint yb; int skip;
    __device__ __forceinline__ void operator()(const f32x4 (&acc)[2][2][4][2], const Unit2& u, int wr, int wc, int fr, int fq) const {
        if (skip) return;
        const int col0 = u.pn * BM + wc * 64 + 16 * fq; const int ybase = yb[u.e] + u.jt * BM;
#pragma unroll
        for (int ai = 0; ai < 2; ++ai)
#pragma unroll
            for (int m = 0; m < 4; ++m) { const int r = ai * HALF + wr * 64 + m * 16 + fr;
                if (r < u.cnt) { u32x4 w; unsigned ww[4];
#pragma unroll
                    for (int bj = 0; bj < 2; ++bj)
#pragma unroll
                        for (int n = 0; n < 2; ++n) { const f32x4 v = acc[ai][bj][m][n]; int x = __builtin_amdgcn_cvt_pk_fp8_f32(v[0], v[1], 0, false); x = __builtin_amdgcn_cvt_pk_fp8_f32(v[2], v[3], x, true); ww[2 * bj + n] = (unsigned)x; }
                    w.x = ww[0]; w.y = ww[1]; w.z = ww[2]; w.w = ww[3];
                    *(u32x4*)(Y + (size_t)(ybase + r) * nv::D + col0) = w; } }
    }
};
}
constexpr int NTHR = 512;
constexpr int LDS_BYTES = 163840;
constexpr int MISC_OFF = 131072 + 320;
constexpr size_t MiB = 1u << 20;
constexpr size_t CTL_ZERO_BYTES = 96 * 1024;
constexpr int CW_BAR = 4096;
constexpr int CW_MOE = 16384;
constexpr int CW_FOXQ = 20992;
constexpr int CW_NRM = 20480;
constexpr int NPHASE = 9;
constexpr size_t WS_H1 = 1, WS_WR = 65, WS_STATS = 66, WS_LF = 67, WS_FG = 68, WS_WO = 72, WS_WIN = 74, WS_TK = 81, WS_LTOK = 83, WS_LGATE = 91,
                 WS_WED = 100, WS_HID = 230, WS_GLA = 230, WS_WEG = 416, WS_XN = 673, WS_YBF = 673, WS_QKV = 737, WS_Z1 = 737, WS_LG = 865, WS_Y = 416, WS_END = 992;

struct Args { const float* in[21]; float* out; unsigned char* ws; int ph_lo, ph_hi, li, pad; };

__global__ void __launch_bounds__(NTHR, 2) mega_fwd(Args a) {
    using namespace nv;
    extern __shared__ __attribute__((aligned(16))) unsigned char lds[];
    const int G = gridDim.x, bx = blockIdx.x;
    const int vcu = (G % 8 == 0) ? (bx % 8) * (G / 8) + bx / 8 : bx;
    int tid, lane, wave, vw;
#define DERIVE() do { int t_ = threadIdx.x; asm volatile("" : "+v"(t_)); tid = t_; lane = tid & 63; wave = __builtin_amdgcn_readfirstlane(tid >> 6); vw = vcu * 8 + wave; } while (0)
    DERIVE();
    volatile LAS unsigned* MISC = (volatile LAS unsigned*)((LAS unsigned char*)lds + MISC_OFF);
    for (int u = tid; u < (LDS_BYTES - 131072) / 4; u += NTHR) ((LAS unsigned*)((LAS unsigned char*)lds + 131072))[u] = 0u;
    __syncthreads();
    unsigned char* ws = a.ws;
    unsigned* ctl = (unsigned*)ws;
    XcdBarrier bar = xcd_barrier_post(ctl + CW_BAR + a.li * XCD_BAR_WORDS, MISC + 8);
    const float* x = a.in[0];
    const float* ln_in_g = a.in[1]; const float* ln_in_b = a.in[2];
    const float* w_in = a.in[3]; const float* b_fgate = a.in[4];
    const float* w_gate_up = a.in[5]; const float* b_gate = a.in[6]; const float* g_gla = a.in[7];
    const float* w_out = a.in[8]; const float* ln1_g = a.in[9]; const float* ln1_b = a.in[10];
    const float* w_router = a.in[11]; const float* rbias = a.in[12];
    const float* w_eg = a.in[13]; const float* w_eu = a.in[14]; const float* w_ed = a.in[15];
    const float* w_sg = a.in[16]; const float* w_su = a.in[17]; const float* w_sd = a.in[18];
    const float* ln2_g = a.in[19]; const float* ln2_b = a.in[20];
    float* out = a.out;
    int* counts = (int*)(ctl + CW_MOE);
    fx::bf16* H1 = (fx::bf16*)(ws + WS_H1 * MiB);
    fx::bf16* WrT = (fx::bf16*)(ws + WS_WR * MiB);
    float* stats = (float*)(ws + WS_STATS * MiB);
    float* LF = (float*)(ws + WS_LF * MiB);
    float* FG = (float*)(ws + WS_FG * MiB);
    fx::bf16* WoT = (fx::bf16*)(ws + WS_WO * MiB);
    fx::bf16* WinT = (fx::bf16*)(ws + WS_WIN * MiB);
    int* TK = (int*)(ws + WS_TK * MiB);
    float* TW = (float*)(ws + (WS_TK + 1) * MiB);
    int* list_tok = (int*)(ws + WS_LTOK * MiB);
    float* list_gate = (float*)(ws + WS_LGATE * MiB);
    fx::bf16* WedT = (fx::bf16*)(ws + WS_WED * MiB);
    fx::bf16* HID = (fx::bf16*)(ws + WS_HID * MiB);
    unsigned char* QPG = ws + WS_GLA * MiB; unsigned char* OIb = ws + (WS_GLA + 16) * MiB; unsigned char* UUb = ws + (WS_GLA + 80) * MiB; float* DECb = (float*)(ws + (WS_GLA + 144) * MiB); unsigned char* AGGb = ws + (WS_GLA + 145) * MiB; float* DAGGb = (float*)(ws + (WS_GLA + 153) * MiB);
    fx::bf16* WegT = (fx::bf16*)(ws + WS_WEG * MiB);
    fx::bf16* XN = (fx::bf16*)(ws + WS_XN * MiB);
    fx::bf16* Ybf = (fx::bf16*)(ws + WS_YBF * MiB);
    fx::bf16* QKV = (fx::bf16*)(ws + WS_QKV * MiB);
    fx::bf16* MIX = (fx::bf16*)(ws + WS_Z1 * MiB);
    float* LG = (float*)(ws + WS_LG * MiB);
    unsigned char* YA = ws + WS_Y * MiB;
    mo::lint tb = (mo::lint)((LAS unsigned char*)lds + mo::L_TB), yb = (mo::lint)((LAS unsigned char*)lds + mo::L_YB), cn = (mo::lint)((LAS unsigned char*)lds + mo::L_CN), ut = (mo::lint)((LAS unsigned char*)lds + mo::L_UT), rg = (mo::lint)((LAS unsigned char*)lds + mo::L_RG);

    const int lo = a.ph_lo, hi = a.ph_hi;
#define IN(k) (lo <= (k) && (k) < hi)
#define SEAM(k) do { if (IN(k) && IN((k) + 1)) xcd_barrier(bar); DERIVE(); } while (0)
    const int GW = G * 8;
#ifndef STG7
#define STG7 0
#endif
#ifndef STG8
#define STG8 0
#endif
#define STAGGER(q) do { if ((q) > 0) { const unsigned long long t0_ = __builtin_amdgcn_s_memrealtime(); const unsigned long long d_ = (unsigned long long)((vcu & 3) * (q)); while (__builtin_amdgcn_s_memrealtime() - t0_ < d_) __builtin_amdgcn_s_sleep(8); } } while (0)

    if (IN(0)) {
        LAS float* scr = (LAS float*)((LAS unsigned char*)lds + wave * 16384);
        constexpr int I_IN = 16 * (fx::NIN / 32), I_OUT = 16 * 32, I_R = 16 * 8, I_SMALL = I_IN + I_OUT + I_R;
        for (int it = vw; it < I_SMALL; it += GW) {
            int r = it;
            if (r < I_IN) { fx::transpose_item(w_in, D, INW, WinT, scr, r / (fx::NIN / 32), r % (fx::NIN / 32), lane, [](int d) { return fx::inproj_src(d); }); continue; } r -= I_IN;
            if (r < I_OUT) { fx::transpose_item(w_out, D, D, WoT, scr, r / 32, r % 32, lane, [](int d) { return d; }); continue; } r -= I_OUT;
            fx::transpose_item(w_router, D, NE, WrT, scr, r / 8, r % 8, lane, [](int d) { return d; });
        }
        for (int r = vw * 4; r < T; r += GW * 4) fx::ln_rows_bf16<4>(x + (size_t)r * D, ln_in_g, ln_in_b, XN + (size_t)r * D, lane, stats + 2 * (size_t)r);
    }
    SEAM(0);
    if (IN(1)) {
        const mo::ExpW XW{w_eg, w_eu, w_ed, w_sg, w_su, w_sd, WegT, WedT};
#ifndef MIXG
#define MIXG 2
#endif
        { const int slot = vcu % MIXG; pg8::StaticOrder S; S.init(T, fx::NIN, G, bx);
          const int nun = (S.nwg - bx + G - 1) / G, nb = (MIXG > 1) ? nun * slot / (MIXG - 1) : nun;
          pg8::Gemm g{XN, WinT, T, fx::NIN, D, D}; pg8::EpiInProj E{QKV, FG, LF, b_fgate, ctl + CW_NRM};
          if (nb > 0) { pg8::RangeOrder R{S, 0, nb}; pg8::gemm_phase<pg8::EpiInProj, pg8::RangeOrder, true, true>((LAS unsigned char*)lds, g, R, E); DERIVE(); }
          mo::expert_conv(XW, (LAS float*)((LAS unsigned char*)lds + wave * 16384), vw, GW, lane); __syncthreads(); DERIVE();
          if (nb < nun) { pg8::RangeOrder R{S, nb, nun - nb}; pg8::gemm_phase<pg8::EpiInProj, pg8::RangeOrder, true, true>((LAS unsigned char*)lds, g, R, E); } }
    }
    SEAM(1);
    if (IN(2)) {
        int cur_h = -1;
        for (int blk = vcu; blk < gl::NUNIT / 8; blk += G) gl::prep_block(blk, QKV, FG, w_gate_up, b_gate, QPG, OIb, UUb, DECb, AGGb, DAGGb, lds, cur_h);
    }
    SEAM(2);
    if (IN(3)) {
        for (int blk = vcu; blk < gl::NUNIT / 8; blk += G) gl::post_block(blk * 8, 8, QKV, QPG, OIb, UUb, DECb, AGGb, DAGGb, g_gla, Ybf, lds);
        { const attn_body::AttnTensors AT{(const attn_body::bf16*)(QKV + fx::P_FQ), (const attn_body::bf16*)(QKV + fx::P_FK), (const attn_body::bf16*)(QKV + fx::P_FV), (attn_body::bf16*)Ybf, LF, ctl + CW_NRM};
          attn_body::attn_phase_dyn<8>((char*)lds, AT, ctl + CW_FOXQ, (volatile int*)(lds + 140288), (G % 8 == 0) ? vcu / (G / 8) : vcu % 8); }
    }
    SEAM(3);
    if (IN(4)) {
        pg8::DenseSched DS; DS.so.init(T, D, G, bx); DS.Bt = WoT; DS.ldb = D;
        pg8::EpiPlainBf16 E{MIX, D};
        pg8::gemm_phase2<pg8::EpiPlainBf16, pg8::DenseSched>((LAS unsigned char*)lds, Ybf, D, D, D, DS, E);
    }
    SEAM(4);
    if (IN(5)) {
        int* lcnt = (int*)(lds + 136192); int* lbase = lcnt + 256;
        for (int rb = vcu; rb < T / 128; rb += G) {
            if (tid < 256) lcnt[tid] = 0;
            for (int r = wave * 16; r < wave * 16 + 16; r += 4) { const size_t row = (size_t)rb * 128 + r;
                fx::ln1_rows_bf16<4>(x + row * D, stats + 2 * row, ln_in_g, ln_in_b, MIX + row * D, ln1_g, ln1_b, H1 + row * D, ALPHA, lane); }
            asm volatile("s_waitcnt vmcnt(0)" ::: "memory"); __syncthreads();
            { pg8::RouterSched RS{rb, WrT}; pg8::EpiLogits E{LG};
              pg8::gemm_phase2<pg8::EpiLogits, pg8::RouterSched>((LAS unsigned char*)lds, H1, D, D, D, RS, E); }
            DERIVE();
            for (int t = rb * 128 + wave * 2; t < rb * 128 + 128; t += 16) mo::route_token2(LG, rbias, lcnt, TK, TW, t, lane);
            __syncthreads();
            if (tid < 256) { const int c = lcnt[tid]; lbase[tid] = c ? atomicAdd(&counts[tid], c) : 0; }
            __syncthreads();
            for (int t = rb * 128 + wave * 2; t < rb * 128 + 128; t += 16) mo::route_finish2(lbase, list_tok, list_gate, TK, TW, t, lane);
            __syncthreads();
        }
    }
    SEAM(5);
    if (IN(6)) {
        if (wave == 0) mo::moe_tables(counts, tb, yb, cn, lane);
        __syncthreads();
        STAGGER(STG7);
        pg8::MoeSched<0> MS{G, vcu, tb[257], tb, cn, list_tok, WegT, ut, rg}; if (wave == 0) MS.build(lane); __syncthreads(); MS.fill_rows(list_gate, tid); __syncthreads(); pg8::EpiSwiGLU E{HID, rg, a.pad};
        pg8::gemm_phase2<pg8::EpiSwiGLU, pg8::MoeSched<0>>((LAS unsigned char*)lds, H1, D, D, D, MS, E);
    }
    SEAM(6);
    if (IN(7)) {
        if (wave == 0) mo::moe_tables(counts, tb, yb, cn, lane);
        __syncthreads();
        STAGGER(STG8);
        pg8::MoeSched<1> MS{G, vcu, tb[257], tb, cn, list_tok, WedT, ut, rg}; if (wave == 0) MS.build(lane); __syncthreads(); pg8::EpiDown E{YA, yb, a.pad};
        pg8::gemm_phase2<pg8::EpiDown, pg8::MoeSched<1>>((LAS unsigned char*)lds, HID, 64, ED, ED, MS, E, 32768);
    }
    SEAM(7);
    if (IN(8)) {
        if (wave == 0) mo::moe_tables(counts, tb, yb, cn, lane);
        __syncthreads();
        for (int t = vw; t < T; t += GW) mo::combine_token(H1, YA, TK, yb, ln2_g, ln2_b, out, t, lane);
    }
#undef IN
#undef SEAM
}

extern "C" void kernel_launch(void* const* d_in, const int* in_sizes, int n_in, void* d_out, int out_size, void* d_ws, size_t ws_size, hipStream_t stream) {
    static int grid = 0;
    if (grid == 0) {
        if (n_in != 21 || out_size != nv::T * nv::D || ws_size < WS_END * MiB) { fprintf(stderr, "kernel_launch: unexpected shapes n_in=%d out=%d ws=%zu\n", n_in, out_size, ws_size); grid = -1; return; }
        int dev = 0, cus = 0;
        if (hipGetDevice(&dev) != hipSuccess || hipDeviceGetAttribute(&cus, hipDeviceAttributeMultiprocessorCount, dev) != hipSuccess) { grid = -1; return; }
        if (hipFuncSetAttribute((const void*)mega_fwd, hipFuncAttributeMaxDynamicSharedMemorySize, LDS_BYTES) != hipSuccess) { fprintf(stderr, "kernel_launch: hipFuncSetAttribute failed\n"); grid = -1; return; }
        grid = cus;
    }
    if (grid < 0) return;
    if (hipMemsetAsync(d_ws, 0, CTL_ZERO_BYTES, stream) != hipSuccess) return;
    Args a{};
    for (int i = 0; i < 21; ++i) a.in[i] = (const float*)d_in[i];
    a.out = (float*)d_out; a.ws = (unsigned char*)d_ws; a.ph_lo = 0; a.ph_hi = NPHASE; a.li = 0;
#ifdef REPEAT_PH
    a.ph_hi = REPEAT_PH + 1; hipLaunchKernelGGL(mega_fwd, dim3(grid), dim3(NTHR), LDS_BYTES, stream, a);
    if (REPEAT_PH == 3) hipMemsetAsync((char*)d_ws + CW_FOXQ * 4, 0, 256, stream);
    if (REPEAT_PH == 5) hipMemsetAsync((char*)d_ws + CW_MOE * 4, 0, 4096, stream);
    a.ph_lo = REPEAT_PH; a.ph_hi = NPHASE; a.li = 1;
#ifdef REPEAT_NOEPI
    a.ph_hi = REPEAT_PH + 1; a.pad = 1; hipLaunchKernelGGL(mega_fwd, dim3(grid), dim3(NTHR), LDS_BYTES, stream, a); a.pad = 0; a.ph_lo = REPEAT_PH + 1; a.ph_hi = NPHASE; a.li = 2;
#endif
#endif
    hipLaunchKernelGGL(mega_fwd, dim3(grid), dim3(NTHR), LDS_BYTES, stream, a);
}
```

```cpp
#include <hip/hip_runtime.h>
#include <cstdio>
#include <cstdint>
#include <cmath>

#define LAS __attribute__((address_space(3)))
#define GAS __attribute__((address_space(1)))

#define XB_TMO      128
#define XB_XCNT(j)  (256  + 64 * (j))
#define XB_XSUB(j)  (1280 + 64 * (j))
#define XB_XGEN(j)  (2304 + 64 * (j))
#define XB_TOP      3328
#define XB_TOPGEN   3392
#define XCD_BAR_WORDS 3456
#define XB_SPIN_CAP (1u << 27)
__device__ __forceinline__ unsigned xb_ld(unsigned* p)              { return __hip_atomic_load(p, __ATOMIC_RELAXED, __HIP_MEMORY_SCOPE_AGENT); }
__device__ __forceinline__ unsigned xb_add(unsigned* p, unsigned v) { return __hip_atomic_fetch_add(p, v, __ATOMIC_RELAXED, __HIP_MEMORY_SCOPE_AGENT); }
__device__ __forceinline__ unsigned xb_xcc_id() { return (unsigned)__builtin_amdgcn_s_getreg((3 << 11) | 20) & 0xFu; }
#define XB_SPIN(cond, bar) do { unsigned _sp = 0; while (cond) { __builtin_amdgcn_s_sleep(1); \
    if ((++_sp & 255u) == 0u) { if (xb_ld(&(bar)[XB_TMO])) break; if (_sp > XB_SPIN_CAP) { atomicAdd(&(bar)[XB_TMO], 1u); break; } } } } while (0)
struct XcdBarrier { unsigned* bar; unsigned x; volatile LAS unsigned* st; };
__device__ __forceinline__ XcdBarrier xcd_barrier_post(unsigned* bar, volatile LAS unsigned* st) {
    XcdBarrier b; b.bar = bar; b.x = xb_xcc_id(); b.st = st;
    if (threadIdx.x == 0) (void)xb_add(&bar[XB_XCNT(b.x)], 1u);
    return b;
}
__device__ __forceinline__ void xcd_barrier_complete(unsigned* bar, unsigned x, unsigned& nloc, unsigned& nx) {
    const unsigned G = gridDim.x * gridDim.y * gridDim.z;
    unsigned sum, cnt, mine, sp = 0u;
    for (;;) {
        sum = 0u; cnt = 0u; mine = 0u;
#pragma unroll
        for (unsigned j = 0; j < 16; ++j) { const unsigned c = xb_ld(&bar[XB_XCNT(j)]); sum += c; cnt += (c > 0u) ? 1u : 0u; mine = (j == x) ? c : mine; }
        if (sum == G) break;
        __builtin_amdgcn_s_sleep(1);
        if ((++sp & 255u) == 0u) { if (xb_ld(&bar[XB_TMO])) break; if (sp > XB_SPIN_CAP) { atomicAdd(&bar[XB_TMO], 1u); break; } }
    }
    nloc = mine > 0u ? mine : 1u; nx = cnt > 0u ? cnt : 1u;
}
__device__ __forceinline__ void xcd_barrier(const XcdBarrier& b) {
    asm volatile("s_waitcnt vmcnt(0)" ::: "memory");
    __syncthreads();
    if (threadIdx.x == 0) {
        unsigned* bar = b.bar;
        __builtin_amdgcn_s_waitcnt(0);
        unsigned nloc = b.st[0], nx = b.st[1];
        if (nloc == 0u) { xcd_barrier_complete(bar, b.x, nloc, nx); b.st[0] = nloc; b.st[1] = nx; }
        const unsigned old = xb_add(&bar[XB_XSUB(b.x)], 1u);
        const unsigned gen = old / nloc;
        if (old + 1u == (gen + 1u) * nloc) {
            __builtin_amdgcn_fence(__ATOMIC_RELEASE, "agent");
            asm volatile("s_waitcnt vmcnt(0)" ::: "memory");
            const unsigned og = xb_add(&bar[XB_TOP], 1u);
            const unsigned tg = og / nx;
            if (og + 1u == (tg + 1u) * nx) xb_add(&bar[XB_TOPGEN], 1u);
            else XB_SPIN(xb_ld(&bar[XB_TOPGEN]) == tg, bar);
            __builtin_amdgcn_fence(__ATOMIC_ACQUIRE, "agent");
            xb_add(&bar[XB_XGEN(b.x)], 1u);
            asm volatile("s_waitcnt vmcnt(0)" ::: "memory");
        } else {
            XB_SPIN(xb_ld(&bar[XB_XGEN(b.x)]) == gen, bar);
            __builtin_amdgcn_fence(__ATOMIC_ACQUIRE, "agent");
            asm volatile("s_waitcnt vmcnt(0)" ::: "memory");
        }
    }
    __syncthreads();
}
namespace pg8 {
#define PG8_LAS __attribute__((address_space(3)))
typedef unsigned short bf16_t;
typedef short bf16x8 __attribute__((ext_vector_type(8)));
typedef float f32x4 __attribute__((ext_vector_type(4)));
typedef unsigned u32x4 __attribute__((ext_vector_type(4)));
constexpr int BM = 256, BK = 64, HALF = 128, HTB = HALF * BK * 2  , STAGE_BYTES = 8 * HTB, NXCD = 8, WGM = 8;

__host__ __device__ __forceinline__ int lds_byte(int r, int c) { const int st = (r >> 4) * 2 + (c >> 5), rr = r & 15, cc = c & 31, ob = rr * 64 + cc * 2; return st * 1024 + (ob ^ (((ob >> 9) & 1) << 5)); }
__host__ __device__ __forceinline__ void stage_rc(int b, int& R, int& C) { const int st = b / 1024, sb = b % 1024, swz = sb ^ (((sb >> 9) & 1) << 5); R = (st >> 1) * 16 + swz / 64; C = (st & 1) * 32 + (swz % 64) / 2; }
__host__ __device__ __forceinline__ int perm32(int rho) { const int n = rho >> 4, i = rho & 15; return 8 * (i >> 2) + 4 * n + (i & 3); }

struct Unit { int pm, pn; };
struct Gemm { const bf16_t* A; const bf16_t* Bt; int M, N, K, lda; };

struct StaticOrder {
    int nM, nN, nwg, G, c;
    __host__ __device__ void init(int M, int N, int G_, int c_) { nM = M / BM; nN = N / BM; nwg = nM * nN; G = G_; c = c_; }
    __host__ __device__ bool next(int i, Unit& u) const {
        const long L = (long)i * G + c; if (L >= nwg) return false;
        int wgid = (int)L; { const int q = nwg / NXCD, r = nwg % NXCD, xcd = wgid % NXCD, off = wgid / NXCD; wgid = (xcd < r ? xcd * (q + 1) : r * (q + 1) + (xcd - r) * q) + off; }
        const int nig = WGM * nN, gid = wgid / nig, fm = gid * WGM, gsz = (nM - fm) < WGM ? (nM - fm) : WGM;
        u.pm = fm + ((wgid % nig) % gsz); u.pn = (wgid % nig) / gsz; return true;
    }
    __device__ __forceinline__ void a_ready(const Unit&) const {}
    __device__ __forceinline__ void done(const Unit&) const {}
};

struct RangeOrder {
    StaticOrder so; int i0, n;
    __host__ __device__ bool next(int i, Unit& u) const { return i < n && so.next(i0 + i, u); }
    __device__ __forceinline__ void a_ready(const Unit&) const {}
    __device__ __forceinline__ void done(const Unit&) const {}
};
__device__ __forceinline__ unsigned cvt_pk_bf16(float lo, float hi) { unsigned r; asm volatile("v_cvt_pk_bf16_f32 %0, %1, %2" : "=v"(r) : "v"(lo), "v"(hi)); return r; }
typedef float f32x2 __attribute__((ext_vector_type(2)));
__device__ __forceinline__ f32x2 gelu_pk(f32x2 v) {
    const f32x2 av = __builtin_elementwise_abs(v), d = av * 0.2316418882f + 1.0f;
    f32x2 t; t.x = __builtin_amdgcn_rcpf(d.x); t.y = __builtin_amdgcn_rcpf(d.y);
    f32x2 q = t * 0.5307027145f + (-0.7265760135f); q = q * t + 0.7107068705f; q = q * t + (-0.142248368f); q = q * t + 0.127414796f; q = q * t;
    const f32x2 s = (v * v) * (-0.72134752044f);
    f32x2 e; e.x = __builtin_amdgcn_exp2f(s.x); e.y = __builtin_amdgcn_exp2f(s.y);
    const f32x2 m = v * (q * e), r = v - m;
    f32x2 o; o.x = v.x < 0.f ? m.x : r.x; o.y = v.y < 0.f ? m.y : r.y; return o;
}

template <int ACT  > struct EpiBf16 {
    static constexpr bool PERM = true, AFTER_DRAIN = false; static_assert(ACT == 0 || ACT == 1, "EpiBf16: ACT is 0 (none) or 1 (gelu_pk)");
    bf16_t* O; int ldc; const float* bias; int split_cols; size_t split_stride; float scale0;
    __device__ __forceinline__ void operator()(const f32x4 (&acc)[2][2][4][2], const Unit& u, int wr, int wc, int fr, int fq) const {
        const int row0 = u.pm * BM + wr * 64 + fr; int colt = u.pn * BM; bf16_t* base = O;
        float sc = 1.f; if (split_cols) { const int t = colt / split_cols; base += (size_t)t * split_stride; colt -= t * split_cols; if (t == 0) sc = scale0; }
        const int col0 = colt + wc * 32 + 8 * fq, bcol0 = u.pn * BM + wc * 32 + 8 * fq;
        f32x4 bv[2][2];
#pragma unroll
        for (int bj = 0; bj < 2; ++bj)
#pragma unroll
            for (int n = 0; n < 2; ++n) bv[bj][n] = bias ? *(const f32x4*)(bias + bcol0 + bj * HALF + 4 * n) : (f32x4){0.f, 0.f, 0.f, 0.f};
#pragma unroll
        for (int ai = 0; ai < 2; ++ai)
#pragma unroll
            for (int m = 0; m < 4; ++m) { bf16_t* rowp = base + (size_t)(row0 + ai * HALF + m * 16) * ldc + col0;
#pragma unroll
                for (int bj = 0; bj < 2; ++bj) { f32x4 v0 = acc[ai][bj][m][0] + bv[bj][0], v1 = acc[ai][bj][m][1] + bv[bj][1];
                    if (ACT == 1) { f32x2 a = gelu_pk((f32x2){v0[0], v0[1]}), b = gelu_pk((f32x2){v0[2], v0[3]}), c = gelu_pk((f32x2){v1[0], v1[1]}), d = gelu_pk((f32x2){v1[2], v1[3]});
                        v0 = (f32x4){a.x, a.y, b.x, b.y}; v1 = (f32x4){c.x, c.y, d.x, d.y}; }
                    v0 = v0 * sc; v1 = v1 * sc; u32x4 w; w.x = cvt_pk_bf16(v0[0], v0[1]); w.y = cvt_pk_bf16(v0[2], v0[3]); w.z = cvt_pk_bf16(v1[0], v1[1]); w.w = cvt_pk_bf16(v1[2], v1[3]);
                    *(u32x4*)(rowp + bj * HALF) = w; } }
    }
};

template <class Epi, class Sched, bool ALIGN_EPI = false, bool SP2 = false>
__device__ __forceinline__ void gemm_phase(PG8_LAS unsigned char* lds, const Gemm g, const Sched& S, const Epi& E) {
    const int tid = threadIdx.x, wid = __builtin_amdgcn_readfirstlane(tid >> 6), lane = tid & 63, wr = wid >> 2, wc = wid & 3, fr = lane & 15, fq = lane >> 4;
    const int K = g.K, nt = K / BK;
    unsigned voffA[2], voffB[2];
#pragma unroll
    for (int i = 0; i < 2; ++i) { int R, C; stage_rc(tid * 16 + i * 8192, R, C); const int Rb = Epi::PERM ? ((R & ~31) + perm32(R & 31)) : R;
        voffA[i] = (unsigned)(R * g.lda + C) * 2u; voffB[i] = (unsigned)(Rb * K + C) * 2u; }
    const size_t kstep = (size_t)(BK * 2);
    const size_t hstepA = (size_t)HALF * g.lda * 2, hstepB = (size_t)HALF * K * 2;
    const size_t tstepA = 2 * hstepA, tstepB = 2 * hstepB;
    const unsigned ldsw = (unsigned)wid * 1024u;
    const int aoff = lds_byte(wr * 64 + fr, fq * 8), boff = lds_byte(wc * 32 + fr, fq * 8);
#define PG8_SA(b, h) (((b) * 2 + (h)) * HTB)
#define PG8_SB(b, h) ((4 + (b) * 2 + (h)) * HTB)
#define PG8_STAGE(bufoff, gbase, voff) do { _Pragma("unroll") for (int _i = 0; _i < 2; ++_i) \
        __builtin_amdgcn_global_load_lds((const unsigned*)((const char*)(gbase) + (voff)[_i]), (PG8_LAS unsigned*)(lds + (bufoff) + ldsw + _i * 8192), 16, 0, 0); } while (0)
#define PG8_LDA(dst, b, h) do { _Pragma("unroll") for (int m = 0; m < 4; ++m) _Pragma("unroll") for (int k = 0; k < 2; ++k) dst[m][k] = *(const PG8_LAS bf16x8*)(lds + PG8_SA(b, h) + aoff + m * 2048 + k * 1024); } while (0)
#define PG8_LDB(dst, b, h) do { _Pragma("unroll") for (int n = 0; n < 2; ++n) _Pragma("unroll") for (int k = 0; k < 2; ++k) dst[n][k] = *(const PG8_LAS bf16x8*)(lds + PG8_SB(b, h) + boff + n * 2048 + k * 1024); } while (0)
#define PG8_MMA(ai, bj, At, Bt) do { __builtin_amdgcn_s_setprio(1); _Pragma("unroll") for (int m = 0; m < 4; ++m) _Pragma("unroll") for (int n = 0; n < 2; ++n) _Pragma("unroll") for (int k = 0; k < 2; ++k) \
        acc[ai][bj][m][n] = __builtin_amdgcn_mfma_f32_16x16x32_bf16(Bt[n][k], At[m][k], acc[ai][bj][m][n], 0, 0, 0); __builtin_amdgcn_s_setprio(0); } while (0)
#define PG8_WAIT_V(n) asm volatile("s_waitcnt vmcnt(" #n ")" ::: "memory")
#define PG8_WAIT_L(n) asm volatile("s_waitcnt lgkmcnt(" #n ")" ::: "memory")
#define PG8_BAR __builtin_amdgcn_s_barrier()
#define PG8_SCHED __builtin_amdgcn_sched_barrier(0)
    Unit cur, nxt; int ui = 0;
    if (!S.next(0, cur)) return;
    f32x4 acc[2][2][4][2];
#pragma unroll
    for (int a = 0; a < 2; ++a)
#pragma unroll
        for (int b = 0; b < 2; ++b)
#pragma unroll
            for (int m = 0; m < 4; ++m)
#pragma unroll
                for (int n = 0; n < 2; ++n) acc[a][b][m][n] = (f32x4){0.f, 0.f, 0.f, 0.f};
    bf16x8 At[4][2], B0[2][2], B1[2][2];
    const char* cA = (const char*)g.A + (size_t)cur.pm * tstepA; const char* cB = (const char*)g.Bt + (size_t)cur.pn * tstepB;
    S.a_ready(cur);
    if constexpr (SP2) {
        PG8_STAGE(PG8_SB(0, 0), cB, voffB); PG8_STAGE(PG8_SB(0, 1), cB + hstepB, voffB); PG8_STAGE(PG8_SA(0, 0), cA, voffA); PG8_STAGE(PG8_SA(0, 1), cA + hstepA, voffA);
        if (wr == 1) PG8_BAR;
        PG8_WAIT_V(2); PG8_BAR;
        PG8_STAGE(PG8_SB(1, 0), cB + kstep, voffB); PG8_STAGE(PG8_SA(1, 0), cA + kstep, voffA); PG8_STAGE(PG8_SB(1, 1), cB + hstepB + kstep, voffB);
        PG8_WAIT_V(6); PG8_BAR;
    } else {
        PG8_STAGE(PG8_SB(0, 0), cB, voffB); PG8_STAGE(PG8_SA(0, 0), cA, voffA); PG8_STAGE(PG8_SB(0, 1), cB + hstepB, voffB); PG8_STAGE(PG8_SA(0, 1), cA + hstepA, voffA);
        if (wr == 1) PG8_BAR;
        PG8_WAIT_V(4); PG8_BAR;
        PG8_STAGE(PG8_SB(1, 0), cB + kstep, voffB); PG8_STAGE(PG8_SA(1, 0), cA + kstep, voffA); PG8_STAGE(PG8_SB(1, 1), cB + hstepB + kstep, voffB);
        PG8_WAIT_V(6); PG8_BAR;
    }
    for (;;) {
        const bool has_next = S.next(ui + 1, nxt);
        const char* nA = has_next ? (const char*)g.A + (size_t)nxt.pm * tstepA : cA; const char* nB = has_next ? (const char*)g.Bt + (size_t)nxt.pn * tstepB : cB;
        for (int t = 0; t < nt; t += 2) {
            const bool last = (t == nt - 2);
            const char* a1 = cA + (size_t)(t + 1) * kstep;
            const char* a2 = last ? nA : cA + (size_t)(t + 2) * kstep; const char* b2 = last ? nB : cB + (size_t)(t + 2) * kstep;
            const char* a3 = a2 + kstep; const char* b3 = b2 + kstep;
            if (last && has_next) S.a_ready(nxt);
            if constexpr (SP2) {
            PG8_LDB(B0, 0, 0); PG8_LDB(B1, 0, 1); PG8_SCHED; PG8_LDA(At, 0, 0); PG8_STAGE(PG8_SA(1, 1), a1 + hstepA, voffA);
            PG8_WAIT_V(8); PG8_WAIT_L(0); PG8_BAR; PG8_MMA(0, 0, At, B0); PG8_MMA(0, 1, At, B1); PG8_BAR; PG8_SCHED;
            PG8_LDA(At, 0, 1); PG8_STAGE(PG8_SB(0, 0), b2, voffB); PG8_STAGE(PG8_SB(0, 1), b2 + hstepB, voffB); PG8_STAGE(PG8_SA(0, 0), a2, voffA);
            PG8_WAIT_V(8); PG8_WAIT_L(0); PG8_BAR; PG8_MMA(1, 0, At, B0); PG8_MMA(1, 1, At, B1); PG8_BAR; PG8_SCHED;
            PG8_LDB(B0, 1, 0); PG8_LDB(B1, 1, 1); PG8_SCHED; PG8_LDA(At, 1, 0); PG8_STAGE(PG8_SA(0, 1), a2 + hstepA, voffA);
            PG8_WAIT_V(8); PG8_WAIT_L(0); PG8_BAR; PG8_MMA(0, 0, At, B0); PG8_MMA(0, 1, At, B1); PG8_BAR; PG8_SCHED;
            PG8_LDA(At, 1, 1); PG8_STAGE(PG8_SB(1, 0), b3, voffB); PG8_STAGE(PG8_SB(1, 1), b3 + hstepB, voffB); PG8_STAGE(PG8_SA(1, 0), a3, voffA);
            PG8_WAIT_V(8); PG8_WAIT_L(0); PG8_BAR; PG8_MMA(1, 0, At, B0); PG8_MMA(1, 1, At, B1); PG8_BAR; PG8_SCHED;
            } else {
            PG8_LDB(B0, 0, 0); PG8_SCHED; PG8_LDA(At, 0, 0); PG8_STAGE(PG8_SA(1, 1), a1 + hstepA, voffA);
            PG8_WAIT_L(8); PG8_BAR; PG8_WAIT_L(0); PG8_MMA(0, 0, At, B0); PG8_BAR; PG8_SCHED;
            PG8_LDB(B1, 0, 1); PG8_STAGE(PG8_SB(0, 0), b2, voffB);
            PG8_BAR; PG8_WAIT_L(0); PG8_MMA(0, 1, At, B1); PG8_BAR;
            PG8_LDA(At, 0, 1); PG8_STAGE(PG8_SA(0, 0), a2, voffA);
            PG8_BAR; PG8_WAIT_L(0); PG8_MMA(1, 0, At, B0); PG8_BAR; PG8_SCHED;
            PG8_STAGE(PG8_SB(0, 1), b2 + hstepB, voffB);
            PG8_WAIT_V(6); PG8_BAR; PG8_MMA(1, 1, At, B1); PG8_BAR;
            PG8_LDB(B0, 1, 0); PG8_SCHED; PG8_LDA(At, 1, 0); PG8_STAGE(PG8_SA(0, 1), a2 + hstepA, voffA);
            PG8_WAIT_L(8); PG8_BAR; PG8_WAIT_L(0); PG8_MMA(0, 0, At, B0); PG8_BAR; PG8_SCHED;
            PG8_LDB(B1, 1, 1); PG8_STAGE(PG8_SB(1, 0), b3, voffB);
            PG8_BAR; PG8_WAIT_L(0); PG8_MMA(0, 1, At, B1); PG8_BAR;
            PG8_LDA(At, 1, 1); PG8_STAGE(PG8_SA(1, 0), a3, voffA);
            PG8_BAR; PG8_WAIT_L(0); PG8_MMA(1, 0, At, B0); PG8_BAR; PG8_SCHED;
            PG8_STAGE(PG8_SB(1, 1), b3 + hstepB, voffB);
            PG8_WAIT_V(6); PG8_BAR; PG8_MMA(1, 1, At, B1); PG8_BAR;
            }
        }
        if constexpr (ALIGN_EPI) { if (wr == 0) PG8_BAR; }
        if constexpr (!Epi::AFTER_DRAIN) { E(acc, cur, wr, wc, fr, fq); S.done(cur); }
        if (!has_next) break;
#pragma unroll
        for (int a = 0; a < 2; ++a)
#pragma unroll
            for (int b = 0; b < 2; ++b)
#pragma unroll
                for (int m = 0; m < 4; ++m)
#pragma unroll
                    for (int n = 0; n < 2; ++n) acc[a][b][m][n] = (f32x4){0.f, 0.f, 0.f, 0.f};
        cur = nxt; cA = nA; cB = nB; ++ui;
        if constexpr (ALIGN_EPI) { if (wr == 1) PG8_BAR; }
    }
    PG8_WAIT_V(0);
    if constexpr (!ALIGN_EPI) { if (wr == 0) PG8_BAR; }
    PG8_BAR;
    if constexpr (Epi::AFTER_DRAIN) { E.fused(acc, cur, wr, wc, fr, fq, lds, wid, lane); S.done(cur); }
#undef PG8_SA
#undef PG8_SB
#undef PG8_STAGE
#undef PG8_LDA
#undef PG8_LDB
#undef PG8_MMA
#undef PG8_WAIT_V
#undef PG8_WAIT_L
#undef PG8_BAR
#undef PG8_SCHED
}
}
namespace pg8 {
struct Unit2 { int pm, pn, e, cnt, jt, ui; };
template <class E, class = void> struct has_perm16 { static constexpr bool value = false; };
template <class E> struct has_perm16<E, decltype((void)E::PERM16)> { static constexpr bool value = E::PERM16; };
template <class E> constexpr bool perm16() { return has_perm16<E>::value; }
template <class Epi, class Sched>
__device__ __forceinline__ void gemm_phase2(PG8_LAS unsigned char* lds, const bf16_t* Abase, int lda, int ldb, int K, const Sched& S, const Epi& E, int kstepA_ = BK * 2) {
    int tid_ = threadIdx.x; asm volatile("" : "+v"(tid_));
    const int tid = tid_, wid = __builtin_amdgcn_readfirstlane(tid >> 6), lane = tid & 63, wr = wid >> 2, wc = wid & 3, fr = lane & 15, fq = lane >> 4;
    int K_ = K; asm volatile("" : "+s"(K_));
    const int nt = K_ / BK;
    unsigned voffB0[2], voffB1[2];
#pragma unroll
    for (int i = 0; i < 2; ++i) { int R, C; stage_rc(tid * 16 + i * 8192, R, C);
        if constexpr (perm16<Epi>()) { const int cb = 64 * (R >> 5) + 16 * ((R >> 2) & 3) + 4 * ((R >> 4) & 1) + (R & 3); voffB0[i] = (unsigned)(cb * ldb + C) * 2u; voffB1[i] = (unsigned)((cb + 8) * ldb + C) * 2u; }
        else { const int Rb = Epi::PERM ? ((R & ~31) + perm32(R & 31)) : R; voffB0[i] = (unsigned)(Rb * ldb + C) * 2u; voffB1[i] = voffB0[i] + (unsigned)(HALF * ldb * 2); } }
    const unsigned lda2 = (unsigned)lda * 2u;
#define PG8_AOFFS(U, o0, o1) do { int t2_ = threadIdx.x; asm volatile("" : "+v"(t2_)); _Pragma("unroll") for (int i_ = 0; i_ < 2; ++i_) { int R_, C_; stage_rc(t2_ * 16 + i_ * 8192, R_, C_); \
        o0[i_] = (unsigned)S.arow(U, R_) * lda2 + (unsigned)C_ * 2u; o1[i_] = (unsigned)S.arow(U, HALF + R_) * lda2 + (unsigned)C_ * 2u; } } while (0)
    const size_t kstep = (size_t)(BK * 2), kstepA = (size_t)kstepA_;
    const unsigned ldsw = (unsigned)wid * 1024u;
    const int aoff = lds_byte(wr * 64 + fr, fq * 8), boff = lds_byte(wc * 32 + fr, fq * 8);
#define PG8_SA(b, h) (((b) * 2 + (h)) * HTB)
#define PG8_SB(b, h) ((4 + (b) * 2 + (h)) * HTB)
#define PG8_STAGE(bufoff, gbase, voff) do { _Pragma("unroll") for (int _i = 0; _i < 2; ++_i) \
        __builtin_amdgcn_global_load_lds((const unsigned*)((const char*)(gbase) + (voff)[_i]), (PG8_LAS unsigned*)(lds + (bufoff) + ldsw + _i * 8192), 16, 0, 0); } while (0)
#define PG8_LDA(dst, b, h) do { _Pragma("unroll") for (int m = 0; m < 4; ++m) _Pragma("unroll") for (int k = 0; k < 2; ++k) dst[m][k] = *(const PG8_LAS bf16x8*)(lds + PG8_SA(b, h) + aoff + m * 2048 + k * 1024); } while (0)
#define PG8_LDB(dst, b, h) do { _Pragma("unroll") for (int n = 0; n < 2; ++n) _Pragma("unroll") for (int k = 0; k < 2; ++k) dst[n][k] = *(const PG8_LAS bf16x8*)(lds + PG8_SB(b, h) + boff + n * 2048 + k * 1024); } while (0)
#define PG8_MMA(ai, bj, At, Bt) do { __builtin_amdgcn_s_setprio(1); _Pragma("unroll") for (int m = 0; m < 4; ++m) _Pragma("unroll") for (int n = 0; n < 2; ++n) _Pragma("unroll") for (int k = 0; k < 2; ++k) \
        acc[ai][bj][m][n] = __builtin_amdgcn_mfma_f32_16x16x32_bf16(Bt[n][k], At[m][k], acc[ai][bj][m][n], 0, 0, 0); __builtin_amdgcn_s_setprio(0); } while (0)
#define PG8_WAIT_V(n) asm volatile("s_waitcnt vmcnt(" #n ")" ::: "memory")
#define PG8_WAIT_L(n) asm volatile("s_waitcnt lgkmcnt(" #n ")" ::: "memory")
#define PG8_BAR __builtin_amdgcn_s_barrier()
#define PG8_SCHED __builtin_amdgcn_sched_barrier(0)
    Unit2 cur, nxt; int ui = 0;
    if (!S.next(0, cur)) return;
    f32x4 acc[2][2][4][2];
#pragma unroll
    for (int a = 0; a < 2; ++a)
#pragma unroll
        for (int b = 0; b < 2; ++b)
#pragma unroll
            for (int m = 0; m < 4; ++m)
#pragma unroll
                for (int n = 0; n < 2; ++n) acc[a][b][m][n] = (f32x4){0.f, 0.f, 0.f, 0.f};
    bf16x8 At[4][2], B0[2][2], B1[2][2];
    unsigned cv0[2], cv1[2], nv0[2], nv1[2];
    PG8_AOFFS(cur, cv0, cv1);
    const char* cA = (const char*)Abase + S.aoff(cur); const char* cB = S.bptr(cur);
    PG8_STAGE(PG8_SB(0, 0), cB, voffB0); PG8_STAGE(PG8_SB(0, 1), cB, voffB1); PG8_STAGE(PG8_SA(0, 0), cA, cv0); PG8_STAGE(PG8_SA(0, 1), cA, cv1);
    if (wr == 1) PG8_BAR;
    PG8_WAIT_V(2); PG8_BAR;
    PG8_STAGE(PG8_SB(1, 0), cB + kstep, voffB0); PG8_STAGE(PG8_SA(1, 0), cA + kstepA, cv0); PG8_STAGE(PG8_SB(1, 1), cB + kstep, voffB1);
    PG8_WAIT_V(6); PG8_BAR;
    for (;;) {
        const bool has_next = S.next(ui + 1, nxt);
        const char* nA = has_next ? (const char*)Abase + S.aoff(nxt) : cA; const char* nB = has_next ? S.bptr(nxt) : cB;
#pragma unroll
        for (int i = 0; i < 2; ++i) { nv0[i] = cv0[i]; nv1[i] = cv1[i]; }
        if (has_next) PG8_AOFFS(nxt, nv0, nv1);
        const bool act0 = cur.cnt > wr * 64, act1 = cur.cnt > HALF + wr * 64;
        for (int t = 0; t < nt; t += 2) {
            const bool last = (t == nt - 2);
            const char* a1 = cA + (size_t)(t + 1) * kstepA;
            const char* a2 = last ? nA : cA + (size_t)(t + 2) * kstepA; const char* b2 = last ? nB : cB + (size_t)(t + 2) * kstep;
            const char* a3 = a2 + kstepA; const char* b3 = b2 + kstep;
            unsigned s0[2] = {cv0[0], cv0[1]}, s1[2] = {cv1[0], cv1[1]};
            if (last) { asm volatile("" ::: "memory"); s0[0] = nv0[0]; s0[1] = nv0[1]; s1[0] = nv1[0]; s1[1] = nv1[1]; }
            PG8_LDB(B0, 0, 0); PG8_LDB(B1, 0, 1); PG8_SCHED; PG8_LDA(At, 0, 0); PG8_STAGE(PG8_SA(1, 1), a1, cv1);
            PG8_WAIT_V(8); PG8_WAIT_L(0); PG8_BAR; if (act0) { PG8_MMA(0, 0, At, B0); PG8_MMA(0, 1, At, B1); } PG8_BAR; PG8_SCHED;
            PG8_LDA(At, 0, 1); PG8_STAGE(PG8_SB(0, 0), b2, voffB0); PG8_STAGE(PG8_SB(0, 1), b2, voffB1); PG8_STAGE(PG8_SA(0, 0), a2, s0);
            PG8_WAIT_V(8); PG8_WAIT_L(0); PG8_BAR; if (act1) { PG8_MMA(1, 0, At, B0); PG8_MMA(1, 1, At, B1); } PG8_BAR; PG8_SCHED;
            PG8_LDB(B0, 1, 0); PG8_LDB(B1, 1, 1); PG8_SCHED; PG8_LDA(At, 1, 0); PG8_STAGE(PG8_SA(0, 1), a2, s1);
            PG8_WAIT_V(8); PG8_WAIT_L(0); PG8_BAR; if (act0) { PG8_MMA(0, 0, At, B0); PG8_MMA(0, 1, At, B1); } PG8_BAR; PG8_SCHED;
            PG8_LDA(At, 1, 1); PG8_STAGE(PG8_SB(1, 0), b3, voffB0); PG8_STAGE(PG8_SB(1, 1), b3, voffB1); PG8_STAGE(PG8_SA(1, 0), a3, s0);
            PG8_WAIT_V(8); PG8_WAIT_L(0); PG8_BAR; if (act1) { PG8_MMA(1, 0, At, B0); PG8_MMA(1, 1, At, B1); } PG8_BAR; PG8_SCHED;
        }
        if (wr == 0) PG8_BAR;
        { Unit2 eu = cur; asm volatile("" : "+s"(eu.pm), "+s"(eu.pn), "+s"(eu.e), "+s"(eu.cnt), "+s"(eu.jt), "+s"(eu.ui));
          E(acc, eu, wr, wc, fr, fq);
          }
        if (!has_next) break;
#pragma unroll
        for (int a = 0; a < 2; ++a)
#pragma unroll
            for (int b = 0; b < 2; ++b)
#pragma unroll
                for (int m = 0; m < 4; ++m)
#pragma unroll
                    for (int n = 0; n < 2; ++n) acc[a][b][m][n] = (f32x4){0.f, 0.f, 0.f, 0.f};
        cur = nxt; cA = nA; cB = nB; ++ui;
#pragma unroll
        for (int i = 0; i < 2; ++i) { cv0[i] = nv0[i]; cv1[i] = nv1[i]; }
        if (wr == 1) PG8_BAR;
    }
    PG8_WAIT_V(0);
    PG8_BAR;
#undef PG8_AOFFS
#undef PG8_SA
#undef PG8_SB
#undef PG8_STAGE
#undef PG8_LDA
#undef PG8_LDB
#undef PG8_MMA
#undef PG8_WAIT_V
#undef PG8_WAIT_L
#undef PG8_BAR
#undef PG8_SCHED
}

struct DenseSched {
    StaticOrder so; const bf16_t* Bt; int ldb;
    __device__ __forceinline__ bool next(int i, Unit2& u) const { Unit t; if (!so.next(i, t)) return false; u.pm = t.pm; u.pn = t.pn; u.e = 0; u.cnt = 256; u.jt = 0; u.ui = i; return true; }
    __device__ __forceinline__ int arow(const Unit2& u, int r) const { return u.pm * BM + r; }
    __device__ __forceinline__ size_t aoff(const Unit2&) const { return 0; }
    __device__ __forceinline__ const char* bptr(const Unit2& u) const { return (const char*)(Bt + (size_t)u.pn * BM * ldb); }
};
struct EpiPlainBf16 {
    static constexpr bool PERM = true, AFTER_DRAIN = false;
    bf16_t* O; int ldc;
    __device__ __forceinline__ void operator()(const f32x4 (&acc)[2][2][4][2], const Unit2& u, int wr, int wc, int fr, int fq) const {
        const int row0 = u.pm * BM + wr * 64 + fr, col0 = u.pn * BM + wc * 32 + 8 * fq;
#pragma unroll
        for (int ai = 0; ai < 2; ++ai)
#pragma unroll
            for (int m = 0; m < 4; ++m) { bf16_t* rowp = O + (size_t)(row0 + ai * HALF + m * 16) * ldc + col0;
#pragma unroll
                for (int bj = 0; bj < 2; ++bj) { const f32x4 v0 = acc[ai][bj][m][0], v1 = acc[ai][bj][m][1];
                    u32x4 w; w.x = cvt_pk_bf16(v0[0], v0[1]); w.y = cvt_pk_bf16(v0[2], v0[3]); w.z = cvt_pk_bf16(v1[0], v1[1]); w.w = cvt_pk_bf16(v1[2], v1[3]);
                    *(u32x4*)(rowp + bj * HALF) = w; } }
    }
};
}
namespace nv {
constexpr int D = 1024, B = 8, S = 4096, T = B * S;
constexpr int FH = 8, FD = 64, GH = 4, GK = 64, GV = 128, RANK = 16;
constexpr int INW = 3096;
constexpr int O_FQ = 0, O_FK = 512, O_FV = 1024, O_FF = 1536, O_GQ = 1544, O_GK = 1800, O_GV = 2056, O_GA = 2568, O_GR = 2584;
constexpr int NE = 256, NG = 8, TOPK = 8, ED = 256;
constexpr float LN_EPS = 1e-5f;
constexpr float ALPHA = 1.189207115002721f;
constexpr int PADR = 64;
constexpr int APAD = T * TOPK + NE * PADR;

__device__ __forceinline__ float logsigmoidf(float x) { return fminf(x, 0.f) - log1pf(expf(-fabsf(x))); }
__device__ __forceinline__ float siluf(float x) { return x / (1.f + expf(-x)); }

}
#include <hip/hip_bf16.h>
#include <cmath>
namespace attn_body {
using bf16=__hip_bfloat16;
using bf16x8=__attribute__((ext_vector_type(8)))short;
using s16x4=__attribute__((ext_vector_type(4)))short;
using f32x16=__attribute__((ext_vector_type(16)))float;
using u32x4=__attribute__((ext_vector_type(4)))unsigned;
constexpr int BATCH=8,NHEAD=8,SEQ=4096,D=64,DM=3072,OPITCH=1024;
constexpr int NW=8,QBLK=32,QB=QBLK*NW,KVBLK=64,NQB=SEQ/QB;
constexpr int ATTN_PITCH=DM, ATTN_UNIT_ROWS=QB;
__device__ __forceinline__ int crow(int r,int hi){return (r&3)+8*(r>>2)+4*hi;}
#define SBAR() __builtin_amdgcn_sched_barrier(0)
__device__ __forceinline__ void cmask(f32x16&p0,f32x16&p1,int jb,int qrel,int hi){
  const float NEG=-INFINITY; int kb=64*jb+4*hi;
  #pragma unroll
  for(int r=0;r<16;++r){int kv=kb+(r&3)+8*(r>>2); if(kv>qrel)p0[r]=NEG; if(kv+32>qrel)p1[r]=NEG;}
}

constexpr int NSLOT=3, SLOTB=8192;
constexpr int LDS_K=0, LDS_V=NSLOT*SLOTB, LDS_WS=2*NSLOT*SLOTB, LDS_OST=LDS_WS+NW*64*4, LDS_KB=LDS_OST+NW*4096, LDS_BYTES=LDS_KB+(SEQ+2)*8;
constexpr float C2=0.125f*1.4426950408889634f;
__device__ __forceinline__ void glds16(const void*gsrc,unsigned lds_dst){unsigned keep;
  asm volatile("s_mov_b32 %0, m0\n\ts_mov_b32 m0, %2\n\ts_nop 0\n\tglobal_load_lds_dwordx4 %1, off\n\ts_mov_b32 m0, %0":"=&s"(keep):"v"(gsrc),"s"(lds_dst):"memory");}
__device__ __forceinline__ float max3f(float a,float b,float c){float r;asm("v_max3_f32 %0, %1, %2, %3":"=v"(r):"v"(a),"v"(b),"v"(c));return r;}
__device__ __forceinline__ float max2f(float a,float b){float r;asm("v_max_f32_e32 %0, %1, %2":"=v"(r):"v"(a),"v"(b));return r;}
__device__ __forceinline__ float fadd_s(float a,float b){float r;asm("v_add_f32_e32 %0, %1, %2":"=v"(r):"v"(a),"v"(b));return r;}
__device__ __forceinline__ float fsub_s(float a,float b){float r;asm("v_sub_f32_e32 %0, %1, %2":"=v"(r):"v"(a),"v"(b));return r;}
typedef float f32x2_t __attribute__((ext_vector_type(2))); typedef float f32x4_t __attribute__((ext_vector_type(4))); typedef __bf16 bf16x2_t __attribute__((ext_vector_type(2)));
__device__ __forceinline__ unsigned cvtpk_s(float lo,float hi){f32x2_t v={lo,hi};bf16x2_t b=__builtin_convertvector(v,bf16x2_t);return __builtin_bit_cast(unsigned,b);}
#define WAIT_BAR(N) asm volatile("s_waitcnt vmcnt(" #N ") lgkmcnt(0)\n\ts_barrier":::"memory")

__device__ __forceinline__ void split3(float b,unsigned&h,unsigned&m,unsigned&l){
  h=cvtpk_s(b,0.f)&0xffffu; const float r1=b-__uint_as_float(h<<16);
  m=cvtpk_s(r1,0.f)&0xffffu; const float r2=r1-__uint_as_float(m<<16);
  l=cvtpk_s(r2,0.f)&0xffffu; }
__device__ __forceinline__ bf16x8 kbias_frag(float b,int hi){unsigned h,m,l;split3(b,h,m,l);u32x4 w;w.x=h|(m<<16);w.y=l|0x3F800000u;w.z=0x3F803F80u;w.w=0u;if(hi){w.x=0u;w.y=0u;w.z=0u;}return __builtin_bit_cast(bf16x8,w);}
__device__ __forceinline__ bf16x8 qref_frag(float x,int hi){unsigned h,m,l;split3(x,h,m,l);u32x4 w;w.x=0x3F803F80u;w.y=0x3F80u|(h<<16);w.z=m|(l<<16);w.w=0u;if(hi){w.x=0u;w.y=0u;w.z=0u;}return __builtin_bit_cast(bf16x8,w);}
typedef unsigned u32x2_t __attribute__((ext_vector_type(2)));
__device__ __forceinline__ bf16x8 mkfrag(u32x2_t e,unsigned zc){u32x4 w;w.x=e.x;w.y=e.y;w.z=zc;w.w=0u;return __builtin_bit_cast(bf16x8,w);}
__device__ __forceinline__ void fox_bias_table(int b,int h,const float*LF,char*shm){
  int tid_=threadIdx.x; asm volatile("":"+v"(tid_)); const int tid=tid_,lane=tid&63,wid=__builtin_amdgcn_readfirstlane(tid>>6);
  const float*lf=LF+((long)b*NHEAD+h)*SEQ; float*wt=(float*)(shm+LDS_WS); u32x2_t*KB8=(u32x2_t*)(shm+LDS_KB);
  f32x4_t va=*(const f32x4_t*)(lf+8*tid),vb=*(const f32x4_t*)(lf+8*tid+4);
  va[1]+=va[0];va[2]+=va[1];va[3]+=va[2];vb[0]+=va[3];vb[1]+=vb[0];vb[2]+=vb[1];vb[3]+=vb[2];
  const float tot=vb[3]; float inc=tot;
  #pragma unroll
  for(int o_=1;o_<64;o_<<=1){const float nn=__shfl_up(inc,o_);if(lane>=o_)inc+=nn;}
  __syncthreads();
  if(lane==63)wt[wid*64]=inc;
  __syncthreads();
  float base=inc-tot;
  #pragma unroll
  for(int w_=0;w_<NW;++w_){const float x_=wt[w_*64]; if(w_<wid)base+=x_;}
  const float cv[8]={va[0]+base,va[1]+base,va[2]+base,va[3]+base,vb[0]+base,vb[1]+base,vb[2]+base,vb[3]+base};
  #pragma unroll
  for(int j=0;j<8;++j){unsigned hh,mm,ll;split3(-cv[j],hh,mm,ll);KB8[8*tid+j]=(u32x2_t){hh|(mm<<16),ll|0x3F800000u};}
  if(tid==0){KB8[SEQ]=(u32x2_t){0u,0u};KB8[SEQ+1]=(u32x2_t){0u,0u};}
  __syncthreads();
}
__device__ __forceinline__ void qkt(f32x16&p0,f32x16&p1,const char*Kslot,const bf16x8*qr,bf16x8 kb0,bf16x8 kb1,bf16x8 qx,int r32,int hi){
  const f32x16 negm=f32x16{};
  const char*kb=Kslot+hi*1024+r32*16;
  #pragma unroll
  for(int d0=0;d0<4;++d0){
    const bf16x8 b0=*reinterpret_cast<const bf16x8*>(kb+d0*2048);
    const bf16x8 b1=*reinterpret_cast<const bf16x8*>(kb+d0*2048+512);
    if(d0==0){p0=__builtin_amdgcn_mfma_f32_32x32x16_bf16(b0,qr[0],negm,0,0,0);p1=__builtin_amdgcn_mfma_f32_32x32x16_bf16(b1,qr[0],negm,0,0,0);}
    else{p0=__builtin_amdgcn_mfma_f32_32x32x16_bf16(b0,qr[d0],p0,0,0,0);p1=__builtin_amdgcn_mfma_f32_32x32x16_bf16(b1,qr[d0],p1,0,0,0);}}
  p0=__builtin_amdgcn_mfma_f32_32x32x16_bf16(kb0,qx,p0,0,0,0);p1=__builtin_amdgcn_mfma_f32_32x32x16_bf16(kb1,qx,p1,0,0,0);
}
typedef __attribute__((address_space(3))) const char* lds_cptr;
typedef short v4i16_t __attribute__((ext_vector_type(4)));
__device__ __forceinline__ void kload8(bf16x8*kf,lds_cptr kp){
  kf[0]=*(const __attribute__((address_space(3))) bf16x8*)(kp);      kf[1]=*(const __attribute__((address_space(3))) bf16x8*)(kp+512);
  kf[2]=*(const __attribute__((address_space(3))) bf16x8*)(kp+2048); kf[3]=*(const __attribute__((address_space(3))) bf16x8*)(kp+2560);
  kf[4]=*(const __attribute__((address_space(3))) bf16x8*)(kp+4096); kf[5]=*(const __attribute__((address_space(3))) bf16x8*)(kp+4608);
  kf[6]=*(const __attribute__((address_space(3))) bf16x8*)(kp+6144); kf[7]=*(const __attribute__((address_space(3))) bf16x8*)(kp+6656);
}
__device__ __forceinline__ void kload2(bf16x8*kf,lds_cptr kp,int j){ kf[2*j]=*(const __attribute__((address_space(3))) bf16x8*)(kp+j*2048); kf[2*j+1]=*(const __attribute__((address_space(3))) bf16x8*)(kp+j*2048+512); }
__device__ __forceinline__ s16x4 vtr(lds_cptr p){ return __builtin_bit_cast(s16x4,__builtin_amdgcn_ds_read_tr16_b64_v4i16((__attribute__((address_space(3))) v4i16_t*)p)); }
__device__ __forceinline__ float rowmax(const f32x16&p0,const f32x16&p1){
  float a=max3f(p0[0],p0[1],p1[0]),b=max3f(p0[2],p0[3],p1[1]);a=max3f(a,p1[2],p1[3]);
  #pragma unroll
  for(int r=4;r<16;r+=4){a=max3f(a,p0[r],p0[r+1]);b=max3f(b,p0[r+2],p0[r+3]);a=max3f(a,p1[r],p1[r+1]);b=max3f(b,p1[r+2],p1[r+3]);}
  const float m=max2f(a,b);
  auto rr=__builtin_amdgcn_permlane32_swap(__float_as_uint(m),__float_as_uint(m),false,false);
  return max2f(__uint_as_float(rr[0]),__uint_as_float(rr[1]));
}
__device__ __forceinline__ void pv(f32x16*o,int vb,bf16x8 pa0,bf16x8 pa1,bf16x8 pa2,bf16x8 pa3){
  #pragma unroll
  for(int d0=0;d0<2;++d0){s16x4 lo[4],hi[4];
    #pragma unroll
    for(int ks=0;ks<4;++ks){
      asm volatile("ds_read_b64_tr_b16 %0,%1 offset:%c2":"=&v"(lo[ks]):"v"(vb),"i"(d0*4096+ks*1024):"memory");
      asm volatile("ds_read_b64_tr_b16 %0,%1 offset:%c2":"=&v"(hi[ks]):"v"(vb),"i"(d0*4096+ks*1024+512):"memory");}
    asm volatile("s_waitcnt lgkmcnt(0)":::"memory");SBAR();
    #define PK(k) (bf16x8){lo[k][0],lo[k][1],lo[k][2],lo[k][3],hi[k][0],hi[k][1],hi[k][2],hi[k][3]}
    o[d0]=__builtin_amdgcn_mfma_f32_32x32x16_bf16(pa0,PK(0),o[d0],0,0,0);
    o[d0]=__builtin_amdgcn_mfma_f32_32x32x16_bf16(pa1,PK(1),o[d0],0,0,0);
    o[d0]=__builtin_amdgcn_mfma_f32_32x32x16_bf16(pa2,PK(2),o[d0],0,0,0);
    o[d0]=__builtin_amdgcn_mfma_f32_32x32x16_bf16(pa3,PK(3),o[d0],0,0,0);
    #undef PK
  }
}

#ifndef ATTN_STORE16
#define ATTN_STORE16(p,v) (*(u32x4*)(p)=(v))
#endif
template<int THRL> __device__ __forceinline__ void attn_unit(int b,int h,int qb,const bf16*Q,const bf16* K,const bf16* V,bf16*O,const float*LF,const unsigned*NRM,char*shm){
  int tid_=threadIdx.x; asm volatile("":"+v"(tid_));
  const int tid=tid_,lane=tid&63,r32=lane&31,hi=lane>>5; const int wid=__builtin_amdgcn_readfirstlane(tid>>6);
  const long rowbase=(long)b*SEQ; const int q0=qb*QB;
  const char*KBt0=shm+LDS_KB;
  int t0;
  { const int NT0=(q0+QB)/KVBLK; const unsigned*nr=NRM+(b*NHEAD+h)*4;
    const float qn2=__uint_as_float(nr[0])+__uint_as_float(nr[1]), kn2=__uint_as_float(nr[2])+__uint_as_float(nr[3]);
    const float thr=-(50.f+2.04f*sqrtf(qn2*kn2));
    const u32x2_t eq0=*(const u32x2_t*)(KBt0+(unsigned)q0*8u); const float bq0=__uint_as_float(eq0.x<<16)+__uint_as_float(eq0.x&0xffff0000u)+__uint_as_float(eq0.y<<16);
    bool ok=(2*lane<=NT0-4);
    if(ok&&lane>0){ const u32x2_t el=*(const u32x2_t*)(KBt0+(unsigned)(128*lane-1)*8u); const float bl=__uint_as_float(el.x<<16)+__uint_as_float(el.x&0xffff0000u)+__uint_as_float(el.y<<16); ok=(bl-bq0<thr); }
    const unsigned long long mk=__ballot(ok); const unsigned long long low=~mk; const int cnt=(low==0ull)?64:__builtin_ctzll(low);
    t0=__builtin_amdgcn_readfirstlane(2*(cnt-1)); }
  const char*KBt=KBt0+(hi?0:t0*512); const unsigned kb_o0=hi?(unsigned)SEQ*8u:(unsigned)r32*8u, kb_o1=hi?(unsigned)SEQ*8u:(unsigned)(r32+32)*8u, kb_str=hi?0u:512u, zc=hi?0u:0x3F803F80u;
  const bf16*Qw=Q+(rowbase+q0+wid*QBLK)*DM+h*D;
  const bf16*Kh=K+(rowbase+(long)t0*KVBLK)*DM+h*D,*Vh=V+(rowbase+(long)t0*KVBLK)*DM+h*D;
  const unsigned lds0=(unsigned)(uintptr_t)shm;
  float*wsf=(float*)(shm+LDS_WS)+wid*64;
  const bf16*ksrc=Kh+(long)lane*DM+wid*8;
  const bf16*vsrc=Vh+(long)(16*(wid&3)+(lane>>2))*DM+(wid>>2)*32+(lane&3)*8;
  const unsigned kdst=lds0+LDS_K+wid*1024, vdst=lds0+LDS_V+wid*1024;
  #define DMA_K(t,slot) glds16(ksrc+(long)(t)*KVBLK*DM,(unsigned)__builtin_amdgcn_readfirstlane(kdst+(slot)))
  #define DMA_V(t,slot) glds16(vsrc+(long)(t)*KVBLK*DM,(unsigned)__builtin_amdgcn_readfirstlane(vdst+(slot)))
  const int vb0=(int)(lds0+LDS_V)+((lane>>4)&1)*32+(lane&3)*8+(4*hi+((lane&15)>>2))*64;
  const char*Kbase=shm+LDS_K; bf16x8 kf[8];
  const lds_cptr shm3=(lds_cptr)shm; const lds_cptr kp0=shm3+LDS_K+hi*1024+r32*16; const lds_cptr vp0=shm3+LDS_V+((lane>>4)&1)*32+(lane&3)*8+(4*hi+((lane&15)>>2))*64;
  const int NT=(q0+QB)/KVBLK-t0;
  DMA_K(0,0);DMA_V(0,0);DMA_K(1,SLOTB);
  bf16x8 qr[4];
  #pragma unroll
  for(int d0=0;d0<4;++d0)qr[d0]=*reinterpret_cast<const bf16x8*>(&Qw[(long)r32*DM+d0*16+hi*8]);
  float mhat; { const u32x2_t eq=*(const u32x2_t*)(KBt0+(unsigned)(q0+wid*QBLK+r32)*8u); mhat=__uint_as_float(eq.x<<16)+__uint_as_float(eq.x&0xffff0000u)+__uint_as_float(eq.y<<16); }
  float l_reg=0.f;f32x16 o[2];o[0]=f32x16{};o[1]=f32x16{};const f32x16 negm=f32x16{};
  bf16x8 qx=qref_frag(-mhat,hi);
  const int qrel=wid*QBLK+r32;
  #define CMASK(P0,P1,t) do{int jb_=(t)-(NT-4); if(jb_>=0)cmask(P0,P1,jb_,qrel,hi);}while(0)
  bool resc=false;
  #define START(P0,P1) do{ const float rm=rowmax(P0,P1); resc=false; \
    { const float dl=__builtin_fmaxf(rm,0.f); mhat=fadd_s(mhat,dl); \
      _Pragma("unroll") for(int r=0;r<16;++r){P0[r]=fsub_s(P0[r],dl);P1[r]=fsub_s(P1[r],dl);} \
      qx=qref_frag(-mhat,hi); } \
    _Pragma("unroll") for(int r=0;r<16;++r)P0[r]=__builtin_amdgcn_exp2f(P0[r]); }while(0)
  #define RESC() do{ if(resc){ asm volatile("s_waitcnt lgkmcnt(0)":::"memory"); \
      _Pragma("unroll") for(int d_=0;d_<2;++d_) _Pragma("unroll") for(int r=0;r<16;++r)o[d_][r]*=wsf[crow(r,hi)]; } }while(0)
  f32x16 pA0,pA1,pB0,pB1;
  int sl_prev=0,sl_cur=0,sl_next=SLOTB;
  #define ROT() do{sl_prev=sl_cur;sl_cur=sl_next;sl_next=(sl_next==(NSLOT-1)*SLOTB)?0:sl_next+SLOTB;}while(0)
  DMA_K(2,2*SLOTB);
  WAIT_BAR(3);
  qkt(pA0,pA1,Kbase,qr,mkfrag(*(const u32x2_t*)(KBt+kb_o0),zc),mkfrag(*(const u32x2_t*)(KBt+kb_o1),zc),qx,r32,hi);asm volatile("s_nop 15\n\ts_nop 7":"+v"(pA0),"+v"(pA1));CMASK(pA0,pA1,0);
  START(pA0,pA1);
  _Pragma("unroll") for(int r=0;r<16;++r)pA1[r]=__builtin_amdgcn_exp2f(pA1[r]);
  WAIT_BAR(0);
  DMA_K(3,0);DMA_V(1,SLOTB);
  ROT();
  kload8(kf,kp0+sl_cur);
  WAIT_BAR(2);
  s16x4 vlo[8],vhi[8]; u32x4 pw0,pw1,pw2,pw3;
  #define PKW(P,B) cvtpk_s(P[B],P[B+1])
  #define PAF(k) __builtin_bit_cast(bf16x8,pw##k)
  #define VFR(i) (bf16x8){vlo[i][0],vlo[i][1],vlo[i][2],vlo[i][3],vhi[i][0],vhi[i][1],vhi[i][2],vhi[i][3]}
  #define PIN(x) asm volatile("":"+v"(x))
  #define MX3(a,b,c) __builtin_fmaxf(__builtin_fmaxf((a),(b)),(c))
  #define GAPA(MF,A0,A1,A2,A3,W0,W1,PW) do{ MF; sacc+=A0; sacc+=A1; sacc+=A2; sacc+=A3; PIN(sacc); W0; W1; PIN(PW); SBAR(); }while(0)
  #define EX(v) __builtin_amdgcn_exp2f(v)
  #define GAPB(MF,X,B) do{ MF; X[B]=EX(X[B]); X[B+1]=EX(X[B+1]); X[B+2]=EX(X[B+2]); X[B+3]=EX(X[B+3]); PIN(X); SBAR(); }while(0)
  #define VRD(i) do{ vlo[i]=vtr(vp_+(((i)>>2)*4096+((i)&3)*1024)); vhi[i]=vtr(vp_+(((i)>>2)*4096+((i)&3)*1024+512)); }while(0)
  #define KRD(G,j) do{ if(G){ kload2(kf,kp0+sl_next,j); SBAR(); } }while(0)
  #define STEP(C0,C1,P0,P1,t,GK,GV,GL) do{ SBAR(); \
    const lds_cptr vp_=vp0+sl_prev; const u32x2_t e0_=*(const u32x2_t*)(KBt+kb_o0+(unsigned)(t)*kb_str),e1_=*(const u32x2_t*)(KBt+kb_o1+(unsigned)(t)*kb_str); \
    VRD(0); SBAR(); float sacc=(P0[0]+P0[1]); \
    GAPA(C0=__builtin_amdgcn_mfma_f32_32x32x16_bf16(kf[0],qr[0],negm,0,0,0), P0[2],P0[3],P0[4],P0[5],     pw0[0]=PKW(P0,0), pw0[1]=PKW(P0,2), pw0); \
    VRD(4); SBAR(); GAPA(C1=__builtin_amdgcn_mfma_f32_32x32x16_bf16(kf[1],qr[0],negm,0,0,0), P0[6],P0[7],P0[8],P0[9],     pw0[2]=PKW(P0,4), pw0[3]=PKW(P0,6), pw0); \
    VRD(1); SBAR(); GAPA(C0=__builtin_amdgcn_mfma_f32_32x32x16_bf16(kf[2],qr[1],C0,0,0,0),   P0[10],P0[11],P0[12],P0[13], pw1[0]=PKW(P0,8), pw1[1]=PKW(P0,10), pw1); \
    VRD(5); SBAR(); GAPA(C1=__builtin_amdgcn_mfma_f32_32x32x16_bf16(kf[3],qr[1],C1,0,0,0),   P0[14],P0[15],P1[0],P1[1],   pw1[2]=PKW(P0,12),pw1[3]=PKW(P0,14), pw1); \
    VRD(2); SBAR(); GAPA(C0=__builtin_amdgcn_mfma_f32_32x32x16_bf16(kf[4],qr[2],C0,0,0,0),   P1[2],P1[3],P1[4],P1[5],     pw2[0]=PKW(P1,0), pw2[1]=PKW(P1,2), pw2); \
    VRD(6); SBAR(); GAPA(C1=__builtin_amdgcn_mfma_f32_32x32x16_bf16(kf[5],qr[2],C1,0,0,0),   P1[6],P1[7],P1[8],P1[9],     pw2[2]=PKW(P1,4), pw2[3]=PKW(P1,6), pw2); \
    VRD(3); SBAR(); GAPA(C0=__builtin_amdgcn_mfma_f32_32x32x16_bf16(kf[6],qr[3],C0,0,0,0),   P1[10],P1[11],P1[12],P1[13], pw3[0]=PKW(P1,8), pw3[1]=PKW(P1,10), pw3); \
    VRD(7); SBAR(); GAPA(C1=__builtin_amdgcn_mfma_f32_32x32x16_bf16(kf[7],qr[3],C1,0,0,0),   P1[14],P1[15],0.f,0.f,       pw3[2]=PKW(P1,12),pw3[3]=PKW(P1,14), pw3); \
    { const bf16x8 kb0_=mkfrag(e0_,zc),kb1_=mkfrag(e1_,zc); C0=__builtin_amdgcn_mfma_f32_32x32x16_bf16(kb0_,qx,C0,0,0,0); C1=__builtin_amdgcn_mfma_f32_32x32x16_bf16(kb1_,qx,C1,0,0,0); } SBAR(); \
    l_reg+=sacc; \
    if(GK){DMA_K((t)+3,sl_cur);} if(GV){DMA_V((t)+1,sl_next);} \
    CMASK(C0,C1,t); \
    { float a=MX3(C0[0],C0[1],C1[0]),b=MX3(C0[2],C0[3],C1[1]); a=MX3(a,C1[2],C1[3]); \
      _Pragma("unroll") for(int r=4;r<16;r+=4){a=MX3(a,C0[r],C0[r+1]);b=MX3(b,C0[r+2],C0[r+3]);a=MX3(a,C1[r],C1[r+1]);b=MX3(b,C1[r+2],C1[r+3]);} \
      float rm=__builtin_fmaxf(a,b); { auto rr=__builtin_amdgcn_permlane32_swap(__float_as_uint(rm),__float_as_uint(rm),false,false); rm=__builtin_fmaxf(__uint_as_float(rr[0]),__uint_as_float(rr[1])); } \
      resc=false; \
      if(__builtin_expect(__any(rm>(float)THRL),0)){ const float dl=__builtin_fmaxf(rm,0.f); mhat+=dl; \
        _Pragma("unroll") for(int r=0;r<16;++r){C0[r]-=dl;C1[r]-=dl;} \
        qx=qref_frag(-mhat,hi); \
        const float f=__builtin_amdgcn_exp2f(-dl); l_reg*=f; if(hi==0)wsf[r32]=f; resc=true; } } \
    SBAR(); \
    GAPB(o[0]=__builtin_amdgcn_mfma_f32_32x32x16_bf16(PAF(0),VFR(0),o[0],0,0,0), C0,0); \
    GAPB(o[1]=__builtin_amdgcn_mfma_f32_32x32x16_bf16(PAF(0),VFR(4),o[1],0,0,0), C0,4); \
    KRD(GL,0); GAPB(o[0]=__builtin_amdgcn_mfma_f32_32x32x16_bf16(PAF(1),VFR(1),o[0],0,0,0), C0,8); \
    KRD(GL,1); GAPB(o[1]=__builtin_amdgcn_mfma_f32_32x32x16_bf16(PAF(1),VFR(5),o[1],0,0,0), C0,12); \
    KRD(GL,2); GAPB(o[0]=__builtin_amdgcn_mfma_f32_32x32x16_bf16(PAF(2),VFR(2),o[0],0,0,0), C1,0); \
    KRD(GL,3); GAPB(o[1]=__builtin_amdgcn_mfma_f32_32x32x16_bf16(PAF(2),VFR(6),o[1],0,0,0), C1,4); \
    GAPB(o[0]=__builtin_amdgcn_mfma_f32_32x32x16_bf16(PAF(3),VFR(3),o[0],0,0,0), C1,8); \
    GAPB(o[1]=__builtin_amdgcn_mfma_f32_32x32x16_bf16(PAF(3),VFR(7),o[1],0,0,0), C1,12); \
    }while(0)
  int t=1;
  #undef CMASK
  #define CMASK(P0,P1,t) do{}while(0)
  for(;t+5<NT;t+=2){
    STEP(pB0,pB1,pA0,pA1,t,true,true,true);     WAIT_BAR(2); RESC(); ROT();
    STEP(pA0,pA1,pB0,pB1,t+1,true,true,true);   WAIT_BAR(2); RESC(); ROT();
  }
  #undef CMASK
  #define CMASK(P0,P1,t) do{int jb_=(t)-(NT-4); if(jb_>=0)cmask(P0,P1,jb_,qrel,hi);}while(0)
  #define ENDW(tt) do{ if((tt)+3<NT){WAIT_BAR(2);} else if((tt)+2<NT){WAIT_BAR(1);} else {WAIT_BAR(0);} }while(0)
  for(;t+1<NT;t+=2){
    STEP(pB0,pB1,pA0,pA1,t,(t+3<NT),(t+1<NT),(t+1<NT));       ENDW(t);   RESC(); ROT();
    STEP(pA0,pA1,pB0,pB1,t+1,(t+4<NT),(t+2<NT),(t+2<NT));     ENDW(t+1); RESC(); ROT();
  }
  STEP(pB0,pB1,pA0,pA1,NT-1,false,false,false); RESC();
  { float sacc=pB0[0]+pB0[1]; _Pragma("unroll") for(int r=2;r<16;++r)sacc+=pB0[r]; _Pragma("unroll") for(int r=0;r<16;++r)sacc+=pB1[r]; l_reg+=sacc;
    pw0=(u32x4){PKW(pB0,0),PKW(pB0,2),PKW(pB0,4),PKW(pB0,6)};pw1=(u32x4){PKW(pB0,8),PKW(pB0,10),PKW(pB0,12),PKW(pB0,14)};pw2=(u32x4){PKW(pB1,0),PKW(pB1,2),PKW(pB1,4),PKW(pB1,6)};pw3=(u32x4){PKW(pB1,8),PKW(pB1,10),PKW(pB1,12),PKW(pB1,14)};
    SBAR(); pv(o,vb0+sl_cur,PAF(0),PAF(1),PAF(2),PAF(3)); }
  #undef PKW
  #undef PAF
  #undef VFR
  #undef PIN
  #undef MX3
  #undef GAPA
  #undef GAPB
  #undef EX
  #undef VRD
  #undef KRD
  #undef STEP
  #undef ENDW
  {auto rr=__builtin_amdgcn_permlane32_swap(__float_as_uint(l_reg),__float_as_uint(l_reg),false,false);l_reg=__uint_as_float(rr[0])+__uint_as_float(rr[1]);}
  if(hi==0)wsf[32+r32]=l_reg;asm volatile("s_waitcnt lgkmcnt(0)":::"memory");
  float rli[16];
  #pragma unroll
  for(int r=0;r<16;++r)rli[r]=__builtin_amdgcn_rcpf(wsf[32+crow(r,hi)]);
  bf16*Ow=O+(rowbase+q0+wid*QBLK)*OPITCH+h*D;
  { bf16*stg=(bf16*)(shm+LDS_OST)+wid*2048;
    #pragma unroll
    for(int r=0;r<16;++r){const int orow=crow(r,hi);
      #pragma unroll
      for(int d0=0;d0<2;++d0)stg[orow*64+d0*32+r32]=__float2bfloat16(o[d0][r]*rli[r]);}
    asm volatile("s_waitcnt lgkmcnt(0)":::"memory");
    #pragma unroll
    for(int i=0;i<4;++i){const int row=i*8+(lane>>3),ch=lane&7; const u32x4 v=*(const u32x4*)(stg+row*64+ch*8); ATTN_STORE16(Ow+(long)row*OPITCH+ch*8,v);} }
  asm volatile("s_waitcnt lgkmcnt(0)\n\ts_barrier":::"memory");
  #undef DMA_K
  #undef DMA_V
  #undef CMASK
  #undef START
  #undef RESC
  #undef ROT
}
constexpr int ATTN_LDS_BYTES=LDS_BYTES;
struct AttnTensors { const bf16* Q; const bf16* K; const bf16* V; bf16* O; const float* LF; const unsigned* NRM; };
struct AttnUnit { int bh; int qb; };
struct StaticOrder {
  int vcu,grid;
  __device__ __forceinline__ explicit StaticOrder(int grid_,int block):vcu((grid_%8==0)?(block%8)*(grid_/8)+block/8:block),grid(grid_){}
  __device__ __forceinline__ bool next(int i,AttnUnit&u)const{
    if(grid==256){ if(i>=4)return false; const int s=vcu&3; u.bh=vcu>>2; u.qb=(i==0)?s:(i==1)?7-s:(i==2)?8+s:15-s; return true; }
    const int L=i*grid+vcu; if(L>=BATCH*NHEAD*NQB)return false; u.bh=L/NQB; u.qb=L%NQB; return true; }
  __device__ __forceinline__ void a_ready(const AttnUnit&)const{}
  __device__ __forceinline__ void done(const AttnUnit&)const{}
};
template<class Sched,int THRL=8> __device__ __forceinline__ void attn_phase(char*lds,const AttnTensors&T,const Sched&S){
  AttnUnit u; int cur_bh=-1;
  for(int i=0;S.next(i,u);++i){ S.a_ready(u); if(u.bh!=cur_bh){ fox_bias_table(u.bh/NHEAD,u.bh%NHEAD,T.LF,lds); cur_bh=u.bh; }
    attn_unit<THRL>(u.bh/NHEAD,u.bh%NHEAD,u.qb,T.Q,T.K,T.V,T.O,T.LF,T.NRM,lds); S.done(u); }
}
template<int THRL=8> __device__ __forceinline__ void attn_phase_dyn(char*lds,const AttnTensors&T,unsigned*qheads,volatile int*slot,int grp){
  int cur_bh=-1; const int NU=NHEAD*NQB; unsigned*qhead=qheads+64*grp;
  if(threadIdx.x==0) slot[0]=(int)__hip_atomic_fetch_add(qhead,1u,__ATOMIC_RELAXED,__HIP_MEMORY_SCOPE_AGENT);
  __syncthreads();
  int idx=__builtin_amdgcn_readfirstlane(slot[0]);
  while(idx<NU){
    __syncthreads();
    if(threadIdx.x==0) slot[0]=(int)__hip_atomic_fetch_add(qhead,1u,__ATOMIC_RELAXED,__HIP_MEMORY_SCOPE_AGENT);
    const int qb=NQB-1-idx/NHEAD, bh=grp*NHEAD+idx%NHEAD;
    if(bh!=cur_bh){ fox_bias_table(bh/NHEAD,bh%NHEAD,T.LF,lds); cur_bh=bh; }
    attn_unit<THRL>(bh/NHEAD,bh%NHEAD,qb,T.Q,T.K,T.V,T.O,T.LF,T.NRM,lds);
    __syncthreads();
    idx=__builtin_amdgcn_readfirstlane(slot[0]);
  }
}
#undef SBAR
#undef WAIT_BAR
}
namespace fx {
using namespace nv;
typedef unsigned short bf16;
typedef unsigned v4u __attribute__((ext_vector_type(4)));
typedef float f32x4 __attribute__((ext_vector_type(4)));
constexpr float C2 = 0.125f * 1.4426950408889634f;
constexpr int NIN = 3328;
constexpr int QKVP = 3072;
constexpr int P_FQ = 0, P_FK = 512, P_FV = 1024, P_GQ = 1536, P_GK = 1792, P_GV = 2048, P_GR = 2560;
__device__ __forceinline__ int inproj_src(int d) {
    if (d < 1536) return d;
    if (d < 1792) return O_GQ + (d - 1536);
    if (d < 2048) return O_GK + (d - 1792);
    if (d < 2560) return O_GV + (d - 2048);
    if (d < 3072) return O_GR + (d - 2560);
    if (d < 3080) return O_FF + (d - 3072);
    if (d < 3096) return O_GA + (d - 3080);
    return -1;
}
__device__ __forceinline__ unsigned f2bf(float f) { unsigned u = __builtin_bit_cast(unsigned, f); return (u + 0x7fffu + ((u >> 16) & 1u)) >> 16; }
__device__ __forceinline__ unsigned pk2(float lo, float hi) { return f2bf(lo) | (f2bf(hi) << 16); }
__device__ __forceinline__ float bf2f(unsigned short h) { return __builtin_bit_cast(float, (unsigned)h << 16); }
__device__ __forceinline__ float wave_sum(float v) {
#pragma unroll
    for (int o = 1; o < 64; o <<= 1) v += __shfl_xor(v, o);
    return v;
}
#define FX_LDS_WAIT() asm volatile("s_waitcnt lgkmcnt(0)" ::: "memory")

template <class Map> __device__ __forceinline__ void transpose_item(const float* __restrict__ W, int K, int N, bf16* WT, LAS float* scr, int kb, int nb, int lane, Map srcmap) {
    const int k0 = 64 * kb, n0 = 32 * nb;
    const int src = srcmap(n0 + (lane & 31));
#pragma unroll 8
    for (int i = 0; i < 32; ++i) { const int kk = 2 * i + (lane >> 5); scr[kk * 33 + (lane & 31)] = (src >= 0) ? W[(size_t)(k0 + kk) * N + src] : 0.f; }
    FX_LDS_WAIT(); asm volatile("" ::: "memory");
    const int c = lane & 7;
#pragma unroll
    for (int j = 0; j < 4; ++j) { const int n = (lane >> 3) + 8 * j; const LAS float* s = scr + (8 * c) * 33 + n;
        v4u o; o.x = pk2(s[0 * 33], s[1 * 33]); o.y = pk2(s[2 * 33], s[3 * 33]); o.z = pk2(s[4 * 33], s[5 * 33]); o.w = pk2(s[6 * 33], s[7 * 33]);
        *(GAS v4u*)(WT + (size_t)(n0 + n) * K + k0 + 8 * c) = o; }
    FX_LDS_WAIT(); asm volatile("" ::: "memory");
}

__device__ __forceinline__ void ln_row_bf16(const float* xrow, const float* __restrict__ g, const float* __restrict__ b, bf16* orow, float* frow, float* st, int lane) {
    const GAS f32x4* xr = (const GAS f32x4*)xrow + lane;
    f32x4 v[4]; float s = 0.f;
#pragma unroll
    for (int j = 0; j < 4; ++j) { v[j] = xr[64 * j]; s += (v[j].x + v[j].y) + (v[j].z + v[j].w); }
    const float mean = wave_sum(s) * (1.f / D); float s2 = 0.f;
#pragma unroll
    for (int j = 0; j < 4; ++j) { v[j] = v[j] - mean; s2 += (v[j].x * v[j].x + v[j].y * v[j].y) + (v[j].z * v[j].z + v[j].w * v[j].w); }
    const float rstd = 1.f / sqrtf(wave_sum(s2) * (1.f / D) + LN_EPS);
    if (st && lane == 0) { st[0] = mean; st[1] = rstd; }
    GAS unsigned long long* o8 = (GAS unsigned long long*)orow + lane;
#pragma unroll
    for (int j = 0; j < 4; ++j) {
        const f32x4 gg = ((const f32x4*)g)[lane + 64 * j], bb = ((const f32x4*)b)[lane + 64 * j];
        const f32x4 o = v[j] * rstd * gg + bb;
        o8[64 * j] = (unsigned long long)pk2(o.x, o.y) | ((unsigned long long)pk2(o.z, o.w) << 32);
        if (frow) ((GAS f32x4*)frow)[lane + 64 * j] = o;
    }
}

struct CvItem { const float* W; bf16* WT; int N, K, k0, n0, s0; };
__device__ __forceinline__ void cv_load(const CvItem& it, f32x4 (&v)[8], int lane) {
    const float* p = it.W + (size_t)(it.k0 + (lane >> 3)) * it.N + it.s0 + 4 * (lane & 7);
#pragma unroll
    for (int i = 0; i < 8; ++i) v[i] = __builtin_nontemporal_load((const f32x4*)(p + (size_t)(8 * i) * it.N));
}
__device__ __forceinline__ void cv_finish(const CvItem& it, const f32x4 (&v)[8], LAS float* scr, int lane) {
    const int rr = lane >> 3, cq = lane & 7;
#pragma unroll
    for (int i = 0; i < 8; ++i) { LAS float* d = scr + (8 * i + rr) * 33 + 4 * cq; d[0] = v[i][0]; d[1] = v[i][1]; d[2] = v[i][2]; d[3] = v[i][3]; }
    FX_LDS_WAIT(); asm volatile("" ::: "memory");
    const int c = lane & 7;
#pragma unroll
    for (int j = 0; j < 4; ++j) { const int n = (lane >> 3) + 8 * j; const LAS float* s = scr + (8 * c) * 33 + n;
        v4u o; o.x = pk2(s[0 * 33], s[1 * 33]); o.y = pk2(s[2 * 33], s[3 * 33]); o.z = pk2(s[4 * 33], s[5 * 33]); o.w = pk2(s[6 * 33], s[7 * 33]);
        __builtin_nontemporal_store(o, (GAS v4u*)(it.WT + (size_t)(it.n0 + n) * it.K + it.k0 + 8 * c)); }
    FX_LDS_WAIT(); asm volatile("" ::: "memory");
}

template <int NR> __device__ __forceinline__ void ln_rows_bf16(const float* xrows, const float* __restrict__ g, const float* __restrict__ b, bf16* orows, int lane, float* st = nullptr) {
    f32x4 v[NR][4];
#pragma unroll
    for (int r = 0; r < NR; ++r)
#pragma unroll
        for (int j = 0; j < 4; ++j) v[r][j] = ((const GAS f32x4*)(xrows + (size_t)r * D))[lane + 64 * j];
    f32x4 gg[4], bb[4];
#pragma unroll
    for (int j = 0; j < 4; ++j) { gg[j] = ((const f32x4*)g)[lane + 64 * j]; bb[j] = ((const f32x4*)b)[lane + 64 * j]; }
#pragma unroll
    for (int r = 0; r < NR; ++r) {
        float s = 0.f;
#pragma unroll
        for (int j = 0; j < 4; ++j) s += (v[r][j].x + v[r][j].y) + (v[r][j].z + v[r][j].w);
        const float mean = wave_sum(s) * (1.f / D); float s2 = 0.f;
#pragma unroll
        for (int j = 0; j < 4; ++j) { v[r][j] = v[r][j] - mean; s2 += (v[r][j].x * v[r][j].x + v[r][j].y * v[r][j].y) + (v[r][j].z * v[r][j].z + v[r][j].w * v[r][j].w); }
        const float rstd = 1.f / sqrtf(wave_sum(s2) * (1.f / D) + LN_EPS);
        if (st && lane == 0) { st[2 * r] = mean; st[2 * r + 1] = rstd; }
        GAS unsigned long long* o8 = (GAS unsigned long long*)(orows + (size_t)r * D) + lane;
#pragma unroll
        for (int j = 0; j < 4; ++j) { const f32x4 o = v[r][j] * rstd * gg[j] + bb[j];
            o8[64 * j] = (unsigned long long)pk2(o.x, o.y) | ((unsigned long long)pk2(o.z, o.w) << 32); }
    }
}

template <int NR> __device__ __forceinline__ void ln1_rows_bf16(const float* xrows, const float* st, const float* __restrict__ gi, const float* __restrict__ bi, const bf16* mixrows,
                                                               const float* __restrict__ g1, const float* __restrict__ b1, bf16* orows, float alpha, int lane) {
    f32x4 v[NR][4]; unsigned long long mx[NR][4]; float mean0[NR], rstd0[NR];
#pragma unroll
    for (int r = 0; r < NR; ++r) { mean0[r] = st[2 * r]; rstd0[r] = st[2 * r + 1];
#pragma unroll
        for (int j = 0; j < 4; ++j) { v[r][j] = ((const GAS f32x4*)(xrows + (size_t)r * D))[lane + 64 * j]; mx[r][j] = ((const GAS unsigned long long*)(mixrows + (size_t)r * D))[lane + 64 * j]; } }
    f32x4 gi4[4], bi4[4];
#pragma unroll
    for (int j = 0; j < 4; ++j) { gi4[j] = ((const f32x4*)gi)[lane + 64 * j] * alpha; bi4[j] = ((const f32x4*)bi)[lane + 64 * j] * alpha; }
#pragma unroll
    for (int r = 0; r < NR; ++r) {
        float s = 0.f;
#pragma unroll
        for (int j = 0; j < 4; ++j) { const unsigned lo = (unsigned)mx[r][j], hi = (unsigned)(mx[r][j] >> 32);
            f32x4 mv; mv.x = __builtin_bit_cast(float, lo << 16); mv.y = __builtin_bit_cast(float, lo & 0xffff0000u); mv.z = __builtin_bit_cast(float, hi << 16); mv.w = __builtin_bit_cast(float, hi & 0xffff0000u);
            v[r][j] = ((v[r][j] - mean0[r]) * rstd0[r]) * gi4[j] + bi4[j] + mv;
            s += (v[r][j].x + v[r][j].y) + (v[r][j].z + v[r][j].w); }
        const float mean = wave_sum(s) * (1.f / D); float s2 = 0.f;
#pragma unroll
        for (int j = 0; j < 4; ++j) { v[r][j] = v[r][j] - mean; s2 += (v[r][j].x * v[r][j].x + v[r][j].y * v[r][j].y) + (v[r][j].z * v[r][j].z + v[r][j].w * v[r][j].w); }
        const float rstd = 1.f / sqrtf(wave_sum(s2) * (1.f / D) + LN_EPS);
        GAS unsigned long long* o8 = (GAS unsigned long long*)(orows + (size_t)r * D) + lane;
#pragma unroll
        for (int j = 0; j < 4; ++j) { const f32x4 gg = ((const f32x4*)g1)[lane + 64 * j], bb = ((const f32x4*)b1)[lane + 64 * j]; const f32x4 o = v[r][j] * rstd * gg + bb;
            o8[64 * j] = (unsigned long long)pk2(o.x, o.y) | ((unsigned long long)pk2(o.z, o.w) << 32); }
    }
}
}

namespace pg8 {
struct EpiInProj {
    static constexpr bool PERM = true, AFTER_DRAIN = false;
    bf16_t* QKV; float* FG; float* LF; const float* bfg; unsigned* NRM;
    __device__ __forceinline__ void operator()(const f32x4 (&acc)[2][2][4][2], const Unit& u, int wr, int wc, int fr, int fq) const {
        const int row0 = u.pm * BM + wr * 64 + fr;
        if (u.pn < 12) {
            const float sc = (u.pn < 2) ? fx::C2 : 1.f;
            const int col0 = u.pn * BM + wc * 32 + 8 * fq;
            float nmax[2] = {0.f, 0.f};
#pragma unroll
            for (int ai = 0; ai < 2; ++ai)
#pragma unroll
                for (int m = 0; m < 4; ++m) { bf16_t* rowp = QKV + (size_t)(row0 + ai * HALF + m * 16) * fx::QKVP + col0;
#pragma unroll
                    for (int bj = 0; bj < 2; ++bj) { const f32x4 v0 = acc[ai][bj][m][0] * sc, v1 = acc[ai][bj][m][1] * sc;
                        u32x4 w; w.x = cvt_pk_bf16(v0[0], v0[1]); w.y = cvt_pk_bf16(v0[2], v0[3]); w.z = cvt_pk_bf16(v1[0], v1[1]); w.w = cvt_pk_bf16(v1[2], v1[3]);
                        *(u32x4*)(rowp + bj * HALF) = w;
                        if (u.pn < 4) { const f32x4 q0 = v0 * v0, q1 = v1 * v1; float s = (q0[0] + q0[1]) + (q0[2] + q0[3]) + (q1[0] + q1[1]) + (q1[2] + q1[3]);
                            s += __shfl_xor(s, 16); s += __shfl_xor(s, 32);
                            nmax[bj] = fmaxf(nmax[bj], s); } } }
            if (u.pn < 4) {
#pragma unroll
                for (int bj = 0; bj < 2; ++bj) { float s = nmax[bj];
#pragma unroll
                    for (int o = 1; o < 16; o <<= 1) s = fmaxf(s, __shfl_xor(s, o));
                    if (fr == 0 && fq == 0) { const int b = (u.pm * BM) >> 12, head = 4 * (u.pn & 1) + 2 * bj + (wc >> 1);
                        atomicMax(NRM + (b * 8 + head) * 4 + (u.pn >= 2 ? 2 : 0) + (wc & 1), __builtin_bit_cast(unsigned, s)); } }
            }
        } else if (wc == 0 && fq < 3) {
#pragma unroll
            for (int ai = 0; ai < 2; ++ai)
#pragma unroll
                for (int m = 0; m < 4; ++m) { const int row = row0 + ai * HALF + m * 16; float* p = FG + (size_t)row * 32 + 8 * fq;
                    *(f32x4*)p = acc[ai][0][m][0]; *(f32x4*)(p + 4) = acc[ai][0][m][1];
                    if (fq == 0) { const int b = row >> 12, s = row & 4095;
#pragma unroll
                        for (int n = 0; n < 2; ++n)
#pragma unroll
                            for (int i = 0; i < 4; ++i) { const int h = 4 * n + i; LF[(size_t)(b * 8 + h) * nv::S + s] = -__builtin_amdgcn_logf(1.f + __builtin_amdgcn_exp2f(-1.4426950408889634f * (acc[ai][0][m][n][i] + bfg[h]))); } } }
        }
    }
};
}
namespace gl {
using namespace nv;
typedef unsigned short bf16;
typedef short bf16x8 __attribute__((ext_vector_type(8)));
typedef float f32x4 __attribute__((ext_vector_type(4)));
typedef unsigned u32x4 __attribute__((ext_vector_type(4)));
typedef unsigned u32x2 __attribute__((ext_vector_type(2)));
constexpr int NCH = S / 64;
constexpr int NUNIT = B * GH * NCH;
constexpr int LS = 72;
constexpr int L_WGU = 0, L_BG = 4096, L_DECS = 4352, L_QP = 8192, L_KP = L_QP + 64 * LS * 2, L_KPT = L_KP + 64 * LS * 2, L_VT = L_KPT + 64 * LS * 2, L_PP = L_VT + 128 * LS * 2, L_WT = L_PP + 64 * LS * 2, L_END = L_WT + 2048;
static_assert(L_END <= 131072, "gla prep LDS");
constexpr int C_ST = 0, C_PART = 128 * LS * 2, C_END = C_PART + 2 * 8 * 64 * 4;
constexpr size_t QPG_B = 64 * 64 * 2, OI_B = 8 * 4 * 64 * 16, UU_B = OI_B, DEC_B = 256;

__device__ __forceinline__ unsigned pkbf(float lo, float hi) { typedef float f2 __attribute__((ext_vector_type(2))); typedef __bf16 b2 __attribute__((ext_vector_type(2))); f2 v = {lo, hi}; b2 r = __builtin_convertvector(v, b2); return __builtin_bit_cast(unsigned, r); }
__device__ __forceinline__ float bf2f(unsigned short h) { return __builtin_bit_cast(float, (unsigned)h << 16); }
__device__ __forceinline__ float bflo(unsigned w) { return __builtin_bit_cast(float, w << 16); }
__device__ __forceinline__ float bfhi(unsigned w) { return __builtin_bit_cast(float, w & 0xffff0000u); }
__device__ __forceinline__ float fast_logsig2(float x) { return -__builtin_amdgcn_logf(1.f + __builtin_amdgcn_exp2f(-1.4426950408889634f * x)); }

__device__ __forceinline__ void prep_unit(int unit, const bf16* QKV, const float* FG, const float* __restrict__ wgu, const float* __restrict__ bgate,
                                          unsigned char* QPG, unsigned char* OI, unsigned char* UU, float* DEC, unsigned char* lds, int& cur_h, f32x4 (&Sagg)[4], f32x4 (&Dagg)[4]) {
    int tid_ = threadIdx.x; asm volatile("" : "+v"(tid_));
    const int tid = tid_, lane = tid & 63, wid = __builtin_amdgcn_readfirstlane(tid >> 6), l15 = lane & 15, g = lane >> 4;
    const int n = unit % NCH, bh = unit / NCH, h = bh % GH, b = bh / GH;
    const size_t row0 = (size_t)b * S + (size_t)n * 64;
    float* WGU = (float*)(lds + L_WGU); float* BG = (float*)(lds + L_BG); float* WT = (float*)(lds + L_WT);
    bf16* QP = (bf16*)(lds + L_QP); bf16* KP = (bf16*)(lds + L_KP); bf16* KPT = (bf16*)(lds + L_KPT); bf16* VT = (bf16*)(lds + L_VT); bf16* PP = (bf16*)(lds + L_PP);
    if (cur_h != h) { __syncthreads(); for (int i = tid; i < 16 * 64; i += 512) WGU[i] = wgu[(i >> 6) * 256 + h * 64 + (i & 63)]; if (tid < 64) BG[tid] = bgate[h * 64 + tid]; cur_h = h; __syncthreads(); }
    const int t = tid >> 3, oc = tid & 7, d0 = oc * 8;
    float la[8];
    { const float* gp = FG + (row0 + t) * 32 + 8;
      f32x4 ga4[4];
#pragma unroll
      for (int i = 0; i < 4; ++i) ga4[i] = *(const f32x4*)(gp + 4 * i);
#pragma unroll
      for (int j = 0; j < 8; ++j) la[j] = BG[d0 + j];
#pragma unroll
      for (int r = 0; r < 16; ++r) { const float gv = ga4[r >> 2][r & 3]; const f32x4 w0 = *(const f32x4*)(WGU + r * 64 + d0), w1 = *(const f32x4*)(WGU + r * 64 + d0 + 4);
#pragma unroll
          for (int j = 0; j < 4; ++j) { la[j] += gv * w0[j]; la[4 + j] += gv * w1[j]; } }
#pragma unroll
      for (int j = 0; j < 8; ++j) la[j] = fast_logsig2(la[j]) * (1.f / 16.f); }
    const u32x4 qv = *(const u32x4*)(QKV + (row0 + t) * fx::QKVP + fx::P_GQ + h * 64 + d0);
    const u32x4 kv = *(const u32x4*)(QKV + (row0 + t) * fx::QKVP + fx::P_GK + h * 64 + d0);
    const u32x4 vv0 = *(const u32x4*)(QKV + (row0 + t) * fx::QKVP + fx::P_GV + h * 128 + oc * 16);
    const u32x4 vv1 = *(const u32x4*)(QKV + (row0 + t) * fx::QKVP + fx::P_GV + h * 128 + oc * 16 + 8);
#pragma unroll
    for (int off = 8; off < 64; off <<= 1) {
#pragma unroll
        for (int j = 0; j < 8; ++j) { const float o = __shfl_up(la[j], off); if (lane >= off) la[j] += o; } }
    if (lane >= 56) {
#pragma unroll
        for (int j = 0; j < 8; ++j) WT[wid * 64 + d0 + j] = la[j]; }
    __syncthreads();
    float bl[8];
#pragma unroll
    for (int j = 0; j < 8; ++j) bl[j] = 0.f;
#pragma unroll
    for (int w = 0; w < 8; ++w) {
        const f32x4 a0 = *(const f32x4*)(WT + w * 64 + d0), a1 = *(const f32x4*)(WT + w * 64 + d0 + 4);
#pragma unroll
        for (int j = 0; j < 4; ++j) { bl[j] += a0[j]; bl[4 + j] += a1[j]; if (w < wid) { la[j] += a0[j]; la[4 + j] += a1[j]; } } }
    {
        const unsigned qw[4] = {qv.x, qv.y, qv.z, qv.w}, kw[4] = {kv.x, kv.y, kv.z, kv.w};
        float qf[8], kf[8];
#pragma unroll
        for (int i = 0; i < 4; ++i) { qf[2 * i] = bflo(qw[i]); qf[2 * i + 1] = bfhi(qw[i]); kf[2 * i] = bflo(kw[i]); kf[2 * i + 1] = bfhi(kw[i]); }
        float qp[8], kp[8], kpp[8];
#pragma unroll
        for (int j = 0; j < 8; ++j) { const float bb = la[j], bbl = bl[j];
            qp[j] = qf[j] * (0.125f * __builtin_amdgcn_exp2f(bb)); kp[j] = kf[j] * __builtin_amdgcn_exp2f(-bb); kpp[j] = kf[j] * __builtin_amdgcn_exp2f(bbl - bb); }
        u32x4 qo, ko; qo.x = pkbf(qp[0], qp[1]); qo.y = pkbf(qp[2], qp[3]); qo.z = pkbf(qp[4], qp[5]); qo.w = pkbf(qp[6], qp[7]);
        ko.x = pkbf(kp[0], kp[1]); ko.y = pkbf(kp[2], kp[3]); ko.z = pkbf(kp[4], kp[5]); ko.w = pkbf(kp[6], kp[7]);
        *(u32x4*)(QP + t * LS + d0) = qo; *(u32x4*)(KP + t * LS + d0) = ko;
        *(u32x4*)(QPG + (size_t)unit * QPG_B + (size_t)(t * 64 + d0) * 2) = qo;
#pragma unroll
        for (int j = 0; j < 8; ++j) KPT[(d0 + j) * LS + t] = (bf16)(pkbf(kpp[j], 0.f) & 0xffffu);
        const unsigned vw[8] = {vv0.x, vv0.y, vv0.z, vv0.w, vv1.x, vv1.y, vv1.z, vv1.w};
#pragma unroll
        for (int i = 0; i < 8; ++i) { VT[(oc * 16 + 2 * i) * LS + t] = (bf16)(vw[i] & 0xffffu); VT[(oc * 16 + 2 * i + 1) * LS + t] = (bf16)(vw[i] >> 16); }
        if (t == 0) {
#pragma unroll
            for (int j = 0; j < 8; ++j) { const float dc = __builtin_amdgcn_exp2f(bl[j]); DEC[(size_t)unit * 64 + d0 + j] = dc; ((float*)(lds + L_DECS))[d0 + j] = dc; } }
    }
    __syncthreads();
    { const int ti = wid >> 1;
#pragma unroll
      for (int q2 = 0; q2 < 2; ++q2) { const int sj = 2 * (wid & 1) + q2;
          f32x4 acc = {0.f, 0.f, 0.f, 0.f};
          if (sj <= ti) {
#pragma unroll
              for (int ks = 0; ks < 2; ++ks) { const bf16x8 a = *(const bf16x8*)(QP + (16 * ti + l15) * LS + 32 * ks + 8 * g), bb = *(const bf16x8*)(KP + (16 * sj + l15) * LS + 32 * ks + 8 * g);
                  acc = __builtin_amdgcn_mfma_f32_16x16x32_bf16(a, bb, acc, 0, 0, 0); }
              if (sj == ti) {
#pragma unroll
                  for (int r = 0; r < 4; ++r) if (l15 > 4 * g + r) acc[r] = 0.f; }
          }
#pragma unroll
          for (int r = 0; r < 4; ++r) PP[(16 * ti + 4 * g + r) * LS + 16 * sj + l15] = (bf16)(pkbf(acc[r], 0.f) & 0xffffu);
      } }
    __syncthreads();
    { bf16x8 vb[2];
#pragma unroll
      for (int ks = 0; ks < 2; ++ks) vb[ks] = *(const bf16x8*)(VT + (16 * wid + l15) * LS + 32 * ks + 8 * g);
#pragma unroll
      for (int m = 0; m < 4; ++m) { f32x4 acc = {0.f, 0.f, 0.f, 0.f};
#pragma unroll
          for (int ks = 0; ks < 2; ++ks) { const bf16x8 a = *(const bf16x8*)(PP + (16 * m + l15) * LS + 32 * ks + 8 * g); acc = __builtin_amdgcn_mfma_f32_16x16x32_bf16(a, vb[ks], acc, 0, 0, 0); }
          *(f32x4*)(OI + (size_t)unit * OI_B + (size_t)((wid * 4 + m) * 64 + lane) * 16) = acc; }
#pragma unroll
      for (int db = 0; db < 4; ++db) { f32x4 acc = {0.f, 0.f, 0.f, 0.f};
#pragma unroll
          for (int ks = 0; ks < 2; ++ks) { const bf16x8 a = *(const bf16x8*)(KPT + (16 * db + l15) * LS + 32 * ks + 8 * g); acc = __builtin_amdgcn_mfma_f32_16x16x32_bf16(a, vb[ks], acc, 0, 0, 0); }
          *(f32x4*)(UU + (size_t)unit * UU_B + (size_t)((wid * 4 + db) * 64 + lane) * 16) = acc;
          const f32x4 dcv = *(const f32x4*)((const float*)(lds + L_DECS) + 16 * db + 4 * g);
          Sagg[db] = dcv * Sagg[db] + acc; Dagg[db] = Dagg[db] * dcv; }
    }
}


__device__ __forceinline__ void prep_block(int blk, const bf16* QKV, const float* FG, const float* __restrict__ wgu, const float* __restrict__ bgate,
                                           unsigned char* QPG, unsigned char* OI, unsigned char* UU, float* DEC, unsigned char* AGG, float* DAGG, unsigned char* lds, int& cur_h) {
    f32x4 Sagg[4], Dagg[4];
#pragma unroll
    for (int db = 0; db < 4; ++db) { Sagg[db] = (f32x4){0.f, 0.f, 0.f, 0.f}; Dagg[db] = (f32x4){1.f, 1.f, 1.f, 1.f}; }
    for (int i = 0; i < 8; ++i) prep_unit(blk * 8 + i, QKV, FG, wgu, bgate, QPG, OI, UU, DEC, lds, cur_h, Sagg, Dagg);
    int tid_ = threadIdx.x; asm volatile("" : "+v"(tid_));
    const int lane = tid_ & 63, wid = __builtin_amdgcn_readfirstlane(tid_ >> 6), l15 = lane & 15, g = lane >> 4;
#pragma unroll
    for (int db = 0; db < 4; ++db) { *(f32x4*)(AGG + (size_t)blk * UU_B + (size_t)((wid * 4 + db) * 64 + lane) * 16) = Sagg[db];
        if (wid == 0 && l15 == 0) *(f32x4*)(DAGG + (size_t)blk * 64 + 16 * db + 4 * g) = Dagg[db]; }
}
constexpr int GS = 136;
constexpr int PO_GR = 0, PO_YT = 64 * GS * 2, PO_PART = 2 * 64 * GS * 2, PO_ST = PO_PART + 8 * 64 * 4, PO_END = PO_ST + 128 * LS * 2;
__device__ __forceinline__ void post_block(int u0, int NB, const bf16* QKV, const unsigned char* QPG, const unsigned char* OI, const unsigned char* UU, const float* DEC, const unsigned char* AGG, const float* DAGG, const float* __restrict__ gnorm, bf16* Y, unsigned char* lds) {
    int tid_ = threadIdx.x; asm volatile("" : "+v"(tid_));
    const int tid = tid_, lane = tid & 63, wid = __builtin_amdgcn_readfirstlane(tid >> 6), l15 = lane & 15, g = lane >> 4;
    const int n0 = u0 % NCH, bh = u0 / NCH, h = bh % GH, b = bh / GH;
    bf16* GRs = (bf16*)(lds + PO_GR); bf16* YT = (bf16*)(lds + PO_YT); float* PART = (float*)(lds + PO_PART); bf16* ST = (bf16*)(lds + PO_ST);
    const int t = tid >> 3, oc = tid & 7, e = 16 * wid + l15;
    const float gn = gnorm[e];
    f32x4 Sa[4];
#pragma unroll
    for (int db = 0; db < 4; ++db) Sa[db] = (f32x4){0.f, 0.f, 0.f, 0.f};
    { const int seg0 = bh * (NCH / 8), nseg = n0 / 8;
      for (int i = 0; i < nseg; ++i) {
          f32x4 Ua[4], Da[4];
#pragma unroll
          for (int db = 0; db < 4; ++db) { Ua[db] = *(const f32x4*)(AGG + (size_t)(seg0 + i) * UU_B + (size_t)((wid * 4 + db) * 64 + lane) * 16); Da[db] = *(const f32x4*)(DAGG + (size_t)(seg0 + i) * 64 + 16 * db + 4 * g); }
#pragma unroll
          for (int db = 0; db < 4; ++db) Sa[db] = Da[db] * Sa[db] + Ua[db]; } }
    for (int i = 0; i < NB; ++i) {
        const int unit = u0 + i; const size_t row0 = (size_t)b * S + (size_t)(n0 + i) * 64;
        const u32x4 g0 = *(const u32x4*)(QKV + (row0 + t) * fx::QKVP + fx::P_GR + h * 128 + oc * 16), g1 = *(const u32x4*)(QKV + (row0 + t) * fx::QKVP + fx::P_GR + h * 128 + oc * 16 + 8);
        f32x4 o[4], Uf[4], dv[4]; bf16x8 qa[4][2], sb[2];
#pragma unroll
        for (int m = 0; m < 4; ++m) { o[m] = *(const f32x4*)(OI + (size_t)unit * OI_B + (size_t)((wid * 4 + m) * 64 + lane) * 16);
            Uf[m] = *(const f32x4*)(UU + (size_t)unit * UU_B + (size_t)((wid * 4 + m) * 64 + lane) * 16); dv[m] = *(const f32x4*)(DEC + (size_t)unit * 64 + 16 * m + 4 * g);
#pragma unroll
            for (int ks = 0; ks < 2; ++ks) qa[m][ks] = *(const bf16x8*)(QPG + (size_t)unit * QPG_B + (size_t)((16 * m + l15) * 64 + 32 * ks + 8 * g) * 2); }
#pragma unroll
        for (int db = 0; db < 4; ++db) *(u32x2*)(ST + e * LS + 16 * db + 4 * g) = (u32x2){pkbf(Sa[db][0], Sa[db][1]), pkbf(Sa[db][2], Sa[db][3])};
#pragma unroll
        for (int ks = 0; ks < 2; ++ks) sb[ks] = *(const bf16x8*)(ST + e * LS + 32 * ks + 8 * g);
        *(u32x4*)(GRs + t * GS + oc * 16) = g0; *(u32x4*)(GRs + t * GS + oc * 16 + 8) = g1;
#pragma unroll
        for (int m = 0; m < 4; ++m)
#pragma unroll
            for (int ks = 0; ks < 2; ++ks) o[m] = __builtin_amdgcn_mfma_f32_16x16x32_bf16(qa[m][ks], sb[ks], o[m], 0, 0, 0);
#pragma unroll
        for (int m = 0; m < 4; ++m) { f32x4 q = o[m] * o[m];
#pragma unroll
            for (int off = 1; off < 16; off <<= 1) { q[0] += __shfl_xor(q[0], off); q[1] += __shfl_xor(q[1], off); q[2] += __shfl_xor(q[2], off); q[3] += __shfl_xor(q[3], off); }
            if (l15 == 0) *(f32x4*)(PART + wid * 64 + 16 * m + 4 * g) = q; }
#pragma unroll
        for (int db = 0; db < 4; ++db) Sa[db] = dv[db] * Sa[db] + Uf[db];
        __syncthreads();
#pragma unroll
        for (int m = 0; m < 4; ++m) { f32x4 tot = {0.f, 0.f, 0.f, 0.f};
#pragma unroll
            for (int w = 0; w < 8; ++w) tot += *(const f32x4*)(PART + w * 64 + 16 * m + 4 * g);
#pragma unroll
            for (int r = 0; r < 4; ++r) { const int tt = 16 * m + 4 * g + r; const float rs = rsqrtf(tot[r] * (1.f / GV) + LN_EPS); const float gr = bf2f(GRs[tt * GS + e]);
                const float v = o[m][r] * rs * gn * (gr * __builtin_amdgcn_rcpf(1.f + __builtin_amdgcn_exp2f(-1.4426950408889634f * gr)));
                YT[tt * GS + e] = (bf16)(pkbf(v, 0.f) & 0xffffu); } }
        __syncthreads();
        { const u32x4 y0 = *(const u32x4*)(YT + t * GS + oc * 16), y1 = *(const u32x4*)(YT + t * GS + oc * 16 + 8);
          *(u32x4*)(Y + (row0 + t) * D + 512 + h * GV + oc * 16) = y0; *(u32x4*)(Y + (row0 + t) * D + 512 + h * GV + oc * 16 + 8) = y1; }
        __syncthreads();
    }
}
}
namespace mo {
using namespace nv;
typedef unsigned short bf16;
typedef float f32x4 __attribute__((ext_vector_type(4)));
typedef unsigned u32x4 __attribute__((ext_vector_type(4)));
constexpr int CAP = 8192;
constexpr int NEX = NE + 1;
constexpr int YSH = T * TOPK;
constexpr int L_TB = 132096, L_YB = L_TB + 1040, L_CN = L_YB + 1040, L_UT = 138240, L_RG = 141312;
typedef LAS int* lint;


constexpr int I_EG = NEX * 256, I_ED = NEX * 128, I_EXP = I_EG + I_ED;
struct ExpW { const float* eg; const float* eu; const float* ed; const float* sg; const float* su; const float* sd; bf16* WegT; bf16* WedT; };
__device__ __forceinline__ void cv_decode(int r, const ExpW& X, fx::CvItem& I) {
    if (r < I_EG) { const int e = r >> 8, kb = (r >> 4) & 15, nb = r & 15, c = nb >> 3, sub = nb & 7;
        I.W = (e < NE) ? ((sub < 4 ? X.eg : X.eu) + (size_t)e * D * ED) : (sub < 4 ? X.sg : X.su); I.WT = X.WegT + (size_t)e * 512 * D; I.N = ED; I.K = D; I.k0 = 64 * kb; I.n0 = 32 * nb; I.s0 = 128 * c + 32 * (sub & 3); }
    else { r -= I_EG; const int e = r >> 7, kb = (r >> 5) & 3, nb = r & 31; I.W = (e < NE) ? (X.ed + (size_t)e * ED * D) : X.sd; I.WT = X.WedT + (size_t)e * D * ED; I.N = D; I.K = ED; I.k0 = 64 * kb; I.n0 = 32 * nb; I.s0 = 32 * nb; }
}
__device__ __forceinline__ void expert_conv(const ExpW& X, LAS float* scr, int it0, int step, int lane) {
    int it = it0; fx::CvItem cur, nx; fx::f32x4 v[8], w[8];
    if (it < I_EXP) { cv_decode(it, X, cur); fx::cv_load(cur, v, lane); }
    while (it < I_EXP) { const int itn = it + step; if (itn < I_EXP) { cv_decode(itn, X, nx); fx::cv_load(nx, w, lane); }
        fx::cv_finish(cur, v, scr, lane); cur = nx;
#pragma unroll
        for (int i = 0; i < 8; ++i) v[i] = w[i];
        it = itn; }
}

__device__ __forceinline__ void moe_tables(const int* counts, lint tb, lint yb, lint cn, int lane) {
    int c[4], nt[4]; int st = 0, sy = 0, pt[4], py[4];
#pragma unroll
    for (int i = 0; i < 4; ++i) { c[i] = counts[lane * 4 + i]; c[i] = c[i] > CAP ? CAP : c[i]; nt[i] = (c[i] + 255) >> 8; pt[i] = st; py[i] = sy; st += nt[i]; sy += c[i]; }
    int it = st, iy = sy;
    for (int o = 1; o < 64; o <<= 1) { const int a = __shfl_up(it, o), b = __shfl_up(iy, o); if (lane >= o) { it += a; iy += b; } }
    const int bt = it - st, by = iy - sy;
#pragma unroll
    for (int i = 0; i < 4; ++i) { tb[lane * 4 + i] = bt + pt[i]; yb[lane * 4 + i] = by + py[i]; cn[lane * 4 + i] = c[i]; }
    if (lane == 63) { tb[256] = it; tb[257] = it + T / 256; yb[256] = YSH; cn[256] = T; }
}

__device__ __forceinline__ void route_token2(const float* LG, const float* __restrict__ rbias, int* lcnt, int* TK, float* TW, int t0, int lane) {
    const int l32 = lane & 31, hb = lane & 32, t = t0 + (lane >> 5);
    const float4 la = ((const float4*)(LG + (size_t)t * NE))[2 * l32], lb = ((const float4*)(LG + (size_t)t * NE))[2 * l32 + 1];
    const float4 ra = ((const float4*)rbias)[2 * l32], rb = ((const float4*)rbias)[2 * l32 + 1];
    const float lg[8] = {la.x, la.y, la.z, la.w, lb.x, lb.y, lb.z, lb.w}, rbv[8] = {ra.x, ra.y, ra.z, ra.w, rb.x, rb.y, rb.z, rb.w};
    float sc[8], bv[8];
#pragma unroll
    for (int i = 0; i < 8; ++i) { sc[i] = __builtin_amdgcn_rcpf(1.f + __builtin_amdgcn_exp2f(-1.4426950408889634f * lg[i])); bv[i] = sc[i] + rbv[i]; }
    float m1 = fmaxf(bv[0], bv[1]), m2 = fminf(bv[0], bv[1]);
#pragma unroll
    for (int i = 2; i < 8; ++i) { const float n1 = fmaxf(m1, bv[i]); m2 = fmaxf(fminf(m1, bv[i]), m2); m1 = n1; }
#pragma unroll
    for (int o = 1; o < 4; o <<= 1) { const float p1 = __shfl_xor(m1, o), p2 = __shfl_xor(m2, o); const float n1 = fmaxf(m1, p1); m2 = fmaxf(fminf(m1, p1), fmaxf(m2, p2)); m1 = n1; }
    const float gs = m1 + m2;
    const int myg = l32 >> 2;
    int rank = 0;
#pragma unroll
    for (int g2 = 0; g2 < NG; ++g2) { const float og = __shfl(gs, hb + g2 * 4); if (og > gs || (og == gs && g2 < myg)) ++rank; }
    const bool sel = rank < 4;
    float mv[8];
#pragma unroll
    for (int i = 0; i < 8; ++i) mv[i] = sel ? bv[i] : -INFINITY;
    int mye = 0; float myw = 0.f; float wsum = 0.f;
#pragma unroll
    for (int k = 0; k < TOPK; ++k) {
        float bvv = mv[0]; int bi = 0;
#pragma unroll
        for (int i = 1; i < 8; ++i) if (mv[i] > bvv) { bvv = mv[i]; bi = i; }
        int gi = l32 * 8 + bi;
#pragma unroll
        for (int o = 16; o > 0; o >>= 1) { const float ov = __shfl_xor(bvv, o); const int oi = __shfl_xor(gi, o); if (ov > bvv || (ov == bvv && oi < gi)) { bvv = ov; gi = oi; } }
        const int ol = gi >> 3, oi = gi & 7;
        float s_own = sc[0];
#pragma unroll
        for (int i = 1; i < 8; ++i) s_own = (oi == i) ? sc[i] : s_own;
        const float sw = __shfl(s_own, hb + ol);
        if (l32 == ol) {
#pragma unroll
            for (int i = 0; i < 8; ++i) if (oi == i) mv[i] = -INFINITY; }
        if (l32 == k) { mye = gi; myw = sw; } wsum += sw;
    }
    if (l32 < TOPK) { const int lp = atomicAdd(&lcnt[mye], 1); TK[t * TOPK + l32] = mye | (lp << 9); TW[t * TOPK + l32] = myw * (2.5f / wsum); }
}
__device__ __forceinline__ void route_finish2(const int* lbase, int* list_tok, float* list_gate, int* TK, const float* TW, int t0, int lane) {
    const int l32 = lane & 31, t = t0 + (lane >> 5);
    if (l32 < TOPK) { const int tk = TK[t * TOPK + l32]; const int e = tk & 511, pos = lbase[e] + (tk >> 9);
        if (pos < CAP) { list_tok[e * CAP + pos] = t; list_gate[e * CAP + pos] = TW[t * TOPK + l32]; }
        TK[t * TOPK + l32] = e | (pos << 9); }
}

constexpr float YSC = 16.f;
__device__ __forceinline__ void combine_token(const bf16* H1, const unsigned char* Y, const int* TK, lint yb, const float* __restrict__ g, const float* __restrict__ b, float* out, int t, int lane) {
    typedef float f2 __attribute__((ext_vector_type(2)));
    float v[16], s[16];
    { const u32x4 a = *(const u32x4*)(H1 + (size_t)t * D + 16 * lane), c = *(const u32x4*)(H1 + (size_t)t * D + 16 * lane + 8);
      const unsigned w[8] = {a.x, a.y, a.z, a.w, c.x, c.y, c.z, c.w};
#pragma unroll
      for (int i = 0; i < 8; ++i) { v[2 * i] = ALPHA * __builtin_bit_cast(float, w[i] << 16); v[2 * i + 1] = ALPHA * __builtin_bit_cast(float, w[i] & 0xffff0000u); } }
#pragma unroll
    for (int i = 0; i < 16; ++i) s[i] = 0.f;
    int tk = (lane < TOPK) ? TK[t * TOPK + lane] : 0;
#pragma unroll
    for (int k = 0; k <= TOPK; ++k) {
        size_t yrow;
        if (k < TOPK) { const int x = __shfl(tk, k); yrow = (size_t)(yb[x & 511] + (x >> 9)); } else yrow = (size_t)YSH + t;
        const u32x4 a = *(const u32x4*)(Y + yrow * D + 16 * lane);
        const int w[4] = {(int)a.x, (int)a.y, (int)a.z, (int)a.w};
#pragma unroll
        for (int i = 0; i < 4; ++i) { const f2 lo = __builtin_amdgcn_cvt_pk_f32_fp8(w[i], false), hi = __builtin_amdgcn_cvt_pk_f32_fp8(w[i], true);
            s[4 * i] += lo[0]; s[4 * i + 1] += lo[1]; s[4 * i + 2] += hi[0]; s[4 * i + 3] += hi[1]; }
    }
    float sm = 0.f;
#pragma unroll
    for (int i = 0; i < 16; ++i) { v[i] += s[i] * (1.f / YSC); sm += v[i]; }
    const float mean = fx::wave_sum(sm) * (1.f / D); float q = 0.f;
#pragma unroll
    for (int i = 0; i < 16; ++i) { v[i] -= mean; q += v[i] * v[i]; }
    const float rstd = 1.f / sqrtf(fx::wave_sum(q) * (1.f / D) + LN_EPS);
#pragma unroll
    for (int i = 0; i < 4; ++i) { const f32x4 gg = *(const f32x4*)(g + 16 * lane + 4 * i), bb = *(const f32x4*)(b + 16 * lane + 4 * i);
        f32x4 o; o[0] = v[4 * i] * rstd * gg[0] + bb[0]; o[1] = v[4 * i + 1] * rstd * gg[1] + bb[1]; o[2] = v[4 * i + 2] * rstd * gg[2] + bb[2]; o[3] = v[4 * i + 3] * rstd * gg[3] + bb[3];
        *(f32x4*)(out + (size_t)t * D + 16 * lane + 4 * i) = o; }
}
}

namespace pg8 {
struct RouterSched {
    int rb; const bf16_t* Bt;
    __device__ __forceinline__ bool next(int i, Unit2& u) const { if (i > 0) return false; u.pm = rb; u.pn = 0; u.e = 0; u.cnt = 128; u.jt = 0; u.ui = 0; return true; }
    __device__ __forceinline__ int arow(const Unit2& u, int r) const { return u.pm * 128 + r; }
    __device__ __forceinline__ size_t aoff(const Unit2&) const { return 0; }
    __device__ __forceinline__ const char* bptr(const Unit2&) const { return (const char*)Bt; }
};
struct EpiLogits {
    static constexpr bool PERM = false, AFTER_DRAIN = false;
    float* LG;
    __device__ __forceinline__ void operator()(const f32x4 (&acc)[2][2][4][2], const Unit2& u, int wr, int wc, int fr, int fq) const {
        const int row0 = u.pm * 128 + wr * 64 + fr, col0 = wc * 32 + 4 * fq;
#pragma unroll
        for (int m = 0; m < 4; ++m) { float* rowp = LG + (size_t)(row0 + m * 16) * nv::NE + col0;
#pragma unroll
            for (int bj = 0; bj < 2; ++bj)
#pragma unroll
                for (int n = 0; n < 2; ++n) *(f32x4*)(rowp + bj * HALF + n * 16) = acc[0][bj][m][n]; }
    }
};
template <int PH> struct MoeSched {
    int G, vcu, nrt; mo::lint tb; mo::lint cn; const int* list_tok; const bf16_t* W; mo::lint ut; mo::lint rg;
    static constexpr int NC = PH == 0 ? 2 : 4;
    static constexpr int MAXU = 64;
    __device__ __forceinline__ void build(int lane) const {
        const int L = lane * G + vcu;
        if (lane < MAXU && L < nrt * NC) {
            const int rt = L / NC, c = L % NC;
            int lo = 0, hi = 256;
            while (lo < hi) { const int mid = (lo + hi + 1) >> 1; if (tb[mid] <= rt) lo = mid; else hi = mid - 1; }
            const int e = lo, jt = rt - tb[e], rem = cn[e] - 256 * jt;
            ut[4 * lane] = rt; ut[4 * lane + 1] = c; ut[4 * lane + 2] = e | (jt << 9); ut[4 * lane + 3] = rem < 256 ? rem : 256;
        }
    }
    __device__ __forceinline__ bool next(int i, Unit2& u) const {
        const int L = i * G + vcu; if (i >= MAXU || L >= nrt * NC) return false;
        const int x = ut[4 * i + 2];
        u.pm = __builtin_amdgcn_readfirstlane(ut[4 * i]); u.pn = __builtin_amdgcn_readfirstlane(ut[4 * i + 1]); u.e = __builtin_amdgcn_readfirstlane(x & 511); u.jt = __builtin_amdgcn_readfirstlane(x >> 9);
        u.cnt = __builtin_amdgcn_readfirstlane(ut[4 * i + 3]); u.ui = i; return true;
    }
    __device__ __forceinline__ void fill_rows(const float* list_gate, int tid) const {
        for (int i = 0; i < MAXU; ++i) { const int L = i * G + vcu; if (L >= nrt * NC) break;
            const int x = ut[4 * i + 2], e = x & 511, jt = x >> 9, cnt = ut[4 * i + 3];
            if (tid < 256) { const int r = tid; unsigned v;
                if (e == 256) v = (unsigned)(jt * BM + r) | (0x4180u << 16);
                else if (r < cnt) { const float gsc = mo::YSC * list_gate[e * mo::CAP + jt * BM + r]; v = (unsigned)list_tok[e * mo::CAP + jt * BM + r] | (fx::f2bf(gsc) << 16); }
                else v = 0u;
                rg[i * 256 + r] = (int)v; } }
    }
    __device__ __forceinline__ int arow(const Unit2& u, int r) const {
        if (PH == 1) return u.pm * BM + r;
        return rg[u.ui * 256 + r] & 0x7fff;
    }
    __device__ __forceinline__ size_t aoff(const Unit2& u) const { return PH == 1 ? (size_t)u.pm * (131072 - 32768) : 0; }
    __device__ __forceinline__ const char* bptr(const Unit2& u) const {
        return PH == 0 ? (const char*)(W + ((size_t)u.e * 512 + 256 * u.pn) * 1024) : (const char*)(W + ((size_t)u.e * 1024 + 256 * u.pn) * 256);
    }
};
struct EpiSwiGLU {
    static constexpr bool PERM = true, AFTER_DRAIN = false;
    bf16_t* H; mo::lint rg; int skip;
    __device__ __forceinline__ void operator()(const f32x4 (&acc)[2][2][4][2], const Unit2& u, int wr, int wc, int fr, int fq) const {
        if (skip) return;
        const int col0 = u.pn * 128 + wc * 32 + 8 * fq;
#pragma unroll
        for (int ai = 0; ai < 2; ++ai)
#pragma unroll
            for (int m = 0; m < 4; ++m) { const int r = ai * HALF + wr * 64 + m * 16 + fr;
                const float gt = __builtin_bit_cast(float, (unsigned)rg[u.ui * 256 + r] & 0xffff0000u);
                float hv[8];
#pragma unroll
                for (int n = 0; n < 2; ++n)
#pragma unroll
                    for (int i = 0; i < 4; ++i) { const float gg = acc[ai][0][m][n][i], uu = acc[ai][1][m][n][i]; hv[4 * n + i] = gt * uu * (gg * __builtin_amdgcn_rcpf(1.f + __builtin_amdgcn_exp2f(-1.4426950408889634f * gg))); }
                u32x4 w; w.x = cvt_pk_bf16(hv[0], hv[1]); w.y = cvt_pk_bf16(hv[2], hv[3]); w.z = cvt_pk_bf16(hv[4], hv[5]); w.w = cvt_pk_bf16(hv[6], hv[7]);
                *(u32x4*)(H + (size_t)u.pm * 65536 + (size_t)(col0 >> 6) * 16384 + r * 64 + (col0 & 63)) = w; }
    }
};
struct EpiDown {
    static constexpr bool PERM = true, PERM16 = true, AFTER_DRAIN = false;
    unsigned char* Y; mo::lint yb; int skip;
    __device__ __forceinline__ void operator()(const f32x4 (&acc)[2][2][4][2], const Unit2& u, int wr, int wc, int fr, int fq) const {
        if (skip) return;
        const int col0 = u.pn * BM + wc * 64 + 16 * fq; const int ybase = yb[u.e] + u.jt * BM;
#pragma unroll
        for (int ai = 0; ai < 2; ++ai)
#pragma unroll
            for (int m = 0; m < 4; ++m) { const int r = ai * HALF + wr * 64 + m * 16 + fr;
                if (r < u.cnt) { u32x4 w; unsigned ww[4];
#pragma unroll
                    for (int bj = 0; bj < 2; ++bj)
#pragma unroll
                        for (int n = 0; n < 2; ++n) { const f32x4 v = acc[ai][bj][m][n]; int x = __builtin_amdgcn_cvt_pk_fp8_f32(v[0], v[1], 0, false); x = __builtin_amdgcn_cvt_pk_fp8_f32(v[2], v[3], x, true); ww[2 * bj + n] = (unsigned)x; }
                    w.x = ww[0]; w.y = ww[1]; w.z = ww[2]; w.w = ww[3];
                    *(u32x4*)(Y + (size_t)(ybase + r) * nv::D + col0) = w; } }
    }
};
}
constexpr int NTHR = 512;
constexpr int LDS_BYTES = 163840;
constexpr int MISC_OFF = 131072 + 320;
constexpr size_t MiB = 1u << 20;
constexpr size_t CTL_ZERO_BYTES = 96 * 1024;
constexpr int CW_BAR = 4096;
constexpr int CW_MOE = 16384;
constexpr int CW_FOXQ = 20992;
constexpr int CW_NRM = 20480;
constexpr int NPHASE = 9;
constexpr size_t WS_H1 = 1, WS_WR = 65, WS_STATS = 66, WS_LF = 67, WS_FG = 68, WS_WO = 72, WS_WIN = 74, WS_TK = 81, WS_LTOK = 83, WS_LGATE = 91,
                 WS_WED = 100, WS_HID = 230, WS_GLA = 230, WS_WEG = 416, WS_XN = 673, WS_YBF = 673, WS_QKV = 737, WS_Z1 = 737, WS_LG = 865, WS_Y = 416, WS_END = 992;

struct Args { const float* in[21]; float* out; unsigned char* ws; int ph_lo, ph_hi, li, pad; };

__global__ void __launch_bounds__(NTHR, 2) mega_fwd(Args a) {
    using namespace nv;
    extern __shared__ __attribute__((aligned(16))) unsigned char lds[];
    const int G = gridDim.x, bx = blockIdx.x;
    const int vcu = (G % 8 == 0) ? (bx % 8) * (G / 8) + bx / 8 : bx;
    int tid, lane, wave, vw;
#define DERIVE() do { int t_ = threadIdx.x; asm volatile("" : "+v"(t_)); tid = t_; lane = tid & 63; wave = __builtin_amdgcn_readfirstlane(tid >> 6); vw = vcu * 8 + wave; } while (0)
    DERIVE();
    volatile LAS unsigned* MISC = (volatile LAS unsigned*)((LAS unsigned char*)lds + MISC_OFF);
    for (int u = tid; u < (LDS_BYTES - 131072) / 4; u += NTHR) ((LAS unsigned*)((LAS unsigned char*)lds + 131072))[u] = 0u;
    __syncthreads();
    unsigned char* ws = a.ws;
    unsigned* ctl = (unsigned*)ws;
    XcdBarrier bar = xcd_barrier_post(ctl + CW_BAR + a.li * XCD_BAR_WORDS, MISC + 8);
    const float* x = a.in[0];
    const float* ln_in_g = a.in[1]; const float* ln_in_b = a.in[2];
    const float* w_in = a.in[3]; const float* b_fgate = a.in[4];
    const float* w_gate_up = a.in[5]; const float* b_gate = a.in[6]; const float* g_gla = a.in[7];
    const float* w_out = a.in[8]; const float* ln1_g = a.in[9]; const float* ln1_b = a.in[10];
    const float* w_router = a.in[11]; const float* rbias = a.in[12];
    const float* w_eg = a.in[13]; const float* w_eu = a.in[14]; const float* w_ed = a.in[15];
    const float* w_sg = a.in[16]; const float* w_su = a.in[17]; const float* w_sd = a.in[18];
    const float* ln2_g = a.in[19]; const float* ln2_b = a.in[20];
    float* out = a.out;
    int* counts = (int*)(ctl + CW_MOE);
    fx::bf16* H1 = (fx::bf16*)(ws + WS_H1 * MiB);
    fx::bf16* WrT = (fx::bf16*)(ws + WS_WR * MiB);
    float* stats = (float*)(ws + WS_STATS * MiB);
    float* LF = (float*)(ws + WS_LF * MiB);
    float* FG = (float*)(ws + WS_FG * MiB);
    fx::bf16* WoT = (fx::bf16*)(ws + WS_WO * MiB);
    fx::bf16* WinT = (fx::bf16*)(ws + WS_WIN * MiB);
    int* TK = (int*)(ws + WS_TK * MiB);
    float* TW = (float*)(ws + (WS_TK + 1) * MiB);
    int* list_tok = (int*)(ws + WS_LTOK * MiB);
    float* list_gate = (float*)(ws + WS_LGATE * MiB);
    fx::bf16* WedT = (fx::bf16*)(ws + WS_WED * MiB);
    fx::bf16* HID = (fx::bf16*)(ws + WS_HID * MiB);
    unsigned char* QPG = ws + WS_GLA * MiB; unsigned char* OIb = ws + (WS_GLA + 16) * MiB; unsigned char* UUb = ws + (WS_GLA + 80) * MiB; float* DECb = (float*)(ws + (WS_GLA + 144) * MiB); unsigned char* AGGb = ws + (WS_GLA + 145) * MiB; float* DAGGb = (float*)(ws + (WS_GLA + 153) * MiB);
    fx::bf16* WegT = (fx::bf16*)(ws + WS_WEG * MiB);
    fx::bf16* XN = (fx::bf16*)(ws + WS_XN * MiB);
    fx::bf16* Ybf = (fx::bf16*)(ws + WS_YBF * MiB);
    fx::bf16* QKV = (fx::bf16*)(ws + WS_QKV * MiB);
    fx::bf16* MIX = (fx::bf16*)(ws + WS_Z1 * MiB);
    float* LG = (float*)(ws + WS_LG * MiB);
    unsigned char* YA = ws + WS_Y * MiB;
    mo::lint tb = (mo::lint)((LAS unsigned char*)lds + mo::L_TB), yb = (mo::lint)((LAS unsigned char*)lds + mo::L_YB), cn = (mo::lint)((LAS unsigned char*)lds + mo::L_CN), ut = (mo::lint)((LAS unsigned char*)lds + mo::L_UT), rg = (mo::lint)((LAS unsigned char*)lds + mo::L_RG);

    const int lo = a.ph_lo, hi = a.ph_hi;
#define IN(k) (lo <= (k) && (k) < hi)
#define SEAM(k) do { if (IN(k) && IN((k) + 1)) xcd_barrier(bar); DERIVE(); } while (0)
    const int GW = G * 8;
#ifndef STG7
#define STG7 0
#endif
#ifndef STG8
#define STG8 0
#endif
#define STAGGER(q) do { if ((q) > 0) { const unsigned long long t0_ = __builtin_amdgcn_s_memrealtime(); const unsigned long long d_ = (unsigned long long)((vcu & 3) * (q)); while (__builtin_amdgcn_s_memrealtime() - t0_ < d_) __builtin_amdgcn_s_sleep(8); } } while (0)

    if (IN(0)) {
        LAS float* scr = (LAS float*)((LAS unsigned char*)lds + wave * 16384);
        constexpr int I_IN = 16 * (fx::NIN / 32), I_OUT = 16 * 32, I_R = 16 * 8, I_SMALL = I_IN + I_OUT + I_R;
        for (int it = vw; it < I_SMALL; it += GW) {
            int r = it;
            if (r < I_IN) { fx::transpose_item(w_in, D, INW, WinT, scr, r / (fx::NIN / 32), r % (fx::NIN / 32), lane, [](int d) { return fx::inproj_src(d); }); continue; } r -= I_IN;
            if (r < I_OUT) { fx::transpose_item(w_out, D, D, WoT, scr, r / 32, r % 32, lane, [](int d) { return d; }); continue; } r -= I_OUT;
            fx::transpose_item(w_router, D, NE, WrT, scr, r / 8, r % 8, lane, [](int d) { return d; });
        }
        for (int r = vw * 4; r < T; r += GW * 4) fx::ln_rows_bf16<4>(x + (size_t)r * D, ln_in_g, ln_in_b, XN + (size_t)r * D, lane, stats + 2 * (size_t)r);
    }
    SEAM(0);
    if (IN(1)) {
        const mo::ExpW XW{w_eg, w_eu, w_ed, w_sg, w_su, w_sd, WegT, WedT};
#ifndef MIXG
#define MIXG 2
#endif
        { const int slot = vcu % MIXG; pg8::StaticOrder S; S.init(T, fx::NIN, G, bx);
          const int nun = (S.nwg - bx + G - 1) / G, nb = (MIXG > 1) ? nun * slot / (MIXG - 1) : nun;
          pg8::Gemm g{XN, WinT, T, fx::NIN, D, D}; pg8::EpiInProj E{QKV, FG, LF, b_fgate, ctl + CW_NRM};
          if (nb > 0) { pg8::RangeOrder R{S, 0, nb}; pg8::gemm_phase<pg8::EpiInProj, pg8::RangeOrder, true, true>((LAS unsigned char*)lds, g, R, E); DERIVE(); }
          mo::expert_conv(XW, (LAS float*)((LAS unsigned char*)lds + wave * 16384), vw, GW, lane); __syncthreads(); DERIVE();
          if (nb < nun) { pg8::RangeOrder R{S, nb, nun - nb}; pg8::gemm_phase<pg8::EpiInProj, pg8::RangeOrder, true, true>((LAS unsigned char*)lds, g, R, E); } }
    }
    SEAM(1);
    if (IN(2)) {
        int cur_h = -1;
        for (int blk = vcu; blk < gl::NUNIT / 8; blk += G) gl::prep_block(blk, QKV, FG, w_gate_up, b_gate, QPG, OIb, UUb, DECb, AGGb, DAGGb, lds, cur_h);
    }
    SEAM(2);
    if (IN(3)) {
        for (int blk = vcu; blk < gl::NUNIT / 8; blk += G) gl::post_block(blk * 8, 8, QKV, QPG, OIb, UUb, DECb, AGGb, DAGGb, g_gla, Ybf, lds);
        { const attn_body::AttnTensors AT{(const attn_body::bf16*)(QKV + fx::P_FQ), (const attn_body::bf16*)(QKV + fx::P_FK), (const attn_body::bf16*)(QKV + fx::P_FV), (attn_body::bf16*)Ybf, LF, ctl + CW_NRM};
          attn_body::attn_phase_dyn<8>((char*)lds, AT, ctl + CW_FOXQ, (volatile int*)(lds + 140288), (G % 8 == 0) ? vcu / (G / 8) : vcu % 8); }
    }
    SEAM(3);
    if (IN(4)) {
        pg8::DenseSched DS; DS.so.init(T, D, G, bx); DS.Bt = WoT; DS.ldb = D;
        pg8::EpiPlainBf16 E{MIX, D};
        pg8::gemm_phase2<pg8::EpiPlainBf16, pg8::DenseSched>((LAS unsigned char*)lds, Ybf, D, D, D, DS, E);
    }
    SEAM(4);
    if (IN(5)) {
        int* lcnt = (int*)(lds + 136192); int* lbase = lcnt + 256;
        for (int rb = vcu; rb < T / 128; rb += G) {
            if (tid < 256) lcnt[tid] = 0;
            for (int r = wave * 16; r < wave * 16 + 16; r += 4) { const size_t row = (size_t)rb * 128 + r;
                fx::ln1_rows_bf16<4>(x + row * D, stats + 2 * row, ln_in_g, ln_in_b, MIX + row * D, ln1_g, ln1_b, H1 + row * D, ALPHA, lane); }
            asm volatile("s_waitcnt vmcnt(0)" ::: "memory"); __syncthreads();
            { pg8::RouterSched RS{rb, WrT}; pg8::EpiLogits E{LG};
              pg8::gemm_phase2<pg8::EpiLogits, pg8::RouterSched>((LAS unsigned char*)lds, H1, D, D, D, RS, E); }
            DERIVE();
            for (int t = rb * 128 + wave * 2; t < rb * 128 + 128; t += 16) mo::route_token2(LG, rbias, lcnt, TK, TW, t, lane);
            __syncthreads();
            if (tid < 256) { const int c = lcnt[tid]; lbase[tid] = c ? atomicAdd(&counts[tid], c) : 0; }
            __syncthreads();
            for (int t = rb * 128 + wave * 2; t < rb * 128 + 128; t += 16) mo::route_finish2(lbase, list_tok, list_gate, TK, TW, t, lane);
            __syncthreads();
        }
    }
    SEAM(5);
    if (IN(6)) {
        if (wave == 0) mo::moe_tables(counts, tb, yb, cn, lane);
        __syncthreads();
        STAGGER(STG7);
        pg8::MoeSched<0> MS{G, vcu, tb[257], tb, cn, list_tok, WegT, ut, rg}; if (wave == 0) MS.build(lane); __syncthreads(); MS.fill_rows(list_gate, tid); __syncthreads(); pg8::EpiSwiGLU E{HID, rg, a.pad};
        pg8::gemm_phase2<pg8::EpiSwiGLU, pg8::MoeSched<0>>((LAS unsigned char*)lds, H1, D, D, D, MS, E);
    }
    SEAM(6);
    if (IN(7)) {
        if (wave == 0) mo::moe_tables(counts, tb, yb, cn, lane);
        __syncthreads();
        STAGGER(STG8);
        pg8::MoeSched<1> MS{G, vcu, tb[257], tb, cn, list_tok, WedT, ut, rg}; if (wave == 0) MS.build(lane); __syncthreads(); pg8::EpiDown E{YA, yb, a.pad};
        pg8::gemm_phase2<pg8::EpiDown, pg8::MoeSched<1>>((LAS unsigned char*)lds, HID, 64, ED, ED, MS, E, 32768);
    }
    SEAM(7);
    if (IN(8)) {
        if (wave == 0) mo::moe_tables(counts, tb, yb, cn, lane);
        __syncthreads();
        for (int t = vw; t < T; t += GW) mo::combine_token(H1, YA, TK, yb, ln2_g, ln2_b, out, t, lane);
    }
#undef IN
#undef SEAM
}

extern "C" void kernel_launch(void* const* d_in, const int* in_sizes, int n_in, void* d_out, int out_size, void* d_ws, size_t ws_size, hipStream_t stream) {
    static int grid = 0;
    if (grid == 0) {
        if (n_in != 21 || out_size != nv::T * nv::D || ws_size < WS_END * MiB) { fprintf(stderr, "kernel_launch: unexpected shapes n_in=%d out=%d ws=%zu\n", n_in, out_size, ws_size); grid = -1; return; }
        int dev = 0, cus = 0;
        if (hipGetDevice(&dev) != hipSuccess || hipDeviceGetAttribute(&cus, hipDeviceAttributeMultiprocessorCount, dev) != hipSuccess) { grid = -1; return; }
        if (hipFuncSetAttribute((const void*)mega_fwd, hipFuncAttributeMaxDynamicSharedMemorySize, LDS_BYTES) != hipSuccess) { fprintf(stderr, "kernel_launch: hipFuncSetAttribute failed\n"); grid = -1; return; }
        grid = cus;
    }
    if (grid < 0) return;
    if (hipMemsetAsync(d_ws, 0, CTL_ZERO_BYTES, stream) != hipSuccess) return;
    Args a{};
    for (int i = 0; i < 21; ++i) a.in[i] = (const float*)d_in[i];
    a.out = (float*)d_out; a.ws = (unsigned char*)d_ws; a.ph_lo = 0; a.ph_hi = NPHASE; a.li = 0;
#ifdef REPEAT_PH
    a.ph_hi = REPEAT_PH + 1; hipLaunchKernelGGL(mega_fwd, dim3(grid), dim3(NTHR), LDS_BYTES, stream, a);
    if (REPEAT_PH == 3) hipMemsetAsync((char*)d_ws + CW_FOXQ * 4, 0, 256, stream);
    if (REPEAT_PH == 5) hipMemsetAsync((char*)d_ws + CW_MOE * 4, 0, 4096, stream);
    a.ph_lo = REPEAT_PH; a.ph_hi = NPHASE; a.li = 1;
#ifdef REPEAT_NOEPI
    a.ph_hi = REPEAT_PH + 1; a.pad = 1; hipLaunchKernelGGL(mega_fwd, dim3(grid), dim3(NTHR), LDS_BYTES, stream, a); a.pad = 0; a.ph_lo = REPEAT_PH + 1; a.ph_hi = NPHASE; a.li = 2;
#endif
#endif
    hipLaunchKernelGGL(mega_fwd, dim3(grid), dim3(NTHR), LDS_BYTES, stream, a);
}
```

```cpp
#include <hip/hip_runtime.h>
#include <cstdio>
#include <cstdint>
#include <cmath>

#define LAS __attribute__((address_space(3)))
#define GAS __attribute__((address_space(1)))

#define XB_TMO      128
#define XB_XCNT(j)  (256  + 64 * (j))
#define XB_XSUB(j)  (1280 + 64 * (j))
#define XB_XGEN(j)  (2304 + 64 * (j))
#define XB_TOP      3328
#define XB_TOPGEN   3392
#define XCD_BAR_WORDS 3456
#define XB_SPIN_CAP (1u << 27)
__device__ __forceinline__ unsigned xb_ld(unsigned* p)              { return __hip_atomic_load(p, __ATOMIC_RELAXED, __HIP_MEMORY_SCOPE_AGENT); }
__device__ __forceinline__ unsigned xb_add(unsigned* p, unsigned v) { return __hip_atomic_fetch_add(p, v, __ATOMIC_RELAXED, __HIP_MEMORY_SCOPE_AGENT); }
__device__ __forceinline__ unsigned xb_xcc_id() { return (unsigned)__builtin_amdgcn_s_getreg((3 << 11) | 20) & 0xFu; }
#define XB_SPIN(cond, bar) do { unsigned _sp = 0; while (cond) { __builtin_amdgcn_s_sleep(1); \
    if ((++_sp & 255u) == 0u) { if (xb_ld(&(bar)[XB_TMO])) break; if (_sp > XB_SPIN_CAP) { atomicAdd(&(bar)[XB_TMO], 1u); break; } } } } while (0)
struct XcdBarrier { unsigned* bar; unsigned x; volatile LAS unsigned* st; };
__device__ __forceinline__ XcdBarrier xcd_barrier_post(unsigned* bar, volatile LAS unsigned* st) {
    XcdBarrier b; b.bar = bar; b.x = xb_xcc_id(); b.st = st;
    if (threadIdx.x == 0) (void)xb_add(&bar[XB_XCNT(b.x)], 1u);
    return b;
}
__device__ __forceinline__ void xcd_barrier_complete(unsigned* bar, unsigned x, unsigned& nloc, unsigned& nx) {
    const unsigned G = gridDim.x * gridDim.y * gridDim.z;
    unsigned sum, cnt, mine, sp = 0u;
    for (;;) {
        sum = 0u; cnt = 0u; mine = 0u;
#pragma unroll
        for (unsigned j = 0; j < 16; ++j) { const unsigned c = xb_ld(&bar[XB_XCNT(j)]); sum += c; cnt += (c > 0u) ? 1u : 0u; mine = (j == x) ? c : mine; }
        if (sum == G) break;
        __builtin_amdgcn_s_sleep(1);
        if ((++sp & 255u) == 0u) { if (xb_ld(&bar[XB_TMO])) break; if (sp > XB_SPIN_CAP) { atomicAdd(&bar[XB_TMO], 1u); break; } }
    }
    nloc = mine > 0u ? mine : 1u; nx = cnt > 0u ? cnt : 1u;
}
__device__ __forceinline__ void xcd_barrier(const XcdBarrier& b) {
    asm volatile("s_waitcnt vmcnt(0)" ::: "memory");
    __syncthreads();
    if (threadIdx.x == 0) {
        unsigned* bar = b.bar;
        __builtin_amdgcn_s_waitcnt(0);
        unsigned nloc = b.st[0], nx = b.st[1];
        if (nloc == 0u) { xcd_barrier_complete(bar, b.x, nloc, nx); b.st[0] = nloc; b.st[1] = nx; }
        const unsigned old = xb_add(&bar[XB_XSUB(b.x)], 1u);
        const unsigned gen = old / nloc;
        if (old + 1u == (gen + 1u) * nloc) {
            __builtin_amdgcn_fence(__ATOMIC_RELEASE, "agent");
            asm volatile("s_waitcnt vmcnt(0)" ::: "memory");
            const unsigned og = xb_add(&bar[XB_TOP], 1u);
            const unsigned tg = og / nx;
            if (og + 1u == (tg + 1u) * nx) xb_add(&bar[XB_TOPGEN], 1u);
            else XB_SPIN(xb_ld(&bar[XB_TOPGEN]) == tg, bar);
            __builtin_amdgcn_fence(__ATOMIC_ACQUIRE, "agent");
            xb_add(&bar[XB_XGEN(b.x)], 1u);
            asm volatile("s_waitcnt vmcnt(0)" ::: "memory");
        } else {
            XB_SPIN(xb_ld(&bar[XB_XGEN(b.x)]) == gen, bar);
            __builtin_amdgcn_fence(__ATOMIC_ACQUIRE, "agent");
            asm volatile("s_waitcnt vmcnt(0)" ::: "memory");
        }
    }
    __syncthreads();
}
namespace pg8 {
#define PG8_LAS __attribute__((address_space(3)))
typedef unsigned short bf16_t;
typedef short bf16x8 __attribute__((ext_vector_type(8)));
typedef float f32x4 __attribute__((ext_vector_type(4)));
typedef unsigned u32x4 __attribute__((ext_vector_type(4)));
constexpr int BM = 256, BK = 64, HALF = 128, HTB = HALF * BK * 2  , STAGE_BYTES = 8 * HTB, NXCD = 8, WGM = 8;

__host__ __device__ __forceinline__ int lds_byte(int r, int c) { const int st = (r >> 4) * 2 + (c >> 5), rr = r & 15, cc = c & 31, ob = rr * 64 + cc * 2; return st * 1024 + (ob ^ (((ob >> 9) & 1) << 5)); }
__host__ __device__ __forceinline__ void stage_rc(int b, int& R, int& C) { const int st = b / 1024, sb = b % 1024, swz = sb ^ (((sb >> 9) & 1) << 5); R = (st >> 1) * 16 + swz / 64; C = (st & 1) * 32 + (swz % 64) / 2; }
__host__ __device__ __forceinline__ int perm32(int rho) { const int n = rho >> 4, i = rho & 15; return 8 * (i >> 2) + 4 * n + (i & 3); }

struct Unit { int pm, pn; };
struct Gemm { const bf16_t* A; const bf16_t* Bt; int M, N, K, lda; };

struct StaticOrder {
    int nM, nN, nwg, G, c;
    __host__ __device__ void init(int M, int N, int G_, int c_) { nM = M / BM; nN = N / BM; nwg = nM * nN; G = G_; c = c_; }
    __host__ __device__ bool next(int i, Unit& u) const {
        const long L = (long)i * G + c; if (L >= nwg) return false;
        int wgid = (int)L; { const int q = nwg / NXCD, r = nwg % NXCD, xcd = wgid % NXCD, off = wgid / NXCD; wgid = (xcd < r ? xcd * (q + 1) : r * (q + 1) + (xcd - r) * q) + off; }
        const int nig = WGM * nN, gid = wgid / nig, fm = gid * WGM, gsz = (nM - fm) < WGM ? (nM - fm) : WGM;
        u.pm = fm + ((wgid % nig) % gsz); u.pn = (wgid % nig) / gsz; return true;
    }
    __device__ __forceinline__ void a_ready(const Unit&) const {}
    __device__ __forceinline__ void done(const Unit&) const {}
};

struct RangeOrder {
    StaticOrder so; int i0, n;
    __host__ __device__ bool next(int i, Unit& u) const { return i < n && so.next(i0 + i, u); }
    __device__ __forceinline__ void a_ready(const Unit&) const {}
    __device__ __forceinline__ void done(const Unit&) const {}
};
__device__ __forceinline__ unsigned cvt_pk_bf16(float lo, float hi) { unsigned r; asm volatile("v_cvt_pk_bf16_f32 %0, %1, %2" : "=v"(r) : "v"(lo), "v"(hi)); return r; }
typedef float f32x2 __attribute__((ext_vector_type(2)));
__device__ __forceinline__ f32x2 gelu_pk(f32x2 v) {
    const f32x2 av = __builtin_elementwise_abs(v), d = av * 0.2316418882f + 1.0f;
    f32x2 t; t.x = __builtin_amdgcn_rcpf(d.x); t.y = __builtin_amdgcn_rcpf(d.y);
    f32x2 q = t * 0.5307027145f + (-0.7265760135f); q = q * t + 0.7107068705f; q = q * t + (-0.142248368f); q = q * t + 0.127414796f; q = q * t;
    const f32x2 s = (v * v) * (-0.72134752044f);
    f32x2 e; e.x = __builtin_amdgcn_exp2f(s.x); e.y = __builtin_amdgcn_exp2f(s.y);
    const f32x2 m = v * (q * e), r = v - m;
    f32x2 o; o.x = v.x < 0.f ? m.x : r.x; o.y = v.y < 0.f ? m.y : r.y; return o;
}

template <int ACT  > struct EpiBf16 {
    static constexpr bool PERM = true, AFTER_DRAIN = false; static_assert(ACT == 0 || ACT == 1, "EpiBf16: ACT is 0 (none) or 1 (gelu_pk)");
    bf16_t* O; int ldc; const float* bias; int split_cols; size_t split_stride; float scale0;
    __device__ __forceinline__ void operator()(const f32x4 (&acc)[2][2][4][2], const Unit& u, int wr, int wc, int fr, int fq) const {
        const int row0 = u.pm * BM + wr * 64 + fr; int colt = u.pn * BM; bf16_t* base = O;
        float sc = 1.f; if (split_cols) { const int t = colt / split_cols; base += (size_t)t * split_stride; colt -= t * split_cols; if (t == 0) sc = scale0; }
        const int col0 = colt + wc * 32 + 8 * fq, bcol0 = u.pn * BM + wc * 32 + 8 * fq;
        f32x4 bv[2][2];
#pragma unroll
        for (int bj = 0; bj < 2; ++bj)
#pragma unroll
            for (int n = 0; n < 2; ++n) bv[bj][n] = bias ? *(const f32x4*)(bias + bcol0 + bj * HALF + 4 * n) : (f32x4){0.f, 0.f, 0.f, 0.f};
#pragma unroll
        for (int ai = 0; ai < 2; ++ai)
#pragma unroll
            for (int m = 0; m < 4; ++m) { bf16_t* rowp = base + (size_t)(row0 + ai * HALF + m * 16) * ldc + col0;
#pragma unroll
                for (int bj = 0; bj < 2; ++bj) { f32x4 v0 = acc[ai][bj][m][0] + bv[bj][0], v1 = acc[ai][bj][m][1] + bv[bj][1];
                    if (ACT == 1) { f32x2 a = gelu_pk((f32x2){v0[0], v0[1]}), b = gelu_pk((f32x2){v0[2], v0[3]}), c = gelu_pk((f32x2){v1[0], v1[1]}), d = gelu_pk((f32x2){v1[2], v1[3]});
                        v0 = (f32x4){a.x, a.y, b.x, b.y}; v1 = (f32x4){c.x, c.y, d.x, d.y}; }
                    v0 = v0 * sc; v1 = v1 * sc; u32x4 w; w.x = cvt_pk_bf16(v0[0], v0[1]); w.y = cvt_pk_bf16(v0[2], v0[3]); w.z = cvt_pk_bf16(v1[0], v1[1]); w.w = cvt_pk_bf16(v1[2], v1[3]);
                    *(u32x4*)(rowp + bj * HALF) = w; } }
    }
};

template <class Epi, class Sched, bool ALIGN_EPI = false, bool SP2 = false>
__device__ __forceinline__ void gemm_phase(PG8_LAS unsigned char* lds, const Gemm g, const Sched& S, const Epi& E) {
    const int tid = threadIdx.x, wid = __builtin_amdgcn_readfirstlane(tid >> 6), lane = tid & 63, wr = wid >> 2, wc = wid & 3, fr = lane & 15, fq = lane >> 4;
    const int K = g.K, nt = K / BK;
    unsigned voffA[2], voffB[2];
#pragma unroll
    for (int i = 0; i < 2; ++i) { int R, C; stage_rc(tid * 16 + i * 8192, R, C); const int Rb = Epi::PERM ? ((R & ~31) + perm32(R & 31)) : R;
        voffA[i] = (unsigned)(R * g.lda + C) * 2u; voffB[i] = (unsigned)(Rb * K + C) * 2u; }
    const size_t kstep = (size_t)(BK * 2);
    const size_t hstepA = (size_t)HALF * g.lda * 2, hstepB = (size_t)HALF * K * 2;
    const size_t tstepA = 2 * hstepA, tstepB = 2 * hstepB;
    const unsigned ldsw = (unsigned)wid * 1024u;
    const int aoff = lds_byte(wr * 64 + fr, fq * 8), boff = lds_byte(wc * 32 + fr, fq * 8);
#define PG8_SA(b, h) (((b) * 2 + (h)) * HTB)
#define PG8_SB(b, h) ((4 + (b) * 2 + (h)) * HTB)
#define PG8_STAGE(bufoff, gbase, voff) do { _Pragma("unroll") for (int _i = 0; _i < 2; ++_i) \
        __builtin_amdgcn_global_load_lds((const unsigned*)((const char*)(gbase) + (voff)[_i]), (PG8_LAS unsigned*)(lds + (bufoff) + ldsw + _i * 8192), 16, 0, 0); } while (0)
#define PG8_LDA(dst, b, h) do { _Pragma("unroll") for (int m = 0; m < 4; ++m) _Pragma("unroll") for (int k = 0; k < 2; ++k) dst[m][k] = *(const PG8_LAS bf16x8*)(lds + PG8_SA(b, h) + aoff + m * 2048 + k * 1024); } while (0)
#define PG8_LDB(dst, b, h) do { _Pragma("unroll") for (int n = 0; n < 2; ++n) _Pragma("unroll") for (int k = 0; k < 2; ++k) dst[n][k] = *(const PG8_LAS bf16x8*)(lds + PG8_SB(b, h) + boff + n * 2048 + k * 1024); } while (0)
#define PG8_MMA(ai, bj, At, Bt) do { __builtin_amdgcn_s_setprio(1); _Pragma("unroll") for (int m = 0; m < 4; ++m) _Pragma("unroll") for (int n = 0; n < 2; ++n) _Pragma("unroll") for (int k = 0; k < 2; ++k) \
        acc[ai][bj][m][n] = __builtin_amdgcn_mfma_f32_16x16x32_bf16(Bt[n][k], At[m][k], acc[ai][bj][m][n], 0, 0, 0); __builtin_amdgcn_s_setprio(0); } while (0)
#define PG8_WAIT_V(n) asm volatile("s_waitcnt vmcnt(" #n ")" ::: "memory")
#define PG8_WAIT_L(n) asm volatile("s_waitcnt lgkmcnt(" #n ")" ::: "memory")
#define PG8_BAR __builtin_amdgcn_s_barrier()
#define PG8_SCHED __builtin_amdgcn_sched_barrier(0)
    Unit cur, nxt; int ui = 0;
    if (!S.next(0, cur)) return;
    f32x4 acc[2][2][4][2];
#pragma unroll
    for (int a = 0; a < 2; ++a)
#pragma unroll
        for (int b = 0; b < 2; ++b)
#pragma unroll
            for (int m = 0; m < 4; ++m)
#pragma unroll
                for (int n = 0; n < 2; ++n) acc[a][b][m][n] = (f32x4){0.f, 0.f, 0.f, 0.f};
    bf16x8 At[4][2], B0[2][2], B1[2][2];
    const char* cA = (const char*)g.A + (size_t)cur.pm * tstepA; const char* cB = (const char*)g.Bt + (size_t)cur.pn * tstepB;
    S.a_ready(cur);
    if constexpr (SP2) {
        PG8_STAGE(PG8_SB(0, 0), cB, voffB); PG8_STAGE(PG8_SB(0, 1), cB + hstepB, voffB); PG8_STAGE(PG8_SA(0, 0), cA, voffA); PG8_STAGE(PG8_SA(0, 1), cA + hstepA, voffA);
        if (wr == 1) PG8_BAR;
        PG8_WAIT_V(2); PG8_BAR;
        PG8_STAGE(PG8_SB(1, 0), cB + kstep, voffB); PG8_STAGE(PG8_SA(1, 0), cA + kstep, voffA); PG8_STAGE(PG8_SB(1, 1), cB + hstepB + kstep, voffB);
        PG8_WAIT_V(6); PG8_BAR;
    } else {
        PG8_STAGE(PG8_SB(0, 0), cB, voffB); PG8_STAGE(PG8_SA(0, 0), cA, voffA); PG8_STAGE(PG8_SB(0, 1), cB + hstepB, voffB); PG8_STAGE(PG8_SA(0, 1), cA + hstepA, voffA);
        if (wr == 1) PG8_BAR;
        PG8_WAIT_V(4); PG8_BAR;
        PG8_STAGE(PG8_SB(1, 0), cB + kstep, voffB); PG8_STAGE(PG8_SA(1, 0), cA + kstep, voffA); PG8_STAGE(PG8_SB(1, 1), cB + hstepB + kstep, voffB);
        PG8_WAIT_V(6); PG8_BAR;
    }
    for (;;) {
        const bool has_next = S.next(ui + 1, nxt);
        const char* nA = has_next ? (const char*)g.A + (size_t)nxt.pm * tstepA : cA; const char* nB = has_next ? (const char*)g.Bt + (size_t)nxt.pn * tstepB : cB;
        for (int t = 0; t < nt; t += 2) {
            const bool last = (t == nt - 2);
            const char* a1 = cA + (size_t)(t + 1) * kstep;
            const char* a2 = last ? nA : cA + (size_t)(t + 2) * kstep; const char* b2 = last ? nB : cB + (size_t)(t + 2) * kstep;
            const char* a3 = a2 + kstep; const char* b3 = b2 + kstep;
            if (last && has_next) S.a_ready(nxt);
            if constexpr (SP2) {
            PG8_LDB(B0, 0, 0); PG8_LDB(B1, 0, 1); PG8_SCHED; PG8_LDA(At, 0, 0); PG8_STAGE(PG8_SA(1, 1), a1 + hstepA, voffA);
            PG8_WAIT_V(8); PG8_WAIT_L(0); PG8_BAR; PG8_MMA(0, 0, At, B0); PG8_MMA(0, 1, At, B1); PG8_BAR; PG8_SCHED;
            PG8_LDA(At, 0, 1); PG8_STAGE(PG8_SB(0, 0), b2, voffB); PG8_STAGE(PG8_SB(0, 1), b2 + hstepB, voffB); PG8_STAGE(PG8_SA(0, 0), a2, voffA);
            PG8_WAIT_V(8); PG8_WAIT_L(0); PG8_BAR; PG8_MMA(1, 0, At, B0); PG8_MMA(1, 1, At, B1); PG8_BAR; PG8_SCHED;
            PG8_LDB(B0, 1, 0); PG8_LDB(B1, 1, 1); PG8_SCHED; PG8_LDA(At, 1, 0); PG8_STAGE(PG8_SA(0, 1), a2 + hstepA, voffA);
            PG8_WAIT_V(8); PG8_WAIT_L(0); PG8_BAR; PG8_MMA(0, 0, At, B0); PG8_MMA(0, 1, At, B1); PG8_BAR; PG8_SCHED;
            PG8_LDA(At, 1, 1); PG8_STAGE(PG8_SB(1, 0), b3, voffB); PG8_STAGE(PG8_SB(1, 1), b3 + hstepB, voffB); PG8_STAGE(PG8_SA(1, 0), a3, voffA);
            PG8_WAIT_V(8); PG8_WAIT_L(0); PG8_BAR; PG8_MMA(1, 0, At, B0); PG8_MMA(1, 1, At, B1); PG8_BAR; PG8_SCHED;
            } else {
            PG8_LDB(B0, 0, 0); PG8_SCHED; PG8_LDA(At, 0, 0); PG8_STAGE(PG8_SA(1, 1), a1 + hstepA, voffA);
            PG8_WAIT_L(8); PG8_BAR; PG8_WAIT_L(0); PG8_MMA(0, 0, At, B0); PG8_BAR; PG8_SCHED;
            PG8_LDB(B1, 0, 1); PG8_STAGE(PG8_SB(0, 0), b2, voffB);
            PG8_BAR; PG8_WAIT_L(0); PG8_MMA(0, 1, At, B1); PG8_BAR;
            PG8_LDA(At, 0, 1); PG8_STAGE(PG8_SA(0, 0), a2, voffA);
            PG8_BAR; PG8_WAIT_L(0); PG8_MMA(1, 0, At, B0); PG8_BAR; PG8_SCHED;
            PG8_STAGE(PG8_SB(0, 1), b2 + hstepB, voffB);
            PG8_WAIT_V(6); PG8_BAR; PG8_MMA(1, 1, At, B1); PG8_BAR;
            PG8_LDB(B0, 1, 0); PG8_SCHED; PG8_LDA(At, 1, 0); PG8_STAGE(PG8_SA(0, 1), a2 + hstepA, voffA);
            PG8_WAIT_L(8); PG8_BAR; PG8_WAIT_L(0); PG8_MMA(0, 0, At, B0); PG8_BAR; PG8_SCHED;
            PG8_LDB(B1, 1, 1); PG8_STAGE(PG8_SB(1, 0), b3, voffB);
            PG8_BAR; PG8_WAIT_L(0); PG8_MMA(0, 1, At, B1); PG8_BAR;
            PG8_LDA(At, 1, 1); PG8_STAGE(PG8_SA(1, 0), a3, voffA);
            PG8_BAR; PG8_WAIT_L(0); PG8_MMA(1, 0, At, B0); PG8_BAR; PG8_SCHED;
            PG8_STAGE(PG8_SB(1, 1), b3 + hstepB, voffB);
            PG8_WAIT_V(6); PG8_BAR; PG8_MMA(1, 1, At, B1); PG8_BAR;
            }
        }
        if constexpr (ALIGN_EPI) { if (wr == 0) PG8_BAR; }
        if constexpr (!Epi::AFTER_DRAIN) { E(acc, cur, wr, wc, fr, fq); S.done(cur); }
        if (!has_next) break;
#pragma unroll
        for (int a = 0; a < 2; ++a)
#pragma unroll
            for (int b = 0; b < 2; ++b)
#pragma unroll
                for (int m = 0; m < 4; ++m)
#pragma unroll
                    for (int n = 0; n < 2; ++n) acc[a][b][m][n] = (f32x4){0.f, 0.f, 0.f, 0.f};
        cur = nxt; cA = nA; cB = nB; ++ui;
        if constexpr (ALIGN_EPI) { if (wr == 1) PG8_BAR; }
    }
    PG8_WAIT_V(0);
    if constexpr (!ALIGN_EPI) { if (wr == 0) PG8_BAR; }
    PG8_BAR;
    if constexpr (Epi::AFTER_DRAIN) { E.fused(acc, cur, wr, wc, fr, fq, lds, wid, lane); S.done(cur); }
#undef PG8_SA
#undef PG8_SB
#undef PG8_STAGE
#undef PG8_LDA
#undef PG8_LDB
#undef PG8_MMA
#undef PG8_WAIT_V
#undef PG8_WAIT_L
#undef PG8_BAR
#undef PG8_SCHED
}
}
namespace pg8 {
struct Unit2 { int pm, pn, e, cnt, jt, ui; };
template <class E, class = void> struct has_perm16 { static constexpr bool value = false; };
template <class E> struct has_perm16<E, decltype((void)E::PERM16)> { static constexpr bool value = E::PERM16; };
template <class E> constexpr bool perm16() { return has_perm16<E>::value; }
template <class Epi, class Sched>
__device__ __forceinline__ void gemm_phase2(PG8_LAS unsigned char* lds, const bf16_t* Abase, int lda, int ldb, int K, const Sched& S, const Epi& E, int kstepA_ = BK * 2) {
    int tid_ = threadIdx.x; asm volatile("" : "+v"(tid_));
    const int tid = tid_, wid = __builtin_amdgcn_readfirstlane(tid >> 6), lane = tid & 63, wr = wid >> 2, wc = wid & 3, fr = lane & 15, fq = lane >> 4;
    int K_ = K; asm volatile("" : "+s"(K_));
    const int nt = K_ / BK;
    unsigned voffB0[2], voffB1[2];
#pragma unroll
    for (int i = 0; i < 2; ++i) { int R, C; stage_rc(tid * 16 + i * 8192, R, C);
        if constexpr (perm16<Epi>()) { const int cb = 64 * (R >> 5) + 16 * ((R >> 2) & 3) + 4 * ((R >> 4) & 1) + (R & 3); voffB0[i] = (unsigned)(cb * ldb + C) * 2u; voffB1[i] = (unsigned)((cb + 8) * ldb + C) * 2u; }
        else { const int Rb = Epi::PERM ? ((R & ~31) + perm32(R & 31)) : R; voffB0[i] = (unsigned)(Rb * ldb + C) * 2u; voffB1[i] = voffB0[i] + (unsigned)(HALF * ldb * 2); } }
    const unsigned lda2 = (unsigned)lda * 2u;
#define PG8_AOFFS(U, o0, o1) do { int t2_ = threadIdx.x; asm volatile("" : "+v"(t2_)); _Pragma("unroll") for (int i_ = 0; i_ < 2; ++i_) { int R_, C_; stage_rc(t2_ * 16 + i_ * 8192, R_, C_); \
        o0[i_] = (unsigned)S.arow(U, R_) * lda2 + (unsigned)C_ * 2u; o1[i_] = (unsigned)S.arow(U, HALF + R_) * lda2 + (unsigned)C_ * 2u; } } while (0)
    const size_t kstep = (size_t)(BK * 2), kstepA = (size_t)kstepA_;
    const unsigned ldsw = (unsigned)wid * 1024u;
    const int aoff = lds_byte(wr * 64 + fr, fq * 8), boff = lds_byte(wc * 32 + fr, fq * 8);
#define PG8_SA(b, h) (((b) * 2 + (h)) * HTB)
#define PG8_SB(b, h) ((4 + (b) * 2 + (h)) * HTB)
#define PG8_STAGE(bufoff, gbase, voff) do { _Pragma("unroll") for (int _i = 0; _i < 2; ++_i) \
        __builtin_amdgcn_global_load_lds((const unsigned*)((const char*)(gbase) + (voff)[_i]), (PG8_LAS unsigned*)(lds + (bufoff) + ldsw + _i * 8192), 16, 0, 0); } while (0)
#define PG8_LDA(dst, b, h) do { _Pragma("unroll") for (int m = 0; m < 4; ++m) _Pragma("unroll") for (int k = 0; k < 2; ++k) dst[m][k] = *(const PG8_LAS bf16x8*)(lds + PG8_SA(b, h) + aoff + m * 2048 + k * 1024); } while (0)
#define PG8_LDB(dst, b, h) do { _Pragma("unroll") for (int n = 0; n < 2; ++n) _Pragma("unroll") for (int k = 0; k < 2; ++k) dst[n][k] = *(const PG8_LAS bf16x8*)(lds + PG8_SB(b, h) + boff + n * 2048 + k * 1024); } while (0)
#define PG8_MMA(ai, bj, At, Bt) do { __builtin_amdgcn_s_setprio(1); _Pragma("unroll") for (int m = 0; m < 4; ++m) _Pragma("unroll") for (int n = 0; n < 2; ++n) _Pragma("unroll") for (int k = 0; k < 2; ++k) \
        acc[ai][bj][m][n] = __builtin_amdgcn_mfma_f32_16x16x32_bf16(Bt[n][k], At[m][k], acc[ai][bj][m][n], 0, 0, 0); __builtin_amdgcn_s_setprio(0); } while (0)
#define PG8_WAIT_V(n) asm volatile("s_waitcnt vmcnt(" #n ")" ::: "memory")
#define PG8_WAIT_L(n) asm volatile("s_waitcnt lgkmcnt(" #n ")" ::: "memory")
#define PG8_BAR __builtin_amdgcn_s_barrier()
#define PG8_SCHED __builtin_amdgcn_sched_barrier(0)
    Unit2 cur, nxt; int ui = 0;
    if (!S.next(0, cur)) return;
    f32x4 acc[2][2][4][2];
#pragma unroll
    for (int a = 0; a < 2; ++a)
#pragma unroll
        for (int b = 0; b < 2; ++b)
#pragma unroll
            for (int m = 0; m < 4; ++m)
#pragma unroll
                for (int n = 0; n < 2; ++n) acc[a][b][m][n] = (f32x4){0.f, 0.f, 0.f, 0.f};
    bf16x8 At[4][2], B0[2][2], B1[2][2];
    unsigned cv0[2], cv1[2], nv0[2], nv1[2];
    PG8_AOFFS(cur, cv0, cv1);
    const char* cA = (const char*)Abase + S.aoff(cur); const char* cB = S.bptr(cur);
    PG8_STAGE(PG8_SB(0, 0), cB, voffB0); PG8_STAGE(PG8_SB(0, 1), cB, voffB1); PG8_STAGE(PG8_SA(0, 0), cA, cv0); PG8_STAGE(PG8_SA(0, 1), cA, cv1);
    if (wr == 1) PG8_BAR;
    PG8_WAIT_V(2); PG8_BAR;
    PG8_STAGE(PG8_SB(1, 0), cB + kstep, voffB0); PG8_STAGE(PG8_SA(1, 0), cA + kstepA, cv0); PG8_STAGE(PG8_SB(1, 1), cB + kstep, voffB1);
    PG8_WAIT_V(6); PG8_BAR;
    for (;;) {
        const bool has_next = S.next(ui + 1, nxt);
        const char* nA = has_next ? (const char*)Abase + S.aoff(nxt) : cA; const char* nB = has_next ? S.bptr(nxt) : cB;
#pragma unroll
        for (int i = 0; i < 2; ++i) { nv0[i] = cv0[i]; nv1[i] = cv1[i]; }
        if (has_next) PG8_AOFFS(nxt, nv0, nv1);
        const bool act0 = cur.cnt > wr * 64, act1 = cur.cnt > HALF + wr * 64;
        for (int t = 0; t < nt; t += 2) {
            const bool last = (t == nt - 2);
            const char* a1 = cA + (size_t)(t + 1) * kstepA;
            const char* a2 = last ? nA : cA + (size_t)(t + 2) * kstepA; const char* b2 = last ? nB : cB + (size_t)(t + 2) * kstep;
            const char* a3 = a2 + kstepA; const char* b3 = b2 + kstep;
            unsigned s0[2] = {cv0[0], cv0[1]}, s1[2] = {cv1[0], cv1[1]};
            if (last) { asm volatile("" ::: "memory"); s0[0] = nv0[0]; s0[1] = nv0[1]; s1[0] = nv1[0]; s1[1] = nv1[1]; }
            PG8_LDB(B0, 0, 0); PG8_LDB(B1, 0, 1); PG8_SCHED; PG8_LDA(At, 0, 0); PG8_STAGE(PG8_SA(1, 1), a1, cv1);
            PG8_WAIT_V(8); PG8_WAIT_L(0); PG8_BAR; if (act0) { PG8_MMA(0, 0, At, B0); PG8_MMA(0, 1, At, B1); } PG8_BAR; PG8_SCHED;
            PG8_LDA(At, 0, 1); PG8_STAGE(PG8_SB(0, 0), b2, voffB0); PG8_STAGE(PG8_SB(0, 1), b2, voffB1); PG8_STAGE(PG8_SA(0, 0), a2, s0);
            PG8_WAIT_V(8); PG8_WAIT_L(0); PG8_BAR; if (act1) { PG8_MMA(1, 0, At, B0); PG8_MMA(1, 1, At, B1); } PG8_BAR; PG8_SCHED;
            PG8_LDB(B0, 1, 0); PG8_LDB(B1, 1, 1); PG8_SCHED; PG8_LDA(At, 1, 0); PG8_STAGE(PG8_SA(0, 1), a2, s1);
            PG8_WAIT_V(8); PG8_WAIT_L(0); PG8_BAR; if (act0) { PG8_MMA(0, 0, At, B0); PG8_MMA(0, 1, At, B1); } PG8_BAR; PG8_SCHED;
            PG8_LDA(At, 1, 1); PG8_STAGE(PG8_SB(1, 0), b3, voffB0); PG8_STAGE(PG8_SB(1, 1), b3, voffB1); PG8_STAGE(PG8_SA(1, 0), a3, s0);
            PG8_WAIT_V(8); PG8_WAIT_L(0); PG8_BAR; if (act1) { PG8_MMA(1, 0, At, B0); PG8_MMA(1, 1, At, B1); } PG8_BAR; PG8_SCHED;
        }
        if (wr == 0) PG8_BAR;
        { Unit2 eu = cur; asm volatile("" : "+s"(eu.pm), "+s"(eu.pn), "+s"(eu.e), "+s"(eu.cnt), "+s"(eu.jt), "+s"(eu.ui));
          E(acc, eu, wr, wc, fr, fq);
          }
        if (!has_next) break;
#pragma unroll
        for (int a = 0; a < 2; ++a)
#pragma unroll
            for (int b = 0; b < 2; ++b)
#pragma unroll
                for (int m = 0; m < 4; ++m)
#pragma unroll
                    for (int n = 0; n < 2; ++n) acc[a][b][m][n] = (f32x4){0.f, 0.f, 0.f, 0.f};
        cur = nxt; cA = nA; cB = nB; ++ui;
#pragma unroll
        for (int i = 0; i < 2; ++i) { cv0[i] = nv0[i]; cv1[i] = nv1[i]; }
        if (wr == 1) PG8_BAR;
    }
    PG8_WAIT_V(0);
    PG8_BAR;
#undef PG8_AOFFS
#undef PG8_SA
#undef PG8_SB
#undef PG8_STAGE
#undef PG8_LDA
#undef PG8_LDB
#undef PG8_MMA
#undef PG8_WAIT_V
#undef PG8_WAIT_L
#undef PG8_BAR
#undef PG8_SCHED
}

struct DenseSched {
    StaticOrder so; const bf16_t* Bt; int ldb;
    __device__ __forceinline__ bool next(int i, Unit2& u) const { Unit t; if (!so.next(i, t)) return false; u.pm = t.pm; u.pn = t.pn; u.e = 0; u.cnt = 256; u.jt = 0; u.ui = i; return true; }
    __device__ __forceinline__ int arow(const Unit2& u, int r) const { return u.pm * BM + r; }
    __device__ __forceinline__ size_t aoff(const Unit2&) const { return 0; }
    __device__ __forceinline__ const char* bptr(const Unit2& u) const { return (const char*)(Bt + (size_t)u.pn * BM * ldb); }
};
struct EpiPlainBf16 {
    static constexpr bool PERM = true, AFTER_DRAIN = false;
    bf16_t* O; int ldc;
    __device__ __forceinline__ void operator()(const f32x4 (&acc)[2][2][4][2], const Unit2& u, int wr, int wc, int fr, int fq) const {
        const int row0 = u.pm * BM + wr * 64 + fr, col0 = u.pn * BM + wc * 32 + 8 * fq;
#pragma unroll
        for (int ai = 0; ai < 2; ++ai)
#pragma unroll
            for (int m = 0; m < 4; ++m) { bf16_t* rowp = O + (size_t)(row0 + ai * HALF + m * 16) * ldc + col0;
#pragma unroll
                for (int bj = 0; bj < 2; ++bj) { const f32x4 v0 = acc[ai][bj][m][0], v1 = acc[ai][bj][m][1];
                    u32x4 w; w.x = cvt_pk_bf16(v0[0], v0[1]); w.y = cvt_pk_bf16(v0[2], v0[3]); w.z = cvt_pk_bf16(v1[0], v1[1]); w.w = cvt_pk_bf16(v1[2], v1[3]);
                    *(u32x4*)(rowp + bj * HALF) = w; } }
    }
};
}
namespace nv {
constexpr int D = 1024, B = 8, S = 4096, T = B * S;
constexpr int FH = 8, FD = 64, GH = 4, GK = 64, GV = 128, RANK = 16;
constexpr int INW = 3096;
constexpr int O_FQ = 0, O_FK = 512, O_FV = 1024, O_FF = 1536, O_GQ = 1544, O_GK = 1800, O_GV = 2056, O_GA = 2568, O_GR = 2584;
constexpr int NE = 256, NG = 8, TOPK = 8, ED = 256;
constexpr float LN_EPS = 1e-5f;
constexpr float ALPHA = 1.189207115002721f;
constexpr int PADR = 64;
constexpr int APAD = T * TOPK + NE * PADR;

__device__ __forceinline__ float logsigmoidf(float x) { return fminf(x, 0.f) - log1pf(expf(-fabsf(x))); }
__device__ __forceinline__ float siluf(float x) { return x / (1.f + expf(-x)); }

}
#include <hip/hip_bf16.h>
#include <cmath>
namespace attn_body {
using bf16=__hip_bfloat16;
using bf16x8=__attribute__((ext_vector_type(8)))short;
using s16x4=__attribute__((ext_vector_type(4)))short;
using f32x16=__attribute__((ext_vector_type(16)))float;
using u32x4=__attribute__((ext_vector_type(4)))unsigned;
constexpr int BATCH=8,NHEAD=8,SEQ=4096,D=64,DM=3072,OPITCH=1024;
constexpr int NW=8,QBLK=32,QB=QBLK*NW,KVBLK=64,NQB=SEQ/QB;
constexpr int ATTN_PITCH=DM, ATTN_UNIT_ROWS=QB;
__device__ __forceinline__ int crow(int r,int hi){return (r&3)+8*(r>>2)+4*hi;}
#define SBAR() __builtin_amdgcn_sched_barrier(0)
__device__ __forceinline__ void cmask(f32x16&p0,f32x16&p1,int jb,int qrel,int hi){
  const float NEG=-INFINITY; int kb=64*jb+4*hi;
  #pragma unroll
  for(int r=0;r<16;++r){int kv=kb+(r&3)+8*(r>>2); if(kv>qrel)p0[r]=NEG; if(kv+32>qrel)p1[r]=NEG;}
}

constexpr int NSLOT=3, SLOTB=8192;
constexpr int LDS_K=0, LDS_V=NSLOT*SLOTB, LDS_WS=2*NSLOT*SLOTB, LDS_OST=LDS_WS+NW*64*4, LDS_KB=LDS_OST+NW*4096, LDS_BYTES=LDS_KB+(SEQ+2)*8;
constexpr float C2=0.125f*1.4426950408889634f;
__device__ __forceinline__ void glds16(const void*gsrc,unsigned lds_dst){unsigned keep;
  asm volatile("s_mov_b32 %0, m0\n\ts_mov_b32 m0, %2\n\ts_nop 0\n\tglobal_load_lds_dwordx4 %1, off\n\ts_mov_b32 m0, %0":"=&s"(keep):"v"(gsrc),"s"(lds_dst):"memory");}
__device__ __forceinline__ float max3f(float a,float b,float c){float r;asm("v_max3_f32 %0, %1, %2, %3":"=v"(r):"v"(a),"v"(b),"v"(c));return r;}
__device__ __forceinline__ float max2f(float a,float b){float r;asm("v_max_f32_e32 %0, %1, %2":"=v"(r):"v"(a),"v"(b));return r;}
__device__ __forceinline__ float fadd_s(float a,float b){float r;asm("v_add_f32_e32 %0, %1, %2":"=v"(r):"v"(a),"v"(b));return r;}
__device__ __forceinline__ float fsub_s(float a,float b){float r;asm("v_sub_f32_e32 %0, %1, %2":"=v"(r):"v"(a),"v"(b));return r;}
typedef float f32x2_t __attribute__((ext_vector_type(2))); typedef float f32x4_t __attribute__((ext_vector_type(4))); typedef __bf16 bf16x2_t __attribute__((ext_vector_type(2)));
__device__ __forceinline__ unsigned cvtpk_s(float lo,float hi){f32x2_t v={lo,hi};bf16x2_t b=__builtin_convertvector(v,bf16x2_t);return __builtin_bit_cast(unsigned,b);}
#define WAIT_BAR(N) asm volatile("s_waitcnt vmcnt(" #N ") lgkmcnt(0)\n\ts_barrier":::"memory")

__device__ __forceinline__ void split3(float b,unsigned&h,unsigned&m,unsigned&l){
  h=cvtpk_s(b,0.f)&0xffffu; const float r1=b-__uint_as_float(h<<16);
  m=cvtpk_s(r1,0.f)&0xffffu; const float r2=r1-__uint_as_float(m<<16);
  l=cvtpk_s(r2,0.f)&0xffffu; }
__device__ __forceinline__ bf16x8 kbias_frag(float b,int hi){unsigned h,m,l;split3(b,h,m,l);u32x4 w;w.x=h|(m<<16);w.y=l|0x3F800000u;w.z=0x3F803F80u;w.w=0u;if(hi){w.x=0u;w.y=0u;w.z=0u;}return __builtin_bit_cast(bf16x8,w);}
__device__ __forceinline__ bf16x8 qref_frag(float x,int hi){unsigned h,m,l;split3(x,h,m,l);u32x4 w;w.x=0x3F803F80u;w.y=0x3F80u|(h<<16);w.z=m|(l<<16);w.w=0u;if(hi){w.x=0u;w.y=0u;w.z=0u;}return __builtin_bit_cast(bf16x8,w);}
typedef unsigned u32x2_t __attribute__((ext_vector_type(2)));
__device__ __forceinline__ bf16x8 mkfrag(u32x2_t e,unsigned zc){u32x4 w;w.x=e.x;w.y=e.y;w.z=zc;w.w=0u;return __builtin_bit_cast(bf16x8,w);}
__device__ __forceinline__ void fox_bias_table(int b,int h,const float*LF,char*shm){
  int tid_=threadIdx.x; asm volatile("":"+v"(tid_)); const int tid=tid_,lane=tid&63,wid=__builtin_amdgcn_readfirstlane(tid>>6);
  const float*lf=LF+((long)b*NHEAD+h)*SEQ; float*wt=(float*)(shm+LDS_WS); u32x2_t*KB8=(u32x2_t*)(shm+LDS_KB);
  f32x4_t va=*(const f32x4_t*)(lf+8*tid),vb=*(const f32x4_t*)(lf+8*tid+4);
  va[1]+=va[0];va[2]+=va[1];va[3]+=va[2];vb[0]+=va[3];vb[1]+=vb[0];vb[2]+=vb[1];vb[3]+=vb[2];
  const float tot=vb[3]; float inc=tot;
  #pragma unroll
  for(int o_=1;o_<64;o_<<=1){const float nn=__shfl_up(inc,o_);if(lane>=o_)inc+=nn;}
  __syncthreads();
  if(lane==63)wt[wid*64]=inc;
  __syncthreads();
  float base=inc-tot;
  #pragma unroll
  for(int w_=0;w_<NW;++w_){const float x_=wt[w_*64]; if(w_<wid)base+=x_;}
  const float cv[8]={va[0]+base,va[1]+base,va[2]+base,va[3]+base,vb[0]+base,vb[1]+base,vb[2]+base,vb[3]+base};
  #pragma unroll
  for(int j=0;j<8;++j){unsigned hh,mm,ll;split3(-cv[j],hh,mm,ll);KB8[8*tid+j]=(u32x2_t){hh|(mm<<16),ll|0x3F800000u};}
  if(tid==0){KB8[SEQ]=(u32x2_t){0u,0u};KB8[SEQ+1]=(u32x2_t){0u,0u};}
  __syncthreads();
}
__device__ __forceinline__ void qkt(f32x16&p0,f32x16&p1,const char*Kslot,const bf16x8*qr,bf16x8 kb0,bf16x8 kb1,bf16x8 qx,int r32,int hi){
  const f32x16 negm=f32x16{};
  const char*kb=Kslot+hi*1024+r32*16;
  #pragma unroll
  for(int d0=0;d0<4;++d0){
    const bf16x8 b0=*reinterpret_cast<const bf16x8*>(kb+d0*2048);
    const bf16x8 b1=*reinterpret_cast<const bf16x8*>(kb+d0*2048+512);
    if(d0==0){p0=__builtin_amdgcn_mfma_f32_32x32x16_bf16(b0,qr[0],negm,0,0,0);p1=__builtin_amdgcn_mfma_f32_32x32x16_bf16(b1,qr[0],negm,0,0,0);}
    else{p0=__builtin_amdgcn_mfma_f32_32x32x16_bf16(b0,qr[d0],p0,0,0,0);p1=__builtin_amdgcn_mfma_f32_32x32x16_bf16(b1,qr[d0],p1,0,0,0);}}
  p0=__builtin_amdgcn_mfma_f32_32x32x16_bf16(kb0,qx,p0,0,0,0);p1=__builtin_amdgcn_mfma_f32_32x32x16_bf16(kb1,qx,p1,0,0,0);
}
typedef __attribute__((address_space(3))) const char* lds_cptr;
typedef short v4i16_t __attribute__((ext_vector_type(4)));
__device__ __forceinline__ void kload8(bf16x8*kf,lds_cptr kp){
  kf[0]=*(const __attribute__((address_space(3))) bf16x8*)(kp);      kf[1]=*(const __attribute__((address_space(3))) bf16x8*)(kp+512);
  kf[2]=*(const __attribute__((address_space(3))) bf16x8*)(kp+2048); kf[3]=*(const __attribute__((address_space(3))) bf16x8*)(kp+2560);
  kf[4]=*(const __attribute__((address_space(3))) bf16x8*)(kp+4096); kf[5]=*(const __attribute__((address_space(3))) bf16x8*)(kp+4608);
  kf[6]=*(const __attribute__((address_space(3))) bf16x8*)(kp+6144); kf[7]=*(const __attribute__((address_space(3))) bf16x8*)(kp+6656);
}
__device__ __forceinline__ void kload2(bf16x8*kf,lds_cptr kp,int j){ kf[2*j]=*(const __attribute__((address_space(3))) bf16x8*)(kp+j*2048); kf[2*j+1]=*(const __attribute__((address_space(3))) bf16x8*)(kp+j*2048+512); }
__device__ __forceinline__ s16x4 vtr(lds_cptr p){ return __builtin_bit_cast(s16x4,__builtin_amdgcn_ds_read_tr16_b64_v4i16((__attribute__((address_space(3))) v4i16_t*)p)); }
__device__ __forceinline__ float rowmax(const f32x16&p0,const f32x16&p1){
  float a=max3f(p0[0],p0[1],p1[0]),b=max3f(p0[2],p0[3],p1[1]);a=max3f(a,p1[2],p1[3]);
  #pragma unroll
  for(int r=4;r<16;r+=4){a=max3f(a,p0[r],p0[r+1]);b=max3f(b,p0[r+2],p0[r+3]);a=max3f(a,p1[r],p1[r+1]);b=max3f(b,p1[r+2],p1[r+3]);}
  const float m=max2f(a,b);
  auto rr=__builtin_amdgcn_permlane32_swap(__float_as_uint(m),__float_as_uint(m),false,false);
  return max2f(__uint_as_float(rr[0]),__uint_as_float(rr[1]));
}
__device__ __forceinline__ void pv(f32x16*o,int vb,bf16x8 pa0,bf16x8 pa1,bf16x8 pa2,bf16x8 pa3){
  #pragma unroll
  for(int d0=0;d0<2;++d0){s16x4 lo[4],hi[4];
    #pragma unroll
    for(int ks=0;ks<4;++ks){
      asm volatile("ds_read_b64_tr_b16 %0,%1 offset:%c2":"=&v"(lo[ks]):"v"(vb),"i"(d0*4096+ks*1024):"memory");
      asm volatile("ds_read_b64_tr_b16 %0,%1 offset:%c2":"=&v"(hi[ks]):"v"(vb),"i"(d0*4096+ks*1024+512):"memory");}
    asm volatile("s_waitcnt lgkmcnt(0)":::"memory");SBAR();
    #define PK(k) (bf16x8){lo[k][0],lo[k][1],lo[k][2],lo[k][3],hi[k][0],hi[k][1],hi[k][2],hi[k][3]}
    o[d0]=__builtin_amdgcn_mfma_f32_32x32x16_bf16(pa0,PK(0),o[d0],0,0,0);
    o[d0]=__builtin_amdgcn_mfma_f32_32x32x16_bf16(pa1,PK(1),o[d0],0,0,0);
    o[d0]=__builtin_amdgcn_mfma_f32_32x32x16_bf16(pa2,PK(2),o[d0],0,0,0);
    o[d0]=__builtin_amdgcn_mfma_f32_32x32x16_bf16(pa3,PK(3),o[d0],0,0,0);
    #undef PK
  }
}

#ifndef ATTN_STORE16
#define ATTN_STORE16(p,v) (*(u32x4*)(p)=(v))
#endif
template<int THRL> __device__ __forceinline__ void attn_unit(int b,int h,int qb,const bf16*Q,const bf16* K,const bf16* V,bf16*O,const float*LF,const unsigned*NRM,char*shm){
  int tid_=threadIdx.x; asm volatile("":"+v"(tid_));
  const int tid=tid_,lane=tid&63,r32=lane&31,hi=lane>>5; const int wid=__builtin_amdgcn_readfirstlane(tid>>6);
  const long rowbase=(long)b*SEQ; const int q0=qb*QB;
  const char*KBt0=shm+LDS_KB;
  int t0;
  { const int NT0=(q0+QB)/KVBLK; const unsigned*nr=NRM+(b*NHEAD+h)*4;
    const float qn2=__uint_as_float(nr[0])+__uint_as_float(nr[1]), kn2=__uint_as_float(nr[2])+__uint_as_float(nr[3]);
    const float thr=-(50.f+2.04f*sqrtf(qn2*kn2));
    const u32x2_t eq0=*(const u32x2_t*)(KBt0+(unsigned)q0*8u); const float bq0=__uint_as_float(eq0.x<<16)+__uint_as_float(eq0.x&0xffff0000u)+__uint_as_float(eq0.y<<16);
    bool ok=(2*lane<=NT0-4);
    if(ok&&lane>0){ const u32x2_t el=*(const u32x2_t*)(KBt0+(unsigned)(128*lane-1)*8u); const float bl=__uint_as_float(el.x<<16)+__uint_as_float(el.x&0xffff0000u)+__uint_as_float(el.y<<16); ok=(bl-bq0<thr); }
    const unsigned long long mk=__ballot(ok); const unsigned long long low=~mk; const int cnt=(low==0ull)?64:__builtin_ctzll(low);
    t0=__builtin_amdgcn_readfirstlane(2*(cnt-1)); }
  const char*KBt=KBt0+(hi?0:t0*512); const unsigned kb_o0=hi?(unsigned)SEQ*8u:(unsigned)r32*8u, kb_o1=hi?(unsigned)SEQ*8u:(unsigned)(r32+32)*8u, kb_str=hi?0u:512u, zc=hi?0u:0x3F803F80u;
  const bf16*Qw=Q+(rowbase+q0+wid*QBLK)*DM+h*D;
  const bf16*Kh=K+(rowbase+(long)t0*KVBLK)*DM+h*D,*Vh=V+(rowbase+(long)t0*KVBLK)*DM+h*D;
  const unsigned lds0=(unsigned)(uintptr_t)shm;
  float*wsf=(float*)(shm+LDS_WS)+wid*64;
  const bf16*ksrc=Kh+(long)lane*DM+wid*8;
  const bf16*vsrc=Vh+(long)(16*(wid&3)+(lane>>2))*DM+(wid>>2)*32+(lane&3)*8;
  const unsigned kdst=lds0+LDS_K+wid*1024, vdst=lds0+LDS_V+wid*1024;
  #define DMA_K(t,slot) glds16(ksrc+(long)(t)*KVBLK*DM,(unsigned)__builtin_amdgcn_readfirstlane(kdst+(slot)))
  #define DMA_V(t,slot) glds16(vsrc+(long)(t)*KVBLK*DM,(unsigned)__builtin_amdgcn_readfirstlane(vdst+(slot)))
  const int vb0=(int)(lds0+LDS_V)+((lane>>4)&1)*32+(lane&3)*8+(4*hi+((lane&15)>>2))*64;
  const char*Kbase=shm+LDS_K; bf16x8 kf[8];
  const lds_cptr shm3=(lds_cptr)shm; const lds_cptr kp0=shm3+LDS_K+hi*1024+r32*16; const lds_cptr vp0=shm3+LDS_V+((lane>>4)&1)*32+(lane&3)*8+(4*hi+((lane&15)>>2))*64;
  const int NT=(q0+QB)/KVBLK-t0;
  DMA_K(0,0);DMA_V(0,0);DMA_K(1,SLOTB);
  bf16x8 qr[4];
  #pragma unroll
  for(int d0=0;d0<4;++d0)qr[d0]=*reinterpret_cast<const bf16x8*>(&Qw[(long)r32*DM+d0*16+hi*8]);
  float mhat; { const u32x2_t eq=*(const u32x2_t*)(KBt0+(unsigned)(q0+wid*QBLK+r32)*8u); mhat=__uint_as_float(eq.x<<16)+__uint_as_float(eq.x&0xffff0000u)+__uint_as_float(eq.y<<16); }
  float l_reg=0.f;f32x16 o[2];o[0]=f32x16{};o[1]=f32x16{};const f32x16 negm=f32x16{};
  bf16x8 qx=qref_frag(-mhat,hi);
  const int qrel=wid*QBLK+r32;
  #define CMASK(P0,P1,t) do{int jb_=(t)-(NT-4); if(jb_>=0)cmask(P0,P1,jb_,qrel,hi);}while(0)
  bool resc=false;
  #define START(P0,P1) do{ const float rm=rowmax(P0,P1); resc=false; \
    { const float dl=__builtin_fmaxf(rm,0.f); mhat=fadd_s(mhat,dl); \
      _Pragma("unroll") for(int r=0;r<16;++r){P0[r]=fsub_s(P0[r],dl);P1[r]=fsub_s(P1[r],dl);} \
      qx=qref_frag(-mhat,hi); } \
    _Pragma("unroll") for(int r=0;r<16;++r)P0[r]=__builtin_amdgcn_exp2f(P0[r]); }while(0)
  #define RESC() do{ if(resc){ asm volatile("s_waitcnt lgkmcnt(0)":::"memory"); \
      _Pragma("unroll") for(int d_=0;d_<2;++d_) _Pragma("unroll") for(int r=0;r<16;++r)o[d_][r]*=wsf[crow(r,hi)]; } }while(0)
  f32x16 pA0,pA1,pB0,pB1;
  int sl_prev=0,sl_cur=0,sl_next=SLOTB;
  #define ROT() do{sl_prev=sl_cur;sl_cur=sl_next;sl_next=(sl_next==(NSLOT-1)*SLOTB)?0:sl_next+SLOTB;}while(0)
  DMA_K(2,2*SLOTB);
  WAIT_BAR(3);
  qkt(pA0,pA1,Kbase,qr,mkfrag(*(const u32x2_t*)(KBt+kb_o0),zc),mkfrag(*(const u32x2_t*)(KBt+kb_o1),zc),qx,r32,hi);asm volatile("s_nop 15\n\ts_nop 7":"+v"(pA0),"+v"(pA1));CMASK(pA0,pA1,0);
  START(pA0,pA1);
  _Pragma("unroll") for(int r=0;r<16;++r)pA1[r]=__builtin_amdgcn_exp2f(pA1[r]);
  WAIT_BAR(0);
  DMA_K(3,0);DMA_V(1,SLOTB);
  ROT();
  kload8(kf,kp0+sl_cur);
  WAIT_BAR(2);
  s16x4 vlo[8],vhi[8]; u32x4 pw0,pw1,pw2,pw3;
  #define PKW(P,B) cvtpk_s(P[B],P[B+1])
  #define PAF(k) __builtin_bit_cast(bf16x8,pw##k)
  #define VFR(i) (bf16x8){vlo[i][0],vlo[i][1],vlo[i][2],vlo[i][3],vhi[i][0],vhi[i][1],vhi[i][2],vhi[i][3]}
  #define PIN(x) asm volatile("":"+v"(x))
  #define MX3(a,b,c) __builtin_fmaxf(__builtin_fmaxf((a),(b)),(c))
  #define GAPA(MF,A0,A1,A2,A3,W0,W1,PW) do{ MF; sacc+=A0; sacc+=A1; sacc+=A2; sacc+=A3; PIN(sacc); W0; W1; PIN(PW); SBAR(); }while(0)
  #define EX(v) __builtin_amdgcn_exp2f(v)
  #define GAPB(MF,X,B) do{ MF; X[B]=EX(X[B]); X[B+1]=EX(X[B+1]); X[B+2]=EX(X[B+2]); X[B+3]=EX(X[B+3]); PIN(X); SBAR(); }while(0)
  #define VRD(i) do{ vlo[i]=vtr(vp_+(((i)>>2)*4096+((i)&3)*1024)); vhi[i]=vtr(vp_+(((i)>>2)*4096+((i)&3)*1024+512)); }while(0)
  #define KRD(G,j) do{ if(G){ kload2(kf,kp0+sl_next,j); SBAR(); } }while(0)
  #define STEP(C0,C1,P0,P1,t,GK,GV,GL) do{ SBAR(); \
    const lds_cptr vp_=vp0+sl_prev; const u32x2_t e0_=*(const u32x2_t*)(KBt+kb_o0+(unsigned)(t)*kb_str),e1_=*(const u32x2_t*)(KBt+kb_o1+(unsigned)(t)*kb_str); \
    VRD(0); SBAR(); float sacc=(P0[0]+P0[1]); \
    GAPA(C0=__builtin_amdgcn_mfma_f32_32x32x16_bf16(kf[0],qr[0],negm,0,0,0), P0[2],P0[3],P0[4],P0[5],     pw0[0]=PKW(P0,0), pw0[1]=PKW(P0,2), pw0); \
    VRD(4); SBAR(); GAPA(C1=__builtin_amdgcn_mfma_f32_32x32x16_bf16(kf[1],qr[0],negm,0,0,0), P0[6],P0[7],P0[8],P0[9],     pw0[2]=PKW(P0,4), pw0[3]=PKW(P0,6), pw0); \
    VRD(1); SBAR(); GAPA(C0=__builtin_amdgcn_mfma_f32_32x32x16_bf16(kf[2],qr[1],C0,0,0,0),   P0[10],P0[11],P0[12],P0[13], pw1[0]=PKW(P0,8), pw1[1]=PKW(P0,10), pw1); \
    VRD(5); SBAR(); GAPA(C1=__builtin_amdgcn_mfma_f32_32x32x16_bf16(kf[3],qr[1],C1,0,0,0),   P0[14],P0[15],P1[0],P1[1],   pw1[2]=PKW(P0,12),pw1[3]=PKW(P0,14), pw1); \
    VRD(2); SBAR(); GAPA(C0=__builtin_amdgcn_mfma_f32_32x32x16_bf16(kf[4],qr[2],C0,0,0,0),   P1[2],P1[3],P1[4],P1[5],     pw2[0]=PKW(P1,0), pw2[1]=PKW(P1,2), pw2); \
    VRD(6); SBAR(); GAPA(C1=__builtin_amdgcn_mfma_f32_32x32x16_bf16(kf[5],qr[2],C1,0,0,0),   P1[6],P1[7],P1[8],P1[9],     pw2[2]=PKW(P1,4), pw2[3]=PKW(P1,6), pw2); \
    VRD(3); SBAR(); GAPA(C0=__builtin_amdgcn_mfma_f32_32x32x16_bf16(kf[6],qr[3],C0,0,0,0),   P1[10],P1[11],P1[12],P1[13], pw3[0]=PKW(P1,8), pw3[1]=PKW(P1,10), pw3); \
    VRD(7); SBAR(); GAPA(C1=__builtin_amdgcn_mfma_f32_32x32x16_bf16(kf[7],qr[3],C1,0,0,0),   P1[14],P1[15],0.f,0.f,       pw3[2]=PKW(P1,12),pw3[3]=PKW(P1,14), pw3); \
    { const bf16x8 kb0_=mkfrag(e0_,zc),kb1_=mkfrag(e1_,zc); C0=__builtin_amdgcn_mfma_f32_32x32x16_bf16(kb0_,qx,C0,0,0,0); C1=__builtin_amdgcn_mfma_f32_32x32x16_bf16(kb1_,qx,C1,0,0,0); } SBAR(); \
    l_reg+=sacc; \
    if(GK){DMA_K((t)+3,sl_cur);} if(GV){DMA_V((t)+1,sl_next);} \
    CMASK(C0,C1,t); \
    { float a=MX3(C0[0],C0[1],C1[0]),b=MX3(C0[2],C0[3],C1[1]); a=MX3(a,C1[2],C1[3]); \
      _Pragma("unroll") for(int r=4;r<16;r+=4){a=MX3(a,C0[r],C0[r+1]);b=MX3(b,C0[r+2],C0[r+3]);a=MX3(a,C1[r],C1[r+1]);b=MX3(b,C1[r+2],C1[r+3]);} \
      float rm=__builtin_fmaxf(a,b); { auto rr=__builtin_amdgcn_permlane32_swap(__float_as_uint(rm),__float_as_uint(rm),false,false); rm=__builtin_fmaxf(__uint_as_float(rr[0]),__uint_as_float(rr[1])); } \
      resc=false; \
      if(__builtin_expect(__any(rm>(float)THRL),0)){ const float dl=__builtin_fmaxf(rm,0.f); mhat+=dl; \
        _Pragma("unroll") for(int r=0;r<16;++r){C0[r]-=dl;C1[r]-=dl;} \
        qx=qref_frag(-mhat,hi); \
        const float f=__builtin_amdgcn_exp2f(-dl); l_reg*=f; if(hi==0)wsf[r32]=f; resc=true; } } \
    SBAR(); \
    GAPB(o[0]=__builtin_amdgcn_mfma_f32_32x32x16_bf16(PAF(0),VFR(0),o[0],0,0,0), C0,0); \
    GAPB(o[1]=__builtin_amdgcn_mfma_f32_32x32x16_bf16(PAF(0),VFR(4),o[1],0,0,0), C0,4); \
    KRD(GL,0); GAPB(o[0]=__builtin_amdgcn_mfma_f32_32x32x16_bf16(PAF(1),VFR(1),o[0],0,0,0), C0,8); \
    KRD(GL,1); GAPB(o[1]=__builtin_amdgcn_mfma_f32_32x32x16_bf16(PAF(1),VFR(5),o[1],0,0,0), C0,12); \
    KRD(GL,2); GAPB(o[0]=__builtin_amdgcn_mfma_f32_32x32x16_bf16(PAF(2),VFR(2),o[0],0,0,0), C1,0); \
    KRD(GL,3); GAPB(o[1]=__builtin_amdgcn_mfma_f32_32x32x16_bf16(PAF(2),VFR(6),o[1],0,0,0), C1,4); \
    GAPB(o[0]=__builtin_amdgcn_mfma_f32_32x32x16_bf16(PAF(3),VFR(3),o[0],0,0,0), C1,8); \
    GAPB(o[1]=__builtin_amdgcn_mfma_f32_32x32x16_bf16(PAF(3),VFR(7),o[1],0,0,0), C1,12); \
    }while(0)
  int t=1;
  #undef CMASK
  #define CMASK(P0,P1,t) do{}while(0)
  for(;t+5<NT;t+=2){
    STEP(pB0,pB1,pA0,pA1,t,true,true,true);     WAIT_BAR(2); RESC(); ROT();
    STEP(pA0,pA1,pB0,pB1,t+1,true,true,true);   WAIT_BAR(2); RESC(); ROT();
  }
  #undef CMASK
  #define CMASK(P0,P1,t) do{int jb_=(t)-(NT-4); if(jb_>=0)cmask(P0,P1,jb_,qrel,hi);}while(0)
  #define ENDW(tt) do{ if((tt)+3<NT){WAIT_BAR(2);} else if((tt)+2<NT){WAIT_BAR(1);} else {WAIT_BAR(0);} }while(0)
  for(;t+1<NT;t+=2){
    STEP(pB0,pB1,pA0,pA1,t,(t+3<NT),(t+1<NT),(t+1<NT));       ENDW(t);   RESC(); ROT();
    STEP(pA0,pA1,pB0,pB1,t+1,(t+4<NT),(t+2<NT),(t+2<NT));     ENDW(t+1); RESC(); ROT();
  }
  STEP(pB0,pB1,pA0,pA1,NT-1,false,false,false); RESC();
  { float sacc=pB0[0]+pB0[1]; _Pragma("unroll") for(int r=2;r<16;++r)sacc+=pB0[r]; _Pragma("unroll") for(int r=0;r<16;++r)sacc+=pB1[r]; l_reg+=sacc;
    pw0=(u32x4){PKW(pB0,0),PKW(pB0,2),PKW(pB0,4),PKW(pB0,6)};pw1=(u32x4){PKW(pB0,8),PKW(pB0,10),PKW(pB0,12),PKW(pB0,14)};pw2=(u32x4){PKW(pB1,0),PKW(pB1,2),PKW(pB1,4),PKW(pB1,6)};pw3=(u32x4){PKW(pB1,8),PKW(pB1,10),PKW(pB1,12),PKW(pB1,14)};
    SBAR(); pv(o,vb0+sl_cur,PAF(0),PAF(1),PAF(2),PAF(3)); }
  #undef PKW
  #undef PAF
  #undef VFR
  #undef PIN
  #undef MX3
  #undef GAPA
  #undef GAPB
  #undef EX
  #undef VRD
  #undef KRD
  #undef STEP
  #undef ENDW
  {auto rr=__builtin_amdgcn_permlane32_swap(__float_as_uint(l_reg),__float_as_uint(l_reg),false,false);l_reg=__uint_as_float(rr[0])+__uint_as_float(rr[1]);}
  if(hi==0)wsf[32+r32]=l_reg;asm volatile("s_waitcnt lgkmcnt(0)":::"memory");
  float rli[16];
  #pragma unroll
  for(int r=0;r<16;++r)rli[r]=__builtin_amdgcn_rcpf(wsf[32+crow(r,hi)]);
  bf16*Ow=O+(rowbase+q0+wid*QBLK)*OPITCH+h*D;
  { bf16*stg=(bf16*)(shm+LDS_OST)+wid*2048;
    #pragma unroll
    for(int r=0;r<16;++r){const int orow=crow(r,hi);
      #pragma unroll
      for(int d0=0;d0<2;++d0)stg[orow*64+d0*32+r32]=__float2bfloat16(o[d0][r]*rli[r]);}
    asm volatile("s_waitcnt lgkmcnt(0)":::"memory");
    #pragma unroll
    for(int i=0;i<4;++i){const int row=i*8+(lane>>3),ch=lane&7; const u32x4 v=*(const u32x4*)(stg+row*64+ch*8); ATTN_STORE16(Ow+(long)row*OPITCH+ch*8,v);} }
  asm volatile("s_waitcnt lgkmcnt(0)\n\ts_barrier":::"memory");
  #undef DMA_K
  #undef DMA_V
  #undef CMASK
  #undef START
  #undef RESC
  #undef ROT
}
constexpr int ATTN_LDS_BYTES=LDS_BYTES;
struct AttnTensors { const bf16* Q; const bf16* K; const bf16* V; bf16* O; const float* LF; const unsigned* NRM; };
struct AttnUnit { int bh; int qb; };
struct StaticOrder {
  int vcu,grid;
  __device__ __forceinline__ explicit StaticOrder(int grid_,int block):vcu((grid_%8==0)?(block%8)*(grid_/8)+block/8:block),grid(grid_){}
  __device__ __forceinline__ bool next(int i,AttnUnit&u)const{
    if(grid==256){ if(i>=4)return false; const int s=vcu&3; u.bh=vcu>>2; u.qb=(i==0)?s:(i==1)?7-s:(i==2)?8+s:15-s; return true; }
    const int L=i*grid+vcu; if(L>=BATCH*NHEAD*NQB)return false; u.bh=L/NQB; u.qb=L%NQB; return true; }
  __device__ __forceinline__ void a_ready(const AttnUnit&)const{}
  __device__ __forceinline__ void done(const AttnUnit&)const{}
};
template<class Sched,int THRL=8> __device__ __forceinline__ void attn_phase(char*lds,const AttnTensors&T,const Sched&S){
  AttnUnit u; int cur_bh=-1;
  for(int i=0;S.next(i,u);++i){ S.a_ready(u); if(u.bh!=cur_bh){ fox_bias_table(u.bh/NHEAD,u.bh%NHEAD,T.LF,lds); cur_bh=u.bh; }
    attn_unit<THRL>(u.bh/NHEAD,u.bh%NHEAD,u.qb,T.Q,T.K,T.V,T.O,T.LF,T.NRM,lds); S.done(u); }
}
template<int THRL=8> __device__ __forceinline__ void attn_phase_dyn(char*lds,const AttnTensors&T,unsigned*qheads,volatile int*slot,int grp){
  int cur_bh=-1; const int NU=NHEAD*NQB; unsigned*qhead=qheads+64*grp;
  if(threadIdx.x==0) slot[0]=(int)__hip_atomic_fetch_add(qhead,1u,__ATOMIC_RELAXED,__HIP_MEMORY_SCOPE_AGENT);
  __syncthreads();
  int idx=__builtin_amdgcn_readfirstlane(slot[0]);
  while(idx<NU){
    __syncthreads();
    if(threadIdx.x==0) slot[0]=(int)__hip_atomic_fetch_add(qhead,1u,__ATOMIC_RELAXED,__HIP_MEMORY_SCOPE_AGENT);
    const int qb=NQB-1-idx/NHEAD, bh=grp*NHEAD+idx%NHEAD;
    if(bh!=cur_bh){ fox_bias_table(bh/NHEAD,bh%NHEAD,T.LF,lds); cur_bh=bh; }
    attn_unit<THRL>(bh/NHEAD,bh%NHEAD,qb,T.Q,T.K,T.V,T.O,T.LF,T.NRM,lds);
    __syncthreads();
    idx=__builtin_amdgcn_readfirstlane(slot[0]);
  }
}
#undef SBAR
#undef WAIT_BAR
}
namespace fx {
using namespace nv;
typedef unsigned short bf16;
typedef unsigned v4u __attribute__((ext_vector_type(4)));
typedef float f32x4 __attribute__((ext_vector_type(4)));
constexpr float C2 = 0.125f * 1.4426950408889634f;
constexpr int NIN = 3328;
constexpr int QKVP = 3072;
constexpr int P_FQ = 0, P_FK = 512, P_FV = 1024, P_GQ = 1536, P_GK = 1792, P_GV = 2048, P_GR = 2560;
__device__ __forceinline__ int inproj_src(int d) {
    if (d < 1536) return d;
    if (d < 1792) return O_GQ + (d - 1536);
    if (d < 2048) return O_GK + (d - 1792);
    if (d < 2560) return O_GV + (d - 2048);
    if (d < 3072) return O_GR + (d - 2560);
    if (d < 3080) return O_FF + (d - 3072);
    if (d < 3096) return O_GA + (d - 3080);
    return -1;
}
__device__ __forceinline__ unsigned f2bf(float f) { unsigned u = __builtin_bit_cast(unsigned, f); return (u + 0x7fffu + ((u >> 16) & 1u)) >> 16; }
__device__ __forceinline__ unsigned pk2(float lo, float hi) { return f2bf(lo) | (f2bf(hi) << 16); }
__device__ __forceinline__ float bf2f(unsigned short h) { return __builtin_bit_cast(float, (unsigned)h << 16); }
__device__ __forceinline__ float wave_sum(float v) {
#pragma unroll
    for (int o = 1; o < 64; o <<= 1) v += __shfl_xor(v, o);
    return v;
}
#define FX_LDS_WAIT() asm volatile("s_waitcnt lgkmcnt(0)" ::: "memory")

template <class Map> __device__ __forceinline__ void transpose_item(const float* __restrict__ W, int K, int N, bf16* WT, LAS float* scr, int kb, int nb, int lane, Map srcmap) {
    const int k0 = 64 * kb, n0 = 32 * nb;
    const int src = srcmap(n0 + (lane & 31));
#pragma unroll 8
    for (int i = 0; i < 32; ++i) { const int kk = 2 * i + (lane >> 5); scr[kk * 33 + (lane & 31)] = (src >= 0) ? W[(size_t)(k0 + kk) * N + src] : 0.f; }
    FX_LDS_WAIT(); asm volatile("" ::: "memory");
    const int c = lane & 7;
#pragma unroll
    for (int j = 0; j < 4; ++j) { const int n = (lane >> 3) + 8 * j; const LAS float* s = scr + (8 * c) * 33 + n;
        v4u o; o.x = pk2(s[0 * 33], s[1 * 33]); o.y = pk2(s[2 * 33], s[3 * 33]); o.z = pk2(s[4 * 33], s[5 * 33]); o.w = pk2(s[6 * 33], s[7 * 33]);
        *(GAS v4u*)(WT + (size_t)(n0 + n) * K + k0 + 8 * c) = o; }
    FX_LDS_WAIT(); asm volatile("" ::: "memory");
}

__device__ __forceinline__ void ln_row_bf16(const float* xrow, const float* __restrict__ g, const float* __restrict__ b, bf16* orow, float* frow, float* st, int lane) {
    const GAS f32x4* xr = (const GAS f32x4*)xrow + lane;
    f32x4 v[4]; float s = 0.f;
#pragma unroll
    for (int j = 0; j < 4; ++j) { v[j] = xr[64 * j]; s += (v[j].x + v[j].y) + (v[j].z + v[j].w); }
    const float mean = wave_sum(s) * (1.f / D); float s2 = 0.f;
#pragma unroll
    for (int j = 0; j < 4; ++j) { v[j] = v[j] - mean; s2 += (v[j].x * v[j].x + v[j].y * v[j].y) + (v[j].z * v[j].z + v[j].w * v[j].w); }
    const float rstd = 1.f / sqrtf(wave_sum(s2) * (1.f / D) + LN_EPS);
    if (st && lane == 0) { st[0] = mean; st[1] = rstd; }
    GAS unsigned long long* o8 = (GAS unsigned long long*)orow + lane;
#pragma unroll
    for (int j = 0; j < 4; ++j) {
        const f32x4 gg = ((const f32x4*)g)[lane + 64 * j], bb = ((const f32x4*)b)[lane + 64 * j];
        const f32x4 o = v[j] * rstd * gg + bb;
        o8[64 * j] = (unsigned long long)pk2(o.x, o.y) | ((unsigned long long)pk2(o.z, o.w) << 32);
        if (frow) ((GAS f32x4*)frow)[lane + 64 * j] = o;
    }
}

struct CvItem { const float* W; bf16* WT; int N, K, k0, n0, s0; };
__device__ __forceinline__ void cv_load(const CvItem& it, f32x4 (&v)[8], int lane) {
    const float* p = it.W + (size_t)(it.k0 + (lane >> 3)) * it.N + it.s0 + 4 * (lane & 7);
#pragma unroll
    for (int i = 0; i < 8; ++i) v[i] = __builtin_nontemporal_load((const f32x4*)(p + (size_t)(8 * i) * it.N));
}
__device__ __forceinline__ void cv_finish(const CvItem& it, const f32x4 (&v)[8], LAS float* scr, int lane) {
    const int rr = lane >> 3, cq = lane & 7;
#pragma unroll
    for (int i = 0; i < 8; ++i) { LAS float* d = scr + (8 * i + rr) * 33 + 4 * cq; d[0] = v[i][0]; d[1] = v[i][1]; d[2] = v[i][2]; d[3] = v[i][3]; }
    FX_LDS_WAIT(); asm volatile("" ::: "memory");
    const int c = lane & 7;
#pragma unroll
    for (int j = 0; j < 4; ++j) { const int n = (lane >> 3) + 8 * j; const LAS float* s = scr + (8 * c) * 33 + n;
        v4u o; o.x = pk2(s[0 * 33], s[1 * 33]); o.y = pk2(s[2 * 33], s[3 * 33]); o.z = pk2(s[4 * 33], s[5 * 33]); o.w = pk2(s[6 * 33], s[7 * 33]);
        __builtin_nontemporal_store(o, (GAS v4u*)(it.WT + (size_t)(it.n0 + n) * it.K + it.k0 + 8 * c)); }
    FX_LDS_WAIT(); asm volatile("" ::: "memory");
}

template <int NR> __device__ __forceinline__ void ln_rows_bf16(const float* xrows, const float* __restrict__ g, const float* __restrict__ b, bf16* orows, int lane, float* st = nullptr) {
    f32x4 v[NR][4];
#pragma unroll
    for (int r = 0; r < NR; ++r)
#pragma unroll
        for (int j = 0; j < 4; ++j) v[r][j] = ((const GAS f32x4*)(xrows + (size_t)r * D))[lane + 64 * j];
    f32x4 gg[4], bb[4];
#pragma unroll
    for (int j = 0; j < 4; ++j) { gg[j] = ((const f32x4*)g)[lane + 64 * j]; bb[j] = ((const f32x4*)b)[lane + 64 * j]; }
#pragma unroll
    for (int r = 0; r < NR; ++r) {
        float s = 0.f;
#pragma unroll
        for (int j = 0; j < 4; ++j) s += (v[r][j].x + v[r][j].y) + (v[r][j].z + v[r][j].w);
        const float mean = wave_sum(s) * (1.f / D); float s2 = 0.f;
#pragma unroll
        for (int j = 0; j < 4; ++j) { v[r][j] = v[r][j] - mean; s2 += (v[r][j].x * v[r][j].x + v[r][j].y * v[r][j].y) + (v[r][j].z * v[r][j].z + v[r][j].w * v[r][j].w); }
        const float rstd = 1.f / sqrtf(wave_sum(s2) * (1.f / D) + LN_EPS);
        if (st && lane == 0) { st[2 * r] = mean; st[2 * r + 1] = rstd; }
        GAS unsigned long long* o8 = (GAS unsigned long long*)(orows + (size_t)r * D) + lane;
#pragma unroll
        for (int j = 0; j < 4; ++j) { const f32x4 o = v[r][j] * rstd * gg[j] + bb[j];
            o8[64 * j] = (unsigned long long)pk2(o.x, o.y) | ((unsigned long long)pk2(o.z, o.w) << 32); }
    }
}

template <int NR> __device__ __forceinline__ void ln1_rows_bf16(const float* xrows, const float* st, const float* __restrict__ gi, const float* __restrict__ bi, const bf16* mixrows,
                                                               const float* __restrict__ g1, const float* __restrict__ b1, bf16* orows, float alpha, int lane) {
    f32x4 v[NR][4]; unsigned long long mx[NR][4]; float mean0[NR], rstd0[NR];
#pragma unroll
    for (int r = 0; r < NR; ++r) { mean0[r] = st[2 * r]; rstd0[r] = st[2 * r + 1];
#pragma unroll
        for (int j = 0; j < 4; ++j) { v[r][j] = ((const GAS f32x4*)(xrows + (size_t)r * D))[lane + 64 * j]; mx[r][j] = ((const GAS unsigned long long*)(mixrows + (size_t)r * D))[lane + 64 * j]; } }
    f32x4 gi4[4], bi4[4];
#pragma unroll
    for (int j = 0; j < 4; ++j) { gi4[j] = ((const f32x4*)gi)[lane + 64 * j] * alpha; bi4[j] = ((const f32x4*)bi)[lane + 64 * j] * alpha; }
#pragma unroll
    for (int r = 0; r < NR; ++r) {
        float s = 0.f;
#pragma unroll
        for (int j = 0; j < 4; ++j) { const unsigned lo = (unsigned)mx[r][j], hi = (unsigned)(mx[r][j] >> 32);
            f32x4 mv; mv.x = __builtin_bit_cast(float, lo << 16); mv.y = __builtin_bit_cast(float, lo & 0xffff0000u); mv.z = __builtin_bit_cast(float, hi << 16); mv.w = __builtin_bit_cast(float, hi & 0xffff0000u);
            v[r][j] = ((v[r][j] - mean0[r]) * rstd0[r]) * gi4[j] + bi4[j] + mv;
            s += (v[r][j].x + v[r][j].y) + (v[r][j].z + v[r][j].w); }
        const float mean = wave_sum(s) * (1.f / D); float s2 = 0.f;
#pragma unroll
        for (int j = 0; j < 4; ++j) { v[r][j] = v[r][j] - mean; s2 += (v[r][j].x * v[r][j].x + v[r][j].y * v[r][j].y) + (v[r][j].z * v[r][j].z + v[r][j].w * v[r][j].w); }
        const float rstd = 1.f / sqrtf(wave_sum(s2) * (1.f / D) + LN_EPS);
        GAS unsigned long long* o8 = (GAS unsigned long long*)(orows + (size_t)r * D) + lane;
#pragma unroll
        for (int j = 0; j < 4; ++j) { const f32x4 gg = ((const f32x4*)g1)[lane + 64 * j], bb = ((const f32x4*)b1)[lane + 64 * j]; const f32x4 o = v[r][j] * rstd * gg + bb;
            o8[64 * j] = (unsigned long long)pk2(o.x, o.y) | ((unsigned long long)pk2(o.z, o.w) << 32); }
    }
}
}

namespace pg8 {
struct EpiInProj {
    static constexpr bool PERM = true, AFTER_DRAIN = false;
    bf16_t* QKV; float* FG; float* LF; const float* bfg; unsigned* NRM;
    __device__ __forceinline__ void operator()(const f32x4 (&acc)[2][2][4][2], const Unit& u, int wr, int wc, int fr, int fq) const {
        const int row0 = u.pm * BM + wr * 64 + fr;
        if (u.pn < 12) {
            const float sc = (u.pn < 2) ? fx::C2 : 1.f;
            const int col0 = u.pn * BM + wc * 32 + 8 * fq;
            float nmax[2] = {0.f, 0.f};
#pragma unroll
            for (int ai = 0; ai < 2; ++ai)
#pragma unroll
                for (int m = 0; m < 4; ++m) { bf16_t* rowp = QKV + (size_t)(row0 + ai * HALF + m * 16) * fx::QKVP + col0;
#pragma unroll
                    for (int bj = 0; bj < 2; ++bj) { const f32x4 v0 = acc[ai][bj][m][0] * sc, v1 = acc[ai][bj][m][1] * sc;
                        u32x4 w; w.x = cvt_pk_bf16(v0[0], v0[1]); w.y = cvt_pk_bf16(v0[2], v0[3]); w.z = cvt_pk_bf16(v1[0], v1[1]); w.w = cvt_pk_bf16(v1[2], v1[3]);
                        *(u32x4*)(rowp + bj * HALF) = w;
                        if (u.pn < 4) { const f32x4 q0 = v0 * v0, q1 = v1 * v1; float s = (q0[0] + q0[1]) + (q0[2] + q0[3]) + (q1[0] + q1[1]) + (q1[2] + q1[3]);
                            s += __shfl_xor(s, 16); s += __shfl_xor(s, 32);
                            nmax[bj] = fmaxf(nmax[bj], s); } } }
            if (u.pn < 4) {
#pragma unroll
                for (int bj = 0; bj < 2; ++bj) { float s = nmax[bj];
#pragma unroll
                    for (int o = 1; o < 16; o <<= 1) s = fmaxf(s, __shfl_xor(s, o));
                    if (fr == 0 && fq == 0) { const int b = (u.pm * BM) >> 12, head = 4 * (u.pn & 1) + 2 * bj + (wc >> 1);
                        atomicMax(NRM + (b * 8 + head) * 4 + (u.pn >= 2 ? 2 : 0) + (wc & 1), __builtin_bit_cast(unsigned, s)); } }
            }
        } else if (wc == 0 && fq < 3) {
#pragma unroll
            for (int ai = 0; ai < 2; ++ai)
#pragma unroll
                for (int m = 0; m < 4; ++m) { const int row = row0 + ai * HALF + m * 16; float* p = FG + (size_t)row * 32 + 8 * fq;
                    *(f32x4*)p = acc[ai][0][m][0]; *(f32x4*)(p + 4) = acc[ai][0][m][1];
                    if (fq == 0) { const int b = row >> 12, s = row & 4095;
#pragma unroll
                        for (int n = 0; n < 2; ++n)
#pragma unroll
                            for (int i = 0; i < 4; ++i) { const int h = 4 * n + i; LF[(size_t)(b * 8 + h) * nv::S + s] = -__builtin_amdgcn_logf(1.f + __builtin_amdgcn_exp2f(-1.4426950408889634f * (acc[ai][0][m][n][i] + bfg[h]))); } } }
        }
    }
};
}
namespace gl {
using namespace nv;
typedef unsigned short bf16;
typedef short bf16x8 __attribute__((ext_vector_type(8)));
typedef float f32x4 __attribute__((ext_vector_type(4)));
typedef unsigned u32x4 __attribute__((ext_vector_type(4)));
typedef unsigned u32x2 __attribute__((ext_vector_type(2)));
constexpr int NCH = S / 64;
constexpr int NUNIT = B * GH * NCH;
constexpr int LS = 72;
constexpr int L_WGU = 0, L_BG = 4096, L_DECS = 4352, L_QP = 8192, L_KP = L_QP + 64 * LS * 2, L_KPT = L_KP + 64 * LS * 2, L_VT = L_KPT + 64 * LS * 2, L_PP = L_VT + 128 * LS * 2, L_WT = L_PP + 64 * LS * 2, L_END = L_WT + 2048;
static_assert(L_END <= 131072, "gla prep LDS");
constexpr int C_ST = 0, C_PART = 128 * LS * 2, C_END = C_PART + 2 * 8 * 64 * 4;
constexpr size_t QPG_B = 64 * 64 * 2, OI_B = 8 * 4 * 64 * 16, UU_B = OI_B, DEC_B = 256;

__device__ __forceinline__ unsigned pkbf(float lo, float hi) { typedef float f2 __attribute__((ext_vector_type(2))); typedef __bf16 b2 __attribute__((ext_vector_type(2))); f2 v = {lo, hi}; b2 r = __builtin_convertvector(v, b2); return __builtin_bit_cast(unsigned, r); }
__device__ __forceinline__ float bf2f(unsigned short h) { return __builtin_bit_cast(float, (unsigned)h << 16); }
__device__ __forceinline__ float bflo(unsigned w) { return __builtin_bit_cast(float, w << 16); }
__device__ __forceinline__ float bfhi(unsigned w) { return __builtin_bit_cast(float, w & 0xffff0000u); }
__device__ __forceinline__ float fast_logsig2(float x) { return -__builtin_amdgcn_logf(1.f + __builtin_amdgcn_exp2f(-1.4426950408889634f * x)); }

__device__ __forceinline__ void prep_unit(int unit, const bf16* QKV, const float* FG, const float* __restrict__ wgu, const float* __restrict__ bgate,
                                          unsigned char* QPG, unsigned char* OI, unsigned char* UU, float* DEC, unsigned char* lds, int& cur_h, f32x4 (&Sagg)[4], f32x4 (&Dagg)[4]) {
    int tid_ = threadIdx.x; asm volatile("" : "+v"(tid_));
    const int tid = tid_, lane = tid & 63, wid = __builtin_amdgcn_readfirstlane(tid >> 6), l15 = lane & 15, g = lane >> 4;
    const int n = unit % NCH, bh = unit / NCH, h = bh % GH, b = bh / GH;
    const size_t row0 = (size_t)b * S + (size_t)n * 64;
    float* WGU = (float*)(lds + L_WGU); float* BG = (float*)(lds + L_BG); float* WT = (float*)(lds + L_WT);
    bf16* QP = (bf16*)(lds + L_QP); bf16* KP = (bf16*)(lds + L_KP); bf16* KPT = (bf16*)(lds + L_KPT); bf16* VT = (bf16*)(lds + L_VT); bf16* PP = (bf16*)(lds + L_PP);
    if (cur_h != h) { __syncthreads(); for (int i = tid; i < 16 * 64; i += 512) WGU[i] = wgu[(i >> 6) * 256 + h * 64 + (i & 63)]; if (tid < 64) BG[tid] = bgate[h * 64 + tid]; cur_h = h; __syncthreads(); }
    const int t = tid >> 3, oc = tid & 7, d0 = oc * 8;
    float la[8];
    { const float* gp = FG + (row0 + t) * 32 + 8;
      f32x4 ga4[4];
#pragma unroll
      for (int i = 0; i < 4; ++i) ga4[i] = *(const f32x4*)(gp + 4 * i);
#pragma unroll
      for (int j = 0; j < 8; ++j) la[j] = BG[d0 + j];
#pragma unroll
      for (int r = 0; r < 16; ++r) { const float gv = ga4[r >> 2][r & 3]; const f32x4 w0 = *(const f32x4*)(WGU + r * 64 + d0), w1 = *(const f32x4*)(WGU + r * 64 + d0 + 4);
#pragma unroll
          for (int j = 0; j < 4; ++j) { la[j] += gv * w0[j]; la[4 + j] += gv * w1[j]; } }
#pragma unroll
      for (int j = 0; j < 8; ++j) la[j] = fast_logsig2(la[j]) * (1.f / 16.f); }
    const u32x4 qv = *(const u32x4*)(QKV + (row0 + t) * fx::QKVP + fx::P_GQ + h * 64 + d0);
    const u32x4 kv = *(const u32x4*)(QKV + (row0 + t) * fx::QKVP + fx::P_GK + h * 64 + d0);
    const u32x4 vv0 = *(const u32x4*)(QKV + (row0 + t) * fx::QKVP + fx::P_GV + h * 128 + oc * 16);
    const u32x4 vv1 = *(const u32x4*)(QKV + (row0 + t) * fx::QKVP + fx::P_GV + h * 128 + oc * 16 + 8);
#pragma unroll
    for (int off = 8; off < 64; off <<= 1) {
#pragma unroll
        for (int j = 0; j < 8; ++j) { const float o = __shfl_up(la[j], off); if (lane >= off) la[j] += o; } }
    if (lane >= 56) {
#pragma unroll
        for (int j = 0; j < 8; ++j) WT[wid * 64 + d0 + j] = la[j]; }
    __syncthreads();
    float bl[8];
#pragma unroll
    for (int j = 0; j < 8; ++j) bl[j] = 0.f;
#pragma unroll
    for (int w = 0; w < 8; ++w) {
        const f32x4 a0 = *(const f32x4*)(WT + w * 64 + d0), a1 = *(const f32x4*)(WT + w * 64 + d0 + 4);
#pragma unroll
        for (int j = 0; j < 4; ++j) { bl[j] += a0[j]; bl[4 + j] += a1[j]; if (w < wid) { la[j] += a0[j]; la[4 + j] += a1[j]; } } }
    {
        const unsigned qw[4] = {qv.x, qv.y, qv.z, qv.w}, kw[4] = {kv.x, kv.y, kv.z, kv.w};
        float qf[8], kf[8];
#pragma unroll
        for (int i = 0; i < 4; ++i) { qf[2 * i] = bflo(qw[i]); qf[2 * i + 1] = bfhi(qw[i]); kf[2 * i] = bflo(kw[i]); kf[2 * i + 1] = bfhi(kw[i]); }
        float qp[8], kp[8], kpp[8];
#pragma unroll
        for (int j = 0; j < 8; ++j) { const float bb = la[j], bbl = bl[j];
            qp[j] = qf[j] * (0.125f * __builtin_amdgcn_exp2f(bb)); kp[j] = kf[j] * __builtin_amdgcn_exp2f(-bb); kpp[j] = kf[j] * __builtin_amdgcn_exp2f(bbl - bb); }
        u32x4 qo, ko; qo.x = pkbf(qp[0], qp[1]); qo.y = pkbf(qp[2], qp[3]); qo.z = pkbf(qp[4], qp[5]); qo.w = pkbf(qp[6], qp[7]);
        ko.x = pkbf(kp[0], kp[1]); ko.y = pkbf(kp[2], kp[3]); ko.z = pkbf(kp[4], kp[5]); ko.w = pkbf(kp[6], kp[7]);
        *(u32x4*)(QP + t * LS + d0) = qo; *(u32x4*)(KP + t * LS + d0) = ko;
        *(u32x4*)(QPG + (size_t)unit * QPG_B + (size_t)(t * 64 + d0) * 2) = qo;
#pragma unroll
        for (int j = 0; j < 8; ++j) KPT[(d0 + j) * LS + t] = (bf16)(pkbf(kpp[j], 0.f) & 0xffffu);
        const unsigned vw[8] = {vv0.x, vv0.y, vv0.z, vv0.w, vv1.x, vv1.y, vv1.z, vv1.w};
#pragma unroll
        for (int i = 0; i < 8; ++i) { VT[(oc * 16 + 2 * i) * LS + t] = (bf16)(vw[i] & 0xffffu); VT[(oc * 16 + 2 * i + 1) * LS + t] = (bf16)(vw[i] >> 16); }
        if (t == 0) {
#pragma unroll
            for (int j = 0; j < 8; ++j) { const float dc = __builtin_amdgcn_exp2f(bl[j]); DEC[(size_t)unit * 64 + d0 + j] = dc; ((float*)(lds + L_DECS))[d0 + j] = dc; } }
    }
    __syncthreads();
    { const int ti = wid >> 1;
#pragma unroll
      for (int q2 = 0; q2 < 2; ++q2) { const int sj = 2 * (wid & 1) + q2;
          f32x4 acc = {0.f, 0.f, 0.f, 0.f};
          if (sj <= ti) {
#pragma unroll
              for (int ks = 0; ks < 2; ++ks) { const bf16x8 a = *(const bf16x8*)(QP + (16 * ti + l15) * LS + 32 * ks + 8 * g), bb = *(const bf16x8*)(KP + (16 * sj + l15) * LS + 32 * ks + 8 * g);
                  acc = __builtin_amdgcn_mfma_f32_16x16x32_bf16(a, bb, acc, 0, 0, 0); }
              if (sj == ti) {
#pragma unroll
                  for (int r = 0; r < 4; ++r) if (l15 > 4 * g + r) acc[r] = 0.f; }
          }
#pragma unroll
          for (int r = 0; r < 4; ++r) PP[(16 * ti + 4 * g + r) * LS + 16 * sj + l15] = (bf16)(pkbf(acc[r], 0.f) & 0xffffu);
      } }
    __syncthreads();
    { bf16x8 vb[2];
#pragma unroll
      for (int ks = 0; ks < 2; ++ks) vb[ks] = *(const bf16x8*)(VT + (16 * wid + l15) * LS + 32 * ks + 8 * g);
#pragma unroll
      for (int m = 0; m < 4; ++m) { f32x4 acc = {0.f, 0.f, 0.f, 0.f};
#pragma unroll
          for (int ks = 0; ks < 2; ++ks) { const bf16x8 a = *(const bf16x8*)(PP + (16 * m + l15) * LS + 32 * ks + 8 * g); acc = __builtin_amdgcn_mfma_f32_16x16x32_bf16(a, vb[ks], acc, 0, 0, 0); }
          *(f32x4*)(OI + (size_t)unit * OI_B + (size_t)((wid * 4 + m) * 64 + lane) * 16) = acc; }
#pragma unroll
      for (int db = 0; db < 4; ++db) { f32x4 acc = {0.f, 0.f, 0.f, 0.f};
#pragma unroll
          for (int ks = 0; ks < 2; ++ks) { const bf16x8 a = *(const bf16x8*)(KPT + (16 * db + l15) * LS + 32 * ks + 8 * g); acc = __builtin_amdgcn_mfma_f32_16x16x32_bf16(a, vb[ks], acc, 0, 0, 0); }
          *(f32x4*)(UU + (size_t)unit * UU_B + (size_t)((wid * 4 + db) * 64 + lane) * 16) = acc;
          const f32x4 dcv = *(const f32x4*)((const float*)(lds + L_DECS) + 16 * db + 4 * g);
          Sagg[db] = dcv * Sagg[db] + acc; Dagg[db] = Dagg[db] * dcv; }
    }
}


__device__ __forceinline__ void prep_block(int blk, const bf16* QKV, const float* FG, const float* __restrict__ wgu, const float* __restrict__ bgate,
                                           unsigned char* QPG, unsigned char* OI, unsigned char* UU, float* DEC, unsigned char* AGG, float* DAGG, unsigned char* lds, int& cur_h) {
    f32x4 Sagg[4], Dagg[4];
#pragma unroll
    for (int db = 0; db < 4; ++db) { Sagg[db] = (f32x4){0.f, 0.f, 0.f, 0.f}; Dagg[db] = (f32x4){1.f, 1.f, 1.f, 1.f}; }
    for (int i = 0; i < 8; ++i) prep_unit(blk * 8 + i, QKV, FG, wgu, bgate, QPG, OI, UU, DEC, lds, cur_h, Sagg, Dagg);
    int tid_ = threadIdx.x; asm volatile("" : "+v"(tid_));
    const int lane = tid_ & 63, wid = __builtin_amdgcn_readfirstlane(tid_ >> 6), l15 = lane & 15, g = lane >> 4;
#pragma unroll
    for (int db = 0; db < 4; ++db) { *(f32x4*)(AGG + (size_t)blk * UU_B + (size_t)((wid * 4 + db) * 64 + lane) * 16) = Sagg[db];
        if (wid == 0 && l15 == 0) *(f32x4*)(DAGG + (size_t)blk * 64 + 16 * db + 4 * g) = Dagg[db]; }
}
constexpr int GS = 136;
constexpr int PO_GR = 0, PO_YT = 64 * GS * 2, PO_PART = 2 * 64 * GS * 2, PO_ST = PO_PART + 8 * 64 * 4, PO_END = PO_ST + 128 * LS * 2;
__device__ __forceinline__ void post_block(int u0, int NB, const bf16* QKV, const unsigned char* QPG, const unsigned char* OI, const unsigned char* UU, const float* DEC, const unsigned char* AGG, const float* DAGG, const float* __restrict__ gnorm, bf16* Y, unsigned char* lds) {
    int tid_ = threadIdx.x; asm volatile("" : "+v"(tid_));
    const int tid = tid_, lane = tid & 63, wid = __builtin_amdgcn_readfirstlane(tid >> 6), l15 = lane & 15, g = lane >> 4;
    const int n0 = u0 % NCH, bh = u0 / NCH, h = bh % GH, b = bh / GH;
    bf16* GRs = (bf16*)(lds + PO_GR); bf16* YT = (bf16*)(lds + PO_YT); float* PART = (float*)(lds + PO_PART); bf16* ST = (bf16*)(lds + PO_ST);
    const int t = tid >> 3, oc = tid & 7, e = 16 * wid + l15;
    const float gn = gnorm[e];
    f32x4 Sa[4];
#pragma unroll
    for (int db = 0; db < 4; ++db) Sa[db] = (f32x4){0.f, 0.f, 0.f, 0.f};
    { const int seg0 = bh * (NCH / 8), nseg = n0 / 8;
      for (int i = 0; i < nseg; ++i) {
          f32x4 Ua[4], Da[4];
#pragma unroll
          for (int db = 0; db < 4; ++db) { Ua[db] = *(const f32x4*)(AGG + (size_t)(seg0 + i) * UU_B + (size_t)((wid * 4 + db) * 64 + lane) * 16); Da[db] = *(const f32x4*)(DAGG + (size_t)(seg0 + i) * 64 + 16 * db + 4 * g); }
#pragma unroll
          for (int db = 0; db < 4; ++db) Sa[db] = Da[db] * Sa[db] + Ua[db]; } }
    for (int i = 0; i < NB; ++i) {
        const int unit = u0 + i; const size_t row0 = (size_t)b * S + (size_t)(n0 + i) * 64;
        const u32x4 g0 = *(const u32x4*)(QKV + (row0 + t) * fx::QKVP + fx::P_GR + h * 128 + oc * 16), g1 = *(const u32x4*)(QKV + (row0 + t) * fx::QKVP + fx::P_GR + h * 128 + oc * 16 + 8);
        f32x4 o[4], Uf[4], dv[4]; bf16x8 qa[4][2], sb[2];
#pragma unroll
        for (int m = 0; m < 4; ++m) { o[m] = *(const f32x4*)(OI + (size_t)unit * OI_B + (size_t)((wid * 4 + m) * 64 + lane) * 16);
            Uf[m] = *(const f32x4*)(UU + (size_t)unit * UU_B + (size_t)((wid * 4 + m) * 64 + lane) * 16); dv[m] = *(const f32x4*)(DEC + (size_t)unit * 64 + 16 * m + 4 * g);
#pragma unroll
            for (int ks = 0; ks < 2; ++ks) qa[m][ks] = *(const bf16x8*)(QPG + (size_t)unit * QPG_B + (size_t)((16 * m + l15) * 64 + 32 * ks + 8 * g) * 2); }
#pragma unroll
        for (int db = 0; db < 4; ++db) *(u32x2*)(ST + e * LS + 16 * db + 4 * g) = (u32x2){pkbf(Sa[db][0], Sa[db][1]), pkbf(Sa[db][2], Sa[db][3])};
#pragma unroll
        for (int ks = 0; ks < 2; ++ks) sb[ks] = *(const bf16x8*)(ST + e * LS + 32 * ks + 8 * g);
        *(u32x4*)(GRs + t * GS + oc * 16) = g0; *(u32x4*)(GRs + t * GS + oc * 16 + 8) = g1;
#pragma unroll
        for (int m = 0; m < 4; ++m)
#pragma unroll
            for (int ks = 0; ks < 2; ++ks) o[m] = __builtin_amdgcn_mfma_f32_16x16x32_bf16(qa[m][ks], sb[ks], o[m], 0, 0, 0);
#pragma unroll
        for (int m = 0; m < 4; ++m) { f32x4 q = o[m] * o[m];
#pragma unroll
            for (int off = 1; off < 16; off <<= 1) { q[0] += __shfl_xor(q[0], off); q[1] += __shfl_xor(q[1], off); q[2] += __shfl_xor(q[2], off); q[3] += __shfl_xor(q[3], off); }
            if (l15 == 0) *(f32x4*)(PART + wid * 64 + 16 * m + 4 * g) = q; }
#pragma unroll
        for (int db = 0; db < 4; ++db) Sa[db] = dv[db] * Sa[db] + Uf[db];
        __syncthreads();
#pragma unroll
        for (int m = 0; m < 4; ++m) { f32x4 tot = {0.f, 0.f, 0.f, 0.f};
#pragma unroll
            for (int w = 0; w < 8; ++w) tot += *(const f32x4*)(PART + w * 64 + 16 * m + 4 * g);
#pragma unroll
            for (int r = 0; r < 4; ++r) { const int tt = 16 * m + 4 * g + r; const float rs = rsqrtf(tot[r] * (1.f / GV) + LN_EPS); const float gr = bf2f(GRs[tt * GS + e]);
                const float v = o[m][r] * rs * gn * (gr * __builtin_amdgcn_rcpf(1.f + __builtin_amdgcn_exp2f(-1.4426950408889634f * gr)));
                YT[tt * GS + e] = (bf16)(pkbf(v, 0.f) & 0xffffu); } }
        __syncthreads();
        { const u32x4 y0 = *(const u32x4*)(YT + t * GS + oc * 16), y1 = *(const u32x4*)(YT + t * GS + oc * 16 + 8);
          *(u32x4*)(Y + (row0 + t) * D + 512 + h * GV + oc * 16) = y0; *(u32x4*)(Y + (row0 + t) * D + 512 + h * GV + oc * 16 + 8) = y1; }
        __syncthreads();
    }
}
}
namespace mo {
using namespace nv;
typedef unsigned short bf16;
typedef float f32x4 __attribute__((ext_vector_type(4)));
typedef unsigned u32x4 __attribute__((ext_vector_type(4)));
constexpr int CAP = 8192;
constexpr int NEX = NE + 1;
constexpr int YSH = T * TOPK;
constexpr int L_TB = 132096, L_YB = L_TB + 1040, L_CN = L_YB + 1040, L_UT = 138240, L_RG = 141312;
typedef LAS int* lint;


constexpr int I_EG = NEX * 256, I_ED = NEX * 128, I_EXP = I_EG + I_ED;
struct ExpW { const float* eg; const float* eu; const float* ed; const float* sg; const float* su; const float* sd; bf16* WegT; bf16* WedT; };
__device__ __forceinline__ void cv_decode(int r, const ExpW& X, fx::CvItem& I) {
    if (r < I_EG) { const int e = r >> 8, kb = (r >> 4) & 15, nb = r & 15, c = nb >> 3, sub = nb & 7;
        I.W = (e < NE) ? ((sub < 4 ? X.eg : X.eu) + (size_t)e * D * ED) : (sub < 4 ? X.sg : X.su); I.WT = X.WegT + (size_t)e * 512 * D; I.N = ED; I.K = D; I.k0 = 64 * kb; I.n0 = 32 * nb; I.s0 = 128 * c + 32 * (sub & 3); }
    else { r -= I_EG; const int e = r >> 7, kb = (r >> 5) & 3, nb = r & 31; I.W = (e < NE) ? (X.ed + (size_t)e * ED * D) : X.sd; I.WT = X.WedT + (size_t)e * D * ED; I.N = D; I.K = ED; I.k0 = 64 * kb; I.n0 = 32 * nb; I.s0 = 32 * nb; }
}
__device__ __forceinline__ void expert_conv(const ExpW& X, LAS float* scr, int it0, int step, int lane) {
    int it = it0; fx::CvItem cur, nx; fx::f32x4 v[8], w[8];
    if (it < I_EXP) { cv_decode(it, X, cur); fx::cv_load(cur, v, lane); }
    while (it < I_EXP) { const int itn = it + step; if (itn < I_EXP) { cv_decode(itn, X, nx); fx::cv_load(nx, w, lane); }
        fx::cv_finish(cur, v, scr, lane); cur = nx;
#pragma unroll
        for (int i = 0; i < 8; ++i) v[i] = w[i];
        it = itn; }
}

__device__ __forceinline__ void moe_tables(const int* counts, lint tb, lint yb, lint cn, int lane) {
    int c[4], nt[4]; int st = 0, sy = 0, pt[4], py[4];
#pragma unroll
    for (int i = 0; i < 4; ++i) { c[i] = counts[lane * 4 + i]; c[i] = c[i] > CAP ? CAP : c[i]; nt[i] = (c[i] + 255) >> 8; pt[i] = st; py[i] = sy; st += nt[i]; sy += c[i]; }
    int it = st, iy = sy;
    for (int o = 1; o < 64; o <<= 1) { const int a = __shfl_up(it, o), b = __shfl_up(iy, o); if (lane >= o) { it += a; iy += b; } }
    const int bt = it - st, by = iy - sy;
#pragma unroll
    for (int i = 0; i < 4; ++i) { tb[lane * 4 + i] = bt + pt[i]; yb[lane * 4 + i] = by + py[i]; cn[lane * 4 + i] = c[i]; }
    if (lane == 63) { tb[256] = it; tb[257] = it + T / 256; yb[256] = YSH; cn[256] = T; }
}

__device__ __forceinline__ void route_token2(const float* LG, const float* __restrict__ rbias, int* lcnt, int* TK, float* TW, int t0, int lane) {
    const int l32 = lane & 31, hb = lane & 32, t = t0 + (lane >> 5);
    const float4 la = ((const float4*)(LG + (size_t)t * NE))[2 * l32], lb = ((const float4*)(LG + (size_t)t * NE))[2 * l32 + 1];
    const float4 ra = ((const float4*)rbias)[2 * l32], rb = ((const float4*)rbias)[2 * l32 + 1];
    const float lg[8] = {la.x, la.y, la.z, la.w, lb.x, lb.y, lb.z, lb.w}, rbv[8] = {ra.x, ra.y, ra.z, ra.w, rb.x, rb.y, rb.z, rb.w};
    float sc[8], bv[8];
#pragma unroll
    for (int i = 0; i < 8; ++i) { sc[i] = __builtin_amdgcn_rcpf(1.f + __builtin_amdgcn_exp2f(-1.4426950408889634f * lg[i])); bv[i] = sc[i] + rbv[i]; }
    float m1 = fmaxf(bv[0], bv[1]), m2 = fminf(bv[0], bv[1]);
#pragma unroll
    for (int i = 2; i < 8; ++i) { const float n1 = fmaxf(m1, bv[i]); m2 = fmaxf(fminf(m1, bv[i]), m2); m1 = n1; }
#pragma unroll
    for (int o = 1; o < 4; o <<= 1) { const float p1 = __shfl_xor(m1, o), p2 = __shfl_xor(m2, o); const float n1 = fmaxf(m1, p1); m2 = fmaxf(fminf(m1, p1), fmaxf(m2, p2)); m1 = n1; }
    const float gs = m1 + m2;
    const int myg = l32 >> 2;
    int rank = 0;
#pragma unroll
    for (int g2 = 0; g2 < NG; ++g2) { const float og = __shfl(gs, hb + g2 * 4); if (og > gs || (og == gs && g2 < myg)) ++rank; }
    const bool sel = rank < 4;
    float mv[8];
#pragma unroll
    for (int i = 0; i < 8; ++i) mv[i] = sel ? bv[i] : -INFINITY;
    int mye = 0; float myw = 0.f; float wsum = 0.f;
#pragma unroll
    for (int k = 0; k < TOPK; ++k) {
        float bvv = mv[0]; int bi = 0;
#pragma unroll
        for (int i = 1; i < 8; ++i) if (mv[i] > bvv) { bvv = mv[i]; bi = i; }
        int gi = l32 * 8 + bi;
#pragma unroll
        for (int o = 16; o > 0; o >>= 1) { const float ov = __shfl_xor(bvv, o); const int oi = __shfl_xor(gi, o); if (ov > bvv || (ov == bvv && oi < gi)) { bvv = ov; gi = oi; } }
        const int ol = gi >> 3, oi = gi & 7;
        float s_own = sc[0];
#pragma unroll
        for (int i = 1; i < 8; ++i) s_own = (oi == i) ? sc[i] : s_own;
        const float sw = __shfl(s_own, hb + ol);
        if (l32 == ol) {
#pragma unroll
            for (int i = 0; i < 8; ++i) if (oi == i) mv[i] = -INFINITY; }
        if (l32 == k) { mye = gi; myw = sw; } wsum += sw;
    }
    if (l32 < TOPK) { const int lp = atomicAdd(&lcnt[mye], 1); TK[t * TOPK + l32] = mye | (lp << 9); TW[t * TOPK + l32] = myw * (2.5f / wsum); }
}
__device__ __forceinline__ void route_finish2(const int* lbase, int* list_tok, float* list_gate, int* TK, const float* TW, int t0, int lane) {
    const int l32 = lane & 31, t = t0 + (lane >> 5);
    if (l32 < TOPK) { const int tk = TK[t * TOPK + l32]; const int e = tk & 511, pos = lbase[e] + (tk >> 9);
        if (pos < CAP) { list_tok[e * CAP + pos] = t; list_gate[e * CAP + pos] = TW[t * TOPK + l32]; }
        TK[t * TOPK + l32] = e | (pos << 9); }
}

constexpr float YSC = 16.f;
__device__ __forceinline__ void combine_token(const bf16* H1, const unsigned char* Y, const int* TK, lint yb, const float* __restrict__ g, const float* __restrict__ b, float* out, int t, int lane) {
    typedef float f2 __attribute__((ext_vector_type(2)));
    float v[16], s[16];
    { const u32x4 a = *(const u32x4*)(H1 + (size_t)t * D + 16 * lane), c = *(const u32x4*)(H1 + (size_t)t * D + 16 * lane + 8);
      const unsigned w[8] = {a.x, a.y, a.z, a.w, c.x, c.y, c.z, c.w};
#pragma unroll
      for (int i = 0; i < 8; ++i) { v[2 * i] = ALPHA * __builtin_bit_cast(float, w[i] << 16); v[2 * i + 1] = ALPHA * __builtin_bit_cast(float, w[i] & 0xffff0000u); } }
#pragma unroll
    for (int i = 0; i < 16; ++i) s[i] = 0.f;
    int tk = (lane < TOPK) ? TK[t * TOPK + lane] : 0;
#pragma unroll
    for (int k = 0; k <= TOPK; ++k) {
        size_t yrow;
        if (k < TOPK) { const int x = __shfl(tk, k); yrow = (size_t)(yb[x & 511] + (x >> 9)); } else yrow = (size_t)YSH + t;
        const u32x4 a = *(const u32x4*)(Y + yrow * D + 16 * lane);
        const int w[4] = {(int)a.x, (int)a.y, (int)a.z, (int)a.w};
#pragma unroll
        for (int i = 0; i < 4; ++i) { const f2 lo = __builtin_amdgcn_cvt_pk_f32_fp8(w[i], false), hi = __builtin_amdgcn_cvt_pk_f32_fp8(w[i], true);
            s[4 * i] += lo[0]; s[4 * i + 1] += lo[1]; s[4 * i + 2] += hi[0]; s[4 * i + 3] += hi[1]; }
    }
    float sm = 0.f;
#pragma unroll
    for (int i = 0; i < 16; ++i) { v[i] += s[i] * (1.f / YSC); sm += v[i]; }
    const float mean = fx::wave_sum(sm) * (1.f / D); float q = 0.f;
#pragma unroll
    for (int i = 0; i < 16; ++i) { v[i] -= mean; q += v[i] * v[i]; }
    const float rstd = 1.f / sqrtf(fx::wave_sum(q) * (1.f / D) + LN_EPS);
#pragma unroll
    for (int i = 0; i < 4; ++i) { const f32x4 gg = *(const f32x4*)(g + 16 * lane + 4 * i), bb = *(const f32x4*)(b + 16 * lane + 4 * i);
        f32x4 o; o[0] = v[4 * i] * rstd * gg[0] + bb[0]; o[1] = v[4 * i + 1] * rstd * gg[1] + bb[1]; o[2] = v[4 * i + 2] * rstd * gg[2] + bb[2]; o[3] = v[4 * i + 3] * rstd * gg[3] + bb[3];
        *(f32x4*)(out + (size_t)t * D + 16 * lane + 4 * i) = o; }
}
}

namespace pg8 {
struct RouterSched {
    int rb; const bf16_t* Bt;
    __device__ __forceinline__ bool next(int i, Unit2& u) const { if (i > 0) return false; u.pm = rb; u.pn = 0; u.e = 0; u.cnt = 128; u.jt = 0; u.ui = 0; return true; }
    __device__ __forceinline__ int arow(const Unit2& u, int r) const { return u.pm * 128 + r; }
    __device__ __forceinline__ size_t aoff(const Unit2&) const { return 0; }
    __device__ __forceinline__ const char* bptr(const Unit2&) const { return (const char*)Bt; }
};
struct EpiLogits {
    static constexpr bool PERM = false, AFTER_DRAIN = false;
    float* LG;
    __device__ __forceinline__ void operator()(const f32x4 (&acc)[2][2][4][2], const Unit2& u, int wr, int wc, int fr, int fq) const {
        const int row0 = u.pm * 128 + wr * 64 + fr, col0 = wc * 32 + 4 * fq;
#pragma unroll
        for (int m = 0; m < 4; ++m) { float* rowp = LG + (size_t)(row0 + m * 16) * nv::NE + col0;
#pragma unroll
            for (int bj = 0; bj < 2; ++bj)
#pragma unroll
                for (int n = 0; n < 2; ++n) *(f32x4*)(rowp + bj * HALF + n * 16) = acc[0][bj][m][n]; }
    }
};
template <int PH> struct MoeSched {
    int G, vcu, nrt; mo::lint tb; mo::lint cn; const int* list_tok; const bf16_t* W; mo::lint ut; mo::lint rg;
    static constexpr int NC = PH == 0 ? 2 : 4;
    static constexpr int MAXU = 64;
    __device__ __forceinline__ void build(int lane) const {
        const int L = lane * G + vcu;
        if (lane < MAXU && L < nrt * NC) {
            const int rt = L / NC, c = L % NC;
            int lo = 0, hi = 256;
            while (lo < hi) { const int mid = (lo + hi + 1) >> 1; if (tb[mid] <= rt) lo = mid; else hi = mid - 1; }
            const int e = lo, jt = rt - tb[e], rem = cn[e] - 256 * jt;
            ut[4 * lane] = rt; ut[4 * lane + 1] = c; ut[4 * lane + 2] = e | (jt << 9); ut[4 * lane + 3] = rem < 256 ? rem : 256;
        }
    }
    __device__ __forceinline__ bool next(int i, Unit2& u) const {
        const int L = i * G + vcu; if (i >= MAXU || L >= nrt * NC) return false;
        const int x = ut[4 * i + 2];
        u.pm = __builtin_amdgcn_readfirstlane(ut[4 * i]); u.pn = __builtin_amdgcn_readfirstlane(ut[4 * i + 1]); u.e = __builtin_amdgcn_readfirstlane(x & 511); u.jt = __builtin_amdgcn_readfirstlane(x >> 9);
        u.cnt = __builtin_amdgcn_readfirstlane(ut[4 * i + 3]); u.ui = i; return true;
    }
    __device__ __forceinline__ void fill_rows(const float* list_gate, int tid) const {
        for (int i = 0; i < MAXU; ++i) { const int L = i * G + vcu; if (L >= nrt * NC) break;
            const int x = ut[4 * i + 2], e = x & 511, jt = x >> 9, cnt = ut[4 * i + 3];
            if (tid < 256) { const int r = tid; unsigned v;
                if (e == 256) v = (unsigned)(jt * BM + r) | (0x4180u << 16);
                else if (r < cnt) { const float gsc = mo::YSC * list_gate[e * mo::CAP + jt * BM + r]; v = (unsigned)list_tok[e * mo::CAP + jt * BM + r] | (fx::f2bf(gsc) << 16); }
                else v = 0u;
                rg[i * 256 + r] = (int)v; } }
    }
    __device__ __forceinline__ int arow(const Unit2& u, int r) const {
        if (PH == 1) return u.pm * BM + r;
        return rg[u.ui * 256 + r] & 0x7fff;
    }
    __device__ __forceinline__ size_t aoff(const Unit2& u) const { return PH == 1 ? (size_t)u.pm * (131072 - 32768) : 0; }
    __device__ __forceinline__ const char* bptr(const Unit2& u) const {
        return PH == 0 ? (const char*)(W + ((size_t)u.e * 512 + 256 * u.pn) * 1024) : (const char*)(W + ((size_t)u.e * 1024 + 256 * u.pn) * 256);
    }
};
struct EpiSwiGLU {
    static constexpr bool PERM = true, AFTER_DRAIN = false;
    bf16_t* H; mo::lint rg; int skip;
    __device__ __forceinline__ void operator()(const f32x4 (&acc)[2][2][4][2], const Unit2& u, int wr, int wc, int fr, int fq) const {
        if (skip) return;
        const int col0 = u.pn * 128 + wc * 32 + 8 * fq;
#pragma unroll
        for (int ai = 0; ai < 2; ++ai)
#pragma unroll
            for (int m = 0; m < 4; ++m) { const int r = ai * HALF + wr * 64 + m * 16 + fr;
                const float gt = __builtin_bit_cast(float, (unsigned)rg[u.ui * 256 + r] & 0xffff0000u);
                float hv[8];
#pragma unroll
                for (int n = 0; n < 2; ++n)
#pragma unroll
                    for (int i = 0; i < 4; ++i) { const float gg = acc[ai][0][m][n][i], uu = acc[ai][1][m][n][i]; hv[4 * n + i] = gt * uu * (gg * __builtin_amdgcn_rcpf(1.f + __builtin_amdgcn_exp2f(-1.4426950408889634f * gg))); }
                u32x4 w; w.x = cvt_pk_bf16(hv[0], hv[1]); w.y = cvt_pk_bf16(hv[2], hv[3]); w.z = cvt_pk_bf16(hv[4], hv[5]); w.w = cvt_pk_bf16(hv[6], hv[7]);
                *(u32x4*)(H + (size_t)u.pm * 65536 + (size_t)(col0 >> 6) * 16384 + r * 64 + (col0 & 63)) = w; }
    }
};
struct EpiDown {
    static constexpr bool PERM = true, PERM16 = true, AFTER_DRAIN = false;
    unsigned char* Y; mo::lint yb; int skip;
    __device__ __forceinline__ void operator()(const f32x4 (&acc)[2][2][4][2], const Unit2& u, int wr, int wc, int fr, int fq) const {
        if (skip) return;
        const int col0 = u.pn * BM + wc * 64 + 16 * fq; const int ybase = yb[u.e] + u.jt * BM;
#pragma unroll
        for (int ai = 0; ai < 2; ++ai)
#pragma unroll
            for (int m = 0; m < 4; ++m) { const int r = ai * HALF + wr * 64 + m * 16 + fr;
                if (r < u.cnt) { u32x4 w; unsigned ww[4];
#pragma unroll
                    for (int bj = 0; bj < 2; ++bj)
#pragma unroll
                        for (int n = 0; n < 2; ++n) { const f32x4 v = acc[ai][bj][m][n]; int x = __builtin_amdgcn_cvt_pk_fp8_f32(v[0], v[1], 0, false); x = __builtin_amdgcn_cvt_pk_fp8_f32(v[2], v[3], x, true); ww[2 * bj + n] = (unsigned)x; }
                    w.x = ww[0]; w.y = ww[1]; w.z = ww[2]; w.w = ww[3];
                    *(u32x4*)(Y + (size_t)(ybase + r) * nv::D + col0) = w; } }
    }
};
}
constexpr int NTHR = 512;
constexpr int LDS_BYTES = 163840;
constexpr int MISC_OFF = 131072 + 320;
constexpr size_t MiB = 1u << 20;
constexpr size_t CTL_ZERO_BYTES = 96 * 1024;
constexpr int CW_BAR = 4096;
constexpr int CW_MOE = 16384;
constexpr int CW_FOXQ = 20992;
constexpr int CW_NRM = 20480;
constexpr int NPHASE = 9;
constexpr size_t WS_H1 = 1, WS_WR = 65, WS_STATS = 66, WS_LF = 67, WS_FG = 68, WS_WO = 72, WS_WIN = 74, WS_TK = 81, WS_LTOK = 83, WS_LGATE = 91,
                 WS_WED = 100, WS_HID = 230, WS_GLA = 230, WS_WEG = 416, WS_XN = 673, WS_YBF = 673, WS_QKV = 737, WS_Z1 = 737, WS_LG = 865, WS_Y = 416, WS_END = 992;

struct Args { const float* in[21]; float* out; unsigned char* ws; int ph_lo, ph_hi, li, pad; };

__global__ void __launch_bounds__(NTHR, 2) mega_fwd(Args a) {
    using namespace nv;
    extern __shared__ __attribute__((aligned(16))) unsigned char lds[];
    const int G = gridDim.x, bx = blockIdx.x;
    const int vcu = (G % 8 == 0) ? (bx % 8) * (G / 8) + bx / 8 : bx;
    int tid, lane, wave, vw;
#define DERIVE() do { int t_ = threadIdx.x; asm volatile("" : "+v"(t_)); tid = t_; lane = tid & 63; wave = __builtin_amdgcn_readfirstlane(tid >> 6); vw = vcu * 8 + wave; } while (0)
    DERIVE();
    volatile LAS unsigned* MISC = (volatile LAS unsigned*)((LAS unsigned char*)lds + MISC_OFF);
    for (int u = tid; u < (LDS_BYTES - 131072) / 4; u += NTHR) ((LAS unsigned*)((LAS unsigned char*)lds + 131072))[u] = 0u;
    __syncthreads();
    unsigned char* ws = a.ws;
    unsigned* ctl = (unsigned*)ws;
    XcdBarrier bar = xcd_barrier_post(ctl + CW_BAR + a.li * XCD_BAR_WORDS, MISC + 8);
    const float* x = a.in[0];
    const float* ln_in_g = a.in[1]; const float* ln_in_b = a.in[2];
    const float* w_in = a.in[3]; const float* b_fgate = a.in[4];
    const float* w_gate_up = a.in[5]; const float* b_gate = a.in[6]; const float* g_gla = a.in[7];
    const float* w_out = a.in[8]; const float* ln1_g = a.in[9]; const float* ln1_b = a.in[10];
    const float* w_router = a.in[11]; const float* rbias = a.in[12];
    const float* w_eg = a.in[13]; const float* w_eu = a.in[14]; const float* w_ed = a.in[15];
    const float* w_sg = a.in[16]; const float* w_su = a.in[17]; const float* w_sd = a.in[18];
    const float* ln2_g = a.in[19]; const float* ln2_b = a.in[20];
    float* out = a.out;
    int* counts = (int*)(ctl + CW_MOE);
    fx::bf16* H1 = (fx::bf16*)(ws + WS_H1 * MiB);
    fx::bf16* WrT = (fx::bf16*)(ws + WS_WR * MiB);
    float* stats = (float*)(ws + WS_STATS * MiB);
    float* LF = (float*)(ws + WS_LF * MiB);
    float* FG = (float*)(ws + WS_FG * MiB);
    fx::bf16* WoT = (fx::bf16*)(ws + WS_WO * MiB);
    fx::bf16* WinT = (fx::bf16*)(ws + WS_WIN * MiB);
    int* TK = (int*)(ws + WS_TK * MiB);
    float* TW = (float*)(ws + (WS_TK + 1) * MiB);
    int* list_tok = (int*)(ws + WS_LTOK * MiB);
    float* list_gate = (float*)(ws + WS_LGATE * MiB);
    fx::bf16* WedT = (fx::bf16*)(ws + WS_WED * MiB);
    fx::bf16* HID = (fx::bf16*)(ws + WS_HID * MiB);
    unsigned char* QPG = ws + WS_GLA * MiB; unsigned char* OIb = ws + (WS_GLA + 16) * MiB; unsigned char* UUb = ws + (WS_GLA + 80) * MiB; float* DECb = (float*)(ws + (WS_GLA + 144) * MiB); unsigned char* AGGb = ws + (WS_GLA + 145) * MiB; float* DAGGb = (float*)(ws + (WS_GLA + 153) * MiB);
    fx::bf16* WegT = (fx::bf16*)(ws + WS_WEG * MiB);
    fx::bf16* XN = (fx::bf16*)(ws + WS_XN * MiB);
    fx::bf16* Ybf = (fx::bf16*)(ws + WS_YBF * MiB);
    fx::bf16* QKV = (fx::bf16*)(ws + WS_QKV * MiB);
    fx::bf16* MIX = (fx::bf16*)(ws + WS_Z1 * MiB);
    float* LG = (float*)(ws + WS_LG * MiB);
    unsigned char* YA = ws + WS_Y * MiB;
    mo::lint tb = (mo::lint)((LAS unsigned char*)lds + mo::L_TB), yb = (mo::lint)((LAS unsigned char*)lds + mo::L_YB), cn = (mo::lint)((LAS unsigned char*)lds + mo::L_CN), ut = (mo::lint)((LAS unsigned char*)lds + mo::L_UT), rg = (mo::lint)((LAS unsigned char*)lds + mo::L_RG);

    const int lo = a.ph_lo, hi = a.ph_hi;
    bool tables_ready = false;
#define IN(k) (lo <= (k) && (k) < hi)
#define SEAM(k) do { if (IN(k) && IN((k) + 1)) xcd_barrier(bar); DERIVE(); } while (0)
    const int GW = G * 8;
#ifndef STG7
#define STG7 0
#endif
#ifndef STG8
#define STG8 0
#endif
#define STAGGER(q) do { if ((q) > 0) { const unsigned long long t0_ = __builtin_amdgcn_s_memrealtime(); const unsigned long long d_ = (unsigned long long)((vcu & 3) * (q)); while (__builtin_amdgcn_s_memrealtime() - t0_ < d_) __builtin_amdgcn_s_sleep(8); } } while (0)

    if (IN(0)) {
        LAS float* scr = (LAS float*)((LAS unsigned char*)lds + wave * 16384);
        constexpr int I_IN = 16 * (fx::NIN / 32), I_OUT = 16 * 32, I_R = 16 * 8, I_SMALL = I_IN + I_OUT + I_R;
        for (int it = vw; it < I_SMALL; it += GW) {
            int r = it;
            if (r < I_IN) { fx::transpose_item(w_in, D, INW, WinT, scr, r / (fx::NIN / 32), r % (fx::NIN / 32), lane, [](int d) { return fx::inproj_src(d); }); continue; } r -= I_IN;
            if (r < I_OUT) { fx::transpose_item(w_out, D, D, WoT, scr, r / 32, r % 32, lane, [](int d) { return d; }); continue; } r -= I_OUT;
            fx::transpose_item(w_router, D, NE, WrT, scr, r / 8, r % 8, lane, [](int d) { return d; });
        }
        for (int r = vw * 4; r < T; r += GW * 4) fx::ln_rows_bf16<4>(x + (size_t)r * D, ln_in_g, ln_in_b, XN + (size_t)r * D, lane, stats + 2 * (size_t)r);
    }
    SEAM(0);
    if (IN(1)) {
        const mo::ExpW XW{w_eg, w_eu, w_ed, w_sg, w_su, w_sd, WegT, WedT};
#ifndef MIXG
#define MIXG 2
#endif
        { const int slot = vcu % MIXG; pg8::StaticOrder S; S.init(T, fx::NIN, G, bx);
          const int nun = (S.nwg - bx + G - 1) / G, nb = (MIXG > 1) ? nun * slot / (MIXG - 1) : nun;
          pg8::Gemm g{XN, WinT, T, fx::NIN, D, D}; pg8::EpiInProj E{QKV, FG, LF, b_fgate, ctl + CW_NRM};
          if (nb > 0) { pg8::RangeOrder R{S, 0, nb}; pg8::gemm_phase<pg8::EpiInProj, pg8::RangeOrder, true, true>((LAS unsigned char*)lds, g, R, E); DERIVE(); }
          mo::expert_conv(XW, (LAS float*)((LAS unsigned char*)lds + wave * 16384), vw, GW, lane); __syncthreads(); DERIVE();
          if (nb < nun) { pg8::RangeOrder R{S, nb, nun - nb}; pg8::gemm_phase<pg8::EpiInProj, pg8::RangeOrder, true, true>((LAS unsigned char*)lds, g, R, E); } }
    }
    SEAM(1);
    if (IN(2)) {
        int cur_h = -1;
        for (int blk = vcu; blk < gl::NUNIT / 8; blk += G) gl::prep_block(blk, QKV, FG, w_gate_up, b_gate, QPG, OIb, UUb, DECb, AGGb, DAGGb, lds, cur_h);
    }
    SEAM(2);
    if (IN(3)) {
        for (int blk = vcu; blk < gl::NUNIT / 8; blk += G) gl::post_block(blk * 8, 8, QKV, QPG, OIb, UUb, DECb, AGGb, DAGGb, g_gla, Ybf, lds);
        { const attn_body::AttnTensors AT{(const attn_body::bf16*)(QKV + fx::P_FQ), (const attn_body::bf16*)(QKV + fx::P_FK), (const attn_body::bf16*)(QKV + fx::P_FV), (attn_body::bf16*)Ybf, LF, ctl + CW_NRM};
          attn_body::attn_phase_dyn<8>((char*)lds, AT, ctl + CW_FOXQ, (volatile int*)(lds + 140288), (G % 8 == 0) ? vcu / (G / 8) : vcu % 8); }
    }
    SEAM(3);
    if (IN(4)) {
        pg8::DenseSched DS; DS.so.init(T, D, G, bx); DS.Bt = WoT; DS.ldb = D;
        pg8::EpiPlainBf16 E{MIX, D};
        pg8::gemm_phase2<pg8::EpiPlainBf16, pg8::DenseSched>((LAS unsigned char*)lds, Ybf, D, D, D, DS, E);
    }
    SEAM(4);
    if (IN(5)) {
        int* lcnt = (int*)(lds + 136192); int* lbase = lcnt + 256;
        for (int rb = vcu; rb < T / 128; rb += G) {
            if (tid < 256) lcnt[tid] = 0;
            for (int r = wave * 16; r < wave * 16 + 16; r += 4) { const size_t row = (size_t)rb * 128 + r;
                fx::ln1_rows_bf16<4>(x + row * D, stats + 2 * row, ln_in_g, ln_in_b, MIX + row * D, ln1_g, ln1_b, H1 + row * D, ALPHA, lane); }
            asm volatile("s_waitcnt vmcnt(0)" ::: "memory"); __syncthreads();
            { pg8::RouterSched RS{rb, WrT}; pg8::EpiLogits E{LG};
              pg8::gemm_phase2<pg8::EpiLogits, pg8::RouterSched>((LAS unsigned char*)lds, H1, D, D, D, RS, E); }
            DERIVE();
            for (int t = rb * 128 + wave * 2; t < rb * 128 + 128; t += 16) mo::route_token2(LG, rbias, lcnt, TK, TW, t, lane);
            __syncthreads();
            if (tid < 256) { const int c = lcnt[tid]; lbase[tid] = c ? atomicAdd(&counts[tid], c) : 0; }
            __syncthreads();
            for (int t = rb * 128 + wave * 2; t < rb * 128 + 128; t += 16) mo::route_finish2(lbase, list_tok, list_gate, TK, TW, t, lane);
            __syncthreads();
        }
    }
    SEAM(5);
    if (IN(6)) {
        if (wave == 0) mo::moe_tables(counts, tb, yb, cn, lane);
        __syncthreads(); tables_ready = true;
        STAGGER(STG7);
        pg8::MoeSched<0> MS{G, vcu, tb[257], tb, cn, list_tok, WegT, ut, rg}; if (wave == 0) MS.build(lane); __syncthreads(); MS.fill_rows(list_gate, tid); __syncthreads(); pg8::EpiSwiGLU E{HID, rg, a.pad};
        pg8::gemm_phase2<pg8::EpiSwiGLU, pg8::MoeSched<0>>((LAS unsigned char*)lds, H1, D, D, D, MS, E);
    }
    SEAM(6);
    if (IN(7)) {
        if (!tables_ready) { if (wave == 0) mo::moe_tables(counts, tb, yb, cn, lane); __syncthreads(); tables_ready = true; }
        STAGGER(STG8);
        pg8::MoeSched<1> MS{G, vcu, tb[257], tb, cn, list_tok, WedT, ut, rg}; if (wave == 0) MS.build(lane); __syncthreads(); pg8::EpiDown E{YA, yb, a.pad};
        pg8::gemm_phase2<pg8::EpiDown, pg8::MoeSched<1>>((LAS unsigned char*)lds, HID, 64, ED, ED, MS, E, 32768);
    }
    SEAM(7);
    if (IN(8)) {
        if (!tables_ready) { if (wave == 0) mo::moe_tables(counts, tb, yb, cn, lane); __syncthreads(); tables_ready = true; }
        for (int t = vw; t < T; t += GW) mo::combine_token(H1, YA, TK, yb, ln2_g, ln2_b, out, t, lane);
    }
#undef IN
#undef SEAM
}

extern "C" void kernel_launch(void* const* d_in, const int* in_sizes, int n_in, void* d_out, int out_size, void* d_ws, size_t ws_size, hipStream_t stream) {
    static int grid = 0;
    if (grid == 0) {
        if (n_in != 21 || out_size != nv::T * nv::D || ws_size < WS_END * MiB) { fprintf(stderr, "kernel_launch: unexpected shapes n_in=%d out=%d ws=%zu\n", n_in, out_size, ws_size); grid = -1; return; }
        int dev = 0, cus = 0;
        if (hipGetDevice(&dev) != hipSuccess || hipDeviceGetAttribute(&cus, hipDeviceAttributeMultiprocessorCount, dev) != hipSuccess) { grid = -1; return; }
        if (hipFuncSetAttribute((const void*)mega_fwd, hipFuncAttributeMaxDynamicSharedMemorySize, LDS_BYTES) != hipSuccess) { fprintf(stderr, "kernel_launch: hipFuncSetAttribute failed\n"); grid = -1; return; }
        grid = cus;
    }
    if (grid < 0) return;
    if (hipMemsetAsync(d_ws, 0, CTL_ZERO_BYTES, stream) != hipSuccess) return;
    Args a{};
    for (int i = 0; i < 21; ++i) a.in[i] = (const float*)d_in[i];
    a.out = (float*)d_out; a.ws = (unsigned char*)d_ws; a.ph_lo = 0; a.ph_hi = NPHASE; a.li = 0;
#ifdef REPEAT_PH
    a.ph_hi = REPEAT_PH + 1; hipLaunchKernelGGL(mega_fwd, dim3(grid), dim3(NTHR), LDS_BYTES, stream, a);
    if (REPEAT_PH == 3) hipMemsetAsync((char*)d_ws + CW_FOXQ * 4, 0, 256, stream);
    if (REPEAT_PH == 5) hipMemsetAsync((char*)d_ws + CW_MOE * 4, 0, 4096, stream);
    a.ph_lo = REPEAT_PH; a.ph_hi = NPHASE; a.li = 1;
#ifdef REPEAT_NOEPI
    a.ph_hi = REPEAT_PH + 1; a.pad = 1; hipLaunchKernelGGL(mega_fwd, dim3(grid), dim3(NTHR), LDS_BYTES, stream, a); a.pad = 0; a.ph_lo = REPEAT_PH + 1; a.ph_hi = NPHASE; a.li = 2;
#endif
#endif
    hipLaunchKernelGGL(mega_fwd, dim3(grid), dim3(NTHR), LDS_BYTES, stream, a);
}
```

```cpp
#include <hip/hip_runtime.h>
#include <cstdio>
#include <cstdint>
#include <cmath>

#define LAS __attribute__((address_space(3)))
#define GAS __attribute__((address_space(1)))

#define XB_TMO      128
#define XB_XCNT(j)  (256  + 64 * (j))
#define XB_XSUB(j)  (1280 + 64 * (j))
#define XB_XGEN(j)  (2304 + 64 * (j))
#define XB_TOP      3328
#define XB_TOPGEN   3392
#define XCD_BAR_WORDS 3456
#define XB_SPIN_CAP (1u << 27)
__device__ __forceinline__ unsigned xb_ld(unsigned* p)              { return __hip_atomic_load(p, __ATOMIC_RELAXED, __HIP_MEMORY_SCOPE_AGENT); }
__device__ __forceinline__ unsigned xb_add(unsigned* p, unsigned v) { return __hip_atomic_fetch_add(p, v, __ATOMIC_RELAXED, __HIP_MEMORY_SCOPE_AGENT); }
__device__ __forceinline__ unsigned xb_xcc_id() { return (unsigned)__builtin_amdgcn_s_getreg((3 << 11) | 20) & 0xFu; }
#define XB_SPIN(cond, bar) do { unsigned _sp = 0; while (cond) { __builtin_amdgcn_s_sleep(1); \
    if ((++_sp & 255u) == 0u) { if (xb_ld(&(bar)[XB_TMO])) break; if (_sp > XB_SPIN_CAP) { atomicAdd(&(bar)[XB_TMO], 1u); break; } } } } while (0)
struct XcdBarrier { unsigned* bar; unsigned x; volatile LAS unsigned* st; };
__device__ __forceinline__ XcdBarrier xcd_barrier_post(unsigned* bar, volatile LAS unsigned* st) {
    XcdBarrier b; b.bar = bar; b.x = xb_xcc_id(); b.st = st;
    if (threadIdx.x == 0) (void)xb_add(&bar[XB_XCNT(b.x)], 1u);
    return b;
}
__device__ __forceinline__ void xcd_barrier_complete(unsigned* bar, unsigned x, unsigned& nloc, unsigned& nx) {
    const unsigned G = gridDim.x * gridDim.y * gridDim.z;
    unsigned sum, cnt, mine, sp = 0u;
    for (;;) {
        sum = 0u; cnt = 0u; mine = 0u;
#pragma unroll
        for (unsigned j = 0; j < 16; ++j) { const unsigned c = xb_ld(&bar[XB_XCNT(j)]); sum += c; cnt += (c > 0u) ? 1u : 0u; mine = (j == x) ? c : mine; }
        if (sum == G) break;
        __builtin_amdgcn_s_sleep(1);
        if ((++sp & 255u) == 0u) { if (xb_ld(&bar[XB_TMO])) break; if (sp > XB_SPIN_CAP) { atomicAdd(&bar[XB_TMO], 1u); break; } }
    }
    nloc = mine > 0u ? mine : 1u; nx = cnt > 0u ? cnt : 1u;
}
__device__ __forceinline__ void xcd_barrier(const XcdBarrier& b) {
    asm volatile("s_waitcnt vmcnt(0)" ::: "memory");
    __syncthreads();
    if (threadIdx.x == 0) {
        unsigned* bar = b.bar;
        __builtin_amdgcn_s_waitcnt(0);
        unsigned nloc = b.st[0], nx = b.st[1];
        if (nloc == 0u) { xcd_barrier_complete(bar, b.x, nloc, nx); b.st[0] = nloc; b.st[1] = nx; }
        const unsigned old = xb_add(&bar[XB_XSUB(b.x)], 1u);
        const unsigned gen = old / nloc;
        if (old + 1u == (gen + 1u) * nloc) {
            __builtin_amdgcn_fence(__ATOMIC_RELEASE, "agent");
            asm volatile("s_waitcnt vmcnt(0)" ::: "memory");
            const unsigned og = xb_add(&bar[XB_TOP], 1u);
            const unsigned tg = og / nx;
            if (og + 1u == (tg + 1u) * nx) xb_add(&bar[XB_TOPGEN], 1u);
            else XB_SPIN(xb_ld(&bar[XB_TOPGEN]) == tg, bar);
            __builtin_amdgcn_fence(__ATOMIC_ACQUIRE, "agent");
            xb_add(&bar[XB_XGEN(b.x)], 1u);
            asm volatile("s_waitcnt vmcnt(0)" ::: "memory");
        } else {
            XB_SPIN(xb_ld(&bar[XB_XGEN(b.x)]) == gen, bar);
            __builtin_amdgcn_fence(__ATOMIC_ACQUIRE, "agent");
            asm volatile("s_waitcnt vmcnt(0)" ::: "memory");
        }
    }
    __syncthreads();
}
namespace pg8 {
#define PG8_LAS __attribute__((address_space(3)))
typedef unsigned short bf16_t;
typedef short bf16x8 __attribute__((ext_vector_type(8)));
typedef float f32x4 __attribute__((ext_vector_type(4)));
typedef unsigned u32x4 __attribute__((ext_vector_type(4)));
constexpr int BM = 256, BK = 64, HALF = 128, HTB = HALF * BK * 2  , STAGE_BYTES = 8 * HTB, NXCD = 8, WGM = 8;

__host__ __device__ __forceinline__ int lds_byte(int r, int c) { const int st = (r >> 4) * 2 + (c >> 5), rr = r & 15, cc = c & 31, ob = rr * 64 + cc * 2; return st * 1024 + (ob ^ (((ob >> 9) & 1) << 5)); }
__host__ __device__ __forceinline__ void stage_rc(int b, int& R, int& C) { const int st = b / 1024, sb = b % 1024, swz = sb ^ (((sb >> 9) & 1) << 5); R = (st >> 1) * 16 + swz / 64; C = (st & 1) * 32 + (swz % 64) / 2; }
__host__ __device__ __forceinline__ int perm32(int rho) { const int n = rho >> 4, i = rho & 15; return 8 * (i >> 2) + 4 * n + (i & 3); }

struct Unit { int pm, pn; };
struct Gemm { const bf16_t* A; const bf16_t* Bt; int M, N, K, lda; };

struct StaticOrder {
    int nM, nN, nwg, G, c;
    __host__ __device__ void init(int M, int N, int G_, int c_) { nM = M / BM; nN = N / BM; nwg = nM * nN; G = G_; c = c_; }
    __host__ __device__ bool next(int i, Unit& u) const {
        const long L = (long)i * G + c; if (L >= nwg) return false;
        int wgid = (int)L; { const int q = nwg / NXCD, r = nwg % NXCD, xcd = wgid % NXCD, off = wgid / NXCD; wgid = (xcd < r ? xcd * (q + 1) : r * (q + 1) + (xcd - r) * q) + off; }
        const int nig = WGM * nN, gid = wgid / nig, fm = gid * WGM, gsz = (nM - fm) < WGM ? (nM - fm) : WGM;
        u.pm = fm + ((wgid % nig) % gsz); u.pn = (wgid % nig) / gsz; return true;
    }
    __device__ __forceinline__ void a_ready(const Unit&) const {}
    __device__ __forceinline__ void done(const Unit&) const {}
};

struct RangeOrder {
    StaticOrder so; int i0, n;
    __host__ __device__ bool next(int i, Unit& u) const { return i < n && so.next(i0 + i, u); }
    __device__ __forceinline__ void a_ready(const Unit&) const {}
    __device__ __forceinline__ void done(const Unit&) const {}
};
__device__ __forceinline__ unsigned cvt_pk_bf16(float lo, float hi) { unsigned r; asm volatile("v_cvt_pk_bf16_f32 %0, %1, %2" : "=v"(r) : "v"(lo), "v"(hi)); return r; }
typedef float f32x2 __attribute__((ext_vector_type(2)));
__device__ __forceinline__ f32x2 gelu_pk(f32x2 v) {
    const f32x2 av = __builtin_elementwise_abs(v), d = av * 0.2316418882f + 1.0f;
    f32x2 t; t.x = __builtin_amdgcn_rcpf(d.x); t.y = __builtin_amdgcn_rcpf(d.y);
    f32x2 q = t * 0.5307027145f + (-0.7265760135f); q = q * t + 0.7107068705f; q = q * t + (-0.142248368f); q = q * t + 0.127414796f; q = q * t;
    const f32x2 s = (v * v) * (-0.72134752044f);
    f32x2 e; e.x = __builtin_amdgcn_exp2f(s.x); e.y = __builtin_amdgcn_exp2f(s.y);
    const f32x2 m = v * (q * e), r = v - m;
    f32x2 o; o.x = v.x < 0.f ? m.x : r.x; o.y = v.y < 0.f ? m.y : r.y; return o;
}

template <int ACT  > struct EpiBf16 {
    static constexpr bool PERM = true, AFTER_DRAIN = false; static_assert(ACT == 0 || ACT == 1, "EpiBf16: ACT is 0 (none) or 1 (gelu_pk)");
    bf16_t* O; int ldc; const float* bias; int split_cols; size_t split_stride; float scale0;
    __device__ __forceinline__ void operator()(const f32x4 (&acc)[2][2][4][2], const Unit& u, int wr, int wc, int fr, int fq) const {
        const int row0 = u.pm * BM + wr * 64 + fr; int colt = u.pn * BM; bf16_t* base = O;
        float sc = 1.f; if (split_cols) { const int t = colt / split_cols; base += (size_t)t * split_stride; colt -= t * split_cols; if (t == 0) sc = scale0; }
        const int col0 = colt + wc * 32 + 8 * fq, bcol0 = u.pn * BM + wc * 32 + 8 * fq;
        f32x4 bv[2][2];
#pragma unroll
        for (int bj = 0; bj < 2; ++bj)
#pragma unroll
            for (int n = 0; n < 2; ++n) bv[bj][n] = bias ? *(const f32x4*)(bias + bcol0 + bj * HALF + 4 * n) : (f32x4){0.f, 0.f, 0.f, 0.f};
#pragma unroll
        for (int ai = 0; ai < 2; ++ai)
#pragma unroll
            for (int m = 0; m < 4; ++m) { bf16_t* rowp = base + (size_t)(row0 + ai * HALF + m * 16) * ldc + col0;
#pragma unroll
                for (int bj = 0; bj < 2; ++bj) { f32x4 v0 = acc[ai][bj][m][0] + bv[bj][0], v1 = acc[ai][bj][m][1] + bv[bj][1];
                    if (ACT == 1) { f32x2 a = gelu_pk((f32x2){v0[0], v0[1]}), b = gelu_pk((f32x2){v0[2], v0[3]}), c = gelu_pk((f32x2){v1[0], v1[1]}), d = gelu_pk((f32x2){v1[2], v1[3]});
                        v0 = (f32x4){a.x, a.y, b.x, b.y}; v1 = (f32x4){c.x, c.y, d.x, d.y}; }
                    v0 = v0 * sc; v1 = v1 * sc; u32x4 w; w.x = cvt_pk_bf16(v0[0], v0[1]); w.y = cvt_pk_bf16(v0[2], v0[3]); w.z = cvt_pk_bf16(v1[0], v1[1]); w.w = cvt_pk_bf16(v1[2], v1[3]);
                    *(u32x4*)(rowp + bj * HALF) = w; } }
    }
};

template <class Epi, class Sched, bool ALIGN_EPI = false, bool SP2 = false>
__device__ __forceinline__ void gemm_phase(PG8_LAS unsigned char* lds, const Gemm g, const Sched& S, const Epi& E) {
    const int tid = threadIdx.x, wid = __builtin_amdgcn_readfirstlane(tid >> 6), lane = tid & 63, wr = wid >> 2, wc = wid & 3, fr = lane & 15, fq = lane >> 4;
    const int K = g.K, nt = K / BK;
    unsigned voffA[2], voffB[2];
#pragma unroll
    for (int i = 0; i < 2; ++i) { int R, C; stage_rc(tid * 16 + i * 8192, R, C); const int Rb = Epi::PERM ? ((R & ~31) + perm32(R & 31)) : R;
        voffA[i] = (unsigned)(R * g.lda + C) * 2u; voffB[i] = (unsigned)(Rb * K + C) * 2u; }
    const size_t kstep = (size_t)(BK * 2);
    const size_t hstepA = (size_t)HALF * g.lda * 2, hstepB = (size_t)HALF * K * 2;
    const size_t tstepA = 2 * hstepA, tstepB = 2 * hstepB;
    const unsigned ldsw = (unsigned)wid * 1024u;
    const int aoff = lds_byte(wr * 64 + fr, fq * 8), boff = lds_byte(wc * 32 + fr, fq * 8);
#define PG8_SA(b, h) (((b) * 2 + (h)) * HTB)
#define PG8_SB(b, h) ((4 + (b) * 2 + (h)) * HTB)
#define PG8_STAGE(bufoff, gbase, voff) do { _Pragma("unroll") for (int _i = 0; _i < 2; ++_i) \
        __builtin_amdgcn_global_load_lds((const unsigned*)((const char*)(gbase) + (voff)[_i]), (PG8_LAS unsigned*)(lds + (bufoff) + ldsw + _i * 8192), 16, 0, 0); } while (0)
#define PG8_LDA(dst, b, h) do { _Pragma("unroll") for (int m = 0; m < 4; ++m) _Pragma("unroll") for (int k = 0; k < 2; ++k) dst[m][k] = *(const PG8_LAS bf16x8*)(lds + PG8_SA(b, h) + aoff + m * 2048 + k * 1024); } while (0)
#define PG8_LDB(dst, b, h) do { _Pragma("unroll") for (int n = 0; n < 2; ++n) _Pragma("unroll") for (int k = 0; k < 2; ++k) dst[n][k] = *(const PG8_LAS bf16x8*)(lds + PG8_SB(b, h) + boff + n * 2048 + k * 1024); } while (0)
#define PG8_MMA(ai, bj, At, Bt) do { __builtin_amdgcn_s_setprio(1); _Pragma("unroll") for (int m = 0; m < 4; ++m) _Pragma("unroll") for (int n = 0; n < 2; ++n) _Pragma("unroll") for (int k = 0; k < 2; ++k) \
        acc[ai][bj][m][n] = __builtin_amdgcn_mfma_f32_16x16x32_bf16(Bt[n][k], At[m][k], acc[ai][bj][m][n], 0, 0, 0); __builtin_amdgcn_s_setprio(0); } while (0)
#define PG8_WAIT_V(n) asm volatile("s_waitcnt vmcnt(" #n ")" ::: "memory")
#define PG8_WAIT_L(n) asm volatile("s_waitcnt lgkmcnt(" #n ")" ::: "memory")
#define PG8_BAR __builtin_amdgcn_s_barrier()
#define PG8_SCHED __builtin_amdgcn_sched_barrier(0)
    Unit cur, nxt; int ui = 0;
    if (!S.next(0, cur)) return;
    f32x4 acc[2][2][4][2];
#pragma unroll
    for (int a = 0; a < 2; ++a)
#pragma unroll
        for (int b = 0; b < 2; ++b)
#pragma unroll
            for (int m = 0; m < 4; ++m)
#pragma unroll
                for (int n = 0; n < 2; ++n) acc[a][b][m][n] = (f32x4){0.f, 0.f, 0.f, 0.f};
    bf16x8 At[4][2], B0[2][2], B1[2][2];
    const char* cA = (const char*)g.A + (size_t)cur.pm * tstepA; const char* cB = (const char*)g.Bt + (size_t)cur.pn * tstepB;
    S.a_ready(cur);
    if constexpr (SP2) {
        PG8_STAGE(PG8_SB(0, 0), cB, voffB); PG8_STAGE(PG8_SB(0, 1), cB + hstepB, voffB); PG8_STAGE(PG8_SA(0, 0), cA, voffA); PG8_STAGE(PG8_SA(0, 1), cA + hstepA, voffA);
        if (wr == 1) PG8_BAR;
        PG8_WAIT_V(2); PG8_BAR;
        PG8_STAGE(PG8_SB(1, 0), cB + kstep, voffB); PG8_STAGE(PG8_SA(1, 0), cA + kstep, voffA); PG8_STAGE(PG8_SB(1, 1), cB + hstepB + kstep, voffB);
        PG8_WAIT_V(6); PG8_BAR;
    } else {
        PG8_STAGE(PG8_SB(0, 0), cB, voffB); PG8_STAGE(PG8_SA(0, 0), cA, voffA); PG8_STAGE(PG8_SB(0, 1), cB + hstepB, voffB); PG8_STAGE(PG8_SA(0, 1), cA + hstepA, voffA);
        if (wr == 1) PG8_BAR;
        PG8_WAIT_V(4); PG8_BAR;
        PG8_STAGE(PG8_SB(1, 0), cB + kstep, voffB); PG8_STAGE(PG8_SA(1, 0), cA + kstep, voffA); PG8_STAGE(PG8_SB(1, 1), cB + hstepB + kstep, voffB);
        PG8_WAIT_V(6); PG8_BAR;
    }
    for (;;) {
        const bool has_next = S.next(ui + 1, nxt);
        const char* nA = has_next ? (const char*)g.A + (size_t)nxt.pm * tstepA : cA; const char* nB = has_next ? (const char*)g.Bt + (size_t)nxt.pn * tstepB : cB;
        for (int t = 0; t < nt; t += 2) {
            const bool last = (t == nt - 2);
            const char* a1 = cA + (size_t)(t + 1) * kstep;
            const char* a2 = last ? nA : cA + (size_t)(t + 2) * kstep; const char* b2 = last ? nB : cB + (size_t)(t + 2) * kstep;
            const char* a3 = a2 + kstep; const char* b3 = b2 + kstep;
            if (last && has_next) S.a_ready(nxt);
            if constexpr (SP2) {
            PG8_LDB(B0, 0, 0); PG8_LDB(B1, 0, 1); PG8_SCHED; PG8_LDA(At, 0, 0); PG8_STAGE(PG8_SA(1, 1), a1 + hstepA, voffA);
            PG8_WAIT_V(8); PG8_WAIT_L(0); PG8_BAR; PG8_MMA(0, 0, At, B0); PG8_MMA(0, 1, At, B1); PG8_BAR; PG8_SCHED;
            PG8_LDA(At, 0, 1); PG8_STAGE(PG8_SB(0, 0), b2, voffB); PG8_STAGE(PG8_SB(0, 1), b2 + hstepB, voffB); PG8_STAGE(PG8_SA(0, 0), a2, voffA);
            PG8_WAIT_V(8); PG8_WAIT_L(0); PG8_BAR; PG8_MMA(1, 0, At, B0); PG8_MMA(1, 1, At, B1); PG8_BAR; PG8_SCHED;
            PG8_LDB(B0, 1, 0); PG8_LDB(B1, 1, 1); PG8_SCHED; PG8_LDA(At, 1, 0); PG8_STAGE(PG8_SA(0, 1), a2 + hstepA, voffA);
            PG8_WAIT_V(8); PG8_WAIT_L(0); PG8_BAR; PG8_MMA(0, 0, At, B0); PG8_MMA(0, 1, At, B1); PG8_BAR; PG8_SCHED;
            PG8_LDA(At, 1, 1); PG8_STAGE(PG8_SB(1, 0), b3, voffB); PG8_STAGE(PG8_SB(1, 1), b3 + hstepB, voffB); PG8_STAGE(PG8_SA(1, 0), a3, voffA);
            PG8_WAIT_V(8); PG8_WAIT_L(0); PG8_BAR; PG8_MMA(1, 0, At, B0); PG8_MMA(1, 1, At, B1); PG8_BAR; PG8_SCHED;
            } else {
            PG8_LDB(B0, 0, 0); PG8_SCHED; PG8_LDA(At, 0, 0); PG8_STAGE(PG8_SA(1, 1), a1 + hstepA, voffA);
            PG8_WAIT_L(8); PG8_BAR; PG8_WAIT_L(0); PG8_MMA(0, 0, At, B0); PG8_BAR; PG8_SCHED;
            PG8_LDB(B1, 0, 1); PG8_STAGE(PG8_SB(0, 0), b2, voffB);
            PG8_BAR; PG8_WAIT_L(0); PG8_MMA(0, 1, At, B1); PG8_BAR;
            PG8_LDA(At, 0, 1); PG8_STAGE(PG8_SA(0, 0), a2, voffA);
            PG8_BAR; PG8_WAIT_L(0); PG8_MMA(1, 0, At, B0); PG8_BAR; PG8_SCHED;
            PG8_STAGE(PG8_SB(0, 1), b2 + hstepB, voffB);
            PG8_WAIT_V(6); PG8_BAR; PG8_MMA(1, 1, At, B1); PG8_BAR;
            PG8_LDB(B0, 1, 0); PG8_SCHED; PG8_LDA(At, 1, 0); PG8_STAGE(PG8_SA(0, 1), a2 + hstepA, voffA);
            PG8_WAIT_L(8); PG8_BAR; PG8_WAIT_L(0); PG8_MMA(0, 0, At, B0); PG8_BAR; PG8_SCHED;
            PG8_LDB(B1, 1, 1); PG8_STAGE(PG8_SB(1, 0), b3, voffB);
            PG8_BAR; PG8_WAIT_L(0); PG8_MMA(0, 1, At, B1); PG8_BAR;
            PG8_LDA(At, 1, 1); PG8_STAGE(PG8_SA(1, 0), a3, voffA);
            PG8_BAR; PG8_WAIT_L(0); PG8_MMA(1, 0, At, B0); PG8_BAR; PG8_SCHED;
            PG8_STAGE(PG8_SB(1, 1), b3 + hstepB, voffB);
            PG8_WAIT_V(6); PG8_BAR; PG8_MMA(1, 1, At, B1); PG8_BAR;
            }
        }
        if constexpr (ALIGN_EPI) { if (wr == 0) PG8_BAR; }
        if constexpr (!Epi::AFTER_DRAIN) { E(acc, cur, wr, wc, fr, fq); S.done(cur); }
        if (!has_next) break;
#pragma unroll
        for (int a = 0; a < 2; ++a)
#pragma unroll
            for (int b = 0; b < 2; ++b)
#pragma unroll
                for (int m = 0; m < 4; ++m)
#pragma unroll
                    for (int n = 0; n < 2; ++n) acc[a][b][m][n] = (f32x4){0.f, 0.f, 0.f, 0.f};
        cur = nxt; cA = nA; cB = nB; ++ui;
        if constexpr (ALIGN_EPI) { if (wr == 1) PG8_BAR; }
    }
    PG8_WAIT_V(0);
    if constexpr (!ALIGN_EPI) { if (wr == 0) PG8_BAR; }
    PG8_BAR;
    if constexpr (Epi::AFTER_DRAIN) { E.fused(acc, cur, wr, wc, fr, fq, lds, wid, lane); S.done(cur); }
#undef PG8_SA
#undef PG8_SB
#undef PG8_STAGE
#undef PG8_LDA
#undef PG8_LDB
#undef PG8_MMA
#undef PG8_WAIT_V
#undef PG8_WAIT_L
#undef PG8_BAR
#undef PG8_SCHED
}
}
namespace pg8 {
struct Unit2 { int pm, pn, e, cnt, jt, ui; };
template <class E, class = void> struct has_perm16 { static constexpr bool value = false; };
template <class E> struct has_perm16<E, decltype((void)E::PERM16)> { static constexpr bool value = E::PERM16; };
template <class E> constexpr bool perm16() { return has_perm16<E>::value; }
template <class Epi, class Sched>
__device__ __forceinline__ void gemm_phase2(PG8_LAS unsigned char* lds, const bf16_t* Abase, int lda, int ldb, int K, const Sched& S, const Epi& E, int kstepA_ = BK * 2) {
    int tid_ = threadIdx.x; asm volatile("" : "+v"(tid_));
    const int tid = tid_, wid = __builtin_amdgcn_readfirstlane(tid >> 6), lane = tid & 63, wr = wid >> 2, wc = wid & 3, fr = lane & 15, fq = lane >> 4;
    int K_ = K; asm volatile("" : "+s"(K_));
    const int nt = K_ / BK;
    unsigned voffB0[2], voffB1[2];
#pragma unroll
    for (int i = 0; i < 2; ++i) { int R, C; stage_rc(tid * 16 + i * 8192, R, C);
        if constexpr (perm16<Epi>()) { const int cb = 64 * (R >> 5) + 16 * ((R >> 2) & 3) + 4 * ((R >> 4) & 1) + (R & 3); voffB0[i] = (unsigned)(cb * ldb + C) * 2u; voffB1[i] = (unsigned)((cb + 8) * ldb + C) * 2u; }
        else { const int Rb = Epi::PERM ? ((R & ~31) + perm32(R & 31)) : R; voffB0[i] = (unsigned)(Rb * ldb + C) * 2u; voffB1[i] = voffB0[i] + (unsigned)(HALF * ldb * 2); } }
    const unsigned lda2 = (unsigned)lda * 2u;
#define PG8_AOFFS(U, o0, o1) do { int t2_ = threadIdx.x; asm volatile("" : "+v"(t2_)); _Pragma("unroll") for (int i_ = 0; i_ < 2; ++i_) { int R_, C_; stage_rc(t2_ * 16 + i_ * 8192, R_, C_); \
        o0[i_] = (unsigned)S.arow(U, R_) * lda2 + (unsigned)C_ * 2u; o1[i_] = (unsigned)S.arow(U, HALF + R_) * lda2 + (unsigned)C_ * 2u; } } while (0)
    const size_t kstep = (size_t)(BK * 2), kstepA = (size_t)kstepA_;
    const unsigned ldsw = (unsigned)wid * 1024u;
    const int aoff = lds_byte(wr * 64 + fr, fq * 8), boff = lds_byte(wc * 32 + fr, fq * 8);
#define PG8_SA(b, h) (((b) * 2 + (h)) * HTB)
#define PG8_SB(b, h) ((4 + (b) * 2 + (h)) * HTB)
#define PG8_STAGE(bufoff, gbase, voff) do { _Pragma("unroll") for (int _i = 0; _i < 2; ++_i) \
        __builtin_amdgcn_global_load_lds((const unsigned*)((const char*)(gbase) + (voff)[_i]), (PG8_LAS unsigned*)(lds + (bufoff) + ldsw + _i * 8192), 16, 0, 0); } while (0)
#define PG8_LDA(dst, b, h) do { _Pragma("unroll") for (int m = 0; m < 4; ++m) _Pragma("unroll") for (int k = 0; k < 2; ++k) dst[m][k] = *(const PG8_LAS bf16x8*)(lds + PG8_SA(b, h) + aoff + m * 2048 + k * 1024); } while (0)
#define PG8_LDB(dst, b, h) do { _Pragma("unroll") for (int n = 0; n < 2; ++n) _Pragma("unroll") for (int k = 0; k < 2; ++k) dst[n][k] = *(const PG8_LAS bf16x8*)(lds + PG8_SB(b, h) + boff + n * 2048 + k * 1024); } while (0)
#define PG8_MMA(ai, bj, At, Bt) do { __builtin_amdgcn_s_setprio(1); _Pragma("unroll") for (int m = 0; m < 4; ++m) _Pragma("unroll") for (int n = 0; n < 2; ++n) _Pragma("unroll") for (int k = 0; k < 2; ++k) \
        acc[ai][bj][m][n] = __builtin_amdgcn_mfma_f32_16x16x32_bf16(Bt[n][k], At[m][k], acc[ai][bj][m][n], 0, 0, 0); __builtin_amdgcn_s_setprio(0); } while (0)
#define PG8_WAIT_V(n) asm volatile("s_waitcnt vmcnt(" #n ")" ::: "memory")
#define PG8_WAIT_L(n) asm volatile("s_waitcnt lgkmcnt(" #n ")" ::: "memory")
#define PG8_BAR __builtin_amdgcn_s_barrier()
#define PG8_SCHED __builtin_amdgcn_sched_barrier(0)
    Unit2 cur, nxt; int ui = 0;
    if (!S.next(0, cur)) return;
    f32x4 acc[2][2][4][2];
#pragma unroll
    for (int a = 0; a < 2; ++a)
#pragma unroll
        for (int b = 0; b < 2; ++b)
#pragma unroll
            for (int m = 0; m < 4; ++m)
#pragma unroll
                for (int n = 0; n < 2; ++n) acc[a][b][m][n] = (f32x4){0.f, 0.f, 0.f, 0.f};
    bf16x8 At[4][2], B0[2][2], B1[2][2];
    unsigned cv0[2], cv1[2], nv0[2], nv1[2];
    PG8_AOFFS(cur, cv0, cv1);
    const char* cA = (const char*)Abase + S.aoff(cur); const char* cB = S.bptr(cur);
    PG8_STAGE(PG8_SB(0, 0), cB, voffB0); PG8_STAGE(PG8_SB(0, 1), cB, voffB1); PG8_STAGE(PG8_SA(0, 0), cA, cv0); PG8_STAGE(PG8_SA(0, 1), cA, cv1);
    if (wr == 1) PG8_BAR;
    PG8_WAIT_V(2); PG8_BAR;
    PG8_STAGE(PG8_SB(1, 0), cB + kstep, voffB0); PG8_STAGE(PG8_SA(1, 0), cA + kstepA, cv0); PG8_STAGE(PG8_SB(1, 1), cB + kstep, voffB1);
    PG8_WAIT_V(6); PG8_BAR;
    for (;;) {
        const bool has_next = S.next(ui + 1, nxt);
        const char* nA = has_next ? (const char*)Abase + S.aoff(nxt) : cA; const char* nB = has_next ? S.bptr(nxt) : cB;
#pragma unroll
        for (int i = 0; i < 2; ++i) { nv0[i] = cv0[i]; nv1[i] = cv1[i]; }
        if (has_next) PG8_AOFFS(nxt, nv0, nv1);
        const bool act0 = cur.cnt > wr * 64, act1 = cur.cnt > HALF + wr * 64;
        for (int t = 0; t < nt; t += 2) {
            const bool last = (t == nt - 2);
            const char* a1 = cA + (size_t)(t + 1) * kstepA;
            const char* a2 = last ? nA : cA + (size_t)(t + 2) * kstepA; const char* b2 = last ? nB : cB + (size_t)(t + 2) * kstep;
            const char* a3 = a2 + kstepA; const char* b3 = b2 + kstep;
            unsigned s0[2] = {cv0[0], cv0[1]}, s1[2] = {cv1[0], cv1[1]};
            if (last) { asm volatile("" ::: "memory"); s0[0] = nv0[0]; s0[1] = nv0[1]; s1[0] = nv1[0]; s1[1] = nv1[1]; }
            PG8_LDB(B0, 0, 0); PG8_LDB(B1, 0, 1); PG8_SCHED; PG8_LDA(At, 0, 0); PG8_STAGE(PG8_SA(1, 1), a1, cv1);
            PG8_WAIT_V(8); PG8_WAIT_L(0); PG8_BAR; if (act0) { PG8_MMA(0, 0, At, B0); PG8_MMA(0, 1, At, B1); } PG8_BAR; PG8_SCHED;
            PG8_LDA(At, 0, 1); PG8_STAGE(PG8_SB(0, 0), b2, voffB0); PG8_STAGE(PG8_SB(0, 1), b2, voffB1); PG8_STAGE(PG8_SA(0, 0), a2, s0);
            PG8_WAIT_V(8); PG8_WAIT_L(0); PG8_BAR; if (act1) { PG8_MMA(1, 0, At, B0); PG8_MMA(1, 1, At, B1); } PG8_BAR; PG8_SCHED;
            PG8_LDB(B0, 1, 0); PG8_LDB(B1, 1, 1); PG8_SCHED; PG8_LDA(At, 1, 0); PG8_STAGE(PG8_SA(0, 1), a2, s1);
            PG8_WAIT_V(8); PG8_WAIT_L(0); PG8_BAR; if (act0) { PG8_MMA(0, 0, At, B0); PG8_MMA(0, 1, At, B1); } PG8_BAR; PG8_SCHED;
            PG8_LDA(At, 1, 1); PG8_STAGE(PG8_SB(1, 0), b3, voffB0); PG8_STAGE(PG8_SB(1, 1), b3, voffB1); PG8_STAGE(PG8_SA(1, 0), a3, s0);
            PG8_WAIT_V(8); PG8_WAIT_L(0); PG8_BAR; if (act1) { PG8_MMA(1, 0, At, B0); PG8_MMA(1, 1, At, B1); } PG8_BAR; PG8_SCHED;
        }
        if (wr == 0) PG8_BAR;
        { Unit2 eu = cur; asm volatile("" : "+s"(eu.pm), "+s"(eu.pn), "+s"(eu.e), "+s"(eu.cnt), "+s"(eu.jt), "+s"(eu.ui));
          E(acc, eu, wr, wc, fr, fq);
          }
        if (!has_next) break;
#pragma unroll
        for (int a = 0; a < 2; ++a)
#pragma unroll
            for (int b = 0; b < 2; ++b)
#pragma unroll
                for (int m = 0; m < 4; ++m)
#pragma unroll
                    for (int n = 0; n < 2; ++n) acc[a][b][m][n] = (f32x4){0.f, 0.f, 0.f, 0.f};
        cur = nxt; cA = nA; cB = nB; ++ui;
#pragma unroll
        for (int i = 0; i < 2; ++i) { cv0[i] = nv0[i]; cv1[i] = nv1[i]; }
        if (wr == 1) PG8_BAR;
    }
    PG8_WAIT_V(0);
    PG8_BAR;
#undef PG8_AOFFS
#undef PG8_SA
#undef PG8_SB
#undef PG8_STAGE
#undef PG8_LDA
#undef PG8_LDB
#undef PG8_MMA
#undef PG8_WAIT_V
#undef PG8_WAIT_L
#undef PG8_BAR
#undef PG8_SCHED
}

struct DenseSched {
    StaticOrder so; const bf16_t* Bt; int ldb;
    __device__ __forceinline__ bool next(int i, Unit2& u) const { Unit t; if (!so.next(i, t)) return false; u.pm = t.pm; u.pn = t.pn; u.e = 0; u.cnt = 256; u.jt = 0; u.ui = i; return true; }
    __device__ __forceinline__ int arow(const Unit2& u, int r) const { return u.pm * BM + r; }
    __device__ __forceinline__ size_t aoff(const Unit2&) const { return 0; }
    __device__ __forceinline__ const char* bptr(const Unit2& u) const { return (const char*)(Bt + (size_t)u.pn * BM * ldb); }
};
struct EpiPlainBf16 {
    static constexpr bool PERM = true, AFTER_DRAIN = false;
    bf16_t* O; int ldc;
    __device__ __forceinline__ void operator()(const f32x4 (&acc)[2][2][4][2], const Unit2& u, int wr, int wc, int fr, int fq) const {
        const int row0 = u.pm * BM + wr * 64 + fr, col0 = u.pn * BM + wc * 32 + 8 * fq;
#pragma unroll
        for (int ai = 0; ai < 2; ++ai)
#pragma unroll
            for (int m = 0; m < 4; ++m) { bf16_t* rowp = O + (size_t)(row0 + ai * HALF + m * 16) * ldc + col0;
#pragma unroll
                for (int bj = 0; bj < 2; ++bj) { const f32x4 v0 = acc[ai][bj][m][0], v1 = acc[ai][bj][m][1];
                    u32x4 w; w.x = cvt_pk_bf16(v0[0], v0[1]); w.y = cvt_pk_bf16(v0[2], v0[3]); w.z = cvt_pk_bf16(v1[0], v1[1]); w.w = cvt_pk_bf16(v1[2], v1[3]);
                    *(u32x4*)(rowp + bj * HALF) = w; } }
    }
};
}
namespace nv {
constexpr int D = 1024, B = 8, S = 4096, T = B * S;
constexpr int FH = 8, FD = 64, GH = 4, GK = 64, GV = 128, RANK = 16;
constexpr int INW = 3096;
constexpr int O_FQ = 0, O_FK = 512, O_FV = 1024, O_FF = 1536, O_GQ = 1544, O_GK = 1800, O_GV = 2056, O_GA = 2568, O_GR = 2584;
constexpr int NE = 256, NG = 8, TOPK = 8, ED = 256;
constexpr float LN_EPS = 1e-5f;
constexpr float ALPHA = 1.189207115002721f;
constexpr int PADR = 64;
constexpr int APAD = T * TOPK + NE * PADR;

__device__ __forceinline__ float logsigmoidf(float x) { return fminf(x, 0.f) - log1pf(expf(-fabsf(x))); }
__device__ __forceinline__ float siluf(float x) { return x / (1.f + expf(-x)); }

}
#include <hip/hip_bf16.h>
#include <cmath>
namespace attn_body {
using bf16=__hip_bfloat16;
using bf16x8=__attribute__((ext_vector_type(8)))short;
using s16x4=__attribute__((ext_vector_type(4)))short;
using f32x16=__attribute__((ext_vector_type(16)))float;
using u32x4=__attribute__((ext_vector_type(4)))unsigned;
constexpr int BATCH=8,NHEAD=8,SEQ=4096,D=64,DM=3072,OPITCH=1024;
constexpr int NW=8,QBLK=32,QB=QBLK*NW,KVBLK=64,NQB=SEQ/QB;
constexpr int ATTN_PITCH=DM, ATTN_UNIT_ROWS=QB;
__device__ __forceinline__ int crow(int r,int hi){return (r&3)+8*(r>>2)+4*hi;}
#define SBAR() __builtin_amdgcn_sched_barrier(0)
__device__ __forceinline__ void cmask(f32x16&p0,f32x16&p1,int jb,int qrel,int hi){
  const float NEG=-INFINITY; int kb=64*jb+4*hi;
  #pragma unroll
  for(int r=0;r<16;++r){int kv=kb+(r&3)+8*(r>>2); if(kv>qrel)p0[r]=NEG; if(kv+32>qrel)p1[r]=NEG;}
}

constexpr int NSLOT=3, SLOTB=8192;
constexpr int LDS_K=0, LDS_V=NSLOT*SLOTB, LDS_WS=2*NSLOT*SLOTB, LDS_OST=LDS_WS+NW*64*4, LDS_KB=LDS_OST+NW*4096, LDS_BYTES=LDS_KB+(SEQ+2)*8;
constexpr float C2=0.125f*1.4426950408889634f;
__device__ __forceinline__ void glds16(const void*gsrc,unsigned lds_dst){unsigned keep;
  asm volatile("s_mov_b32 %0, m0\n\ts_mov_b32 m0, %2\n\ts_nop 0\n\tglobal_load_lds_dwordx4 %1, off\n\ts_mov_b32 m0, %0":"=&s"(keep):"v"(gsrc),"s"(lds_dst):"memory");}
__device__ __forceinline__ float max3f(float a,float b,float c){float r;asm("v_max3_f32 %0, %1, %2, %3":"=v"(r):"v"(a),"v"(b),"v"(c));return r;}
__device__ __forceinline__ float max2f(float a,float b){float r;asm("v_max_f32_e32 %0, %1, %2":"=v"(r):"v"(a),"v"(b));return r;}
__device__ __forceinline__ float fadd_s(float a,float b){float r;asm("v_add_f32_e32 %0, %1, %2":"=v"(r):"v"(a),"v"(b));return r;}
__device__ __forceinline__ float fsub_s(float a,float b){float r;asm("v_sub_f32_e32 %0, %1, %2":"=v"(r):"v"(a),"v"(b));return r;}
typedef float f32x2_t __attribute__((ext_vector_type(2))); typedef float f32x4_t __attribute__((ext_vector_type(4))); typedef __bf16 bf16x2_t __attribute__((ext_vector_type(2)));
__device__ __forceinline__ unsigned cvtpk_s(float lo,float hi){f32x2_t v={lo,hi};bf16x2_t b=__builtin_convertvector(v,bf16x2_t);return __builtin_bit_cast(unsigned,b);}
#define WAIT_BAR(N) asm volatile("s_waitcnt vmcnt(" #N ") lgkmcnt(0)\n\ts_barrier":::"memory")

__device__ __forceinline__ void split3(float b,unsigned&h,unsigned&m,unsigned&l){
  h=cvtpk_s(b,0.f)&0xffffu; const float r1=b-__uint_as_float(h<<16);
  m=cvtpk_s(r1,0.f)&0xffffu; const float r2=r1-__uint_as_float(m<<16);
  l=cvtpk_s(r2,0.f)&0xffffu; }
__device__ __forceinline__ bf16x8 kbias_frag(float b,int hi){unsigned h,m,l;split3(b,h,m,l);u32x4 w;w.x=h|(m<<16);w.y=l|0x3F800000u;w.z=0x3F803F80u;w.w=0u;if(hi){w.x=0u;w.y=0u;w.z=0u;}return __builtin_bit_cast(bf16x8,w);}
__device__ __forceinline__ bf16x8 qref_frag(float x,int hi){unsigned h,m,l;split3(x,h,m,l);u32x4 w;w.x=0x3F803F80u;w.y=0x3F80u|(h<<16);w.z=m|(l<<16);w.w=0u;if(hi){w.x=0u;w.y=0u;w.z=0u;}return __builtin_bit_cast(bf16x8,w);}
typedef unsigned u32x2_t __attribute__((ext_vector_type(2)));
__device__ __forceinline__ bf16x8 mkfrag(u32x2_t e,unsigned zc){u32x4 w;w.x=e.x;w.y=e.y;w.z=zc;w.w=0u;return __builtin_bit_cast(bf16x8,w);}
__device__ __forceinline__ void fox_bias_table(int b,int h,const float*LF,char*shm){
  int tid_=threadIdx.x; asm volatile("":"+v"(tid_)); const int tid=tid_,lane=tid&63,wid=__builtin_amdgcn_readfirstlane(tid>>6);
  const float*lf=LF+((long)b*NHEAD+h)*SEQ; float*wt=(float*)(shm+LDS_WS); u32x2_t*KB8=(u32x2_t*)(shm+LDS_KB);
  f32x4_t va=*(const f32x4_t*)(lf+8*tid),vb=*(const f32x4_t*)(lf+8*tid+4);
  va[1]+=va[0];va[2]+=va[1];va[3]+=va[2];vb[0]+=va[3];vb[1]+=vb[0];vb[2]+=vb[1];vb[3]+=vb[2];
  const float tot=vb[3]; float inc=tot;
  #pragma unroll
  for(int o_=1;o_<64;o_<<=1){const float nn=__shfl_up(inc,o_);if(lane>=o_)inc+=nn;}
  __syncthreads();
  if(lane==63)wt[wid*64]=inc;
  __syncthreads();
  float base=inc-tot;
  #pragma unroll
  for(int w_=0;w_<NW;++w_){const float x_=wt[w_*64]; if(w_<wid)base+=x_;}
  const float cv[8]={va[0]+base,va[1]+base,va[2]+base,va[3]+base,vb[0]+base,vb[1]+base,vb[2]+base,vb[3]+base};
  #pragma unroll
  for(int j=0;j<8;++j){unsigned hh,mm,ll;split3(-cv[j],hh,mm,ll);KB8[8*tid+j]=(u32x2_t){hh|(mm<<16),ll|0x3F800000u};}
  if(tid==0){KB8[SEQ]=(u32x2_t){0u,0u};KB8[SEQ+1]=(u32x2_t){0u,0u};}
  __syncthreads();
}
__device__ __forceinline__ void qkt(f32x16&p0,f32x16&p1,const char*Kslot,const bf16x8*qr,bf16x8 kb0,bf16x8 kb1,bf16x8 qx,int r32,int hi){
  const f32x16 negm=f32x16{};
  const char*kb=Kslot+hi*1024+r32*16;
  #pragma unroll
  for(int d0=0;d0<4;++d0){
    const bf16x8 b0=*reinterpret_cast<const bf16x8*>(kb+d0*2048);
    const bf16x8 b1=*reinterpret_cast<const bf16x8*>(kb+d0*2048+512);
    if(d0==0){p0=__builtin_amdgcn_mfma_f32_32x32x16_bf16(b0,qr[0],negm,0,0,0);p1=__builtin_amdgcn_mfma_f32_32x32x16_bf16(b1,qr[0],negm,0,0,0);}
    else{p0=__builtin_amdgcn_mfma_f32_32x32x16_bf16(b0,qr[d0],p0,0,0,0);p1=__builtin_amdgcn_mfma_f32_32x32x16_bf16(b1,qr[d0],p1,0,0,0);}}
  p0=__builtin_amdgcn_mfma_f32_32x32x16_bf16(kb0,qx,p0,0,0,0);p1=__builtin_amdgcn_mfma_f32_32x32x16_bf16(kb1,qx,p1,0,0,0);
}
typedef __attribute__((address_space(3))) const char* lds_cptr;
typedef short v4i16_t __attribute__((ext_vector_type(4)));
__device__ __forceinline__ void kload8(bf16x8*kf,lds_cptr kp){
  kf[0]=*(const __attribute__((address_space(3))) bf16x8*)(kp);      kf[1]=*(const __attribute__((address_space(3))) bf16x8*)(kp+512);
  kf[2]=*(const __attribute__((address_space(3))) bf16x8*)(kp+2048); kf[3]=*(const __attribute__((address_space(3))) bf16x8*)(kp+2560);
  kf[4]=*(const __attribute__((address_space(3))) bf16x8*)(kp+4096); kf[5]=*(const __attribute__((address_space(3))) bf16x8*)(kp+4608);
  kf[6]=*(const __attribute__((address_space(3))) bf16x8*)(kp+6144); kf[7]=*(const __attribute__((address_space(3))) bf16x8*)(kp+6656);
}
__device__ __forceinline__ void kload2(bf16x8*kf,lds_cptr kp,int j){ kf[2*j]=*(const __attribute__((address_space(3))) bf16x8*)(kp+j*2048); kf[2*j+1]=*(const __attribute__((address_space(3))) bf16x8*)(kp+j*2048+512); }
__device__ __forceinline__ s16x4 vtr(lds_cptr p){ return __builtin_bit_cast(s16x4,__builtin_amdgcn_ds_read_tr16_b64_v4i16((__attribute__((address_space(3))) v4i16_t*)p)); }
__device__ __forceinline__ float rowmax(const f32x16&p0,const f32x16&p1){
  float a=max3f(p0[0],p0[1],p1[0]),b=max3f(p0[2],p0[3],p1[1]);a=max3f(a,p1[2],p1[3]);
  #pragma unroll
  for(int r=4;r<16;r+=4){a=max3f(a,p0[r],p0[r+1]);b=max3f(b,p0[r+2],p0[r+3]);a=max3f(a,p1[r],p1[r+1]);b=max3f(b,p1[r+2],p1[r+3]);}
  const float m=max2f(a,b);
  auto rr=__builtin_amdgcn_permlane32_swap(__float_as_uint(m),__float_as_uint(m),false,false);
  return max2f(__uint_as_float(rr[0]),__uint_as_float(rr[1]));
}
__device__ __forceinline__ void pv(f32x16*o,int vb,bf16x8 pa0,bf16x8 pa1,bf16x8 pa2,bf16x8 pa3){
  #pragma unroll
  for(int d0=0;d0<2;++d0){s16x4 lo[4],hi[4];
    #pragma unroll
    for(int ks=0;ks<4;++ks){
      asm volatile("ds_read_b64_tr_b16 %0,%1 offset:%c2":"=&v"(lo[ks]):"v"(vb),"i"(d0*4096+ks*1024):"memory");
      asm volatile("ds_read_b64_tr_b16 %0,%1 offset:%c2":"=&v"(hi[ks]):"v"(vb),"i"(d0*4096+ks*1024+512):"memory");}
    asm volatile("s_waitcnt lgkmcnt(0)":::"memory");SBAR();
    #define PK(k) (bf16x8){lo[k][0],lo[k][1],lo[k][2],lo[k][3],hi[k][0],hi[k][1],hi[k][2],hi[k][3]}
    o[d0]=__builtin_amdgcn_mfma_f32_32x32x16_bf16(pa0,PK(0),o[d0],0,0,0);
    o[d0]=__builtin_amdgcn_mfma_f32_32x32x16_bf16(pa1,PK(1),o[d0],0,0,0);
    o[d0]=__builtin_amdgcn_mfma_f32_32x32x16_bf16(pa2,PK(2),o[d0],0,0,0);
    o[d0]=__builtin_amdgcn_mfma_f32_32x32x16_bf16(pa3,PK(3),o[d0],0,0,0);
    #undef PK
  }
}

#ifndef ATTN_STORE16
#define ATTN_STORE16(p,v) (*(u32x4*)(p)=(v))
#endif
template<int THRL> __device__ __forceinline__ void attn_unit(int b,int h,int qb,const bf16*Q,const bf16* K,const bf16* V,bf16*O,const float*LF,const unsigned*NRM,char*shm){
  int tid_=threadIdx.x; asm volatile("":"+v"(tid_));
  const int tid=tid_,lane=tid&63,r32=lane&31,hi=lane>>5; const int wid=__builtin_amdgcn_readfirstlane(tid>>6);
  const long rowbase=(long)b*SEQ; const int q0=qb*QB;
  const char*KBt0=shm+LDS_KB;
  int t0;
  { const int NT0=(q0+QB)/KVBLK; const unsigned*nr=NRM+(b*NHEAD+h)*4;
    const float qn2=__uint_as_float(nr[0])+__uint_as_float(nr[1]), kn2=__uint_as_float(nr[2])+__uint_as_float(nr[3]);
    const float thr=-(50.f+2.04f*sqrtf(qn2*kn2));
    const u32x2_t eq0=*(const u32x2_t*)(KBt0+(unsigned)q0*8u); const float bq0=__uint_as_float(eq0.x<<16)+__uint_as_float(eq0.x&0xffff0000u)+__uint_as_float(eq0.y<<16);
    bool ok=(2*lane<=NT0-4);
    if(ok&&lane>0){ const u32x2_t el=*(const u32x2_t*)(KBt0+(unsigned)(128*lane-1)*8u); const float bl=__uint_as_float(el.x<<16)+__uint_as_float(el.x&0xffff0000u)+__uint_as_float(el.y<<16); ok=(bl-bq0<thr); }
    const unsigned long long mk=__ballot(ok); const unsigned long long low=~mk; const int cnt=(low==0ull)?64:__builtin_ctzll(low);
    t0=__builtin_amdgcn_readfirstlane(2*(cnt-1)); }
  const char*KBt=KBt0+(hi?0:t0*512); const unsigned kb_o0=hi?(unsigned)SEQ*8u:(unsigned)r32*8u, kb_o1=hi?(unsigned)SEQ*8u:(unsigned)(r32+32)*8u, kb_str=hi?0u:512u, zc=hi?0u:0x3F803F80u;
  const bf16*Qw=Q+(rowbase+q0+wid*QBLK)*DM+h*D;
  const bf16*Kh=K+(rowbase+(long)t0*KVBLK)*DM+h*D,*Vh=V+(rowbase+(long)t0*KVBLK)*DM+h*D;
  const unsigned lds0=(unsigned)(uintptr_t)shm;
  float*wsf=(float*)(shm+LDS_WS)+wid*64;
  const bf16*ksrc=Kh+(long)lane*DM+wid*8;
  const bf16*vsrc=Vh+(long)(16*(wid&3)+(lane>>2))*DM+(wid>>2)*32+(lane&3)*8;
  const unsigned kdst=lds0+LDS_K+wid*1024, vdst=lds0+LDS_V+wid*1024;
  #define DMA_K(t,slot) glds16(ksrc+(long)(t)*KVBLK*DM,(unsigned)__builtin_amdgcn_readfirstlane(kdst+(slot)))
  #define DMA_V(t,slot) glds16(vsrc+(long)(t)*KVBLK*DM,(unsigned)__builtin_amdgcn_readfirstlane(vdst+(slot)))
  const int vb0=(int)(lds0+LDS_V)+((lane>>4)&1)*32+(lane&3)*8+(4*hi+((lane&15)>>2))*64;
  const char*Kbase=shm+LDS_K; bf16x8 kf[8];
  const lds_cptr shm3=(lds_cptr)shm; const lds_cptr kp0=shm3+LDS_K+hi*1024+r32*16; const lds_cptr vp0=shm3+LDS_V+((lane>>4)&1)*32+(lane&3)*8+(4*hi+((lane&15)>>2))*64;
  const int NT=(q0+QB)/KVBLK-t0;
  DMA_K(0,0);DMA_V(0,0);DMA_K(1,SLOTB);
  bf16x8 qr[4];
  #pragma unroll
  for(int d0=0;d0<4;++d0)qr[d0]=*reinterpret_cast<const bf16x8*>(&Qw[(long)r32*DM+d0*16+hi*8]);
  float mhat; { const u32x2_t eq=*(const u32x2_t*)(KBt0+(unsigned)(q0+wid*QBLK+r32)*8u); mhat=__uint_as_float(eq.x<<16)+__uint_as_float(eq.x&0xffff0000u)+__uint_as_float(eq.y<<16); }
  float l_reg=0.f;f32x16 o[2];o[0]=f32x16{};o[1]=f32x16{};const f32x16 negm=f32x16{};
  bf16x8 qx=qref_frag(-mhat,hi);
  const int qrel=wid*QBLK+r32;
  #define CMASK(P0,P1,t) do{int jb_=(t)-(NT-4); if(jb_>=0)cmask(P0,P1,jb_,qrel,hi);}while(0)
  bool resc=false;
  #define START(P0,P1) do{ const float rm=rowmax(P0,P1); resc=false; \
    { const float dl=__builtin_fmaxf(rm,0.f); mhat=fadd_s(mhat,dl); \
      _Pragma("unroll") for(int r=0;r<16;++r){P0[r]=fsub_s(P0[r],dl);P1[r]=fsub_s(P1[r],dl);} \
      qx=qref_frag(-mhat,hi); } \
    _Pragma("unroll") for(int r=0;r<16;++r)P0[r]=__builtin_amdgcn_exp2f(P0[r]); }while(0)
  #define RESC() do{ if(resc){ asm volatile("s_waitcnt lgkmcnt(0)":::"memory"); \
      _Pragma("unroll") for(int d_=0;d_<2;++d_) _Pragma("unroll") for(int r=0;r<16;++r)o[d_][r]*=wsf[crow(r,hi)]; } }while(0)
  f32x16 pA0,pA1,pB0,pB1;
  int sl_prev=0,sl_cur=0,sl_next=SLOTB;
  #define ROT() do{sl_prev=sl_cur;sl_cur=sl_next;sl_next=(sl_next==(NSLOT-1)*SLOTB)?0:sl_next+SLOTB;}while(0)
  DMA_K(2,2*SLOTB);
  WAIT_BAR(3);
  qkt(pA0,pA1,Kbase,qr,mkfrag(*(const u32x2_t*)(KBt+kb_o0),zc),mkfrag(*(const u32x2_t*)(KBt+kb_o1),zc),qx,r32,hi);asm volatile("s_nop 15\n\ts_nop 7":"+v"(pA0),"+v"(pA1));CMASK(pA0,pA1,0);
  START(pA0,pA1);
  _Pragma("unroll") for(int r=0;r<16;++r)pA1[r]=__builtin_amdgcn_exp2f(pA1[r]);
  WAIT_BAR(0);
  DMA_K(3,0);DMA_V(1,SLOTB);
  ROT();
  kload8(kf,kp0+sl_cur);
  WAIT_BAR(2);
  s16x4 vlo[8],vhi[8]; u32x4 pw0,pw1,pw2,pw3;
  #define PKW(P,B) cvtpk_s(P[B],P[B+1])
  #define PAF(k) __builtin_bit_cast(bf16x8,pw##k)
  #define VFR(i) (bf16x8){vlo[i][0],vlo[i][1],vlo[i][2],vlo[i][3],vhi[i][0],vhi[i][1],vhi[i][2],vhi[i][3]}
  #define PIN(x) asm volatile("":"+v"(x))
  #define MX3(a,b,c) __builtin_fmaxf(__builtin_fmaxf((a),(b)),(c))
  #define GAPA(MF,A0,A1,A2,A3,W0,W1,PW) do{ MF; sacc+=A0; sacc+=A1; sacc+=A2; sacc+=A3; PIN(sacc); W0; W1; PIN(PW); SBAR(); }while(0)
  #define EX(v) __builtin_amdgcn_exp2f(v)
  #define GAPB(MF,X,B) do{ MF; X[B]=EX(X[B]); X[B+1]=EX(X[B+1]); X[B+2]=EX(X[B+2]); X[B+3]=EX(X[B+3]); PIN(X); SBAR(); }while(0)
  #define VRD(i) do{ vlo[i]=vtr(vp_+(((i)>>2)*4096+((i)&3)*1024)); vhi[i]=vtr(vp_+(((i)>>2)*4096+((i)&3)*1024+512)); }while(0)
  #define KRD(G,j) do{ if(G){ kload2(kf,kp0+sl_next,j); SBAR(); } }while(0)
  #define STEP(C0,C1,P0,P1,t,GK,GV,GL) do{ SBAR(); \
    const lds_cptr vp_=vp0+sl_prev; const u32x2_t e0_=*(const u32x2_t*)(KBt+kb_o0+(unsigned)(t)*kb_str),e1_=*(const u32x2_t*)(KBt+kb_o1+(unsigned)(t)*kb_str); \
    VRD(0); SBAR(); float sacc=(P0[0]+P0[1]); \
    GAPA(C0=__builtin_amdgcn_mfma_f32_32x32x16_bf16(kf[0],qr[0],negm,0,0,0), P0[2],P0[3],P0[4],P0[5],     pw0[0]=PKW(P0,0), pw0[1]=PKW(P0,2), pw0); \
    VRD(4); SBAR(); GAPA(C1=__builtin_amdgcn_mfma_f32_32x32x16_bf16(kf[1],qr[0],negm,0,0,0), P0[6],P0[7],P0[8],P0[9],     pw0[2]=PKW(P0,4), pw0[3]=PKW(P0,6), pw0); \
    VRD(1); SBAR(); GAPA(C0=__builtin_amdgcn_mfma_f32_32x32x16_bf16(kf[2],qr[1],C0,0,0,0),   P0[10],P0[11],P0[12],P0[13], pw1[0]=PKW(P0,8), pw1[1]=PKW(P0,10), pw1); \
    VRD(5); SBAR(); GAPA(C1=__builtin_amdgcn_mfma_f32_32x32x16_bf16(kf[3],qr[1],C1,0,0,0),   P0[14],P0[15],P1[0],P1[1],   pw1[2]=PKW(P0,12),pw1[3]=PKW(P0,14), pw1); \
    VRD(2); SBAR(); GAPA(C0=__builtin_amdgcn_mfma_f32_32x32x16_bf16(kf[4],qr[2],C0,0,0,0),   P1[2],P1[3],P1[4],P1[5],     pw2[0]=PKW(P1,0), pw2[1]=PKW(P1,2), pw2); \
    VRD(6); SBAR(); GAPA(C1=__builtin_amdgcn_mfma_f32_32x32x16_bf16(kf[5],qr[2],C1,0,0,0),   P1[6],P1[7],P1[8],P1[9],     pw2[2]=PKW(P1,4), pw2[3]=PKW(P1,6), pw2); \
    VRD(3); SBAR(); GAPA(C0=__builtin_amdgcn_mfma_f32_32x32x16_bf16(kf[6],qr[3],C0,0,0,0),   P1[10],P1[11],P1[12],P1[13], pw3[0]=PKW(P1,8), pw3[1]=PKW(P1,10), pw3); \
    VRD(7); SBAR(); GAPA(C1=__builtin_amdgcn_mfma_f32_32x32x16_bf16(kf[7],qr[3],C1,0,0,0),   P1[14],P1[15],0.f,0.f,       pw3[2]=PKW(P1,12),pw3[3]=PKW(P1,14), pw3); \
    { const bf16x8 kb0_=mkfrag(e0_,zc),kb1_=mkfrag(e1_,zc); C0=__builtin_amdgcn_mfma_f32_32x32x16_bf16(kb0_,qx,C0,0,0,0); C1=__builtin_amdgcn_mfma_f32_32x32x16_bf16(kb1_,qx,C1,0,0,0); } SBAR(); \
    l_reg+=sacc; \
    if(GK){DMA_K((t)+3,sl_cur);} if(GV){DMA_V((t)+1,sl_next);} \
    CMASK(C0,C1,t); \
    { float a=MX3(C0[0],C0[1],C1[0]),b=MX3(C0[2],C0[3],C1[1]); a=MX3(a,C1[2],C1[3]); \
      _Pragma("unroll") for(int r=4;r<16;r+=4){a=MX3(a,C0[r],C0[r+1]);b=MX3(b,C0[r+2],C0[r+3]);a=MX3(a,C1[r],C1[r+1]);b=MX3(b,C1[r+2],C1[r+3]);} \
      float rm=__builtin_fmaxf(a,b); { auto rr=__builtin_amdgcn_permlane32_swap(__float_as_uint(rm),__float_as_uint(rm),false,false); rm=__builtin_fmaxf(__uint_as_float(rr[0]),__uint_as_float(rr[1])); } \
      resc=false; \
      if(__builtin_expect(__any(rm>(float)THRL),0)){ const float dl=__builtin_fmaxf(rm,0.f); mhat+=dl; \
        _Pragma("unroll") for(int r=0;r<16;++r){C0[r]-=dl;C1[r]-=dl;} \
        qx=qref_frag(-mhat,hi); \
        const float f=__builtin_amdgcn_exp2f(-dl); l_reg*=f; if(hi==0)wsf[r32]=f; resc=true; } } \
    SBAR(); \
    GAPB(o[0]=__builtin_amdgcn_mfma_f32_32x32x16_bf16(PAF(0),VFR(0),o[0],0,0,0), C0,0); \
    GAPB(o[1]=__builtin_amdgcn_mfma_f32_32x32x16_bf16(PAF(0),VFR(4),o[1],0,0,0), C0,4); \
    KRD(GL,0); GAPB(o[0]=__builtin_amdgcn_mfma_f32_32x32x16_bf16(PAF(1),VFR(1),o[0],0,0,0), C0,8); \
    KRD(GL,1); GAPB(o[1]=__builtin_amdgcn_mfma_f32_32x32x16_bf16(PAF(1),VFR(5),o[1],0,0,0), C0,12); \
    KRD(GL,2); GAPB(o[0]=__builtin_amdgcn_mfma_f32_32x32x16_bf16(PAF(2),VFR(2),o[0],0,0,0), C1,0); \
    KRD(GL,3); GAPB(o[1]=__builtin_amdgcn_mfma_f32_32x32x16_bf16(PAF(2),VFR(6),o[1],0,0,0), C1,4); \
    GAPB(o[0]=__builtin_amdgcn_mfma_f32_32x32x16_bf16(PAF(3),VFR(3),o[0],0,0,0), C1,8); \
    GAPB(o[1]=__builtin_amdgcn_mfma_f32_32x32x16_bf16(PAF(3),VFR(7),o[1],0,0,0), C1,12); \
    }while(0)
  int t=1;
  #undef CMASK
  #define CMASK(P0,P1,t) do{}while(0)
  for(;t+5<NT;t+=2){
    STEP(pB0,pB1,pA0,pA1,t,true,true,true);     WAIT_BAR(2); RESC(); ROT();
    STEP(pA0,pA1,pB0,pB1,t+1,true,true,true);   WAIT_BAR(2); RESC(); ROT();
  }
  #undef CMASK
  #define CMASK(P0,P1,t) do{int jb_=(t)-(NT-4); if(jb_>=0)cmask(P0,P1,jb_,qrel,hi);}while(0)
  #define ENDW(tt) do{ if((tt)+3<NT){WAIT_BAR(2);} else if((tt)+2<NT){WAIT_BAR(1);} else {WAIT_BAR(0);} }while(0)
  for(;t+1<NT;t+=2){
    STEP(pB0,pB1,pA0,pA1,t,(t+3<NT),(t+1<NT),(t+1<NT));       ENDW(t);   RESC(); ROT();
    STEP(pA0,pA1,pB0,pB1,t+1,(t+4<NT),(t+2<NT),(t+2<NT));     ENDW(t+1); RESC(); ROT();
  }
  STEP(pB0,pB1,pA0,pA1,NT-1,false,false,false); RESC();
  { float sacc=pB0[0]+pB0[1]; _Pragma("unroll") for(int r=2;r<16;++r)sacc+=pB0[r]; _Pragma("unroll") for(int r=0;r<16;++r)sacc+=pB1[r]; l_reg+=sacc;
    pw0=(u32x4){PKW(pB0,0),PKW(pB0,2),PKW(pB0,4),PKW(pB0,6)};pw1=(u32x4){PKW(pB0,8),PKW(pB0,10),PKW(pB0,12),PKW(pB0,14)};pw2=(u32x4){PKW(pB1,0),PKW(pB1,2),PKW(pB1,4),PKW(pB1,6)};pw3=(u32x4){PKW(pB1,8),PKW(pB1,10),PKW(pB1,12),PKW(pB1,14)};
    SBAR(); pv(o,vb0+sl_cur,PAF(0),PAF(1),PAF(2),PAF(3)); }
  #undef PKW
  #undef PAF
  #undef VFR
  #undef PIN
  #undef MX3
  #undef GAPA
  #undef GAPB
  #undef EX
  #undef VRD
  #undef KRD
  #undef STEP
  #undef ENDW
  {auto rr=__builtin_amdgcn_permlane32_swap(__float_as_uint(l_reg),__float_as_uint(l_reg),false,false);l_reg=__uint_as_float(rr[0])+__uint_as_float(rr[1]);}
  if(hi==0)wsf[32+r32]=l_reg;asm volatile("s_waitcnt lgkmcnt(0)":::"memory");
  float rli[16];
  #pragma unroll
  for(int r=0;r<16;++r)rli[r]=__builtin_amdgcn_rcpf(wsf[32+crow(r,hi)]);
  bf16*Ow=O+(rowbase+q0+wid*QBLK)*OPITCH+h*D;
  { bf16*stg=(bf16*)(shm+LDS_OST)+wid*2048;
    #pragma unroll
    for(int r=0;r<16;++r){const int orow=crow(r,hi);
      #pragma unroll
      for(int d0=0;d0<2;++d0)stg[orow*64+d0*32+r32]=__float2bfloat16(o[d0][r]*rli[r]);}
    asm volatile("s_waitcnt lgkmcnt(0)":::"memory");
    #pragma unroll
    for(int i=0;i<4;++i){const int row=i*8+(lane>>3),ch=lane&7; const u32x4 v=*(const u32x4*)(stg+row*64+ch*8); ATTN_STORE16(Ow+(long)row*OPITCH+ch*8,v);} }
  asm volatile("s_waitcnt lgkmcnt(0)\n\ts_barrier":::"memory");
  #undef DMA_K
  #undef DMA_V
  #undef CMASK
  #undef START
  #undef RESC
  #undef ROT
}
constexpr int ATTN_LDS_BYTES=LDS_BYTES;
struct AttnTensors { const bf16* Q; const bf16* K; const bf16* V; bf16* O; const float* LF; const unsigned* NRM; };
struct AttnUnit { int bh; int qb; };
struct StaticOrder {
  int vcu,grid;
  __device__ __forceinline__ explicit StaticOrder(int grid_,int block):vcu((grid_%8==0)?(block%8)*(grid_/8)+block/8:block),grid(grid_){}
  __device__ __forceinline__ bool next(int i,AttnUnit&u)const{
    if(grid==256){ if(i>=4)return false; const int s=vcu&3; u.bh=vcu>>2; u.qb=(i==0)?s:(i==1)?7-s:(i==2)?8+s:15-s; return true; }
    const int L=i*grid+vcu; if(L>=BATCH*NHEAD*NQB)return false; u.bh=L/NQB; u.qb=L%NQB; return true; }
  __device__ __forceinline__ void a_ready(const AttnUnit&)const{}
  __device__ __forceinline__ void done(const AttnUnit&)const{}
};
template<class Sched,int THRL=8> __device__ __forceinline__ void attn_phase(char*lds,const AttnTensors&T,const Sched&S){
  AttnUnit u; int cur_bh=-1;
  for(int i=0;S.next(i,u);++i){ S.a_ready(u); if(u.bh!=cur_bh){ fox_bias_table(u.bh/NHEAD,u.bh%NHEAD,T.LF,lds); cur_bh=u.bh; }
    attn_unit<THRL>(u.bh/NHEAD,u.bh%NHEAD,u.qb,T.Q,T.K,T.V,T.O,T.LF,T.NRM,lds); S.done(u); }
}
template<int THRL=8> __device__ __forceinline__ void attn_phase_dyn(char*lds,const AttnTensors&T,unsigned*qheads,volatile int*slot,int grp){
  int cur_bh=-1; const int NU=NHEAD*NQB; unsigned*qhead=qheads+64*grp;
  if(threadIdx.x==0) slot[0]=(int)__hip_atomic_fetch_add(qhead,1u,__ATOMIC_RELAXED,__HIP_MEMORY_SCOPE_AGENT);
  __syncthreads();
  int idx=__builtin_amdgcn_readfirstlane(slot[0]);
  while(idx<NU){
    __syncthreads();
    if(threadIdx.x==0) slot[0]=(int)__hip_atomic_fetch_add(qhead,1u,__ATOMIC_RELAXED,__HIP_MEMORY_SCOPE_AGENT);
    const int qb=NQB-1-idx/NHEAD, bh=grp*NHEAD+idx%NHEAD;
    if(bh!=cur_bh){ fox_bias_table(bh/NHEAD,bh%NHEAD,T.LF,lds); cur_bh=bh; }
    attn_unit<THRL>(bh/NHEAD,bh%NHEAD,qb,T.Q,T.K,T.V,T.O,T.LF,T.NRM,lds);
    __syncthreads();
    idx=__builtin_amdgcn_readfirstlane(slot[0]);
  }
}
#undef SBAR
#undef WAIT_BAR
}
namespace fx {
using namespace nv;
typedef unsigned short bf16;
typedef unsigned v4u __attribute__((ext_vector_type(4)));
typedef float f32x4 __attribute__((ext_vector_type(4)));
constexpr float C2 = 0.125f * 1.4426950408889634f;
constexpr int NIN = 3328;
constexpr int QKVP = 3072;
constexpr int P_FQ = 0, P_FK = 512, P_FV = 1024, P_GQ = 1536, P_GK = 1792, P_GV = 2048, P_GR = 2560;
__device__ __forceinline__ int inproj_src(int d) {
    if (d < 1536) return d;
    if (d < 1792) return O_GQ + (d - 1536);
    if (d < 2048) return O_GK + (d - 1792);
    if (d < 2560) return O_GV + (d - 2048);
    if (d < 3072) return O_GR + (d - 2560);
    if (d < 3080) return O_FF + (d - 3072);
    if (d < 3096) return O_GA + (d - 3080);
    return -1;
}
__device__ __forceinline__ unsigned f2bf(float f) { unsigned u = __builtin_bit_cast(unsigned, f); return (u + 0x7fffu + ((u >> 16) & 1u)) >> 16; }
__device__ __forceinline__ unsigned pk2(float lo, float hi) { return f2bf(lo) | (f2bf(hi) << 16); }
__device__ __forceinline__ float bf2f(unsigned short h) { return __builtin_bit_cast(float, (unsigned)h << 16); }
__device__ __forceinline__ float wave_sum(float v) {
#pragma unroll
    for (int o = 1; o < 64; o <<= 1) v += __shfl_xor(v, o);
    return v;
}
#define FX_LDS_WAIT() asm volatile("s_waitcnt lgkmcnt(0)" ::: "memory")

template <class Map> __device__ __forceinline__ void transpose_item(const float* __restrict__ W, int K, int N, bf16* WT, LAS float* scr, int kb, int nb, int lane, Map srcmap) {
    const int k0 = 64 * kb, n0 = 32 * nb;
    const int src = srcmap(n0 + (lane & 31));
#pragma unroll 8
    for (int i = 0; i < 32; ++i) { const int kk = 2 * i + (lane >> 5); scr[kk * 33 + (lane & 31)] = (src >= 0) ? W[(size_t)(k0 + kk) * N + src] : 0.f; }
    FX_LDS_WAIT(); asm volatile("" ::: "memory");
    const int c = lane & 7;
#pragma unroll
    for (int j = 0; j < 4; ++j) { const int n = (lane >> 3) + 8 * j; const LAS float* s = scr + (8 * c) * 33 + n;
        v4u o; o.x = pk2(s[0 * 33], s[1 * 33]); o.y = pk2(s[2 * 33], s[3 * 33]); o.z = pk2(s[4 * 33], s[5 * 33]); o.w = pk2(s[6 * 33], s[7 * 33]);
        *(GAS v4u*)(WT + (size_t)(n0 + n) * K + k0 + 8 * c) = o; }
    FX_LDS_WAIT(); asm volatile("" ::: "memory");
}

__device__ __forceinline__ void ln_row_bf16(const float* xrow, const float* __restrict__ g, const float* __restrict__ b, bf16* orow, float* frow, float* st, int lane) {
    const GAS f32x4* xr = (const GAS f32x4*)xrow + lane;
    f32x4 v[4]; float s = 0.f;
#pragma unroll
    for (int j = 0; j < 4; ++j) { v[j] = xr[64 * j]; s += (v[j].x + v[j].y) + (v[j].z + v[j].w); }
    const float mean = wave_sum(s) * (1.f / D); float s2 = 0.f;
#pragma unroll
    for (int j = 0; j < 4; ++j) { v[j] = v[j] - mean; s2 += (v[j].x * v[j].x + v[j].y * v[j].y) + (v[j].z * v[j].z + v[j].w * v[j].w); }
    const float rstd = 1.f / sqrtf(wave_sum(s2) * (1.f / D) + LN_EPS);
    if (st && lane == 0) { st[0] = mean; st[1] = rstd; }
    GAS unsigned long long* o8 = (GAS unsigned long long*)orow + lane;
#pragma unroll
    for (int j = 0; j < 4; ++j) {
        const f32x4 gg = ((const f32x4*)g)[lane + 64 * j], bb = ((const f32x4*)b)[lane + 64 * j];
        const f32x4 o = v[j] * rstd * gg + bb;
        o8[64 * j] = (unsigned long long)pk2(o.x, o.y) | ((unsigned long long)pk2(o.z, o.w) << 32);
        if (frow) ((GAS f32x4*)frow)[lane + 64 * j] = o;
    }
}

struct CvItem { const float* W; bf16* WT; int N, K, k0, n0, s0; };
__device__ __forceinline__ void cv_load(const CvItem& it, f32x4 (&v)[8], int lane) {
    const float* p = it.W + (size_t)(it.k0 + (lane >> 3)) * it.N + it.s0 + 4 * (lane & 7);
#pragma unroll
    for (int i = 0; i < 8; ++i) v[i] = __builtin_nontemporal_load((const f32x4*)(p + (size_t)(8 * i) * it.N));
}
__device__ __forceinline__ void cv_finish(const CvItem& it, const f32x4 (&v)[8], LAS float* scr, int lane) {
    const int rr = lane >> 3, cq = lane & 7;
#pragma unroll
    for (int i = 0; i < 8; ++i) { LAS float* d = scr + (8 * i + rr) * 33 + 4 * cq; d[0] = v[i][0]; d[1] = v[i][1]; d[2] = v[i][2]; d[3] = v[i][3]; }
    FX_LDS_WAIT(); asm volatile("" ::: "memory");
    const int c = lane & 7;
#pragma unroll
    for (int j = 0; j < 4; ++j) { const int n = (lane >> 3) + 8 * j; const LAS float* s = scr + (8 * c) * 33 + n;
        v4u o; o.x = pk2(s[0 * 33], s[1 * 33]); o.y = pk2(s[2 * 33], s[3 * 33]); o.z = pk2(s[4 * 33], s[5 * 33]); o.w = pk2(s[6 * 33], s[7 * 33]);
        __builtin_nontemporal_store(o, (GAS v4u*)(it.WT + (size_t)(it.n0 + n) * it.K + it.k0 + 8 * c)); }
    FX_LDS_WAIT(); asm volatile("" ::: "memory");
}

template <int NR> __device__ __forceinline__ void ln_rows_bf16(const float* xrows, const float* __restrict__ g, const float* __restrict__ b, bf16* orows, int lane, float* st = nullptr) {
    f32x4 v[NR][4];
#pragma unroll
    for (int r = 0; r < NR; ++r)
#pragma unroll
        for (int j = 0; j < 4; ++j) v[r][j] = ((const GAS f32x4*)(xrows + (size_t)r * D))[lane + 64 * j];
    f32x4 gg[4], bb[4];
#pragma unroll
    for (int j = 0; j < 4; ++j) { gg[j] = ((const f32x4*)g)[lane + 64 * j]; bb[j] = ((const f32x4*)b)[lane + 64 * j]; }
#pragma unroll
    for (int r = 0; r < NR; ++r) {
        float s = 0.f;
#pragma unroll
        for (int j = 0; j < 4; ++j) s += (v[r][j].x + v[r][j].y) + (v[r][j].z + v[r][j].w);
        const float mean = wave_sum(s) * (1.f / D); float s2 = 0.f;
#pragma unroll
        for (int j = 0; j < 4; ++j) { v[r][j] = v[r][j] - mean; s2 += (v[r][j].x * v[r][j].x + v[r][j].y * v[r][j].y) + (v[r][j].z * v[r][j].z + v[r][j].w * v[r][j].w); }
        const float rstd = 1.f / sqrtf(wave_sum(s2) * (1.f / D) + LN_EPS);
        if (st && lane == 0) { st[2 * r] = mean; st[2 * r + 1] = rstd; }
        GAS unsigned long long* o8 = (GAS unsigned long long*)(orows + (size_t)r * D) + lane;
#pragma unroll
        for (int j = 0; j < 4; ++j) { const f32x4 o = v[r][j] * rstd * gg[j] + bb[j];
            o8[64 * j] = (unsigned long long)pk2(o.x, o.y) | ((unsigned long long)pk2(o.z, o.w) << 32); }
    }
}

template <int NR> __device__ __forceinline__ void ln1_rows_bf16(const float* xrows, const float* st, const float* __restrict__ gi, const float* __restrict__ bi, const bf16* mixrows,
                                                               const float* __restrict__ g1, const float* __restrict__ b1, bf16* orows, float alpha, int lane) {
    f32x4 v[NR][4]; unsigned long long mx[NR][4]; float mean0[NR], rstd0[NR];
#pragma unroll
    for (int r = 0; r < NR; ++r) { mean0[r] = st[2 * r]; rstd0[r] = st[2 * r + 1];
#pragma unroll
        for (int j = 0; j < 4; ++j) { v[r][j] = ((const GAS f32x4*)(xrows + (size_t)r * D))[lane + 64 * j]; mx[r][j] = ((const GAS unsigned long long*)(mixrows + (size_t)r * D))[lane + 64 * j]; } }
    f32x4 gi4[4], bi4[4];
#pragma unroll
    for (int j = 0; j < 4; ++j) { gi4[j] = ((const f32x4*)gi)[lane + 64 * j] * alpha; bi4[j] = ((const f32x4*)bi)[lane + 64 * j] * alpha; }
#pragma unroll
    for (int r = 0; r < NR; ++r) {
        float s = 0.f;
#pragma unroll
        for (int j = 0; j < 4; ++j) { const unsigned lo = (unsigned)mx[r][j], hi = (unsigned)(mx[r][j] >> 32);
            f32x4 mv; mv.x = __builtin_bit_cast(float, lo << 16); mv.y = __builtin_bit_cast(float, lo & 0xffff0000u); mv.z = __builtin_bit_cast(float, hi << 16); mv.w = __builtin_bit_cast(float, hi & 0xffff0000u);
            v[r][j] = ((v[r][j] - mean0[r]) * rstd0[r]) * gi4[j] + bi4[j] + mv;
            s += (v[r][j].x + v[r][j].y) + (v[r][j].z + v[r][j].w); }
        const float mean = wave_sum(s) * (1.f / D); float s2 = 0.f;
#pragma unroll
        for (int j = 0; j < 4; ++j) { v[r][j] = v[r][j] - mean; s2 += (v[r][j].x * v[r][j].x + v[r][j].y * v[r][j].y) + (v[r][j].z * v[r][j].z + v[r][j].w * v[r][j].w); }
        const float rstd = 1.f / sqrtf(wave_sum(s2) * (1.f / D) + LN_EPS);
        GAS unsigned long long* o8 = (GAS unsigned long long*)(orows + (size_t)r * D) + lane;
#pragma unroll
        for (int j = 0; j < 4; ++j) { const f32x4 gg = ((const f32x4*)g1)[lane + 64 * j], bb = ((const f32x4*)b1)[lane + 64 * j]; const f32x4 o = v[r][j] * rstd * gg + bb;
            o8[64 * j] = (unsigned long long)pk2(o.x, o.y) | ((unsigned long long)pk2(o.z, o.w) << 32); }
    }
}
}

namespace pg8 {
struct EpiInProj {
    static constexpr bool PERM = true, AFTER_DRAIN = false;
    bf16_t* QKV; float* FG; float* LF; const float* bfg; unsigned* NRM;
    __device__ __forceinline__ void operator()(const f32x4 (&acc)[2][2][4][2], const Unit& u, int wr, int wc, int fr, int fq) const {
        const int row0 = u.pm * BM + wr * 64 + fr;
        if (u.pn < 12) {
            const float sc = (u.pn < 2) ? fx::C2 : 1.f;
            const int col0 = u.pn * BM + wc * 32 + 8 * fq;
            float nmax[2] = {0.f, 0.f};
#pragma unroll
            for (int ai = 0; ai < 2; ++ai)
#pragma unroll
                for (int m = 0; m < 4; ++m) { bf16_t* rowp = QKV + (size_t)(row0 + ai * HALF + m * 16) * fx::QKVP + col0;
#pragma unroll
                    for (int bj = 0; bj < 2; ++bj) { const f32x4 v0 = acc[ai][bj][m][0] * sc, v1 = acc[ai][bj][m][1] * sc;
                        u32x4 w; w.x = cvt_pk_bf16(v0[0], v0[1]); w.y = cvt_pk_bf16(v0[2], v0[3]); w.z = cvt_pk_bf16(v1[0], v1[1]); w.w = cvt_pk_bf16(v1[2], v1[3]);
                        *(u32x4*)(rowp + bj * HALF) = w;
                        if (u.pn < 4) { const f32x4 q0 = v0 * v0, q1 = v1 * v1; float s = (q0[0] + q0[1]) + (q0[2] + q0[3]) + (q1[0] + q1[1]) + (q1[2] + q1[3]);
                            s += __shfl_xor(s, 16); s += __shfl_xor(s, 32);
                            nmax[bj] = fmaxf(nmax[bj], s); } } }
            if (u.pn < 4) {
#pragma unroll
                for (int bj = 0; bj < 2; ++bj) { float s = nmax[bj];
#pragma unroll
                    for (int o = 1; o < 16; o <<= 1) s = fmaxf(s, __shfl_xor(s, o));
                    if (fr == 0 && fq == 0) { const int b = (u.pm * BM) >> 12, head = 4 * (u.pn & 1) + 2 * bj + (wc >> 1);
                        atomicMax(NRM + (b * 8 + head) * 4 + (u.pn >= 2 ? 2 : 0) + (wc & 1), __builtin_bit_cast(unsigned, s)); } }
            }
        } else if (wc == 0 && fq < 3) {
#pragma unroll
            for (int ai = 0; ai < 2; ++ai)
#pragma unroll
                for (int m = 0; m < 4; ++m) { const int row = row0 + ai * HALF + m * 16; float* p = FG + (size_t)row * 32 + 8 * fq;
                    *(f32x4*)p = acc[ai][0][m][0]; *(f32x4*)(p + 4) = acc[ai][0][m][1];
                    if (fq == 0) { const int b = row >> 12, s = row & 4095;
#pragma unroll
                        for (int n = 0; n < 2; ++n)
#pragma unroll
                            for (int i = 0; i < 4; ++i) { const int h = 4 * n + i; LF[(size_t)(b * 8 + h) * nv::S + s] = -__builtin_amdgcn_logf(1.f + __builtin_amdgcn_exp2f(-1.4426950408889634f * (acc[ai][0][m][n][i] + bfg[h]))); } } }
        }
    }
};
}
namespace gl {
using namespace nv;
typedef unsigned short bf16;
typedef short bf16x8 __attribute__((ext_vector_type(8)));
typedef float f32x4 __attribute__((ext_vector_type(4)));
typedef unsigned u32x4 __attribute__((ext_vector_type(4)));
typedef unsigned u32x2 __attribute__((ext_vector_type(2)));
constexpr int NCH = S / 64;
constexpr int NUNIT = B * GH * NCH;
constexpr int LS = 72;
constexpr int L_WGU = 0, L_BG = 4096, L_DECS = 4352, L_QP = 8192, L_KP = L_QP + 64 * LS * 2, L_KPT = L_KP + 64 * LS * 2, L_VT = L_KPT + 64 * LS * 2, L_PP = L_VT + 128 * LS * 2, L_WT = L_PP + 64 * LS * 2, L_END = L_WT + 2048;
static_assert(L_END <= 131072, "gla prep LDS");
constexpr int C_ST = 0, C_PART = 128 * LS * 2, C_END = C_PART + 2 * 8 * 64 * 4;
constexpr size_t QPG_B = 64 * 64 * 2, OI_B = 8 * 4 * 64 * 16, UU_B = OI_B, DEC_B = 256;

__device__ __forceinline__ unsigned pkbf(float lo, float hi) { typedef float f2 __attribute__((ext_vector_type(2))); typedef __bf16 b2 __attribute__((ext_vector_type(2))); f2 v = {lo, hi}; b2 r = __builtin_convertvector(v, b2); return __builtin_bit_cast(unsigned, r); }
__device__ __forceinline__ float bf2f(unsigned short h) { return __builtin_bit_cast(float, (unsigned)h << 16); }
__device__ __forceinline__ float bflo(unsigned w) { return __builtin_bit_cast(float, w << 16); }
__device__ __forceinline__ float bfhi(unsigned w) { return __builtin_bit_cast(float, w & 0xffff0000u); }
__device__ __forceinline__ float fast_logsig2(float x) { return -__builtin_amdgcn_logf(1.f + __builtin_amdgcn_exp2f(-1.4426950408889634f * x)); }

__device__ __forceinline__ void prep_unit(int unit, const bf16* QKV, const float* FG, const float* __restrict__ wgu, const float* __restrict__ bgate,
                                          unsigned char* QPG, unsigned char* OI, unsigned char* UU, float* DEC, unsigned char* lds, int& cur_h, f32x4 (&Sagg)[4], f32x4 (&Dagg)[4]) {
    int tid_ = threadIdx.x; asm volatile("" : "+v"(tid_));
    const int tid = tid_, lane = tid & 63, wid = __builtin_amdgcn_readfirstlane(tid >> 6), l15 = lane & 15, g = lane >> 4;
    const int n = unit % NCH, bh = unit / NCH, h = bh % GH, b = bh / GH;
    const size_t row0 = (size_t)b * S + (size_t)n * 64;
    float* WGU = (float*)(lds + L_WGU); float* BG = (float*)(lds + L_BG); float* WT = (float*)(lds + L_WT);
    bf16* QP = (bf16*)(lds + L_QP); bf16* KP = (bf16*)(lds + L_KP); bf16* KPT = (bf16*)(lds + L_KPT); bf16* VT = (bf16*)(lds + L_VT); bf16* PP = (bf16*)(lds + L_PP);
    if (cur_h != h) { __syncthreads(); for (int i = tid; i < 16 * 64; i += 512) WGU[i] = wgu[(i >> 6) * 256 + h * 64 + (i & 63)]; if (tid < 64) BG[tid] = bgate[h * 64 + tid]; cur_h = h; __syncthreads(); }
    const int t = tid >> 3, oc = tid & 7, d0 = oc * 8;
    float la[8];
    { const float* gp = FG + (row0 + t) * 32 + 8;
      f32x4 ga4[4];
#pragma unroll
      for (int i = 0; i < 4; ++i) ga4[i] = *(const f32x4*)(gp + 4 * i);
#pragma unroll
      for (int j = 0; j < 8; ++j) la[j] = BG[d0 + j];
#pragma unroll
      for (int r = 0; r < 16; ++r) { const float gv = ga4[r >> 2][r & 3]; const f32x4 w0 = *(const f32x4*)(WGU + r * 64 + d0), w1 = *(const f32x4*)(WGU + r * 64 + d0 + 4);
#pragma unroll
          for (int j = 0; j < 4; ++j) { la[j] += gv * w0[j]; la[4 + j] += gv * w1[j]; } }
#pragma unroll
      for (int j = 0; j < 8; ++j) la[j] = fast_logsig2(la[j]) * (1.f / 16.f); }
    const u32x4 qv = *(const u32x4*)(QKV + (row0 + t) * fx::QKVP + fx::P_GQ + h * 64 + d0);
    const u32x4 kv = *(const u32x4*)(QKV + (row0 + t) * fx::QKVP + fx::P_GK + h * 64 + d0);
    const u32x4 vv0 = *(const u32x4*)(QKV + (row0 + t) * fx::QKVP + fx::P_GV + h * 128 + oc * 16);
    const u32x4 vv1 = *(const u32x4*)(QKV + (row0 + t) * fx::QKVP + fx::P_GV + h * 128 + oc * 16 + 8);
#pragma unroll
    for (int off = 8; off < 64; off <<= 1) {
#pragma unroll
        for (int j = 0; j < 8; ++j) { const float o = __shfl_up(la[j], off); if (lane >= off) la[j] += o; } }
    if (lane >= 56) {
#pragma unroll
        for (int j = 0; j < 8; ++j) WT[wid * 64 + d0 + j] = la[j]; }
    __syncthreads();
    float bl[8];
#pragma unroll
    for (int j = 0; j < 8; ++j) bl[j] = 0.f;
#pragma unroll
    for (int w = 0; w < 8; ++w) {
        const f32x4 a0 = *(const f32x4*)(WT + w * 64 + d0), a1 = *(const f32x4*)(WT + w * 64 + d0 + 4);
#pragma unroll
        for (int j = 0; j < 4; ++j) { bl[j] += a0[j]; bl[4 + j] += a1[j]; if (w < wid) { la[j] += a0[j]; la[4 + j] += a1[j]; } } }
    {
        const unsigned qw[4] = {qv.x, qv.y, qv.z, qv.w}, kw[4] = {kv.x, kv.y, kv.z, kv.w};
        float qf[8], kf[8];
#pragma unroll
        for (int i = 0; i < 4; ++i) { qf[2 * i] = bflo(qw[i]); qf[2 * i + 1] = bfhi(qw[i]); kf[2 * i] = bflo(kw[i]); kf[2 * i + 1] = bfhi(kw[i]); }
        float qp[8], kp[8], kpp[8];
#pragma unroll
        for (int j = 0; j < 8; ++j) { const float bb = la[j], bbl = bl[j];
            qp[j] = qf[j] * (0.125f * __builtin_amdgcn_exp2f(bb)); kp[j] = kf[j] * __builtin_amdgcn_exp2f(-bb); kpp[j] = kf[j] * __builtin_amdgcn_exp2f(bbl - bb); }
        u32x4 qo, ko; qo.x = pkbf(qp[0], qp[1]); qo.y = pkbf(qp[2], qp[3]); qo.z = pkbf(qp[4], qp[5]); qo.w = pkbf(qp[6], qp[7]);
        ko.x = pkbf(kp[0], kp[1]); ko.y = pkbf(kp[2], kp[3]); ko.z = pkbf(kp[4], kp[5]); ko.w = pkbf(kp[6], kp[7]);
        *(u32x4*)(QP + t * LS + d0) = qo; *(u32x4*)(KP + t * LS + d0) = ko;
        *(u32x4*)(QPG + (size_t)unit * QPG_B + (size_t)(t * 64 + d0) * 2) = qo;
#pragma unroll
        for (int j = 0; j < 8; ++j) KPT[(d0 + j) * LS + t] = (bf16)(pkbf(kpp[j], 0.f) & 0xffffu);
        const unsigned vw[8] = {vv0.x, vv0.y, vv0.z, vv0.w, vv1.x, vv1.y, vv1.z, vv1.w};
#pragma unroll
        for (int i = 0; i < 8; ++i) { VT[(oc * 16 + 2 * i) * LS + t] = (bf16)(vw[i] & 0xffffu); VT[(oc * 16 + 2 * i + 1) * LS + t] = (bf16)(vw[i] >> 16); }
        if (t == 0) {
#pragma unroll
            for (int j = 0; j < 8; ++j) { const float dc = __builtin_amdgcn_exp2f(bl[j]); DEC[(size_t)unit * 64 + d0 + j] = dc; ((float*)(lds + L_DECS))[d0 + j] = dc; } }
    }
    __syncthreads();
    { const int ti = wid >> 1;
#pragma unroll
      for (int q2 = 0; q2 < 2; ++q2) { const int sj = 2 * (wid & 1) + q2;
          f32x4 acc = {0.f, 0.f, 0.f, 0.f};
          if (sj <= ti) {
#pragma unroll
              for (int ks = 0; ks < 2; ++ks) { const bf16x8 a = *(const bf16x8*)(QP + (16 * ti + l15) * LS + 32 * ks + 8 * g), bb = *(const bf16x8*)(KP + (16 * sj + l15) * LS + 32 * ks + 8 * g);
                  acc = __builtin_amdgcn_mfma_f32_16x16x32_bf16(a, bb, acc, 0, 0, 0); }
              if (sj == ti) {
#pragma unroll
                  for (int r = 0; r < 4; ++r) if (l15 > 4 * g + r) acc[r] = 0.f; }
          }
#pragma unroll
          for (int r = 0; r < 4; ++r) PP[(16 * ti + 4 * g + r) * LS + 16 * sj + l15] = (bf16)(pkbf(acc[r], 0.f) & 0xffffu);
      } }
    __syncthreads();
    { bf16x8 vb[2];
#pragma unroll
      for (int ks = 0; ks < 2; ++ks) vb[ks] = *(const bf16x8*)(VT + (16 * wid + l15) * LS + 32 * ks + 8 * g);
#pragma unroll
      for (int m = 0; m < 4; ++m) { f32x4 acc = {0.f, 0.f, 0.f, 0.f};
#pragma unroll
          for (int ks = 0; ks < 2; ++ks) { const bf16x8 a = *(const bf16x8*)(PP + (16 * m + l15) * LS + 32 * ks + 8 * g); acc = __builtin_amdgcn_mfma_f32_16x16x32_bf16(a, vb[ks], acc, 0, 0, 0); }
          *(f32x4*)(OI + (size_t)unit * OI_B + (size_t)((wid * 4 + m) * 64 + lane) * 16) = acc; }
#pragma unroll
      for (int db = 0; db < 4; ++db) { f32x4 acc = {0.f, 0.f, 0.f, 0.f};
#pragma unroll
          for (int ks = 0; ks < 2; ++ks) { const bf16x8 a = *(const bf16x8*)(KPT + (16 * db + l15) * LS + 32 * ks + 8 * g); acc = __builtin_amdgcn_mfma_f32_16x16x32_bf16(a, vb[ks], acc, 0, 0, 0); }
          *(f32x4*)(UU + (size_t)unit * UU_B + (size_t)((wid * 4 + db) * 64 + lane) * 16) = acc;
          const f32x4 dcv = *(const f32x4*)((const float*)(lds + L_DECS) + 16 * db + 4 * g);
          Sagg[db] = dcv * Sagg[db] + acc; Dagg[db] = Dagg[db] * dcv; }
    }
}


__device__ __forceinline__ void prep_block(int blk, const bf16* QKV, const float* FG, const float* __restrict__ wgu, const float* __restrict__ bgate,
                                           unsigned char* QPG, unsigned char* OI, unsigned char* UU, float* DEC, unsigned char* AGG, float* DAGG, unsigned char* lds, int& cur_h) {
    f32x4 Sagg[4], Dagg[4];
#pragma unroll
    for (int db = 0; db < 4; ++db) { Sagg[db] = (f32x4){0.f, 0.f, 0.f, 0.f}; Dagg[db] = (f32x4){1.f, 1.f, 1.f, 1.f}; }
    for (int i = 0; i < 8; ++i) prep_unit(blk * 8 + i, QKV, FG, wgu, bgate, QPG, OI, UU, DEC, lds, cur_h, Sagg, Dagg);
    int tid_ = threadIdx.x; asm volatile("" : "+v"(tid_));
    const int lane = tid_ & 63, wid = __builtin_amdgcn_readfirstlane(tid_ >> 6), l15 = lane & 15, g = lane >> 4;
#pragma unroll
    for (int db = 0; db < 4; ++db) { *(f32x4*)(AGG + (size_t)blk * UU_B + (size_t)((wid * 4 + db) * 64 + lane) * 16) = Sagg[db];
        if (wid == 0 && l15 == 0) *(f32x4*)(DAGG + (size_t)blk * 64 + 16 * db + 4 * g) = Dagg[db]; }
}
constexpr int GS = 136;
constexpr int PO_GR = 0, PO_YT = 64 * GS * 2, PO_PART = 2 * 64 * GS * 2, PO_ST = PO_PART + 8 * 64 * 4, PO_END = PO_ST + 128 * LS * 2;
__device__ __forceinline__ void post_block(int u0, int NB, const bf16* QKV, const unsigned char* QPG, const unsigned char* OI, const unsigned char* UU, const float* DEC, const unsigned char* AGG, const float* DAGG, const float* __restrict__ gnorm, bf16* Y, unsigned char* lds) {
    int tid_ = threadIdx.x; asm volatile("" : "+v"(tid_));
    const int tid = tid_, lane = tid & 63, wid = __builtin_amdgcn_readfirstlane(tid >> 6), l15 = lane & 15, g = lane >> 4;
    const int n0 = u0 % NCH, bh = u0 / NCH, h = bh % GH, b = bh / GH;
    bf16* GRs = (bf16*)(lds + PO_GR); bf16* YT = (bf16*)(lds + PO_YT); float* PART = (float*)(lds + PO_PART); bf16* ST = (bf16*)(lds + PO_ST);
    const int t = tid >> 3, oc = tid & 7, e = 16 * wid + l15;
    const float gn = gnorm[e];
    f32x4 Sa[4];
#pragma unroll
    for (int db = 0; db < 4; ++db) Sa[db] = (f32x4){0.f, 0.f, 0.f, 0.f};
    { const int seg0 = bh * (NCH / 8), nseg = n0 / 8;
      for (int i = 0; i < nseg; ++i) {
          f32x4 Ua[4], Da[4];
#pragma unroll
          for (int db = 0; db < 4; ++db) { Ua[db] = *(const f32x4*)(AGG + (size_t)(seg0 + i) * UU_B + (size_t)((wid * 4 + db) * 64 + lane) * 16); Da[db] = *(const f32x4*)(DAGG + (size_t)(seg0 + i) * 64 + 16 * db + 4 * g); }
#pragma unroll
          for (int db = 0; db < 4; ++db) Sa[db] = Da[db] * Sa[db] + Ua[db]; } }
    for (int i = 0; i < NB; ++i) {
        const int unit = u0 + i; const size_t row0 = (size_t)b * S + (size_t)(n0 + i) * 64;
        const u32x4 g0 = *(const u32x4*)(QKV + (row0 + t) * fx::QKVP + fx::P_GR + h * 128 + oc * 16), g1 = *(const u32x4*)(QKV + (row0 + t) * fx::QKVP + fx::P_GR + h * 128 + oc * 16 + 8);
        f32x4 o[4], Uf[4], dv[4]; bf16x8 qa[4][2], sb[2];
#pragma unroll
        for (int m = 0; m < 4; ++m) { o[m] = *(const f32x4*)(OI + (size_t)unit * OI_B + (size_t)((wid * 4 + m) * 64 + lane) * 16);
            Uf[m] = *(const f32x4*)(UU + (size_t)unit * UU_B + (size_t)((wid * 4 + m) * 64 + lane) * 16); dv[m] = *(const f32x4*)(DEC + (size_t)unit * 64 + 16 * m + 4 * g);
#pragma unroll
            for (int ks = 0; ks < 2; ++ks) qa[m][ks] = *(const bf16x8*)(QPG + (size_t)unit * QPG_B + (size_t)((16 * m + l15) * 64 + 32 * ks + 8 * g) * 2); }
#pragma unroll
        for (int db = 0; db < 4; ++db) *(u32x2*)(ST + e * LS + 16 * db + 4 * g) = (u32x2){pkbf(Sa[db][0], Sa[db][1]), pkbf(Sa[db][2], Sa[db][3])};
#pragma unroll
        for (int ks = 0; ks < 2; ++ks) sb[ks] = *(const bf16x8*)(ST + e * LS + 32 * ks + 8 * g);
        *(u32x4*)(GRs + t * GS + oc * 16) = g0; *(u32x4*)(GRs + t * GS + oc * 16 + 8) = g1;
#pragma unroll
        for (int m = 0; m < 4; ++m)
#pragma unroll
            for (int ks = 0; ks < 2; ++ks) o[m] = __builtin_amdgcn_mfma_f32_16x16x32_bf16(qa[m][ks], sb[ks], o[m], 0, 0, 0);
#pragma unroll
        for (int m = 0; m < 4; ++m) { f32x4 q = o[m] * o[m];
#pragma unroll
            for (int off = 1; off < 16; off <<= 1) { q[0] += __shfl_xor(q[0], off); q[1] += __shfl_xor(q[1], off); q[2] += __shfl_xor(q[2], off); q[3] += __shfl_xor(q[3], off); }
            if (l15 == 0) *(f32x4*)(PART + wid * 64 + 16 * m + 4 * g) = q; }
#pragma unroll
        for (int db = 0; db < 4; ++db) Sa[db] = dv[db] * Sa[db] + Uf[db];
        __syncthreads();
#pragma unroll
        for (int m = 0; m < 4; ++m) { f32x4 tot = {0.f, 0.f, 0.f, 0.f};
#pragma unroll
            for (int w = 0; w < 8; ++w) tot += *(const f32x4*)(PART + w * 64 + 16 * m + 4 * g);
#pragma unroll
            for (int r = 0; r < 4; ++r) { const int tt = 16 * m + 4 * g + r; const float rs = rsqrtf(tot[r] * (1.f / GV) + LN_EPS); const float gr = bf2f(GRs[tt * GS + e]);
                const float v = o[m][r] * rs * gn * (gr * __builtin_amdgcn_rcpf(1.f + __builtin_amdgcn_exp2f(-1.4426950408889634f * gr)));
                YT[tt * GS + e] = (bf16)(pkbf(v, 0.f) & 0xffffu); } }
        __syncthreads();
        { const u32x4 y0 = *(const u32x4*)(YT + t * GS + oc * 16), y1 = *(const u32x4*)(YT + t * GS + oc * 16 + 8);
          *(u32x4*)(Y + (row0 + t) * D + 512 + h * GV + oc * 16) = y0; *(u32x4*)(Y + (row0 + t) * D + 512 + h * GV + oc * 16 + 8) = y1; }
        __syncthreads();
    }
}
}
namespace mo {
using namespace nv;
typedef unsigned short bf16;
typedef float f32x4 __attribute__((ext_vector_type(4)));
typedef unsigned u32x4 __attribute__((ext_vector_type(4)));
constexpr int CAP = 8192;
constexpr int NEX = NE + 1;
constexpr int YSH = T * TOPK;
constexpr int L_TB = 132096, L_YB = L_TB + 1040, L_CN = L_YB + 1040, L_UT = 138240, L_RG = 141312;
typedef LAS int* lint;


constexpr int I_EG = NEX * 256, I_ED = NEX * 128, I_EXP = I_EG + I_ED;
struct ExpW { const float* eg; const float* eu; const float* ed; const float* sg; const float* su; const float* sd; bf16* WegT; bf16* WedT; };
__device__ __forceinline__ void cv_decode(int r, const ExpW& X, fx::CvItem& I) {
    if (r < I_EG) { const int e = r >> 8, kb = (r >> 4) & 15, nb = r & 15, c = nb >> 3, sub = nb & 7;
        I.W = (e < NE) ? ((sub < 4 ? X.eg : X.eu) + (size_t)e * D * ED) : (sub < 4 ? X.sg : X.su); I.WT = X.WegT + (size_t)e * 512 * D; I.N = ED; I.K = D; I.k0 = 64 * kb; I.n0 = 32 * nb; I.s0 = 128 * c + 32 * (sub & 3); }
    else { r -= I_EG; const int e = r >> 7, kb = (r >> 5) & 3, nb = r & 31; I.W = (e < NE) ? (X.ed + (size_t)e * ED * D) : X.sd; I.WT = X.WedT + (size_t)e * D * ED; I.N = D; I.K = ED; I.k0 = 64 * kb; I.n0 = 32 * nb; I.s0 = 32 * nb; }
}
__device__ __forceinline__ void expert_conv(const ExpW& X, LAS float* scr, int it0, int step, int it_end, int lane) {
    int it = it0; fx::CvItem cur, nx; fx::f32x4 v[8], w[8];
    if (it < it_end) { cv_decode(it, X, cur); fx::cv_load(cur, v, lane); }
    while (it < it_end) { const int itn = it + step; if (itn < it_end) { cv_decode(itn, X, nx); fx::cv_load(nx, w, lane); }
        fx::cv_finish(cur, v, scr, lane); cur = nx;
#pragma unroll
        for (int i = 0; i < 8; ++i) v[i] = w[i];
        it = itn; }
}

__device__ __forceinline__ void moe_tables(const int* counts, lint tb, lint yb, lint cn, int lane) {
    int c[4], nt[4]; int st = 0, sy = 0, pt[4], py[4];
#pragma unroll
    for (int i = 0; i < 4; ++i) { c[i] = counts[lane * 4 + i]; c[i] = c[i] > CAP ? CAP : c[i]; nt[i] = (c[i] + 255) >> 8; pt[i] = st; py[i] = sy; st += nt[i]; sy += c[i]; }
    int it = st, iy = sy;
    for (int o = 1; o < 64; o <<= 1) { const int a = __shfl_up(it, o), b = __shfl_up(iy, o); if (lane >= o) { it += a; iy += b; } }
    const int bt = it - st, by = iy - sy;
#pragma unroll
    for (int i = 0; i < 4; ++i) { tb[lane * 4 + i] = bt + pt[i]; yb[lane * 4 + i] = by + py[i]; cn[lane * 4 + i] = c[i]; }
    if (lane == 63) { tb[256] = it; tb[257] = it + T / 256; yb[256] = YSH; cn[256] = T; }
}

__device__ __forceinline__ void route_token2(const float* LG, const float* __restrict__ rbias, int* lcnt, int* TK, float* TW, int t0, int lane) {
    const int l32 = lane & 31, hb = lane & 32, t = t0 + (lane >> 5);
    const float4 la = ((const float4*)(LG + (size_t)t * NE))[2 * l32], lb = ((const float4*)(LG + (size_t)t * NE))[2 * l32 + 1];
    const float4 ra = ((const float4*)rbias)[2 * l32], rb = ((const float4*)rbias)[2 * l32 + 1];
    const float lg[8] = {la.x, la.y, la.z, la.w, lb.x, lb.y, lb.z, lb.w}, rbv[8] = {ra.x, ra.y, ra.z, ra.w, rb.x, rb.y, rb.z, rb.w};
    float sc[8], bv[8];
#pragma unroll
    for (int i = 0; i < 8; ++i) { sc[i] = __builtin_amdgcn_rcpf(1.f + __builtin_amdgcn_exp2f(-1.4426950408889634f * lg[i])); bv[i] = sc[i] + rbv[i]; }
    float m1 = fmaxf(bv[0], bv[1]), m2 = fminf(bv[0], bv[1]);
#pragma unroll
    for (int i = 2; i < 8; ++i) { const float n1 = fmaxf(m1, bv[i]); m2 = fmaxf(fminf(m1, bv[i]), m2); m1 = n1; }
#pragma unroll
    for (int o = 1; o < 4; o <<= 1) { const float p1 = __shfl_xor(m1, o), p2 = __shfl_xor(m2, o); const float n1 = fmaxf(m1, p1); m2 = fmaxf(fminf(m1, p1), fmaxf(m2, p2)); m1 = n1; }
    const float gs = m1 + m2;
    const int myg = l32 >> 2;
    int rank = 0;
#pragma unroll
    for (int g2 = 0; g2 < NG; ++g2) { const float og = __shfl(gs, hb + g2 * 4); if (og > gs || (og == gs && g2 < myg)) ++rank; }
    const bool sel = rank < 4;
    float mv[8];
#pragma unroll
    for (int i = 0; i < 8; ++i) mv[i] = sel ? bv[i] : -INFINITY;
    int mye = 0; float myw = 0.f; float wsum = 0.f;
#pragma unroll
    for (int k = 0; k < TOPK; ++k) {
        float bvv = mv[0]; int bi = 0;
#pragma unroll
        for (int i = 1; i < 8; ++i) if (mv[i] > bvv) { bvv = mv[i]; bi = i; }
        int gi = l32 * 8 + bi;
#pragma unroll
        for (int o = 16; o > 0; o >>= 1) { const float ov = __shfl_xor(bvv, o); const int oi = __shfl_xor(gi, o); if (ov > bvv || (ov == bvv && oi < gi)) { bvv = ov; gi = oi; } }
        const int ol = gi >> 3, oi = gi & 7;
        float s_own = sc[0];
#pragma unroll
        for (int i = 1; i < 8; ++i) s_own = (oi == i) ? sc[i] : s_own;
        const float sw = __shfl(s_own, hb + ol);
        if (l32 == ol) {
#pragma unroll
            for (int i = 0; i < 8; ++i) if (oi == i) mv[i] = -INFINITY; }
        if (l32 == k) { mye = gi; myw = sw; } wsum += sw;
    }
    if (l32 < TOPK) { const int lp = atomicAdd(&lcnt[mye], 1); TK[t * TOPK + l32] = mye | (lp << 9); TW[t * TOPK + l32] = myw * (2.5f / wsum); }
}
__device__ __forceinline__ void route_finish2(const int* lbase, int* list_tok, float* list_gate, int* TK, const float* TW, int t0, int lane) {
    const int l32 = lane & 31, t = t0 + (lane >> 5);
    if (l32 < TOPK) { const int tk = TK[t * TOPK + l32]; const int e = tk & 511, pos = lbase[e] + (tk >> 9);
        if (pos < CAP) { list_tok[e * CAP + pos] = t; list_gate[e * CAP + pos] = TW[t * TOPK + l32]; }
        TK[t * TOPK + l32] = e | (pos << 9); }
}

constexpr float YSC = 16.f;
__device__ __forceinline__ void combine_token(const bf16* H1, const unsigned char* Y, const int* TK, lint yb, const float* __restrict__ g, const float* __restrict__ b, float* out, int t, int lane) {
    typedef float f2 __attribute__((ext_vector_type(2)));
    float v[16], s[16];
    { const u32x4 a = *(const u32x4*)(H1 + (size_t)t * D + 16 * lane), c = *(const u32x4*)(H1 + (size_t)t * D + 16 * lane + 8);
      const unsigned w[8] = {a.x, a.y, a.z, a.w, c.x, c.y, c.z, c.w};
#pragma unroll
      for (int i = 0; i < 8; ++i) { v[2 * i] = ALPHA * __builtin_bit_cast(float, w[i] << 16); v[2 * i + 1] = ALPHA * __builtin_bit_cast(float, w[i] & 0xffff0000u); } }
#pragma unroll
    for (int i = 0; i < 16; ++i) s[i] = 0.f;
    int tk = (lane < TOPK) ? TK[t * TOPK + lane] : 0;
#pragma unroll
    for (int k = 0; k <= TOPK; ++k) {
        size_t yrow;
        if (k < TOPK) { const int x = __shfl(tk, k); yrow = (size_t)(yb[x & 511] + (x >> 9)); } else yrow = (size_t)YSH + t;
        const u32x4 a = *(const u32x4*)(Y + yrow * D + 16 * lane);
        const int w[4] = {(int)a.x, (int)a.y, (int)a.z, (int)a.w};
#pragma unroll
        for (int i = 0; i < 4; ++i) { const f2 lo = __builtin_amdgcn_cvt_pk_f32_fp8(w[i], false), hi = __builtin_amdgcn_cvt_pk_f32_fp8(w[i], true);
            s[4 * i] += lo[0]; s[4 * i + 1] += lo[1]; s[4 * i + 2] += hi[0]; s[4 * i + 3] += hi[1]; }
    }
    float sm = 0.f;
#pragma unroll
    for (int i = 0; i < 16; ++i) { v[i] += s[i] * (1.f / YSC); sm += v[i]; }
    const float mean = fx::wave_sum(sm) * (1.f / D); float q = 0.f;
#pragma unroll
    for (int i = 0; i < 16; ++i) { v[i] -= mean; q += v[i] * v[i]; }
    const float rstd = 1.f / sqrtf(fx::wave_sum(q) * (1.f / D) + LN_EPS);
#pragma unroll
    for (int i = 0; i < 4; ++i) { const f32x4 gg = *(const f32x4*)(g + 16 * lane + 4 * i), bb = *(const f32x4*)(b + 16 * lane + 4 * i);
        f32x4 o; o[0] = v[4 * i] * rstd * gg[0] + bb[0]; o[1] = v[4 * i + 1] * rstd * gg[1] + bb[1]; o[2] = v[4 * i + 2] * rstd * gg[2] + bb[2]; o[3] = v[4 * i + 3] * rstd * gg[3] + bb[3];
        *(f32x4*)(out + (size_t)t * D + 16 * lane + 4 * i) = o; }
}
}

namespace pg8 {
struct RouterSched {
    int rb; const bf16_t* Bt;
    __device__ __forceinline__ bool next(int i, Unit2& u) const { if (i > 0) return false; u.pm = rb; u.pn = 0; u.e = 0; u.cnt = 128; u.jt = 0; u.ui = 0; return true; }
    __device__ __forceinline__ int arow(const Unit2& u, int r) const { return u.pm * 128 + r; }
    __device__ __forceinline__ size_t aoff(const Unit2&) const { return 0; }
    __device__ __forceinline__ const char* bptr(const Unit2&) const { return (const char*)Bt; }
};
struct EpiLogits {
    static constexpr bool PERM = false, AFTER_DRAIN = false;
    float* LG;
    __device__ __forceinline__ void operator()(const f32x4 (&acc)[2][2][4][2], const Unit2& u, int wr, int wc, int fr, int fq) const {
        const int row0 = u.pm * 128 + wr * 64 + fr, col0 = wc * 32 + 4 * fq;
#pragma unroll
        for (int m = 0; m < 4; ++m) { float* rowp = LG + (size_t)(row0 + m * 16) * nv::NE + col0;
#pragma unroll
            for (int bj = 0; bj < 2; ++bj)
#pragma unroll
                for (int n = 0; n < 2; ++n) *(f32x4*)(rowp + bj * HALF + n * 16) = acc[0][bj][m][n]; }
    }
};
template <int PH> struct MoeSched {
    int G, vcu, nrt; mo::lint tb; mo::lint cn; const int* list_tok; const bf16_t* W; mo::lint ut; mo::lint rg;
    static constexpr int NC = PH == 0 ? 2 : 4;
    static constexpr int MAXU = 64;
    __device__ __forceinline__ void build(int lane) const {
        const int L = lane * G + vcu;
        if (lane < MAXU && L < nrt * NC) {
            const int rt = L / NC, c = L % NC;
            int lo = 0, hi = 256;
            while (lo < hi) { const int mid = (lo + hi + 1) >> 1; if (tb[mid] <= rt) lo = mid; else hi = mid - 1; }
            const int e = lo, jt = rt - tb[e], rem = cn[e] - 256 * jt;
            ut[4 * lane] = rt; ut[4 * lane + 1] = c; ut[4 * lane + 2] = e | (jt << 9); ut[4 * lane + 3] = rem < 256 ? rem : 256;
        }
    }
    __device__ __forceinline__ bool next(int i, Unit2& u) const {
        const int L = i * G + vcu; if (i >= MAXU || L >= nrt * NC) return false;
        const int x = ut[4 * i + 2];
        u.pm = __builtin_amdgcn_readfirstlane(ut[4 * i]); u.pn = __builtin_amdgcn_readfirstlane(ut[4 * i + 1]); u.e = __builtin_amdgcn_readfirstlane(x & 511); u.jt = __builtin_amdgcn_readfirstlane(x >> 9);
        u.cnt = __builtin_amdgcn_readfirstlane(ut[4 * i + 3]); u.ui = i; return true;
    }
    __device__ __forceinline__ void fill_rows(const float* list_gate, int tid) const {
        for (int i = 0; i < MAXU; ++i) { const int L = i * G + vcu; if (L >= nrt * NC) break;
            const int x = ut[4 * i + 2], e = x & 511, jt = x >> 9, cnt = ut[4 * i + 3];
            if (tid < 256) { const int r = tid; unsigned v;
                if (e == 256) v = (unsigned)(jt * BM + r) | (0x4180u << 16);
                else if (r < cnt) { const float gsc = mo::YSC * list_gate[e * mo::CAP + jt * BM + r]; v = (unsigned)list_tok[e * mo::CAP + jt * BM + r] | (fx::f2bf(gsc) << 16); }
                else v = 0u;
                rg[i * 256 + r] = (int)v; } }
    }
    __device__ __forceinline__ int arow(const Unit2& u, int r) const {
        if (PH == 1) return u.pm * BM + r;
        return rg[u.ui * 256 + r] & 0x7fff;
    }
    __device__ __forceinline__ size_t aoff(const Unit2& u) const { return PH == 1 ? (size_t)u.pm * (131072 - 32768) : 0; }
    __device__ __forceinline__ const char* bptr(const Unit2& u) const {
        return PH == 0 ? (const char*)(W + ((size_t)u.e * 512 + 256 * u.pn) * 1024) : (const char*)(W + ((size_t)u.e * 1024 + 256 * u.pn) * 256);
    }
};
struct EpiSwiGLU {
    static constexpr bool PERM = true, AFTER_DRAIN = false;
    bf16_t* H; mo::lint rg; int skip;
    __device__ __forceinline__ void operator()(const f32x4 (&acc)[2][2][4][2], const Unit2& u, int wr, int wc, int fr, int fq) const {
        if (skip) return;
        const int col0 = u.pn * 128 + wc * 32 + 8 * fq;
#pragma unroll
        for (int ai = 0; ai < 2; ++ai)
#pragma unroll
            for (int m = 0; m < 4; ++m) { const int r = ai * HALF + wr * 64 + m * 16 + fr;
                const float gt = __builtin_bit_cast(float, (unsigned)rg[u.ui * 256 + r] & 0xffff0000u);
                float hv[8];
#pragma unroll
                for (int n = 0; n < 2; ++n)
#pragma unroll
                    for (int i = 0; i < 4; ++i) { const float gg = acc[ai][0][m][n][i], uu = acc[ai][1][m][n][i]; hv[4 * n + i] = gt * uu * (gg * __builtin_amdgcn_rcpf(1.f + __builtin_amdgcn_exp2f(-1.4426950408889634f * gg))); }
                u32x4 w; w.x = cvt_pk_bf16(hv[0], hv[1]); w.y = cvt_pk_bf16(hv[2], hv[3]); w.z = cvt_pk_bf16(hv[4], hv[5]); w.w = cvt_pk_bf16(hv[6], hv[7]);
                *(u32x4*)(H + (size_t)u.pm * 65536 + (size_t)(col0 >> 6) * 16384 + r * 64 + (col0 & 63)) = w; }
    }
};
struct EpiDown {
    static constexpr bool PERM = true, PERM16 = true, AFTER_DRAIN = false;
    unsigned char* Y; mo::lint yb; int skip;
    __device__ __forceinline__ void operator()(const f32x4 (&acc)[2][2][4][2], const Unit2& u, int wr, int wc, int fr, int fq) const {
        if (skip) return;
        const int col0 = u.pn * BM + wc * 64 + 16 * fq; const int ybase = yb[u.e] + u.jt * BM;
#pragma unroll
        for (int ai = 0; ai < 2; ++ai)
#pragma unroll
            for (int m = 0; m < 4; ++m) { const int r = ai * HALF + wr * 64 + m * 16 + fr;
                if (r < u.cnt) { u32x4 w; unsigned ww[4];
#pragma unroll
                    for (int bj = 0; bj < 2; ++bj)
#pragma unroll
                        for (int n = 0; n < 2; ++n) { const f32x4 v = acc[ai][bj][m][n]; int x = __builtin_amdgcn_cvt_pk_fp8_f32(v[0], v[1], 0, false); x = __builtin_amdgcn_cvt_pk_fp8_f32(v[2], v[3], x, true); ww[2 * bj + n] = (unsigned)x; }
                    w.x = ww[0]; w.y = ww[1]; w.z = ww[2]; w.w = ww[3];
                    *(u32x4*)(Y + (size_t)(ybase + r) * nv::D + col0) = w; } }
    }
};
}
constexpr int NTHR = 512;
constexpr int LDS_BYTES = 163840;
constexpr int MISC_OFF = 131072 + 320;
constexpr size_t MiB = 1u << 20;
constexpr size_t CTL_ZERO_BYTES = 96 * 1024;
constexpr int CW_BAR = 4096;
constexpr int CW_MOE = 16384;
constexpr int CW_FOXQ = 20992;
constexpr int CW_NRM = 20480;
constexpr int NPHASE = 9;
constexpr size_t WS_H1 = 1, WS_WR = 65, WS_STATS = 66, WS_LF = 67, WS_FG = 68, WS_WO = 72, WS_WIN = 74, WS_TK = 81, WS_LTOK = 83, WS_LGATE = 91,
                 WS_WED = 100, WS_HID = 230, WS_GLA = 230, WS_WEG = 416, WS_XN = 673, WS_YBF = 673, WS_QKV = 737, WS_Z1 = 737, WS_LG = 865, WS_Y = 416, WS_END = 992;

struct Args { const float* in[21]; float* out; unsigned char* ws; int ph_lo, ph_hi, li, pad; };

__global__ void __launch_bounds__(NTHR, 2) mega_fwd(Args a) {
    using namespace nv;
    extern __shared__ __attribute__((aligned(16))) unsigned char lds[];
    const int G = gridDim.x, bx = blockIdx.x;
    const int vcu = (G % 8 == 0) ? (bx % 8) * (G / 8) + bx / 8 : bx;
    int tid, lane, wave, vw;
#define DERIVE() do { int t_ = threadIdx.x; asm volatile("" : "+v"(t_)); tid = t_; lane = tid & 63; wave = __builtin_amdgcn_readfirstlane(tid >> 6); vw = vcu * 8 + wave; } while (0)
    DERIVE();
    volatile LAS unsigned* MISC = (volatile LAS unsigned*)((LAS unsigned char*)lds + MISC_OFF);
    for (int u = tid; u < (LDS_BYTES - 131072) / 4; u += NTHR) ((LAS unsigned*)((LAS unsigned char*)lds + 131072))[u] = 0u;
    __syncthreads();
    unsigned char* ws = a.ws;
    unsigned* ctl = (unsigned*)ws;
    XcdBarrier bar = xcd_barrier_post(ctl + CW_BAR + a.li * XCD_BAR_WORDS, MISC + 8);
    const float* x = a.in[0];
    const float* ln_in_g = a.in[1]; const float* ln_in_b = a.in[2];
    const float* w_in = a.in[3]; const float* b_fgate = a.in[4];
    const float* w_gate_up = a.in[5]; const float* b_gate = a.in[6]; const float* g_gla = a.in[7];
    const float* w_out = a.in[8]; const float* ln1_g = a.in[9]; const float* ln1_b = a.in[10];
    const float* w_router = a.in[11]; const float* rbias = a.in[12];
    const float* w_eg = a.in[13]; const float* w_eu = a.in[14]; const float* w_ed = a.in[15];
    const float* w_sg = a.in[16]; const float* w_su = a.in[17]; const float* w_sd = a.in[18];
    const float* ln2_g = a.in[19]; const float* ln2_b = a.in[20];
    float* out = a.out;
    int* counts = (int*)(ctl + CW_MOE);
    fx::bf16* H1 = (fx::bf16*)(ws + WS_H1 * MiB);
    fx::bf16* WrT = (fx::bf16*)(ws + WS_WR * MiB);
    float* stats = (float*)(ws + WS_STATS * MiB);
    float* LF = (float*)(ws + WS_LF * MiB);
    float* FG = (float*)(ws + WS_FG * MiB);
    fx::bf16* WoT = (fx::bf16*)(ws + WS_WO * MiB);
    fx::bf16* WinT = (fx::bf16*)(ws + WS_WIN * MiB);
    int* TK = (int*)(ws + WS_TK * MiB);
    float* TW = (float*)(ws + (WS_TK + 1) * MiB);
    int* list_tok = (int*)(ws + WS_LTOK * MiB);
    float* list_gate = (float*)(ws + WS_LGATE * MiB);
    fx::bf16* WedT = (fx::bf16*)(ws + WS_WED * MiB);
    fx::bf16* HID = (fx::bf16*)(ws + WS_HID * MiB);
    unsigned char* QPG = ws + WS_GLA * MiB; unsigned char* OIb = ws + (WS_GLA + 16) * MiB; unsigned char* UUb = ws + (WS_GLA + 80) * MiB; float* DECb = (float*)(ws + (WS_GLA + 144) * MiB); unsigned char* AGGb = ws + (WS_GLA + 145) * MiB; float* DAGGb = (float*)(ws + (WS_GLA + 153) * MiB);
    fx::bf16* WegT = (fx::bf16*)(ws + WS_WEG * MiB);
    fx::bf16* XN = (fx::bf16*)(ws + WS_XN * MiB);
    fx::bf16* Ybf = (fx::bf16*)(ws + WS_YBF * MiB);
    fx::bf16* QKV = (fx::bf16*)(ws + WS_QKV * MiB);
    fx::bf16* MIX = (fx::bf16*)(ws + WS_Z1 * MiB);
    float* LG = (float*)(ws + WS_LG * MiB);
    unsigned char* YA = ws + WS_Y * MiB;
    mo::lint tb = (mo::lint)((LAS unsigned char*)lds + mo::L_TB), yb = (mo::lint)((LAS unsigned char*)lds + mo::L_YB), cn = (mo::lint)((LAS unsigned char*)lds + mo::L_CN), ut = (mo::lint)((LAS unsigned char*)lds + mo::L_UT), rg = (mo::lint)((LAS unsigned char*)lds + mo::L_RG);

    const int lo = a.ph_lo, hi = a.ph_hi;
    bool tables_ready = false;
#define IN(k) (lo <= (k) && (k) < hi)
#define SEAM(k) do { if (IN(k) && IN((k) + 1)) xcd_barrier(bar); DERIVE(); } while (0)
    const int GW = G * 8;
#ifndef STG7
#define STG7 0
#endif
#ifndef STG8
#define STG8 0
#endif
#define STAGGER(q) do { if ((q) > 0) { const unsigned long long t0_ = __builtin_amdgcn_s_memrealtime(); const unsigned long long d_ = (unsigned long long)((vcu & 3) * (q)); while (__builtin_amdgcn_s_memrealtime() - t0_ < d_) __builtin_amdgcn_s_sleep(8); } } while (0)

    if (IN(0)) {
        LAS float* scr = (LAS float*)((LAS unsigned char*)lds + wave * 16384);
        constexpr int I_IN = 16 * (fx::NIN / 32), I_OUT = 16 * 32, I_R = 16 * 8, I_SMALL = I_IN + I_OUT + I_R;
        for (int it = vw; it < I_SMALL; it += GW) {
            int r = it;
            if (r < I_IN) { fx::transpose_item(w_in, D, INW, WinT, scr, r / (fx::NIN / 32), r % (fx::NIN / 32), lane, [](int d) { return fx::inproj_src(d); }); continue; } r -= I_IN;
            if (r < I_OUT) { fx::transpose_item(w_out, D, D, WoT, scr, r / 32, r % 32, lane, [](int d) { return d; }); continue; } r -= I_OUT;
            fx::transpose_item(w_router, D, NE, WrT, scr, r / 8, r % 8, lane, [](int d) { return d; });
        }
        for (int r = vw * 4; r < T; r += GW * 4) fx::ln_rows_bf16<4>(x + (size_t)r * D, ln_in_g, ln_in_b, XN + (size_t)r * D, lane, stats + 2 * (size_t)r);
    }
    SEAM(0);
    if (IN(1)) {
        const mo::ExpW XW{w_eg, w_eu, w_ed, w_sg, w_su, w_sd, WegT, WedT};
#ifndef MIXG
#define MIXG 2
#endif
        { const int slot = vcu % MIXG; pg8::StaticOrder S; S.init(T, fx::NIN, G, bx);
          const int nun = (S.nwg - bx + G - 1) / G, nb = (MIXG > 1) ? nun * slot / (MIXG - 1) : nun;
          pg8::Gemm g{XN, WinT, T, fx::NIN, D, D}; pg8::EpiInProj E{QKV, FG, LF, b_fgate, ctl + CW_NRM};
          if (nb > 0) { pg8::RangeOrder R{S, 0, nb}; pg8::gemm_phase<pg8::EpiInProj, pg8::RangeOrder, true, true>((LAS unsigned char*)lds, g, R, E); DERIVE(); }
          { LAS float* scr = (LAS float*)((LAS unsigned char*)lds + wave * 16384);
            const int nmax = (S.nwg + G - 1) / G, nlight = G * nmax - S.nwg;
#ifndef CONV_SKEW
#define CONV_SKEW 0.18f
#endif
            const bool two = (CONV_SKEW != 0.0f) && nlight > 0 && nlight < G;
            const float sk = CONV_SKEW < 0.f ? -CONV_SKEW : CONV_SKEW;
            const int nsub = (CONV_SKEW > 0.f) ? nlight : G - nlight;
            const int n1 = two ? mo::I_EXP - (int)(sk * (float)mo::I_EXP * (float)nsub / (float)G) : mo::I_EXP;
            mo::expert_conv(XW, scr, vw, GW, n1, lane);
            const bool light = bx >= G - nlight;
            if (two && (light == (CONV_SKEW > 0.f))) { const int rank = light ? bx - (G - nlight) : bx; mo::expert_conv(XW, scr, n1 + rank * 8 + wave, nsub * 8, mo::I_EXP, lane); } }
          __syncthreads(); DERIVE();
          if (nb < nun) { pg8::RangeOrder R{S, nb, nun - nb}; pg8::gemm_phase<pg8::EpiInProj, pg8::RangeOrder, true, true>((LAS unsigned char*)lds, g, R, E); } }
    }
    SEAM(1);
    if (IN(2)) {
        int cur_h = -1;
        for (int blk = vcu; blk < gl::NUNIT / 8; blk += G) gl::prep_block(blk, QKV, FG, w_gate_up, b_gate, QPG, OIb, UUb, DECb, AGGb, DAGGb, lds, cur_h);
    }
    SEAM(2);
    if (IN(3)) {
        for (int blk = vcu; blk < gl::NUNIT / 8; blk += G) gl::post_block(blk * 8, 8, QKV, QPG, OIb, UUb, DECb, AGGb, DAGGb, g_gla, Ybf, lds);
        { const attn_body::AttnTensors AT{(const attn_body::bf16*)(QKV + fx::P_FQ), (const attn_body::bf16*)(QKV + fx::P_FK), (const attn_body::bf16*)(QKV + fx::P_FV), (attn_body::bf16*)Ybf, LF, ctl + CW_NRM};
          attn_body::attn_phase_dyn<8>((char*)lds, AT, ctl + CW_FOXQ, (volatile int*)(lds + 140288), (G % 8 == 0) ? vcu / (G / 8) : vcu % 8); }
    }
    SEAM(3);
    if (IN(4)) {
        pg8::DenseSched DS; DS.so.init(T, D, G, bx); DS.Bt = WoT; DS.ldb = D;
        pg8::EpiPlainBf16 E{MIX, D};
        pg8::gemm_phase2<pg8::EpiPlainBf16, pg8::DenseSched>((LAS unsigned char*)lds, Ybf, D, D, D, DS, E);
    }
    SEAM(4);
    if (IN(5)) {
        int* lcnt = (int*)(lds + 136192); int* lbase = lcnt + 256;
        for (int rb = vcu; rb < T / 128; rb += G) {
            if (tid < 256) lcnt[tid] = 0;
            for (int r = wave * 16; r < wave * 16 + 16; r += 4) { const size_t row = (size_t)rb * 128 + r;
                fx::ln1_rows_bf16<4>(x + row * D, stats + 2 * row, ln_in_g, ln_in_b, MIX + row * D, ln1_g, ln1_b, H1 + row * D, ALPHA, lane); }
            asm volatile("s_waitcnt vmcnt(0)" ::: "memory"); __syncthreads();
            { pg8::RouterSched RS{rb, WrT}; pg8::EpiLogits E{LG};
              pg8::gemm_phase2<pg8::EpiLogits, pg8::RouterSched>((LAS unsigned char*)lds, H1, D, D, D, RS, E); }
            DERIVE();
            for (int t = rb * 128 + wave * 2; t < rb * 128 + 128; t += 16) mo::route_token2(LG, rbias, lcnt, TK, TW, t, lane);
            __syncthreads();
            if (tid < 256) { const int c = lcnt[tid]; lbase[tid] = c ? atomicAdd(&counts[tid], c) : 0; }
            __syncthreads();
            for (int t = rb * 128 + wave * 2; t < rb * 128 + 128; t += 16) mo::route_finish2(lbase, list_tok, list_gate, TK, TW, t, lane);
            __syncthreads();
        }
    }
    SEAM(5);
    if (IN(6)) {
        if (wave == 0) mo::moe_tables(counts, tb, yb, cn, lane);
        __syncthreads(); tables_ready = true;
        STAGGER(STG7);
        pg8::MoeSched<0> MS{G, vcu, tb[257], tb, cn, list_tok, WegT, ut, rg}; if (wave == 0) MS.build(lane); __syncthreads(); MS.fill_rows(list_gate, tid); __syncthreads(); pg8::EpiSwiGLU E{HID, rg, a.pad};
        pg8::gemm_phase2<pg8::EpiSwiGLU, pg8::MoeSched<0>>((LAS unsigned char*)lds, H1, D, D, D, MS, E);
    }
    SEAM(6);
    if (IN(7)) {
        if (!tables_ready) { if (wave == 0) mo::moe_tables(counts, tb, yb, cn, lane); __syncthreads(); tables_ready = true; }
        STAGGER(STG8);
        pg8::MoeSched<1> MS{G, vcu, tb[257], tb, cn, list_tok, WedT, ut, rg}; if (wave == 0) MS.build(lane); __syncthreads(); pg8::EpiDown E{YA, yb, a.pad};
        pg8::gemm_phase2<pg8::EpiDown, pg8::MoeSched<1>>((LAS unsigned char*)lds, HID, 64, ED, ED, MS, E, 32768);
    }
    SEAM(7);
    if (IN(8)) {
        if (!tables_ready) { if (wave == 0) mo::moe_tables(counts, tb, yb, cn, lane); __syncthreads(); tables_ready = true; }
        for (int t = vw; t < T; t += GW) mo::combine_token(H1, YA, TK, yb, ln2_g, ln2_b, out, t, lane);
    }
#undef IN
#undef SEAM
}

extern "C" void kernel_launch(void* const* d_in, const int* in_sizes, int n_in, void* d_out, int out_size, void* d_ws, size_t ws_size, hipStream_t stream) {
    static int grid = 0;
    if (grid == 0) {
        if (n_in != 21 || out_size != nv::T * nv::D || ws_size < WS_END * MiB) { fprintf(stderr, "kernel_launch: unexpected shapes n_in=%d out=%d ws=%zu\n", n_in, out_size, ws_size); grid = -1; return; }
        int dev = 0, cus = 0;
        if (hipGetDevice(&dev) != hipSuccess || hipDeviceGetAttribute(&cus, hipDeviceAttributeMultiprocessorCount, dev) != hipSuccess) { grid = -1; return; }
        if (hipFuncSetAttribute((const void*)mega_fwd, hipFuncAttributeMaxDynamicSharedMemorySize, LDS_BYTES) != hipSuccess) { fprintf(stderr, "kernel_launch: hipFuncSetAttribute failed\n"); grid = -1; return; }
        grid = cus;
    }
    if (grid < 0) return;
    if (hipMemsetAsync(d_ws, 0, CTL_ZERO_BYTES, stream) != hipSuccess) return;
    Args a{};
    for (int i = 0; i < 21; ++i) a.in[i] = (const float*)d_in[i];
    a.out = (float*)d_out; a.ws = (unsigned char*)d_ws; a.ph_lo = 0; a.ph_hi = NPHASE; a.li = 0;
#ifdef REPEAT_PH
    a.ph_hi = REPEAT_PH + 1; hipLaunchKernelGGL(mega_fwd, dim3(grid), dim3(NTHR), LDS_BYTES, stream, a);
    if (REPEAT_PH == 3) hipMemsetAsync((char*)d_ws + CW_FOXQ * 4, 0, 256, stream);
    if (REPEAT_PH == 5) hipMemsetAsync((char*)d_ws + CW_MOE * 4, 0, 4096, stream);
    a.ph_lo = REPEAT_PH; a.ph_hi = NPHASE; a.li = 1;
#ifdef REPEAT_NOEPI
    a.ph_hi = REPEAT_PH + 1; a.pad = 1; hipLaunchKernelGGL(mega_fwd, dim3(grid), dim3(NTHR), LDS_BYTES, stream, a); a.pad = 0; a.ph_lo = REPEAT_PH + 1; a.ph_hi = NPHASE; a.li = 2;
#endif
#endif
    hipLaunchKernelGGL(mega_fwd, dim3(grid), dim3(NTHR), LDS_BYTES, stream, a);
}
```

```cpp
#include <hip/hip_runtime.h>
#include <cstdio>
#include <cstdint>
#include <cmath>

#define LAS __attribute__((address_space(3)))
#define GAS __attribute__((address_space(1)))

#define XB_TMO      128
#define XB_XCNT(j)  (256  + 64 * (j))
#define XB_XSUB(j)  (1280 + 64 * (j))
#define XB_XGEN(j)  (2304 + 64 * (j))
#define XB_TOP      3328
#define XB_TOPGEN   3392
#define XCD_BAR_WORDS 3456
#define XB_SPIN_CAP (1u << 27)
__device__ __forceinline__ unsigned xb_ld(unsigned* p)              { return __hip_atomic_load(p, __ATOMIC_RELAXED, __HIP_MEMORY_SCOPE_AGENT); }
__device__ __forceinline__ unsigned xb_add(unsigned* p, unsigned v) { return __hip_atomic_fetch_add(p, v, __ATOMIC_RELAXED, __HIP_MEMORY_SCOPE_AGENT); }
__device__ __forceinline__ unsigned xb_xcc_id() { return (unsigned)__builtin_amdgcn_s_getreg((3 << 11) | 20) & 0xFu; }
#define XB_SPIN(cond, bar) do { unsigned _sp = 0; while (cond) { __builtin_amdgcn_s_sleep(1); \
    if ((++_sp & 255u) == 0u) { if (xb_ld(&(bar)[XB_TMO])) break; if (_sp > XB_SPIN_CAP) { atomicAdd(&(bar)[XB_TMO], 1u); break; } } } } while (0)
struct XcdBarrier { unsigned* bar; unsigned x; volatile LAS unsigned* st; };
__device__ __forceinline__ XcdBarrier xcd_barrier_post(unsigned* bar, volatile LAS unsigned* st) {
    XcdBarrier b; b.bar = bar; b.x = xb_xcc_id(); b.st = st;
    if (threadIdx.x == 0) (void)xb_add(&bar[XB_XCNT(b.x)], 1u);
    return b;
}
__device__ __forceinline__ void xcd_barrier_complete(unsigned* bar, unsigned x, unsigned& nloc, unsigned& nx) {
    const unsigned G = gridDim.x * gridDim.y * gridDim.z;
    unsigned sum, cnt, mine, sp = 0u;
    for (;;) {
        sum = 0u; cnt = 0u; mine = 0u;
#pragma unroll
        for (unsigned j = 0; j < 16; ++j) { const unsigned c = xb_ld(&bar[XB_XCNT(j)]); sum += c; cnt += (c > 0u) ? 1u : 0u; mine = (j == x) ? c : mine; }
        if (sum == G) break;
        __builtin_amdgcn_s_sleep(1);
        if ((++sp & 255u) == 0u) { if (xb_ld(&bar[XB_TMO])) break; if (sp > XB_SPIN_CAP) { atomicAdd(&bar[XB_TMO], 1u); break; } }
    }
    nloc = mine > 0u ? mine : 1u; nx = cnt > 0u ? cnt : 1u;
}
__device__ __forceinline__ void xcd_barrier(const XcdBarrier& b) {
    asm volatile("s_waitcnt vmcnt(0)" ::: "memory");
    __syncthreads();
    if (threadIdx.x == 0) {
        unsigned* bar = b.bar;
        __builtin_amdgcn_s_waitcnt(0);
        unsigned nloc = b.st[0], nx = b.st[1];
        if (nloc == 0u) { xcd_barrier_complete(bar, b.x, nloc, nx); b.st[0] = nloc; b.st[1] = nx; }
        const unsigned old = xb_add(&bar[XB_XSUB(b.x)], 1u);
        const unsigned gen = old / nloc;
        if (old + 1u == (gen + 1u) * nloc) {
            __builtin_amdgcn_fence(__ATOMIC_RELEASE, "agent");
            asm volatile("s_waitcnt vmcnt(0)" ::: "memory");
            const unsigned og = xb_add(&bar[XB_TOP], 1u);
            const unsigned tg = og / nx;
            if (og + 1u == (tg + 1u) * nx) xb_add(&bar[XB_TOPGEN], 1u);
            else XB_SPIN(xb_ld(&bar[XB_TOPGEN]) == tg, bar);
            __builtin_amdgcn_fence(__ATOMIC_ACQUIRE, "agent");
            xb_add(&bar[XB_XGEN(b.x)], 1u);
            asm volatile("s_waitcnt vmcnt(0)" ::: "memory");
        } else {
            XB_SPIN(xb_ld(&bar[XB_XGEN(b.x)]) == gen, bar);
            __builtin_amdgcn_fence(__ATOMIC_ACQUIRE, "agent");
            asm volatile("s_waitcnt vmcnt(0)" ::: "memory");
        }
    }
    __syncthreads();
}
namespace pg8 {
#define PG8_LAS __attribute__((address_space(3)))
typedef unsigned short bf16_t;
typedef short bf16x8 __attribute__((ext_vector_type(8)));
typedef float f32x4 __attribute__((ext_vector_type(4)));
typedef unsigned u32x4 __attribute__((ext_vector_type(4)));
constexpr int BM = 256, BK = 64, HALF = 128, HTB = HALF * BK * 2  , STAGE_BYTES = 8 * HTB, NXCD = 8, WGM = 8;

__host__ __device__ __forceinline__ int lds_byte(int r, int c) { const int st = (r >> 4) * 2 + (c >> 5), rr = r & 15, cc = c & 31, ob = rr * 64 + cc * 2; return st * 1024 + (ob ^ (((ob >> 9) & 1) << 5)); }
__host__ __device__ __forceinline__ void stage_rc(int b, int& R, int& C) { const int st = b / 1024, sb = b % 1024, swz = sb ^ (((sb >> 9) & 1) << 5); R = (st >> 1) * 16 + swz / 64; C = (st & 1) * 32 + (swz % 64) / 2; }
__host__ __device__ __forceinline__ int perm32(int rho) { const int n = rho >> 4, i = rho & 15; return 8 * (i >> 2) + 4 * n + (i & 3); }

struct Unit { int pm, pn; };
struct Gemm { const bf16_t* A; const bf16_t* Bt; int M, N, K, lda; };

struct StaticOrder {
    int nM, nN, nwg, G, c;
    __host__ __device__ void init(int M, int N, int G_, int c_) { nM = M / BM; nN = N / BM; nwg = nM * nN; G = G_; c = c_; }
    __host__ __device__ bool next(int i, Unit& u) const {
        const long L = (long)i * G + c; if (L >= nwg) return false;
        int wgid = (int)L; { const int q = nwg / NXCD, r = nwg % NXCD, xcd = wgid % NXCD, off = wgid / NXCD; wgid = (xcd < r ? xcd * (q + 1) : r * (q + 1) + (xcd - r) * q) + off; }
        const int nig = WGM * nN, gid = wgid / nig, fm = gid * WGM, gsz = (nM - fm) < WGM ? (nM - fm) : WGM;
        u.pm = fm + ((wgid % nig) % gsz); u.pn = (wgid % nig) / gsz; return true;
    }
    __device__ __forceinline__ void a_ready(const Unit&) const {}
    __device__ __forceinline__ void done(const Unit&) const {}
};

struct RangeOrder {
    StaticOrder so; int i0, n;
    __host__ __device__ bool next(int i, Unit& u) const { return i < n && so.next(i0 + i, u); }
    __device__ __forceinline__ void a_ready(const Unit&) const {}
    __device__ __forceinline__ void done(const Unit&) const {}
};
__device__ __forceinline__ unsigned cvt_pk_bf16(float lo, float hi) { unsigned r; asm volatile("v_cvt_pk_bf16_f32 %0, %1, %2" : "=v"(r) : "v"(lo), "v"(hi)); return r; }
typedef float f32x2 __attribute__((ext_vector_type(2)));
__device__ __forceinline__ f32x2 gelu_pk(f32x2 v) {
    const f32x2 av = __builtin_elementwise_abs(v), d = av * 0.2316418882f + 1.0f;
    f32x2 t; t.x = __builtin_amdgcn_rcpf(d.x); t.y = __builtin_amdgcn_rcpf(d.y);
    f32x2 q = t * 0.5307027145f + (-0.7265760135f); q = q * t + 0.7107068705f; q = q * t + (-0.142248368f); q = q * t + 0.127414796f; q = q * t;
    const f32x2 s = (v * v) * (-0.72134752044f);
    f32x2 e; e.x = __builtin_amdgcn_exp2f(s.x); e.y = __builtin_amdgcn_exp2f(s.y);
    const f32x2 m = v * (q * e), r = v - m;
    f32x2 o; o.x = v.x < 0.f ? m.x : r.x; o.y = v.y < 0.f ? m.y : r.y; return o;
}

template <int ACT  > struct EpiBf16 {
    static constexpr bool PERM = true, AFTER_DRAIN = false; static_assert(ACT == 0 || ACT == 1, "EpiBf16: ACT is 0 (none) or 1 (gelu_pk)");
    bf16_t* O; int ldc; const float* bias; int split_cols; size_t split_stride; float scale0;
    __device__ __forceinline__ void operator()(const f32x4 (&acc)[2][2][4][2], const Unit& u, int wr, int wc, int fr, int fq) const {
        const int row0 = u.pm * BM + wr * 64 + fr; int colt = u.pn * BM; bf16_t* base = O;
        float sc = 1.f; if (split_cols) { const int t = colt / split_cols; base += (size_t)t * split_stride; colt -= t * split_cols; if (t == 0) sc = scale0; }
        const int col0 = colt + wc * 32 + 8 * fq, bcol0 = u.pn * BM + wc * 32 + 8 * fq;
        f32x4 bv[2][2];
#pragma unroll
        for (int bj = 0; bj < 2; ++bj)
#pragma unroll
            for (int n = 0; n < 2; ++n) bv[bj][n] = bias ? *(const f32x4*)(bias + bcol0 + bj * HALF + 4 * n) : (f32x4){0.f, 0.f, 0.f, 0.f};
#pragma unroll
        for (int ai = 0; ai < 2; ++ai)
#pragma unroll
            for (int m = 0; m < 4; ++m) { bf16_t* rowp = base + (size_t)(row0 + ai * HALF + m * 16) * ldc + col0;
#pragma unroll
                for (int bj = 0; bj < 2; ++bj) { f32x4 v0 = acc[ai][bj][m][0] + bv[bj][0], v1 = acc[ai][bj][m][1] + bv[bj][1];
                    if (ACT == 1) { f32x2 a = gelu_pk((f32x2){v0[0], v0[1]}), b = gelu_pk((f32x2){v0[2], v0[3]}), c = gelu_pk((f32x2){v1[0], v1[1]}), d = gelu_pk((f32x2){v1[2], v1[3]});
                        v0 = (f32x4){a.x, a.y, b.x, b.y}; v1 = (f32x4){c.x, c.y, d.x, d.y}; }
                    v0 = v0 * sc; v1 = v1 * sc; u32x4 w; w.x = cvt_pk_bf16(v0[0], v0[1]); w.y = cvt_pk_bf16(v0[2], v0[3]); w.z = cvt_pk_bf16(v1[0], v1[1]); w.w = cvt_pk_bf16(v1[2], v1[3]);
                    *(u32x4*)(rowp + bj * HALF) = w; } }
    }
};

template <class Epi, class Sched, bool ALIGN_EPI = false, bool SP2 = false>
__device__ __forceinline__ void gemm_phase(PG8_LAS unsigned char* lds, const Gemm g, const Sched& S, const Epi& E) {
    const int tid = threadIdx.x, wid = __builtin_amdgcn_readfirstlane(tid >> 6), lane = tid & 63, wr = wid >> 2, wc = wid & 3, fr = lane & 15, fq = lane >> 4;
    const int K = g.K, nt = K / BK;
    unsigned voffA[2], voffB[2];
#pragma unroll
    for (int i = 0; i < 2; ++i) { int R, C; stage_rc(tid * 16 + i * 8192, R, C); const int Rb = Epi::PERM ? ((R & ~31) + perm32(R & 31)) : R;
        voffA[i] = (unsigned)(R * g.lda + C) * 2u; voffB[i] = (unsigned)(Rb * K + C) * 2u; }
    const size_t kstep = (size_t)(BK * 2);
    const size_t hstepA = (size_t)HALF * g.lda * 2, hstepB = (size_t)HALF * K * 2;
    const size_t tstepA = 2 * hstepA, tstepB = 2 * hstepB;
    const unsigned ldsw = (unsigned)wid * 1024u;
    const int aoff = lds_byte(wr * 64 + fr, fq * 8), boff = lds_byte(wc * 32 + fr, fq * 8);
#define PG8_SA(b, h) (((b) * 2 + (h)) * HTB)
#define PG8_SB(b, h) ((4 + (b) * 2 + (h)) * HTB)
#define PG8_STAGE(bufoff, gbase, voff) do { _Pragma("unroll") for (int _i = 0; _i < 2; ++_i) \
        __builtin_amdgcn_global_load_lds((const unsigned*)((const char*)(gbase) + (voff)[_i]), (PG8_LAS unsigned*)(lds + (bufoff) + ldsw + _i * 8192), 16, 0, 0); } while (0)
#define PG8_LDA(dst, b, h) do { _Pragma("unroll") for (int m = 0; m < 4; ++m) _Pragma("unroll") for (int k = 0; k < 2; ++k) dst[m][k] = *(const PG8_LAS bf16x8*)(lds + PG8_SA(b, h) + aoff + m * 2048 + k * 1024); } while (0)
#define PG8_LDB(dst, b, h) do { _Pragma("unroll") for (int n = 0; n < 2; ++n) _Pragma("unroll") for (int k = 0; k < 2; ++k) dst[n][k] = *(const PG8_LAS bf16x8*)(lds + PG8_SB(b, h) + boff + n * 2048 + k * 1024); } while (0)
#define PG8_MMA(ai, bj, At, Bt) do { __builtin_amdgcn_s_setprio(1); _Pragma("unroll") for (int m = 0; m < 4; ++m) _Pragma("unroll") for (int n = 0; n < 2; ++n) _Pragma("unroll") for (int k = 0; k < 2; ++k) \
        acc[ai][bj][m][n] = __builtin_amdgcn_mfma_f32_16x16x32_bf16(Bt[n][k], At[m][k], acc[ai][bj][m][n], 0, 0, 0); __builtin_amdgcn_s_setprio(0); } while (0)
#define PG8_WAIT_V(n) asm volatile("s_waitcnt vmcnt(" #n ")" ::: "memory")
#define PG8_WAIT_L(n) asm volatile("s_waitcnt lgkmcnt(" #n ")" ::: "memory")
#define PG8_BAR __builtin_amdgcn_s_barrier()
#define PG8_SCHED __builtin_amdgcn_sched_barrier(0)
    Unit cur, nxt; int ui = 0;
    if (!S.next(0, cur)) return;
    f32x4 acc[2][2][4][2];
#pragma unroll
    for (int a = 0; a < 2; ++a)
#pragma unroll
        for (int b = 0; b < 2; ++b)
#pragma unroll
            for (int m = 0; m < 4; ++m)
#pragma unroll
                for (int n = 0; n < 2; ++n) acc[a][b][m][n] = (f32x4){0.f, 0.f, 0.f, 0.f};
    bf16x8 At[4][2], B0[2][2], B1[2][2];
    const char* cA = (const char*)g.A + (size_t)cur.pm * tstepA; const char* cB = (const char*)g.Bt + (size_t)cur.pn * tstepB;
    S.a_ready(cur);
    if constexpr (SP2) {
        PG8_STAGE(PG8_SB(0, 0), cB, voffB); PG8_STAGE(PG8_SB(0, 1), cB + hstepB, voffB); PG8_STAGE(PG8_SA(0, 0), cA, voffA); PG8_STAGE(PG8_SA(0, 1), cA + hstepA, voffA);
        if (wr == 1) PG8_BAR;
        PG8_WAIT_V(2); PG8_BAR;
        PG8_STAGE(PG8_SB(1, 0), cB + kstep, voffB); PG8_STAGE(PG8_SA(1, 0), cA + kstep, voffA); PG8_STAGE(PG8_SB(1, 1), cB + hstepB + kstep, voffB);
        PG8_WAIT_V(6); PG8_BAR;
    } else {
        PG8_STAGE(PG8_SB(0, 0), cB, voffB); PG8_STAGE(PG8_SA(0, 0), cA, voffA); PG8_STAGE(PG8_SB(0, 1), cB + hstepB, voffB); PG8_STAGE(PG8_SA(0, 1), cA + hstepA, voffA);
        if (wr == 1) PG8_BAR;
        PG8_WAIT_V(4); PG8_BAR;
        PG8_STAGE(PG8_SB(1, 0), cB + kstep, voffB); PG8_STAGE(PG8_SA(1, 0), cA + kstep, voffA); PG8_STAGE(PG8_SB(1, 1), cB + hstepB + kstep, voffB);
        PG8_WAIT_V(6); PG8_BAR;
    }
    for (;;) {
        const bool has_next = S.next(ui + 1, nxt);
        const char* nA = has_next ? (const char*)g.A + (size_t)nxt.pm * tstepA : cA; const char* nB = has_next ? (const char*)g.Bt + (size_t)nxt.pn * tstepB : cB;
        for (int t = 0; t < nt; t += 2) {
            const bool last = (t == nt - 2);
            const char* a1 = cA + (size_t)(t + 1) * kstep;
            const char* a2 = last ? nA : cA + (size_t)(t + 2) * kstep; const char* b2 = last ? nB : cB + (size_t)(t + 2) * kstep;
            const char* a3 = a2 + kstep; const char* b3 = b2 + kstep;
            if (last && has_next) S.a_ready(nxt);
            if constexpr (SP2) {
            PG8_LDB(B0, 0, 0); PG8_LDB(B1, 0, 1); PG8_SCHED; PG8_LDA(At, 0, 0); PG8_STAGE(PG8_SA(1, 1), a1 + hstepA, voffA);
            PG8_WAIT_V(8); PG8_WAIT_L(0); PG8_BAR; PG8_MMA(0, 0, At, B0); PG8_MMA(0, 1, At, B1); PG8_BAR; PG8_SCHED;
            PG8_LDA(At, 0, 1); PG8_STAGE(PG8_SB(0, 0), b2, voffB); PG8_STAGE(PG8_SB(0, 1), b2 + hstepB, voffB); PG8_STAGE(PG8_SA(0, 0), a2, voffA);
            PG8_WAIT_V(8); PG8_WAIT_L(0); PG8_BAR; PG8_MMA(1, 0, At, B0); PG8_MMA(1, 1, At, B1); PG8_BAR; PG8_SCHED;
            PG8_LDB(B0, 1, 0); PG8_LDB(B1, 1, 1); PG8_SCHED; PG8_LDA(At, 1, 0); PG8_STAGE(PG8_SA(0, 1), a2 + hstepA, voffA);
            PG8_WAIT_V(8); PG8_WAIT_L(0); PG8_BAR; PG8_MMA(0, 0, At, B0); PG8_MMA(0, 1, At, B1); PG8_BAR; PG8_SCHED;
            PG8_LDA(At, 1, 1); PG8_STAGE(PG8_SB(1, 0), b3, voffB); PG8_STAGE(PG8_SB(1, 1), b3 + hstepB, voffB); PG8_STAGE(PG8_SA(1, 0), a3, voffA);
            PG8_WAIT_V(8); PG8_WAIT_L(0); PG8_BAR; PG8_MMA(1, 0, At, B0); PG8_MMA(1, 1, At, B1); PG8_BAR; PG8_SCHED;
            } else {
            PG8_LDB(B0, 0, 0); PG8_SCHED; PG8_LDA(At, 0, 0); PG8_STAGE(PG8_SA(1, 1), a1 + hstepA, voffA);
            PG8_WAIT_L(8); PG8_BAR; PG8_WAIT_L(0); PG8_MMA(0, 0, At, B0); PG8_BAR; PG8_SCHED;
            PG8_LDB(B1, 0, 1); PG8_STAGE(PG8_SB(0, 0), b2, voffB);
            PG8_BAR; PG8_WAIT_L(0); PG8_MMA(0, 1, At, B1); PG8_BAR;
            PG8_LDA(At, 0, 1); PG8_STAGE(PG8_SA(0, 0), a2, voffA);
            PG8_BAR; PG8_WAIT_L(0); PG8_MMA(1, 0, At, B0); PG8_BAR; PG8_SCHED;
            PG8_STAGE(PG8_SB(0, 1), b2 + hstepB, voffB);
            PG8_WAIT_V(6); PG8_BAR; PG8_MMA(1, 1, At, B1); PG8_BAR;
            PG8_LDB(B0, 1, 0); PG8_SCHED; PG8_LDA(At, 1, 0); PG8_STAGE(PG8_SA(0, 1), a2 + hstepA, voffA);
            PG8_WAIT_L(8); PG8_BAR; PG8_WAIT_L(0); PG8_MMA(0, 0, At, B0); PG8_BAR; PG8_SCHED;
            PG8_LDB(B1, 1, 1); PG8_STAGE(PG8_SB(1, 0), b3, voffB);
            PG8_BAR; PG8_WAIT_L(0); PG8_MMA(0, 1, At, B1); PG8_BAR;
            PG8_LDA(At, 1, 1); PG8_STAGE(PG8_SA(1, 0), a3, voffA);
            PG8_BAR; PG8_WAIT_L(0); PG8_MMA(1, 0, At, B0); PG8_BAR; PG8_SCHED;
            PG8_STAGE(PG8_SB(1, 1), b3 + hstepB, voffB);
            PG8_WAIT_V(6); PG8_BAR; PG8_MMA(1, 1, At, B1); PG8_BAR;
            }
        }
        if constexpr (ALIGN_EPI) { if (wr == 0) PG8_BAR; }
        if constexpr (!Epi::AFTER_DRAIN) { E(acc, cur, wr, wc, fr, fq); S.done(cur); }
        if (!has_next) break;
#pragma unroll
        for (int a = 0; a < 2; ++a)
#pragma unroll
            for (int b = 0; b < 2; ++b)
#pragma unroll
                for (int m = 0; m < 4; ++m)
#pragma unroll
                    for (int n = 0; n < 2; ++n) acc[a][b][m][n] = (f32x4){0.f, 0.f, 0.f, 0.f};
        cur = nxt; cA = nA; cB = nB; ++ui;
        if constexpr (ALIGN_EPI) { if (wr == 1) PG8_BAR; }
    }
    PG8_WAIT_V(0);
    if constexpr (!ALIGN_EPI) { if (wr == 0) PG8_BAR; }
    PG8_BAR;
    if constexpr (Epi::AFTER_DRAIN) { E.fused(acc, cur, wr, wc, fr, fq, lds, wid, lane); S.done(cur); }
#undef PG8_SA
#undef PG8_SB
#undef PG8_STAGE
#undef PG8_LDA
#undef PG8_LDB
#undef PG8_MMA
#undef PG8_WAIT_V
#undef PG8_WAIT_L
#undef PG8_BAR
#undef PG8_SCHED
}
}
namespace pg8 {
struct Unit2 { int pm, pn, e, cnt, jt, ui; };
template <class E, class = void> struct has_perm16 { static constexpr bool value = false; };
template <class E> struct has_perm16<E, decltype((void)E::PERM16)> { static constexpr bool value = E::PERM16; };
template <class E> constexpr bool perm16() { return has_perm16<E>::value; }
template <class Epi, class Sched>
__device__ __forceinline__ void gemm_phase2(PG8_LAS unsigned char* lds, const bf16_t* Abase, int lda, int ldb, int K, const Sched& S, const Epi& E, int kstepA_ = BK * 2) {
    int tid_ = threadIdx.x; asm volatile("" : "+v"(tid_));
    const int tid = tid_, wid = __builtin_amdgcn_readfirstlane(tid >> 6), lane = tid & 63, wr = wid >> 2, wc = wid & 3, fr = lane & 15, fq = lane >> 4;
    int K_ = K; asm volatile("" : "+s"(K_));
    const int nt = K_ / BK;
    unsigned voffB0[2], voffB1[2];
#pragma unroll
    for (int i = 0; i < 2; ++i) { int R, C; stage_rc(tid * 16 + i * 8192, R, C);
        if constexpr (perm16<Epi>()) { const int cb = 64 * (R >> 5) + 16 * ((R >> 2) & 3) + 4 * ((R >> 4) & 1) + (R & 3); voffB0[i] = (unsigned)(cb * ldb + C) * 2u; voffB1[i] = (unsigned)((cb + 8) * ldb + C) * 2u; }
        else { const int Rb = Epi::PERM ? ((R & ~31) + perm32(R & 31)) : R; voffB0[i] = (unsigned)(Rb * ldb + C) * 2u; voffB1[i] = voffB0[i] + (unsigned)(HALF * ldb * 2); } }
    const unsigned lda2 = (unsigned)lda * 2u;
#define PG8_AOFFS(U, o0, o1) do { int t2_ = threadIdx.x; asm volatile("" : "+v"(t2_)); _Pragma("unroll") for (int i_ = 0; i_ < 2; ++i_) { int R_, C_; stage_rc(t2_ * 16 + i_ * 8192, R_, C_); \
        o0[i_] = (unsigned)S.arow(U, R_) * lda2 + (unsigned)C_ * 2u; o1[i_] = (unsigned)S.arow(U, HALF + R_) * lda2 + (unsigned)C_ * 2u; } } while (0)
    const size_t kstep = (size_t)(BK * 2), kstepA = (size_t)kstepA_;
    const unsigned ldsw = (unsigned)wid * 1024u;
    const int aoff = lds_byte(wr * 64 + fr, fq * 8), boff = lds_byte(wc * 32 + fr, fq * 8);
#define PG8_SA(b, h) (((b) * 2 + (h)) * HTB)
#define PG8_SB(b, h) ((4 + (b) * 2 + (h)) * HTB)
#define PG8_STAGE(bufoff, gbase, voff) do { _Pragma("unroll") for (int _i = 0; _i < 2; ++_i) \
        __builtin_amdgcn_global_load_lds((const unsigned*)((const char*)(gbase) + (voff)[_i]), (PG8_LAS unsigned*)(lds + (bufoff) + ldsw + _i * 8192), 16, 0, 0); } while (0)
#define PG8_LDA(dst, b, h) do { _Pragma("unroll") for (int m = 0; m < 4; ++m) _Pragma("unroll") for (int k = 0; k < 2; ++k) dst[m][k] = *(const PG8_LAS bf16x8*)(lds + PG8_SA(b, h) + aoff + m * 2048 + k * 1024); } while (0)
#define PG8_LDB(dst, b, h) do { _Pragma("unroll") for (int n = 0; n < 2; ++n) _Pragma("unroll") for (int k = 0; k < 2; ++k) dst[n][k] = *(const PG8_LAS bf16x8*)(lds + PG8_SB(b, h) + boff + n * 2048 + k * 1024); } while (0)
#define PG8_MMA(ai, bj, At, Bt) do { __builtin_amdgcn_s_setprio(1); _Pragma("unroll") for (int m = 0; m < 4; ++m) _Pragma("unroll") for (int n = 0; n < 2; ++n) _Pragma("unroll") for (int k = 0; k < 2; ++k) \
        acc[ai][bj][m][n] = __builtin_amdgcn_mfma_f32_16x16x32_bf16(Bt[n][k], At[m][k], acc[ai][bj][m][n], 0, 0, 0); __builtin_amdgcn_s_setprio(0); } while (0)
#define PG8_WAIT_V(n) asm volatile("s_waitcnt vmcnt(" #n ")" ::: "memory")
#define PG8_WAIT_L(n) asm volatile("s_waitcnt lgkmcnt(" #n ")" ::: "memory")
#define PG8_BAR __builtin_amdgcn_s_barrier()
#define PG8_SCHED __builtin_amdgcn_sched_barrier(0)
    Unit2 cur, nxt; int ui = 0;
    if (!S.next(0, cur)) return;
    f32x4 acc[2][2][4][2];
#pragma unroll
    for (int a = 0; a < 2; ++a)
#pragma unroll
        for (int b = 0; b < 2; ++b)
#pragma unroll
            for (int m = 0; m < 4; ++m)
#pragma unroll
                for (int n = 0; n < 2; ++n) acc[a][b][m][n] = (f32x4){0.f, 0.f, 0.f, 0.f};
    bf16x8 At[4][2], B0[2][2], B1[2][2];
    unsigned cv0[2], cv1[2], nv0[2], nv1[2];
    PG8_AOFFS(cur, cv0, cv1);
    const char* cA = (const char*)Abase + S.aoff(cur); const char* cB = S.bptr(cur);
    PG8_STAGE(PG8_SB(0, 0), cB, voffB0); PG8_STAGE(PG8_SB(0, 1), cB, voffB1); PG8_STAGE(PG8_SA(0, 0), cA, cv0); PG8_STAGE(PG8_SA(0, 1), cA, cv1);
    if (wr == 1) PG8_BAR;
    PG8_WAIT_V(2); PG8_BAR;
    PG8_STAGE(PG8_SB(1, 0), cB + kstep, voffB0); PG8_STAGE(PG8_SA(1, 0), cA + kstepA, cv0); PG8_STAGE(PG8_SB(1, 1), cB + kstep, voffB1);
    PG8_WAIT_V(6); PG8_BAR;
    for (;;) {
        const bool has_next = S.next(ui + 1, nxt);
        const char* nA = has_next ? (const char*)Abase + S.aoff(nxt) : cA; const char* nB = has_next ? S.bptr(nxt) : cB;
#pragma unroll
        for (int i = 0; i < 2; ++i) { nv0[i] = cv0[i]; nv1[i] = cv1[i]; }
        if (has_next) PG8_AOFFS(nxt, nv0, nv1);
        const bool act0 = cur.cnt > wr * 64, act1 = cur.cnt > HALF + wr * 64;
        for (int t = 0; t < nt; t += 2) {
            const bool last = (t == nt - 2);
            const char* a1 = cA + (size_t)(t + 1) * kstepA;
            const char* a2 = last ? nA : cA + (size_t)(t + 2) * kstepA; const char* b2 = last ? nB : cB + (size_t)(t + 2) * kstep;
            const char* a3 = a2 + kstepA; const char* b3 = b2 + kstep;
            unsigned s0[2] = {cv0[0], cv0[1]}, s1[2] = {cv1[0], cv1[1]};
            if (last) { asm volatile("" ::: "memory"); s0[0] = nv0[0]; s0[1] = nv0[1]; s1[0] = nv1[0]; s1[1] = nv1[1]; }
            PG8_LDB(B0, 0, 0); PG8_LDB(B1, 0, 1); PG8_SCHED; PG8_LDA(At, 0, 0); PG8_STAGE(PG8_SA(1, 1), a1, cv1);
            PG8_WAIT_V(8); PG8_WAIT_L(0); PG8_BAR; if (act0) { PG8_MMA(0, 0, At, B0); PG8_MMA(0, 1, At, B1); } PG8_BAR; PG8_SCHED;
            PG8_LDA(At, 0, 1); PG8_STAGE(PG8_SB(0, 0), b2, voffB0); PG8_STAGE(PG8_SB(0, 1), b2, voffB1); PG8_STAGE(PG8_SA(0, 0), a2, s0);
            PG8_WAIT_V(8); PG8_WAIT_L(0); PG8_BAR; if (act1) { PG8_MMA(1, 0, At, B0); PG8_MMA(1, 1, At, B1); } PG8_BAR; PG8_SCHED;
            PG8_LDB(B0, 1, 0); PG8_LDB(B1, 1, 1); PG8_SCHED; PG8_LDA(At, 1, 0); PG8_STAGE(PG8_SA(0, 1), a2, s1);
            PG8_WAIT_V(8); PG8_WAIT_L(0); PG8_BAR; if (act0) { PG8_MMA(0, 0, At, B0); PG8_MMA(0, 1, At, B1); } PG8_BAR; PG8_SCHED;
            PG8_LDA(At, 1, 1); PG8_STAGE(PG8_SB(1, 0), b3, voffB0); PG8_STAGE(PG8_SB(1, 1), b3, voffB1); PG8_STAGE(PG8_SA(1, 0), a3, s0);
            PG8_WAIT_V(8); PG8_WAIT_L(0); PG8_BAR; if (act1) { PG8_MMA(1, 0, At, B0); PG8_MMA(1, 1, At, B1); } PG8_BAR; PG8_SCHED;
        }
        if (wr == 0) PG8_BAR;
        { Unit2 eu = cur; asm volatile("" : "+s"(eu.pm), "+s"(eu.pn), "+s"(eu.e), "+s"(eu.cnt), "+s"(eu.jt), "+s"(eu.ui));
          E(acc, eu, wr, wc, fr, fq);
          }
        if (!has_next) break;
#pragma unroll
        for (int a = 0; a < 2; ++a)
#pragma unroll
            for (int b = 0; b < 2; ++b)
#pragma unroll
                for (int m = 0; m < 4; ++m)
#pragma unroll
                    for (int n = 0; n < 2; ++n) acc[a][b][m][n] = (f32x4){0.f, 0.f, 0.f, 0.f};
        cur = nxt; cA = nA; cB = nB; ++ui;
#pragma unroll
        for (int i = 0; i < 2; ++i) { cv0[i] = nv0[i]; cv1[i] = nv1[i]; }
        if (wr == 1) PG8_BAR;
    }
    PG8_WAIT_V(0);
    PG8_BAR;
#undef PG8_AOFFS
#undef PG8_SA
#undef PG8_SB
#undef PG8_STAGE
#undef PG8_LDA
#undef PG8_LDB
#undef PG8_MMA
#undef PG8_WAIT_V
#undef PG8_WAIT_L
#undef PG8_BAR
#undef PG8_SCHED
}

struct DenseSched {
    StaticOrder so; const bf16_t* Bt; int ldb;
    __device__ __forceinline__ bool next(int i, Unit2& u) const { Unit t; if (!so.next(i, t)) return false; u.pm = t.pm; u.pn = t.pn; u.e = 0; u.cnt = 256; u.jt = 0; u.ui = i; return true; }
    __device__ __forceinline__ int arow(const Unit2& u, int r) const { return u.pm * BM + r; }
    __device__ __forceinline__ size_t aoff(const Unit2&) const { return 0; }
    __device__ __forceinline__ const char* bptr(const Unit2& u) const { return (const char*)(Bt + (size_t)u.pn * BM * ldb); }
};
struct EpiPlainBf16 {
    static constexpr bool PERM = true, AFTER_DRAIN = false;
    bf16_t* O; int ldc;
    __device__ __forceinline__ void operator()(const f32x4 (&acc)[2][2][4][2], const Unit2& u, int wr, int wc, int fr, int fq) const {
        const int row0 = u.pm * BM + wr * 64 + fr, col0 = u.pn * BM + wc * 32 + 8 * fq;
#pragma unroll
        for (int ai = 0; ai < 2; ++ai)
#pragma unroll
            for (int m = 0; m < 4; ++m) { bf16_t* rowp = O + (size_t)(row0 + ai * HALF + m * 16) * ldc + col0;
#pragma unroll
                for (int bj = 0; bj < 2; ++bj) { const f32x4 v0 = acc[ai][bj][m][0], v1 = acc[ai][bj][m][1];
                    u32x4 w; w.x = cvt_pk_bf16(v0[0], v0[1]); w.y = cvt_pk_bf16(v0[2], v0[3]); w.z = cvt_pk_bf16(v1[0], v1[1]); w.w = cvt_pk_bf16(v1[2], v1[3]);
                    *(u32x4*)(rowp + bj * HALF) = w; } }
    }
};
}
namespace nv {
constexpr int D = 1024, B = 8, S = 4096, T = B * S;
constexpr int FH = 8, FD = 64, GH = 4, GK = 64, GV = 128, RANK = 16;
constexpr int INW = 3096;
constexpr int O_FQ = 0, O_FK = 512, O_FV = 1024, O_FF = 1536, O_GQ = 1544, O_GK = 1800, O_GV = 2056, O_GA = 2568, O_GR = 2584;
constexpr int NE = 256, NG = 8, TOPK = 8, ED = 256;
constexpr float LN_EPS = 1e-5f;
constexpr float ALPHA = 1.189207115002721f;
constexpr int PADR = 64;
constexpr int APAD = T * TOPK + NE * PADR;

__device__ __forceinline__ float logsigmoidf(float x) { return fminf(x, 0.f) - log1pf(expf(-fabsf(x))); }
__device__ __forceinline__ float siluf(float x) { return x / (1.f + expf(-x)); }

}
#include <hip/hip_bf16.h>
#include <cmath>
namespace attn_body {
using bf16=__hip_bfloat16;
using bf16x8=__attribute__((ext_vector_type(8)))short;
using s16x4=__attribute__((ext_vector_type(4)))short;
using f32x16=__attribute__((ext_vector_type(16)))float;
using u32x4=__attribute__((ext_vector_type(4)))unsigned;
constexpr int BATCH=8,NHEAD=8,SEQ=4096,D=64,DM=3072,OPITCH=1024;
constexpr int NW=8,QBLK=32,QB=QBLK*NW,KVBLK=64,NQB=SEQ/QB;
constexpr int ATTN_PITCH=DM, ATTN_UNIT_ROWS=QB;
__device__ __forceinline__ int crow(int r,int hi){return (r&3)+8*(r>>2)+4*hi;}
#define SBAR() __builtin_amdgcn_sched_barrier(0)
__device__ __forceinline__ void cmask(f32x16&p0,f32x16&p1,int jb,int qrel,int hi){
  const float NEG=-INFINITY; int kb=64*jb+4*hi;
  #pragma unroll
  for(int r=0;r<16;++r){int kv=kb+(r&3)+8*(r>>2); if(kv>qrel)p0[r]=NEG; if(kv+32>qrel)p1[r]=NEG;}
}

constexpr int NSLOT=3, SLOTB=8192;
constexpr int LDS_K=0, LDS_V=NSLOT*SLOTB, LDS_WS=2*NSLOT*SLOTB, LDS_OST=LDS_WS+NW*64*4, LDS_KB=LDS_OST+NW*4096, LDS_BYTES=LDS_KB+(SEQ+2)*8;
constexpr float C2=0.125f*1.4426950408889634f;
__device__ __forceinline__ void glds16(const void*gsrc,unsigned lds_dst){unsigned keep;
  asm volatile("s_mov_b32 %0, m0\n\ts_mov_b32 m0, %2\n\ts_nop 0\n\tglobal_load_lds_dwordx4 %1, off\n\ts_mov_b32 m0, %0":"=&s"(keep):"v"(gsrc),"s"(lds_dst):"memory");}
__device__ __forceinline__ float max3f(float a,float b,float c){float r;asm("v_max3_f32 %0, %1, %2, %3":"=v"(r):"v"(a),"v"(b),"v"(c));return r;}
__device__ __forceinline__ float max2f(float a,float b){float r;asm("v_max_f32_e32 %0, %1, %2":"=v"(r):"v"(a),"v"(b));return r;}
__device__ __forceinline__ float fadd_s(float a,float b){float r;asm("v_add_f32_e32 %0, %1, %2":"=v"(r):"v"(a),"v"(b));return r;}
__device__ __forceinline__ float fsub_s(float a,float b){float r;asm("v_sub_f32_e32 %0, %1, %2":"=v"(r):"v"(a),"v"(b));return r;}
typedef float f32x2_t __attribute__((ext_vector_type(2))); typedef float f32x4_t __attribute__((ext_vector_type(4))); typedef __bf16 bf16x2_t __attribute__((ext_vector_type(2)));
__device__ __forceinline__ unsigned cvtpk_s(float lo,float hi){f32x2_t v={lo,hi};bf16x2_t b=__builtin_convertvector(v,bf16x2_t);return __builtin_bit_cast(unsigned,b);}
#define WAIT_BAR(N) asm volatile("s_waitcnt vmcnt(" #N ") lgkmcnt(0)\n\ts_barrier":::"memory")

__device__ __forceinline__ void split3(float b,unsigned&h,unsigned&m,unsigned&l){
  h=cvtpk_s(b,0.f)&0xffffu; const float r1=b-__uint_as_float(h<<16);
  m=cvtpk_s(r1,0.f)&0xffffu; const float r2=r1-__uint_as_float(m<<16);
  l=cvtpk_s(r2,0.f)&0xffffu; }
__device__ __forceinline__ bf16x8 kbias_frag(float b,int hi){unsigned h,m,l;split3(b,h,m,l);u32x4 w;w.x=h|(m<<16);w.y=l|0x3F800000u;w.z=0x3F803F80u;w.w=0u;if(hi){w.x=0u;w.y=0u;w.z=0u;}return __builtin_bit_cast(bf16x8,w);}
__device__ __forceinline__ bf16x8 qref_frag(float x,int hi){unsigned h,m,l;split3(x,h,m,l);u32x4 w;w.x=0x3F803F80u;w.y=0x3F80u|(h<<16);w.z=m|(l<<16);w.w=0u;if(hi){w.x=0u;w.y=0u;w.z=0u;}return __builtin_bit_cast(bf16x8,w);}
typedef unsigned u32x2_t __attribute__((ext_vector_type(2)));
__device__ __forceinline__ bf16x8 mkfrag(u32x2_t e,unsigned zc){u32x4 w;w.x=e.x;w.y=e.y;w.z=zc;w.w=0u;return __builtin_bit_cast(bf16x8,w);}
__device__ __forceinline__ void fox_bias_table(int b,int h,const float*LF,char*shm){
  int tid_=threadIdx.x; asm volatile("":"+v"(tid_)); const int tid=tid_,lane=tid&63,wid=__builtin_amdgcn_readfirstlane(tid>>6);
  const float*lf=LF+((long)b*NHEAD+h)*SEQ; float*wt=(float*)(shm+LDS_WS); u32x2_t*KB8=(u32x2_t*)(shm+LDS_KB);
  f32x4_t va=*(const f32x4_t*)(lf+8*tid),vb=*(const f32x4_t*)(lf+8*tid+4);
  va[1]+=va[0];va[2]+=va[1];va[3]+=va[2];vb[0]+=va[3];vb[1]+=vb[0];vb[2]+=vb[1];vb[3]+=vb[2];
  const float tot=vb[3]; float inc=tot;
  #pragma unroll
  for(int o_=1;o_<64;o_<<=1){const float nn=__shfl_up(inc,o_);if(lane>=o_)inc+=nn;}
  __syncthreads();
  if(lane==63)wt[wid*64]=inc;
  __syncthreads();
  float base=inc-tot;
  #pragma unroll
  for(int w_=0;w_<NW;++w_){const float x_=wt[w_*64]; if(w_<wid)base+=x_;}
  const float cv[8]={va[0]+base,va[1]+base,va[2]+base,va[3]+base,vb[0]+base,vb[1]+base,vb[2]+base,vb[3]+base};
  #pragma unroll
  for(int j=0;j<8;++j){unsigned hh,mm,ll;split3(-cv[j],hh,mm,ll);KB8[8*tid+j]=(u32x2_t){hh|(mm<<16),ll|0x3F800000u};}
  if(tid==0){KB8[SEQ]=(u32x2_t){0u,0u};KB8[SEQ+1]=(u32x2_t){0u,0u};}
  __syncthreads();
}
__device__ __forceinline__ void qkt(f32x16&p0,f32x16&p1,const char*Kslot,const bf16x8*qr,bf16x8 kb0,bf16x8 kb1,bf16x8 qx,int r32,int hi){
  const f32x16 negm=f32x16{};
  const char*kb=Kslot+hi*1024+r32*16;
  #pragma unroll
  for(int d0=0;d0<4;++d0){
    const bf16x8 b0=*reinterpret_cast<const bf16x8*>(kb+d0*2048);
    const bf16x8 b1=*reinterpret_cast<const bf16x8*>(kb+d0*2048+512);
    if(d0==0){p0=__builtin_amdgcn_mfma_f32_32x32x16_bf16(b0,qr[0],negm,0,0,0);p1=__builtin_amdgcn_mfma_f32_32x32x16_bf16(b1,qr[0],negm,0,0,0);}
    else{p0=__builtin_amdgcn_mfma_f32_32x32x16_bf16(b0,qr[d0],p0,0,0,0);p1=__builtin_amdgcn_mfma_f32_32x32x16_bf16(b1,qr[d0],p1,0,0,0);}}
  p0=__builtin_amdgcn_mfma_f32_32x32x16_bf16(kb0,qx,p0,0,0,0);p1=__builtin_amdgcn_mfma_f32_32x32x16_bf16(kb1,qx,p1,0,0,0);
}
typedef __attribute__((address_space(3))) const char* lds_cptr;
typedef short v4i16_t __attribute__((ext_vector_type(4)));
__device__ __forceinline__ void kload8(bf16x8*kf,lds_cptr kp){
  kf[0]=*(const __attribute__((address_space(3))) bf16x8*)(kp);      kf[1]=*(const __attribute__((address_space(3))) bf16x8*)(kp+512);
  kf[2]=*(const __attribute__((address_space(3))) bf16x8*)(kp+2048); kf[3]=*(const __attribute__((address_space(3))) bf16x8*)(kp+2560);
  kf[4]=*(const __attribute__((address_space(3))) bf16x8*)(kp+4096); kf[5]=*(const __attribute__((address_space(3))) bf16x8*)(kp+4608);
  kf[6]=*(const __attribute__((address_space(3))) bf16x8*)(kp+6144); kf[7]=*(const __attribute__((address_space(3))) bf16x8*)(kp+6656);
}
__device__ __forceinline__ void kload2(bf16x8*kf,lds_cptr kp,int j){ kf[2*j]=*(const __attribute__((address_space(3))) bf16x8*)(kp+j*2048); kf[2*j+1]=*(const __attribute__((address_space(3))) bf16x8*)(kp+j*2048+512); }
__device__ __forceinline__ s16x4 vtr(lds_cptr p){ return __builtin_bit_cast(s16x4,__builtin_amdgcn_ds_read_tr16_b64_v4i16((__attribute__((address_space(3))) v4i16_t*)p)); }
__device__ __forceinline__ float rowmax(const f32x16&p0,const f32x16&p1){
  float a=max3f(p0[0],p0[1],p1[0]),b=max3f(p0[2],p0[3],p1[1]);a=max3f(a,p1[2],p1[3]);
  #pragma unroll
  for(int r=4;r<16;r+=4){a=max3f(a,p0[r],p0[r+1]);b=max3f(b,p0[r+2],p0[r+3]);a=max3f(a,p1[r],p1[r+1]);b=max3f(b,p1[r+2],p1[r+3]);}
  const float m=max2f(a,b);
  auto rr=__builtin_amdgcn_permlane32_swap(__float_as_uint(m),__float_as_uint(m),false,false);
  return max2f(__uint_as_float(rr[0]),__uint_as_float(rr[1]));
}
__device__ __forceinline__ void pv(f32x16*o,int vb,bf16x8 pa0,bf16x8 pa1,bf16x8 pa2,bf16x8 pa3){
  #pragma unroll
  for(int d0=0;d0<2;++d0){s16x4 lo[4],hi[4];
    #pragma unroll
    for(int ks=0;ks<4;++ks){
      asm volatile("ds_read_b64_tr_b16 %0,%1 offset:%c2":"=&v"(lo[ks]):"v"(vb),"i"(d0*4096+ks*1024):"memory");
      asm volatile("ds_read_b64_tr_b16 %0,%1 offset:%c2":"=&v"(hi[ks]):"v"(vb),"i"(d0*4096+ks*1024+512):"memory");}
    asm volatile("s_waitcnt lgkmcnt(0)":::"memory");SBAR();
    #define PK(k) (bf16x8){lo[k][0],lo[k][1],lo[k][2],lo[k][3],hi[k][0],hi[k][1],hi[k][2],hi[k][3]}
    o[d0]=__builtin_amdgcn_mfma_f32_32x32x16_bf16(pa0,PK(0),o[d0],0,0,0);
    o[d0]=__builtin_amdgcn_mfma_f32_32x32x16_bf16(pa1,PK(1),o[d0],0,0,0);
    o[d0]=__builtin_amdgcn_mfma_f32_32x32x16_bf16(pa2,PK(2),o[d0],0,0,0);
    o[d0]=__builtin_amdgcn_mfma_f32_32x32x16_bf16(pa3,PK(3),o[d0],0,0,0);
    #undef PK
  }
}

#ifndef ATTN_STORE16
#define ATTN_STORE16(p,v) (*(u32x4*)(p)=(v))
#endif
template<int THRL> __device__ __forceinline__ void attn_unit(int b,int h,int qb,const bf16*Q,const bf16* K,const bf16* V,bf16*O,const float*LF,const unsigned*NRM,char*shm){
  int tid_=threadIdx.x; asm volatile("":"+v"(tid_));
  const int tid=tid_,lane=tid&63,r32=lane&31,hi=lane>>5; const int wid=__builtin_amdgcn_readfirstlane(tid>>6);
  const long rowbase=(long)b*SEQ; const int q0=qb*QB;
  const char*KBt0=shm+LDS_KB;
  int t0;
  { const int NT0=(q0+QB)/KVBLK; const unsigned*nr=NRM+(b*NHEAD+h)*4;
    const float qn2=__uint_as_float(nr[0])+__uint_as_float(nr[1]), kn2=__uint_as_float(nr[2])+__uint_as_float(nr[3]);
    const float thr=-(50.f+2.04f*sqrtf(qn2*kn2));
    const u32x2_t eq0=*(const u32x2_t*)(KBt0+(unsigned)q0*8u); const float bq0=__uint_as_float(eq0.x<<16)+__uint_as_float(eq0.x&0xffff0000u)+__uint_as_float(eq0.y<<16);
    bool ok=(2*lane<=NT0-4);
    if(ok&&lane>0){ const u32x2_t el=*(const u32x2_t*)(KBt0+(unsigned)(128*lane-1)*8u); const float bl=__uint_as_float(el.x<<16)+__uint_as_float(el.x&0xffff0000u)+__uint_as_float(el.y<<16); ok=(bl-bq0<thr); }
    const unsigned long long mk=__ballot(ok); const unsigned long long low=~mk; const int cnt=(low==0ull)?64:__builtin_ctzll(low);
    t0=__builtin_amdgcn_readfirstlane(2*(cnt-1)); }
  const char*KBt=KBt0+(hi?0:t0*512); const unsigned kb_o0=hi?(unsigned)SEQ*8u:(unsigned)r32*8u, kb_o1=hi?(unsigned)SEQ*8u:(unsigned)(r32+32)*8u, kb_str=hi?0u:512u, zc=hi?0u:0x3F803F80u;
  const bf16*Qw=Q+(rowbase+q0+wid*QBLK)*DM+h*D;
  const bf16*Kh=K+(rowbase+(long)t0*KVBLK)*DM+h*D,*Vh=V+(rowbase+(long)t0*KVBLK)*DM+h*D;
  const unsigned lds0=(unsigned)(uintptr_t)shm;
  float*wsf=(float*)(shm+LDS_WS)+wid*64;
  const bf16*ksrc=Kh+(long)lane*DM+wid*8;
  const bf16*vsrc=Vh+(long)(16*(wid&3)+(lane>>2))*DM+(wid>>2)*32+(lane&3)*8;
  const unsigned kdst=lds0+LDS_K+wid*1024, vdst=lds0+LDS_V+wid*1024;
  #define DMA_K(t,slot) glds16(ksrc+(long)(t)*KVBLK*DM,(unsigned)__builtin_amdgcn_readfirstlane(kdst+(slot)))
  #define DMA_V(t,slot) glds16(vsrc+(long)(t)*KVBLK*DM,(unsigned)__builtin_amdgcn_readfirstlane(vdst+(slot)))
  const int vb0=(int)(lds0+LDS_V)+((lane>>4)&1)*32+(lane&3)*8+(4*hi+((lane&15)>>2))*64;
  const char*Kbase=shm+LDS_K; bf16x8 kf[8];
  const lds_cptr shm3=(lds_cptr)shm; const lds_cptr kp0=shm3+LDS_K+hi*1024+r32*16; const lds_cptr vp0=shm3+LDS_V+((lane>>4)&1)*32+(lane&3)*8+(4*hi+((lane&15)>>2))*64;
  const int NT=(q0+QB)/KVBLK-t0;
  DMA_K(0,0);DMA_V(0,0);DMA_K(1,SLOTB);
  bf16x8 qr[4];
  #pragma unroll
  for(int d0=0;d0<4;++d0)qr[d0]=*reinterpret_cast<const bf16x8*>(&Qw[(long)r32*DM+d0*16+hi*8]);
  float mhat; { const u32x2_t eq=*(const u32x2_t*)(KBt0+(unsigned)(q0+wid*QBLK+r32)*8u); mhat=__uint_as_float(eq.x<<16)+__uint_as_float(eq.x&0xffff0000u)+__uint_as_float(eq.y<<16); }
  float l_reg=0.f;f32x16 o[2];o[0]=f32x16{};o[1]=f32x16{};const f32x16 negm=f32x16{};
  bf16x8 qx=qref_frag(-mhat,hi);
  const int qrel=wid*QBLK+r32;
  #define CMASK(P0,P1,t) do{int jb_=(t)-(NT-4); if(jb_>=0)cmask(P0,P1,jb_,qrel,hi);}while(0)
  bool resc=false;
  #define START(P0,P1) do{ const float rm=rowmax(P0,P1); resc=false; \
    { const float dl=__builtin_fmaxf(rm,0.f); mhat=fadd_s(mhat,dl); \
      _Pragma("unroll") for(int r=0;r<16;++r){P0[r]=fsub_s(P0[r],dl);P1[r]=fsub_s(P1[r],dl);} \
      qx=qref_frag(-mhat,hi); } \
    _Pragma("unroll") for(int r=0;r<16;++r)P0[r]=__builtin_amdgcn_exp2f(P0[r]); }while(0)
  #define RESC() do{ if(resc){ asm volatile("s_waitcnt lgkmcnt(0)":::"memory"); \
      _Pragma("unroll") for(int d_=0;d_<2;++d_) _Pragma("unroll") for(int r=0;r<16;++r)o[d_][r]*=wsf[crow(r,hi)]; } }while(0)
  f32x16 pA0,pA1,pB0,pB1;
  int sl_prev=0,sl_cur=0,sl_next=SLOTB;
  #define ROT() do{sl_prev=sl_cur;sl_cur=sl_next;sl_next=(sl_next==(NSLOT-1)*SLOTB)?0:sl_next+SLOTB;}while(0)
  DMA_K(2,2*SLOTB);
  WAIT_BAR(3);
  qkt(pA0,pA1,Kbase,qr,mkfrag(*(const u32x2_t*)(KBt+kb_o0),zc),mkfrag(*(const u32x2_t*)(KBt+kb_o1),zc),qx,r32,hi);asm volatile("s_nop 15\n\ts_nop 7":"+v"(pA0),"+v"(pA1));CMASK(pA0,pA1,0);
  START(pA0,pA1);
  _Pragma("unroll") for(int r=0;r<16;++r)pA1[r]=__builtin_amdgcn_exp2f(pA1[r]);
  WAIT_BAR(0);
  DMA_K(3,0);DMA_V(1,SLOTB);
  ROT();
  kload8(kf,kp0+sl_cur);
  WAIT_BAR(2);
  s16x4 vlo[8],vhi[8]; u32x4 pw0,pw1,pw2,pw3;
  #define PKW(P,B) cvtpk_s(P[B],P[B+1])
  #define PAF(k) __builtin_bit_cast(bf16x8,pw##k)
  #define VFR(i) (bf16x8){vlo[i][0],vlo[i][1],vlo[i][2],vlo[i][3],vhi[i][0],vhi[i][1],vhi[i][2],vhi[i][3]}
  #define PIN(x) asm volatile("":"+v"(x))
  #define MX3(a,b,c) __builtin_fmaxf(__builtin_fmaxf((a),(b)),(c))
  #define GAPA(MF,A0,A1,A2,A3,W0,W1,PW) do{ MF; sacc+=A0; sacc+=A1; sacc+=A2; sacc+=A3; PIN(sacc); W0; W1; PIN(PW); SBAR(); }while(0)
  #define EX(v) __builtin_amdgcn_exp2f(v)
  #define GAPB(MF,X,B) do{ MF; X[B]=EX(X[B]); X[B+1]=EX(X[B+1]); X[B+2]=EX(X[B+2]); X[B+3]=EX(X[B+3]); PIN(X); SBAR(); }while(0)
  #define VRD(i) do{ vlo[i]=vtr(vp_+(((i)>>2)*4096+((i)&3)*1024)); vhi[i]=vtr(vp_+(((i)>>2)*4096+((i)&3)*1024+512)); }while(0)
  #define KRD(G,j) do{ if(G){ kload2(kf,kp0+sl_next,j); SBAR(); } }while(0)
  #define STEP(C0,C1,P0,P1,t,GK,GV,GL) do{ SBAR(); \
    const lds_cptr vp_=vp0+sl_prev; const u32x2_t e0_=*(const u32x2_t*)(KBt+kb_o0+(unsigned)(t)*kb_str),e1_=*(const u32x2_t*)(KBt+kb_o1+(unsigned)(t)*kb_str); \
    VRD(0); SBAR(); float sacc=(P0[0]+P0[1]); \
    GAPA(C0=__builtin_amdgcn_mfma_f32_32x32x16_bf16(kf[0],qr[0],negm,0,0,0), P0[2],P0[3],P0[4],P0[5],     pw0[0]=PKW(P0,0), pw0[1]=PKW(P0,2), pw0); \
    VRD(4); SBAR(); GAPA(C1=__builtin_amdgcn_mfma_f32_32x32x16_bf16(kf[1],qr[0],negm,0,0,0), P0[6],P0[7],P0[8],P0[9],     pw0[2]=PKW(P0,4), pw0[3]=PKW(P0,6), pw0); \
    VRD(1); SBAR(); GAPA(C0=__builtin_amdgcn_mfma_f32_32x32x16_bf16(kf[2],qr[1],C0,0,0,0),   P0[10],P0[11],P0[12],P0[13], pw1[0]=PKW(P0,8), pw1[1]=PKW(P0,10), pw1); \
    VRD(5); SBAR(); GAPA(C1=__builtin_amdgcn_mfma_f32_32x32x16_bf16(kf[3],qr[1],C1,0,0,0),   P0[14],P0[15],P1[0],P1[1],   pw1[2]=PKW(P0,12),pw1[3]=PKW(P0,14), pw1); \
    VRD(2); SBAR(); GAPA(C0=__builtin_amdgcn_mfma_f32_32x32x16_bf16(kf[4],qr[2],C0,0,0,0),   P1[2],P1[3],P1[4],P1[5],     pw2[0]=PKW(P1,0), pw2[1]=PKW(P1,2), pw2); \
    VRD(6); SBAR(); GAPA(C1=__builtin_amdgcn_mfma_f32_32x32x16_bf16(kf[5],qr[2],C1,0,0,0),   P1[6],P1[7],P1[8],P1[9],     pw2[2]=PKW(P1,4), pw2[3]=PKW(P1,6), pw2); \
    VRD(3); SBAR(); GAPA(C0=__builtin_amdgcn_mfma_f32_32x32x16_bf16(kf[6],qr[3],C0,0,0,0),   P1[10],P1[11],P1[12],P1[13], pw3[0]=PKW(P1,8), pw3[1]=PKW(P1,10), pw3); \
    VRD(7); SBAR(); GAPA(C1=__builtin_amdgcn_mfma_f32_32x32x16_bf16(kf[7],qr[3],C1,0,0,0),   P1[14],P1[15],0.f,0.f,       pw3[2]=PKW(P1,12),pw3[3]=PKW(P1,14), pw3); \
    { const bf16x8 kb0_=mkfrag(e0_,zc),kb1_=mkfrag(e1_,zc); C0=__builtin_amdgcn_mfma_f32_32x32x16_bf16(kb0_,qx,C0,0,0,0); C1=__builtin_amdgcn_mfma_f32_32x32x16_bf16(kb1_,qx,C1,0,0,0); } SBAR(); \
    l_reg+=sacc; \
    if(GK){DMA_K((t)+3,sl_cur);} if(GV){DMA_V((t)+1,sl_next);} \
    CMASK(C0,C1,t); \
    { float a=MX3(C0[0],C0[1],C1[0]),b=MX3(C0[2],C0[3],C1[1]); a=MX3(a,C1[2],C1[3]); \
      _Pragma("unroll") for(int r=4;r<16;r+=4){a=MX3(a,C0[r],C0[r+1]);b=MX3(b,C0[r+2],C0[r+3]);a=MX3(a,C1[r],C1[r+1]);b=MX3(b,C1[r+2],C1[r+3]);} \
      float rm=__builtin_fmaxf(a,b); { auto rr=__builtin_amdgcn_permlane32_swap(__float_as_uint(rm),__float_as_uint(rm),false,false); rm=__builtin_fmaxf(__uint_as_float(rr[0]),__uint_as_float(rr[1])); } \
      resc=false; \
      if(__builtin_expect(__any(rm>(float)THRL),0)){ const float dl=__builtin_fmaxf(rm,0.f); mhat+=dl; \
        _Pragma("unroll") for(int r=0;r<16;++r){C0[r]-=dl;C1[r]-=dl;} \
        qx=qref_frag(-mhat,hi); \
        const float f=__builtin_amdgcn_exp2f(-dl); l_reg*=f; if(hi==0)wsf[r32]=f; resc=true; } } \
    SBAR(); \
    GAPB(o[0]=__builtin_amdgcn_mfma_f32_32x32x16_bf16(PAF(0),VFR(0),o[0],0,0,0), C0,0); \
    GAPB(o[1]=__builtin_amdgcn_mfma_f32_32x32x16_bf16(PAF(0),VFR(4),o[1],0,0,0), C0,4); \
    KRD(GL,0); GAPB(o[0]=__builtin_amdgcn_mfma_f32_32x32x16_bf16(PAF(1),VFR(1),o[0],0,0,0), C0,8); \
    KRD(GL,1); GAPB(o[1]=__builtin_amdgcn_mfma_f32_32x32x16_bf16(PAF(1),VFR(5),o[1],0,0,0), C0,12); \
    KRD(GL,2); GAPB(o[0]=__builtin_amdgcn_mfma_f32_32x32x16_bf16(PAF(2),VFR(2),o[0],0,0,0), C1,0); \
    KRD(GL,3); GAPB(o[1]=__builtin_amdgcn_mfma_f32_32x32x16_bf16(PAF(2),VFR(6),o[1],0,0,0), C1,4); \
    GAPB(o[0]=__builtin_amdgcn_mfma_f32_32x32x16_bf16(PAF(3),VFR(3),o[0],0,0,0), C1,8); \
    GAPB(o[1]=__builtin_amdgcn_mfma_f32_32x32x16_bf16(PAF(3),VFR(7),o[1],0,0,0), C1,12); \
    }while(0)
  int t=1;
  #undef CMASK
  #define CMASK(P0,P1,t) do{}while(0)
  for(;t+5<NT;t+=2){
    STEP(pB0,pB1,pA0,pA1,t,true,true,true);     WAIT_BAR(2); RESC(); ROT();
    STEP(pA0,pA1,pB0,pB1,t+1,true,true,true);   WAIT_BAR(2); RESC(); ROT();
  }
  #undef CMASK
  #define CMASK(P0,P1,t) do{int jb_=(t)-(NT-4); if(jb_>=0)cmask(P0,P1,jb_,qrel,hi);}while(0)
  #define ENDW(tt) do{ if((tt)+3<NT){WAIT_BAR(2);} else if((tt)+2<NT){WAIT_BAR(1);} else {WAIT_BAR(0);} }while(0)
  for(;t+1<NT;t+=2){
    STEP(pB0,pB1,pA0,pA1,t,(t+3<NT),(t+1<NT),(t+1<NT));       ENDW(t);   RESC(); ROT();
    STEP(pA0,pA1,pB0,pB1,t+1,(t+4<NT),(t+2<NT),(t+2<NT));     ENDW(t+1); RESC(); ROT();
  }
  STEP(pB0,pB1,pA0,pA1,NT-1,false,false,false); RESC();
  { float sacc=pB0[0]+pB0[1]; _Pragma("unroll") for(int r=2;r<16;++r)sacc+=pB0[r]; _Pragma("unroll") for(int r=0;r<16;++r)sacc+=pB1[r]; l_reg+=sacc;
    pw0=(u32x4){PKW(pB0,0),PKW(pB0,2),PKW(pB0,4),PKW(pB0,6)};pw1=(u32x4){PKW(pB0,8),PKW(pB0,10),PKW(pB0,12),PKW(pB0,14)};pw2=(u32x4){PKW(pB1,0),PKW(pB1,2),PKW(pB1,4),PKW(pB1,6)};pw3=(u32x4){PKW(pB1,8),PKW(pB1,10),PKW(pB1,12),PKW(pB1,14)};
    SBAR(); pv(o,vb0+sl_cur,PAF(0),PAF(1),PAF(2),PAF(3)); }
  #undef PKW
  #undef PAF
  #undef VFR
  #undef PIN
  #undef MX3
  #undef GAPA
  #undef GAPB
  #undef EX
  #undef VRD
  #undef KRD
  #undef STEP
  #undef ENDW
  {auto rr=__builtin_amdgcn_permlane32_swap(__float_as_uint(l_reg),__float_as_uint(l_reg),false,false);l_reg=__uint_as_float(rr[0])+__uint_as_float(rr[1]);}
  if(hi==0)wsf[32+r32]=l_reg;asm volatile("s_waitcnt lgkmcnt(0)":::"memory");
  float rli[16];
  #pragma unroll
  for(int r=0;r<16;++r)rli[r]=__builtin_amdgcn_rcpf(wsf[32+crow(r,hi)]);
  bf16*Ow=O+(rowbase+q0+wid*QBLK)*OPITCH+h*D;
  { bf16*stg=(bf16*)(shm+LDS_OST)+wid*2048;
    #pragma unroll
    for(int r=0;r<16;++r){const int orow=crow(r,hi);
      #pragma unroll
      for(int d0=0;d0<2;++d0)stg[orow*64+d0*32+r32]=__float2bfloat16(o[d0][r]*rli[r]);}
    asm volatile("s_waitcnt lgkmcnt(0)":::"memory");
    #pragma unroll
    for(int i=0;i<4;++i){const int row=i*8+(lane>>3),ch=lane&7; const u32x4 v=*(const u32x4*)(stg+row*64+ch*8); ATTN_STORE16(Ow+(long)row*OPITCH+ch*8,v);} }
  asm volatile("s_waitcnt lgkmcnt(0)\n\ts_barrier":::"memory");
  #undef DMA_K
  #undef DMA_V
  #undef CMASK
  #undef START
  #undef RESC
  #undef ROT
}
constexpr int ATTN_LDS_BYTES=LDS_BYTES;
struct AttnTensors { const bf16* Q; const bf16* K; const bf16* V; bf16* O; const float* LF; const unsigned* NRM; };
struct AttnUnit { int bh; int qb; };
struct StaticOrder {
  int vcu,grid;
  __device__ __forceinline__ explicit StaticOrder(int grid_,int block):vcu((grid_%8==0)?(block%8)*(grid_/8)+block/8:block),grid(grid_){}
  __device__ __forceinline__ bool next(int i,AttnUnit&u)const{
    if(grid==256){ if(i>=4)return false; const int s=vcu&3; u.bh=vcu>>2; u.qb=(i==0)?s:(i==1)?7-s:(i==2)?8+s:15-s; return true; }
    const int L=i*grid+vcu; if(L>=BATCH*NHEAD*NQB)return false; u.bh=L/NQB; u.qb=L%NQB; return true; }
  __device__ __forceinline__ void a_ready(const AttnUnit&)const{}
  __device__ __forceinline__ void done(const AttnUnit&)const{}
};
template<class Sched,int THRL=8> __device__ __forceinline__ void attn_phase(char*lds,const AttnTensors&T,const Sched&S){
  AttnUnit u; int cur_bh=-1;
  for(int i=0;S.next(i,u);++i){ S.a_ready(u); if(u.bh!=cur_bh){ fox_bias_table(u.bh/NHEAD,u.bh%NHEAD,T.LF,lds); cur_bh=u.bh; }
    attn_unit<THRL>(u.bh/NHEAD,u.bh%NHEAD,u.qb,T.Q,T.K,T.V,T.O,T.LF,T.NRM,lds); S.done(u); }
}
template<int THRL=8> __device__ __forceinline__ void attn_phase_dyn(char*lds,const AttnTensors&T,unsigned*qheads,volatile int*slot,int grp){
  int cur_bh=-1; const int NU=NHEAD*NQB; unsigned*qhead=qheads+64*grp;
  if(threadIdx.x==0) slot[0]=(int)__hip_atomic_fetch_add(qhead,1u,__ATOMIC_RELAXED,__HIP_MEMORY_SCOPE_AGENT);
  __syncthreads();
  int idx=__builtin_amdgcn_readfirstlane(slot[0]);
  while(idx<NU){
    __syncthreads();
    if(threadIdx.x==0) slot[0]=(int)__hip_atomic_fetch_add(qhead,1u,__ATOMIC_RELAXED,__HIP_MEMORY_SCOPE_AGENT);
    const int qb=NQB-1-idx/NHEAD, bh=grp*NHEAD+idx%NHEAD;
    if(bh!=cur_bh){ fox_bias_table(bh/NHEAD,bh%NHEAD,T.LF,lds); cur_bh=bh; }
    attn_unit<THRL>(bh/NHEAD,bh%NHEAD,qb,T.Q,T.K,T.V,T.O,T.LF,T.NRM,lds);
    __syncthreads();
    idx=__builtin_amdgcn_readfirstlane(slot[0]);
  }
}
#undef SBAR
#undef WAIT_BAR
}
namespace fx {
using namespace nv;
typedef unsigned short bf16;
typedef unsigned v4u __attribute__((ext_vector_type(4)));
typedef float f32x4 __attribute__((ext_vector_type(4)));
constexpr float C2 = 0.125f * 1.4426950408889634f;
constexpr int NIN = 3328;
constexpr int QKVP = 3072;
constexpr int P_FQ = 0, P_FK = 512, P_FV = 1024, P_GQ = 1536, P_GK = 1792, P_GV = 2048, P_GR = 2560;
__device__ __forceinline__ int inproj_src(int d) {
    if (d < 1536) return d;
    if (d < 1792) return O_GQ + (d - 1536);
    if (d < 2048) return O_GK + (d - 1792);
    if (d < 2560) return O_GV + (d - 2048);
    if (d < 3072) return O_GR + (d - 2560);
    if (d < 3080) return O_FF + (d - 3072);
    if (d < 3096) return O_GA + (d - 3080);
    return -1;
}
__device__ __forceinline__ unsigned f2bf(float f) { unsigned u = __builtin_bit_cast(unsigned, f); return (u + 0x7fffu + ((u >> 16) & 1u)) >> 16; }
__device__ __forceinline__ unsigned pk2(float lo, float hi) { return f2bf(lo) | (f2bf(hi) << 16); }
__device__ __forceinline__ float bf2f(unsigned short h) { return __builtin_bit_cast(float, (unsigned)h << 16); }
__device__ __forceinline__ float wave_sum(float v) {
#pragma unroll
    for (int o = 1; o < 64; o <<= 1) v += __shfl_xor(v, o);
    return v;
}
#define FX_LDS_WAIT() asm volatile("s_waitcnt lgkmcnt(0)" ::: "memory")

template <class Map> __device__ __forceinline__ void transpose_item(const float* __restrict__ W, int K, int N, bf16* WT, LAS float* scr, int kb, int nb, int lane, Map srcmap) {
    const int k0 = 64 * kb, n0 = 32 * nb;
    const int src = srcmap(n0 + (lane & 31));
#pragma unroll 8
    for (int i = 0; i < 32; ++i) { const int kk = 2 * i + (lane >> 5); scr[kk * 33 + (lane & 31)] = (src >= 0) ? W[(size_t)(k0 + kk) * N + src] : 0.f; }
    FX_LDS_WAIT(); asm volatile("" ::: "memory");
    const int c = lane & 7;
#pragma unroll
    for (int j = 0; j < 4; ++j) { const int n = (lane >> 3) + 8 * j; const LAS float* s = scr + (8 * c) * 33 + n;
        v4u o; o.x = pk2(s[0 * 33], s[1 * 33]); o.y = pk2(s[2 * 33], s[3 * 33]); o.z = pk2(s[4 * 33], s[5 * 33]); o.w = pk2(s[6 * 33], s[7 * 33]);
        *(GAS v4u*)(WT + (size_t)(n0 + n) * K + k0 + 8 * c) = o; }
    FX_LDS_WAIT(); asm volatile("" ::: "memory");
}

__device__ __forceinline__ void ln_row_bf16(const float* xrow, const float* __restrict__ g, const float* __restrict__ b, bf16* orow, float* frow, float* st, int lane) {
    const GAS f32x4* xr = (const GAS f32x4*)xrow + lane;
    f32x4 v[4]; float s = 0.f;
#pragma unroll
    for (int j = 0; j < 4; ++j) { v[j] = xr[64 * j]; s += (v[j].x + v[j].y) + (v[j].z + v[j].w); }
    const float mean = wave_sum(s) * (1.f / D); float s2 = 0.f;
#pragma unroll
    for (int j = 0; j < 4; ++j) { v[j] = v[j] - mean; s2 += (v[j].x * v[j].x + v[j].y * v[j].y) + (v[j].z * v[j].z + v[j].w * v[j].w); }
    const float rstd = 1.f / sqrtf(wave_sum(s2) * (1.f / D) + LN_EPS);
    if (st && lane == 0) { st[0] = mean; st[1] = rstd; }
    GAS unsigned long long* o8 = (GAS unsigned long long*)orow + lane;
#pragma unroll
    for (int j = 0; j < 4; ++j) {
        const f32x4 gg = ((const f32x4*)g)[lane + 64 * j], bb = ((const f32x4*)b)[lane + 64 * j];
        const f32x4 o = v[j] * rstd * gg + bb;
        o8[64 * j] = (unsigned long long)pk2(o.x, o.y) | ((unsigned long long)pk2(o.z, o.w) << 32);
        if (frow) ((GAS f32x4*)frow)[lane + 64 * j] = o;
    }
}

struct CvItem { const float* W; bf16* WT; int N, K, k0, n0, s0; };
__device__ __forceinline__ void cv_load(const CvItem& it, f32x4 (&v)[8], int lane) {
    const float* p = it.W + (size_t)(it.k0 + (lane >> 3)) * it.N + it.s0 + 4 * (lane & 7);
#pragma unroll
    for (int i = 0; i < 8; ++i) v[i] = __builtin_nontemporal_load((const f32x4*)(p + (size_t)(8 * i) * it.N));
}
__device__ __forceinline__ void cv_finish(const CvItem& it, const f32x4 (&v)[8], LAS float* scr, int lane) {
    const int rr = lane >> 3, cq = lane & 7;
#pragma unroll
    for (int i = 0; i < 8; ++i) { LAS float* d = scr + (8 * i + rr) * 33 + 4 * cq; d[0] = v[i][0]; d[1] = v[i][1]; d[2] = v[i][2]; d[3] = v[i][3]; }
    FX_LDS_WAIT(); asm volatile("" ::: "memory");
    const int c = lane & 7;
#pragma unroll
    for (int j = 0; j < 4; ++j) { const int n = (lane >> 3) + 8 * j; const LAS float* s = scr + (8 * c) * 33 + n;
        v4u o; o.x = pk2(s[0 * 33], s[1 * 33]); o.y = pk2(s[2 * 33], s[3 * 33]); o.z = pk2(s[4 * 33], s[5 * 33]); o.w = pk2(s[6 * 33], s[7 * 33]);
        __builtin_nontemporal_store(o, (GAS v4u*)(it.WT + (size_t)(it.n0 + n) * it.K + it.k0 + 8 * c)); }
    FX_LDS_WAIT(); asm volatile("" ::: "memory");
}

template <int NR> __device__ __forceinline__ void ln_rows_bf16(const float* xrows, const float* __restrict__ g, const float* __restrict__ b, bf16* orows, int lane, float* st = nullptr) {
    f32x4 v[NR][4];
#pragma unroll
    for (int r = 0; r < NR; ++r)
#pragma unroll
        for (int j = 0; j < 4; ++j) v[r][j] = ((const GAS f32x4*)(xrows + (size_t)r * D))[lane + 64 * j];
    f32x4 gg[4], bb[4];
#pragma unroll
    for (int j = 0; j < 4; ++j) { gg[j] = ((const f32x4*)g)[lane + 64 * j]; bb[j] = ((const f32x4*)b)[lane + 64 * j]; }
#pragma unroll
    for (int r = 0; r < NR; ++r) {
        float s = 0.f;
#pragma unroll
        for (int j = 0; j < 4; ++j) s += (v[r][j].x + v[r][j].y) + (v[r][j].z + v[r][j].w);
        const float mean = wave_sum(s) * (1.f / D); float s2 = 0.f;
#pragma unroll
        for (int j = 0; j < 4; ++j) { v[r][j] = v[r][j] - mean; s2 += (v[r][j].x * v[r][j].x + v[r][j].y * v[r][j].y) + (v[r][j].z * v[r][j].z + v[r][j].w * v[r][j].w); }
        const float rstd = 1.f / sqrtf(wave_sum(s2) * (1.f / D) + LN_EPS);
        if (st && lane == 0) { st[2 * r] = mean; st[2 * r + 1] = rstd; }
        GAS unsigned long long* o8 = (GAS unsigned long long*)(orows + (size_t)r * D) + lane;
#pragma unroll
        for (int j = 0; j < 4; ++j) { const f32x4 o = v[r][j] * rstd * gg[j] + bb[j];
            o8[64 * j] = (unsigned long long)pk2(o.x, o.y) | ((unsigned long long)pk2(o.z, o.w) << 32); }
    }
}

template <int NR> __device__ __forceinline__ void ln1_rows_bf16(const float* xrows, const float* st, const float* __restrict__ gi, const float* __restrict__ bi, const bf16* mixrows,
                                                               const float* __restrict__ g1, const float* __restrict__ b1, bf16* orows, float alpha, int lane) {
    f32x4 v[NR][4]; unsigned long long mx[NR][4]; float mean0[NR], rstd0[NR];
#pragma unroll
    for (int r = 0; r < NR; ++r) { mean0[r] = st[2 * r]; rstd0[r] = st[2 * r + 1];
#pragma unroll
        for (int j = 0; j < 4; ++j) { v[r][j] = ((const GAS f32x4*)(xrows + (size_t)r * D))[lane + 64 * j]; mx[r][j] = ((const GAS unsigned long long*)(mixrows + (size_t)r * D))[lane + 64 * j]; } }
    f32x4 gi4[4], bi4[4];
#pragma unroll
    for (int j = 0; j < 4; ++j) { gi4[j] = ((const f32x4*)gi)[lane + 64 * j] * alpha; bi4[j] = ((const f32x4*)bi)[lane + 64 * j] * alpha; }
#pragma unroll
    for (int r = 0; r < NR; ++r) {
        float s = 0.f;
#pragma unroll
        for (int j = 0; j < 4; ++j) { const unsigned lo = (unsigned)mx[r][j], hi = (unsigned)(mx[r][j] >> 32);
            f32x4 mv; mv.x = __builtin_bit_cast(float, lo << 16); mv.y = __builtin_bit_cast(float, lo & 0xffff0000u); mv.z = __builtin_bit_cast(float, hi << 16); mv.w = __builtin_bit_cast(float, hi & 0xffff0000u);
            v[r][j] = ((v[r][j] - mean0[r]) * rstd0[r]) * gi4[j] + bi4[j] + mv;
            s += (v[r][j].x + v[r][j].y) + (v[r][j].z + v[r][j].w); }
        const float mean = wave_sum(s) * (1.f / D); float s2 = 0.f;
#pragma unroll
        for (int j = 0; j < 4; ++j) { v[r][j] = v[r][j] - mean; s2 += (v[r][j].x * v[r][j].x + v[r][j].y * v[r][j].y) + (v[r][j].z * v[r][j].z + v[r][j].w * v[r][j].w); }
        const float rstd = 1.f / sqrtf(wave_sum(s2) * (1.f / D) + LN_EPS);
        GAS unsigned long long* o8 = (GAS unsigned long long*)(orows + (size_t)r * D) + lane;
#pragma unroll
        for (int j = 0; j < 4; ++j) { const f32x4 gg = ((const f32x4*)g1)[lane + 64 * j], bb = ((const f32x4*)b1)[lane + 64 * j]; const f32x4 o = v[r][j] * rstd * gg + bb;
            o8[64 * j] = (unsigned long long)pk2(o.x, o.y) | ((unsigned long long)pk2(o.z, o.w) << 32); }
    }
}
}

namespace pg8 {
struct EpiInProj {
    static constexpr bool PERM = true, AFTER_DRAIN = false;
    bf16_t* QKV; float* FG; float* LF; const float* bfg; unsigned* NRM;
    __device__ __forceinline__ void operator()(const f32x4 (&acc)[2][2][4][2], const Unit& u, int wr, int wc, int fr, int fq) const {
        const int row0 = u.pm * BM + wr * 64 + fr;
        if (u.pn < 12) {
            const float sc = (u.pn < 2) ? fx::C2 : 1.f;
            const int col0 = u.pn * BM + wc * 32 + 8 * fq;
            float nmax[2] = {0.f, 0.f};
#pragma unroll
            for (int ai = 0; ai < 2; ++ai)
#pragma unroll
                for (int m = 0; m < 4; ++m) { bf16_t* rowp = QKV + (size_t)(row0 + ai * HALF + m * 16) * fx::QKVP + col0;
#pragma unroll
                    for (int bj = 0; bj < 2; ++bj) { const f32x4 v0 = acc[ai][bj][m][0] * sc, v1 = acc[ai][bj][m][1] * sc;
                        u32x4 w; w.x = cvt_pk_bf16(v0[0], v0[1]); w.y = cvt_pk_bf16(v0[2], v0[3]); w.z = cvt_pk_bf16(v1[0], v1[1]); w.w = cvt_pk_bf16(v1[2], v1[3]);
                        *(u32x4*)(rowp + bj * HALF) = w;
                        if (u.pn < 4) { const f32x4 q0 = v0 * v0, q1 = v1 * v1; float s = (q0[0] + q0[1]) + (q0[2] + q0[3]) + (q1[0] + q1[1]) + (q1[2] + q1[3]);
                            s += __shfl_xor(s, 16); s += __shfl_xor(s, 32);
                            nmax[bj] = fmaxf(nmax[bj], s); } } }
            if (u.pn < 4) {
#pragma unroll
                for (int bj = 0; bj < 2; ++bj) { float s = nmax[bj];
#pragma unroll
                    for (int o = 1; o < 16; o <<= 1) s = fmaxf(s, __shfl_xor(s, o));
                    if (fr == 0 && fq == 0) { const int b = (u.pm * BM) >> 12, head = 4 * (u.pn & 1) + 2 * bj + (wc >> 1);
                        atomicMax(NRM + (b * 8 + head) * 4 + (u.pn >= 2 ? 2 : 0) + (wc & 1), __builtin_bit_cast(unsigned, s)); } }
            }
        } else if (wc == 0 && fq < 3) {
#pragma unroll
            for (int ai = 0; ai < 2; ++ai)
#pragma unroll
                for (int m = 0; m < 4; ++m) { const int row = row0 + ai * HALF + m * 16; float* p = FG + (size_t)row * 32 + 8 * fq;
                    *(f32x4*)p = acc[ai][0][m][0]; *(f32x4*)(p + 4) = acc[ai][0][m][1];
                    if (fq == 0) { const int b = row >> 12, s = row & 4095;
#pragma unroll
                        for (int n = 0; n < 2; ++n)
#pragma unroll
                            for (int i = 0; i < 4; ++i) { const int h = 4 * n + i; LF[(size_t)(b * 8 + h) * nv::S + s] = -__builtin_amdgcn_logf(1.f + __builtin_amdgcn_exp2f(-1.4426950408889634f * (acc[ai][0][m][n][i] + bfg[h]))); } } }
        }
    }
};
}
namespace gl {
using namespace nv;
typedef unsigned short bf16;
typedef short bf16x8 __attribute__((ext_vector_type(8)));
typedef float f32x4 __attribute__((ext_vector_type(4)));
typedef unsigned u32x4 __attribute__((ext_vector_type(4)));
typedef unsigned u32x2 __attribute__((ext_vector_type(2)));
constexpr int NCH = S / 64;
constexpr int NUNIT = B * GH * NCH;
constexpr int LS = 72;
constexpr int L_WGU = 0, L_BG = 4096, L_DECS = 4352, L_QP = 8192, L_KP = L_QP + 64 * LS * 2, L_KPT = L_KP + 64 * LS * 2, L_VT = L_KPT + 64 * LS * 2, L_PP = L_VT + 128 * LS * 2, L_WT = L_PP + 64 * LS * 2, L_END = L_WT + 2048;
static_assert(L_END <= 131072, "gla prep LDS");
constexpr int C_ST = 0, C_PART = 128 * LS * 2, C_END = C_PART + 2 * 8 * 64 * 4;
constexpr size_t QPG_B = 64 * 64 * 2, OI_B = 8 * 4 * 64 * 16, UU_B = OI_B, DEC_B = 256;

__device__ __forceinline__ unsigned pkbf(float lo, float hi) { typedef float f2 __attribute__((ext_vector_type(2))); typedef __bf16 b2 __attribute__((ext_vector_type(2))); f2 v = {lo, hi}; b2 r = __builtin_convertvector(v, b2); return __builtin_bit_cast(unsigned, r); }
__device__ __forceinline__ float bf2f(unsigned short h) { return __builtin_bit_cast(float, (unsigned)h << 16); }
__device__ __forceinline__ float bflo(unsigned w) { return __builtin_bit_cast(float, w << 16); }
__device__ __forceinline__ float bfhi(unsigned w) { return __builtin_bit_cast(float, w & 0xffff0000u); }
__device__ __forceinline__ float fast_logsig2(float x) { return -__builtin_amdgcn_logf(1.f + __builtin_amdgcn_exp2f(-1.4426950408889634f * x)); }

__device__ __forceinline__ void prep_unit(int unit, const bf16* QKV, const float* FG, const float* __restrict__ wgu, const float* __restrict__ bgate,
                                          unsigned char* QPG, unsigned char* OI, unsigned char* UU, float* DEC, unsigned char* lds, int& cur_h, f32x4 (&Sagg)[4], f32x4 (&Dagg)[4]) {
    int tid_ = threadIdx.x; asm volatile("" : "+v"(tid_));
    const int tid = tid_, lane = tid & 63, wid = __builtin_amdgcn_readfirstlane(tid >> 6), l15 = lane & 15, g = lane >> 4;
    const int n = unit % NCH, bh = unit / NCH, h = bh % GH, b = bh / GH;
    const size_t row0 = (size_t)b * S + (size_t)n * 64;
    float* WGU = (float*)(lds + L_WGU); float* BG = (float*)(lds + L_BG); float* WT = (float*)(lds + L_WT);
    bf16* QP = (bf16*)(lds + L_QP); bf16* KP = (bf16*)(lds + L_KP); bf16* KPT = (bf16*)(lds + L_KPT); bf16* VT = (bf16*)(lds + L_VT); bf16* PP = (bf16*)(lds + L_PP);
    if (cur_h != h) { __syncthreads(); for (int i = tid; i < 16 * 64; i += 512) WGU[i] = wgu[(i >> 6) * 256 + h * 64 + (i & 63)]; if (tid < 64) BG[tid] = bgate[h * 64 + tid]; cur_h = h; __syncthreads(); }
    const int t = tid >> 3, oc = tid & 7, d0 = oc * 8;
    float la[8];
    { const float* gp = FG + (row0 + t) * 32 + 8;
      f32x4 ga4[4];
#pragma unroll
      for (int i = 0; i < 4; ++i) ga4[i] = *(const f32x4*)(gp + 4 * i);
#pragma unroll
      for (int j = 0; j < 8; ++j) la[j] = BG[d0 + j];
#pragma unroll
      for (int r = 0; r < 16; ++r) { const float gv = ga4[r >> 2][r & 3]; const f32x4 w0 = *(const f32x4*)(WGU + r * 64 + d0), w1 = *(const f32x4*)(WGU + r * 64 + d0 + 4);
#pragma unroll
          for (int j = 0; j < 4; ++j) { la[j] += gv * w0[j]; la[4 + j] += gv * w1[j]; } }
#pragma unroll
      for (int j = 0; j < 8; ++j) la[j] = fast_logsig2(la[j]) * (1.f / 16.f); }
    const u32x4 qv = *(const u32x4*)(QKV + (row0 + t) * fx::QKVP + fx::P_GQ + h * 64 + d0);
    const u32x4 kv = *(const u32x4*)(QKV + (row0 + t) * fx::QKVP + fx::P_GK + h * 64 + d0);
    const u32x4 vv0 = *(const u32x4*)(QKV + (row0 + t) * fx::QKVP + fx::P_GV + h * 128 + oc * 16);
    const u32x4 vv1 = *(const u32x4*)(QKV + (row0 + t) * fx::QKVP + fx::P_GV + h * 128 + oc * 16 + 8);
#pragma unroll
    for (int off = 8; off < 64; off <<= 1) {
#pragma unroll
        for (int j = 0; j < 8; ++j) { const float o = __shfl_up(la[j], off); if (lane >= off) la[j] += o; } }
    if (lane >= 56) {
#pragma unroll
        for (int j = 0; j < 8; ++j) WT[wid * 64 + d0 + j] = la[j]; }
    __syncthreads();
    float bl[8];
#pragma unroll
    for (int j = 0; j < 8; ++j) bl[j] = 0.f;
#pragma unroll
    for (int w = 0; w < 8; ++w) {
        const f32x4 a0 = *(const f32x4*)(WT + w * 64 + d0), a1 = *(const f32x4*)(WT + w * 64 + d0 + 4);
#pragma unroll
        for (int j = 0; j < 4; ++j) { bl[j] += a0[j]; bl[4 + j] += a1[j]; if (w < wid) { la[j] += a0[j]; la[4 + j] += a1[j]; } } }
    {
        const unsigned qw[4] = {qv.x, qv.y, qv.z, qv.w}, kw[4] = {kv.x, kv.y, kv.z, kv.w};
        float qf[8], kf[8];
#pragma unroll
        for (int i = 0; i < 4; ++i) { qf[2 * i] = bflo(qw[i]); qf[2 * i + 1] = bfhi(qw[i]); kf[2 * i] = bflo(kw[i]); kf[2 * i + 1] = bfhi(kw[i]); }
        float qp[8], kp[8], kpp[8];
#pragma unroll
        for (int j = 0; j < 8; ++j) { const float bb = la[j], bbl = bl[j];
            qp[j] = qf[j] * (0.125f * __builtin_amdgcn_exp2f(bb)); kp[j] = kf[j] * __builtin_amdgcn_exp2f(-bb); kpp[j] = kf[j] * __builtin_amdgcn_exp2f(bbl - bb); }
        u32x4 qo, ko; qo.x = pkbf(qp[0], qp[1]); qo.y = pkbf(qp[2], qp[3]); qo.z = pkbf(qp[4], qp[5]); qo.w = pkbf(qp[6], qp[7]);
        ko.x = pkbf(kp[0], kp[1]); ko.y = pkbf(kp[2], kp[3]); ko.z = pkbf(kp[4], kp[5]); ko.w = pkbf(kp[6], kp[7]);
        *(u32x4*)(QP + t * LS + d0) = qo; *(u32x4*)(KP + t * LS + d0) = ko;
        *(u32x4*)(QPG + (size_t)unit * QPG_B + (size_t)(t * 64 + d0) * 2) = qo;
#pragma unroll
        for (int j = 0; j < 8; ++j) KPT[(d0 + j) * LS + t] = (bf16)(pkbf(kpp[j], 0.f) & 0xffffu);
        const unsigned vw[8] = {vv0.x, vv0.y, vv0.z, vv0.w, vv1.x, vv1.y, vv1.z, vv1.w};
#pragma unroll
        for (int i = 0; i < 8; ++i) { VT[(oc * 16 + 2 * i) * LS + t] = (bf16)(vw[i] & 0xffffu); VT[(oc * 16 + 2 * i + 1) * LS + t] = (bf16)(vw[i] >> 16); }
        if (t == 0) {
#pragma unroll
            for (int j = 0; j < 8; ++j) { const float dc = __builtin_amdgcn_exp2f(bl[j]); DEC[(size_t)unit * 64 + d0 + j] = dc; ((float*)(lds + L_DECS))[d0 + j] = dc; } }
    }
    __syncthreads();
    { const int ti = wid >> 1;
#pragma unroll
      for (int q2 = 0; q2 < 2; ++q2) { const int sj = 2 * (wid & 1) + q2;
          f32x4 acc = {0.f, 0.f, 0.f, 0.f};
          if (sj <= ti) {
#pragma unroll
              for (int ks = 0; ks < 2; ++ks) { const bf16x8 a = *(const bf16x8*)(QP + (16 * ti + l15) * LS + 32 * ks + 8 * g), bb = *(const bf16x8*)(KP + (16 * sj + l15) * LS + 32 * ks + 8 * g);
                  acc = __builtin_amdgcn_mfma_f32_16x16x32_bf16(a, bb, acc, 0, 0, 0); }
              if (sj == ti) {
#pragma unroll
                  for (int r = 0; r < 4; ++r) if (l15 > 4 * g + r) acc[r] = 0.f; }
          }
#pragma unroll
          for (int r = 0; r < 4; ++r) PP[(16 * ti + 4 * g + r) * LS + 16 * sj + l15] = (bf16)(pkbf(acc[r], 0.f) & 0xffffu);
      } }
    __syncthreads();
    { bf16x8 vb[2];
#pragma unroll
      for (int ks = 0; ks < 2; ++ks) vb[ks] = *(const bf16x8*)(VT + (16 * wid + l15) * LS + 32 * ks + 8 * g);
#pragma unroll
      for (int m = 0; m < 4; ++m) { f32x4 acc = {0.f, 0.f, 0.f, 0.f};
#pragma unroll
          for (int ks = 0; ks < 2; ++ks) { const bf16x8 a = *(const bf16x8*)(PP + (16 * m + l15) * LS + 32 * ks + 8 * g); acc = __builtin_amdgcn_mfma_f32_16x16x32_bf16(a, vb[ks], acc, 0, 0, 0); }
          *(f32x4*)(OI + (size_t)unit * OI_B + (size_t)((wid * 4 + m) * 64 + lane) * 16) = acc; }
#pragma unroll
      for (int db = 0; db < 4; ++db) { f32x4 acc = {0.f, 0.f, 0.f, 0.f};
#pragma unroll
          for (int ks = 0; ks < 2; ++ks) { const bf16x8 a = *(const bf16x8*)(KPT + (16 * db + l15) * LS + 32 * ks + 8 * g); acc = __builtin_amdgcn_mfma_f32_16x16x32_bf16(a, vb[ks], acc, 0, 0, 0); }
          *(f32x4*)(UU + (size_t)unit * UU_B + (size_t)((wid * 4 + db) * 64 + lane) * 16) = acc;
          const f32x4 dcv = *(const f32x4*)((const float*)(lds + L_DECS) + 16 * db + 4 * g);
          Sagg[db] = dcv * Sagg[db] + acc; Dagg[db] = Dagg[db] * dcv; }
    }
}


__device__ __forceinline__ void prep_block(int blk, const bf16* QKV, const float* FG, const float* __restrict__ wgu, const float* __restrict__ bgate,
                                           unsigned char* QPG, unsigned char* OI, unsigned char* UU, float* DEC, unsigned char* AGG, float* DAGG, unsigned char* lds, int& cur_h) {
    f32x4 Sagg[4], Dagg[4];
#pragma unroll
    for (int db = 0; db < 4; ++db) { Sagg[db] = (f32x4){0.f, 0.f, 0.f, 0.f}; Dagg[db] = (f32x4){1.f, 1.f, 1.f, 1.f}; }
    for (int i = 0; i < 8; ++i) prep_unit(blk * 8 + i, QKV, FG, wgu, bgate, QPG, OI, UU, DEC, lds, cur_h, Sagg, Dagg);
    int tid_ = threadIdx.x; asm volatile("" : "+v"(tid_));
    const int lane = tid_ & 63, wid = __builtin_amdgcn_readfirstlane(tid_ >> 6), l15 = lane & 15, g = lane >> 4;
#pragma unroll
    for (int db = 0; db < 4; ++db) { *(f32x4*)(AGG + (size_t)blk * UU_B + (size_t)((wid * 4 + db) * 64 + lane) * 16) = Sagg[db];
        if (wid == 0 && l15 == 0) *(f32x4*)(DAGG + (size_t)blk * 64 + 16 * db + 4 * g) = Dagg[db]; }
}
constexpr int GS = 136;
constexpr int PO_GR = 0, PO_YT = 64 * GS * 2, PO_PART = 2 * 64 * GS * 2, PO_ST = PO_PART + 8 * 64 * 4, PO_END = PO_ST + 128 * LS * 2;
__device__ __forceinline__ void post_block(int u0, int NB, const bf16* QKV, const unsigned char* QPG, const unsigned char* OI, const unsigned char* UU, const float* DEC, const unsigned char* AGG, const float* DAGG, const float* __restrict__ gnorm, bf16* Y, unsigned char* lds) {
    int tid_ = threadIdx.x; asm volatile("" : "+v"(tid_));
    const int tid = tid_, lane = tid & 63, wid = __builtin_amdgcn_readfirstlane(tid >> 6), l15 = lane & 15, g = lane >> 4;
    const int n0 = u0 % NCH, bh = u0 / NCH, h = bh % GH, b = bh / GH;
    bf16* GRs = (bf16*)(lds + PO_GR); bf16* YT = (bf16*)(lds + PO_YT); float* PART = (float*)(lds + PO_PART); bf16* ST = (bf16*)(lds + PO_ST);
    const int t = tid >> 3, oc = tid & 7, e = 16 * wid + l15;
    const float gn = gnorm[e];
    f32x4 Sa[4];
#pragma unroll
    for (int db = 0; db < 4; ++db) Sa[db] = (f32x4){0.f, 0.f, 0.f, 0.f};
    { const int seg0 = bh * (NCH / 8), nseg = n0 / 8;
      for (int i = 0; i < nseg; ++i) {
          f32x4 Ua[4], Da[4];
#pragma unroll
          for (int db = 0; db < 4; ++db) { Ua[db] = *(const f32x4*)(AGG + (size_t)(seg0 + i) * UU_B + (size_t)((wid * 4 + db) * 64 + lane) * 16); Da[db] = *(const f32x4*)(DAGG + (size_t)(seg0 + i) * 64 + 16 * db + 4 * g); }
#pragma unroll
          for (int db = 0; db < 4; ++db) Sa[db] = Da[db] * Sa[db] + Ua[db]; } }
    for (int i = 0; i < NB; ++i) {
        const int unit = u0 + i; const size_t row0 = (size_t)b * S + (size_t)(n0 + i) * 64;
        const u32x4 g0 = *(const u32x4*)(QKV + (row0 + t) * fx::QKVP + fx::P_GR + h * 128 + oc * 16), g1 = *(const u32x4*)(QKV + (row0 + t) * fx::QKVP + fx::P_GR + h * 128 + oc * 16 + 8);
        f32x4 o[4], Uf[4], dv[4]; bf16x8 qa[4][2], sb[2];
#pragma unroll
        for (int m = 0; m < 4; ++m) { o[m] = *(const f32x4*)(OI + (size_t)unit * OI_B + (size_t)((wid * 4 + m) * 64 + lane) * 16);
            Uf[m] = *(const f32x4*)(UU + (size_t)unit * UU_B + (size_t)((wid * 4 + m) * 64 + lane) * 16); dv[m] = *(const f32x4*)(DEC + (size_t)unit * 64 + 16 * m + 4 * g);
#pragma unroll
            for (int ks = 0; ks < 2; ++ks) qa[m][ks] = *(const bf16x8*)(QPG + (size_t)unit * QPG_B + (size_t)((16 * m + l15) * 64 + 32 * ks + 8 * g) * 2); }
#pragma unroll
        for (int db = 0; db < 4; ++db) *(u32x2*)(ST + e * LS + 16 * db + 4 * g) = (u32x2){pkbf(Sa[db][0], Sa[db][1]), pkbf(Sa[db][2], Sa[db][3])};
#pragma unroll
        for (int ks = 0; ks < 2; ++ks) sb[ks] = *(const bf16x8*)(ST + e * LS + 32 * ks + 8 * g);
        *(u32x4*)(GRs + t * GS + oc * 16) = g0; *(u32x4*)(GRs + t * GS + oc * 16 + 8) = g1;
#pragma unroll
        for (int m = 0; m < 4; ++m)
#pragma unroll
            for (int ks = 0; ks < 2; ++ks) o[m] = __builtin_amdgcn_mfma_f32_16x16x32_bf16(qa[m][ks], sb[ks], o[m], 0, 0, 0);
#pragma unroll
        for (int m = 0; m < 4; ++m) { f32x4 q = o[m] * o[m];
#pragma unroll
            for (int off = 1; off < 16; off <<= 1) { q[0] += __shfl_xor(q[0], off); q[1] += __shfl_xor(q[1], off); q[2] += __shfl_xor(q[2], off); q[3] += __shfl_xor(q[3], off); }
            if (l15 == 0) *(f32x4*)(PART + wid * 64 + 16 * m + 4 * g) = q; }
#pragma unroll
        for (int db = 0; db < 4; ++db) Sa[db] = dv[db] * Sa[db] + Uf[db];
        __syncthreads();
#pragma unroll
        for (int m = 0; m < 4; ++m) { f32x4 tot = {0.f, 0.f, 0.f, 0.f};
#pragma unroll
            for (int w = 0; w < 8; ++w) tot += *(const f32x4*)(PART + w * 64 + 16 * m + 4 * g);
#pragma unroll
            for (int r = 0; r < 4; ++r) { const int tt = 16 * m + 4 * g + r; const float rs = rsqrtf(tot[r] * (1.f / GV) + LN_EPS); const float gr = bf2f(GRs[tt * GS + e]);
                const float v = o[m][r] * rs * gn * (gr * __builtin_amdgcn_rcpf(1.f + __builtin_amdgcn_exp2f(-1.4426950408889634f * gr)));
                YT[tt * GS + e] = (bf16)(pkbf(v, 0.f) & 0xffffu); } }
        __syncthreads();
        { const u32x4 y0 = *(const u32x4*)(YT + t * GS + oc * 16), y1 = *(const u32x4*)(YT + t * GS + oc * 16 + 8);
          *(u32x4*)(Y + (row0 + t) * D + 512 + h * GV + oc * 16) = y0; *(u32x4*)(Y + (row0 + t) * D + 512 + h * GV + oc * 16 + 8) = y1; }
        __syncthreads();
    }
}
}
namespace mo {
using namespace nv;
typedef unsigned short bf16;
typedef float f32x4 __attribute__((ext_vector_type(4)));
typedef unsigned u32x4 __attribute__((ext_vector_type(4)));
constexpr int CAP = 8192;
constexpr int NEX = NE + 1;
constexpr int YSH = T * TOPK;
constexpr int L_TB = 132096, L_YB = L_TB + 1040, L_CN = L_YB + 1040, L_UT = 138240, L_RG = 141312;
typedef LAS int* lint;


constexpr int I_EG = NEX * 256, I_ED = NEX * 128, I_EXP = I_EG + I_ED;
struct ExpW { const float* eg; const float* eu; const float* ed; const float* sg; const float* su; const float* sd; bf16* WegT; bf16* WedT; };
__device__ __forceinline__ void cv_decode(int r, const ExpW& X, fx::CvItem& I) {
    if (r < I_EG) { const int e = r >> 8, kb = (r >> 4) & 15, nb = r & 15, c = nb >> 3, sub = nb & 7;
        I.W = (e < NE) ? ((sub < 4 ? X.eg : X.eu) + (size_t)e * D * ED) : (sub < 4 ? X.sg : X.su); I.WT = X.WegT + (size_t)e * 512 * D; I.N = ED; I.K = D; I.k0 = 64 * kb; I.n0 = 32 * nb; I.s0 = 128 * c + 32 * (sub & 3); }
    else { r -= I_EG; const int e = r >> 7, kb = (r >> 5) & 3, nb = r & 31; I.W = (e < NE) ? (X.ed + (size_t)e * ED * D) : X.sd; I.WT = X.WedT + (size_t)e * D * ED; I.N = D; I.K = ED; I.k0 = 64 * kb; I.n0 = 32 * nb; I.s0 = 32 * nb; }
}
__device__ __forceinline__ void expert_conv(const ExpW& X, LAS float* scr, int it0, int step, int it_end, int lane) {
    int it = it0; fx::CvItem cur, nx; fx::f32x4 v[8], w[8];
    if (it < it_end) { cv_decode(it, X, cur); fx::cv_load(cur, v, lane); }
    while (it < it_end) { const int itn = it + step; if (itn < it_end) { cv_decode(itn, X, nx); fx::cv_load(nx, w, lane); }
        fx::cv_finish(cur, v, scr, lane); cur = nx;
#pragma unroll
        for (int i = 0; i < 8; ++i) v[i] = w[i];
        it = itn; }
}

__device__ __forceinline__ void moe_tables(const int* counts, lint tb, lint yb, lint cn, int lane) {
    int c[4], nt[4]; int st = 0, sy = 0, pt[4], py[4];
#pragma unroll
    for (int i = 0; i < 4; ++i) { c[i] = counts[lane * 4 + i]; c[i] = c[i] > CAP ? CAP : c[i]; nt[i] = (c[i] + 255) >> 8; pt[i] = st; py[i] = sy; st += nt[i]; sy += c[i]; }
    int it = st, iy = sy;
    for (int o = 1; o < 64; o <<= 1) { const int a = __shfl_up(it, o), b = __shfl_up(iy, o); if (lane >= o) { it += a; iy += b; } }
    const int bt = it - st, by = iy - sy;
#pragma unroll
    for (int i = 0; i < 4; ++i) { tb[lane * 4 + i] = bt + pt[i]; yb[lane * 4 + i] = by + py[i]; cn[lane * 4 + i] = c[i]; }
    if (lane == 63) { tb[256] = it; tb[257] = it + T / 256; yb[256] = YSH; cn[256] = T; }
}

__device__ __forceinline__ void route_token2(const float* LG, const float* __restrict__ rbias, int* lcnt, int* TK, float* TW, int t0, int lane) {
    const int l32 = lane & 31, hb = lane & 32, t = t0 + (lane >> 5);
    const float4 la = ((const float4*)(LG + (size_t)t * NE))[2 * l32], lb = ((const float4*)(LG + (size_t)t * NE))[2 * l32 + 1];
    const float4 ra = ((const float4*)rbias)[2 * l32], rb = ((const float4*)rbias)[2 * l32 + 1];
    const float lg[8] = {la.x, la.y, la.z, la.w, lb.x, lb.y, lb.z, lb.w}, rbv[8] = {ra.x, ra.y, ra.z, ra.w, rb.x, rb.y, rb.z, rb.w};
    float sc[8], bv[8];
#pragma unroll
    for (int i = 0; i < 8; ++i) { sc[i] = __builtin_amdgcn_rcpf(1.f + __builtin_amdgcn_exp2f(-1.4426950408889634f * lg[i])); bv[i] = sc[i] + rbv[i]; }
    float m1 = fmaxf(bv[0], bv[1]), m2 = fminf(bv[0], bv[1]);
#pragma unroll
    for (int i = 2; i < 8; ++i) { const float n1 = fmaxf(m1, bv[i]); m2 = fmaxf(fminf(m1, bv[i]), m2); m1 = n1; }
#pragma unroll
    for (int o = 1; o < 4; o <<= 1) { const float p1 = __shfl_xor(m1, o), p2 = __shfl_xor(m2, o); const float n1 = fmaxf(m1, p1); m2 = fmaxf(fminf(m1, p1), fmaxf(m2, p2)); m1 = n1; }
    const float gs = m1 + m2;
    const int myg = l32 >> 2;
    int rank = 0;
#pragma unroll
    for (int g2 = 0; g2 < NG; ++g2) { const float og = __shfl(gs, hb + g2 * 4); if (og > gs || (og == gs && g2 < myg)) ++rank; }
    const bool sel = rank < 4;
    float mv[8];
#pragma unroll
    for (int i = 0; i < 8; ++i) mv[i] = sel ? bv[i] : -INFINITY;
    int mye = 0; float myw = 0.f; float wsum = 0.f;
#pragma unroll
    for (int k = 0; k < TOPK; ++k) {
        float bvv = mv[0]; int bi = 0;
#pragma unroll
        for (int i = 1; i < 8; ++i) if (mv[i] > bvv) { bvv = mv[i]; bi = i; }
        int gi = l32 * 8 + bi;
#pragma unroll
        for (int o = 16; o > 0; o >>= 1) { const float ov = __shfl_xor(bvv, o); const int oi = __shfl_xor(gi, o); if (ov > bvv || (ov == bvv && oi < gi)) { bvv = ov; gi = oi; } }
        const int ol = gi >> 3, oi = gi & 7;
        float s_own = sc[0];
#pragma unroll
        for (int i = 1; i < 8; ++i) s_own = (oi == i) ? sc[i] : s_own;
        const float sw = __shfl(s_own, hb + ol);
        if (l32 == ol) {
#pragma unroll
            for (int i = 0; i < 8; ++i) if (oi == i) mv[i] = -INFINITY; }
        if (l32 == k) { mye = gi; myw = sw; } wsum += sw;
    }
    if (l32 < TOPK) { const int lp = atomicAdd(&lcnt[mye], 1); TK[t * TOPK + l32] = mye | (lp << 9); TW[t * TOPK + l32] = myw * (2.5f / wsum); }
}
__device__ __forceinline__ void route_finish2(const int* lbase, int* list_tok, float* list_gate, int* TK, const float* TW, int t0, int lane) {
    const int l32 = lane & 31, t = t0 + (lane >> 5);
    if (l32 < TOPK) { const int tk = TK[t * TOPK + l32]; const int e = tk & 511, pos = lbase[e] + (tk >> 9);
        if (pos < CAP) { list_tok[e * CAP + pos] = t; list_gate[e * CAP + pos] = TW[t * TOPK + l32]; }
        TK[t * TOPK + l32] = e | (pos << 9); }
}

constexpr float YSC = 16.f;
__device__ __forceinline__ void combine_token(const bf16* H1, const unsigned char* Y, const int* TK, lint yb, const float* __restrict__ g, const float* __restrict__ b, float* out, int t, int lane) {
    typedef float f2 __attribute__((ext_vector_type(2)));
    float v[16], s[16];
    { const u32x4 a = *(const u32x4*)(H1 + (size_t)t * D + 16 * lane), c = *(const u32x4*)(H1 + (size_t)t * D + 16 * lane + 8);
      const unsigned w[8] = {a.x, a.y, a.z, a.w, c.x, c.y, c.z, c.w};
#pragma unroll
      for (int i = 0; i < 8; ++i) { v[2 * i] = ALPHA * __builtin_bit_cast(float, w[i] << 16); v[2 * i + 1] = ALPHA * __builtin_bit_cast(float, w[i] & 0xffff0000u); } }
#pragma unroll
    for (int i = 0; i < 16; ++i) s[i] = 0.f;
    int tk = (lane < TOPK) ? TK[t * TOPK + lane] : 0;
#pragma unroll
    for (int k = 0; k <= TOPK; ++k) {
        size_t yrow;
        if (k < TOPK) { const int x = __shfl(tk, k); yrow = (size_t)(yb[x & 511] + (x >> 9)); } else yrow = (size_t)YSH + t;
        const u32x4 a = *(const u32x4*)(Y + yrow * D + 16 * lane);
        const int w[4] = {(int)a.x, (int)a.y, (int)a.z, (int)a.w};
#pragma unroll
        for (int i = 0; i < 4; ++i) { const f2 lo = __builtin_amdgcn_cvt_pk_f32_fp8(w[i], false), hi = __builtin_amdgcn_cvt_pk_f32_fp8(w[i], true);
            s[4 * i] += lo[0]; s[4 * i + 1] += lo[1]; s[4 * i + 2] += hi[0]; s[4 * i + 3] += hi[1]; }
    }
    float sm = 0.f;
#pragma unroll
    for (int i = 0; i < 16; ++i) { v[i] += s[i] * (1.f / YSC); sm += v[i]; }
    const float mean = fx::wave_sum(sm) * (1.f / D); float q = 0.f;
#pragma unroll
    for (int i = 0; i < 16; ++i) { v[i] -= mean; q += v[i] * v[i]; }
    const float rstd = 1.f / sqrtf(fx::wave_sum(q) * (1.f / D) + LN_EPS);
#pragma unroll
    for (int i = 0; i < 4; ++i) { const f32x4 gg = *(const f32x4*)(g + 16 * lane + 4 * i), bb = *(const f32x4*)(b + 16 * lane + 4 * i);
        f32x4 o; o[0] = v[4 * i] * rstd * gg[0] + bb[0]; o[1] = v[4 * i + 1] * rstd * gg[1] + bb[1]; o[2] = v[4 * i + 2] * rstd * gg[2] + bb[2]; o[3] = v[4 * i + 3] * rstd * gg[3] + bb[3];
        *(f32x4*)(out + (size_t)t * D + 16 * lane + 4 * i) = o; }
}
}

namespace pg8 {
struct RouterSched {
    int rb; const bf16_t* Bt;
    __device__ __forceinline__ bool next(int i, Unit2& u) const { if (i > 0) return false; u.pm = rb; u.pn = 0; u.e = 0; u.cnt = 128; u.jt = 0; u.ui = 0; return true; }
    __device__ __forceinline__ int arow(const Unit2& u, int r) const { return u.pm * 128 + r; }
    __device__ __forceinline__ size_t aoff(const Unit2&) const { return 0; }
    __device__ __forceinline__ const char* bptr(const Unit2&) const { return (const char*)Bt; }
};
struct EpiLogits {
    static constexpr bool PERM = false, AFTER_DRAIN = false;
    float* LG;
    __device__ __forceinline__ void operator()(const f32x4 (&acc)[2][2][4][2], const Unit2& u, int wr, int wc, int fr, int fq) const {
        const int row0 = u.pm * 128 + wr * 64 + fr, col0 = wc * 32 + 4 * fq;
#pragma unroll
        for (int m = 0; m < 4; ++m) { float* rowp = LG + (size_t)(row0 + m * 16) * nv::NE + col0;
#pragma unroll
            for (int bj = 0; bj < 2; ++bj)
#pragma unroll
                for (int n = 0; n < 2; ++n) *(f32x4*)(rowp + bj * HALF + n * 16) = acc[0][bj][m][n]; }
    }
};
template <int PH> struct MoeSched {
    int G, vcu, nrt; mo::lint tb; mo::lint cn; const int* list_tok; const bf16_t* W; mo::lint ut; mo::lint rg;
    static constexpr int NC = PH == 0 ? 2 : 4;
    static constexpr int MAXU = 64;
    __device__ __forceinline__ void build(int lane) const {
        const int L = lane * G + vcu;
        if (lane < MAXU && L < nrt * NC) {
            const int rt = L / NC, c = L % NC;
            int lo = 0, hi = 256;
            while (lo < hi) { const int mid = (lo + hi + 1) >> 1; if (tb[mid] <= rt) lo = mid; else hi = mid - 1; }
            const int e = lo, jt = rt - tb[e], rem = cn[e] - 256 * jt;
            ut[4 * lane] = rt; ut[4 * lane + 1] = c; ut[4 * lane + 2] = e | (jt << 9); ut[4 * lane + 3] = rem < 256 ? rem : 256;
        }
    }
    __device__ __forceinline__ bool next(int i, Unit2& u) const {
        const int L = i * G + vcu; if (i >= MAXU || L >= nrt * NC) return false;
        const int x = ut[4 * i + 2];
        u.pm = __builtin_amdgcn_readfirstlane(ut[4 * i]); u.pn = __builtin_amdgcn_readfirstlane(ut[4 * i + 1]); u.e = __builtin_amdgcn_readfirstlane(x & 511); u.jt = __builtin_amdgcn_readfirstlane(x >> 9);
        u.cnt = __builtin_amdgcn_readfirstlane(ut[4 * i + 3]); u.ui = i; return true;
    }
    __device__ __forceinline__ void fill_rows(const float* list_gate, int tid) const {
        for (int i = 0; i < MAXU; ++i) { const int L = i * G + vcu; if (L >= nrt * NC) break;
            const int x = ut[4 * i + 2], e = x & 511, jt = x >> 9, cnt = ut[4 * i + 3];
            if (tid < 256) { const int r = tid; unsigned v;
                if (e == 256) v = (unsigned)(jt * BM + r) | (0x4180u << 16);
                else if (r < cnt) { const float gsc = mo::YSC * list_gate[e * mo::CAP + jt * BM + r]; v = (unsigned)list_tok[e * mo::CAP + jt * BM + r] | (fx::f2bf(gsc) << 16); }
                else v = 0u;
                rg[i * 256 + r] = (int)v; } }
    }
    __device__ __forceinline__ int arow(const Unit2& u, int r) const {
        if (PH == 1) return u.pm * BM + r;
        return rg[u.ui * 256 + r] & 0x7fff;
    }
    __device__ __forceinline__ size_t aoff(const Unit2& u) const { return PH == 1 ? (size_t)u.pm * (131072 - 32768) : 0; }
    __device__ __forceinline__ const char* bptr(const Unit2& u) const {
        return PH == 0 ? (const char*)(W + ((size_t)u.e * 512 + 256 * u.pn) * 1024) : (const char*)(W + ((size_t)u.e * 1024 + 256 * u.pn) * 256);
    }
};
struct EpiSwiGLU {
    static constexpr bool PERM = true, AFTER_DRAIN = false;
    bf16_t* H; mo::lint rg; int skip;
    __device__ __forceinline__ void operator()(const f32x4 (&acc)[2][2][4][2], const Unit2& u, int wr, int wc, int fr, int fq) const {
        if (skip) return;
        const int col0 = u.pn * 128 + wc * 32 + 8 * fq;
#pragma unroll
        for (int ai = 0; ai < 2; ++ai)
#pragma unroll
            for (int m = 0; m < 4; ++m) { const int r = ai * HALF + wr * 64 + m * 16 + fr;
                const float gt = __builtin_bit_cast(float, (unsigned)rg[u.ui * 256 + r] & 0xffff0000u);
                float hv[8];
#pragma unroll
                for (int n = 0; n < 2; ++n)
#pragma unroll
                    for (int i = 0; i < 4; ++i) { const float gg = acc[ai][0][m][n][i], uu = acc[ai][1][m][n][i]; hv[4 * n + i] = gt * uu * (gg * __builtin_amdgcn_rcpf(1.f + __builtin_amdgcn_exp2f(-1.4426950408889634f * gg))); }
                u32x4 w; w.x = cvt_pk_bf16(hv[0], hv[1]); w.y = cvt_pk_bf16(hv[2], hv[3]); w.z = cvt_pk_bf16(hv[4], hv[5]); w.w = cvt_pk_bf16(hv[6], hv[7]);
                *(u32x4*)(H + (size_t)u.pm * 65536 + (size_t)(col0 >> 6) * 16384 + r * 64 + (col0 & 63)) = w; }
    }
};
struct EpiDown {
    static constexpr bool PERM = true, PERM16 = true, AFTER_DRAIN = false;
    unsigned char* Y; mo::lint yb; int skip;
    __device__ __forceinline__ void operator()(const f32x4 (&acc)[2][2][4][2], const Unit2& u, int wr, int wc, int fr, int fq) const {
        if (skip) return;
        const int col0 = u.pn * BM + wc * 64 + 16 * fq; const int ybase = yb[u.e] + u.jt * BM;
#pragma unroll
        for (int ai = 0; ai < 2; ++ai)
#pragma unroll
            for (int m = 0; m < 4; ++m) { const int r = ai * HALF + wr * 64 + m * 16 + fr;
                if (r < u.cnt) { u32x4 w; unsigned ww[4];
#pragma unroll
                    for (int bj = 0; bj < 2; ++bj)
#pragma unroll
                        for (int n = 0; n < 2; ++n) { const f32x4 v = acc[ai][bj][m][n]; int x = __builtin_amdgcn_cvt_pk_fp8_f32(v[0], v[1], 0, false); x = __builtin_amdgcn_cvt_pk_fp8_f32(v[2], v[3], x, true); ww[2 * bj + n] = (unsigned)x; }
                    w.x = ww[0]; w.y = ww[1]; w.z = ww[2]; w.w = ww[3];
                    *(u32x4*)(Y + (size_t)(ybase + r) * nv::D + col0) = w; } }
    }
};
}
constexpr int NTHR = 512;
constexpr int LDS_BYTES = 163840;
constexpr int MISC_OFF = 131072 + 320;
constexpr size_t MiB = 1u << 20;
constexpr size_t CTL_ZERO_BYTES = 96 * 1024;
constexpr int CW_BAR = 4096;
constexpr int CW_MOE = 16384;
constexpr int CW_FOXQ = 20992;
constexpr int CW_NRM = 20480;
constexpr int NPHASE = 9;
constexpr size_t WS_H1 = 1, WS_WR = 65, WS_STATS = 66, WS_LF = 67, WS_FG = 68, WS_WO = 72, WS_WIN = 74, WS_TK = 81, WS_LTOK = 83, WS_LGATE = 91,
                 WS_WED = 100, WS_HID = 230, WS_GLA = 230, WS_WEG = 416, WS_XN = 673, WS_YBF = 673, WS_QKV = 737, WS_Z1 = 737, WS_LG = 865, WS_Y = 416, WS_END = 992;

struct Args { const float* in[21]; float* out; unsigned char* ws; int ph_lo, ph_hi, li, pad; };

__global__ void __launch_bounds__(NTHR, 2) mega_fwd(Args a) {
    using namespace nv;
    extern __shared__ __attribute__((aligned(16))) unsigned char lds[];
    const int G = gridDim.x, bx = blockIdx.x;
    const int vcu = (G % 8 == 0) ? (bx % 8) * (G / 8) + bx / 8 : bx;
    int tid, lane, wave, vw;
#define DERIVE() do { int t_ = threadIdx.x; asm volatile("" : "+v"(t_)); tid = t_; lane = tid & 63; wave = __builtin_amdgcn_readfirstlane(tid >> 6); vw = vcu * 8 + wave; } while (0)
    DERIVE();
    volatile LAS unsigned* MISC = (volatile LAS unsigned*)((LAS unsigned char*)lds + MISC_OFF);
    for (int u = tid; u < (LDS_BYTES - 131072) / 4; u += NTHR) ((LAS unsigned*)((LAS unsigned char*)lds + 131072))[u] = 0u;
    __syncthreads();
    unsigned char* ws = a.ws;
    unsigned* ctl = (unsigned*)ws;
    XcdBarrier bar = xcd_barrier_post(ctl + CW_BAR + a.li * XCD_BAR_WORDS, MISC + 8);
    const float* x = a.in[0];
    const float* ln_in_g = a.in[1]; const float* ln_in_b = a.in[2];
    const float* w_in = a.in[3]; const float* b_fgate = a.in[4];
    const float* w_gate_up = a.in[5]; const float* b_gate = a.in[6]; const float* g_gla = a.in[7];
    const float* w_out = a.in[8]; const float* ln1_g = a.in[9]; const float* ln1_b = a.in[10];
    const float* w_router = a.in[11]; const float* rbias = a.in[12];
    const float* w_eg = a.in[13]; const float* w_eu = a.in[14]; const float* w_ed = a.in[15];
    const float* w_sg = a.in[16]; const float* w_su = a.in[17]; const float* w_sd = a.in[18];
    const float* ln2_g = a.in[19]; const float* ln2_b = a.in[20];
    float* out = a.out;
    int* counts = (int*)(ctl + CW_MOE);
    fx::bf16* H1 = (fx::bf16*)(ws + WS_H1 * MiB);
    fx::bf16* WrT = (fx::bf16*)(ws + WS_WR * MiB);
    float* stats = (float*)(ws + WS_STATS * MiB);
    float* LF = (float*)(ws + WS_LF * MiB);
    float* FG = (float*)(ws + WS_FG * MiB);
    fx::bf16* WoT = (fx::bf16*)(ws + WS_WO * MiB);
    fx::bf16* WinT = (fx::bf16*)(ws + WS_WIN * MiB);
    int* TK = (int*)(ws + WS_TK * MiB);
    float* TW = (float*)(ws + (WS_TK + 1) * MiB);
    int* list_tok = (int*)(ws + WS_LTOK * MiB);
    float* list_gate = (float*)(ws + WS_LGATE * MiB);
    fx::bf16* WedT = (fx::bf16*)(ws + WS_WED * MiB);
    fx::bf16* HID = (fx::bf16*)(ws + WS_HID * MiB);
    unsigned char* QPG = ws + WS_GLA * MiB; unsigned char* OIb = ws + (WS_GLA + 16) * MiB; unsigned char* UUb = ws + (WS_GLA + 80) * MiB; float* DECb = (float*)(ws + (WS_GLA + 144) * MiB); unsigned char* AGGb = ws + (WS_GLA + 145) * MiB; float* DAGGb = (float*)(ws + (WS_GLA + 153) * MiB);
    fx::bf16* WegT = (fx::bf16*)(ws + WS_WEG * MiB);
    fx::bf16* XN = (fx::bf16*)(ws + WS_XN * MiB);
    fx::bf16* Ybf = (fx::bf16*)(ws + WS_YBF * MiB);
    fx::bf16* QKV = (fx::bf16*)(ws + WS_QKV * MiB);
    fx::bf16* MIX = (fx::bf16*)(ws + WS_Z1 * MiB);
    float* LG = (float*)(ws + WS_LG * MiB);
    unsigned char* YA = ws + WS_Y * MiB;
    mo::lint tb = (mo::lint)((LAS unsigned char*)lds + mo::L_TB), yb = (mo::lint)((LAS unsigned char*)lds + mo::L_YB), cn = (mo::lint)((LAS unsigned char*)lds + mo::L_CN), ut = (mo::lint)((LAS unsigned char*)lds + mo::L_UT), rg = (mo::lint)((LAS unsigned char*)lds + mo::L_RG);

    const int lo = a.ph_lo, hi = a.ph_hi;
    bool tables_ready = false;
#define IN(k) (lo <= (k) && (k) < hi)
#define SEAM(k) do { if (IN(k) && IN((k) + 1)) xcd_barrier(bar); DERIVE(); } while (0)
    const int GW = G * 8;
#ifndef STG7
#define STG7 0
#endif
#ifndef STG8
#define STG8 0
#endif
#define STAGGER(q) do { if ((q) > 0) { const unsigned long long t0_ = __builtin_amdgcn_s_memrealtime(); const unsigned long long d_ = (unsigned long long)((vcu & 3) * (q)); while (__builtin_amdgcn_s_memrealtime() - t0_ < d_) __builtin_amdgcn_s_sleep(8); } } while (0)

    if (IN(0)) {
        LAS float* scr = (LAS float*)((LAS unsigned char*)lds + wave * 16384);
        constexpr int I_IN = 16 * (fx::NIN / 32), I_OUT = 16 * 32, I_R = 16 * 8, I_SMALL = I_IN + I_OUT + I_R;
        for (int it = vw; it < I_SMALL; it += GW) {
            int r = it;
            if (r < I_IN) { fx::transpose_item(w_in, D, INW, WinT, scr, r / (fx::NIN / 32), r % (fx::NIN / 32), lane, [](int d) { return fx::inproj_src(d); }); continue; } r -= I_IN;
            if (r < I_OUT) { fx::transpose_item(w_out, D, D, WoT, scr, r / 32, r % 32, lane, [](int d) { return d; }); continue; } r -= I_OUT;
            fx::transpose_item(w_router, D, NE, WrT, scr, r / 8, r % 8, lane, [](int d) { return d; });
        }
        for (int r = vw * 4; r < T; r += GW * 4) fx::ln_rows_bf16<4>(x + (size_t)r * D, ln_in_g, ln_in_b, XN + (size_t)r * D, lane, stats + 2 * (size_t)r);
    }
    SEAM(0);
    if (IN(1)) {
        const mo::ExpW XW{w_eg, w_eu, w_ed, w_sg, w_su, w_sd, WegT, WedT};
#ifndef MIXG
#define MIXG 2
#endif
        #ifndef SLOT_XCD
#define SLOT_XCD 0
#endif
        { const int slot = SLOT_XCD ? (bx & 7) % MIXG : vcu % MIXG; pg8::StaticOrder S; S.init(T, fx::NIN, G, bx);
          const int nun = (S.nwg - bx + G - 1) / G, nb = (MIXG > 1) ? nun * slot / (MIXG - 1) : nun;
          pg8::Gemm g{XN, WinT, T, fx::NIN, D, D}; pg8::EpiInProj E{QKV, FG, LF, b_fgate, ctl + CW_NRM};
          if (nb > 0) { pg8::RangeOrder R{S, 0, nb}; pg8::gemm_phase<pg8::EpiInProj, pg8::RangeOrder, true, true>((LAS unsigned char*)lds, g, R, E); DERIVE(); }
          { LAS float* scr = (LAS float*)((LAS unsigned char*)lds + wave * 16384);
            const int nmax = (S.nwg + G - 1) / G, nlight = G * nmax - S.nwg;
#ifndef CONV_SKEW
#define CONV_SKEW 0.18f
#endif
            const bool two = (CONV_SKEW != 0.0f) && nlight > 0 && nlight < G;
            const float sk = CONV_SKEW < 0.f ? -CONV_SKEW : CONV_SKEW;
            const int nsub = (CONV_SKEW > 0.f) ? nlight : G - nlight;
#ifndef SLOT_SKEW
#define SLOT_SKEW -0.1f
#endif
            const bool three = (SLOT_SKEW != 0.0f) && MIXG == 2 && !SLOT_XCD && (G % 16 == 0);
            const float ssk = SLOT_SKEW < 0.f ? -SLOT_SKEW : SLOT_SKEW;
            const int n2 = three ? mo::I_EXP - (int)(ssk * 0.5f * (float)mo::I_EXP) : mo::I_EXP;
            const int n1 = two ? n2 - (int)(sk * (float)mo::I_EXP * (float)nsub / (float)G) : n2;
            mo::expert_conv(XW, scr, vw, GW, n1, lane);
            const bool light = bx >= G - nlight;
            if (two && (light == (CONV_SKEW > 0.f))) { const int rank = light ? bx - (G - nlight) : bx; mo::expert_conv(XW, scr, n1 + rank * 8 + wave, nsub * 8, n2, lane); }
            if (three && ((slot == 0) == (SLOT_SKEW > 0.f))) { const int rank = (bx / 16) * 8 + (bx & 7); mo::expert_conv(XW, scr, n2 + rank * 8 + wave, (G / 2) * 8, mo::I_EXP, lane); } }
          __syncthreads(); DERIVE();
          if (nb < nun) { pg8::RangeOrder R{S, nb, nun - nb}; pg8::gemm_phase<pg8::EpiInProj, pg8::RangeOrder, true, true>((LAS unsigned char*)lds, g, R, E); } }
    }
    SEAM(1);
    if (IN(2)) {
        int cur_h = -1;
        for (int blk = vcu; blk < gl::NUNIT / 8; blk += G) gl::prep_block(blk, QKV, FG, w_gate_up, b_gate, QPG, OIb, UUb, DECb, AGGb, DAGGb, lds, cur_h);
    }
    SEAM(2);
    if (IN(3)) {
        for (int blk = vcu; blk < gl::NUNIT / 8; blk += G) gl::post_block(blk * 8, 8, QKV, QPG, OIb, UUb, DECb, AGGb, DAGGb, g_gla, Ybf, lds);
        { const attn_body::AttnTensors AT{(const attn_body::bf16*)(QKV + fx::P_FQ), (const attn_body::bf16*)(QKV + fx::P_FK), (const attn_body::bf16*)(QKV + fx::P_FV), (attn_body::bf16*)Ybf, LF, ctl + CW_NRM};
          attn_body::attn_phase_dyn<8>((char*)lds, AT, ctl + CW_FOXQ, (volatile int*)(lds + 140288), (G % 8 == 0) ? vcu / (G / 8) : vcu % 8); }
    }
    SEAM(3);
    if (IN(4)) {
        pg8::DenseSched DS; DS.so.init(T, D, G, bx); DS.Bt = WoT; DS.ldb = D;
        pg8::EpiPlainBf16 E{MIX, D};
        pg8::gemm_phase2<pg8::EpiPlainBf16, pg8::DenseSched>((LAS unsigned char*)lds, Ybf, D, D, D, DS, E);
    }
    SEAM(4);
    if (IN(5)) {
        int* lcnt = (int*)(lds + 136192); int* lbase = lcnt + 256;
        for (int rb = vcu; rb < T / 128; rb += G) {
            if (tid < 256) lcnt[tid] = 0;
            for (int r = wave * 16; r < wave * 16 + 16; r += 4) { const size_t row = (size_t)rb * 128 + r;
                fx::ln1_rows_bf16<4>(x + row * D, stats + 2 * row, ln_in_g, ln_in_b, MIX + row * D, ln1_g, ln1_b, H1 + row * D, ALPHA, lane); }
            asm volatile("s_waitcnt vmcnt(0)" ::: "memory"); __syncthreads();
            { pg8::RouterSched RS{rb, WrT}; pg8::EpiLogits E{LG};
              pg8::gemm_phase2<pg8::EpiLogits, pg8::RouterSched>((LAS unsigned char*)lds, H1, D, D, D, RS, E); }
            DERIVE();
            for (int t = rb * 128 + wave * 2; t < rb * 128 + 128; t += 16) mo::route_token2(LG, rbias, lcnt, TK, TW, t, lane);
            __syncthreads();
            if (tid < 256) { const int c = lcnt[tid]; lbase[tid] = c ? atomicAdd(&counts[tid], c) : 0; }
            __syncthreads();
            for (int t = rb * 128 + wave * 2; t < rb * 128 + 128; t += 16) mo::route_finish2(lbase, list_tok, list_gate, TK, TW, t, lane);
            __syncthreads();
        }
    }
    SEAM(5);
    if (IN(6)) {
        if (wave == 0) mo::moe_tables(counts, tb, yb, cn, lane);
        __syncthreads(); tables_ready = true;
        STAGGER(STG7);
        pg8::MoeSched<0> MS{G, vcu, tb[257], tb, cn, list_tok, WegT, ut, rg}; if (wave == 0) MS.build(lane); __syncthreads(); MS.fill_rows(list_gate, tid); __syncthreads(); pg8::EpiSwiGLU E{HID, rg, a.pad};
        pg8::gemm_phase2<pg8::EpiSwiGLU, pg8::MoeSched<0>>((LAS unsigned char*)lds, H1, D, D, D, MS, E);
    }
    SEAM(6);
    if (IN(7)) {
        if (!tables_ready) { if (wave == 0) mo::moe_tables(counts, tb, yb, cn, lane); __syncthreads(); tables_ready = true; }
        STAGGER(STG8);
        pg8::MoeSched<1> MS{G, vcu, tb[257], tb, cn, list_tok, WedT, ut, rg}; if (wave == 0) MS.build(lane); __syncthreads(); pg8::EpiDown E{YA, yb, a.pad};
        pg8::gemm_phase2<pg8::EpiDown, pg8::MoeSched<1>>((LAS unsigned char*)lds, HID, 64, ED, ED, MS, E, 32768);
    }
    SEAM(7);
    if (IN(8)) {
        if (!tables_ready) { if (wave == 0) mo::moe_tables(counts, tb, yb, cn, lane); __syncthreads(); tables_ready = true; }
        for (int t = vw; t < T; t += GW) mo::combine_token(H1, YA, TK, yb, ln2_g, ln2_b, out, t, lane);
    }
#undef IN
#undef SEAM
}

extern "C" void kernel_launch(void* const* d_in, const int* in_sizes, int n_in, void* d_out, int out_size, void* d_ws, size_t ws_size, hipStream_t stream) {
    static int grid = 0;
    if (grid == 0) {
        if (n_in != 21 || out_size != nv::T * nv::D || ws_size < WS_END * MiB) { fprintf(stderr, "kernel_launch: unexpected shapes n_in=%d out=%d ws=%zu\n", n_in, out_size, ws_size); grid = -1; return; }
        int dev = 0, cus = 0;
        if (hipGetDevice(&dev) != hipSuccess || hipDeviceGetAttribute(&cus, hipDeviceAttributeMultiprocessorCount, dev) != hipSuccess) { grid = -1; return; }
        if (hipFuncSetAttribute((const void*)mega_fwd, hipFuncAttributeMaxDynamicSharedMemorySize, LDS_BYTES) != hipSuccess) { fprintf(stderr, "kernel_launch: hipFuncSetAttribute failed\n"); grid = -1; return; }
        grid = cus;
    }
    if (grid < 0) return;
    if (hipMemsetAsync(d_ws, 0, CTL_ZERO_BYTES, stream) != hipSuccess) return;
    Args a{};
    for (int i = 0; i < 21; ++i) a.in[i] = (const float*)d_in[i];
    a.out = (float*)d_out; a.ws = (unsigned char*)d_ws; a.ph_lo = 0; a.ph_hi = NPHASE; a.li = 0;
#ifdef REPEAT_PH
    a.ph_hi = REPEAT_PH + 1; hipLaunchKernelGGL(mega_fwd, dim3(grid), dim3(NTHR), LDS_BYTES, stream, a);
    if (REPEAT_PH == 3) hipMemsetAsync((char*)d_ws + CW_FOXQ * 4, 0, 256, stream);
    if (REPEAT_PH == 5) hipMemsetAsync((char*)d_ws + CW_MOE * 4, 0, 4096, stream);
    a.ph_lo = REPEAT_PH; a.ph_hi = NPHASE; a.li = 1;
#ifdef REPEAT_NOEPI
    a.ph_hi = REPEAT_PH + 1; a.pad = 1; hipLaunchKernelGGL(mega_fwd, dim3(grid), dim3(NTHR), LDS_BYTES, stream, a); a.pad = 0; a.ph_lo = REPEAT_PH + 1; a.ph_hi = NPHASE; a.li = 2;
#endif
#endif
    hipLaunchKernelGGL(mega_fwd, dim3(grid), dim3(NTHR), LDS_BYTES, stream, a);
}
```

```cpp
#include <hip/hip_runtime.h>
#include <cstdio>
#include <cstdint>
#include <cmath>

#define LAS __attribute__((address_space(3)))
#define GAS __attribute__((address_space(1)))

#define XB_TMO      128
#define XB_XCNT(j)  (256  + 64 * (j))
#define XB_XSUB(j)  (1280 + 64 * (j))
#define XB_XGEN(j)  (2304 + 64 * (j))
#define XB_TOP      3328
#define XB_TOPGEN   3392
#define XCD_BAR_WORDS 3456
#define XB_SPIN_CAP (1u << 27)
__device__ __forceinline__ unsigned xb_ld(unsigned* p)              { return __hip_atomic_load(p, __ATOMIC_RELAXED, __HIP_MEMORY_SCOPE_AGENT); }
__device__ __forceinline__ unsigned xb_add(unsigned* p, unsigned v) { return __hip_atomic_fetch_add(p, v, __ATOMIC_RELAXED, __HIP_MEMORY_SCOPE_AGENT); }
__device__ __forceinline__ unsigned xb_xcc_id() { return (unsigned)__builtin_amdgcn_s_getreg((3 << 11) | 20) & 0xFu; }
#define XB_SPIN(cond, bar) do { unsigned _sp = 0; while (cond) { __builtin_amdgcn_s_sleep(1); \
    if ((++_sp & 255u) == 0u) { if (xb_ld(&(bar)[XB_TMO])) break; if (_sp > XB_SPIN_CAP) { atomicAdd(&(bar)[XB_TMO], 1u); break; } } } } while (0)
struct XcdBarrier { unsigned* bar; unsigned x; volatile LAS unsigned* st; };
__device__ __forceinline__ XcdBarrier xcd_barrier_post(unsigned* bar, volatile LAS unsigned* st) {
    XcdBarrier b; b.bar = bar; b.x = xb_xcc_id(); b.st = st;
    if (threadIdx.x == 0) (void)xb_add(&bar[XB_XCNT(b.x)], 1u);
    return b;
}
__device__ __forceinline__ void xcd_barrier_complete(unsigned* bar, unsigned x, unsigned& nloc, unsigned& nx) {
    const unsigned G = gridDim.x * gridDim.y * gridDim.z;
    unsigned sum, cnt, mine, sp = 0u;
    for (;;) {
        sum = 0u; cnt = 0u; mine = 0u;
#pragma unroll
        for (unsigned j = 0; j < 16; ++j) { const unsigned c = xb_ld(&bar[XB_XCNT(j)]); sum += c; cnt += (c > 0u) ? 1u : 0u; mine = (j == x) ? c : mine; }
        if (sum == G) break;
        __builtin_amdgcn_s_sleep(1);
        if ((++sp & 255u) == 0u) { if (xb_ld(&bar[XB_TMO])) break; if (sp > XB_SPIN_CAP) { atomicAdd(&bar[XB_TMO], 1u); break; } }
    }
    nloc = mine > 0u ? mine : 1u; nx = cnt > 0u ? cnt : 1u;
}
__device__ __forceinline__ void xcd_barrier(const XcdBarrier& b) {
    asm volatile("s_waitcnt vmcnt(0)" ::: "memory");
    __syncthreads();
    if (threadIdx.x == 0) {
        unsigned* bar = b.bar;
        __builtin_amdgcn_s_waitcnt(0);
        unsigned nloc = b.st[0], nx = b.st[1];
        if (nloc == 0u) { xcd_barrier_complete(bar, b.x, nloc, nx); b.st[0] = nloc; b.st[1] = nx; }
        const unsigned old = xb_add(&bar[XB_XSUB(b.x)], 1u);
        const unsigned gen = old / nloc;
        if (old + 1u == (gen + 1u) * nloc) {
            __builtin_amdgcn_fence(__ATOMIC_RELEASE, "agent");
            asm volatile("s_waitcnt vmcnt(0)" ::: "memory");
            const unsigned og = xb_add(&bar[XB_TOP], 1u);
            const unsigned tg = og / nx;
            if (og + 1u == (tg + 1u) * nx) xb_add(&bar[XB_TOPGEN], 1u);
            else XB_SPIN(xb_ld(&bar[XB_TOPGEN]) == tg, bar);
            __builtin_amdgcn_fence(__ATOMIC_ACQUIRE, "agent");
            xb_add(&bar[XB_XGEN(b.x)], 1u);
            asm volatile("s_waitcnt vmcnt(0)" ::: "memory");
        } else {
            XB_SPIN(xb_ld(&bar[XB_XGEN(b.x)]) == gen, bar);
            __builtin_amdgcn_fence(__ATOMIC_ACQUIRE, "agent");
            asm volatile("s_waitcnt vmcnt(0)" ::: "memory");
        }
    }
    __syncthreads();
}
namespace pg8 {
#define PG8_LAS __attribute__((address_space(3)))
typedef unsigned short bf16_t;
typedef short bf16x8 __attribute__((ext_vector_type(8)));
typedef float f32x4 __attribute__((ext_vector_type(4)));
typedef unsigned u32x4 __attribute__((ext_vector_type(4)));
constexpr int BM = 256, BK = 64, HALF = 128, HTB = HALF * BK * 2  , STAGE_BYTES = 8 * HTB, NXCD = 8, WGM = 8;

__host__ __device__ __forceinline__ int lds_byte(int r, int c) { const int st = (r >> 4) * 2 + (c >> 5), rr = r & 15, cc = c & 31, ob = rr * 64 + cc * 2; return st * 1024 + (ob ^ (((ob >> 9) & 1) << 5)); }
__host__ __device__ __forceinline__ void stage_rc(int b, int& R, int& C) { const int st = b / 1024, sb = b % 1024, swz = sb ^ (((sb >> 9) & 1) << 5); R = (st >> 1) * 16 + swz / 64; C = (st & 1) * 32 + (swz % 64) / 2; }
__host__ __device__ __forceinline__ int perm32(int rho) { const int n = rho >> 4, i = rho & 15; return 8 * (i >> 2) + 4 * n + (i & 3); }

struct Unit { int pm, pn; };
struct Gemm { const bf16_t* A; const bf16_t* Bt; int M, N, K, lda; };

struct StaticOrder {
    int nM, nN, nwg, G, c;
    __host__ __device__ void init(int M, int N, int G_, int c_) { nM = M / BM; nN = N / BM; nwg = nM * nN; G = G_; c = c_; }
    __host__ __device__ bool next(int i, Unit& u) const {
        const long L = (long)i * G + c; if (L >= nwg) return false;
        int wgid = (int)L; { const int q = nwg / NXCD, r = nwg % NXCD, xcd = wgid % NXCD, off = wgid / NXCD; wgid = (xcd < r ? xcd * (q + 1) : r * (q + 1) + (xcd - r) * q) + off; }
        const int nig = WGM * nN, gid = wgid / nig, fm = gid * WGM, gsz = (nM - fm) < WGM ? (nM - fm) : WGM;
        u.pm = fm + ((wgid % nig) % gsz); u.pn = (wgid % nig) / gsz; return true;
    }
    __device__ __forceinline__ void a_ready(const Unit&) const {}
    __device__ __forceinline__ void done(const Unit&) const {}
};

struct RangeOrder {
    StaticOrder so; int i0, n;
    __host__ __device__ bool next(int i, Unit& u) const { return i < n && so.next(i0 + i, u); }
    __device__ __forceinline__ void a_ready(const Unit&) const {}
    __device__ __forceinline__ void done(const Unit&) const {}
};
__device__ __forceinline__ unsigned cvt_pk_bf16(float lo, float hi) { unsigned r; asm volatile("v_cvt_pk_bf16_f32 %0, %1, %2" : "=v"(r) : "v"(lo), "v"(hi)); return r; }
typedef float f32x2 __attribute__((ext_vector_type(2)));
__device__ __forceinline__ f32x2 gelu_pk(f32x2 v) {
    const f32x2 av = __builtin_elementwise_abs(v), d = av * 0.2316418882f + 1.0f;
    f32x2 t; t.x = __builtin_amdgcn_rcpf(d.x); t.y = __builtin_amdgcn_rcpf(d.y);
    f32x2 q = t * 0.5307027145f + (-0.7265760135f); q = q * t + 0.7107068705f; q = q * t + (-0.142248368f); q = q * t + 0.127414796f; q = q * t;
    const f32x2 s = (v * v) * (-0.72134752044f);
    f32x2 e; e.x = __builtin_amdgcn_exp2f(s.x); e.y = __builtin_amdgcn_exp2f(s.y);
    const f32x2 m = v * (q * e), r = v - m;
    f32x2 o; o.x = v.x < 0.f ? m.x : r.x; o.y = v.y < 0.f ? m.y : r.y; return o;
}

template <int ACT  > struct EpiBf16 {
    static constexpr bool PERM = true, AFTER_DRAIN = false; static_assert(ACT == 0 || ACT == 1, "EpiBf16: ACT is 0 (none) or 1 (gelu_pk)");
    bf16_t* O; int ldc; const float* bias; int split_cols; size_t split_stride; float scale0;
    __device__ __forceinline__ void operator()(const f32x4 (&acc)[2][2][4][2], const Unit& u, int wr, int wc, int fr, int fq) const {
        const int row0 = u.pm * BM + wr * 64 + fr; int colt = u.pn * BM; bf16_t* base = O;
        float sc = 1.f; if (split_cols) { const int t = colt / split_cols; base += (size_t)t * split_stride; colt -= t * split_cols; if (t == 0) sc = scale0; }
        const int col0 = colt + wc * 32 + 8 * fq, bcol0 = u.pn * BM + wc * 32 + 8 * fq;
        f32x4 bv[2][2];
#pragma unroll
        for (int bj = 0; bj < 2; ++bj)
#pragma unroll
            for (int n = 0; n < 2; ++n) bv[bj][n] = bias ? *(const f32x4*)(bias + bcol0 + bj * HALF + 4 * n) : (f32x4){0.f, 0.f, 0.f, 0.f};
#pragma unroll
        for (int ai = 0; ai < 2; ++ai)
#pragma unroll
            for (int m = 0; m < 4; ++m) { bf16_t* rowp = base + (size_t)(row0 + ai * HALF + m * 16) * ldc + col0;
#pragma unroll
                for (int bj = 0; bj < 2; ++bj) { f32x4 v0 = acc[ai][bj][m][0] + bv[bj][0], v1 = acc[ai][bj][m][1] + bv[bj][1];
                    if (ACT == 1) { f32x2 a = gelu_pk((f32x2){v0[0], v0[1]}), b = gelu_pk((f32x2){v0[2], v0[3]}), c = gelu_pk((f32x2){v1[0], v1[1]}), d = gelu_pk((f32x2){v1[2], v1[3]});
                        v0 = (f32x4){a.x, a.y, b.x, b.y}; v1 = (f32x4){c.x, c.y, d.x, d.y}; }
                    v0 = v0 * sc; v1 = v1 * sc; u32x4 w; w.x = cvt_pk_bf16(v0[0], v0[1]); w.y = cvt_pk_bf16(v0[2], v0[3]); w.z = cvt_pk_bf16(v1[0], v1[1]); w.w = cvt_pk_bf16(v1[2], v1[3]);
                    *(u32x4*)(rowp + bj * HALF) = w; } }
    }
};

template <class Epi, class Sched, bool ALIGN_EPI = false, bool SP2 = false>
__device__ __forceinline__ void gemm_phase(PG8_LAS unsigned char* lds, const Gemm g, const Sched& S, const Epi& E) {
    const int tid = threadIdx.x, wid = __builtin_amdgcn_readfirstlane(tid >> 6), lane = tid & 63, wr = wid >> 2, wc = wid & 3, fr = lane & 15, fq = lane >> 4;
    const int K = g.K, nt = K / BK;
    unsigned voffA[2], voffB[2];
#pragma unroll
    for (int i = 0; i < 2; ++i) { int R, C; stage_rc(tid * 16 + i * 8192, R, C); const int Rb = Epi::PERM ? ((R & ~31) + perm32(R & 31)) : R;
        voffA[i] = (unsigned)(R * g.lda + C) * 2u; voffB[i] = (unsigned)(Rb * K + C) * 2u; }
    const size_t kstep = (size_t)(BK * 2);
    const size_t hstepA = (size_t)HALF * g.lda * 2, hstepB = (size_t)HALF * K * 2;
    const size_t tstepA = 2 * hstepA, tstepB = 2 * hstepB;
    const unsigned ldsw = (unsigned)wid * 1024u;
    const int aoff = lds_byte(wr * 64 + fr, fq * 8), boff = lds_byte(wc * 32 + fr, fq * 8);
#define PG8_SA(b, h) (((b) * 2 + (h)) * HTB)
#define PG8_SB(b, h) ((4 + (b) * 2 + (h)) * HTB)
#define PG8_STAGE(bufoff, gbase, voff) do { _Pragma("unroll") for (int _i = 0; _i < 2; ++_i) \
        __builtin_amdgcn_global_load_lds((const unsigned*)((const char*)(gbase) + (voff)[_i]), (PG8_LAS unsigned*)(lds + (bufoff) + ldsw + _i * 8192), 16, 0, 0); } while (0)
#define PG8_LDA(dst, b, h) do { _Pragma("unroll") for (int m = 0; m < 4; ++m) _Pragma("unroll") for (int k = 0; k < 2; ++k) dst[m][k] = *(const PG8_LAS bf16x8*)(lds + PG8_SA(b, h) + aoff + m * 2048 + k * 1024); } while (0)
#define PG8_LDB(dst, b, h) do { _Pragma("unroll") for (int n = 0; n < 2; ++n) _Pragma("unroll") for (int k = 0; k < 2; ++k) dst[n][k] = *(const PG8_LAS bf16x8*)(lds + PG8_SB(b, h) + boff + n * 2048 + k * 1024); } while (0)
#define PG8_MMA(ai, bj, At, Bt) do { __builtin_amdgcn_s_setprio(1); _Pragma("unroll") for (int m = 0; m < 4; ++m) _Pragma("unroll") for (int n = 0; n < 2; ++n) _Pragma("unroll") for (int k = 0; k < 2; ++k) \
        acc[ai][bj][m][n] = __builtin_amdgcn_mfma_f32_16x16x32_bf16(Bt[n][k], At[m][k], acc[ai][bj][m][n], 0, 0, 0); __builtin_amdgcn_s_setprio(0); } while (0)
#define PG8_WAIT_V(n) asm volatile("s_waitcnt vmcnt(" #n ")" ::: "memory")
#define PG8_WAIT_L(n) asm volatile("s_waitcnt lgkmcnt(" #n ")" ::: "memory")
#define PG8_BAR __builtin_amdgcn_s_barrier()
#define PG8_SCHED __builtin_amdgcn_sched_barrier(0)
    Unit cur, nxt; int ui = 0;
    if (!S.next(0, cur)) return;
    f32x4 acc[2][2][4][2];
#pragma unroll
    for (int a = 0; a < 2; ++a)
#pragma unroll
        for (int b = 0; b < 2; ++b)
#pragma unroll
            for (int m = 0; m < 4; ++m)
#pragma unroll
                for (int n = 0; n < 2; ++n) acc[a][b][m][n] = (f32x4){0.f, 0.f, 0.f, 0.f};
    bf16x8 At[4][2], B0[2][2], B1[2][2];
    const char* cA = (const char*)g.A + (size_t)cur.pm * tstepA; const char* cB = (const char*)g.Bt + (size_t)cur.pn * tstepB;
    S.a_ready(cur);
    if constexpr (SP2) {
        PG8_STAGE(PG8_SB(0, 0), cB, voffB); PG8_STAGE(PG8_SB(0, 1), cB + hstepB, voffB); PG8_STAGE(PG8_SA(0, 0), cA, voffA); PG8_STAGE(PG8_SA(0, 1), cA + hstepA, voffA);
        if (wr == 1) PG8_BAR;
        PG8_WAIT_V(2); PG8_BAR;
        PG8_STAGE(PG8_SB(1, 0), cB + kstep, voffB); PG8_STAGE(PG8_SA(1, 0), cA + kstep, voffA); PG8_STAGE(PG8_SB(1, 1), cB + hstepB + kstep, voffB);
        PG8_WAIT_V(6); PG8_BAR;
    } else {
        PG8_STAGE(PG8_SB(0, 0), cB, voffB); PG8_STAGE(PG8_SA(0, 0), cA, voffA); PG8_STAGE(PG8_SB(0, 1), cB + hstepB, voffB); PG8_STAGE(PG8_SA(0, 1), cA + hstepA, voffA);
        if (wr == 1) PG8_BAR;
        PG8_WAIT_V(4); PG8_BAR;
        PG8_STAGE(PG8_SB(1, 0), cB + kstep, voffB); PG8_STAGE(PG8_SA(1, 0), cA + kstep, voffA); PG8_STAGE(PG8_SB(1, 1), cB + hstepB + kstep, voffB);
        PG8_WAIT_V(6); PG8_BAR;
    }
    for (;;) {
        const bool has_next = S.next(ui + 1, nxt);
        const char* nA = has_next ? (const char*)g.A + (size_t)nxt.pm * tstepA : cA; const char* nB = has_next ? (const char*)g.Bt + (size_t)nxt.pn * tstepB : cB;
        for (int t = 0; t < nt; t += 2) {
            const bool last = (t == nt - 2);
            const char* a1 = cA + (size_t)(t + 1) * kstep;
            const char* a2 = last ? nA : cA + (size_t)(t + 2) * kstep; const char* b2 = last ? nB : cB + (size_t)(t + 2) * kstep;
            const char* a3 = a2 + kstep; const char* b3 = b2 + kstep;
            if (last && has_next) S.a_ready(nxt);
            if constexpr (SP2) {
            PG8_LDB(B0, 0, 0); PG8_LDB(B1, 0, 1); PG8_SCHED; PG8_LDA(At, 0, 0); PG8_STAGE(PG8_SA(1, 1), a1 + hstepA, voffA);
            PG8_WAIT_V(8); PG8_WAIT_L(0); PG8_BAR; PG8_MMA(0, 0, At, B0); PG8_MMA(0, 1, At, B1); PG8_BAR; PG8_SCHED;
            PG8_LDA(At, 0, 1); PG8_STAGE(PG8_SB(0, 0), b2, voffB); PG8_STAGE(PG8_SB(0, 1), b2 + hstepB, voffB); PG8_STAGE(PG8_SA(0, 0), a2, voffA);
            PG8_WAIT_V(8); PG8_WAIT_L(0); PG8_BAR; PG8_MMA(1, 0, At, B0); PG8_MMA(1, 1, At, B1); PG8_BAR; PG8_SCHED;
            PG8_LDB(B0, 1, 0); PG8_LDB(B1, 1, 1); PG8_SCHED; PG8_LDA(At, 1, 0); PG8_STAGE(PG8_SA(0, 1), a2 + hstepA, voffA);
            PG8_WAIT_V(8); PG8_WAIT_L(0); PG8_BAR; PG8_MMA(0, 0, At, B0); PG8_MMA(0, 1, At, B1); PG8_BAR; PG8_SCHED;
            PG8_LDA(At, 1, 1); PG8_STAGE(PG8_SB(1, 0), b3, voffB); PG8_STAGE(PG8_SB(1, 1), b3 + hstepB, voffB); PG8_STAGE(PG8_SA(1, 0), a3, voffA);
            PG8_WAIT_V(8); PG8_WAIT_L(0); PG8_BAR; PG8_MMA(1, 0, At, B0); PG8_MMA(1, 1, At, B1); PG8_BAR; PG8_SCHED;
            } else {
            PG8_LDB(B0, 0, 0); PG8_SCHED; PG8_LDA(At, 0, 0); PG8_STAGE(PG8_SA(1, 1), a1 + hstepA, voffA);
            PG8_WAIT_L(8); PG8_BAR; PG8_WAIT_L(0); PG8_MMA(0, 0, At, B0); PG8_BAR; PG8_SCHED;
            PG8_LDB(B1, 0, 1); PG8_STAGE(PG8_SB(0, 0), b2, voffB);
            PG8_BAR; PG8_WAIT_L(0); PG8_MMA(0, 1, At, B1); PG8_BAR;
            PG8_LDA(At, 0, 1); PG8_STAGE(PG8_SA(0, 0), a2, voffA);
            PG8_BAR; PG8_WAIT_L(0); PG8_MMA(1, 0, At, B0); PG8_BAR; PG8_SCHED;
            PG8_STAGE(PG8_SB(0, 1), b2 + hstepB, voffB);
            PG8_WAIT_V(6); PG8_BAR; PG8_MMA(1, 1, At, B1); PG8_BAR;
            PG8_LDB(B0, 1, 0); PG8_SCHED; PG8_LDA(At, 1, 0); PG8_STAGE(PG8_SA(0, 1), a2 + hstepA, voffA);
            PG8_WAIT_L(8); PG8_BAR; PG8_WAIT_L(0); PG8_MMA(0, 0, At, B0); PG8_BAR; PG8_SCHED;
            PG8_LDB(B1, 1, 1); PG8_STAGE(PG8_SB(1, 0), b3, voffB);
            PG8_BAR; PG8_WAIT_L(0); PG8_MMA(0, 1, At, B1); PG8_BAR;
            PG8_LDA(At, 1, 1); PG8_STAGE(PG8_SA(1, 0), a3, voffA);
            PG8_BAR; PG8_WAIT_L(0); PG8_MMA(1, 0, At, B0); PG8_BAR; PG8_SCHED;
            PG8_STAGE(PG8_SB(1, 1), b3 + hstepB, voffB);
            PG8_WAIT_V(6); PG8_BAR; PG8_MMA(1, 1, At, B1); PG8_BAR;
            }
        }
        if constexpr (ALIGN_EPI) { if (wr == 0) PG8_BAR; }
        if constexpr (!Epi::AFTER_DRAIN) { E(acc, cur, wr, wc, fr, fq); S.done(cur); }
        if (!has_next) break;
#pragma unroll
        for (int a = 0; a < 2; ++a)
#pragma unroll
            for (int b = 0; b < 2; ++b)
#pragma unroll
                for (int m = 0; m < 4; ++m)
#pragma unroll
                    for (int n = 0; n < 2; ++n) acc[a][b][m][n] = (f32x4){0.f, 0.f, 0.f, 0.f};
        cur = nxt; cA = nA; cB = nB; ++ui;
        if constexpr (ALIGN_EPI) { if (wr == 1) PG8_BAR; }
    }
    PG8_WAIT_V(0);
    if constexpr (!ALIGN_EPI) { if (wr == 0) PG8_BAR; }
    PG8_BAR;
    if constexpr (Epi::AFTER_DRAIN) { E.fused(acc, cur, wr, wc, fr, fq, lds, wid, lane); S.done(cur); }
#undef PG8_SA
#undef PG8_SB
#undef PG8_STAGE
#undef PG8_LDA
#undef PG8_LDB
#undef PG8_MMA
#undef PG8_WAIT_V
#undef PG8_WAIT_L
#undef PG8_BAR
#undef PG8_SCHED
}
}
namespace pg8 {
struct Unit2 { int pm, pn, e, cnt, jt, ui; };
template <class E, class = void> struct has_perm16 { static constexpr bool value = false; };
template <class E> struct has_perm16<E, decltype((void)E::PERM16)> { static constexpr bool value = E::PERM16; };
template <class E> constexpr bool perm16() { return has_perm16<E>::value; }
template <class Epi, class Sched>
__device__ __forceinline__ void gemm_phase2(PG8_LAS unsigned char* lds, const bf16_t* Abase, int lda, int ldb, int K, const Sched& S, const Epi& E, int kstepA_ = BK * 2) {
    int tid_ = threadIdx.x; asm volatile("" : "+v"(tid_));
    const int tid = tid_, wid = __builtin_amdgcn_readfirstlane(tid >> 6), lane = tid & 63, wr = wid >> 2, wc = wid & 3, fr = lane & 15, fq = lane >> 4;
    int K_ = K; asm volatile("" : "+s"(K_));
    const int nt = K_ / BK;
    unsigned voffB0[2], voffB1[2];
#pragma unroll
    for (int i = 0; i < 2; ++i) { int R, C; stage_rc(tid * 16 + i * 8192, R, C);
        if constexpr (perm16<Epi>()) { const int cb = 64 * (R >> 5) + 16 * ((R >> 2) & 3) + 4 * ((R >> 4) & 1) + (R & 3); voffB0[i] = (unsigned)(cb * ldb + C) * 2u; voffB1[i] = (unsigned)((cb + 8) * ldb + C) * 2u; }
        else { const int Rb = Epi::PERM ? ((R & ~31) + perm32(R & 31)) : R; voffB0[i] = (unsigned)(Rb * ldb + C) * 2u; voffB1[i] = voffB0[i] + (unsigned)(HALF * ldb * 2); } }
    const unsigned lda2 = (unsigned)lda * 2u;
#define PG8_AOFFS(U, o0, o1) do { int t2_ = threadIdx.x; asm volatile("" : "+v"(t2_)); _Pragma("unroll") for (int i_ = 0; i_ < 2; ++i_) { int R_, C_; stage_rc(t2_ * 16 + i_ * 8192, R_, C_); \
        o0[i_] = (unsigned)S.arow(U, R_) * lda2 + (unsigned)C_ * 2u; o1[i_] = (unsigned)S.arow(U, HALF + R_) * lda2 + (unsigned)C_ * 2u; } } while (0)
    const size_t kstep = (size_t)(BK * 2), kstepA = (size_t)kstepA_;
    const unsigned ldsw = (unsigned)wid * 1024u;
    const int aoff = lds_byte(wr * 64 + fr, fq * 8), boff = lds_byte(wc * 32 + fr, fq * 8);
#define PG8_SA(b, h) (((b) * 2 + (h)) * HTB)
#define PG8_SB(b, h) ((4 + (b) * 2 + (h)) * HTB)
#define PG8_STAGE(bufoff, gbase, voff) do { _Pragma("unroll") for (int _i = 0; _i < 2; ++_i) \
        __builtin_amdgcn_global_load_lds((const unsigned*)((const char*)(gbase) + (voff)[_i]), (PG8_LAS unsigned*)(lds + (bufoff) + ldsw + _i * 8192), 16, 0, 0); } while (0)
#define PG8_LDA(dst, b, h) do { _Pragma("unroll") for (int m = 0; m < 4; ++m) _Pragma("unroll") for (int k = 0; k < 2; ++k) dst[m][k] = *(const PG8_LAS bf16x8*)(lds + PG8_SA(b, h) + aoff + m * 2048 + k * 1024); } while (0)
#define PG8_LDB(dst, b, h) do { _Pragma("unroll") for (int n = 0; n < 2; ++n) _Pragma("unroll") for (int k = 0; k < 2; ++k) dst[n][k] = *(const PG8_LAS bf16x8*)(lds + PG8_SB(b, h) + boff + n * 2048 + k * 1024); } while (0)
#define PG8_MMA(ai, bj, At, Bt) do { __builtin_amdgcn_s_setprio(1); _Pragma("unroll") for (int m = 0; m < 4; ++m) _Pragma("unroll") for (int n = 0; n < 2; ++n) _Pragma("unroll") for (int k = 0; k < 2; ++k) \
        acc[ai][bj][m][n] = __builtin_amdgcn_mfma_f32_16x16x32_bf16(Bt[n][k], At[m][k], acc[ai][bj][m][n], 0, 0, 0); __builtin_amdgcn_s_setprio(0); } while (0)
#define PG8_WAIT_V(n) asm volatile("s_waitcnt vmcnt(" #n ")" ::: "memory")
#define PG8_WAIT_L(n) asm volatile("s_waitcnt lgkmcnt(" #n ")" ::: "memory")
#define PG8_BAR __builtin_amdgcn_s_barrier()
#define PG8_SCHED __builtin_amdgcn_sched_barrier(0)
    Unit2 cur, nxt; int ui = 0;
    if (!S.next(0, cur)) return;
    f32x4 acc[2][2][4][2];
#pragma unroll
    for (int a = 0; a < 2; ++a)
#pragma unroll
        for (int b = 0; b < 2; ++b)
#pragma unroll
            for (int m = 0; m < 4; ++m)
#pragma unroll
                for (int n = 0; n < 2; ++n) acc[a][b][m][n] = (f32x4){0.f, 0.f, 0.f, 0.f};
    bf16x8 At[4][2], B0[2][2], B1[2][2];
    unsigned cv0[2], cv1[2], nv0[2], nv1[2];
    PG8_AOFFS(cur, cv0, cv1);
    const char* cA = (const char*)Abase + S.aoff(cur); const char* cB = S.bptr(cur);
    PG8_STAGE(PG8_SB(0, 0), cB, voffB0); PG8_STAGE(PG8_SB(0, 1), cB, voffB1); PG8_STAGE(PG8_SA(0, 0), cA, cv0); PG8_STAGE(PG8_SA(0, 1), cA, cv1);
    if (wr == 1) PG8_BAR;
    PG8_WAIT_V(2); PG8_BAR;
    PG8_STAGE(PG8_SB(1, 0), cB + kstep, voffB0); PG8_STAGE(PG8_SA(1, 0), cA + kstepA, cv0); PG8_STAGE(PG8_SB(1, 1), cB + kstep, voffB1);
    PG8_WAIT_V(6); PG8_BAR;
    for (;;) {
        const bool has_next = S.next(ui + 1, nxt);
        const char* nA = has_next ? (const char*)Abase + S.aoff(nxt) : cA; const char* nB = has_next ? S.bptr(nxt) : cB;
#pragma unroll
        for (int i = 0; i < 2; ++i) { nv0[i] = cv0[i]; nv1[i] = cv1[i]; }
        if (has_next) PG8_AOFFS(nxt, nv0, nv1);
        const bool act0 = cur.cnt > wr * 64, act1 = cur.cnt > HALF + wr * 64;
        for (int t = 0; t < nt; t += 2) {
            const bool last = (t == nt - 2);
            const char* a1 = cA + (size_t)(t + 1) * kstepA;
            const char* a2 = last ? nA : cA + (size_t)(t + 2) * kstepA; const char* b2 = last ? nB : cB + (size_t)(t + 2) * kstep;
            const char* a3 = a2 + kstepA; const char* b3 = b2 + kstep;
            unsigned s0[2] = {cv0[0], cv0[1]}, s1[2] = {cv1[0], cv1[1]};
            if (last) { asm volatile("" ::: "memory"); s0[0] = nv0[0]; s0[1] = nv0[1]; s1[0] = nv1[0]; s1[1] = nv1[1]; }
            PG8_LDB(B0, 0, 0); PG8_LDB(B1, 0, 1); PG8_SCHED; PG8_LDA(At, 0, 0); PG8_STAGE(PG8_SA(1, 1), a1, cv1);
            PG8_WAIT_V(8); PG8_WAIT_L(0); PG8_BAR; if (act0) { PG8_MMA(0, 0, At, B0); PG8_MMA(0, 1, At, B1); } PG8_BAR; PG8_SCHED;
            PG8_LDA(At, 0, 1); PG8_STAGE(PG8_SB(0, 0), b2, voffB0); PG8_STAGE(PG8_SB(0, 1), b2, voffB1); PG8_STAGE(PG8_SA(0, 0), a2, s0);
            PG8_WAIT_V(8); PG8_WAIT_L(0); PG8_BAR; if (act1) { PG8_MMA(1, 0, At, B0); PG8_MMA(1, 1, At, B1); } PG8_BAR; PG8_SCHED;
            PG8_LDB(B0, 1, 0); PG8_LDB(B1, 1, 1); PG8_SCHED; PG8_LDA(At, 1, 0); PG8_STAGE(PG8_SA(0, 1), a2, s1);
            PG8_WAIT_V(8); PG8_WAIT_L(0); PG8_BAR; if (act0) { PG8_MMA(0, 0, At, B0); PG8_MMA(0, 1, At, B1); } PG8_BAR; PG8_SCHED;
            PG8_LDA(At, 1, 1); PG8_STAGE(PG8_SB(1, 0), b3, voffB0); PG8_STAGE(PG8_SB(1, 1), b3, voffB1); PG8_STAGE(PG8_SA(1, 0), a3, s0);
            PG8_WAIT_V(8); PG8_WAIT_L(0); PG8_BAR; if (act1) { PG8_MMA(1, 0, At, B0); PG8_MMA(1, 1, At, B1); } PG8_BAR; PG8_SCHED;
        }
        if (wr == 0) PG8_BAR;
        { Unit2 eu = cur; asm volatile("" : "+s"(eu.pm), "+s"(eu.pn), "+s"(eu.e), "+s"(eu.cnt), "+s"(eu.jt), "+s"(eu.ui));
          E(acc, eu, wr, wc, fr, fq);
          }
        if (!has_next) break;
#pragma unroll
        for (int a = 0; a < 2; ++a)
#pragma unroll
            for (int b = 0; b < 2; ++b)
#pragma unroll
                for (int m = 0; m < 4; ++m)
#pragma unroll
                    for (int n = 0; n < 2; ++n) acc[a][b][m][n] = (f32x4){0.f, 0.f, 0.f, 0.f};
        cur = nxt; cA = nA; cB = nB; ++ui;
#pragma unroll
        for (int i = 0; i < 2; ++i) { cv0[i] = nv0[i]; cv1[i] = nv1[i]; }
        if (wr == 1) PG8_BAR;
    }
    PG8_WAIT_V(0);
    PG8_BAR;
#undef PG8_AOFFS
#undef PG8_SA
#undef PG8_SB
#undef PG8_STAGE
#undef PG8_LDA
#undef PG8_LDB
#undef PG8_MMA
#undef PG8_WAIT_V
#undef PG8_WAIT_L
#undef PG8_BAR
#undef PG8_SCHED
}

struct DenseSched {
    StaticOrder so; const bf16_t* Bt; int ldb;
    __device__ __forceinline__ bool next(int i, Unit2& u) const { Unit t; if (!so.next(i, t)) return false; u.pm = t.pm; u.pn = t.pn; u.e = 0; u.cnt = 256; u.jt = 0; u.ui = i; return true; }
    __device__ __forceinline__ int arow(const Unit2& u, int r) const { return u.pm * BM + r; }
    __device__ __forceinline__ size_t aoff(const Unit2&) const { return 0; }
    __device__ __forceinline__ const char* bptr(const Unit2& u) const { return (const char*)(Bt + (size_t)u.pn * BM * ldb); }
};
struct EpiPlainBf16 {
    static constexpr bool PERM = true, AFTER_DRAIN = false;
    bf16_t* O; int ldc;
    __device__ __forceinline__ void operator()(const f32x4 (&acc)[2][2][4][2], const Unit2& u, int wr, int wc, int fr, int fq) const {
        const int row0 = u.pm * BM + wr * 64 + fr, col0 = u.pn * BM + wc * 32 + 8 * fq;
#pragma unroll
        for (int ai = 0; ai < 2; ++ai)
#pragma unroll
            for (int m = 0; m < 4; ++m) { bf16_t* rowp = O + (size_t)(row0 + ai * HALF + m * 16) * ldc + col0;
#pragma unroll
                for (int bj = 0; bj < 2; ++bj) { const f32x4 v0 = acc[ai][bj][m][0], v1 = acc[ai][bj][m][1];
                    u32x4 w; w.x = cvt_pk_bf16(v0[0], v0[1]); w.y = cvt_pk_bf16(v0[2], v0[3]); w.z = cvt_pk_bf16(v1[0], v1[1]); w.w = cvt_pk_bf16(v1[2], v1[3]);
                    *(u32x4*)(rowp + bj * HALF) = w; } }
    }
};
}
namespace nv {
constexpr int D = 1024, B = 8, S = 4096, T = B * S;
constexpr int FH = 8, FD = 64, GH = 4, GK = 64, GV = 128, RANK = 16;
constexpr int INW = 3096;
constexpr int O_FQ = 0, O_FK = 512, O_FV = 1024, O_FF = 1536, O_GQ = 1544, O_GK = 1800, O_GV = 2056, O_GA = 2568, O_GR = 2584;
constexpr int NE = 256, NG = 8, TOPK = 8, ED = 256;
constexpr float LN_EPS = 1e-5f;
constexpr float ALPHA = 1.189207115002721f;
constexpr int PADR = 64;
constexpr int APAD = T * TOPK + NE * PADR;

__device__ __forceinline__ float logsigmoidf(float x) { return fminf(x, 0.f) - log1pf(expf(-fabsf(x))); }
__device__ __forceinline__ float siluf(float x) { return x / (1.f + expf(-x)); }

}
#include <hip/hip_bf16.h>
#include <cmath>
namespace attn_body {
using bf16=__hip_bfloat16;
using bf16x8=__attribute__((ext_vector_type(8)))short;
using s16x4=__attribute__((ext_vector_type(4)))short;
using f32x16=__attribute__((ext_vector_type(16)))float;
using u32x4=__attribute__((ext_vector_type(4)))unsigned;
constexpr int BATCH=8,NHEAD=8,SEQ=4096,D=64,DM=3072,OPITCH=1024;
constexpr int NW=8,QBLK=32,QB=QBLK*NW,KVBLK=64,NQB=SEQ/QB;
constexpr int ATTN_PITCH=DM, ATTN_UNIT_ROWS=QB;
__device__ __forceinline__ int crow(int r,int hi){return (r&3)+8*(r>>2)+4*hi;}
#define SBAR() __builtin_amdgcn_sched_barrier(0)
__device__ __forceinline__ void cmask(f32x16&p0,f32x16&p1,int jb,int qrel,int hi){
  const float NEG=-INFINITY; int kb=64*jb+4*hi;
  #pragma unroll
  for(int r=0;r<16;++r){int kv=kb+(r&3)+8*(r>>2); if(kv>qrel)p0[r]=NEG; if(kv+32>qrel)p1[r]=NEG;}
}

constexpr int NSLOT=3, SLOTB=8192;
constexpr int LDS_K=0, LDS_V=NSLOT*SLOTB, LDS_WS=2*NSLOT*SLOTB, LDS_OST=LDS_WS+NW*64*4, LDS_KB=LDS_OST+NW*4096, LDS_BYTES=LDS_KB+(SEQ+2)*8;
constexpr float C2=0.125f*1.4426950408889634f;
__device__ __forceinline__ void glds16(const void*gsrc,unsigned lds_dst){unsigned keep;
  asm volatile("s_mov_b32 %0, m0\n\ts_mov_b32 m0, %2\n\ts_nop 0\n\tglobal_load_lds_dwordx4 %1, off\n\ts_mov_b32 m0, %0":"=&s"(keep):"v"(gsrc),"s"(lds_dst):"memory");}
__device__ __forceinline__ float max3f(float a,float b,float c){float r;asm("v_max3_f32 %0, %1, %2, %3":"=v"(r):"v"(a),"v"(b),"v"(c));return r;}
__device__ __forceinline__ float max2f(float a,float b){float r;asm("v_max_f32_e32 %0, %1, %2":"=v"(r):"v"(a),"v"(b));return r;}
__device__ __forceinline__ float fadd_s(float a,float b){float r;asm("v_add_f32_e32 %0, %1, %2":"=v"(r):"v"(a),"v"(b));return r;}
__device__ __forceinline__ float fsub_s(float a,float b){float r;asm("v_sub_f32_e32 %0, %1, %2":"=v"(r):"v"(a),"v"(b));return r;}
typedef float f32x2_t __attribute__((ext_vector_type(2))); typedef float f32x4_t __attribute__((ext_vector_type(4))); typedef __bf16 bf16x2_t __attribute__((ext_vector_type(2)));
__device__ __forceinline__ unsigned cvtpk_s(float lo,float hi){f32x2_t v={lo,hi};bf16x2_t b=__builtin_convertvector(v,bf16x2_t);return __builtin_bit_cast(unsigned,b);}
#define WAIT_BAR(N) asm volatile("s_waitcnt vmcnt(" #N ") lgkmcnt(0)\n\ts_barrier":::"memory")

__device__ __forceinline__ void split3(float b,unsigned&h,unsigned&m,unsigned&l){
  h=cvtpk_s(b,0.f)&0xffffu; const float r1=b-__uint_as_float(h<<16);
  m=cvtpk_s(r1,0.f)&0xffffu; const float r2=r1-__uint_as_float(m<<16);
  l=cvtpk_s(r2,0.f)&0xffffu; }
__device__ __forceinline__ bf16x8 kbias_frag(float b,int hi){unsigned h,m,l;split3(b,h,m,l);u32x4 w;w.x=h|(m<<16);w.y=l|0x3F800000u;w.z=0x3F803F80u;w.w=0u;if(hi){w.x=0u;w.y=0u;w.z=0u;}return __builtin_bit_cast(bf16x8,w);}
__device__ __forceinline__ bf16x8 qref_frag(float x,int hi){unsigned h,m,l;split3(x,h,m,l);u32x4 w;w.x=0x3F803F80u;w.y=0x3F80u|(h<<16);w.z=m|(l<<16);w.w=0u;if(hi){w.x=0u;w.y=0u;w.z=0u;}return __builtin_bit_cast(bf16x8,w);}
typedef unsigned u32x2_t __attribute__((ext_vector_type(2)));
__device__ __forceinline__ bf16x8 mkfrag(u32x2_t e,unsigned zc){u32x4 w;w.x=e.x;w.y=e.y;w.z=zc;w.w=0u;return __builtin_bit_cast(bf16x8,w);}
__device__ __forceinline__ void fox_bias_table(int b,int h,const float*LF,char*shm){
  int tid_=threadIdx.x; asm volatile("":"+v"(tid_)); const int tid=tid_,lane=tid&63,wid=__builtin_amdgcn_readfirstlane(tid>>6);
  const float*lf=LF+((long)b*NHEAD+h)*SEQ; float*wt=(float*)(shm+LDS_WS); u32x2_t*KB8=(u32x2_t*)(shm+LDS_KB);
  f32x4_t va=*(const f32x4_t*)(lf+8*tid),vb=*(const f32x4_t*)(lf+8*tid+4);
  va[1]+=va[0];va[2]+=va[1];va[3]+=va[2];vb[0]+=va[3];vb[1]+=vb[0];vb[2]+=vb[1];vb[3]+=vb[2];
  const float tot=vb[3]; float inc=tot;
  #pragma unroll
  for(int o_=1;o_<64;o_<<=1){const float nn=__shfl_up(inc,o_);if(lane>=o_)inc+=nn;}
  __syncthreads();
  if(lane==63)wt[wid*64]=inc;
  __syncthreads();
  float base=inc-tot;
  #pragma unroll
  for(int w_=0;w_<NW;++w_){const float x_=wt[w_*64]; if(w_<wid)base+=x_;}
  const float cv[8]={va[0]+base,va[1]+base,va[2]+base,va[3]+base,vb[0]+base,vb[1]+base,vb[2]+base,vb[3]+base};
  #pragma unroll
  for(int j=0;j<8;++j){unsigned hh,mm,ll;split3(-cv[j],hh,mm,ll);KB8[8*tid+j]=(u32x2_t){hh|(mm<<16),ll|0x3F800000u};}
  if(tid==0){KB8[SEQ]=(u32x2_t){0u,0u};KB8[SEQ+1]=(u32x2_t){0u,0u};}
  __syncthreads();
}
__device__ __forceinline__ void qkt(f32x16&p0,f32x16&p1,const char*Kslot,const bf16x8*qr,bf16x8 kb0,bf16x8 kb1,bf16x8 qx,int r32,int hi){
  const f32x16 negm=f32x16{};
  const char*kb=Kslot+hi*1024+r32*16;
  #pragma unroll
  for(int d0=0;d0<4;++d0){
    const bf16x8 b0=*reinterpret_cast<const bf16x8*>(kb+d0*2048);
    const bf16x8 b1=*reinterpret_cast<const bf16x8*>(kb+d0*2048+512);
    if(d0==0){p0=__builtin_amdgcn_mfma_f32_32x32x16_bf16(b0,qr[0],negm,0,0,0);p1=__builtin_amdgcn_mfma_f32_32x32x16_bf16(b1,qr[0],negm,0,0,0);}
    else{p0=__builtin_amdgcn_mfma_f32_32x32x16_bf16(b0,qr[d0],p0,0,0,0);p1=__builtin_amdgcn_mfma_f32_32x32x16_bf16(b1,qr[d0],p1,0,0,0);}}
  p0=__builtin_amdgcn_mfma_f32_32x32x16_bf16(kb0,qx,p0,0,0,0);p1=__builtin_amdgcn_mfma_f32_32x32x16_bf16(kb1,qx,p1,0,0,0);
}
typedef __attribute__((address_space(3))) const char* lds_cptr;
typedef short v4i16_t __attribute__((ext_vector_type(4)));
__device__ __forceinline__ void kload8(bf16x8*kf,lds_cptr kp){
  kf[0]=*(const __attribute__((address_space(3))) bf16x8*)(kp);      kf[1]=*(const __attribute__((address_space(3))) bf16x8*)(kp+512);
  kf[2]=*(const __attribute__((address_space(3))) bf16x8*)(kp+2048); kf[3]=*(const __attribute__((address_space(3))) bf16x8*)(kp+2560);
  kf[4]=*(const __attribute__((address_space(3))) bf16x8*)(kp+4096); kf[5]=*(const __attribute__((address_space(3))) bf16x8*)(kp+4608);
  kf[6]=*(const __attribute__((address_space(3))) bf16x8*)(kp+6144); kf[7]=*(const __attribute__((address_space(3))) bf16x8*)(kp+6656);
}
__device__ __forceinline__ void kload2(bf16x8*kf,lds_cptr kp,int j){ kf[2*j]=*(const __attribute__((address_space(3))) bf16x8*)(kp+j*2048); kf[2*j+1]=*(const __attribute__((address_space(3))) bf16x8*)(kp+j*2048+512); }
__device__ __forceinline__ s16x4 vtr(lds_cptr p){ return __builtin_bit_cast(s16x4,__builtin_amdgcn_ds_read_tr16_b64_v4i16((__attribute__((address_space(3))) v4i16_t*)p)); }
__device__ __forceinline__ float rowmax(const f32x16&p0,const f32x16&p1){
  float a=max3f(p0[0],p0[1],p1[0]),b=max3f(p0[2],p0[3],p1[1]);a=max3f(a,p1[2],p1[3]);
  #pragma unroll
  for(int r=4;r<16;r+=4){a=max3f(a,p0[r],p0[r+1]);b=max3f(b,p0[r+2],p0[r+3]);a=max3f(a,p1[r],p1[r+1]);b=max3f(b,p1[r+2],p1[r+3]);}
  const float m=max2f(a,b);
  auto rr=__builtin_amdgcn_permlane32_swap(__float_as_uint(m),__float_as_uint(m),false,false);
  return max2f(__uint_as_float(rr[0]),__uint_as_float(rr[1]));
}
__device__ __forceinline__ void pv(f32x16*o,int vb,bf16x8 pa0,bf16x8 pa1,bf16x8 pa2,bf16x8 pa3){
  #pragma unroll
  for(int d0=0;d0<2;++d0){s16x4 lo[4],hi[4];
    #pragma unroll
    for(int ks=0;ks<4;++ks){
      asm volatile("ds_read_b64_tr_b16 %0,%1 offset:%c2":"=&v"(lo[ks]):"v"(vb),"i"(d0*4096+ks*1024):"memory");
      asm volatile("ds_read_b64_tr_b16 %0,%1 offset:%c2":"=&v"(hi[ks]):"v"(vb),"i"(d0*4096+ks*1024+512):"memory");}
    asm volatile("s_waitcnt lgkmcnt(0)":::"memory");SBAR();
    #define PK(k) (bf16x8){lo[k][0],lo[k][1],lo[k][2],lo[k][3],hi[k][0],hi[k][1],hi[k][2],hi[k][3]}
    o[d0]=__builtin_amdgcn_mfma_f32_32x32x16_bf16(pa0,PK(0),o[d0],0,0,0);
    o[d0]=__builtin_amdgcn_mfma_f32_32x32x16_bf16(pa1,PK(1),o[d0],0,0,0);
    o[d0]=__builtin_amdgcn_mfma_f32_32x32x16_bf16(pa2,PK(2),o[d0],0,0,0);
    o[d0]=__builtin_amdgcn_mfma_f32_32x32x16_bf16(pa3,PK(3),o[d0],0,0,0);
    #undef PK
  }
}

#ifndef ATTN_STORE16
#define ATTN_STORE16(p,v) (*(u32x4*)(p)=(v))
#endif
template<int THRL> __device__ __forceinline__ void attn_unit(int b,int h,int qb,const bf16*Q,const bf16* K,const bf16* V,bf16*O,const float*LF,const unsigned*NRM,char*shm){
  int tid_=threadIdx.x; asm volatile("":"+v"(tid_));
  const int tid=tid_,lane=tid&63,r32=lane&31,hi=lane>>5; const int wid=__builtin_amdgcn_readfirstlane(tid>>6);
  const long rowbase=(long)b*SEQ; const int q0=qb*QB;
  const char*KBt0=shm+LDS_KB;
  int t0;
  { const int NT0=(q0+QB)/KVBLK; const unsigned*nr=NRM+(b*NHEAD+h)*4;
    const float qn2=__uint_as_float(nr[0])+__uint_as_float(nr[1]), kn2=__uint_as_float(nr[2])+__uint_as_float(nr[3]);
    const float thr=-(50.f+2.04f*sqrtf(qn2*kn2));
    const u32x2_t eq0=*(const u32x2_t*)(KBt0+(unsigned)q0*8u); const float bq0=__uint_as_float(eq0.x<<16)+__uint_as_float(eq0.x&0xffff0000u)+__uint_as_float(eq0.y<<16);
    bool ok=(2*lane<=NT0-4);
    if(ok&&lane>0){ const u32x2_t el=*(const u32x2_t*)(KBt0+(unsigned)(128*lane-1)*8u); const float bl=__uint_as_float(el.x<<16)+__uint_as_float(el.x&0xffff0000u)+__uint_as_float(el.y<<16); ok=(bl-bq0<thr); }
    const unsigned long long mk=__ballot(ok); const unsigned long long low=~mk; const int cnt=(low==0ull)?64:__builtin_ctzll(low);
    t0=__builtin_amdgcn_readfirstlane(2*(cnt-1)); }
  const char*KBt=KBt0+(hi?0:t0*512); const unsigned kb_o0=hi?(unsigned)SEQ*8u:(unsigned)r32*8u, kb_o1=hi?(unsigned)SEQ*8u:(unsigned)(r32+32)*8u, kb_str=hi?0u:512u, zc=hi?0u:0x3F803F80u;
  const bf16*Qw=Q+(rowbase+q0+wid*QBLK)*DM+h*D;
  const bf16*Kh=K+(rowbase+(long)t0*KVBLK)*DM+h*D,*Vh=V+(rowbase+(long)t0*KVBLK)*DM+h*D;
  const unsigned lds0=(unsigned)(uintptr_t)shm;
  float*wsf=(float*)(shm+LDS_WS)+wid*64;
  const bf16*ksrc=Kh+(long)lane*DM+wid*8;
  const bf16*vsrc=Vh+(long)(16*(wid&3)+(lane>>2))*DM+(wid>>2)*32+(lane&3)*8;
  const unsigned kdst=lds0+LDS_K+wid*1024, vdst=lds0+LDS_V+wid*1024;
  #define DMA_K(t,slot) glds16(ksrc+(long)(t)*KVBLK*DM,(unsigned)__builtin_amdgcn_readfirstlane(kdst+(slot)))
  #define DMA_V(t,slot) glds16(vsrc+(long)(t)*KVBLK*DM,(unsigned)__builtin_amdgcn_readfirstlane(vdst+(slot)))
  const int vb0=(int)(lds0+LDS_V)+((lane>>4)&1)*32+(lane&3)*8+(4*hi+((lane&15)>>2))*64;
  const char*Kbase=shm+LDS_K; bf16x8 kf[8];
  const lds_cptr shm3=(lds_cptr)shm; const lds_cptr kp0=shm3+LDS_K+hi*1024+r32*16; const lds_cptr vp0=shm3+LDS_V+((lane>>4)&1)*32+(lane&3)*8+(4*hi+((lane&15)>>2))*64;
  const int NT=(q0+QB)/KVBLK-t0;
  DMA_K(0,0);DMA_V(0,0);DMA_K(1,SLOTB);
  bf16x8 qr[4];
  #pragma unroll
  for(int d0=0;d0<4;++d0)qr[d0]=*reinterpret_cast<const bf16x8*>(&Qw[(long)r32*DM+d0*16+hi*8]);
  float mhat; { const u32x2_t eq=*(const u32x2_t*)(KBt0+(unsigned)(q0+wid*QBLK+r32)*8u); mhat=__uint_as_float(eq.x<<16)+__uint_as_float(eq.x&0xffff0000u)+__uint_as_float(eq.y<<16); }
  float l_reg=0.f;f32x16 o[2];o[0]=f32x16{};o[1]=f32x16{};const f32x16 negm=f32x16{};
  bf16x8 qx=qref_frag(-mhat,hi);
  const int qrel=wid*QBLK+r32;
  #define CMASK(P0,P1,t) do{int jb_=(t)-(NT-4); if(jb_>=0)cmask(P0,P1,jb_,qrel,hi);}while(0)
  bool resc=false;
  #define START(P0,P1) do{ const float rm=rowmax(P0,P1); resc=false; \
    { const float dl=__builtin_fmaxf(rm,0.f); mhat=fadd_s(mhat,dl); \
      _Pragma("unroll") for(int r=0;r<16;++r){P0[r]=fsub_s(P0[r],dl);P1[r]=fsub_s(P1[r],dl);} \
      qx=qref_frag(-mhat,hi); } \
    _Pragma("unroll") for(int r=0;r<16;++r)P0[r]=__builtin_amdgcn_exp2f(P0[r]); }while(0)
  #define RESC() do{ if(resc){ asm volatile("s_waitcnt lgkmcnt(0)":::"memory"); \
      _Pragma("unroll") for(int d_=0;d_<2;++d_) _Pragma("unroll") for(int r=0;r<16;++r)o[d_][r]*=wsf[crow(r,hi)]; } }while(0)
  f32x16 pA0,pA1,pB0,pB1;
  int sl_prev=0,sl_cur=0,sl_next=SLOTB;
  #define ROT() do{sl_prev=sl_cur;sl_cur=sl_next;sl_next=(sl_next==(NSLOT-1)*SLOTB)?0:sl_next+SLOTB;}while(0)
  DMA_K(2,2*SLOTB);
  WAIT_BAR(3);
  qkt(pA0,pA1,Kbase,qr,mkfrag(*(const u32x2_t*)(KBt+kb_o0),zc),mkfrag(*(const u32x2_t*)(KBt+kb_o1),zc),qx,r32,hi);asm volatile("s_nop 15\n\ts_nop 7":"+v"(pA0),"+v"(pA1));CMASK(pA0,pA1,0);
  START(pA0,pA1);
  _Pragma("unroll") for(int r=0;r<16;++r)pA1[r]=__builtin_amdgcn_exp2f(pA1[r]);
  WAIT_BAR(0);
  DMA_K(3,0);DMA_V(1,SLOTB);
  ROT();
  kload8(kf,kp0+sl_cur);
  WAIT_BAR(2);
  s16x4 vlo[8],vhi[8]; u32x4 pw0,pw1,pw2,pw3;
  #define PKW(P,B) cvtpk_s(P[B],P[B+1])
  #define PAF(k) __builtin_bit_cast(bf16x8,pw##k)
  #define VFR(i) (bf16x8){vlo[i][0],vlo[i][1],vlo[i][2],vlo[i][3],vhi[i][0],vhi[i][1],vhi[i][2],vhi[i][3]}
  #define PIN(x) asm volatile("":"+v"(x))
  #define MX3(a,b,c) __builtin_fmaxf(__builtin_fmaxf((a),(b)),(c))
  #define GAPA(MF,A0,A1,A2,A3,W0,W1,PW) do{ MF; sacc+=A0; sacc+=A1; sacc+=A2; sacc+=A3; PIN(sacc); W0; W1; PIN(PW); SBAR(); }while(0)
  #define EX(v) __builtin_amdgcn_exp2f(v)
  #define GAPB(MF,X,B) do{ MF; X[B]=EX(X[B]); X[B+1]=EX(X[B+1]); X[B+2]=EX(X[B+2]); X[B+3]=EX(X[B+3]); PIN(X); SBAR(); }while(0)
  #define VRD(i) do{ vlo[i]=vtr(vp_+(((i)>>2)*4096+((i)&3)*1024)); vhi[i]=vtr(vp_+(((i)>>2)*4096+((i)&3)*1024+512)); }while(0)
  #define KRD(G,j) do{ if(G){ kload2(kf,kp0+sl_next,j); SBAR(); } }while(0)
  #define STEP(C0,C1,P0,P1,t,GK,GV,GL) do{ SBAR(); \
    const lds_cptr vp_=vp0+sl_prev; const u32x2_t e0_=*(const u32x2_t*)(KBt+kb_o0+(unsigned)(t)*kb_str),e1_=*(const u32x2_t*)(KBt+kb_o1+(unsigned)(t)*kb_str); \
    VRD(0); SBAR(); float sacc=(P0[0]+P0[1]); \
    GAPA(C0=__builtin_amdgcn_mfma_f32_32x32x16_bf16(kf[0],qr[0],negm,0,0,0), P0[2],P0[3],P0[4],P0[5],     pw0[0]=PKW(P0,0), pw0[1]=PKW(P0,2), pw0); \
    VRD(4); SBAR(); GAPA(C1=__builtin_amdgcn_mfma_f32_32x32x16_bf16(kf[1],qr[0],negm,0,0,0), P0[6],P0[7],P0[8],P0[9],     pw0[2]=PKW(P0,4), pw0[3]=PKW(P0,6), pw0); \
    VRD(1); SBAR(); GAPA(C0=__builtin_amdgcn_mfma_f32_32x32x16_bf16(kf[2],qr[1],C0,0,0,0),   P0[10],P0[11],P0[12],P0[13], pw1[0]=PKW(P0,8), pw1[1]=PKW(P0,10), pw1); \
    VRD(5); SBAR(); GAPA(C1=__builtin_amdgcn_mfma_f32_32x32x16_bf16(kf[3],qr[1],C1,0,0,0),   P0[14],P0[15],P1[0],P1[1],   pw1[2]=PKW(P0,12),pw1[3]=PKW(P0,14), pw1); \
    VRD(2); SBAR(); GAPA(C0=__builtin_amdgcn_mfma_f32_32x32x16_bf16(kf[4],qr[2],C0,0,0,0),   P1[2],P1[3],P1[4],P1[5],     pw2[0]=PKW(P1,0), pw2[1]=PKW(P1,2), pw2); \
    VRD(6); SBAR(); GAPA(C1=__builtin_amdgcn_mfma_f32_32x32x16_bf16(kf[5],qr[2],C1,0,0,0),   P1[6],P1[7],P1[8],P1[9],     pw2[2]=PKW(P1,4), pw2[3]=PKW(P1,6), pw2); \
    VRD(3); SBAR(); GAPA(C0=__builtin_amdgcn_mfma_f32_32x32x16_bf16(kf[6],qr[3],C0,0,0,0),   P1[10],P1[11],P1[12],P1[13], pw3[0]=PKW(P1,8), pw3[1]=PKW(P1,10), pw3); \
    VRD(7); SBAR(); GAPA(C1=__builtin_amdgcn_mfma_f32_32x32x16_bf16(kf[7],qr[3],C1,0,0,0),   P1[14],P1[15],0.f,0.f,       pw3[2]=PKW(P1,12),pw3[3]=PKW(P1,14), pw3); \
    { const bf16x8 kb0_=mkfrag(e0_,zc),kb1_=mkfrag(e1_,zc); C0=__builtin_amdgcn_mfma_f32_32x32x16_bf16(kb0_,qx,C0,0,0,0); C1=__builtin_amdgcn_mfma_f32_32x32x16_bf16(kb1_,qx,C1,0,0,0); } SBAR(); \
    l_reg+=sacc; \
    if(GK){DMA_K((t)+3,sl_cur);} if(GV){DMA_V((t)+1,sl_next);} \
    CMASK(C0,C1,t); \
    { float a=MX3(C0[0],C0[1],C1[0]),b=MX3(C0[2],C0[3],C1[1]); a=MX3(a,C1[2],C1[3]); \
      _Pragma("unroll") for(int r=4;r<16;r+=4){a=MX3(a,C0[r],C0[r+1]);b=MX3(b,C0[r+2],C0[r+3]);a=MX3(a,C1[r],C1[r+1]);b=MX3(b,C1[r+2],C1[r+3]);} \
      float rm=__builtin_fmaxf(a,b); { auto rr=__builtin_amdgcn_permlane32_swap(__float_as_uint(rm),__float_as_uint(rm),false,false); rm=__builtin_fmaxf(__uint_as_float(rr[0]),__uint_as_float(rr[1])); } \
      resc=false; \
      if(__builtin_expect(__any(rm>(float)THRL),0)){ const float dl=__builtin_fmaxf(rm,0.f); mhat+=dl; \
        _Pragma("unroll") for(int r=0;r<16;++r){C0[r]-=dl;C1[r]-=dl;} \
        qx=qref_frag(-mhat,hi); \
        const float f=__builtin_amdgcn_exp2f(-dl); l_reg*=f; if(hi==0)wsf[r32]=f; resc=true; } } \
    SBAR(); \
    GAPB(o[0]=__builtin_amdgcn_mfma_f32_32x32x16_bf16(PAF(0),VFR(0),o[0],0,0,0), C0,0); \
    GAPB(o[1]=__builtin_amdgcn_mfma_f32_32x32x16_bf16(PAF(0),VFR(4),o[1],0,0,0), C0,4); \
    KRD(GL,0); GAPB(o[0]=__builtin_amdgcn_mfma_f32_32x32x16_bf16(PAF(1),VFR(1),o[0],0,0,0), C0,8); \
    KRD(GL,1); GAPB(o[1]=__builtin_amdgcn_mfma_f32_32x32x16_bf16(PAF(1),VFR(5),o[1],0,0,0), C0,12); \
    KRD(GL,2); GAPB(o[0]=__builtin_amdgcn_mfma_f32_32x32x16_bf16(PAF(2),VFR(2),o[0],0,0,0), C1,0); \
    KRD(GL,3); GAPB(o[1]=__builtin_amdgcn_mfma_f32_32x32x16_bf16(PAF(2),VFR(6),o[1],0,0,0), C1,4); \
    GAPB(o[0]=__builtin_amdgcn_mfma_f32_32x32x16_bf16(PAF(3),VFR(3),o[0],0,0,0), C1,8); \
    GAPB(o[1]=__builtin_amdgcn_mfma_f32_32x32x16_bf16(PAF(3),VFR(7),o[1],0,0,0), C1,12); \
    }while(0)
  int t=1;
  #undef CMASK
  #define CMASK(P0,P1,t) do{}while(0)
  for(;t+5<NT;t+=2){
    STEP(pB0,pB1,pA0,pA1,t,true,true,true);     WAIT_BAR(2); RESC(); ROT();
    STEP(pA0,pA1,pB0,pB1,t+1,true,true,true);   WAIT_BAR(2); RESC(); ROT();
  }
  #undef CMASK
  #define CMASK(P0,P1,t) do{int jb_=(t)-(NT-4); if(jb_>=0)cmask(P0,P1,jb_,qrel,hi);}while(0)
  #define ENDW(tt) do{ if((tt)+3<NT){WAIT_BAR(2);} else if((tt)+2<NT){WAIT_BAR(1);} else {WAIT_BAR(0);} }while(0)
  for(;t+1<NT;t+=2){
    STEP(pB0,pB1,pA0,pA1,t,(t+3<NT),(t+1<NT),(t+1<NT));       ENDW(t);   RESC(); ROT();
    STEP(pA0,pA1,pB0,pB1,t+1,(t+4<NT),(t+2<NT),(t+2<NT));     ENDW(t+1); RESC(); ROT();
  }
  STEP(pB0,pB1,pA0,pA1,NT-1,false,false,false); RESC();
  { float sacc=pB0[0]+pB0[1]; _Pragma("unroll") for(int r=2;r<16;++r)sacc+=pB0[r]; _Pragma("unroll") for(int r=0;r<16;++r)sacc+=pB1[r]; l_reg+=sacc;
    pw0=(u32x4){PKW(pB0,0),PKW(pB0,2),PKW(pB0,4),PKW(pB0,6)};pw1=(u32x4){PKW(pB0,8),PKW(pB0,10),PKW(pB0,12),PKW(pB0,14)};pw2=(u32x4){PKW(pB1,0),PKW(pB1,2),PKW(pB1,4),PKW(pB1,6)};pw3=(u32x4){PKW(pB1,8),PKW(pB1,10),PKW(pB1,12),PKW(pB1,14)};
    SBAR(); pv(o,vb0+sl_cur,PAF(0),PAF(1),PAF(2),PAF(3)); }
  #undef PKW
  #undef PAF
  #undef VFR
  #undef PIN
  #undef MX3
  #undef GAPA
  #undef GAPB
  #undef EX
  #undef VRD
  #undef KRD
  #undef STEP
  #undef ENDW
  {auto rr=__builtin_amdgcn_permlane32_swap(__float_as_uint(l_reg),__float_as_uint(l_reg),false,false);l_reg=__uint_as_float(rr[0])+__uint_as_float(rr[1]);}
  if(hi==0)wsf[32+r32]=l_reg;asm volatile("s_waitcnt lgkmcnt(0)":::"memory");
  float rli[16];
  #pragma unroll
  for(int r=0;r<16;++r)rli[r]=__builtin_amdgcn_rcpf(wsf[32+crow(r,hi)]);
  bf16*Ow=O+(rowbase+q0+wid*QBLK)*OPITCH+h*D;
  { bf16*stg=(bf16*)(shm+LDS_OST)+wid*2048;
    #pragma unroll
    for(int r=0;r<16;++r){const int orow=crow(r,hi);
      #pragma unroll
      for(int d0=0;d0<2;++d0)stg[orow*64+d0*32+r32]=__float2bfloat16(o[d0][r]*rli[r]);}
    asm volatile("s_waitcnt lgkmcnt(0)":::"memory");
    #pragma unroll
    for(int i=0;i<4;++i){const int row=i*8+(lane>>3),ch=lane&7; const u32x4 v=*(const u32x4*)(stg+row*64+ch*8); ATTN_STORE16(Ow+(long)row*OPITCH+ch*8,v);} }
  asm volatile("s_waitcnt lgkmcnt(0)\n\ts_barrier":::"memory");
  #undef DMA_K
  #undef DMA_V
  #undef CMASK
  #undef START
  #undef RESC
  #undef ROT
}
constexpr int ATTN_LDS_BYTES=LDS_BYTES;
struct AttnTensors { const bf16* Q; const bf16* K; const bf16* V; bf16* O; const float* LF; const unsigned* NRM; };
struct AttnUnit { int bh; int qb; };
struct StaticOrder {
  int vcu,grid;
  __device__ __forceinline__ explicit StaticOrder(int grid_,int block):vcu((grid_%8==0)?(block%8)*(grid_/8)+block/8:block),grid(grid_){}
  __device__ __forceinline__ bool next(int i,AttnUnit&u)const{
    if(grid==256){ if(i>=4)return false; const int s=vcu&3; u.bh=vcu>>2; u.qb=(i==0)?s:(i==1)?7-s:(i==2)?8+s:15-s; return true; }
    const int L=i*grid+vcu; if(L>=BATCH*NHEAD*NQB)return false; u.bh=L/NQB; u.qb=L%NQB; return true; }
  __device__ __forceinline__ void a_ready(const AttnUnit&)const{}
  __device__ __forceinline__ void done(const AttnUnit&)const{}
};
template<class Sched,int THRL=8> __device__ __forceinline__ void attn_phase(char*lds,const AttnTensors&T,const Sched&S){
  AttnUnit u; int cur_bh=-1;
  for(int i=0;S.next(i,u);++i){ S.a_ready(u); if(u.bh!=cur_bh){ fox_bias_table(u.bh/NHEAD,u.bh%NHEAD,T.LF,lds); cur_bh=u.bh; }
    attn_unit<THRL>(u.bh/NHEAD,u.bh%NHEAD,u.qb,T.Q,T.K,T.V,T.O,T.LF,T.NRM,lds); S.done(u); }
}
template<int THRL=8> __device__ __forceinline__ void attn_phase_dyn(char*lds,const AttnTensors&T,unsigned*qheads,volatile int*slot,int grp){
  int cur_bh=-1; const int NU=NHEAD*NQB; unsigned*qhead=qheads+64*grp;
  if(threadIdx.x==0) slot[0]=(int)__hip_atomic_fetch_add(qhead,1u,__ATOMIC_RELAXED,__HIP_MEMORY_SCOPE_AGENT);
  __syncthreads();
  int idx=__builtin_amdgcn_readfirstlane(slot[0]);
  while(idx<NU){
    __syncthreads();
    if(threadIdx.x==0) slot[0]=(int)__hip_atomic_fetch_add(qhead,1u,__ATOMIC_RELAXED,__HIP_MEMORY_SCOPE_AGENT);
    const int qb=NQB-1-idx/NHEAD, bh=grp*NHEAD+idx%NHEAD;
    if(bh!=cur_bh){ fox_bias_table(bh/NHEAD,bh%NHEAD,T.LF,lds); cur_bh=bh; }
    attn_unit<THRL>(bh/NHEAD,bh%NHEAD,qb,T.Q,T.K,T.V,T.O,T.LF,T.NRM,lds);
    __syncthreads();
    idx=__builtin_amdgcn_readfirstlane(slot[0]);
  }
}
#undef SBAR
#undef WAIT_BAR
}
namespace fx {
using namespace nv;
typedef unsigned short bf16;
typedef unsigned v4u __attribute__((ext_vector_type(4)));
typedef float f32x4 __attribute__((ext_vector_type(4)));
constexpr float C2 = 0.125f * 1.4426950408889634f;
constexpr int NIN = 3328;
constexpr int QKVP = 3072;
constexpr int P_FQ = 0, P_FK = 512, P_FV = 1024, P_GQ = 1536, P_GK = 1792, P_GV = 2048, P_GR = 2560;
__device__ __forceinline__ int inproj_src(int d) {
    if (d < 1536) return d;
    if (d < 1792) return O_GQ + (d - 1536);
    if (d < 2048) return O_GK + (d - 1792);
    if (d < 2560) return O_GV + (d - 2048);
    if (d < 3072) return O_GR + (d - 2560);
    if (d < 3080) return O_FF + (d - 3072);
    if (d < 3096) return O_GA + (d - 3080);
    return -1;
}
__device__ __forceinline__ unsigned f2bf(float f) { unsigned u = __builtin_bit_cast(unsigned, f); return (u + 0x7fffu + ((u >> 16) & 1u)) >> 16; }
__device__ __forceinline__ unsigned pk2(float lo, float hi) { return f2bf(lo) | (f2bf(hi) << 16); }
__device__ __forceinline__ float bf2f(unsigned short h) { return __builtin_bit_cast(float, (unsigned)h << 16); }
__device__ __forceinline__ float wave_sum(float v) {
#pragma unroll
    for (int o = 1; o < 64; o <<= 1) v += __shfl_xor(v, o);
    return v;
}
#define FX_LDS_WAIT() asm volatile("s_waitcnt lgkmcnt(0)" ::: "memory")

template <class Map> __device__ __forceinline__ void transpose_item(const float* __restrict__ W, int K, int N, bf16* WT, LAS float* scr, int kb, int nb, int lane, Map srcmap) {
    const int k0 = 64 * kb, n0 = 32 * nb;
    const int src = srcmap(n0 + (lane & 31));
#pragma unroll 8
    for (int i = 0; i < 32; ++i) { const int kk = 2 * i + (lane >> 5); scr[kk * 33 + (lane & 31)] = (src >= 0) ? W[(size_t)(k0 + kk) * N + src] : 0.f; }
    FX_LDS_WAIT(); asm volatile("" ::: "memory");
    const int c = lane & 7;
#pragma unroll
    for (int j = 0; j < 4; ++j) { const int n = (lane >> 3) + 8 * j; const LAS float* s = scr + (8 * c) * 33 + n;
        v4u o; o.x = pk2(s[0 * 33], s[1 * 33]); o.y = pk2(s[2 * 33], s[3 * 33]); o.z = pk2(s[4 * 33], s[5 * 33]); o.w = pk2(s[6 * 33], s[7 * 33]);
        *(GAS v4u*)(WT + (size_t)(n0 + n) * K + k0 + 8 * c) = o; }
    FX_LDS_WAIT(); asm volatile("" ::: "memory");
}

__device__ __forceinline__ void ln_row_bf16(const float* xrow, const float* __restrict__ g, const float* __restrict__ b, bf16* orow, float* frow, float* st, int lane) {
    const GAS f32x4* xr = (const GAS f32x4*)xrow + lane;
    f32x4 v[4]; float s = 0.f;
#pragma unroll
    for (int j = 0; j < 4; ++j) { v[j] = xr[64 * j]; s += (v[j].x + v[j].y) + (v[j].z + v[j].w); }
    const float mean = wave_sum(s) * (1.f / D); float s2 = 0.f;
#pragma unroll
    for (int j = 0; j < 4; ++j) { v[j] = v[j] - mean; s2 += (v[j].x * v[j].x + v[j].y * v[j].y) + (v[j].z * v[j].z + v[j].w * v[j].w); }
    const float rstd = 1.f / sqrtf(wave_sum(s2) * (1.f / D) + LN_EPS);
    if (st && lane == 0) { st[0] = mean; st[1] = rstd; }
    GAS unsigned long long* o8 = (GAS unsigned long long*)orow + lane;
#pragma unroll
    for (int j = 0; j < 4; ++j) {
        const f32x4 gg = ((const f32x4*)g)[lane + 64 * j], bb = ((const f32x4*)b)[lane + 64 * j];
        const f32x4 o = v[j] * rstd * gg + bb;
        o8[64 * j] = (unsigned long long)pk2(o.x, o.y) | ((unsigned long long)pk2(o.z, o.w) << 32);
        if (frow) ((GAS f32x4*)frow)[lane + 64 * j] = o;
    }
}

struct CvItem { const float* W; bf16* WT; int N, K, k0, n0, s0; };
__device__ __forceinline__ void cv_load(const CvItem& it, f32x4 (&v)[8], int lane) {
    const float* p = it.W + (size_t)(it.k0 + (lane >> 3)) * it.N + it.s0 + 4 * (lane & 7);
#pragma unroll
    for (int i = 0; i < 8; ++i) v[i] = __builtin_nontemporal_load((const f32x4*)(p + (size_t)(8 * i) * it.N));
}
__device__ __forceinline__ void cv_finish(const CvItem& it, const f32x4 (&v)[8], LAS float* scr, int lane) {
    const int rr = lane >> 3, cq = lane & 7;
#pragma unroll
    for (int i = 0; i < 8; ++i) { LAS float* d = scr + (8 * i + rr) * 33 + 4 * cq; d[0] = v[i][0]; d[1] = v[i][1]; d[2] = v[i][2]; d[3] = v[i][3]; }
    FX_LDS_WAIT(); asm volatile("" ::: "memory");
    const int c = lane & 7;
#pragma unroll
    for (int j = 0; j < 4; ++j) { const int n = (lane >> 3) + 8 * j; const LAS float* s = scr + (8 * c) * 33 + n;
        v4u o; o.x = pk2(s[0 * 33], s[1 * 33]); o.y = pk2(s[2 * 33], s[3 * 33]); o.z = pk2(s[4 * 33], s[5 * 33]); o.w = pk2(s[6 * 33], s[7 * 33]);
        __builtin_nontemporal_store(o, (GAS v4u*)(it.WT + (size_t)(it.n0 + n) * it.K + it.k0 + 8 * c)); }
    FX_LDS_WAIT(); asm volatile("" ::: "memory");
}

template <int NR> __device__ __forceinline__ void ln_rows_bf16(const float* xrows, const float* __restrict__ g, const float* __restrict__ b, bf16* orows, int lane, float* st = nullptr) {
    f32x4 v[NR][4];
#pragma unroll
    for (int r = 0; r < NR; ++r)
#pragma unroll
        for (int j = 0; j < 4; ++j) v[r][j] = ((const GAS f32x4*)(xrows + (size_t)r * D))[lane + 64 * j];
    f32x4 gg[4], bb[4];
#pragma unroll
    for (int j = 0; j < 4; ++j) { gg[j] = ((const f32x4*)g)[lane + 64 * j]; bb[j] = ((const f32x4*)b)[lane + 64 * j]; }
#pragma unroll
    for (int r = 0; r < NR; ++r) {
        float s = 0.f;
#pragma unroll
        for (int j = 0; j < 4; ++j) s += (v[r][j].x + v[r][j].y) + (v[r][j].z + v[r][j].w);
        const float mean = wave_sum(s) * (1.f / D); float s2 = 0.f;
#pragma unroll
        for (int j = 0; j < 4; ++j) { v[r][j] = v[r][j] - mean; s2 += (v[r][j].x * v[r][j].x + v[r][j].y * v[r][j].y) + (v[r][j].z * v[r][j].z + v[r][j].w * v[r][j].w); }
        const float rstd = 1.f / sqrtf(wave_sum(s2) * (1.f / D) + LN_EPS);
        if (st && lane == 0) { st[2 * r] = mean; st[2 * r + 1] = rstd; }
        GAS unsigned long long* o8 = (GAS unsigned long long*)(orows + (size_t)r * D) + lane;
#pragma unroll
        for (int j = 0; j < 4; ++j) { const f32x4 o = v[r][j] * rstd * gg[j] + bb[j];
            o8[64 * j] = (unsigned long long)pk2(o.x, o.y) | ((unsigned long long)pk2(o.z, o.w) << 32); }
    }
}

template <int NR> __device__ __forceinline__ void ln1_rows_bf16(const float* xrows, const float* st, const float* __restrict__ gi, const float* __restrict__ bi, const bf16* mixrows,
                                                               const float* __restrict__ g1, const float* __restrict__ b1, bf16* orows, float alpha, int lane) {
    f32x4 v[NR][4]; unsigned long long mx[NR][4]; float mean0[NR], rstd0[NR];
#pragma unroll
    for (int r = 0; r < NR; ++r) { mean0[r] = st[2 * r]; rstd0[r] = st[2 * r + 1];
#pragma unroll
        for (int j = 0; j < 4; ++j) { v[r][j] = ((const GAS f32x4*)(xrows + (size_t)r * D))[lane + 64 * j]; mx[r][j] = ((const GAS unsigned long long*)(mixrows + (size_t)r * D))[lane + 64 * j]; } }
    f32x4 gi4[4], bi4[4];
#pragma unroll
    for (int j = 0; j < 4; ++j) { gi4[j] = ((const f32x4*)gi)[lane + 64 * j] * alpha; bi4[j] = ((const f32x4*)bi)[lane + 64 * j] * alpha; }
#pragma unroll
    for (int r = 0; r < NR; ++r) {
        float s = 0.f;
#pragma unroll
        for (int j = 0; j < 4; ++j) { const unsigned lo = (unsigned)mx[r][j], hi = (unsigned)(mx[r][j] >> 32);
            f32x4 mv; mv.x = __builtin_bit_cast(float, lo << 16); mv.y = __builtin_bit_cast(float, lo & 0xffff0000u); mv.z = __builtin_bit_cast(float, hi << 16); mv.w = __builtin_bit_cast(float, hi & 0xffff0000u);
            v[r][j] = ((v[r][j] - mean0[r]) * rstd0[r]) * gi4[j] + bi4[j] + mv;
            s += (v[r][j].x + v[r][j].y) + (v[r][j].z + v[r][j].w); }
        const float mean = wave_sum(s) * (1.f / D); float s2 = 0.f;
#pragma unroll
        for (int j = 0; j < 4; ++j) { v[r][j] = v[r][j] - mean; s2 += (v[r][j].x * v[r][j].x + v[r][j].y * v[r][j].y) + (v[r][j].z * v[r][j].z + v[r][j].w * v[r][j].w); }
        const float rstd = 1.f / sqrtf(wave_sum(s2) * (1.f / D) + LN_EPS);
        GAS unsigned long long* o8 = (GAS unsigned long long*)(orows + (size_t)r * D) + lane;
#pragma unroll
        for (int j = 0; j < 4; ++j) { const f32x4 gg = ((const f32x4*)g1)[lane + 64 * j], bb = ((const f32x4*)b1)[lane + 64 * j]; const f32x4 o = v[r][j] * rstd * gg + bb;
            o8[64 * j] = (unsigned long long)pk2(o.x, o.y) | ((unsigned long long)pk2(o.z, o.w) << 32); }
    }
}
}

namespace pg8 {
struct EpiInProj {
    static constexpr bool PERM = true, AFTER_DRAIN = false;
    bf16_t* QKV; float* FG; float* LF; const float* bfg; unsigned* NRM;
    __device__ __forceinline__ void operator()(const f32x4 (&acc)[2][2][4][2], const Unit& u, int wr, int wc, int fr, int fq) const {
        const int row0 = u.pm * BM + wr * 64 + fr;
        if (u.pn < 12) {
            const float sc = (u.pn < 2) ? fx::C2 : 1.f;
            const int col0 = u.pn * BM + wc * 32 + 8 * fq;
            float nmax[2] = {0.f, 0.f};
#pragma unroll
            for (int ai = 0; ai < 2; ++ai)
#pragma unroll
                for (int m = 0; m < 4; ++m) { bf16_t* rowp = QKV + (size_t)(row0 + ai * HALF + m * 16) * fx::QKVP + col0;
#pragma unroll
                    for (int bj = 0; bj < 2; ++bj) { const f32x4 v0 = acc[ai][bj][m][0] * sc, v1 = acc[ai][bj][m][1] * sc;
                        u32x4 w; w.x = cvt_pk_bf16(v0[0], v0[1]); w.y = cvt_pk_bf16(v0[2], v0[3]); w.z = cvt_pk_bf16(v1[0], v1[1]); w.w = cvt_pk_bf16(v1[2], v1[3]);
                        *(u32x4*)(rowp + bj * HALF) = w;
                        if (u.pn < 4) { const f32x4 q0 = v0 * v0, q1 = v1 * v1; float s = (q0[0] + q0[1]) + (q0[2] + q0[3]) + (q1[0] + q1[1]) + (q1[2] + q1[3]);
                            s += __shfl_xor(s, 16); s += __shfl_xor(s, 32);
                            nmax[bj] = fmaxf(nmax[bj], s); } } }
            if (u.pn < 4) {
#pragma unroll
                for (int bj = 0; bj < 2; ++bj) { float s = nmax[bj];
#pragma unroll
                    for (int o = 1; o < 16; o <<= 1) s = fmaxf(s, __shfl_xor(s, o));
                    if (fr == 0 && fq == 0) { const int b = (u.pm * BM) >> 12, head = 4 * (u.pn & 1) + 2 * bj + (wc >> 1);
                        atomicMax(NRM + (b * 8 + head) * 4 + (u.pn >= 2 ? 2 : 0) + (wc & 1), __builtin_bit_cast(unsigned, s)); } }
            }
        } else if (wc == 0 && fq < 3) {
#pragma unroll
            for (int ai = 0; ai < 2; ++ai)
#pragma unroll
                for (int m = 0; m < 4; ++m) { const int row = row0 + ai * HALF + m * 16; float* p = FG + (size_t)row * 32 + 8 * fq;
                    *(f32x4*)p = acc[ai][0][m][0]; *(f32x4*)(p + 4) = acc[ai][0][m][1];
                    if (fq == 0) { const int b = row >> 12, s = row & 4095;
#pragma unroll
                        for (int n = 0; n < 2; ++n)
#pragma unroll
                            for (int i = 0; i < 4; ++i) { const int h = 4 * n + i; LF[(size_t)(b * 8 + h) * nv::S + s] = -__builtin_amdgcn_logf(1.f + __builtin_amdgcn_exp2f(-1.4426950408889634f * (acc[ai][0][m][n][i] + bfg[h]))); } } }
        }
    }
};
}
namespace gl {
using namespace nv;
typedef unsigned short bf16;
typedef short bf16x8 __attribute__((ext_vector_type(8)));
typedef float f32x4 __attribute__((ext_vector_type(4)));
typedef unsigned u32x4 __attribute__((ext_vector_type(4)));
typedef unsigned u32x2 __attribute__((ext_vector_type(2)));
constexpr int NCH = S / 64;
constexpr int NUNIT = B * GH * NCH;
constexpr int LS = 72;
constexpr int L_WGU = 0, L_BG = 4096, L_DECS = 4352, L_QP = 8192, L_KP = L_QP + 64 * LS * 2, L_KPT = L_KP + 64 * LS * 2, L_VT = L_KPT + 64 * LS * 2, L_PP = L_VT + 128 * LS * 2, L_WT = L_PP + 64 * LS * 2, L_END = L_WT + 2048;
static_assert(L_END <= 131072, "gla prep LDS");
constexpr int C_ST = 0, C_PART = 128 * LS * 2, C_END = C_PART + 2 * 8 * 64 * 4;
constexpr size_t QPG_B = 64 * 64 * 2, OI_B = 8 * 4 * 64 * 16, UU_B = OI_B, DEC_B = 256;

__device__ __forceinline__ unsigned pkbf(float lo, float hi) { typedef float f2 __attribute__((ext_vector_type(2))); typedef __bf16 b2 __attribute__((ext_vector_type(2))); f2 v = {lo, hi}; b2 r = __builtin_convertvector(v, b2); return __builtin_bit_cast(unsigned, r); }
__device__ __forceinline__ float bf2f(unsigned short h) { return __builtin_bit_cast(float, (unsigned)h << 16); }
__device__ __forceinline__ float bflo(unsigned w) { return __builtin_bit_cast(float, w << 16); }
__device__ __forceinline__ float bfhi(unsigned w) { return __builtin_bit_cast(float, w & 0xffff0000u); }
__device__ __forceinline__ float fast_logsig2(float x) { return -__builtin_amdgcn_logf(1.f + __builtin_amdgcn_exp2f(-1.4426950408889634f * x)); }

__device__ __forceinline__ void prep_unit(int unit, const bf16* QKV, const float* FG, const float* __restrict__ wgu, const float* __restrict__ bgate,
                                          unsigned char* QPG, unsigned char* OI, unsigned char* UU, float* DEC, unsigned char* lds, int& cur_h, f32x4 (&Sagg)[4], f32x4 (&Dagg)[4]) {
    int tid_ = threadIdx.x; asm volatile("" : "+v"(tid_));
    const int tid = tid_, lane = tid & 63, wid = __builtin_amdgcn_readfirstlane(tid >> 6), l15 = lane & 15, g = lane >> 4;
    const int n = unit % NCH, bh = unit / NCH, h = bh % GH, b = bh / GH;
    const size_t row0 = (size_t)b * S + (size_t)n * 64;
    float* WGU = (float*)(lds + L_WGU); float* BG = (float*)(lds + L_BG); float* WT = (float*)(lds + L_WT);
    bf16* QP = (bf16*)(lds + L_QP); bf16* KP = (bf16*)(lds + L_KP); bf16* KPT = (bf16*)(lds + L_KPT); bf16* VT = (bf16*)(lds + L_VT); bf16* PP = (bf16*)(lds + L_PP);
    if (cur_h != h) { __syncthreads(); for (int i = tid; i < 16 * 64; i += 512) WGU[i] = wgu[(i >> 6) * 256 + h * 64 + (i & 63)]; if (tid < 64) BG[tid] = bgate[h * 64 + tid]; cur_h = h; __syncthreads(); }
    const int t = tid >> 3, oc = tid & 7, d0 = oc * 8;
    float la[8];
    { const float* gp = FG + (row0 + t) * 32 + 8;
      f32x4 ga4[4];
#pragma unroll
      for (int i = 0; i < 4; ++i) ga4[i] = *(const f32x4*)(gp + 4 * i);
#pragma unroll
      for (int j = 0; j < 8; ++j) la[j] = BG[d0 + j];
#pragma unroll
      for (int r = 0; r < 16; ++r) { const float gv = ga4[r >> 2][r & 3]; const f32x4 w0 = *(const f32x4*)(WGU + r * 64 + d0), w1 = *(const f32x4*)(WGU + r * 64 + d0 + 4);
#pragma unroll
          for (int j = 0; j < 4; ++j) { la[j] += gv * w0[j]; la[4 + j] += gv * w1[j]; } }
#pragma unroll
      for (int j = 0; j < 8; ++j) la[j] = fast_logsig2(la[j]) * (1.f / 16.f); }
    const u32x4 qv = *(const u32x4*)(QKV + (row0 + t) * fx::QKVP + fx::P_GQ + h * 64 + d0);
    const u32x4 kv = *(const u32x4*)(QKV + (row0 + t) * fx::QKVP + fx::P_GK + h * 64 + d0);
    const u32x4 vv0 = *(const u32x4*)(QKV + (row0 + t) * fx::QKVP + fx::P_GV + h * 128 + oc * 16);
    const u32x4 vv1 = *(const u32x4*)(QKV + (row0 + t) * fx::QKVP + fx::P_GV + h * 128 + oc * 16 + 8);
#pragma unroll
    for (int off = 8; off < 64; off <<= 1) {
#pragma unroll
        for (int j = 0; j < 8; ++j) { const float o = __shfl_up(la[j], off); if (lane >= off) la[j] += o; } }
    if (lane >= 56) {
#pragma unroll
        for (int j = 0; j < 8; ++j) WT[wid * 64 + d0 + j] = la[j]; }
    __syncthreads();
    float bl[8];
#pragma unroll
    for (int j = 0; j < 8; ++j) bl[j] = 0.f;
#pragma unroll
    for (int w = 0; w < 8; ++w) {
        const f32x4 a0 = *(const f32x4*)(WT + w * 64 + d0), a1 = *(const f32x4*)(WT + w * 64 + d0 + 4);
#pragma unroll
        for (int j = 0; j < 4; ++j) { bl[j] += a0[j]; bl[4 + j] += a1[j]; if (w < wid) { la[j] += a0[j]; la[4 + j] += a1[j]; } } }
    {
        const unsigned qw[4] = {qv.x, qv.y, qv.z, qv.w}, kw[4] = {kv.x, kv.y, kv.z, kv.w};
        float qf[8], kf[8];
#pragma unroll
        for (int i = 0; i < 4; ++i) { qf[2 * i] = bflo(qw[i]); qf[2 * i + 1] = bfhi(qw[i]); kf[2 * i] = bflo(kw[i]); kf[2 * i + 1] = bfhi(kw[i]); }
        float qp[8], kp[8], kpp[8];
#pragma unroll
        for (int j = 0; j < 8; ++j) { const float bb = la[j], bbl = bl[j];
            qp[j] = qf[j] * (0.125f * __builtin_amdgcn_exp2f(bb)); kp[j] = kf[j] * __builtin_amdgcn_exp2f(-bb); kpp[j] = kf[j] * __builtin_amdgcn_exp2f(bbl - bb); }
        u32x4 qo, ko; qo.x = pkbf(qp[0], qp[1]); qo.y = pkbf(qp[2], qp[3]); qo.z = pkbf(qp[4], qp[5]); qo.w = pkbf(qp[6], qp[7]);
        ko.x = pkbf(kp[0], kp[1]); ko.y = pkbf(kp[2], kp[3]); ko.z = pkbf(kp[4], kp[5]); ko.w = pkbf(kp[6], kp[7]);
        *(u32x4*)(QP + t * LS + d0) = qo; *(u32x4*)(KP + t * LS + d0) = ko;
        *(u32x4*)(QPG + (size_t)unit * QPG_B + (size_t)(t * 64 + d0) * 2) = qo;
#pragma unroll
        for (int j = 0; j < 8; ++j) KPT[(d0 + j) * LS + t] = (bf16)(pkbf(kpp[j], 0.f) & 0xffffu);
        const unsigned vw[8] = {vv0.x, vv0.y, vv0.z, vv0.w, vv1.x, vv1.y, vv1.z, vv1.w};
#pragma unroll
        for (int i = 0; i < 8; ++i) { VT[(oc * 16 + 2 * i) * LS + t] = (bf16)(vw[i] & 0xffffu); VT[(oc * 16 + 2 * i + 1) * LS + t] = (bf16)(vw[i] >> 16); }
        if (t == 0) {
#pragma unroll
            for (int j = 0; j < 8; ++j) { const float dc = __builtin_amdgcn_exp2f(bl[j]); DEC[(size_t)unit * 64 + d0 + j] = dc; ((float*)(lds + L_DECS))[d0 + j] = dc; } }
    }
    __syncthreads();
    { const int ti = wid >> 1;
#pragma unroll
      for (int q2 = 0; q2 < 2; ++q2) { const int sj = 2 * (wid & 1) + q2;
          f32x4 acc = {0.f, 0.f, 0.f, 0.f};
          if (sj <= ti) {
#pragma unroll
              for (int ks = 0; ks < 2; ++ks) { const bf16x8 a = *(const bf16x8*)(QP + (16 * ti + l15) * LS + 32 * ks + 8 * g), bb = *(const bf16x8*)(KP + (16 * sj + l15) * LS + 32 * ks + 8 * g);
                  acc = __builtin_amdgcn_mfma_f32_16x16x32_bf16(a, bb, acc, 0, 0, 0); }
              if (sj == ti) {
#pragma unroll
                  for (int r = 0; r < 4; ++r) if (l15 > 4 * g + r) acc[r] = 0.f; }
          }
#pragma unroll
          for (int r = 0; r < 4; ++r) PP[(16 * ti + 4 * g + r) * LS + 16 * sj + l15] = (bf16)(pkbf(acc[r], 0.f) & 0xffffu);
      } }
    __syncthreads();
    { bf16x8 vb[2];
#pragma unroll
      for (int ks = 0; ks < 2; ++ks) vb[ks] = *(const bf16x8*)(VT + (16 * wid + l15) * LS + 32 * ks + 8 * g);
#pragma unroll
      for (int m = 0; m < 4; ++m) { f32x4 acc = {0.f, 0.f, 0.f, 0.f};
#pragma unroll
          for (int ks = 0; ks < 2; ++ks) { const bf16x8 a = *(const bf16x8*)(PP + (16 * m + l15) * LS + 32 * ks + 8 * g); acc = __builtin_amdgcn_mfma_f32_16x16x32_bf16(a, vb[ks], acc, 0, 0, 0); }
          *(f32x4*)(OI + (size_t)unit * OI_B + (size_t)((wid * 4 + m) * 64 + lane) * 16) = acc; }
#pragma unroll
      for (int db = 0; db < 4; ++db) { f32x4 acc = {0.f, 0.f, 0.f, 0.f};
#pragma unroll
          for (int ks = 0; ks < 2; ++ks) { const bf16x8 a = *(const bf16x8*)(KPT + (16 * db + l15) * LS + 32 * ks + 8 * g); acc = __builtin_amdgcn_mfma_f32_16x16x32_bf16(a, vb[ks], acc, 0, 0, 0); }
          *(f32x4*)(UU + (size_t)unit * UU_B + (size_t)((wid * 4 + db) * 64 + lane) * 16) = acc;
          const f32x4 dcv = *(const f32x4*)((const float*)(lds + L_DECS) + 16 * db + 4 * g);
          Sagg[db] = dcv * Sagg[db] + acc; Dagg[db] = Dagg[db] * dcv; }
    }
}


__device__ __forceinline__ void prep_block(int blk, const bf16* QKV, const float* FG, const float* __restrict__ wgu, const float* __restrict__ bgate,
                                           unsigned char* QPG, unsigned char* OI, unsigned char* UU, float* DEC, unsigned char* AGG, float* DAGG, unsigned char* lds, int& cur_h) {
    f32x4 Sagg[4], Dagg[4];
#pragma unroll
    for (int db = 0; db < 4; ++db) { Sagg[db] = (f32x4){0.f, 0.f, 0.f, 0.f}; Dagg[db] = (f32x4){1.f, 1.f, 1.f, 1.f}; }
    for (int i = 0; i < 8; ++i) prep_unit(blk * 8 + i, QKV, FG, wgu, bgate, QPG, OI, UU, DEC, lds, cur_h, Sagg, Dagg);
    int tid_ = threadIdx.x; asm volatile("" : "+v"(tid_));
    const int lane = tid_ & 63, wid = __builtin_amdgcn_readfirstlane(tid_ >> 6), l15 = lane & 15, g = lane >> 4;
#pragma unroll
    for (int db = 0; db < 4; ++db) { *(f32x4*)(AGG + (size_t)blk * UU_B + (size_t)((wid * 4 + db) * 64 + lane) * 16) = Sagg[db];
        if (wid == 0 && l15 == 0) *(f32x4*)(DAGG + (size_t)blk * 64 + 16 * db + 4 * g) = Dagg[db]; }
}
constexpr int GS = 136;
constexpr int PO_GR = 0, PO_YT = 64 * GS * 2, PO_PART = 2 * 64 * GS * 2, PO_ST = PO_PART + 8 * 64 * 4, PO_END = PO_ST + 128 * LS * 2;
__device__ __forceinline__ void post_block(int u0, int NB, const bf16* QKV, const unsigned char* QPG, const unsigned char* OI, const unsigned char* UU, const float* DEC, const unsigned char* AGG, const float* DAGG, const float* __restrict__ gnorm, bf16* Y, unsigned char* lds) {
    int tid_ = threadIdx.x; asm volatile("" : "+v"(tid_));
    const int tid = tid_, lane = tid & 63, wid = __builtin_amdgcn_readfirstlane(tid >> 6), l15 = lane & 15, g = lane >> 4;
    const int n0 = u0 % NCH, bh = u0 / NCH, h = bh % GH, b = bh / GH;
    bf16* GRs = (bf16*)(lds + PO_GR); bf16* YT = (bf16*)(lds + PO_YT); float* PART = (float*)(lds + PO_PART); bf16* ST = (bf16*)(lds + PO_ST);
    const int t = tid >> 3, oc = tid & 7, e = 16 * wid + l15;
    const float gn = gnorm[e];
    f32x4 Sa[4];
#pragma unroll
    for (int db = 0; db < 4; ++db) Sa[db] = (f32x4){0.f, 0.f, 0.f, 0.f};
    { const int seg0 = bh * (NCH / 8), nseg = n0 / 8;
      for (int i = 0; i < nseg; ++i) {
          f32x4 Ua[4], Da[4];
#pragma unroll
          for (int db = 0; db < 4; ++db) { Ua[db] = *(const f32x4*)(AGG + (size_t)(seg0 + i) * UU_B + (size_t)((wid * 4 + db) * 64 + lane) * 16); Da[db] = *(const f32x4*)(DAGG + (size_t)(seg0 + i) * 64 + 16 * db + 4 * g); }
#pragma unroll
          for (int db = 0; db < 4; ++db) Sa[db] = Da[db] * Sa[db] + Ua[db]; } }
    for (int i = 0; i < NB; ++i) {
        const int unit = u0 + i; const size_t row0 = (size_t)b * S + (size_t)(n0 + i) * 64;
        const u32x4 g0 = *(const u32x4*)(QKV + (row0 + t) * fx::QKVP + fx::P_GR + h * 128 + oc * 16), g1 = *(const u32x4*)(QKV + (row0 + t) * fx::QKVP + fx::P_GR + h * 128 + oc * 16 + 8);
        f32x4 o[4], Uf[4], dv[4]; bf16x8 qa[4][2], sb[2];
#pragma unroll
        for (int m = 0; m < 4; ++m) { o[m] = *(const f32x4*)(OI + (size_t)unit * OI_B + (size_t)((wid * 4 + m) * 64 + lane) * 16);
            Uf[m] = *(const f32x4*)(UU + (size_t)unit * UU_B + (size_t)((wid * 4 + m) * 64 + lane) * 16); dv[m] = *(const f32x4*)(DEC + (size_t)unit * 64 + 16 * m + 4 * g);
#pragma unroll
            for (int ks = 0; ks < 2; ++ks) qa[m][ks] = *(const bf16x8*)(QPG + (size_t)unit * QPG_B + (size_t)((16 * m + l15) * 64 + 32 * ks + 8 * g) * 2); }
#pragma unroll
        for (int db = 0; db < 4; ++db) *(u32x2*)(ST + e * LS + 16 * db + 4 * g) = (u32x2){pkbf(Sa[db][0], Sa[db][1]), pkbf(Sa[db][2], Sa[db][3])};
#pragma unroll
        for (int ks = 0; ks < 2; ++ks) sb[ks] = *(const bf16x8*)(ST + e * LS + 32 * ks + 8 * g);
        *(u32x4*)(GRs + t * GS + oc * 16) = g0; *(u32x4*)(GRs + t * GS + oc * 16 + 8) = g1;
#pragma unroll
        for (int m = 0; m < 4; ++m)
#pragma unroll
            for (int ks = 0; ks < 2; ++ks) o[m] = __builtin_amdgcn_mfma_f32_16x16x32_bf16(qa[m][ks], sb[ks], o[m], 0, 0, 0);
#pragma unroll
        for (int m = 0; m < 4; ++m) { f32x4 q = o[m] * o[m];
#pragma unroll
            for (int off = 1; off < 16; off <<= 1) { q[0] += __shfl_xor(q[0], off); q[1] += __shfl_xor(q[1], off); q[2] += __shfl_xor(q[2], off); q[3] += __shfl_xor(q[3], off); }
            if (l15 == 0) *(f32x4*)(PART + wid * 64 + 16 * m + 4 * g) = q; }
#pragma unroll
        for (int db = 0; db < 4; ++db) Sa[db] = dv[db] * Sa[db] + Uf[db];
        __syncthreads();
#pragma unroll
        for (int m = 0; m < 4; ++m) { f32x4 tot = {0.f, 0.f, 0.f, 0.f};
#pragma unroll
            for (int w = 0; w < 8; ++w) tot += *(const f32x4*)(PART + w * 64 + 16 * m + 4 * g);
#pragma unroll
            for (int r = 0; r < 4; ++r) { const int tt = 16 * m + 4 * g + r; const float rs = rsqrtf(tot[r] * (1.f / GV) + LN_EPS); const float gr = bf2f(GRs[tt * GS + e]);
                const float v = o[m][r] * rs * gn * (gr * __builtin_amdgcn_rcpf(1.f + __builtin_amdgcn_exp2f(-1.4426950408889634f * gr)));
                YT[tt * GS + e] = (bf16)(pkbf(v, 0.f) & 0xffffu); } }
        __syncthreads();
        { const u32x4 y0 = *(const u32x4*)(YT + t * GS + oc * 16), y1 = *(const u32x4*)(YT + t * GS + oc * 16 + 8);
          *(u32x4*)(Y + (row0 + t) * D + 512 + h * GV + oc * 16) = y0; *(u32x4*)(Y + (row0 + t) * D + 512 + h * GV + oc * 16 + 8) = y1; }
        __syncthreads();
    }
}
}
namespace mo {
using namespace nv;
typedef unsigned short bf16;
typedef float f32x4 __attribute__((ext_vector_type(4)));
typedef unsigned u32x4 __attribute__((ext_vector_type(4)));
constexpr int CAP = 8192;
constexpr int NEX = NE + 1;
constexpr int YSH = T * TOPK;
constexpr int L_TB = 132096, L_YB = L_TB + 1040, L_CN = L_YB + 1040, L_UT = 138240, L_RG = 141312;
typedef LAS int* lint;


constexpr int I_EG = NEX * 256, I_ED = NEX * 128, I_EXP = I_EG + I_ED;
struct ExpW { const float* eg; const float* eu; const float* ed; const float* sg; const float* su; const float* sd; bf16* WegT; bf16* WedT; };
__device__ __forceinline__ void cv_decode(int r, const ExpW& X, fx::CvItem& I) {
    if (r < I_EG) { const int e = r >> 8, kb = (r >> 4) & 15, nb = r & 15, c = nb >> 3, sub = nb & 7;
        I.W = (e < NE) ? ((sub < 4 ? X.eg : X.eu) + (size_t)e * D * ED) : (sub < 4 ? X.sg : X.su); I.WT = X.WegT + (size_t)e * 512 * D; I.N = ED; I.K = D; I.k0 = 64 * kb; I.n0 = 32 * nb; I.s0 = 128 * c + 32 * (sub & 3); }
    else { r -= I_EG; const int e = r >> 7, kb = (r >> 5) & 3, nb = r & 31; I.W = (e < NE) ? (X.ed + (size_t)e * ED * D) : X.sd; I.WT = X.WedT + (size_t)e * D * ED; I.N = D; I.K = ED; I.k0 = 64 * kb; I.n0 = 32 * nb; I.s0 = 32 * nb; }
}
__device__ __forceinline__ void expert_conv(const ExpW& X, LAS float* scr, int it0, int step, int it_end, int lane) {
    int it = it0; fx::CvItem cur, nx; fx::f32x4 v[8], w[8];
    if (it < it_end) { cv_decode(it, X, cur); fx::cv_load(cur, v, lane); }
    while (it < it_end) { const int itn = it + step; if (itn < it_end) { cv_decode(itn, X, nx); fx::cv_load(nx, w, lane); }
        fx::cv_finish(cur, v, scr, lane); cur = nx;
#pragma unroll
        for (int i = 0; i < 8; ++i) v[i] = w[i];
        it = itn; }
}

__device__ __forceinline__ void moe_tables(const int* counts, lint tb, lint yb, lint cn, int lane) {
    int c[4], nt[4]; int st = 0, sy = 0, pt[4], py[4];
#pragma unroll
    for (int i = 0; i < 4; ++i) { c[i] = counts[lane * 4 + i]; c[i] = c[i] > CAP ? CAP : c[i]; nt[i] = (c[i] + 255) >> 8; pt[i] = st; py[i] = sy; st += nt[i]; sy += c[i]; }
    int it = st, iy = sy;
    for (int o = 1; o < 64; o <<= 1) { const int a = __shfl_up(it, o), b = __shfl_up(iy, o); if (lane >= o) { it += a; iy += b; } }
    const int bt = it - st, by = iy - sy;
#pragma unroll
    for (int i = 0; i < 4; ++i) { tb[lane * 4 + i] = bt + pt[i]; yb[lane * 4 + i] = by + py[i]; cn[lane * 4 + i] = c[i]; }
    if (lane == 63) { tb[256] = it; tb[257] = it + T / 256; yb[256] = YSH; cn[256] = T; }
}

template <int CTRL> __device__ __forceinline__ float dppf(float x) { return __builtin_bit_cast(float, __builtin_amdgcn_update_dpp(0, __builtin_bit_cast(int, x), CTRL, 0xf, 0xf, true)); }
__device__ __forceinline__ float rlf(float x, int l) { return __builtin_bit_cast(float, __builtin_amdgcn_readlane(__builtin_bit_cast(int, x), l)); }
__device__ __forceinline__ void route_token2(const float* LG, const float* __restrict__ rbias, int* lcnt, int* TK, float* TW, int t0, int lane) {
    const int l32 = lane & 31, t = t0 + (lane >> 5); const bool hiH = lane >= 32;
    const float4 la = ((const float4*)(LG + (size_t)t * NE))[2 * l32], lb = ((const float4*)(LG + (size_t)t * NE))[2 * l32 + 1];
    const float4 ra = ((const float4*)rbias)[2 * l32], rb = ((const float4*)rbias)[2 * l32 + 1];
    const float lg[8] = {la.x, la.y, la.z, la.w, lb.x, lb.y, lb.z, lb.w}, rbv[8] = {ra.x, ra.y, ra.z, ra.w, rb.x, rb.y, rb.z, rb.w};
    float sc[8], bv[8];
#pragma unroll
    for (int i = 0; i < 8; ++i) { sc[i] = __builtin_amdgcn_rcpf(1.f + __builtin_amdgcn_exp2f(-1.4426950408889634f * lg[i])); bv[i] = sc[i] + rbv[i]; }
    float m1 = fmaxf(bv[0], bv[1]), m2 = fminf(bv[0], bv[1]);
#pragma unroll
    for (int i = 2; i < 8; ++i) { const float n1 = fmaxf(m1, bv[i]); m2 = fmaxf(fminf(m1, bv[i]), m2); m1 = n1; }
    { const float p1 = dppf<0xB1>(m1), p2 = dppf<0xB1>(m2); const float n1 = fmaxf(m1, p1); m2 = fmaxf(fminf(m1, p1), fmaxf(m2, p2)); m1 = n1; }
    { const float p1 = dppf<0x4E>(m1), p2 = dppf<0x4E>(m2); const float n1 = fmaxf(m1, p1); m2 = fmaxf(fminf(m1, p1), fmaxf(m2, p2)); m1 = n1; }
    const float gs = m1 + m2;
    const int myg = l32 >> 2;
    int rank = 0;
#pragma unroll
    for (int g2 = 0; g2 < NG; ++g2) { const float oa = rlf(gs, g2 * 4), ob = rlf(gs, 32 + g2 * 4); const float og = hiH ? ob : oa; if (og > gs || (og == gs && g2 < myg)) ++rank; }
    const bool sel = rank < 4;
    float mv[8];
#pragma unroll
    for (int i = 0; i < 8; ++i) mv[i] = sel ? bv[i] : -INFINITY;
    int mye = 0; float myw = 0.f; float wsum = 0.f;
#pragma unroll
    for (int k = 0; k < TOPK; ++k) {
        float lm = fmaxf(fmaxf(fmaxf(mv[0], mv[1]), fmaxf(mv[2], mv[3])), fmaxf(fmaxf(mv[4], mv[5]), fmaxf(mv[6], mv[7])));
        int hi = 7; float hs = sc[7];
#pragma unroll
        for (int i = 6; i >= 0; --i) { const bool h = mv[i] == lm; hi = h ? i : hi; hs = h ? sc[i] : hs; }
        float am = fmaxf(lm, dppf<0xB1>(lm)); am = fmaxf(am, dppf<0x4E>(am)); am = fmaxf(am, dppf<0x141>(am)); am = fmaxf(am, dppf<0x140>(am));
        const float a0 = fmaxf(rlf(am, 0), rlf(am, 16)), a1 = fmaxf(rlf(am, 32), rlf(am, 48));
        const float allm = hiH ? a1 : a0;
        const unsigned long long bal = __ballot(lm == allm);
        const int oA = __builtin_ctz((unsigned)bal), oB = 32 + __builtin_ctz((unsigned)(bal >> 32));
        const int cgi = l32 * 8 + hi;
        const int gA = __builtin_amdgcn_readlane(cgi, oA), gB = __builtin_amdgcn_readlane(cgi, oB);
        const float sA = rlf(hs, oA), sB = rlf(hs, oB);
        const bool own = lane == (hiH ? oB : oA);
#pragma unroll
        for (int i = 0; i < 8; ++i) mv[i] = (own && hi == i) ? -INFINITY : mv[i];
        const float sw = hiH ? sB : sA;
        if (l32 == k) { mye = hiH ? gB : gA; myw = sw; } wsum += sw;
    }
    if (l32 < TOPK) { const int lp = atomicAdd(&lcnt[mye], 1); TK[t * TOPK + l32] = mye | (lp << 9); TW[t * TOPK + l32] = myw * (2.5f / wsum); }
}
__device__ __forceinline__ void route_finish2(const int* lbase, int* list_tok, float* list_gate, int* TK, const float* TW, int t0, int lane) {
    const int l32 = lane & 31, t = t0 + (lane >> 5);
    if (l32 < TOPK) { const int tk = TK[t * TOPK + l32]; const int e = tk & 511, pos = lbase[e] + (tk >> 9);
        if (pos < CAP) { list_tok[e * CAP + pos] = t; list_gate[e * CAP + pos] = TW[t * TOPK + l32]; }
        TK[t * TOPK + l32] = e | (pos << 9); }
}

constexpr float YSC = 16.f;
__device__ __forceinline__ void combine_token(const bf16* H1, const unsigned char* Y, const int* TK, lint yb, const float* __restrict__ g, const float* __restrict__ b, float* out, int t, int lane) {
    typedef float f2 __attribute__((ext_vector_type(2)));
    float v[16], s[16];
    { const u32x4 a = *(const u32x4*)(H1 + (size_t)t * D + 16 * lane), c = *(const u32x4*)(H1 + (size_t)t * D + 16 * lane + 8);
      const unsigned w[8] = {a.x, a.y, a.z, a.w, c.x, c.y, c.z, c.w};
#pragma unroll
      for (int i = 0; i < 8; ++i) { v[2 * i] = ALPHA * __builtin_bit_cast(float, w[i] << 16); v[2 * i + 1] = ALPHA * __builtin_bit_cast(float, w[i] & 0xffff0000u); } }
#pragma unroll
    for (int i = 0; i < 16; ++i) s[i] = 0.f;
    int tk = (lane < TOPK) ? TK[t * TOPK + lane] : 0;
#pragma unroll
    for (int k = 0; k <= TOPK; ++k) {
        size_t yrow;
        if (k < TOPK) { const int x = __shfl(tk, k); yrow = (size_t)(yb[x & 511] + (x >> 9)); } else yrow = (size_t)YSH + t;
        const u32x4 a = *(const u32x4*)(Y + yrow * D + 16 * lane);
        const int w[4] = {(int)a.x, (int)a.y, (int)a.z, (int)a.w};
#pragma unroll
        for (int i = 0; i < 4; ++i) { const f2 lo = __builtin_amdgcn_cvt_pk_f32_fp8(w[i], false), hi = __builtin_amdgcn_cvt_pk_f32_fp8(w[i], true);
            s[4 * i] += lo[0]; s[4 * i + 1] += lo[1]; s[4 * i + 2] += hi[0]; s[4 * i + 3] += hi[1]; }
    }
    float sm = 0.f;
#pragma unroll
    for (int i = 0; i < 16; ++i) { v[i] += s[i] * (1.f / YSC); sm += v[i]; }
    const float mean = fx::wave_sum(sm) * (1.f / D); float q = 0.f;
#pragma unroll
    for (int i = 0; i < 16; ++i) { v[i] -= mean; q += v[i] * v[i]; }
    const float rstd = 1.f / sqrtf(fx::wave_sum(q) * (1.f / D) + LN_EPS);
#pragma unroll
    for (int i = 0; i < 4; ++i) { const f32x4 gg = *(const f32x4*)(g + 16 * lane + 4 * i), bb = *(const f32x4*)(b + 16 * lane + 4 * i);
        f32x4 o; o[0] = v[4 * i] * rstd * gg[0] + bb[0]; o[1] = v[4 * i + 1] * rstd * gg[1] + bb[1]; o[2] = v[4 * i + 2] * rstd * gg[2] + bb[2]; o[3] = v[4 * i + 3] * rstd * gg[3] + bb[3];
        *(f32x4*)(out + (size_t)t * D + 16 * lane + 4 * i) = o; }
}
}

namespace pg8 {
struct RouterSched {
    int rb; const bf16_t* Bt;
    __device__ __forceinline__ bool next(int i, Unit2& u) const { if (i > 0) return false; u.pm = rb; u.pn = 0; u.e = 0; u.cnt = 128; u.jt = 0; u.ui = 0; return true; }
    __device__ __forceinline__ int arow(const Unit2& u, int r) const { return u.pm * 128 + r; }
    __device__ __forceinline__ size_t aoff(const Unit2&) const { return 0; }
    __device__ __forceinline__ const char* bptr(const Unit2&) const { return (const char*)Bt; }
};
struct EpiLogits {
    static constexpr bool PERM = false, AFTER_DRAIN = false;
    float* LG;
    __device__ __forceinline__ void operator()(const f32x4 (&acc)[2][2][4][2], const Unit2& u, int wr, int wc, int fr, int fq) const {
        const int row0 = u.pm * 128 + wr * 64 + fr, col0 = wc * 32 + 4 * fq;
#pragma unroll
        for (int m = 0; m < 4; ++m) { float* rowp = LG + (size_t)(row0 + m * 16) * nv::NE + col0;
#pragma unroll
            for (int bj = 0; bj < 2; ++bj)
#pragma unroll
                for (int n = 0; n < 2; ++n) *(f32x4*)(rowp + bj * HALF + n * 16) = acc[0][bj][m][n]; }
    }
};
template <int PH> struct MoeSched {
    int G, vcu, nrt; mo::lint tb; mo::lint cn; const int* list_tok; const bf16_t* W; mo::lint ut; mo::lint rg;
    static constexpr int NC = PH == 0 ? 2 : 4;
    static constexpr int MAXU = 64;
    __device__ __forceinline__ void build(int lane) const {
        const int L = lane * G + vcu;
        if (lane < MAXU && L < nrt * NC) {
            const int rt = L / NC, c = L % NC;
            int lo = 0, hi = 256;
            while (lo < hi) { const int mid = (lo + hi + 1) >> 1; if (tb[mid] <= rt) lo = mid; else hi = mid - 1; }
            const int e = lo, jt = rt - tb[e], rem = cn[e] - 256 * jt;
            ut[4 * lane] = rt; ut[4 * lane + 1] = c; ut[4 * lane + 2] = e | (jt << 9); ut[4 * lane + 3] = rem < 256 ? rem : 256;
        }
    }
    __device__ __forceinline__ bool next(int i, Unit2& u) const {
        const int L = i * G + vcu; if (i >= MAXU || L >= nrt * NC) return false;
        const int x = ut[4 * i + 2];
        u.pm = __builtin_amdgcn_readfirstlane(ut[4 * i]); u.pn = __builtin_amdgcn_readfirstlane(ut[4 * i + 1]); u.e = __builtin_amdgcn_readfirstlane(x & 511); u.jt = __builtin_amdgcn_readfirstlane(x >> 9);
        u.cnt = __builtin_amdgcn_readfirstlane(ut[4 * i + 3]); u.ui = i; return true;
    }
    __device__ __forceinline__ void fill_rows(const float* list_gate, int tid) const {
        for (int i = 0; i < MAXU; ++i) { const int L = i * G + vcu; if (L >= nrt * NC) break;
            const int x = ut[4 * i + 2], e = x & 511, jt = x >> 9, cnt = ut[4 * i + 3];
            if (tid < 256) { const int r = tid; unsigned v;
                if (e == 256) v = (unsigned)(jt * BM + r) | (0x4180u << 16);
                else if (r < cnt) { const float gsc = mo::YSC * list_gate[e * mo::CAP + jt * BM + r]; v = (unsigned)list_tok[e * mo::CAP + jt * BM + r] | (fx::f2bf(gsc) << 16); }
                else v = 0u;
                rg[i * 256 + r] = (int)v; } }
    }
    __device__ __forceinline__ int arow(const Unit2& u, int r) const {
        if (PH == 1) return u.pm * BM + r;
        return rg[u.ui * 256 + r] & 0x7fff;
    }
    __device__ __forceinline__ size_t aoff(const Unit2& u) const { return PH == 1 ? (size_t)u.pm * (131072 - 32768) : 0; }
    __device__ __forceinline__ const char* bptr(const Unit2& u) const {
        return PH == 0 ? (const char*)(W + ((size_t)u.e * 512 + 256 * u.pn) * 1024) : (const char*)(W + ((size_t)u.e * 1024 + 256 * u.pn) * 256);
    }
};
struct EpiSwiGLU {
    static constexpr bool PERM = true, AFTER_DRAIN = false;
    bf16_t* H; mo::lint rg; int skip;
    __device__ __forceinline__ void operator()(const f32x4 (&acc)[2][2][4][2], const Unit2& u, int wr, int wc, int fr, int fq) const {
        if (skip) return;
        const int col0 = u.pn * 128 + wc * 32 + 8 * fq;
#pragma unroll
        for (int ai = 0; ai < 2; ++ai)
#pragma unroll
            for (int m = 0; m < 4; ++m) { const int r = ai * HALF + wr * 64 + m * 16 + fr;
                const float gt = __builtin_bit_cast(float, (unsigned)rg[u.ui * 256 + r] & 0xffff0000u);
                float hv[8];
#pragma unroll
                for (int n = 0; n < 2; ++n)
#pragma unroll
                    for (int i = 0; i < 4; ++i) { const float gg = acc[ai][0][m][n][i], uu = acc[ai][1][m][n][i]; hv[4 * n + i] = gt * uu * (gg * __builtin_amdgcn_rcpf(1.f + __builtin_amdgcn_exp2f(-1.4426950408889634f * gg))); }
                u32x4 w; w.x = cvt_pk_bf16(hv[0], hv[1]); w.y = cvt_pk_bf16(hv[2], hv[3]); w.z = cvt_pk_bf16(hv[4], hv[5]); w.w = cvt_pk_bf16(hv[6], hv[7]);
                *(u32x4*)(H + (size_t)u.pm * 65536 + (size_t)(col0 >> 6) * 16384 + r * 64 + (col0 & 63)) = w; }
    }
};
struct EpiDown {
    static constexpr bool PERM = true, PERM16 = true, AFTER_DRAIN = false;
    unsigned char* Y; mo::lint yb; int skip;
    __device__ __forceinline__ void operator()(const f32x4 (&acc)[2][2][4][2], const Unit2& u, int wr, int wc, int fr, int fq) const {
        if (skip) return;
        const int col0 = u.pn * BM + wc * 64 + 16 * fq; const int ybase = yb[u.e] + u.jt * BM;
#pragma unroll
        for (int ai = 0; ai < 2; ++ai)
#pragma unroll
            for (int m = 0; m < 4; ++m) { const int r = ai * HALF + wr * 64 + m * 16 + fr;
                if (r < u.cnt) { u32x4 w; unsigned ww[4];
#pragma unroll
                    for (int bj = 0; bj < 2; ++bj)
#pragma unroll
                        for (int n = 0; n < 2; ++n) { const f32x4 v = acc[ai][bj][m][n]; int x = __builtin_amdgcn_cvt_pk_fp8_f32(v[0], v[1], 0, false); x = __builtin_amdgcn_cvt_pk_fp8_f32(v[2], v[3], x, true); ww[2 * bj + n] = (unsigned)x; }
                    w.x = ww[0]; w.y = ww[1]; w.z = ww[2]; w.w = ww[3];
                    *(u32x4*)(Y + (size_t)(ybase + r) * nv::D + col0) = w; } }
    }
};
}
constexpr int NTHR = 512;
constexpr int LDS_BYTES = 163840;
constexpr int MISC_OFF = 131072 + 320;
constexpr size_t MiB = 1u << 20;
constexpr size_t CTL_ZERO_BYTES = 96 * 1024;
constexpr int CW_BAR = 4096;
constexpr int CW_MOE = 16384;
constexpr int CW_FOXQ = 20992;
constexpr int CW_NRM = 20480;
constexpr int NPHASE = 9;
constexpr size_t WS_H1 = 1, WS_WR = 65, WS_STATS = 66, WS_LF = 67, WS_FG = 68, WS_WO = 72, WS_WIN = 74, WS_TK = 81, WS_LTOK = 83, WS_LGATE = 91,
                 WS_WED = 100, WS_HID = 230, WS_GLA = 230, WS_WEG = 416, WS_XN = 673, WS_YBF = 673, WS_QKV = 737, WS_Z1 = 737, WS_LG = 865, WS_Y = 416, WS_END = 992;

struct Args { const float* in[21]; float* out; unsigned char* ws; int ph_lo, ph_hi, li, pad; };

__global__ void __launch_bounds__(NTHR, 2) mega_fwd(Args a) {
    using namespace nv;
    extern __shared__ __attribute__((aligned(16))) unsigned char lds[];
    const int G = gridDim.x, bx = blockIdx.x;
    const int vcu = (G % 8 == 0) ? (bx % 8) * (G / 8) + bx / 8 : bx;
    int tid, lane, wave, vw;
#define DERIVE() do { int t_ = threadIdx.x; asm volatile("" : "+v"(t_)); tid = t_; lane = tid & 63; wave = __builtin_amdgcn_readfirstlane(tid >> 6); vw = vcu * 8 + wave; } while (0)
    DERIVE();
    volatile LAS unsigned* MISC = (volatile LAS unsigned*)((LAS unsigned char*)lds + MISC_OFF);
    for (int u = tid; u < (LDS_BYTES - 131072) / 4; u += NTHR) ((LAS unsigned*)((LAS unsigned char*)lds + 131072))[u] = 0u;
    __syncthreads();
    unsigned char* ws = a.ws;
    unsigned* ctl = (unsigned*)ws;
    XcdBarrier bar = xcd_barrier_post(ctl + CW_BAR + a.li * XCD_BAR_WORDS, MISC + 8);
    const float* x = a.in[0];
    const float* ln_in_g = a.in[1]; const float* ln_in_b = a.in[2];
    const float* w_in = a.in[3]; const float* b_fgate = a.in[4];
    const float* w_gate_up = a.in[5]; const float* b_gate = a.in[6]; const float* g_gla = a.in[7];
    const float* w_out = a.in[8]; const float* ln1_g = a.in[9]; const float* ln1_b = a.in[10];
    const float* w_router = a.in[11]; const float* rbias = a.in[12];
    const float* w_eg = a.in[13]; const float* w_eu = a.in[14]; const float* w_ed = a.in[15];
    const float* w_sg = a.in[16]; const float* w_su = a.in[17]; const float* w_sd = a.in[18];
    const float* ln2_g = a.in[19]; const float* ln2_b = a.in[20];
    float* out = a.out;
    int* counts = (int*)(ctl + CW_MOE);
    fx::bf16* H1 = (fx::bf16*)(ws + WS_H1 * MiB);
    fx::bf16* WrT = (fx::bf16*)(ws + WS_WR * MiB);
    float* stats = (float*)(ws + WS_STATS * MiB);
    float* LF = (float*)(ws + WS_LF * MiB);
    float* FG = (float*)(ws + WS_FG * MiB);
    fx::bf16* WoT = (fx::bf16*)(ws + WS_WO * MiB);
    fx::bf16* WinT = (fx::bf16*)(ws + WS_WIN * MiB);
    int* TK = (int*)(ws + WS_TK * MiB);
    float* TW = (float*)(ws + (WS_TK + 1) * MiB);
    int* list_tok = (int*)(ws + WS_LTOK * MiB);
    float* list_gate = (float*)(ws + WS_LGATE * MiB);
    fx::bf16* WedT = (fx::bf16*)(ws + WS_WED * MiB);
    fx::bf16* HID = (fx::bf16*)(ws + WS_HID * MiB);
    unsigned char* QPG = ws + WS_GLA * MiB; unsigned char* OIb = ws + (WS_GLA + 16) * MiB; unsigned char* UUb = ws + (WS_GLA + 80) * MiB; float* DECb = (float*)(ws + (WS_GLA + 144) * MiB); unsigned char* AGGb = ws + (WS_GLA + 145) * MiB; float* DAGGb = (float*)(ws + (WS_GLA + 153) * MiB);
    fx::bf16* WegT = (fx::bf16*)(ws + WS_WEG * MiB);
    fx::bf16* XN = (fx::bf16*)(ws + WS_XN * MiB);
    fx::bf16* Ybf = (fx::bf16*)(ws + WS_YBF * MiB);
    fx::bf16* QKV = (fx::bf16*)(ws + WS_QKV * MiB);
    fx::bf16* MIX = (fx::bf16*)(ws + WS_Z1 * MiB);
    float* LG = (float*)(ws + WS_LG * MiB);
    unsigned char* YA = ws + WS_Y * MiB;
    mo::lint tb = (mo::lint)((LAS unsigned char*)lds + mo::L_TB), yb = (mo::lint)((LAS unsigned char*)lds + mo::L_YB), cn = (mo::lint)((LAS unsigned char*)lds + mo::L_CN), ut = (mo::lint)((LAS unsigned char*)lds + mo::L_UT), rg = (mo::lint)((LAS unsigned char*)lds + mo::L_RG);

    const int lo = a.ph_lo, hi = a.ph_hi;
    bool tables_ready = false;
#define IN(k) (lo <= (k) && (k) < hi)
#define SEAM(k) do { if (IN(k) && IN((k) + 1)) xcd_barrier(bar); DERIVE(); } while (0)
    const int GW = G * 8;
#ifndef STG7
#define STG7 0
#endif
#ifndef STG8
#define STG8 0
#endif
#define STAGGER(q) do { if ((q) > 0) { const unsigned long long t0_ = __builtin_amdgcn_s_memrealtime(); const unsigned long long d_ = (unsigned long long)((vcu & 3) * (q)); while (__builtin_amdgcn_s_memrealtime() - t0_ < d_) __builtin_amdgcn_s_sleep(8); } } while (0)

    if (IN(0)) {
        LAS float* scr = (LAS float*)((LAS unsigned char*)lds + wave * 16384);
        constexpr int I_IN = 16 * (fx::NIN / 32), I_OUT = 16 * 32, I_R = 16 * 8, I_SMALL = I_IN + I_OUT + I_R;
        for (int it = vw; it < I_SMALL; it += GW) {
            int r = it;
            if (r < I_IN) { fx::transpose_item(w_in, D, INW, WinT, scr, r / (fx::NIN / 32), r % (fx::NIN / 32), lane, [](int d) { return fx::inproj_src(d); }); continue; } r -= I_IN;
            if (r < I_OUT) { fx::transpose_item(w_out, D, D, WoT, scr, r / 32, r % 32, lane, [](int d) { return d; }); continue; } r -= I_OUT;
            fx::transpose_item(w_router, D, NE, WrT, scr, r / 8, r % 8, lane, [](int d) { return d; });
        }
        for (int r = vw * 4; r < T; r += GW * 4) fx::ln_rows_bf16<4>(x + (size_t)r * D, ln_in_g, ln_in_b, XN + (size_t)r * D, lane, stats + 2 * (size_t)r);
    }
    SEAM(0);
    if (IN(1)) {
        const mo::ExpW XW{w_eg, w_eu, w_ed, w_sg, w_su, w_sd, WegT, WedT};
#ifndef MIXG
#define MIXG 2
#endif
        #ifndef SLOT_XCD
#define SLOT_XCD 0
#endif
        { const int slot = SLOT_XCD ? (bx & 7) % MIXG : vcu % MIXG; pg8::StaticOrder S; S.init(T, fx::NIN, G, bx);
          const int nun = (S.nwg - bx + G - 1) / G, nb = (MIXG > 1) ? nun * slot / (MIXG - 1) : nun;
          pg8::Gemm g{XN, WinT, T, fx::NIN, D, D}; pg8::EpiInProj E{QKV, FG, LF, b_fgate, ctl + CW_NRM};
          if (nb > 0) { pg8::RangeOrder R{S, 0, nb}; pg8::gemm_phase<pg8::EpiInProj, pg8::RangeOrder, true, true>((LAS unsigned char*)lds, g, R, E); DERIVE(); }
          { LAS float* scr = (LAS float*)((LAS unsigned char*)lds + wave * 16384);
            const int nmax = (S.nwg + G - 1) / G, nlight = G * nmax - S.nwg;
#ifndef CONV_SKEW
#define CONV_SKEW 0.18f
#endif
            const bool two = (CONV_SKEW != 0.0f) && nlight > 0 && nlight < G;
            const float sk = CONV_SKEW < 0.f ? -CONV_SKEW : CONV_SKEW;
            const int nsub = (CONV_SKEW > 0.f) ? nlight : G - nlight;
#ifndef SLOT_SKEW
#define SLOT_SKEW -0.1f
#endif
            const bool three = (SLOT_SKEW != 0.0f) && MIXG == 2 && !SLOT_XCD && (G % 16 == 0);
            const float ssk = SLOT_SKEW < 0.f ? -SLOT_SKEW : SLOT_SKEW;
            const int n2 = three ? mo::I_EXP - (int)(ssk * 0.5f * (float)mo::I_EXP) : mo::I_EXP;
            const int n1 = two ? n2 - (int)(sk * (float)mo::I_EXP * (float)nsub / (float)G) : n2;
            mo::expert_conv(XW, scr, vw, GW, n1, lane);
            const bool light = bx >= G - nlight;
            if (two && (light == (CONV_SKEW > 0.f))) { const int rank = light ? bx - (G - nlight) : bx; mo::expert_conv(XW, scr, n1 + rank * 8 + wave, nsub * 8, n2, lane); }
            if (three && ((slot == 0) == (SLOT_SKEW > 0.f))) { const int rank = (bx / 16) * 8 + (bx & 7); mo::expert_conv(XW, scr, n2 + rank * 8 + wave, (G / 2) * 8, mo::I_EXP, lane); } }
          __syncthreads(); DERIVE();
          if (nb < nun) { pg8::RangeOrder R{S, nb, nun - nb}; pg8::gemm_phase<pg8::EpiInProj, pg8::RangeOrder, true, true>((LAS unsigned char*)lds, g, R, E); } }
    }
    SEAM(1);
    if (IN(2)) {
        int cur_h = -1;
        for (int blk = vcu; blk < gl::NUNIT / 8; blk += G) gl::prep_block(blk, QKV, FG, w_gate_up, b_gate, QPG, OIb, UUb, DECb, AGGb, DAGGb, lds, cur_h);
    }
    SEAM(2);
    if (IN(3)) {
        for (int blk = vcu; blk < gl::NUNIT / 8; blk += G) gl::post_block(blk * 8, 8, QKV, QPG, OIb, UUb, DECb, AGGb, DAGGb, g_gla, Ybf, lds);
        { const attn_body::AttnTensors AT{(const attn_body::bf16*)(QKV + fx::P_FQ), (const attn_body::bf16*)(QKV + fx::P_FK), (const attn_body::bf16*)(QKV + fx::P_FV), (attn_body::bf16*)Ybf, LF, ctl + CW_NRM};
          attn_body::attn_phase_dyn<8>((char*)lds, AT, ctl + CW_FOXQ, (volatile int*)(lds + 140288), (G % 8 == 0) ? vcu / (G / 8) : vcu % 8); }
    }
    SEAM(3);
    if (IN(4)) {
        pg8::DenseSched DS; DS.so.init(T, D, G, bx); DS.Bt = WoT; DS.ldb = D;
        pg8::EpiPlainBf16 E{MIX, D};
        pg8::gemm_phase2<pg8::EpiPlainBf16, pg8::DenseSched>((LAS unsigned char*)lds, Ybf, D, D, D, DS, E);
    }
    SEAM(4);
    if (IN(5)) {
        int* lcnt = (int*)(lds + 136192); int* lbase = lcnt + 256;
        for (int rb = vcu; rb < T / 128; rb += G) {
            if (tid < 256) lcnt[tid] = 0;
            for (int r = wave * 16; r < wave * 16 + 16; r += 4) { const size_t row = (size_t)rb * 128 + r;
                fx::ln1_rows_bf16<4>(x + row * D, stats + 2 * row, ln_in_g, ln_in_b, MIX + row * D, ln1_g, ln1_b, H1 + row * D, ALPHA, lane); }
            asm volatile("s_waitcnt vmcnt(0)" ::: "memory"); __syncthreads();
            { pg8::RouterSched RS{rb, WrT}; pg8::EpiLogits E{LG};
              pg8::gemm_phase2<pg8::EpiLogits, pg8::RouterSched>((LAS unsigned char*)lds, H1, D, D, D, RS, E); }
            DERIVE();
            for (int t = rb * 128 + wave * 2; t < rb * 128 + 128; t += 16) mo::route_token2(LG, rbias, lcnt, TK, TW, t, lane);
            __syncthreads();
            if (tid < 256) { const int c = lcnt[tid]; lbase[tid] = c ? atomicAdd(&counts[tid], c) : 0; }
            __syncthreads();
            for (int t = rb * 128 + wave * 2; t < rb * 128 + 128; t += 16) mo::route_finish2(lbase, list_tok, list_gate, TK, TW, t, lane);
            __syncthreads();
        }
    }
    SEAM(5);
    if (IN(6)) {
        if (wave == 0) mo::moe_tables(counts, tb, yb, cn, lane);
        __syncthreads(); tables_ready = true;
        STAGGER(STG7);
        pg8::MoeSched<0> MS{G, vcu, tb[257], tb, cn, list_tok, WegT, ut, rg}; if (wave == 0) MS.build(lane); __syncthreads(); MS.fill_rows(list_gate, tid); __syncthreads(); pg8::EpiSwiGLU E{HID, rg, a.pad};
        pg8::gemm_phase2<pg8::EpiSwiGLU, pg8::MoeSched<0>>((LAS unsigned char*)lds, H1, D, D, D, MS, E);
    }
    SEAM(6);
    if (IN(7)) {
        if (!tables_ready) { if (wave == 0) mo::moe_tables(counts, tb, yb, cn, lane); __syncthreads(); tables_ready = true; }
        STAGGER(STG8);
        pg8::MoeSched<1> MS{G, vcu, tb[257], tb, cn, list_tok, WedT, ut, rg}; if (wave == 0) MS.build(lane); __syncthreads(); pg8::EpiDown E{YA, yb, a.pad};
        pg8::gemm_phase2<pg8::EpiDown, pg8::MoeSched<1>>((LAS unsigned char*)lds, HID, 64, ED, ED, MS, E, 32768);
    }
    SEAM(7);
    if (IN(8)) {
        if (!tables_ready) { if (wave == 0) mo::moe_tables(counts, tb, yb, cn, lane); __syncthreads(); tables_ready = true; }
        for (int t = vw; t < T; t += GW) mo::combine_token(H1, YA, TK, yb, ln2_g, ln2_b, out, t, lane);
    }
#undef IN
#undef SEAM
}

extern "C" void kernel_launch(void* const* d_in, const int* in_sizes, int n_in, void* d_out, int out_size, void* d_ws, size_t ws_size, hipStream_t stream) {
    static int grid = 0;
    if (grid == 0) {
        if (n_in != 21 || out_size != nv::T * nv::D || ws_size < WS_END * MiB) { fprintf(stderr, "kernel_launch: unexpected shapes n_in=%d out=%d ws=%zu\n", n_in, out_size, ws_size); grid = -1; return; }
        int dev = 0, cus = 0;
        if (hipGetDevice(&dev) != hipSuccess || hipDeviceGetAttribute(&cus, hipDeviceAttributeMultiprocessorCount, dev) != hipSuccess) { grid = -1; return; }
        if (hipFuncSetAttribute((const void*)mega_fwd, hipFuncAttributeMaxDynamicSharedMemorySize, LDS_BYTES) != hipSuccess) { fprintf(stderr, "kernel_launch: hipFuncSetAttribute failed\n"); grid = -1; return; }
        grid = cus;
    }
    if (grid < 0) return;
    if (hipMemsetAsync(d_ws, 0, CTL_ZERO_BYTES, stream) != hipSuccess) return;
    Args a{};
    for (int i = 0; i < 21; ++i) a.in[i] = (const float*)d_in[i];
    a.out = (float*)d_out; a.ws = (unsigned char*)d_ws; a.ph_lo = 0; a.ph_hi = NPHASE; a.li = 0;
#ifdef REPEAT_PH
    a.ph_hi = REPEAT_PH + 1; hipLaunchKernelGGL(mega_fwd, dim3(grid), dim3(NTHR), LDS_BYTES, stream, a);
    if (REPEAT_PH == 3) hipMemsetAsync((char*)d_ws + CW_FOXQ * 4, 0, 256, stream);
    if (REPEAT_PH == 5) hipMemsetAsync((char*)d_ws + CW_MOE * 4, 0, 4096, stream);
    a.ph_lo = REPEAT_PH; a.ph_hi = NPHASE; a.li = 1;
#ifdef REPEAT_NOEPI
    a.ph_hi = REPEAT_PH + 1; a.pad = 1; hipLaunchKernelGGL(mega_fwd, dim3(grid), dim3(NTHR), LDS_BYTES, stream, a); a.pad = 0; a.ph_lo = REPEAT_PH + 1; a.ph_hi = NPHASE; a.li = 2;
#endif
#endif
    hipLaunchKernelGGL(mega_fwd, dim3(grid), dim3(NTHR), LDS_BYTES, stream, a);
}
```

```cpp
#include <hip/hip_runtime.h>
#include <cstdio>
#include <cstdint>
#include <cmath>

#define LAS __attribute__((address_space(3)))
#define GAS __attribute__((address_space(1)))

#define XB_TMO      128
#define XB_XCNT(j)  (256  + 64 * (j))
#define XB_XSUB(j)  (1280 + 64 * (j))
#define XB_XGEN(j)  (2304 + 64 * (j))
#define XB_TOP      3328
#define XB_TOPGEN   3392
#define XCD_BAR_WORDS 3456
#define XB_SPIN_CAP (1u << 27)
__device__ __forceinline__ unsigned xb_ld(unsigned* p)              { return __hip_atomic_load(p, __ATOMIC_RELAXED, __HIP_MEMORY_SCOPE_AGENT); }
__device__ __forceinline__ unsigned xb_add(unsigned* p, unsigned v) { return __hip_atomic_fetch_add(p, v, __ATOMIC_RELAXED, __HIP_MEMORY_SCOPE_AGENT); }
__device__ __forceinline__ unsigned xb_xcc_id() { return (unsigned)__builtin_amdgcn_s_getreg((3 << 11) | 20) & 0xFu; }
#define XB_SPIN(cond, bar) do { unsigned _sp = 0; while (cond) { __builtin_amdgcn_s_sleep(1); \
    if ((++_sp & 255u) == 0u) { if (xb_ld(&(bar)[XB_TMO])) break; if (_sp > XB_SPIN_CAP) { atomicAdd(&(bar)[XB_TMO], 1u); break; } } } } while (0)
struct XcdBarrier { unsigned* bar; unsigned x; volatile LAS unsigned* st; };
__device__ __forceinline__ XcdBarrier xcd_barrier_post(unsigned* bar, volatile LAS unsigned* st) {
    XcdBarrier b; b.bar = bar; b.x = xb_xcc_id(); b.st = st;
    if (threadIdx.x == 0) (void)xb_add(&bar[XB_XCNT(b.x)], 1u);
    return b;
}
__device__ __forceinline__ void xcd_barrier_complete(unsigned* bar, unsigned x, unsigned& nloc, unsigned& nx) {
    const unsigned G = gridDim.x * gridDim.y * gridDim.z;
    unsigned sum, cnt, mine, sp = 0u;
    for (;;) {
        sum = 0u; cnt = 0u; mine = 0u;
#pragma unroll
        for (unsigned j = 0; j < 16; ++j) { const unsigned c = xb_ld(&bar[XB_XCNT(j)]); sum += c; cnt += (c > 0u) ? 1u : 0u; mine = (j == x) ? c : mine; }
        if (sum == G) break;
        __builtin_amdgcn_s_sleep(1);
        if ((++sp & 255u) == 0u) { if (xb_ld(&bar[XB_TMO])) break; if (sp > XB_SPIN_CAP) { atomicAdd(&bar[XB_TMO], 1u); break; } }
    }
    nloc = mine > 0u ? mine : 1u; nx = cnt > 0u ? cnt : 1u;
}
__device__ __forceinline__ void xcd_barrier(const XcdBarrier& b) {
    asm volatile("s_waitcnt vmcnt(0)" ::: "memory");
    __syncthreads();
    if (threadIdx.x == 0) {
        unsigned* bar = b.bar;
        __builtin_amdgcn_s_waitcnt(0);
        unsigned nloc = b.st[0], nx = b.st[1];
        if (nloc == 0u) { xcd_barrier_complete(bar, b.x, nloc, nx); b.st[0] = nloc; b.st[1] = nx; }
        const unsigned old = xb_add(&bar[XB_XSUB(b.x)], 1u);
        const unsigned gen = old / nloc;
        if (old + 1u == (gen + 1u) * nloc) {
            __builtin_amdgcn_fence(__ATOMIC_RELEASE, "agent");
            asm volatile("s_waitcnt vmcnt(0)" ::: "memory");
            const unsigned og = xb_add(&bar[XB_TOP], 1u);
            const unsigned tg = og / nx;
            if (og + 1u == (tg + 1u) * nx) xb_add(&bar[XB_TOPGEN], 1u);
            else XB_SPIN(xb_ld(&bar[XB_TOPGEN]) == tg, bar);
            __builtin_amdgcn_fence(__ATOMIC_ACQUIRE, "agent");
            xb_add(&bar[XB_XGEN(b.x)], 1u);
            asm volatile("s_waitcnt vmcnt(0)" ::: "memory");
        } else {
            XB_SPIN(xb_ld(&bar[XB_XGEN(b.x)]) == gen, bar);
            __builtin_amdgcn_fence(__ATOMIC_ACQUIRE, "agent");
            asm volatile("s_waitcnt vmcnt(0)" ::: "memory");
        }
    }
    __syncthreads();
}
namespace pg8 {
#define PG8_LAS __attribute__((address_space(3)))
typedef unsigned short bf16_t;
typedef short bf16x8 __attribute__((ext_vector_type(8)));
typedef float f32x4 __attribute__((ext_vector_type(4)));
typedef unsigned u32x4 __attribute__((ext_vector_type(4)));
constexpr int BM = 256, BK = 64, HALF = 128, HTB = HALF * BK * 2  , STAGE_BYTES = 8 * HTB, NXCD = 8, WGM = 8;

__host__ __device__ __forceinline__ int lds_byte(int r, int c) { const int st = (r >> 4) * 2 + (c >> 5), rr = r & 15, cc = c & 31, ob = rr * 64 + cc * 2; return st * 1024 + (ob ^ (((ob >> 9) & 1) << 5)); }
__host__ __device__ __forceinline__ void stage_rc(int b, int& R, int& C) { const int st = b / 1024, sb = b % 1024, swz = sb ^ (((sb >> 9) & 1) << 5); R = (st >> 1) * 16 + swz / 64; C = (st & 1) * 32 + (swz % 64) / 2; }
__host__ __device__ __forceinline__ int perm32(int rho) { const int n = rho >> 4, i = rho & 15; return 8 * (i >> 2) + 4 * n + (i & 3); }

struct Unit { int pm, pn; };
struct Gemm { const bf16_t* A; const bf16_t* Bt; int M, N, K, lda; };

struct StaticOrder {
    int nM, nN, nwg, G, c;
    __host__ __device__ void init(int M, int N, int G_, int c_) { nM = M / BM; nN = N / BM; nwg = nM * nN; G = G_; c = c_; }
    __host__ __device__ bool next(int i, Unit& u) const {
        const long L = (long)i * G + c; if (L >= nwg) return false;
        int wgid = (int)L; { const int q = nwg / NXCD, r = nwg % NXCD, xcd = wgid % NXCD, off = wgid / NXCD; wgid = (xcd < r ? xcd * (q + 1) : r * (q + 1) + (xcd - r) * q) + off; }
        const int nig = WGM * nN, gid = wgid / nig, fm = gid * WGM, gsz = (nM - fm) < WGM ? (nM - fm) : WGM;
        u.pm = fm + ((wgid % nig) % gsz); u.pn = (wgid % nig) / gsz; return true;
    }
    __device__ __forceinline__ void a_ready(const Unit&) const {}
    __device__ __forceinline__ void done(const Unit&) const {}
};

struct RangeOrder {
    StaticOrder so; int i0, n;
    __host__ __device__ bool next(int i, Unit& u) const { return i < n && so.next(i0 + i, u); }
    __device__ __forceinline__ void a_ready(const Unit&) const {}
    __device__ __forceinline__ void done(const Unit&) const {}
};
__device__ __forceinline__ unsigned cvt_pk_bf16(float lo, float hi) { unsigned r; asm volatile("v_cvt_pk_bf16_f32 %0, %1, %2" : "=v"(r) : "v"(lo), "v"(hi)); return r; }
typedef float f32x2 __attribute__((ext_vector_type(2)));
__device__ __forceinline__ f32x2 gelu_pk(f32x2 v) {
    const f32x2 av = __builtin_elementwise_abs(v), d = av * 0.2316418882f + 1.0f;
    f32x2 t; t.x = __builtin_amdgcn_rcpf(d.x); t.y = __builtin_amdgcn_rcpf(d.y);
    f32x2 q = t * 0.5307027145f + (-0.7265760135f); q = q * t + 0.7107068705f; q = q * t + (-0.142248368f); q = q * t + 0.127414796f; q = q * t;
    const f32x2 s = (v * v) * (-0.72134752044f);
    f32x2 e; e.x = __builtin_amdgcn_exp2f(s.x); e.y = __builtin_amdgcn_exp2f(s.y);
    const f32x2 m = v * (q * e), r = v - m;
    f32x2 o; o.x = v.x < 0.f ? m.x : r.x; o.y = v.y < 0.f ? m.y : r.y; return o;
}

template <int ACT  > struct EpiBf16 {
    static constexpr bool PERM = true, AFTER_DRAIN = false; static_assert(ACT == 0 || ACT == 1, "EpiBf16: ACT is 0 (none) or 1 (gelu_pk)");
    bf16_t* O; int ldc; const float* bias; int split_cols; size_t split_stride; float scale0;
    __device__ __forceinline__ void operator()(const f32x4 (&acc)[2][2][4][2], const Unit& u, int wr, int wc, int fr, int fq) const {
        const int row0 = u.pm * BM + wr * 64 + fr; int colt = u.pn * BM; bf16_t* base = O;
        float sc = 1.f; if (split_cols) { const int t = colt / split_cols; base += (size_t)t * split_stride; colt -= t * split_cols; if (t == 0) sc = scale0; }
        const int col0 = colt + wc * 32 + 8 * fq, bcol0 = u.pn * BM + wc * 32 + 8 * fq;
        f32x4 bv[2][2];
#pragma unroll
        for (int bj = 0; bj < 2; ++bj)
#pragma unroll
            for (int n = 0; n < 2; ++n) bv[bj][n] = bias ? *(const f32x4*)(bias + bcol0 + bj * HALF + 4 * n) : (f32x4){0.f, 0.f, 0.f, 0.f};
#pragma unroll
        for (int ai = 0; ai < 2; ++ai)
#pragma unroll
            for (int m = 0; m < 4; ++m) { bf16_t* rowp = base + (size_t)(row0 + ai * HALF + m * 16) * ldc + col0;
#pragma unroll
                for (int bj = 0; bj < 2; ++bj) { f32x4 v0 = acc[ai][bj][m][0] + bv[bj][0], v1 = acc[ai][bj][m][1] + bv[bj][1];
                    if (ACT == 1) { f32x2 a = gelu_pk((f32x2){v0[0], v0[1]}), b = gelu_pk((f32x2){v0[2], v0[3]}), c = gelu_pk((f32x2){v1[0], v1[1]}), d = gelu_pk((f32x2){v1[2], v1[3]});
                        v0 = (f32x4){a.x, a.y, b.x, b.y}; v1 = (f32x4){c.x, c.y, d.x, d.y}; }
                    v0 = v0 * sc; v1 = v1 * sc; u32x4 w; w.x = cvt_pk_bf16(v0[0], v0[1]); w.y = cvt_pk_bf16(v0[2], v0[3]); w.z = cvt_pk_bf16(v1[0], v1[1]); w.w = cvt_pk_bf16(v1[2], v1[3]);
                    *(u32x4*)(rowp + bj * HALF) = w; } }
    }
};

template <class Epi, class Sched, bool ALIGN_EPI = false, bool SP2 = false>
__device__ __forceinline__ void gemm_phase(PG8_LAS unsigned char* lds, const Gemm g, const Sched& S, const Epi& E) {
    const int tid = threadIdx.x, wid = __builtin_amdgcn_readfirstlane(tid >> 6), lane = tid & 63, wr = wid >> 2, wc = wid & 3, fr = lane & 15, fq = lane >> 4;
    const int K = g.K, nt = K / BK;
    unsigned voffA[2], voffB[2];
#pragma unroll
    for (int i = 0; i < 2; ++i) { int R, C; stage_rc(tid * 16 + i * 8192, R, C); const int Rb = Epi::PERM ? ((R & ~31) + perm32(R & 31)) : R;
        voffA[i] = (unsigned)(R * g.lda + C) * 2u; voffB[i] = (unsigned)(Rb * K + C) * 2u; }
    const size_t kstep = (size_t)(BK * 2);
    const size_t hstepA = (size_t)HALF * g.lda * 2, hstepB = (size_t)HALF * K * 2;
    const size_t tstepA = 2 * hstepA, tstepB = 2 * hstepB;
    const unsigned ldsw = (unsigned)wid * 1024u;
    const int aoff = lds_byte(wr * 64 + fr, fq * 8), boff = lds_byte(wc * 32 + fr, fq * 8);
#define PG8_SA(b, h) (((b) * 2 + (h)) * HTB)
#define PG8_SB(b, h) ((4 + (b) * 2 + (h)) * HTB)
#define PG8_STAGE(bufoff, gbase, voff) do { _Pragma("unroll") for (int _i = 0; _i < 2; ++_i) \
        __builtin_amdgcn_global_load_lds((const unsigned*)((const char*)(gbase) + (voff)[_i]), (PG8_LAS unsigned*)(lds + (bufoff) + ldsw + _i * 8192), 16, 0, 0); } while (0)
#define PG8_LDA(dst, b, h) do { _Pragma("unroll") for (int m = 0; m < 4; ++m) _Pragma("unroll") for (int k = 0; k < 2; ++k) dst[m][k] = *(const PG8_LAS bf16x8*)(lds + PG8_SA(b, h) + aoff + m * 2048 + k * 1024); } while (0)
#define PG8_LDB(dst, b, h) do { _Pragma("unroll") for (int n = 0; n < 2; ++n) _Pragma("unroll") for (int k = 0; k < 2; ++k) dst[n][k] = *(const PG8_LAS bf16x8*)(lds + PG8_SB(b, h) + boff + n * 2048 + k * 1024); } while (0)
#define PG8_MMA(ai, bj, At, Bt) do { __builtin_amdgcn_s_setprio(1); _Pragma("unroll") for (int m = 0; m < 4; ++m) _Pragma("unroll") for (int n = 0; n < 2; ++n) _Pragma("unroll") for (int k = 0; k < 2; ++k) \
        acc[ai][bj][m][n] = __builtin_amdgcn_mfma_f32_16x16x32_bf16(Bt[n][k], At[m][k], acc[ai][bj][m][n], 0, 0, 0); __builtin_amdgcn_s_setprio(0); } while (0)
#define PG8_WAIT_V(n) asm volatile("s_waitcnt vmcnt(" #n ")" ::: "memory")
#define PG8_WAIT_L(n) asm volatile("s_waitcnt lgkmcnt(" #n ")" ::: "memory")
#define PG8_BAR __builtin_amdgcn_s_barrier()
#define PG8_SCHED __builtin_amdgcn_sched_barrier(0)
    Unit cur, nxt; int ui = 0;
    if (!S.next(0, cur)) return;
    f32x4 acc[2][2][4][2];
#pragma unroll
    for (int a = 0; a < 2; ++a)
#pragma unroll
        for (int b = 0; b < 2; ++b)
#pragma unroll
            for (int m = 0; m < 4; ++m)
#pragma unroll
                for (int n = 0; n < 2; ++n) acc[a][b][m][n] = (f32x4){0.f, 0.f, 0.f, 0.f};
    bf16x8 At[4][2], B0[2][2], B1[2][2];
    const char* cA = (const char*)g.A + (size_t)cur.pm * tstepA; const char* cB = (const char*)g.Bt + (size_t)cur.pn * tstepB;
    S.a_ready(cur);
    if constexpr (SP2) {
        PG8_STAGE(PG8_SB(0, 0), cB, voffB); PG8_STAGE(PG8_SB(0, 1), cB + hstepB, voffB); PG8_STAGE(PG8_SA(0, 0), cA, voffA); PG8_STAGE(PG8_SA(0, 1), cA + hstepA, voffA);
        if (wr == 1) PG8_BAR;
        PG8_WAIT_V(2); PG8_BAR;
        PG8_STAGE(PG8_SB(1, 0), cB + kstep, voffB); PG8_STAGE(PG8_SA(1, 0), cA + kstep, voffA); PG8_STAGE(PG8_SB(1, 1), cB + hstepB + kstep, voffB);
        PG8_WAIT_V(6); PG8_BAR;
    } else {
        PG8_STAGE(PG8_SB(0, 0), cB, voffB); PG8_STAGE(PG8_SA(0, 0), cA, voffA); PG8_STAGE(PG8_SB(0, 1), cB + hstepB, voffB); PG8_STAGE(PG8_SA(0, 1), cA + hstepA, voffA);
        if (wr == 1) PG8_BAR;
        PG8_WAIT_V(4); PG8_BAR;
        PG8_STAGE(PG8_SB(1, 0), cB + kstep, voffB); PG8_STAGE(PG8_SA(1, 0), cA + kstep, voffA); PG8_STAGE(PG8_SB(1, 1), cB + hstepB + kstep, voffB);
        PG8_WAIT_V(6); PG8_BAR;
    }
    for (;;) {
        const bool has_next = S.next(ui + 1, nxt);
        const char* nA = has_next ? (const char*)g.A + (size_t)nxt.pm * tstepA : cA; const char* nB = has_next ? (const char*)g.Bt + (size_t)nxt.pn * tstepB : cB;
        for (int t = 0; t < nt; t += 2) {
            const bool last = (t == nt - 2);
            const char* a1 = cA + (size_t)(t + 1) * kstep;
            const char* a2 = last ? nA : cA + (size_t)(t + 2) * kstep; const char* b2 = last ? nB : cB + (size_t)(t + 2) * kstep;
            const char* a3 = a2 + kstep; const char* b3 = b2 + kstep;
            if (last && has_next) S.a_ready(nxt);
            if constexpr (SP2) {
            PG8_LDB(B0, 0, 0); PG8_LDB(B1, 0, 1); PG8_SCHED; PG8_LDA(At, 0, 0); PG8_STAGE(PG8_SA(1, 1), a1 + hstepA, voffA);
            PG8_WAIT_V(8); PG8_WAIT_L(0); PG8_BAR; PG8_MMA(0, 0, At, B0); PG8_MMA(0, 1, At, B1); PG8_BAR; PG8_SCHED;
            PG8_LDA(At, 0, 1); PG8_STAGE(PG8_SB(0, 0), b2, voffB); PG8_STAGE(PG8_SB(0, 1), b2 + hstepB, voffB); PG8_STAGE(PG8_SA(0, 0), a2, voffA);
            PG8_WAIT_V(8); PG8_WAIT_L(0); PG8_BAR; PG8_MMA(1, 0, At, B0); PG8_MMA(1, 1, At, B1); PG8_BAR; PG8_SCHED;
            PG8_LDB(B0, 1, 0); PG8_LDB(B1, 1, 1); PG8_SCHED; PG8_LDA(At, 1, 0); PG8_STAGE(PG8_SA(0, 1), a2 + hstepA, voffA);
            PG8_WAIT_V(8); PG8_WAIT_L(0); PG8_BAR; PG8_MMA(0, 0, At, B0); PG8_MMA(0, 1, At, B1); PG8_BAR; PG8_SCHED;
            PG8_LDA(At, 1, 1); PG8_STAGE(PG8_SB(1, 0), b3, voffB); PG8_STAGE(PG8_SB(1, 1), b3 + hstepB, voffB); PG8_STAGE(PG8_SA(1, 0), a3, voffA);
            PG8_WAIT_V(8); PG8_WAIT_L(0); PG8_BAR; PG8_MMA(1, 0, At, B0); PG8_MMA(1, 1, At, B1); PG8_BAR; PG8_SCHED;
            } else {
            PG8_LDB(B0, 0, 0); PG8_SCHED; PG8_LDA(At, 0, 0); PG8_STAGE(PG8_SA(1, 1), a1 + hstepA, voffA);
            PG8_WAIT_L(8); PG8_BAR; PG8_WAIT_L(0); PG8_MMA(0, 0, At, B0); PG8_BAR; PG8_SCHED;
            PG8_LDB(B1, 0, 1); PG8_STAGE(PG8_SB(0, 0), b2, voffB);
            PG8_BAR; PG8_WAIT_L(0); PG8_MMA(0, 1, At, B1); PG8_BAR;
            PG8_LDA(At, 0, 1); PG8_STAGE(PG8_SA(0, 0), a2, voffA);
            PG8_BAR; PG8_WAIT_L(0); PG8_MMA(1, 0, At, B0); PG8_BAR; PG8_SCHED;
            PG8_STAGE(PG8_SB(0, 1), b2 + hstepB, voffB);
            PG8_WAIT_V(6); PG8_BAR; PG8_MMA(1, 1, At, B1); PG8_BAR;
            PG8_LDB(B0, 1, 0); PG8_SCHED; PG8_LDA(At, 1, 0); PG8_STAGE(PG8_SA(0, 1), a2 + hstepA, voffA);
            PG8_WAIT_L(8); PG8_BAR; PG8_WAIT_L(0); PG8_MMA(0, 0, At, B0); PG8_BAR; PG8_SCHED;
            PG8_LDB(B1, 1, 1); PG8_STAGE(PG8_SB(1, 0), b3, voffB);
            PG8_BAR; PG8_WAIT_L(0); PG8_MMA(0, 1, At, B1); PG8_BAR;
            PG8_LDA(At, 1, 1); PG8_STAGE(PG8_SA(1, 0), a3, voffA);
            PG8_BAR; PG8_WAIT_L(0); PG8_MMA(1, 0, At, B0); PG8_BAR; PG8_SCHED;
            PG8_STAGE(PG8_SB(1, 1), b3 + hstepB, voffB);
            PG8_WAIT_V(6); PG8_BAR; PG8_MMA(1, 1, At, B1); PG8_BAR;
            }
        }
        if constexpr (ALIGN_EPI) { if (wr == 0) PG8_BAR; }
        if constexpr (!Epi::AFTER_DRAIN) { E(acc, cur, wr, wc, fr, fq); S.done(cur); }
        if (!has_next) break;
#pragma unroll
        for (int a = 0; a < 2; ++a)
#pragma unroll
            for (int b = 0; b < 2; ++b)
#pragma unroll
                for (int m = 0; m < 4; ++m)
#pragma unroll
                    for (int n = 0; n < 2; ++n) acc[a][b][m][n] = (f32x4){0.f, 0.f, 0.f, 0.f};
        cur = nxt; cA = nA; cB = nB; ++ui;
        if constexpr (ALIGN_EPI) { if (wr == 1) PG8_BAR; }
    }
    PG8_WAIT_V(0);
    if constexpr (!ALIGN_EPI) { if (wr == 0) PG8_BAR; }
    PG8_BAR;
    if constexpr (Epi::AFTER_DRAIN) { E.fused(acc, cur, wr, wc, fr, fq, lds, wid, lane); S.done(cur); }
#undef PG8_SA
#undef PG8_SB
#undef PG8_STAGE
#undef PG8_LDA
#undef PG8_LDB
#undef PG8_MMA
#undef PG8_WAIT_V
#undef PG8_WAIT_L
#undef PG8_BAR
#undef PG8_SCHED
}
}
namespace pg8 {
struct Unit2 { int pm, pn, e, cnt, jt, ui; };
template <class E, class = void> struct has_perm16 { static constexpr bool value = false; };
template <class E> struct has_perm16<E, decltype((void)E::PERM16)> { static constexpr bool value = E::PERM16; };
template <class E> constexpr bool perm16() { return has_perm16<E>::value; }
template <class Epi, class Sched>
__device__ __forceinline__ void gemm_phase2(PG8_LAS unsigned char* lds, const bf16_t* Abase, int lda, int ldb, int K, const Sched& S, const Epi& E, int kstepA_ = BK * 2) {
    int tid_ = threadIdx.x; asm volatile("" : "+v"(tid_));
    const int tid = tid_, wid = __builtin_amdgcn_readfirstlane(tid >> 6), lane = tid & 63, wr = wid >> 2, wc = wid & 3, fr = lane & 15, fq = lane >> 4;
    int K_ = K; asm volatile("" : "+s"(K_));
    const int nt = K_ / BK;
    unsigned voffB0[2], voffB1[2];
#pragma unroll
    for (int i = 0; i < 2; ++i) { int R, C; stage_rc(tid * 16 + i * 8192, R, C);
        if constexpr (perm16<Epi>()) { const int cb = 64 * (R >> 5) + 16 * ((R >> 2) & 3) + 4 * ((R >> 4) & 1) + (R & 3); voffB0[i] = (unsigned)(cb * ldb + C) * 2u; voffB1[i] = (unsigned)((cb + 8) * ldb + C) * 2u; }
        else { const int Rb = Epi::PERM ? ((R & ~31) + perm32(R & 31)) : R; voffB0[i] = (unsigned)(Rb * ldb + C) * 2u; voffB1[i] = voffB0[i] + (unsigned)(HALF * ldb * 2); } }
    const unsigned lda2 = (unsigned)lda * 2u;
#define PG8_AOFFS(U, o0, o1) do { int t2_ = threadIdx.x; asm volatile("" : "+v"(t2_)); _Pragma("unroll") for (int i_ = 0; i_ < 2; ++i_) { int R_, C_; stage_rc(t2_ * 16 + i_ * 8192, R_, C_); \
        o0[i_] = (unsigned)S.arow(U, R_) * lda2 + (unsigned)C_ * 2u; o1[i_] = (unsigned)S.arow(U, HALF + R_) * lda2 + (unsigned)C_ * 2u; } } while (0)
    const size_t kstep = (size_t)(BK * 2), kstepA = (size_t)kstepA_;
    const unsigned ldsw = (unsigned)wid * 1024u;
    const int aoff = lds_byte(wr * 64 + fr, fq * 8), boff = lds_byte(wc * 32 + fr, fq * 8);
#define PG8_SA(b, h) (((b) * 2 + (h)) * HTB)
#define PG8_SB(b, h) ((4 + (b) * 2 + (h)) * HTB)
#define PG8_STAGE(bufoff, gbase, voff) do { _Pragma("unroll") for (int _i = 0; _i < 2; ++_i) \
        __builtin_amdgcn_global_load_lds((const unsigned*)((const char*)(gbase) + (voff)[_i]), (PG8_LAS unsigned*)(lds + (bufoff) + ldsw + _i * 8192), 16, 0, 0); } while (0)
#define PG8_LDA(dst, b, h) do { _Pragma("unroll") for (int m = 0; m < 4; ++m) _Pragma("unroll") for (int k = 0; k < 2; ++k) dst[m][k] = *(const PG8_LAS bf16x8*)(lds + PG8_SA(b, h) + aoff + m * 2048 + k * 1024); } while (0)
#define PG8_LDB(dst, b, h) do { _Pragma("unroll") for (int n = 0; n < 2; ++n) _Pragma("unroll") for (int k = 0; k < 2; ++k) dst[n][k] = *(const PG8_LAS bf16x8*)(lds + PG8_SB(b, h) + boff + n * 2048 + k * 1024); } while (0)
#define PG8_MMA(ai, bj, At, Bt) do { __builtin_amdgcn_s_setprio(1); _Pragma("unroll") for (int m = 0; m < 4; ++m) _Pragma("unroll") for (int n = 0; n < 2; ++n) _Pragma("unroll") for (int k = 0; k < 2; ++k) \
        acc[ai][bj][m][n] = __builtin_amdgcn_mfma_f32_16x16x32_bf16(Bt[n][k], At[m][k], acc[ai][bj][m][n], 0, 0, 0); __builtin_amdgcn_s_setprio(0); } while (0)
#define PG8_WAIT_V(n) asm volatile("s_waitcnt vmcnt(" #n ")" ::: "memory")
#define PG8_WAIT_L(n) asm volatile("s_waitcnt lgkmcnt(" #n ")" ::: "memory")
#define PG8_BAR __builtin_amdgcn_s_barrier()
#define PG8_SCHED __builtin_amdgcn_sched_barrier(0)
    Unit2 cur, nxt; int ui = 0;
    if (!S.next(0, cur)) return;
    f32x4 acc[2][2][4][2];
#pragma unroll
    for (int a = 0; a < 2; ++a)
#pragma unroll
        for (int b = 0; b < 2; ++b)
#pragma unroll
            for (int m = 0; m < 4; ++m)
#pragma unroll
                for (int n = 0; n < 2; ++n) acc[a][b][m][n] = (f32x4){0.f, 0.f, 0.f, 0.f};
    bf16x8 At[4][2], B0[2][2], B1[2][2];
    unsigned cv0[2], cv1[2], nv0[2], nv1[2];
    PG8_AOFFS(cur, cv0, cv1);
    const char* cA = (const char*)Abase + S.aoff(cur); const char* cB = S.bptr(cur);
    PG8_STAGE(PG8_SB(0, 0), cB, voffB0); PG8_STAGE(PG8_SB(0, 1), cB, voffB1); PG8_STAGE(PG8_SA(0, 0), cA, cv0); PG8_STAGE(PG8_SA(0, 1), cA, cv1);
    if (wr == 1) PG8_BAR;
    PG8_WAIT_V(2); PG8_BAR;
    PG8_STAGE(PG8_SB(1, 0), cB + kstep, voffB0); PG8_STAGE(PG8_SA(1, 0), cA + kstepA, cv0); PG8_STAGE(PG8_SB(1, 1), cB + kstep, voffB1);
    PG8_WAIT_V(6); PG8_BAR;
    for (;;) {
        const bool has_next = S.next(ui + 1, nxt);
        const char* nA = has_next ? (const char*)Abase + S.aoff(nxt) : cA; const char* nB = has_next ? S.bptr(nxt) : cB;
#pragma unroll
        for (int i = 0; i < 2; ++i) { nv0[i] = cv0[i]; nv1[i] = cv1[i]; }
        if (has_next) PG8_AOFFS(nxt, nv0, nv1);
        const bool act0 = cur.cnt > wr * 64, act1 = cur.cnt > HALF + wr * 64;
        for (int t = 0; t < nt; t += 2) {
            const bool last = (t == nt - 2);
            const char* a1 = cA + (size_t)(t + 1) * kstepA;
            const char* a2 = last ? nA : cA + (size_t)(t + 2) * kstepA; const char* b2 = last ? nB : cB + (size_t)(t + 2) * kstep;
            const char* a3 = a2 + kstepA; const char* b3 = b2 + kstep;
            unsigned s0[2] = {cv0[0], cv0[1]}, s1[2] = {cv1[0], cv1[1]};
            if (last) { asm volatile("" ::: "memory"); s0[0] = nv0[0]; s0[1] = nv0[1]; s1[0] = nv1[0]; s1[1] = nv1[1]; }
            PG8_LDB(B0, 0, 0); PG8_LDB(B1, 0, 1); PG8_SCHED; PG8_LDA(At, 0, 0); PG8_STAGE(PG8_SA(1, 1), a1, cv1);
            PG8_WAIT_V(8); PG8_WAIT_L(0); PG8_BAR; if (act0) { PG8_MMA(0, 0, At, B0); PG8_MMA(0, 1, At, B1); } PG8_BAR; PG8_SCHED;
            PG8_LDA(At, 0, 1); PG8_STAGE(PG8_SB(0, 0), b2, voffB0); PG8_STAGE(PG8_SB(0, 1), b2, voffB1); PG8_STAGE(PG8_SA(0, 0), a2, s0);
            PG8_WAIT_V(8); PG8_WAIT_L(0); PG8_BAR; if (act1) { PG8_MMA(1, 0, At, B0); PG8_MMA(1, 1, At, B1); } PG8_BAR; PG8_SCHED;
            PG8_LDB(B0, 1, 0); PG8_LDB(B1, 1, 1); PG8_SCHED; PG8_LDA(At, 1, 0); PG8_STAGE(PG8_SA(0, 1), a2, s1);
            PG8_WAIT_V(8); PG8_WAIT_L(0); PG8_BAR; if (act0) { PG8_MMA(0, 0, At, B0); PG8_MMA(0, 1, At, B1); } PG8_BAR; PG8_SCHED;
            PG8_LDA(At, 1, 1); PG8_STAGE(PG8_SB(1, 0), b3, voffB0); PG8_STAGE(PG8_SB(1, 1), b3, voffB1); PG8_STAGE(PG8_SA(1, 0), a3, s0);
            PG8_WAIT_V(8); PG8_WAIT_L(0); PG8_BAR; if (act1) { PG8_MMA(1, 0, At, B0); PG8_MMA(1, 1, At, B1); } PG8_BAR; PG8_SCHED;
        }
        if (wr == 0) PG8_BAR;
        { Unit2 eu = cur; asm volatile("" : "+s"(eu.pm), "+s"(eu.pn), "+s"(eu.e), "+s"(eu.cnt), "+s"(eu.jt), "+s"(eu.ui));
          E(acc, eu, wr, wc, fr, fq);
          }
        if (!has_next) break;
#pragma unroll
        for (int a = 0; a < 2; ++a)
#pragma unroll
            for (int b = 0; b < 2; ++b)
#pragma unroll
                for (int m = 0; m < 4; ++m)
#pragma unroll
                    for (int n = 0; n < 2; ++n) acc[a][b][m][n] = (f32x4){0.f, 0.f, 0.f, 0.f};
        cur = nxt; cA = nA; cB = nB; ++ui;
#pragma unroll
        for (int i = 0; i < 2; ++i) { cv0[i] = nv0[i]; cv1[i] = nv1[i]; }
        if (wr == 1) PG8_BAR;
    }
    PG8_WAIT_V(0);
    PG8_BAR;
#undef PG8_AOFFS
#undef PG8_SA
#undef PG8_SB
#undef PG8_STAGE
#undef PG8_LDA
#undef PG8_LDB
#undef PG8_MMA
#undef PG8_WAIT_V
#undef PG8_WAIT_L
#undef PG8_BAR
#undef PG8_SCHED
}

struct DenseSched {
    StaticOrder so; const bf16_t* Bt; int ldb;
    __device__ __forceinline__ bool next(int i, Unit2& u) const { Unit t; if (!so.next(i, t)) return false; u.pm = t.pm; u.pn = t.pn; u.e = 0; u.cnt = 256; u.jt = 0; u.ui = i; return true; }
    __device__ __forceinline__ int arow(const Unit2& u, int r) const { return u.pm * BM + r; }
    __device__ __forceinline__ size_t aoff(const Unit2&) const { return 0; }
    __device__ __forceinline__ const char* bptr(const Unit2& u) const { return (const char*)(Bt + (size_t)u.pn * BM * ldb); }
};
struct EpiPlainBf16 {
    static constexpr bool PERM = true, AFTER_DRAIN = false;
    bf16_t* O; int ldc;
    __device__ __forceinline__ void operator()(const f32x4 (&acc)[2][2][4][2], const Unit2& u, int wr, int wc, int fr, int fq) const {
        const int row0 = u.pm * BM + wr * 64 + fr, col0 = u.pn * BM + wc * 32 + 8 * fq;
#pragma unroll
        for (int ai = 0; ai < 2; ++ai)
#pragma unroll
            for (int m = 0; m < 4; ++m) { bf16_t* rowp = O + (size_t)(row0 + ai * HALF + m * 16) * ldc + col0;
#pragma unroll
                for (int bj = 0; bj < 2; ++bj) { const f32x4 v0 = acc[ai][bj][m][0], v1 = acc[ai][bj][m][1];
                    u32x4 w; w.x = cvt_pk_bf16(v0[0], v0[1]); w.y = cvt_pk_bf16(v0[2], v0[3]); w.z = cvt_pk_bf16(v1[0], v1[1]); w.w = cvt_pk_bf16(v1[2], v1[3]);
                    *(u32x4*)(rowp + bj * HALF) = w; } }
    }
};
}
namespace nv {
constexpr int D = 1024, B = 8, S = 4096, T = B * S;
constexpr int FH = 8, FD = 64, GH = 4, GK = 64, GV = 128, RANK = 16;
constexpr int INW = 3096;
constexpr int O_FQ = 0, O_FK = 512, O_FV = 1024, O_FF = 1536, O_GQ = 1544, O_GK = 1800, O_GV = 2056, O_GA = 2568, O_GR = 2584;
constexpr int NE = 256, NG = 8, TOPK = 8, ED = 256;
constexpr float LN_EPS = 1e-5f;
constexpr float ALPHA = 1.189207115002721f;
constexpr int PADR = 64;
constexpr int APAD = T * TOPK + NE * PADR;

__device__ __forceinline__ float logsigmoidf(float x) { return fminf(x, 0.f) - log1pf(expf(-fabsf(x))); }
__device__ __forceinline__ float siluf(float x) { return x / (1.f + expf(-x)); }

}
#include <hip/hip_bf16.h>
#include <cmath>
namespace attn_body {
using bf16=__hip_bfloat16;
using bf16x8=__attribute__((ext_vector_type(8)))short;
using s16x4=__attribute__((ext_vector_type(4)))short;
using f32x16=__attribute__((ext_vector_type(16)))float;
using u32x4=__attribute__((ext_vector_type(4)))unsigned;
constexpr int BATCH=8,NHEAD=8,SEQ=4096,D=64,DM=3072,OPITCH=1024;
constexpr int NW=8,QBLK=32,QB=QBLK*NW,KVBLK=64,NQB=SEQ/QB;
constexpr int ATTN_PITCH=DM, ATTN_UNIT_ROWS=QB;
__device__ __forceinline__ int crow(int r,int hi){return (r&3)+8*(r>>2)+4*hi;}
#define SBAR() __builtin_amdgcn_sched_barrier(0)
__device__ __forceinline__ void cmask(f32x16&p0,f32x16&p1,int jb,int qrel,int hi){
  const float NEG=-INFINITY; int kb=64*jb+4*hi;
  #pragma unroll
  for(int r=0;r<16;++r){int kv=kb+(r&3)+8*(r>>2); if(kv>qrel)p0[r]=NEG; if(kv+32>qrel)p1[r]=NEG;}
}

constexpr int NSLOT=3, SLOTB=8192;
constexpr int LDS_K=0, LDS_V=NSLOT*SLOTB, LDS_WS=2*NSLOT*SLOTB, LDS_OST=LDS_WS+NW*64*4, LDS_KB=LDS_OST+NW*4096, LDS_BYTES=LDS_KB+(SEQ+2)*8;
constexpr float C2=0.125f*1.4426950408889634f;
__device__ __forceinline__ void glds16(const void*gsrc,unsigned lds_dst){unsigned keep;
  asm volatile("s_mov_b32 %0, m0\n\ts_mov_b32 m0, %2\n\ts_nop 0\n\tglobal_load_lds_dwordx4 %1, off\n\ts_mov_b32 m0, %0":"=&s"(keep):"v"(gsrc),"s"(lds_dst):"memory");}
__device__ __forceinline__ float max3f(float a,float b,float c){float r;asm("v_max3_f32 %0, %1, %2, %3":"=v"(r):"v"(a),"v"(b),"v"(c));return r;}
__device__ __forceinline__ float max2f(float a,float b){float r;asm("v_max_f32_e32 %0, %1, %2":"=v"(r):"v"(a),"v"(b));return r;}
__device__ __forceinline__ float fadd_s(float a,float b){float r;asm("v_add_f32_e32 %0, %1, %2":"=v"(r):"v"(a),"v"(b));return r;}
__device__ __forceinline__ float fsub_s(float a,float b){float r;asm("v_sub_f32_e32 %0, %1, %2":"=v"(r):"v"(a),"v"(b));return r;}
typedef float f32x2_t __attribute__((ext_vector_type(2))); typedef float f32x4_t __attribute__((ext_vector_type(4))); typedef __bf16 bf16x2_t __attribute__((ext_vector_type(2)));
__device__ __forceinline__ unsigned cvtpk_s(float lo,float hi){f32x2_t v={lo,hi};bf16x2_t b=__builtin_convertvector(v,bf16x2_t);return __builtin_bit_cast(unsigned,b);}
#define WAIT_BAR(N) asm volatile("s_waitcnt vmcnt(" #N ") lgkmcnt(0)\n\ts_barrier":::"memory")

__device__ __forceinline__ void split3(float b,unsigned&h,unsigned&m,unsigned&l){
  h=cvtpk_s(b,0.f)&0xffffu; const float r1=b-__uint_as_float(h<<16);
  m=cvtpk_s(r1,0.f)&0xffffu; const float r2=r1-__uint_as_float(m<<16);
  l=cvtpk_s(r2,0.f)&0xffffu; }
__device__ __forceinline__ bf16x8 kbias_frag(float b,int hi){unsigned h,m,l;split3(b,h,m,l);u32x4 w;w.x=h|(m<<16);w.y=l|0x3F800000u;w.z=0x3F803F80u;w.w=0u;if(hi){w.x=0u;w.y=0u;w.z=0u;}return __builtin_bit_cast(bf16x8,w);}
__device__ __forceinline__ bf16x8 qref_frag(float x,int hi){unsigned h,m,l;split3(x,h,m,l);u32x4 w;w.x=0x3F803F80u;w.y=0x3F80u|(h<<16);w.z=m|(l<<16);w.w=0u;if(hi){w.x=0u;w.y=0u;w.z=0u;}return __builtin_bit_cast(bf16x8,w);}
typedef unsigned u32x2_t __attribute__((ext_vector_type(2)));
__device__ __forceinline__ bf16x8 mkfrag(u32x2_t e,unsigned zc){u32x4 w;w.x=e.x;w.y=e.y;w.z=zc;w.w=0u;return __builtin_bit_cast(bf16x8,w);}
__device__ __forceinline__ void fox_bias_table(int b,int h,const float*LF,char*shm){
  int tid_=threadIdx.x; asm volatile("":"+v"(tid_)); const int tid=tid_,lane=tid&63,wid=__builtin_amdgcn_readfirstlane(tid>>6);
  const float*lf=LF+((long)b*NHEAD+h)*SEQ; float*wt=(float*)(shm+LDS_WS); u32x2_t*KB8=(u32x2_t*)(shm+LDS_KB);
  f32x4_t va=*(const f32x4_t*)(lf+8*tid),vb=*(const f32x4_t*)(lf+8*tid+4);
  va[1]+=va[0];va[2]+=va[1];va[3]+=va[2];vb[0]+=va[3];vb[1]+=vb[0];vb[2]+=vb[1];vb[3]+=vb[2];
  const float tot=vb[3]; float inc=tot;
  #pragma unroll
  for(int o_=1;o_<64;o_<<=1){const float nn=__shfl_up(inc,o_);if(lane>=o_)inc+=nn;}
  __syncthreads();
  if(lane==63)wt[wid*64]=inc;
  __syncthreads();
  float base=inc-tot;
  #pragma unroll
  for(int w_=0;w_<NW;++w_){const float x_=wt[w_*64]; if(w_<wid)base+=x_;}
  const float cv[8]={va[0]+base,va[1]+base,va[2]+base,va[3]+base,vb[0]+base,vb[1]+base,vb[2]+base,vb[3]+base};
  #pragma unroll
  for(int j=0;j<8;++j){unsigned hh,mm,ll;split3(-cv[j],hh,mm,ll);KB8[8*tid+j]=(u32x2_t){hh|(mm<<16),ll|0x3F800000u};}
  if(tid==0){KB8[SEQ]=(u32x2_t){0u,0u};KB8[SEQ+1]=(u32x2_t){0u,0u};}
  __syncthreads();
}
__device__ __forceinline__ void qkt(f32x16&p0,f32x16&p1,const char*Kslot,const bf16x8*qr,bf16x8 kb0,bf16x8 kb1,bf16x8 qx,int r32,int hi){
  const f32x16 negm=f32x16{};
  const char*kb=Kslot+hi*1024+r32*16;
  #pragma unroll
  for(int d0=0;d0<4;++d0){
    const bf16x8 b0=*reinterpret_cast<const bf16x8*>(kb+d0*2048);
    const bf16x8 b1=*reinterpret_cast<const bf16x8*>(kb+d0*2048+512);
    if(d0==0){p0=__builtin_amdgcn_mfma_f32_32x32x16_bf16(b0,qr[0],negm,0,0,0);p1=__builtin_amdgcn_mfma_f32_32x32x16_bf16(b1,qr[0],negm,0,0,0);}
    else{p0=__builtin_amdgcn_mfma_f32_32x32x16_bf16(b0,qr[d0],p0,0,0,0);p1=__builtin_amdgcn_mfma_f32_32x32x16_bf16(b1,qr[d0],p1,0,0,0);}}
  p0=__builtin_amdgcn_mfma_f32_32x32x16_bf16(kb0,qx,p0,0,0,0);p1=__builtin_amdgcn_mfma_f32_32x32x16_bf16(kb1,qx,p1,0,0,0);
}
typedef __attribute__((address_space(3))) const char* lds_cptr;
typedef short v4i16_t __attribute__((ext_vector_type(4)));
__device__ __forceinline__ void kload8(bf16x8*kf,lds_cptr kp){
  kf[0]=*(const __attribute__((address_space(3))) bf16x8*)(kp);      kf[1]=*(const __attribute__((address_space(3))) bf16x8*)(kp+512);
  kf[2]=*(const __attribute__((address_space(3))) bf16x8*)(kp+2048); kf[3]=*(const __attribute__((address_space(3))) bf16x8*)(kp+2560);
  kf[4]=*(const __attribute__((address_space(3))) bf16x8*)(kp+4096); kf[5]=*(const __attribute__((address_space(3))) bf16x8*)(kp+4608);
  kf[6]=*(const __attribute__((address_space(3))) bf16x8*)(kp+6144); kf[7]=*(const __attribute__((address_space(3))) bf16x8*)(kp+6656);
}
__device__ __forceinline__ void kload2(bf16x8*kf,lds_cptr kp,int j){ kf[2*j]=*(const __attribute__((address_space(3))) bf16x8*)(kp+j*2048); kf[2*j+1]=*(const __attribute__((address_space(3))) bf16x8*)(kp+j*2048+512); }
__device__ __forceinline__ s16x4 vtr(lds_cptr p){ return __builtin_bit_cast(s16x4,__builtin_amdgcn_ds_read_tr16_b64_v4i16((__attribute__((address_space(3))) v4i16_t*)p)); }
__device__ __forceinline__ float rowmax(const f32x16&p0,const f32x16&p1){
  float a=max3f(p0[0],p0[1],p1[0]),b=max3f(p0[2],p0[3],p1[1]);a=max3f(a,p1[2],p1[3]);
  #pragma unroll
  for(int r=4;r<16;r+=4){a=max3f(a,p0[r],p0[r+1]);b=max3f(b,p0[r+2],p0[r+3]);a=max3f(a,p1[r],p1[r+1]);b=max3f(b,p1[r+2],p1[r+3]);}
  const float m=max2f(a,b);
  auto rr=__builtin_amdgcn_permlane32_swap(__float_as_uint(m),__float_as_uint(m),false,false);
  return max2f(__uint_as_float(rr[0]),__uint_as_float(rr[1]));
}
__device__ __forceinline__ void pv(f32x16*o,int vb,bf16x8 pa0,bf16x8 pa1,bf16x8 pa2,bf16x8 pa3){
  #pragma unroll
  for(int d0=0;d0<2;++d0){s16x4 lo[4],hi[4];
    #pragma unroll
    for(int ks=0;ks<4;++ks){
      asm volatile("ds_read_b64_tr_b16 %0,%1 offset:%c2":"=&v"(lo[ks]):"v"(vb),"i"(d0*4096+ks*1024):"memory");
      asm volatile("ds_read_b64_tr_b16 %0,%1 offset:%c2":"=&v"(hi[ks]):"v"(vb),"i"(d0*4096+ks*1024+512):"memory");}
    asm volatile("s_waitcnt lgkmcnt(0)":::"memory");SBAR();
    #define PK(k) (bf16x8){lo[k][0],lo[k][1],lo[k][2],lo[k][3],hi[k][0],hi[k][1],hi[k][2],hi[k][3]}
    o[d0]=__builtin_amdgcn_mfma_f32_32x32x16_bf16(pa0,PK(0),o[d0],0,0,0);
    o[d0]=__builtin_amdgcn_mfma_f32_32x32x16_bf16(pa1,PK(1),o[d0],0,0,0);
    o[d0]=__builtin_amdgcn_mfma_f32_32x32x16_bf16(pa2,PK(2),o[d0],0,0,0);
    o[d0]=__builtin_amdgcn_mfma_f32_32x32x16_bf16(pa3,PK(3),o[d0],0,0,0);
    #undef PK
  }
}

#ifndef ATTN_STORE16
#define ATTN_STORE16(p,v) (*(u32x4*)(p)=(v))
#endif
template<int THRL> __device__ __forceinline__ void attn_unit(int b,int h,int qb,const bf16*Q,const bf16* K,const bf16* V,bf16*O,const float*LF,const unsigned*NRM,char*shm){
  int tid_=threadIdx.x; asm volatile("":"+v"(tid_));
  const int tid=tid_,lane=tid&63,r32=lane&31,hi=lane>>5; const int wid=__builtin_amdgcn_readfirstlane(tid>>6);
  const long rowbase=(long)b*SEQ; const int q0=qb*QB;
  const char*KBt0=shm+LDS_KB;
  int t0;
  { const int NT0=(q0+QB)/KVBLK; const unsigned*nr=NRM+(b*NHEAD+h)*4;
    const float qn2=__uint_as_float(nr[0])+__uint_as_float(nr[1]), kn2=__uint_as_float(nr[2])+__uint_as_float(nr[3]);
    const float thr=-(50.f+2.04f*sqrtf(qn2*kn2));
    const u32x2_t eq0=*(const u32x2_t*)(KBt0+(unsigned)q0*8u); const float bq0=__uint_as_float(eq0.x<<16)+__uint_as_float(eq0.x&0xffff0000u)+__uint_as_float(eq0.y<<16);
    bool ok=(2*lane<=NT0-4);
    if(ok&&lane>0){ const u32x2_t el=*(const u32x2_t*)(KBt0+(unsigned)(128*lane-1)*8u); const float bl=__uint_as_float(el.x<<16)+__uint_as_float(el.x&0xffff0000u)+__uint_as_float(el.y<<16); ok=(bl-bq0<thr); }
    const unsigned long long mk=__ballot(ok); const unsigned long long low=~mk; const int cnt=(low==0ull)?64:__builtin_ctzll(low);
    t0=__builtin_amdgcn_readfirstlane(2*(cnt-1)); }
  const char*KBt=KBt0+(hi?0:t0*512); const unsigned kb_o0=hi?(unsigned)SEQ*8u:(unsigned)r32*8u, kb_o1=hi?(unsigned)SEQ*8u:(unsigned)(r32+32)*8u, kb_str=hi?0u:512u, zc=hi?0u:0x3F803F80u;
  const bf16*Qw=Q+(rowbase+q0+wid*QBLK)*DM+h*D;
  const bf16*Kh=K+(rowbase+(long)t0*KVBLK)*DM+h*D,*Vh=V+(rowbase+(long)t0*KVBLK)*DM+h*D;
  const unsigned lds0=(unsigned)(uintptr_t)shm;
  float*wsf=(float*)(shm+LDS_WS)+wid*64;
  const bf16*ksrc=Kh+(long)lane*DM+wid*8;
  const bf16*vsrc=Vh+(long)(16*(wid&3)+(lane>>2))*DM+(wid>>2)*32+(lane&3)*8;
  const unsigned kdst=lds0+LDS_K+wid*1024, vdst=lds0+LDS_V+wid*1024;
  #define DMA_K(t,slot) glds16(ksrc+(long)(t)*KVBLK*DM,(unsigned)__builtin_amdgcn_readfirstlane(kdst+(slot)))
  #define DMA_V(t,slot) glds16(vsrc+(long)(t)*KVBLK*DM,(unsigned)__builtin_amdgcn_readfirstlane(vdst+(slot)))
  const int vb0=(int)(lds0+LDS_V)+((lane>>4)&1)*32+(lane&3)*8+(4*hi+((lane&15)>>2))*64;
  const char*Kbase=shm+LDS_K; bf16x8 kf[8];
  const lds_cptr shm3=(lds_cptr)shm; const lds_cptr kp0=shm3+LDS_K+hi*1024+r32*16; const lds_cptr vp0=shm3+LDS_V+((lane>>4)&1)*32+(lane&3)*8+(4*hi+((lane&15)>>2))*64;
  const int NT=(q0+QB)/KVBLK-t0;
  DMA_K(0,0);DMA_V(0,0);DMA_K(1,SLOTB);
  bf16x8 qr[4];
  #pragma unroll
  for(int d0=0;d0<4;++d0)qr[d0]=*reinterpret_cast<const bf16x8*>(&Qw[(long)r32*DM+d0*16+hi*8]);
  float mhat; { const u32x2_t eq=*(const u32x2_t*)(KBt0+(unsigned)(q0+wid*QBLK+r32)*8u); mhat=__uint_as_float(eq.x<<16)+__uint_as_float(eq.x&0xffff0000u)+__uint_as_float(eq.y<<16); }
  float l_reg=0.f;f32x16 o[2];o[0]=f32x16{};o[1]=f32x16{};const f32x16 negm=f32x16{};
  bf16x8 qx=qref_frag(-mhat,hi);
  const int qrel=wid*QBLK+r32;
  #define CMASK(P0,P1,t) do{int jb_=(t)-(NT-4); if(jb_>=0)cmask(P0,P1,jb_,qrel,hi);}while(0)
  bool resc=false;
  #define START(P0,P1) do{ const float rm=rowmax(P0,P1); resc=false; \
    { const float dl=__builtin_fmaxf(rm,0.f); mhat=fadd_s(mhat,dl); \
      _Pragma("unroll") for(int r=0;r<16;++r){P0[r]=fsub_s(P0[r],dl);P1[r]=fsub_s(P1[r],dl);} \
      qx=qref_frag(-mhat,hi); } \
    _Pragma("unroll") for(int r=0;r<16;++r)P0[r]=__builtin_amdgcn_exp2f(P0[r]); }while(0)
  #define RESC() do{ if(resc){ asm volatile("s_waitcnt lgkmcnt(0)":::"memory"); \
      _Pragma("unroll") for(int d_=0;d_<2;++d_) _Pragma("unroll") for(int r=0;r<16;++r)o[d_][r]*=wsf[crow(r,hi)]; } }while(0)
  f32x16 pA0,pA1,pB0,pB1;
  int sl_prev=0,sl_cur=0,sl_next=SLOTB;
  #define ROT() do{sl_prev=sl_cur;sl_cur=sl_next;sl_next=(sl_next==(NSLOT-1)*SLOTB)?0:sl_next+SLOTB;}while(0)
  DMA_K(2,2*SLOTB);
  WAIT_BAR(3);
  qkt(pA0,pA1,Kbase,qr,mkfrag(*(const u32x2_t*)(KBt+kb_o0),zc),mkfrag(*(const u32x2_t*)(KBt+kb_o1),zc),qx,r32,hi);asm volatile("s_nop 15\n\ts_nop 7":"+v"(pA0),"+v"(pA1));CMASK(pA0,pA1,0);
  START(pA0,pA1);
  _Pragma("unroll") for(int r=0;r<16;++r)pA1[r]=__builtin_amdgcn_exp2f(pA1[r]);
  WAIT_BAR(0);
  DMA_K(3,0);DMA_V(1,SLOTB);
  ROT();
  kload8(kf,kp0+sl_cur);
  WAIT_BAR(2);
  s16x4 vlo[8],vhi[8]; u32x4 pw0,pw1,pw2,pw3;
  #define PKW(P,B) cvtpk_s(P[B],P[B+1])
  #define PAF(k) __builtin_bit_cast(bf16x8,pw##k)
  #define VFR(i) (bf16x8){vlo[i][0],vlo[i][1],vlo[i][2],vlo[i][3],vhi[i][0],vhi[i][1],vhi[i][2],vhi[i][3]}
  #define PIN(x) asm volatile("":"+v"(x))
  #define MX3(a,b,c) __builtin_fmaxf(__builtin_fmaxf((a),(b)),(c))
  #define GAPA(MF,A0,A1,A2,A3,W0,W1,PW) do{ MF; sacc+=A0; sacc+=A1; sacc+=A2; sacc+=A3; PIN(sacc); W0; W1; PIN(PW); SBAR(); }while(0)
  #define EX(v) __builtin_amdgcn_exp2f(v)
  #define GAPB(MF,X,B) do{ MF; X[B]=EX(X[B]); X[B+1]=EX(X[B+1]); X[B+2]=EX(X[B+2]); X[B+3]=EX(X[B+3]); PIN(X); SBAR(); }while(0)
  #define VRD(i) do{ vlo[i]=vtr(vp_+(((i)>>2)*4096+((i)&3)*1024)); vhi[i]=vtr(vp_+(((i)>>2)*4096+((i)&3)*1024+512)); }while(0)
  #define KRD(G,j) do{ if(G){ kload2(kf,kp0+sl_next,j); SBAR(); } }while(0)
  #define STEP(C0,C1,P0,P1,t,GK,GV,GL) do{ SBAR(); \
    const lds_cptr vp_=vp0+sl_prev; const u32x2_t e0_=*(const u32x2_t*)(KBt+kb_o0+(unsigned)(t)*kb_str),e1_=*(const u32x2_t*)(KBt+kb_o1+(unsigned)(t)*kb_str); \
    VRD(0); SBAR(); float sacc=(P0[0]+P0[1]); \
    GAPA(C0=__builtin_amdgcn_mfma_f32_32x32x16_bf16(kf[0],qr[0],negm,0,0,0), P0[2],P0[3],P0[4],P0[5],     pw0[0]=PKW(P0,0), pw0[1]=PKW(P0,2), pw0); \
    VRD(4); SBAR(); GAPA(C1=__builtin_amdgcn_mfma_f32_32x32x16_bf16(kf[1],qr[0],negm,0,0,0), P0[6],P0[7],P0[8],P0[9],     pw0[2]=PKW(P0,4), pw0[3]=PKW(P0,6), pw0); \
    VRD(1); SBAR(); GAPA(C0=__builtin_amdgcn_mfma_f32_32x32x16_bf16(kf[2],qr[1],C0,0,0,0),   P0[10],P0[11],P0[12],P0[13], pw1[0]=PKW(P0,8), pw1[1]=PKW(P0,10), pw1); \
    VRD(5); SBAR(); GAPA(C1=__builtin_amdgcn_mfma_f32_32x32x16_bf16(kf[3],qr[1],C1,0,0,0),   P0[14],P0[15],P1[0],P1[1],   pw1[2]=PKW(P0,12),pw1[3]=PKW(P0,14), pw1); \
    VRD(2); SBAR(); GAPA(C0=__builtin_amdgcn_mfma_f32_32x32x16_bf16(kf[4],qr[2],C0,0,0,0),   P1[2],P1[3],P1[4],P1[5],     pw2[0]=PKW(P1,0), pw2[1]=PKW(P1,2), pw2); \
    VRD(6); SBAR(); GAPA(C1=__builtin_amdgcn_mfma_f32_32x32x16_bf16(kf[5],qr[2],C1,0,0,0),   P1[6],P1[7],P1[8],P1[9],     pw2[2]=PKW(P1,4), pw2[3]=PKW(P1,6), pw2); \
    VRD(3); SBAR(); GAPA(C0=__builtin_amdgcn_mfma_f32_32x32x16_bf16(kf[6],qr[3],C0,0,0,0),   P1[10],P1[11],P1[12],P1[13], pw3[0]=PKW(P1,8), pw3[1]=PKW(P1,10), pw3); \
    VRD(7); SBAR(); GAPA(C1=__builtin_amdgcn_mfma_f32_32x32x16_bf16(kf[7],qr[3],C1,0,0,0),   P1[14],P1[15],0.f,0.f,       pw3[2]=PKW(P1,12),pw3[3]=PKW(P1,14), pw3); \
    { const bf16x8 kb0_=mkfrag(e0_,zc),kb1_=mkfrag(e1_,zc); C0=__builtin_amdgcn_mfma_f32_32x32x16_bf16(kb0_,qx,C0,0,0,0); C1=__builtin_amdgcn_mfma_f32_32x32x16_bf16(kb1_,qx,C1,0,0,0); } SBAR(); \
    l_reg+=sacc; \
    if(GK){DMA_K((t)+3,sl_cur);} if(GV){DMA_V((t)+1,sl_next);} \
    CMASK(C0,C1,t); \
    { float a=MX3(C0[0],C0[1],C1[0]),b=MX3(C0[2],C0[3],C1[1]); a=MX3(a,C1[2],C1[3]); \
      _Pragma("unroll") for(int r=4;r<16;r+=4){a=MX3(a,C0[r],C0[r+1]);b=MX3(b,C0[r+2],C0[r+3]);a=MX3(a,C1[r],C1[r+1]);b=MX3(b,C1[r+2],C1[r+3]);} \
      float rm=__builtin_fmaxf(a,b); { auto rr=__builtin_amdgcn_permlane32_swap(__float_as_uint(rm),__float_as_uint(rm),false,false); rm=__builtin_fmaxf(__uint_as_float(rr[0]),__uint_as_float(rr[1])); } \
      resc=false; \
      if(__builtin_expect(__any(rm>(float)THRL),0)){ const float dl=__builtin_fmaxf(rm,0.f); mhat+=dl; \
        _Pragma("unroll") for(int r=0;r<16;++r){C0[r]-=dl;C1[r]-=dl;} \
        qx=qref_frag(-mhat,hi); \
        const float f=__builtin_amdgcn_exp2f(-dl); l_reg*=f; if(hi==0)wsf[r32]=f; resc=true; } } \
    SBAR(); \
    GAPB(o[0]=__builtin_amdgcn_mfma_f32_32x32x16_bf16(PAF(0),VFR(0),o[0],0,0,0), C0,0); \
    GAPB(o[1]=__builtin_amdgcn_mfma_f32_32x32x16_bf16(PAF(0),VFR(4),o[1],0,0,0), C0,4); \
    KRD(GL,0); GAPB(o[0]=__builtin_amdgcn_mfma_f32_32x32x16_bf16(PAF(1),VFR(1),o[0],0,0,0), C0,8); \
    KRD(GL,1); GAPB(o[1]=__builtin_amdgcn_mfma_f32_32x32x16_bf16(PAF(1),VFR(5),o[1],0,0,0), C0,12); \
    KRD(GL,2); GAPB(o[0]=__builtin_amdgcn_mfma_f32_32x32x16_bf16(PAF(2),VFR(2),o[0],0,0,0), C1,0); \
    KRD(GL,3); GAPB(o[1]=__builtin_amdgcn_mfma_f32_32x32x16_bf16(PAF(2),VFR(6),o[1],0,0,0), C1,4); \
    GAPB(o[0]=__builtin_amdgcn_mfma_f32_32x32x16_bf16(PAF(3),VFR(3),o[0],0,0,0), C1,8); \
    GAPB(o[1]=__builtin_amdgcn_mfma_f32_32x32x16_bf16(PAF(3),VFR(7),o[1],0,0,0), C1,12); \
    }while(0)
  int t=1;
  #undef CMASK
  #define CMASK(P0,P1,t) do{}while(0)
  for(;t+5<NT;t+=2){
    STEP(pB0,pB1,pA0,pA1,t,true,true,true);     WAIT_BAR(2); RESC(); ROT();
    STEP(pA0,pA1,pB0,pB1,t+1,true,true,true);   WAIT_BAR(2); RESC(); ROT();
  }
  #undef CMASK
  #define CMASK(P0,P1,t) do{int jb_=(t)-(NT-4); if(jb_>=0)cmask(P0,P1,jb_,qrel,hi);}while(0)
  #define ENDW(tt) do{ if((tt)+3<NT){WAIT_BAR(2);} else if((tt)+2<NT){WAIT_BAR(1);} else {WAIT_BAR(0);} }while(0)
  for(;t+1<NT;t+=2){
    STEP(pB0,pB1,pA0,pA1,t,(t+3<NT),(t+1<NT),(t+1<NT));       ENDW(t);   RESC(); ROT();
    STEP(pA0,pA1,pB0,pB1,t+1,(t+4<NT),(t+2<NT),(t+2<NT));     ENDW(t+1); RESC(); ROT();
  }
  STEP(pB0,pB1,pA0,pA1,NT-1,false,false,false); RESC();
  { float sacc=pB0[0]+pB0[1]; _Pragma("unroll") for(int r=2;r<16;++r)sacc+=pB0[r]; _Pragma("unroll") for(int r=0;r<16;++r)sacc+=pB1[r]; l_reg+=sacc;
    pw0=(u32x4){PKW(pB0,0),PKW(pB0,2),PKW(pB0,4),PKW(pB0,6)};pw1=(u32x4){PKW(pB0,8),PKW(pB0,10),PKW(pB0,12),PKW(pB0,14)};pw2=(u32x4){PKW(pB1,0),PKW(pB1,2),PKW(pB1,4),PKW(pB1,6)};pw3=(u32x4){PKW(pB1,8),PKW(pB1,10),PKW(pB1,12),PKW(pB1,14)};
    SBAR(); pv(o,vb0+sl_cur,PAF(0),PAF(1),PAF(2),PAF(3)); }
  #undef PKW
  #undef PAF
  #undef VFR
  #undef PIN
  #undef MX3
  #undef GAPA
  #undef GAPB
  #undef EX
  #undef VRD
  #undef KRD
  #undef STEP
  #undef ENDW
  {auto rr=__builtin_amdgcn_permlane32_swap(__float_as_uint(l_reg),__float_as_uint(l_reg),false,false);l_reg=__uint_as_float(rr[0])+__uint_as_float(rr[1]);}
  if(hi==0)wsf[32+r32]=l_reg;asm volatile("s_waitcnt lgkmcnt(0)":::"memory");
  float rli[16];
  #pragma unroll
  for(int r=0;r<16;++r)rli[r]=__builtin_amdgcn_rcpf(wsf[32+crow(r,hi)]);
  bf16*Ow=O+(rowbase+q0+wid*QBLK)*OPITCH+h*D;
  { bf16*stg=(bf16*)(shm+LDS_OST)+wid*2048;
    #pragma unroll
    for(int r=0;r<16;++r){const int orow=crow(r,hi);
      #pragma unroll
      for(int d0=0;d0<2;++d0)stg[orow*64+d0*32+r32]=__float2bfloat16(o[d0][r]*rli[r]);}
    asm volatile("s_waitcnt lgkmcnt(0)":::"memory");
    #pragma unroll
    for(int i=0;i<4;++i){const int row=i*8+(lane>>3),ch=lane&7; const u32x4 v=*(const u32x4*)(stg+row*64+ch*8); ATTN_STORE16(Ow+(long)row*OPITCH+ch*8,v);} }
  asm volatile("s_waitcnt lgkmcnt(0)\n\ts_barrier":::"memory");
  #undef DMA_K
  #undef DMA_V
  #undef CMASK
  #undef START
  #undef RESC
  #undef ROT
}
constexpr int ATTN_LDS_BYTES=LDS_BYTES;
struct AttnTensors { const bf16* Q; const bf16* K; const bf16* V; bf16* O; const float* LF; const unsigned* NRM; };
struct AttnUnit { int bh; int qb; };
struct StaticOrder {
  int vcu,grid;
  __device__ __forceinline__ explicit StaticOrder(int grid_,int block):vcu((grid_%8==0)?(block%8)*(grid_/8)+block/8:block),grid(grid_){}
  __device__ __forceinline__ bool next(int i,AttnUnit&u)const{
    if(grid==256){ if(i>=4)return false; const int s=vcu&3; u.bh=vcu>>2; u.qb=(i==0)?s:(i==1)?7-s:(i==2)?8+s:15-s; return true; }
    const int L=i*grid+vcu; if(L>=BATCH*NHEAD*NQB)return false; u.bh=L/NQB; u.qb=L%NQB; return true; }
  __device__ __forceinline__ void a_ready(const AttnUnit&)const{}
  __device__ __forceinline__ void done(const AttnUnit&)const{}
};
template<class Sched,int THRL=8> __device__ __forceinline__ void attn_phase(char*lds,const AttnTensors&T,const Sched&S){
  AttnUnit u; int cur_bh=-1;
  for(int i=0;S.next(i,u);++i){ S.a_ready(u); if(u.bh!=cur_bh){ fox_bias_table(u.bh/NHEAD,u.bh%NHEAD,T.LF,lds); cur_bh=u.bh; }
    attn_unit<THRL>(u.bh/NHEAD,u.bh%NHEAD,u.qb,T.Q,T.K,T.V,T.O,T.LF,T.NRM,lds); S.done(u); }
}
template<int THRL=8> __device__ __forceinline__ void attn_phase_dyn(char*lds,const AttnTensors&T,unsigned*qheads,volatile int*slot,int grp){
  int cur_bh=-1; const int NU=NHEAD*NQB; unsigned*qhead=qheads+64*grp;
  if(threadIdx.x==0) slot[0]=(int)__hip_atomic_fetch_add(qhead,1u,__ATOMIC_RELAXED,__HIP_MEMORY_SCOPE_AGENT);
  __syncthreads();
  int idx=__builtin_amdgcn_readfirstlane(slot[0]);
  while(idx<NU){
    __syncthreads();
    if(threadIdx.x==0) slot[0]=(int)__hip_atomic_fetch_add(qhead,1u,__ATOMIC_RELAXED,__HIP_MEMORY_SCOPE_AGENT);
    const int qb=NQB-1-idx/NHEAD, bh=grp*NHEAD+idx%NHEAD;
    if(bh!=cur_bh){ fox_bias_table(bh/NHEAD,bh%NHEAD,T.LF,lds); cur_bh=bh; }
    attn_unit<THRL>(bh/NHEAD,bh%NHEAD,qb,T.Q,T.K,T.V,T.O,T.LF,T.NRM,lds);
    __syncthreads();
    idx=__builtin_amdgcn_readfirstlane(slot[0]);
  }
}
#undef SBAR
#undef WAIT_BAR
}
namespace fx {
using namespace nv;
typedef unsigned short bf16;
typedef unsigned v4u __attribute__((ext_vector_type(4)));
typedef float f32x4 __attribute__((ext_vector_type(4)));
constexpr float C2 = 0.125f * 1.4426950408889634f;
constexpr int NIN = 3328;
constexpr int QKVP = 3072;
constexpr int P_FQ = 0, P_FK = 512, P_FV = 1024, P_GQ = 1536, P_GK = 1792, P_GV = 2048, P_GR = 2560;
__device__ __forceinline__ int inproj_src(int d) {
    if (d < 1536) return d;
    if (d < 1792) return O_GQ + (d - 1536);
    if (d < 2048) return O_GK + (d - 1792);
    if (d < 2560) return O_GV + (d - 2048);
    if (d < 3072) return O_GR + (d - 2560);
    if (d < 3080) return O_FF + (d - 3072);
    if (d < 3096) return O_GA + (d - 3080);
    return -1;
}
__device__ __forceinline__ unsigned f2bf(float f) { unsigned u = __builtin_bit_cast(unsigned, f); return (u + 0x7fffu + ((u >> 16) & 1u)) >> 16; }
__device__ __forceinline__ unsigned pk2(float lo, float hi) { return f2bf(lo) | (f2bf(hi) << 16); }
__device__ __forceinline__ float bf2f(unsigned short h) { return __builtin_bit_cast(float, (unsigned)h << 16); }
__device__ __forceinline__ float wave_sum(float v) {
#pragma unroll
    for (int o = 1; o < 64; o <<= 1) v += __shfl_xor(v, o);
    return v;
}
#define FX_LDS_WAIT() asm volatile("s_waitcnt lgkmcnt(0)" ::: "memory")

template <class Map> __device__ __forceinline__ void transpose_item(const float* __restrict__ W, int K, int N, bf16* WT, LAS float* scr, int kb, int nb, int lane, Map srcmap) {
    const int k0 = 64 * kb, n0 = 32 * nb;
    const int src = srcmap(n0 + (lane & 31));
#pragma unroll 8
    for (int i = 0; i < 32; ++i) { const int kk = 2 * i + (lane >> 5); scr[kk * 33 + (lane & 31)] = (src >= 0) ? W[(size_t)(k0 + kk) * N + src] : 0.f; }
    FX_LDS_WAIT(); asm volatile("" ::: "memory");
    const int c = lane & 7;
#pragma unroll
    for (int j = 0; j < 4; ++j) { const int n = (lane >> 3) + 8 * j; const LAS float* s = scr + (8 * c) * 33 + n;
        v4u o; o.x = pk2(s[0 * 33], s[1 * 33]); o.y = pk2(s[2 * 33], s[3 * 33]); o.z = pk2(s[4 * 33], s[5 * 33]); o.w = pk2(s[6 * 33], s[7 * 33]);
        *(GAS v4u*)(WT + (size_t)(n0 + n) * K + k0 + 8 * c) = o; }
    FX_LDS_WAIT(); asm volatile("" ::: "memory");
}

__device__ __forceinline__ void ln_row_bf16(const float* xrow, const float* __restrict__ g, const float* __restrict__ b, bf16* orow, float* frow, float* st, int lane) {
    const GAS f32x4* xr = (const GAS f32x4*)xrow + lane;
    f32x4 v[4]; float s = 0.f;
#pragma unroll
    for (int j = 0; j < 4; ++j) { v[j] = xr[64 * j]; s += (v[j].x + v[j].y) + (v[j].z + v[j].w); }
    const float mean = wave_sum(s) * (1.f / D); float s2 = 0.f;
#pragma unroll
    for (int j = 0; j < 4; ++j) { v[j] = v[j] - mean; s2 += (v[j].x * v[j].x + v[j].y * v[j].y) + (v[j].z * v[j].z + v[j].w * v[j].w); }
    const float rstd = 1.f / sqrtf(wave_sum(s2) * (1.f / D) + LN_EPS);
    if (st && lane == 0) { st[0] = mean; st[1] = rstd; }
    GAS unsigned long long* o8 = (GAS unsigned long long*)orow + lane;
#pragma unroll
    for (int j = 0; j < 4; ++j) {
        const f32x4 gg = ((const f32x4*)g)[lane + 64 * j], bb = ((const f32x4*)b)[lane + 64 * j];
        const f32x4 o = v[j] * rstd * gg + bb;
        o8[64 * j] = (unsigned long long)pk2(o.x, o.y) | ((unsigned long long)pk2(o.z, o.w) << 32);
        if (frow) ((GAS f32x4*)frow)[lane + 64 * j] = o;
    }
}

struct CvItem { const float* W; bf16* WT; int N, K, k0, n0, s0; };
__device__ __forceinline__ void cv_load(const CvItem& it, f32x4 (&v)[8], int lane) {
    const float* p = it.W + (size_t)(it.k0 + (lane >> 3)) * it.N + it.s0 + 4 * (lane & 7);
#pragma unroll
    for (int i = 0; i < 8; ++i) v[i] = __builtin_nontemporal_load((const f32x4*)(p + (size_t)(8 * i) * it.N));
}
__device__ __forceinline__ void cv_finish(const CvItem& it, const f32x4 (&v)[8], LAS float* scr, int lane) {
    const int rr = lane >> 3, cq = lane & 7;
#pragma unroll
    for (int i = 0; i < 8; ++i) { LAS float* d = scr + (8 * i + rr) * 33 + 4 * cq; d[0] = v[i][0]; d[1] = v[i][1]; d[2] = v[i][2]; d[3] = v[i][3]; }
    FX_LDS_WAIT(); asm volatile("" ::: "memory");
    const int c = lane & 7;
#pragma unroll
    for (int j = 0; j < 4; ++j) { const int n = (lane >> 3) + 8 * j; const LAS float* s = scr + (8 * c) * 33 + n;
        v4u o; o.x = pk2(s[0 * 33], s[1 * 33]); o.y = pk2(s[2 * 33], s[3 * 33]); o.z = pk2(s[4 * 33], s[5 * 33]); o.w = pk2(s[6 * 33], s[7 * 33]);
        __builtin_nontemporal_store(o, (GAS v4u*)(it.WT + (size_t)(it.n0 + n) * it.K + it.k0 + 8 * c)); }
    FX_LDS_WAIT(); asm volatile("" ::: "memory");
}

template <int NR> __device__ __forceinline__ void ln_rows_bf16(const float* xrows, const float* __restrict__ g, const float* __restrict__ b, bf16* orows, int lane, float* st = nullptr) {
    f32x4 v[NR][4];
#pragma unroll
    for (int r = 0; r < NR; ++r)
#pragma unroll
        for (int j = 0; j < 4; ++j) v[r][j] = ((const GAS f32x4*)(xrows + (size_t)r * D))[lane + 64 * j];
    f32x4 gg[4], bb[4];
#pragma unroll
    for (int j = 0; j < 4; ++j) { gg[j] = ((const f32x4*)g)[lane + 64 * j]; bb[j] = ((const f32x4*)b)[lane + 64 * j]; }
#pragma unroll
    for (int r = 0; r < NR; ++r) {
        float s = 0.f;
#pragma unroll
        for (int j = 0; j < 4; ++j) s += (v[r][j].x + v[r][j].y) + (v[r][j].z + v[r][j].w);
        const float mean = wave_sum(s) * (1.f / D); float s2 = 0.f;
#pragma unroll
        for (int j = 0; j < 4; ++j) { v[r][j] = v[r][j] - mean; s2 += (v[r][j].x * v[r][j].x + v[r][j].y * v[r][j].y) + (v[r][j].z * v[r][j].z + v[r][j].w * v[r][j].w); }
        const float rstd = 1.f / sqrtf(wave_sum(s2) * (1.f / D) + LN_EPS);
        if (st && lane == 0) { st[2 * r] = mean; st[2 * r + 1] = rstd; }
        GAS unsigned long long* o8 = (GAS unsigned long long*)(orows + (size_t)r * D) + lane;
#pragma unroll
        for (int j = 0; j < 4; ++j) { const f32x4 o = v[r][j] * rstd * gg[j] + bb[j];
            o8[64 * j] = (unsigned long long)pk2(o.x, o.y) | ((unsigned long long)pk2(o.z, o.w) << 32); }
    }
}

template <int NR> __device__ __forceinline__ void ln1_rows_bf16(const float* xrows, const float* st, const float* __restrict__ gi, const float* __restrict__ bi, const bf16* mixrows,
                                                               const float* __restrict__ g1, const float* __restrict__ b1, bf16* orows, float alpha, int lane) {
    f32x4 v[NR][4]; unsigned long long mx[NR][4]; float mean0[NR], rstd0[NR];
#pragma unroll
    for (int r = 0; r < NR; ++r) { mean0[r] = st[2 * r]; rstd0[r] = st[2 * r + 1];
#pragma unroll
        for (int j = 0; j < 4; ++j) { v[r][j] = ((const GAS f32x4*)(xrows + (size_t)r * D))[lane + 64 * j]; mx[r][j] = ((const GAS unsigned long long*)(mixrows + (size_t)r * D))[lane + 64 * j]; } }
    f32x4 gi4[4], bi4[4];
#pragma unroll
    for (int j = 0; j < 4; ++j) { gi4[j] = ((const f32x4*)gi)[lane + 64 * j] * alpha; bi4[j] = ((const f32x4*)bi)[lane + 64 * j] * alpha; }
#pragma unroll
    for (int r = 0; r < NR; ++r) {
        float s = 0.f;
#pragma unroll
        for (int j = 0; j < 4; ++j) { const unsigned lo = (unsigned)mx[r][j], hi = (unsigned)(mx[r][j] >> 32);
            f32x4 mv; mv.x = __builtin_bit_cast(float, lo << 16); mv.y = __builtin_bit_cast(float, lo & 0xffff0000u); mv.z = __builtin_bit_cast(float, hi << 16); mv.w = __builtin_bit_cast(float, hi & 0xffff0000u);
            v[r][j] = ((v[r][j] - mean0[r]) * rstd0[r]) * gi4[j] + bi4[j] + mv;
            s += (v[r][j].x + v[r][j].y) + (v[r][j].z + v[r][j].w); }
        const float mean = wave_sum(s) * (1.f / D); float s2 = 0.f;
#pragma unroll
        for (int j = 0; j < 4; ++j) { v[r][j] = v[r][j] - mean; s2 += (v[r][j].x * v[r][j].x + v[r][j].y * v[r][j].y) + (v[r][j].z * v[r][j].z + v[r][j].w * v[r][j].w); }
        const float rstd = 1.f / sqrtf(wave_sum(s2) * (1.f / D) + LN_EPS);
        GAS unsigned long long* o8 = (GAS unsigned long long*)(orows + (size_t)r * D) + lane;
#pragma unroll
        for (int j = 0; j < 4; ++j) { const f32x4 gg = ((const f32x4*)g1)[lane + 64 * j], bb = ((const f32x4*)b1)[lane + 64 * j]; const f32x4 o = v[r][j] * rstd * gg + bb;
            o8[64 * j] = (unsigned long long)pk2(o.x, o.y) | ((unsigned long long)pk2(o.z, o.w) << 32); }
    }
}
}

namespace pg8 {
struct EpiInProj {
    static constexpr bool PERM = true, AFTER_DRAIN = false;
    bf16_t* QKV; float* FG; float* LF; const float* bfg; unsigned* NRM;
    __device__ __forceinline__ void operator()(const f32x4 (&acc)[2][2][4][2], const Unit& u, int wr, int wc, int fr, int fq) const {
        const int row0 = u.pm * BM + wr * 64 + fr;
        if (u.pn < 12) {
            const float sc = (u.pn < 2) ? fx::C2 : 1.f;
            const int col0 = u.pn * BM + wc * 32 + 8 * fq;
            float nmax[2] = {0.f, 0.f};
#pragma unroll
            for (int ai = 0; ai < 2; ++ai)
#pragma unroll
                for (int m = 0; m < 4; ++m) { bf16_t* rowp = QKV + (size_t)(row0 + ai * HALF + m * 16) * fx::QKVP + col0;
#pragma unroll
                    for (int bj = 0; bj < 2; ++bj) { const f32x4 v0 = acc[ai][bj][m][0] * sc, v1 = acc[ai][bj][m][1] * sc;
                        u32x4 w; w.x = cvt_pk_bf16(v0[0], v0[1]); w.y = cvt_pk_bf16(v0[2], v0[3]); w.z = cvt_pk_bf16(v1[0], v1[1]); w.w = cvt_pk_bf16(v1[2], v1[3]);
                        *(u32x4*)(rowp + bj * HALF) = w;
                        if (u.pn < 4) { const f32x4 q0 = v0 * v0, q1 = v1 * v1; float s = (q0[0] + q0[1]) + (q0[2] + q0[3]) + (q1[0] + q1[1]) + (q1[2] + q1[3]);
                            s += __shfl_xor(s, 16); s += __shfl_xor(s, 32);
                            nmax[bj] = fmaxf(nmax[bj], s); } } }
            if (u.pn < 4) {
#pragma unroll
                for (int bj = 0; bj < 2; ++bj) { float s = nmax[bj];
#pragma unroll
                    for (int o = 1; o < 16; o <<= 1) s = fmaxf(s, __shfl_xor(s, o));
                    if (fr == 0 && fq == 0) { const int b = (u.pm * BM) >> 12, head = 4 * (u.pn & 1) + 2 * bj + (wc >> 1);
                        atomicMax(NRM + (b * 8 + head) * 4 + (u.pn >= 2 ? 2 : 0) + (wc & 1), __builtin_bit_cast(unsigned, s)); } }
            }
        } else if (wc == 0 && fq < 3) {
#pragma unroll
            for (int ai = 0; ai < 2; ++ai)
#pragma unroll
                for (int m = 0; m < 4; ++m) { const int row = row0 + ai * HALF + m * 16; float* p = FG + (size_t)row * 32 + 8 * fq;
                    *(f32x4*)p = acc[ai][0][m][0]; *(f32x4*)(p + 4) = acc[ai][0][m][1];
                    if (fq == 0) { const int b = row >> 12, s = row & 4095;
#pragma unroll
                        for (int n = 0; n < 2; ++n)
#pragma unroll
                            for (int i = 0; i < 4; ++i) { const int h = 4 * n + i; LF[(size_t)(b * 8 + h) * nv::S + s] = -__builtin_amdgcn_logf(1.f + __builtin_amdgcn_exp2f(-1.4426950408889634f * (acc[ai][0][m][n][i] + bfg[h]))); } } }
        }
    }
};
}
namespace gl {
using namespace nv;
typedef unsigned short bf16;
typedef short bf16x8 __attribute__((ext_vector_type(8)));
typedef float f32x4 __attribute__((ext_vector_type(4)));
typedef unsigned u32x4 __attribute__((ext_vector_type(4)));
typedef unsigned u32x2 __attribute__((ext_vector_type(2)));
constexpr int NCH = S / 64;
constexpr int NUNIT = B * GH * NCH;
constexpr int LS = 72;
constexpr int L_WGU = 0, L_BG = 4096, L_DECS = 4352, L_QP = 8192, L_KP = L_QP + 64 * LS * 2, L_KPT = L_KP + 64 * LS * 2, L_VT = L_KPT + 64 * LS * 2, L_PP = L_VT + 128 * LS * 2, L_WT = L_PP + 64 * LS * 2, L_END = L_WT + 2048;
static_assert(L_END <= 131072, "gla prep LDS");
constexpr int C_ST = 0, C_PART = 128 * LS * 2, C_END = C_PART + 2 * 8 * 64 * 4;
constexpr size_t QPG_B = 64 * 64 * 2, OI_B = 8 * 4 * 64 * 16, UU_B = OI_B, DEC_B = 256;

__device__ __forceinline__ unsigned pkbf(float lo, float hi) { typedef float f2 __attribute__((ext_vector_type(2))); typedef __bf16 b2 __attribute__((ext_vector_type(2))); f2 v = {lo, hi}; b2 r = __builtin_convertvector(v, b2); return __builtin_bit_cast(unsigned, r); }
__device__ __forceinline__ float bf2f(unsigned short h) { return __builtin_bit_cast(float, (unsigned)h << 16); }
__device__ __forceinline__ float bflo(unsigned w) { return __builtin_bit_cast(float, w << 16); }
__device__ __forceinline__ float bfhi(unsigned w) { return __builtin_bit_cast(float, w & 0xffff0000u); }
__device__ __forceinline__ float fast_logsig2(float x) { return -__builtin_amdgcn_logf(1.f + __builtin_amdgcn_exp2f(-1.4426950408889634f * x)); }

__device__ __forceinline__ void prep_unit(int unit, const bf16* QKV, const float* FG, const float* __restrict__ wgu, const float* __restrict__ bgate,
                                          unsigned char* QPG, unsigned char* OI, unsigned char* UU, float* DEC, unsigned char* lds, int& cur_h, f32x4 (&Sagg)[4], f32x4 (&Dagg)[4]) {
    int tid_ = threadIdx.x; asm volatile("" : "+v"(tid_));
    const int tid = tid_, lane = tid & 63, wid = __builtin_amdgcn_readfirstlane(tid >> 6), l15 = lane & 15, g = lane >> 4;
    const int n = unit % NCH, bh = unit / NCH, h = bh % GH, b = bh / GH;
    const size_t row0 = (size_t)b * S + (size_t)n * 64;
    float* WGU = (float*)(lds + L_WGU); float* BG = (float*)(lds + L_BG); float* WT = (float*)(lds + L_WT);
    bf16* QP = (bf16*)(lds + L_QP); bf16* KP = (bf16*)(lds + L_KP); bf16* KPT = (bf16*)(lds + L_KPT); bf16* VT = (bf16*)(lds + L_VT); bf16* PP = (bf16*)(lds + L_PP);
    if (cur_h != h) { __syncthreads(); for (int i = tid; i < 16 * 64; i += 512) WGU[i] = wgu[(i >> 6) * 256 + h * 64 + (i & 63)]; if (tid < 64) BG[tid] = bgate[h * 64 + tid]; cur_h = h; __syncthreads(); }
    const int t = tid >> 3, oc = tid & 7, d0 = oc * 8;
    float la[8];
    { const float* gp = FG + (row0 + t) * 32 + 8;
      f32x4 ga4[4];
#pragma unroll
      for (int i = 0; i < 4; ++i) ga4[i] = *(const f32x4*)(gp + 4 * i);
#pragma unroll
      for (int j = 0; j < 8; ++j) la[j] = BG[d0 + j];
#pragma unroll
      for (int r = 0; r < 16; ++r) { const float gv = ga4[r >> 2][r & 3]; const f32x4 w0 = *(const f32x4*)(WGU + r * 64 + d0), w1 = *(const f32x4*)(WGU + r * 64 + d0 + 4);
#pragma unroll
          for (int j = 0; j < 4; ++j) { la[j] += gv * w0[j]; la[4 + j] += gv * w1[j]; } }
#pragma unroll
      for (int j = 0; j < 8; ++j) la[j] = fast_logsig2(la[j]) * (1.f / 16.f); }
    const u32x4 qv = *(const u32x4*)(QKV + (row0 + t) * fx::QKVP + fx::P_GQ + h * 64 + d0);
    const u32x4 kv = *(const u32x4*)(QKV + (row0 + t) * fx::QKVP + fx::P_GK + h * 64 + d0);
    const u32x4 vv0 = *(const u32x4*)(QKV + (row0 + t) * fx::QKVP + fx::P_GV + h * 128 + oc * 16);
    const u32x4 vv1 = *(const u32x4*)(QKV + (row0 + t) * fx::QKVP + fx::P_GV + h * 128 + oc * 16 + 8);
#pragma unroll
    for (int off = 8; off < 64; off <<= 1) {
#pragma unroll
        for (int j = 0; j < 8; ++j) { const float o = __shfl_up(la[j], off); if (lane >= off) la[j] += o; } }
    if (lane >= 56) {
#pragma unroll
        for (int j = 0; j < 8; ++j) WT[wid * 64 + d0 + j] = la[j]; }
    __syncthreads();
    float bl[8];
#pragma unroll
    for (int j = 0; j < 8; ++j) bl[j] = 0.f;
#pragma unroll
    for (int w = 0; w < 8; ++w) {
        const f32x4 a0 = *(const f32x4*)(WT + w * 64 + d0), a1 = *(const f32x4*)(WT + w * 64 + d0 + 4);
#pragma unroll
        for (int j = 0; j < 4; ++j) { bl[j] += a0[j]; bl[4 + j] += a1[j]; if (w < wid) { la[j] += a0[j]; la[4 + j] += a1[j]; } } }
    {
        const unsigned qw[4] = {qv.x, qv.y, qv.z, qv.w}, kw[4] = {kv.x, kv.y, kv.z, kv.w};
        float qf[8], kf[8];
#pragma unroll
        for (int i = 0; i < 4; ++i) { qf[2 * i] = bflo(qw[i]); qf[2 * i + 1] = bfhi(qw[i]); kf[2 * i] = bflo(kw[i]); kf[2 * i + 1] = bfhi(kw[i]); }
        float qp[8], kp[8], kpp[8];
#pragma unroll
        for (int j = 0; j < 8; ++j) { const float bb = la[j], bbl = bl[j];
            qp[j] = qf[j] * (0.125f * __builtin_amdgcn_exp2f(bb)); kp[j] = kf[j] * __builtin_amdgcn_exp2f(-bb); kpp[j] = kf[j] * __builtin_amdgcn_exp2f(bbl - bb); }
        u32x4 qo, ko; qo.x = pkbf(qp[0], qp[1]); qo.y = pkbf(qp[2], qp[3]); qo.z = pkbf(qp[4], qp[5]); qo.w = pkbf(qp[6], qp[7]);
        ko.x = pkbf(kp[0], kp[1]); ko.y = pkbf(kp[2], kp[3]); ko.z = pkbf(kp[4], kp[5]); ko.w = pkbf(kp[6], kp[7]);
        *(u32x4*)(QP + t * LS + d0) = qo; *(u32x4*)(KP + t * LS + d0) = ko;
        *(u32x4*)(QPG + (size_t)unit * QPG_B + (size_t)(t * 64 + d0) * 2) = qo;
#pragma unroll
        for (int j = 0; j < 8; ++j) KPT[(d0 + j) * LS + t] = (bf16)(pkbf(kpp[j], 0.f) & 0xffffu);
        const unsigned vw[8] = {vv0.x, vv0.y, vv0.z, vv0.w, vv1.x, vv1.y, vv1.z, vv1.w};
#pragma unroll
        for (int i = 0; i < 8; ++i) { VT[(oc * 16 + 2 * i) * LS + t] = (bf16)(vw[i] & 0xffffu); VT[(oc * 16 + 2 * i + 1) * LS + t] = (bf16)(vw[i] >> 16); }
        if (t == 0) {
#pragma unroll
            for (int j = 0; j < 8; ++j) { const float dc = __builtin_amdgcn_exp2f(bl[j]); DEC[(size_t)unit * 64 + d0 + j] = dc; ((float*)(lds + L_DECS))[d0 + j] = dc; } }
    }
    __syncthreads();
    { const int ti = wid >> 1;
#pragma unroll
      for (int q2 = 0; q2 < 2; ++q2) { const int sj = 2 * (wid & 1) + q2;
          f32x4 acc = {0.f, 0.f, 0.f, 0.f};
          if (sj <= ti) {
#pragma unroll
              for (int ks = 0; ks < 2; ++ks) { const bf16x8 a = *(const bf16x8*)(QP + (16 * ti + l15) * LS + 32 * ks + 8 * g), bb = *(const bf16x8*)(KP + (16 * sj + l15) * LS + 32 * ks + 8 * g);
                  acc = __builtin_amdgcn_mfma_f32_16x16x32_bf16(a, bb, acc, 0, 0, 0); }
              if (sj == ti) {
#pragma unroll
                  for (int r = 0; r < 4; ++r) if (l15 > 4 * g + r) acc[r] = 0.f; }
          }
#pragma unroll
          for (int r = 0; r < 4; ++r) PP[(16 * ti + 4 * g + r) * LS + 16 * sj + l15] = (bf16)(pkbf(acc[r], 0.f) & 0xffffu);
      } }
    __syncthreads();
    { bf16x8 vb[2];
#pragma unroll
      for (int ks = 0; ks < 2; ++ks) vb[ks] = *(const bf16x8*)(VT + (16 * wid + l15) * LS + 32 * ks + 8 * g);
#pragma unroll
      for (int m = 0; m < 4; ++m) { f32x4 acc = {0.f, 0.f, 0.f, 0.f};
#pragma unroll
          for (int ks = 0; ks < 2; ++ks) { const bf16x8 a = *(const bf16x8*)(PP + (16 * m + l15) * LS + 32 * ks + 8 * g); acc = __builtin_amdgcn_mfma_f32_16x16x32_bf16(a, vb[ks], acc, 0, 0, 0); }
          *(f32x4*)(OI + (size_t)unit * OI_B + (size_t)((wid * 4 + m) * 64 + lane) * 16) = acc; }
#pragma unroll
      for (int db = 0; db < 4; ++db) { f32x4 acc = {0.f, 0.f, 0.f, 0.f};
#pragma unroll
          for (int ks = 0; ks < 2; ++ks) { const bf16x8 a = *(const bf16x8*)(KPT + (16 * db + l15) * LS + 32 * ks + 8 * g); acc = __builtin_amdgcn_mfma_f32_16x16x32_bf16(a, vb[ks], acc, 0, 0, 0); }
          *(f32x4*)(UU + (size_t)unit * UU_B + (size_t)((wid * 4 + db) * 64 + lane) * 16) = acc;
          const f32x4 dcv = *(const f32x4*)((const float*)(lds + L_DECS) + 16 * db + 4 * g);
          Sagg[db] = dcv * Sagg[db] + acc; Dagg[db] = Dagg[db] * dcv; }
    }
}


__device__ __forceinline__ void prep_block(int blk, const bf16* QKV, const float* FG, const float* __restrict__ wgu, const float* __restrict__ bgate,
                                           unsigned char* QPG, unsigned char* OI, unsigned char* UU, float* DEC, unsigned char* AGG, float* DAGG, unsigned char* lds, int& cur_h) {
    f32x4 Sagg[4], Dagg[4];
#pragma unroll
    for (int db = 0; db < 4; ++db) { Sagg[db] = (f32x4){0.f, 0.f, 0.f, 0.f}; Dagg[db] = (f32x4){1.f, 1.f, 1.f, 1.f}; }
    for (int i = 0; i < 8; ++i) prep_unit(blk * 8 + i, QKV, FG, wgu, bgate, QPG, OI, UU, DEC, lds, cur_h, Sagg, Dagg);
    int tid_ = threadIdx.x; asm volatile("" : "+v"(tid_));
    const int lane = tid_ & 63, wid = __builtin_amdgcn_readfirstlane(tid_ >> 6), l15 = lane & 15, g = lane >> 4;
#pragma unroll
    for (int db = 0; db < 4; ++db) { *(f32x4*)(AGG + (size_t)blk * UU_B + (size_t)((wid * 4 + db) * 64 + lane) * 16) = Sagg[db];
        if (wid == 0 && l15 == 0) *(f32x4*)(DAGG + (size_t)blk * 64 + 16 * db + 4 * g) = Dagg[db]; }
}
constexpr int GS = 136;
constexpr int PO_GR = 0, PO_YT = 64 * GS * 2, PO_PART = 2 * 64 * GS * 2, PO_ST = PO_PART + 8 * 64 * 4, PO_END = PO_ST + 128 * LS * 2;
__device__ __forceinline__ void post_block(int u0, int NB, const bf16* QKV, const unsigned char* QPG, const unsigned char* OI, const unsigned char* UU, const float* DEC, const unsigned char* AGG, const float* DAGG, const float* __restrict__ gnorm, bf16* Y, unsigned char* lds) {
    int tid_ = threadIdx.x; asm volatile("" : "+v"(tid_));
    const int tid = tid_, lane = tid & 63, wid = __builtin_amdgcn_readfirstlane(tid >> 6), l15 = lane & 15, g = lane >> 4;
    const int n0 = u0 % NCH, bh = u0 / NCH, h = bh % GH, b = bh / GH;
    bf16* GRs = (bf16*)(lds + PO_GR); bf16* YT = (bf16*)(lds + PO_YT); float* PART = (float*)(lds + PO_PART); bf16* ST = (bf16*)(lds + PO_ST);
    const int t = tid >> 3, oc = tid & 7, e = 16 * wid + l15;
    const float gn = gnorm[e];
    f32x4 Sa[4];
#pragma unroll
    for (int db = 0; db < 4; ++db) Sa[db] = (f32x4){0.f, 0.f, 0.f, 0.f};
    { const int seg0 = bh * (NCH / 8), nseg = n0 / 8;
      for (int i = 0; i < nseg; ++i) {
          f32x4 Ua[4], Da[4];
#pragma unroll
          for (int db = 0; db < 4; ++db) { Ua[db] = *(const f32x4*)(AGG + (size_t)(seg0 + i) * UU_B + (size_t)((wid * 4 + db) * 64 + lane) * 16); Da[db] = *(const f32x4*)(DAGG + (size_t)(seg0 + i) * 64 + 16 * db + 4 * g); }
#pragma unroll
          for (int db = 0; db < 4; ++db) Sa[db] = Da[db] * Sa[db] + Ua[db]; } }
    for (int i = 0; i < NB; ++i) {
        const int unit = u0 + i; const size_t row0 = (size_t)b * S + (size_t)(n0 + i) * 64;
        const u32x4 g0 = *(const u32x4*)(QKV + (row0 + t) * fx::QKVP + fx::P_GR + h * 128 + oc * 16), g1 = *(const u32x4*)(QKV + (row0 + t) * fx::QKVP + fx::P_GR + h * 128 + oc * 16 + 8);
        f32x4 o[4], Uf[4], dv[4]; bf16x8 qa[4][2], sb[2];
#pragma unroll
        for (int m = 0; m < 4; ++m) { o[m] = *(const f32x4*)(OI + (size_t)unit * OI_B + (size_t)((wid * 4 + m) * 64 + lane) * 16);
            Uf[m] = *(const f32x4*)(UU + (size_t)unit * UU_B + (size_t)((wid * 4 + m) * 64 + lane) * 16); dv[m] = *(const f32x4*)(DEC + (size_t)unit * 64 + 16 * m + 4 * g);
#pragma unroll
            for (int ks = 0; ks < 2; ++ks) qa[m][ks] = *(const bf16x8*)(QPG + (size_t)unit * QPG_B + (size_t)((16 * m + l15) * 64 + 32 * ks + 8 * g) * 2); }
#pragma unroll
        for (int db = 0; db < 4; ++db) *(u32x2*)(ST + e * LS + 16 * db + 4 * g) = (u32x2){pkbf(Sa[db][0], Sa[db][1]), pkbf(Sa[db][2], Sa[db][3])};
#pragma unroll
        for (int ks = 0; ks < 2; ++ks) sb[ks] = *(const bf16x8*)(ST + e * LS + 32 * ks + 8 * g);
        *(u32x4*)(GRs + t * GS + oc * 16) = g0; *(u32x4*)(GRs + t * GS + oc * 16 + 8) = g1;
#pragma unroll
        for (int m = 0; m < 4; ++m)
#pragma unroll
            for (int ks = 0; ks < 2; ++ks) o[m] = __builtin_amdgcn_mfma_f32_16x16x32_bf16(qa[m][ks], sb[ks], o[m], 0, 0, 0);
#pragma unroll
        for (int m = 0; m < 4; ++m) { f32x4 q = o[m] * o[m];
#pragma unroll
            for (int off = 1; off < 16; off <<= 1) { q[0] += __shfl_xor(q[0], off); q[1] += __shfl_xor(q[1], off); q[2] += __shfl_xor(q[2], off); q[3] += __shfl_xor(q[3], off); }
            if (l15 == 0) *(f32x4*)(PART + wid * 64 + 16 * m + 4 * g) = q; }
#pragma unroll
        for (int db = 0; db < 4; ++db) Sa[db] = dv[db] * Sa[db] + Uf[db];
        __syncthreads();
#pragma unroll
        for (int m = 0; m < 4; ++m) { f32x4 tot = {0.f, 0.f, 0.f, 0.f};
#pragma unroll
            for (int w = 0; w < 8; ++w) tot += *(const f32x4*)(PART + w * 64 + 16 * m + 4 * g);
#pragma unroll
            for (int r = 0; r < 4; ++r) { const int tt = 16 * m + 4 * g + r; const float rs = rsqrtf(tot[r] * (1.f / GV) + LN_EPS); const float gr = bf2f(GRs[tt * GS + e]);
                const float v = o[m][r] * rs * gn * (gr * __builtin_amdgcn_rcpf(1.f + __builtin_amdgcn_exp2f(-1.4426950408889634f * gr)));
                YT[tt * GS + e] = (bf16)(pkbf(v, 0.f) & 0xffffu); } }
        __syncthreads();
        { const u32x4 y0 = *(const u32x4*)(YT + t * GS + oc * 16), y1 = *(const u32x4*)(YT + t * GS + oc * 16 + 8);
          *(u32x4*)(Y + (row0 + t) * D + 512 + h * GV + oc * 16) = y0; *(u32x4*)(Y + (row0 + t) * D + 512 + h * GV + oc * 16 + 8) = y1; }
        __syncthreads();
    }
}
}
namespace mo {
using namespace nv;
typedef unsigned short bf16;
typedef float f32x4 __attribute__((ext_vector_type(4)));
typedef unsigned u32x4 __attribute__((ext_vector_type(4)));
constexpr int CAP = 8192;
constexpr int NEX = NE + 1;
constexpr int YSH = T * TOPK;
constexpr int L_TB = 132096, L_YB = L_TB + 1040, L_CN = L_YB + 1040, L_UT = 138240, L_RG = 141312;
typedef LAS int* lint;


constexpr int I_EG = NEX * 256, I_ED = NEX * 128, I_EXP = I_EG + I_ED;
struct ExpW { const float* eg; const float* eu; const float* ed; const float* sg; const float* su; const float* sd; bf16* WegT; bf16* WedT; };
__device__ __forceinline__ void cv_decode(int r, const ExpW& X, fx::CvItem& I) {
    if (r < I_EG) { const int e = r >> 8, kb = (r >> 4) & 15, nb = r & 15, c = nb >> 3, sub = nb & 7;
        I.W = (e < NE) ? ((sub < 4 ? X.eg : X.eu) + (size_t)e * D * ED) : (sub < 4 ? X.sg : X.su); I.WT = X.WegT + (size_t)e * 512 * D; I.N = ED; I.K = D; I.k0 = 64 * kb; I.n0 = 32 * nb; I.s0 = 128 * c + 32 * (sub & 3); }
    else { r -= I_EG; const int e = r >> 7, kb = (r >> 5) & 3, nb = r & 31; I.W = (e < NE) ? (X.ed + (size_t)e * ED * D) : X.sd; I.WT = X.WedT + (size_t)e * D * ED; I.N = D; I.K = ED; I.k0 = 64 * kb; I.n0 = 32 * nb; I.s0 = 32 * nb; }
}
__device__ __forceinline__ void expert_conv(const ExpW& X, LAS float* scr, int it0, int step, int it_end, int lane) {
    int it = it0; fx::CvItem cur, nx; fx::f32x4 v[8], w[8];
    if (it < it_end) { cv_decode(it, X, cur); fx::cv_load(cur, v, lane); }
    while (it < it_end) { const int itn = it + step; if (itn < it_end) { cv_decode(itn, X, nx); fx::cv_load(nx, w, lane); }
        fx::cv_finish(cur, v, scr, lane); cur = nx;
#pragma unroll
        for (int i = 0; i < 8; ++i) v[i] = w[i];
        it = itn; }
}

__device__ __forceinline__ void moe_tables(const int* counts, lint tb, lint yb, lint cn, int lane) {
    int c[4], nt[4]; int st = 0, sy = 0, pt[4], py[4];
#pragma unroll
    for (int i = 0; i < 4; ++i) { c[i] = counts[lane * 4 + i]; c[i] = c[i] > CAP ? CAP : c[i]; nt[i] = (c[i] + 255) >> 8; pt[i] = st; py[i] = sy; st += nt[i]; sy += c[i]; }
    int it = st, iy = sy;
    for (int o = 1; o < 64; o <<= 1) { const int a = __shfl_up(it, o), b = __shfl_up(iy, o); if (lane >= o) { it += a; iy += b; } }
    const int bt = it - st, by = iy - sy;
#pragma unroll
    for (int i = 0; i < 4; ++i) { tb[lane * 4 + i] = bt + pt[i]; yb[lane * 4 + i] = by + py[i]; cn[lane * 4 + i] = c[i]; }
    if (lane == 63) { tb[256] = it; tb[257] = it + T / 256; yb[256] = YSH; cn[256] = T; }
}

template <int CTRL> __device__ __forceinline__ float dppf(float x) { return __builtin_bit_cast(float, __builtin_amdgcn_update_dpp(0, __builtin_bit_cast(int, x), CTRL, 0xf, 0xf, true)); }
__device__ __forceinline__ float rlf(float x, int l) { return __builtin_bit_cast(float, __builtin_amdgcn_readlane(__builtin_bit_cast(int, x), l)); }
__device__ __forceinline__ double mkd(unsigned lo, unsigned hi) { return __builtin_bit_cast(double, ((unsigned long long)hi << 32) | lo); }
__device__ __forceinline__ double maxd(double a, double b) { double r; asm("v_max_f64 %0, %1, %2" : "=v"(r) : "v"(a), "v"(b)); return r; }
template <int CTRL> __device__ __forceinline__ double dppd(double x) { const unsigned long long u = __builtin_bit_cast(unsigned long long, x);
    return mkd((unsigned)__builtin_amdgcn_update_dpp(0, (int)(unsigned)u, CTRL, 0xf, 0xf, true), (unsigned)__builtin_amdgcn_update_dpp(0, (int)(unsigned)(u >> 32), CTRL, 0xf, 0xf, true)); }
__device__ __forceinline__ double rowpair_max(double x) {
    const unsigned long long u = __builtin_bit_cast(unsigned long long, x);
    const auto a = __builtin_amdgcn_permlane16_swap((unsigned)u, (unsigned)u, false, false); const auto b = __builtin_amdgcn_permlane16_swap((unsigned)(u >> 32), (unsigned)(u >> 32), false, false);
    return maxd(mkd(a[0], b[0]), mkd(a[1], b[1])); }
__device__ __forceinline__ void route_token2(const float* LG, const float* __restrict__ rbias, int* lcnt, LAS float* scs, int* TK, float* TW, int t0, int lane) {
    const int l32 = lane & 31, t = t0 + (lane >> 5); const bool hiH = lane >= 32;
    const float4 la = ((const float4*)(LG + (size_t)t * NE))[2 * l32], lb = ((const float4*)(LG + (size_t)t * NE))[2 * l32 + 1];
    const float4 ra = ((const float4*)rbias)[2 * l32], rb = ((const float4*)rbias)[2 * l32 + 1];
    const float lg[8] = {la.x, la.y, la.z, la.w, lb.x, lb.y, lb.z, lb.w}, rbv[8] = {ra.x, ra.y, ra.z, ra.w, rb.x, rb.y, rb.z, rb.w};
    float sc[8], bv[8];
#pragma unroll
    for (int i = 0; i < 8; ++i) { sc[i] = __builtin_amdgcn_rcpf(1.f + __builtin_amdgcn_exp2f(-1.4426950408889634f * lg[i])); bv[i] = sc[i] + rbv[i]; }
    float m1 = fmaxf(bv[0], bv[1]), m2 = fminf(bv[0], bv[1]);
#pragma unroll
    for (int i = 2; i < 8; ++i) { const float n1 = fmaxf(m1, bv[i]); m2 = fmaxf(fminf(m1, bv[i]), m2); m1 = n1; }
    { const float p1 = dppf<0xB1>(m1), p2 = dppf<0xB1>(m2); const float n1 = fmaxf(m1, p1); m2 = fmaxf(fminf(m1, p1), fmaxf(m2, p2)); m1 = n1; }
    { const float p1 = dppf<0x4E>(m1), p2 = dppf<0x4E>(m2); const float n1 = fmaxf(m1, p1); m2 = fmaxf(fminf(m1, p1), fmaxf(m2, p2)); m1 = n1; }
    const float gs = m1 + m2;
    const int myg = l32 >> 2;
    int rank = 0;
#pragma unroll
    for (int g2 = 0; g2 < NG; ++g2) { const float oa = rlf(gs, g2 * 4), ob = rlf(gs, 32 + g2 * 4); const float og = hiH ? ob : oa; if (og > gs || (og == gs && g2 < myg)) ++rank; }
    const bool sel = rank < 4;
    unsigned klo[8], khi[8];
#pragma unroll
    for (int i = 0; i < 8; ++i) { const unsigned long long u = __builtin_bit_cast(unsigned long long, (double)bv[i]); const unsigned h = (unsigned)(u >> 32), eid = (unsigned)(l32 * 8 + i);
        klo[i] = (unsigned)u | ((h >> 31) ? eid : 255u - eid); khi[i] = sel ? h : 0xFFE00000u; }
    { f32x4 s0, s1; s0[0] = sc[0]; s0[1] = sc[1]; s0[2] = sc[2]; s0[3] = sc[3]; s1[0] = sc[4]; s1[1] = sc[5]; s1[2] = sc[6]; s1[3] = sc[7];
      *(LAS f32x4*)(scs + lane * 8) = s0; *(LAS f32x4*)(scs + lane * 8 + 4) = s1; }
    unsigned mlo = 0u, mhi = 0u;
#pragma unroll
    for (int k = 0; k < TOPK; ++k) {
        double am = maxd(maxd(maxd(mkd(klo[0], khi[0]), mkd(klo[1], khi[1])), maxd(mkd(klo[2], khi[2]), mkd(klo[3], khi[3]))), maxd(maxd(mkd(klo[4], khi[4]), mkd(klo[5], khi[5])), maxd(mkd(klo[6], khi[6]), mkd(klo[7], khi[7]))));
        am = maxd(am, dppd<0xB1>(am)); am = maxd(am, dppd<0x4E>(am)); am = maxd(am, dppd<0x141>(am)); am = maxd(am, dppd<0x140>(am));
        am = rowpair_max(am);
#pragma unroll
        for (int i = 0; i < 8; ++i) khi[i] = (mkd(klo[i], khi[i]) == am) ? 0xFFE00000u : khi[i];
        const unsigned long long ua = __builtin_bit_cast(unsigned long long, am);
        if (l32 == k) { mlo = (unsigned)ua; mhi = (unsigned)(ua >> 32); }
    }
    const int mye = (int)((mhi >> 31) ? (mlo & 255u) : 255u - (mlo & 255u));
    const float myw = scs[(lane & 32) * 8 + mye];
    float wsum = myw + dppf<0xB1>(myw); wsum += dppf<0x4E>(wsum); wsum += dppf<0x141>(wsum);
    if (l32 < TOPK) { const int lp = atomicAdd(&lcnt[mye], 1); TK[t * TOPK + l32] = mye | (lp << 9); TW[t * TOPK + l32] = myw * (2.5f / wsum); }
}
__device__ __forceinline__ void route_finish2(const int* lbase, int* list_tok, float* list_gate, int* TK, const float* TW, int t0, int lane) {
    const int l32 = lane & 31, t = t0 + (lane >> 5);
    if (l32 < TOPK) { const int tk = TK[t * TOPK + l32]; const int e = tk & 511, pos = lbase[e] + (tk >> 9);
        if (pos < CAP) { list_tok[e * CAP + pos] = t; list_gate[e * CAP + pos] = TW[t * TOPK + l32]; }
        TK[t * TOPK + l32] = e | (pos << 9); }
}

constexpr float YSC = 16.f;
__device__ __forceinline__ void combine_token(const bf16* H1, const unsigned char* Y, const int* TK, lint yb, const float* __restrict__ g, const float* __restrict__ b, float* out, int t, int lane) {
    typedef float f2 __attribute__((ext_vector_type(2)));
    float v[16], s[16];
    { const u32x4 a = *(const u32x4*)(H1 + (size_t)t * D + 16 * lane), c = *(const u32x4*)(H1 + (size_t)t * D + 16 * lane + 8);
      const unsigned w[8] = {a.x, a.y, a.z, a.w, c.x, c.y, c.z, c.w};
#pragma unroll
      for (int i = 0; i < 8; ++i) { v[2 * i] = ALPHA * __builtin_bit_cast(float, w[i] << 16); v[2 * i + 1] = ALPHA * __builtin_bit_cast(float, w[i] & 0xffff0000u); } }
#pragma unroll
    for (int i = 0; i < 16; ++i) s[i] = 0.f;
    int tk = (lane < TOPK) ? TK[t * TOPK + lane] : 0;
#pragma unroll
    for (int k = 0; k <= TOPK; ++k) {
        size_t yrow;
        if (k < TOPK) { const int x = __shfl(tk, k); yrow = (size_t)(yb[x & 511] + (x >> 9)); } else yrow = (size_t)YSH + t;
        const u32x4 a = *(const u32x4*)(Y + yrow * D + 16 * lane);
        const int w[4] = {(int)a.x, (int)a.y, (int)a.z, (int)a.w};
#pragma unroll
        for (int i = 0; i < 4; ++i) { const f2 lo = __builtin_amdgcn_cvt_pk_f32_fp8(w[i], false), hi = __builtin_amdgcn_cvt_pk_f32_fp8(w[i], true);
            s[4 * i] += lo[0]; s[4 * i + 1] += lo[1]; s[4 * i + 2] += hi[0]; s[4 * i + 3] += hi[1]; }
    }
    float sm = 0.f;
#pragma unroll
    for (int i = 0; i < 16; ++i) { v[i] += s[i] * (1.f / YSC); sm += v[i]; }
    const float mean = fx::wave_sum(sm) * (1.f / D); float q = 0.f;
#pragma unroll
    for (int i = 0; i < 16; ++i) { v[i] -= mean; q += v[i] * v[i]; }
    const float rstd = 1.f / sqrtf(fx::wave_sum(q) * (1.f / D) + LN_EPS);
#pragma unroll
    for (int i = 0; i < 4; ++i) { const f32x4 gg = *(const f32x4*)(g + 16 * lane + 4 * i), bb = *(const f32x4*)(b + 16 * lane + 4 * i);
        f32x4 o; o[0] = v[4 * i] * rstd * gg[0] + bb[0]; o[1] = v[4 * i + 1] * rstd * gg[1] + bb[1]; o[2] = v[4 * i + 2] * rstd * gg[2] + bb[2]; o[3] = v[4 * i + 3] * rstd * gg[3] + bb[3];
        *(f32x4*)(out + (size_t)t * D + 16 * lane + 4 * i) = o; }
}
}

namespace pg8 {
struct RouterSched {
    int rb; const bf16_t* Bt;
    __device__ __forceinline__ bool next(int i, Unit2& u) const { if (i > 0) return false; u.pm = rb; u.pn = 0; u.e = 0; u.cnt = 128; u.jt = 0; u.ui = 0; return true; }
    __device__ __forceinline__ int arow(const Unit2& u, int r) const { return u.pm * 128 + r; }
    __device__ __forceinline__ size_t aoff(const Unit2&) const { return 0; }
    __device__ __forceinline__ const char* bptr(const Unit2&) const { return (const char*)Bt; }
};
struct EpiLogits {
    static constexpr bool PERM = false, AFTER_DRAIN = false;
    float* LG;
    __device__ __forceinline__ void operator()(const f32x4 (&acc)[2][2][4][2], const Unit2& u, int wr, int wc, int fr, int fq) const {
        const int row0 = u.pm * 128 + wr * 64 + fr, col0 = wc * 32 + 4 * fq;
#pragma unroll
        for (int m = 0; m < 4; ++m) { float* rowp = LG + (size_t)(row0 + m * 16) * nv::NE + col0;
#pragma unroll
            for (int bj = 0; bj < 2; ++bj)
#pragma unroll
                for (int n = 0; n < 2; ++n) *(f32x4*)(rowp + bj * HALF + n * 16) = acc[0][bj][m][n]; }
    }
};
template <int PH> struct MoeSched {
    int G, vcu, nrt; mo::lint tb; mo::lint cn; const int* list_tok; const bf16_t* W; mo::lint ut; mo::lint rg;
    static constexpr int NC = PH == 0 ? 2 : 4;
    static constexpr int MAXU = 64;
    __device__ __forceinline__ void build(int lane) const {
        const int L = lane * G + vcu;
        if (lane < MAXU && L < nrt * NC) {
            const int rt = L / NC, c = L % NC;
            int lo = 0, hi = 256;
            while (lo < hi) { const int mid = (lo + hi + 1) >> 1; if (tb[mid] <= rt) lo = mid; else hi = mid - 1; }
            const int e = lo, jt = rt - tb[e], rem = cn[e] - 256 * jt;
            ut[4 * lane] = rt; ut[4 * lane + 1] = c; ut[4 * lane + 2] = e | (jt << 9); ut[4 * lane + 3] = rem < 256 ? rem : 256;
        }
    }
    __device__ __forceinline__ bool next(int i, Unit2& u) const {
        const int L = i * G + vcu; if (i >= MAXU || L >= nrt * NC) return false;
        const int x = ut[4 * i + 2];
        u.pm = __builtin_amdgcn_readfirstlane(ut[4 * i]); u.pn = __builtin_amdgcn_readfirstlane(ut[4 * i + 1]); u.e = __builtin_amdgcn_readfirstlane(x & 511); u.jt = __builtin_amdgcn_readfirstlane(x >> 9);
        u.cnt = __builtin_amdgcn_readfirstlane(ut[4 * i + 3]); u.ui = i; return true;
    }
    __device__ __forceinline__ void fill_rows(const float* list_gate, int tid) const {
        for (int i = 0; i < MAXU; ++i) { const int L = i * G + vcu; if (L >= nrt * NC) break;
            const int x = ut[4 * i + 2], e = x & 511, jt = x >> 9, cnt = ut[4 * i + 3];
            if (tid < 256) { const int r = tid; unsigned v;
                if (e == 256) v = (unsigned)(jt * BM + r) | (0x4180u << 16);
                else if (r < cnt) { const float gsc = mo::YSC * list_gate[e * mo::CAP + jt * BM + r]; v = (unsigned)list_tok[e * mo::CAP + jt * BM + r] | (fx::f2bf(gsc) << 16); }
                else v = 0u;
                rg[i * 256 + r] = (int)v; } }
    }
    __device__ __forceinline__ int arow(const Unit2& u, int r) const {
        if (PH == 1) return u.pm * BM + r;
        return rg[u.ui * 256 + r] & 0x7fff;
    }
    __device__ __forceinline__ size_t aoff(const Unit2& u) const { return PH == 1 ? (size_t)u.pm * (131072 - 32768) : 0; }
    __device__ __forceinline__ const char* bptr(const Unit2& u) const {
        return PH == 0 ? (const char*)(W + ((size_t)u.e * 512 + 256 * u.pn) * 1024) : (const char*)(W + ((size_t)u.e * 1024 + 256 * u.pn) * 256);
    }
};
struct EpiSwiGLU {
    static constexpr bool PERM = true, AFTER_DRAIN = false;
    bf16_t* H; mo::lint rg; int skip;
    __device__ __forceinline__ void operator()(const f32x4 (&acc)[2][2][4][2], const Unit2& u, int wr, int wc, int fr, int fq) const {
        if (skip) return;
        const int col0 = u.pn * 128 + wc * 32 + 8 * fq;
#pragma unroll
        for (int ai = 0; ai < 2; ++ai)
#pragma unroll
            for (int m = 0; m < 4; ++m) { const int r = ai * HALF + wr * 64 + m * 16 + fr;
                const float gt = __builtin_bit_cast(float, (unsigned)rg[u.ui * 256 + r] & 0xffff0000u);
                float hv[8];
#pragma unroll
                for (int n = 0; n < 2; ++n)
#pragma unroll
                    for (int i = 0; i < 4; ++i) { const float gg = acc[ai][0][m][n][i], uu = acc[ai][1][m][n][i]; hv[4 * n + i] = gt * uu * (gg * __builtin_amdgcn_rcpf(1.f + __builtin_amdgcn_exp2f(-1.4426950408889634f * gg))); }
                u32x4 w; w.x = cvt_pk_bf16(hv[0], hv[1]); w.y = cvt_pk_bf16(hv[2], hv[3]); w.z = cvt_pk_bf16(hv[4], hv[5]); w.w = cvt_pk_bf16(hv[6], hv[7]);
                *(u32x4*)(H + (size_t)u.pm * 65536 + (size_t)(col0 >> 6) * 16384 + r * 64 + (col0 & 63)) = w; }
    }
};
struct EpiDown {
    static constexpr bool PERM = true, PERM16 = true, AFTER_DRAIN = false;
    unsigned char* Y; mo::lint yb; int skip;
    __device__ __forceinline__ void operator()(const f32x4 (&acc)[2][2][4][2], const Unit2& u, int wr, int wc, int fr, int fq) const {
        if (skip) return;
        const int col0 = u.pn * BM + wc * 64 + 16 * fq; const int ybase = yb[u.e] + u.jt * BM;
#pragma unroll
        for (int ai = 0; ai < 2; ++ai)
#pragma unroll
            for (int m = 0; m < 4; ++m) { const int r = ai * HALF + wr * 64 + m * 16 + fr;
                if (r < u.cnt) { u32x4 w; unsigned ww[4];
#pragma unroll
                    for (int bj = 0; bj < 2; ++bj)
#pragma unroll
                        for (int n = 0; n < 2; ++n) { const f32x4 v = acc[ai][bj][m][n]; int x = __builtin_amdgcn_cvt_pk_fp8_f32(v[0], v[1], 0, false); x = __builtin_amdgcn_cvt_pk_fp8_f32(v[2], v[3], x, true); ww[2 * bj + n] = (unsigned)x; }
                    w.x = ww[0]; w.y = ww[1]; w.z = ww[2]; w.w = ww[3];
                    *(u32x4*)(Y + (size_t)(ybase + r) * nv::D + col0) = w; } }
    }
};
}
constexpr int NTHR = 512;
constexpr int LDS_BYTES = 163840;
constexpr int MISC_OFF = 131072 + 320;
constexpr size_t MiB = 1u << 20;
constexpr size_t CTL_ZERO_BYTES = 96 * 1024;
constexpr int CW_BAR = 4096;
constexpr int CW_MOE = 16384;
constexpr int CW_FOXQ = 20992;
constexpr int CW_NRM = 20480;
constexpr int NPHASE = 9;
constexpr size_t WS_H1 = 1, WS_WR = 65, WS_STATS = 66, WS_LF = 67, WS_FG = 68, WS_WO = 72, WS_WIN = 74, WS_TK = 81, WS_LTOK = 83, WS_LGATE = 91,
                 WS_WED = 100, WS_HID = 230, WS_GLA = 230, WS_WEG = 416, WS_XN = 673, WS_YBF = 673, WS_QKV = 737, WS_Z1 = 737, WS_LG = 865, WS_Y = 416, WS_END = 992;

struct Args { const float* in[21]; float* out; unsigned char* ws; int ph_lo, ph_hi, li, pad; };

__global__ void __launch_bounds__(NTHR, 2) mega_fwd(Args a) {
    using namespace nv;
    extern __shared__ __attribute__((aligned(16))) unsigned char lds[];
    const int G = gridDim.x, bx = blockIdx.x;
    const int vcu = (G % 8 == 0) ? (bx % 8) * (G / 8) + bx / 8 : bx;
    int tid, lane, wave, vw;
#define DERIVE() do { int t_ = threadIdx.x; asm volatile("" : "+v"(t_)); tid = t_; lane = tid & 63; wave = __builtin_amdgcn_readfirstlane(tid >> 6); vw = vcu * 8 + wave; } while (0)
    DERIVE();
    volatile LAS unsigned* MISC = (volatile LAS unsigned*)((LAS unsigned char*)lds + MISC_OFF);
    for (int u = tid; u < (LDS_BYTES - 131072) / 4; u += NTHR) ((LAS unsigned*)((LAS unsigned char*)lds + 131072))[u] = 0u;
    __syncthreads();
    unsigned char* ws = a.ws;
    unsigned* ctl = (unsigned*)ws;
    XcdBarrier bar = xcd_barrier_post(ctl + CW_BAR + a.li * XCD_BAR_WORDS, MISC + 8);
    const float* x = a.in[0];
    const float* ln_in_g = a.in[1]; const float* ln_in_b = a.in[2];
    const float* w_in = a.in[3]; const float* b_fgate = a.in[4];
    const float* w_gate_up = a.in[5]; const float* b_gate = a.in[6]; const float* g_gla = a.in[7];
    const float* w_out = a.in[8]; const float* ln1_g = a.in[9]; const float* ln1_b = a.in[10];
    const float* w_router = a.in[11]; const float* rbias = a.in[12];
    const float* w_eg = a.in[13]; const float* w_eu = a.in[14]; const float* w_ed = a.in[15];
    const float* w_sg = a.in[16]; const float* w_su = a.in[17]; const float* w_sd = a.in[18];
    const float* ln2_g = a.in[19]; const float* ln2_b = a.in[20];
    float* out = a.out;
    int* counts = (int*)(ctl + CW_MOE);
    fx::bf16* H1 = (fx::bf16*)(ws + WS_H1 * MiB);
    fx::bf16* WrT = (fx::bf16*)(ws + WS_WR * MiB);
    float* stats = (float*)(ws + WS_STATS * MiB);
    float* LF = (float*)(ws + WS_LF * MiB);
    float* FG = (float*)(ws + WS_FG * MiB);
    fx::bf16* WoT = (fx::bf16*)(ws + WS_WO * MiB);
    fx::bf16* WinT = (fx::bf16*)(ws + WS_WIN * MiB);
    int* TK = (int*)(ws + WS_TK * MiB);
    float* TW = (float*)(ws + (WS_TK + 1) * MiB);
    int* list_tok = (int*)(ws + WS_LTOK * MiB);
    float* list_gate = (float*)(ws + WS_LGATE * MiB);
    fx::bf16* WedT = (fx::bf16*)(ws + WS_WED * MiB);
    fx::bf16* HID = (fx::bf16*)(ws + WS_HID * MiB);
    unsigned char* QPG = ws + WS_GLA * MiB; unsigned char* OIb = ws + (WS_GLA + 16) * MiB; unsigned char* UUb = ws + (WS_GLA + 80) * MiB; float* DECb = (float*)(ws + (WS_GLA + 144) * MiB); unsigned char* AGGb = ws + (WS_GLA + 145) * MiB; float* DAGGb = (float*)(ws + (WS_GLA + 153) * MiB);
    fx::bf16* WegT = (fx::bf16*)(ws + WS_WEG * MiB);
    fx::bf16* XN = (fx::bf16*)(ws + WS_XN * MiB);
    fx::bf16* Ybf = (fx::bf16*)(ws + WS_YBF * MiB);
    fx::bf16* QKV = (fx::bf16*)(ws + WS_QKV * MiB);
    fx::bf16* MIX = (fx::bf16*)(ws + WS_Z1 * MiB);
    float* LG = (float*)(ws + WS_LG * MiB);
    unsigned char* YA = ws + WS_Y * MiB;
    mo::lint tb = (mo::lint)((LAS unsigned char*)lds + mo::L_TB), yb = (mo::lint)((LAS unsigned char*)lds + mo::L_YB), cn = (mo::lint)((LAS unsigned char*)lds + mo::L_CN), ut = (mo::lint)((LAS unsigned char*)lds + mo::L_UT), rg = (mo::lint)((LAS unsigned char*)lds + mo::L_RG);

    const int lo = a.ph_lo, hi = a.ph_hi;
    bool tables_ready = false;
#define IN(k) (lo <= (k) && (k) < hi)
#define SEAM(k) do { if (IN(k) && IN((k) + 1)) xcd_barrier(bar); DERIVE(); } while (0)
    const int GW = G * 8;
#ifndef STG7
#define STG7 0
#endif
#ifndef STG8
#define STG8 0
#endif
#define STAGGER(q) do { if ((q) > 0) { const unsigned long long t0_ = __builtin_amdgcn_s_memrealtime(); const unsigned long long d_ = (unsigned long long)((vcu & 3) * (q)); while (__builtin_amdgcn_s_memrealtime() - t0_ < d_) __builtin_amdgcn_s_sleep(8); } } while (0)

    if (IN(0)) {
        LAS float* scr = (LAS float*)((LAS unsigned char*)lds + wave * 16384);
        constexpr int I_IN = 16 * (fx::NIN / 32), I_OUT = 16 * 32, I_R = 16 * 8, I_SMALL = I_IN + I_OUT + I_R;
        for (int it = vw; it < I_SMALL; it += GW) {
            int r = it;
            if (r < I_IN) { fx::transpose_item(w_in, D, INW, WinT, scr, r / (fx::NIN / 32), r % (fx::NIN / 32), lane, [](int d) { return fx::inproj_src(d); }); continue; } r -= I_IN;
            if (r < I_OUT) { fx::transpose_item(w_out, D, D, WoT, scr, r / 32, r % 32, lane, [](int d) { return d; }); continue; } r -= I_OUT;
            fx::transpose_item(w_router, D, NE, WrT, scr, r / 8, r % 8, lane, [](int d) { return d; });
        }
        for (int r = vw * 4; r < T; r += GW * 4) fx::ln_rows_bf16<4>(x + (size_t)r * D, ln_in_g, ln_in_b, XN + (size_t)r * D, lane, stats + 2 * (size_t)r);
    }
    SEAM(0);
    if (IN(1)) {
        const mo::ExpW XW{w_eg, w_eu, w_ed, w_sg, w_su, w_sd, WegT, WedT};
#ifndef MIXG
#define MIXG 2
#endif
        #ifndef SLOT_XCD
#define SLOT_XCD 0
#endif
        { const int slot = SLOT_XCD ? (bx & 7) % MIXG : vcu % MIXG; pg8::StaticOrder S; S.init(T, fx::NIN, G, bx);
          const int nun = (S.nwg - bx + G - 1) / G, nb = (MIXG > 1) ? nun * slot / (MIXG - 1) : nun;
          pg8::Gemm g{XN, WinT, T, fx::NIN, D, D}; pg8::EpiInProj E{QKV, FG, LF, b_fgate, ctl + CW_NRM};
          if (nb > 0) { pg8::RangeOrder R{S, 0, nb}; pg8::gemm_phase<pg8::EpiInProj, pg8::RangeOrder, true, true>((LAS unsigned char*)lds, g, R, E); DERIVE(); }
          { LAS float* scr = (LAS float*)((LAS unsigned char*)lds + wave * 16384);
            const int nmax = (S.nwg + G - 1) / G, nlight = G * nmax - S.nwg;
#ifndef CONV_SKEW
#define CONV_SKEW 0.18f
#endif
            const bool two = (CONV_SKEW != 0.0f) && nlight > 0 && nlight < G;
            const float sk = CONV_SKEW < 0.f ? -CONV_SKEW : CONV_SKEW;
            const int nsub = (CONV_SKEW > 0.f) ? nlight : G - nlight;
#ifndef SLOT_SKEW
#define SLOT_SKEW -0.1f
#endif
            const bool three = (SLOT_SKEW != 0.0f) && MIXG == 2 && !SLOT_XCD && (G % 16 == 0);
            const float ssk = SLOT_SKEW < 0.f ? -SLOT_SKEW : SLOT_SKEW;
            const int n2 = three ? mo::I_EXP - (int)(ssk * 0.5f * (float)mo::I_EXP) : mo::I_EXP;
            const int n1 = two ? n2 - (int)(sk * (float)mo::I_EXP * (float)nsub / (float)G) : n2;
            mo::expert_conv(XW, scr, vw, GW, n1, lane);
            const bool light = bx >= G - nlight;
            if (two && (light == (CONV_SKEW > 0.f))) { const int rank = light ? bx - (G - nlight) : bx; mo::expert_conv(XW, scr, n1 + rank * 8 + wave, nsub * 8, n2, lane); }
            if (three && ((slot == 0) == (SLOT_SKEW > 0.f))) { const int rank = (bx / 16) * 8 + (bx & 7); mo::expert_conv(XW, scr, n2 + rank * 8 + wave, (G / 2) * 8, mo::I_EXP, lane); } }
          __syncthreads(); DERIVE();
          if (nb < nun) { pg8::RangeOrder R{S, nb, nun - nb}; pg8::gemm_phase<pg8::EpiInProj, pg8::RangeOrder, true, true>((LAS unsigned char*)lds, g, R, E); } }
    }
    SEAM(1);
    if (IN(2)) {
        int cur_h = -1;
        for (int blk = vcu; blk < gl::NUNIT / 8; blk += G) gl::prep_block(blk, QKV, FG, w_gate_up, b_gate, QPG, OIb, UUb, DECb, AGGb, DAGGb, lds, cur_h);
    }
    SEAM(2);
    if (IN(3)) {
        for (int blk = vcu; blk < gl::NUNIT / 8; blk += G) gl::post_block(blk * 8, 8, QKV, QPG, OIb, UUb, DECb, AGGb, DAGGb, g_gla, Ybf, lds);
        { const attn_body::AttnTensors AT{(const attn_body::bf16*)(QKV + fx::P_FQ), (const attn_body::bf16*)(QKV + fx::P_FK), (const attn_body::bf16*)(QKV + fx::P_FV), (attn_body::bf16*)Ybf, LF, ctl + CW_NRM};
          attn_body::attn_phase_dyn<8>((char*)lds, AT, ctl + CW_FOXQ, (volatile int*)(lds + 140288), (G % 8 == 0) ? vcu / (G / 8) : vcu % 8); }
    }
    SEAM(3);
    if (IN(4)) {
        pg8::DenseSched DS; DS.so.init(T, D, G, bx); DS.Bt = WoT; DS.ldb = D;
        pg8::EpiPlainBf16 E{MIX, D};
        pg8::gemm_phase2<pg8::EpiPlainBf16, pg8::DenseSched>((LAS unsigned char*)lds, Ybf, D, D, D, DS, E);
    }
    SEAM(4);
    if (IN(5)) {
        int* lcnt = (int*)(lds + 136192); int* lbase = lcnt + 256;
        for (int rb = vcu; rb < T / 128; rb += G) {
            if (tid < 256) lcnt[tid] = 0;
#ifndef P5_REP_LN
#define P5_REP_LN 1
#endif
#ifndef P5_REP_GEMM
#define P5_REP_GEMM 1
#endif
#ifndef P5_REP_ROUTE
#define P5_REP_ROUTE 1
#endif
            for (int rep = 0; rep < P5_REP_LN; ++rep) {
            for (int r = wave * 16; r < wave * 16 + 16; r += 4) { const size_t row = (size_t)rb * 128 + r;
                fx::ln1_rows_bf16<4>(x + row * D, stats + 2 * row, ln_in_g, ln_in_b, MIX + row * D, ln1_g, ln1_b, H1 + row * D, ALPHA, lane); }
            asm volatile("s_waitcnt vmcnt(0)" ::: "memory"); __syncthreads(); }
            for (int rep = 0; rep < P5_REP_GEMM; ++rep) {
            { pg8::RouterSched RS{rb, WrT}; pg8::EpiLogits E{LG};
              pg8::gemm_phase2<pg8::EpiLogits, pg8::RouterSched>((LAS unsigned char*)lds, H1, D, D, D, RS, E); }
            DERIVE(); }
            for (int rep = 0; rep < P5_REP_ROUTE; ++rep) {
            if (rep > 0) { __syncthreads(); if (tid < 256) lcnt[tid] = 0; __syncthreads(); }
            for (int t = rb * 128 + wave * 2; t < rb * 128 + 128; t += 16) mo::route_token2(LG, rbias, lcnt, (LAS float*)((LAS unsigned char*)lds + 141312 + wave * 2048), TK, TW, t, lane); }
            __syncthreads();
            if (tid < 256) { const int c = lcnt[tid]; lbase[tid] = c ? atomicAdd(&counts[tid], c) : 0; }
            __syncthreads();
            for (int t = rb * 128 + wave * 2; t < rb * 128 + 128; t += 16) mo::route_finish2(lbase, list_tok, list_gate, TK, TW, t, lane);
            __syncthreads();
        }
    }
    SEAM(5);
    if (IN(6)) {
        if (wave == 0) mo::moe_tables(counts, tb, yb, cn, lane);
        __syncthreads(); tables_ready = true;
        STAGGER(STG7);
        pg8::MoeSched<0> MS{G, vcu, tb[257], tb, cn, list_tok, WegT, ut, rg}; if (wave == 0) MS.build(lane); __syncthreads(); MS.fill_rows(list_gate, tid); __syncthreads(); pg8::EpiSwiGLU E{HID, rg, a.pad};
        pg8::gemm_phase2<pg8::EpiSwiGLU, pg8::MoeSched<0>>((LAS unsigned char*)lds, H1, D, D, D, MS, E);
    }
    SEAM(6);
    if (IN(7)) {
        if (!tables_ready) { if (wave == 0) mo::moe_tables(counts, tb, yb, cn, lane); __syncthreads(); tables_ready = true; }
        STAGGER(STG8);
        pg8::MoeSched<1> MS{G, vcu, tb[257], tb, cn, list_tok, WedT, ut, rg}; if (wave == 0) MS.build(lane); __syncthreads(); pg8::EpiDown E{YA, yb, a.pad};
        pg8::gemm_phase2<pg8::EpiDown, pg8::MoeSched<1>>((LAS unsigned char*)lds, HID, 64, ED, ED, MS, E, 32768);
    }
    SEAM(7);
    if (IN(8)) {
        if (!tables_ready) { if (wave == 0) mo::moe_tables(counts, tb, yb, cn, lane); __syncthreads(); tables_ready = true; }
        for (int t = vw; t < T; t += GW) mo::combine_token(H1, YA, TK, yb, ln2_g, ln2_b, out, t, lane);
    }
#undef IN
#undef SEAM
}

extern "C" void kernel_launch(void* const* d_in, const int* in_sizes, int n_in, void* d_out, int out_size, void* d_ws, size_t ws_size, hipStream_t stream) {
    static int grid = 0;
    if (grid == 0) {
        if (n_in != 21 || out_size != nv::T * nv::D || ws_size < WS_END * MiB) { fprintf(stderr, "kernel_launch: unexpected shapes n_in=%d out=%d ws=%zu\n", n_in, out_size, ws_size); grid = -1; return; }
        int dev = 0, cus = 0;
        if (hipGetDevice(&dev) != hipSuccess || hipDeviceGetAttribute(&cus, hipDeviceAttributeMultiprocessorCount, dev) != hipSuccess) { grid = -1; return; }
        if (hipFuncSetAttribute((const void*)mega_fwd, hipFuncAttributeMaxDynamicSharedMemorySize, LDS_BYTES) != hipSuccess) { fprintf(stderr, "kernel_launch: hipFuncSetAttribute failed\n"); grid = -1; return; }
        grid = cus;
    }
    if (grid < 0) return;
    if (hipMemsetAsync(d_ws, 0, CTL_ZERO_BYTES, stream) != hipSuccess) return;
    Args a{};
    for (int i = 0; i < 21; ++i) a.in[i] = (const float*)d_in[i];
    a.out = (float*)d_out; a.ws = (unsigned char*)d_ws; a.ph_lo = 0; a.ph_hi = NPHASE; a.li = 0;
#ifdef REPEAT_PH
    a.ph_hi = REPEAT_PH + 1; hipLaunchKernelGGL(mega_fwd, dim3(grid), dim3(NTHR), LDS_BYTES, stream, a);
    if (REPEAT_PH == 3) hipMemsetAsync((char*)d_ws + CW_FOXQ * 4, 0, 256, stream);
    if (REPEAT_PH == 5) hipMemsetAsync((char*)d_ws + CW_MOE * 4, 0, 4096, stream);
    a.ph_lo = REPEAT_PH; a.ph_hi = NPHASE; a.li = 1;
#ifdef REPEAT_NOEPI
    a.ph_hi = REPEAT_PH + 1; a.pad = 1; hipLaunchKernelGGL(mega_fwd, dim3(grid), dim3(NTHR), LDS_BYTES, stream, a); a.pad = 0; a.ph_lo = REPEAT_PH + 1; a.ph_hi = NPHASE; a.li = 2;
#endif
#endif
    hipLaunchKernelGGL(mega_fwd, dim3(grid), dim3(NTHR), LDS_BYTES, stream, a);
}
```

```cpp
#include <hip/hip_runtime.h>
#include <cstdio>
#include <cstdint>
#include <cmath>

#define LAS __attribute__((address_space(3)))
#define GAS __attribute__((address_space(1)))

#define XB_TMO      128
#define XB_XCNT(j)  (256  + 64 * (j))
#define XB_XSUB(j)  (1280 + 64 * (j))
#define XB_XGEN(j)  (2304 + 64 * (j))
#define XB_TOP      3328
#define XB_TOPGEN   3392
#define XCD_BAR_WORDS 3456
#define XB_SPIN_CAP (1u << 27)
__device__ __forceinline__ unsigned xb_ld(unsigned* p)              { return __hip_atomic_load(p, __ATOMIC_RELAXED, __HIP_MEMORY_SCOPE_AGENT); }
__device__ __forceinline__ unsigned xb_add(unsigned* p, unsigned v) { return __hip_atomic_fetch_add(p, v, __ATOMIC_RELAXED, __HIP_MEMORY_SCOPE_AGENT); }
__device__ __forceinline__ unsigned xb_xcc_id() { return (unsigned)__builtin_amdgcn_s_getreg((3 << 11) | 20) & 0xFu; }
#define XB_SPIN(cond, bar) do { unsigned _sp = 0; while (cond) { __builtin_amdgcn_s_sleep(1); \
    if ((++_sp & 255u) == 0u) { if (xb_ld(&(bar)[XB_TMO])) break; if (_sp > XB_SPIN_CAP) { atomicAdd(&(bar)[XB_TMO], 1u); break; } } } } while (0)
struct XcdBarrier { unsigned* bar; unsigned x; volatile LAS unsigned* st; };
__device__ __forceinline__ XcdBarrier xcd_barrier_post(unsigned* bar, volatile LAS unsigned* st) {
    XcdBarrier b; b.bar = bar; b.x = xb_xcc_id(); b.st = st;
    if (threadIdx.x == 0) (void)xb_add(&bar[XB_XCNT(b.x)], 1u);
    return b;
}
__device__ __forceinline__ void xcd_barrier_complete(unsigned* bar, unsigned x, unsigned& nloc, unsigned& nx) {
    const unsigned G = gridDim.x * gridDim.y * gridDim.z;
    unsigned sum, cnt, mine, sp = 0u;
    for (;;) {
        sum = 0u; cnt = 0u; mine = 0u;
#pragma unroll
        for (unsigned j = 0; j < 16; ++j) { const unsigned c = xb_ld(&bar[XB_XCNT(j)]); sum += c; cnt += (c > 0u) ? 1u : 0u; mine = (j == x) ? c : mine; }
        if (sum == G) break;
        __builtin_amdgcn_s_sleep(1);
        if ((++sp & 255u) == 0u) { if (xb_ld(&bar[XB_TMO])) break; if (sp > XB_SPIN_CAP) { atomicAdd(&bar[XB_TMO], 1u); break; } }
    }
    nloc = mine > 0u ? mine : 1u; nx = cnt > 0u ? cnt : 1u;
}
__device__ __forceinline__ void xcd_barrier(const XcdBarrier& b) {
    asm volatile("s_waitcnt vmcnt(0)" ::: "memory");
    __syncthreads();
    if (threadIdx.x == 0) {
        unsigned* bar = b.bar;
        __builtin_amdgcn_s_waitcnt(0);
        unsigned nloc = b.st[0], nx = b.st[1];
        if (nloc == 0u) { xcd_barrier_complete(bar, b.x, nloc, nx); b.st[0] = nloc; b.st[1] = nx; }
        const unsigned old = xb_add(&bar[XB_XSUB(b.x)], 1u);
        const unsigned gen = old / nloc;
        if (old + 1u == (gen + 1u) * nloc) {
            __builtin_amdgcn_fence(__ATOMIC_RELEASE, "agent");
            asm volatile("s_waitcnt vmcnt(0)" ::: "memory");
            const unsigned og = xb_add(&bar[XB_TOP], 1u);
            const unsigned tg = og / nx;
            if (og + 1u == (tg + 1u) * nx) xb_add(&bar[XB_TOPGEN], 1u);
            else XB_SPIN(xb_ld(&bar[XB_TOPGEN]) == tg, bar);
            __builtin_amdgcn_fence(__ATOMIC_ACQUIRE, "agent");
            xb_add(&bar[XB_XGEN(b.x)], 1u);
            asm volatile("s_waitcnt vmcnt(0)" ::: "memory");
        } else {
            XB_SPIN(xb_ld(&bar[XB_XGEN(b.x)]) == gen, bar);
            __builtin_amdgcn_fence(__ATOMIC_ACQUIRE, "agent");
            asm volatile("s_waitcnt vmcnt(0)" ::: "memory");
        }
    }
    __syncthreads();
}
namespace pg8 {
#define PG8_LAS __attribute__((address_space(3)))
typedef unsigned short bf16_t;
typedef short bf16x8 __attribute__((ext_vector_type(8)));
typedef float f32x4 __attribute__((ext_vector_type(4)));
typedef unsigned u32x4 __attribute__((ext_vector_type(4)));
constexpr int BM = 256, BK = 64, HALF = 128, HTB = HALF * BK * 2  , STAGE_BYTES = 8 * HTB, NXCD = 8, WGM = 8;

__host__ __device__ __forceinline__ int lds_byte(int r, int c) { const int st = (r >> 4) * 2 + (c >> 5), rr = r & 15, cc = c & 31, ob = rr * 64 + cc * 2; return st * 1024 + (ob ^ (((ob >> 9) & 1) << 5)); }
__host__ __device__ __forceinline__ void stage_rc(int b, int& R, int& C) { const int st = b / 1024, sb = b % 1024, swz = sb ^ (((sb >> 9) & 1) << 5); R = (st >> 1) * 16 + swz / 64; C = (st & 1) * 32 + (swz % 64) / 2; }
__host__ __device__ __forceinline__ int perm32(int rho) { const int n = rho >> 4, i = rho & 15; return 8 * (i >> 2) + 4 * n + (i & 3); }

struct Unit { int pm, pn; };
struct Gemm { const bf16_t* A; const bf16_t* Bt; int M, N, K, lda; int akt = 0; };

struct StaticOrder {
    int nM, nN, nwg, G, c;
    __host__ __device__ void init(int M, int N, int G_, int c_) { nM = M / BM; nN = N / BM; nwg = nM * nN; G = G_; c = c_; }
    __host__ __device__ bool next(int i, Unit& u) const {
        const long L = (long)i * G + c; if (L >= nwg) return false;
        int wgid = (int)L; { const int q = nwg / NXCD, r = nwg % NXCD, xcd = wgid % NXCD, off = wgid / NXCD; wgid = (xcd < r ? xcd * (q + 1) : r * (q + 1) + (xcd - r) * q) + off; }
        const int nig = WGM * nN, gid = wgid / nig, fm = gid * WGM, gsz = (nM - fm) < WGM ? (nM - fm) : WGM;
        u.pm = fm + ((wgid % nig) % gsz); u.pn = (wgid % nig) / gsz; return true;
    }
    __device__ __forceinline__ void a_ready(const Unit&) const {}
    __device__ __forceinline__ void done(const Unit&) const {}
};

struct RangeOrder {
    StaticOrder so; int i0, n;
    __host__ __device__ bool next(int i, Unit& u) const { return i < n && so.next(i0 + i, u); }
    __device__ __forceinline__ void a_ready(const Unit&) const {}
    __device__ __forceinline__ void done(const Unit&) const {}
};
__device__ __forceinline__ unsigned cvt_pk_bf16(float lo, float hi) { unsigned r; asm volatile("v_cvt_pk_bf16_f32 %0, %1, %2" : "=v"(r) : "v"(lo), "v"(hi)); return r; }
typedef float f32x2 __attribute__((ext_vector_type(2)));
__device__ __forceinline__ f32x2 gelu_pk(f32x2 v) {
    const f32x2 av = __builtin_elementwise_abs(v), d = av * 0.2316418882f + 1.0f;
    f32x2 t; t.x = __builtin_amdgcn_rcpf(d.x); t.y = __builtin_amdgcn_rcpf(d.y);
    f32x2 q = t * 0.5307027145f + (-0.7265760135f); q = q * t + 0.7107068705f; q = q * t + (-0.142248368f); q = q * t + 0.127414796f; q = q * t;
    const f32x2 s = (v * v) * (-0.72134752044f);
    f32x2 e; e.x = __builtin_amdgcn_exp2f(s.x); e.y = __builtin_amdgcn_exp2f(s.y);
    const f32x2 m = v * (q * e), r = v - m;
    f32x2 o; o.x = v.x < 0.f ? m.x : r.x; o.y = v.y < 0.f ? m.y : r.y; return o;
}

template <int ACT  > struct EpiBf16 {
    static constexpr bool PERM = true, AFTER_DRAIN = false; static_assert(ACT == 0 || ACT == 1, "EpiBf16: ACT is 0 (none) or 1 (gelu_pk)");
    bf16_t* O; int ldc; const float* bias; int split_cols; size_t split_stride; float scale0;
    __device__ __forceinline__ void operator()(const f32x4 (&acc)[2][2][4][2], const Unit& u, int wr, int wc, int fr, int fq) const {
        const int row0 = u.pm * BM + wr * 64 + fr; int colt = u.pn * BM; bf16_t* base = O;
        float sc = 1.f; if (split_cols) { const int t = colt / split_cols; base += (size_t)t * split_stride; colt -= t * split_cols; if (t == 0) sc = scale0; }
        const int col0 = colt + wc * 32 + 8 * fq, bcol0 = u.pn * BM + wc * 32 + 8 * fq;
        f32x4 bv[2][2];
#pragma unroll
        for (int bj = 0; bj < 2; ++bj)
#pragma unroll
            for (int n = 0; n < 2; ++n) bv[bj][n] = bias ? *(const f32x4*)(bias + bcol0 + bj * HALF + 4 * n) : (f32x4){0.f, 0.f, 0.f, 0.f};
#pragma unroll
        for (int ai = 0; ai < 2; ++ai)
#pragma unroll
            for (int m = 0; m < 4; ++m) { bf16_t* rowp = base + (size_t)(row0 + ai * HALF + m * 16) * ldc + col0;
#pragma unroll
                for (int bj = 0; bj < 2; ++bj) { f32x4 v0 = acc[ai][bj][m][0] + bv[bj][0], v1 = acc[ai][bj][m][1] + bv[bj][1];
                    if (ACT == 1) { f32x2 a = gelu_pk((f32x2){v0[0], v0[1]}), b = gelu_pk((f32x2){v0[2], v0[3]}), c = gelu_pk((f32x2){v1[0], v1[1]}), d = gelu_pk((f32x2){v1[2], v1[3]});
                        v0 = (f32x4){a.x, a.y, b.x, b.y}; v1 = (f32x4){c.x, c.y, d.x, d.y}; }
                    v0 = v0 * sc; v1 = v1 * sc; u32x4 w; w.x = cvt_pk_bf16(v0[0], v0[1]); w.y = cvt_pk_bf16(v0[2], v0[3]); w.z = cvt_pk_bf16(v1[0], v1[1]); w.w = cvt_pk_bf16(v1[2], v1[3]);
                    *(u32x4*)(rowp + bj * HALF) = w; } }
    }
};

template <class Epi, class Sched, bool ALIGN_EPI = false, bool SP2 = false>
__device__ __forceinline__ void gemm_phase(PG8_LAS unsigned char* lds, const Gemm g, const Sched& S, const Epi& E) {
    const int tid = threadIdx.x, wid = __builtin_amdgcn_readfirstlane(tid >> 6), lane = tid & 63, wr = wid >> 2, wc = wid & 3, fr = lane & 15, fq = lane >> 4;
    const int K = g.K, nt = K / BK;
    unsigned voffA[2], voffB[2];
#pragma unroll
    for (int i = 0; i < 2; ++i) { int R, C; stage_rc(tid * 16 + i * 8192, R, C); const int Rb = Epi::PERM ? ((R & ~31) + perm32(R & 31)) : R;
        voffA[i] = (unsigned)(R * g.lda + C) * 2u; voffB[i] = (unsigned)(Rb * K + C) * 2u; }
    const size_t kstep = (size_t)(BK * 2);
    const size_t hstepA = (size_t)HALF * g.lda * 2, hstepB = (size_t)HALF * K * 2;
    const size_t tstepA = g.akt ? (size_t)BM * K * 2 : 2 * hstepA, tstepB = 2 * hstepB; const size_t kstepA = g.akt ? (size_t)32768 : kstep;
    const unsigned ldsw = (unsigned)wid * 1024u;
    const int aoff = lds_byte(wr * 64 + fr, fq * 8), boff = lds_byte(wc * 32 + fr, fq * 8);
#define PG8_SA(b, h) (((b) * 2 + (h)) * HTB)
#define PG8_SB(b, h) ((4 + (b) * 2 + (h)) * HTB)
#define PG8_STAGE(bufoff, gbase, voff) do { _Pragma("unroll") for (int _i = 0; _i < 2; ++_i) \
        __builtin_amdgcn_global_load_lds((const unsigned*)((const char*)(gbase) + (voff)[_i]), (PG8_LAS unsigned*)(lds + (bufoff) + ldsw + _i * 8192), 16, 0, 0); } while (0)
#define PG8_LDA(dst, b, h) do { _Pragma("unroll") for (int m = 0; m < 4; ++m) _Pragma("unroll") for (int k = 0; k < 2; ++k) dst[m][k] = *(const PG8_LAS bf16x8*)(lds + PG8_SA(b, h) + aoff + m * 2048 + k * 1024); } while (0)
#define PG8_LDB(dst, b, h) do { _Pragma("unroll") for (int n = 0; n < 2; ++n) _Pragma("unroll") for (int k = 0; k < 2; ++k) dst[n][k] = *(const PG8_LAS bf16x8*)(lds + PG8_SB(b, h) + boff + n * 2048 + k * 1024); } while (0)
#define PG8_MMA(ai, bj, At, Bt) do { __builtin_amdgcn_s_setprio(1); _Pragma("unroll") for (int m = 0; m < 4; ++m) _Pragma("unroll") for (int n = 0; n < 2; ++n) _Pragma("unroll") for (int k = 0; k < 2; ++k) \
        acc[ai][bj][m][n] = __builtin_amdgcn_mfma_f32_16x16x32_bf16(Bt[n][k], At[m][k], acc[ai][bj][m][n], 0, 0, 0); __builtin_amdgcn_s_setprio(0); } while (0)
#define PG8_WAIT_V(n) asm volatile("s_waitcnt vmcnt(" #n ")" ::: "memory")
#define PG8_WAIT_L(n) asm volatile("s_waitcnt lgkmcnt(" #n ")" ::: "memory")
#define PG8_BAR __builtin_amdgcn_s_barrier()
#define PG8_SCHED __builtin_amdgcn_sched_barrier(0)
    Unit cur, nxt; int ui = 0;
    if (!S.next(0, cur)) return;
    f32x4 acc[2][2][4][2];
#pragma unroll
    for (int a = 0; a < 2; ++a)
#pragma unroll
        for (int b = 0; b < 2; ++b)
#pragma unroll
            for (int m = 0; m < 4; ++m)
#pragma unroll
                for (int n = 0; n < 2; ++n) acc[a][b][m][n] = (f32x4){0.f, 0.f, 0.f, 0.f};
    bf16x8 At[4][2], B0[2][2], B1[2][2];
    const char* cA = (const char*)g.A + (size_t)cur.pm * tstepA; const char* cB = (const char*)g.Bt + (size_t)cur.pn * tstepB;
    S.a_ready(cur);
    if constexpr (SP2) {
        PG8_STAGE(PG8_SB(0, 0), cB, voffB); PG8_STAGE(PG8_SB(0, 1), cB + hstepB, voffB); PG8_STAGE(PG8_SA(0, 0), cA, voffA); PG8_STAGE(PG8_SA(0, 1), cA + hstepA, voffA);
        if (wr == 1) PG8_BAR;
        PG8_WAIT_V(2); PG8_BAR;
        PG8_STAGE(PG8_SB(1, 0), cB + kstep, voffB); PG8_STAGE(PG8_SA(1, 0), cA + kstepA, voffA); PG8_STAGE(PG8_SB(1, 1), cB + hstepB + kstep, voffB);
        PG8_WAIT_V(6); PG8_BAR;
    } else {
        PG8_STAGE(PG8_SB(0, 0), cB, voffB); PG8_STAGE(PG8_SA(0, 0), cA, voffA); PG8_STAGE(PG8_SB(0, 1), cB + hstepB, voffB); PG8_STAGE(PG8_SA(0, 1), cA + hstepA, voffA);
        if (wr == 1) PG8_BAR;
        PG8_WAIT_V(4); PG8_BAR;
        PG8_STAGE(PG8_SB(1, 0), cB + kstep, voffB); PG8_STAGE(PG8_SA(1, 0), cA + kstepA, voffA); PG8_STAGE(PG8_SB(1, 1), cB + hstepB + kstep, voffB);
        PG8_WAIT_V(6); PG8_BAR;
    }
    for (;;) {
        const bool has_next = S.next(ui + 1, nxt);
        const char* nA = has_next ? (const char*)g.A + (size_t)nxt.pm * tstepA : cA; const char* nB = has_next ? (const char*)g.Bt + (size_t)nxt.pn * tstepB : cB;
        for (int t = 0; t < nt; t += 2) {
            const bool last = (t == nt - 2);
            const char* a1 = cA + (size_t)(t + 1) * kstepA;
            const char* a2 = last ? nA : cA + (size_t)(t + 2) * kstepA; const char* b2 = last ? nB : cB + (size_t)(t + 2) * kstep;
            const char* a3 = a2 + kstepA; const char* b3 = b2 + kstep;
            if (last && has_next) S.a_ready(nxt);
            if constexpr (SP2) {
            PG8_LDB(B0, 0, 0); PG8_LDB(B1, 0, 1); PG8_SCHED; PG8_LDA(At, 0, 0); PG8_STAGE(PG8_SA(1, 1), a1 + hstepA, voffA);
            PG8_WAIT_V(8); PG8_WAIT_L(0); PG8_BAR; PG8_MMA(0, 0, At, B0); PG8_MMA(0, 1, At, B1); PG8_BAR; PG8_SCHED;
            PG8_LDA(At, 0, 1); PG8_STAGE(PG8_SB(0, 0), b2, voffB); PG8_STAGE(PG8_SB(0, 1), b2 + hstepB, voffB); PG8_STAGE(PG8_SA(0, 0), a2, voffA);
            PG8_WAIT_V(8); PG8_WAIT_L(0); PG8_BAR; PG8_MMA(1, 0, At, B0); PG8_MMA(1, 1, At, B1); PG8_BAR; PG8_SCHED;
            PG8_LDB(B0, 1, 0); PG8_LDB(B1, 1, 1); PG8_SCHED; PG8_LDA(At, 1, 0); PG8_STAGE(PG8_SA(0, 1), a2 + hstepA, voffA);
            PG8_WAIT_V(8); PG8_WAIT_L(0); PG8_BAR; PG8_MMA(0, 0, At, B0); PG8_MMA(0, 1, At, B1); PG8_BAR; PG8_SCHED;
            PG8_LDA(At, 1, 1); PG8_STAGE(PG8_SB(1, 0), b3, voffB); PG8_STAGE(PG8_SB(1, 1), b3 + hstepB, voffB); PG8_STAGE(PG8_SA(1, 0), a3, voffA);
            PG8_WAIT_V(8); PG8_WAIT_L(0); PG8_BAR; PG8_MMA(1, 0, At, B0); PG8_MMA(1, 1, At, B1); PG8_BAR; PG8_SCHED;
            } else {
            PG8_LDB(B0, 0, 0); PG8_SCHED; PG8_LDA(At, 0, 0); PG8_STAGE(PG8_SA(1, 1), a1 + hstepA, voffA);
            PG8_WAIT_L(8); PG8_BAR; PG8_WAIT_L(0); PG8_MMA(0, 0, At, B0); PG8_BAR; PG8_SCHED;
            PG8_LDB(B1, 0, 1); PG8_STAGE(PG8_SB(0, 0), b2, voffB);
            PG8_BAR; PG8_WAIT_L(0); PG8_MMA(0, 1, At, B1); PG8_BAR;
            PG8_LDA(At, 0, 1); PG8_STAGE(PG8_SA(0, 0), a2, voffA);
            PG8_BAR; PG8_WAIT_L(0); PG8_MMA(1, 0, At, B0); PG8_BAR; PG8_SCHED;
            PG8_STAGE(PG8_SB(0, 1), b2 + hstepB, voffB);
            PG8_WAIT_V(6); PG8_BAR; PG8_MMA(1, 1, At, B1); PG8_BAR;
            PG8_LDB(B0, 1, 0); PG8_SCHED; PG8_LDA(At, 1, 0); PG8_STAGE(PG8_SA(0, 1), a2 + hstepA, voffA);
            PG8_WAIT_L(8); PG8_BAR; PG8_WAIT_L(0); PG8_MMA(0, 0, At, B0); PG8_BAR; PG8_SCHED;
            PG8_LDB(B1, 1, 1); PG8_STAGE(PG8_SB(1, 0), b3, voffB);
            PG8_BAR; PG8_WAIT_L(0); PG8_MMA(0, 1, At, B1); PG8_BAR;
            PG8_LDA(At, 1, 1); PG8_STAGE(PG8_SA(1, 0), a3, voffA);
            PG8_BAR; PG8_WAIT_L(0); PG8_MMA(1, 0, At, B0); PG8_BAR; PG8_SCHED;
            PG8_STAGE(PG8_SB(1, 1), b3 + hstepB, voffB);
            PG8_WAIT_V(6); PG8_BAR; PG8_MMA(1, 1, At, B1); PG8_BAR;
            }
        }
        if constexpr (ALIGN_EPI) { if (wr == 0) PG8_BAR; }
        if constexpr (!Epi::AFTER_DRAIN) { E(acc, cur, wr, wc, fr, fq); S.done(cur); }
        if (!has_next) break;
#pragma unroll
        for (int a = 0; a < 2; ++a)
#pragma unroll
            for (int b = 0; b < 2; ++b)
#pragma unroll
                for (int m = 0; m < 4; ++m)
#pragma unroll
                    for (int n = 0; n < 2; ++n) acc[a][b][m][n] = (f32x4){0.f, 0.f, 0.f, 0.f};
        cur = nxt; cA = nA; cB = nB; ++ui;
        if constexpr (ALIGN_EPI) { if (wr == 1) PG8_BAR; }
    }
    PG8_WAIT_V(0);
    if constexpr (!ALIGN_EPI) { if (wr == 0) PG8_BAR; }
    PG8_BAR;
    if constexpr (Epi::AFTER_DRAIN) { E.fused(acc, cur, wr, wc, fr, fq, lds, wid, lane); S.done(cur); }
#undef PG8_SA
#undef PG8_SB
#undef PG8_STAGE
#undef PG8_LDA
#undef PG8_LDB
#undef PG8_MMA
#undef PG8_WAIT_V
#undef PG8_WAIT_L
#undef PG8_BAR
#undef PG8_SCHED
}
}
namespace pg8 {
struct Unit2 { int pm, pn, e, cnt, jt, ui; };
template <class E, class = void> struct has_perm16 { static constexpr bool value = false; };
template <class E> struct has_perm16<E, decltype((void)E::PERM16)> { static constexpr bool value = E::PERM16; };
template <class E> constexpr bool perm16() { return has_perm16<E>::value; }
template <class S, class = void> struct has_fp8 { static constexpr bool value = false; };
template <class S> struct has_fp8<S, decltype((void)S::FP8)> { static constexpr bool value = S::FP8; };
typedef int v8i_t __attribute__((ext_vector_type(8)));
typedef int v4i_t __attribute__((ext_vector_type(4)));
__device__ __forceinline__ v8i_t cat8(const bf16x8& a, const bf16x8& b) { const v4i_t x = __builtin_bit_cast(v4i_t, a), y = __builtin_bit_cast(v4i_t, b); v8i_t r; r[0] = x[0]; r[1] = x[1]; r[2] = x[2]; r[3] = x[3]; r[4] = y[0]; r[5] = y[1]; r[6] = y[2]; r[7] = y[3]; return r; }
template <class Epi, class Sched>
__device__ __forceinline__ void gemm_phase2(PG8_LAS unsigned char* lds, const bf16_t* Abase, int lda, int ldb, int K, const Sched& S, const Epi& E, int kstepA_ = BK * 2, int kstepB_ = BK * 2) {
    int tid_ = threadIdx.x; asm volatile("" : "+v"(tid_));
    const int tid = tid_, wid = __builtin_amdgcn_readfirstlane(tid >> 6), lane = tid & 63, wr = wid >> 2, wc = wid & 3, fr = lane & 15, fq = lane >> 4;
    int K_ = K; asm volatile("" : "+s"(K_));
    const int nt = K_ / BK;
    unsigned voffB0[2], voffB1[2];
#pragma unroll
    for (int i = 0; i < 2; ++i) { int R, C; stage_rc(tid * 16 + i * 8192, R, C);
        if constexpr (perm16<Epi>()) { const int cb = 64 * (R >> 5) + 16 * ((R >> 2) & 3) + 4 * ((R >> 4) & 1) + (R & 3); voffB0[i] = (unsigned)(cb * ldb + C) * 2u; voffB1[i] = (unsigned)((cb + 8) * ldb + C) * 2u; }
        else { const int Rb = Epi::PERM ? ((R & ~31) + perm32(R & 31)) : R; voffB0[i] = (unsigned)(Rb * ldb + C) * 2u; voffB1[i] = voffB0[i] + (unsigned)(HALF * ldb * 2); } }
    const unsigned lda2 = (unsigned)lda * 2u;
#define PG8_AOFFS(U, o0, o1) do { int t2_ = threadIdx.x; asm volatile("" : "+v"(t2_)); _Pragma("unroll") for (int i_ = 0; i_ < 2; ++i_) { int R_, C_; stage_rc(t2_ * 16 + i_ * 8192, R_, C_); \
        o0[i_] = (unsigned)S.arow(U, R_) * lda2 + (unsigned)C_ * 2u; o1[i_] = (unsigned)S.arow(U, HALF + R_) * lda2 + (unsigned)C_ * 2u; } } while (0)
    const size_t kstep = (size_t)kstepB_, kstepA = (size_t)kstepA_;
    const unsigned ldsw = (unsigned)wid * 1024u;
    const int aoff = lds_byte(wr * 64 + fr, fq * 8), boff = lds_byte(wc * 32 + fr, fq * 8);
#define PG8_SA(b, h) (((b) * 2 + (h)) * HTB)
#define PG8_SB(b, h) ((4 + (b) * 2 + (h)) * HTB)
#define PG8_STAGE(bufoff, gbase, voff) do { _Pragma("unroll") for (int _i = 0; _i < 2; ++_i) \
        __builtin_amdgcn_global_load_lds((const unsigned*)((const char*)(gbase) + (voff)[_i]), (PG8_LAS unsigned*)(lds + (bufoff) + ldsw + _i * 8192), 16, 0, 0); } while (0)
#define PG8_LDA(dst, b, h) do { _Pragma("unroll") for (int m = 0; m < 4; ++m) _Pragma("unroll") for (int k = 0; k < 2; ++k) dst[m][k] = *(const PG8_LAS bf16x8*)(lds + PG8_SA(b, h) + aoff + m * 2048 + k * 1024); } while (0)
#define PG8_LDB(dst, b, h) do { _Pragma("unroll") for (int n = 0; n < 2; ++n) _Pragma("unroll") for (int k = 0; k < 2; ++k) dst[n][k] = *(const PG8_LAS bf16x8*)(lds + PG8_SB(b, h) + boff + n * 2048 + k * 1024); } while (0)
#define PG8_MMA(ai, bj, At, Bt) do { __builtin_amdgcn_s_setprio(1); if constexpr (has_fp8<Sched>::value) { _Pragma("unroll") for (int m = 0; m < 4; ++m) _Pragma("unroll") for (int n = 0; n < 2; ++n) \
        acc[ai][bj][m][n] = __builtin_amdgcn_mfma_scale_f32_16x16x128_f8f6f4(cat8(Bt[n][0], Bt[n][1]), cat8(At[m][0], At[m][1]), acc[ai][bj][m][n], 0, 0, 0, 0, 0, 0); } else { \
        _Pragma("unroll") for (int m = 0; m < 4; ++m) _Pragma("unroll") for (int n = 0; n < 2; ++n) _Pragma("unroll") for (int k = 0; k < 2; ++k) \
        acc[ai][bj][m][n] = __builtin_amdgcn_mfma_f32_16x16x32_bf16(Bt[n][k], At[m][k], acc[ai][bj][m][n], 0, 0, 0); } __builtin_amdgcn_s_setprio(0); } while (0)
#define PG8_WAIT_V(n) asm volatile("s_waitcnt vmcnt(" #n ")" ::: "memory")
#define PG8_WAIT_L(n) asm volatile("s_waitcnt lgkmcnt(" #n ")" ::: "memory")
#define PG8_BAR __builtin_amdgcn_s_barrier()
#define PG8_SCHED __builtin_amdgcn_sched_barrier(0)
    Unit2 cur, nxt; int ui = 0;
    if (!S.next(0, cur)) return;
    f32x4 acc[2][2][4][2];
#pragma unroll
    for (int a = 0; a < 2; ++a)
#pragma unroll
        for (int b = 0; b < 2; ++b)
#pragma unroll
            for (int m = 0; m < 4; ++m)
#pragma unroll
                for (int n = 0; n < 2; ++n) acc[a][b][m][n] = (f32x4){0.f, 0.f, 0.f, 0.f};
    bf16x8 At[4][2], B0[2][2], B1[2][2];
    unsigned cv0[2], cv1[2], nv0[2], nv1[2];
    PG8_AOFFS(cur, cv0, cv1);
    const char* cA = (const char*)Abase + S.aoff(cur); const char* cB = S.bptr(cur);
    PG8_STAGE(PG8_SB(0, 0), cB, voffB0); PG8_STAGE(PG8_SB(0, 1), cB, voffB1); PG8_STAGE(PG8_SA(0, 0), cA, cv0); PG8_STAGE(PG8_SA(0, 1), cA, cv1);
    if (wr == 1) PG8_BAR;
    PG8_WAIT_V(2); PG8_BAR;
    PG8_STAGE(PG8_SB(1, 0), cB + kstep, voffB0); PG8_STAGE(PG8_SA(1, 0), cA + kstepA, cv0); PG8_STAGE(PG8_SB(1, 1), cB + kstep, voffB1);
    PG8_WAIT_V(6); PG8_BAR;
    for (;;) {
        const bool has_next = S.next(ui + 1, nxt);
        const char* nA = has_next ? (const char*)Abase + S.aoff(nxt) : cA; const char* nB = has_next ? S.bptr(nxt) : cB;
#pragma unroll
        for (int i = 0; i < 2; ++i) { nv0[i] = cv0[i]; nv1[i] = cv1[i]; }
        if (has_next) PG8_AOFFS(nxt, nv0, nv1);
        const bool act0 = cur.cnt > wr * 64, act1 = cur.cnt > HALF + wr * 64;
        for (int t = 0; t < nt; t += 2) {
            const bool last = (t == nt - 2);
            const char* a1 = cA + (size_t)(t + 1) * kstepA;
            const char* a2 = last ? nA : cA + (size_t)(t + 2) * kstepA; const char* b2 = last ? nB : cB + (size_t)(t + 2) * kstep;
            const char* a3 = a2 + kstepA; const char* b3 = b2 + kstep;
            unsigned s0[2] = {cv0[0], cv0[1]}, s1[2] = {cv1[0], cv1[1]};
            if (last) { asm volatile("" ::: "memory"); s0[0] = nv0[0]; s0[1] = nv0[1]; s1[0] = nv1[0]; s1[1] = nv1[1]; }
            PG8_LDB(B0, 0, 0); PG8_LDB(B1, 0, 1); PG8_SCHED; PG8_LDA(At, 0, 0); PG8_STAGE(PG8_SA(1, 1), a1, cv1);
            PG8_WAIT_V(8); PG8_WAIT_L(0); PG8_BAR; if (act0) { PG8_MMA(0, 0, At, B0); PG8_MMA(0, 1, At, B1); } PG8_BAR; PG8_SCHED;
            PG8_LDA(At, 0, 1); PG8_STAGE(PG8_SB(0, 0), b2, voffB0); PG8_STAGE(PG8_SB(0, 1), b2, voffB1); PG8_STAGE(PG8_SA(0, 0), a2, s0);
            PG8_WAIT_V(8); PG8_WAIT_L(0); PG8_BAR; if (act1) { PG8_MMA(1, 0, At, B0); PG8_MMA(1, 1, At, B1); } PG8_BAR; PG8_SCHED;
            PG8_LDB(B0, 1, 0); PG8_LDB(B1, 1, 1); PG8_SCHED; PG8_LDA(At, 1, 0); PG8_STAGE(PG8_SA(0, 1), a2, s1);
            PG8_WAIT_V(8); PG8_WAIT_L(0); PG8_BAR; if (act0) { PG8_MMA(0, 0, At, B0); PG8_MMA(0, 1, At, B1); } PG8_BAR; PG8_SCHED;
            PG8_LDA(At, 1, 1); PG8_STAGE(PG8_SB(1, 0), b3, voffB0); PG8_STAGE(PG8_SB(1, 1), b3, voffB1); PG8_STAGE(PG8_SA(1, 0), a3, s0);
            PG8_WAIT_V(8); PG8_WAIT_L(0); PG8_BAR; if (act1) { PG8_MMA(1, 0, At, B0); PG8_MMA(1, 1, At, B1); } PG8_BAR; PG8_SCHED;
        }
        if (wr == 0) PG8_BAR;
        if constexpr (!Epi::AFTER_DRAIN) { Unit2 eu = cur; asm volatile("" : "+s"(eu.pm), "+s"(eu.pn), "+s"(eu.e), "+s"(eu.cnt), "+s"(eu.jt), "+s"(eu.ui));
          E(acc, eu, wr, wc, fr, fq);
          }
        if (!has_next) break;
#pragma unroll
        for (int a = 0; a < 2; ++a)
#pragma unroll
            for (int b = 0; b < 2; ++b)
#pragma unroll
                for (int m = 0; m < 4; ++m)
#pragma unroll
                    for (int n = 0; n < 2; ++n) acc[a][b][m][n] = (f32x4){0.f, 0.f, 0.f, 0.f};
        cur = nxt; cA = nA; cB = nB; ++ui;
#pragma unroll
        for (int i = 0; i < 2; ++i) { cv0[i] = nv0[i]; cv1[i] = nv1[i]; }
        if (wr == 1) PG8_BAR;
    }
    PG8_WAIT_V(0);
    PG8_BAR;
    if constexpr (Epi::AFTER_DRAIN) E(acc, cur, wr, wc, fr, fq);
#undef PG8_AOFFS
#undef PG8_SA
#undef PG8_SB
#undef PG8_STAGE
#undef PG8_LDA
#undef PG8_LDB
#undef PG8_MMA
#undef PG8_WAIT_V
#undef PG8_WAIT_L
#undef PG8_BAR
#undef PG8_SCHED
}

struct DenseSched {
    StaticOrder so; const bf16_t* Bt; int ldb;
    __device__ __forceinline__ bool next(int i, Unit2& u) const { Unit t; if (!so.next(i, t)) return false; u.pm = t.pm; u.pn = t.pn; u.e = 0; u.cnt = 256; u.jt = 0; u.ui = i; return true; }
    int akt = 0;
    __device__ __forceinline__ int arow(const Unit2& u, int r) const { return akt ? r : u.pm * BM + r; }
    __device__ __forceinline__ size_t aoff(const Unit2& u) const { return akt ? (size_t)u.pm * (size_t)akt : 0; }
    __device__ __forceinline__ const char* bptr(const Unit2& u) const { return (const char*)(Bt + (size_t)u.pn * BM * ldb); }
};
struct EpiPlainBf16 {
    static constexpr bool PERM = true, AFTER_DRAIN = false;
    bf16_t* O; int ldc;
    __device__ __forceinline__ void operator()(const f32x4 (&acc)[2][2][4][2], const Unit2& u, int wr, int wc, int fr, int fq) const {
        const int row0 = u.pm * BM + wr * 64 + fr, col0 = u.pn * BM + wc * 32 + 8 * fq;
#pragma unroll
        for (int ai = 0; ai < 2; ++ai)
#pragma unroll
            for (int m = 0; m < 4; ++m) { bf16_t* rowp = O + (size_t)(row0 + ai * HALF + m * 16) * ldc + col0;
#pragma unroll
                for (int bj = 0; bj < 2; ++bj) { const f32x4 v0 = acc[ai][bj][m][0], v1 = acc[ai][bj][m][1];
                    u32x4 w; w.x = cvt_pk_bf16(v0[0], v0[1]); w.y = cvt_pk_bf16(v0[2], v0[3]); w.z = cvt_pk_bf16(v1[0], v1[1]); w.w = cvt_pk_bf16(v1[2], v1[3]);
                    *(u32x4*)(rowp + bj * HALF) = w; } }
    }
};
}
namespace nv {
constexpr int D = 1024, B = 8, S = 4096, T = B * S;
constexpr int FH = 8, FD = 64, GH = 4, GK = 64, GV = 128, RANK = 16;
constexpr int INW = 3096;
constexpr int O_FQ = 0, O_FK = 512, O_FV = 1024, O_FF = 1536, O_GQ = 1544, O_GK = 1800, O_GV = 2056, O_GA = 2568, O_GR = 2584;
constexpr int NE = 256, NG = 8, TOPK = 8, ED = 256;
constexpr float LN_EPS = 1e-5f;
constexpr float ALPHA = 1.189207115002721f;
constexpr int PADR = 64;
constexpr int APAD = T * TOPK + NE * PADR;

__device__ __forceinline__ float logsigmoidf(float x) { return fminf(x, 0.f) - log1pf(expf(-fabsf(x))); }
__device__ __forceinline__ float siluf(float x) { return x / (1.f + expf(-x)); }

}
#include <hip/hip_bf16.h>
#include <cmath>
namespace attn_body {
using bf16=__hip_bfloat16;
using bf16x8=__attribute__((ext_vector_type(8)))short;
using s16x4=__attribute__((ext_vector_type(4)))short;
using f32x16=__attribute__((ext_vector_type(16)))float;
using u32x4=__attribute__((ext_vector_type(4)))unsigned;
constexpr long HSTR=8L*4096*64;
constexpr int BATCH=8,NHEAD=8,SEQ=4096,D=64,DM=64,OPITCH=64;
constexpr int NW=8,QBLK=32,QB=QBLK*NW,KVBLK=64,NQB=SEQ/QB;
constexpr int ATTN_PITCH=DM, ATTN_UNIT_ROWS=QB;
__device__ __forceinline__ int crow(int r,int hi){return (r&3)+8*(r>>2)+4*hi;}
#define SBAR() __builtin_amdgcn_sched_barrier(0)
__device__ __forceinline__ void cmask(f32x16&p0,f32x16&p1,int jb,int qrel,int hi){
  const float NEG=-INFINITY; int kb=64*jb+4*hi;
  #pragma unroll
  for(int r=0;r<16;++r){int kv=kb+(r&3)+8*(r>>2); if(kv>qrel)p0[r]=NEG; if(kv+32>qrel)p1[r]=NEG;}
}

constexpr int NSLOT=3, SLOTB=8192;
constexpr int LDS_K=0, LDS_V=NSLOT*SLOTB, LDS_WS=2*NSLOT*SLOTB, LDS_OST=LDS_WS+NW*64*4, LDS_KB=LDS_OST+NW*4096, LDS_BYTES=LDS_KB+(SEQ+2)*8;
constexpr float C2=0.125f*1.4426950408889634f;
__device__ __forceinline__ void glds16(const void*gsrc,unsigned lds_dst){unsigned keep;
  asm volatile("s_mov_b32 %0, m0\n\ts_mov_b32 m0, %2\n\ts_nop 0\n\tglobal_load_lds_dwordx4 %1, off\n\ts_mov_b32 m0, %0":"=&s"(keep):"v"(gsrc),"s"(lds_dst):"memory");}
__device__ __forceinline__ float max3f(float a,float b,float c){float r;asm("v_max3_f32 %0, %1, %2, %3":"=v"(r):"v"(a),"v"(b),"v"(c));return r;}
__device__ __forceinline__ float max2f(float a,float b){float r;asm("v_max_f32_e32 %0, %1, %2":"=v"(r):"v"(a),"v"(b));return r;}
__device__ __forceinline__ float fadd_s(float a,float b){float r;asm("v_add_f32_e32 %0, %1, %2":"=v"(r):"v"(a),"v"(b));return r;}
__device__ __forceinline__ float fsub_s(float a,float b){float r;asm("v_sub_f32_e32 %0, %1, %2":"=v"(r):"v"(a),"v"(b));return r;}
typedef float f32x2_t __attribute__((ext_vector_type(2))); typedef float f32x4_t __attribute__((ext_vector_type(4))); typedef __bf16 bf16x2_t __attribute__((ext_vector_type(2)));
__device__ __forceinline__ unsigned cvtpk_s(float lo,float hi){f32x2_t v={lo,hi};bf16x2_t b=__builtin_convertvector(v,bf16x2_t);return __builtin_bit_cast(unsigned,b);}
#define WAIT_BAR(N) asm volatile("s_waitcnt vmcnt(" #N ") lgkmcnt(0)\n\ts_barrier":::"memory")

__device__ __forceinline__ void split3(float b,unsigned&h,unsigned&m,unsigned&l){
  h=cvtpk_s(b,0.f)&0xffffu; const float r1=b-__uint_as_float(h<<16);
  m=cvtpk_s(r1,0.f)&0xffffu; const float r2=r1-__uint_as_float(m<<16);
  l=cvtpk_s(r2,0.f)&0xffffu; }
__device__ __forceinline__ bf16x8 kbias_frag(float b,int hi){unsigned h,m,l;split3(b,h,m,l);u32x4 w;w.x=h|(m<<16);w.y=l|0x3F800000u;w.z=0x3F803F80u;w.w=0u;if(hi){w.x=0u;w.y=0u;w.z=0u;}return __builtin_bit_cast(bf16x8,w);}
__device__ __forceinline__ bf16x8 qref_frag(float x,int hi){unsigned h,m,l;split3(x,h,m,l);u32x4 w;w.x=0x3F803F80u;w.y=0x3F80u|(h<<16);w.z=m|(l<<16);w.w=0u;if(hi){w.x=0u;w.y=0u;w.z=0u;}return __builtin_bit_cast(bf16x8,w);}
typedef unsigned u32x2_t __attribute__((ext_vector_type(2)));
__device__ __forceinline__ bf16x8 mkfrag(u32x2_t e,unsigned zc){u32x4 w;w.x=e.x;w.y=e.y;w.z=zc;w.w=0u;return __builtin_bit_cast(bf16x8,w);}
__device__ __forceinline__ void fox_bias_table(int b,int h,const float*LF,char*shm){
  int tid_=threadIdx.x; asm volatile("":"+v"(tid_)); const int tid=tid_,lane=tid&63,wid=__builtin_amdgcn_readfirstlane(tid>>6);
  const float*lf=LF+((long)b*NHEAD+h)*SEQ; float*wt=(float*)(shm+LDS_WS); u32x2_t*KB8=(u32x2_t*)(shm+LDS_KB);
  f32x4_t va=*(const f32x4_t*)(lf+8*tid),vb=*(const f32x4_t*)(lf+8*tid+4);
  va[1]+=va[0];va[2]+=va[1];va[3]+=va[2];vb[0]+=va[3];vb[1]+=vb[0];vb[2]+=vb[1];vb[3]+=vb[2];
  const float tot=vb[3]; float inc=tot;
  #pragma unroll
  for(int o_=1;o_<64;o_<<=1){const float nn=__shfl_up(inc,o_);if(lane>=o_)inc+=nn;}
  __syncthreads();
  if(lane==63)wt[wid*64]=inc;
  __syncthreads();
  float base=inc-tot;
  #pragma unroll
  for(int w_=0;w_<NW;++w_){const float x_=wt[w_*64]; if(w_<wid)base+=x_;}
  const float cv[8]={va[0]+base,va[1]+base,va[2]+base,va[3]+base,vb[0]+base,vb[1]+base,vb[2]+base,vb[3]+base};
  #pragma unroll
  for(int j=0;j<8;++j){unsigned hh,mm,ll;split3(-cv[j],hh,mm,ll);KB8[8*tid+j]=(u32x2_t){hh|(mm<<16),ll|0x3F800000u};}
  if(tid==0){KB8[SEQ]=(u32x2_t){0u,0u};KB8[SEQ+1]=(u32x2_t){0u,0u};}
  __syncthreads();
}
__device__ __forceinline__ void qkt(f32x16&p0,f32x16&p1,const char*Kslot,const bf16x8*qr,bf16x8 kb0,bf16x8 kb1,bf16x8 qx,int r32,int hi){
  const f32x16 negm=f32x16{};
  const char*kb=Kslot+hi*1024+r32*16;
  #pragma unroll
  for(int d0=0;d0<4;++d0){
    const bf16x8 b0=*reinterpret_cast<const bf16x8*>(kb+d0*2048);
    const bf16x8 b1=*reinterpret_cast<const bf16x8*>(kb+d0*2048+512);
    if(d0==0){p0=__builtin_amdgcn_mfma_f32_32x32x16_bf16(b0,qr[0],negm,0,0,0);p1=__builtin_amdgcn_mfma_f32_32x32x16_bf16(b1,qr[0],negm,0,0,0);}
    else{p0=__builtin_amdgcn_mfma_f32_32x32x16_bf16(b0,qr[d0],p0,0,0,0);p1=__builtin_amdgcn_mfma_f32_32x32x16_bf16(b1,qr[d0],p1,0,0,0);}}
  p0=__builtin_amdgcn_mfma_f32_32x32x16_bf16(kb0,qx,p0,0,0,0);p1=__builtin_amdgcn_mfma_f32_32x32x16_bf16(kb1,qx,p1,0,0,0);
}
typedef __attribute__((address_space(3))) const char* lds_cptr;
typedef short v4i16_t __attribute__((ext_vector_type(4)));
__device__ __forceinline__ void kload8(bf16x8*kf,lds_cptr kp){
  kf[0]=*(const __attribute__((address_space(3))) bf16x8*)(kp);      kf[1]=*(const __attribute__((address_space(3))) bf16x8*)(kp+512);
  kf[2]=*(const __attribute__((address_space(3))) bf16x8*)(kp+2048); kf[3]=*(const __attribute__((address_space(3))) bf16x8*)(kp+2560);
  kf[4]=*(const __attribute__((address_space(3))) bf16x8*)(kp+4096); kf[5]=*(const __attribute__((address_space(3))) bf16x8*)(kp+4608);
  kf[6]=*(const __attribute__((address_space(3))) bf16x8*)(kp+6144); kf[7]=*(const __attribute__((address_space(3))) bf16x8*)(kp+6656);
}
__device__ __forceinline__ void kload2(bf16x8*kf,lds_cptr kp,int j){ kf[2*j]=*(const __attribute__((address_space(3))) bf16x8*)(kp+j*2048); kf[2*j+1]=*(const __attribute__((address_space(3))) bf16x8*)(kp+j*2048+512); }
__device__ __forceinline__ s16x4 vtr(lds_cptr p){ return __builtin_bit_cast(s16x4,__builtin_amdgcn_ds_read_tr16_b64_v4i16((__attribute__((address_space(3))) v4i16_t*)p)); }
__device__ __forceinline__ float rowmax(const f32x16&p0,const f32x16&p1){
  float a=max3f(p0[0],p0[1],p1[0]),b=max3f(p0[2],p0[3],p1[1]);a=max3f(a,p1[2],p1[3]);
  #pragma unroll
  for(int r=4;r<16;r+=4){a=max3f(a,p0[r],p0[r+1]);b=max3f(b,p0[r+2],p0[r+3]);a=max3f(a,p1[r],p1[r+1]);b=max3f(b,p1[r+2],p1[r+3]);}
  const float m=max2f(a,b);
  auto rr=__builtin_amdgcn_permlane32_swap(__float_as_uint(m),__float_as_uint(m),false,false);
  return max2f(__uint_as_float(rr[0]),__uint_as_float(rr[1]));
}
__device__ __forceinline__ void pv(f32x16*o,int vb,bf16x8 pa0,bf16x8 pa1,bf16x8 pa2,bf16x8 pa3){
  #pragma unroll
  for(int d0=0;d0<2;++d0){s16x4 lo[4],hi[4];
    #pragma unroll
    for(int ks=0;ks<4;++ks){
      asm volatile("ds_read_b64_tr_b16 %0,%1 offset:%c2":"=&v"(lo[ks]):"v"(vb),"i"(d0*4096+ks*1024):"memory");
      asm volatile("ds_read_b64_tr_b16 %0,%1 offset:%c2":"=&v"(hi[ks]):"v"(vb),"i"(d0*4096+ks*1024+512):"memory");}
    asm volatile("s_waitcnt lgkmcnt(0)":::"memory");SBAR();
    #define PK(k) (bf16x8){lo[k][0],lo[k][1],lo[k][2],lo[k][3],hi[k][0],hi[k][1],hi[k][2],hi[k][3]}
    o[d0]=__builtin_amdgcn_mfma_f32_32x32x16_bf16(pa0,PK(0),o[d0],0,0,0);
    o[d0]=__builtin_amdgcn_mfma_f32_32x32x16_bf16(pa1,PK(1),o[d0],0,0,0);
    o[d0]=__builtin_amdgcn_mfma_f32_32x32x16_bf16(pa2,PK(2),o[d0],0,0,0);
    o[d0]=__builtin_amdgcn_mfma_f32_32x32x16_bf16(pa3,PK(3),o[d0],0,0,0);
    #undef PK
  }
}

#ifndef ATTN_STORE16
#define ATTN_STORE16(p,v) (*(u32x4*)(p)=(v))
#endif
template<int THRL> __device__ __forceinline__ void attn_unit(int b,int h,int qb,const bf16*Q,const bf16* K,const bf16* V,bf16*O,const float*LF,const unsigned*NRM,char*shm){
  int tid_=threadIdx.x; asm volatile("":"+v"(tid_));
  const int tid=tid_,lane=tid&63,r32=lane&31,hi=lane>>5; const int wid=__builtin_amdgcn_readfirstlane(tid>>6);
  const long rowbase=(long)b*SEQ; const int q0=qb*QB;
  const char*KBt0=shm+LDS_KB;
  int t0;
  { const int NT0=(q0+QB)/KVBLK; const unsigned*nr=NRM+(b*NHEAD+h)*4;
    const float qn2=__uint_as_float(nr[0])+__uint_as_float(nr[1]), kn2=__uint_as_float(nr[2])+__uint_as_float(nr[3]);
    const float thr=-(50.f+2.04f*sqrtf(qn2*kn2));
    const u32x2_t eq0=*(const u32x2_t*)(KBt0+(unsigned)q0*8u); const float bq0=__uint_as_float(eq0.x<<16)+__uint_as_float(eq0.x&0xffff0000u)+__uint_as_float(eq0.y<<16);
    bool ok=(2*lane<=NT0-4);
    if(ok&&lane>0){ const u32x2_t el=*(const u32x2_t*)(KBt0+(unsigned)(128*lane-1)*8u); const float bl=__uint_as_float(el.x<<16)+__uint_as_float(el.x&0xffff0000u)+__uint_as_float(el.y<<16); ok=(bl-bq0<thr); }
    const unsigned long long mk=__ballot(ok); const unsigned long long low=~mk; const int cnt=(low==0ull)?64:__builtin_ctzll(low);
    t0=__builtin_amdgcn_readfirstlane(2*(cnt-1)); }
  const char*KBt=KBt0+(hi?0:t0*512); const unsigned kb_o0=hi?(unsigned)SEQ*8u:(unsigned)r32*8u, kb_o1=hi?(unsigned)SEQ*8u:(unsigned)(r32+32)*8u, kb_str=hi?0u:512u, zc=hi?0u:0x3F803F80u;
  const bf16*Qw=Q+(rowbase+q0+wid*QBLK)*DM+h*HSTR;
  const bf16*Kh=K+(rowbase+(long)t0*KVBLK)*DM+h*HSTR,*Vh=V+(rowbase+(long)t0*KVBLK)*DM+h*HSTR;
  const unsigned lds0=(unsigned)(uintptr_t)shm;
  float*wsf=(float*)(shm+LDS_WS)+wid*64;
  const bf16*ksrc=Kh+(long)lane*DM+wid*8;
  const bf16*vsrc=Vh+(long)(16*(wid&3)+(lane>>2))*DM+(wid>>2)*32+(lane&3)*8;
  const unsigned kdst=lds0+LDS_K+wid*1024, vdst=lds0+LDS_V+wid*1024;
  #define DMA_K(t,slot) glds16(ksrc+(long)(t)*KVBLK*DM,(unsigned)__builtin_amdgcn_readfirstlane(kdst+(slot)))
  #define DMA_V(t,slot) glds16(vsrc+(long)(t)*KVBLK*DM,(unsigned)__builtin_amdgcn_readfirstlane(vdst+(slot)))
  const int vb0=(int)(lds0+LDS_V)+((lane>>4)&1)*32+(lane&3)*8+(4*hi+((lane&15)>>2))*64;
  const char*Kbase=shm+LDS_K; bf16x8 kf[8];
  const lds_cptr shm3=(lds_cptr)shm; const lds_cptr kp0=shm3+LDS_K+hi*1024+r32*16; const lds_cptr vp0=shm3+LDS_V+((lane>>4)&1)*32+(lane&3)*8+(4*hi+((lane&15)>>2))*64;
  const int NT=(q0+QB)/KVBLK-t0;
  DMA_K(0,0);DMA_V(0,0);DMA_K(1,SLOTB);
  bf16x8 qr[4];
  #pragma unroll
  for(int d0=0;d0<4;++d0)qr[d0]=*reinterpret_cast<const bf16x8*>(&Qw[(long)r32*DM+d0*16+hi*8]);
  float mhat; { const u32x2_t eq=*(const u32x2_t*)(KBt0+(unsigned)(q0+wid*QBLK+r32)*8u); mhat=__uint_as_float(eq.x<<16)+__uint_as_float(eq.x&0xffff0000u)+__uint_as_float(eq.y<<16); }
  float l_reg=0.f;f32x16 o[2];o[0]=f32x16{};o[1]=f32x16{};const f32x16 negm=f32x16{};
  bf16x8 qx=qref_frag(-mhat,hi);
  const int qrel=wid*QBLK+r32;
  #define CMASK(P0,P1,t) do{int jb_=(t)-(NT-4); if(jb_>=0)cmask(P0,P1,jb_,qrel,hi);}while(0)
  bool resc=false;
  #define START(P0,P1) do{ const float rm=rowmax(P0,P1); resc=false; \
    { const float dl=__builtin_fmaxf(rm,0.f); mhat=fadd_s(mhat,dl); \
      _Pragma("unroll") for(int r=0;r<16;++r){P0[r]=fsub_s(P0[r],dl);P1[r]=fsub_s(P1[r],dl);} \
      qx=qref_frag(-mhat,hi); } \
    _Pragma("unroll") for(int r=0;r<16;++r)P0[r]=__builtin_amdgcn_exp2f(P0[r]); }while(0)
  #define RESC() do{ if(resc){ asm volatile("s_waitcnt lgkmcnt(0)":::"memory"); \
      _Pragma("unroll") for(int d_=0;d_<2;++d_) _Pragma("unroll") for(int r=0;r<16;++r)o[d_][r]*=wsf[crow(r,hi)]; } }while(0)
  f32x16 pA0,pA1,pB0,pB1;
  int sl_prev=0,sl_cur=0,sl_next=SLOTB;
  #define ROT() do{sl_prev=sl_cur;sl_cur=sl_next;sl_next=(sl_next==(NSLOT-1)*SLOTB)?0:sl_next+SLOTB;}while(0)
  DMA_K(2,2*SLOTB);
  WAIT_BAR(3);
  qkt(pA0,pA1,Kbase,qr,mkfrag(*(const u32x2_t*)(KBt+kb_o0),zc),mkfrag(*(const u32x2_t*)(KBt+kb_o1),zc),qx,r32,hi);asm volatile("s_nop 15\n\ts_nop 7":"+v"(pA0),"+v"(pA1));CMASK(pA0,pA1,0);
  START(pA0,pA1);
  _Pragma("unroll") for(int r=0;r<16;++r)pA1[r]=__builtin_amdgcn_exp2f(pA1[r]);
  WAIT_BAR(0);
  DMA_K(3,0);DMA_V(1,SLOTB);
  ROT();
  kload8(kf,kp0+sl_cur);
  WAIT_BAR(2);
  s16x4 vlo[8],vhi[8]; u32x4 pw0,pw1,pw2,pw3;
  #define PKW(P,B) cvtpk_s(P[B],P[B+1])
  #define PAF(k) __builtin_bit_cast(bf16x8,pw##k)
  #define VFR(i) (bf16x8){vlo[i][0],vlo[i][1],vlo[i][2],vlo[i][3],vhi[i][0],vhi[i][1],vhi[i][2],vhi[i][3]}
  #define PIN(x) asm volatile("":"+v"(x))
  #define MX3(a,b,c) __builtin_fmaxf(__builtin_fmaxf((a),(b)),(c))
  #define GAPA(MF,A0,A1,A2,A3,W0,W1,PW) do{ MF; sacc+=A0; sacc+=A1; sacc+=A2; sacc+=A3; PIN(sacc); W0; W1; PIN(PW); SBAR(); }while(0)
  #define EX(v) __builtin_amdgcn_exp2f(v)
  #define GAPB(MF,X,B) do{ MF; X[B]=EX(X[B]); X[B+1]=EX(X[B+1]); X[B+2]=EX(X[B+2]); X[B+3]=EX(X[B+3]); PIN(X); SBAR(); }while(0)
  #define VRD(i) do{ vlo[i]=vtr(vp_+(((i)>>2)*4096+((i)&3)*1024)); vhi[i]=vtr(vp_+(((i)>>2)*4096+((i)&3)*1024+512)); }while(0)
  #define KRD(G,j) do{ if(G){ kload2(kf,kp0+sl_next,j); SBAR(); } }while(0)
  #define STEP(C0,C1,P0,P1,t,GK,GV,GL) do{ SBAR(); \
    const lds_cptr vp_=vp0+sl_prev; const u32x2_t e0_=*(const u32x2_t*)(KBt+kb_o0+(unsigned)(t)*kb_str),e1_=*(const u32x2_t*)(KBt+kb_o1+(unsigned)(t)*kb_str); \
    VRD(0); SBAR(); float sacc=(P0[0]+P0[1]); \
    GAPA(C0=__builtin_amdgcn_mfma_f32_32x32x16_bf16(kf[0],qr[0],negm,0,0,0), P0[2],P0[3],P0[4],P0[5],     pw0[0]=PKW(P0,0), pw0[1]=PKW(P0,2), pw0); \
    VRD(4); SBAR(); GAPA(C1=__builtin_amdgcn_mfma_f32_32x32x16_bf16(kf[1],qr[0],negm,0,0,0), P0[6],P0[7],P0[8],P0[9],     pw0[2]=PKW(P0,4), pw0[3]=PKW(P0,6), pw0); \
    VRD(1); SBAR(); GAPA(C0=__builtin_amdgcn_mfma_f32_32x32x16_bf16(kf[2],qr[1],C0,0,0,0),   P0[10],P0[11],P0[12],P0[13], pw1[0]=PKW(P0,8), pw1[1]=PKW(P0,10), pw1); \
    VRD(5); SBAR(); GAPA(C1=__builtin_amdgcn_mfma_f32_32x32x16_bf16(kf[3],qr[1],C1,0,0,0),   P0[14],P0[15],P1[0],P1[1],   pw1[2]=PKW(P0,12),pw1[3]=PKW(P0,14), pw1); \
    VRD(2); SBAR(); GAPA(C0=__builtin_amdgcn_mfma_f32_32x32x16_bf16(kf[4],qr[2],C0,0,0,0),   P1[2],P1[3],P1[4],P1[5],     pw2[0]=PKW(P1,0), pw2[1]=PKW(P1,2), pw2); \
    VRD(6); SBAR(); GAPA(C1=__builtin_amdgcn_mfma_f32_32x32x16_bf16(kf[5],qr[2],C1,0,0,0),   P1[6],P1[7],P1[8],P1[9],     pw2[2]=PKW(P1,4), pw2[3]=PKW(P1,6), pw2); \
    VRD(3); SBAR(); GAPA(C0=__builtin_amdgcn_mfma_f32_32x32x16_bf16(kf[6],qr[3],C0,0,0,0),   P1[10],P1[11],P1[12],P1[13], pw3[0]=PKW(P1,8), pw3[1]=PKW(P1,10), pw3); \
    VRD(7); SBAR(); GAPA(C1=__builtin_amdgcn_mfma_f32_32x32x16_bf16(kf[7],qr[3],C1,0,0,0),   P1[14],P1[15],0.f,0.f,       pw3[2]=PKW(P1,12),pw3[3]=PKW(P1,14), pw3); \
    { const bf16x8 kb0_=mkfrag(e0_,zc),kb1_=mkfrag(e1_,zc); C0=__builtin_amdgcn_mfma_f32_32x32x16_bf16(kb0_,qx,C0,0,0,0); C1=__builtin_amdgcn_mfma_f32_32x32x16_bf16(kb1_,qx,C1,0,0,0); } SBAR(); \
    l_reg+=sacc; \
    if(GK){DMA_K((t)+3,sl_cur);} if(GV){DMA_V((t)+1,sl_next);} \
    CMASK(C0,C1,t); \
    { float a=MX3(C0[0],C0[1],C1[0]),b=MX3(C0[2],C0[3],C1[1]); a=MX3(a,C1[2],C1[3]); \
      _Pragma("unroll") for(int r=4;r<16;r+=4){a=MX3(a,C0[r],C0[r+1]);b=MX3(b,C0[r+2],C0[r+3]);a=MX3(a,C1[r],C1[r+1]);b=MX3(b,C1[r+2],C1[r+3]);} \
      float rm=__builtin_fmaxf(a,b); { auto rr=__builtin_amdgcn_permlane32_swap(__float_as_uint(rm),__float_as_uint(rm),false,false); rm=__builtin_fmaxf(__uint_as_float(rr[0]),__uint_as_float(rr[1])); } \
      resc=false; \
      if(__builtin_expect(__any(rm>(float)THRL),0)){ const float dl=__builtin_fmaxf(rm,0.f); mhat+=dl; \
        _Pragma("unroll") for(int r=0;r<16;++r){C0[r]-=dl;C1[r]-=dl;} \
        qx=qref_frag(-mhat,hi); \
        const float f=__builtin_amdgcn_exp2f(-dl); l_reg*=f; if(hi==0)wsf[r32]=f; resc=true; } } \
    SBAR(); \
    GAPB(o[0]=__builtin_amdgcn_mfma_f32_32x32x16_bf16(PAF(0),VFR(0),o[0],0,0,0), C0,0); \
    GAPB(o[1]=__builtin_amdgcn_mfma_f32_32x32x16_bf16(PAF(0),VFR(4),o[1],0,0,0), C0,4); \
    KRD(GL,0); GAPB(o[0]=__builtin_amdgcn_mfma_f32_32x32x16_bf16(PAF(1),VFR(1),o[0],0,0,0), C0,8); \
    KRD(GL,1); GAPB(o[1]=__builtin_amdgcn_mfma_f32_32x32x16_bf16(PAF(1),VFR(5),o[1],0,0,0), C0,12); \
    KRD(GL,2); GAPB(o[0]=__builtin_amdgcn_mfma_f32_32x32x16_bf16(PAF(2),VFR(2),o[0],0,0,0), C1,0); \
    KRD(GL,3); GAPB(o[1]=__builtin_amdgcn_mfma_f32_32x32x16_bf16(PAF(2),VFR(6),o[1],0,0,0), C1,4); \
    GAPB(o[0]=__builtin_amdgcn_mfma_f32_32x32x16_bf16(PAF(3),VFR(3),o[0],0,0,0), C1,8); \
    GAPB(o[1]=__builtin_amdgcn_mfma_f32_32x32x16_bf16(PAF(3),VFR(7),o[1],0,0,0), C1,12); \
    }while(0)
  int t=1;
  #undef CMASK
  #define CMASK(P0,P1,t) do{}while(0)
  for(;t+5<NT;t+=2){
    STEP(pB0,pB1,pA0,pA1,t,true,true,true);     WAIT_BAR(2); RESC(); ROT();
    STEP(pA0,pA1,pB0,pB1,t+1,true,true,true);   WAIT_BAR(2); RESC(); ROT();
  }
  #undef CMASK
  #define CMASK(P0,P1,t) do{int jb_=(t)-(NT-4); if(jb_>=0)cmask(P0,P1,jb_,qrel,hi);}while(0)
  #define ENDW(tt) do{ if((tt)+3<NT){WAIT_BAR(2);} else if((tt)+2<NT){WAIT_BAR(1);} else {WAIT_BAR(0);} }while(0)
  for(;t+1<NT;t+=2){
    STEP(pB0,pB1,pA0,pA1,t,(t+3<NT),(t+1<NT),(t+1<NT));       ENDW(t);   RESC(); ROT();
    STEP(pA0,pA1,pB0,pB1,t+1,(t+4<NT),(t+2<NT),(t+2<NT));     ENDW(t+1); RESC(); ROT();
  }
  STEP(pB0,pB1,pA0,pA1,NT-1,false,false,false); RESC();
  { float sacc=pB0[0]+pB0[1]; _Pragma("unroll") for(int r=2;r<16;++r)sacc+=pB0[r]; _Pragma("unroll") for(int r=0;r<16;++r)sacc+=pB1[r]; l_reg+=sacc;
    pw0=(u32x4){PKW(pB0,0),PKW(pB0,2),PKW(pB0,4),PKW(pB0,6)};pw1=(u32x4){PKW(pB0,8),PKW(pB0,10),PKW(pB0,12),PKW(pB0,14)};pw2=(u32x4){PKW(pB1,0),PKW(pB1,2),PKW(pB1,4),PKW(pB1,6)};pw3=(u32x4){PKW(pB1,8),PKW(pB1,10),PKW(pB1,12),PKW(pB1,14)};
    SBAR(); pv(o,vb0+sl_cur,PAF(0),PAF(1),PAF(2),PAF(3)); }
  #undef PKW
  #undef PAF
  #undef VFR
  #undef PIN
  #undef MX3
  #undef GAPA
  #undef GAPB
  #undef EX
  #undef VRD
  #undef KRD
  #undef STEP
  #undef ENDW
  {auto rr=__builtin_amdgcn_permlane32_swap(__float_as_uint(l_reg),__float_as_uint(l_reg),false,false);l_reg=__uint_as_float(rr[0])+__uint_as_float(rr[1]);}
  if(hi==0)wsf[32+r32]=l_reg;asm volatile("s_waitcnt lgkmcnt(0)":::"memory");
  float rli[16];
  #pragma unroll
  for(int r=0;r<16;++r)rli[r]=__builtin_amdgcn_rcpf(wsf[32+crow(r,hi)]);
  bf16*Ow=O+((rowbase+q0)>>8)*262144L+h*16384+((q0&255)+wid*QBLK)*OPITCH;
  { bf16*stg=(bf16*)(shm+LDS_OST)+wid*2048;
    #pragma unroll
    for(int r=0;r<16;++r){const int orow=crow(r,hi);
      #pragma unroll
      for(int d0=0;d0<2;++d0)stg[orow*64+d0*32+r32]=__float2bfloat16(o[d0][r]*rli[r]);}
    asm volatile("s_waitcnt lgkmcnt(0)":::"memory");
    #pragma unroll
    for(int i=0;i<4;++i){const int row=i*8+(lane>>3),ch=lane&7; const u32x4 v=*(const u32x4*)(stg+row*64+ch*8); ATTN_STORE16(Ow+(long)row*OPITCH+ch*8,v);} }
  asm volatile("s_waitcnt lgkmcnt(0)\n\ts_barrier":::"memory");
  #undef DMA_K
  #undef DMA_V
  #undef CMASK
  #undef START
  #undef RESC
  #undef ROT
}
constexpr int ATTN_LDS_BYTES=LDS_BYTES;
struct AttnTensors { const bf16* Q; const bf16* K; const bf16* V; bf16* O; const float* LF; const unsigned* NRM; };
struct AttnUnit { int bh; int qb; };
struct StaticOrder {
  int vcu,grid;
  __device__ __forceinline__ explicit StaticOrder(int grid_,int block):vcu((grid_%8==0)?(block%8)*(grid_/8)+block/8:block),grid(grid_){}
  __device__ __forceinline__ bool next(int i,AttnUnit&u)const{
    if(grid==256){ if(i>=4)return false; const int s=vcu&3; u.bh=vcu>>2; u.qb=(i==0)?s:(i==1)?7-s:(i==2)?8+s:15-s; return true; }
    const int L=i*grid+vcu; if(L>=BATCH*NHEAD*NQB)return false; u.bh=L/NQB; u.qb=L%NQB; return true; }
  __device__ __forceinline__ void a_ready(const AttnUnit&)const{}
  __device__ __forceinline__ void done(const AttnUnit&)const{}
};
template<class Sched,int THRL=8> __device__ __forceinline__ void attn_phase(char*lds,const AttnTensors&T,const Sched&S){
  AttnUnit u; int cur_bh=-1;
  for(int i=0;S.next(i,u);++i){ S.a_ready(u); if(u.bh!=cur_bh){ fox_bias_table(u.bh/NHEAD,u.bh%NHEAD,T.LF,lds); cur_bh=u.bh; }
    attn_unit<THRL>(u.bh/NHEAD,u.bh%NHEAD,u.qb,T.Q,T.K,T.V,T.O,T.LF,T.NRM,lds); S.done(u); }
}
template<int THRL=8> __device__ __forceinline__ void attn_phase_dyn(char*lds,const AttnTensors&T,unsigned*qheads,volatile int*slot,int grp){
  int cur_bh=-1; const int NU=NHEAD*NQB; unsigned*qhead=qheads+64*grp;
  if(threadIdx.x==0) slot[0]=(int)__hip_atomic_fetch_add(qhead,1u,__ATOMIC_RELAXED,__HIP_MEMORY_SCOPE_AGENT);
  __syncthreads();
  int idx=__builtin_amdgcn_readfirstlane(slot[0]);
  while(idx<NU){
    __syncthreads();
    if(threadIdx.x==0) slot[0]=(int)__hip_atomic_fetch_add(qhead,1u,__ATOMIC_RELAXED,__HIP_MEMORY_SCOPE_AGENT);
    const int qb=NQB-1-idx/NHEAD, bh=grp*NHEAD+idx%NHEAD;
    if(bh!=cur_bh){ fox_bias_table(bh/NHEAD,bh%NHEAD,T.LF,lds); cur_bh=bh; }
    attn_unit<THRL>(bh/NHEAD,bh%NHEAD,qb,T.Q,T.K,T.V,T.O,T.LF,T.NRM,lds);
    __syncthreads();
    idx=__builtin_amdgcn_readfirstlane(slot[0]);
  }
}
#undef SBAR
#undef WAIT_BAR
}
namespace fx {
using namespace nv;
typedef unsigned short bf16;
typedef unsigned v4u __attribute__((ext_vector_type(4)));
typedef float f32x4 __attribute__((ext_vector_type(4)));
constexpr float C2 = 0.125f * 1.4426950408889634f;
constexpr int NIN = 3328;
constexpr int QKVP = 3072;
constexpr size_t QSLAB = (size_t)nv::T * 64;
constexpr int P_FQ = 0, P_FK = 512, P_FV = 1024, P_GQ = 1536, P_GK = 1792, P_GV = 2048, P_GR = 2560;
__device__ __forceinline__ int inproj_src(int d) {
    if (d < 1536) return d;
    if (d < 1792) return O_GQ + (d - 1536);
    if (d < 2048) return O_GK + (d - 1792);
    if (d < 2560) return O_GV + (d - 2048);
    if (d < 3072) return O_GR + (d - 2560);
    if (d < 3080) return O_FF + (d - 3072);
    if (d < 3096) return O_GA + (d - 3080);
    return -1;
}
__device__ __forceinline__ unsigned f2bf(float f) { unsigned u = __builtin_bit_cast(unsigned, f); return (u + 0x7fffu + ((u >> 16) & 1u)) >> 16; }
__device__ __forceinline__ unsigned pk2(float lo, float hi) { return f2bf(lo) | (f2bf(hi) << 16); }
__device__ __forceinline__ float bf2f(unsigned short h) { return __builtin_bit_cast(float, (unsigned)h << 16); }
__device__ __forceinline__ float wave_sum(float v) {
#pragma unroll
    for (int o = 1; o < 64; o <<= 1) v += __shfl_xor(v, o);
    return v;
}
#define FX_LDS_WAIT() asm volatile("s_waitcnt lgkmcnt(0)" ::: "memory")

template <class Map> __device__ __forceinline__ void transpose_item(const float* __restrict__ W, int K, int N, bf16* WT, LAS float* scr, int kb, int nb, int lane, Map srcmap) {
    const int k0 = 64 * kb, n0 = 32 * nb;
    const int src = srcmap(n0 + (lane & 31));
#pragma unroll 8
    for (int i = 0; i < 32; ++i) { const int kk = 2 * i + (lane >> 5); scr[kk * 33 + (lane & 31)] = (src >= 0) ? W[(size_t)(k0 + kk) * N + src] : 0.f; }
    FX_LDS_WAIT(); asm volatile("" ::: "memory");
    const int c = lane & 7;
#pragma unroll
    for (int j = 0; j < 4; ++j) { const int n = (lane >> 3) + 8 * j; const LAS float* s = scr + (8 * c) * 33 + n;
        v4u o; o.x = pk2(s[0 * 33], s[1 * 33]); o.y = pk2(s[2 * 33], s[3 * 33]); o.z = pk2(s[4 * 33], s[5 * 33]); o.w = pk2(s[6 * 33], s[7 * 33]);
        *(GAS v4u*)(WT + (size_t)(n0 + n) * K + k0 + 8 * c) = o; }
    FX_LDS_WAIT(); asm volatile("" ::: "memory");
}

__device__ __forceinline__ void ln_row_bf16(const float* xrow, const float* __restrict__ g, const float* __restrict__ b, bf16* orow, float* frow, float* st, int lane) {
    const GAS f32x4* xr = (const GAS f32x4*)xrow + lane;
    f32x4 v[4]; float s = 0.f;
#pragma unroll
    for (int j = 0; j < 4; ++j) { v[j] = xr[64 * j]; s += (v[j].x + v[j].y) + (v[j].z + v[j].w); }
    const float mean = wave_sum(s) * (1.f / D); float s2 = 0.f;
#pragma unroll
    for (int j = 0; j < 4; ++j) { v[j] = v[j] - mean; s2 += (v[j].x * v[j].x + v[j].y * v[j].y) + (v[j].z * v[j].z + v[j].w * v[j].w); }
    const float rstd = 1.f / sqrtf(wave_sum(s2) * (1.f / D) + LN_EPS);
    if (st && lane == 0) { st[0] = mean; st[1] = rstd; }
    GAS unsigned long long* o8 = (GAS unsigned long long*)orow + lane;
#pragma unroll
    for (int j = 0; j < 4; ++j) {
        const f32x4 gg = ((const f32x4*)g)[lane + 64 * j], bb = ((const f32x4*)b)[lane + 64 * j];
        const f32x4 o = v[j] * rstd * gg + bb;
        o8[64 * j] = (unsigned long long)pk2(o.x, o.y) | ((unsigned long long)pk2(o.z, o.w) << 32);
        if (frow) ((GAS f32x4*)frow)[lane + 64 * j] = o;
    }
}

struct CvItem { const float* W; bf16* WT; int N, K, k0, n0, s0; int q8; };
__device__ __forceinline__ void cv_load(const CvItem& it, f32x4 (&v)[8], int lane) {
    const float* p = it.W + (size_t)(it.k0 + (lane >> 3)) * it.N + it.s0 + 4 * (lane & 7);
#pragma unroll
    for (int i = 0; i < 8; ++i) v[i] = __builtin_nontemporal_load((const f32x4*)(p + (size_t)(8 * i) * it.N));
}
__device__ __forceinline__ void cv_finish(const CvItem& it, const f32x4 (&v)[8], LAS float* scr, int lane) {
    const int rr = lane >> 3, cq = lane & 7;
#pragma unroll
    for (int i = 0; i < 8; ++i) { LAS float* d = scr + (8 * i + rr) * 33 + 4 * cq; d[0] = v[i][0]; d[1] = v[i][1]; d[2] = v[i][2]; d[3] = v[i][3]; }
    FX_LDS_WAIT(); asm volatile("" ::: "memory");
    const int c = lane & 7;
#pragma unroll
    for (int j = 0; j < 4; ++j) { const int n = (lane >> 3) + 8 * j; const LAS float* s = scr + (8 * c) * 33 + n;
        v4u o; o.x = pk2(s[0 * 33], s[1 * 33]); o.y = pk2(s[2 * 33], s[3 * 33]); o.z = pk2(s[4 * 33], s[5 * 33]); o.w = pk2(s[6 * 33], s[7 * 33]);
        __builtin_nontemporal_store(o, (GAS v4u*)(it.WT + (size_t)(it.n0 + n) * it.K + it.k0 + 8 * c)); }
    FX_LDS_WAIT(); asm volatile("" ::: "memory");
}

constexpr float WSC8 = 64.f;
__device__ __forceinline__ void cv_finish8(const CvItem& it, const f32x4 (&v)[8], LAS float* scr, int lane) {
    const int rr = lane >> 3, cq = lane & 7;
#pragma unroll
    for (int i = 0; i < 8; ++i) { LAS float* d = scr + (8 * i + rr) * 33 + 4 * cq; d[0] = v[i][0]; d[1] = v[i][1]; d[2] = v[i][2]; d[3] = v[i][3]; }
    FX_LDS_WAIT(); asm volatile("" ::: "memory");
    const int n = lane & 31, hf = lane >> 5; const LAS float* s = scr + (32 * hf) * 33 + n;
    unsigned w[8];
#pragma unroll
    for (int q = 0; q < 8; ++q) { int x = __builtin_amdgcn_cvt_pk_fp8_f32(s[(4 * q) * 33] * WSC8, s[(4 * q + 1) * 33] * WSC8, 0, false); x = __builtin_amdgcn_cvt_pk_fp8_f32(s[(4 * q + 2) * 33] * WSC8, s[(4 * q + 3) * 33] * WSC8, x, true); w[q] = (unsigned)x; }
    GAS unsigned char* d8 = (GAS unsigned char*)it.WT + (size_t)n * 128 + 32 * hf;
    v4u o0, o1; o0.x = w[0]; o0.y = w[1]; o0.z = w[2]; o0.w = w[3]; o1.x = w[4]; o1.y = w[5]; o1.z = w[6]; o1.w = w[7];
    __builtin_nontemporal_store(o0, (GAS v4u*)d8); __builtin_nontemporal_store(o1, (GAS v4u*)(d8 + 16));
    FX_LDS_WAIT(); asm volatile("" ::: "memory");
}

template <int NR, bool KTM = false> __device__ __forceinline__ void ln_rows_bf16(const float* xrows, const float* __restrict__ g, const float* __restrict__ b, bf16* orows, int lane, float* st = nullptr) {
    f32x4 v[NR][4];
#pragma unroll
    for (int r = 0; r < NR; ++r)
#pragma unroll
        for (int j = 0; j < 4; ++j) v[r][j] = __builtin_nontemporal_load((const GAS f32x4*)(xrows + (size_t)r * D) + lane + 64 * j);
    f32x4 gg[4], bb[4];
#pragma unroll
    for (int j = 0; j < 4; ++j) { gg[j] = ((const f32x4*)g)[lane + 64 * j]; bb[j] = ((const f32x4*)b)[lane + 64 * j]; }
#pragma unroll
    for (int r = 0; r < NR; ++r) {
        float s = 0.f;
#pragma unroll
        for (int j = 0; j < 4; ++j) s += (v[r][j].x + v[r][j].y) + (v[r][j].z + v[r][j].w);
        const float mean = wave_sum(s) * (1.f / D); float s2 = 0.f;
#pragma unroll
        for (int j = 0; j < 4; ++j) { v[r][j] = v[r][j] - mean; s2 += (v[r][j].x * v[r][j].x + v[r][j].y * v[r][j].y) + (v[r][j].z * v[r][j].z + v[r][j].w * v[r][j].w); }
        const float rstd = 1.f / sqrtf(wave_sum(s2) * (1.f / D) + LN_EPS);
        if (st && lane == 0) { st[2 * r] = mean; st[2 * r + 1] = rstd; }
        GAS unsigned long long* o8 = KTM ? (GAS unsigned long long*)(orows + (size_t)r * 64 + (size_t)(lane >> 4) * 16384 + 4 * (lane & 15)) : (GAS unsigned long long*)(orows + (size_t)r * D) + lane;
#pragma unroll
        for (int j = 0; j < 4; ++j) { const f32x4 o = v[r][j] * rstd * gg[j] + bb[j];
            o8[KTM ? 16384 * j : 64 * j] = (unsigned long long)pk2(o.x, o.y) | ((unsigned long long)pk2(o.z, o.w) << 32); }
    }
}

template <int NR> __device__ __forceinline__ void ln1_rows_bf16(const float* xrows, const float* st, const float* __restrict__ gi, const float* __restrict__ bi, const bf16* mixrows,
                                                               const float* __restrict__ g1, const float* __restrict__ b1, bf16* orows, float alpha, int lane, unsigned char* q8rows = nullptr) {
    f32x4 v[NR][4]; unsigned long long mx[NR][4]; float mean0[NR], rstd0[NR];
#pragma unroll
    for (int r = 0; r < NR; ++r) { mean0[r] = st[2 * r]; rstd0[r] = st[2 * r + 1];
#pragma unroll
        for (int j = 0; j < 4; ++j) { v[r][j] = __builtin_nontemporal_load((const GAS f32x4*)(xrows + (size_t)r * D) + lane + 64 * j); mx[r][j] = __builtin_nontemporal_load((const GAS unsigned long long*)(mixrows + (size_t)r * D) + lane + 64 * j); } }
    f32x4 gi4[4], bi4[4];
#pragma unroll
    for (int j = 0; j < 4; ++j) { gi4[j] = ((const f32x4*)gi)[lane + 64 * j] * alpha; bi4[j] = ((const f32x4*)bi)[lane + 64 * j] * alpha; }
#pragma unroll
    for (int r = 0; r < NR; ++r) {
        float s = 0.f;
#pragma unroll
        for (int j = 0; j < 4; ++j) { const unsigned lo = (unsigned)mx[r][j], hi = (unsigned)(mx[r][j] >> 32);
            f32x4 mv; mv.x = __builtin_bit_cast(float, lo << 16); mv.y = __builtin_bit_cast(float, lo & 0xffff0000u); mv.z = __builtin_bit_cast(float, hi << 16); mv.w = __builtin_bit_cast(float, hi & 0xffff0000u);
            v[r][j] = ((v[r][j] - mean0[r]) * rstd0[r]) * gi4[j] + bi4[j] + mv;
            s += (v[r][j].x + v[r][j].y) + (v[r][j].z + v[r][j].w); }
        const float mean = wave_sum(s) * (1.f / D); float s2 = 0.f;
#pragma unroll
        for (int j = 0; j < 4; ++j) { v[r][j] = v[r][j] - mean; s2 += (v[r][j].x * v[r][j].x + v[r][j].y * v[r][j].y) + (v[r][j].z * v[r][j].z + v[r][j].w * v[r][j].w); }
        const float rstd = 1.f / sqrtf(wave_sum(s2) * (1.f / D) + LN_EPS);
        GAS unsigned long long* o8 = (GAS unsigned long long*)(orows + (size_t)r * D) + lane;
#pragma unroll
        for (int j = 0; j < 4; ++j) { const f32x4 gg = ((const f32x4*)g1)[lane + 64 * j], bb = ((const f32x4*)b1)[lane + 64 * j]; const f32x4 o = v[r][j] * rstd * gg + bb;
            o8[64 * j] = (unsigned long long)pk2(o.x, o.y) | ((unsigned long long)pk2(o.z, o.w) << 32);
            if (q8rows) { int x = __builtin_amdgcn_cvt_pk_fp8_f32(o.x, o.y, 0, false); x = __builtin_amdgcn_cvt_pk_fp8_f32(o.z, o.w, x, true); ((GAS int*)(q8rows + (size_t)r * D))[lane + 64 * j] = x; } }
    }
}
}

namespace pg8 {
struct EpiInProj {
    static constexpr bool PERM = true, AFTER_DRAIN = false;
    bf16_t* QKV; float* FG; float* LF; const float* bfg; unsigned* NRM;
    __device__ __forceinline__ void operator()(const f32x4 (&acc)[2][2][4][2], const Unit& u, int wr, int wc, int fr, int fq) const {
        const int row0 = u.pm * BM + wr * 64 + fr;
        if (u.pn < 12) {
            const float sc = (u.pn < 2) ? fx::C2 : 1.f;
            const int col0 = u.pn * BM + wc * 32 + 8 * fq;
            float nmax[2] = {0.f, 0.f};
#pragma unroll
            for (int ai = 0; ai < 2; ++ai)
#pragma unroll
                for (int m = 0; m < 4; ++m) { bf16_t* rowp = QKV + (size_t)(col0 >> 6) * fx::QSLAB + (size_t)(row0 + ai * HALF + m * 16) * 64 + (col0 & 63);
#pragma unroll
                    for (int bj = 0; bj < 2; ++bj) { const f32x4 v0 = acc[ai][bj][m][0] * sc, v1 = acc[ai][bj][m][1] * sc;
                        u32x4 w; w.x = cvt_pk_bf16(v0[0], v0[1]); w.y = cvt_pk_bf16(v0[2], v0[3]); w.z = cvt_pk_bf16(v1[0], v1[1]); w.w = cvt_pk_bf16(v1[2], v1[3]);
                        *(u32x4*)(rowp + (size_t)bj * 2 * fx::QSLAB) = w;
                        if (u.pn < 4) { const f32x4 q0 = v0 * v0, q1 = v1 * v1; float s = (q0[0] + q0[1]) + (q0[2] + q0[3]) + (q1[0] + q1[1]) + (q1[2] + q1[3]);
                            s += __shfl_xor(s, 16); s += __shfl_xor(s, 32);
                            nmax[bj] = fmaxf(nmax[bj], s); } } }
            if (u.pn < 4) {
#pragma unroll
                for (int bj = 0; bj < 2; ++bj) { float s = nmax[bj];
#pragma unroll
                    for (int o = 1; o < 16; o <<= 1) s = fmaxf(s, __shfl_xor(s, o));
                    if (fr == 0 && fq == 0) { const int b = (u.pm * BM) >> 12, head = 4 * (u.pn & 1) + 2 * bj + (wc >> 1);
                        atomicMax(NRM + (b * 8 + head) * 4 + (u.pn >= 2 ? 2 : 0) + (wc & 1), __builtin_bit_cast(unsigned, s)); } }
            }
        } else if (wc == 0 && fq < 3) {
#pragma unroll
            for (int ai = 0; ai < 2; ++ai)
#pragma unroll
                for (int m = 0; m < 4; ++m) { const int row = row0 + ai * HALF + m * 16; float* p = FG + (size_t)row * 32 + 8 * fq;
                    *(f32x4*)p = acc[ai][0][m][0]; *(f32x4*)(p + 4) = acc[ai][0][m][1];
                    if (fq == 0) { const int b = row >> 12, s = row & 4095;
#pragma unroll
                        for (int n = 0; n < 2; ++n)
#pragma unroll
                            for (int i = 0; i < 4; ++i) { const int h = 4 * n + i; LF[(size_t)(b * 8 + h) * nv::S + s] = -__builtin_amdgcn_logf(1.f + __builtin_amdgcn_exp2f(-1.4426950408889634f * (acc[ai][0][m][n][i] + bfg[h]))); } } }
        }
    }
};
}
namespace gl {
using namespace nv;
typedef unsigned short bf16;
typedef short bf16x8 __attribute__((ext_vector_type(8)));
typedef float f32x4 __attribute__((ext_vector_type(4)));
typedef unsigned u32x4 __attribute__((ext_vector_type(4)));
typedef unsigned u32x2 __attribute__((ext_vector_type(2)));
constexpr int NCH = S / 64;
constexpr int NUNIT = B * GH * NCH;
constexpr int LS = 72;
constexpr int L_WGU = 0, L_BG = 4096, L_DECS = 4352, L_QP = 8192, L_KP = L_QP + 64 * LS * 2, L_KPT = L_KP + 64 * LS * 2, L_VT = L_KPT + 64 * LS * 2, L_PP = L_VT + 128 * LS * 2, L_WT = L_PP + 64 * LS * 2, L_END = L_WT + 2048;
static_assert(L_END <= 131072, "gla prep LDS");
constexpr int C_ST = 0, C_PART = 128 * LS * 2, C_END = C_PART + 2 * 8 * 64 * 4;
constexpr size_t QPG_B = 64 * 64 * 2, OI_B = 8 * 4 * 64 * 16, UU_B = OI_B, DEC_B = 256;
constexpr size_t OIH_B = 8 * 2 * 64 * 16;

template <int CTRL> __device__ __forceinline__ float dpp_f(float x) { return __builtin_bit_cast(float, __builtin_amdgcn_update_dpp(0, __builtin_bit_cast(int, x), CTRL, 0xf, 0xf, true)); }
__device__ __forceinline__ unsigned pkbf(float lo, float hi) { typedef float f2 __attribute__((ext_vector_type(2))); typedef __bf16 b2 __attribute__((ext_vector_type(2))); f2 v = {lo, hi}; b2 r = __builtin_convertvector(v, b2); return __builtin_bit_cast(unsigned, r); }
__device__ __forceinline__ float bf2f(unsigned short h) { return __builtin_bit_cast(float, (unsigned)h << 16); }
__device__ __forceinline__ float bflo(unsigned w) { return __builtin_bit_cast(float, w << 16); }
__device__ __forceinline__ float bfhi(unsigned w) { return __builtin_bit_cast(float, w & 0xffff0000u); }
__device__ __forceinline__ float fast_logsig2(float x) { return -__builtin_amdgcn_logf(1.f + __builtin_amdgcn_exp2f(-1.4426950408889634f * x)); }

__device__ __forceinline__ void prep_unit(int unit, const bf16* QKV, const float* FG, const float* __restrict__ wgu, const float* __restrict__ bgate,
                                          unsigned char* QPG, unsigned char* OI, unsigned char* UU, float* DEC, unsigned char* lds, int& cur_h, f32x4 (&Sagg)[4], f32x4 (&Dagg)[4]) {
    int tid_ = threadIdx.x; asm volatile("" : "+v"(tid_));
    const int tid = tid_, lane = tid & 63, wid = __builtin_amdgcn_readfirstlane(tid >> 6), l15 = lane & 15, g = lane >> 4;
    const int n = unit % NCH, bh = unit / NCH, h = bh % GH, b = bh / GH;
    const size_t row0 = (size_t)b * S + (size_t)n * 64;
    float* WGU = (float*)(lds + L_WGU); float* BG = (float*)(lds + L_BG); float* WT = (float*)(lds + L_WT);
    bf16* QP = (bf16*)(lds + L_QP); bf16* KP = (bf16*)(lds + L_KP); bf16* KPT = (bf16*)(lds + L_KPT); bf16* VT = (bf16*)(lds + L_VT); bf16* PP = (bf16*)(lds + L_PP);
    if (cur_h != h) { __syncthreads(); for (int i = tid; i < 16 * 64; i += 512) WGU[i] = wgu[(i >> 6) * 256 + h * 64 + (i & 63)]; if (tid < 64) BG[tid] = bgate[h * 64 + tid]; cur_h = h; __syncthreads(); }
    const int t = tid >> 3, oc = tid & 7, d0 = oc * 8;
    float la[8];
    { const float* gp = FG + (row0 + t) * 32 + 8;
      f32x4 ga4[4];
#pragma unroll
      for (int i = 0; i < 4; ++i) ga4[i] = *(const f32x4*)(gp + 4 * i);
#pragma unroll
      for (int j = 0; j < 8; ++j) la[j] = BG[d0 + j];
#pragma unroll
      for (int r = 0; r < 16; ++r) { const float gv = ga4[r >> 2][r & 3]; const f32x4 w0 = *(const f32x4*)(WGU + r * 64 + d0), w1 = *(const f32x4*)(WGU + r * 64 + d0 + 4);
#pragma unroll
          for (int j = 0; j < 4; ++j) { la[j] += gv * w0[j]; la[4 + j] += gv * w1[j]; } }
#pragma unroll
      for (int j = 0; j < 8; ++j) la[j] = fast_logsig2(la[j]) * (1.f / 16.f); }
    const u32x4 qv = *(const u32x4*)(QKV + (size_t)((fx::P_GQ >> 6) + h) * fx::QSLAB + (row0 + t) * 64 + d0);
    const u32x4 kv = *(const u32x4*)(QKV + (size_t)((fx::P_GK >> 6) + h) * fx::QSLAB + (row0 + t) * 64 + d0);
    const u32x4 vv0 = *(const u32x4*)(QKV + (size_t)((fx::P_GV >> 6) + 2 * h + (oc >> 2)) * fx::QSLAB + (row0 + t) * 64 + (oc & 3) * 16);
    const u32x4 vv1 = *(const u32x4*)(QKV + (size_t)((fx::P_GV >> 6) + 2 * h + (oc >> 2)) * fx::QSLAB + (row0 + t) * 64 + (oc & 3) * 16 + 8);
#pragma unroll
    for (int off = 8; off < 64; off <<= 1) {
#pragma unroll
        for (int j = 0; j < 8; ++j) { const float o = __shfl_up(la[j], off); if (lane >= off) la[j] += o; } }
    if (lane >= 56) {
#pragma unroll
        for (int j = 0; j < 8; ++j) WT[wid * 64 + d0 + j] = la[j]; }
    __syncthreads();
    float bl[8];
#pragma unroll
    for (int j = 0; j < 8; ++j) bl[j] = 0.f;
#pragma unroll
    for (int w = 0; w < 8; ++w) {
        const f32x4 a0 = *(const f32x4*)(WT + w * 64 + d0), a1 = *(const f32x4*)(WT + w * 64 + d0 + 4);
#pragma unroll
        for (int j = 0; j < 4; ++j) { bl[j] += a0[j]; bl[4 + j] += a1[j]; if (w < wid) { la[j] += a0[j]; la[4 + j] += a1[j]; } } }
    {
        const unsigned qw[4] = {qv.x, qv.y, qv.z, qv.w}, kw[4] = {kv.x, kv.y, kv.z, kv.w};
        float qf[8], kf[8];
#pragma unroll
        for (int i = 0; i < 4; ++i) { qf[2 * i] = bflo(qw[i]); qf[2 * i + 1] = bfhi(qw[i]); kf[2 * i] = bflo(kw[i]); kf[2 * i + 1] = bfhi(kw[i]); }
        float qp[8], kp[8], kpp[8];
#pragma unroll
        for (int j = 0; j < 8; ++j) { const float bb = la[j], bbl = bl[j];
            qp[j] = qf[j] * (0.125f * __builtin_amdgcn_exp2f(bb)); kp[j] = kf[j] * __builtin_amdgcn_exp2f(-bb); kpp[j] = kf[j] * __builtin_amdgcn_exp2f(bbl - bb); }
        u32x4 qo, ko; qo.x = pkbf(qp[0], qp[1]); qo.y = pkbf(qp[2], qp[3]); qo.z = pkbf(qp[4], qp[5]); qo.w = pkbf(qp[6], qp[7]);
        ko.x = pkbf(kp[0], kp[1]); ko.y = pkbf(kp[2], kp[3]); ko.z = pkbf(kp[4], kp[5]); ko.w = pkbf(kp[6], kp[7]);
        *(u32x4*)(QP + t * LS + d0) = qo; *(u32x4*)(KP + t * LS + d0) = ko;
        *(u32x4*)(QPG + (size_t)unit * QPG_B + (size_t)(t * 64 + d0) * 2) = qo;
#pragma unroll
        for (int j = 0; j < 8; ++j) KPT[(d0 + j) * LS + t] = (bf16)(pkbf(kpp[j], 0.f) & 0xffffu);
        const unsigned vw[8] = {vv0.x, vv0.y, vv0.z, vv0.w, vv1.x, vv1.y, vv1.z, vv1.w};
#pragma unroll
        for (int i = 0; i < 8; ++i) { VT[(oc * 16 + 2 * i) * LS + t] = (bf16)(vw[i] & 0xffffu); VT[(oc * 16 + 2 * i + 1) * LS + t] = (bf16)(vw[i] >> 16); }
        if (t == 0) {
#pragma unroll
            for (int j = 0; j < 8; ++j) { const float dc = __builtin_amdgcn_exp2f(bl[j]); DEC[(size_t)unit * 64 + d0 + j] = dc; ((float*)(lds + L_DECS))[d0 + j] = dc; } }
    }
    __syncthreads();
    { const int ti = wid >> 1;
#pragma unroll
      for (int q2 = 0; q2 < 2; ++q2) { const int sj = 2 * (wid & 1) + q2;
          f32x4 acc = {0.f, 0.f, 0.f, 0.f};
          if (sj <= ti) {
#pragma unroll
              for (int ks = 0; ks < 2; ++ks) { const bf16x8 a = *(const bf16x8*)(QP + (16 * ti + l15) * LS + 32 * ks + 8 * g), bb = *(const bf16x8*)(KP + (16 * sj + l15) * LS + 32 * ks + 8 * g);
                  acc = __builtin_amdgcn_mfma_f32_16x16x32_bf16(a, bb, acc, 0, 0, 0); }
              if (sj == ti) {
#pragma unroll
                  for (int r = 0; r < 4; ++r) if (l15 > 4 * g + r) acc[r] = 0.f; }
          }
#pragma unroll
          for (int r = 0; r < 4; ++r) PP[(16 * ti + 4 * g + r) * LS + 16 * sj + l15] = (bf16)(pkbf(acc[r], 0.f) & 0xffffu);
      } }
    __syncthreads();
    { bf16x8 vb[2];
#pragma unroll
      for (int ks = 0; ks < 2; ++ks) vb[ks] = *(const bf16x8*)(VT + (16 * wid + l15) * LS + 32 * ks + 8 * g);
#pragma unroll
      for (int mp = 0; mp < 2; ++mp) { u32x4 pw;
#pragma unroll
          for (int mh = 0; mh < 2; ++mh) { const int m = 2 * mp + mh; f32x4 acc = {0.f, 0.f, 0.f, 0.f};
#pragma unroll
              for (int ks = 0; ks < 2; ++ks) { const bf16x8 a = *(const bf16x8*)(PP + (16 * m + l15) * LS + 32 * ks + 8 * g); acc = __builtin_amdgcn_mfma_f32_16x16x32_bf16(a, vb[ks], acc, 0, 0, 0); }
              if (mh == 0) { pw.x = pkbf(acc[0], acc[1]); pw.y = pkbf(acc[2], acc[3]); } else { pw.z = pkbf(acc[0], acc[1]); pw.w = pkbf(acc[2], acc[3]); } }
          *(u32x4*)(OI + (size_t)unit * OIH_B + (size_t)((wid * 2 + mp) * 64 + lane) * 16) = pw; }
      u32x4 pu;
#pragma unroll
      for (int db = 0; db < 4; ++db) { f32x4 acc = {0.f, 0.f, 0.f, 0.f};
#pragma unroll
          for (int ks = 0; ks < 2; ++ks) { const bf16x8 a = *(const bf16x8*)(KPT + (16 * db + l15) * LS + 32 * ks + 8 * g); acc = __builtin_amdgcn_mfma_f32_16x16x32_bf16(a, vb[ks], acc, 0, 0, 0); }
          if ((db & 1) == 0) { pu.x = pkbf(acc[0], acc[1]); pu.y = pkbf(acc[2], acc[3]); } else { pu.z = pkbf(acc[0], acc[1]); pu.w = pkbf(acc[2], acc[3]); *(u32x4*)(UU + (size_t)unit * OIH_B + (size_t)((wid * 2 + (db >> 1)) * 64 + lane) * 16) = pu; }
          const f32x4 dcv = *(const f32x4*)((const float*)(lds + L_DECS) + 16 * db + 4 * g);
          Sagg[db] = dcv * Sagg[db] + acc; Dagg[db] = Dagg[db] * dcv; }
    }
}


__device__ __forceinline__ void prep_block(int blk, const bf16* QKV, const float* FG, const float* __restrict__ wgu, const float* __restrict__ bgate,
                                           unsigned char* QPG, unsigned char* OI, unsigned char* UU, float* DEC, unsigned char* AGG, float* DAGG, unsigned char* lds, int& cur_h) {
    f32x4 Sagg[4], Dagg[4];
#pragma unroll
    for (int db = 0; db < 4; ++db) { Sagg[db] = (f32x4){0.f, 0.f, 0.f, 0.f}; Dagg[db] = (f32x4){1.f, 1.f, 1.f, 1.f}; }
    for (int i = 0; i < 8; ++i) prep_unit(blk * 8 + i, QKV, FG, wgu, bgate, QPG, OI, UU, DEC, lds, cur_h, Sagg, Dagg);
    int tid_ = threadIdx.x; asm volatile("" : "+v"(tid_));
    const int lane = tid_ & 63, wid = __builtin_amdgcn_readfirstlane(tid_ >> 6), l15 = lane & 15, g = lane >> 4;
#pragma unroll
    for (int db = 0; db < 4; ++db) { *(f32x4*)(AGG + (size_t)blk * UU_B + (size_t)((wid * 4 + db) * 64 + lane) * 16) = Sagg[db];
        if (wid == 0 && l15 == 0) *(f32x4*)(DAGG + (size_t)blk * 64 + 16 * db + 4 * g) = Dagg[db]; }
}
constexpr int GS = 136;
constexpr int PO_GR = 0, PO_YT = 64 * GS * 2, PO_PART = 2 * 64 * GS * 2, PO_ST = PO_PART + 8 * 64 * 4, PO_END = PO_ST + 128 * LS * 2;
__device__ __forceinline__ void post_block(int u0, int NB, const bf16* QKV, const unsigned char* QPG, const unsigned char* OI, const unsigned char* UU, const float* DEC, const unsigned char* AGG, const float* DAGG, const float* __restrict__ gnorm, bf16* Y, unsigned char* lds) {
    int tid_ = threadIdx.x; asm volatile("" : "+v"(tid_));
    const int tid = tid_, lane = tid & 63, wid = __builtin_amdgcn_readfirstlane(tid >> 6), l15 = lane & 15, g = lane >> 4;
    const int n0 = u0 % NCH, bh = u0 / NCH, h = bh % GH, b = bh / GH;
    bf16* GRs = (bf16*)(lds + PO_GR); bf16* YT = (bf16*)(lds + PO_YT); float* PART = (float*)(lds + PO_PART); bf16* ST = (bf16*)(lds + PO_ST);
    const int t = tid >> 3, oc = tid & 7, e = 16 * wid + l15;
    const float gn = gnorm[e];
    f32x4 Sa[4];
#pragma unroll
    for (int db = 0; db < 4; ++db) Sa[db] = (f32x4){0.f, 0.f, 0.f, 0.f};
    { const int seg0 = bh * (NCH / 8), nseg = n0 / 8;
      for (int i = 0; i < nseg; ++i) {
          f32x4 Ua[4], Da[4];
#pragma unroll
          for (int db = 0; db < 4; ++db) { Ua[db] = *(const f32x4*)(AGG + (size_t)(seg0 + i) * UU_B + (size_t)((wid * 4 + db) * 64 + lane) * 16); Da[db] = *(const f32x4*)(DAGG + (size_t)(seg0 + i) * 64 + 16 * db + 4 * g); }
#pragma unroll
          for (int db = 0; db < 4; ++db) Sa[db] = Da[db] * Sa[db] + Ua[db]; } }
    for (int i = 0; i < NB; ++i) {
        const int unit = u0 + i; const size_t row0 = (size_t)b * S + (size_t)(n0 + i) * 64;
        const u32x4 g0 = *(const u32x4*)(QKV + (size_t)((fx::P_GR >> 6) + 2 * h + (oc >> 2)) * fx::QSLAB + (row0 + t) * 64 + (oc & 3) * 16), g1 = *(const u32x4*)(QKV + (size_t)((fx::P_GR >> 6) + 2 * h + (oc >> 2)) * fx::QSLAB + (row0 + t) * 64 + (oc & 3) * 16 + 8);
        f32x4 o[4], Uf[4], dv[4]; bf16x8 qa[4][2], sb[2];
#pragma unroll
        for (int mp = 0; mp < 2; ++mp) { const u32x4 ow = *(const u32x4*)(OI + (size_t)unit * OIH_B + (size_t)((wid * 2 + mp) * 64 + lane) * 16), uw = *(const u32x4*)(UU + (size_t)unit * OIH_B + (size_t)((wid * 2 + mp) * 64 + lane) * 16);
            o[2 * mp] = (f32x4){__builtin_bit_cast(float, ow.x << 16), __builtin_bit_cast(float, ow.x & 0xffff0000u), __builtin_bit_cast(float, ow.y << 16), __builtin_bit_cast(float, ow.y & 0xffff0000u)};
            o[2 * mp + 1] = (f32x4){__builtin_bit_cast(float, ow.z << 16), __builtin_bit_cast(float, ow.z & 0xffff0000u), __builtin_bit_cast(float, ow.w << 16), __builtin_bit_cast(float, ow.w & 0xffff0000u)};
            Uf[2 * mp] = (f32x4){__builtin_bit_cast(float, uw.x << 16), __builtin_bit_cast(float, uw.x & 0xffff0000u), __builtin_bit_cast(float, uw.y << 16), __builtin_bit_cast(float, uw.y & 0xffff0000u)};
            Uf[2 * mp + 1] = (f32x4){__builtin_bit_cast(float, uw.z << 16), __builtin_bit_cast(float, uw.z & 0xffff0000u), __builtin_bit_cast(float, uw.w << 16), __builtin_bit_cast(float, uw.w & 0xffff0000u)}; }
#pragma unroll
        for (int m = 0; m < 4; ++m) { dv[m] = *(const f32x4*)(DEC + (size_t)unit * 64 + 16 * m + 4 * g);
#pragma unroll
            for (int ks = 0; ks < 2; ++ks) qa[m][ks] = *(const bf16x8*)(QPG + (size_t)unit * QPG_B + (size_t)((16 * m + l15) * 64 + 32 * ks + 8 * g) * 2); }
#pragma unroll
        for (int db = 0; db < 4; ++db) *(u32x2*)(ST + e * LS + 16 * db + 4 * g) = (u32x2){pkbf(Sa[db][0], Sa[db][1]), pkbf(Sa[db][2], Sa[db][3])};
#pragma unroll
        for (int ks = 0; ks < 2; ++ks) sb[ks] = *(const bf16x8*)(ST + e * LS + 32 * ks + 8 * g);
        *(u32x4*)(GRs + t * GS + oc * 16) = g0; *(u32x4*)(GRs + t * GS + oc * 16 + 8) = g1;
#pragma unroll
        for (int m = 0; m < 4; ++m)
#pragma unroll
            for (int ks = 0; ks < 2; ++ks) o[m] = __builtin_amdgcn_mfma_f32_16x16x32_bf16(qa[m][ks], sb[ks], o[m], 0, 0, 0);
#pragma unroll
        for (int m = 0; m < 4; ++m) { f32x4 q = o[m] * o[m];
#pragma unroll
            for (int j = 0; j < 4; ++j) { float x = q[j]; x += dpp_f<0xB1>(x); x += dpp_f<0x4E>(x); x += dpp_f<0x141>(x); x += dpp_f<0x140>(x); q[j] = x; }
            if (l15 == 0) *(f32x4*)(PART + wid * 64 + 16 * m + 4 * g) = q; }
#pragma unroll
        for (int db = 0; db < 4; ++db) Sa[db] = dv[db] * Sa[db] + Uf[db];
        __syncthreads();
#pragma unroll
        for (int m = 0; m < 4; ++m) { f32x4 tot = {0.f, 0.f, 0.f, 0.f};
#pragma unroll
            for (int w = 0; w < 8; ++w) tot += *(const f32x4*)(PART + w * 64 + 16 * m + 4 * g);
#pragma unroll
            for (int r = 0; r < 4; ++r) { const int tt = 16 * m + 4 * g + r; const float rs = rsqrtf(tot[r] * (1.f / GV) + LN_EPS); const float gr = bf2f(GRs[tt * GS + e]);
                const float v = o[m][r] * rs * gn * (gr * __builtin_amdgcn_rcpf(1.f + __builtin_amdgcn_exp2f(-1.4426950408889634f * gr)));
                YT[tt * GS + e] = (bf16)(pkbf(v, 0.f) & 0xffffu); } }
        __syncthreads();
        { const u32x4 y0 = *(const u32x4*)(YT + t * GS + oc * 16), y1 = *(const u32x4*)(YT + t * GS + oc * 16 + 8);
          bf16* yp = Y + ((row0 + t) >> 8) * 262144 + (size_t)(8 + 2 * h + (oc >> 2)) * 16384 + ((row0 + t) & 255) * 64 + (oc & 3) * 16;
          *(u32x4*)yp = y0; *(u32x4*)(yp + 8) = y1; }
        __syncthreads();
    }
}
}
namespace mo {
using namespace nv;
typedef unsigned short bf16;
typedef float f32x4 __attribute__((ext_vector_type(4)));
typedef unsigned u32x4 __attribute__((ext_vector_type(4)));
constexpr int CAP = 8192;
constexpr int NEX = NE + 1;
constexpr int YSH = T * TOPK;
constexpr int L_TB = 132096, L_YB = L_TB + 1040, L_CN = L_YB + 1040, L_UT = 138240, L_RG = 141312;
typedef LAS int* lint;


constexpr int I_EG = NEX * 256, I_ED = NEX * 128, I_EXP = I_EG + I_ED;
struct ExpW { const float* eg; const float* eu; const float* ed; const float* sg; const float* su; const float* sd; bf16* WegT; bf16* WedT; };
__device__ __forceinline__ void cv_decode(int r, const ExpW& X, fx::CvItem& I) {
    if (r < I_EG) { const int e = r >> 8, kb = ((r >> 5) & 7) * 2 + (r & 1), nb = (r >> 1) & 15, c = nb >> 3, sub = nb & 7;
        I.W = (e < NE) ? ((sub < 4 ? X.eg : X.eu) + (size_t)e * D * ED) : (sub < 4 ? X.sg : X.su); I.WT = (bf16*)((unsigned char*)X.WegT + (size_t)(2 * e + c) * 262144 + (size_t)(kb >> 1) * 32768 + (size_t)(32 * sub) * 128 + 64 * (kb & 1)); I.N = ED; I.K = 64; I.k0 = 64 * kb; I.n0 = 32 * sub; I.s0 = 128 * c + 32 * (sub & 3); I.q8 = 1; }
    else { r -= I_EG; const int e = r >> 7, kb = ((r >> 6) & 1) * 2 + (r & 1), nb = (r >> 1) & 31; I.W = (e < NE) ? (X.ed + (size_t)e * ED * D) : X.sd; I.WT = (bf16*)((unsigned char*)X.WedT + (size_t)(4 * e + (nb >> 3)) * 65536 + (size_t)(kb >> 1) * 32768 + (size_t)(32 * (nb & 7)) * 128 + 64 * (kb & 1)); I.N = D; I.K = 64; I.k0 = 64 * kb; I.n0 = 32 * (nb & 7); I.s0 = 32 * nb; I.q8 = 1; }
}
__device__ __forceinline__ void expert_conv(const ExpW& X, LAS float* scr, int it0, int step, int it_end, int lane) {
    int it = it0; fx::CvItem cur, nx; fx::f32x4 v[8], w[8];
    if (it < it_end) { cv_decode(it, X, cur); fx::cv_load(cur, v, lane); }
    while (it < it_end) { const int itn = it + step; if (itn < it_end) { cv_decode(itn, X, nx); fx::cv_load(nx, w, lane); }
        if (cur.q8) fx::cv_finish8(cur, v, scr, lane); else fx::cv_finish(cur, v, scr, lane); cur = nx;
#pragma unroll
        for (int i = 0; i < 8; ++i) v[i] = w[i];
        it = itn; }
}

__device__ __forceinline__ void moe_tables(const int* counts, lint tb, lint yb, lint cn, int lane) {
    int c[4], nt[4]; int st = 0, sy = 0, pt[4], py[4];
#pragma unroll
    for (int i = 0; i < 4; ++i) { c[i] = counts[lane * 4 + i]; c[i] = c[i] > CAP ? CAP : c[i]; nt[i] = (c[i] + 255) >> 8; pt[i] = st; py[i] = sy; st += nt[i]; sy += c[i]; }
    int it = st, iy = sy;
    for (int o = 1; o < 64; o <<= 1) { const int a = __shfl_up(it, o), b = __shfl_up(iy, o); if (lane >= o) { it += a; iy += b; } }
    const int bt = it - st, by = iy - sy;
#pragma unroll
    for (int i = 0; i < 4; ++i) { tb[lane * 4 + i] = bt + pt[i]; yb[lane * 4 + i] = by + py[i]; cn[lane * 4 + i] = c[i]; }
    if (lane == 63) { tb[256] = it; tb[257] = it + T / 256; yb[256] = YSH; cn[256] = T; }
}

template <int CTRL> __device__ __forceinline__ float dppf(float x) { return __builtin_bit_cast(float, __builtin_amdgcn_update_dpp(0, __builtin_bit_cast(int, x), CTRL, 0xf, 0xf, true)); }
__device__ __forceinline__ float rlf(float x, int l) { return __builtin_bit_cast(float, __builtin_amdgcn_readlane(__builtin_bit_cast(int, x), l)); }
__device__ __forceinline__ double mkd(unsigned lo, unsigned hi) { return __builtin_bit_cast(double, ((unsigned long long)hi << 32) | lo); }
__device__ __forceinline__ double maxd(double a, double b) { double r; asm("v_max_f64 %0, %1, %2" : "=v"(r) : "v"(a), "v"(b)); return r; }
template <int CTRL> __device__ __forceinline__ double dppd(double x) { const unsigned long long u = __builtin_bit_cast(unsigned long long, x);
    return mkd((unsigned)__builtin_amdgcn_update_dpp(0, (int)(unsigned)u, CTRL, 0xf, 0xf, true), (unsigned)__builtin_amdgcn_update_dpp(0, (int)(unsigned)(u >> 32), CTRL, 0xf, 0xf, true)); }
__device__ __forceinline__ double rowpair_max(double x) {
    const unsigned long long u = __builtin_bit_cast(unsigned long long, x);
    const auto a = __builtin_amdgcn_permlane16_swap((unsigned)u, (unsigned)u, false, false); const auto b = __builtin_amdgcn_permlane16_swap((unsigned)(u >> 32), (unsigned)(u >> 32), false, false);
    return maxd(mkd(a[0], b[0]), mkd(a[1], b[1])); }
__device__ __forceinline__ void route_token2(const LAS float* L, int tl0, const float* __restrict__ rbias, int* lcnt, LAS float* scs, int* TK, float* TW, int t0, int lane) {
    const int l32 = lane & 31, t = t0 + (lane >> 5), tl = tl0 + (lane >> 5); const bool hiH = lane >= 32;
    const f32x4 la4 = *(const LAS f32x4*)(L + tl * 256 + (((2 * l32) ^ (tl & 63)) << 2)), lb4 = *(const LAS f32x4*)(L + tl * 256 + (((2 * l32 + 1) ^ (tl & 63)) << 2));
    const float4 la = {la4[0], la4[1], la4[2], la4[3]}, lb = {lb4[0], lb4[1], lb4[2], lb4[3]};
    const float4 ra = ((const float4*)rbias)[2 * l32], rb = ((const float4*)rbias)[2 * l32 + 1];
    const float lg[8] = {la.x, la.y, la.z, la.w, lb.x, lb.y, lb.z, lb.w}, rbv[8] = {ra.x, ra.y, ra.z, ra.w, rb.x, rb.y, rb.z, rb.w};
    float sc[8], bv[8];
#pragma unroll
    for (int i = 0; i < 8; ++i) { sc[i] = __builtin_amdgcn_rcpf(1.f + __builtin_amdgcn_exp2f(-1.4426950408889634f * lg[i])); bv[i] = sc[i] + rbv[i]; }
    float m1 = fmaxf(bv[0], bv[1]), m2 = fminf(bv[0], bv[1]);
#pragma unroll
    for (int i = 2; i < 8; ++i) { const float n1 = fmaxf(m1, bv[i]); m2 = fmaxf(fminf(m1, bv[i]), m2); m1 = n1; }
    { const float p1 = dppf<0xB1>(m1), p2 = dppf<0xB1>(m2); const float n1 = fmaxf(m1, p1); m2 = fmaxf(fminf(m1, p1), fmaxf(m2, p2)); m1 = n1; }
    { const float p1 = dppf<0x4E>(m1), p2 = dppf<0x4E>(m2); const float n1 = fmaxf(m1, p1); m2 = fmaxf(fminf(m1, p1), fmaxf(m2, p2)); m1 = n1; }
    const float gs = m1 + m2;
    const int myg = l32 >> 2;
    int rank = 0;
#pragma unroll
    for (int g2 = 0; g2 < NG; ++g2) { const float oa = rlf(gs, g2 * 4), ob = rlf(gs, 32 + g2 * 4); const float og = hiH ? ob : oa; if (og > gs || (og == gs && g2 < myg)) ++rank; }
    const bool sel = rank < 4;
    unsigned klo[8], khi[8];
#pragma unroll
    for (int i = 0; i < 8; ++i) { const unsigned long long u = __builtin_bit_cast(unsigned long long, (double)bv[i]); const unsigned h = (unsigned)(u >> 32), eid = (unsigned)(l32 * 8 + i);
        klo[i] = (unsigned)u | ((h >> 31) ? eid : 255u - eid); khi[i] = sel ? h : 0xFFE00000u; }
    { f32x4 s0, s1; s0[0] = sc[0]; s0[1] = sc[1]; s0[2] = sc[2]; s0[3] = sc[3]; s1[0] = sc[4]; s1[1] = sc[5]; s1[2] = sc[6]; s1[3] = sc[7];
      *(LAS f32x4*)(scs + lane * 8) = s0; *(LAS f32x4*)(scs + lane * 8 + 4) = s1; }
    unsigned mlo = 0u, mhi = 0u;
#pragma unroll
    for (int k = 0; k < TOPK; ++k) {
        double am = maxd(maxd(maxd(mkd(klo[0], khi[0]), mkd(klo[1], khi[1])), maxd(mkd(klo[2], khi[2]), mkd(klo[3], khi[3]))), maxd(maxd(mkd(klo[4], khi[4]), mkd(klo[5], khi[5])), maxd(mkd(klo[6], khi[6]), mkd(klo[7], khi[7]))));
        am = maxd(am, dppd<0xB1>(am)); am = maxd(am, dppd<0x4E>(am)); am = maxd(am, dppd<0x141>(am)); am = maxd(am, dppd<0x140>(am));
        am = rowpair_max(am);
#pragma unroll
        for (int i = 0; i < 8; ++i) khi[i] = (mkd(klo[i], khi[i]) == am) ? 0xFFE00000u : khi[i];
        const unsigned long long ua = __builtin_bit_cast(unsigned long long, am);
        if (l32 == k) { mlo = (unsigned)ua; mhi = (unsigned)(ua >> 32); }
    }
    const int mye = (int)((mhi >> 31) ? (mlo & 255u) : 255u - (mlo & 255u));
    const float myw = scs[(lane & 32) * 8 + mye];
    float wsum = myw + dppf<0xB1>(myw); wsum += dppf<0x4E>(wsum); wsum += dppf<0x141>(wsum);
    if (l32 < TOPK) { const int lp = atomicAdd(&lcnt[mye], 1); TK[t * TOPK + l32] = mye | (lp << 9); TW[t * TOPK + l32] = myw * (2.5f / wsum); }
}
__device__ __forceinline__ void route_finish2(const int* lbase, int* list_tok, float* list_gate, int* TK, const float* TW, int t0, int lane) {
    const int l32 = lane & 31, t = t0 + (lane >> 5);
    if (l32 < TOPK) { const int tk = TK[t * TOPK + l32]; const int e = tk & 511, pos = lbase[e] + (tk >> 9);
        if (pos < CAP) { list_tok[e * CAP + pos] = t; list_gate[e * CAP + pos] = TW[t * TOPK + l32]; }
        TK[t * TOPK + l32] = e | (pos << 9); }
}
__device__ __forceinline__ void route_finish8(const int* lbase, int* list_tok, float* list_gate, int* TK, const float* TW, int t0, int lane) {
    const int l32 = lane & 31; const bool act = l32 < TOPK; int tk[8]; float tw[8];
#pragma unroll
    for (int i = 0; i < 8; ++i) { const int t = t0 + 16 * i + (lane >> 5); tk[i] = act ? TK[t * TOPK + l32] : 0; tw[i] = act ? TW[t * TOPK + l32] : 0.f; }
#pragma unroll
    for (int i = 0; i < 8; ++i) { const int t = t0 + 16 * i + (lane >> 5);
        if (act) { const int e = tk[i] & 511, pos = lbase[e] + (tk[i] >> 9);
            if (pos < CAP) { list_tok[e * CAP + pos] = t; list_gate[e * CAP + pos] = tw[i]; }
            TK[t * TOPK + l32] = e | (pos << 9); } }
}

constexpr float YSC = 16.f;
__device__ __forceinline__ void combine_token(const bf16* H1, const unsigned char* Y, const int* TK, lint yb, const float* __restrict__ g, const float* __restrict__ b, float* out, int t, int lane) {
    typedef float f2 __attribute__((ext_vector_type(2)));
    float v[16], s[16];
    { const u32x4 a = *(const u32x4*)(H1 + (size_t)t * D + 16 * lane), c = *(const u32x4*)(H1 + (size_t)t * D + 16 * lane + 8);
      const unsigned w[8] = {a.x, a.y, a.z, a.w, c.x, c.y, c.z, c.w};
#pragma unroll
      for (int i = 0; i < 8; ++i) { v[2 * i] = ALPHA * __builtin_bit_cast(float, w[i] << 16); v[2 * i + 1] = ALPHA * __builtin_bit_cast(float, w[i] & 0xffff0000u); } }
#pragma unroll
    for (int i = 0; i < 16; ++i) s[i] = 0.f;
    int tk = (lane < TOPK) ? TK[t * TOPK + lane] : 0;
#pragma unroll
    for (int k = 0; k <= TOPK; ++k) {
        size_t yrow;
        if (k < TOPK) { const int x = __shfl(tk, k); yrow = (size_t)(yb[x & 511] + (x >> 9)); } else yrow = (size_t)YSH + t;
        const u32x4 a = __builtin_nontemporal_load((const u32x4*)(Y + yrow * D + 16 * lane));
        const int w[4] = {(int)a.x, (int)a.y, (int)a.z, (int)a.w};
#pragma unroll
        for (int i = 0; i < 4; ++i) { const f2 lo = __builtin_amdgcn_cvt_pk_f32_fp8(w[i], false), hi = __builtin_amdgcn_cvt_pk_f32_fp8(w[i], true);
            s[4 * i] += lo[0]; s[4 * i + 1] += lo[1]; s[4 * i + 2] += hi[0]; s[4 * i + 3] += hi[1]; }
    }
    float sm = 0.f;
#pragma unroll
    for (int i = 0; i < 16; ++i) { v[i] += s[i] * (1.f / YSC); sm += v[i]; }
    const float mean = fx::wave_sum(sm) * (1.f / D); float q = 0.f;
#pragma unroll
    for (int i = 0; i < 16; ++i) { v[i] -= mean; q += v[i] * v[i]; }
    const float rstd = 1.f / sqrtf(fx::wave_sum(q) * (1.f / D) + LN_EPS);
#pragma unroll
    for (int i = 0; i < 4; ++i) { const f32x4 gg = *(const f32x4*)(g + 16 * lane + 4 * i), bb = *(const f32x4*)(b + 16 * lane + 4 * i);
        f32x4 o; o[0] = v[4 * i] * rstd * gg[0] + bb[0]; o[1] = v[4 * i + 1] * rstd * gg[1] + bb[1]; o[2] = v[4 * i + 2] * rstd * gg[2] + bb[2]; o[3] = v[4 * i + 3] * rstd * gg[3] + bb[3];
        *(f32x4*)(out + (size_t)t * D + 16 * lane + 4 * i) = o; }
}
}

namespace pg8 {
struct RouterSched {
    int rb; const bf16_t* Bt;
    __device__ __forceinline__ bool next(int i, Unit2& u) const { if (i > 0) return false; u.pm = rb; u.pn = 0; u.e = 0; u.cnt = 128; u.jt = 0; u.ui = 0; return true; }
    __device__ __forceinline__ int arow(const Unit2& u, int r) const { return u.pm * 128 + r; }
    __device__ __forceinline__ size_t aoff(const Unit2&) const { return 0; }
    __device__ __forceinline__ const char* bptr(const Unit2&) const { return (const char*)Bt; }
};
struct EpiLogits {
    static constexpr bool PERM = false, AFTER_DRAIN = true;
    LAS float* L;
    __device__ __forceinline__ void operator()(const f32x4 (&acc)[2][2][4][2], const Unit2& u, int wr, int wc, int fr, int fq) const {
#pragma unroll
        for (int m = 0; m < 4; ++m) { const int row = wr * 64 + m * 16 + fr;
#pragma unroll
            for (int bj = 0; bj < 2; ++bj)
#pragma unroll
                for (int n = 0; n < 2; ++n) { const int c4 = wc * 8 + fq + bj * 32 + n * 4; *(LAS f32x4*)(L + row * 256 + ((c4 ^ (row & 63)) << 2)) = acc[0][bj][m][n]; } }
    }
};
template <int PH> struct MoeSched {
    int G, vcu, nrt; mo::lint tb; mo::lint cn; const int* list_tok; const bf16_t* W; mo::lint ut; mo::lint rg;
    static constexpr int NC = PH == 0 ? 2 : 4;
    static constexpr bool FP8 = true;
    static constexpr int MAXU = 64;
    __device__ __forceinline__ void build(int lane) const {
        const int L = lane * G + vcu;
        if (lane < MAXU && L < nrt * NC) {
            const int rt = L / NC, c = L % NC;
            int lo = 0, hi = 256;
            while (lo < hi) { const int mid = (lo + hi + 1) >> 1; if (tb[mid] <= rt) lo = mid; else hi = mid - 1; }
            const int e = lo, jt = rt - tb[e], rem = cn[e] - 256 * jt;
            ut[4 * lane] = rt; ut[4 * lane + 1] = c; ut[4 * lane + 2] = e | (jt << 9); ut[4 * lane + 3] = rem < 256 ? rem : 256;
        }
    }
    __device__ __forceinline__ bool next(int i, Unit2& u) const {
        const int L = i * G + vcu; if (i >= MAXU || L >= nrt * NC) return false;
        const int x = ut[4 * i + 2];
        u.pm = __builtin_amdgcn_readfirstlane(ut[4 * i]); u.pn = __builtin_amdgcn_readfirstlane(ut[4 * i + 1]); u.e = __builtin_amdgcn_readfirstlane(x & 511); u.jt = __builtin_amdgcn_readfirstlane(x >> 9);
        u.cnt = __builtin_amdgcn_readfirstlane(ut[4 * i + 3]); u.ui = i; return true;
    }
    __device__ __forceinline__ void fill_rows(const float* list_gate, int tid) const {
        for (int i = 0; i < MAXU; ++i) { const int L = i * G + vcu; if (L >= nrt * NC) break;
            const int x = ut[4 * i + 2], e = x & 511, jt = x >> 9, cnt = ut[4 * i + 3];
            if (tid < 256) { const int r = tid; unsigned v;
                if (e == 256) v = (unsigned)(jt * BM + r) | (0x4180u << 16);
                else if (r < cnt) { const float gsc = mo::YSC * list_gate[e * mo::CAP + jt * BM + r]; v = (unsigned)list_tok[e * mo::CAP + jt * BM + r] | (fx::f2bf(gsc) << 16); }
                else v = 0u;
                rg[i * 256 + r] = (int)v; } }
    }
    __device__ __forceinline__ int arow(const Unit2& u, int r) const {
        if (PH == 1) return u.pm * BM + r;
        return rg[u.ui * 256 + r] & 0x7fff;
    }
    __device__ __forceinline__ size_t aoff(const Unit2& u) const { return PH == 1 ? (size_t)u.pm * (65536 - 32768) : 0; }
    __device__ __forceinline__ const char* bptr(const Unit2& u) const {
        return PH == 0 ? (const char*)W + (size_t)(2 * u.e + u.pn) * 262144 : (const char*)W + (size_t)(4 * u.e + u.pn) * 65536;
    }
};
struct EpiSwiGLU {
    static constexpr bool PERM = true, AFTER_DRAIN = false;
    bf16_t* H; mo::lint rg; int skip;
    __device__ __forceinline__ void operator()(const f32x4 (&acc)[2][2][4][2], const Unit2& u, int wr, int wc, int fr, int fq) const {
        if (skip) return;
        const int col0 = u.pn * 128 + wc * 32 + 8 * fq;
#pragma unroll
        for (int ai = 0; ai < 2; ++ai)
#pragma unroll
            for (int m = 0; m < 4; ++m) { const int r = ai * HALF + wr * 64 + m * 16 + fr;
                const float gt = __builtin_bit_cast(float, (unsigned)rg[u.ui * 256 + r] & 0xffff0000u) * (1.f / (fx::WSC8 * fx::WSC8));
                float hv[8];
#pragma unroll
                for (int n = 0; n < 2; ++n)
#pragma unroll
                    for (int i = 0; i < 4; ++i) { const float gg = acc[ai][0][m][n][i], uu = acc[ai][1][m][n][i];
                        hv[4 * n + i] = __builtin_amdgcn_fmed3f((gg * __builtin_amdgcn_rcpf(1.f + __builtin_amdgcn_exp2f((-1.4426950408889634f / fx::WSC8) * gg))) * (uu * gt), -448.f, 448.f); }
                typedef unsigned u32x2_ __attribute__((ext_vector_type(2))); u32x2_ w;
                { int x = __builtin_amdgcn_cvt_pk_fp8_f32(hv[0], hv[1], 0, false); x = __builtin_amdgcn_cvt_pk_fp8_f32(hv[2], hv[3], x, true); w.x = (unsigned)x;
                  x = __builtin_amdgcn_cvt_pk_fp8_f32(hv[4], hv[5], 0, false); x = __builtin_amdgcn_cvt_pk_fp8_f32(hv[6], hv[7], x, true); w.y = (unsigned)x; }
                *(u32x2_*)((unsigned char*)H + (size_t)u.pm * 65536 + (size_t)(col0 >> 7) * 32768 + r * 128 + (col0 & 127)) = w; }
    }
};
struct EpiDown {
    static constexpr bool PERM = true, PERM16 = true, AFTER_DRAIN = false;
    unsigned char* Y; mo::lint yb; int skip;
    __device__ __forceinline__ void operator()(const f32x4 (&acc)[2][2][4][2], const Unit2& u, int wr, int wc, int fr, int fq) const {
        if (skip) return;
        const int col0 = u.pn * BM + wc * 64 + 16 * fq; const int ybase = yb[u.e] + u.jt * BM;
#pragma unroll
        for (int ai = 0; ai < 2; ++ai)
#pragma unroll
            for (int m = 0; m < 4; ++m) { const int r = ai * HALF + wr * 64 + m * 16 + fr;
                if (r < u.cnt) { u32x4 w; unsigned ww[4];
#pragma unroll
                    for (int bj = 0; bj < 2; ++bj)
#pragma unroll
                        for (int n = 0; n < 2; ++n) { const f32x4 v = acc[ai][bj][m][n] * (1.f / fx::WSC8); int x = __builtin_amdgcn_cvt_pk_fp8_f32(v[0], v[1], 0, false); x = __builtin_amdgcn_cvt_pk_fp8_f32(v[2], v[3], x, true); ww[2 * bj + n] = (unsigned)x; }
                    w.x = ww[0]; w.y = ww[1]; w.z = ww[2]; w.w = ww[3];
                    *(u32x4*)(Y + (size_t)(ybase + r) * nv::D + col0) = w; } }
    }
};
}
constexpr int NTHR = 512;
constexpr int LDS_BYTES = 163840;
constexpr int MISC_OFF = 131072 + 320;
constexpr size_t MiB = 1u << 20;
constexpr size_t CTL_ZERO_BYTES = 96 * 1024;
constexpr int CW_BAR = 4096;
constexpr int CW_MOE = 16384;
constexpr int CW_FOXQ = 20992;
constexpr int CW_NRM = 20480;
constexpr int NPHASE = 9;
constexpr size_t WS_H1 = 1, WS_WR = 65, WS_STATS = 66, WS_LF = 67, WS_FG = 68, WS_WO = 72, WS_WIN = 74, WS_TK = 81, WS_LTOK = 83, WS_LGATE = 91,
                 WS_WED = 100, WS_HID = 230, WS_GLA = 230, WS_WEG = 416, WS_XN = 673, WS_YBF = 673, WS_QKV = 737, WS_Z1 = 737, WS_LG = 865, WS_Y = 416, WS_END = 992, WS_H1Q = 560;

struct Args { const float* in[21]; float* out; unsigned char* ws; int ph_lo, ph_hi, li, pad; };

__global__ void __launch_bounds__(NTHR, 2) mega_fwd(Args a) {
    using namespace nv;
    extern __shared__ __attribute__((aligned(16))) unsigned char lds[];
    const int G = gridDim.x, bx = blockIdx.x;
    const int vcu = (G % 8 == 0) ? (bx % 8) * (G / 8) + bx / 8 : bx;
    int tid, lane, wave, vw;
#define DERIVE() do { int t_ = threadIdx.x; asm volatile("" : "+v"(t_)); tid = t_; lane = tid & 63; wave = __builtin_amdgcn_readfirstlane(tid >> 6); vw = vcu * 8 + wave; } while (0)
    DERIVE();
    volatile LAS unsigned* MISC = (volatile LAS unsigned*)((LAS unsigned char*)lds + MISC_OFF);
    for (int u = tid; u < (LDS_BYTES - 131072) / 4; u += NTHR) ((LAS unsigned*)((LAS unsigned char*)lds + 131072))[u] = 0u;
    __syncthreads();
    unsigned char* ws = a.ws;
    unsigned* ctl = (unsigned*)ws;
    XcdBarrier bar = xcd_barrier_post(ctl + CW_BAR + a.li * XCD_BAR_WORDS, MISC + 8);
    const float* x = a.in[0];
    const float* ln_in_g = a.in[1]; const float* ln_in_b = a.in[2];
    const float* w_in = a.in[3]; const float* b_fgate = a.in[4];
    const float* w_gate_up = a.in[5]; const float* b_gate = a.in[6]; const float* g_gla = a.in[7];
    const float* w_out = a.in[8]; const float* ln1_g = a.in[9]; const float* ln1_b = a.in[10];
    const float* w_router = a.in[11]; const float* rbias = a.in[12];
    const float* w_eg = a.in[13]; const float* w_eu = a.in[14]; const float* w_ed = a.in[15];
    const float* w_sg = a.in[16]; const float* w_su = a.in[17]; const float* w_sd = a.in[18];
    const float* ln2_g = a.in[19]; const float* ln2_b = a.in[20];
    float* out = a.out;
    int* counts = (int*)(ctl + CW_MOE);
    fx::bf16* H1 = (fx::bf16*)(ws + WS_H1 * MiB);
    unsigned char* H1q = ws + WS_H1Q * MiB;
    fx::bf16* WrT = (fx::bf16*)(ws + WS_WR * MiB);
    float* stats = (float*)(ws + WS_STATS * MiB);
    float* LF = (float*)(ws + WS_LF * MiB);
    float* FG = (float*)(ws + WS_FG * MiB);
    fx::bf16* WoT = (fx::bf16*)(ws + WS_WO * MiB);
    fx::bf16* WinT = (fx::bf16*)(ws + WS_WIN * MiB);
    int* TK = (int*)(ws + WS_TK * MiB);
    float* TW = (float*)(ws + (WS_TK + 1) * MiB);
    int* list_tok = (int*)(ws + WS_LTOK * MiB);
    float* list_gate = (float*)(ws + WS_LGATE * MiB);
    fx::bf16* WedT = (fx::bf16*)(ws + WS_WED * MiB);
    fx::bf16* HID = (fx::bf16*)(ws + WS_HID * MiB);
    unsigned char* QPG = ws + WS_GLA * MiB; unsigned char* OIb = ws + (WS_GLA + 16) * MiB; unsigned char* UUb = ws + (WS_GLA + 80) * MiB; float* DECb = (float*)(ws + (WS_GLA + 144) * MiB); unsigned char* AGGb = ws + (WS_GLA + 145) * MiB; float* DAGGb = (float*)(ws + (WS_GLA + 153) * MiB);
    fx::bf16* WegT = (fx::bf16*)(ws + WS_WEG * MiB);
    fx::bf16* XN = (fx::bf16*)(ws + WS_XN * MiB);
    fx::bf16* Ybf = (fx::bf16*)(ws + WS_YBF * MiB);
    fx::bf16* QKV = (fx::bf16*)(ws + WS_QKV * MiB);
    fx::bf16* MIX = (fx::bf16*)(ws + WS_Z1 * MiB);
    float* LG = (float*)(ws + WS_LG * MiB);
    unsigned char* YA = ws + WS_Y * MiB;
    mo::lint tb = (mo::lint)((LAS unsigned char*)lds + mo::L_TB), yb = (mo::lint)((LAS unsigned char*)lds + mo::L_YB), cn = (mo::lint)((LAS unsigned char*)lds + mo::L_CN), ut = (mo::lint)((LAS unsigned char*)lds + mo::L_UT), rg = (mo::lint)((LAS unsigned char*)lds + mo::L_RG);

    const int lo = a.ph_lo, hi = a.ph_hi;
    bool tables_ready = false;
#define IN(k) (lo <= (k) && (k) < hi)
#define SEAM(k) do { if (IN(k) && IN((k) + 1)) xcd_barrier(bar); DERIVE(); } while (0)
    const int GW = G * 8;
#ifndef STG7
#define STG7 0
#endif
#ifndef STG8
#define STG8 0
#endif
#define STAGGER(q) do { if ((q) > 0) { const unsigned long long t0_ = __builtin_amdgcn_s_memrealtime(); const unsigned long long d_ = (unsigned long long)((vcu & 3) * (q)); while (__builtin_amdgcn_s_memrealtime() - t0_ < d_) __builtin_amdgcn_s_sleep(8); } } while (0)

    if (IN(0)) {
        LAS float* scr = (LAS float*)((LAS unsigned char*)lds + wave * 16384);
        constexpr int I_IN = 16 * (fx::NIN / 32), I_OUT = 16 * 32, I_R = 16 * 8, I_SMALL = I_IN + I_OUT + I_R;
        for (int it = vw; it < I_SMALL; it += GW) {
            int r = it;
            if (r < I_IN) { fx::transpose_item(w_in, D, INW, WinT, scr, r / (fx::NIN / 32), r % (fx::NIN / 32), lane, [](int d) { return fx::inproj_src(d); }); continue; } r -= I_IN;
            if (r < I_OUT) { fx::transpose_item(w_out, D, D, WoT, scr, r / 32, r % 32, lane, [](int d) { return d; }); continue; } r -= I_OUT;
            fx::transpose_item(w_router, D, NE, WrT, scr, r / 8, r % 8, lane, [](int d) { return d; });
        }
        for (int r = vw * 4; r < T; r += GW * 4) fx::ln_rows_bf16<4, true>(x + (size_t)r * D, ln_in_g, ln_in_b, XN + (size_t)(r >> 8) * 262144 + (size_t)(r & 255) * 64, lane, stats + 2 * (size_t)r);
    }
    SEAM(0);
    if (IN(1)) {
        const mo::ExpW XW{w_eg, w_eu, w_ed, w_sg, w_su, w_sd, WegT, WedT};
#ifndef MIXG
#define MIXG 2
#endif
        #ifndef SLOT_XCD
#define SLOT_XCD 0
#endif
        { const int slot = SLOT_XCD ? (bx & 7) % MIXG : vcu % MIXG; pg8::StaticOrder S; S.init(T, fx::NIN, G, bx);
          const int nun = (S.nwg - bx + G - 1) / G, nb = (MIXG > 1) ? nun * slot / (MIXG - 1) : nun;
          pg8::Gemm g{XN, WinT, T, fx::NIN, D, 64, 1};     pg8::EpiInProj E{QKV, FG, LF, b_fgate, ctl + CW_NRM};
          if (nb > 0) { pg8::RangeOrder R{S, 0, nb}; pg8::gemm_phase<pg8::EpiInProj, pg8::RangeOrder, true, true>((LAS unsigned char*)lds, g, R, E); DERIVE(); }
          { LAS float* scr = (LAS float*)((LAS unsigned char*)lds + wave * 16384);
            const int nmax = (S.nwg + G - 1) / G, nlight = G * nmax - S.nwg;
#ifndef CONV_SKEW
#define CONV_SKEW 0.18f
#endif
            const bool two = (CONV_SKEW != 0.0f) && nlight > 0 && nlight < G;
            const float sk = CONV_SKEW < 0.f ? -CONV_SKEW : CONV_SKEW;
            const int nsub = (CONV_SKEW > 0.f) ? nlight : G - nlight;
#ifndef SLOT_SKEW
#define SLOT_SKEW -0.1f
#endif
            const bool three = (SLOT_SKEW != 0.0f) && MIXG == 2 && !SLOT_XCD && (G % 16 == 0);
            const float ssk = SLOT_SKEW < 0.f ? -SLOT_SKEW : SLOT_SKEW;
            const int n2 = three ? mo::I_EXP - (int)(ssk * 0.5f * (float)mo::I_EXP) : mo::I_EXP;
            const int n1 = two ? n2 - (int)(sk * (float)mo::I_EXP * (float)nsub / (float)G) : n2;
            mo::expert_conv(XW, scr, vw, GW, n1, lane);
            const bool light = bx >= G - nlight;
            if (two && (light == (CONV_SKEW > 0.f))) { const int rank = light ? bx - (G - nlight) : bx; mo::expert_conv(XW, scr, n1 + rank * 8 + wave, nsub * 8, n2, lane); }
            if (three && ((slot == 0) == (SLOT_SKEW > 0.f))) { const int rank = (bx / 16) * 8 + (bx & 7); mo::expert_conv(XW, scr, n2 + rank * 8 + wave, (G / 2) * 8, mo::I_EXP, lane); } }
          __syncthreads(); DERIVE();
          if (nb < nun) { pg8::RangeOrder R{S, nb, nun - nb}; pg8::gemm_phase<pg8::EpiInProj, pg8::RangeOrder, true, true>((LAS unsigned char*)lds, g, R, E); } }
    }
    SEAM(1);
    if (IN(2)) {
        int cur_h = -1;
        for (int blk = vcu; blk < gl::NUNIT / 8; blk += G) gl::prep_block(blk, QKV, FG, w_gate_up, b_gate, QPG, OIb, UUb, DECb, AGGb, DAGGb, lds, cur_h);
    }
    SEAM(2);
    if (IN(3)) {
#ifndef POST_REP
#define POST_REP 1
#endif
        for (int rep = 0; rep < POST_REP; ++rep)
        for (int blk = vcu; blk < gl::NUNIT / 8; blk += G) gl::post_block(blk * 8, 8, QKV, QPG, OIb, UUb, DECb, AGGb, DAGGb, g_gla, Ybf, lds);
        { const attn_body::AttnTensors AT{(const attn_body::bf16*)(QKV + (fx::P_FQ >> 6) * fx::QSLAB), (const attn_body::bf16*)(QKV + (fx::P_FK >> 6) * fx::QSLAB), (const attn_body::bf16*)(QKV + (fx::P_FV >> 6) * fx::QSLAB), (attn_body::bf16*)Ybf, LF, ctl + CW_NRM};
          attn_body::attn_phase_dyn<8>((char*)lds, AT, ctl + CW_FOXQ, (volatile int*)(lds + 140288), (G % 8 == 0) ? vcu / (G / 8) : vcu % 8); }
    }
    SEAM(3);
    if (IN(4)) {
        pg8::DenseSched DS; DS.so.init(T, D, G, bx); DS.Bt = WoT; DS.ldb = D; DS.akt = 256 * D * 2;
        pg8::EpiPlainBf16 E{MIX, D};
        pg8::gemm_phase2<pg8::EpiPlainBf16, pg8::DenseSched>((LAS unsigned char*)lds, Ybf, 64, D, D, DS, E, 32768);
    }
    SEAM(4);
    if (IN(5)) {
        int* lcnt = (int*)(lds + 136192); int* lbase = lcnt + 256;
        for (int rb = vcu; rb < T / 128; rb += G) {
            if (tid < 256) lcnt[tid] = 0;
#ifndef P5_REP_LN
#define P5_REP_LN 1
#endif
#ifndef P5_REP_GEMM
#define P5_REP_GEMM 1
#endif
#ifndef P5_REP_ROUTE
#define P5_REP_ROUTE 1
#endif
            for (int rep = 0; rep < P5_REP_LN; ++rep) {
            for (int r = wave * 16; r < wave * 16 + 16; r += 4) { const size_t row = (size_t)rb * 128 + r;
                fx::ln1_rows_bf16<4>(x + row * D, stats + 2 * row, ln_in_g, ln_in_b, MIX + row * D, ln1_g, ln1_b, H1 + row * D, ALPHA, lane, H1q + row * D); }
            asm volatile("s_waitcnt vmcnt(0)" ::: "memory"); __syncthreads(); }
            for (int rep = 0; rep < P5_REP_GEMM; ++rep) {
            { pg8::RouterSched RS{rb, WrT}; pg8::EpiLogits E{(LAS float*)lds};
              pg8::gemm_phase2<pg8::EpiLogits, pg8::RouterSched>((LAS unsigned char*)lds, H1, D, D, D, RS, E); }
            __syncthreads(); DERIVE(); }
            for (int rep = 0; rep < P5_REP_ROUTE; ++rep) {
            if (rep > 0) { __syncthreads(); if (tid < 256) lcnt[tid] = 0; __syncthreads(); }
            for (int t = rb * 128 + wave * 2; t < rb * 128 + 128; t += 16) mo::route_token2((const LAS float*)lds, t - rb * 128, rbias, lcnt, (LAS float*)((LAS unsigned char*)lds + 141312 + wave * 2048), TK, TW, t, lane); }
            __syncthreads();
            if (tid < 256) { const int c = lcnt[tid]; lbase[tid] = c ? atomicAdd(&counts[tid], c) : 0; }
            __syncthreads();
            mo::route_finish8(lbase, list_tok, list_gate, TK, TW, rb * 128 + wave * 2, lane);
            __syncthreads();
        }
    }
    SEAM(5);
    if (IN(6)) {
        if (wave == 0) mo::moe_tables(counts, tb, yb, cn, lane);
        __syncthreads(); tables_ready = true;
        STAGGER(STG7);
        pg8::MoeSched<0> MS{G, vcu, tb[257], tb, cn, list_tok, WegT, ut, rg}; if (wave == 0) MS.build(lane); __syncthreads(); MS.fill_rows(list_gate, tid); __syncthreads(); pg8::EpiSwiGLU E{HID, rg, a.pad};
        pg8::gemm_phase2<pg8::EpiSwiGLU, pg8::MoeSched<0>>((LAS unsigned char*)lds, (const fx::bf16*)H1q, D / 2, 64, D / 2, MS, E, 128, 32768);
    }
    SEAM(6);
    if (IN(7)) {
        if (!tables_ready) { if (wave == 0) mo::moe_tables(counts, tb, yb, cn, lane); __syncthreads(); tables_ready = true; }
        STAGGER(STG8);
        pg8::MoeSched<1> MS{G, vcu, tb[257], tb, cn, list_tok, WedT, ut, rg}; if (wave == 0) MS.build(lane); __syncthreads(); pg8::EpiDown E{YA, yb, a.pad};
        pg8::gemm_phase2<pg8::EpiDown, pg8::MoeSched<1>>((LAS unsigned char*)lds, HID, 64, 64, ED / 2, MS, E, 32768, 32768);
    }
    SEAM(7);
    if (IN(8)) {
        if (!tables_ready) { if (wave == 0) mo::moe_tables(counts, tb, yb, cn, lane); __syncthreads(); tables_ready = true; }
        for (int t = vw; t < T; t += GW) mo::combine_token(H1, YA, TK, yb, ln2_g, ln2_b, out, t, lane);
    }
#undef IN
#undef SEAM
}

extern "C" void kernel_launch(void* const* d_in, const int* in_sizes, int n_in, void* d_out, int out_size, void* d_ws, size_t ws_size, hipStream_t stream) {
    static int grid = 0;
    if (grid == 0) {
        if (n_in != 21 || out_size != nv::T * nv::D || ws_size < WS_END * MiB) { fprintf(stderr, "kernel_launch: unexpected shapes n_in=%d out=%d ws=%zu\n", n_in, out_size, ws_size); grid = -1; return; }
        int dev = 0, cus = 0;
        if (hipGetDevice(&dev) != hipSuccess || hipDeviceGetAttribute(&cus, hipDeviceAttributeMultiprocessorCount, dev) != hipSuccess) { grid = -1; return; }
        if (hipFuncSetAttribute((const void*)mega_fwd, hipFuncAttributeMaxDynamicSharedMemorySize, LDS_BYTES) != hipSuccess) { fprintf(stderr, "kernel_launch: hipFuncSetAttribute failed\n"); grid = -1; return; }
        grid = cus;
    }
    if (grid < 0) return;
    if (hipMemsetAsync(d_ws, 0, CTL_ZERO_BYTES, stream) != hipSuccess) return;
    Args a{};
    for (int i = 0; i < 21; ++i) a.in[i] = (const float*)d_in[i];
    a.out = (float*)d_out; a.ws = (unsigned char*)d_ws; a.ph_lo = 0; a.ph_hi = NPHASE; a.li = 0;
#ifdef REPEAT_PH
    a.ph_hi = REPEAT_PH + 1; hipLaunchKernelGGL(mega_fwd, dim3(grid), dim3(NTHR), LDS_BYTES, stream, a);
    if (REPEAT_PH == 3) hipMemsetAsync((char*)d_ws + CW_FOXQ * 4, 0, 256, stream);
    if (REPEAT_PH == 5) hipMemsetAsync((char*)d_ws + CW_MOE * 4, 0, 4096, stream);
    a.ph_lo = REPEAT_PH; a.ph_hi = NPHASE; a.li = 1;
#ifdef REPEAT_NOEPI
    a.ph_hi = REPEAT_PH + 1; a.pad = 1; hipLaunchKernelGGL(mega_fwd, dim3(grid), dim3(NTHR), LDS_BYTES, stream, a); a.pad = 0; a.ph_lo = REPEAT_PH + 1; a.ph_hi = NPHASE; a.li = 2;
#endif
#endif
    hipLaunchKernelGGL(mega_fwd, dim3(grid), dim3(NTHR), LDS_BYTES, stream, a);
}
```
